# Optimizing an MI355X kernel written in HIP

```python
import jax, jax.numpy as jnp
from jax import lax
import numpy as np

D_MODEL = 1024
BATCH = 4
SEQ = 8192
DEPTH = 1

N_META = 16
CHUNK = 64
N_PAD = CHUNK - N_META
EPS = 1e-6

GLA_HEADS = 4
GLA_DV = D_MODEL // 2 // GLA_HEADS
GLA_DK = GLA_DV // 2
GLA_GATE_RANK = 16
GLA_GATE_TAU = 16.0

RET_HEADS = 4
RET_DV = D_MODEL // 2 // RET_HEADS
RET_DK = RET_DV // 2
ROPE_BASE = 10000.0

IN_SPLITS = (
    GLA_HEADS * GLA_DK,
    GLA_HEADS * GLA_DK,
    GLA_HEADS * GLA_DV,
    GLA_HEADS * GLA_DV,
    GLA_GATE_RANK,
    RET_HEADS * RET_DK,
    RET_HEADS * RET_DK,
    RET_HEADS * RET_DV,
    RET_HEADS * RET_DV,
)
IN_WIDTH = sum(IN_SPLITS)
MIX_WIDTH = GLA_HEADS * GLA_DV + RET_HEADS * RET_DV

PEER_HEADS = 8
PEER_NKEYS = 128
PEER_NEXPERTS = PEER_NKEYS * PEER_NKEYS
PEER_DKEY = 256
PEER_TOPK = 16

kernel_name = "hybrid_gla_retnet_peer_meta"


def rmsnorm(x, g):
    xf = x.astype(jnp.float32)
    y = xf * lax.rsqrt(jnp.mean(xf * xf, axis=-1, keepdims=True) + EPS)
    return (y * g.astype(jnp.float32)).astype(x.dtype)


def to_chunks(t, n_heads, d):
    b, p, _ = t.shape
    return t.reshape(b, p // CHUNK, CHUNK, n_heads, d).transpose(0, 3, 1, 2, 4)


def from_chunks(t):
    b, h, n, c, d = t.shape
    return t.transpose(0, 2, 3, 1, 4).reshape(b, n * c, h * d)


def apply_rope(t, cos, sin):
    t1, t2 = jnp.split(t, 2, axis=-1)
    c = cos[None, :, None, :]
    s = sin[None, :, None, :]
    return jnp.concatenate([t1 * c - t2 * s, t1 * s + t2 * c], axis=-1)


def gla_chunked(q, k, v, log_a):
    bcum = jnp.cumsum(log_a, axis=-2)
    b_last = bcum[..., -1:, :]
    q_t = q * jnp.exp(bcum)
    k_t = k * jnp.exp(-bcum)
    causal = jnp.tril(jnp.ones((CHUNK, CHUNK), dtype=bool))
    att = jnp.einsum('bhnid,bhnjd->bhnij', q_t, k_t)
    att = jnp.where(causal, att, 0.0)
    o_intra = jnp.einsum('bhnij,bhnjv->bhniv', att, v)
    k_end = k * jnp.exp(b_last - bcum)
    chunk_kv = jnp.einsum('bhnjd,bhnjv->bhndv', k_end, v)
    chunk_decay = jnp.exp(b_last[..., 0, :])

    def step(state, inp):
        kv_n, a_n = inp
        return a_n[..., None] * state + kv_n, state

    b, h, n, c, dk = q.shape
    s0 = jnp.zeros((b, h, dk, v.shape[-1]), jnp.float32)
    _, s_prev = lax.scan(step, s0, (jnp.moveaxis(chunk_kv, 2, 0), jnp.moveaxis(chunk_decay, 2, 0)))
    s_prev = jnp.moveaxis(s_prev, 0, 2)
    o_inter = jnp.einsum('bhnid,bhndv->bhniv', q_t, s_prev)
    return o_intra + o_inter


def retention_chunked(q, k, v, log_gamma):
    idx = jnp.arange(CHUNK, dtype=jnp.float32)
    lg = log_gamma[:, None]
    diff = idx[:, None] - idx[None, :]
    dmat = jnp.where(diff >= 0, jnp.exp(lg[..., None] * jnp.maximum(diff, 0.0)), 0.0)
    att = jnp.einsum('bhnid,bhnjd->bhnij', q, k) * dmat[None, :, None]
    o_intra = jnp.einsum('bhnij,bhnjv->bhniv', att, v)
    xi = jnp.exp(lg * (idx + 1.0))
    zeta = jnp.exp(lg * (CHUNK - 1.0 - idx))
    chunk_kv = jnp.einsum('bhnjd,hj,bhnjv->bhndv', k, zeta, v)
    gamma_chunk = jnp.exp(log_gamma * CHUNK)[None, :, None, None]

    def step(state, kv_n):
        return gamma_chunk * state + kv_n, state

    b, h, n, c, dk = q.shape
    r0 = jnp.zeros((b, h, dk, v.shape[-1]), jnp.float32)
    _, r_prev = lax.scan(step, r0, jnp.moveaxis(chunk_kv, 2, 0))
    r_prev = jnp.moveaxis(r_prev, 0, 2)
    o_inter = jnp.einsum('bhnid,bhndv->bhniv', q, r_prev) * xi[None, :, None, :, None]
    return o_intra + o_inter


def head_rmsnorm(o, g):
    return o * lax.rsqrt(jnp.mean(o * o, axis=-1, keepdims=True) + EPS) * g


def head_layernorm(o, g, b):
    mu = jnp.mean(o, axis=-1, keepdims=True)
    var = jnp.mean(jnp.square(o - mu), axis=-1, keepdims=True)
    return (o - mu) * lax.rsqrt(var + EPS) * g + b


def token_mixers(xn, w_in, gate_w2, gate_b, gla_gain, ret_gain, ret_bias, w_out,
                 valid, cos, sin, log_gamma):
    f32 = jnp.float32
    split_points = np.cumsum(IN_SPLITS)[:-1].tolist()
    proj = xn @ w_in
    gq, gk, gv, gg, ga, rq, rk, rv, rg = jnp.split(proj, split_points, axis=-1)
    mask = valid[None, :, None]

    log_a = jax.nn.log_sigmoid((ga @ gate_w2 + gate_b).astype(f32)) / GLA_GATE_TAU
    q = to_chunks(gq.astype(f32) * (GLA_DK ** -0.5), GLA_HEADS, GLA_DK)
    k = to_chunks((gk * mask).astype(f32), GLA_HEADS, GLA_DK)
    v = to_chunks(gv.astype(f32), GLA_HEADS, GLA_DV)
    o_gla = gla_chunked(q, k, v, to_chunks(log_a, GLA_HEADS, GLA_DK))
    o_gla = from_chunks(head_rmsnorm(o_gla, gla_gain.astype(f32)))
    o_gla = o_gla * jax.nn.silu(gg.astype(f32))

    b, p, _ = xn.shape
    rq4 = apply_rope(rq.astype(f32).reshape(b, p, RET_HEADS, RET_DK), cos, sin)
    rk4 = apply_rope((rk * mask).astype(f32).reshape(b, p, RET_HEADS, RET_DK), cos, sin) * (RET_DK ** -0.5)
    q = to_chunks(rq4.reshape(b, p, -1), RET_HEADS, RET_DK)
    k = to_chunks(rk4.reshape(b, p, -1), RET_HEADS, RET_DK)
    v = to_chunks(rv.astype(f32), RET_HEADS, RET_DV)
    o_ret = retention_chunked(q, k, v, log_gamma)
    o_ret = from_chunks(head_layernorm(o_ret, ret_gain.astype(f32), ret_bias.astype(f32)))
    o_ret = o_ret * jax.nn.silu(rg.astype(f32))

    o = jnp.concatenate([o_gla, o_ret], axis=-1).astype(xn.dtype)
    return o @ w_out


def peer(xn, w_q, subkeys, u, v):
    b, p, d = xn.shape
    n_chunks = p // CHUNK
    xb = xn.reshape(b, n_chunks, CHUNK, d).transpose(1, 0, 2, 3).reshape(n_chunks, b * CHUNK, d)

    def block(xt):
        t = xt.shape[0]
        q = (xt @ w_q).reshape(t, PEER_HEADS, 2, PEER_DKEY // 2)
        s = jnp.einsum('thcd,hcnd->thcn', q, subkeys).astype(jnp.float32)
        s_top, i_top = lax.top_k(s, PEER_TOPK)
        cand = s_top[:, :, 0, :, None] + s_top[:, :, 1, None, :]
        cand_idx = i_top[:, :, 0, :, None] * PEER_NKEYS + i_top[:, :, 1, None, :]
        best, pos = lax.top_k(cand.reshape(t, PEER_HEADS, PEER_TOPK * PEER_TOPK), PEER_TOPK)
        idx = jnp.take_along_axis(cand_idx.reshape(t, PEER_HEADS, PEER_TOPK * PEER_TOPK), pos, axis=-1)
        g = jax.nn.softmax(best, axis=-1)
        u_sel = u[idx]
        act = jax.nn.gelu(jnp.einsum('td,thkd->thk', xt, u_sel).astype(jnp.float32), approximate=False)
        coef = (g * act).astype(xt.dtype)
        v_sel = v[idx]
        return jnp.einsum('thk,thkd->td', coef, v_sel)

    out = lax.map(block, xb)
    return out.reshape(n_chunks, b, CHUNK, d).transpose(1, 0, 2, 3).reshape(b, p, d)


def setup_inputs(seed: int = 0) -> dict:
    key = jax.random.key(seed)
    ks = jax.random.split(key, 16)
    f32 = jnp.float32
    nrm = lambda k, shape, scale: jax.random.normal(k, shape, f32) * scale
    return {
        "x": nrm(ks[0], (BATCH, SEQ, D_MODEL), 1.0),
        "meta_tokens": nrm(ks[1], (N_META, D_MODEL), 1.0),
        "norm1_gain": 1.0 + nrm(ks[2], (DEPTH, D_MODEL), 0.02),
        "w_in": nrm(ks[3], (DEPTH, D_MODEL, IN_WIDTH), D_MODEL ** -0.5),
        "gla_gate_w2": nrm(ks[4], (DEPTH, GLA_GATE_RANK, GLA_HEADS * GLA_DK), GLA_GATE_RANK ** -0.5),
        "gla_gate_b": nrm(ks[5], (DEPTH, GLA_HEADS * GLA_DK), 0.1),
        "gla_norm_gain": 1.0 + nrm(ks[6], (DEPTH, GLA_DV), 0.02),
        "ret_norm_gain": 1.0 + nrm(ks[7], (DEPTH, RET_DV), 0.02),
        "ret_norm_bias": nrm(ks[8], (DEPTH, RET_DV), 0.02),
        "w_out": nrm(ks[9], (DEPTH, MIX_WIDTH, D_MODEL), MIX_WIDTH ** -0.5),
        "norm2_gain": 1.0 + nrm(ks[10], (DEPTH, D_MODEL), 0.02),
        "peer_w_q": nrm(ks[11], (DEPTH, D_MODEL, PEER_HEADS * PEER_DKEY), D_MODEL ** -0.5),
        "peer_subkeys": nrm(ks[12], (DEPTH, PEER_HEADS, 2, PEER_NKEYS, PEER_DKEY // 2), (PEER_DKEY // 2) ** -0.5),
        "peer_u": nrm(ks[13], (DEPTH, PEER_NEXPERTS, D_MODEL), D_MODEL ** -0.5),
        "peer_v": nrm(ks[14], (DEPTH, PEER_NEXPERTS, D_MODEL), PEER_HEADS ** -0.5),
        "final_gain": 1.0 + nrm(ks[15], (D_MODEL,), 0.02),
    }


def reference(x, meta_tokens, norm1_gain, w_in, gla_gate_w2, gla_gate_b, gla_norm_gain,
              ret_norm_gain, ret_norm_bias, w_out, norm2_gain, peer_w_q, peer_subkeys,
              peer_u, peer_v, final_gain):
    b, s, d = x.shape
    p = s + CHUNK
    pad = jnp.zeros((b, N_PAD, d), x.dtype)
    meta = jnp.broadcast_to(meta_tokens.astype(x.dtype)[None], (b, N_META, d))
    h = jnp.concatenate([pad, meta, x], axis=1)

    pos = (jnp.arange(p) - N_PAD).astype(jnp.float32)
    valid = (pos >= 0).astype(x.dtype)
    inv_freq = ROPE_BASE ** (-jnp.arange(0, RET_DK, 2, dtype=jnp.float32) / RET_DK)
    ang = pos[:, None] * inv_freq[None, :]
    cos, sin = jnp.cos(ang), jnp.sin(ang)
    log_gamma = jnp.log(1.0 - jnp.power(2.0, -5.0 - jnp.arange(RET_HEADS, dtype=jnp.float32)))

    for l in range(DEPTH):
        h = h + token_mixers(rmsnorm(h, norm1_gain[l]), w_in[l], gla_gate_w2[l], gla_gate_b[l],
                             gla_norm_gain[l], ret_norm_gain[l], ret_norm_bias[l], w_out[l],
                             valid, cos, sin, log_gamma).astype(h.dtype)
        h = h + peer(rmsnorm(h, norm2_gain[l]), peer_w_q[l], peer_subkeys[l],
                     peer_u[l], peer_v[l]).astype(h.dtype)

    h = rmsnorm(h, final_gain)
    return h[:, CHUNK:]
```

```cpp
#include <hip/hip_runtime.h>
#include <hip/hip_cooperative_groups.h>
#include <cstdio>
#include <cstdint>
namespace cg = cooperative_groups;
namespace pg8 {
#define PG8_LAS __attribute__((address_space(3)))
typedef unsigned short bf16_t;
typedef short bf16x8 __attribute__((ext_vector_type(8)));
typedef float f32x4 __attribute__((ext_vector_type(4)));
typedef unsigned u32x4 __attribute__((ext_vector_type(4)));
constexpr int BM = 256, BK = 64, HALF = 128, HTB = HALF * BK * 2  , STAGE_BYTES = 8 * HTB, NXCD = 8, WGM = 8;

__host__ __device__ __forceinline__ int lds_byte(int r, int c) { const int st = (r >> 4) * 2 + (c >> 5), rr = r & 15, cc = c & 31, ob = rr * 64 + cc * 2; return st * 1024 + (ob ^ (((ob >> 9) & 1) << 5)); }
__host__ __device__ __forceinline__ void stage_rc(int b, int& R, int& C) { const int st = b / 1024, sb = b % 1024, swz = sb ^ (((sb >> 9) & 1) << 5); R = (st >> 1) * 16 + swz / 64; C = (st & 1) * 32 + (swz % 64) / 2; }
__host__ __device__ __forceinline__ int perm32(int rho) { const int n = rho >> 4, i = rho & 15; return 8 * (i >> 2) + 4 * n + (i & 3); }

struct Unit { int pm, pn; };
struct Gemm { const bf16_t* A; const bf16_t* Bt; int M, N, K; };

struct StaticOrder {
    int nM, nN, nwg, G, c;
    __host__ __device__ void init(int M, int N, int G_, int c_) { nM = M / BM; nN = N / BM; nwg = nM * nN; G = G_; c = c_; }
    __host__ __device__ bool next(int i, Unit& u) const {
        const long L = (long)i * G + c; if (L >= nwg) return false;
        int wgid = (int)L; { const int q = nwg / NXCD, r = nwg % NXCD, xcd = wgid % NXCD, off = wgid / NXCD; wgid = (xcd < r ? xcd * (q + 1) : r * (q + 1) + (xcd - r) * q) + off; }
        const int nig = WGM * nN, gid = wgid / nig, fm = gid * WGM, gsz = (nM - fm) < WGM ? (nM - fm) : WGM;
        u.pm = fm + ((wgid % nig) % gsz); u.pn = (wgid % nig) / gsz; return true;
    }
    __device__ __forceinline__ void a_ready(const Unit&) const {}
    __device__ __forceinline__ void done(const Unit&) const {}
};

__device__ __forceinline__ unsigned cvt_pk_bf16(float lo, float hi) { unsigned r; asm volatile("v_cvt_pk_bf16_f32 %0, %1, %2" : "=v"(r) : "v"(lo), "v"(hi)); return r; }
typedef float f32x2 __attribute__((ext_vector_type(2)));
template <class Epi, class Sched, bool ALIGN_EPI = false, bool SP2 = false>
__device__ __forceinline__ void gemm_phase(PG8_LAS unsigned char* lds, const Gemm g, const Sched& S, const Epi& E) {
    const int tid = threadIdx.x, wid = __builtin_amdgcn_readfirstlane(tid >> 6), lane = tid & 63, wr = wid >> 2, wc = wid & 3, fr = lane & 15, fq = lane >> 4;
    const int K = g.K, nt = K / BK;
    unsigned voffA[2], voffB[2];
#pragma unroll
    for (int i = 0; i < 2; ++i) { int R, C; stage_rc(tid * 16 + i * 8192, R, C); const int Rb = Epi::PERM ? ((R & ~31) + perm32(R & 31)) : R;
        voffA[i] = (unsigned)(R * K + C) * 2u; voffB[i] = (unsigned)(Rb * K + C) * 2u; }
    const size_t kstep = (size_t)(BK * 2);
    const size_t hstep = (size_t)HALF * K * 2;
    const size_t tstep = 2 * hstep;
    const unsigned ldsw = (unsigned)wid * 1024u;
    const int aoff = lds_byte(wr * 64 + fr, fq * 8), boff = lds_byte(wc * 32 + fr, fq * 8);
#define PG8_SA(b, h) (((b) * 2 + (h)) * HTB)
#define PG8_SB(b, h) ((4 + (b) * 2 + (h)) * HTB)
#define PG8_STAGE(bufoff, gbase, voff) do { _Pragma("unroll") for (int _i = 0; _i < 2; ++_i) \
        __builtin_amdgcn_global_load_lds((const unsigned*)((const char*)(gbase) + (voff)[_i]), (PG8_LAS unsigned*)(lds + (bufoff) + ldsw + _i * 8192), 16, 0, 0); } while (0)
#define PG8_LDA(dst, b, h) do { _Pragma("unroll") for (int m = 0; m < 4; ++m) _Pragma("unroll") for (int k = 0; k < 2; ++k) dst[m][k] = *(const PG8_LAS bf16x8*)(lds + PG8_SA(b, h) + aoff + m * 2048 + k * 1024); } while (0)
#define PG8_LDB(dst, b, h) do { _Pragma("unroll") for (int n = 0; n < 2; ++n) _Pragma("unroll") for (int k = 0; k < 2; ++k) dst[n][k] = *(const PG8_LAS bf16x8*)(lds + PG8_SB(b, h) + boff + n * 2048 + k * 1024); } while (0)
#define PG8_MMA(ai, bj, At, Bt) do { __builtin_amdgcn_s_setprio(1); _Pragma("unroll") for (int m = 0; m < 4; ++m) _Pragma("unroll") for (int n = 0; n < 2; ++n) _Pragma("unroll") for (int k = 0; k < 2; ++k) \
        acc[ai][bj][m][n] = __builtin_amdgcn_mfma_f32_16x16x32_bf16(Bt[n][k], At[m][k], acc[ai][bj][m][n], 0, 0, 0); __builtin_amdgcn_s_setprio(0); } while (0)
#define PG8_WAIT_V(n) asm volatile("s_waitcnt vmcnt(" #n ")" ::: "memory")
#define PG8_WAIT_L(n) asm volatile("s_waitcnt lgkmcnt(" #n ")" ::: "memory")
#define PG8_BAR __builtin_amdgcn_s_barrier()
#define PG8_SCHED __builtin_amdgcn_sched_barrier(0)
    Unit cur, nxt; int ui = 0;
    if (!S.next(0, cur)) return;
    f32x4 acc[2][2][4][2];
#pragma unroll
    for (int a = 0; a < 2; ++a)
#pragma unroll
        for (int b = 0; b < 2; ++b)
#pragma unroll
            for (int m = 0; m < 4; ++m)
#pragma unroll
                for (int n = 0; n < 2; ++n) acc[a][b][m][n] = (f32x4){0.f, 0.f, 0.f, 0.f};
    bf16x8 At[4][2], B0[2][2], B1[2][2];
    const char* cA = (const char*)g.A + (size_t)cur.pm * tstep; const char* cB = (const char*)g.Bt + (size_t)cur.pn * tstep;
    S.a_ready(cur);
    if constexpr (SP2) {
        PG8_STAGE(PG8_SB(0, 0), cB, voffB); PG8_STAGE(PG8_SB(0, 1), cB + hstep, voffB); PG8_STAGE(PG8_SA(0, 0), cA, voffA); PG8_STAGE(PG8_SA(0, 1), cA + hstep, voffA);
        if (wr == 1) PG8_BAR;
        PG8_WAIT_V(2); PG8_BAR;
        PG8_STAGE(PG8_SB(1, 0), cB + kstep, voffB); PG8_STAGE(PG8_SA(1, 0), cA + kstep, voffA); PG8_STAGE(PG8_SB(1, 1), cB + hstep + kstep, voffB);
        PG8_WAIT_V(6); PG8_BAR;
    } else {
        PG8_STAGE(PG8_SB(0, 0), cB, voffB); PG8_STAGE(PG8_SA(0, 0), cA, voffA); PG8_STAGE(PG8_SB(0, 1), cB + hstep, voffB); PG8_STAGE(PG8_SA(0, 1), cA + hstep, voffA);
        if (wr == 1) PG8_BAR;
        PG8_WAIT_V(4); PG8_BAR;
        PG8_STAGE(PG8_SB(1, 0), cB + kstep, voffB); PG8_STAGE(PG8_SA(1, 0), cA + kstep, voffA); PG8_STAGE(PG8_SB(1, 1), cB + hstep + kstep, voffB);
        PG8_WAIT_V(6); PG8_BAR;
    }
    for (;;) {
        const bool has_next = S.next(ui + 1, nxt);
        const char* nA = has_next ? (const char*)g.A + (size_t)nxt.pm * tstep : cA; const char* nB = has_next ? (const char*)g.Bt + (size_t)nxt.pn * tstep : cB;
        for (int t = 0; t < nt; t += 2) {
            const bool last = (t == nt - 2);
            const char* a1 = cA + (size_t)(t + 1) * kstep;
            const char* a2 = last ? nA : cA + (size_t)(t + 2) * kstep; const char* b2 = last ? nB : cB + (size_t)(t + 2) * kstep;
            const char* a3 = a2 + kstep; const char* b3 = b2 + kstep;
            if (last && has_next) S.a_ready(nxt);
            if constexpr (SP2) {
            PG8_LDB(B0, 0, 0); PG8_LDB(B1, 0, 1); PG8_SCHED; PG8_LDA(At, 0, 0); PG8_STAGE(PG8_SA(1, 1), a1 + hstep, voffA);
            PG8_WAIT_V(8); PG8_WAIT_L(0); PG8_BAR; PG8_MMA(0, 0, At, B0); PG8_MMA(0, 1, At, B1); PG8_BAR; PG8_SCHED;
            PG8_LDA(At, 0, 1); PG8_STAGE(PG8_SB(0, 0), b2, voffB); PG8_STAGE(PG8_SB(0, 1), b2 + hstep, voffB); PG8_STAGE(PG8_SA(0, 0), a2, voffA);
            PG8_WAIT_V(8); PG8_WAIT_L(0); PG8_BAR; PG8_MMA(1, 0, At, B0); PG8_MMA(1, 1, At, B1); PG8_BAR; PG8_SCHED;
            PG8_LDB(B0, 1, 0); PG8_LDB(B1, 1, 1); PG8_SCHED; PG8_LDA(At, 1, 0); PG8_STAGE(PG8_SA(0, 1), a2 + hstep, voffA);
            PG8_WAIT_V(8); PG8_WAIT_L(0); PG8_BAR; PG8_MMA(0, 0, At, B0); PG8_MMA(0, 1, At, B1); PG8_BAR; PG8_SCHED;
            PG8_LDA(At, 1, 1); PG8_STAGE(PG8_SB(1, 0), b3, voffB); PG8_STAGE(PG8_SB(1, 1), b3 + hstep, voffB); PG8_STAGE(PG8_SA(1, 0), a3, voffA);
            PG8_WAIT_V(8); PG8_WAIT_L(0); PG8_BAR; PG8_MMA(1, 0, At, B0); PG8_MMA(1, 1, At, B1); PG8_BAR; PG8_SCHED;
            } else {
            PG8_LDB(B0, 0, 0); PG8_SCHED; PG8_LDA(At, 0, 0); PG8_STAGE(PG8_SA(1, 1), a1 + hstep, voffA);
            PG8_WAIT_L(8); PG8_BAR; PG8_WAIT_L(0); PG8_MMA(0, 0, At, B0); PG8_BAR; PG8_SCHED;
            PG8_LDB(B1, 0, 1); PG8_STAGE(PG8_SB(0, 0), b2, voffB);
            PG8_BAR; PG8_WAIT_L(0); PG8_MMA(0, 1, At, B1); PG8_BAR;
            PG8_LDA(At, 0, 1); PG8_STAGE(PG8_SA(0, 0), a2, voffA);
            PG8_BAR; PG8_WAIT_L(0); PG8_MMA(1, 0, At, B0); PG8_BAR; PG8_SCHED;
            PG8_STAGE(PG8_SB(0, 1), b2 + hstep, voffB);
            PG8_WAIT_V(6); PG8_BAR; PG8_MMA(1, 1, At, B1); PG8_BAR;
            PG8_LDB(B0, 1, 0); PG8_SCHED; PG8_LDA(At, 1, 0); PG8_STAGE(PG8_SA(0, 1), a2 + hstep, voffA);
            PG8_WAIT_L(8); PG8_BAR; PG8_WAIT_L(0); PG8_MMA(0, 0, At, B0); PG8_BAR; PG8_SCHED;
            PG8_LDB(B1, 1, 1); PG8_STAGE(PG8_SB(1, 0), b3, voffB);
            PG8_BAR; PG8_WAIT_L(0); PG8_MMA(0, 1, At, B1); PG8_BAR;
            PG8_LDA(At, 1, 1); PG8_STAGE(PG8_SA(1, 0), a3, voffA);
            PG8_BAR; PG8_WAIT_L(0); PG8_MMA(1, 0, At, B0); PG8_BAR; PG8_SCHED;
            PG8_STAGE(PG8_SB(1, 1), b3 + hstep, voffB);
            PG8_WAIT_V(6); PG8_BAR; PG8_MMA(1, 1, At, B1); PG8_BAR;
            }
        }
        if constexpr (ALIGN_EPI) { if (wr == 0) PG8_BAR; }
        if constexpr (!Epi::AFTER_DRAIN) { E(acc, cur, wr, wc, fr, fq); S.done(cur); }
        if (!has_next) break;
#pragma unroll
        for (int a = 0; a < 2; ++a)
#pragma unroll
            for (int b = 0; b < 2; ++b)
#pragma unroll
                for (int m = 0; m < 4; ++m)
#pragma unroll
                    for (int n = 0; n < 2; ++n) acc[a][b][m][n] = (f32x4){0.f, 0.f, 0.f, 0.f};
        cur = nxt; cA = nA; cB = nB; ++ui;
        if constexpr (ALIGN_EPI) { if (wr == 1) PG8_BAR; }
    }
    PG8_WAIT_V(0);
    if constexpr (!ALIGN_EPI) { if (wr == 0) PG8_BAR; }
    PG8_BAR;
    if constexpr (Epi::AFTER_DRAIN) { E.fused(acc, cur, wr, wc, fr, fq, lds, wid, lane); S.done(cur); }
#undef PG8_SA
#undef PG8_SB
#undef PG8_STAGE
#undef PG8_LDA
#undef PG8_LDB
#undef PG8_MMA
#undef PG8_WAIT_V
#undef PG8_WAIT_L
#undef PG8_BAR
#undef PG8_SCHED
}
}

#define LAS __attribute__((address_space(3)))
typedef unsigned short bf16_t;
typedef float f32x4 __attribute__((ext_vector_type(4)));
typedef unsigned u32x4 __attribute__((ext_vector_type(4)));
typedef unsigned u32x2 __attribute__((ext_vector_type(2)));
typedef short bf16x8 __attribute__((ext_vector_type(8)));
typedef short s16x4 __attribute__((ext_vector_type(4)));
typedef __bf16 bf16x2_t __attribute__((ext_vector_type(2)));
typedef _Float16 f16x2_t __attribute__((ext_vector_type(2)));

constexpr int DM = 1024, NB = 4, SEQ = 8192, NTOK = NB * SEQ;
constexpr int MROWS = NTOK + 256;
constexpr int INW = 3088;
constexpr int NPROJ = 3072, NP1 = 3328;
constexpr int NEXP = 16384;
constexpr float EPS = 1e-6f;
constexpr int C_GQ = 0, C_GK = 256, C_GV = 512, C_GG = 1024, C_RQ = 1536, C_RK = 1792, C_RV = 2048, C_RG = 2560;
constexpr int S_GA = 1536, S_RQ = 1552, S_RV = 2064;

constexpr size_t MiB = 1u << 20;
constexpr size_t WS_CTL = 0, WS_WIN = 1 * MiB, WS_WOUT = 8 * MiB, WS_WS = 10 * MiB, WS_ROPE = 14 * MiB, WS_SSQ = 17 * MiB, WS_SEG = 19 * MiB, WS_ASEG = 27 * MiB,
                 WS_UB = 28 * MiB, WS_VB = 60 * MiB, WS_XN = 92 * MiB, WS_O = 157 * MiB, WS_LA = 221 * MiB, WS_PROJ = 254 * MiB, WS_END = 448 * MiB;
static_assert(WS_WIN + (size_t)NP1 * DM * 2 <= WS_WOUT && WS_ROPE + (size_t)(SEQ + 64) * 32 * 8 <= WS_SSQ && WS_XN + (size_t)MROWS * DM * 2 <= WS_O &&
              WS_LA + (size_t)MROWS * 256 * 4 <= WS_PROJ && WS_PROJ + (size_t)MROWS * NPROJ * 2 <= WS_END && WS_PROJ + (size_t)NTOK * 2048 * 2 <= WS_END, "ws map");

constexpr int LDS_BYTES = 147456;
constexpr int NPHASE = 7;
#ifndef PEER_SIMPLE
#define PEER_SIMPLE 0
#endif
#ifndef PEER_SIMPLE_TAIL
#define PEER_SIMPLE_TAIL 0
#define TAIL_U_F32 0
#endif

struct Params {
    const float *x, *meta, *g1, *w_in, *gw2, *gb, *gla_gain, *ret_gain, *ret_bias, *w_out, *g2, *w_q, *subkeys, *pu, *pv, *gfin;
    float* out; unsigned char* ws;
    int ph_lo, ph_hi;
};

#define LDS_WAIT() asm volatile("s_waitcnt lgkmcnt(0)" ::: "memory")
__device__ __forceinline__ unsigned f2bf(float f) { unsigned u = __builtin_bit_cast(unsigned, f); return (u + 0x7fffu + ((u >> 16) & 1u)) >> 16; }
__device__ __forceinline__ unsigned pk2(float lo, float hi) { return f2bf(lo) | (f2bf(hi) << 16); }
__device__ __forceinline__ float bf_lo(unsigned w) { return __builtin_bit_cast(float, w << 16); }
__device__ __forceinline__ float bf_hi(unsigned w) { return __builtin_bit_cast(float, w & 0xffff0000u); }
__device__ __forceinline__ float bf1(bf16_t h) { return __builtin_bit_cast(float, (unsigned)h << 16); }
__device__ __forceinline__ float wave_sum(float v) {
#pragma unroll
    for (int o = 1; o < 64; o <<= 1) v += __shfl_xor(v, o);
    return v;
}

struct MapIn {
    __device__ __forceinline__ void operator()(int j, int& src, float& sc) const {
        if (j < C_RQ) { src = j; sc = (j < 256) ? 0.125f : 1.0f; }
        else if (j < C_RV) { const int jj = j - C_RQ, which = jj >> 8, within = jj & 255, head = within >> 6, p = within & 63;
            const int a = p >> 3, n = (p >> 2) & 1, i = p & 3; src = S_RQ + which * 256 + head * 64 + 32 * n + 4 * a + i; sc = which ? 0.125f : 1.0f; }
        else { src = S_RV + (j - C_RV); sc = 1.0f; }
    }
};
struct MapId { __device__ __forceinline__ void operator()(int j, int& src, float& sc) const { src = j; sc = 1.0f; } };

template <class Map>
__device__ __forceinline__ void transpose_item(const float* W, int K, int N, bf16_t* WT, LAS float* scr, int item, int nblk, int lane, const Map map) {
    const int kb = item / nblk, nb = item % nblk, k0 = 64 * kb, n0 = 32 * nb;
    int src; float sc; map(n0 + (lane & 31), src, sc);
#pragma unroll 8
    for (int i = 0; i < 32; ++i) { const int kk = 2 * i + (lane >> 5); scr[kk * 33 + (lane & 31)] = W[(size_t)(k0 + kk) * N + src] * sc; }
    LDS_WAIT();
    const int c = lane & 7;
#pragma unroll
    for (int j = 0; j < 4; ++j) { const int n = (lane >> 3) + 8 * j; const LAS float* s = scr + (8 * c) * 33 + n;
        u32x4 o; o.x = pk2(s[0 * 33], s[1 * 33]); o.y = pk2(s[2 * 33], s[3 * 33]); o.z = pk2(s[4 * 33], s[5 * 33]); o.w = pk2(s[6 * 33], s[7 * 33]);
        *(u32x4*)(WT + (size_t)(n0 + n) * K + k0 + 8 * c) = o; }
    LDS_WAIT();
}

__device__ __forceinline__ void phase0(const Params& p, LAS unsigned char* lds, int bid, int nb) {
    const int tid = threadIdx.x, lane = tid & 63, wave = __builtin_amdgcn_readfirstlane(tid >> 6);
    unsigned char* ws = p.ws;
    bf16_t* XN = (bf16_t*)(ws + WS_XN); bf16_t* WinT = (bf16_t*)(ws + WS_WIN); bf16_t* WoutT = (bf16_t*)(ws + WS_WOUT); bf16_t* WsT = (bf16_t*)(ws + WS_WS);
    const int gw = bid * 8 + wave, NGW = nb * 8;
    const int gt = bid * 512 + tid, NGT = nb * 512;

    {
        LAS float* SKT = (LAS float*)lds;
        LAS float* WQT = (LAS float*)(lds + 128 * 132 * 4);
        for (int item = bid; item < 256; item += nb) {
            const int hc = item >> 4, kb = item & 15;
            __syncthreads();
            for (int e = tid; e < 128 * 128; e += 512) { const int n = e >> 7, d = e & 127; SKT[d * 132 + n] = p.subkeys[(size_t)hc * 16384 + e]; }
            for (int e = tid; e < 64 * 128; e += 512) { const int k = e >> 7, d = e & 127; WQT[d * 68 + k] = p.w_q[(size_t)(kb * 64 + k) * 2048 + hc * 128 + d]; }
            __syncthreads();
            const int tn = tid & 31, tk = tid >> 5;
            f32x4 acc[4];
#pragma unroll
            for (int i = 0; i < 4; ++i) acc[i] = (f32x4){0.f, 0.f, 0.f, 0.f};
#pragma unroll 4
            for (int d = 0; d < 128; ++d) {
                const f32x4 sk = *(const LAS f32x4*)(SKT + d * 132 + 4 * tn); const f32x4 wq = *(const LAS f32x4*)(WQT + d * 68 + 4 * tk);
#pragma unroll
                for (int i = 0; i < 4; ++i) acc[i] += sk[i] * wq;
            }
            const f32x4 gg = *(const f32x4*)(p.g2 + kb * 64 + 4 * tk);
#pragma unroll
            for (int i = 0; i < 4; ++i) { const f32x4 v = acc[i] * gg; u32x2 o; o.x = pk2(v[0], v[1]); o.y = pk2(v[2], v[3]);
                *(u32x2*)(WsT + (size_t)(hc * 128 + 4 * tn + i) * DM + kb * 64 + 4 * tk) = o; }
        }
        __syncthreads();
    }
    {
        LAS float* scr = (LAS float*)(lds + wave * 16384);
        constexpr int I_IN = (DM / 64) * (NPROJ / 32), I_OUT = (DM / 64) * (DM / 32);
        for (int it = gw; it < I_IN + I_OUT; it += NGW) {
            if (it < I_IN) transpose_item(p.w_in, DM, INW, WinT, scr, it, NPROJ / 32, lane, MapIn());
            else transpose_item(p.w_out, DM, DM, WoutT, scr, it - I_IN, DM / 32, lane, MapId());
        }
    }
    for (int e = gt; e < 256 * DM; e += NGT) {
        const int n = e >> 10, k = e & 1023; const float* wr = p.w_in + (size_t)k * INW + S_GA; float s = 0.f;
#pragma unroll
        for (int r = 0; r < 16; ++r) s += wr[r] * p.gw2[r * 256 + n];
        WinT[(size_t)(NPROJ + n) * DM + k] = (bf16_t)f2bf(s);
    }
    {
        u32x2* UB = (u32x2*)(ws + WS_UB); u32x2* VB = (u32x2*)(ws + WS_VB);
        const f32x4* u4 = (const f32x4*)p.pu; const f32x4* v4 = (const f32x4*)p.pv;
        for (int e = gt; e < NEXP * DM / 4; e += NGT) { const f32x4 a = u4[e]; u32x2 o; o.x = pk2(a[0], a[1]); o.y = pk2(a[2], a[3]); UB[e] = o;
            const f32x4 b = v4[e]; u32x2 q; q.x = pk2(b[0], b[1]); q.y = pk2(b[2], b[3]); VB[e] = q; }
    }
    {
        float2* rope = (float2*)(ws + WS_ROPE);
        for (int e = gt; e < (SEQ + 64) * 32; e += NGT) { const int pi = e >> 5, d = e & 31;
            const float invf = (float)pow(10000.0, -(double)d / 32.0); const float ang = (float)(pi - 48) * invf;
            rope[e] = make_float2((float)cos((double)ang), (float)sin((double)ang)); }
    }
    for (int m = gw; m < MROWS; m += NGW) {
        const float* src = nullptr;
        if (m >= 256) src = p.x + (size_t)(m - 256) * DM; else if (m >= 48 && m < 64) src = p.meta + (size_t)(m - 48) * DM;
        unsigned long long* o8 = (unsigned long long*)(XN + (size_t)m * DM) + lane;
        if (src == nullptr) {
#pragma unroll
            for (int j = 0; j < 4; ++j) o8[64 * j] = 0ull;
        } else {
            const f32x4* xr = (const f32x4*)src + lane; const f32x4* gr = (const f32x4*)p.g1 + lane;
            f32x4 v[4]; float s = 0.f;
#pragma unroll
            for (int j = 0; j < 4; ++j) { v[j] = xr[64 * j]; s += (v[j].x * v[j].x + v[j].y * v[j].y) + (v[j].z * v[j].z + v[j].w * v[j].w); }
            const float r = 1.0f / sqrtf(wave_sum(s) * (1.0f / DM) + EPS);
#pragma unroll
            for (int j = 0; j < 4; ++j) { const f32x4 g = gr[64 * j]; const f32x4 y = v[j] * r * g;
                o8[64 * j] = (unsigned long long)pk2(y.x, y.y) | ((unsigned long long)pk2(y.z, y.w) << 32); }
        }
    }
}

struct EpiProj {
    static constexpr bool PERM = true, AFTER_DRAIN = false;
    bf16_t* PROJ; float* LA; const float* gb; const float2* rope;
    __device__ __forceinline__ void operator()(const pg8::f32x4 (&acc)[2][2][4][2], const pg8::Unit& u, int wr, int wc, int fr, int fq) const {
        const int row0 = u.pm * 256 + wr * 64 + fr, cb0 = wc * 32 + 8 * fq;
        if (u.pn == 12) {
#pragma unroll
            for (int bj = 0; bj < 2; ++bj) { const int c = cb0 + 128 * bj; const f32x4 b0 = *(const f32x4*)(gb + c), b1 = *(const f32x4*)(gb + c + 4);
#pragma unroll
                for (int ai = 0; ai < 2; ++ai)
#pragma unroll
                    for (int m = 0; m < 4; ++m) { const int row = row0 + ai * 128 + m * 16; f32x4 v0 = acc[ai][bj][m][0] + b0, v1 = acc[ai][bj][m][1] + b1;
#pragma unroll
                        for (int i = 0; i < 4; ++i) { v0[i] = (fminf(v0[i], 0.f) - log1pf(__expf(-fabsf(v0[i])))) * 0.0625f; v1[i] = (fminf(v1[i], 0.f) - log1pf(__expf(-fabsf(v1[i])))) * 0.0625f; }
                        float* o = LA + (size_t)row * 256 + c; *(f32x4*)o = v0; *(f32x4*)(o + 4) = v1; } }
        } else if (u.pn == 6 || u.pn == 7) {
#pragma unroll
            for (int ai = 0; ai < 2; ++ai)
#pragma unroll
                for (int m = 0; m < 4; ++m) { const int row = row0 + ai * 128 + m * 16; const int pidx = (row < 256) ? row : 64 + ((row - 256) & (SEQ - 1));
#pragma unroll
                    for (int bj = 0; bj < 2; ++bj) { const int c = cb0 + 128 * bj, d0 = (c & 63) >> 1;
                        const f32x4 cs0 = *(const f32x4*)(rope + (size_t)pidx * 32 + d0), cs1 = *(const f32x4*)(rope + (size_t)pidx * 32 + d0 + 2);
                        const f32x4 t1 = acc[ai][bj][m][0], t2 = acc[ai][bj][m][1];
                        const float co[4] = {cs0[0], cs0[2], cs1[0], cs1[2]}, si[4] = {cs0[1], cs0[3], cs1[1], cs1[3]};
                        float o1[4], o2[4];
#pragma unroll
                        for (int i = 0; i < 4; ++i) { o1[i] = t1[i] * co[i] - t2[i] * si[i]; o2[i] = t1[i] * si[i] + t2[i] * co[i]; }
                        u32x4 w; w.x = pg8::cvt_pk_bf16(o1[0], o1[1]); w.y = pg8::cvt_pk_bf16(o1[2], o1[3]); w.z = pg8::cvt_pk_bf16(o2[0], o2[1]); w.w = pg8::cvt_pk_bf16(o2[2], o2[3]);
                        *(u32x4*)(PROJ + (size_t)row * NPROJ + u.pn * 256 + c) = w; } }
        } else {
#pragma unroll
            for (int ai = 0; ai < 2; ++ai)
#pragma unroll
                for (int m = 0; m < 4; ++m) { bf16_t* rowp = PROJ + (size_t)(row0 + ai * 128 + m * 16) * NPROJ + u.pn * 256 + cb0;
#pragma unroll
                    for (int bj = 0; bj < 2; ++bj) { const f32x4 v0 = acc[ai][bj][m][0], v1 = acc[ai][bj][m][1];
                        u32x4 w; w.x = pg8::cvt_pk_bf16(v0[0], v0[1]); w.y = pg8::cvt_pk_bf16(v0[2], v0[3]); w.z = pg8::cvt_pk_bf16(v1[0], v1[1]); w.w = pg8::cvt_pk_bf16(v1[2], v1[3]);
                        *(u32x4*)(rowp + bj * 128) = w; } }
        }
    }
};
struct EpiRes {
    static constexpr bool PERM = true, AFTER_DRAIN = false;
    const float* x; bf16_t* HB; float* SSQ;
    __device__ __forceinline__ void operator()(const pg8::f32x4 (&acc)[2][2][4][2], const pg8::Unit& u, int wr, int wc, int fr, int fq) const {
        const int row0 = u.pm * 256 + wr * 64 + fr, col0 = u.pn * 256 + wc * 32 + 8 * fq;
#pragma unroll
        for (int ai = 0; ai < 2; ++ai)
#pragma unroll
            for (int m = 0; m < 4; ++m) { const int row = row0 + ai * 128 + m * 16; const float* xr = x + (size_t)row * DM + col0; bf16_t* hr = HB + (size_t)row * DM + col0; float ss = 0.f;
#pragma unroll
                for (int bj = 0; bj < 2; ++bj) { const f32x4 v0 = acc[ai][bj][m][0] + *(const f32x4*)(xr + bj * 128), v1 = acc[ai][bj][m][1] + *(const f32x4*)(xr + bj * 128 + 4);
                    ss += (v0[0] * v0[0] + v0[1] * v0[1]) + (v0[2] * v0[2] + v0[3] * v0[3]) + (v1[0] * v1[0] + v1[1] * v1[1]) + (v1[2] * v1[2] + v1[3] * v1[3]);
                    u32x4 w; w.x = pg8::cvt_pk_bf16(v0[0], v0[1]); w.y = pg8::cvt_pk_bf16(v0[2], v0[3]); w.z = pg8::cvt_pk_bf16(v1[0], v1[1]); w.w = pg8::cvt_pk_bf16(v1[2], v1[3]);
                    *(u32x4*)(hr + bj * 128) = w; }
                ss += __shfl_xor(ss, 16); ss += __shfl_xor(ss, 32);
                if (fq == 0) SSQ[(size_t)row * 16 + u.pn * 4 + wc] = ss; }
    }
};
struct EpiF16 {
    static constexpr bool PERM = true, AFTER_DRAIN = false;
    _Float16* SC;
    __device__ __forceinline__ void operator()(const pg8::f32x4 (&acc)[2][2][4][2], const pg8::Unit& u, int wr, int wc, int fr, int fq) const {
        const int row0 = u.pm * 256 + wr * 64 + fr, col0 = u.pn * 256 + wc * 32 + 8 * fq;
#pragma unroll
        for (int ai = 0; ai < 2; ++ai)
#pragma unroll
            for (int m = 0; m < 4; ++m) { _Float16* rowp = SC + (size_t)(row0 + ai * 128 + m * 16) * 2048 + col0;
#pragma unroll
                for (int bj = 0; bj < 2; ++bj) { const f32x4 v0 = acc[ai][bj][m][0], v1 = acc[ai][bj][m][1];
                    u32x4 w;
                    w.x = __builtin_bit_cast(unsigned, (f16x2_t){(_Float16)v0[0], (_Float16)v0[1]}); w.y = __builtin_bit_cast(unsigned, (f16x2_t){(_Float16)v0[2], (_Float16)v0[3]});
                    w.z = __builtin_bit_cast(unsigned, (f16x2_t){(_Float16)v1[0], (_Float16)v1[1]}); w.w = __builtin_bit_cast(unsigned, (f16x2_t){(_Float16)v1[2], (_Float16)v1[3]});
                    *(u32x4*)(rowp + bj * 128) = w; } }
    }
};

constexpr int A_QT = 0, A_KT = 9216, A_KE = 18432, A_V = 27648, A_ST = 45056, A_STSZ = 18432, A_OB = 81920, A_DEC = 115712, A_CS = 115968;
constexpr int PQ = 72, PV = 136, POB = 132;

__device__ __forceinline__ bf16x8 tr2(const LAS bf16_t* p0, const LAS bf16_t* p1) {
    const s16x4 a = __builtin_amdgcn_ds_read_tr16_b64_v4i16((LAS s16x4*)p0), b = __builtin_amdgcn_ds_read_tr16_b64_v4i16((LAS s16x4*)p1);
    return (bf16x8){a[0], a[1], a[2], a[3], b[0], b[1], b[2], b[3]};
}
__device__ __forceinline__ float ln_gamma(int hr) { return log1pf(-exp2f(-5.0f - (float)hr)); }

template <bool FULL>
__device__ __forceinline__ void attn_pass(const Params& p, LAS unsigned char* lds, int bid, int nb) {
    const int tid = threadIdx.x, lane = tid & 63, wave = __builtin_amdgcn_readfirstlane(tid >> 6);
    const int r16 = lane & 15, g4 = lane >> 4, q4 = (lane & 15) >> 2, p4 = lane & 3;
    unsigned char* ws = p.ws;
    const bf16_t* PROJ = (const bf16_t*)(ws + WS_PROJ); const float* LA = (const float*)(ws + WS_LA);
    float* SEG = (float*)(ws + WS_SEG); float* ASEG = (float*)(ws + WS_ASEG); bf16_t* OUT = (bf16_t*)(ws + WS_O);
    LAS bf16_t* QT = (LAS bf16_t*)(lds + A_QT); LAS bf16_t* KT = (LAS bf16_t*)(lds + A_KT); LAS bf16_t* KE = (LAS bf16_t*)(lds + A_KE); LAS bf16_t* VS = (LAS bf16_t*)(lds + A_V);
    LAS float* OB = (LAS float*)(lds + A_OB); LAS float* DEC = (LAS float*)(lds + A_DEC); LAS float* CS = (LAS float*)(lds + A_CS);

    for (int item = bid; item < 256; item += nb) {
        const int seg = item & 7, h8 = (item >> 3) & 7, b = item >> 6;
        if (!FULL && seg == 7) continue;
        const bool gla = h8 < 4; const int hr = h8 & 3;
        const float lng = ln_gamma(hr);
        const int qcol = gla ? C_GQ + hr * 64 : C_RQ + hr * 64, kcol = gla ? C_GK + hr * 64 : C_RK + hr * 64;
        const int vcol = gla ? C_GV + hr * 128 : C_RV + hr * 128, gcol = gla ? C_GG + hr * 128 : C_RG + hr * 128;
        const int nch = (seg == 0) ? 17 : 16;

        f32x4 accS[8];
#pragma unroll
        for (int cb = 0; cb < 8; ++cb) accS[cb] = (f32x4){0.f, 0.f, 0.f, 0.f};
        float blsum = 0.f;
        __syncthreads();
        if (FULL) {
            if (wave >= 4) {
                const int wq = wave - 4;
                for (int sp = 0; sp < seg; ++sp) { const int it2 = (item & ~7) + sp; const float* Sg = SEG + (size_t)it2 * 8192; const float* Ag = ASEG + it2 * 64;
                    float dec[4];
#pragma unroll
                    for (int rg = 0; rg < 4; ++rg) dec[rg] = Ag[16 * wq + 4 * g4 + rg];
#pragma unroll
                    for (int cb = 0; cb < 8; ++cb)
#pragma unroll
                        for (int rg = 0; rg < 4; ++rg) accS[cb][rg] = dec[rg] * accS[cb][rg] + Sg[(16 * wq + 4 * g4 + rg) * 128 + 16 * cb + r16]; }
                LAS bf16_t* ST0 = (LAS bf16_t*)(lds + A_ST);
#pragma unroll
                for (int cb = 0; cb < 8; ++cb) { u32x2 w; w.x = pk2(accS[cb][0], accS[cb][1]); w.y = pk2(accS[cb][2], accS[cb][3]); *(LAS u32x2*)(ST0 + (16 * cb + r16) * PQ + 16 * wq + 4 * g4) = w; }
            }
        }
        for (int ci = 0; ci < nch; ++ci) {
            const bool metac = (seg == 0 && ci == 0);
            const int rc = (seg == 0) ? ci - 1 : 16 * seg + ci;
            const int rowbase = metac ? 0 : 256 + b * SEQ + rc * 64;
            const LAS bf16_t* STr = (const LAS bf16_t*)(lds + A_ST + (ci & 1) * A_STSZ); LAS bf16_t* STw = (LAS bf16_t*)(lds + A_ST + ((ci + 1) & 1) * A_STSZ);
            const int d = tid & 63, sg = tid >> 6;
            float pre[8]; bf16_t qv[8], kv[8];
            {
                float run = 0.f;
#pragma unroll
                for (int k = 0; k < 8; ++k) { const size_t row = (size_t)(rowbase + 8 * sg + k);
                    const float la = gla ? LA[row * 256 + hr * 64 + d] : lng; run += la; pre[k] = run;
                    if (FULL) qv[k] = PROJ[row * NPROJ + qcol + d];
                    kv[k] = PROJ[row * NPROJ + kcol + d]; }
                CS[sg * 64 + d] = run;
            }
            u32x4 vreg[2];
            { const int vr = tid >> 3, cc = tid & 7; const u32x4* src = (const u32x4*)(PROJ + (size_t)(rowbase + vr) * NPROJ + vcol + cc * 16); vreg[0] = src[0]; vreg[1] = src[1]; }
            __syncthreads();
            {
                float off = 0.f, tot = 0.f;
#pragma unroll
                for (int s = 0; s < 8; ++s) { const float c = CS[s * 64 + d]; tot += c; off += (s < sg) ? c : 0.f; }
#pragma unroll
                for (int k = 0; k < 8; ++k) { const float bc = off + pre[k]; const int i = 8 * sg + k; const float kf = bf1(kv[k]);
                    if (FULL) { QT[i * PQ + d] = (bf16_t)f2bf(bf1(qv[k]) * __expf(bc)); KT[i * PQ + d] = (bf16_t)f2bf(kf * __expf(-bc)); }
                    KE[i * PQ + d] = (bf16_t)f2bf(kf * __expf(tot - bc)); }
                if (sg == 0) { DEC[d] = __expf(tot); blsum += tot; }
                const int vr = tid >> 3, cc = tid & 7; LAS u32x4* dst = (LAS u32x4*)(VS + vr * PV + cc * 16); dst[0] = vreg[0]; dst[1] = vreg[1];
            }
            __syncthreads();
            if (wave < 4) {
                if (FULL && !metac) {
                    const int w = wave;
                    bf16x8 qf[2];
#pragma unroll
                    for (int s = 0; s < 2; ++s) qf[s] = *(const LAS bf16x8*)(QT + (16 * w + r16) * PQ + 32 * s + 8 * g4);
                    f32x4 att[4];
#pragma unroll
                    for (int jb = 0; jb < 4; ++jb) { att[jb] = (f32x4){0.f, 0.f, 0.f, 0.f};
                        if (jb <= w) {
#pragma unroll
                            for (int s = 0; s < 2; ++s) { const bf16x8 kf = *(const LAS bf16x8*)(KT + (16 * jb + r16) * PQ + 32 * s + 8 * g4);
                                att[jb] = __builtin_amdgcn_mfma_f32_16x16x32_bf16(kf, qf[s], att[jb], 0, 0, 0); }
                            if (jb == w) {
#pragma unroll
                                for (int rg = 0; rg < 4; ++rg) att[jb][rg] = (4 * g4 + rg <= r16) ? att[jb][rg] : 0.f;
                            }
                        } }
                    bf16x8 af[2];
#pragma unroll
                    for (int s = 0; s < 2; ++s) { u32x4 t; t.x = pk2(att[2 * s][0], att[2 * s][1]); t.y = pk2(att[2 * s][2], att[2 * s][3]); t.z = pk2(att[2 * s + 1][0], att[2 * s + 1][1]); t.w = pk2(att[2 * s + 1][2], att[2 * s + 1][3]);
                        af[s] = __builtin_bit_cast(bf16x8, t); }
#pragma unroll
                    for (int cb = 0; cb < 8; ++cb) { f32x4 o = (f32x4){0.f, 0.f, 0.f, 0.f};
#pragma unroll
                        for (int s = 0; s < 2; ++s) {
                            const bf16x8 vf = tr2(VS + (32 * s + 4 * g4 + q4) * PV + 16 * cb + 4 * p4, VS + (32 * s + 16 + 4 * g4 + q4) * PV + 16 * cb + 4 * p4);
                            o = __builtin_amdgcn_mfma_f32_16x16x32_bf16(af[s], vf, o, 0, 0, 0);
                            const bf16x8 sf = *(const LAS bf16x8*)(STr + (16 * cb + r16) * PQ + 32 * s + 8 * g4);
                            o = __builtin_amdgcn_mfma_f32_16x16x32_bf16(qf[s], sf, o, 0, 0, 0); }
#pragma unroll
                        for (int rg = 0; rg < 4; ++rg) OB[(16 * w + 4 * g4 + rg) * POB + 16 * cb + r16] = o[rg]; }
                }
            } else {
                const int wq = wave - 4;
                float dec[4];
#pragma unroll
                for (int rg = 0; rg < 4; ++rg) dec[rg] = DEC[16 * wq + 4 * g4 + rg];
                bf16x8 kef[2];
#pragma unroll
                for (int s = 0; s < 2; ++s) kef[s] = tr2(KE + (32 * s + 8 * g4 + q4) * PQ + 16 * wq + 4 * p4, KE + (32 * s + 8 * g4 + 4 + q4) * PQ + 16 * wq + 4 * p4);
#pragma unroll
                for (int cb = 0; cb < 8; ++cb) {
#pragma unroll
                    for (int rg = 0; rg < 4; ++rg) accS[cb][rg] *= dec[rg];
#pragma unroll
                    for (int s = 0; s < 2; ++s) { const bf16x8 vf = tr2(VS + (32 * s + 8 * g4 + q4) * PV + 16 * cb + 4 * p4, VS + (32 * s + 8 * g4 + 4 + q4) * PV + 16 * cb + 4 * p4);
                        accS[cb] = __builtin_amdgcn_mfma_f32_16x16x32_bf16(kef[s], vf, accS[cb], 0, 0, 0); }
                    if (FULL) { u32x2 w; w.x = pk2(accS[cb][0], accS[cb][1]); w.y = pk2(accS[cb][2], accS[cb][3]); *(LAS u32x2*)(STw + (16 * cb + r16) * PQ + 16 * wq + 4 * g4) = w; }
                }
            }
            __syncthreads();
            if (FULL && !metac) {
                const int i = tid >> 3, cc = tid & 7;
                float o[16];
#pragma unroll
                for (int k4 = 0; k4 < 4; ++k4) { const f32x4 t = *(const LAS f32x4*)(OB + i * POB + 16 * cc + 4 * k4); o[4 * k4] = t[0]; o[4 * k4 + 1] = t[1]; o[4 * k4 + 2] = t[2]; o[4 * k4 + 3] = t[3]; }
                const size_t row = (size_t)(rowbase + i);
                const u32x4* gp = (const u32x4*)(PROJ + row * NPROJ + gcol + 16 * cc); const u32x4 ga = gp[0], gb2 = gp[1];
                const unsigned gw[8] = {ga.x, ga.y, ga.z, ga.w, gb2.x, gb2.y, gb2.z, gb2.w};
                float s1 = 0.f, s2 = 0.f;
#pragma unroll
                for (int k = 0; k < 16; ++k) { s1 += o[k]; s2 += o[k] * o[k]; }
#pragma unroll
                for (int m = 1; m < 8; m <<= 1) { s1 += __shfl_xor(s1, m); s2 += __shfl_xor(s2, m); }
                float mu, rs;
                if (gla) { mu = 0.f; rs = 1.0f / sqrtf(s2 * (1.0f / 128.0f) + EPS); }
                else { mu = s1 * (1.0f / 128.0f); const float var = fmaxf(s2 * (1.0f / 128.0f) - mu * mu, 0.f); rs = 1.0f / sqrtf(var + EPS); }
                const float* gn = (gla ? p.gla_gain : p.ret_gain) + 16 * cc; const float* bs = p.ret_bias + 16 * cc;
                unsigned ow[8];
#pragma unroll
                for (int k2 = 0; k2 < 8; ++k2) { float y[2];
#pragma unroll
                    for (int e = 0; e < 2; ++e) { const int k = 2 * k2 + e; float v = (o[k] - mu) * rs * gn[k]; if (!gla) v += bs[k];
                        const float gt = e ? bf_hi(gw[k2]) : bf_lo(gw[k2]); y[e] = v * gt / (1.0f + __expf(-gt)); }
                    ow[k2] = pk2(y[0], y[1]); }
                u32x4* op = (u32x4*)(OUT + (row - 256) * DM + h8 * 128 + 16 * cc);
                op[0] = (u32x4){ow[0], ow[1], ow[2], ow[3]}; op[1] = (u32x4){ow[4], ow[5], ow[6], ow[7]};
            }
        }
        if (!FULL) {
            if (wave >= 4) { const int wq = wave - 4; float* Sg = SEG + (size_t)item * 8192;
#pragma unroll
                for (int cb = 0; cb < 8; ++cb)
#pragma unroll
                    for (int rg = 0; rg < 4; ++rg) Sg[(16 * wq + 4 * g4 + rg) * 128 + 16 * cb + r16] = accS[cb][rg]; }
            if (tid < 64) ASEG[item * 64 + tid] = __expf(blsum);
        }
    }
}

__device__ __forceinline__ unsigned ord32(float f) { const unsigned b = __builtin_bit_cast(unsigned, f); return b ^ ((b >> 31) ? 0xffffffffu : 0x80000000u); }
__device__ __forceinline__ float unord32(unsigned o) { const unsigned b = (o >> 31) ? (o ^ 0x80000000u) : ~o; return __builtin_bit_cast(float, b); }
#define DPP_MAXU(v, ctrl, rmask) do { const unsigned _t = (unsigned)__builtin_amdgcn_update_dpp((int)(v), (int)(v), (ctrl), (rmask), 0xf, false); (v) = (v) > _t ? (v) : _t; } while (0)
#define DPP_ADDF(v, ctrl) do { const float _t = __builtin_bit_cast(float, __builtin_amdgcn_update_dpp(0, __builtin_bit_cast(int, (v)), (ctrl), 0xf, 0xf, false)); (v) += _t; } while (0)
__device__ __forceinline__ unsigned row_max_u(unsigned v) { DPP_MAXU(v, 0xB1, 0xf); DPP_MAXU(v, 0x4E, 0xf); DPP_MAXU(v, 0x124, 0xf); DPP_MAXU(v, 0x128, 0xf); return v; }
__device__ __forceinline__ float row_sum_f(float v) { DPP_ADDF(v, 0xB1); DPP_ADDF(v, 0x4E); DPP_ADDF(v, 0x124); DPP_ADDF(v, 0x128); return v; }
__device__ __forceinline__ unsigned wave_max_u(unsigned v) { v = row_max_u(v); DPP_MAXU(v, 0x142, 0xa); DPP_MAXU(v, 0x143, 0xc); return (unsigned)__builtin_amdgcn_readlane((int)v, 63); }

#if PEER_SIMPLE
#undef ROWSUM
__device__ __forceinline__ float row_sum_x(float v) { v += __shfl_xor(v, 1); v += __shfl_xor(v, 2); v += __shfl_xor(v, 4); v += __shfl_xor(v, 8); return v; }
#else
__device__ __forceinline__ float row_sum_x(float v) { return row_sum_f(v); }
#endif
__device__ __forceinline__ float dot2_bf16(unsigned w, unsigned x, float acc) { return __builtin_amdgcn_fdot2_f32_bf16(__builtin_bit_cast(bf16x2_t, w), __builtin_bit_cast(bf16x2_t, x), acc, false); }
__device__ __forceinline__ float gelu_exact(float v) { return 0.5f * v * (1.0f + erff(v * 0.70710678118654752f)); }

__device__ __forceinline__ void phase_peer(const Params& p, LAS unsigned char* lds, int bid, int nb) {
    const int tid = threadIdx.x, lane = tid & 63, wave = __builtin_amdgcn_readfirstlane(tid >> 6);
    const int p16 = lane & 15, rg4 = lane >> 4;
    unsigned char* ws = p.ws;
    const _Float16* SC = (const _Float16*)(ws + WS_PROJ); const bf16_t* HB = (const bf16_t*)(ws + WS_XN); const float* SSQ = (const float*)(ws + WS_SSQ);
    const unsigned char* UB = (const unsigned char*)(ws + WS_UB); const unsigned char* VB = (const unsigned char*)(ws + WS_VB);
    LAS float* A_s = (LAS float*)(lds + wave * 4096);
    LAS int* A_i = (LAS int*)(lds + wave * 4096 + 1024);
    LAS int* E_i = (LAS int*)(lds + wave * 4096 + 2048);
    LAS float* E_s = (LAS float*)(lds + wave * 4096 + 2560);
    int ci = 0, cj = 0; bool cvalid = lane < 50;
    { int l = lane;
      if (l < 16) { ci = 0; cj = l; } else if (l < 24) { ci = 1; cj = l - 16; } else if (l < 29) { ci = 2; cj = l - 24; } else if (l < 33) { ci = 3; cj = l - 29; }
      else if (l < 36) { ci = 4; cj = l - 33; } else if (l < 42) { ci = 5 + (l - 36) / 2; cj = (l - 36) & 1; } else { ci = 8 + (l - 42); cj = 0; } if (!cvalid) { ci = 0; cj = 0; } }
    const int gw = bid * 8 + wave, NGW = nb * 8;
    for (int t = gw; t < NTOK; t += NGW) {
        float ssq = (lane < 16) ? SSQ[(size_t)t * 16 + lane] : 0.f; ssq = wave_sum(ssq);
        const float rstd = 1.0f / sqrtf(ssq * (1.0f / DM) + EPS);
#if PEER_SIMPLE
        {
            LAS unsigned* KK = (LAS unsigned*)(lds + 32768 + wave * 8448);
#pragma unroll 1
            for (int q = 0; q < 4; ++q) {
                const u32x4 raw = *(const u32x4*)(SC + (size_t)t * 2048 + 512 * q + 8 * lane);
                const unsigned rw[4] = {raw.x, raw.y, raw.z, raw.w};
#pragma unroll
                for (int e = 0; e < 8; ++e) { const unsigned hbits = (e & 1) ? (rw[e >> 1] >> 16) : (rw[e >> 1] & 0xffffu);
                    const float f = (float)__builtin_bit_cast(_Float16, (unsigned short)hbits);
                    KK[(4 * q + rg4) * 129 + 8 * p16 + e] = (ord32(f) & ~0x7fu) | (unsigned)(127 - (8 * p16 + e)); }
            }
            LDS_WAIT();
            if (lane < 16) { unsigned prev = 0xffffffffu;
#pragma unroll 1
                for (int r = 0; r < 16; ++r) { unsigned best = 0u;
#pragma unroll 4
                    for (int n = 0; n < 128; ++n) { const unsigned k = KK[lane * 129 + n]; best = (k < prev && k > best) ? k : best; }
                    A_s[lane * 16 + r] = unord32(best & ~0x7fu); A_i[lane * 16 + r] = 127 - (int)(best & 0x7fu); prev = best; } }
            LDS_WAIT();
            if (lane < 8) { const int h = lane; unsigned prev = 0xffffffffu;
#pragma unroll 1
                for (int r = 0; r < 16; ++r) { unsigned best = 0u;
#pragma unroll 1
                    for (int c = 0; c < 256; ++c) { const float sum = A_s[(2 * h) * 16 + (c >> 4)] + A_s[(2 * h + 1) * 16 + (c & 15)];
                        const unsigned k = (ord32(sum) & ~0xffu) | (unsigned)(255 - c); best = (k < prev && k > best) ? k : best; }
                    const int c = 255 - (int)(best & 0xffu);
                    E_i[h * 16 + r] = A_i[(2 * h) * 16 + (c >> 4)] * 128 + A_i[(2 * h + 1) * 16 + (c & 15)];
                    E_s[h * 16 + r] = A_s[(2 * h) * 16 + (c >> 4)] + A_s[(2 * h + 1) * 16 + (c & 15)]; prev = best; } }
            LDS_WAIT();
        }
#else
#pragma unroll 1
        for (int q = 0; q < 4; ++q) {
            const u32x4 raw = *(const u32x4*)(SC + (size_t)t * 2048 + 512 * q + 8 * lane);
            const unsigned rw[4] = {raw.x, raw.y, raw.z, raw.w};
            unsigned key[8];
#pragma unroll
            for (int e = 0; e < 8; ++e) { const unsigned hbits = (e & 1) ? (rw[e >> 1] >> 16) : (rw[e >> 1] & 0xffffu);
                const float f = (float)__builtin_bit_cast(_Float16, (unsigned short)hbits);
                key[e] = (ord32(f) & ~0x7fu) | (unsigned)(127 - (8 * p16 + e)); }
            unsigned mine = 0u;
#pragma unroll 1
            for (int it = 0; it < 16; ++it) {
                unsigned m = key[0];
#pragma unroll
                for (int e = 1; e < 8; ++e) m = m > key[e] ? m : key[e];
                const unsigned W = row_max_u(m);
                mine = (p16 == it) ? W : mine;
#pragma unroll
                for (int e = 0; e < 8; ++e) key[e] = (key[e] == W) ? 0u : key[e];
            }
            const int g = 4 * q + rg4;
            A_s[g * 16 + p16] = unord32(mine & ~0x7fu); A_i[g * 16 + p16] = 127 - (int)(mine & 0x7fu);
        }
        LDS_WAIT();
#pragma unroll 1
        for (int h = 0; h < 8; ++h) {
            const float sa = A_s[(2 * h) * 16 + ci], sb = A_s[(2 * h + 1) * 16 + cj];
            const int ia = A_i[(2 * h) * 16 + ci], ib = A_i[(2 * h + 1) * 16 + cj];
            const float sum = sa + sb;
            unsigned key = cvalid ? ((ord32(sum) & ~0x3fu) | (unsigned)(63 - lane)) : 0u;
            int rank = -1;
#pragma unroll 1
            for (int it = 0; it < 16; ++it) { const unsigned W = wave_max_u(key); if (key == W) { rank = it; key = 0u; } }
            if (rank >= 0) { E_i[h * 16 + rank] = ia * 128 + ib; E_s[h * 16 + rank] = sum; }
        }
        LDS_WAIT();
#endif
#if PEER_SIMPLE_TAIL
        {
            float xv[16], accv[16];
            { const u32x4 h0 = *(const u32x4*)(HB + (size_t)t * DM + 16 * lane), h1 = *(const u32x4*)(HB + (size_t)t * DM + 16 * lane + 8);
              const unsigned hw[8] = {h0.x, h0.y, h0.z, h0.w, h1.x, h1.y, h1.z, h1.w};
#pragma unroll
              for (int k = 0; k < 16; ++k) { const float hv = (k & 1) ? bf_hi(hw[k >> 1]) : bf_lo(hw[k >> 1]); xv[k] = hv * rstd * p.g2[16 * lane + k]; accv[k] = 0.f; } }
#pragma unroll 1
            for (int h = 0; h < 8; ++h) {
                const float mx = E_s[h * 16] * rstd; float den = 0.f;
#pragma unroll 1
                for (int k = 0; k < 16; ++k) den += __expf(E_s[h * 16 + k] * rstd - mx);
#pragma unroll 1
                for (int k = 0; k < 16; ++k) {
                    const int ex = __builtin_amdgcn_readfirstlane(E_i[h * 16 + k]); const float g = __expf(E_s[h * 16 + k] * rstd - mx) / den;
                    const float* ur = p.pu + (size_t)ex * DM + 16 * lane; const float* vr = p.pv + (size_t)ex * DM + 16 * lane;
                    float s = 0.f;
#pragma unroll
                    for (int j = 0; j < 16; ++j) s += xv[j] * ur[j];
                    s = wave_sum(s);
                    const float cf = g * gelu_exact(s);
#pragma unroll
                    for (int j = 0; j < 16; ++j) accv[j] += cf * vr[j];
                }
            }
            float ss = 0.f;
            { const u32x4 h0 = *(const u32x4*)(HB + (size_t)t * DM + 16 * lane), h1 = *(const u32x4*)(HB + (size_t)t * DM + 16 * lane + 8);
              const unsigned hw[8] = {h0.x, h0.y, h0.z, h0.w, h1.x, h1.y, h1.z, h1.w};
#pragma unroll
              for (int k = 0; k < 16; ++k) { const float hv = (k & 1) ? bf_hi(hw[k >> 1]) : bf_lo(hw[k >> 1]); accv[k] += hv; ss += accv[k] * accv[k]; } }
            ss = wave_sum(ss);
            const float rf = 1.0f / sqrtf(ss * (1.0f / DM) + EPS);
#pragma unroll
            for (int k = 0; k < 16; ++k) p.out[(size_t)t * DM + 16 * lane + k] = accv[k] * rf * p.gfin[16 * lane + k];
        }
#else
        float gsm[2]; int eidx[2];
#pragma unroll
        for (int sl = 0; sl < 2; ++sl) { const int e = lane + 64 * sl; const float s = E_s[e] * rstd, mx = E_s[e & ~15] * rstd; const float pe = __expf(s - mx); const float den = row_sum_x(pe);
            gsm[sl] = pe / den; eidx[sl] = E_i[e]; }
        unsigned xp[8][4];
#pragma unroll
        for (int i = 0; i < 8; ++i) { const u32x4 hw = *(const u32x4*)(HB + (size_t)t * DM + 128 * i + 8 * p16); const f32x4 ga = *(const f32x4*)(p.g2 + 128 * i + 8 * p16), gb = *(const f32x4*)(p.g2 + 128 * i + 8 * p16 + 4);
            xp[i][0] = pk2(bf_lo(hw.x) * rstd * ga[0], bf_hi(hw.x) * rstd * ga[1]); xp[i][1] = pk2(bf_lo(hw.y) * rstd * ga[2], bf_hi(hw.y) * rstd * ga[3]);
            xp[i][2] = pk2(bf_lo(hw.z) * rstd * gb[0], bf_hi(hw.z) * rstd * gb[1]); xp[i][3] = pk2(bf_lo(hw.w) * rstd * gb[2], bf_hi(hw.w) * rstd * gb[3]); }
        float act[2] = {0.f, 0.f};
#pragma unroll
        for (int sl = 0; sl < 2; ++sl) {
#pragma unroll 2
            for (int b16 = 0; b16 < 16; ++b16) {
                const int e = 64 * sl + 16 * rg4 + b16; const int ex = E_i[e];
                const unsigned char* rowp = UB + (size_t)ex * 2048 + 16 * p16;
                float s = 0.f;
#if TAIL_U_F32
#pragma unroll
                for (int i = 0; i < 8; ++i) { const float* ur = p.pu + (size_t)ex * DM + 128 * i + 8 * p16; const f32x4 ua = *(const f32x4*)ur, ub = *(const f32x4*)(ur + 4);
                    s += bf_lo(xp[i][0]) * ua[0] + bf_hi(xp[i][0]) * ua[1] + bf_lo(xp[i][1]) * ua[2] + bf_hi(xp[i][1]) * ua[3] + bf_lo(xp[i][2]) * ub[0] + bf_hi(xp[i][2]) * ub[1] + bf_lo(xp[i][3]) * ub[2] + bf_hi(xp[i][3]) * ub[3]; }
#else
#pragma unroll
                for (int i = 0; i < 8; ++i) { const u32x4 uw = *(const u32x4*)(rowp + 256 * i);
                    s = dot2_bf16(uw.x, xp[i][0], s); s = dot2_bf16(uw.y, xp[i][1], s); s = dot2_bf16(uw.z, xp[i][2], s); s = dot2_bf16(uw.w, xp[i][3], s); }
#endif
                s = row_sum_x(s);
                act[sl] = (p16 == b16) ? s : act[sl];
            }
        }
        float coef[2];
#pragma unroll
        for (int sl = 0; sl < 2; ++sl) coef[sl] = gsm[sl] * gelu_exact(act[sl]);
        float acc[8][8];
#pragma unroll
        for (int i = 0; i < 8; ++i)
#pragma unroll
            for (int k = 0; k < 8; ++k) acc[i][k] = 0.f;
#pragma unroll
        for (int sl = 0; sl < 2; ++sl) {
#pragma unroll 2
            for (int b16 = 0; b16 < 16; ++b16) {
                const int srcl = (lane & 48) + b16;
                const float cf = __shfl(coef[sl], srcl); const int ex = __shfl(eidx[sl], srcl);
                const unsigned char* rowp = VB + (size_t)ex * 2048 + 16 * p16;
#pragma unroll
                for (int i = 0; i < 8; ++i) { const u32x4 vw = *(const u32x4*)(rowp + 256 * i);
                    acc[i][0] += cf * bf_lo(vw.x); acc[i][1] += cf * bf_hi(vw.x); acc[i][2] += cf * bf_lo(vw.y); acc[i][3] += cf * bf_hi(vw.y);
                    acc[i][4] += cf * bf_lo(vw.z); acc[i][5] += cf * bf_hi(vw.z); acc[i][6] += cf * bf_lo(vw.w); acc[i][7] += cf * bf_hi(vw.w); }
            }
        }
        float ss = 0.f;
#pragma unroll
        for (int i = 0; i < 8; ++i) { const u32x4 hw = *(const u32x4*)(HB + (size_t)t * DM + 128 * i + 8 * p16); const unsigned hv[4] = {hw.x, hw.y, hw.z, hw.w};
#pragma unroll
            for (int k = 0; k < 8; ++k) { float a = acc[i][k]; a += __shfl_xor(a, 16); a += __shfl_xor(a, 32);
                a += (k & 1) ? bf_hi(hv[k >> 1]) : bf_lo(hv[k >> 1]); acc[i][k] = a; ss += a * a; } }
        ss = row_sum_x(ss);
        const float rf = 1.0f / sqrtf(ss * (1.0f / DM) + EPS);
#pragma unroll
        for (int i = 0; i < 8; ++i) { if ((i >> 1) == rg4) { const f32x4 ga = *(const f32x4*)(p.gfin + 128 * i + 8 * p16), gb = *(const f32x4*)(p.gfin + 128 * i + 8 * p16 + 4);
                float* op = p.out + (size_t)t * DM + 128 * i + 8 * p16;
                *(f32x4*)op = (f32x4){acc[i][0] * rf * ga[0], acc[i][1] * rf * ga[1], acc[i][2] * rf * ga[2], acc[i][3] * rf * ga[3]};
                *(f32x4*)(op + 4) = (f32x4){acc[i][4] * rf * gb[0], acc[i][5] * rf * gb[1], acc[i][6] * rf * gb[2], acc[i][7] * rf * gb[3]}; } }
#endif
        LDS_WAIT();
    }
}


__device__ __forceinline__ void phase_naive_scores(const Params& p, LAS unsigned char* lds, int bid, int nb) {
    const int tid = threadIdx.x;
    unsigned char* ws = p.ws;
    const bf16_t* HB = (const bf16_t*)(ws + WS_XN); const float* SSQ = (const float*)(ws + WS_SSQ); _Float16* SC = (_Float16*)(ws + WS_PROJ);
    LAS float* XS = (LAS float*)lds;
    LAS float* QS = (LAS float*)(lds + 32768);
    for (int item = bid; item < NTOK / 8; item += nb) {
        const int t0 = item * 8;
        __syncthreads();
        for (int e = tid; e < 8 * 1024; e += 512) { const int tt = e >> 10, k = e & 1023; XS[e] = bf1(HB[(size_t)(t0 + tt) * DM + k]) * p.g2[k]; }
        __syncthreads();
        float acc[8][4];
#pragma unroll
        for (int tt = 0; tt < 8; ++tt)
#pragma unroll
            for (int c = 0; c < 4; ++c) acc[tt][c] = 0.f;
        for (int k = 0; k < 1024; ++k) { const f32x4 w = *(const f32x4*)(p.w_q + (size_t)k * 2048 + 4 * tid);
#pragma unroll
            for (int tt = 0; tt < 8; ++tt) { const float xv = XS[tt * 1024 + k]; acc[tt][0] += xv * w[0]; acc[tt][1] += xv * w[1]; acc[tt][2] += xv * w[2]; acc[tt][3] += xv * w[3]; } }
#pragma unroll
        for (int tt = 0; tt < 8; ++tt)
#pragma unroll
            for (int c = 0; c < 4; ++c) QS[tt * 2048 + 4 * tid + c] = acc[tt][c];
        __syncthreads();
#pragma unroll 1
        for (int c = 0; c < 4; ++c) { const int col = 4 * tid + c, hc = col >> 7; const float* sk = p.subkeys + (size_t)col * 128;
            float s[8];
#pragma unroll
            for (int tt = 0; tt < 8; ++tt) s[tt] = 0.f;
            for (int d = 0; d < 128; ++d) { const float kv = sk[d];
#pragma unroll
                for (int tt = 0; tt < 8; ++tt) s[tt] += QS[tt * 2048 + hc * 128 + d] * kv; }
#pragma unroll
            for (int tt = 0; tt < 8; ++tt) SC[(size_t)(t0 + tt) * 2048 + col] = (_Float16)s[tt]; }
    }
}

__global__ void __launch_bounds__(512, 2) mk_fwd(Params p) {
    extern __shared__ __attribute__((aligned(16))) unsigned char lds_raw[];
    LAS unsigned char* lds = (LAS unsigned char*)lds_raw;
    const int bid = blockIdx.x, nb = gridDim.x;
    unsigned char* ws = p.ws;
#define IN(k) (p.ph_lo <= (k) && (k) < p.ph_hi)
#define SEAM(k) do { if (IN(k) && IN((k) + 1)) { cg::this_grid().sync(); } } while (0)
    if (IN(0)) phase0(p, lds, bid, nb);
    SEAM(0);
    if (IN(1)) {
        pg8::Gemm g{(const bf16_t*)(ws + WS_XN), (const bf16_t*)(ws + WS_WIN), MROWS, NP1, DM}; pg8::StaticOrder S; S.init(MROWS, NP1, nb, bid);
        EpiProj E{(bf16_t*)(ws + WS_PROJ), (float*)(ws + WS_LA), p.gb, (const float2*)(ws + WS_ROPE)};
        pg8::gemm_phase<EpiProj, pg8::StaticOrder, true, true>(lds, g, S, E);
    }
    SEAM(1);
    if (IN(2)) attn_pass<false>(p, lds, bid, nb);
    SEAM(2);
    if (IN(3)) attn_pass<true>(p, lds, bid, nb);
    SEAM(3);
    if (IN(4)) {
        pg8::Gemm g{(const bf16_t*)(ws + WS_O), (const bf16_t*)(ws + WS_WOUT), NTOK, DM, DM}; pg8::StaticOrder S; S.init(NTOK, DM, nb, bid);
        EpiRes E{p.x, (bf16_t*)(ws + WS_XN), (float*)(ws + WS_SSQ)};
        pg8::gemm_phase<EpiRes, pg8::StaticOrder, true, true>(lds, g, S, E);
    }
    SEAM(4);
    if (IN(5)) {
        pg8::Gemm g{(const bf16_t*)(ws + WS_XN), (const bf16_t*)(ws + WS_WS), NTOK, 2048, DM}; pg8::StaticOrder S; S.init(NTOK, 2048, nb, bid);
        EpiF16 E{(_Float16*)(ws + WS_PROJ)};
        pg8::gemm_phase<EpiF16, pg8::StaticOrder, true, true>(lds, g, S, E);
    }
    SEAM(5);
    if (IN(6)) phase_peer(p, lds, bid, nb);
    if (IN(7)) phase_naive_scores(p, lds, bid, nb);
#undef IN
#undef SEAM
}

#ifndef PEER_SIMPLE_DUMMY
#endif
#ifndef MK_FUSED
#define MK_FUSED 0
#endif
extern "C" void kernel_launch(void* const* d_in, const int* in_sizes, int n_in, void* d_out, int out_size, void* d_ws, size_t ws_size, hipStream_t stream) {
    static int grid = 0;
    if (grid == 0) {
        if (n_in != 16 || in_sizes[0] != NTOK * DM || out_size != NTOK * DM || ws_size < WS_END) {
            fprintf(stderr, "kernel_launch: unexpected shapes (n_in %d, in0 %d, out %d, ws %zu); nothing launched\n", n_in, n_in > 0 ? in_sizes[0] : -1, out_size, ws_size); grid = -1; return; }
        int dev = 0, cus = 0, per_cu = 0;
        hipGetDevice(&dev); hipDeviceGetAttribute(&cus, hipDeviceAttributeMultiprocessorCount, dev);
        if (hipFuncSetAttribute((const void*)mk_fwd, hipFuncAttributeMaxDynamicSharedMemorySize, LDS_BYTES) != hipSuccess) { fprintf(stderr, "kernel_launch: hipFuncSetAttribute failed\n"); grid = -1; return; }
        if (hipOccupancyMaxActiveBlocksPerMultiprocessor(&per_cu, (const void*)mk_fwd, 512, LDS_BYTES) != hipSuccess || per_cu < 1) { fprintf(stderr, "kernel_launch: occupancy query failed (%d)\n", per_cu); (void)hipGetLastError(); per_cu = 1; }
        grid = cus * (per_cu < 1 ? 1 : 1);
        fprintf(stderr, "kernel_launch: %d CUs, occupancy %d/CU, grid %d\n", cus, per_cu, grid);
    }
    if (grid < 0) return;
    Params p{};
    p.x = (const float*)d_in[0]; p.meta = (const float*)d_in[1]; p.g1 = (const float*)d_in[2]; p.w_in = (const float*)d_in[3]; p.gw2 = (const float*)d_in[4]; p.gb = (const float*)d_in[5];
    p.gla_gain = (const float*)d_in[6]; p.ret_gain = (const float*)d_in[7]; p.ret_bias = (const float*)d_in[8]; p.w_out = (const float*)d_in[9]; p.g2 = (const float*)d_in[10];
    p.w_q = (const float*)d_in[11]; p.subkeys = (const float*)d_in[12]; p.pu = (const float*)d_in[13]; p.pv = (const float*)d_in[14]; p.gfin = (const float*)d_in[15];
    p.out = (float*)d_out; p.ws = (unsigned char*)d_ws;
#if MK_FUSED
    p.ph_lo = 0; p.ph_hi = NPHASE;
    void* args[] = {&p};
    hipError_t e = hipLaunchCooperativeKernel((const void*)mk_fwd, dim3(grid), dim3(512), args, LDS_BYTES, stream);
    if (e != hipSuccess) fprintf(stderr, "kernel_launch: cooperative launch failed: %s (grid %d)\n", hipGetErrorString(e), grid);
#else
    { const int order[7] = {0, 1, 2, 3, 4, 5, 6}; for (int i = 0; i < 7; ++i) { p.ph_lo = order[i]; p.ph_hi = order[i] + 1; hipLaunchKernelGGL(mk_fwd, dim3(grid), dim3(512), LDS_BYTES, stream, p); } }
#endif
}
```

```cpp
#include <hip/hip_runtime.h>
#include <hip/hip_cooperative_groups.h>
#include <cstdio>
#include <cstdint>
namespace cg = cooperative_groups;
namespace pg8 {
#define PG8_LAS __attribute__((address_space(3)))
typedef unsigned short bf16_t;
typedef short bf16x8 __attribute__((ext_vector_type(8)));
typedef float f32x4 __attribute__((ext_vector_type(4)));
typedef unsigned u32x4 __attribute__((ext_vector_type(4)));
constexpr int BM = 256, BK = 64, HALF = 128, HTB = HALF * BK * 2  , STAGE_BYTES = 8 * HTB, NXCD = 8, WGM = 8;

__host__ __device__ __forceinline__ int lds_byte(int r, int c) { const int st = (r >> 4) * 2 + (c >> 5), rr = r & 15, cc = c & 31, ob = rr * 64 + cc * 2; return st * 1024 + (ob ^ (((ob >> 9) & 1) << 5)); }
__host__ __device__ __forceinline__ void stage_rc(int b, int& R, int& C) { const int st = b / 1024, sb = b % 1024, swz = sb ^ (((sb >> 9) & 1) << 5); R = (st >> 1) * 16 + swz / 64; C = (st & 1) * 32 + (swz % 64) / 2; }
__host__ __device__ __forceinline__ int perm32(int rho) { const int n = rho >> 4, i = rho & 15; return 8 * (i >> 2) + 4 * n + (i & 3); }

struct Unit { int pm, pn; };
struct Gemm { const bf16_t* A; const bf16_t* Bt; int M, N, K; };

struct StaticOrder {
    int nM, nN, nwg, G, c;
    __host__ __device__ void init(int M, int N, int G_, int c_) { nM = M / BM; nN = N / BM; nwg = nM * nN; G = G_; c = c_; }
    __host__ __device__ bool next(int i, Unit& u) const {
        const long L = (long)i * G + c; if (L >= nwg) return false;
        int wgid = (int)L; { const int q = nwg / NXCD, r = nwg % NXCD, xcd = wgid % NXCD, off = wgid / NXCD; wgid = (xcd < r ? xcd * (q + 1) : r * (q + 1) + (xcd - r) * q) + off; }
        const int nig = WGM * nN, gid = wgid / nig, fm = gid * WGM, gsz = (nM - fm) < WGM ? (nM - fm) : WGM;
        u.pm = fm + ((wgid % nig) % gsz); u.pn = (wgid % nig) / gsz; return true;
    }
    __device__ __forceinline__ void a_ready(const Unit&) const {}
    __device__ __forceinline__ void done(const Unit&) const {}
};

__device__ __forceinline__ unsigned cvt_pk_bf16(float lo, float hi) { unsigned r; asm volatile("v_cvt_pk_bf16_f32 %0, %1, %2" : "=v"(r) : "v"(lo), "v"(hi)); return r; }
typedef float f32x2 __attribute__((ext_vector_type(2)));
template <class Epi, class Sched, bool ALIGN_EPI = false, bool SP2 = false>
__device__ __forceinline__ void gemm_phase(PG8_LAS unsigned char* lds, const Gemm g, const Sched& S, const Epi& E) {
    const int tid = threadIdx.x, wid = __builtin_amdgcn_readfirstlane(tid >> 6), lane = tid & 63, wr = wid >> 2, wc = wid & 3, fr = lane & 15, fq = lane >> 4;
    const int K = g.K, nt = K / BK;
    unsigned voffA[2], voffB[2];
#pragma unroll
    for (int i = 0; i < 2; ++i) { int R, C; stage_rc(tid * 16 + i * 8192, R, C); const int Rb = Epi::PERM ? ((R & ~31) + perm32(R & 31)) : R;
        voffA[i] = (unsigned)(R * K + C) * 2u; voffB[i] = (unsigned)(Rb * K + C) * 2u; }
    const size_t kstep = (size_t)(BK * 2);
    const size_t hstep = (size_t)HALF * K * 2;
    const size_t tstep = 2 * hstep;
    const unsigned ldsw = (unsigned)wid * 1024u;
    const int aoff = lds_byte(wr * 64 + fr, fq * 8), boff = lds_byte(wc * 32 + fr, fq * 8);
#define PG8_SA(b, h) (((b) * 2 + (h)) * HTB)
#define PG8_SB(b, h) ((4 + (b) * 2 + (h)) * HTB)
#define PG8_STAGE(bufoff, gbase, voff) do { _Pragma("unroll") for (int _i = 0; _i < 2; ++_i) \
        __builtin_amdgcn_global_load_lds((const unsigned*)((const char*)(gbase) + (voff)[_i]), (PG8_LAS unsigned*)(lds + (bufoff) + ldsw + _i * 8192), 16, 0, 0); } while (0)
#define PG8_LDA(dst, b, h) do { _Pragma("unroll") for (int m = 0; m < 4; ++m) _Pragma("unroll") for (int k = 0; k < 2; ++k) dst[m][k] = *(const PG8_LAS bf16x8*)(lds + PG8_SA(b, h) + aoff + m * 2048 + k * 1024); } while (0)
#define PG8_LDB(dst, b, h) do { _Pragma("unroll") for (int n = 0; n < 2; ++n) _Pragma("unroll") for (int k = 0; k < 2; ++k) dst[n][k] = *(const PG8_LAS bf16x8*)(lds + PG8_SB(b, h) + boff + n * 2048 + k * 1024); } while (0)
#define PG8_MMA(ai, bj, At, Bt) do { __builtin_amdgcn_s_setprio(1); _Pragma("unroll") for (int m = 0; m < 4; ++m) _Pragma("unroll") for (int n = 0; n < 2; ++n) _Pragma("unroll") for (int k = 0; k < 2; ++k) \
        acc[ai][bj][m][n] = __builtin_amdgcn_mfma_f32_16x16x32_bf16(Bt[n][k], At[m][k], acc[ai][bj][m][n], 0, 0, 0); __builtin_amdgcn_s_setprio(0); } while (0)
#define PG8_WAIT_V(n) asm volatile("s_waitcnt vmcnt(" #n ")" ::: "memory")
#define PG8_WAIT_L(n) asm volatile("s_waitcnt lgkmcnt(" #n ")" ::: "memory")
#define PG8_BAR __builtin_amdgcn_s_barrier()
#define PG8_SCHED __builtin_amdgcn_sched_barrier(0)
    Unit cur, nxt; int ui = 0;
    if (!S.next(0, cur)) return;
    f32x4 acc[2][2][4][2];
#pragma unroll
    for (int a = 0; a < 2; ++a)
#pragma unroll
        for (int b = 0; b < 2; ++b)
#pragma unroll
            for (int m = 0; m < 4; ++m)
#pragma unroll
                for (int n = 0; n < 2; ++n) acc[a][b][m][n] = (f32x4){0.f, 0.f, 0.f, 0.f};
    bf16x8 At[4][2], B0[2][2], B1[2][2];
    const char* cA = (const char*)g.A + (size_t)cur.pm * tstep; const char* cB = (const char*)g.Bt + (size_t)cur.pn * tstep;
    S.a_ready(cur);
    if constexpr (SP2) {
        PG8_STAGE(PG8_SB(0, 0), cB, voffB); PG8_STAGE(PG8_SB(0, 1), cB + hstep, voffB); PG8_STAGE(PG8_SA(0, 0), cA, voffA); PG8_STAGE(PG8_SA(0, 1), cA + hstep, voffA);
        if (wr == 1) PG8_BAR;
        PG8_WAIT_V(2); PG8_BAR;
        PG8_STAGE(PG8_SB(1, 0), cB + kstep, voffB); PG8_STAGE(PG8_SA(1, 0), cA + kstep, voffA); PG8_STAGE(PG8_SB(1, 1), cB + hstep + kstep, voffB);
        PG8_WAIT_V(6); PG8_BAR;
    } else {
        PG8_STAGE(PG8_SB(0, 0), cB, voffB); PG8_STAGE(PG8_SA(0, 0), cA, voffA); PG8_STAGE(PG8_SB(0, 1), cB + hstep, voffB); PG8_STAGE(PG8_SA(0, 1), cA + hstep, voffA);
        if (wr == 1) PG8_BAR;
        PG8_WAIT_V(4); PG8_BAR;
        PG8_STAGE(PG8_SB(1, 0), cB + kstep, voffB); PG8_STAGE(PG8_SA(1, 0), cA + kstep, voffA); PG8_STAGE(PG8_SB(1, 1), cB + hstep + kstep, voffB);
        PG8_WAIT_V(6); PG8_BAR;
    }
    for (;;) {
        const bool has_next = S.next(ui + 1, nxt);
        const char* nA = has_next ? (const char*)g.A + (size_t)nxt.pm * tstep : cA; const char* nB = has_next ? (const char*)g.Bt + (size_t)nxt.pn * tstep : cB;
        for (int t = 0; t < nt; t += 2) {
            const bool last = (t == nt - 2);
            const char* a1 = cA + (size_t)(t + 1) * kstep;
            const char* a2 = last ? nA : cA + (size_t)(t + 2) * kstep; const char* b2 = last ? nB : cB + (size_t)(t + 2) * kstep;
            const char* a3 = a2 + kstep; const char* b3 = b2 + kstep;
            if (last && has_next) S.a_ready(nxt);
            if constexpr (SP2) {
            PG8_LDB(B0, 0, 0); PG8_LDB(B1, 0, 1); PG8_SCHED; PG8_LDA(At, 0, 0); PG8_STAGE(PG8_SA(1, 1), a1 + hstep, voffA);
            PG8_WAIT_V(8); PG8_WAIT_L(0); PG8_BAR; PG8_MMA(0, 0, At, B0); PG8_MMA(0, 1, At, B1); PG8_BAR; PG8_SCHED;
            PG8_LDA(At, 0, 1); PG8_STAGE(PG8_SB(0, 0), b2, voffB); PG8_STAGE(PG8_SB(0, 1), b2 + hstep, voffB); PG8_STAGE(PG8_SA(0, 0), a2, voffA);
            PG8_WAIT_V(8); PG8_WAIT_L(0); PG8_BAR; PG8_MMA(1, 0, At, B0); PG8_MMA(1, 1, At, B1); PG8_BAR; PG8_SCHED;
            PG8_LDB(B0, 1, 0); PG8_LDB(B1, 1, 1); PG8_SCHED; PG8_LDA(At, 1, 0); PG8_STAGE(PG8_SA(0, 1), a2 + hstep, voffA);
            PG8_WAIT_V(8); PG8_WAIT_L(0); PG8_BAR; PG8_MMA(0, 0, At, B0); PG8_MMA(0, 1, At, B1); PG8_BAR; PG8_SCHED;
            PG8_LDA(At, 1, 1); PG8_STAGE(PG8_SB(1, 0), b3, voffB); PG8_STAGE(PG8_SB(1, 1), b3 + hstep, voffB); PG8_STAGE(PG8_SA(1, 0), a3, voffA);
            PG8_WAIT_V(8); PG8_WAIT_L(0); PG8_BAR; PG8_MMA(1, 0, At, B0); PG8_MMA(1, 1, At, B1); PG8_BAR; PG8_SCHED;
            } else {
            PG8_LDB(B0, 0, 0); PG8_SCHED; PG8_LDA(At, 0, 0); PG8_STAGE(PG8_SA(1, 1), a1 + hstep, voffA);
            PG8_WAIT_L(8); PG8_BAR; PG8_WAIT_L(0); PG8_MMA(0, 0, At, B0); PG8_BAR; PG8_SCHED;
            PG8_LDB(B1, 0, 1); PG8_STAGE(PG8_SB(0, 0), b2, voffB);
            PG8_BAR; PG8_WAIT_L(0); PG8_MMA(0, 1, At, B1); PG8_BAR;
            PG8_LDA(At, 0, 1); PG8_STAGE(PG8_SA(0, 0), a2, voffA);
            PG8_BAR; PG8_WAIT_L(0); PG8_MMA(1, 0, At, B0); PG8_BAR; PG8_SCHED;
            PG8_STAGE(PG8_SB(0, 1), b2 + hstep, voffB);
            PG8_WAIT_V(6); PG8_BAR; PG8_MMA(1, 1, At, B1); PG8_BAR;
            PG8_LDB(B0, 1, 0); PG8_SCHED; PG8_LDA(At, 1, 0); PG8_STAGE(PG8_SA(0, 1), a2 + hstep, voffA);
            PG8_WAIT_L(8); PG8_BAR; PG8_WAIT_L(0); PG8_MMA(0, 0, At, B0); PG8_BAR; PG8_SCHED;
            PG8_LDB(B1, 1, 1); PG8_STAGE(PG8_SB(1, 0), b3, voffB);
            PG8_BAR; PG8_WAIT_L(0); PG8_MMA(0, 1, At, B1); PG8_BAR;
            PG8_LDA(At, 1, 1); PG8_STAGE(PG8_SA(1, 0), a3, voffA);
            PG8_BAR; PG8_WAIT_L(0); PG8_MMA(1, 0, At, B0); PG8_BAR; PG8_SCHED;
            PG8_STAGE(PG8_SB(1, 1), b3 + hstep, voffB);
            PG8_WAIT_V(6); PG8_BAR; PG8_MMA(1, 1, At, B1); PG8_BAR;
            }
        }
        if constexpr (ALIGN_EPI) { if (wr == 0) PG8_BAR; }
        if constexpr (!Epi::AFTER_DRAIN) { E(acc, cur, wr, wc, fr, fq); S.done(cur); }
        if (!has_next) break;
#pragma unroll
        for (int a = 0; a < 2; ++a)
#pragma unroll
            for (int b = 0; b < 2; ++b)
#pragma unroll
                for (int m = 0; m < 4; ++m)
#pragma unroll
                    for (int n = 0; n < 2; ++n) acc[a][b][m][n] = (f32x4){0.f, 0.f, 0.f, 0.f};
        cur = nxt; cA = nA; cB = nB; ++ui;
        if constexpr (ALIGN_EPI) { if (wr == 1) PG8_BAR; }
    }
    PG8_WAIT_V(0);
    if constexpr (!ALIGN_EPI) { if (wr == 0) PG8_BAR; }
    PG8_BAR;
    if constexpr (Epi::AFTER_DRAIN) { E.fused(acc, cur, wr, wc, fr, fq, lds, wid, lane); S.done(cur); }
#undef PG8_SA
#undef PG8_SB
#undef PG8_STAGE
#undef PG8_LDA
#undef PG8_LDB
#undef PG8_MMA
#undef PG8_WAIT_V
#undef PG8_WAIT_L
#undef PG8_BAR
#undef PG8_SCHED
}
}

#define LAS __attribute__((address_space(3)))
typedef unsigned short bf16_t;
typedef float f32x4 __attribute__((ext_vector_type(4)));
typedef unsigned u32x4 __attribute__((ext_vector_type(4)));
typedef unsigned u32x2 __attribute__((ext_vector_type(2)));
typedef short bf16x8 __attribute__((ext_vector_type(8)));
typedef short s16x4 __attribute__((ext_vector_type(4)));
typedef __bf16 bf16x2_t __attribute__((ext_vector_type(2)));
typedef _Float16 f16x2_t __attribute__((ext_vector_type(2)));

constexpr int DM = 1024, NB = 4, SEQ = 8192, NTOK = NB * SEQ;
constexpr int MROWS = NTOK + 256;
constexpr int INW = 3088;
constexpr int NPROJ = 3072, NP1 = 3328;
constexpr int NEXP = 16384;
constexpr float EPS = 1e-6f;
constexpr int C_GQ = 0, C_GK = 256, C_GV = 512, C_GG = 1024, C_RQ = 1536, C_RK = 1792, C_RV = 2048, C_RG = 2560;
constexpr int S_GA = 1536, S_RQ = 1552, S_RV = 2064;

constexpr size_t MiB = 1u << 20;
constexpr size_t WS_CTL = 0, WS_WIN = 1 * MiB, WS_WOUT = 8 * MiB, WS_WS = 10 * MiB, WS_ROPE = 14 * MiB, WS_SSQ = 17 * MiB, WS_SEG = 19 * MiB, WS_ASEG = 27 * MiB,
                 WS_UB = 28 * MiB, WS_VB = 60 * MiB, WS_XN = 92 * MiB, WS_O = 157 * MiB, WS_LA = 221 * MiB, WS_PROJ = 254 * MiB, WS_END = 448 * MiB;
static_assert(WS_WIN + (size_t)NP1 * DM * 2 <= WS_WOUT && WS_ROPE + (size_t)(SEQ + 64) * 32 * 8 <= WS_SSQ && WS_XN + (size_t)MROWS * DM * 2 <= WS_O &&
              WS_LA + (size_t)MROWS * 256 * 4 <= WS_PROJ && WS_PROJ + (size_t)MROWS * NPROJ * 2 <= WS_END && WS_PROJ + (size_t)NTOK * 2048 * 2 <= WS_END, "ws map");

constexpr int LDS_BYTES = 147456;
constexpr int NPHASE = 7;
#ifndef PEER_SIMPLE
#define PEER_SIMPLE 0
#endif
#ifndef PEER_SIMPLE_TAIL
#define PEER_SIMPLE_TAIL 0
#define TAIL_U_F32 0
#endif

struct Params {
    const float *x, *meta, *g1, *w_in, *gw2, *gb, *gla_gain, *ret_gain, *ret_bias, *w_out, *g2, *w_q, *subkeys, *pu, *pv, *gfin;
    float* out; unsigned char* ws;
    int ph_lo, ph_hi;
};

#define LDS_WAIT() asm volatile("s_waitcnt lgkmcnt(0)" ::: "memory")
__device__ __forceinline__ unsigned f2bf(float f) { unsigned u = __builtin_bit_cast(unsigned, f); return (u + 0x7fffu + ((u >> 16) & 1u)) >> 16; }
__device__ __forceinline__ unsigned pk2(float lo, float hi) { return f2bf(lo) | (f2bf(hi) << 16); }
__device__ __forceinline__ float bf_lo(unsigned w) { return __builtin_bit_cast(float, w << 16); }
__device__ __forceinline__ float bf_hi(unsigned w) { return __builtin_bit_cast(float, w & 0xffff0000u); }
__device__ __forceinline__ float bf1(bf16_t h) { return __builtin_bit_cast(float, (unsigned)h << 16); }
__device__ __forceinline__ float wave_sum(float v) {
#pragma unroll
    for (int o = 1; o < 64; o <<= 1) v += __shfl_xor(v, o);
    return v;
}

struct MapIn {
    __device__ __forceinline__ void operator()(int j, int& src, float& sc) const {
        if (j < C_RQ) { src = j; sc = (j < 256) ? 0.125f : 1.0f; }
        else if (j < C_RV) { const int jj = j - C_RQ, which = jj >> 8, within = jj & 255, head = within >> 6, p = within & 63;
            const int a = p >> 3, n = (p >> 2) & 1, i = p & 3; src = S_RQ + which * 256 + head * 64 + 32 * n + 4 * a + i; sc = which ? 0.125f : 1.0f; }
        else { src = S_RV + (j - C_RV); sc = 1.0f; }
    }
};
struct MapId { __device__ __forceinline__ void operator()(int j, int& src, float& sc) const { src = j; sc = 1.0f; } };

template <class Map>
__device__ __forceinline__ void transpose_item(const float* W, int K, int N, bf16_t* WT, LAS float* scr, int item, int nblk, int lane, const Map map) {
    const int kb = item / nblk, nb = item % nblk, k0 = 64 * kb, n0 = 32 * nb;
    int src; float sc; map(n0 + (lane & 31), src, sc);
#pragma unroll 8
    for (int i = 0; i < 32; ++i) { const int kk = 2 * i + (lane >> 5); scr[kk * 33 + (lane & 31)] = W[(size_t)(k0 + kk) * N + src] * sc; }
    LDS_WAIT();
    const int c = lane & 7;
#pragma unroll
    for (int j = 0; j < 4; ++j) { const int n = (lane >> 3) + 8 * j; const LAS float* s = scr + (8 * c) * 33 + n;
        u32x4 o; o.x = pk2(s[0 * 33], s[1 * 33]); o.y = pk2(s[2 * 33], s[3 * 33]); o.z = pk2(s[4 * 33], s[5 * 33]); o.w = pk2(s[6 * 33], s[7 * 33]);
        *(u32x4*)(WT + (size_t)(n0 + n) * K + k0 + 8 * c) = o; }
    LDS_WAIT();
}

__device__ __forceinline__ void phase0(const Params& p, LAS unsigned char* lds, int bid, int nb) {
    const int tid = threadIdx.x, lane = tid & 63, wave = __builtin_amdgcn_readfirstlane(tid >> 6);
    unsigned char* ws = p.ws;
    bf16_t* XN = (bf16_t*)(ws + WS_XN); bf16_t* WinT = (bf16_t*)(ws + WS_WIN); bf16_t* WoutT = (bf16_t*)(ws + WS_WOUT); bf16_t* WsT = (bf16_t*)(ws + WS_WS);
    const int gw = bid * 8 + wave, NGW = nb * 8;
    const int gt = bid * 512 + tid, NGT = nb * 512;

    {
        LAS float* SKT = (LAS float*)lds;
        LAS float* WQT = (LAS float*)(lds + 128 * 132 * 4);
        for (int item = bid; item < 256; item += nb) {
            const int hc = item >> 4, kb = item & 15;
            __syncthreads();
            for (int e = tid; e < 128 * 128; e += 512) { const int n = e >> 7, d = e & 127; SKT[d * 132 + n] = p.subkeys[(size_t)hc * 16384 + e]; }
            for (int e = tid; e < 64 * 128; e += 512) { const int k = e >> 7, d = e & 127; WQT[d * 68 + k] = p.w_q[(size_t)(kb * 64 + k) * 2048 + hc * 128 + d]; }
            __syncthreads();
            const int tn = tid & 31, tk = tid >> 5;
            f32x4 acc[4];
#pragma unroll
            for (int i = 0; i < 4; ++i) acc[i] = (f32x4){0.f, 0.f, 0.f, 0.f};
#pragma unroll 4
            for (int d = 0; d < 128; ++d) {
                const f32x4 sk = *(const LAS f32x4*)(SKT + d * 132 + 4 * tn); const f32x4 wq = *(const LAS f32x4*)(WQT + d * 68 + 4 * tk);
#pragma unroll
                for (int i = 0; i < 4; ++i) acc[i] += sk[i] * wq;
            }
            const f32x4 gg = *(const f32x4*)(p.g2 + kb * 64 + 4 * tk);
#pragma unroll
            for (int i = 0; i < 4; ++i) { const f32x4 v = acc[i] * gg; u32x2 o; o.x = pk2(v[0], v[1]); o.y = pk2(v[2], v[3]);
                *(u32x2*)(WsT + (size_t)(hc * 128 + 4 * tn + i) * DM + kb * 64 + 4 * tk) = o; }
        }
        __syncthreads();
    }
    {
        LAS float* scr = (LAS float*)(lds + wave * 16384);
        constexpr int I_IN = (DM / 64) * (NPROJ / 32), I_OUT = (DM / 64) * (DM / 32);
        for (int it = gw; it < I_IN + I_OUT; it += NGW) {
            if (it < I_IN) transpose_item(p.w_in, DM, INW, WinT, scr, it, NPROJ / 32, lane, MapIn());
            else transpose_item(p.w_out, DM, DM, WoutT, scr, it - I_IN, DM / 32, lane, MapId());
        }
    }
    for (int e = gt; e < 256 * DM; e += NGT) {
        const int n = e >> 10, k = e & 1023; const float* wr = p.w_in + (size_t)k * INW + S_GA; float s = 0.f;
#pragma unroll
        for (int r = 0; r < 16; ++r) s += wr[r] * p.gw2[r * 256 + n];
        WinT[(size_t)(NPROJ + n) * DM + k] = (bf16_t)f2bf(s);
    }
    {
        u32x2* UB = (u32x2*)(ws + WS_UB); u32x2* VB = (u32x2*)(ws + WS_VB);
        const f32x4* u4 = (const f32x4*)p.pu; const f32x4* v4 = (const f32x4*)p.pv;
        for (int e = gt; e < NEXP * DM / 4; e += NGT) { const f32x4 a = u4[e]; u32x2 o; o.x = pk2(a[0], a[1]); o.y = pk2(a[2], a[3]); UB[e] = o;
            const f32x4 b = v4[e]; u32x2 q; q.x = pk2(b[0], b[1]); q.y = pk2(b[2], b[3]); VB[e] = q; }
    }
    {
        float2* rope = (float2*)(ws + WS_ROPE);
        for (int e = gt; e < (SEQ + 64) * 32; e += NGT) { const int pi = e >> 5, d = e & 31;
            const float invf = (float)pow(10000.0, -(double)d / 32.0); const float ang = (float)(pi - 48) * invf;
            rope[e] = make_float2((float)cos((double)ang), (float)sin((double)ang)); }
    }
    for (int m = gw; m < MROWS; m += NGW) {
        const float* src = nullptr;
        if (m >= 256) src = p.x + (size_t)(m - 256) * DM; else if (m >= 48 && m < 64) src = p.meta + (size_t)(m - 48) * DM;
        unsigned long long* o8 = (unsigned long long*)(XN + (size_t)m * DM) + lane;
        if (src == nullptr) {
#pragma unroll
            for (int j = 0; j < 4; ++j) o8[64 * j] = 0ull;
        } else {
            const f32x4* xr = (const f32x4*)src + lane; const f32x4* gr = (const f32x4*)p.g1 + lane;
            f32x4 v[4]; float s = 0.f;
#pragma unroll
            for (int j = 0; j < 4; ++j) { v[j] = xr[64 * j]; s += (v[j].x * v[j].x + v[j].y * v[j].y) + (v[j].z * v[j].z + v[j].w * v[j].w); }
            const float r = 1.0f / sqrtf(wave_sum(s) * (1.0f / DM) + EPS);
#pragma unroll
            for (int j = 0; j < 4; ++j) { const f32x4 g = gr[64 * j]; const f32x4 y = v[j] * r * g;
                o8[64 * j] = (unsigned long long)pk2(y.x, y.y) | ((unsigned long long)pk2(y.z, y.w) << 32); }
        }
    }
}

struct EpiProj {
    static constexpr bool PERM = true, AFTER_DRAIN = false;
    bf16_t* PROJ; float* LA; const float* gb; const float2* rope;
    __device__ __forceinline__ void operator()(const pg8::f32x4 (&acc)[2][2][4][2], const pg8::Unit& u, int wr, int wc, int fr, int fq) const {
        const int row0 = u.pm * 256 + wr * 64 + fr, cb0 = wc * 32 + 8 * fq;
        if (u.pn == 12) {
#pragma unroll
            for (int bj = 0; bj < 2; ++bj) { const int c = cb0 + 128 * bj; const f32x4 b0 = *(const f32x4*)(gb + c), b1 = *(const f32x4*)(gb + c + 4);
#pragma unroll
                for (int ai = 0; ai < 2; ++ai)
#pragma unroll
                    for (int m = 0; m < 4; ++m) { const int row = row0 + ai * 128 + m * 16; f32x4 v0 = acc[ai][bj][m][0] + b0, v1 = acc[ai][bj][m][1] + b1;
#pragma unroll
                        for (int i = 0; i < 4; ++i) { v0[i] = (fminf(v0[i], 0.f) - log1pf(__expf(-fabsf(v0[i])))) * 0.0625f; v1[i] = (fminf(v1[i], 0.f) - log1pf(__expf(-fabsf(v1[i])))) * 0.0625f; }
                        float* o = LA + (size_t)row * 256 + c; *(f32x4*)o = v0; *(f32x4*)(o + 4) = v1; } }
        } else if (u.pn == 6 || u.pn == 7) {
#pragma unroll
            for (int ai = 0; ai < 2; ++ai)
#pragma unroll
                for (int m = 0; m < 4; ++m) { const int row = row0 + ai * 128 + m * 16; const int pidx = (row < 256) ? row : 64 + ((row - 256) & (SEQ - 1));
#pragma unroll
                    for (int bj = 0; bj < 2; ++bj) { const int c = cb0 + 128 * bj, d0 = (c & 63) >> 1;
                        const f32x4 cs0 = *(const f32x4*)(rope + (size_t)pidx * 32 + d0), cs1 = *(const f32x4*)(rope + (size_t)pidx * 32 + d0 + 2);
                        const f32x4 t1 = acc[ai][bj][m][0], t2 = acc[ai][bj][m][1];
                        const float co[4] = {cs0[0], cs0[2], cs1[0], cs1[2]}, si[4] = {cs0[1], cs0[3], cs1[1], cs1[3]};
                        float o1[4], o2[4];
#pragma unroll
                        for (int i = 0; i < 4; ++i) { o1[i] = t1[i] * co[i] - t2[i] * si[i]; o2[i] = t1[i] * si[i] + t2[i] * co[i]; }
                        u32x4 w; w.x = pg8::cvt_pk_bf16(o1[0], o1[1]); w.y = pg8::cvt_pk_bf16(o1[2], o1[3]); w.z = pg8::cvt_pk_bf16(o2[0], o2[1]); w.w = pg8::cvt_pk_bf16(o2[2], o2[3]);
                        *(u32x4*)(PROJ + (size_t)row * NPROJ + u.pn * 256 + c) = w; } }
        } else {
#pragma unroll
            for (int ai = 0; ai < 2; ++ai)
#pragma unroll
                for (int m = 0; m < 4; ++m) { bf16_t* rowp = PROJ + (size_t)(row0 + ai * 128 + m * 16) * NPROJ + u.pn * 256 + cb0;
#pragma unroll
                    for (int bj = 0; bj < 2; ++bj) { const f32x4 v0 = acc[ai][bj][m][0], v1 = acc[ai][bj][m][1];
                        u32x4 w; w.x = pg8::cvt_pk_bf16(v0[0], v0[1]); w.y = pg8::cvt_pk_bf16(v0[2], v0[3]); w.z = pg8::cvt_pk_bf16(v1[0], v1[1]); w.w = pg8::cvt_pk_bf16(v1[2], v1[3]);
                        *(u32x4*)(rowp + bj * 128) = w; } }
        }
    }
};
struct EpiRes {
    static constexpr bool PERM = true, AFTER_DRAIN = false;
    const float* x; bf16_t* HB; float* SSQ;
    __device__ __forceinline__ void operator()(const pg8::f32x4 (&acc)[2][2][4][2], const pg8::Unit& u, int wr, int wc, int fr, int fq) const {
        const int row0 = u.pm * 256 + wr * 64 + fr, col0 = u.pn * 256 + wc * 32 + 8 * fq;
#pragma unroll
        for (int ai = 0; ai < 2; ++ai)
#pragma unroll
            for (int m = 0; m < 4; ++m) { const int row = row0 + ai * 128 + m * 16; const float* xr = x + (size_t)row * DM + col0; bf16_t* hr = HB + (size_t)row * DM + col0; float ss = 0.f;
#pragma unroll
                for (int bj = 0; bj < 2; ++bj) { const f32x4 v0 = acc[ai][bj][m][0] + *(const f32x4*)(xr + bj * 128), v1 = acc[ai][bj][m][1] + *(const f32x4*)(xr + bj * 128 + 4);
                    ss += (v0[0] * v0[0] + v0[1] * v0[1]) + (v0[2] * v0[2] + v0[3] * v0[3]) + (v1[0] * v1[0] + v1[1] * v1[1]) + (v1[2] * v1[2] + v1[3] * v1[3]);
                    u32x4 w; w.x = pg8::cvt_pk_bf16(v0[0], v0[1]); w.y = pg8::cvt_pk_bf16(v0[2], v0[3]); w.z = pg8::cvt_pk_bf16(v1[0], v1[1]); w.w = pg8::cvt_pk_bf16(v1[2], v1[3]);
                    *(u32x4*)(hr + bj * 128) = w; }
                ss += __shfl_xor(ss, 16); ss += __shfl_xor(ss, 32);
                if (fq == 0) SSQ[(size_t)row * 16 + u.pn * 4 + wc] = ss; }
    }
};
struct EpiF16 {
    static constexpr bool PERM = true, AFTER_DRAIN = false;
    _Float16* SC;
    __device__ __forceinline__ void operator()(const pg8::f32x4 (&acc)[2][2][4][2], const pg8::Unit& u, int wr, int wc, int fr, int fq) const {
        const int row0 = u.pm * 256 + wr * 64 + fr, col0 = u.pn * 256 + wc * 32 + 8 * fq;
#pragma unroll
        for (int ai = 0; ai < 2; ++ai)
#pragma unroll
            for (int m = 0; m < 4; ++m) { _Float16* rowp = SC + (size_t)(row0 + ai * 128 + m * 16) * 2048 + col0;
#pragma unroll
                for (int bj = 0; bj < 2; ++bj) { const f32x4 v0 = acc[ai][bj][m][0], v1 = acc[ai][bj][m][1];
                    u32x4 w;
                    w.x = __builtin_bit_cast(unsigned, (f16x2_t){(_Float16)v0[0], (_Float16)v0[1]}); w.y = __builtin_bit_cast(unsigned, (f16x2_t){(_Float16)v0[2], (_Float16)v0[3]});
                    w.z = __builtin_bit_cast(unsigned, (f16x2_t){(_Float16)v1[0], (_Float16)v1[1]}); w.w = __builtin_bit_cast(unsigned, (f16x2_t){(_Float16)v1[2], (_Float16)v1[3]});
                    *(u32x4*)(rowp + bj * 128) = w; } }
    }
};

constexpr int A_QT = 0, A_KT = 9216, A_KE = 18432, A_V = 27648, A_ST = 45056, A_STSZ = 18432, A_OB = 81920, A_DEC = 115712, A_CS = 115968;
constexpr int PQ = 72, PV = 136, POB = 132;

__device__ __forceinline__ bf16x8 tr2(const LAS bf16_t* p0, const LAS bf16_t* p1) {
    const s16x4 a = __builtin_amdgcn_ds_read_tr16_b64_v4i16((LAS s16x4*)p0), b = __builtin_amdgcn_ds_read_tr16_b64_v4i16((LAS s16x4*)p1);
    return (bf16x8){a[0], a[1], a[2], a[3], b[0], b[1], b[2], b[3]};
}
__device__ __forceinline__ float ln_gamma(int hr) { return log1pf(-exp2f(-5.0f - (float)hr)); }

template <bool FULL>
__device__ __forceinline__ void attn_pass(const Params& p, LAS unsigned char* lds, int bid, int nb) {
    const int tid = threadIdx.x, lane = tid & 63, wave = __builtin_amdgcn_readfirstlane(tid >> 6);
    const int r16 = lane & 15, g4 = lane >> 4, q4 = (lane & 15) >> 2, p4 = lane & 3;
    unsigned char* ws = p.ws;
    const bf16_t* PROJ = (const bf16_t*)(ws + WS_PROJ); const float* LA = (const float*)(ws + WS_LA);
    float* SEG = (float*)(ws + WS_SEG); float* ASEG = (float*)(ws + WS_ASEG); bf16_t* OUT = (bf16_t*)(ws + WS_O);
    LAS bf16_t* QT = (LAS bf16_t*)(lds + A_QT); LAS bf16_t* KT = (LAS bf16_t*)(lds + A_KT); LAS bf16_t* KE = (LAS bf16_t*)(lds + A_KE); LAS bf16_t* VS = (LAS bf16_t*)(lds + A_V);
    LAS float* OB = (LAS float*)(lds + A_OB); LAS float* DEC = (LAS float*)(lds + A_DEC); LAS float* CS = (LAS float*)(lds + A_CS);

    for (int item = bid; item < 256; item += nb) {
        const int seg = item & 7, h8 = (item >> 3) & 7, b = item >> 6;
        if (!FULL && seg == 7) continue;
        const bool gla = h8 < 4; const int hr = h8 & 3;
        const float lng = ln_gamma(hr);
        const int qcol = gla ? C_GQ + hr * 64 : C_RQ + hr * 64, kcol = gla ? C_GK + hr * 64 : C_RK + hr * 64;
        const int vcol = gla ? C_GV + hr * 128 : C_RV + hr * 128, gcol = gla ? C_GG + hr * 128 : C_RG + hr * 128;
        const int nch = (seg == 0) ? 17 : 16;

        f32x4 accS[8];
#pragma unroll
        for (int cb = 0; cb < 8; ++cb) accS[cb] = (f32x4){0.f, 0.f, 0.f, 0.f};
        float blsum = 0.f;
        __syncthreads();
        if (FULL) {
            if (wave >= 4) {
                const int wq = wave - 4;
                for (int sp = 0; sp < seg; ++sp) { const int it2 = (item & ~7) + sp; const float* Sg = SEG + (size_t)it2 * 8192; const float* Ag = ASEG + it2 * 64;
                    float dec[4];
#pragma unroll
                    for (int rg = 0; rg < 4; ++rg) dec[rg] = Ag[16 * wq + 4 * g4 + rg];
#pragma unroll
                    for (int cb = 0; cb < 8; ++cb)
#pragma unroll
                        for (int rg = 0; rg < 4; ++rg) accS[cb][rg] = dec[rg] * accS[cb][rg] + Sg[(16 * wq + 4 * g4 + rg) * 128 + 16 * cb + r16]; }
                LAS bf16_t* ST0 = (LAS bf16_t*)(lds + A_ST);
#pragma unroll
                for (int cb = 0; cb < 8; ++cb) { u32x2 w; w.x = pk2(accS[cb][0], accS[cb][1]); w.y = pk2(accS[cb][2], accS[cb][3]); *(LAS u32x2*)(ST0 + (16 * cb + r16) * PQ + 16 * wq + 4 * g4) = w; }
            }
        }
        for (int ci = 0; ci < nch; ++ci) {
            const bool metac = (seg == 0 && ci == 0);
            const int rc = (seg == 0) ? ci - 1 : 16 * seg + ci;
            const int rowbase = metac ? 0 : 256 + b * SEQ + rc * 64;
            const LAS bf16_t* STr = (const LAS bf16_t*)(lds + A_ST + (ci & 1) * A_STSZ); LAS bf16_t* STw = (LAS bf16_t*)(lds + A_ST + ((ci + 1) & 1) * A_STSZ);
            const int d = tid & 63, sg = tid >> 6;
            float pre[8]; bf16_t qv[8], kv[8];
            {
                float run = 0.f;
#pragma unroll
                for (int k = 0; k < 8; ++k) { const size_t row = (size_t)(rowbase + 8 * sg + k);
                    const float la = gla ? LA[row * 256 + hr * 64 + d] : lng; run += la; pre[k] = run;
                    if (FULL) qv[k] = PROJ[row * NPROJ + qcol + d];
                    kv[k] = PROJ[row * NPROJ + kcol + d]; }
                CS[sg * 64 + d] = run;
            }
            u32x4 vreg[2];
            { const int vr = tid >> 3, cc = tid & 7; const u32x4* src = (const u32x4*)(PROJ + (size_t)(rowbase + vr) * NPROJ + vcol + cc * 16); vreg[0] = src[0]; vreg[1] = src[1]; }
            __syncthreads();
            {
                float off = 0.f, tot = 0.f;
#pragma unroll
                for (int s = 0; s < 8; ++s) { const float c = CS[s * 64 + d]; tot += c; off += (s < sg) ? c : 0.f; }
#pragma unroll
                for (int k = 0; k < 8; ++k) { const float bc = off + pre[k]; const int i = 8 * sg + k; const float kf = bf1(kv[k]);
                    if (FULL) { QT[i * PQ + d] = (bf16_t)f2bf(bf1(qv[k]) * __expf(bc)); KT[i * PQ + d] = (bf16_t)f2bf(kf * __expf(-bc)); }
                    KE[i * PQ + d] = (bf16_t)f2bf(kf * __expf(tot - bc)); }
                if (sg == 0) { DEC[d] = __expf(tot); blsum += tot; }
                const int vr = tid >> 3, cc = tid & 7; LAS u32x4* dst = (LAS u32x4*)(VS + vr * PV + cc * 16); dst[0] = vreg[0]; dst[1] = vreg[1];
            }
            __syncthreads();
            if (wave < 4) {
                if (FULL && !metac) {
                    const int w = wave;
                    bf16x8 qf[2];
#pragma unroll
                    for (int s = 0; s < 2; ++s) qf[s] = *(const LAS bf16x8*)(QT + (16 * w + r16) * PQ + 32 * s + 8 * g4);
                    f32x4 att[4];
#pragma unroll
                    for (int jb = 0; jb < 4; ++jb) { att[jb] = (f32x4){0.f, 0.f, 0.f, 0.f};
                        if (jb <= w) {
#pragma unroll
                            for (int s = 0; s < 2; ++s) { const bf16x8 kf = *(const LAS bf16x8*)(KT + (16 * jb + r16) * PQ + 32 * s + 8 * g4);
                                att[jb] = __builtin_amdgcn_mfma_f32_16x16x32_bf16(kf, qf[s], att[jb], 0, 0, 0); }
                            if (jb == w) {
#pragma unroll
                                for (int rg = 0; rg < 4; ++rg) att[jb][rg] = (4 * g4 + rg <= r16) ? att[jb][rg] : 0.f;
                            }
                        } }
                    bf16x8 af[2];
#pragma unroll
                    for (int s = 0; s < 2; ++s) { u32x4 t; t.x = pk2(att[2 * s][0], att[2 * s][1]); t.y = pk2(att[2 * s][2], att[2 * s][3]); t.z = pk2(att[2 * s + 1][0], att[2 * s + 1][1]); t.w = pk2(att[2 * s + 1][2], att[2 * s + 1][3]);
                        af[s] = __builtin_bit_cast(bf16x8, t); }
#pragma unroll
                    for (int cb = 0; cb < 8; ++cb) { f32x4 o = (f32x4){0.f, 0.f, 0.f, 0.f};
#pragma unroll
                        for (int s = 0; s < 2; ++s) {
                            const bf16x8 vf = tr2(VS + (32 * s + 4 * g4 + q4) * PV + 16 * cb + 4 * p4, VS + (32 * s + 16 + 4 * g4 + q4) * PV + 16 * cb + 4 * p4);
                            o = __builtin_amdgcn_mfma_f32_16x16x32_bf16(af[s], vf, o, 0, 0, 0);
                            const bf16x8 sf = *(const LAS bf16x8*)(STr + (16 * cb + r16) * PQ + 32 * s + 8 * g4);
                            o = __builtin_amdgcn_mfma_f32_16x16x32_bf16(qf[s], sf, o, 0, 0, 0); }
#pragma unroll
                        for (int rg = 0; rg < 4; ++rg) OB[(16 * w + 4 * g4 + rg) * POB + 16 * cb + r16] = o[rg]; }
                }
            } else {
                const int wq = wave - 4;
                float dec[4];
#pragma unroll
                for (int rg = 0; rg < 4; ++rg) dec[rg] = DEC[16 * wq + 4 * g4 + rg];
                bf16x8 kef[2];
#pragma unroll
                for (int s = 0; s < 2; ++s) kef[s] = tr2(KE + (32 * s + 8 * g4 + q4) * PQ + 16 * wq + 4 * p4, KE + (32 * s + 8 * g4 + 4 + q4) * PQ + 16 * wq + 4 * p4);
#pragma unroll
                for (int cb = 0; cb < 8; ++cb) {
#pragma unroll
                    for (int rg = 0; rg < 4; ++rg) accS[cb][rg] *= dec[rg];
#pragma unroll
                    for (int s = 0; s < 2; ++s) { const bf16x8 vf = tr2(VS + (32 * s + 8 * g4 + q4) * PV + 16 * cb + 4 * p4, VS + (32 * s + 8 * g4 + 4 + q4) * PV + 16 * cb + 4 * p4);
                        accS[cb] = __builtin_amdgcn_mfma_f32_16x16x32_bf16(kef[s], vf, accS[cb], 0, 0, 0); }
                    if (FULL) { u32x2 w; w.x = pk2(accS[cb][0], accS[cb][1]); w.y = pk2(accS[cb][2], accS[cb][3]); *(LAS u32x2*)(STw + (16 * cb + r16) * PQ + 16 * wq + 4 * g4) = w; }
                }
            }
            __syncthreads();
            if (FULL && !metac) {
                const int i = tid >> 3, cc = tid & 7;
                float o[16];
#pragma unroll
                for (int k4 = 0; k4 < 4; ++k4) { const f32x4 t = *(const LAS f32x4*)(OB + i * POB + 16 * cc + 4 * k4); o[4 * k4] = t[0]; o[4 * k4 + 1] = t[1]; o[4 * k4 + 2] = t[2]; o[4 * k4 + 3] = t[3]; }
                const size_t row = (size_t)(rowbase + i);
                const u32x4* gp = (const u32x4*)(PROJ + row * NPROJ + gcol + 16 * cc); const u32x4 ga = gp[0], gb2 = gp[1];
                const unsigned gw[8] = {ga.x, ga.y, ga.z, ga.w, gb2.x, gb2.y, gb2.z, gb2.w};
                float s1 = 0.f, s2 = 0.f;
#pragma unroll
                for (int k = 0; k < 16; ++k) { s1 += o[k]; s2 += o[k] * o[k]; }
#pragma unroll
                for (int m = 1; m < 8; m <<= 1) { s1 += __shfl_xor(s1, m); s2 += __shfl_xor(s2, m); }
                float mu, rs;
                if (gla) { mu = 0.f; rs = 1.0f / sqrtf(s2 * (1.0f / 128.0f) + EPS); }
                else { mu = s1 * (1.0f / 128.0f); const float var = fmaxf(s2 * (1.0f / 128.0f) - mu * mu, 0.f); rs = 1.0f / sqrtf(var + EPS); }
                const float* gn = (gla ? p.gla_gain : p.ret_gain) + 16 * cc; const float* bs = p.ret_bias + 16 * cc;
                unsigned ow[8];
#pragma unroll
                for (int k2 = 0; k2 < 8; ++k2) { float y[2];
#pragma unroll
                    for (int e = 0; e < 2; ++e) { const int k = 2 * k2 + e; float v = (o[k] - mu) * rs * gn[k]; if (!gla) v += bs[k];
                        const float gt = e ? bf_hi(gw[k2]) : bf_lo(gw[k2]); y[e] = v * gt / (1.0f + __expf(-gt)); }
                    ow[k2] = pk2(y[0], y[1]); }
                u32x4* op = (u32x4*)(OUT + (row - 256) * DM + h8 * 128 + 16 * cc);
                op[0] = (u32x4){ow[0], ow[1], ow[2], ow[3]}; op[1] = (u32x4){ow[4], ow[5], ow[6], ow[7]};
            }
        }
        if (!FULL) {
            if (wave >= 4) { const int wq = wave - 4; float* Sg = SEG + (size_t)item * 8192;
#pragma unroll
                for (int cb = 0; cb < 8; ++cb)
#pragma unroll
                    for (int rg = 0; rg < 4; ++rg) Sg[(16 * wq + 4 * g4 + rg) * 128 + 16 * cb + r16] = accS[cb][rg]; }
            if (tid < 64) ASEG[item * 64 + tid] = __expf(blsum);
        }
    }
}

__device__ __forceinline__ unsigned ord32(float f) { const unsigned b = __builtin_bit_cast(unsigned, f); return b ^ ((b >> 31) ? 0xffffffffu : 0x80000000u); }
__device__ __forceinline__ float unord32(unsigned o) { const unsigned b = (o >> 31) ? (o ^ 0x80000000u) : ~o; return __builtin_bit_cast(float, b); }
#define DPP_MAXU(v, ctrl, rmask) do { const unsigned _t = (unsigned)__builtin_amdgcn_update_dpp((int)(v), (int)(v), (ctrl), (rmask), 0xf, false); (v) = (v) > _t ? (v) : _t; } while (0)
#define DPP_ADDF(v, ctrl) do { const float _t = __builtin_bit_cast(float, __builtin_amdgcn_update_dpp(0, __builtin_bit_cast(int, (v)), (ctrl), 0xf, 0xf, false)); (v) += _t; } while (0)
__device__ __forceinline__ unsigned row_max_u(unsigned v) { DPP_MAXU(v, 0xB1, 0xf); DPP_MAXU(v, 0x4E, 0xf); DPP_MAXU(v, 0x124, 0xf); DPP_MAXU(v, 0x128, 0xf); return v; }
__device__ __forceinline__ float row_sum_f(float v) { DPP_ADDF(v, 0xB1); DPP_ADDF(v, 0x4E); DPP_ADDF(v, 0x124); DPP_ADDF(v, 0x128); return v; }
__device__ __forceinline__ unsigned wave_max_u(unsigned v) { v = row_max_u(v); DPP_MAXU(v, 0x142, 0xa); DPP_MAXU(v, 0x143, 0xc); return (unsigned)__builtin_amdgcn_readlane((int)v, 63); }

#if PEER_SIMPLE
#undef ROWSUM
__device__ __forceinline__ float row_sum_x(float v) { v += __shfl_xor(v, 1); v += __shfl_xor(v, 2); v += __shfl_xor(v, 4); v += __shfl_xor(v, 8); return v; }
#else
__device__ __forceinline__ float row_sum_x(float v) { return row_sum_f(v); }
#endif
__device__ __forceinline__ float dot2_bf16(unsigned w, unsigned x, float acc) { return __builtin_amdgcn_fdot2_f32_bf16(__builtin_bit_cast(bf16x2_t, w), __builtin_bit_cast(bf16x2_t, x), acc, false); }
__device__ __forceinline__ float gelu_exact(float v) { return 0.5f * v * (1.0f + erff(v * 0.70710678118654752f)); }

__device__ __forceinline__ void phase_peer(const Params& p, LAS unsigned char* lds, int bid, int nb) {
    const int tid = threadIdx.x, lane = tid & 63, wave = __builtin_amdgcn_readfirstlane(tid >> 6);
    const int p16 = lane & 15, rg4 = lane >> 4;
    unsigned char* ws = p.ws;
    const _Float16* SC = (const _Float16*)(ws + WS_PROJ); const bf16_t* HB = (const bf16_t*)(ws + WS_XN); const float* SSQ = (const float*)(ws + WS_SSQ);
    const unsigned char* UB = (const unsigned char*)(ws + WS_UB); const unsigned char* VB = (const unsigned char*)(ws + WS_VB);
    LAS float* A_s = (LAS float*)(lds + wave * 4096);
    LAS int* A_i = (LAS int*)(lds + wave * 4096 + 1024);
    LAS int* E_i = (LAS int*)(lds + wave * 4096 + 2048);
    LAS float* E_s = (LAS float*)(lds + wave * 4096 + 2560);
    int ci = 0, cj = 0; bool cvalid = lane < 50;
    { int l = lane;
      if (l < 16) { ci = 0; cj = l; } else if (l < 24) { ci = 1; cj = l - 16; } else if (l < 29) { ci = 2; cj = l - 24; } else if (l < 33) { ci = 3; cj = l - 29; }
      else if (l < 36) { ci = 4; cj = l - 33; } else if (l < 42) { ci = 5 + (l - 36) / 2; cj = (l - 36) & 1; } else { ci = 8 + (l - 42); cj = 0; } if (!cvalid) { ci = 0; cj = 0; } }
    const int gw = bid * 8 + wave, NGW = nb * 8;
    for (int t = gw; t < NTOK; t += NGW) {
        float ssq = (lane < 16) ? SSQ[(size_t)t * 16 + lane] : 0.f; ssq = wave_sum(ssq);
        const float rstd = 1.0f / sqrtf(ssq * (1.0f / DM) + EPS);
#if PEER_SIMPLE
        {
            LAS unsigned* KK = (LAS unsigned*)(lds + 32768 + wave * 8448);
#pragma unroll 1
            for (int q = 0; q < 4; ++q) {
                const u32x4 raw = *(const u32x4*)(SC + (size_t)t * 2048 + 512 * q + 8 * lane);
                const unsigned rw[4] = {raw.x, raw.y, raw.z, raw.w};
#pragma unroll
                for (int e = 0; e < 8; ++e) { const unsigned hbits = (e & 1) ? (rw[e >> 1] >> 16) : (rw[e >> 1] & 0xffffu);
                    const float f = (float)__builtin_bit_cast(_Float16, (unsigned short)hbits);
                    KK[(4 * q + rg4) * 129 + 8 * p16 + e] = (ord32(f) & ~0x7fu) | (unsigned)(127 - (8 * p16 + e)); }
            }
            LDS_WAIT();
            if (lane < 16) { unsigned prev = 0xffffffffu;
#pragma unroll 1
                for (int r = 0; r < 16; ++r) { unsigned best = 0u;
#pragma unroll 4
                    for (int n = 0; n < 128; ++n) { const unsigned k = KK[lane * 129 + n]; best = (k < prev && k > best) ? k : best; }
                    A_s[lane * 16 + r] = unord32(best & ~0x7fu); A_i[lane * 16 + r] = 127 - (int)(best & 0x7fu); prev = best; } }
            LDS_WAIT();
            if (lane < 8) { const int h = lane; unsigned prev = 0xffffffffu;
#pragma unroll 1
                for (int r = 0; r < 16; ++r) { unsigned best = 0u;
#pragma unroll 1
                    for (int c = 0; c < 256; ++c) { const float sum = A_s[(2 * h) * 16 + (c >> 4)] + A_s[(2 * h + 1) * 16 + (c & 15)];
                        const unsigned k = (ord32(sum) & ~0xffu) | (unsigned)(255 - c); best = (k < prev && k > best) ? k : best; }
                    const int c = 255 - (int)(best & 0xffu);
                    E_i[h * 16 + r] = A_i[(2 * h) * 16 + (c >> 4)] * 128 + A_i[(2 * h + 1) * 16 + (c & 15)];
                    E_s[h * 16 + r] = A_s[(2 * h) * 16 + (c >> 4)] + A_s[(2 * h + 1) * 16 + (c & 15)]; prev = best; } }
            LDS_WAIT();
        }
#else
#pragma unroll 1
        for (int q = 0; q < 4; ++q) {
            const u32x4 raw = *(const u32x4*)(SC + (size_t)t * 2048 + 512 * q + 8 * lane);
            const unsigned rw[4] = {raw.x, raw.y, raw.z, raw.w};
            unsigned key[8];
#pragma unroll
            for (int e = 0; e < 8; ++e) { const unsigned hbits = (e & 1) ? (rw[e >> 1] >> 16) : (rw[e >> 1] & 0xffffu);
                const float f = (float)__builtin_bit_cast(_Float16, (unsigned short)hbits);
                key[e] = (ord32(f) & ~0x7fu) | (unsigned)(127 - (8 * p16 + e)); }
            unsigned mine = 0u;
#pragma unroll 1
            for (int it = 0; it < 16; ++it) {
                unsigned m = key[0];
#pragma unroll
                for (int e = 1; e < 8; ++e) m = m > key[e] ? m : key[e];
                const unsigned W = row_max_u(m);
                mine = (p16 == it) ? W : mine;
#pragma unroll
                for (int e = 0; e < 8; ++e) key[e] = (key[e] == W) ? 0u : key[e];
            }
            const int g = 4 * q + rg4;
            A_s[g * 16 + p16] = unord32(mine & ~0x7fu); A_i[g * 16 + p16] = 127 - (int)(mine & 0x7fu);
        }
        LDS_WAIT();
#pragma unroll 1
        for (int h = 0; h < 8; ++h) {
            const float sa = A_s[(2 * h) * 16 + ci], sb = A_s[(2 * h + 1) * 16 + cj];
            const int ia = A_i[(2 * h) * 16 + ci], ib = A_i[(2 * h + 1) * 16 + cj];
            const float sum = sa + sb;
            unsigned key = cvalid ? ((ord32(sum) & ~0x3fu) | (unsigned)(63 - lane)) : 0u;
            int rank = -1;
#pragma unroll 1
            for (int it = 0; it < 16; ++it) { const unsigned W = wave_max_u(key); if (key == W) { rank = it; key = 0u; } }
            if (rank >= 0) { E_i[h * 16 + rank] = ia * 128 + ib; E_s[h * 16 + rank] = sum; }
        }
        LDS_WAIT();
#endif
#if PEER_SIMPLE_TAIL
        {
            float xv[16], accv[16];
            { const u32x4 h0 = *(const u32x4*)(HB + (size_t)t * DM + 16 * lane), h1 = *(const u32x4*)(HB + (size_t)t * DM + 16 * lane + 8);
              const unsigned hw[8] = {h0.x, h0.y, h0.z, h0.w, h1.x, h1.y, h1.z, h1.w};
#pragma unroll
              for (int k = 0; k < 16; ++k) { const float hv = (k & 1) ? bf_hi(hw[k >> 1]) : bf_lo(hw[k >> 1]); xv[k] = hv * rstd * p.g2[16 * lane + k]; accv[k] = 0.f; } }
#pragma unroll 1
            for (int h = 0; h < 8; ++h) {
                const float mx = E_s[h * 16] * rstd; float den = 0.f;
#pragma unroll 1
                for (int k = 0; k < 16; ++k) den += __expf(E_s[h * 16 + k] * rstd - mx);
#pragma unroll 1
                for (int k = 0; k < 16; ++k) {
                    const int ex = __builtin_amdgcn_readfirstlane(E_i[h * 16 + k]); const float g = __expf(E_s[h * 16 + k] * rstd - mx) / den;
                    const float* ur = p.pu + (size_t)ex * DM + 16 * lane; const float* vr = p.pv + (size_t)ex * DM + 16 * lane;
                    float s = 0.f;
#pragma unroll
                    for (int j = 0; j < 16; ++j) s += xv[j] * ur[j];
                    s = wave_sum(s);
                    const float cf = g * gelu_exact(s);
#pragma unroll
                    for (int j = 0; j < 16; ++j) accv[j] += cf * vr[j];
                }
            }
            float ss = 0.f;
            { const u32x4 h0 = *(const u32x4*)(HB + (size_t)t * DM + 16 * lane), h1 = *(const u32x4*)(HB + (size_t)t * DM + 16 * lane + 8);
              const unsigned hw[8] = {h0.x, h0.y, h0.z, h0.w, h1.x, h1.y, h1.z, h1.w};
#pragma unroll
              for (int k = 0; k < 16; ++k) { const float hv = (k & 1) ? bf_hi(hw[k >> 1]) : bf_lo(hw[k >> 1]); accv[k] += hv; ss += accv[k] * accv[k]; } }
            ss = wave_sum(ss);
            const float rf = 1.0f / sqrtf(ss * (1.0f / DM) + EPS);
#pragma unroll
            for (int k = 0; k < 16; ++k) p.out[(size_t)t * DM + 16 * lane + k] = accv[k] * rf * p.gfin[16 * lane + k];
        }
#else
        float gsm[2]; int eidx[2];
#pragma unroll
        for (int sl = 0; sl < 2; ++sl) { const int e = lane + 64 * sl; const float s = E_s[e] * rstd, mx = E_s[e & ~15] * rstd; const float pe = __expf(s - mx); const float den = row_sum_x(pe);
            gsm[sl] = pe / den; eidx[sl] = E_i[e]; }
        unsigned xp[8][4];
#pragma unroll
        for (int i = 0; i < 8; ++i) { const u32x4 hw = *(const u32x4*)(HB + (size_t)t * DM + 128 * i + 8 * p16); const f32x4 ga = *(const f32x4*)(p.g2 + 128 * i + 8 * p16), gb = *(const f32x4*)(p.g2 + 128 * i + 8 * p16 + 4);
            xp[i][0] = pk2(bf_lo(hw.x) * rstd * ga[0], bf_hi(hw.x) * rstd * ga[1]); xp[i][1] = pk2(bf_lo(hw.y) * rstd * ga[2], bf_hi(hw.y) * rstd * ga[3]);
            xp[i][2] = pk2(bf_lo(hw.z) * rstd * gb[0], bf_hi(hw.z) * rstd * gb[1]); xp[i][3] = pk2(bf_lo(hw.w) * rstd * gb[2], bf_hi(hw.w) * rstd * gb[3]); }
        float act[2] = {0.f, 0.f};
#pragma unroll
        for (int sl = 0; sl < 2; ++sl) {
#pragma unroll 2
            for (int b16 = 0; b16 < 16; ++b16) {
                const int e = 64 * sl + 16 * rg4 + b16; const int ex = E_i[e];
                const unsigned char* rowp = UB + (size_t)ex * 2048 + 16 * p16;
                float s = 0.f;
#if TAIL_U_F32
#pragma unroll
                for (int i = 0; i < 8; ++i) { const float* ur = p.pu + (size_t)ex * DM + 128 * i + 8 * p16; const f32x4 ua = *(const f32x4*)ur, ub = *(const f32x4*)(ur + 4);
                    s += bf_lo(xp[i][0]) * ua[0] + bf_hi(xp[i][0]) * ua[1] + bf_lo(xp[i][1]) * ua[2] + bf_hi(xp[i][1]) * ua[3] + bf_lo(xp[i][2]) * ub[0] + bf_hi(xp[i][2]) * ub[1] + bf_lo(xp[i][3]) * ub[2] + bf_hi(xp[i][3]) * ub[3]; }
#else
#pragma unroll
                for (int i = 0; i < 8; ++i) { const u32x4 uw = *(const u32x4*)(rowp + 256 * i);
                    s = dot2_bf16(uw.x, xp[i][0], s); s = dot2_bf16(uw.y, xp[i][1], s); s = dot2_bf16(uw.z, xp[i][2], s); s = dot2_bf16(uw.w, xp[i][3], s); }
#endif
                s = row_sum_x(s);
                act[sl] = (p16 == b16) ? s : act[sl];
            }
        }
        float coef[2];
#pragma unroll
        for (int sl = 0; sl < 2; ++sl) coef[sl] = gsm[sl] * gelu_exact(act[sl]);
        float acc[8][8];
#pragma unroll
        for (int i = 0; i < 8; ++i)
#pragma unroll
            for (int k = 0; k < 8; ++k) acc[i][k] = 0.f;
#pragma unroll
        for (int sl = 0; sl < 2; ++sl) {
#pragma unroll 2
            for (int b16 = 0; b16 < 16; ++b16) {
                const int srcl = (lane & 48) + b16;
                const float cf = __shfl(coef[sl], srcl); const int ex = __shfl(eidx[sl], srcl);
                const unsigned char* rowp = VB + (size_t)ex * 2048 + 16 * p16;
#pragma unroll
                for (int i = 0; i < 8; ++i) { const u32x4 vw = *(const u32x4*)(rowp + 256 * i);
                    acc[i][0] += cf * bf_lo(vw.x); acc[i][1] += cf * bf_hi(vw.x); acc[i][2] += cf * bf_lo(vw.y); acc[i][3] += cf * bf_hi(vw.y);
                    acc[i][4] += cf * bf_lo(vw.z); acc[i][5] += cf * bf_hi(vw.z); acc[i][6] += cf * bf_lo(vw.w); acc[i][7] += cf * bf_hi(vw.w); }
            }
        }
        float ss = 0.f;
#pragma unroll
        for (int i = 0; i < 8; ++i) { const u32x4 hw = *(const u32x4*)(HB + (size_t)t * DM + 128 * i + 8 * p16); const unsigned hv[4] = {hw.x, hw.y, hw.z, hw.w};
#pragma unroll
            for (int k = 0; k < 8; ++k) { float a = acc[i][k]; a += __shfl_xor(a, 16); a += __shfl_xor(a, 32);
                a += (k & 1) ? bf_hi(hv[k >> 1]) : bf_lo(hv[k >> 1]); acc[i][k] = a; ss += a * a; } }
        ss = row_sum_x(ss);
        const float rf = 1.0f / sqrtf(ss * (1.0f / DM) + EPS);
#pragma unroll
        for (int i = 0; i < 8; ++i) { if ((i >> 1) == rg4) { const f32x4 ga = *(const f32x4*)(p.gfin + 128 * i + 8 * p16), gb = *(const f32x4*)(p.gfin + 128 * i + 8 * p16 + 4);
                float* op = p.out + (size_t)t * DM + 128 * i + 8 * p16;
                *(f32x4*)op = (f32x4){acc[i][0] * rf * ga[0], acc[i][1] * rf * ga[1], acc[i][2] * rf * ga[2], acc[i][3] * rf * ga[3]};
                *(f32x4*)(op + 4) = (f32x4){acc[i][4] * rf * gb[0], acc[i][5] * rf * gb[1], acc[i][6] * rf * gb[2], acc[i][7] * rf * gb[3]}; } }
#endif
        LDS_WAIT();
    }
}


__device__ __forceinline__ void phase_naive_scores(const Params& p, LAS unsigned char* lds, int bid, int nb) {
    const int tid = threadIdx.x;
    unsigned char* ws = p.ws;
    const bf16_t* HB = (const bf16_t*)(ws + WS_XN); const float* SSQ = (const float*)(ws + WS_SSQ); _Float16* SC = (_Float16*)(ws + WS_PROJ);
    LAS float* XS = (LAS float*)lds;
    LAS float* QS = (LAS float*)(lds + 32768);
    for (int item = bid; item < NTOK / 8; item += nb) {
        const int t0 = item * 8;
        __syncthreads();
        for (int e = tid; e < 8 * 1024; e += 512) { const int tt = e >> 10, k = e & 1023; XS[e] = bf1(HB[(size_t)(t0 + tt) * DM + k]) * p.g2[k]; }
        __syncthreads();
        float acc[8][4];
#pragma unroll
        for (int tt = 0; tt < 8; ++tt)
#pragma unroll
            for (int c = 0; c < 4; ++c) acc[tt][c] = 0.f;
        for (int k = 0; k < 1024; ++k) { const f32x4 w = *(const f32x4*)(p.w_q + (size_t)k * 2048 + 4 * tid);
#pragma unroll
            for (int tt = 0; tt < 8; ++tt) { const float xv = XS[tt * 1024 + k]; acc[tt][0] += xv * w[0]; acc[tt][1] += xv * w[1]; acc[tt][2] += xv * w[2]; acc[tt][3] += xv * w[3]; } }
#pragma unroll
        for (int tt = 0; tt < 8; ++tt)
#pragma unroll
            for (int c = 0; c < 4; ++c) QS[tt * 2048 + 4 * tid + c] = acc[tt][c];
        __syncthreads();
#pragma unroll 1
        for (int c = 0; c < 4; ++c) { const int col = 4 * tid + c, hc = col >> 7; const float* sk = p.subkeys + (size_t)col * 128;
            float s[8];
#pragma unroll
            for (int tt = 0; tt < 8; ++tt) s[tt] = 0.f;
            for (int d = 0; d < 128; ++d) { const float kv = sk[d];
#pragma unroll
                for (int tt = 0; tt < 8; ++tt) s[tt] += QS[tt * 2048 + hc * 128 + d] * kv; }
#pragma unroll
            for (int tt = 0; tt < 8; ++tt) SC[(size_t)(t0 + tt) * 2048 + col] = (_Float16)s[tt]; }
    }
}

__global__ void __launch_bounds__(512, 2) mk_fwd(Params p) {
    extern __shared__ __attribute__((aligned(16))) unsigned char lds_raw[];
    LAS unsigned char* lds = (LAS unsigned char*)lds_raw;
    const int bid = blockIdx.x, nb = gridDim.x;
    unsigned char* ws = p.ws;
#define IN(k) (p.ph_lo <= (k) && (k) < p.ph_hi)
#define SEAM(k) do { if (IN(k) && IN((k) + 1)) { cg::this_grid().sync(); } } while (0)
    if (IN(0)) phase0(p, lds, bid, nb);
    SEAM(0);
    if (IN(1)) {
        pg8::Gemm g{(const bf16_t*)(ws + WS_XN), (const bf16_t*)(ws + WS_WIN), MROWS, NP1, DM}; pg8::StaticOrder S; S.init(MROWS, NP1, nb, bid);
        EpiProj E{(bf16_t*)(ws + WS_PROJ), (float*)(ws + WS_LA), p.gb, (const float2*)(ws + WS_ROPE)};
        pg8::gemm_phase<EpiProj, pg8::StaticOrder, true, true>(lds, g, S, E);
    }
    SEAM(1);
    if (IN(2)) attn_pass<false>(p, lds, bid, nb);
    SEAM(2);
    if (IN(3)) attn_pass<true>(p, lds, bid, nb);
    SEAM(3);
    if (IN(4)) {
        pg8::Gemm g{(const bf16_t*)(ws + WS_O), (const bf16_t*)(ws + WS_WOUT), NTOK, DM, DM}; pg8::StaticOrder S; S.init(NTOK, DM, nb, bid);
        EpiRes E{p.x, (bf16_t*)(ws + WS_XN), (float*)(ws + WS_SSQ)};
        pg8::gemm_phase<EpiRes, pg8::StaticOrder, true, true>(lds, g, S, E);
    }
    SEAM(4);
    if (IN(5)) {
        pg8::Gemm g{(const bf16_t*)(ws + WS_XN), (const bf16_t*)(ws + WS_WS), NTOK, 2048, DM}; pg8::StaticOrder S; S.init(NTOK, 2048, nb, bid);
        EpiF16 E{(_Float16*)(ws + WS_PROJ)};
        pg8::gemm_phase<EpiF16, pg8::StaticOrder, true, true>(lds, g, S, E);
    }
    SEAM(5);
    if (IN(6)) phase_peer(p, lds, bid, nb);
    if (IN(7)) phase_naive_scores(p, lds, bid, nb);
#undef IN
#undef SEAM
}

#ifndef PEER_SIMPLE_DUMMY
#endif
#ifndef MK_FUSED
#define MK_FUSED 1
#endif
extern "C" void kernel_launch(void* const* d_in, const int* in_sizes, int n_in, void* d_out, int out_size, void* d_ws, size_t ws_size, hipStream_t stream) {
    static int grid = 0;
    if (grid == 0) {
        if (n_in != 16 || in_sizes[0] != NTOK * DM || out_size != NTOK * DM || ws_size < WS_END) {
            fprintf(stderr, "kernel_launch: unexpected shapes (n_in %d, in0 %d, out %d, ws %zu); nothing launched\n", n_in, n_in > 0 ? in_sizes[0] : -1, out_size, ws_size); grid = -1; return; }
        int dev = 0, cus = 0, per_cu = 0;
        hipGetDevice(&dev); hipDeviceGetAttribute(&cus, hipDeviceAttributeMultiprocessorCount, dev);
        if (hipFuncSetAttribute((const void*)mk_fwd, hipFuncAttributeMaxDynamicSharedMemorySize, LDS_BYTES) != hipSuccess) { fprintf(stderr, "kernel_launch: hipFuncSetAttribute failed\n"); grid = -1; return; }
        if (hipOccupancyMaxActiveBlocksPerMultiprocessor(&per_cu, (const void*)mk_fwd, 512, LDS_BYTES) != hipSuccess || per_cu < 1) { fprintf(stderr, "kernel_launch: occupancy query failed (%d)\n", per_cu); (void)hipGetLastError(); per_cu = 1; }
        grid = cus * (per_cu < 1 ? 1 : 1);
        fprintf(stderr, "kernel_launch: %d CUs, occupancy %d/CU, grid %d\n", cus, per_cu, grid);
    }
    if (grid < 0) return;
    Params p{};
    p.x = (const float*)d_in[0]; p.meta = (const float*)d_in[1]; p.g1 = (const float*)d_in[2]; p.w_in = (const float*)d_in[3]; p.gw2 = (const float*)d_in[4]; p.gb = (const float*)d_in[5];
    p.gla_gain = (const float*)d_in[6]; p.ret_gain = (const float*)d_in[7]; p.ret_bias = (const float*)d_in[8]; p.w_out = (const float*)d_in[9]; p.g2 = (const float*)d_in[10];
    p.w_q = (const float*)d_in[11]; p.subkeys = (const float*)d_in[12]; p.pu = (const float*)d_in[13]; p.pv = (const float*)d_in[14]; p.gfin = (const float*)d_in[15];
    p.out = (float*)d_out; p.ws = (unsigned char*)d_ws;
#if MK_FUSED
    p.ph_lo = 0; p.ph_hi = NPHASE;
    void* args[] = {&p};
    hipError_t e = hipLaunchCooperativeKernel((const void*)mk_fwd, dim3(grid), dim3(512), args, LDS_BYTES, stream);
    if (e != hipSuccess) fprintf(stderr, "kernel_launch: cooperative launch failed: %s (grid %d)\n", hipGetErrorString(e), grid);
#else
    { const int order[7] = {0, 1, 2, 3, 4, 5, 6}; for (int i = 0; i < 7; ++i) { p.ph_lo = order[i]; p.ph_hi = order[i] + 1; hipLaunchKernelGGL(mk_fwd, dim3(grid), dim3(512), LDS_BYTES, stream, p); } }
#endif
}
```

```cpp
#include <hip/hip_runtime.h>
#include <hip/hip_cooperative_groups.h>
#include <cstdio>
#include <cstdint>
namespace cg = cooperative_groups;
namespace pg8 {
#define PG8_LAS __attribute__((address_space(3)))
typedef unsigned short bf16_t;
typedef short bf16x8 __attribute__((ext_vector_type(8)));
typedef float f32x4 __attribute__((ext_vector_type(4)));
typedef unsigned u32x4 __attribute__((ext_vector_type(4)));
constexpr int BM = 256, BK = 64, HALF = 128, HTB = HALF * BK * 2  , STAGE_BYTES = 8 * HTB, NXCD = 8, WGM = 8;

__host__ __device__ __forceinline__ int lds_byte(int r, int c) { const int st = (r >> 4) * 2 + (c >> 5), rr = r & 15, cc = c & 31, ob = rr * 64 + cc * 2; return st * 1024 + (ob ^ (((ob >> 9) & 1) << 5)); }
__host__ __device__ __forceinline__ void stage_rc(int b, int& R, int& C) { const int st = b / 1024, sb = b % 1024, swz = sb ^ (((sb >> 9) & 1) << 5); R = (st >> 1) * 16 + swz / 64; C = (st & 1) * 32 + (swz % 64) / 2; }
__host__ __device__ __forceinline__ int perm32(int rho) { const int n = rho >> 4, i = rho & 15; return 8 * (i >> 2) + 4 * n + (i & 3); }

struct Unit { int pm, pn; };
struct Gemm { const bf16_t* A; const bf16_t* Bt; int M, N, K; };

struct StaticOrder {
    int nM, nN, nwg, G, c;
    __host__ __device__ void init(int M, int N, int G_, int c_) { nM = M / BM; nN = N / BM; nwg = nM * nN; G = G_; c = c_; }
    __host__ __device__ bool next(int i, Unit& u) const {
        const long L = (long)i * G + c; if (L >= nwg) return false;
        int wgid = (int)L; { const int q = nwg / NXCD, r = nwg % NXCD, xcd = wgid % NXCD, off = wgid / NXCD; wgid = (xcd < r ? xcd * (q + 1) : r * (q + 1) + (xcd - r) * q) + off; }
        const int nig = WGM * nN, gid = wgid / nig, fm = gid * WGM, gsz = (nM - fm) < WGM ? (nM - fm) : WGM;
        u.pm = fm + ((wgid % nig) % gsz); u.pn = (wgid % nig) / gsz; return true;
    }
    __device__ __forceinline__ void a_ready(const Unit&) const {}
    __device__ __forceinline__ void done(const Unit&) const {}
};

__device__ __forceinline__ unsigned cvt_pk_bf16(float lo, float hi) { unsigned r; asm volatile("v_cvt_pk_bf16_f32 %0, %1, %2" : "=v"(r) : "v"(lo), "v"(hi)); return r; }
typedef float f32x2 __attribute__((ext_vector_type(2)));
template <class Epi, class Sched, bool ALIGN_EPI = false, bool SP2 = false>
__device__ __forceinline__ void gemm_phase(PG8_LAS unsigned char* lds, const Gemm g, const Sched& S, const Epi& E) {
    const int tid = threadIdx.x, wid = __builtin_amdgcn_readfirstlane(tid >> 6), lane = tid & 63, wr = wid >> 2, wc = wid & 3, fr = lane & 15, fq = lane >> 4;
    const int K = g.K, nt = K / BK;
    unsigned voffA[2], voffB[2];
#pragma unroll
    for (int i = 0; i < 2; ++i) { int R, C; stage_rc(tid * 16 + i * 8192, R, C); const int Rb = Epi::PERM ? ((R & ~31) + perm32(R & 31)) : R;
        voffA[i] = (unsigned)(R * K + C) * 2u; voffB[i] = (unsigned)(Rb * K + C) * 2u; }
    const size_t kstep = (size_t)(BK * 2);
    const size_t hstep = (size_t)HALF * K * 2;
    const size_t tstep = 2 * hstep;
    const unsigned ldsw = (unsigned)wid * 1024u;
    const int aoff = lds_byte(wr * 64 + fr, fq * 8), boff = lds_byte(wc * 32 + fr, fq * 8);
#define PG8_SA(b, h) (((b) * 2 + (h)) * HTB)
#define PG8_SB(b, h) ((4 + (b) * 2 + (h)) * HTB)
#define PG8_STAGE(bufoff, gbase, voff) do { _Pragma("unroll") for (int _i = 0; _i < 2; ++_i) \
        __builtin_amdgcn_global_load_lds((const unsigned*)((const char*)(gbase) + (voff)[_i]), (PG8_LAS unsigned*)(lds + (bufoff) + ldsw + _i * 8192), 16, 0, 0); } while (0)
#define PG8_LDA(dst, b, h) do { _Pragma("unroll") for (int m = 0; m < 4; ++m) _Pragma("unroll") for (int k = 0; k < 2; ++k) dst[m][k] = *(const PG8_LAS bf16x8*)(lds + PG8_SA(b, h) + aoff + m * 2048 + k * 1024); } while (0)
#define PG8_LDB(dst, b, h) do { _Pragma("unroll") for (int n = 0; n < 2; ++n) _Pragma("unroll") for (int k = 0; k < 2; ++k) dst[n][k] = *(const PG8_LAS bf16x8*)(lds + PG8_SB(b, h) + boff + n * 2048 + k * 1024); } while (0)
#define PG8_MMA(ai, bj, At, Bt) do { __builtin_amdgcn_s_setprio(1); _Pragma("unroll") for (int m = 0; m < 4; ++m) _Pragma("unroll") for (int n = 0; n < 2; ++n) _Pragma("unroll") for (int k = 0; k < 2; ++k) \
        acc[ai][bj][m][n] = __builtin_amdgcn_mfma_f32_16x16x32_bf16(Bt[n][k], At[m][k], acc[ai][bj][m][n], 0, 0, 0); __builtin_amdgcn_s_setprio(0); } while (0)
#define PG8_WAIT_V(n) asm volatile("s_waitcnt vmcnt(" #n ")" ::: "memory")
#define PG8_WAIT_L(n) asm volatile("s_waitcnt lgkmcnt(" #n ")" ::: "memory")
#define PG8_BAR __builtin_amdgcn_s_barrier()
#define PG8_SCHED __builtin_amdgcn_sched_barrier(0)
    Unit cur, nxt; int ui = 0;
    if (!S.next(0, cur)) return;
    f32x4 acc[2][2][4][2];
#pragma unroll
    for (int a = 0; a < 2; ++a)
#pragma unroll
        for (int b = 0; b < 2; ++b)
#pragma unroll
            for (int m = 0; m < 4; ++m)
#pragma unroll
                for (int n = 0; n < 2; ++n) acc[a][b][m][n] = (f32x4){0.f, 0.f, 0.f, 0.f};
    bf16x8 At[4][2], B0[2][2], B1[2][2];
    const char* cA = (const char*)g.A + (size_t)cur.pm * tstep; const char* cB = (const char*)g.Bt + (size_t)cur.pn * tstep;
    S.a_ready(cur);
    if constexpr (SP2) {
        PG8_STAGE(PG8_SB(0, 0), cB, voffB); PG8_STAGE(PG8_SB(0, 1), cB + hstep, voffB); PG8_STAGE(PG8_SA(0, 0), cA, voffA); PG8_STAGE(PG8_SA(0, 1), cA + hstep, voffA);
        if (wr == 1) PG8_BAR;
        PG8_WAIT_V(2); PG8_BAR;
        PG8_STAGE(PG8_SB(1, 0), cB + kstep, voffB); PG8_STAGE(PG8_SA(1, 0), cA + kstep, voffA); PG8_STAGE(PG8_SB(1, 1), cB + hstep + kstep, voffB);
        PG8_WAIT_V(6); PG8_BAR;
    } else {
        PG8_STAGE(PG8_SB(0, 0), cB, voffB); PG8_STAGE(PG8_SA(0, 0), cA, voffA); PG8_STAGE(PG8_SB(0, 1), cB + hstep, voffB); PG8_STAGE(PG8_SA(0, 1), cA + hstep, voffA);
        if (wr == 1) PG8_BAR;
        PG8_WAIT_V(4); PG8_BAR;
        PG8_STAGE(PG8_SB(1, 0), cB + kstep, voffB); PG8_STAGE(PG8_SA(1, 0), cA + kstep, voffA); PG8_STAGE(PG8_SB(1, 1), cB + hstep + kstep, voffB);
        PG8_WAIT_V(6); PG8_BAR;
    }
    for (;;) {
        const bool has_next = S.next(ui + 1, nxt);
        const char* nA = has_next ? (const char*)g.A + (size_t)nxt.pm * tstep : cA; const char* nB = has_next ? (const char*)g.Bt + (size_t)nxt.pn * tstep : cB;
        for (int t = 0; t < nt; t += 2) {
            const bool last = (t == nt - 2);
            const char* a1 = cA + (size_t)(t + 1) * kstep;
            const char* a2 = last ? nA : cA + (size_t)(t + 2) * kstep; const char* b2 = last ? nB : cB + (size_t)(t + 2) * kstep;
            const char* a3 = a2 + kstep; const char* b3 = b2 + kstep;
            if (last && has_next) S.a_ready(nxt);
            if constexpr (SP2) {
            PG8_LDB(B0, 0, 0); PG8_LDB(B1, 0, 1); PG8_SCHED; PG8_LDA(At, 0, 0); PG8_STAGE(PG8_SA(1, 1), a1 + hstep, voffA);
            PG8_WAIT_V(8); PG8_WAIT_L(0); PG8_BAR; PG8_MMA(0, 0, At, B0); PG8_MMA(0, 1, At, B1); PG8_BAR; PG8_SCHED;
            PG8_LDA(At, 0, 1); PG8_STAGE(PG8_SB(0, 0), b2, voffB); PG8_STAGE(PG8_SB(0, 1), b2 + hstep, voffB); PG8_STAGE(PG8_SA(0, 0), a2, voffA);
            PG8_WAIT_V(8); PG8_WAIT_L(0); PG8_BAR; PG8_MMA(1, 0, At, B0); PG8_MMA(1, 1, At, B1); PG8_BAR; PG8_SCHED;
            PG8_LDB(B0, 1, 0); PG8_LDB(B1, 1, 1); PG8_SCHED; PG8_LDA(At, 1, 0); PG8_STAGE(PG8_SA(0, 1), a2 + hstep, voffA);
            PG8_WAIT_V(8); PG8_WAIT_L(0); PG8_BAR; PG8_MMA(0, 0, At, B0); PG8_MMA(0, 1, At, B1); PG8_BAR; PG8_SCHED;
            PG8_LDA(At, 1, 1); PG8_STAGE(PG8_SB(1, 0), b3, voffB); PG8_STAGE(PG8_SB(1, 1), b3 + hstep, voffB); PG8_STAGE(PG8_SA(1, 0), a3, voffA);
            PG8_WAIT_V(8); PG8_WAIT_L(0); PG8_BAR; PG8_MMA(1, 0, At, B0); PG8_MMA(1, 1, At, B1); PG8_BAR; PG8_SCHED;
            } else {
            PG8_LDB(B0, 0, 0); PG8_SCHED; PG8_LDA(At, 0, 0); PG8_STAGE(PG8_SA(1, 1), a1 + hstep, voffA);
            PG8_WAIT_L(8); PG8_BAR; PG8_WAIT_L(0); PG8_MMA(0, 0, At, B0); PG8_BAR; PG8_SCHED;
            PG8_LDB(B1, 0, 1); PG8_STAGE(PG8_SB(0, 0), b2, voffB);
            PG8_BAR; PG8_WAIT_L(0); PG8_MMA(0, 1, At, B1); PG8_BAR;
            PG8_LDA(At, 0, 1); PG8_STAGE(PG8_SA(0, 0), a2, voffA);
            PG8_BAR; PG8_WAIT_L(0); PG8_MMA(1, 0, At, B0); PG8_BAR; PG8_SCHED;
            PG8_STAGE(PG8_SB(0, 1), b2 + hstep, voffB);
            PG8_WAIT_V(6); PG8_BAR; PG8_MMA(1, 1, At, B1); PG8_BAR;
            PG8_LDB(B0, 1, 0); PG8_SCHED; PG8_LDA(At, 1, 0); PG8_STAGE(PG8_SA(0, 1), a2 + hstep, voffA);
            PG8_WAIT_L(8); PG8_BAR; PG8_WAIT_L(0); PG8_MMA(0, 0, At, B0); PG8_BAR; PG8_SCHED;
            PG8_LDB(B1, 1, 1); PG8_STAGE(PG8_SB(1, 0), b3, voffB);
            PG8_BAR; PG8_WAIT_L(0); PG8_MMA(0, 1, At, B1); PG8_BAR;
            PG8_LDA(At, 1, 1); PG8_STAGE(PG8_SA(1, 0), a3, voffA);
            PG8_BAR; PG8_WAIT_L(0); PG8_MMA(1, 0, At, B0); PG8_BAR; PG8_SCHED;
            PG8_STAGE(PG8_SB(1, 1), b3 + hstep, voffB);
            PG8_WAIT_V(6); PG8_BAR; PG8_MMA(1, 1, At, B1); PG8_BAR;
            }
        }
        if constexpr (ALIGN_EPI) { if (wr == 0) PG8_BAR; }
        if constexpr (!Epi::AFTER_DRAIN) { E(acc, cur, wr, wc, fr, fq); S.done(cur); }
        if (!has_next) break;
#pragma unroll
        for (int a = 0; a < 2; ++a)
#pragma unroll
            for (int b = 0; b < 2; ++b)
#pragma unroll
                for (int m = 0; m < 4; ++m)
#pragma unroll
                    for (int n = 0; n < 2; ++n) acc[a][b][m][n] = (f32x4){0.f, 0.f, 0.f, 0.f};
        cur = nxt; cA = nA; cB = nB; ++ui;
        if constexpr (ALIGN_EPI) { if (wr == 1) PG8_BAR; }
    }
    PG8_WAIT_V(0);
    if constexpr (!ALIGN_EPI) { if (wr == 0) PG8_BAR; }
    PG8_BAR;
    if constexpr (Epi::AFTER_DRAIN) { E.fused(acc, cur, wr, wc, fr, fq, lds, wid, lane); S.done(cur); }
#undef PG8_SA
#undef PG8_SB
#undef PG8_STAGE
#undef PG8_LDA
#undef PG8_LDB
#undef PG8_MMA
#undef PG8_WAIT_V
#undef PG8_WAIT_L
#undef PG8_BAR
#undef PG8_SCHED
}
}

#define LAS __attribute__((address_space(3)))
typedef unsigned short bf16_t;
typedef float f32x4 __attribute__((ext_vector_type(4)));
typedef unsigned u32x4 __attribute__((ext_vector_type(4)));
typedef unsigned u32x2 __attribute__((ext_vector_type(2)));
typedef short bf16x8 __attribute__((ext_vector_type(8)));
typedef short s16x4 __attribute__((ext_vector_type(4)));
typedef __bf16 bf16x2_t __attribute__((ext_vector_type(2)));
typedef _Float16 f16x2_t __attribute__((ext_vector_type(2)));
typedef float f32x2v __attribute__((ext_vector_type(2)));

constexpr int DM = 1024, NB = 4, SEQ = 8192, NTOK = NB * SEQ;
constexpr int MROWS = NTOK + 256;
constexpr int INW = 3088;
constexpr int NPROJ = 3072, NP1 = 3328;
constexpr int NEXP = 16384;
constexpr float EPS = 1e-6f;
constexpr int C_GQ = 0, C_GK = 256, C_GV = 512, C_GG = 1024, C_RQ = 1536, C_RK = 1792, C_RV = 2048, C_RG = 2560;
constexpr int S_GA = 1536, S_RQ = 1552, S_RV = 2064;

constexpr size_t MiB = 1u << 20;
constexpr size_t WS_CTL = 0, WS_WIN = 1 * MiB, WS_WOUT = 8 * MiB, WS_WS = 10 * MiB, WS_ROPE = 14 * MiB, WS_SSQ = 17 * MiB, WS_SEG = 19 * MiB, WS_ASEG = 27 * MiB,
                 WS_UB = 28 * MiB, WS_VB = 60 * MiB, WS_XN = 92 * MiB, WS_O = 157 * MiB, WS_LA = 221 * MiB, WS_PROJ = 254 * MiB, WS_END = 448 * MiB;
static_assert(WS_WIN + (size_t)NP1 * DM * 2 <= WS_WOUT && WS_ROPE + (size_t)(SEQ + 64) * 32 * 8 <= WS_SSQ && WS_XN + (size_t)MROWS * DM * 2 <= WS_O &&
              WS_LA + (size_t)MROWS * 256 * 4 <= WS_PROJ && WS_PROJ + (size_t)MROWS * NPROJ * 2 <= WS_END && WS_PROJ + (size_t)NTOK * 2048 * 2 <= WS_END, "ws map");

constexpr int LDS_BYTES = 147456;
constexpr int NPHASE = 7;
#ifndef PEER_FP8
#define PEER_FP8 1
#endif

struct Params {
    const float *x, *meta, *g1, *w_in, *gw2, *gb, *gla_gain, *ret_gain, *ret_bias, *w_out, *g2, *w_q, *subkeys, *pu, *pv, *gfin;
    float* out; unsigned char* ws;
    int ph_lo, ph_hi;
};

#define LDS_WAIT() asm volatile("s_waitcnt lgkmcnt(0)" ::: "memory")
__device__ __forceinline__ unsigned f2bf(float f) { unsigned u = __builtin_bit_cast(unsigned, f); return (u + 0x7fffu + ((u >> 16) & 1u)) >> 16; }
__device__ __forceinline__ unsigned pk2(float lo, float hi) { return f2bf(lo) | (f2bf(hi) << 16); }
__device__ __forceinline__ float bf_lo(unsigned w) { return __builtin_bit_cast(float, w << 16); }
__device__ __forceinline__ float bf_hi(unsigned w) { return __builtin_bit_cast(float, w & 0xffff0000u); }
__device__ __forceinline__ float bf1(bf16_t h) { return __builtin_bit_cast(float, (unsigned)h << 16); }
__device__ __forceinline__ float wave_sum(float v) {
#pragma unroll
    for (int o = 1; o < 64; o <<= 1) v += __shfl_xor(v, o);
    return v;
}

struct MapIn {
    __device__ __forceinline__ void operator()(int j, int& src, float& sc) const {
        if (j < C_RQ) { src = j; sc = (j < 256) ? 0.125f : 1.0f; }
        else if (j < C_RV) { const int jj = j - C_RQ, which = jj >> 8, within = jj & 255, head = within >> 6, p = within & 63;
            const int a = p >> 3, n = (p >> 2) & 1, i = p & 3; src = S_RQ + which * 256 + head * 64 + 32 * n + 4 * a + i; sc = which ? 0.125f : 1.0f; }
        else { src = S_RV + (j - C_RV); sc = 1.0f; }
    }
};
struct MapId { __device__ __forceinline__ void operator()(int j, int& src, float& sc) const { src = j; sc = 1.0f; } };

template <class Map>
__device__ __forceinline__ void transpose_item(const float* W, int K, int N, bf16_t* WT, LAS float* scr, int item, int nblk, int lane, const Map map) {
    const int kb = item / nblk, nb = item % nblk, k0 = 64 * kb, n0 = 32 * nb;
    int src; float sc; map(n0 + (lane & 31), src, sc);
#pragma unroll 8
    for (int i = 0; i < 32; ++i) { const int kk = 2 * i + (lane >> 5); scr[kk * 33 + (lane & 31)] = W[(size_t)(k0 + kk) * N + src] * sc; }
    LDS_WAIT();
    const int c = lane & 7;
#pragma unroll
    for (int j = 0; j < 4; ++j) { const int n = (lane >> 3) + 8 * j; const LAS float* s = scr + (8 * c) * 33 + n;
        u32x4 o; o.x = pk2(s[0 * 33], s[1 * 33]); o.y = pk2(s[2 * 33], s[3 * 33]); o.z = pk2(s[4 * 33], s[5 * 33]); o.w = pk2(s[6 * 33], s[7 * 33]);
        *(u32x4*)(WT + (size_t)(n0 + n) * K + k0 + 8 * c) = o; }
    LDS_WAIT();
}

__device__ __forceinline__ void phase0(const Params& p, LAS unsigned char* lds, int bid, int nb) {
    const int tid = threadIdx.x, lane = tid & 63, wave = __builtin_amdgcn_readfirstlane(tid >> 6);
    unsigned char* ws = p.ws;
    bf16_t* XN = (bf16_t*)(ws + WS_XN); bf16_t* WinT = (bf16_t*)(ws + WS_WIN); bf16_t* WoutT = (bf16_t*)(ws + WS_WOUT); bf16_t* WsT = (bf16_t*)(ws + WS_WS);
    const int gw = bid * 8 + wave, NGW = nb * 8;
    const int gt = bid * 512 + tid, NGT = nb * 512;

    {
        LAS float* SKT = (LAS float*)lds;
        LAS float* WQT = (LAS float*)(lds + 128 * 132 * 4);
        for (int item = bid; item < 256; item += nb) {
            const int hc = item >> 4, kb = item & 15;
            __syncthreads();
            for (int e = tid; e < 128 * 128; e += 512) { const int n = e >> 7, d = e & 127; SKT[d * 132 + n] = p.subkeys[(size_t)hc * 16384 + e]; }
            for (int e = tid; e < 64 * 128; e += 512) { const int k = e >> 7, d = e & 127; WQT[d * 68 + k] = p.w_q[(size_t)(kb * 64 + k) * 2048 + hc * 128 + d]; }
            __syncthreads();
            const int tn = tid & 31, tk = tid >> 5;
            f32x4 acc[4];
#pragma unroll
            for (int i = 0; i < 4; ++i) acc[i] = (f32x4){0.f, 0.f, 0.f, 0.f};
#pragma unroll 4
            for (int d = 0; d < 128; ++d) {
                const f32x4 sk = *(const LAS f32x4*)(SKT + d * 132 + 4 * tn); const f32x4 wq = *(const LAS f32x4*)(WQT + d * 68 + 4 * tk);
#pragma unroll
                for (int i = 0; i < 4; ++i) acc[i] += sk[i] * wq;
            }
            const f32x4 gg = *(const f32x4*)(p.g2 + kb * 64 + 4 * tk);
#pragma unroll
            for (int i = 0; i < 4; ++i) { const f32x4 v = acc[i] * gg; u32x2 o; o.x = pk2(v[0], v[1]); o.y = pk2(v[2], v[3]);
                *(u32x2*)(WsT + (size_t)(hc * 128 + 4 * tn + i) * DM + kb * 64 + 4 * tk) = o; }
        }
        __syncthreads();
    }
    {
        LAS float* scr = (LAS float*)(lds + wave * 16384);
        constexpr int I_IN = (DM / 64) * (NPROJ / 32), I_OUT = (DM / 64) * (DM / 32);
        for (int it = gw; it < I_IN + I_OUT; it += NGW) {
            if (it < I_IN) transpose_item(p.w_in, DM, INW, WinT, scr, it, NPROJ / 32, lane, MapIn());
            else transpose_item(p.w_out, DM, DM, WoutT, scr, it - I_IN, DM / 32, lane, MapId());
        }
    }
    for (int e = gt; e < 256 * DM; e += NGT) {
        const int n = e >> 10, k = e & 1023; const float* wr = p.w_in + (size_t)k * INW + S_GA; float s = 0.f;
#pragma unroll
        for (int r = 0; r < 16; ++r) s += wr[r] * p.gw2[r * 256 + n];
        WinT[(size_t)(NPROJ + n) * DM + k] = (bf16_t)f2bf(s);
    }
#if PEER_FP8
    {
        u32x4* U8 = (u32x4*)(ws + WS_UB); u32x4* V8 = (u32x4*)(ws + WS_VB);
        for (int e = gt; e < NEXP * DM / 16; e += NGT) {
            const f32x4* us = (const f32x4*)p.pu + 4 * (size_t)e; const f32x4* vs = (const f32x4*)p.pv + 4 * (size_t)e;
            u32x4 wu, wv; unsigned tu[4], tv[4];
#pragma unroll
            for (int j = 0; j < 4; ++j) { const f32x4 a = us[j] * 512.0f, b = vs[j] * 32.0f;
                int w = __builtin_amdgcn_cvt_pk_fp8_f32(a[0], a[1], 0, false); w = __builtin_amdgcn_cvt_pk_fp8_f32(a[2], a[3], w, true); tu[j] = (unsigned)w;
                int x = __builtin_amdgcn_cvt_pk_fp8_f32(b[0], b[1], 0, false); x = __builtin_amdgcn_cvt_pk_fp8_f32(b[2], b[3], x, true); tv[j] = (unsigned)x; }
            wu = (u32x4){tu[0], tu[1], tu[2], tu[3]}; wv = (u32x4){tv[0], tv[1], tv[2], tv[3]};
            U8[e] = wu; V8[e] = wv; }
    }
#else
    {
        u32x2* UB = (u32x2*)(ws + WS_UB); u32x2* VB = (u32x2*)(ws + WS_VB);
        const f32x4* u4 = (const f32x4*)p.pu; const f32x4* v4 = (const f32x4*)p.pv;
        for (int e = gt; e < NEXP * DM / 4; e += NGT) { const f32x4 a = u4[e]; u32x2 o; o.x = pk2(a[0], a[1]); o.y = pk2(a[2], a[3]); UB[e] = o;
            const f32x4 b = v4[e]; u32x2 q; q.x = pk2(b[0], b[1]); q.y = pk2(b[2], b[3]); VB[e] = q; }
    }
#endif
    {
        float2* rope = (float2*)(ws + WS_ROPE);
        for (int e = gt; e < (SEQ + 64) * 32; e += NGT) { const int pi = e >> 5, d = e & 31;
            const float invf = (float)pow(10000.0, -(double)d / 32.0); const float ang = (float)(pi - 48) * invf;
            rope[e] = make_float2((float)cos((double)ang), (float)sin((double)ang)); }
    }
    for (int m = gw; m < MROWS; m += NGW) {
        const float* src = nullptr;
        if (m >= 256) src = p.x + (size_t)(m - 256) * DM; else if (m >= 48 && m < 64) src = p.meta + (size_t)(m - 48) * DM;
        unsigned long long* o8 = (unsigned long long*)(XN + (size_t)m * DM) + lane;
        if (src == nullptr) {
#pragma unroll
            for (int j = 0; j < 4; ++j) o8[64 * j] = 0ull;
        } else {
            const f32x4* xr = (const f32x4*)src + lane; const f32x4* gr = (const f32x4*)p.g1 + lane;
            f32x4 v[4]; float s = 0.f;
#pragma unroll
            for (int j = 0; j < 4; ++j) { v[j] = xr[64 * j]; s += (v[j].x * v[j].x + v[j].y * v[j].y) + (v[j].z * v[j].z + v[j].w * v[j].w); }
            const float r = 1.0f / sqrtf(wave_sum(s) * (1.0f / DM) + EPS);
#pragma unroll
            for (int j = 0; j < 4; ++j) { const f32x4 g = gr[64 * j]; const f32x4 y = v[j] * r * g;
                o8[64 * j] = (unsigned long long)pk2(y.x, y.y) | ((unsigned long long)pk2(y.z, y.w) << 32); }
        }
    }
}

struct EpiProj {
    static constexpr bool PERM = true, AFTER_DRAIN = false;
    bf16_t* PROJ; float* LA; const float* gb; const float2* rope;
    __device__ __forceinline__ void operator()(const pg8::f32x4 (&acc)[2][2][4][2], const pg8::Unit& u, int wr, int wc, int fr, int fq) const {
        const int row0 = u.pm * 256 + wr * 64 + fr, cb0 = wc * 32 + 8 * fq;
        if (u.pn == 12) {
#pragma unroll
            for (int bj = 0; bj < 2; ++bj) { const int c = cb0 + 128 * bj; const f32x4 b0 = *(const f32x4*)(gb + c), b1 = *(const f32x4*)(gb + c + 4);
#pragma unroll
                for (int ai = 0; ai < 2; ++ai)
#pragma unroll
                    for (int m = 0; m < 4; ++m) { const int row = row0 + ai * 128 + m * 16; f32x4 v0 = acc[ai][bj][m][0] + b0, v1 = acc[ai][bj][m][1] + b1;
#pragma unroll
                        for (int i = 0; i < 4; ++i) { v0[i] = (fminf(v0[i], 0.f) - log1pf(__expf(-fabsf(v0[i])))) * 0.0625f; v1[i] = (fminf(v1[i], 0.f) - log1pf(__expf(-fabsf(v1[i])))) * 0.0625f; }
                        float* o = LA + (size_t)row * 256 + c; *(f32x4*)o = v0; *(f32x4*)(o + 4) = v1; } }
        } else if (u.pn == 6 || u.pn == 7) {
#pragma unroll
            for (int ai = 0; ai < 2; ++ai)
#pragma unroll
                for (int m = 0; m < 4; ++m) { const int row = row0 + ai * 128 + m * 16; const int pidx = (row < 256) ? row : 64 + ((row - 256) & (SEQ - 1));
#pragma unroll
                    for (int bj = 0; bj < 2; ++bj) { const int c = cb0 + 128 * bj, d0 = (c & 63) >> 1;
                        const f32x4 cs0 = *(const f32x4*)(rope + (size_t)pidx * 32 + d0), cs1 = *(const f32x4*)(rope + (size_t)pidx * 32 + d0 + 2);
                        const f32x4 t1 = acc[ai][bj][m][0], t2 = acc[ai][bj][m][1];
                        const float co[4] = {cs0[0], cs0[2], cs1[0], cs1[2]}, si[4] = {cs0[1], cs0[3], cs1[1], cs1[3]};
                        float o1[4], o2[4];
#pragma unroll
                        for (int i = 0; i < 4; ++i) { o1[i] = t1[i] * co[i] - t2[i] * si[i]; o2[i] = t1[i] * si[i] + t2[i] * co[i]; }
                        u32x4 w; w.x = pg8::cvt_pk_bf16(o1[0], o1[1]); w.y = pg8::cvt_pk_bf16(o1[2], o1[3]); w.z = pg8::cvt_pk_bf16(o2[0], o2[1]); w.w = pg8::cvt_pk_bf16(o2[2], o2[3]);
                        *(u32x4*)(PROJ + (size_t)row * NPROJ + u.pn * 256 + c) = w; } }
        } else {
#pragma unroll
            for (int ai = 0; ai < 2; ++ai)
#pragma unroll
                for (int m = 0; m < 4; ++m) { bf16_t* rowp = PROJ + (size_t)(row0 + ai * 128 + m * 16) * NPROJ + u.pn * 256 + cb0;
#pragma unroll
                    for (int bj = 0; bj < 2; ++bj) { const f32x4 v0 = acc[ai][bj][m][0], v1 = acc[ai][bj][m][1];
                        u32x4 w; w.x = pg8::cvt_pk_bf16(v0[0], v0[1]); w.y = pg8::cvt_pk_bf16(v0[2], v0[3]); w.z = pg8::cvt_pk_bf16(v1[0], v1[1]); w.w = pg8::cvt_pk_bf16(v1[2], v1[3]);
                        *(u32x4*)(rowp + bj * 128) = w; } }
        }
    }
};
struct EpiRes {
    static constexpr bool PERM = true, AFTER_DRAIN = false;
    const float* x; bf16_t* HB; float* SSQ;
    __device__ __forceinline__ void operator()(const pg8::f32x4 (&acc)[2][2][4][2], const pg8::Unit& u, int wr, int wc, int fr, int fq) const {
        const int row0 = u.pm * 256 + wr * 64 + fr, col0 = u.pn * 256 + wc * 32 + 8 * fq;
#pragma unroll
        for (int ai = 0; ai < 2; ++ai)
#pragma unroll
            for (int m = 0; m < 4; ++m) { const int row = row0 + ai * 128 + m * 16; const float* xr = x + (size_t)row * DM + col0; bf16_t* hr = HB + (size_t)row * DM + col0; float ss = 0.f;
#pragma unroll
                for (int bj = 0; bj < 2; ++bj) { const f32x4 v0 = acc[ai][bj][m][0] + *(const f32x4*)(xr + bj * 128), v1 = acc[ai][bj][m][1] + *(const f32x4*)(xr + bj * 128 + 4);
                    ss += (v0[0] * v0[0] + v0[1] * v0[1]) + (v0[2] * v0[2] + v0[3] * v0[3]) + (v1[0] * v1[0] + v1[1] * v1[1]) + (v1[2] * v1[2] + v1[3] * v1[3]);
                    u32x4 w; w.x = pg8::cvt_pk_bf16(v0[0], v0[1]); w.y = pg8::cvt_pk_bf16(v0[2], v0[3]); w.z = pg8::cvt_pk_bf16(v1[0], v1[1]); w.w = pg8::cvt_pk_bf16(v1[2], v1[3]);
                    *(u32x4*)(hr + bj * 128) = w; }
                ss += __shfl_xor(ss, 16); ss += __shfl_xor(ss, 32);
                if (fq == 0) SSQ[(size_t)row * 16 + u.pn * 4 + wc] = ss; }
    }
};
struct EpiF16 {
    static constexpr bool PERM = true, AFTER_DRAIN = false;
    _Float16* SC;
    __device__ __forceinline__ void operator()(const pg8::f32x4 (&acc)[2][2][4][2], const pg8::Unit& u, int wr, int wc, int fr, int fq) const {
        const int row0 = u.pm * 256 + wr * 64 + fr, col0 = u.pn * 256 + wc * 32 + 8 * fq;
#pragma unroll
        for (int ai = 0; ai < 2; ++ai)
#pragma unroll
            for (int m = 0; m < 4; ++m) { _Float16* rowp = SC + (size_t)(row0 + ai * 128 + m * 16) * 2048 + col0;
#pragma unroll
                for (int bj = 0; bj < 2; ++bj) { const f32x4 v0 = acc[ai][bj][m][0], v1 = acc[ai][bj][m][1];
                    u32x4 w;
                    w.x = __builtin_bit_cast(unsigned, (f16x2_t){(_Float16)v0[0], (_Float16)v0[1]}); w.y = __builtin_bit_cast(unsigned, (f16x2_t){(_Float16)v0[2], (_Float16)v0[3]});
                    w.z = __builtin_bit_cast(unsigned, (f16x2_t){(_Float16)v1[0], (_Float16)v1[1]}); w.w = __builtin_bit_cast(unsigned, (f16x2_t){(_Float16)v1[2], (_Float16)v1[3]});
                    *(u32x4*)(rowp + bj * 128) = w; } }
    }
};

constexpr int A_QT = 0, A_KT = 9216, A_KE = 18432, A_V = 27648, A_ST = 45056, A_STSZ = 18432, A_OB = 81920, A_DEC = 115712, A_CS = 115968;
constexpr int PQ = 72, PV = 136, POB = 132;

__device__ __forceinline__ bf16x8 tr2(const LAS bf16_t* p0, const LAS bf16_t* p1) {
    const s16x4 a = __builtin_amdgcn_ds_read_tr16_b64_v4i16((LAS s16x4*)p0), b = __builtin_amdgcn_ds_read_tr16_b64_v4i16((LAS s16x4*)p1);
    return (bf16x8){a[0], a[1], a[2], a[3], b[0], b[1], b[2], b[3]};
}
__device__ __forceinline__ float ln_gamma(int hr) { return log1pf(-exp2f(-5.0f - (float)hr)); }

template <bool FULL>
__device__ __forceinline__ void attn_pass(const Params& p, LAS unsigned char* lds, int bid, int nb) {
    const int tid = threadIdx.x, lane = tid & 63, wave = __builtin_amdgcn_readfirstlane(tid >> 6);
    const int r16 = lane & 15, g4 = lane >> 4, q4 = (lane & 15) >> 2, p4 = lane & 3;
    unsigned char* ws = p.ws;
    const bf16_t* PROJ = (const bf16_t*)(ws + WS_PROJ); const float* LA = (const float*)(ws + WS_LA);
    float* SEG = (float*)(ws + WS_SEG); float* ASEG = (float*)(ws + WS_ASEG); bf16_t* OUT = (bf16_t*)(ws + WS_O);
    LAS bf16_t* QT = (LAS bf16_t*)(lds + A_QT); LAS bf16_t* KT = (LAS bf16_t*)(lds + A_KT); LAS bf16_t* KE = (LAS bf16_t*)(lds + A_KE); LAS bf16_t* VS = (LAS bf16_t*)(lds + A_V);
    LAS float* OB = (LAS float*)(lds + A_OB); LAS float* DEC = (LAS float*)(lds + A_DEC); LAS float* CS = (LAS float*)(lds + A_CS);

    for (int item = bid; item < 256; item += nb) {
        const int seg = item & 7, h8 = (item >> 3) & 7, b = item >> 6;
        if (!FULL && seg == 7) continue;
        const bool gla = h8 < 4; const int hr = h8 & 3;
        const float lng = ln_gamma(hr);
        const int qcol = gla ? C_GQ + hr * 64 : C_RQ + hr * 64, kcol = gla ? C_GK + hr * 64 : C_RK + hr * 64;
        const int vcol = gla ? C_GV + hr * 128 : C_RV + hr * 128, gcol = gla ? C_GG + hr * 128 : C_RG + hr * 128;
        const int nch = (seg == 0) ? 17 : 16;

        f32x4 accS[8];
#pragma unroll
        for (int cb = 0; cb < 8; ++cb) accS[cb] = (f32x4){0.f, 0.f, 0.f, 0.f};
        float blsum = 0.f;
        __syncthreads();
        if (FULL) {
            if (wave >= 4) {
                const int wq = wave - 4;
                for (int sp = 0; sp < seg; ++sp) { const int it2 = (item & ~7) + sp; const float* Sg = SEG + (size_t)it2 * 8192; const float* Ag = ASEG + it2 * 64;
                    float dec[4];
#pragma unroll
                    for (int rg = 0; rg < 4; ++rg) dec[rg] = Ag[16 * wq + 4 * g4 + rg];
#pragma unroll
                    for (int cb = 0; cb < 8; ++cb)
#pragma unroll
                        for (int rg = 0; rg < 4; ++rg) accS[cb][rg] = dec[rg] * accS[cb][rg] + Sg[(16 * wq + 4 * g4 + rg) * 128 + 16 * cb + r16]; }
                LAS bf16_t* ST0 = (LAS bf16_t*)(lds + A_ST);
#pragma unroll
                for (int cb = 0; cb < 8; ++cb) { u32x2 w; w.x = pk2(accS[cb][0], accS[cb][1]); w.y = pk2(accS[cb][2], accS[cb][3]); *(LAS u32x2*)(ST0 + (16 * cb + r16) * PQ + 16 * wq + 4 * g4) = w; }
            }
        }
        for (int ci = 0; ci < nch; ++ci) {
            const bool metac = (seg == 0 && ci == 0);
            const int rc = (seg == 0) ? ci - 1 : 16 * seg + ci;
            const int rowbase = metac ? 0 : 256 + b * SEQ + rc * 64;
            const LAS bf16_t* STr = (const LAS bf16_t*)(lds + A_ST + (ci & 1) * A_STSZ); LAS bf16_t* STw = (LAS bf16_t*)(lds + A_ST + ((ci + 1) & 1) * A_STSZ);
            const int d = tid & 63, sg = tid >> 6;
            float pre[8]; bf16_t qv[8], kv[8];
            {
                float run = 0.f;
#pragma unroll
                for (int k = 0; k < 8; ++k) { const size_t row = (size_t)(rowbase + 8 * sg + k);
                    const float la = gla ? LA[row * 256 + hr * 64 + d] : lng; run += la; pre[k] = run;
                    if (FULL) qv[k] = PROJ[row * NPROJ + qcol + d];
                    kv[k] = PROJ[row * NPROJ + kcol + d]; }
                CS[sg * 64 + d] = run;
            }
            u32x4 vreg[2];
            { const int vr = tid >> 3, cc = tid & 7; const u32x4* src = (const u32x4*)(PROJ + (size_t)(rowbase + vr) * NPROJ + vcol + cc * 16); vreg[0] = src[0]; vreg[1] = src[1]; }
            __syncthreads();
            {
                float off = 0.f, tot = 0.f;
#pragma unroll
                for (int s = 0; s < 8; ++s) { const float c = CS[s * 64 + d]; tot += c; off += (s < sg) ? c : 0.f; }
#pragma unroll
                for (int k = 0; k < 8; ++k) { const float bc = off + pre[k]; const int i = 8 * sg + k; const float kf = bf1(kv[k]);
                    if (FULL) { QT[i * PQ + d] = (bf16_t)f2bf(bf1(qv[k]) * __expf(bc)); KT[i * PQ + d] = (bf16_t)f2bf(kf * __expf(-bc)); }
                    KE[i * PQ + d] = (bf16_t)f2bf(kf * __expf(tot - bc)); }
                if (sg == 0) { DEC[d] = __expf(tot); blsum += tot; }
                const int vr = tid >> 3, cc = tid & 7; LAS u32x4* dst = (LAS u32x4*)(VS + vr * PV + cc * 16); dst[0] = vreg[0]; dst[1] = vreg[1];
            }
            __syncthreads();
            if (wave < 4) {
                if (FULL && !metac) {
                    const int w = wave;
                    bf16x8 qf[2];
#pragma unroll
                    for (int s = 0; s < 2; ++s) qf[s] = *(const LAS bf16x8*)(QT + (16 * w + r16) * PQ + 32 * s + 8 * g4);
                    f32x4 att[4];
#pragma unroll
                    for (int jb = 0; jb < 4; ++jb) { att[jb] = (f32x4){0.f, 0.f, 0.f, 0.f};
                        if (jb <= w) {
#pragma unroll
                            for (int s = 0; s < 2; ++s) { const bf16x8 kf = *(const LAS bf16x8*)(KT + (16 * jb + r16) * PQ + 32 * s + 8 * g4);
                                att[jb] = __builtin_amdgcn_mfma_f32_16x16x32_bf16(kf, qf[s], att[jb], 0, 0, 0); }
                            if (jb == w) {
#pragma unroll
                                for (int rg = 0; rg < 4; ++rg) att[jb][rg] = (4 * g4 + rg <= r16) ? att[jb][rg] : 0.f;
                            }
                        } }
                    bf16x8 af[2];
#pragma unroll
                    for (int s = 0; s < 2; ++s) { u32x4 t; t.x = pk2(att[2 * s][0], att[2 * s][1]); t.y = pk2(att[2 * s][2], att[2 * s][3]); t.z = pk2(att[2 * s + 1][0], att[2 * s + 1][1]); t.w = pk2(att[2 * s + 1][2], att[2 * s + 1][3]);
                        af[s] = __builtin_bit_cast(bf16x8, t); }
#pragma unroll
                    for (int cb = 0; cb < 8; ++cb) { f32x4 o = (f32x4){0.f, 0.f, 0.f, 0.f};
#pragma unroll
                        for (int s = 0; s < 2; ++s) {
                            const bf16x8 vf = tr2(VS + (32 * s + 4 * g4 + q4) * PV + 16 * cb + 4 * p4, VS + (32 * s + 16 + 4 * g4 + q4) * PV + 16 * cb + 4 * p4);
                            o = __builtin_amdgcn_mfma_f32_16x16x32_bf16(af[s], vf, o, 0, 0, 0);
                            const bf16x8 sf = *(const LAS bf16x8*)(STr + (16 * cb + r16) * PQ + 32 * s + 8 * g4);
                            o = __builtin_amdgcn_mfma_f32_16x16x32_bf16(qf[s], sf, o, 0, 0, 0); }
#pragma unroll
                        for (int rg = 0; rg < 4; ++rg) OB[(16 * w + 4 * g4 + rg) * POB + 16 * cb + r16] = o[rg]; }
                }
            } else {
                const int wq = wave - 4;
                float dec[4];
#pragma unroll
                for (int rg = 0; rg < 4; ++rg) dec[rg] = DEC[16 * wq + 4 * g4 + rg];
                bf16x8 kef[2];
#pragma unroll
                for (int s = 0; s < 2; ++s) kef[s] = tr2(KE + (32 * s + 8 * g4 + q4) * PQ + 16 * wq + 4 * p4, KE + (32 * s + 8 * g4 + 4 + q4) * PQ + 16 * wq + 4 * p4);
#pragma unroll
                for (int cb = 0; cb < 8; ++cb) {
#pragma unroll
                    for (int rg = 0; rg < 4; ++rg) accS[cb][rg] *= dec[rg];
#pragma unroll
                    for (int s = 0; s < 2; ++s) { const bf16x8 vf = tr2(VS + (32 * s + 8 * g4 + q4) * PV + 16 * cb + 4 * p4, VS + (32 * s + 8 * g4 + 4 + q4) * PV + 16 * cb + 4 * p4);
                        accS[cb] = __builtin_amdgcn_mfma_f32_16x16x32_bf16(kef[s], vf, accS[cb], 0, 0, 0); }
                    if (FULL) { u32x2 w; w.x = pk2(accS[cb][0], accS[cb][1]); w.y = pk2(accS[cb][2], accS[cb][3]); *(LAS u32x2*)(STw + (16 * cb + r16) * PQ + 16 * wq + 4 * g4) = w; }
                }
            }
            __syncthreads();
            if (FULL && !metac) {
                const int i = tid >> 3, cc = tid & 7;
                float o[16];
#pragma unroll
                for (int k4 = 0; k4 < 4; ++k4) { const f32x4 t = *(const LAS f32x4*)(OB + i * POB + 16 * cc + 4 * k4); o[4 * k4] = t[0]; o[4 * k4 + 1] = t[1]; o[4 * k4 + 2] = t[2]; o[4 * k4 + 3] = t[3]; }
                const size_t row = (size_t)(rowbase + i);
                const u32x4* gp = (const u32x4*)(PROJ + row * NPROJ + gcol + 16 * cc); const u32x4 ga = gp[0], gb2 = gp[1];
                const unsigned gw[8] = {ga.x, ga.y, ga.z, ga.w, gb2.x, gb2.y, gb2.z, gb2.w};
                float s1 = 0.f, s2 = 0.f;
#pragma unroll
                for (int k = 0; k < 16; ++k) { s1 += o[k]; s2 += o[k] * o[k]; }
#pragma unroll
                for (int m = 1; m < 8; m <<= 1) { s1 += __shfl_xor(s1, m); s2 += __shfl_xor(s2, m); }
                float mu, rs;
                if (gla) { mu = 0.f; rs = 1.0f / sqrtf(s2 * (1.0f / 128.0f) + EPS); }
                else { mu = s1 * (1.0f / 128.0f); const float var = fmaxf(s2 * (1.0f / 128.0f) - mu * mu, 0.f); rs = 1.0f / sqrtf(var + EPS); }
                const float* gn = (gla ? p.gla_gain : p.ret_gain) + 16 * cc; const float* bs = p.ret_bias + 16 * cc;
                unsigned ow[8];
#pragma unroll
                for (int k2 = 0; k2 < 8; ++k2) { float y[2];
#pragma unroll
                    for (int e = 0; e < 2; ++e) { const int k = 2 * k2 + e; float v = (o[k] - mu) * rs * gn[k]; if (!gla) v += bs[k];
                        const float gt = e ? bf_hi(gw[k2]) : bf_lo(gw[k2]); y[e] = v * gt / (1.0f + __expf(-gt)); }
                    ow[k2] = pk2(y[0], y[1]); }
                u32x4* op = (u32x4*)(OUT + (row - 256) * DM + h8 * 128 + 16 * cc);
                op[0] = (u32x4){ow[0], ow[1], ow[2], ow[3]}; op[1] = (u32x4){ow[4], ow[5], ow[6], ow[7]};
            }
        }
        if (!FULL) {
            if (wave >= 4) { const int wq = wave - 4; float* Sg = SEG + (size_t)item * 8192;
#pragma unroll
                for (int cb = 0; cb < 8; ++cb)
#pragma unroll
                    for (int rg = 0; rg < 4; ++rg) Sg[(16 * wq + 4 * g4 + rg) * 128 + 16 * cb + r16] = accS[cb][rg]; }
            if (tid < 64) ASEG[item * 64 + tid] = __expf(blsum);
        }
    }
}

__device__ __forceinline__ unsigned ord32(float f) { const unsigned b = __builtin_bit_cast(unsigned, f); return b ^ ((b >> 31) ? 0xffffffffu : 0x80000000u); }
__device__ __forceinline__ float unord32(unsigned o) { const unsigned b = (o >> 31) ? (o ^ 0x80000000u) : ~o; return __builtin_bit_cast(float, b); }
#define DPP_MAXU(v, ctrl, rmask) do { const unsigned _t = (unsigned)__builtin_amdgcn_update_dpp((int)(v), (int)(v), (ctrl), (rmask), 0xf, false); (v) = (v) > _t ? (v) : _t; } while (0)
#define DPP_ADDF(v, ctrl) do { const float _t = __builtin_bit_cast(float, __builtin_amdgcn_update_dpp(0, __builtin_bit_cast(int, (v)), (ctrl), 0xf, 0xf, false)); (v) += _t; } while (0)
__device__ __forceinline__ unsigned row_max_u(unsigned v) { DPP_MAXU(v, 0xB1, 0xf); DPP_MAXU(v, 0x4E, 0xf); DPP_MAXU(v, 0x124, 0xf); DPP_MAXU(v, 0x128, 0xf); return v; }
__device__ __forceinline__ float row_sum_f(float v) { DPP_ADDF(v, 0xB1); DPP_ADDF(v, 0x4E); DPP_ADDF(v, 0x124); DPP_ADDF(v, 0x128); return v; }
__device__ __forceinline__ unsigned wave_max_u(unsigned v) { v = row_max_u(v); DPP_MAXU(v, 0x142, 0xa); DPP_MAXU(v, 0x143, 0xc); return (unsigned)__builtin_amdgcn_readlane((int)v, 63); }

__device__ __forceinline__ float row_sum_x(float v) { return row_sum_f(v); }
__device__ __forceinline__ float dot2_bf16(unsigned w, unsigned x, float acc) { return __builtin_amdgcn_fdot2_f32_bf16(__builtin_bit_cast(bf16x2_t, w), __builtin_bit_cast(bf16x2_t, x), acc, false); }
__device__ __forceinline__ float gelu_exact(float v) { return 0.5f * v * (1.0f + erff(v * 0.70710678118654752f)); }

__device__ __forceinline__ void phase_peer(const Params& p, LAS unsigned char* lds, int bid, int nb) {
    const int tid = threadIdx.x, lane = tid & 63, wave = __builtin_amdgcn_readfirstlane(tid >> 6);
    const int p16 = lane & 15, rg4 = lane >> 4;
    unsigned char* ws = p.ws;
    const _Float16* SC = (const _Float16*)(ws + WS_PROJ); const bf16_t* HB = (const bf16_t*)(ws + WS_XN); const float* SSQ = (const float*)(ws + WS_SSQ);
    const unsigned char* UB = (const unsigned char*)(ws + WS_UB); const unsigned char* VB = (const unsigned char*)(ws + WS_VB);
    LAS float* A_s = (LAS float*)(lds + wave * 4096);
    LAS int* A_i = (LAS int*)(lds + wave * 4096 + 1024);
    LAS int* E_i = (LAS int*)(lds + wave * 4096 + 2048);
    LAS float* E_s = (LAS float*)(lds + wave * 4096 + 2560);
    int ci = 0, cj = 0; bool cvalid = lane < 50;
    { int l = lane;
      if (l < 16) { ci = 0; cj = l; } else if (l < 24) { ci = 1; cj = l - 16; } else if (l < 29) { ci = 2; cj = l - 24; } else if (l < 33) { ci = 3; cj = l - 29; }
      else if (l < 36) { ci = 4; cj = l - 33; } else if (l < 42) { ci = 5 + (l - 36) / 2; cj = (l - 36) & 1; } else { ci = 8 + (l - 42); cj = 0; } if (!cvalid) { ci = 0; cj = 0; } }
    const int gw = bid * 8 + wave, NGW = nb * 8;
    for (int t = gw; t < NTOK; t += NGW) {
        float ssq = (lane < 16) ? SSQ[(size_t)t * 16 + lane] : 0.f; ssq = wave_sum(ssq);
        const float rstd = 1.0f / sqrtf(ssq * (1.0f / DM) + EPS);
#pragma unroll 1
        for (int q = 0; q < 4; ++q) {
            const u32x4 raw = *(const u32x4*)(SC + (size_t)t * 2048 + 512 * q + 8 * lane);
            const unsigned rw[4] = {raw.x, raw.y, raw.z, raw.w};
            unsigned key[8];
#pragma unroll
            for (int e = 0; e < 8; ++e) { const unsigned hbits = (e & 1) ? (rw[e >> 1] >> 16) : (rw[e >> 1] & 0xffffu);
                const float f = (float)__builtin_bit_cast(_Float16, (unsigned short)hbits);
                key[e] = (ord32(f) & ~0x7fu) | (unsigned)(127 - (8 * p16 + e)); }
            unsigned mine = 0u;
#pragma unroll 1
            for (int it = 0; it < 16; ++it) {
                unsigned m = key[0];
#pragma unroll
                for (int e = 1; e < 8; ++e) m = m > key[e] ? m : key[e];
                const unsigned W = row_max_u(m);
                mine = (p16 == it) ? W : mine;
#pragma unroll
                for (int e = 0; e < 8; ++e) key[e] = (key[e] == W) ? 0u : key[e];
            }
            const int g = 4 * q + rg4;
            A_s[g * 16 + p16] = unord32(mine & ~0x7fu); A_i[g * 16 + p16] = 127 - (int)(mine & 0x7fu);
        }
        LDS_WAIT();
#pragma unroll 1
        for (int h = 0; h < 8; ++h) {
            const float sa = A_s[(2 * h) * 16 + ci], sb = A_s[(2 * h + 1) * 16 + cj];
            const int ia = A_i[(2 * h) * 16 + ci], ib = A_i[(2 * h + 1) * 16 + cj];
            const float sum = sa + sb;
            unsigned key = cvalid ? ((ord32(sum) & ~0x3fu) | (unsigned)(63 - lane)) : 0u;
            int rank = -1;
#pragma unroll 1
            for (int it = 0; it < 16; ++it) { const unsigned W = wave_max_u(key); if (key == W) { rank = it; key = 0u; } }
            if (rank >= 0) { E_i[h * 16 + rank] = ia * 128 + ib; E_s[h * 16 + rank] = sum; }
        }
        LDS_WAIT();
        float gsm[2]; int eidx[2];
#pragma unroll
        for (int sl = 0; sl < 2; ++sl) { const int e = lane + 64 * sl; const float s = E_s[e] * rstd, mx = E_s[e & ~15] * rstd; const float pe = __expf(s - mx); const float den = row_sum_x(pe);
            gsm[sl] = pe / den; eidx[sl] = E_i[e]; }
#if PEER_FP8
        f32x2v xf[4][8];
#pragma unroll
        for (int i = 0; i < 4; ++i) { const u32x4 h0 = *(const u32x4*)(HB + (size_t)t * DM + 256 * i + 16 * p16), h1 = *(const u32x4*)(HB + (size_t)t * DM + 256 * i + 16 * p16 + 8);
            const unsigned hv[8] = {h0.x, h0.y, h0.z, h0.w, h1.x, h1.y, h1.z, h1.w}; const float* gp = p.g2 + 256 * i + 16 * p16;
#pragma unroll
            for (int k2 = 0; k2 < 8; ++k2) { const f32x2v g = *(const f32x2v*)(gp + 2 * k2); xf[i][k2] = (f32x2v){bf_lo(hv[k2]) * rstd * g.x, bf_hi(hv[k2]) * rstd * g.y}; } }
        constexpr int NBB = 2;
#define P6_LOADB(buf, TAB, bt0) do { _Pragma("unroll") for (int j = 0; j < NBB; ++j) { const int bt = (bt0) + j; const int ex = E_i[64 * (bt >> 4) + 16 * rg4 + (bt & 15)]; \
            const unsigned char* rp = (TAB) + (size_t)ex * 1024 + 16 * p16; _Pragma("unroll") for (int i = 0; i < 4; ++i) buf[j][i] = *(const u32x4*)(rp + 256 * i); } } while (0)
        u32x4 bA[NBB][4], bB[NBB][4];
        float act0 = 0.f, act1 = 0.f;
#define P6_COMPU(buf, bt0) do { _Pragma("unroll") for (int j = 0; j < NBB; ++j) { const int bt = (bt0) + j; f32x2v s2 = (f32x2v){0.f, 0.f}; \
            _Pragma("unroll") for (int i = 0; i < 4; ++i) { const unsigned uu[4] = {buf[j][i].x, buf[j][i].y, buf[j][i].z, buf[j][i].w}; \
                _Pragma("unroll") for (int w = 0; w < 4; ++w) { const f32x2v lo = __builtin_amdgcn_cvt_pk_f32_fp8((int)uu[w], false), hi = __builtin_amdgcn_cvt_pk_f32_fp8((int)uu[w], true); \
                    s2 = __builtin_elementwise_fma(lo, xf[i][2 * w], s2); s2 = __builtin_elementwise_fma(hi, xf[i][2 * w + 1], s2); } } \
            const float s = row_sum_x(s2.x + s2.y); const bool mine = (p16 == (bt & 15)); act0 = (mine && bt < 16) ? s : act0; act1 = (mine && bt >= 16) ? s : act1; } } while (0)
        P6_LOADB(bA, UB, 0);
#pragma unroll 1
        for (int g = 0; g < 32; g += 2 * NBB) { P6_LOADB(bB, UB, g + NBB); P6_COMPU(bA, g); if (g + 2 * NBB < 32) P6_LOADB(bA, UB, g + 2 * NBB); P6_COMPU(bB, g + NBB); }
        P6_LOADB(bA, VB, 0);
        LAS float* E_c = E_s;
        { const float c0 = gsm[0] * gelu_exact(act0 * (1.0f / 512.0f)) * (1.0f / 32.0f), c1 = gsm[1] * gelu_exact(act1 * (1.0f / 512.0f)) * (1.0f / 32.0f);
          LDS_WAIT(); E_c[lane] = c0; E_c[lane + 64] = c1; LDS_WAIT(); }
        f32x2v acc2[4][8];
#pragma unroll
        for (int i = 0; i < 4; ++i)
#pragma unroll
            for (int k = 0; k < 8; ++k) acc2[i][k] = (f32x2v){0.f, 0.f};
#define P6_COMPV(buf, bt0) do { _Pragma("unroll") for (int j = 0; j < NBB; ++j) { const int bt = (bt0) + j; const float cf = E_c[64 * (bt >> 4) + 16 * rg4 + (bt & 15)]; const f32x2v cf2 = (f32x2v){cf, cf}; \
            _Pragma("unroll") for (int i = 0; i < 4; ++i) { const unsigned vv[4] = {buf[j][i].x, buf[j][i].y, buf[j][i].z, buf[j][i].w}; \
                _Pragma("unroll") for (int w = 0; w < 4; ++w) { const f32x2v lo = __builtin_amdgcn_cvt_pk_f32_fp8((int)vv[w], false), hi = __builtin_amdgcn_cvt_pk_f32_fp8((int)vv[w], true); \
                    acc2[i][2 * w] = __builtin_elementwise_fma(lo, cf2, acc2[i][2 * w]); acc2[i][2 * w + 1] = __builtin_elementwise_fma(hi, cf2, acc2[i][2 * w + 1]); } } } } while (0)
#pragma unroll 1
        for (int g = 0; g < 32; g += 2 * NBB) { P6_LOADB(bB, VB, g + NBB); P6_COMPV(bA, g); if (g + 2 * NBB < 32) P6_LOADB(bA, VB, g + 2 * NBB); P6_COMPV(bB, g + NBB); }
#undef P6_LOADB
#undef P6_COMPU
#undef P6_COMPV
        float ss = 0.f;
#pragma unroll
        for (int i = 0; i < 4; ++i) { const u32x4 h0 = *(const u32x4*)(HB + (size_t)t * DM + 256 * i + 16 * p16), h1 = *(const u32x4*)(HB + (size_t)t * DM + 256 * i + 16 * p16 + 8);
            const unsigned hv[8] = {h0.x, h0.y, h0.z, h0.w, h1.x, h1.y, h1.z, h1.w};
#pragma unroll
            for (int k2 = 0; k2 < 8; ++k2) { float ax = acc2[i][k2].x, ay = acc2[i][k2].y;
                ax += __shfl_xor(ax, 16); ax += __shfl_xor(ax, 32); ay += __shfl_xor(ay, 16); ay += __shfl_xor(ay, 32);
                ax += bf_lo(hv[k2]); ay += bf_hi(hv[k2]); acc2[i][k2] = (f32x2v){ax, ay}; ss += ax * ax + ay * ay; } }
        ss = row_sum_x(ss);
        const float rf = 1.0f / sqrtf(ss * (1.0f / DM) + EPS);
#pragma unroll
        for (int i = 0; i < 4; ++i) { if (i == rg4) { const float* gp = p.gfin + 256 * i + 16 * p16; float* op = p.out + (size_t)t * DM + 256 * i + 16 * p16;
#pragma unroll
                for (int k4 = 0; k4 < 4; ++k4) { const f32x4 g = *(const f32x4*)(gp + 4 * k4);
                    *(f32x4*)(op + 4 * k4) = (f32x4){acc2[i][2 * k4].x * rf * g[0], acc2[i][2 * k4].y * rf * g[1], acc2[i][2 * k4 + 1].x * rf * g[2], acc2[i][2 * k4 + 1].y * rf * g[3]}; } } }
#else
        unsigned xp[8][4];
#pragma unroll
        for (int i = 0; i < 8; ++i) { const u32x4 hw = *(const u32x4*)(HB + (size_t)t * DM + 128 * i + 8 * p16); const f32x4 ga = *(const f32x4*)(p.g2 + 128 * i + 8 * p16), gb = *(const f32x4*)(p.g2 + 128 * i + 8 * p16 + 4);
            xp[i][0] = pk2(bf_lo(hw.x) * rstd * ga[0], bf_hi(hw.x) * rstd * ga[1]); xp[i][1] = pk2(bf_lo(hw.y) * rstd * ga[2], bf_hi(hw.y) * rstd * ga[3]);
            xp[i][2] = pk2(bf_lo(hw.z) * rstd * gb[0], bf_hi(hw.z) * rstd * gb[1]); xp[i][3] = pk2(bf_lo(hw.w) * rstd * gb[2], bf_hi(hw.w) * rstd * gb[3]); }
        float act[2] = {0.f, 0.f};
#pragma unroll
        for (int sl = 0; sl < 2; ++sl) {
#pragma unroll 2
            for (int b16 = 0; b16 < 16; ++b16) {
                const int e = 64 * sl + 16 * rg4 + b16; const int ex = E_i[e];
                const unsigned char* rowp = UB + (size_t)ex * 2048 + 16 * p16;
                float s = 0.f;
#pragma unroll
                for (int i = 0; i < 8; ++i) { const u32x4 uw = *(const u32x4*)(rowp + 256 * i);
                    s = dot2_bf16(uw.x, xp[i][0], s); s = dot2_bf16(uw.y, xp[i][1], s); s = dot2_bf16(uw.z, xp[i][2], s); s = dot2_bf16(uw.w, xp[i][3], s); }
                s = row_sum_x(s);
                act[sl] = (p16 == b16) ? s : act[sl];
            }
        }
        float coef[2];
#pragma unroll
        for (int sl = 0; sl < 2; ++sl) coef[sl] = gsm[sl] * gelu_exact(act[sl]);
        float acc[8][8];
#pragma unroll
        for (int i = 0; i < 8; ++i)
#pragma unroll
            for (int k = 0; k < 8; ++k) acc[i][k] = 0.f;
#pragma unroll
        for (int sl = 0; sl < 2; ++sl) {
#pragma unroll 2
            for (int b16 = 0; b16 < 16; ++b16) {
                const int srcl = (lane & 48) + b16;
                const float cf = __shfl(coef[sl], srcl); const int ex = __shfl(eidx[sl], srcl);
                const unsigned char* rowp = VB + (size_t)ex * 2048 + 16 * p16;
#pragma unroll
                for (int i = 0; i < 8; ++i) { const u32x4 vw = *(const u32x4*)(rowp + 256 * i);
                    acc[i][0] += cf * bf_lo(vw.x); acc[i][1] += cf * bf_hi(vw.x); acc[i][2] += cf * bf_lo(vw.y); acc[i][3] += cf * bf_hi(vw.y);
                    acc[i][4] += cf * bf_lo(vw.z); acc[i][5] += cf * bf_hi(vw.z); acc[i][6] += cf * bf_lo(vw.w); acc[i][7] += cf * bf_hi(vw.w); }
            }
        }
        float ss = 0.f;
#pragma unroll
        for (int i = 0; i < 8; ++i) { const u32x4 hw = *(const u32x4*)(HB + (size_t)t * DM + 128 * i + 8 * p16); const unsigned hv[4] = {hw.x, hw.y, hw.z, hw.w};
#pragma unroll
            for (int k = 0; k < 8; ++k) { float a = acc[i][k]; a += __shfl_xor(a, 16); a += __shfl_xor(a, 32);
                a += (k & 1) ? bf_hi(hv[k >> 1]) : bf_lo(hv[k >> 1]); acc[i][k] = a; ss += a * a; } }
        ss = row_sum_x(ss);
        const float rf = 1.0f / sqrtf(ss * (1.0f / DM) + EPS);
#pragma unroll
        for (int i = 0; i < 8; ++i) { if ((i >> 1) == rg4) { const f32x4 ga = *(const f32x4*)(p.gfin + 128 * i + 8 * p16), gb = *(const f32x4*)(p.gfin + 128 * i + 8 * p16 + 4);
                float* op = p.out + (size_t)t * DM + 128 * i + 8 * p16;
                *(f32x4*)op = (f32x4){acc[i][0] * rf * ga[0], acc[i][1] * rf * ga[1], acc[i][2] * rf * ga[2], acc[i][3] * rf * ga[3]};
                *(f32x4*)(op + 4) = (f32x4){acc[i][4] * rf * gb[0], acc[i][5] * rf * gb[1], acc[i][6] * rf * gb[2], acc[i][7] * rf * gb[3]}; } }
#endif
        LDS_WAIT();
    }
}


__global__ void __launch_bounds__(512, 2) mk_fwd(Params p) {
    extern __shared__ __attribute__((aligned(16))) unsigned char lds_raw[];
    LAS unsigned char* lds = (LAS unsigned char*)lds_raw;
    const int bid = blockIdx.x, nb = gridDim.x;
    unsigned char* ws = p.ws;
#define IN(k) (p.ph_lo <= (k) && (k) < p.ph_hi)
#define SEAM(k) do { if (IN(k) && IN((k) + 1)) { cg::this_grid().sync(); } } while (0)
    if (IN(0)) phase0(p, lds, bid, nb);
    SEAM(0);
    if (IN(1)) {
        pg8::Gemm g{(const bf16_t*)(ws + WS_XN), (const bf16_t*)(ws + WS_WIN), MROWS, NP1, DM}; pg8::StaticOrder S; S.init(MROWS, NP1, nb, bid);
        EpiProj E{(bf16_t*)(ws + WS_PROJ), (float*)(ws + WS_LA), p.gb, (const float2*)(ws + WS_ROPE)};
        pg8::gemm_phase<EpiProj, pg8::StaticOrder, true, true>(lds, g, S, E);
    }
    SEAM(1);
    if (IN(2)) attn_pass<false>(p, lds, bid, nb);
    SEAM(2);
    if (IN(3)) attn_pass<true>(p, lds, bid, nb);
    SEAM(3);
    if (IN(4)) {
        pg8::Gemm g{(const bf16_t*)(ws + WS_O), (const bf16_t*)(ws + WS_WOUT), NTOK, DM, DM}; pg8::StaticOrder S; S.init(NTOK, DM, nb, bid);
        EpiRes E{p.x, (bf16_t*)(ws + WS_XN), (float*)(ws + WS_SSQ)};
        pg8::gemm_phase<EpiRes, pg8::StaticOrder, true, true>(lds, g, S, E);
    }
    SEAM(4);
    if (IN(5)) {
        pg8::Gemm g{(const bf16_t*)(ws + WS_XN), (const bf16_t*)(ws + WS_WS), NTOK, 2048, DM}; pg8::StaticOrder S; S.init(NTOK, 2048, nb, bid);
        EpiF16 E{(_Float16*)(ws + WS_PROJ)};
        pg8::gemm_phase<EpiF16, pg8::StaticOrder, true, true>(lds, g, S, E);
    }
    SEAM(5);
    if (IN(6)) phase_peer(p, lds, bid, nb);
#undef IN
#undef SEAM
}

#ifndef MK_FUSED
#define MK_FUSED 1
#endif
extern "C" void kernel_launch(void* const* d_in, const int* in_sizes, int n_in, void* d_out, int out_size, void* d_ws, size_t ws_size, hipStream_t stream) {
    static int grid = 0;
    if (grid == 0) {
        if (n_in != 16 || in_sizes[0] != NTOK * DM || out_size != NTOK * DM || ws_size < WS_END) {
            fprintf(stderr, "kernel_launch: unexpected shapes (n_in %d, in0 %d, out %d, ws %zu); nothing launched\n", n_in, n_in > 0 ? in_sizes[0] : -1, out_size, ws_size); grid = -1; return; }
        int dev = 0, cus = 0, per_cu = 0;
        hipGetDevice(&dev); hipDeviceGetAttribute(&cus, hipDeviceAttributeMultiprocessorCount, dev);
        if (hipFuncSetAttribute((const void*)mk_fwd, hipFuncAttributeMaxDynamicSharedMemorySize, LDS_BYTES) != hipSuccess) { fprintf(stderr, "kernel_launch: hipFuncSetAttribute failed\n"); grid = -1; return; }
        if (hipOccupancyMaxActiveBlocksPerMultiprocessor(&per_cu, (const void*)mk_fwd, 512, LDS_BYTES) != hipSuccess || per_cu < 1) { fprintf(stderr, "kernel_launch: occupancy query failed (%d)\n", per_cu); (void)hipGetLastError(); per_cu = 1; }
        grid = cus * (per_cu < 1 ? 1 : 1);
        fprintf(stderr, "kernel_launch: %d CUs, occupancy %d/CU, grid %d\n", cus, per_cu, grid);
    }
    if (grid < 0) return;
    Params p{};
    p.x = (const float*)d_in[0]; p.meta = (const float*)d_in[1]; p.g1 = (const float*)d_in[2]; p.w_in = (const float*)d_in[3]; p.gw2 = (const float*)d_in[4]; p.gb = (const float*)d_in[5];
    p.gla_gain = (const float*)d_in[6]; p.ret_gain = (const float*)d_in[7]; p.ret_bias = (const float*)d_in[8]; p.w_out = (const float*)d_in[9]; p.g2 = (const float*)d_in[10];
    p.w_q = (const float*)d_in[11]; p.subkeys = (const float*)d_in[12]; p.pu = (const float*)d_in[13]; p.pv = (const float*)d_in[14]; p.gfin = (const float*)d_in[15];
    p.out = (float*)d_out; p.ws = (unsigned char*)d_ws;
#if MK_FUSED
    p.ph_lo = 0; p.ph_hi = NPHASE;
    void* args[] = {&p};
    hipError_t e = hipLaunchCooperativeKernel((const void*)mk_fwd, dim3(grid), dim3(512), args, LDS_BYTES, stream);
    if (e != hipSuccess) fprintf(stderr, "kernel_launch: cooperative launch failed: %s (grid %d)\n", hipGetErrorString(e), grid);
#else
    { const int order[7] = {0, 1, 2, 3, 4, 5, 6}; for (int i = 0; i < 7; ++i) { p.ph_lo = order[i]; p.ph_hi = order[i] + 1; hipLaunchKernelGGL(mk_fwd, dim3(grid), dim3(512), LDS_BYTES, stream, p); } }
#endif
}
```

```cpp
#include <hip/hip_runtime.h>
#include <hip/hip_cooperative_groups.h>
#include <cstdio>
#include <cstdint>
namespace cg = cooperative_groups;
namespace pg8 {
#define PG8_LAS __attribute__((address_space(3)))
typedef unsigned short bf16_t;
typedef short bf16x8 __attribute__((ext_vector_type(8)));
typedef float f32x4 __attribute__((ext_vector_type(4)));
typedef unsigned u32x4 __attribute__((ext_vector_type(4)));
constexpr int BM = 256, BK = 64, HALF = 128, HTB = HALF * BK * 2  , STAGE_BYTES = 8 * HTB, NXCD = 8, WGM = 8;

__host__ __device__ __forceinline__ int lds_byte(int r, int c) { const int st = (r >> 4) * 2 + (c >> 5), rr = r & 15, cc = c & 31, ob = rr * 64 + cc * 2; return st * 1024 + (ob ^ (((ob >> 9) & 1) << 5)); }
__host__ __device__ __forceinline__ void stage_rc(int b, int& R, int& C) { const int st = b / 1024, sb = b % 1024, swz = sb ^ (((sb >> 9) & 1) << 5); R = (st >> 1) * 16 + swz / 64; C = (st & 1) * 32 + (swz % 64) / 2; }
__host__ __device__ __forceinline__ int perm32(int rho) { const int n = rho >> 4, i = rho & 15; return 8 * (i >> 2) + 4 * n + (i & 3); }

struct Unit { int pm, pn; };
struct Gemm { const bf16_t* A; const bf16_t* Bt; int M, N, K; };

struct StaticOrder {
    int nM, nN, nwg, G, c;
    __host__ __device__ void init(int M, int N, int G_, int c_) { nM = M / BM; nN = N / BM; nwg = nM * nN; G = G_; c = c_; }
    __host__ __device__ bool next(int i, Unit& u) const {
        const long L = (long)i * G + c; if (L >= nwg) return false;
        int wgid = (int)L; { const int q = nwg / NXCD, r = nwg % NXCD, xcd = wgid % NXCD, off = wgid / NXCD; wgid = (xcd < r ? xcd * (q + 1) : r * (q + 1) + (xcd - r) * q) + off; }
        const int nig = WGM * nN, gid = wgid / nig, fm = gid * WGM, gsz = (nM - fm) < WGM ? (nM - fm) : WGM;
        u.pm = fm + ((wgid % nig) % gsz); u.pn = (wgid % nig) / gsz; return true;
    }
    __device__ __forceinline__ void a_ready(const Unit&) const {}
    __device__ __forceinline__ void done(const Unit&) const {}
};

__device__ __forceinline__ unsigned cvt_pk_bf16(float lo, float hi) { unsigned r; asm volatile("v_cvt_pk_bf16_f32 %0, %1, %2" : "=v"(r) : "v"(lo), "v"(hi)); return r; }
typedef float f32x2 __attribute__((ext_vector_type(2)));
template <class Epi, class Sched, bool ALIGN_EPI = false, bool SP2 = false>
__device__ __forceinline__ void gemm_phase(PG8_LAS unsigned char* lds, const Gemm g, const Sched& S, const Epi& E) {
    const int tid = threadIdx.x, wid = __builtin_amdgcn_readfirstlane(tid >> 6), lane = tid & 63, wr = wid >> 2, wc = wid & 3, fr = lane & 15, fq = lane >> 4;
    const int K = g.K, nt = K / BK;
    unsigned voffA[2], voffB[2];
#pragma unroll
    for (int i = 0; i < 2; ++i) { int R, C; stage_rc(tid * 16 + i * 8192, R, C); const int Rb = Epi::PERM ? ((R & ~31) + perm32(R & 31)) : R;
        voffA[i] = (unsigned)(R * K + C) * 2u; voffB[i] = (unsigned)(Rb * K + C) * 2u; }
    const size_t kstep = (size_t)(BK * 2);
    const size_t hstep = (size_t)HALF * K * 2;
    const size_t tstep = 2 * hstep;
    const unsigned ldsw = (unsigned)wid * 1024u;
    const int aoff = lds_byte(wr * 64 + fr, fq * 8), boff = lds_byte(wc * 32 + fr, fq * 8);
#define PG8_SA(b, h) (((b) * 2 + (h)) * HTB)
#define PG8_SB(b, h) ((4 + (b) * 2 + (h)) * HTB)
#define PG8_STAGE(bufoff, gbase, voff) do { _Pragma("unroll") for (int _i = 0; _i < 2; ++_i) \
        __builtin_amdgcn_global_load_lds((const unsigned*)((const char*)(gbase) + (voff)[_i]), (PG8_LAS unsigned*)(lds + (bufoff) + ldsw + _i * 8192), 16, 0, 0); } while (0)
#define PG8_LDA(dst, b, h) do { _Pragma("unroll") for (int m = 0; m < 4; ++m) _Pragma("unroll") for (int k = 0; k < 2; ++k) dst[m][k] = *(const PG8_LAS bf16x8*)(lds + PG8_SA(b, h) + aoff + m * 2048 + k * 1024); } while (0)
#define PG8_LDB(dst, b, h) do { _Pragma("unroll") for (int n = 0; n < 2; ++n) _Pragma("unroll") for (int k = 0; k < 2; ++k) dst[n][k] = *(const PG8_LAS bf16x8*)(lds + PG8_SB(b, h) + boff + n * 2048 + k * 1024); } while (0)
#define PG8_MMA(ai, bj, At, Bt) do { __builtin_amdgcn_s_setprio(1); _Pragma("unroll") for (int m = 0; m < 4; ++m) _Pragma("unroll") for (int n = 0; n < 2; ++n) _Pragma("unroll") for (int k = 0; k < 2; ++k) \
        acc[ai][bj][m][n] = __builtin_amdgcn_mfma_f32_16x16x32_bf16(Bt[n][k], At[m][k], acc[ai][bj][m][n], 0, 0, 0); __builtin_amdgcn_s_setprio(0); } while (0)
#define PG8_WAIT_V(n) asm volatile("s_waitcnt vmcnt(" #n ")" ::: "memory")
#define PG8_WAIT_L(n) asm volatile("s_waitcnt lgkmcnt(" #n ")" ::: "memory")
#define PG8_BAR __builtin_amdgcn_s_barrier()
#define PG8_SCHED __builtin_amdgcn_sched_barrier(0)
    Unit cur, nxt; int ui = 0;
    if (!S.next(0, cur)) return;
    f32x4 acc[2][2][4][2];
#pragma unroll
    for (int a = 0; a < 2; ++a)
#pragma unroll
        for (int b = 0; b < 2; ++b)
#pragma unroll
            for (int m = 0; m < 4; ++m)
#pragma unroll
                for (int n = 0; n < 2; ++n) acc[a][b][m][n] = (f32x4){0.f, 0.f, 0.f, 0.f};
    bf16x8 At[4][2], B0[2][2], B1[2][2];
    const char* cA = (const char*)g.A + (size_t)cur.pm * tstep; const char* cB = (const char*)g.Bt + (size_t)cur.pn * tstep;
    S.a_ready(cur);
    if constexpr (SP2) {
        PG8_STAGE(PG8_SB(0, 0), cB, voffB); PG8_STAGE(PG8_SB(0, 1), cB + hstep, voffB); PG8_STAGE(PG8_SA(0, 0), cA, voffA); PG8_STAGE(PG8_SA(0, 1), cA + hstep, voffA);
        if (wr == 1) PG8_BAR;
        PG8_WAIT_V(2); PG8_BAR;
        PG8_STAGE(PG8_SB(1, 0), cB + kstep, voffB); PG8_STAGE(PG8_SA(1, 0), cA + kstep, voffA); PG8_STAGE(PG8_SB(1, 1), cB + hstep + kstep, voffB);
        PG8_WAIT_V(6); PG8_BAR;
    } else {
        PG8_STAGE(PG8_SB(0, 0), cB, voffB); PG8_STAGE(PG8_SA(0, 0), cA, voffA); PG8_STAGE(PG8_SB(0, 1), cB + hstep, voffB); PG8_STAGE(PG8_SA(0, 1), cA + hstep, voffA);
        if (wr == 1) PG8_BAR;
        PG8_WAIT_V(4); PG8_BAR;
        PG8_STAGE(PG8_SB(1, 0), cB + kstep, voffB); PG8_STAGE(PG8_SA(1, 0), cA + kstep, voffA); PG8_STAGE(PG8_SB(1, 1), cB + hstep + kstep, voffB);
        PG8_WAIT_V(6); PG8_BAR;
    }
    for (;;) {
        const bool has_next = S.next(ui + 1, nxt);
        const char* nA = has_next ? (const char*)g.A + (size_t)nxt.pm * tstep : cA; const char* nB = has_next ? (const char*)g.Bt + (size_t)nxt.pn * tstep : cB;
        for (int t = 0; t < nt; t += 2) {
            const bool last = (t == nt - 2);
            const char* a1 = cA + (size_t)(t + 1) * kstep;
            const char* a2 = last ? nA : cA + (size_t)(t + 2) * kstep; const char* b2 = last ? nB : cB + (size_t)(t + 2) * kstep;
            const char* a3 = a2 + kstep; const char* b3 = b2 + kstep;
            if (last && has_next) S.a_ready(nxt);
            if constexpr (SP2) {
            PG8_LDB(B0, 0, 0); PG8_LDB(B1, 0, 1); PG8_SCHED; PG8_LDA(At, 0, 0); PG8_STAGE(PG8_SA(1, 1), a1 + hstep, voffA);
            PG8_WAIT_V(8); PG8_WAIT_L(0); PG8_BAR; PG8_MMA(0, 0, At, B0); PG8_MMA(0, 1, At, B1); PG8_BAR; PG8_SCHED;
            PG8_LDA(At, 0, 1); PG8_STAGE(PG8_SB(0, 0), b2, voffB); PG8_STAGE(PG8_SB(0, 1), b2 + hstep, voffB); PG8_STAGE(PG8_SA(0, 0), a2, voffA);
            PG8_WAIT_V(8); PG8_WAIT_L(0); PG8_BAR; PG8_MMA(1, 0, At, B0); PG8_MMA(1, 1, At, B1); PG8_BAR; PG8_SCHED;
            PG8_LDB(B0, 1, 0); PG8_LDB(B1, 1, 1); PG8_SCHED; PG8_LDA(At, 1, 0); PG8_STAGE(PG8_SA(0, 1), a2 + hstep, voffA);
            PG8_WAIT_V(8); PG8_WAIT_L(0); PG8_BAR; PG8_MMA(0, 0, At, B0); PG8_MMA(0, 1, At, B1); PG8_BAR; PG8_SCHED;
            PG8_LDA(At, 1, 1); PG8_STAGE(PG8_SB(1, 0), b3, voffB); PG8_STAGE(PG8_SB(1, 1), b3 + hstep, voffB); PG8_STAGE(PG8_SA(1, 0), a3, voffA);
            PG8_WAIT_V(8); PG8_WAIT_L(0); PG8_BAR; PG8_MMA(1, 0, At, B0); PG8_MMA(1, 1, At, B1); PG8_BAR; PG8_SCHED;
            } else {
            PG8_LDB(B0, 0, 0); PG8_SCHED; PG8_LDA(At, 0, 0); PG8_STAGE(PG8_SA(1, 1), a1 + hstep, voffA);
            PG8_WAIT_L(8); PG8_BAR; PG8_WAIT_L(0); PG8_MMA(0, 0, At, B0); PG8_BAR; PG8_SCHED;
            PG8_LDB(B1, 0, 1); PG8_STAGE(PG8_SB(0, 0), b2, voffB);
            PG8_BAR; PG8_WAIT_L(0); PG8_MMA(0, 1, At, B1); PG8_BAR;
            PG8_LDA(At, 0, 1); PG8_STAGE(PG8_SA(0, 0), a2, voffA);
            PG8_BAR; PG8_WAIT_L(0); PG8_MMA(1, 0, At, B0); PG8_BAR; PG8_SCHED;
            PG8_STAGE(PG8_SB(0, 1), b2 + hstep, voffB);
            PG8_WAIT_V(6); PG8_BAR; PG8_MMA(1, 1, At, B1); PG8_BAR;
            PG8_LDB(B0, 1, 0); PG8_SCHED; PG8_LDA(At, 1, 0); PG8_STAGE(PG8_SA(0, 1), a2 + hstep, voffA);
            PG8_WAIT_L(8); PG8_BAR; PG8_WAIT_L(0); PG8_MMA(0, 0, At, B0); PG8_BAR; PG8_SCHED;
            PG8_LDB(B1, 1, 1); PG8_STAGE(PG8_SB(1, 0), b3, voffB);
            PG8_BAR; PG8_WAIT_L(0); PG8_MMA(0, 1, At, B1); PG8_BAR;
            PG8_LDA(At, 1, 1); PG8_STAGE(PG8_SA(1, 0), a3, voffA);
            PG8_BAR; PG8_WAIT_L(0); PG8_MMA(1, 0, At, B0); PG8_BAR; PG8_SCHED;
            PG8_STAGE(PG8_SB(1, 1), b3 + hstep, voffB);
            PG8_WAIT_V(6); PG8_BAR; PG8_MMA(1, 1, At, B1); PG8_BAR;
            }
        }
        if constexpr (ALIGN_EPI) { if (wr == 0) PG8_BAR; }
        if constexpr (!Epi::AFTER_DRAIN) { E(acc, cur, wr, wc, fr, fq); S.done(cur); }
        if (!has_next) break;
#pragma unroll
        for (int a = 0; a < 2; ++a)
#pragma unroll
            for (int b = 0; b < 2; ++b)
#pragma unroll
                for (int m = 0; m < 4; ++m)
#pragma unroll
                    for (int n = 0; n < 2; ++n) acc[a][b][m][n] = (f32x4){0.f, 0.f, 0.f, 0.f};
        cur = nxt; cA = nA; cB = nB; ++ui;
        if constexpr (ALIGN_EPI) { if (wr == 1) PG8_BAR; }
    }
    PG8_WAIT_V(0);
    if constexpr (!ALIGN_EPI) { if (wr == 0) PG8_BAR; }
    PG8_BAR;
    if constexpr (Epi::AFTER_DRAIN) { E.fused(acc, cur, wr, wc, fr, fq, lds, wid, lane); S.done(cur); }
#undef PG8_SA
#undef PG8_SB
#undef PG8_STAGE
#undef PG8_LDA
#undef PG8_LDB
#undef PG8_MMA
#undef PG8_WAIT_V
#undef PG8_WAIT_L
#undef PG8_BAR
#undef PG8_SCHED
}
}

#define LAS __attribute__((address_space(3)))
typedef unsigned short bf16_t;
typedef float f32x4 __attribute__((ext_vector_type(4)));
typedef unsigned u32x4 __attribute__((ext_vector_type(4)));
typedef unsigned u32x2 __attribute__((ext_vector_type(2)));
typedef short bf16x8 __attribute__((ext_vector_type(8)));
typedef short s16x4 __attribute__((ext_vector_type(4)));
typedef __bf16 bf16x2_t __attribute__((ext_vector_type(2)));
typedef _Float16 f16x2_t __attribute__((ext_vector_type(2)));
typedef float f32x2v __attribute__((ext_vector_type(2)));

constexpr int DM = 1024, NB = 4, SEQ = 8192, NTOK = NB * SEQ;
constexpr int MROWS = NTOK + 256;
constexpr int INW = 3088;
constexpr int NPROJ = 3072, NP1 = 3328;
constexpr int NEXP = 16384;
constexpr float EPS = 1e-6f;
constexpr int C_GQ = 0, C_GK = 256, C_GV = 512, C_GG = 1024, C_RQ = 1536, C_RK = 1792, C_RV = 2048, C_RG = 2560;
constexpr int S_GA = 1536, S_RQ = 1552, S_RV = 2064;

constexpr size_t MiB = 1u << 20;
constexpr size_t WS_CTL = 0, WS_WIN = 1 * MiB, WS_WOUT = 8 * MiB, WS_WS = 10 * MiB, WS_ROPE = 14 * MiB, WS_SSQ = 17 * MiB, WS_SEG = 19 * MiB, WS_ASEG = 27 * MiB,
                 WS_UB = 28 * MiB, WS_VB = 60 * MiB, WS_XN = 92 * MiB, WS_O = 157 * MiB, WS_LA = 221 * MiB, WS_PROJ = 254 * MiB, WS_END = 448 * MiB;
static_assert(WS_WIN + (size_t)NP1 * DM * 2 <= WS_WOUT && WS_ROPE + (size_t)(SEQ + 64) * 32 * 8 <= WS_SSQ && WS_XN + (size_t)MROWS * DM * 2 <= WS_O &&
              WS_LA + (size_t)MROWS * 256 * 4 <= WS_PROJ && WS_PROJ + (size_t)MROWS * NPROJ * 2 <= WS_END && WS_PROJ + (size_t)NTOK * 2048 * 2 <= WS_END, "ws map");

constexpr int LDS_BYTES = 147456;
constexpr int NPHASE = 7;
#ifndef PROBE_R
#define PROBE_R 1
#define PROBE_U 1
#define PROBE_V 1
#endif
#ifndef PEER_FP8
#define PEER_FP8 1
#endif

struct Params {
    const float *x, *meta, *g1, *w_in, *gw2, *gb, *gla_gain, *ret_gain, *ret_bias, *w_out, *g2, *w_q, *subkeys, *pu, *pv, *gfin;
    float* out; unsigned char* ws;
    int ph_lo, ph_hi;
};

#define LDS_WAIT() asm volatile("s_waitcnt lgkmcnt(0)" ::: "memory")
__device__ __forceinline__ unsigned f2bf(float f) { unsigned u = __builtin_bit_cast(unsigned, f); return (u + 0x7fffu + ((u >> 16) & 1u)) >> 16; }
__device__ __forceinline__ unsigned pk2(float lo, float hi) { return f2bf(lo) | (f2bf(hi) << 16); }
__device__ __forceinline__ float bf_lo(unsigned w) { return __builtin_bit_cast(float, w << 16); }
__device__ __forceinline__ float bf_hi(unsigned w) { return __builtin_bit_cast(float, w & 0xffff0000u); }
__device__ __forceinline__ float bf1(bf16_t h) { return __builtin_bit_cast(float, (unsigned)h << 16); }
__device__ __forceinline__ float wave_sum(float v) {
#pragma unroll
    for (int o = 1; o < 64; o <<= 1) v += __shfl_xor(v, o);
    return v;
}

struct MapIn {
    __device__ __forceinline__ void operator()(int j, int& src, float& sc) const {
        if (j < C_RQ) { src = j; sc = (j < 256) ? 0.125f : 1.0f; }
        else if (j < C_RV) { const int jj = j - C_RQ, which = jj >> 8, within = jj & 255, head = within >> 6, p = within & 63;
            const int a = p >> 3, n = (p >> 2) & 1, i = p & 3; src = S_RQ + which * 256 + head * 64 + 32 * n + 4 * a + i; sc = which ? 0.125f : 1.0f; }
        else { src = S_RV + (j - C_RV); sc = 1.0f; }
    }
};
struct MapId { __device__ __forceinline__ void operator()(int j, int& src, float& sc) const { src = j; sc = 1.0f; } };

template <class Map>
__device__ __forceinline__ void transpose_item(const float* W, int K, int N, bf16_t* WT, LAS float* scr, int item, int nblk, int lane, const Map map) {
    const int kb = item / nblk, nb = item % nblk, k0 = 64 * kb, n0 = 32 * nb;
    int src; float sc; map(n0 + (lane & 31), src, sc);
#pragma unroll 8
    for (int i = 0; i < 32; ++i) { const int kk = 2 * i + (lane >> 5); scr[kk * 33 + (lane & 31)] = W[(size_t)(k0 + kk) * N + src] * sc; }
    LDS_WAIT();
    const int c = lane & 7;
#pragma unroll
    for (int j = 0; j < 4; ++j) { const int n = (lane >> 3) + 8 * j; const LAS float* s = scr + (8 * c) * 33 + n;
        u32x4 o; o.x = pk2(s[0 * 33], s[1 * 33]); o.y = pk2(s[2 * 33], s[3 * 33]); o.z = pk2(s[4 * 33], s[5 * 33]); o.w = pk2(s[6 * 33], s[7 * 33]);
        *(u32x4*)(WT + (size_t)(n0 + n) * K + k0 + 8 * c) = o; }
    LDS_WAIT();
}

__device__ __forceinline__ void phase0(const Params& p, LAS unsigned char* lds, int bid, int nb) {
    const int tid = threadIdx.x, lane = tid & 63, wave = __builtin_amdgcn_readfirstlane(tid >> 6);
    unsigned char* ws = p.ws;
    bf16_t* XN = (bf16_t*)(ws + WS_XN); bf16_t* WinT = (bf16_t*)(ws + WS_WIN); bf16_t* WoutT = (bf16_t*)(ws + WS_WOUT); bf16_t* WsT = (bf16_t*)(ws + WS_WS);
    const int gw = bid * 8 + wave, NGW = nb * 8;
    const int gt = bid * 512 + tid, NGT = nb * 512;

    {
        LAS float* SKT = (LAS float*)lds;
        LAS float* WQT = (LAS float*)(lds + 128 * 132 * 4);
        for (int item = bid; item < 256; item += nb) {
            const int hc = item >> 4, kb = item & 15;
            __syncthreads();
            for (int e = tid; e < 128 * 128; e += 512) { const int n = e >> 7, d = e & 127; SKT[d * 132 + n] = p.subkeys[(size_t)hc * 16384 + e]; }
            for (int e = tid; e < 64 * 128; e += 512) { const int k = e >> 7, d = e & 127; WQT[d * 68 + k] = p.w_q[(size_t)(kb * 64 + k) * 2048 + hc * 128 + d]; }
            __syncthreads();
            const int tn = tid & 31, tk = tid >> 5;
            f32x4 acc[4];
#pragma unroll
            for (int i = 0; i < 4; ++i) acc[i] = (f32x4){0.f, 0.f, 0.f, 0.f};
#pragma unroll 4
            for (int d = 0; d < 128; ++d) {
                const f32x4 sk = *(const LAS f32x4*)(SKT + d * 132 + 4 * tn); const f32x4 wq = *(const LAS f32x4*)(WQT + d * 68 + 4 * tk);
#pragma unroll
                for (int i = 0; i < 4; ++i) acc[i] += sk[i] * wq;
            }
            const f32x4 gg = *(const f32x4*)(p.g2 + kb * 64 + 4 * tk);
#pragma unroll
            for (int i = 0; i < 4; ++i) { const f32x4 v = acc[i] * gg; u32x2 o; o.x = pk2(v[0], v[1]); o.y = pk2(v[2], v[3]);
                *(u32x2*)(WsT + (size_t)(hc * 128 + 4 * tn + i) * DM + kb * 64 + 4 * tk) = o; }
        }
        __syncthreads();
    }
    {
        LAS float* scr = (LAS float*)(lds + wave * 16384);
        constexpr int I_IN = (DM / 64) * (NPROJ / 32), I_OUT = (DM / 64) * (DM / 32);
        for (int it = gw; it < I_IN + I_OUT; it += NGW) {
            if (it < I_IN) transpose_item(p.w_in, DM, INW, WinT, scr, it, NPROJ / 32, lane, MapIn());
            else transpose_item(p.w_out, DM, DM, WoutT, scr, it - I_IN, DM / 32, lane, MapId());
        }
    }
    for (int e = gt; e < 256 * DM; e += NGT) {
        const int n = e >> 10, k = e & 1023; const float* wr = p.w_in + (size_t)k * INW + S_GA; float s = 0.f;
#pragma unroll
        for (int r = 0; r < 16; ++r) s += wr[r] * p.gw2[r * 256 + n];
        WinT[(size_t)(NPROJ + n) * DM + k] = (bf16_t)f2bf(s);
    }
#if PEER_FP8
    {
        u32x4* U8 = (u32x4*)(ws + WS_UB); u32x4* V8 = (u32x4*)(ws + WS_VB);
        for (int e = gt; e < NEXP * DM / 16; e += NGT) {
            const f32x4* us = (const f32x4*)p.pu + 4 * (size_t)e; const f32x4* vs = (const f32x4*)p.pv + 4 * (size_t)e;
            u32x4 wu, wv; unsigned tu[4], tv[4];
#pragma unroll
            for (int j = 0; j < 4; ++j) { const f32x4 a = us[j] * 512.0f, b = vs[j] * 32.0f;
                int w = __builtin_amdgcn_cvt_pk_fp8_f32(a[0], a[1], 0, false); w = __builtin_amdgcn_cvt_pk_fp8_f32(a[2], a[3], w, true); tu[j] = (unsigned)w;
                int x = __builtin_amdgcn_cvt_pk_fp8_f32(b[0], b[1], 0, false); x = __builtin_amdgcn_cvt_pk_fp8_f32(b[2], b[3], x, true); tv[j] = (unsigned)x; }
            wu = (u32x4){tu[0], tu[1], tu[2], tu[3]}; wv = (u32x4){tv[0], tv[1], tv[2], tv[3]};
            const int row = e >> 6, c16 = e & 63;
            const size_t dst = ((size_t)(c16 >> 3) * NEXP + row) * 8 + (c16 & 7);
            U8[dst] = wu; V8[dst] = wv; }
    }
#else
    {
        u32x2* UB = (u32x2*)(ws + WS_UB); u32x2* VB = (u32x2*)(ws + WS_VB);
        const f32x4* u4 = (const f32x4*)p.pu; const f32x4* v4 = (const f32x4*)p.pv;
        for (int e = gt; e < NEXP * DM / 4; e += NGT) { const f32x4 a = u4[e]; u32x2 o; o.x = pk2(a[0], a[1]); o.y = pk2(a[2], a[3]); UB[e] = o;
            const f32x4 b = v4[e]; u32x2 q; q.x = pk2(b[0], b[1]); q.y = pk2(b[2], b[3]); VB[e] = q; }
    }
#endif
    {
        float2* rope = (float2*)(ws + WS_ROPE);
        for (int e = gt; e < (SEQ + 64) * 32; e += NGT) { const int pi = e >> 5, d = e & 31;
            const float invf = (float)pow(10000.0, -(double)d / 32.0); const float ang = (float)(pi - 48) * invf;
            rope[e] = make_float2((float)cos((double)ang), (float)sin((double)ang)); }
    }
    for (int m = gw; m < MROWS; m += NGW) {
        const float* src = nullptr;
        if (m >= 256) src = p.x + (size_t)(m - 256) * DM; else if (m >= 48 && m < 64) src = p.meta + (size_t)(m - 48) * DM;
        unsigned long long* o8 = (unsigned long long*)(XN + (size_t)m * DM) + lane;
        if (src == nullptr) {
#pragma unroll
            for (int j = 0; j < 4; ++j) o8[64 * j] = 0ull;
        } else {
            const f32x4* xr = (const f32x4*)src + lane; const f32x4* gr = (const f32x4*)p.g1 + lane;
            f32x4 v[4]; float s = 0.f;
#pragma unroll
            for (int j = 0; j < 4; ++j) { v[j] = xr[64 * j]; s += (v[j].x * v[j].x + v[j].y * v[j].y) + (v[j].z * v[j].z + v[j].w * v[j].w); }
            const float r = 1.0f / sqrtf(wave_sum(s) * (1.0f / DM) + EPS);
#pragma unroll
            for (int j = 0; j < 4; ++j) { const f32x4 g = gr[64 * j]; const f32x4 y = v[j] * r * g;
                o8[64 * j] = (unsigned long long)pk2(y.x, y.y) | ((unsigned long long)pk2(y.z, y.w) << 32); }
        }
    }
}

struct EpiProj {
    static constexpr bool PERM = true, AFTER_DRAIN = false;
    bf16_t* PROJ; float* LA; const float* gb; const float2* rope;
    __device__ __forceinline__ void operator()(const pg8::f32x4 (&acc)[2][2][4][2], const pg8::Unit& u, int wr, int wc, int fr, int fq) const {
        const int row0 = u.pm * 256 + wr * 64 + fr, cb0 = wc * 32 + 8 * fq;
        if (u.pn == 12) {
#pragma unroll
            for (int bj = 0; bj < 2; ++bj) { const int c = cb0 + 128 * bj; const f32x4 b0 = *(const f32x4*)(gb + c), b1 = *(const f32x4*)(gb + c + 4);
#pragma unroll
                for (int ai = 0; ai < 2; ++ai)
#pragma unroll
                    for (int m = 0; m < 4; ++m) { const int row = row0 + ai * 128 + m * 16; f32x4 v0 = acc[ai][bj][m][0] + b0, v1 = acc[ai][bj][m][1] + b1;
#pragma unroll
                        for (int i = 0; i < 4; ++i) { v0[i] = (fminf(v0[i], 0.f) - log1pf(__expf(-fabsf(v0[i])))) * 0.0625f; v1[i] = (fminf(v1[i], 0.f) - log1pf(__expf(-fabsf(v1[i])))) * 0.0625f; }
                        float* o = LA + (size_t)row * 256 + c; *(f32x4*)o = v0; *(f32x4*)(o + 4) = v1; } }
        } else if (u.pn == 6 || u.pn == 7) {
#pragma unroll
            for (int ai = 0; ai < 2; ++ai)
#pragma unroll
                for (int m = 0; m < 4; ++m) { const int row = row0 + ai * 128 + m * 16; const int pidx = (row < 256) ? row : 64 + ((row - 256) & (SEQ - 1));
#pragma unroll
                    for (int bj = 0; bj < 2; ++bj) { const int c = cb0 + 128 * bj, d0 = (c & 63) >> 1;
                        const f32x4 cs0 = *(const f32x4*)(rope + (size_t)pidx * 32 + d0), cs1 = *(const f32x4*)(rope + (size_t)pidx * 32 + d0 + 2);
                        const f32x4 t1 = acc[ai][bj][m][0], t2 = acc[ai][bj][m][1];
                        const float co[4] = {cs0[0], cs0[2], cs1[0], cs1[2]}, si[4] = {cs0[1], cs0[3], cs1[1], cs1[3]};
                        float o1[4], o2[4];
#pragma unroll
                        for (int i = 0; i < 4; ++i) { o1[i] = t1[i] * co[i] - t2[i] * si[i]; o2[i] = t1[i] * si[i] + t2[i] * co[i]; }
                        u32x4 w; w.x = pg8::cvt_pk_bf16(o1[0], o1[1]); w.y = pg8::cvt_pk_bf16(o1[2], o1[3]); w.z = pg8::cvt_pk_bf16(o2[0], o2[1]); w.w = pg8::cvt_pk_bf16(o2[2], o2[3]);
                        *(u32x4*)(PROJ + (size_t)row * NPROJ + u.pn * 256 + c) = w; } }
        } else {
#pragma unroll
            for (int ai = 0; ai < 2; ++ai)
#pragma unroll
                for (int m = 0; m < 4; ++m) { bf16_t* rowp = PROJ + (size_t)(row0 + ai * 128 + m * 16) * NPROJ + u.pn * 256 + cb0;
#pragma unroll
                    for (int bj = 0; bj < 2; ++bj) { const f32x4 v0 = acc[ai][bj][m][0], v1 = acc[ai][bj][m][1];
                        u32x4 w; w.x = pg8::cvt_pk_bf16(v0[0], v0[1]); w.y = pg8::cvt_pk_bf16(v0[2], v0[3]); w.z = pg8::cvt_pk_bf16(v1[0], v1[1]); w.w = pg8::cvt_pk_bf16(v1[2], v1[3]);
                        *(u32x4*)(rowp + bj * 128) = w; } }
        }
    }
};
struct EpiRes {
    static constexpr bool PERM = true, AFTER_DRAIN = false;
    const float* x; bf16_t* HB; float* SSQ;
    __device__ __forceinline__ void operator()(const pg8::f32x4 (&acc)[2][2][4][2], const pg8::Unit& u, int wr, int wc, int fr, int fq) const {
        const int row0 = u.pm * 256 + wr * 64 + fr, col0 = u.pn * 256 + wc * 32 + 8 * fq;
#pragma unroll
        for (int ai = 0; ai < 2; ++ai)
#pragma unroll
            for (int m = 0; m < 4; ++m) { const int row = row0 + ai * 128 + m * 16; const float* xr = x + (size_t)row * DM + col0; bf16_t* hr = HB + (size_t)row * DM + col0; float ss = 0.f;
#pragma unroll
                for (int bj = 0; bj < 2; ++bj) { const f32x4 v0 = acc[ai][bj][m][0] + *(const f32x4*)(xr + bj * 128), v1 = acc[ai][bj][m][1] + *(const f32x4*)(xr + bj * 128 + 4);
                    ss += (v0[0] * v0[0] + v0[1] * v0[1]) + (v0[2] * v0[2] + v0[3] * v0[3]) + (v1[0] * v1[0] + v1[1] * v1[1]) + (v1[2] * v1[2] + v1[3] * v1[3]);
                    u32x4 w; w.x = pg8::cvt_pk_bf16(v0[0], v0[1]); w.y = pg8::cvt_pk_bf16(v0[2], v0[3]); w.z = pg8::cvt_pk_bf16(v1[0], v1[1]); w.w = pg8::cvt_pk_bf16(v1[2], v1[3]);
                    *(u32x4*)(hr + bj * 128) = w; }
                ss += __shfl_xor(ss, 16); ss += __shfl_xor(ss, 32);
                if (fq == 0) SSQ[(size_t)row * 16 + u.pn * 4 + wc] = ss; }
    }
};
struct EpiF16 {
    static constexpr bool PERM = true, AFTER_DRAIN = false;
    _Float16* SC;
    __device__ __forceinline__ void operator()(const pg8::f32x4 (&acc)[2][2][4][2], const pg8::Unit& u, int wr, int wc, int fr, int fq) const {
        const int row0 = u.pm * 256 + wr * 64 + fr, col0 = u.pn * 256 + wc * 32 + 8 * fq;
#pragma unroll
        for (int ai = 0; ai < 2; ++ai)
#pragma unroll
            for (int m = 0; m < 4; ++m) { _Float16* rowp = SC + (size_t)(row0 + ai * 128 + m * 16) * 2048 + col0;
#pragma unroll
                for (int bj = 0; bj < 2; ++bj) { const f32x4 v0 = acc[ai][bj][m][0], v1 = acc[ai][bj][m][1];
                    u32x4 w;
                    w.x = __builtin_bit_cast(unsigned, (f16x2_t){(_Float16)v0[0], (_Float16)v0[1]}); w.y = __builtin_bit_cast(unsigned, (f16x2_t){(_Float16)v0[2], (_Float16)v0[3]});
                    w.z = __builtin_bit_cast(unsigned, (f16x2_t){(_Float16)v1[0], (_Float16)v1[1]}); w.w = __builtin_bit_cast(unsigned, (f16x2_t){(_Float16)v1[2], (_Float16)v1[3]});
                    *(u32x4*)(rowp + bj * 128) = w; } }
    }
};

constexpr int A_QT = 0, A_KT = 9216, A_KE = 18432, A_V = 27648, A_ST = 45056, A_STSZ = 18432, A_OB = 81920, A_DEC = 115712, A_CS = 115968;
constexpr int PQ = 72, PV = 136, POB = 132;

__device__ __forceinline__ bf16x8 tr2(const LAS bf16_t* p0, const LAS bf16_t* p1) {
    const s16x4 a = __builtin_amdgcn_ds_read_tr16_b64_v4i16((LAS s16x4*)p0), b = __builtin_amdgcn_ds_read_tr16_b64_v4i16((LAS s16x4*)p1);
    return (bf16x8){a[0], a[1], a[2], a[3], b[0], b[1], b[2], b[3]};
}
__device__ __forceinline__ float ln_gamma(int hr) { return log1pf(-exp2f(-5.0f - (float)hr)); }

template <bool FULL>
__device__ __forceinline__ void attn_pass(const Params& p, LAS unsigned char* lds, int bid, int nb) {
    const int tid = threadIdx.x, lane = tid & 63, wave = __builtin_amdgcn_readfirstlane(tid >> 6);
    const int r16 = lane & 15, g4 = lane >> 4, q4 = (lane & 15) >> 2, p4 = lane & 3;
    unsigned char* ws = p.ws;
    const bf16_t* PROJ = (const bf16_t*)(ws + WS_PROJ); const float* LA = (const float*)(ws + WS_LA);
    float* SEG = (float*)(ws + WS_SEG); float* ASEG = (float*)(ws + WS_ASEG); bf16_t* OUT = (bf16_t*)(ws + WS_O);
    LAS bf16_t* QT = (LAS bf16_t*)(lds + A_QT); LAS bf16_t* KT = (LAS bf16_t*)(lds + A_KT); LAS bf16_t* KE = (LAS bf16_t*)(lds + A_KE); LAS bf16_t* VS = (LAS bf16_t*)(lds + A_V);
    LAS float* OB = (LAS float*)(lds + A_OB); LAS float* DEC = (LAS float*)(lds + A_DEC); LAS float* CS = (LAS float*)(lds + A_CS);

    for (int item = bid; item < 256; item += nb) {
        const int seg = item & 7, h8 = (item >> 3) & 7, b = item >> 6;
        if (!FULL && seg == 7) continue;
        const bool gla = h8 < 4; const int hr = h8 & 3;
        const float lng = ln_gamma(hr);
        const int qcol = gla ? C_GQ + hr * 64 : C_RQ + hr * 64, kcol = gla ? C_GK + hr * 64 : C_RK + hr * 64;
        const int vcol = gla ? C_GV + hr * 128 : C_RV + hr * 128, gcol = gla ? C_GG + hr * 128 : C_RG + hr * 128;
        const int nch = (seg == 0) ? 17 : 16;

        f32x4 accS[8];
#pragma unroll
        for (int cb = 0; cb < 8; ++cb) accS[cb] = (f32x4){0.f, 0.f, 0.f, 0.f};
        float blsum = 0.f;
        __syncthreads();
        if (FULL) {
            if (wave >= 4) {
                const int wq = wave - 4;
                for (int sp = 0; sp < seg; ++sp) { const int it2 = (item & ~7) + sp; const float* Sg = SEG + (size_t)it2 * 8192; const float* Ag = ASEG + it2 * 64;
                    float dec[4];
#pragma unroll
                    for (int rg = 0; rg < 4; ++rg) dec[rg] = Ag[16 * wq + 4 * g4 + rg];
#pragma unroll
                    for (int cb = 0; cb < 8; ++cb)
#pragma unroll
                        for (int rg = 0; rg < 4; ++rg) accS[cb][rg] = dec[rg] * accS[cb][rg] + Sg[(16 * wq + 4 * g4 + rg) * 128 + 16 * cb + r16]; }
                LAS bf16_t* ST0 = (LAS bf16_t*)(lds + A_ST);
#pragma unroll
                for (int cb = 0; cb < 8; ++cb) { u32x2 w; w.x = pk2(accS[cb][0], accS[cb][1]); w.y = pk2(accS[cb][2], accS[cb][3]); *(LAS u32x2*)(ST0 + (16 * cb + r16) * PQ + 16 * wq + 4 * g4) = w; }
            }
        }
        for (int ci = 0; ci < nch; ++ci) {
            const bool metac = (seg == 0 && ci == 0);
            const int rc = (seg == 0) ? ci - 1 : 16 * seg + ci;
            const int rowbase = metac ? 0 : 256 + b * SEQ + rc * 64;
            const LAS bf16_t* STr = (const LAS bf16_t*)(lds + A_ST + (ci & 1) * A_STSZ); LAS bf16_t* STw = (LAS bf16_t*)(lds + A_ST + ((ci + 1) & 1) * A_STSZ);
            const int d = tid & 63, sg = tid >> 6;
            float pre[8]; bf16_t qv[8], kv[8];
            {
                float run = 0.f;
#pragma unroll
                for (int k = 0; k < 8; ++k) { const size_t row = (size_t)(rowbase + 8 * sg + k);
                    const float la = gla ? LA[row * 256 + hr * 64 + d] : lng; run += la; pre[k] = run;
                    if (FULL) qv[k] = PROJ[row * NPROJ + qcol + d];
                    kv[k] = PROJ[row * NPROJ + kcol + d]; }
                CS[sg * 64 + d] = run;
            }
            u32x4 vreg[2];
            { const int vr = tid >> 3, cc = tid & 7; const u32x4* src = (const u32x4*)(PROJ + (size_t)(rowbase + vr) * NPROJ + vcol + cc * 16); vreg[0] = src[0]; vreg[1] = src[1]; }
            __syncthreads();
            {
                float off = 0.f, tot = 0.f;
#pragma unroll
                for (int s = 0; s < 8; ++s) { const float c = CS[s * 64 + d]; tot += c; off += (s < sg) ? c : 0.f; }
#pragma unroll
                for (int k = 0; k < 8; ++k) { const float bc = off + pre[k]; const int i = 8 * sg + k; const float kf = bf1(kv[k]);
                    if (FULL) { QT[i * PQ + d] = (bf16_t)f2bf(bf1(qv[k]) * __expf(bc)); KT[i * PQ + d] = (bf16_t)f2bf(kf * __expf(-bc)); }
                    KE[i * PQ + d] = (bf16_t)f2bf(kf * __expf(tot - bc)); }
                if (sg == 0) { DEC[d] = __expf(tot); blsum += tot; }
                const int vr = tid >> 3, cc = tid & 7; LAS u32x4* dst = (LAS u32x4*)(VS + vr * PV + cc * 16); dst[0] = vreg[0]; dst[1] = vreg[1];
            }
            __syncthreads();
            if (wave < 4) {
                if (FULL && !metac) {
                    const int w = wave;
                    bf16x8 qf[2];
#pragma unroll
                    for (int s = 0; s < 2; ++s) qf[s] = *(const LAS bf16x8*)(QT + (16 * w + r16) * PQ + 32 * s + 8 * g4);
                    f32x4 att[4];
#pragma unroll
                    for (int jb = 0; jb < 4; ++jb) { att[jb] = (f32x4){0.f, 0.f, 0.f, 0.f};
                        if (jb <= w) {
#pragma unroll
                            for (int s = 0; s < 2; ++s) { const bf16x8 kf = *(const LAS bf16x8*)(KT + (16 * jb + r16) * PQ + 32 * s + 8 * g4);
                                att[jb] = __builtin_amdgcn_mfma_f32_16x16x32_bf16(kf, qf[s], att[jb], 0, 0, 0); }
                            if (jb == w) {
#pragma unroll
                                for (int rg = 0; rg < 4; ++rg) att[jb][rg] = (4 * g4 + rg <= r16) ? att[jb][rg] : 0.f;
                            }
                        } }
                    bf16x8 af[2];
#pragma unroll
                    for (int s = 0; s < 2; ++s) { u32x4 t; t.x = pk2(att[2 * s][0], att[2 * s][1]); t.y = pk2(att[2 * s][2], att[2 * s][3]); t.z = pk2(att[2 * s + 1][0], att[2 * s + 1][1]); t.w = pk2(att[2 * s + 1][2], att[2 * s + 1][3]);
                        af[s] = __builtin_bit_cast(bf16x8, t); }
#pragma unroll
                    for (int cb = 0; cb < 8; ++cb) { f32x4 o = (f32x4){0.f, 0.f, 0.f, 0.f};
#pragma unroll
                        for (int s = 0; s < 2; ++s) {
                            const bf16x8 vf = tr2(VS + (32 * s + 4 * g4 + q4) * PV + 16 * cb + 4 * p4, VS + (32 * s + 16 + 4 * g4 + q4) * PV + 16 * cb + 4 * p4);
                            o = __builtin_amdgcn_mfma_f32_16x16x32_bf16(af[s], vf, o, 0, 0, 0);
                            const bf16x8 sf = *(const LAS bf16x8*)(STr + (16 * cb + r16) * PQ + 32 * s + 8 * g4);
                            o = __builtin_amdgcn_mfma_f32_16x16x32_bf16(qf[s], sf, o, 0, 0, 0); }
#pragma unroll
                        for (int rg = 0; rg < 4; ++rg) OB[(16 * w + 4 * g4 + rg) * POB + 16 * cb + r16] = o[rg]; }
                }
            } else {
                const int wq = wave - 4;
                float dec[4];
#pragma unroll
                for (int rg = 0; rg < 4; ++rg) dec[rg] = DEC[16 * wq + 4 * g4 + rg];
                bf16x8 kef[2];
#pragma unroll
                for (int s = 0; s < 2; ++s) kef[s] = tr2(KE + (32 * s + 8 * g4 + q4) * PQ + 16 * wq + 4 * p4, KE + (32 * s + 8 * g4 + 4 + q4) * PQ + 16 * wq + 4 * p4);
#pragma unroll
                for (int cb = 0; cb < 8; ++cb) {
#pragma unroll
                    for (int rg = 0; rg < 4; ++rg) accS[cb][rg] *= dec[rg];
#pragma unroll
                    for (int s = 0; s < 2; ++s) { const bf16x8 vf = tr2(VS + (32 * s + 8 * g4 + q4) * PV + 16 * cb + 4 * p4, VS + (32 * s + 8 * g4 + 4 + q4) * PV + 16 * cb + 4 * p4);
                        accS[cb] = __builtin_amdgcn_mfma_f32_16x16x32_bf16(kef[s], vf, accS[cb], 0, 0, 0); }
                    if (FULL) { u32x2 w; w.x = pk2(accS[cb][0], accS[cb][1]); w.y = pk2(accS[cb][2], accS[cb][3]); *(LAS u32x2*)(STw + (16 * cb + r16) * PQ + 16 * wq + 4 * g4) = w; }
                }
            }
            __syncthreads();
            if (FULL && !metac) {
                const int i = tid >> 3, cc = tid & 7;
                float o[16];
#pragma unroll
                for (int k4 = 0; k4 < 4; ++k4) { const f32x4 t = *(const LAS f32x4*)(OB + i * POB + 16 * cc + 4 * k4); o[4 * k4] = t[0]; o[4 * k4 + 1] = t[1]; o[4 * k4 + 2] = t[2]; o[4 * k4 + 3] = t[3]; }
                const size_t row = (size_t)(rowbase + i);
                const u32x4* gp = (const u32x4*)(PROJ + row * NPROJ + gcol + 16 * cc); const u32x4 ga = gp[0], gb2 = gp[1];
                const unsigned gw[8] = {ga.x, ga.y, ga.z, ga.w, gb2.x, gb2.y, gb2.z, gb2.w};
                float s1 = 0.f, s2 = 0.f;
#pragma unroll
                for (int k = 0; k < 16; ++k) { s1 += o[k]; s2 += o[k] * o[k]; }
#pragma unroll
                for (int m = 1; m < 8; m <<= 1) { s1 += __shfl_xor(s1, m); s2 += __shfl_xor(s2, m); }
                float mu, rs;
                if (gla) { mu = 0.f; rs = 1.0f / sqrtf(s2 * (1.0f / 128.0f) + EPS); }
                else { mu = s1 * (1.0f / 128.0f); const float var = fmaxf(s2 * (1.0f / 128.0f) - mu * mu, 0.f); rs = 1.0f / sqrtf(var + EPS); }
                const float* gn = (gla ? p.gla_gain : p.ret_gain) + 16 * cc; const float* bs = p.ret_bias + 16 * cc;
                unsigned ow[8];
#pragma unroll
                for (int k2 = 0; k2 < 8; ++k2) { float y[2];
#pragma unroll
                    for (int e = 0; e < 2; ++e) { const int k = 2 * k2 + e; float v = (o[k] - mu) * rs * gn[k]; if (!gla) v += bs[k];
                        const float gt = e ? bf_hi(gw[k2]) : bf_lo(gw[k2]); y[e] = v * gt / (1.0f + __expf(-gt)); }
                    ow[k2] = pk2(y[0], y[1]); }
                u32x4* op = (u32x4*)(OUT + (row - 256) * DM + h8 * 128 + 16 * cc);
                op[0] = (u32x4){ow[0], ow[1], ow[2], ow[3]}; op[1] = (u32x4){ow[4], ow[5], ow[6], ow[7]};
            }
        }
        if (!FULL) {
            if (wave >= 4) { const int wq = wave - 4; float* Sg = SEG + (size_t)item * 8192;
#pragma unroll
                for (int cb = 0; cb < 8; ++cb)
#pragma unroll
                    for (int rg = 0; rg < 4; ++rg) Sg[(16 * wq + 4 * g4 + rg) * 128 + 16 * cb + r16] = accS[cb][rg]; }
            if (tid < 64) ASEG[item * 64 + tid] = __expf(blsum);
        }
    }
}

__device__ __forceinline__ unsigned ord32(float f) { const unsigned b = __builtin_bit_cast(unsigned, f); return b ^ ((b >> 31) ? 0xffffffffu : 0x80000000u); }
__device__ __forceinline__ float unord32(unsigned o) { const unsigned b = (o >> 31) ? (o ^ 0x80000000u) : ~o; return __builtin_bit_cast(float, b); }
#define DPP_MAXU(v, ctrl, rmask) do { const unsigned _t = (unsigned)__builtin_amdgcn_update_dpp((int)(v), (int)(v), (ctrl), (rmask), 0xf, false); (v) = (v) > _t ? (v) : _t; } while (0)
#define DPP_ADDF(v, ctrl) do { const float _t = __builtin_bit_cast(float, __builtin_amdgcn_update_dpp(0, __builtin_bit_cast(int, (v)), (ctrl), 0xf, 0xf, false)); (v) += _t; } while (0)
__device__ __forceinline__ unsigned row_max_u(unsigned v) { DPP_MAXU(v, 0xB1, 0xf); DPP_MAXU(v, 0x4E, 0xf); DPP_MAXU(v, 0x124, 0xf); DPP_MAXU(v, 0x128, 0xf); return v; }
__device__ __forceinline__ float row_sum_f(float v) { DPP_ADDF(v, 0xB1); DPP_ADDF(v, 0x4E); DPP_ADDF(v, 0x124); DPP_ADDF(v, 0x128); return v; }
__device__ __forceinline__ unsigned wave_max_u(unsigned v) { v = row_max_u(v); DPP_MAXU(v, 0x142, 0xa); DPP_MAXU(v, 0x143, 0xc); return (unsigned)__builtin_amdgcn_readlane((int)v, 63); }

__device__ __forceinline__ float row_sum_x(float v) { return row_sum_f(v); }
__device__ __forceinline__ float dot2_bf16(unsigned w, unsigned x, float acc) { return __builtin_amdgcn_fdot2_f32_bf16(__builtin_bit_cast(bf16x2_t, w), __builtin_bit_cast(bf16x2_t, x), acc, false); }
__device__ __forceinline__ float gelu_exact(float v) { return 0.5f * v * (1.0f + erff(v * 0.70710678118654752f)); }

__device__ __forceinline__ void phase_peer(const Params& p, LAS unsigned char* lds, int bid, int nb) {
    const int tid = threadIdx.x, lane = tid & 63, wave = __builtin_amdgcn_readfirstlane(tid >> 6);
    const int p16 = lane & 15, rg4 = lane >> 4;
    unsigned char* ws = p.ws;
    const _Float16* SC = (const _Float16*)(ws + WS_PROJ); const bf16_t* HB = (const bf16_t*)(ws + WS_XN); const float* SSQ = (const float*)(ws + WS_SSQ);
    const unsigned char* UB = (const unsigned char*)(ws + WS_UB); const unsigned char* VB = (const unsigned char*)(ws + WS_VB);
    LAS float* A_s = (LAS float*)(lds + wave * 4096);
    LAS int* A_i = (LAS int*)(lds + wave * 4096 + 1024);
    LAS int* E_i = (LAS int*)(lds + wave * 4096 + 2048);
    LAS float* E_s = (LAS float*)(lds + wave * 4096 + 2560);
    int ci = 0, cj = 0; bool cvalid = lane < 50;
    { int l = lane;
      if (l < 16) { ci = 0; cj = l; } else if (l < 24) { ci = 1; cj = l - 16; } else if (l < 29) { ci = 2; cj = l - 24; } else if (l < 33) { ci = 3; cj = l - 29; }
      else if (l < 36) { ci = 4; cj = l - 33; } else if (l < 42) { ci = 5 + (l - 36) / 2; cj = (l - 36) & 1; } else { ci = 8 + (l - 42); cj = 0; } if (!cvalid) { ci = 0; cj = 0; } }
    const int gw = bid * 8 + wave, NGW = nb * 8;
    for (int t = gw; t < NTOK; t += NGW) {
        float ssq = (lane < 16) ? SSQ[(size_t)t * 16 + lane] : 0.f; ssq = wave_sum(ssq);
        const float rstd = 1.0f / sqrtf(ssq * (1.0f / DM) + EPS);
#pragma unroll 1
        for (int q = 0; q < 4; ++q) {
            const u32x4 raw = *(const u32x4*)(SC + (size_t)t * 2048 + 512 * q + 8 * lane);
            const unsigned rw[4] = {raw.x, raw.y, raw.z, raw.w};
            unsigned key[8];
#pragma unroll
            for (int e = 0; e < 8; ++e) { const unsigned hbits = (e & 1) ? (rw[e >> 1] >> 16) : (rw[e >> 1] & 0xffffu);
                const float f = (float)__builtin_bit_cast(_Float16, (unsigned short)hbits);
                key[e] = (ord32(f) & ~0x7fu) | (unsigned)(127 - (8 * p16 + e)); }
            unsigned mine = 0u;
#pragma unroll 1
            for (int it = 0; it < 16; ++it) {
                unsigned m = key[0];
#pragma unroll
                for (int e = 1; e < 8; ++e) m = m > key[e] ? m : key[e];
                const unsigned W = row_max_u(m);
                mine = (p16 == it) ? W : mine;
#pragma unroll
                for (int e = 0; e < 8; ++e) key[e] = (key[e] == W) ? 0u : key[e];
            }
            const int g = 4 * q + rg4;
            A_s[g * 16 + p16] = unord32(mine & ~0x7fu); A_i[g * 16 + p16] = 127 - (int)(mine & 0x7fu);
        }
        LDS_WAIT();
#pragma unroll 1
        for (int h = 0; h < 8; ++h) {
            const float sa = A_s[(2 * h) * 16 + ci], sb = A_s[(2 * h + 1) * 16 + cj];
            const int ia = A_i[(2 * h) * 16 + ci], ib = A_i[(2 * h + 1) * 16 + cj];
            const float sum = sa + sb;
            unsigned key = cvalid ? ((ord32(sum) & ~0x3fu) | (unsigned)(63 - lane)) : 0u;
            int rank = -1;
#pragma unroll 1
            for (int it = 0; it < 16; ++it) { const unsigned W = wave_max_u(key); if (key == W) { rank = it; key = 0u; } }
            if (rank >= 0) { E_i[h * 16 + rank] = ia * 128 + ib; E_s[h * 16 + rank] = sum; }
        }
        LDS_WAIT();
        float gsm[2]; int eidx[2];
#pragma unroll
        for (int sl = 0; sl < 2; ++sl) { const int e = lane + 64 * sl; const float s = E_s[e] * rstd, mx = E_s[e & ~15] * rstd; const float pe = __expf(s - mx); const float den = row_sum_x(pe);
            gsm[sl] = pe / den; eidx[sl] = E_i[e]; }
#if PEER_FP8
        f32x2v xf[4][8];
#pragma unroll
        for (int i = 0; i < 4; ++i) { const u32x4 h0 = *(const u32x4*)(HB + (size_t)t * DM + 256 * i + 16 * p16), h1 = *(const u32x4*)(HB + (size_t)t * DM + 256 * i + 16 * p16 + 8);
            const unsigned hv[8] = {h0.x, h0.y, h0.z, h0.w, h1.x, h1.y, h1.z, h1.w}; const float* gp = p.g2 + 256 * i + 16 * p16;
#pragma unroll
            for (int k2 = 0; k2 < 8; ++k2) { const f32x2v g = *(const f32x2v*)(gp + 2 * k2); xf[i][k2] = (f32x2v){bf_lo(hv[k2]) * rstd * g.x, bf_hi(hv[k2]) * rstd * g.y}; } }
        constexpr int NBB = 2;
#define P6_LOADB(buf, TAB, bt0) do { _Pragma("unroll") for (int j = 0; j < NBB; ++j) { const int bt = (bt0) + j; const int ex = E_i[64 * (bt >> 4) + 16 * rg4 + (bt & 15)]; \
            const unsigned char* rp = (TAB) + (size_t)ex * 1024 + 16 * p16; _Pragma("unroll") for (int i = 0; i < 4; ++i) buf[j][i] = *(const u32x4*)(rp + 256 * i); } } while (0)
        u32x4 bA[NBB][4], bB[NBB][4];
        float act0 = 0.f, act1 = 0.f;
#define P6_COMPU(buf, bt0) do { _Pragma("unroll") for (int j = 0; j < NBB; ++j) { const int bt = (bt0) + j; f32x2v s2 = (f32x2v){0.f, 0.f}; \
            _Pragma("unroll") for (int i = 0; i < 4; ++i) { const unsigned uu[4] = {buf[j][i].x, buf[j][i].y, buf[j][i].z, buf[j][i].w}; \
                _Pragma("unroll") for (int w = 0; w < 4; ++w) { const f32x2v lo = __builtin_amdgcn_cvt_pk_f32_fp8((int)uu[w], false), hi = __builtin_amdgcn_cvt_pk_f32_fp8((int)uu[w], true); \
                    s2 = __builtin_elementwise_fma(lo, xf[i][2 * w], s2); s2 = __builtin_elementwise_fma(hi, xf[i][2 * w + 1], s2); } } \
            const float s = row_sum_x(s2.x + s2.y); const bool mine = (p16 == (bt & 15)); act0 = (mine && bt < 16) ? s : act0; act1 = (mine && bt >= 16) ? s : act1; } } while (0)
        P6_LOADB(bA, UB, 0);
#pragma unroll 1
        for (int g = 0; g < 32; g += 2 * NBB) { P6_LOADB(bB, UB, g + NBB); P6_COMPU(bA, g); if (g + 2 * NBB < 32) P6_LOADB(bA, UB, g + 2 * NBB); P6_COMPU(bB, g + NBB); }
        P6_LOADB(bA, VB, 0);
        LAS float* E_c = E_s;
        { const float c0 = gsm[0] * gelu_exact(act0 * (1.0f / 512.0f)) * (1.0f / 32.0f), c1 = gsm[1] * gelu_exact(act1 * (1.0f / 512.0f)) * (1.0f / 32.0f);
          LDS_WAIT(); E_c[lane] = c0; E_c[lane + 64] = c1; LDS_WAIT(); }
        f32x2v acc2[4][8];
#pragma unroll
        for (int i = 0; i < 4; ++i)
#pragma unroll
            for (int k = 0; k < 8; ++k) acc2[i][k] = (f32x2v){0.f, 0.f};
#define P6_COMPV(buf, bt0) do { _Pragma("unroll") for (int j = 0; j < NBB; ++j) { const int bt = (bt0) + j; const float cf = E_c[64 * (bt >> 4) + 16 * rg4 + (bt & 15)]; const f32x2v cf2 = (f32x2v){cf, cf}; \
            _Pragma("unroll") for (int i = 0; i < 4; ++i) { const unsigned vv[4] = {buf[j][i].x, buf[j][i].y, buf[j][i].z, buf[j][i].w}; \
                _Pragma("unroll") for (int w = 0; w < 4; ++w) { const f32x2v lo = __builtin_amdgcn_cvt_pk_f32_fp8((int)vv[w], false), hi = __builtin_amdgcn_cvt_pk_f32_fp8((int)vv[w], true); \
                    acc2[i][2 * w] = __builtin_elementwise_fma(lo, cf2, acc2[i][2 * w]); acc2[i][2 * w + 1] = __builtin_elementwise_fma(hi, cf2, acc2[i][2 * w + 1]); } } } } while (0)
#pragma unroll 1
        for (int g = 0; g < 32; g += 2 * NBB) { P6_LOADB(bB, VB, g + NBB); P6_COMPV(bA, g); if (g + 2 * NBB < 32) P6_LOADB(bA, VB, g + 2 * NBB); P6_COMPV(bB, g + NBB); }
#undef P6_LOADB
#undef P6_COMPU
#undef P6_COMPV
        float ss = 0.f;
#pragma unroll
        for (int i = 0; i < 4; ++i) { const u32x4 h0 = *(const u32x4*)(HB + (size_t)t * DM + 256 * i + 16 * p16), h1 = *(const u32x4*)(HB + (size_t)t * DM + 256 * i + 16 * p16 + 8);
            const unsigned hv[8] = {h0.x, h0.y, h0.z, h0.w, h1.x, h1.y, h1.z, h1.w};
#pragma unroll
            for (int k2 = 0; k2 < 8; ++k2) { float ax = acc2[i][k2].x, ay = acc2[i][k2].y;
                ax += __shfl_xor(ax, 16); ax += __shfl_xor(ax, 32); ay += __shfl_xor(ay, 16); ay += __shfl_xor(ay, 32);
                ax += bf_lo(hv[k2]); ay += bf_hi(hv[k2]); acc2[i][k2] = (f32x2v){ax, ay}; ss += ax * ax + ay * ay; } }
        ss = row_sum_x(ss);
        const float rf = 1.0f / sqrtf(ss * (1.0f / DM) + EPS);
#pragma unroll
        for (int i = 0; i < 4; ++i) { if (i == rg4) { const float* gp = p.gfin + 256 * i + 16 * p16; float* op = p.out + (size_t)t * DM + 256 * i + 16 * p16;
#pragma unroll
                for (int k4 = 0; k4 < 4; ++k4) { const f32x4 g = *(const f32x4*)(gp + 4 * k4);
                    *(f32x4*)(op + 4 * k4) = (f32x4){acc2[i][2 * k4].x * rf * g[0], acc2[i][2 * k4].y * rf * g[1], acc2[i][2 * k4 + 1].x * rf * g[2], acc2[i][2 * k4 + 1].y * rf * g[3]}; } } }
#else
        unsigned xp[8][4];
#pragma unroll
        for (int i = 0; i < 8; ++i) { const u32x4 hw = *(const u32x4*)(HB + (size_t)t * DM + 128 * i + 8 * p16); const f32x4 ga = *(const f32x4*)(p.g2 + 128 * i + 8 * p16), gb = *(const f32x4*)(p.g2 + 128 * i + 8 * p16 + 4);
            xp[i][0] = pk2(bf_lo(hw.x) * rstd * ga[0], bf_hi(hw.x) * rstd * ga[1]); xp[i][1] = pk2(bf_lo(hw.y) * rstd * ga[2], bf_hi(hw.y) * rstd * ga[3]);
            xp[i][2] = pk2(bf_lo(hw.z) * rstd * gb[0], bf_hi(hw.z) * rstd * gb[1]); xp[i][3] = pk2(bf_lo(hw.w) * rstd * gb[2], bf_hi(hw.w) * rstd * gb[3]); }
        float act[2] = {0.f, 0.f};
#pragma unroll
        for (int sl = 0; sl < 2; ++sl) {
#pragma unroll 2
            for (int b16 = 0; b16 < 16; ++b16) {
                const int e = 64 * sl + 16 * rg4 + b16; const int ex = E_i[e];
                const unsigned char* rowp = UB + (size_t)ex * 2048 + 16 * p16;
                float s = 0.f;
#pragma unroll
                for (int i = 0; i < 8; ++i) { const u32x4 uw = *(const u32x4*)(rowp + 256 * i);
                    s = dot2_bf16(uw.x, xp[i][0], s); s = dot2_bf16(uw.y, xp[i][1], s); s = dot2_bf16(uw.z, xp[i][2], s); s = dot2_bf16(uw.w, xp[i][3], s); }
                s = row_sum_x(s);
                act[sl] = (p16 == b16) ? s : act[sl];
            }
        }
        float coef[2];
#pragma unroll
        for (int sl = 0; sl < 2; ++sl) coef[sl] = gsm[sl] * gelu_exact(act[sl]);
        float acc[8][8];
#pragma unroll
        for (int i = 0; i < 8; ++i)
#pragma unroll
            for (int k = 0; k < 8; ++k) acc[i][k] = 0.f;
#pragma unroll
        for (int sl = 0; sl < 2; ++sl) {
#pragma unroll 2
            for (int b16 = 0; b16 < 16; ++b16) {
                const int srcl = (lane & 48) + b16;
                const float cf = __shfl(coef[sl], srcl); const int ex = __shfl(eidx[sl], srcl);
                const unsigned char* rowp = VB + (size_t)ex * 2048 + 16 * p16;
#pragma unroll
                for (int i = 0; i < 8; ++i) { const u32x4 vw = *(const u32x4*)(rowp + 256 * i);
                    acc[i][0] += cf * bf_lo(vw.x); acc[i][1] += cf * bf_hi(vw.x); acc[i][2] += cf * bf_lo(vw.y); acc[i][3] += cf * bf_hi(vw.y);
                    acc[i][4] += cf * bf_lo(vw.z); acc[i][5] += cf * bf_hi(vw.z); acc[i][6] += cf * bf_lo(vw.w); acc[i][7] += cf * bf_hi(vw.w); }
            }
        }
        float ss = 0.f;
#pragma unroll
        for (int i = 0; i < 8; ++i) { const u32x4 hw = *(const u32x4*)(HB + (size_t)t * DM + 128 * i + 8 * p16); const unsigned hv[4] = {hw.x, hw.y, hw.z, hw.w};
#pragma unroll
            for (int k = 0; k < 8; ++k) { float a = acc[i][k]; a += __shfl_xor(a, 16); a += __shfl_xor(a, 32);
                a += (k & 1) ? bf_hi(hv[k >> 1]) : bf_lo(hv[k >> 1]); acc[i][k] = a; ss += a * a; } }
        ss = row_sum_x(ss);
        const float rf = 1.0f / sqrtf(ss * (1.0f / DM) + EPS);
#pragma unroll
        for (int i = 0; i < 8; ++i) { if ((i >> 1) == rg4) { const f32x4 ga = *(const f32x4*)(p.gfin + 128 * i + 8 * p16), gb = *(const f32x4*)(p.gfin + 128 * i + 8 * p16 + 4);
                float* op = p.out + (size_t)t * DM + 128 * i + 8 * p16;
                *(f32x4*)op = (f32x4){acc[i][0] * rf * ga[0], acc[i][1] * rf * ga[1], acc[i][2] * rf * ga[2], acc[i][3] * rf * ga[3]};
                *(f32x4*)(op + 4) = (f32x4){acc[i][4] * rf * gb[0], acc[i][5] * rf * gb[1], acc[i][6] * rf * gb[2], acc[i][7] * rf * gb[3]}; } }
#endif
        LDS_WAIT();
    }
}


constexpr int NT6 = 8;
constexpr int W6_BYTES = 14336;
__device__ __forceinline__ float dpp_f(float v, int ctrl_dummy);
#define DPPF(v, ctrl) __builtin_bit_cast(float, __builtin_amdgcn_update_dpp(0, __builtin_bit_cast(int, (v)), (ctrl), 0xf, 0xf, false))

__device__ __forceinline__ void phase_peer2(const Params& p, LAS unsigned char* lds, int bid, int nb) {
    const int tid = threadIdx.x, lane = tid & 63, wave = __builtin_amdgcn_readfirstlane(tid >> 6);
    const int p16 = lane & 15, rg4 = lane >> 4, q8 = lane >> 3, p8 = lane & 7;
    const bool b0 = lane & 1, b1 = lane & 2, b2 = lane & 4, c0 = lane & 8, c1 = lane & 16, c2 = lane & 32;
    unsigned char* ws = p.ws;
    const _Float16* SC = (const _Float16*)(ws + WS_PROJ); const bf16_t* HB = (const bf16_t*)(ws + WS_XN); const float* SSQ = (const float*)(ws + WS_SSQ);
    const unsigned char* UB = (const unsigned char*)(ws + WS_UB); const unsigned char* VB = (const unsigned char*)(ws + WS_VB);
    LAS unsigned char* wl = lds + wave * W6_BYTES;
    LAS float* A_s = (LAS float*)(wl);
    LAS int* A_i = (LAS int*)(wl + 1024);
    LAS int* E_i = (LAS int*)(wl + 2048);
    LAS float* E_s = (LAS float*)(wl + 2560);
    LAS unsigned short* E16 = (LAS unsigned short*)(wl + 3072);
    LAS float* GC = (LAS float*)(wl + 5120);
    LAS float* ACT = (LAS float*)(wl + 9216);
    LAS float* RS = (LAS float*)(wl + 13312);
    int ci = 0, cj = 0; bool cvalid = lane < 50;
    { int l = lane;
      if (l < 16) { ci = 0; cj = l; } else if (l < 24) { ci = 1; cj = l - 16; } else if (l < 29) { ci = 2; cj = l - 24; } else if (l < 33) { ci = 3; cj = l - 29; }
      else if (l < 36) { ci = 4; cj = l - 33; } else if (l < 42) { ci = 5 + (l - 36) / 2; cj = (l - 36) & 1; } else { ci = 8 + (l - 42); cj = 0; } if (!cvalid) { ci = 0; cj = 0; } }
    const int gw = bid * 8 + wave, NGW = nb * 8;
#define TOK6(k) min(base + (k) * NGW, NTOK - 1)
    for (int base = gw; base < NTOK; base += NT6 * NGW) {
#pragma unroll 1
        for (int rep_r = 0; rep_r < PROBE_R; ++rep_r)
#pragma unroll 1
        for (int k = 0; k < NT6; ++k) {
            const int t = TOK6(k);
            u32x4 raw[4];
#pragma unroll
            for (int q = 0; q < 4; ++q) raw[q] = *(const u32x4*)(SC + (size_t)t * 2048 + 512 * q + 8 * lane);
            float ssq = (lane < 16) ? SSQ[(size_t)t * 16 + lane] : 0.f; ssq = wave_sum(ssq);
            const float rstd = 1.0f / sqrtf(ssq * (1.0f / DM) + EPS);
#pragma unroll
            for (int qq = 0; qq < 2; ++qq) {
                unsigned ka[2][8];
#pragma unroll
                for (int u = 0; u < 2; ++u) { const u32x4 rv = raw[2 * qq + u]; const unsigned rw[4] = {rv.x, rv.y, rv.z, rv.w};
#pragma unroll
                    for (int e = 0; e < 8; ++e) { const unsigned hbits = (e & 1) ? (rw[e >> 1] >> 16) : (rw[e >> 1] & 0xffffu);
                        const float f = (float)__builtin_bit_cast(_Float16, (unsigned short)hbits);
                        ka[u][e] = (ord32(f) & ~0x7fu) | (unsigned)(127 - (8 * p16 + e)); } }
#define CE6(u, i, j) do { const unsigned _a = ka[u][i], _b = ka[u][j]; ka[u][i] = _a > _b ? _a : _b; ka[u][j] = _a > _b ? _b : _a; } while (0)
#pragma unroll
                for (int u = 0; u < 2; ++u) {
                    CE6(u, 0, 1); CE6(u, 2, 3); CE6(u, 4, 5); CE6(u, 6, 7);
                    CE6(u, 0, 2); CE6(u, 1, 3); CE6(u, 4, 6); CE6(u, 5, 7);
                    CE6(u, 1, 2); CE6(u, 5, 6);
                    CE6(u, 0, 4); CE6(u, 1, 5); CE6(u, 2, 6); CE6(u, 3, 7);
                    CE6(u, 2, 4); CE6(u, 3, 5);
                    CE6(u, 1, 2); CE6(u, 3, 4); CE6(u, 5, 6);
                }
#undef CE6
                unsigned mine[2] = {0u, 0u};
#pragma unroll 1
                for (int it = 0; it < 16; ++it) {
#pragma unroll
                    for (int u = 0; u < 2; ++u) {
                        const unsigned W = row_max_u(ka[u][0]);
                        mine[u] = (p16 == it) ? W : mine[u];
                        const bool win = (ka[u][0] == W);
#pragma unroll
                        for (int e = 0; e < 7; ++e) ka[u][e] = win ? ka[u][e + 1] : ka[u][e];
                        ka[u][7] = win ? 0u : ka[u][7];
                    }
                }
#pragma unroll
                for (int u = 0; u < 2; ++u) { const int g = 4 * (2 * qq + u) + rg4;
                    A_s[g * 16 + p16] = unord32(mine[u] & ~0x7fu); A_i[g * 16 + p16] = 127 - (int)(mine[u] & 0x7fu); }
            }
            LDS_WAIT();
            {
                float av[2], bc[2]; int iav[2], jp[2], hh[2]; unsigned key[2];
#pragma unroll
                for (int u = 0; u < 2; ++u) { hh[u] = 4 * u + rg4; av[u] = A_s[(2 * hh[u]) * 16 + p16]; iav[u] = A_i[(2 * hh[u]) * 16 + p16]; jp[u] = 0; bc[u] = A_s[(2 * hh[u] + 1) * 16];
                    key[u] = (ord32(av[u] + bc[u]) & ~0xfu) | (unsigned)(15 - p16); }
#pragma unroll 1
                for (int it = 0; it < 16; ++it) {
#pragma unroll
                    for (int u = 0; u < 2; ++u) {
                        const unsigned W = row_max_u(key[u]);
                        if (key[u] == W) {
                            E_i[hh[u] * 16 + it] = iav[u] * 128 + A_i[(2 * hh[u] + 1) * 16 + jp[u]]; E_s[hh[u] * 16 + it] = av[u] + bc[u];
                            jp[u] += 1;
                            if (jp[u] < 16) { bc[u] = A_s[(2 * hh[u] + 1) * 16 + jp[u]]; key[u] = (ord32(av[u] + bc[u]) & ~0xfu) | (unsigned)(15 - p16); } else key[u] = 0u;
                        }
                    }
                }
            }
            LDS_WAIT();
#pragma unroll
            for (int sl = 0; sl < 2; ++sl) { const int e = lane + 64 * sl; const float s = E_s[e] * rstd, mx = E_s[e & ~15] * rstd; const float pe = __expf(s - mx); const float den = row_sum_x(pe);
                const int pos = 16 * (e & 7) + (e >> 3);
                GC[k * 128 + pos] = pe / den; E16[k * 128 + pos] = (unsigned short)E_i[e]; }
            if (lane == 0) RS[k] = rstd;
            LDS_WAIT();
        }
#define P6_LOADH(buf, TAB, jj, kk, hh) do { const u32x4 _iv = *(const LAS u32x4*)(E16 + (kk) * 128 + 16 * q8 + 8 * (hh)); const unsigned _iw[4] = {_iv.x, _iv.y, _iv.z, _iv.w}; \
            _Pragma("unroll") for (int c = 0; c < 8; ++c) { const unsigned _idx = (c & 1) ? (_iw[c >> 1] >> 16) : (_iw[c >> 1] & 0xffffu); \
                buf[c] = *(const u32x4*)((TAB) + (((size_t)(jj) * NEXP + _idx) << 7) + 16 * p8); } } while (0)
#define P6_LOADX(hb, jj, kk) do { const bf16_t* _hp = HB + (size_t)TOK6(kk) * DM + 128 * (jj) + 16 * p8; hb[0] = *(const u32x4*)_hp; hb[1] = *(const u32x4*)(_hp + 8); } while (0)
#pragma unroll 1
        for (int rep_u = 0; rep_u < PROBE_U; ++rep_u) {
            for (int k = 0; k < NT6; ++k) { ACT[k * 128 + 2 * lane] = 0.f; ACT[k * 128 + 2 * lane + 1] = 0.f; }
            LDS_WAIT();
            u32x4 bA[8], bB[8], hc[2], hn[2];
            P6_LOADH(bA, UB, 0, 0, 0); P6_LOADX(hc, 0, 0);
#pragma unroll 1
            for (int n = 0; n < 8 * NT6; ++n) {
                const int j = n / NT6, k = n % NT6, n1 = (n + 1 < 8 * NT6) ? n + 1 : n, j1 = n1 / NT6, k1 = n1 % NT6;
                P6_LOADH(bB, UB, j, k, 1);
                P6_LOADX(hn, j1, k1);
                f32x2v xs[8];
                { const float rk = RS[k]; const float* gp = p.g2 + 128 * j + 16 * p8; const unsigned hv[8] = {hc[0].x, hc[0].y, hc[0].z, hc[0].w, hc[1].x, hc[1].y, hc[1].z, hc[1].w};
#pragma unroll
                  for (int k2 = 0; k2 < 8; ++k2) { const f32x2v g = *(const f32x2v*)(gp + 2 * k2); xs[k2] = (f32x2v){bf_lo(hv[k2]) * rk * g.x, bf_hi(hv[k2]) * rk * g.y}; } }
                float s[16];
#define P6_DOT(buf, off) do { _Pragma("unroll") for (int c = 0; c < 8; ++c) { const unsigned uu[4] = {buf[c].x, buf[c].y, buf[c].z, buf[c].w}; f32x2v s2 = (f32x2v){0.f, 0.f}; \
                    _Pragma("unroll") for (int w = 0; w < 4; ++w) { const f32x2v lo = __builtin_amdgcn_cvt_pk_f32_fp8((int)uu[w], false), hi = __builtin_amdgcn_cvt_pk_f32_fp8((int)uu[w], true); \
                        s2 = __builtin_elementwise_fma(lo, xs[2 * w], s2); s2 = __builtin_elementwise_fma(hi, xs[2 * w + 1], s2); } s[(off) + c] = s2.x + s2.y; } } while (0)
                P6_DOT(bA, 0);
                if (n + 1 < 8 * NT6) P6_LOADH(bA, UB, j1, k1, 0);
                P6_DOT(bB, 8);
                float r[8], r2[4], r3[2];
#pragma unroll
                for (int m = 0; m < 8; ++m) { const float keep = b2 ? s[m + 8] : s[m], send = b2 ? s[m] : s[m + 8]; r[m] = keep + DPPF(send, 0x141); }
#pragma unroll
                for (int m = 0; m < 4; ++m) { const float keep = b1 ? r[m + 4] : r[m], send = b1 ? r[m] : r[m + 4]; r2[m] = keep + DPPF(send, 0x4E); }
#pragma unroll
                for (int m = 0; m < 2; ++m) { const float keep = b0 ? r2[m + 2] : r2[m], send = b0 ? r2[m] : r2[m + 2]; r3[m] = keep + DPPF(send, 0xB1); }
                { LAS f32x2v* ap = (LAS f32x2v*)(ACT + k * 128 + 2 * lane); f32x2v a = *ap; a.x += r3[0]; a.y += r3[1]; *ap = a; }
                hc[0] = hn[0]; hc[1] = hn[1];
            }
        }
        LDS_WAIT();
#pragma unroll 1
        for (int k = 0; k < NT6; ++k) { LAS f32x2v* gp = (LAS f32x2v*)(GC + k * 128 + 16 * q8 + 2 * p8); const f32x2v g = *gp; const f32x2v a = *(const LAS f32x2v*)(ACT + k * 128 + 2 * lane);
            *gp = (f32x2v){g.x * gelu_exact(a.x * (1.0f / 512.0f)) * (1.0f / 32.0f), g.y * gelu_exact(a.y * (1.0f / 512.0f)) * (1.0f / 32.0f)}; }
        LDS_WAIT();
#pragma unroll 1
        for (int k = 0; k < NT6; ++k) ACT[k * 64 + lane] = 0.f;
        LDS_WAIT();
#pragma unroll 1
        for (int rep_v = 0; rep_v < PROBE_V; ++rep_v) {
            for (int k = 0; k < NT6; ++k) ACT[k * 64 + lane] = 0.f;
            LDS_WAIT();
            u32x4 bA[8], bB[8];
            P6_LOADH(bA, VB, 0, 0, 0);
#pragma unroll 1
            for (int n = 0; n < 8 * NT6; ++n) {
                const int j = n / NT6, k = n % NT6, n1 = (n + 1 < 8 * NT6) ? n + 1 : n, j1 = n1 / NT6, k1 = n1 % NT6;
                const int t = TOK6(k);
                P6_LOADH(bB, VB, j, k, 1);
                const unsigned hres = *(const unsigned*)(HB + (size_t)t * DM + 128 * j + 16 * p8 + 2 * q8);
                float cf[16];
#pragma unroll
                for (int c4 = 0; c4 < 4; ++c4) { const f32x4 cv = *(const LAS f32x4*)(GC + k * 128 + 16 * q8 + 4 * c4); cf[4 * c4] = cv[0]; cf[4 * c4 + 1] = cv[1]; cf[4 * c4 + 2] = cv[2]; cf[4 * c4 + 3] = cv[3]; }
                f32x2v acc2[8];
#pragma unroll
                for (int w = 0; w < 8; ++w) acc2[w] = (f32x2v){0.f, 0.f};
#define P6_AXPY(buf, off) do { _Pragma("unroll") for (int c = 0; c < 8; ++c) { const unsigned vv[4] = {buf[c].x, buf[c].y, buf[c].z, buf[c].w}; const f32x2v cf2 = (f32x2v){cf[(off) + c], cf[(off) + c]}; \
                    _Pragma("unroll") for (int w = 0; w < 4; ++w) { const f32x2v lo = __builtin_amdgcn_cvt_pk_f32_fp8((int)vv[w], false), hi = __builtin_amdgcn_cvt_pk_f32_fp8((int)vv[w], true); \
                        acc2[2 * w] = __builtin_elementwise_fma(lo, cf2, acc2[2 * w]); acc2[2 * w + 1] = __builtin_elementwise_fma(hi, cf2, acc2[2 * w + 1]); } } } while (0)
                P6_AXPY(bA, 0);
                if (n + 1 < 8 * NT6) P6_LOADH(bA, VB, j1, k1, 0);
                P6_AXPY(bB, 8);
                float v[16];
#pragma unroll
                for (int w = 0; w < 8; ++w) { v[2 * w] = acc2[w].x; v[2 * w + 1] = acc2[w].y; }
                float r[8], r2[4], r3[2];
#pragma unroll
                for (int m = 0; m < 8; ++m) { const float keep = c2 ? v[m + 8] : v[m], send = c2 ? v[m] : v[m + 8]; r[m] = keep + __shfl_xor(send, 32); }
#pragma unroll
                for (int m = 0; m < 4; ++m) { const float keep = c1 ? r[m + 4] : r[m], send = c1 ? r[m] : r[m + 4]; r2[m] = keep + __shfl_xor(send, 16); }
#pragma unroll
                for (int m = 0; m < 2; ++m) { const float keep = c0 ? r2[m + 2] : r2[m], send = c0 ? r2[m] : r2[m + 2]; r3[m] = keep + DPPF(send, 0x128); }
                const float o0 = r3[0] + bf_lo(hres), o1 = r3[1] + bf_hi(hres);
                *(f32x2v*)(p.out + (size_t)t * DM + 128 * j + 16 * p8 + 2 * q8) = (f32x2v){o0, o1};
                ACT[k * 64 + lane] += o0 * o0 + o1 * o1;
                if (j == 7) {
                    LDS_WAIT();
                    const float ss = wave_sum(ACT[k * 64 + lane]);
                    const float rf = 1.0f / sqrtf(ss * (1.0f / DM) + EPS);
                    asm volatile("s_waitcnt vmcnt(0)" ::: "memory");
                    float* op = p.out + (size_t)t * DM + 4 * lane;
#pragma unroll
                    for (int i = 0; i < 4; ++i) { const f32x4 o = *(const f32x4*)(op + 256 * i), g = *(const f32x4*)(p.gfin + 256 * i + 4 * lane); *(f32x4*)(op + 256 * i) = o * rf * g; }
                }
            }
        }
        LDS_WAIT();
    }
#undef P6_LOADH
#undef P6_LOADX
#undef P6_DOT
#undef P6_AXPY
#undef TOK6
}

#define XB_TMO      128
#define XB_XCNT(j)  (256  + 64 * (j))
#define XB_XSUB(j)  (1280 + 64 * (j))
#define XB_XGEN(j)  (2304 + 64 * (j))
#define XB_TOP      3328
#define XB_TOPGEN   3392
#define XCD_BAR_WORDS 3456
#define XB_SPIN_CAP (1u << 18)

__device__ __forceinline__ unsigned xb_ld(unsigned* p)              { return __hip_atomic_load(p, __ATOMIC_RELAXED, __HIP_MEMORY_SCOPE_AGENT); }
__device__ __forceinline__ unsigned xb_add(unsigned* p, unsigned v) { return __hip_atomic_fetch_add(p, v, __ATOMIC_RELAXED, __HIP_MEMORY_SCOPE_AGENT); }
__device__ __forceinline__ unsigned xb_xcc_id() { return (unsigned)__builtin_amdgcn_s_getreg((3 << 11) | 20) & 0xFu; }
#define XB_SPIN(cond, bar) do { unsigned _sp = 0; while (cond) { __builtin_amdgcn_s_sleep(1); \
    if ((++_sp & 255u) == 0u) { if (xb_ld(&(bar)[XB_TMO])) break; if (_sp > XB_SPIN_CAP) { atomicAdd(&(bar)[XB_TMO], 1u); break; } } } } while (0)

struct XcdBarrier {
    unsigned* bar; unsigned x;
    volatile LAS unsigned* st;
};

__device__ __forceinline__ XcdBarrier xcd_barrier_post(unsigned* bar, volatile LAS unsigned* st) {
    XcdBarrier b; b.bar = bar; b.x = xb_xcc_id(); b.st = st;
    if (threadIdx.x == 0) (void)xb_add(&bar[XB_XCNT(b.x)], 1u);
    return b;
}
__device__ __forceinline__ void xcd_barrier_complete(unsigned* bar, unsigned x, unsigned& nloc, unsigned& nx) {
    const unsigned G = gridDim.x * gridDim.y * gridDim.z;
    unsigned sum, cnt, mine, sp = 0u;
    for (;;) {
        sum = 0u; cnt = 0u; mine = 0u;
#pragma unroll
        for (unsigned j = 0; j < 16; ++j) { const unsigned c = xb_ld(&bar[XB_XCNT(j)]); sum += c; cnt += (c > 0u) ? 1u : 0u; mine = (j == x) ? c : mine; }
        if (sum == G) break;
        __builtin_amdgcn_s_sleep(1);
        if ((++sp & 255u) == 0u) { if (xb_ld(&bar[XB_TMO])) break; if (sp > XB_SPIN_CAP) { atomicAdd(&bar[XB_TMO], 1u); break; } }
    }
    nloc = mine > 0u ? mine : 1u; nx = cnt > 0u ? cnt : 1u;
}

__device__ __forceinline__ void xcd_barrier(const XcdBarrier& b) {
    asm volatile("s_waitcnt vmcnt(0)" ::: "memory");
    __syncthreads();
    if (threadIdx.x == 0) {
        unsigned* bar = b.bar;
        __builtin_amdgcn_s_waitcnt(0);
        unsigned nloc = b.st[0], nx = b.st[1];
        if (nloc == 0u) { xcd_barrier_complete(bar, b.x, nloc, nx); b.st[0] = nloc; b.st[1] = nx; }
        const unsigned old = xb_add(&bar[XB_XSUB(b.x)], 1u);
        const unsigned gen = old / nloc;
        if (old + 1u == (gen + 1u) * nloc) {
            __builtin_amdgcn_fence(__ATOMIC_RELEASE, "agent");
            asm volatile("s_waitcnt vmcnt(0)" ::: "memory");
            const unsigned og = xb_add(&bar[XB_TOP], 1u);
            const unsigned tg = og / nx;
            if (og + 1u == (tg + 1u) * nx) xb_add(&bar[XB_TOPGEN], 1u);
            else XB_SPIN(xb_ld(&bar[XB_TOPGEN]) == tg, bar);
            __builtin_amdgcn_fence(__ATOMIC_ACQUIRE, "agent");
            xb_add(&bar[XB_XGEN(b.x)], 1u);
            asm volatile("s_waitcnt vmcnt(0)" ::: "memory");
        } else {
            XB_SPIN(xb_ld(&bar[XB_XGEN(b.x)]) == gen, bar);
            __builtin_amdgcn_fence(__ATOMIC_ACQUIRE, "agent");
            asm volatile("s_waitcnt vmcnt(0)" ::: "memory");
        }
    }
    __syncthreads();
}

__global__ void __launch_bounds__(512, 2) mk_fwd(Params p) {
    extern __shared__ __attribute__((aligned(16))) unsigned char lds_raw[];
    LAS unsigned char* lds = (LAS unsigned char*)lds_raw;
    const int bid = blockIdx.x, nb = gridDim.x;
    unsigned char* ws = p.ws;
#define IN(k) (p.ph_lo <= (k) && (k) < p.ph_hi)
#define SEAM(k) do { if (IN(k) && IN((k) + 1)) { if ((k) == 0) cg::this_grid().sync(); else xcd_barrier(bar); } } while (0)
    if (threadIdx.x < 4) ((volatile LAS unsigned*)(lds + LDS_BYTES - 16))[threadIdx.x] = 0u;
    __syncthreads();
    const XcdBarrier bar = xcd_barrier_post((unsigned*)(ws + WS_CTL) + 4096, (volatile LAS unsigned*)(lds + LDS_BYTES - 16));
    if (IN(0)) phase0(p, lds, bid, nb);
    SEAM(0);
    if (IN(1)) {
        pg8::Gemm g{(const bf16_t*)(ws + WS_XN), (const bf16_t*)(ws + WS_WIN), MROWS, NP1, DM}; pg8::StaticOrder S; S.init(MROWS, NP1, nb, bid);
        EpiProj E{(bf16_t*)(ws + WS_PROJ), (float*)(ws + WS_LA), p.gb, (const float2*)(ws + WS_ROPE)};
        pg8::gemm_phase<EpiProj, pg8::StaticOrder, true, true>(lds, g, S, E);
    }
    SEAM(1);
    if (IN(2)) attn_pass<false>(p, lds, bid, nb);
    SEAM(2);
    if (IN(3)) attn_pass<true>(p, lds, bid, nb);
    SEAM(3);
    if (IN(4)) {
        pg8::Gemm g{(const bf16_t*)(ws + WS_O), (const bf16_t*)(ws + WS_WOUT), NTOK, DM, DM}; pg8::StaticOrder S; S.init(NTOK, DM, nb, bid);
        EpiRes E{p.x, (bf16_t*)(ws + WS_XN), (float*)(ws + WS_SSQ)};
        pg8::gemm_phase<EpiRes, pg8::StaticOrder, true, true>(lds, g, S, E);
    }
    SEAM(4);
    if (IN(5)) {
        pg8::Gemm g{(const bf16_t*)(ws + WS_XN), (const bf16_t*)(ws + WS_WS), NTOK, 2048, DM}; pg8::StaticOrder S; S.init(NTOK, 2048, nb, bid);
        EpiF16 E{(_Float16*)(ws + WS_PROJ)};
        pg8::gemm_phase<EpiF16, pg8::StaticOrder, true, true>(lds, g, S, E);
    }
    SEAM(5);
    if (IN(6)) phase_peer2(p, lds, bid, nb);
#undef IN
#undef SEAM
}

#ifndef MK_FUSED
#define MK_FUSED 1
#endif
extern "C" void kernel_launch(void* const* d_in, const int* in_sizes, int n_in, void* d_out, int out_size, void* d_ws, size_t ws_size, hipStream_t stream) {
    static int grid = 0;
    if (grid == 0) {
        if (n_in != 16 || in_sizes[0] != NTOK * DM || out_size != NTOK * DM || ws_size < WS_END) {
            fprintf(stderr, "kernel_launch: unexpected shapes (n_in %d, in0 %d, out %d, ws %zu); nothing launched\n", n_in, n_in > 0 ? in_sizes[0] : -1, out_size, ws_size); grid = -1; return; }
        int dev = 0, cus = 0, per_cu = 0;
        hipGetDevice(&dev); hipDeviceGetAttribute(&cus, hipDeviceAttributeMultiprocessorCount, dev);
        if (hipFuncSetAttribute((const void*)mk_fwd, hipFuncAttributeMaxDynamicSharedMemorySize, LDS_BYTES) != hipSuccess) { fprintf(stderr, "kernel_launch: hipFuncSetAttribute failed\n"); grid = -1; return; }
        if (hipOccupancyMaxActiveBlocksPerMultiprocessor(&per_cu, (const void*)mk_fwd, 512, LDS_BYTES) != hipSuccess || per_cu < 1) { fprintf(stderr, "kernel_launch: occupancy query failed (%d)\n", per_cu); (void)hipGetLastError(); per_cu = 1; }
        grid = cus * (per_cu < 1 ? 1 : 1);
        fprintf(stderr, "kernel_launch: %d CUs, occupancy %d/CU, grid %d\n", cus, per_cu, grid);
    }
    if (grid < 0) return;
    (void)hipMemsetAsync((char*)d_ws + WS_CTL, 0, 65536, stream);
    Params p{};
    p.x = (const float*)d_in[0]; p.meta = (const float*)d_in[1]; p.g1 = (const float*)d_in[2]; p.w_in = (const float*)d_in[3]; p.gw2 = (const float*)d_in[4]; p.gb = (const float*)d_in[5];
    p.gla_gain = (const float*)d_in[6]; p.ret_gain = (const float*)d_in[7]; p.ret_bias = (const float*)d_in[8]; p.w_out = (const float*)d_in[9]; p.g2 = (const float*)d_in[10];
    p.w_q = (const float*)d_in[11]; p.subkeys = (const float*)d_in[12]; p.pu = (const float*)d_in[13]; p.pv = (const float*)d_in[14]; p.gfin = (const float*)d_in[15];
    p.out = (float*)d_out; p.ws = (unsigned char*)d_ws;
#if MK_FUSED
    p.ph_lo = 0; p.ph_hi = NPHASE;
    void* args[] = {&p};
    hipError_t e = hipLaunchCooperativeKernel((const void*)mk_fwd, dim3(grid), dim3(512), args, LDS_BYTES, stream);
    if (e != hipSuccess) fprintf(stderr, "kernel_launch: cooperative launch failed: %s (grid %d)\n", hipGetErrorString(e), grid);
#else
    { const int order[7] = {0, 1, 2, 3, 4, 5, 6}; for (int i = 0; i < 7; ++i) { p.ph_lo = order[i]; p.ph_hi = order[i] + 1; hipLaunchKernelGGL(mk_fwd, dim3(grid), dim3(512), LDS_BYTES, stream, p); } }
#endif
}
```

```cpp
#include <hip/hip_runtime.h>
#include <hip/hip_cooperative_groups.h>
#include <cstdio>
#include <cstdint>
namespace cg = cooperative_groups;
namespace pg8 {
#define PG8_LAS __attribute__((address_space(3)))
typedef unsigned short bf16_t;
typedef short bf16x8 __attribute__((ext_vector_type(8)));
typedef float f32x4 __attribute__((ext_vector_type(4)));
typedef unsigned u32x4 __attribute__((ext_vector_type(4)));
constexpr int BM = 256, BK = 64, HALF = 128, HTB = HALF * BK * 2  , STAGE_BYTES = 8 * HTB, NXCD = 8, WGM = 8;

__host__ __device__ __forceinline__ int lds_byte(int r, int c) { const int st = (r >> 4) * 2 + (c >> 5), rr = r & 15, cc = c & 31, ob = rr * 64 + cc * 2; return st * 1024 + (ob ^ (((ob >> 9) & 1) << 5)); }
__host__ __device__ __forceinline__ void stage_rc(int b, int& R, int& C) { const int st = b / 1024, sb = b % 1024, swz = sb ^ (((sb >> 9) & 1) << 5); R = (st >> 1) * 16 + swz / 64; C = (st & 1) * 32 + (swz % 64) / 2; }
__host__ __device__ __forceinline__ int perm32(int rho) { const int n = rho >> 4, i = rho & 15; return 8 * (i >> 2) + 4 * n + (i & 3); }

struct Unit { int pm, pn; };
struct Gemm { const bf16_t* A; const bf16_t* Bt; int M, N, K; };

struct StaticOrder {
    int nM, nN, nwg, G, c;
    __host__ __device__ void init(int M, int N, int G_, int c_) { nM = M / BM; nN = N / BM; nwg = nM * nN; G = G_; c = c_; }
    __host__ __device__ bool next(int i, Unit& u) const {
        const long L = (long)i * G + c; if (L >= nwg) return false;
        int wgid = (int)L; { const int q = nwg / NXCD, r = nwg % NXCD, xcd = wgid % NXCD, off = wgid / NXCD; wgid = (xcd < r ? xcd * (q + 1) : r * (q + 1) + (xcd - r) * q) + off; }
        const int nig = WGM * nN, gid = wgid / nig, fm = gid * WGM, gsz = (nM - fm) < WGM ? (nM - fm) : WGM;
        u.pm = fm + ((wgid % nig) % gsz); u.pn = (wgid % nig) / gsz; return true;
    }
    __device__ __forceinline__ void a_ready(const Unit&) const {}
    __device__ __forceinline__ void done(const Unit&) const {}
};

__device__ __forceinline__ unsigned cvt_pk_bf16(float lo, float hi) { unsigned r; asm volatile("v_cvt_pk_bf16_f32 %0, %1, %2" : "=v"(r) : "v"(lo), "v"(hi)); return r; }
typedef float f32x2 __attribute__((ext_vector_type(2)));
template <class Epi, class Sched, bool ALIGN_EPI = false, bool SP2 = false>
__device__ __forceinline__ void gemm_phase(PG8_LAS unsigned char* lds, const Gemm g, const Sched& S, const Epi& E) {
    const int tid = threadIdx.x, wid = __builtin_amdgcn_readfirstlane(tid >> 6), lane = tid & 63, wr = wid >> 2, wc = wid & 3, fr = lane & 15, fq = lane >> 4;
    const int K = g.K, nt = K / BK;
    unsigned voffA[2], voffB[2];
#pragma unroll
    for (int i = 0; i < 2; ++i) { int R, C; stage_rc(tid * 16 + i * 8192, R, C); const int Rb = Epi::PERM ? ((R & ~31) + perm32(R & 31)) : R;
        voffA[i] = (unsigned)(R * K + C) * 2u; voffB[i] = (unsigned)(Rb * K + C) * 2u; }
    const size_t kstep = (size_t)(BK * 2);
    const size_t hstep = (size_t)HALF * K * 2;
    const size_t tstep = 2 * hstep;
    const unsigned ldsw = (unsigned)wid * 1024u;
    const int aoff = lds_byte(wr * 64 + fr, fq * 8), boff = lds_byte(wc * 32 + fr, fq * 8);
#define PG8_SA(b, h) (((b) * 2 + (h)) * HTB)
#define PG8_SB(b, h) ((4 + (b) * 2 + (h)) * HTB)
#define PG8_STAGE(bufoff, gbase, voff) do { _Pragma("unroll") for (int _i = 0; _i < 2; ++_i) \
        __builtin_amdgcn_global_load_lds((const unsigned*)((const char*)(gbase) + (voff)[_i]), (PG8_LAS unsigned*)(lds + (bufoff) + ldsw + _i * 8192), 16, 0, 0); } while (0)
#define PG8_LDA(dst, b, h) do { _Pragma("unroll") for (int m = 0; m < 4; ++m) _Pragma("unroll") for (int k = 0; k < 2; ++k) dst[m][k] = *(const PG8_LAS bf16x8*)(lds + PG8_SA(b, h) + aoff + m * 2048 + k * 1024); } while (0)
#define PG8_LDB(dst, b, h) do { _Pragma("unroll") for (int n = 0; n < 2; ++n) _Pragma("unroll") for (int k = 0; k < 2; ++k) dst[n][k] = *(const PG8_LAS bf16x8*)(lds + PG8_SB(b, h) + boff + n * 2048 + k * 1024); } while (0)
#define PG8_MMA(ai, bj, At, Bt) do { __builtin_amdgcn_s_setprio(1); _Pragma("unroll") for (int m = 0; m < 4; ++m) _Pragma("unroll") for (int n = 0; n < 2; ++n) _Pragma("unroll") for (int k = 0; k < 2; ++k) \
        acc[ai][bj][m][n] = __builtin_amdgcn_mfma_f32_16x16x32_bf16(Bt[n][k], At[m][k], acc[ai][bj][m][n], 0, 0, 0); __builtin_amdgcn_s_setprio(0); } while (0)
#define PG8_WAIT_V(n) asm volatile("s_waitcnt vmcnt(" #n ")" ::: "memory")
#define PG8_WAIT_L(n) asm volatile("s_waitcnt lgkmcnt(" #n ")" ::: "memory")
#define PG8_BAR __builtin_amdgcn_s_barrier()
#define PG8_SCHED __builtin_amdgcn_sched_barrier(0)
    Unit cur, nxt; int ui = 0;
    if (!S.next(0, cur)) return;
    f32x4 acc[2][2][4][2];
#pragma unroll
    for (int a = 0; a < 2; ++a)
#pragma unroll
        for (int b = 0; b < 2; ++b)
#pragma unroll
            for (int m = 0; m < 4; ++m)
#pragma unroll
                for (int n = 0; n < 2; ++n) acc[a][b][m][n] = (f32x4){0.f, 0.f, 0.f, 0.f};
    bf16x8 At[4][2], B0[2][2], B1[2][2];
    const char* cA = (const char*)g.A + (size_t)cur.pm * tstep; const char* cB = (const char*)g.Bt + (size_t)cur.pn * tstep;
    S.a_ready(cur);
    if constexpr (SP2) {
        PG8_STAGE(PG8_SB(0, 0), cB, voffB); PG8_STAGE(PG8_SB(0, 1), cB + hstep, voffB); PG8_STAGE(PG8_SA(0, 0), cA, voffA); PG8_STAGE(PG8_SA(0, 1), cA + hstep, voffA);
        if (wr == 1) PG8_BAR;
        PG8_WAIT_V(2); PG8_BAR;
        PG8_STAGE(PG8_SB(1, 0), cB + kstep, voffB); PG8_STAGE(PG8_SA(1, 0), cA + kstep, voffA); PG8_STAGE(PG8_SB(1, 1), cB + hstep + kstep, voffB);
        PG8_WAIT_V(6); PG8_BAR;
    } else {
        PG8_STAGE(PG8_SB(0, 0), cB, voffB); PG8_STAGE(PG8_SA(0, 0), cA, voffA); PG8_STAGE(PG8_SB(0, 1), cB + hstep, voffB); PG8_STAGE(PG8_SA(0, 1), cA + hstep, voffA);
        if (wr == 1) PG8_BAR;
        PG8_WAIT_V(4); PG8_BAR;
        PG8_STAGE(PG8_SB(1, 0), cB + kstep, voffB); PG8_STAGE(PG8_SA(1, 0), cA + kstep, voffA); PG8_STAGE(PG8_SB(1, 1), cB + hstep + kstep, voffB);
        PG8_WAIT_V(6); PG8_BAR;
    }
    for (;;) {
        const bool has_next = S.next(ui + 1, nxt);
        const char* nA = has_next ? (const char*)g.A + (size_t)nxt.pm * tstep : cA; const char* nB = has_next ? (const char*)g.Bt + (size_t)nxt.pn * tstep : cB;
        for (int t = 0; t < nt; t += 2) {
            const bool last = (t == nt - 2);
            const char* a1 = cA + (size_t)(t + 1) * kstep;
            const char* a2 = last ? nA : cA + (size_t)(t + 2) * kstep; const char* b2 = last ? nB : cB + (size_t)(t + 2) * kstep;
            const char* a3 = a2 + kstep; const char* b3 = b2 + kstep;
            if (last && has_next) S.a_ready(nxt);
            if constexpr (SP2) {
            PG8_LDB(B0, 0, 0); PG8_LDB(B1, 0, 1); PG8_SCHED; PG8_LDA(At, 0, 0); PG8_STAGE(PG8_SA(1, 1), a1 + hstep, voffA);
            PG8_WAIT_V(8); PG8_WAIT_L(0); PG8_BAR; PG8_MMA(0, 0, At, B0); PG8_MMA(0, 1, At, B1); PG8_BAR; PG8_SCHED;
            PG8_LDA(At, 0, 1); PG8_STAGE(PG8_SB(0, 0), b2, voffB); PG8_STAGE(PG8_SB(0, 1), b2 + hstep, voffB); PG8_STAGE(PG8_SA(0, 0), a2, voffA);
            PG8_WAIT_V(8); PG8_WAIT_L(0); PG8_BAR; PG8_MMA(1, 0, At, B0); PG8_MMA(1, 1, At, B1); PG8_BAR; PG8_SCHED;
            PG8_LDB(B0, 1, 0); PG8_LDB(B1, 1, 1); PG8_SCHED; PG8_LDA(At, 1, 0); PG8_STAGE(PG8_SA(0, 1), a2 + hstep, voffA);
            PG8_WAIT_V(8); PG8_WAIT_L(0); PG8_BAR; PG8_MMA(0, 0, At, B0); PG8_MMA(0, 1, At, B1); PG8_BAR; PG8_SCHED;
            PG8_LDA(At, 1, 1); PG8_STAGE(PG8_SB(1, 0), b3, voffB); PG8_STAGE(PG8_SB(1, 1), b3 + hstep, voffB); PG8_STAGE(PG8_SA(1, 0), a3, voffA);
            PG8_WAIT_V(8); PG8_WAIT_L(0); PG8_BAR; PG8_MMA(1, 0, At, B0); PG8_MMA(1, 1, At, B1); PG8_BAR; PG8_SCHED;
            } else {
            PG8_LDB(B0, 0, 0); PG8_SCHED; PG8_LDA(At, 0, 0); PG8_STAGE(PG8_SA(1, 1), a1 + hstep, voffA);
            PG8_WAIT_L(8); PG8_BAR; PG8_WAIT_L(0); PG8_MMA(0, 0, At, B0); PG8_BAR; PG8_SCHED;
            PG8_LDB(B1, 0, 1); PG8_STAGE(PG8_SB(0, 0), b2, voffB);
            PG8_BAR; PG8_WAIT_L(0); PG8_MMA(0, 1, At, B1); PG8_BAR;
            PG8_LDA(At, 0, 1); PG8_STAGE(PG8_SA(0, 0), a2, voffA);
            PG8_BAR; PG8_WAIT_L(0); PG8_MMA(1, 0, At, B0); PG8_BAR; PG8_SCHED;
            PG8_STAGE(PG8_SB(0, 1), b2 + hstep, voffB);
            PG8_WAIT_V(6); PG8_BAR; PG8_MMA(1, 1, At, B1); PG8_BAR;
            PG8_LDB(B0, 1, 0); PG8_SCHED; PG8_LDA(At, 1, 0); PG8_STAGE(PG8_SA(0, 1), a2 + hstep, voffA);
            PG8_WAIT_L(8); PG8_BAR; PG8_WAIT_L(0); PG8_MMA(0, 0, At, B0); PG8_BAR; PG8_SCHED;
            PG8_LDB(B1, 1, 1); PG8_STAGE(PG8_SB(1, 0), b3, voffB);
            PG8_BAR; PG8_WAIT_L(0); PG8_MMA(0, 1, At, B1); PG8_BAR;
            PG8_LDA(At, 1, 1); PG8_STAGE(PG8_SA(1, 0), a3, voffA);
            PG8_BAR; PG8_WAIT_L(0); PG8_MMA(1, 0, At, B0); PG8_BAR; PG8_SCHED;
            PG8_STAGE(PG8_SB(1, 1), b3 + hstep, voffB);
            PG8_WAIT_V(6); PG8_BAR; PG8_MMA(1, 1, At, B1); PG8_BAR;
            }
        }
        if constexpr (ALIGN_EPI) { if (wr == 0) PG8_BAR; }
        if constexpr (!Epi::AFTER_DRAIN) { E(acc, cur, wr, wc, fr, fq); S.done(cur); }
        if (!has_next) break;
#pragma unroll
        for (int a = 0; a < 2; ++a)
#pragma unroll
            for (int b = 0; b < 2; ++b)
#pragma unroll
                for (int m = 0; m < 4; ++m)
#pragma unroll
                    for (int n = 0; n < 2; ++n) acc[a][b][m][n] = (f32x4){0.f, 0.f, 0.f, 0.f};
        cur = nxt; cA = nA; cB = nB; ++ui;
        if constexpr (ALIGN_EPI) { if (wr == 1) PG8_BAR; }
    }
    PG8_WAIT_V(0);
    if constexpr (!ALIGN_EPI) { if (wr == 0) PG8_BAR; }
    PG8_BAR;
    if constexpr (Epi::AFTER_DRAIN) { E.fused(acc, cur, wr, wc, fr, fq, lds, wid, lane); S.done(cur); }
#undef PG8_SA
#undef PG8_SB
#undef PG8_STAGE
#undef PG8_LDA
#undef PG8_LDB
#undef PG8_MMA
#undef PG8_WAIT_V
#undef PG8_WAIT_L
#undef PG8_BAR
#undef PG8_SCHED
}
}

#define LAS __attribute__((address_space(3)))
typedef unsigned short bf16_t;
typedef float f32x4 __attribute__((ext_vector_type(4)));
typedef unsigned u32x4 __attribute__((ext_vector_type(4)));
typedef unsigned u32x2 __attribute__((ext_vector_type(2)));
typedef short bf16x8 __attribute__((ext_vector_type(8)));
typedef short s16x4 __attribute__((ext_vector_type(4)));
typedef __bf16 bf16x2_t __attribute__((ext_vector_type(2)));
typedef _Float16 f16x2_t __attribute__((ext_vector_type(2)));
typedef float f32x2v __attribute__((ext_vector_type(2)));

constexpr int DM = 1024, NB = 4, SEQ = 8192, NTOK = NB * SEQ;
constexpr int MROWS = NTOK + 256;
constexpr int INW = 3088;
constexpr int NPROJ = 3072, NP1 = 3328;
constexpr int NEXP = 16384;
constexpr float EPS = 1e-6f;
constexpr int C_GQ = 0, C_GK = 256, C_GV = 512, C_GG = 1024, C_RQ = 1536, C_RK = 1792, C_RV = 2048, C_RG = 2560;
constexpr int S_GA = 1536, S_RQ = 1552, S_RV = 2064;

constexpr size_t MiB = 1u << 20;
constexpr size_t WS_CTL = 0, WS_WIN = 1 * MiB, WS_WOUT = 8 * MiB, WS_WS = 10 * MiB, WS_ROPE = 14 * MiB, WS_SSQ = 17 * MiB, WS_SEG = 19 * MiB, WS_ASEG = 27 * MiB,
                 WS_UB = 28 * MiB, WS_VB = 60 * MiB, WS_XN = 92 * MiB, WS_O = 157 * MiB, WS_LA = 221 * MiB, WS_PROJ = 254 * MiB, WS_END = 448 * MiB;
static_assert(WS_WIN + (size_t)NP1 * DM * 2 <= WS_WOUT && WS_ROPE + (size_t)(SEQ + 64) * 32 * 8 <= WS_SSQ && WS_XN + (size_t)MROWS * DM * 2 <= WS_O &&
              WS_LA + (size_t)MROWS * 256 * 4 <= WS_PROJ && WS_PROJ + (size_t)MROWS * NPROJ * 2 <= WS_END && WS_PROJ + (size_t)NTOK * 2048 * 2 <= WS_END, "ws map");

constexpr int LDS_BYTES = 147456;
constexpr int NPHASE = 7;
#ifndef PROBE_R
#define PROBE_R 1
#define PROBE_U 1
#define PROBE_V 1
#endif
#ifndef PEER_FP8
#define PEER_FP8 1
#endif

struct Params {
    const float *x, *meta, *g1, *w_in, *gw2, *gb, *gla_gain, *ret_gain, *ret_bias, *w_out, *g2, *w_q, *subkeys, *pu, *pv, *gfin;
    float* out; unsigned char* ws;
    int ph_lo, ph_hi;
};

#define LDS_WAIT() asm volatile("s_waitcnt lgkmcnt(0)" ::: "memory")
__device__ __forceinline__ unsigned f2bf(float f) { unsigned u = __builtin_bit_cast(unsigned, f); return (u + 0x7fffu + ((u >> 16) & 1u)) >> 16; }
__device__ __forceinline__ unsigned pk2(float lo, float hi) { return f2bf(lo) | (f2bf(hi) << 16); }
__device__ __forceinline__ float bf_lo(unsigned w) { return __builtin_bit_cast(float, w << 16); }
__device__ __forceinline__ float bf_hi(unsigned w) { return __builtin_bit_cast(float, w & 0xffff0000u); }
__device__ __forceinline__ float bf1(bf16_t h) { return __builtin_bit_cast(float, (unsigned)h << 16); }
__device__ __forceinline__ float wave_sum(float v) {
#pragma unroll
    for (int o = 1; o < 64; o <<= 1) v += __shfl_xor(v, o);
    return v;
}

struct MapIn {
    __device__ __forceinline__ void operator()(int j, int& src, float& sc) const {
        if (j < C_RQ) { src = j; sc = (j < 256) ? 0.125f : 1.0f; }
        else if (j < C_RV) { const int jj = j - C_RQ, which = jj >> 8, within = jj & 255, head = within >> 6, p = within & 63;
            const int a = p >> 3, n = (p >> 2) & 1, i = p & 3; src = S_RQ + which * 256 + head * 64 + 32 * n + 4 * a + i; sc = which ? 0.125f : 1.0f; }
        else { src = S_RV + (j - C_RV); sc = 1.0f; }
    }
};
struct MapId { __device__ __forceinline__ void operator()(int j, int& src, float& sc) const { src = j; sc = 1.0f; } };

template <class Map>
__device__ __forceinline__ void transpose_item(const float* W, int K, int N, bf16_t* WT, LAS float* scr, int item, int nblk, int lane, const Map map) {
    const int kb = item / nblk, nb = item % nblk, k0 = 64 * kb, n0 = 32 * nb;
    int src; float sc; map(n0 + (lane & 31), src, sc);
#pragma unroll 8
    for (int i = 0; i < 32; ++i) { const int kk = 2 * i + (lane >> 5); scr[kk * 33 + (lane & 31)] = W[(size_t)(k0 + kk) * N + src] * sc; }
    LDS_WAIT();
    const int c = lane & 7;
#pragma unroll
    for (int j = 0; j < 4; ++j) { const int n = (lane >> 3) + 8 * j; const LAS float* s = scr + (8 * c) * 33 + n;
        u32x4 o; o.x = pk2(s[0 * 33], s[1 * 33]); o.y = pk2(s[2 * 33], s[3 * 33]); o.z = pk2(s[4 * 33], s[5 * 33]); o.w = pk2(s[6 * 33], s[7 * 33]);
        *(u32x4*)(WT + (size_t)(n0 + n) * K + k0 + 8 * c) = o; }
    LDS_WAIT();
}

__device__ __forceinline__ void phase0(const Params& p, LAS unsigned char* lds, int bid, int nb) {
    const int tid = threadIdx.x, lane = tid & 63, wave = __builtin_amdgcn_readfirstlane(tid >> 6);
    unsigned char* ws = p.ws;
    bf16_t* XN = (bf16_t*)(ws + WS_XN); bf16_t* WinT = (bf16_t*)(ws + WS_WIN); bf16_t* WoutT = (bf16_t*)(ws + WS_WOUT); bf16_t* WsT = (bf16_t*)(ws + WS_WS);
    const int gw = bid * 8 + wave, NGW = nb * 8;
    const int gt = bid * 512 + tid, NGT = nb * 512;

    {
        LAS float* SKT = (LAS float*)lds;
        LAS float* WQT = (LAS float*)(lds + 128 * 132 * 4);
        for (int item = bid; item < 256; item += nb) {
            const int hc = item >> 4, kb = item & 15;
            __syncthreads();
            for (int e = tid; e < 128 * 128; e += 512) { const int n = e >> 7, d = e & 127; SKT[d * 132 + n] = p.subkeys[(size_t)hc * 16384 + e]; }
            for (int e = tid; e < 64 * 128; e += 512) { const int k = e >> 7, d = e & 127; WQT[d * 68 + k] = p.w_q[(size_t)(kb * 64 + k) * 2048 + hc * 128 + d]; }
            __syncthreads();
            const int tn = tid & 31, tk = tid >> 5;
            f32x4 acc[4];
#pragma unroll
            for (int i = 0; i < 4; ++i) acc[i] = (f32x4){0.f, 0.f, 0.f, 0.f};
#pragma unroll 4
            for (int d = 0; d < 128; ++d) {
                const f32x4 sk = *(const LAS f32x4*)(SKT + d * 132 + 4 * tn); const f32x4 wq = *(const LAS f32x4*)(WQT + d * 68 + 4 * tk);
#pragma unroll
                for (int i = 0; i < 4; ++i) acc[i] += sk[i] * wq;
            }
            const f32x4 gg = *(const f32x4*)(p.g2 + kb * 64 + 4 * tk);
#pragma unroll
            for (int i = 0; i < 4; ++i) { const f32x4 v = acc[i] * gg; u32x2 o; o.x = pk2(v[0], v[1]); o.y = pk2(v[2], v[3]);
                *(u32x2*)(WsT + (size_t)(hc * 128 + 4 * tn + i) * DM + kb * 64 + 4 * tk) = o; }
        }
        __syncthreads();
    }
    {
        LAS float* scr = (LAS float*)(lds + wave * 16384);
        constexpr int I_IN = (DM / 64) * (NPROJ / 32), I_OUT = (DM / 64) * (DM / 32);
        for (int it = gw; it < I_IN + I_OUT; it += NGW) {
            if (it < I_IN) transpose_item(p.w_in, DM, INW, WinT, scr, it, NPROJ / 32, lane, MapIn());
            else transpose_item(p.w_out, DM, DM, WoutT, scr, it - I_IN, DM / 32, lane, MapId());
        }
    }
    for (int e = gt; e < 256 * DM; e += NGT) {
        const int n = e >> 10, k = e & 1023; const float* wr = p.w_in + (size_t)k * INW + S_GA; float s = 0.f;
#pragma unroll
        for (int r = 0; r < 16; ++r) s += wr[r] * p.gw2[r * 256 + n];
        WinT[(size_t)(NPROJ + n) * DM + k] = (bf16_t)f2bf(s);
    }
#if PEER_FP8
    {
        u32x4* U8 = (u32x4*)(ws + WS_UB); u32x4* V8 = (u32x4*)(ws + WS_VB);
        for (int e = gt; e < NEXP * DM / 16; e += NGT) {
            const f32x4* us = (const f32x4*)p.pu + 4 * (size_t)e; const f32x4* vs = (const f32x4*)p.pv + 4 * (size_t)e;
            u32x4 wu, wv; unsigned tu[4], tv[4];
            const f32x4* g2s = (const f32x4*)p.g2 + 4 * (e & 63);
#pragma unroll
            for (int j = 0; j < 4; ++j) { const f32x4 a = us[j] * g2s[j] * 512.0f, b = vs[j] * 32.0f;
                int w = __builtin_amdgcn_cvt_pk_fp8_f32(a[0], a[1], 0, false); w = __builtin_amdgcn_cvt_pk_fp8_f32(a[2], a[3], w, true); tu[j] = (unsigned)w;
                int x = __builtin_amdgcn_cvt_pk_fp8_f32(b[0], b[1], 0, false); x = __builtin_amdgcn_cvt_pk_fp8_f32(b[2], b[3], x, true); tv[j] = (unsigned)x; }
            wu = (u32x4){tu[0], tu[1], tu[2], tu[3]}; wv = (u32x4){tv[0], tv[1], tv[2], tv[3]};
            const int row = e >> 6, c16 = e & 63;
            const size_t dst = ((size_t)(c16 >> 3) * NEXP + row) * 8 + (c16 & 7);
            U8[dst] = wu; V8[dst] = wv; }
    }
#else
    {
        u32x2* UB = (u32x2*)(ws + WS_UB); u32x2* VB = (u32x2*)(ws + WS_VB);
        const f32x4* u4 = (const f32x4*)p.pu; const f32x4* v4 = (const f32x4*)p.pv;
        for (int e = gt; e < NEXP * DM / 4; e += NGT) { const f32x4 a = u4[e]; u32x2 o; o.x = pk2(a[0], a[1]); o.y = pk2(a[2], a[3]); UB[e] = o;
            const f32x4 b = v4[e]; u32x2 q; q.x = pk2(b[0], b[1]); q.y = pk2(b[2], b[3]); VB[e] = q; }
    }
#endif
    {
        float2* rope = (float2*)(ws + WS_ROPE);
        for (int e = gt; e < (SEQ + 64) * 32; e += NGT) { const int pi = e >> 5, d = e & 31;
            const float invf = (float)pow(10000.0, -(double)d / 32.0); const float ang = (float)(pi - 48) * invf;
            rope[e] = make_float2((float)cos((double)ang), (float)sin((double)ang)); }
    }
    for (int m = gw; m < MROWS; m += NGW) {
        const float* src = nullptr;
        if (m >= 256) src = p.x + (size_t)(m - 256) * DM; else if (m >= 48 && m < 64) src = p.meta + (size_t)(m - 48) * DM;
        unsigned long long* o8 = (unsigned long long*)(XN + (size_t)m * DM) + lane;
        if (src == nullptr) {
#pragma unroll
            for (int j = 0; j < 4; ++j) o8[64 * j] = 0ull;
        } else {
            const f32x4* xr = (const f32x4*)src + lane; const f32x4* gr = (const f32x4*)p.g1 + lane;
            f32x4 v[4]; float s = 0.f;
#pragma unroll
            for (int j = 0; j < 4; ++j) { v[j] = xr[64 * j]; s += (v[j].x * v[j].x + v[j].y * v[j].y) + (v[j].z * v[j].z + v[j].w * v[j].w); }
            const float r = 1.0f / sqrtf(wave_sum(s) * (1.0f / DM) + EPS);
#pragma unroll
            for (int j = 0; j < 4; ++j) { const f32x4 g = gr[64 * j]; const f32x4 y = v[j] * r * g;
                o8[64 * j] = (unsigned long long)pk2(y.x, y.y) | ((unsigned long long)pk2(y.z, y.w) << 32); }
        }
    }
}

struct EpiProj {
    static constexpr bool PERM = true, AFTER_DRAIN = false;
    bf16_t* PROJ; float* LA; const float* gb; const float2* rope;
    __device__ __forceinline__ void operator()(const pg8::f32x4 (&acc)[2][2][4][2], const pg8::Unit& u, int wr, int wc, int fr, int fq) const {
        const int row0 = u.pm * 256 + wr * 64 + fr, cb0 = wc * 32 + 8 * fq;
        if (u.pn == 12) {
#pragma unroll
            for (int bj = 0; bj < 2; ++bj) { const int c = cb0 + 128 * bj; const f32x4 b0 = *(const f32x4*)(gb + c), b1 = *(const f32x4*)(gb + c + 4);
#pragma unroll
                for (int ai = 0; ai < 2; ++ai)
#pragma unroll
                    for (int m = 0; m < 4; ++m) { const int row = row0 + ai * 128 + m * 16; f32x4 v0 = acc[ai][bj][m][0] + b0, v1 = acc[ai][bj][m][1] + b1;
#pragma unroll
                        for (int i = 0; i < 4; ++i) { v0[i] = (fminf(v0[i], 0.f) - log1pf(__expf(-fabsf(v0[i])))) * 0.0625f; v1[i] = (fminf(v1[i], 0.f) - log1pf(__expf(-fabsf(v1[i])))) * 0.0625f; }
                        float* o = LA + (size_t)row * 256 + c; *(f32x4*)o = v0; *(f32x4*)(o + 4) = v1; } }
        } else if (u.pn == 6 || u.pn == 7) {
#pragma unroll
            for (int ai = 0; ai < 2; ++ai)
#pragma unroll
                for (int m = 0; m < 4; ++m) { const int row = row0 + ai * 128 + m * 16; const int pidx = (row < 256) ? row : 64 + ((row - 256) & (SEQ - 1));
#pragma unroll
                    for (int bj = 0; bj < 2; ++bj) { const int c = cb0 + 128 * bj, d0 = (c & 63) >> 1;
                        const f32x4 cs0 = *(const f32x4*)(rope + (size_t)pidx * 32 + d0), cs1 = *(const f32x4*)(rope + (size_t)pidx * 32 + d0 + 2);
                        const f32x4 t1 = acc[ai][bj][m][0], t2 = acc[ai][bj][m][1];
                        const float co[4] = {cs0[0], cs0[2], cs1[0], cs1[2]}, si[4] = {cs0[1], cs0[3], cs1[1], cs1[3]};
                        float o1[4], o2[4];
#pragma unroll
                        for (int i = 0; i < 4; ++i) { o1[i] = t1[i] * co[i] - t2[i] * si[i]; o2[i] = t1[i] * si[i] + t2[i] * co[i]; }
                        u32x4 w; w.x = pg8::cvt_pk_bf16(o1[0], o1[1]); w.y = pg8::cvt_pk_bf16(o1[2], o1[3]); w.z = pg8::cvt_pk_bf16(o2[0], o2[1]); w.w = pg8::cvt_pk_bf16(o2[2], o2[3]);
                        *(u32x4*)(PROJ + (size_t)row * NPROJ + u.pn * 256 + c) = w; } }
        } else {
#pragma unroll
            for (int ai = 0; ai < 2; ++ai)
#pragma unroll
                for (int m = 0; m < 4; ++m) { bf16_t* rowp = PROJ + (size_t)(row0 + ai * 128 + m * 16) * NPROJ + u.pn * 256 + cb0;
#pragma unroll
                    for (int bj = 0; bj < 2; ++bj) { const f32x4 v0 = acc[ai][bj][m][0], v1 = acc[ai][bj][m][1];
                        u32x4 w; w.x = pg8::cvt_pk_bf16(v0[0], v0[1]); w.y = pg8::cvt_pk_bf16(v0[2], v0[3]); w.z = pg8::cvt_pk_bf16(v1[0], v1[1]); w.w = pg8::cvt_pk_bf16(v1[2], v1[3]);
                        *(u32x4*)(rowp + bj * 128) = w; } }
        }
    }
};
struct EpiRes {
    static constexpr bool PERM = true, AFTER_DRAIN = false;
    const float* x; bf16_t* HB; float* SSQ;
    __device__ __forceinline__ void operator()(const pg8::f32x4 (&acc)[2][2][4][2], const pg8::Unit& u, int wr, int wc, int fr, int fq) const {
        const int row0 = u.pm * 256 + wr * 64 + fr, col0 = u.pn * 256 + wc * 32 + 8 * fq;
#pragma unroll
        for (int ai = 0; ai < 2; ++ai)
#pragma unroll
            for (int m = 0; m < 4; ++m) { const int row = row0 + ai * 128 + m * 16; const float* xr = x + (size_t)row * DM + col0; bf16_t* hr = HB + (size_t)row * DM + col0; float ss = 0.f;
#pragma unroll
                for (int bj = 0; bj < 2; ++bj) { const f32x4 v0 = acc[ai][bj][m][0] + *(const f32x4*)(xr + bj * 128), v1 = acc[ai][bj][m][1] + *(const f32x4*)(xr + bj * 128 + 4);
                    ss += (v0[0] * v0[0] + v0[1] * v0[1]) + (v0[2] * v0[2] + v0[3] * v0[3]) + (v1[0] * v1[0] + v1[1] * v1[1]) + (v1[2] * v1[2] + v1[3] * v1[3]);
                    u32x4 w; w.x = pg8::cvt_pk_bf16(v0[0], v0[1]); w.y = pg8::cvt_pk_bf16(v0[2], v0[3]); w.z = pg8::cvt_pk_bf16(v1[0], v1[1]); w.w = pg8::cvt_pk_bf16(v1[2], v1[3]);
                    *(u32x4*)(hr + bj * 128) = w; }
                ss += __shfl_xor(ss, 16); ss += __shfl_xor(ss, 32);
                if (fq == 0) SSQ[(size_t)row * 16 + u.pn * 4 + wc] = ss; }
    }
};
struct EpiF16 {
    static constexpr bool PERM = true, AFTER_DRAIN = false;
    _Float16* SC;
    __device__ __forceinline__ void operator()(const pg8::f32x4 (&acc)[2][2][4][2], const pg8::Unit& u, int wr, int wc, int fr, int fq) const {
        const int row0 = u.pm * 256 + wr * 64 + fr, col0 = u.pn * 256 + wc * 32 + 8 * fq;
#pragma unroll
        for (int ai = 0; ai < 2; ++ai)
#pragma unroll
            for (int m = 0; m < 4; ++m) { _Float16* rowp = SC + (size_t)(row0 + ai * 128 + m * 16) * 2048 + col0;
#pragma unroll
                for (int bj = 0; bj < 2; ++bj) { const f32x4 v0 = acc[ai][bj][m][0], v1 = acc[ai][bj][m][1];
                    u32x4 w;
                    w.x = __builtin_bit_cast(unsigned, (f16x2_t){(_Float16)v0[0], (_Float16)v0[1]}); w.y = __builtin_bit_cast(unsigned, (f16x2_t){(_Float16)v0[2], (_Float16)v0[3]});
                    w.z = __builtin_bit_cast(unsigned, (f16x2_t){(_Float16)v1[0], (_Float16)v1[1]}); w.w = __builtin_bit_cast(unsigned, (f16x2_t){(_Float16)v1[2], (_Float16)v1[3]});
                    *(u32x4*)(rowp + bj * 128) = w; } }
    }
};

constexpr int A_QT = 0, A_KT = 9216, A_KE = 18432, A_V = 27648, A_ST = 45056, A_STSZ = 18432, A_OB = 81920, A_DEC = 115712, A_CS = 115968;
constexpr int PQ = 72, PV = 136, POB = 132;

__device__ __forceinline__ bf16x8 tr2(const LAS bf16_t* p0, const LAS bf16_t* p1) {
    const s16x4 a = __builtin_amdgcn_ds_read_tr16_b64_v4i16((LAS s16x4*)p0), b = __builtin_amdgcn_ds_read_tr16_b64_v4i16((LAS s16x4*)p1);
    return (bf16x8){a[0], a[1], a[2], a[3], b[0], b[1], b[2], b[3]};
}
__device__ __forceinline__ float ln_gamma(int hr) { return log1pf(-exp2f(-5.0f - (float)hr)); }

template <bool FULL>
__device__ __forceinline__ void attn_pass(const Params& p, LAS unsigned char* lds, int bid, int nb) {
    const int tid = threadIdx.x, lane = tid & 63, wave = __builtin_amdgcn_readfirstlane(tid >> 6);
    const int r16 = lane & 15, g4 = lane >> 4, q4 = (lane & 15) >> 2, p4 = lane & 3;
    unsigned char* ws = p.ws;
    const bf16_t* PROJ = (const bf16_t*)(ws + WS_PROJ); const float* LA = (const float*)(ws + WS_LA);
    float* SEG = (float*)(ws + WS_SEG); float* ASEG = (float*)(ws + WS_ASEG); bf16_t* OUT = (bf16_t*)(ws + WS_O);
    LAS bf16_t* QT = (LAS bf16_t*)(lds + A_QT); LAS bf16_t* KT = (LAS bf16_t*)(lds + A_KT); LAS bf16_t* KE = (LAS bf16_t*)(lds + A_KE); LAS bf16_t* VS = (LAS bf16_t*)(lds + A_V);
    LAS float* OB = (LAS float*)(lds + A_OB); LAS float* DEC = (LAS float*)(lds + A_DEC); LAS float* CS = (LAS float*)(lds + A_CS);

    for (int item = bid; item < 256; item += nb) {
        const int seg = item & 7, h8 = (item >> 3) & 7, b = item >> 6;
        if (!FULL && seg == 7) continue;
        const bool gla = h8 < 4; const int hr = h8 & 3;
        const float lng = ln_gamma(hr);
        const int qcol = gla ? C_GQ + hr * 64 : C_RQ + hr * 64, kcol = gla ? C_GK + hr * 64 : C_RK + hr * 64;
        const int vcol = gla ? C_GV + hr * 128 : C_RV + hr * 128, gcol = gla ? C_GG + hr * 128 : C_RG + hr * 128;
        const int nch = (seg == 0) ? 17 : 16;

        f32x4 accS[8];
#pragma unroll
        for (int cb = 0; cb < 8; ++cb) accS[cb] = (f32x4){0.f, 0.f, 0.f, 0.f};
        float blsum = 0.f;
        __syncthreads();
        if (FULL) {
            if (wave >= 4) {
                const int wq = wave - 4;
                for (int sp = 0; sp < seg; ++sp) { const int it2 = (item & ~7) + sp; const float* Sg = SEG + (size_t)it2 * 8192; const float* Ag = ASEG + it2 * 64;
                    float dec[4];
#pragma unroll
                    for (int rg = 0; rg < 4; ++rg) dec[rg] = Ag[16 * wq + 4 * g4 + rg];
#pragma unroll
                    for (int cb = 0; cb < 8; ++cb)
#pragma unroll
                        for (int rg = 0; rg < 4; ++rg) accS[cb][rg] = dec[rg] * accS[cb][rg] + Sg[(16 * wq + 4 * g4 + rg) * 128 + 16 * cb + r16]; }
                LAS bf16_t* ST0 = (LAS bf16_t*)(lds + A_ST);
#pragma unroll
                for (int cb = 0; cb < 8; ++cb) { u32x2 w; w.x = pk2(accS[cb][0], accS[cb][1]); w.y = pk2(accS[cb][2], accS[cb][3]); *(LAS u32x2*)(ST0 + (16 * cb + r16) * PQ + 16 * wq + 4 * g4) = w; }
            }
        }
#define A_ROWBASE(ci_) (((seg == 0 && (ci_) == 0)) ? 0 : 256 + b * SEQ + ((seg == 0) ? (ci_) - 1 : 16 * seg + (ci_)) * 64)
        const int d = tid & 63, sg = tid >> 6;
        float lav[8]; bf16_t qv[8], kv[8]; u32x4 vreg[2];
#define A_LOADCHUNK(ci_) do { const int _rb = A_ROWBASE(ci_); \
            if (gla) { _Pragma("unroll") for (int k = 0; k < 8; ++k) lav[k] = LA[(size_t)(_rb + 8 * sg + k) * 256 + hr * 64 + d]; } \
            else { _Pragma("unroll") for (int k = 0; k < 8; ++k) lav[k] = lng; } \
            _Pragma("unroll") for (int k = 0; k < 8; ++k) { const size_t row = (size_t)(_rb + 8 * sg + k); \
                if (FULL) qv[k] = PROJ[row * NPROJ + qcol + d]; kv[k] = PROJ[row * NPROJ + kcol + d]; } \
            { const int vr = tid >> 3, cc = tid & 7; const u32x4* src = (const u32x4*)(PROJ + (size_t)(_rb + vr) * NPROJ + vcol + cc * 16); vreg[0] = src[0]; vreg[1] = src[1]; } } while (0)
#define A_LBAR() do { asm volatile("s_waitcnt lgkmcnt(0)" ::: "memory"); __builtin_amdgcn_s_barrier(); asm volatile("" ::: "memory"); } while (0)
        A_LOADCHUNK(0);
        f32x4 gnv[4], bsv[4];
        { const float* gptr = (gla ? p.gla_gain : p.ret_gain) + 16 * (tid & 7); const float* bptr = p.ret_bias + 16 * (tid & 7); const float bsc = gla ? 0.f : 1.f;
#pragma unroll
          for (int k4 = 0; k4 < 4; ++k4) { gnv[k4] = *(const f32x4*)(gptr + 4 * k4); bsv[k4] = *(const f32x4*)(bptr + 4 * k4) * bsc; } }
        for (int ci = 0; ci < nch; ++ci) {
            const bool metac = (seg == 0 && ci == 0);
            const int rowbase = A_ROWBASE(ci);
            const LAS bf16_t* STr = (const LAS bf16_t*)(lds + A_ST + (ci & 1) * A_STSZ); LAS bf16_t* STw = (LAS bf16_t*)(lds + A_ST + ((ci + 1) & 1) * A_STSZ);
            u32x4 gpre[2] = {(u32x4){0u, 0u, 0u, 0u}, (u32x4){0u, 0u, 0u, 0u}};
            if (FULL && !metac) { const u32x4* gp = (const u32x4*)(PROJ + (size_t)(rowbase + (tid >> 3)) * NPROJ + gcol + 16 * (tid & 7)); gpre[0] = gp[0]; gpre[1] = gp[1]; }
            float pre[8];
            {
                float run = 0.f;
#pragma unroll
                for (int k = 0; k < 8; ++k) { run += lav[k]; pre[k] = run; }
                CS[sg * 64 + d] = run;
            }
            A_LBAR();
            {
                float off = 0.f, tot = 0.f;
#pragma unroll
                for (int s = 0; s < 8; ++s) { const float c = CS[s * 64 + d]; tot += c; off += (s < sg) ? c : 0.f; }
#pragma unroll
                for (int k = 0; k < 8; ++k) { const float bc = off + pre[k]; const int i = 8 * sg + k; const float kf = bf1(kv[k]);
                    if (FULL) { QT[i * PQ + d] = (bf16_t)f2bf(bf1(qv[k]) * __expf(bc)); KT[i * PQ + d] = (bf16_t)f2bf(kf * __expf(-bc)); }
                    KE[i * PQ + d] = (bf16_t)f2bf(kf * __expf(tot - bc)); }
                if (sg == 0) { DEC[d] = __expf(tot); blsum += tot; }
                const int vr = tid >> 3, cc = tid & 7; LAS u32x4* dst = (LAS u32x4*)(VS + vr * PV + cc * 16); dst[0] = vreg[0]; dst[1] = vreg[1];
            }
            if (ci + 1 < nch) A_LOADCHUNK(ci + 1);
            A_LBAR();
            if (wave < 4) {
                if (FULL && !metac) {
                    const int w = wave;
                    bf16x8 qf[2];
#pragma unroll
                    for (int s = 0; s < 2; ++s) qf[s] = *(const LAS bf16x8*)(QT + (16 * w + r16) * PQ + 32 * s + 8 * g4);
                    f32x4 att[4];
#pragma unroll
                    for (int jb = 0; jb < 4; ++jb) { att[jb] = (f32x4){0.f, 0.f, 0.f, 0.f};
                        if (jb <= w) {
#pragma unroll
                            for (int s = 0; s < 2; ++s) { const bf16x8 kf = *(const LAS bf16x8*)(KT + (16 * jb + r16) * PQ + 32 * s + 8 * g4);
                                att[jb] = __builtin_amdgcn_mfma_f32_16x16x32_bf16(kf, qf[s], att[jb], 0, 0, 0); }
                            if (jb == w) {
#pragma unroll
                                for (int rg = 0; rg < 4; ++rg) att[jb][rg] = (4 * g4 + rg <= r16) ? att[jb][rg] : 0.f;
                            }
                        } }
                    bf16x8 af[2];
#pragma unroll
                    for (int s = 0; s < 2; ++s) { u32x4 t; t.x = pk2(att[2 * s][0], att[2 * s][1]); t.y = pk2(att[2 * s][2], att[2 * s][3]); t.z = pk2(att[2 * s + 1][0], att[2 * s + 1][1]); t.w = pk2(att[2 * s + 1][2], att[2 * s + 1][3]);
                        af[s] = __builtin_bit_cast(bf16x8, t); }
#pragma unroll
                    for (int cb = 0; cb < 8; ++cb) { f32x4 o = (f32x4){0.f, 0.f, 0.f, 0.f};
#pragma unroll
                        for (int s = 0; s < 2; ++s) {
                            const bf16x8 vf = tr2(VS + (32 * s + 4 * g4 + q4) * PV + 16 * cb + 4 * p4, VS + (32 * s + 16 + 4 * g4 + q4) * PV + 16 * cb + 4 * p4);
                            o = __builtin_amdgcn_mfma_f32_16x16x32_bf16(af[s], vf, o, 0, 0, 0);
                            const bf16x8 sf = *(const LAS bf16x8*)(STr + (16 * cb + r16) * PQ + 32 * s + 8 * g4);
                            o = __builtin_amdgcn_mfma_f32_16x16x32_bf16(qf[s], sf, o, 0, 0, 0); }
#pragma unroll
                        for (int rg = 0; rg < 4; ++rg) OB[(16 * w + 4 * g4 + rg) * POB + 16 * cb + r16] = o[rg]; }
                }
            } else {
                const int wq = wave - 4;
                float dec[4];
#pragma unroll
                for (int rg = 0; rg < 4; ++rg) dec[rg] = DEC[16 * wq + 4 * g4 + rg];
                bf16x8 kef[2];
#pragma unroll
                for (int s = 0; s < 2; ++s) kef[s] = tr2(KE + (32 * s + 8 * g4 + q4) * PQ + 16 * wq + 4 * p4, KE + (32 * s + 8 * g4 + 4 + q4) * PQ + 16 * wq + 4 * p4);
#pragma unroll
                for (int cb = 0; cb < 8; ++cb) {
#pragma unroll
                    for (int rg = 0; rg < 4; ++rg) accS[cb][rg] *= dec[rg];
#pragma unroll
                    for (int s = 0; s < 2; ++s) { const bf16x8 vf = tr2(VS + (32 * s + 8 * g4 + q4) * PV + 16 * cb + 4 * p4, VS + (32 * s + 8 * g4 + 4 + q4) * PV + 16 * cb + 4 * p4);
                        accS[cb] = __builtin_amdgcn_mfma_f32_16x16x32_bf16(kef[s], vf, accS[cb], 0, 0, 0); }
                    if (FULL) { u32x2 w; w.x = pk2(accS[cb][0], accS[cb][1]); w.y = pk2(accS[cb][2], accS[cb][3]); *(LAS u32x2*)(STw + (16 * cb + r16) * PQ + 16 * wq + 4 * g4) = w; }
                }
            }
            A_LBAR();
            if (FULL && !metac) {
                const int i = tid >> 3, cc = tid & 7;
                float o[16];
#pragma unroll
                for (int k4 = 0; k4 < 4; ++k4) { const f32x4 t = *(const LAS f32x4*)(OB + i * POB + 16 * cc + 4 * k4); o[4 * k4] = t[0]; o[4 * k4 + 1] = t[1]; o[4 * k4 + 2] = t[2]; o[4 * k4 + 3] = t[3]; }
                const size_t row = (size_t)(rowbase + i);
                const u32x4 ga = gpre[0], gb2 = gpre[1];
                const unsigned gw[8] = {ga.x, ga.y, ga.z, ga.w, gb2.x, gb2.y, gb2.z, gb2.w};
                float s1 = 0.f, s2 = 0.f;
#pragma unroll
                for (int k = 0; k < 16; ++k) { s1 += o[k]; s2 += o[k] * o[k]; }
#pragma unroll
                for (int m = 1; m < 8; m <<= 1) { s1 += __shfl_xor(s1, m); s2 += __shfl_xor(s2, m); }
                const float mu = gla ? 0.f : s1 * (1.0f / 128.0f);
                const float rs = __builtin_amdgcn_rsqf(fmaxf(s2 * (1.0f / 128.0f) - mu * mu, 0.f) + EPS);
                unsigned ow[8];
#pragma unroll
                for (int k2 = 0; k2 < 8; ++k2) { float y[2];
#pragma unroll
                    for (int e = 0; e < 2; ++e) { const int k = 2 * k2 + e; const float v = (o[k] - mu) * rs * gnv[k >> 2][k & 3] + bsv[k >> 2][k & 3];
                        const float gt = e ? bf_hi(gw[k2]) : bf_lo(gw[k2]); y[e] = v * gt * __builtin_amdgcn_rcpf(1.0f + __expf(-gt)); }
                    ow[k2] = pk2(y[0], y[1]); }
                u32x4* op = (u32x4*)(OUT + (row - 256) * DM + h8 * 128 + 16 * cc);
                op[0] = (u32x4){ow[0], ow[1], ow[2], ow[3]}; op[1] = (u32x4){ow[4], ow[5], ow[6], ow[7]};
            }
        }
        if (!FULL) {
            if (wave >= 4) { const int wq = wave - 4; float* Sg = SEG + (size_t)item * 8192;
#pragma unroll
                for (int cb = 0; cb < 8; ++cb)
#pragma unroll
                    for (int rg = 0; rg < 4; ++rg) Sg[(16 * wq + 4 * g4 + rg) * 128 + 16 * cb + r16] = accS[cb][rg]; }
            if (tid < 64) ASEG[item * 64 + tid] = __expf(blsum);
        }
#undef A_LBAR
#undef A_ROWBASE
#undef A_LOADCHUNK
    }
}

__device__ __forceinline__ unsigned ord32(float f) { const unsigned b = __builtin_bit_cast(unsigned, f); return b ^ ((b >> 31) ? 0xffffffffu : 0x80000000u); }
__device__ __forceinline__ float unord32(unsigned o) { const unsigned b = (o >> 31) ? (o ^ 0x80000000u) : ~o; return __builtin_bit_cast(float, b); }
#define DPP_MAXU(v, ctrl, rmask) do { const unsigned _t = (unsigned)__builtin_amdgcn_update_dpp((int)(v), (int)(v), (ctrl), (rmask), 0xf, false); (v) = (v) > _t ? (v) : _t; } while (0)
#define DPP_ADDF(v, ctrl) do { const float _t = __builtin_bit_cast(float, __builtin_amdgcn_update_dpp(0, __builtin_bit_cast(int, (v)), (ctrl), 0xf, 0xf, false)); (v) += _t; } while (0)
__device__ __forceinline__ unsigned row_max_u(unsigned v) { DPP_MAXU(v, 0xB1, 0xf); DPP_MAXU(v, 0x4E, 0xf); DPP_MAXU(v, 0x124, 0xf); DPP_MAXU(v, 0x128, 0xf); return v; }
__device__ __forceinline__ float row_sum_f(float v) { DPP_ADDF(v, 0xB1); DPP_ADDF(v, 0x4E); DPP_ADDF(v, 0x124); DPP_ADDF(v, 0x128); return v; }
__device__ __forceinline__ unsigned wave_max_u(unsigned v) { v = row_max_u(v); DPP_MAXU(v, 0x142, 0xa); DPP_MAXU(v, 0x143, 0xc); return (unsigned)__builtin_amdgcn_readlane((int)v, 63); }

__device__ __forceinline__ float row_sum_x(float v) { return row_sum_f(v); }
__device__ __forceinline__ float dot2_bf16(unsigned w, unsigned x, float acc) { return __builtin_amdgcn_fdot2_f32_bf16(__builtin_bit_cast(bf16x2_t, w), __builtin_bit_cast(bf16x2_t, x), acc, false); }
__device__ __forceinline__ float gelu_exact(float v) { return 0.5f * v * (1.0f + erff(v * 0.70710678118654752f)); }

__device__ __forceinline__ void phase_peer(const Params& p, LAS unsigned char* lds, int bid, int nb) {
    const int tid = threadIdx.x, lane = tid & 63, wave = __builtin_amdgcn_readfirstlane(tid >> 6);
    const int p16 = lane & 15, rg4 = lane >> 4;
    unsigned char* ws = p.ws;
    const _Float16* SC = (const _Float16*)(ws + WS_PROJ); const bf16_t* HB = (const bf16_t*)(ws + WS_XN); const float* SSQ = (const float*)(ws + WS_SSQ);
    const unsigned char* UB = (const unsigned char*)(ws + WS_UB); const unsigned char* VB = (const unsigned char*)(ws + WS_VB);
    LAS float* A_s = (LAS float*)(lds + wave * 4096);
    LAS int* A_i = (LAS int*)(lds + wave * 4096 + 1024);
    LAS int* E_i = (LAS int*)(lds + wave * 4096 + 2048);
    LAS float* E_s = (LAS float*)(lds + wave * 4096 + 2560);
    int ci = 0, cj = 0; bool cvalid = lane < 50;
    { int l = lane;
      if (l < 16) { ci = 0; cj = l; } else if (l < 24) { ci = 1; cj = l - 16; } else if (l < 29) { ci = 2; cj = l - 24; } else if (l < 33) { ci = 3; cj = l - 29; }
      else if (l < 36) { ci = 4; cj = l - 33; } else if (l < 42) { ci = 5 + (l - 36) / 2; cj = (l - 36) & 1; } else { ci = 8 + (l - 42); cj = 0; } if (!cvalid) { ci = 0; cj = 0; } }
    const int gw = bid * 8 + wave, NGW = nb * 8;
    for (int t = gw; t < NTOK; t += NGW) {
        float ssq = (lane < 16) ? SSQ[(size_t)t * 16 + lane] : 0.f; ssq = wave_sum(ssq);
        const float rstd = 1.0f / sqrtf(ssq * (1.0f / DM) + EPS);
#pragma unroll 1
        for (int q = 0; q < 4; ++q) {
            const u32x4 raw = *(const u32x4*)(SC + (size_t)t * 2048 + 512 * q + 8 * lane);
            const unsigned rw[4] = {raw.x, raw.y, raw.z, raw.w};
            unsigned key[8];
#pragma unroll
            for (int e = 0; e < 8; ++e) { const unsigned hbits = (e & 1) ? (rw[e >> 1] >> 16) : (rw[e >> 1] & 0xffffu);
                const float f = (float)__builtin_bit_cast(_Float16, (unsigned short)hbits);
                key[e] = (ord32(f) & ~0x7fu) | (unsigned)(127 - (8 * p16 + e)); }
            unsigned mine = 0u;
#pragma unroll 1
            for (int it = 0; it < 16; ++it) {
                unsigned m = key[0];
#pragma unroll
                for (int e = 1; e < 8; ++e) m = m > key[e] ? m : key[e];
                const unsigned W = row_max_u(m);
                mine = (p16 == it) ? W : mine;
#pragma unroll
                for (int e = 0; e < 8; ++e) key[e] = (key[e] == W) ? 0u : key[e];
            }
            const int g = 4 * q + rg4;
            A_s[g * 16 + p16] = unord32(mine & ~0x7fu); A_i[g * 16 + p16] = 127 - (int)(mine & 0x7fu);
        }
        LDS_WAIT();
#pragma unroll 1
        for (int h = 0; h < 8; ++h) {
            const float sa = A_s[(2 * h) * 16 + ci], sb = A_s[(2 * h + 1) * 16 + cj];
            const int ia = A_i[(2 * h) * 16 + ci], ib = A_i[(2 * h + 1) * 16 + cj];
            const float sum = sa + sb;
            unsigned key = cvalid ? ((ord32(sum) & ~0x3fu) | (unsigned)(63 - lane)) : 0u;
            int rank = -1;
#pragma unroll 1
            for (int it = 0; it < 16; ++it) { const unsigned W = wave_max_u(key); if (key == W) { rank = it; key = 0u; } }
            if (rank >= 0) { E_i[h * 16 + rank] = ia * 128 + ib; E_s[h * 16 + rank] = sum; }
        }
        LDS_WAIT();
        float gsm[2]; int eidx[2];
#pragma unroll
        for (int sl = 0; sl < 2; ++sl) { const int e = lane + 64 * sl; const float s = E_s[e] * rstd, mx = E_s[e & ~15] * rstd; const float pe = __expf(s - mx); const float den = row_sum_x(pe);
            gsm[sl] = pe / den; eidx[sl] = E_i[e]; }
#if PEER_FP8
        f32x2v xf[4][8];
#pragma unroll
        for (int i = 0; i < 4; ++i) { const u32x4 h0 = *(const u32x4*)(HB + (size_t)t * DM + 256 * i + 16 * p16), h1 = *(const u32x4*)(HB + (size_t)t * DM + 256 * i + 16 * p16 + 8);
            const unsigned hv[8] = {h0.x, h0.y, h0.z, h0.w, h1.x, h1.y, h1.z, h1.w}; const float* gp = p.g2 + 256 * i + 16 * p16;
#pragma unroll
            for (int k2 = 0; k2 < 8; ++k2) { const f32x2v g = *(const f32x2v*)(gp + 2 * k2); xf[i][k2] = (f32x2v){bf_lo(hv[k2]) * rstd * g.x, bf_hi(hv[k2]) * rstd * g.y}; } }
        constexpr int NBB = 2;
#define P6_LOADB(buf, TAB, bt0) do { _Pragma("unroll") for (int j = 0; j < NBB; ++j) { const int bt = (bt0) + j; const int ex = E_i[64 * (bt >> 4) + 16 * rg4 + (bt & 15)]; \
            const unsigned char* rp = (TAB) + (size_t)ex * 1024 + 16 * p16; _Pragma("unroll") for (int i = 0; i < 4; ++i) buf[j][i] = *(const u32x4*)(rp + 256 * i); } } while (0)
        u32x4 bA[NBB][4], bB[NBB][4];
        float act0 = 0.f, act1 = 0.f;
#define P6_COMPU(buf, bt0) do { _Pragma("unroll") for (int j = 0; j < NBB; ++j) { const int bt = (bt0) + j; f32x2v s2 = (f32x2v){0.f, 0.f}; \
            _Pragma("unroll") for (int i = 0; i < 4; ++i) { const unsigned uu[4] = {buf[j][i].x, buf[j][i].y, buf[j][i].z, buf[j][i].w}; \
                _Pragma("unroll") for (int w = 0; w < 4; ++w) { const f32x2v lo = __builtin_amdgcn_cvt_pk_f32_fp8((int)uu[w], false), hi = __builtin_amdgcn_cvt_pk_f32_fp8((int)uu[w], true); \
                    s2 = __builtin_elementwise_fma(lo, xf[i][2 * w], s2); s2 = __builtin_elementwise_fma(hi, xf[i][2 * w + 1], s2); } } \
            const float s = row_sum_x(s2.x + s2.y); const bool mine = (p16 == (bt & 15)); act0 = (mine && bt < 16) ? s : act0; act1 = (mine && bt >= 16) ? s : act1; } } while (0)
        P6_LOADB(bA, UB, 0);
#pragma unroll 1
        for (int g = 0; g < 32; g += 2 * NBB) { P6_LOADB(bB, UB, g + NBB); P6_COMPU(bA, g); if (g + 2 * NBB < 32) P6_LOADB(bA, UB, g + 2 * NBB); P6_COMPU(bB, g + NBB); }
        P6_LOADB(bA, VB, 0);
        LAS float* E_c = E_s;
        { const float c0 = gsm[0] * gelu_exact(act0 * (1.0f / 512.0f)) * (1.0f / 32.0f), c1 = gsm[1] * gelu_exact(act1 * (1.0f / 512.0f)) * (1.0f / 32.0f);
          LDS_WAIT(); E_c[lane] = c0; E_c[lane + 64] = c1; LDS_WAIT(); }
        f32x2v acc2[4][8];
#pragma unroll
        for (int i = 0; i < 4; ++i)
#pragma unroll
            for (int k = 0; k < 8; ++k) acc2[i][k] = (f32x2v){0.f, 0.f};
#define P6_COMPV(buf, bt0) do { _Pragma("unroll") for (int j = 0; j < NBB; ++j) { const int bt = (bt0) + j; const float cf = E_c[64 * (bt >> 4) + 16 * rg4 + (bt & 15)]; const f32x2v cf2 = (f32x2v){cf, cf}; \
            _Pragma("unroll") for (int i = 0; i < 4; ++i) { const unsigned vv[4] = {buf[j][i].x, buf[j][i].y, buf[j][i].z, buf[j][i].w}; \
                _Pragma("unroll") for (int w = 0; w < 4; ++w) { const f32x2v lo = __builtin_amdgcn_cvt_pk_f32_fp8((int)vv[w], false), hi = __builtin_amdgcn_cvt_pk_f32_fp8((int)vv[w], true); \
                    acc2[i][2 * w] = __builtin_elementwise_fma(lo, cf2, acc2[i][2 * w]); acc2[i][2 * w + 1] = __builtin_elementwise_fma(hi, cf2, acc2[i][2 * w + 1]); } } } } while (0)
#pragma unroll 1
        for (int g = 0; g < 32; g += 2 * NBB) { P6_LOADB(bB, VB, g + NBB); P6_COMPV(bA, g); if (g + 2 * NBB < 32) P6_LOADB(bA, VB, g + 2 * NBB); P6_COMPV(bB, g + NBB); }
#undef P6_LOADB
#undef P6_COMPU
#undef P6_COMPV
        float ss = 0.f;
#pragma unroll
        for (int i = 0; i < 4; ++i) { const u32x4 h0 = *(const u32x4*)(HB + (size_t)t * DM + 256 * i + 16 * p16), h1 = *(const u32x4*)(HB + (size_t)t * DM + 256 * i + 16 * p16 + 8);
            const unsigned hv[8] = {h0.x, h0.y, h0.z, h0.w, h1.x, h1.y, h1.z, h1.w};
#pragma unroll
            for (int k2 = 0; k2 < 8; ++k2) { float ax = acc2[i][k2].x, ay = acc2[i][k2].y;
                ax += __shfl_xor(ax, 16); ax += __shfl_xor(ax, 32); ay += __shfl_xor(ay, 16); ay += __shfl_xor(ay, 32);
                ax += bf_lo(hv[k2]); ay += bf_hi(hv[k2]); acc2[i][k2] = (f32x2v){ax, ay}; ss += ax * ax + ay * ay; } }
        ss = row_sum_x(ss);
        const float rf = 1.0f / sqrtf(ss * (1.0f / DM) + EPS);
#pragma unroll
        for (int i = 0; i < 4; ++i) { if (i == rg4) { const float* gp = p.gfin + 256 * i + 16 * p16; float* op = p.out + (size_t)t * DM + 256 * i + 16 * p16;
#pragma unroll
                for (int k4 = 0; k4 < 4; ++k4) { const f32x4 g = *(const f32x4*)(gp + 4 * k4);
                    *(f32x4*)(op + 4 * k4) = (f32x4){acc2[i][2 * k4].x * rf * g[0], acc2[i][2 * k4].y * rf * g[1], acc2[i][2 * k4 + 1].x * rf * g[2], acc2[i][2 * k4 + 1].y * rf * g[3]}; } } }
#else
        unsigned xp[8][4];
#pragma unroll
        for (int i = 0; i < 8; ++i) { const u32x4 hw = *(const u32x4*)(HB + (size_t)t * DM + 128 * i + 8 * p16); const f32x4 ga = *(const f32x4*)(p.g2 + 128 * i + 8 * p16), gb = *(const f32x4*)(p.g2 + 128 * i + 8 * p16 + 4);
            xp[i][0] = pk2(bf_lo(hw.x) * rstd * ga[0], bf_hi(hw.x) * rstd * ga[1]); xp[i][1] = pk2(bf_lo(hw.y) * rstd * ga[2], bf_hi(hw.y) * rstd * ga[3]);
            xp[i][2] = pk2(bf_lo(hw.z) * rstd * gb[0], bf_hi(hw.z) * rstd * gb[1]); xp[i][3] = pk2(bf_lo(hw.w) * rstd * gb[2], bf_hi(hw.w) * rstd * gb[3]); }
        float act[2] = {0.f, 0.f};
#pragma unroll
        for (int sl = 0; sl < 2; ++sl) {
#pragma unroll 2
            for (int b16 = 0; b16 < 16; ++b16) {
                const int e = 64 * sl + 16 * rg4 + b16; const int ex = E_i[e];
                const unsigned char* rowp = UB + (size_t)ex * 2048 + 16 * p16;
                float s = 0.f;
#pragma unroll
                for (int i = 0; i < 8; ++i) { const u32x4 uw = *(const u32x4*)(rowp + 256 * i);
                    s = dot2_bf16(uw.x, xp[i][0], s); s = dot2_bf16(uw.y, xp[i][1], s); s = dot2_bf16(uw.z, xp[i][2], s); s = dot2_bf16(uw.w, xp[i][3], s); }
                s = row_sum_x(s);
                act[sl] = (p16 == b16) ? s : act[sl];
            }
        }
        float coef[2];
#pragma unroll
        for (int sl = 0; sl < 2; ++sl) coef[sl] = gsm[sl] * gelu_exact(act[sl]);
        float acc[8][8];
#pragma unroll
        for (int i = 0; i < 8; ++i)
#pragma unroll
            for (int k = 0; k < 8; ++k) acc[i][k] = 0.f;
#pragma unroll
        for (int sl = 0; sl < 2; ++sl) {
#pragma unroll 2
            for (int b16 = 0; b16 < 16; ++b16) {
                const int srcl = (lane & 48) + b16;
                const float cf = __shfl(coef[sl], srcl); const int ex = __shfl(eidx[sl], srcl);
                const unsigned char* rowp = VB + (size_t)ex * 2048 + 16 * p16;
#pragma unroll
                for (int i = 0; i < 8; ++i) { const u32x4 vw = *(const u32x4*)(rowp + 256 * i);
                    acc[i][0] += cf * bf_lo(vw.x); acc[i][1] += cf * bf_hi(vw.x); acc[i][2] += cf * bf_lo(vw.y); acc[i][3] += cf * bf_hi(vw.y);
                    acc[i][4] += cf * bf_lo(vw.z); acc[i][5] += cf * bf_hi(vw.z); acc[i][6] += cf * bf_lo(vw.w); acc[i][7] += cf * bf_hi(vw.w); }
            }
        }
        float ss = 0.f;
#pragma unroll
        for (int i = 0; i < 8; ++i) { const u32x4 hw = *(const u32x4*)(HB + (size_t)t * DM + 128 * i + 8 * p16); const unsigned hv[4] = {hw.x, hw.y, hw.z, hw.w};
#pragma unroll
            for (int k = 0; k < 8; ++k) { float a = acc[i][k]; a += __shfl_xor(a, 16); a += __shfl_xor(a, 32);
                a += (k & 1) ? bf_hi(hv[k >> 1]) : bf_lo(hv[k >> 1]); acc[i][k] = a; ss += a * a; } }
        ss = row_sum_x(ss);
        const float rf = 1.0f / sqrtf(ss * (1.0f / DM) + EPS);
#pragma unroll
        for (int i = 0; i < 8; ++i) { if ((i >> 1) == rg4) { const f32x4 ga = *(const f32x4*)(p.gfin + 128 * i + 8 * p16), gb = *(const f32x4*)(p.gfin + 128 * i + 8 * p16 + 4);
                float* op = p.out + (size_t)t * DM + 128 * i + 8 * p16;
                *(f32x4*)op = (f32x4){acc[i][0] * rf * ga[0], acc[i][1] * rf * ga[1], acc[i][2] * rf * ga[2], acc[i][3] * rf * ga[3]};
                *(f32x4*)(op + 4) = (f32x4){acc[i][4] * rf * gb[0], acc[i][5] * rf * gb[1], acc[i][6] * rf * gb[2], acc[i][7] * rf * gb[3]}; } }
#endif
        LDS_WAIT();
    }
}


__device__ __forceinline__ void row_max4(unsigned k0, unsigned k1, unsigned k2, unsigned k3, unsigned& w0, unsigned& w1, unsigned& w2, unsigned& w3) {
    asm volatile("s_nop 1\n\t"
                 "v_max_u32_dpp %0, %4, %4 quad_perm:[1,0,3,2] row_mask:0xf bank_mask:0xf\n\t"
                 "v_max_u32_dpp %1, %5, %5 quad_perm:[1,0,3,2] row_mask:0xf bank_mask:0xf\n\t"
                 "v_max_u32_dpp %2, %6, %6 quad_perm:[1,0,3,2] row_mask:0xf bank_mask:0xf\n\t"
                 "v_max_u32_dpp %3, %7, %7 quad_perm:[1,0,3,2] row_mask:0xf bank_mask:0xf\n\t"
                 "v_max_u32_dpp %0, %0, %0 quad_perm:[2,3,0,1] row_mask:0xf bank_mask:0xf\n\t"
                 "v_max_u32_dpp %1, %1, %1 quad_perm:[2,3,0,1] row_mask:0xf bank_mask:0xf\n\t"
                 "v_max_u32_dpp %2, %2, %2 quad_perm:[2,3,0,1] row_mask:0xf bank_mask:0xf\n\t"
                 "v_max_u32_dpp %3, %3, %3 quad_perm:[2,3,0,1] row_mask:0xf bank_mask:0xf\n\t"
                 "v_max_u32_dpp %0, %0, %0 row_ror:4 row_mask:0xf bank_mask:0xf\n\t"
                 "v_max_u32_dpp %1, %1, %1 row_ror:4 row_mask:0xf bank_mask:0xf\n\t"
                 "v_max_u32_dpp %2, %2, %2 row_ror:4 row_mask:0xf bank_mask:0xf\n\t"
                 "v_max_u32_dpp %3, %3, %3 row_ror:4 row_mask:0xf bank_mask:0xf\n\t"
                 "v_max_u32_dpp %0, %0, %0 row_ror:8 row_mask:0xf bank_mask:0xf\n\t"
                 "v_max_u32_dpp %1, %1, %1 row_ror:8 row_mask:0xf bank_mask:0xf\n\t"
                 "v_max_u32_dpp %2, %2, %2 row_ror:8 row_mask:0xf bank_mask:0xf\n\t"
                 "v_max_u32_dpp %3, %3, %3 row_ror:8 row_mask:0xf bank_mask:0xf\n\t"
                 "s_nop 1"
                 : "=&v"(w0), "=&v"(w1), "=&v"(w2), "=&v"(w3) : "v"(k0), "v"(k1), "v"(k2), "v"(k3));
}
constexpr int NT6 = 8;
constexpr int W6_BYTES = 16640;
__device__ __forceinline__ float dpp_f(float v, int ctrl_dummy);
#define DPPF(v, ctrl) __builtin_bit_cast(float, __builtin_amdgcn_update_dpp(0, __builtin_bit_cast(int, (v)), (ctrl), 0xf, 0xf, false))

__device__ __forceinline__ void phase_peer2(const Params& p, LAS unsigned char* lds, int bid, int nb) {
    const int tid = threadIdx.x, lane = tid & 63, wave = __builtin_amdgcn_readfirstlane(tid >> 6);
    const int p16 = lane & 15, rg4 = lane >> 4, q8 = lane >> 3, p8 = lane & 7;
    const bool b0 = lane & 1, b1 = lane & 2, b2 = lane & 4, c0 = lane & 8, c1 = lane & 16, c2 = lane & 32;
    unsigned char* ws = p.ws;
    const _Float16* SC = (const _Float16*)(ws + WS_PROJ); const bf16_t* HB = (const bf16_t*)(ws + WS_XN); const float* SSQ = (const float*)(ws + WS_SSQ);
    const unsigned char* UB = (const unsigned char*)(ws + WS_UB); const unsigned char* VB = (const unsigned char*)(ws + WS_VB);
    LAS unsigned char* wl = lds + wave * W6_BYTES;
    LAS unsigned short* E16 = (LAS unsigned short*)(wl + 6144);
    LAS float* GC = (LAS float*)(wl + 8192);
    LAS float* ACT = (LAS float*)(wl + 12288);
    LAS float* RS = (LAS float*)(wl + 16384);
    int ci = 0, cj = 0; bool cvalid = lane < 50;
    { int l = lane;
      if (l < 16) { ci = 0; cj = l; } else if (l < 24) { ci = 1; cj = l - 16; } else if (l < 29) { ci = 2; cj = l - 24; } else if (l < 33) { ci = 3; cj = l - 29; }
      else if (l < 36) { ci = 4; cj = l - 33; } else if (l < 42) { ci = 5 + (l - 36) / 2; cj = (l - 36) & 1; } else { ci = 8 + (l - 42); cj = 0; } if (!cvalid) { ci = 0; cj = 0; } }
    const int gw = bid * 8 + wave, NGW = nb * 8;
#define TOK6(k) min(base + (k) * NGW, NTOK - 1)
    for (int base = gw; base < NTOK; base += NT6 * NGW) {
#pragma unroll 1
        for (int rep_r = 0; rep_r < PROBE_R; ++rep_r)
#pragma unroll 1
        for (int k = 0; k < NT6; k += 2) {
            u32x4 raw[2][4]; float rstd[2];
#pragma unroll
            for (int v = 0; v < 2; ++v) { const int t = TOK6(k + v);
#pragma unroll
                for (int q = 0; q < 4; ++q) raw[v][q] = *(const u32x4*)(SC + (size_t)t * 2048 + 512 * q + 8 * lane);
                float ssq = (lane < 16) ? SSQ[(size_t)t * 16 + lane] : 0.f; ssq = wave_sum(ssq);
                rstd[v] = 1.0f / sqrtf(ssq * (1.0f / DM) + EPS); }
#pragma unroll
            for (int qq = 0; qq < 2; ++qq) {
                unsigned ka[4][8];
#pragma unroll
                for (int c = 0; c < 4; ++c) { const u32x4 rv = raw[c >> 1][2 * qq + (c & 1)]; const unsigned rw[4] = {rv.x, rv.y, rv.z, rv.w};
#pragma unroll
                    for (int e = 0; e < 8; ++e) { const unsigned hbits = (e & 1) ? (rw[e >> 1] >> 16) : (rw[e >> 1] & 0xffffu);
                        const float f = (float)__builtin_bit_cast(_Float16, (unsigned short)hbits);
                        ka[c][e] = (ord32(f) & ~0x7fu) | (unsigned)(127 - (8 * p16 + e)); } }
#define CE6(u, i, j) do { const unsigned _a = ka[u][i], _b = ka[u][j]; ka[u][i] = _a > _b ? _a : _b; ka[u][j] = _a > _b ? _b : _a; } while (0)
#pragma unroll
                for (int u = 0; u < 4; ++u) {
                    CE6(u, 0, 1); CE6(u, 2, 3); CE6(u, 4, 5); CE6(u, 6, 7);
                    CE6(u, 0, 2); CE6(u, 1, 3); CE6(u, 4, 6); CE6(u, 5, 7);
                    CE6(u, 1, 2); CE6(u, 5, 6);
                    CE6(u, 0, 4); CE6(u, 1, 5); CE6(u, 2, 6); CE6(u, 3, 7);
                    CE6(u, 2, 4); CE6(u, 3, 5);
                    CE6(u, 1, 2); CE6(u, 3, 4); CE6(u, 5, 6);
                }
#undef CE6
                unsigned mine[4] = {0u, 0u, 0u, 0u};
#pragma unroll 1
                for (int it = 0; it < 16; ++it) {
                    unsigned Wv[4]; row_max4(ka[0][0], ka[1][0], ka[2][0], ka[3][0], Wv[0], Wv[1], Wv[2], Wv[3]);
#pragma unroll
                    for (int c = 0; c < 4; ++c) {
                        const unsigned W = Wv[c];
                        mine[c] = (p16 == it) ? W : mine[c];
                        const bool win = (ka[c][0] == W);
#pragma unroll
                        for (int e = 0; e < 7; ++e) ka[c][e] = win ? ka[c][e + 1] : ka[c][e];
                        ka[c][7] = win ? 0u : ka[c][7];
                    }
                }
#pragma unroll
                for (int c = 0; c < 4; ++c) { const int g = 4 * (2 * qq + (c & 1)) + rg4; LAS float* A_s = (LAS float*)(wl + 3072 * (c >> 1)); LAS int* A_i = (LAS int*)(wl + 3072 * (c >> 1) + 1024);
                    A_s[g * 16 + p16] = unord32(mine[c] & ~0x7fu); A_i[g * 16 + p16] = 127 - (int)(mine[c] & 0x7fu); }
            }
            LDS_WAIT();
            {
                float av[4], bc[4]; int iav[4], ibc[4], jp[4], hh[4], bb[4]; unsigned key[4];
#pragma unroll
                for (int c = 0; c < 4; ++c) { const LAS float* A_s = (const LAS float*)(wl + 3072 * (c >> 1)); const LAS int* A_i = (const LAS int*)(wl + 3072 * (c >> 1) + 1024);
                    hh[c] = 4 * (c & 1) + rg4; bb[c] = (2 * hh[c] + 1) * 16; av[c] = A_s[(2 * hh[c]) * 16 + p16]; iav[c] = A_i[(2 * hh[c]) * 16 + p16] * 128; jp[c] = 0; bc[c] = A_s[bb[c]]; ibc[c] = A_i[bb[c]];
                    key[c] = (ord32(av[c] + bc[c]) & ~0xfu) | (unsigned)(15 - p16); }
#pragma unroll 1
                for (int it = 0; it < 16; ++it) {
                    unsigned Wv[4]; row_max4(key[0], key[1], key[2], key[3], Wv[0], Wv[1], Wv[2], Wv[3]);
#pragma unroll
                    for (int c = 0; c < 4; ++c) {
                        const LAS float* A_s = (const LAS float*)(wl + 3072 * (c >> 1)); const LAS int* A_i = (const LAS int*)(wl + 3072 * (c >> 1) + 1024);
                        LAS int* E_i = (LAS int*)(wl + 3072 * (c >> 1) + 2048); LAS float* E_s = (LAS float*)(wl + 3072 * (c >> 1) + 2560);
                        const bool win = (key[c] == Wv[c]);
                        if (win) { E_i[hh[c] * 16 + it] = iav[c] + ibc[c]; E_s[hh[c] * 16 + it] = av[c] + bc[c]; }
                        jp[c] += win ? 1 : 0;
                        const int jr = jp[c] < 16 ? jp[c] : 15;
                        bc[c] = A_s[bb[c] + jr]; ibc[c] = A_i[bb[c] + jr];
                        key[c] = jp[c] < 16 ? ((ord32(av[c] + bc[c]) & ~0xfu) | (unsigned)(15 - p16)) : 0u;
                    }
                }
            }
            LDS_WAIT();
#pragma unroll
            for (int v = 0; v < 2; ++v) { const LAS int* E_i = (const LAS int*)(wl + 3072 * v + 2048); const LAS float* E_s = (const LAS float*)(wl + 3072 * v + 2560);
#pragma unroll
                for (int sl = 0; sl < 2; ++sl) { const int e = lane + 64 * sl; const float s = E_s[e] * rstd[v], mx = E_s[e & ~15] * rstd[v]; const float pe = __expf(s - mx); const float den = row_sum_x(pe);
                    const int pos = 16 * (e & 7) + (e >> 3);
                    GC[(k + v) * 128 + pos] = pe / den; E16[(k + v) * 128 + pos] = (unsigned short)E_i[e]; }
                if (lane == 0) RS[k + v] = rstd[v]; }
            LDS_WAIT();
        }
#define P6_LOADH(buf, TAB, jj, kk, hh) do { const u32x4 _iv = *(const LAS u32x4*)(E16 + (kk) * 128 + 16 * q8 + 8 * (hh)); const unsigned _iw[4] = {_iv.x, _iv.y, _iv.z, _iv.w}; \
            _Pragma("unroll") for (int c = 0; c < 8; ++c) { const unsigned _idx = (c & 1) ? (_iw[c >> 1] >> 16) : (_iw[c >> 1] & 0xffffu); \
                buf[c] = *(const u32x4*)((TAB) + (((size_t)(jj) * NEXP + _idx) << 7) + 16 * p8); } } while (0)
#define P6_LOADX(hb, jj, kk) do { const bf16_t* _hp = HB + (size_t)TOK6(kk) * DM + 128 * (jj) + 16 * p8; hb[0] = *(const u32x4*)_hp; hb[1] = *(const u32x4*)(_hp + 8); } while (0)
#pragma unroll 1
        for (int rep_u = 0; rep_u < PROBE_U; ++rep_u) {
            for (int k = 0; k < NT6; ++k) { ACT[k * 128 + 2 * lane] = 0.f; ACT[k * 128 + 2 * lane + 1] = 0.f; }
            LDS_WAIT();
            u32x4 bfP[16], bfQ[16], hX[2];
#define P6_LOADI(buf, TAB, nn) do { const int _j = (nn) / NT6, _k = (nn) % NT6; P6_LOADH(buf, TAB, _j, _k, 0); P6_LOADH((buf + 8), TAB, _j, _k, 1); } while (0)
#define P6_DOT1(ld, dst) do { const unsigned uu[4] = {(ld).x, (ld).y, (ld).z, (ld).w}; f32x2v s2 = (f32x2v){0.f, 0.f}; \
                    _Pragma("unroll") for (int w = 0; w < 4; ++w) { const f32x2v lo = __builtin_amdgcn_cvt_pk_f32_fp8((int)uu[w], false), hi = __builtin_amdgcn_cvt_pk_f32_fp8((int)uu[w], true); \
                        s2 = __builtin_elementwise_fma(lo, xs[2 * w], s2); s2 = __builtin_elementwise_fma(hi, xs[2 * w + 1], s2); } (dst) = s2.x + s2.y; } while (0)
#define P6_UBODY(buf, hb, nn) do { const int j = (nn) / NT6, k = (nn) % NT6; f32x2v xs[8]; \
                { const float rk = RS[k]; const unsigned hv[8] = {hb[0].x, hb[0].y, hb[0].z, hb[0].w, hb[1].x, hb[1].y, hb[1].z, hb[1].w}; \
                  _Pragma("unroll") for (int k2 = 0; k2 < 8; ++k2) xs[k2] = (f32x2v){bf_lo(hv[k2]) * rk, bf_hi(hv[k2]) * rk}; } \
                { const int _n1 = ((nn) + 1 < 8 * NT6) ? (nn) + 1 : (nn); P6_LOADX(hb, _n1 / NT6, _n1 % NT6); asm volatile("" ::: "memory"); } \
                float r[8], r2[4], r3[2]; \
                _Pragma("unroll") for (int m = 0; m < 8; ++m) { float s[2]; P6_DOT1(buf[m], s[0]); P6_DOT1(buf[m + 8], s[1]); const float keep = b2 ? s[1] : s[0], send = b2 ? s[0] : s[1]; r[m] = keep + DPPF(send, 0x141); } \
                _Pragma("unroll") for (int m = 0; m < 4; ++m) { const float keep = b1 ? r[m + 4] : r[m], send = b1 ? r[m] : r[m + 4]; r2[m] = keep + DPPF(send, 0x4E); } \
                _Pragma("unroll") for (int m = 0; m < 2; ++m) { const float keep = b0 ? r2[m + 2] : r2[m], send = b0 ? r2[m] : r2[m + 2]; r3[m] = keep + DPPF(send, 0xB1); } \
                { LAS f32x2v* ap = (LAS f32x2v*)(ACT + k * 128 + 2 * lane); f32x2v a = *ap; a.x += r3[0]; a.y += r3[1]; *ap = a; } } while (0)
            P6_LOADI(bfP, UB, 0); P6_LOADX(hX, 0, 0);
#pragma unroll 1
            for (int n = 0; n < 8 * NT6; n += 2) {
                P6_LOADI(bfQ, UB, n + 1); asm volatile("" ::: "memory");
                P6_UBODY(bfP, hX, n);
                if (n + 2 < 8 * NT6) P6_LOADI(bfP, UB, n + 2);
                asm volatile("" ::: "memory");
                P6_UBODY(bfQ, hX, n + 1);
            }
        }
        LDS_WAIT();
#pragma unroll 1
        for (int k = 0; k < NT6; ++k) { LAS f32x2v* gp = (LAS f32x2v*)(GC + k * 128 + 16 * q8 + 2 * p8); const f32x2v g = *gp; const f32x2v a = *(const LAS f32x2v*)(ACT + k * 128 + 2 * lane);
            *gp = (f32x2v){g.x * gelu_exact(a.x * (1.0f / 512.0f)) * (1.0f / 32.0f), g.y * gelu_exact(a.y * (1.0f / 512.0f)) * (1.0f / 32.0f)}; }
        LDS_WAIT();
#pragma unroll 1
        for (int k = 0; k < NT6; ++k) ACT[k * 64 + lane] = 0.f;
        LDS_WAIT();
#pragma unroll 1
        for (int rep_v = 0; rep_v < PROBE_V; ++rep_v) {
            for (int k = 0; k < NT6; ++k) ACT[k * 64 + lane] = 0.f;
            LDS_WAIT();
            u32x4 bfP[16], bfQ[16];
#define P6_AXPY(buf, off) do { _Pragma("unroll") for (int c = 0; c < 8; ++c) { const unsigned vv[4] = {buf[(off) + c].x, buf[(off) + c].y, buf[(off) + c].z, buf[(off) + c].w}; const f32x2v cf2 = (f32x2v){cf[(off) + c], cf[(off) + c]}; \
                    _Pragma("unroll") for (int w = 0; w < 4; ++w) { const f32x2v lo = __builtin_amdgcn_cvt_pk_f32_fp8((int)vv[w], false), hi = __builtin_amdgcn_cvt_pk_f32_fp8((int)vv[w], true); \
                        acc2[2 * w] = __builtin_elementwise_fma(lo, cf2, acc2[2 * w]); acc2[2 * w + 1] = __builtin_elementwise_fma(hi, cf2, acc2[2 * w + 1]); } } } while (0)
#define P6_LOADR(nn) (*(const unsigned*)(HB + (size_t)TOK6((nn) % NT6) * DM + 128 * ((nn) / NT6) + 16 * p8 + 2 * q8))
#define P6_VBODY(buf, nn, hres) do { const int j = (nn) / NT6, k = (nn) % NT6; const int t = TOK6(k); \
                float cf[16]; \
                _Pragma("unroll") for (int c4 = 0; c4 < 4; ++c4) { const f32x4 cv = *(const LAS f32x4*)(GC + k * 128 + 16 * q8 + 4 * c4); cf[4 * c4] = cv[0]; cf[4 * c4 + 1] = cv[1]; cf[4 * c4 + 2] = cv[2]; cf[4 * c4 + 3] = cv[3]; } \
                f32x2v acc2[8]; \
                _Pragma("unroll") for (int w = 0; w < 8; ++w) acc2[w] = (f32x2v){0.f, 0.f}; \
                P6_AXPY(buf, 0); P6_AXPY(buf, 8); \
                float v[16]; \
                _Pragma("unroll") for (int w = 0; w < 8; ++w) { v[2 * w] = acc2[w].x; v[2 * w + 1] = acc2[w].y; } \
                float r[8], r2[4], r3[2]; \
                _Pragma("unroll") for (int m = 0; m < 8; ++m) { const float keep = c2 ? v[m + 8] : v[m], send = c2 ? v[m] : v[m + 8]; r[m] = keep + __shfl_xor(send, 32); } \
                _Pragma("unroll") for (int m = 0; m < 4; ++m) { const float keep = c1 ? r[m + 4] : r[m], send = c1 ? r[m] : r[m + 4]; r2[m] = keep + __shfl_xor(send, 16); } \
                _Pragma("unroll") for (int m = 0; m < 2; ++m) { const float keep = c0 ? r2[m + 2] : r2[m], send = c0 ? r2[m] : r2[m + 2]; r3[m] = keep + DPPF(send, 0x128); } \
                const float o0 = r3[0] + bf_lo(hres), o1 = r3[1] + bf_hi(hres); \
                *(f32x2v*)(p.out + (size_t)t * DM + 128 * j + 16 * p8 + 2 * q8) = (f32x2v){o0, o1}; \
                ACT[k * 64 + lane] += o0 * o0 + o1 * o1; \
                if (j == 7) { \
                    LDS_WAIT(); \
                    const float ss = wave_sum(ACT[k * 64 + lane]); \
                    const float rf = 1.0f / sqrtf(ss * (1.0f / DM) + EPS); \
                    asm volatile("s_waitcnt vmcnt(0)" ::: "memory"); \
                    float* op = p.out + (size_t)t * DM + 4 * lane; \
                    _Pragma("unroll") for (int i = 0; i < 4; ++i) { const f32x4 o = *(const f32x4*)(op + 256 * i), g = *(const f32x4*)(p.gfin + 256 * i + 4 * lane); *(f32x4*)(op + 256 * i) = o * rf * g; } \
                } } while (0)
            P6_LOADI(bfP, VB, 0);
#pragma unroll 1
            for (int n = 0; n < 8 * NT6; n += 2) {
                const unsigned hr0 = P6_LOADR(n), hr1 = P6_LOADR(n + 1);
                asm volatile("" ::: "memory");
                P6_LOADI(bfQ, VB, n + 1); asm volatile("" ::: "memory");
                P6_VBODY(bfP, n, hr0);
                if (n + 2 < 8 * NT6) P6_LOADI(bfP, VB, n + 2);
                asm volatile("" ::: "memory");
                P6_VBODY(bfQ, n + 1, hr1);
            }
        }
        LDS_WAIT();
    }
#undef P6_LOADH
#undef P6_LOADX
#undef P6_DOT1
#undef P6_AXPY
#undef P6_LOADI
#undef P6_UBODY
#undef P6_VBODY
#undef P6_LOADR
#undef TOK6
}

#define XB_TMO      128
#define XB_XCNT(j)  (256  + 64 * (j))
#define XB_XSUB(j)  (1280 + 64 * (j))
#define XB_XGEN(j)  (2304 + 64 * (j))
#define XB_TOP      3328
#define XB_TOPGEN   3392
#define XCD_BAR_WORDS 3456
#define XB_SPIN_CAP (1u << 18)

__device__ __forceinline__ unsigned xb_ld(unsigned* p)              { return __hip_atomic_load(p, __ATOMIC_RELAXED, __HIP_MEMORY_SCOPE_AGENT); }
__device__ __forceinline__ unsigned xb_add(unsigned* p, unsigned v) { return __hip_atomic_fetch_add(p, v, __ATOMIC_RELAXED, __HIP_MEMORY_SCOPE_AGENT); }
__device__ __forceinline__ unsigned xb_xcc_id() { return (unsigned)__builtin_amdgcn_s_getreg((3 << 11) | 20) & 0xFu; }
#define XB_SPIN(cond, bar) do { unsigned _sp = 0; while (cond) { __builtin_amdgcn_s_sleep(1); \
    if ((++_sp & 255u) == 0u) { if (xb_ld(&(bar)[XB_TMO])) break; if (_sp > XB_SPIN_CAP) { atomicAdd(&(bar)[XB_TMO], 1u); break; } } } } while (0)

struct XcdBarrier {
    unsigned* bar; unsigned x;
    volatile LAS unsigned* st;
};

__device__ __forceinline__ XcdBarrier xcd_barrier_post(unsigned* bar, volatile LAS unsigned* st) {
    XcdBarrier b; b.bar = bar; b.x = xb_xcc_id(); b.st = st;
    if (threadIdx.x == 0) (void)xb_add(&bar[XB_XCNT(b.x)], 1u);
    return b;
}
__device__ __forceinline__ void xcd_barrier_complete(unsigned* bar, unsigned x, unsigned& nloc, unsigned& nx) {
    const unsigned G = gridDim.x * gridDim.y * gridDim.z;
    unsigned sum, cnt, mine, sp = 0u;
    for (;;) {
        sum = 0u; cnt = 0u; mine = 0u;
#pragma unroll
        for (unsigned j = 0; j < 16; ++j) { const unsigned c = xb_ld(&bar[XB_XCNT(j)]); sum += c; cnt += (c > 0u) ? 1u : 0u; mine = (j == x) ? c : mine; }
        if (sum == G) break;
        __builtin_amdgcn_s_sleep(1);
        if ((++sp & 255u) == 0u) { if (xb_ld(&bar[XB_TMO])) break; if (sp > XB_SPIN_CAP) { atomicAdd(&bar[XB_TMO], 1u); break; } }
    }
    nloc = mine > 0u ? mine : 1u; nx = cnt > 0u ? cnt : 1u;
}

__device__ __forceinline__ void xcd_barrier(const XcdBarrier& b) {
    asm volatile("s_waitcnt vmcnt(0)" ::: "memory");
    __syncthreads();
    if (threadIdx.x == 0) {
        unsigned* bar = b.bar;
        __builtin_amdgcn_s_waitcnt(0);
        unsigned nloc = b.st[0], nx = b.st[1];
        if (nloc == 0u) { xcd_barrier_complete(bar, b.x, nloc, nx); b.st[0] = nloc; b.st[1] = nx; }
        const unsigned old = xb_add(&bar[XB_XSUB(b.x)], 1u);
        const unsigned gen = old / nloc;
        if (old + 1u == (gen + 1u) * nloc) {
            __builtin_amdgcn_fence(__ATOMIC_RELEASE, "agent");
            asm volatile("s_waitcnt vmcnt(0)" ::: "memory");
            const unsigned og = xb_add(&bar[XB_TOP], 1u);
            const unsigned tg = og / nx;
            if (og + 1u == (tg + 1u) * nx) xb_add(&bar[XB_TOPGEN], 1u);
            else XB_SPIN(xb_ld(&bar[XB_TOPGEN]) == tg, bar);
            __builtin_amdgcn_fence(__ATOMIC_ACQUIRE, "agent");
            xb_add(&bar[XB_XGEN(b.x)], 1u);
            asm volatile("s_waitcnt vmcnt(0)" ::: "memory");
        } else {
            XB_SPIN(xb_ld(&bar[XB_XGEN(b.x)]) == gen, bar);
            __builtin_amdgcn_fence(__ATOMIC_ACQUIRE, "agent");
            asm volatile("s_waitcnt vmcnt(0)" ::: "memory");
        }
    }
    __syncthreads();
}

__global__ void __launch_bounds__(512, 2) mk_fwd(Params p) {
    extern __shared__ __attribute__((aligned(16))) unsigned char lds_raw[];
    LAS unsigned char* lds = (LAS unsigned char*)lds_raw;
    const int bid = blockIdx.x, nb = gridDim.x;
    unsigned char* ws = p.ws;
#define IN(k) (p.ph_lo <= (k) && (k) < p.ph_hi)
#define SEAM(k) do { if (IN(k) && IN((k) + 1)) { if ((k) == 0) cg::this_grid().sync(); else xcd_barrier(bar); } } while (0)
    if (threadIdx.x < 4) ((volatile LAS unsigned*)(lds + LDS_BYTES - 16))[threadIdx.x] = 0u;
    __syncthreads();
    const XcdBarrier bar = xcd_barrier_post((unsigned*)(ws + WS_CTL) + 4096, (volatile LAS unsigned*)(lds + LDS_BYTES - 16));
    if (IN(0)) phase0(p, lds, bid, nb);
    SEAM(0);
    if (IN(1)) {
        pg8::Gemm g{(const bf16_t*)(ws + WS_XN), (const bf16_t*)(ws + WS_WIN), MROWS, NP1, DM}; pg8::StaticOrder S; S.init(MROWS, NP1, nb, bid);
        EpiProj E{(bf16_t*)(ws + WS_PROJ), (float*)(ws + WS_LA), p.gb, (const float2*)(ws + WS_ROPE)};
        pg8::gemm_phase<EpiProj, pg8::StaticOrder, true, true>(lds, g, S, E);
    }
    SEAM(1);
    if (IN(2)) attn_pass<false>(p, lds, bid, nb);
    SEAM(2);
    if (IN(3)) attn_pass<true>(p, lds, bid, nb);
    SEAM(3);
    if (IN(4)) {
        pg8::Gemm g{(const bf16_t*)(ws + WS_O), (const bf16_t*)(ws + WS_WOUT), NTOK, DM, DM}; pg8::StaticOrder S; S.init(NTOK, DM, nb, bid);
        EpiRes E{p.x, (bf16_t*)(ws + WS_XN), (float*)(ws + WS_SSQ)};
        pg8::gemm_phase<EpiRes, pg8::StaticOrder, true, true>(lds, g, S, E);
    }
    SEAM(4);
    if (IN(5)) {
        pg8::Gemm g{(const bf16_t*)(ws + WS_XN), (const bf16_t*)(ws + WS_WS), NTOK, 2048, DM}; pg8::StaticOrder S; S.init(NTOK, 2048, nb, bid);
        EpiF16 E{(_Float16*)(ws + WS_PROJ)};
        pg8::gemm_phase<EpiF16, pg8::StaticOrder, true, true>(lds, g, S, E);
    }
    SEAM(5);
    if (IN(6)) phase_peer2(p, lds, bid, nb);
#undef IN
#undef SEAM
}

#ifndef MK_FUSED
#define MK_FUSED 1
#endif
extern "C" void kernel_launch(void* const* d_in, const int* in_sizes, int n_in, void* d_out, int out_size, void* d_ws, size_t ws_size, hipStream_t stream) {
    static int grid = 0;
    if (grid == 0) {
        if (n_in != 16 || in_sizes[0] != NTOK * DM || out_size != NTOK * DM || ws_size < WS_END) {
            fprintf(stderr, "kernel_launch: unexpected shapes (n_in %d, in0 %d, out %d, ws %zu); nothing launched\n", n_in, n_in > 0 ? in_sizes[0] : -1, out_size, ws_size); grid = -1; return; }
        int dev = 0, cus = 0, per_cu = 0;
        hipGetDevice(&dev); hipDeviceGetAttribute(&cus, hipDeviceAttributeMultiprocessorCount, dev);
        if (hipFuncSetAttribute((const void*)mk_fwd, hipFuncAttributeMaxDynamicSharedMemorySize, LDS_BYTES) != hipSuccess) { fprintf(stderr, "kernel_launch: hipFuncSetAttribute failed\n"); grid = -1; return; }
        if (hipOccupancyMaxActiveBlocksPerMultiprocessor(&per_cu, (const void*)mk_fwd, 512, LDS_BYTES) != hipSuccess || per_cu < 1) { fprintf(stderr, "kernel_launch: occupancy query failed (%d)\n", per_cu); (void)hipGetLastError(); per_cu = 1; }
        grid = cus * (per_cu < 1 ? 1 : 1);
        fprintf(stderr, "kernel_launch: %d CUs, occupancy %d/CU, grid %d\n", cus, per_cu, grid);
    }
    if (grid < 0) return;
    (void)hipMemsetAsync((char*)d_ws + WS_CTL, 0, 65536, stream);
    Params p{};
    p.x = (const float*)d_in[0]; p.meta = (const float*)d_in[1]; p.g1 = (const float*)d_in[2]; p.w_in = (const float*)d_in[3]; p.gw2 = (const float*)d_in[4]; p.gb = (const float*)d_in[5];
    p.gla_gain = (const float*)d_in[6]; p.ret_gain = (const float*)d_in[7]; p.ret_bias = (const float*)d_in[8]; p.w_out = (const float*)d_in[9]; p.g2 = (const float*)d_in[10];
    p.w_q = (const float*)d_in[11]; p.subkeys = (const float*)d_in[12]; p.pu = (const float*)d_in[13]; p.pv = (const float*)d_in[14]; p.gfin = (const float*)d_in[15];
    p.out = (float*)d_out; p.ws = (unsigned char*)d_ws;
#if MK_FUSED
    p.ph_lo = 0; p.ph_hi = NPHASE;
    void* args[] = {&p};
    hipError_t e = hipLaunchCooperativeKernel((const void*)mk_fwd, dim3(grid), dim3(512), args, LDS_BYTES, stream);
    if (e != hipSuccess) fprintf(stderr, "kernel_launch: cooperative launch failed: %s (grid %d)\n", hipGetErrorString(e), grid);
#else
    { const int order[7] = {0, 1, 2, 3, 4, 5, 6}; for (int i = 0; i < 7; ++i) { p.ph_lo = order[i]; p.ph_hi = order[i] + 1; hipLaunchKernelGGL(mk_fwd, dim3(grid), dim3(512), LDS_BYTES, stream, p); } }
#endif
}
```

```cpp
#include <hip/hip_runtime.h>
#include <hip/hip_cooperative_groups.h>
#include <cstdio>
#include <cstdint>
namespace cg = cooperative_groups;
namespace pg8 {
#define PG8_LAS __attribute__((address_space(3)))
typedef unsigned short bf16_t;
typedef short bf16x8 __attribute__((ext_vector_type(8)));
typedef float f32x4 __attribute__((ext_vector_type(4)));
typedef unsigned u32x4 __attribute__((ext_vector_type(4)));
constexpr int BM = 256, BK = 64, HALF = 128, HTB = HALF * BK * 2  , STAGE_BYTES = 8 * HTB, NXCD = 8, WGM = 8;

__host__ __device__ __forceinline__ int lds_byte(int r, int c) { const int st = (r >> 4) * 2 + (c >> 5), rr = r & 15, cc = c & 31, ob = rr * 64 + cc * 2; return st * 1024 + (ob ^ (((ob >> 9) & 1) << 5)); }
__host__ __device__ __forceinline__ void stage_rc(int b, int& R, int& C) { const int st = b / 1024, sb = b % 1024, swz = sb ^ (((sb >> 9) & 1) << 5); R = (st >> 1) * 16 + swz / 64; C = (st & 1) * 32 + (swz % 64) / 2; }
__host__ __device__ __forceinline__ int perm32(int rho) { const int n = rho >> 4, i = rho & 15; return 8 * (i >> 2) + 4 * n + (i & 3); }

struct Unit { int pm, pn; };
struct Gemm { const bf16_t* A; const bf16_t* Bt; int M, N, K; };

struct StaticOrder {
    int nM, nN, nwg, G, c;
    __host__ __device__ void init(int M, int N, int G_, int c_) { nM = M / BM; nN = N / BM; nwg = nM * nN; G = G_; c = c_; }
    __host__ __device__ bool next(int i, Unit& u) const {
        const long L = (long)i * G + c; if (L >= nwg) return false;
        int wgid = (int)L; { const int q = nwg / NXCD, r = nwg % NXCD, xcd = wgid % NXCD, off = wgid / NXCD; wgid = (xcd < r ? xcd * (q + 1) : r * (q + 1) + (xcd - r) * q) + off; }
        const int nig = WGM * nN, gid = wgid / nig, fm = gid * WGM, gsz = (nM - fm) < WGM ? (nM - fm) : WGM;
        u.pm = fm + ((wgid % nig) % gsz); u.pn = (wgid % nig) / gsz; return true;
    }
    __device__ __forceinline__ void a_ready(const Unit&) const {}
    __device__ __forceinline__ void done(const Unit&) const {}
};

__device__ __forceinline__ unsigned cvt_pk_bf16(float lo, float hi) { unsigned r; asm volatile("v_cvt_pk_bf16_f32 %0, %1, %2" : "=v"(r) : "v"(lo), "v"(hi)); return r; }
typedef float f32x2 __attribute__((ext_vector_type(2)));
template <class Epi, class Sched, bool ALIGN_EPI = false, bool SP2 = false>
__device__ __forceinline__ void gemm_phase(PG8_LAS unsigned char* lds, const Gemm g, const Sched& S, const Epi& E) {
    const int tid = threadIdx.x, wid = __builtin_amdgcn_readfirstlane(tid >> 6), lane = tid & 63, wr = wid >> 2, wc = wid & 3, fr = lane & 15, fq = lane >> 4;
    const int K = g.K, nt = K / BK;
    unsigned voffA[2], voffB[2];
#pragma unroll
    for (int i = 0; i < 2; ++i) { int R, C; stage_rc(tid * 16 + i * 8192, R, C); const int Rb = Epi::PERM ? ((R & ~31) + perm32(R & 31)) : R;
        voffA[i] = (unsigned)(R * K + C) * 2u; voffB[i] = (unsigned)(Rb * K + C) * 2u; }
    const size_t kstep = (size_t)(BK * 2);
    const size_t hstep = (size_t)HALF * K * 2;
    const size_t tstep = 2 * hstep;
    const unsigned ldsw = (unsigned)wid * 1024u;
    const int aoff = lds_byte(wr * 64 + fr, fq * 8), boff = lds_byte(wc * 32 + fr, fq * 8);
#define PG8_SA(b, h) (((b) * 2 + (h)) * HTB)
#define PG8_SB(b, h) ((4 + (b) * 2 + (h)) * HTB)
#define PG8_STAGE(bufoff, gbase, voff) do { _Pragma("unroll") for (int _i = 0; _i < 2; ++_i) \
        __builtin_amdgcn_global_load_lds((const unsigned*)((const char*)(gbase) + (voff)[_i]), (PG8_LAS unsigned*)(lds + (bufoff) + ldsw + _i * 8192), 16, 0, 0); } while (0)
#define PG8_LDA(dst, b, h) do { _Pragma("unroll") for (int m = 0; m < 4; ++m) _Pragma("unroll") for (int k = 0; k < 2; ++k) dst[m][k] = *(const PG8_LAS bf16x8*)(lds + PG8_SA(b, h) + aoff + m * 2048 + k * 1024); } while (0)
#define PG8_LDB(dst, b, h) do { _Pragma("unroll") for (int n = 0; n < 2; ++n) _Pragma("unroll") for (int k = 0; k < 2; ++k) dst[n][k] = *(const PG8_LAS bf16x8*)(lds + PG8_SB(b, h) + boff + n * 2048 + k * 1024); } while (0)
#define PG8_MMA(ai, bj, At, Bt) do { __builtin_amdgcn_s_setprio(1); _Pragma("unroll") for (int m = 0; m < 4; ++m) _Pragma("unroll") for (int n = 0; n < 2; ++n) _Pragma("unroll") for (int k = 0; k < 2; ++k) \
        acc[ai][bj][m][n] = __builtin_amdgcn_mfma_f32_16x16x32_bf16(Bt[n][k], At[m][k], acc[ai][bj][m][n], 0, 0, 0); __builtin_amdgcn_s_setprio(0); } while (0)
#define PG8_WAIT_V(n) asm volatile("s_waitcnt vmcnt(" #n ")" ::: "memory")
#define PG8_WAIT_L(n) asm volatile("s_waitcnt lgkmcnt(" #n ")" ::: "memory")
#define PG8_BAR __builtin_amdgcn_s_barrier()
#define PG8_SCHED __builtin_amdgcn_sched_barrier(0)
    Unit cur, nxt; int ui = 0;
    if (!S.next(0, cur)) return;
    f32x4 acc[2][2][4][2];
#pragma unroll
    for (int a = 0; a < 2; ++a)
#pragma unroll
        for (int b = 0; b < 2; ++b)
#pragma unroll
            for (int m = 0; m < 4; ++m)
#pragma unroll
                for (int n = 0; n < 2; ++n) acc[a][b][m][n] = (f32x4){0.f, 0.f, 0.f, 0.f};
    bf16x8 At[4][2], B0[2][2], B1[2][2];
    const char* cA = (const char*)g.A + (size_t)cur.pm * tstep; const char* cB = (const char*)g.Bt + (size_t)cur.pn * tstep;
    S.a_ready(cur);
    if constexpr (SP2) {
        PG8_STAGE(PG8_SB(0, 0), cB, voffB); PG8_STAGE(PG8_SB(0, 1), cB + hstep, voffB); PG8_STAGE(PG8_SA(0, 0), cA, voffA); PG8_STAGE(PG8_SA(0, 1), cA + hstep, voffA);
        if (wr == 1) PG8_BAR;
        PG8_WAIT_V(2); PG8_BAR;
        PG8_STAGE(PG8_SB(1, 0), cB + kstep, voffB); PG8_STAGE(PG8_SA(1, 0), cA + kstep, voffA); PG8_STAGE(PG8_SB(1, 1), cB + hstep + kstep, voffB);
        PG8_WAIT_V(6); PG8_BAR;
    } else {
        PG8_STAGE(PG8_SB(0, 0), cB, voffB); PG8_STAGE(PG8_SA(0, 0), cA, voffA); PG8_STAGE(PG8_SB(0, 1), cB + hstep, voffB); PG8_STAGE(PG8_SA(0, 1), cA + hstep, voffA);
        if (wr == 1) PG8_BAR;
        PG8_WAIT_V(4); PG8_BAR;
        PG8_STAGE(PG8_SB(1, 0), cB + kstep, voffB); PG8_STAGE(PG8_SA(1, 0), cA + kstep, voffA); PG8_STAGE(PG8_SB(1, 1), cB + hstep + kstep, voffB);
        PG8_WAIT_V(6); PG8_BAR;
    }
    for (;;) {
        const bool has_next = S.next(ui + 1, nxt);
        const char* nA = has_next ? (const char*)g.A + (size_t)nxt.pm * tstep : cA; const char* nB = has_next ? (const char*)g.Bt + (size_t)nxt.pn * tstep : cB;
        for (int t = 0; t < nt; t += 2) {
            const bool last = (t == nt - 2);
            const char* a1 = cA + (size_t)(t + 1) * kstep;
            const char* a2 = last ? nA : cA + (size_t)(t + 2) * kstep; const char* b2 = last ? nB : cB + (size_t)(t + 2) * kstep;
            const char* a3 = a2 + kstep; const char* b3 = b2 + kstep;
            if (last && has_next) S.a_ready(nxt);
            if constexpr (SP2) {
            PG8_LDB(B0, 0, 0); PG8_LDB(B1, 0, 1); PG8_SCHED; PG8_LDA(At, 0, 0); PG8_STAGE(PG8_SA(1, 1), a1 + hstep, voffA);
            PG8_WAIT_V(8); PG8_WAIT_L(0); PG8_BAR; PG8_MMA(0, 0, At, B0); PG8_MMA(0, 1, At, B1); PG8_BAR; PG8_SCHED;
            PG8_LDA(At, 0, 1); PG8_STAGE(PG8_SB(0, 0), b2, voffB); PG8_STAGE(PG8_SB(0, 1), b2 + hstep, voffB); PG8_STAGE(PG8_SA(0, 0), a2, voffA);
            PG8_WAIT_V(8); PG8_WAIT_L(0); PG8_BAR; PG8_MMA(1, 0, At, B0); PG8_MMA(1, 1, At, B1); PG8_BAR; PG8_SCHED;
            PG8_LDB(B0, 1, 0); PG8_LDB(B1, 1, 1); PG8_SCHED; PG8_LDA(At, 1, 0); PG8_STAGE(PG8_SA(0, 1), a2 + hstep, voffA);
            PG8_WAIT_V(8); PG8_WAIT_L(0); PG8_BAR; PG8_MMA(0, 0, At, B0); PG8_MMA(0, 1, At, B1); PG8_BAR; PG8_SCHED;
            PG8_LDA(At, 1, 1); PG8_STAGE(PG8_SB(1, 0), b3, voffB); PG8_STAGE(PG8_SB(1, 1), b3 + hstep, voffB); PG8_STAGE(PG8_SA(1, 0), a3, voffA);
            PG8_WAIT_V(8); PG8_WAIT_L(0); PG8_BAR; PG8_MMA(1, 0, At, B0); PG8_MMA(1, 1, At, B1); PG8_BAR; PG8_SCHED;
            } else {
            PG8_LDB(B0, 0, 0); PG8_SCHED; PG8_LDA(At, 0, 0); PG8_STAGE(PG8_SA(1, 1), a1 + hstep, voffA);
            PG8_WAIT_L(8); PG8_BAR; PG8_WAIT_L(0); PG8_MMA(0, 0, At, B0); PG8_BAR; PG8_SCHED;
            PG8_LDB(B1, 0, 1); PG8_STAGE(PG8_SB(0, 0), b2, voffB);
            PG8_BAR; PG8_WAIT_L(0); PG8_MMA(0, 1, At, B1); PG8_BAR;
            PG8_LDA(At, 0, 1); PG8_STAGE(PG8_SA(0, 0), a2, voffA);
            PG8_BAR; PG8_WAIT_L(0); PG8_MMA(1, 0, At, B0); PG8_BAR; PG8_SCHED;
            PG8_STAGE(PG8_SB(0, 1), b2 + hstep, voffB);
            PG8_WAIT_V(6); PG8_BAR; PG8_MMA(1, 1, At, B1); PG8_BAR;
            PG8_LDB(B0, 1, 0); PG8_SCHED; PG8_LDA(At, 1, 0); PG8_STAGE(PG8_SA(0, 1), a2 + hstep, voffA);
            PG8_WAIT_L(8); PG8_BAR; PG8_WAIT_L(0); PG8_MMA(0, 0, At, B0); PG8_BAR; PG8_SCHED;
            PG8_LDB(B1, 1, 1); PG8_STAGE(PG8_SB(1, 0), b3, voffB);
            PG8_BAR; PG8_WAIT_L(0); PG8_MMA(0, 1, At, B1); PG8_BAR;
            PG8_LDA(At, 1, 1); PG8_STAGE(PG8_SA(1, 0), a3, voffA);
            PG8_BAR; PG8_WAIT_L(0); PG8_MMA(1, 0, At, B0); PG8_BAR; PG8_SCHED;
            PG8_STAGE(PG8_SB(1, 1), b3 + hstep, voffB);
            PG8_WAIT_V(6); PG8_BAR; PG8_MMA(1, 1, At, B1); PG8_BAR;
            }
        }
        if constexpr (ALIGN_EPI) { if (wr == 0) PG8_BAR; }
        if constexpr (!Epi::AFTER_DRAIN) { E(acc, cur, wr, wc, fr, fq); S.done(cur); }
        if (!has_next) break;
#pragma unroll
        for (int a = 0; a < 2; ++a)
#pragma unroll
            for (int b = 0; b < 2; ++b)
#pragma unroll
                for (int m = 0; m < 4; ++m)
#pragma unroll
                    for (int n = 0; n < 2; ++n) acc[a][b][m][n] = (f32x4){0.f, 0.f, 0.f, 0.f};
        cur = nxt; cA = nA; cB = nB; ++ui;
        if constexpr (ALIGN_EPI) { if (wr == 1) PG8_BAR; }
    }
    PG8_WAIT_V(0);
    if constexpr (!ALIGN_EPI) { if (wr == 0) PG8_BAR; }
    PG8_BAR;
    if constexpr (Epi::AFTER_DRAIN) { E.fused(acc, cur, wr, wc, fr, fq, lds, wid, lane); S.done(cur); }
#undef PG8_SA
#undef PG8_SB
#undef PG8_STAGE
#undef PG8_LDA
#undef PG8_LDB
#undef PG8_MMA
#undef PG8_WAIT_V
#undef PG8_WAIT_L
#undef PG8_BAR
#undef PG8_SCHED
}
}

#define LAS __attribute__((address_space(3)))
typedef unsigned short bf16_t;
typedef float f32x4 __attribute__((ext_vector_type(4)));
typedef unsigned u32x4 __attribute__((ext_vector_type(4)));
typedef unsigned u32x2 __attribute__((ext_vector_type(2)));
typedef short bf16x8 __attribute__((ext_vector_type(8)));
typedef short s16x4 __attribute__((ext_vector_type(4)));
typedef __bf16 bf16x2_t __attribute__((ext_vector_type(2)));
typedef _Float16 f16x2_t __attribute__((ext_vector_type(2)));
typedef float f32x2v __attribute__((ext_vector_type(2)));
typedef _Float16 h2v __attribute__((ext_vector_type(2)));

constexpr int DM = 1024, NB = 4, SEQ = 8192, NTOK = NB * SEQ;
constexpr int MROWS = NTOK + 256;
constexpr int INW = 3088;
constexpr int NPROJ = 3072, NP1 = 3328;
constexpr int NEXP = 16384;
constexpr float EPS = 1e-6f;
constexpr int C_GQ = 0, C_GK = 256, C_GV = 512, C_GG = 1024, C_RQ = 1536, C_RK = 1792, C_RV = 2048, C_RG = 2560;
constexpr int S_GA = 1536, S_RQ = 1552, S_RV = 2064;

constexpr size_t MiB = 1u << 20;
constexpr size_t WS_CTL = 0, WS_WIN = 1 * MiB, WS_WOUT = 8 * MiB, WS_WS = 10 * MiB, WS_ROPE = 14 * MiB, WS_SSQ = 17 * MiB, WS_SEG = 19 * MiB, WS_ASEG = 27 * MiB,
                 WS_UB = 28 * MiB, WS_VB = 60 * MiB, WS_XN = 92 * MiB, WS_O = 157 * MiB, WS_LA = 221 * MiB, WS_PROJ = 254 * MiB, WS_XQ = 448 * MiB, WS_END = 480 * MiB;
static_assert(WS_WIN + (size_t)NP1 * DM * 2 <= WS_WOUT && WS_ROPE + (size_t)(SEQ + 64) * 32 * 8 <= WS_SSQ && WS_XN + (size_t)MROWS * DM * 2 <= WS_O &&
              WS_LA + (size_t)MROWS * 256 * 4 <= WS_PROJ && WS_PROJ + (size_t)MROWS * NPROJ * 2 <= WS_END && WS_PROJ + (size_t)NTOK * 2048 * 2 <= WS_END, "ws map");

constexpr int LDS_BYTES = 147456;
constexpr int NPHASE = 7;
#ifndef PROBE_R
#define PROBE_R 1
#define PROBE_U 1
#define PROBE_V 1
#endif
#ifndef PEER_FP8
#define PEER_FP8 1
#endif

struct Params {
    const float *x, *meta, *g1, *w_in, *gw2, *gb, *gla_gain, *ret_gain, *ret_bias, *w_out, *g2, *w_q, *subkeys, *pu, *pv, *gfin;
    float* out; unsigned char* ws;
    int ph_lo, ph_hi;
};

#define LDS_WAIT() asm volatile("s_waitcnt lgkmcnt(0)" ::: "memory")
__device__ __forceinline__ unsigned f2bf(float f) { unsigned u = __builtin_bit_cast(unsigned, f); return (u + 0x7fffu + ((u >> 16) & 1u)) >> 16; }
__device__ __forceinline__ unsigned pk2(float lo, float hi) { return f2bf(lo) | (f2bf(hi) << 16); }
__device__ __forceinline__ float bf_lo(unsigned w) { return __builtin_bit_cast(float, w << 16); }
__device__ __forceinline__ float bf_hi(unsigned w) { return __builtin_bit_cast(float, w & 0xffff0000u); }
__device__ __forceinline__ float bf1(bf16_t h) { return __builtin_bit_cast(float, (unsigned)h << 16); }
__device__ __forceinline__ float wave_sum(float v) {
#pragma unroll
    for (int o = 1; o < 64; o <<= 1) v += __shfl_xor(v, o);
    return v;
}

struct MapIn {
    __device__ __forceinline__ void operator()(int j, int& src, float& sc) const {
        if (j < C_RQ) { src = j; sc = (j < 256) ? 0.125f : 1.0f; }
        else if (j < C_RV) { const int jj = j - C_RQ, which = jj >> 8, within = jj & 255, head = within >> 6, p = within & 63;
            const int a = p >> 3, n = (p >> 2) & 1, i = p & 3; src = S_RQ + which * 256 + head * 64 + 32 * n + 4 * a + i; sc = which ? 0.125f : 1.0f; }
        else { src = S_RV + (j - C_RV); sc = 1.0f; }
    }
};
struct MapId { __device__ __forceinline__ void operator()(int j, int& src, float& sc) const { src = j; sc = 1.0f; } };

template <class Map>
__device__ __forceinline__ void transpose_item(const float* W, int K, int N, bf16_t* WT, LAS float* scr, int item, int nblk, int lane, const Map map) {
    const int kb = item / nblk, nb = item % nblk, k0 = 64 * kb, n0 = 32 * nb;
    int src; float sc; map(n0 + (lane & 31), src, sc);
#pragma unroll 8
    for (int i = 0; i < 32; ++i) { const int kk = 2 * i + (lane >> 5); scr[kk * 33 + (lane & 31)] = W[(size_t)(k0 + kk) * N + src] * sc; }
    LDS_WAIT();
    const int c = lane & 7;
#pragma unroll
    for (int j = 0; j < 4; ++j) { const int n = (lane >> 3) + 8 * j; const LAS float* s = scr + (8 * c) * 33 + n;
        u32x4 o; o.x = pk2(s[0 * 33], s[1 * 33]); o.y = pk2(s[2 * 33], s[3 * 33]); o.z = pk2(s[4 * 33], s[5 * 33]); o.w = pk2(s[6 * 33], s[7 * 33]);
        *(u32x4*)(WT + (size_t)(n0 + n) * K + k0 + 8 * c) = o; }
    LDS_WAIT();
}

__device__ __forceinline__ void phase0(const Params& p, LAS unsigned char* lds, int bid, int nb) {
    const int tid = threadIdx.x, lane = tid & 63, wave = __builtin_amdgcn_readfirstlane(tid >> 6);
    unsigned char* ws = p.ws;
    bf16_t* XN = (bf16_t*)(ws + WS_XN); bf16_t* WinT = (bf16_t*)(ws + WS_WIN); bf16_t* WoutT = (bf16_t*)(ws + WS_WOUT); bf16_t* WsT = (bf16_t*)(ws + WS_WS);
    const int gw = bid * 8 + wave, NGW = nb * 8;
    const int gt = bid * 512 + tid, NGT = nb * 512;

    {
        LAS float* SKT = (LAS float*)lds;
        LAS float* WQT = (LAS float*)(lds + 128 * 132 * 4);
        for (int item = bid; item < 256; item += nb) {
            const int hc = item >> 4, kb = item & 15;
            __syncthreads();
            for (int e = tid; e < 128 * 128; e += 512) { const int n = e >> 7, d = e & 127; SKT[d * 132 + n] = p.subkeys[(size_t)hc * 16384 + e]; }
            for (int e = tid; e < 64 * 128; e += 512) { const int k = e >> 7, d = e & 127; WQT[d * 68 + k] = p.w_q[(size_t)(kb * 64 + k) * 2048 + hc * 128 + d]; }
            __syncthreads();
            const int tn = tid & 31, tk = tid >> 5;
            f32x4 acc[4];
#pragma unroll
            for (int i = 0; i < 4; ++i) acc[i] = (f32x4){0.f, 0.f, 0.f, 0.f};
#pragma unroll 4
            for (int d = 0; d < 128; ++d) {
                const f32x4 sk = *(const LAS f32x4*)(SKT + d * 132 + 4 * tn); const f32x4 wq = *(const LAS f32x4*)(WQT + d * 68 + 4 * tk);
#pragma unroll
                for (int i = 0; i < 4; ++i) acc[i] += sk[i] * wq;
            }
            const f32x4 gg = *(const f32x4*)(p.g2 + kb * 64 + 4 * tk);
#pragma unroll
            for (int i = 0; i < 4; ++i) { const f32x4 v = acc[i] * gg; u32x2 o; o.x = pk2(v[0], v[1]); o.y = pk2(v[2], v[3]);
                *(u32x2*)(WsT + (size_t)(hc * 128 + 4 * tn + i) * DM + kb * 64 + 4 * tk) = o; }
        }
        __syncthreads();
    }
    {
        LAS float* scr = (LAS float*)(lds + wave * 16384);
        constexpr int I_IN = (DM / 64) * (NPROJ / 32), I_OUT = (DM / 64) * (DM / 32);
        for (int it = gw; it < I_IN + I_OUT; it += NGW) {
            if (it < I_IN) transpose_item(p.w_in, DM, INW, WinT, scr, it, NPROJ / 32, lane, MapIn());
            else transpose_item(p.w_out, DM, DM, WoutT, scr, it - I_IN, DM / 32, lane, MapId());
        }
    }
    for (int e = gt; e < 256 * DM; e += NGT) {
        const int n = e >> 10, k = e & 1023; const float* wr = p.w_in + (size_t)k * INW + S_GA; float s = 0.f;
#pragma unroll
        for (int r = 0; r < 16; ++r) s += wr[r] * p.gw2[r * 256 + n];
        WinT[(size_t)(NPROJ + n) * DM + k] = (bf16_t)f2bf(s);
    }
#if PEER_FP8
    {
        u32x4* U8 = (u32x4*)(ws + WS_UB); u32x4* V8 = (u32x4*)(ws + WS_VB);
        for (int e = gt; e < NEXP * DM / 16; e += NGT) {
            const f32x4* us = (const f32x4*)p.pu + 4 * (size_t)e; const f32x4* vs = (const f32x4*)p.pv + 4 * (size_t)e;
            u32x4 wu, wv; unsigned tu[4], tv[4];
            const f32x4* g2s = (const f32x4*)p.g2 + 4 * (e & 63);
#pragma unroll
            for (int j = 0; j < 4; ++j) { const f32x4 a = us[j] * g2s[j] * 512.0f, b = vs[j] * 32.0f;
                int w = __builtin_amdgcn_cvt_pk_fp8_f32(a[0], a[1], 0, false); w = __builtin_amdgcn_cvt_pk_fp8_f32(a[2], a[3], w, true); tu[j] = (unsigned)w;
                int x = __builtin_amdgcn_cvt_pk_fp8_f32(b[0], b[1], 0, false); x = __builtin_amdgcn_cvt_pk_fp8_f32(b[2], b[3], x, true); tv[j] = (unsigned)x; }
            wu = (u32x4){tu[0], tu[1], tu[2], tu[3]}; wv = (u32x4){tv[0], tv[1], tv[2], tv[3]};
            const int row = e >> 6, c16 = e & 63;
            const size_t dst = ((size_t)(c16 >> 3) * NEXP + row) * 8 + (c16 & 7);
            U8[dst] = wu; V8[dst] = wv; }
    }
#else
    {
        u32x2* UB = (u32x2*)(ws + WS_UB); u32x2* VB = (u32x2*)(ws + WS_VB);
        const f32x4* u4 = (const f32x4*)p.pu; const f32x4* v4 = (const f32x4*)p.pv;
        for (int e = gt; e < NEXP * DM / 4; e += NGT) { const f32x4 a = u4[e]; u32x2 o; o.x = pk2(a[0], a[1]); o.y = pk2(a[2], a[3]); UB[e] = o;
            const f32x4 b = v4[e]; u32x2 q; q.x = pk2(b[0], b[1]); q.y = pk2(b[2], b[3]); VB[e] = q; }
    }
#endif
    {
        float2* rope = (float2*)(ws + WS_ROPE);
        for (int e = gt; e < (SEQ + 64) * 32; e += NGT) { const int pi = e >> 5, d = e & 31;
            const float invf = (float)pow(10000.0, -(double)d / 32.0); const float ang = (float)(pi - 48) * invf;
            rope[e] = make_float2((float)cos((double)ang), (float)sin((double)ang)); }
    }
    for (int m = gw; m < MROWS; m += NGW) {
        const float* src = nullptr;
        if (m >= 256) src = p.x + (size_t)(m - 256) * DM; else if (m >= 48 && m < 64) src = p.meta + (size_t)(m - 48) * DM;
        unsigned long long* o8 = (unsigned long long*)(XN + (size_t)m * DM) + lane;
        if (src == nullptr) {
#pragma unroll
            for (int j = 0; j < 4; ++j) o8[64 * j] = 0ull;
        } else {
            const f32x4* xr = (const f32x4*)src + lane; const f32x4* gr = (const f32x4*)p.g1 + lane;
            f32x4 v[4]; float s = 0.f;
#pragma unroll
            for (int j = 0; j < 4; ++j) { v[j] = xr[64 * j]; s += (v[j].x * v[j].x + v[j].y * v[j].y) + (v[j].z * v[j].z + v[j].w * v[j].w); }
            const float r = 1.0f / sqrtf(wave_sum(s) * (1.0f / DM) + EPS);
#pragma unroll
            for (int j = 0; j < 4; ++j) { const f32x4 g = gr[64 * j]; const f32x4 y = v[j] * r * g;
                o8[64 * j] = (unsigned long long)pk2(y.x, y.y) | ((unsigned long long)pk2(y.z, y.w) << 32); }
        }
    }
}

struct EpiProj {
    static constexpr bool PERM = true, AFTER_DRAIN = false;
    bf16_t* PROJ; float* LA; const float* gb; const float2* rope;
    __device__ __forceinline__ void operator()(const pg8::f32x4 (&acc)[2][2][4][2], const pg8::Unit& u, int wr, int wc, int fr, int fq) const {
        const int row0 = u.pm * 256 + wr * 64 + fr, cb0 = wc * 32 + 8 * fq;
        if (u.pn == 12) {
#pragma unroll
            for (int bj = 0; bj < 2; ++bj) { const int c = cb0 + 128 * bj; const f32x4 b0 = *(const f32x4*)(gb + c), b1 = *(const f32x4*)(gb + c + 4);
#pragma unroll
                for (int ai = 0; ai < 2; ++ai)
#pragma unroll
                    for (int m = 0; m < 4; ++m) { const int row = row0 + ai * 128 + m * 16; f32x4 v0 = acc[ai][bj][m][0] + b0, v1 = acc[ai][bj][m][1] + b1;
#pragma unroll
                        for (int i = 0; i < 4; ++i) { v0[i] = (fminf(v0[i], 0.f) - log1pf(__expf(-fabsf(v0[i])))) * 0.0625f; v1[i] = (fminf(v1[i], 0.f) - log1pf(__expf(-fabsf(v1[i])))) * 0.0625f; }
                        float* o = LA + (size_t)row * 256 + c; *(f32x4*)o = v0; *(f32x4*)(o + 4) = v1; } }
        } else if (u.pn == 6 || u.pn == 7) {
#pragma unroll
            for (int ai = 0; ai < 2; ++ai)
#pragma unroll
                for (int m = 0; m < 4; ++m) { const int row = row0 + ai * 128 + m * 16; const int pidx = (row < 256) ? row : 64 + ((row - 256) & (SEQ - 1));
#pragma unroll
                    for (int bj = 0; bj < 2; ++bj) { const int c = cb0 + 128 * bj, d0 = (c & 63) >> 1;
                        const f32x4 cs0 = *(const f32x4*)(rope + (size_t)pidx * 32 + d0), cs1 = *(const f32x4*)(rope + (size_t)pidx * 32 + d0 + 2);
                        const f32x4 t1 = acc[ai][bj][m][0], t2 = acc[ai][bj][m][1];
                        const float co[4] = {cs0[0], cs0[2], cs1[0], cs1[2]}, si[4] = {cs0[1], cs0[3], cs1[1], cs1[3]};
                        float o1[4], o2[4];
#pragma unroll
                        for (int i = 0; i < 4; ++i) { o1[i] = t1[i] * co[i] - t2[i] * si[i]; o2[i] = t1[i] * si[i] + t2[i] * co[i]; }
                        u32x4 w; w.x = pg8::cvt_pk_bf16(o1[0], o1[1]); w.y = pg8::cvt_pk_bf16(o1[2], o1[3]); w.z = pg8::cvt_pk_bf16(o2[0], o2[1]); w.w = pg8::cvt_pk_bf16(o2[2], o2[3]);
                        *(u32x4*)(PROJ + (size_t)row * NPROJ + u.pn * 256 + c) = w; } }
        } else {
#pragma unroll
            for (int ai = 0; ai < 2; ++ai)
#pragma unroll
                for (int m = 0; m < 4; ++m) { bf16_t* rowp = PROJ + (size_t)(row0 + ai * 128 + m * 16) * NPROJ + u.pn * 256 + cb0;
#pragma unroll
                    for (int bj = 0; bj < 2; ++bj) { const f32x4 v0 = acc[ai][bj][m][0], v1 = acc[ai][bj][m][1];
                        u32x4 w; w.x = pg8::cvt_pk_bf16(v0[0], v0[1]); w.y = pg8::cvt_pk_bf16(v0[2], v0[3]); w.z = pg8::cvt_pk_bf16(v1[0], v1[1]); w.w = pg8::cvt_pk_bf16(v1[2], v1[3]);
                        *(u32x4*)(rowp + bj * 128) = w; } }
        }
    }
};
struct EpiRes {
    static constexpr bool PERM = true, AFTER_DRAIN = false;
    const float* x; bf16_t* HB; float* SSQ;
    __device__ __forceinline__ void operator()(const pg8::f32x4 (&acc)[2][2][4][2], const pg8::Unit& u, int wr, int wc, int fr, int fq) const {
        const int row0 = u.pm * 256 + wr * 64 + fr, col0 = u.pn * 256 + wc * 32 + 8 * fq;
#pragma unroll
        for (int ai = 0; ai < 2; ++ai)
#pragma unroll
            for (int m = 0; m < 4; ++m) { const int row = row0 + ai * 128 + m * 16; const float* xr = x + (size_t)row * DM + col0; bf16_t* hr = HB + (size_t)row * DM + col0; float ss = 0.f;
#pragma unroll
                for (int bj = 0; bj < 2; ++bj) { const f32x4 v0 = acc[ai][bj][m][0] + *(const f32x4*)(xr + bj * 128), v1 = acc[ai][bj][m][1] + *(const f32x4*)(xr + bj * 128 + 4);
                    ss += (v0[0] * v0[0] + v0[1] * v0[1]) + (v0[2] * v0[2] + v0[3] * v0[3]) + (v1[0] * v1[0] + v1[1] * v1[1]) + (v1[2] * v1[2] + v1[3] * v1[3]);
                    u32x4 w; w.x = pg8::cvt_pk_bf16(v0[0], v0[1]); w.y = pg8::cvt_pk_bf16(v0[2], v0[3]); w.z = pg8::cvt_pk_bf16(v1[0], v1[1]); w.w = pg8::cvt_pk_bf16(v1[2], v1[3]);
                    *(u32x4*)(hr + bj * 128) = w; }
                ss += __shfl_xor(ss, 16); ss += __shfl_xor(ss, 32);
                if (fq == 0) SSQ[(size_t)row * 16 + u.pn * 4 + wc] = ss; }
    }
};
struct EpiF16 {
    static constexpr bool PERM = true, AFTER_DRAIN = false;
    _Float16* SC;
    __device__ __forceinline__ void operator()(const pg8::f32x4 (&acc)[2][2][4][2], const pg8::Unit& u, int wr, int wc, int fr, int fq) const {
        const int row0 = u.pm * 256 + wr * 64 + fr, col0 = u.pn * 256 + wc * 32 + 8 * fq;
#pragma unroll
        for (int ai = 0; ai < 2; ++ai)
#pragma unroll
            for (int m = 0; m < 4; ++m) { _Float16* rowp = SC + (size_t)(row0 + ai * 128 + m * 16) * 2048 + col0;
#pragma unroll
                for (int bj = 0; bj < 2; ++bj) { const f32x4 v0 = acc[ai][bj][m][0], v1 = acc[ai][bj][m][1];
                    u32x4 w;
                    w.x = __builtin_bit_cast(unsigned, (f16x2_t){(_Float16)v0[0], (_Float16)v0[1]}); w.y = __builtin_bit_cast(unsigned, (f16x2_t){(_Float16)v0[2], (_Float16)v0[3]});
                    w.z = __builtin_bit_cast(unsigned, (f16x2_t){(_Float16)v1[0], (_Float16)v1[1]}); w.w = __builtin_bit_cast(unsigned, (f16x2_t){(_Float16)v1[2], (_Float16)v1[3]});
                    *(u32x4*)(rowp + bj * 128) = w; } }
    }
};

constexpr int A_QT = 0, A_KT = 9216, A_KE = 18432, A_V = 27648, A_ST = 45056, A_STSZ = 18432, A_OB = 81920, A_DEC = 115712, A_CS = 115968;
constexpr int PQ = 72, PV = 136, POB = 132;

__device__ __forceinline__ bf16x8 tr2(const LAS bf16_t* p0, const LAS bf16_t* p1) {
    const s16x4 a = __builtin_amdgcn_ds_read_tr16_b64_v4i16((LAS s16x4*)p0), b = __builtin_amdgcn_ds_read_tr16_b64_v4i16((LAS s16x4*)p1);
    return (bf16x8){a[0], a[1], a[2], a[3], b[0], b[1], b[2], b[3]};
}
__device__ __forceinline__ float ln_gamma(int hr) { return log1pf(-exp2f(-5.0f - (float)hr)); }

template <bool FULL>
__device__ __forceinline__ void attn_pass(const Params& p, LAS unsigned char* lds, int bid, int nb) {
    const int tid = threadIdx.x, lane = tid & 63, wave = __builtin_amdgcn_readfirstlane(tid >> 6);
    const int r16 = lane & 15, g4 = lane >> 4, q4 = (lane & 15) >> 2, p4 = lane & 3;
    unsigned char* ws = p.ws;
    const bf16_t* PROJ = (const bf16_t*)(ws + WS_PROJ); const float* LA = (const float*)(ws + WS_LA);
    float* SEG = (float*)(ws + WS_SEG); float* ASEG = (float*)(ws + WS_ASEG); bf16_t* OUT = (bf16_t*)(ws + WS_O);
    LAS bf16_t* QT = (LAS bf16_t*)(lds + A_QT); LAS bf16_t* KT = (LAS bf16_t*)(lds + A_KT); LAS bf16_t* KE = (LAS bf16_t*)(lds + A_KE); LAS bf16_t* VS = (LAS bf16_t*)(lds + A_V);
    LAS float* OB = (LAS float*)(lds + A_OB); LAS float* DEC = (LAS float*)(lds + A_DEC); LAS float* CS = (LAS float*)(lds + A_CS);

    for (int item = bid; item < 256; item += nb) {
        const int seg = item & 7, h8 = (item >> 3) & 7, b = item >> 6;
        if (!FULL && seg == 7) continue;
        const bool gla = h8 < 4; const int hr = h8 & 3;
        const float lng = ln_gamma(hr);
        const int qcol = gla ? C_GQ + hr * 64 : C_RQ + hr * 64, kcol = gla ? C_GK + hr * 64 : C_RK + hr * 64;
        const int vcol = gla ? C_GV + hr * 128 : C_RV + hr * 128, gcol = gla ? C_GG + hr * 128 : C_RG + hr * 128;
        const int nch = (seg == 0) ? 17 : 16;

        f32x4 accS[8];
#pragma unroll
        for (int cb = 0; cb < 8; ++cb) accS[cb] = (f32x4){0.f, 0.f, 0.f, 0.f};
        float blsum = 0.f;
        __syncthreads();
        if (FULL) {
            if (wave >= 4) {
                const int wq = wave - 4;
                for (int sp = 0; sp < seg; ++sp) { const int it2 = (item & ~7) + sp; const float* Sg = SEG + (size_t)it2 * 8192; const float* Ag = ASEG + it2 * 64;
                    float dec[4];
#pragma unroll
                    for (int rg = 0; rg < 4; ++rg) dec[rg] = Ag[16 * wq + 4 * g4 + rg];
#pragma unroll
                    for (int cb = 0; cb < 8; ++cb)
#pragma unroll
                        for (int rg = 0; rg < 4; ++rg) accS[cb][rg] = dec[rg] * accS[cb][rg] + Sg[(16 * wq + 4 * g4 + rg) * 128 + 16 * cb + r16]; }
                LAS bf16_t* ST0 = (LAS bf16_t*)(lds + A_ST);
#pragma unroll
                for (int cb = 0; cb < 8; ++cb) { u32x2 w; w.x = pk2(accS[cb][0], accS[cb][1]); w.y = pk2(accS[cb][2], accS[cb][3]); *(LAS u32x2*)(ST0 + (16 * cb + r16) * PQ + 16 * wq + 4 * g4) = w; }
            }
        }
#define A_ROWBASE(ci_) (((seg == 0 && (ci_) == 0)) ? 0 : 256 + b * SEQ + ((seg == 0) ? (ci_) - 1 : 16 * seg + (ci_)) * 64)
        const int d = tid & 63, sg = tid >> 6;
        float lav[8]; bf16_t qv[8], kv[8]; u32x4 vreg[2];
#define A_LOADCHUNK(ci_) do { const int _rb = A_ROWBASE(ci_); \
            if (gla) { _Pragma("unroll") for (int k = 0; k < 8; ++k) lav[k] = LA[(size_t)(_rb + 8 * sg + k) * 256 + hr * 64 + d]; } \
            else { _Pragma("unroll") for (int k = 0; k < 8; ++k) lav[k] = lng; } \
            _Pragma("unroll") for (int k = 0; k < 8; ++k) { const size_t row = (size_t)(_rb + 8 * sg + k); \
                if (FULL) qv[k] = PROJ[row * NPROJ + qcol + d]; kv[k] = PROJ[row * NPROJ + kcol + d]; } \
            { const int vr = tid >> 3, cc = tid & 7; const u32x4* src = (const u32x4*)(PROJ + (size_t)(_rb + vr) * NPROJ + vcol + cc * 16); vreg[0] = src[0]; vreg[1] = src[1]; } } while (0)
#define A_LBAR() do { asm volatile("s_waitcnt lgkmcnt(0)" ::: "memory"); __builtin_amdgcn_s_barrier(); asm volatile("" ::: "memory"); } while (0)
        A_LOADCHUNK(0);
        f32x4 gnv[4], bsv[4];
        { const float* gptr = (gla ? p.gla_gain : p.ret_gain) + 16 * (tid & 7); const float* bptr = p.ret_bias + 16 * (tid & 7); const float bsc = gla ? 0.f : 1.f;
#pragma unroll
          for (int k4 = 0; k4 < 4; ++k4) { gnv[k4] = *(const f32x4*)(gptr + 4 * k4); bsv[k4] = *(const f32x4*)(bptr + 4 * k4) * bsc; } }
        for (int ci = 0; ci < nch; ++ci) {
            const bool metac = (seg == 0 && ci == 0);
            const int rowbase = A_ROWBASE(ci);
            const LAS bf16_t* STr = (const LAS bf16_t*)(lds + A_ST + (ci & 1) * A_STSZ); LAS bf16_t* STw = (LAS bf16_t*)(lds + A_ST + ((ci + 1) & 1) * A_STSZ);
            u32x4 gpre[2] = {(u32x4){0u, 0u, 0u, 0u}, (u32x4){0u, 0u, 0u, 0u}};
            if (FULL && !metac) { const u32x4* gp = (const u32x4*)(PROJ + (size_t)(rowbase + (tid >> 3)) * NPROJ + gcol + 16 * (tid & 7)); gpre[0] = gp[0]; gpre[1] = gp[1]; }
            float pre[8];
            {
                float run = 0.f;
#pragma unroll
                for (int k = 0; k < 8; ++k) { run += lav[k]; pre[k] = run; }
                CS[sg * 64 + d] = run;
            }
            A_LBAR();
            {
                float off = 0.f, tot = 0.f;
#pragma unroll
                for (int s = 0; s < 8; ++s) { const float c = CS[s * 64 + d]; tot += c; off += (s < sg) ? c : 0.f; }
#pragma unroll
                for (int k = 0; k < 8; ++k) { const float bc = off + pre[k]; const int i = 8 * sg + k; const float kf = bf1(kv[k]);
                    if (FULL) { QT[i * PQ + d] = (bf16_t)f2bf(bf1(qv[k]) * __expf(bc)); KT[i * PQ + d] = (bf16_t)f2bf(kf * __expf(-bc)); }
                    KE[i * PQ + d] = (bf16_t)f2bf(kf * __expf(tot - bc)); }
                if (sg == 0) { DEC[d] = __expf(tot); blsum += tot; }
                const int vr = tid >> 3, cc = tid & 7; LAS u32x4* dst = (LAS u32x4*)(VS + vr * PV + cc * 16); dst[0] = vreg[0]; dst[1] = vreg[1];
            }
            if (ci + 1 < nch) A_LOADCHUNK(ci + 1);
            A_LBAR();
            if (wave < 4) {
                if (FULL && !metac) {
                    const int w = wave;
                    bf16x8 qf[2];
#pragma unroll
                    for (int s = 0; s < 2; ++s) qf[s] = *(const LAS bf16x8*)(QT + (16 * w + r16) * PQ + 32 * s + 8 * g4);
                    f32x4 att[4];
#pragma unroll
                    for (int jb = 0; jb < 4; ++jb) { att[jb] = (f32x4){0.f, 0.f, 0.f, 0.f};
                        if (jb <= w) {
#pragma unroll
                            for (int s = 0; s < 2; ++s) { const bf16x8 kf = *(const LAS bf16x8*)(KT + (16 * jb + r16) * PQ + 32 * s + 8 * g4);
                                att[jb] = __builtin_amdgcn_mfma_f32_16x16x32_bf16(kf, qf[s], att[jb], 0, 0, 0); }
                            if (jb == w) {
#pragma unroll
                                for (int rg = 0; rg < 4; ++rg) att[jb][rg] = (4 * g4 + rg <= r16) ? att[jb][rg] : 0.f;
                            }
                        } }
                    bf16x8 af[2];
#pragma unroll
                    for (int s = 0; s < 2; ++s) { u32x4 t; t.x = pk2(att[2 * s][0], att[2 * s][1]); t.y = pk2(att[2 * s][2], att[2 * s][3]); t.z = pk2(att[2 * s + 1][0], att[2 * s + 1][1]); t.w = pk2(att[2 * s + 1][2], att[2 * s + 1][3]);
                        af[s] = __builtin_bit_cast(bf16x8, t); }
#pragma unroll
                    for (int cb = 0; cb < 8; ++cb) { f32x4 o = (f32x4){0.f, 0.f, 0.f, 0.f};
#pragma unroll
                        for (int s = 0; s < 2; ++s) {
                            const bf16x8 vf = tr2(VS + (32 * s + 4 * g4 + q4) * PV + 16 * cb + 4 * p4, VS + (32 * s + 16 + 4 * g4 + q4) * PV + 16 * cb + 4 * p4);
                            o = __builtin_amdgcn_mfma_f32_16x16x32_bf16(af[s], vf, o, 0, 0, 0);
                            const bf16x8 sf = *(const LAS bf16x8*)(STr + (16 * cb + r16) * PQ + 32 * s + 8 * g4);
                            o = __builtin_amdgcn_mfma_f32_16x16x32_bf16(qf[s], sf, o, 0, 0, 0); }
#pragma unroll
                        for (int rg = 0; rg < 4; ++rg) OB[(16 * w + 4 * g4 + rg) * POB + 16 * cb + r16] = o[rg]; }
                }
            } else {
                const int wq = wave - 4;
                float dec[4];
#pragma unroll
                for (int rg = 0; rg < 4; ++rg) dec[rg] = DEC[16 * wq + 4 * g4 + rg];
                bf16x8 kef[2];
#pragma unroll
                for (int s = 0; s < 2; ++s) kef[s] = tr2(KE + (32 * s + 8 * g4 + q4) * PQ + 16 * wq + 4 * p4, KE + (32 * s + 8 * g4 + 4 + q4) * PQ + 16 * wq + 4 * p4);
#pragma unroll
                for (int cb = 0; cb < 8; ++cb) {
#pragma unroll
                    for (int rg = 0; rg < 4; ++rg) accS[cb][rg] *= dec[rg];
#pragma unroll
                    for (int s = 0; s < 2; ++s) { const bf16x8 vf = tr2(VS + (32 * s + 8 * g4 + q4) * PV + 16 * cb + 4 * p4, VS + (32 * s + 8 * g4 + 4 + q4) * PV + 16 * cb + 4 * p4);
                        accS[cb] = __builtin_amdgcn_mfma_f32_16x16x32_bf16(kef[s], vf, accS[cb], 0, 0, 0); }
                    if (FULL) { u32x2 w; w.x = pk2(accS[cb][0], accS[cb][1]); w.y = pk2(accS[cb][2], accS[cb][3]); *(LAS u32x2*)(STw + (16 * cb + r16) * PQ + 16 * wq + 4 * g4) = w; }
                }
            }
            A_LBAR();
            if (FULL && !metac) {
                const int i = tid >> 3, cc = tid & 7;
                float o[16];
#pragma unroll
                for (int k4 = 0; k4 < 4; ++k4) { const f32x4 t = *(const LAS f32x4*)(OB + i * POB + 16 * cc + 4 * k4); o[4 * k4] = t[0]; o[4 * k4 + 1] = t[1]; o[4 * k4 + 2] = t[2]; o[4 * k4 + 3] = t[3]; }
                const size_t row = (size_t)(rowbase + i);
                const u32x4 ga = gpre[0], gb2 = gpre[1];
                const unsigned gw[8] = {ga.x, ga.y, ga.z, ga.w, gb2.x, gb2.y, gb2.z, gb2.w};
                float s1 = 0.f, s2 = 0.f;
#pragma unroll
                for (int k = 0; k < 16; ++k) { s1 += o[k]; s2 += o[k] * o[k]; }
#pragma unroll
                for (int m = 1; m < 8; m <<= 1) { s1 += __shfl_xor(s1, m); s2 += __shfl_xor(s2, m); }
                const float mu = gla ? 0.f : s1 * (1.0f / 128.0f);
                const float rs = __builtin_amdgcn_rsqf(fmaxf(s2 * (1.0f / 128.0f) - mu * mu, 0.f) + EPS);
                unsigned ow[8];
#pragma unroll
                for (int k2 = 0; k2 < 8; ++k2) { float y[2];
#pragma unroll
                    for (int e = 0; e < 2; ++e) { const int k = 2 * k2 + e; const float v = (o[k] - mu) * rs * gnv[k >> 2][k & 3] + bsv[k >> 2][k & 3];
                        const float gt = e ? bf_hi(gw[k2]) : bf_lo(gw[k2]); y[e] = v * gt * __builtin_amdgcn_rcpf(1.0f + __expf(-gt)); }
                    ow[k2] = pk2(y[0], y[1]); }
                u32x4* op = (u32x4*)(OUT + (row - 256) * DM + h8 * 128 + 16 * cc);
                op[0] = (u32x4){ow[0], ow[1], ow[2], ow[3]}; op[1] = (u32x4){ow[4], ow[5], ow[6], ow[7]};
            }
        }
        if (!FULL) {
            if (wave >= 4) { const int wq = wave - 4; float* Sg = SEG + (size_t)item * 8192;
#pragma unroll
                for (int cb = 0; cb < 8; ++cb)
#pragma unroll
                    for (int rg = 0; rg < 4; ++rg) Sg[(16 * wq + 4 * g4 + rg) * 128 + 16 * cb + r16] = accS[cb][rg]; }
            if (tid < 64) ASEG[item * 64 + tid] = __expf(blsum);
        }
#undef A_LBAR
#undef A_ROWBASE
#undef A_LOADCHUNK
    }
}

__device__ __forceinline__ unsigned ord32(float f) { const unsigned b = __builtin_bit_cast(unsigned, f); return b ^ ((b >> 31) ? 0xffffffffu : 0x80000000u); }
__device__ __forceinline__ float unord32(unsigned o) { const unsigned b = (o >> 31) ? (o ^ 0x80000000u) : ~o; return __builtin_bit_cast(float, b); }
#define DPP_MAXU(v, ctrl, rmask) do { const unsigned _t = (unsigned)__builtin_amdgcn_update_dpp((int)(v), (int)(v), (ctrl), (rmask), 0xf, false); (v) = (v) > _t ? (v) : _t; } while (0)
#define DPP_ADDF(v, ctrl) do { const float _t = __builtin_bit_cast(float, __builtin_amdgcn_update_dpp(0, __builtin_bit_cast(int, (v)), (ctrl), 0xf, 0xf, false)); (v) += _t; } while (0)
__device__ __forceinline__ unsigned row_max_u(unsigned v) { DPP_MAXU(v, 0xB1, 0xf); DPP_MAXU(v, 0x4E, 0xf); DPP_MAXU(v, 0x124, 0xf); DPP_MAXU(v, 0x128, 0xf); return v; }
__device__ __forceinline__ float row_sum_f(float v) { DPP_ADDF(v, 0xB1); DPP_ADDF(v, 0x4E); DPP_ADDF(v, 0x124); DPP_ADDF(v, 0x128); return v; }
__device__ __forceinline__ unsigned wave_max_u(unsigned v) { v = row_max_u(v); DPP_MAXU(v, 0x142, 0xa); DPP_MAXU(v, 0x143, 0xc); return (unsigned)__builtin_amdgcn_readlane((int)v, 63); }

__device__ __forceinline__ float row_sum_x(float v) { return row_sum_f(v); }
__device__ __forceinline__ float dot2_bf16(unsigned w, unsigned x, float acc) { return __builtin_amdgcn_fdot2_f32_bf16(__builtin_bit_cast(bf16x2_t, w), __builtin_bit_cast(bf16x2_t, x), acc, false); }
__device__ __forceinline__ float gelu_exact(float v) { return 0.5f * v * (1.0f + erff(v * 0.70710678118654752f)); }

__device__ __forceinline__ void phase_peer(const Params& p, LAS unsigned char* lds, int bid, int nb) {
    const int tid = threadIdx.x, lane = tid & 63, wave = __builtin_amdgcn_readfirstlane(tid >> 6);
    const int p16 = lane & 15, rg4 = lane >> 4;
    unsigned char* ws = p.ws;
    const _Float16* SC = (const _Float16*)(ws + WS_PROJ); const bf16_t* HB = (const bf16_t*)(ws + WS_XN); const float* SSQ = (const float*)(ws + WS_SSQ);
    const unsigned char* UB = (const unsigned char*)(ws + WS_UB); const unsigned char* VB = (const unsigned char*)(ws + WS_VB);
    LAS float* A_s = (LAS float*)(lds + wave * 4096);
    LAS int* A_i = (LAS int*)(lds + wave * 4096 + 1024);
    LAS int* E_i = (LAS int*)(lds + wave * 4096 + 2048);
    LAS float* E_s = (LAS float*)(lds + wave * 4096 + 2560);
    int ci = 0, cj = 0; bool cvalid = lane < 50;
    { int l = lane;
      if (l < 16) { ci = 0; cj = l; } else if (l < 24) { ci = 1; cj = l - 16; } else if (l < 29) { ci = 2; cj = l - 24; } else if (l < 33) { ci = 3; cj = l - 29; }
      else if (l < 36) { ci = 4; cj = l - 33; } else if (l < 42) { ci = 5 + (l - 36) / 2; cj = (l - 36) & 1; } else { ci = 8 + (l - 42); cj = 0; } if (!cvalid) { ci = 0; cj = 0; } }
    const int gw = bid * 8 + wave, NGW = nb * 8;
    for (int t = gw; t < NTOK; t += NGW) {
        float ssq = (lane < 16) ? SSQ[(size_t)t * 16 + lane] : 0.f; ssq = wave_sum(ssq);
        const float rstd = 1.0f / sqrtf(ssq * (1.0f / DM) + EPS);
#pragma unroll 1
        for (int q = 0; q < 4; ++q) {
            const u32x4 raw = *(const u32x4*)(SC + (size_t)t * 2048 + 512 * q + 8 * lane);
            const unsigned rw[4] = {raw.x, raw.y, raw.z, raw.w};
            unsigned key[8];
#pragma unroll
            for (int e = 0; e < 8; ++e) { const unsigned hbits = (e & 1) ? (rw[e >> 1] >> 16) : (rw[e >> 1] & 0xffffu);
                const float f = (float)__builtin_bit_cast(_Float16, (unsigned short)hbits);
                key[e] = (ord32(f) & ~0x7fu) | (unsigned)(127 - (8 * p16 + e)); }
            unsigned mine = 0u;
#pragma unroll 1
            for (int it = 0; it < 16; ++it) {
                unsigned m = key[0];
#pragma unroll
                for (int e = 1; e < 8; ++e) m = m > key[e] ? m : key[e];
                const unsigned W = row_max_u(m);
                mine = (p16 == it) ? W : mine;
#pragma unroll
                for (int e = 0; e < 8; ++e) key[e] = (key[e] == W) ? 0u : key[e];
            }
            const int g = 4 * q + rg4;
            A_s[g * 16 + p16] = unord32(mine & ~0x7fu); A_i[g * 16 + p16] = 127 - (int)(mine & 0x7fu);
        }
        LDS_WAIT();
#pragma unroll 1
        for (int h = 0; h < 8; ++h) {
            const float sa = A_s[(2 * h) * 16 + ci], sb = A_s[(2 * h + 1) * 16 + cj];
            const int ia = A_i[(2 * h) * 16 + ci], ib = A_i[(2 * h + 1) * 16 + cj];
            const float sum = sa + sb;
            unsigned key = cvalid ? ((ord32(sum) & ~0x3fu) | (unsigned)(63 - lane)) : 0u;
            int rank = -1;
#pragma unroll 1
            for (int it = 0; it < 16; ++it) { const unsigned W = wave_max_u(key); if (key == W) { rank = it; key = 0u; } }
            if (rank >= 0) { E_i[h * 16 + rank] = ia * 128 + ib; E_s[h * 16 + rank] = sum; }
        }
        LDS_WAIT();
        float gsm[2]; int eidx[2];
#pragma unroll
        for (int sl = 0; sl < 2; ++sl) { const int e = lane + 64 * sl; const float s = E_s[e] * rstd, mx = E_s[e & ~15] * rstd; const float pe = __expf(s - mx); const float den = row_sum_x(pe);
            gsm[sl] = pe / den; eidx[sl] = E_i[e]; }
#if PEER_FP8
        f32x2v xf[4][8];
#pragma unroll
        for (int i = 0; i < 4; ++i) { const u32x4 h0 = *(const u32x4*)(HB + (size_t)t * DM + 256 * i + 16 * p16), h1 = *(const u32x4*)(HB + (size_t)t * DM + 256 * i + 16 * p16 + 8);
            const unsigned hv[8] = {h0.x, h0.y, h0.z, h0.w, h1.x, h1.y, h1.z, h1.w}; const float* gp = p.g2 + 256 * i + 16 * p16;
#pragma unroll
            for (int k2 = 0; k2 < 8; ++k2) { const f32x2v g = *(const f32x2v*)(gp + 2 * k2); xf[i][k2] = (f32x2v){bf_lo(hv[k2]) * rstd * g.x, bf_hi(hv[k2]) * rstd * g.y}; } }
        constexpr int NBB = 2;
#define P6_LOADB(buf, TAB, bt0) do { _Pragma("unroll") for (int j = 0; j < NBB; ++j) { const int bt = (bt0) + j; const int ex = E_i[64 * (bt >> 4) + 16 * rg4 + (bt & 15)]; \
            const unsigned char* rp = (TAB) + (size_t)ex * 1024 + 16 * p16; _Pragma("unroll") for (int i = 0; i < 4; ++i) buf[j][i] = *(const u32x4*)(rp + 256 * i); } } while (0)
        u32x4 bA[NBB][4], bB[NBB][4];
        float act0 = 0.f, act1 = 0.f;
#define P6_COMPU(buf, bt0) do { _Pragma("unroll") for (int j = 0; j < NBB; ++j) { const int bt = (bt0) + j; f32x2v s2 = (f32x2v){0.f, 0.f}; \
            _Pragma("unroll") for (int i = 0; i < 4; ++i) { const unsigned uu[4] = {buf[j][i].x, buf[j][i].y, buf[j][i].z, buf[j][i].w}; \
                _Pragma("unroll") for (int w = 0; w < 4; ++w) { const f32x2v lo = __builtin_amdgcn_cvt_pk_f32_fp8((int)uu[w], false), hi = __builtin_amdgcn_cvt_pk_f32_fp8((int)uu[w], true); \
                    s2 = __builtin_elementwise_fma(lo, xf[i][2 * w], s2); s2 = __builtin_elementwise_fma(hi, xf[i][2 * w + 1], s2); } } \
            const float s = row_sum_x(s2.x + s2.y); const bool mine = (p16 == (bt & 15)); act0 = (mine && bt < 16) ? s : act0; act1 = (mine && bt >= 16) ? s : act1; } } while (0)
        P6_LOADB(bA, UB, 0);
#pragma unroll 1
        for (int g = 0; g < 32; g += 2 * NBB) { P6_LOADB(bB, UB, g + NBB); P6_COMPU(bA, g); if (g + 2 * NBB < 32) P6_LOADB(bA, UB, g + 2 * NBB); P6_COMPU(bB, g + NBB); }
        P6_LOADB(bA, VB, 0);
        LAS float* E_c = E_s;
        { const float c0 = gsm[0] * gelu_exact(act0 * (1.0f / 512.0f)) * (1.0f / 32.0f), c1 = gsm[1] * gelu_exact(act1 * (1.0f / 512.0f)) * (1.0f / 32.0f);
          LDS_WAIT(); E_c[lane] = c0; E_c[lane + 64] = c1; LDS_WAIT(); }
        f32x2v acc2[4][8];
#pragma unroll
        for (int i = 0; i < 4; ++i)
#pragma unroll
            for (int k = 0; k < 8; ++k) acc2[i][k] = (f32x2v){0.f, 0.f};
#define P6_COMPV(buf, bt0) do { _Pragma("unroll") for (int j = 0; j < NBB; ++j) { const int bt = (bt0) + j; const float cf = E_c[64 * (bt >> 4) + 16 * rg4 + (bt & 15)]; const f32x2v cf2 = (f32x2v){cf, cf}; \
            _Pragma("unroll") for (int i = 0; i < 4; ++i) { const unsigned vv[4] = {buf[j][i].x, buf[j][i].y, buf[j][i].z, buf[j][i].w}; \
                _Pragma("unroll") for (int w = 0; w < 4; ++w) { const f32x2v lo = __builtin_amdgcn_cvt_pk_f32_fp8((int)vv[w], false), hi = __builtin_amdgcn_cvt_pk_f32_fp8((int)vv[w], true); \
                    acc2[i][2 * w] = __builtin_elementwise_fma(lo, cf2, acc2[i][2 * w]); acc2[i][2 * w + 1] = __builtin_elementwise_fma(hi, cf2, acc2[i][2 * w + 1]); } } } } while (0)
#pragma unroll 1
        for (int g = 0; g < 32; g += 2 * NBB) { P6_LOADB(bB, VB, g + NBB); P6_COMPV(bA, g); if (g + 2 * NBB < 32) P6_LOADB(bA, VB, g + 2 * NBB); P6_COMPV(bB, g + NBB); }
#undef P6_LOADB
#undef P6_COMPU
#undef P6_COMPV
        float ss = 0.f;
#pragma unroll
        for (int i = 0; i < 4; ++i) { const u32x4 h0 = *(const u32x4*)(HB + (size_t)t * DM + 256 * i + 16 * p16), h1 = *(const u32x4*)(HB + (size_t)t * DM + 256 * i + 16 * p16 + 8);
            const unsigned hv[8] = {h0.x, h0.y, h0.z, h0.w, h1.x, h1.y, h1.z, h1.w};
#pragma unroll
            for (int k2 = 0; k2 < 8; ++k2) { float ax = acc2[i][k2].x, ay = acc2[i][k2].y;
                ax += __shfl_xor(ax, 16); ax += __shfl_xor(ax, 32); ay += __shfl_xor(ay, 16); ay += __shfl_xor(ay, 32);
                ax += bf_lo(hv[k2]); ay += bf_hi(hv[k2]); acc2[i][k2] = (f32x2v){ax, ay}; ss += ax * ax + ay * ay; } }
        ss = row_sum_x(ss);
        const float rf = 1.0f / sqrtf(ss * (1.0f / DM) + EPS);
#pragma unroll
        for (int i = 0; i < 4; ++i) { if (i == rg4) { const float* gp = p.gfin + 256 * i + 16 * p16; float* op = p.out + (size_t)t * DM + 256 * i + 16 * p16;
#pragma unroll
                for (int k4 = 0; k4 < 4; ++k4) { const f32x4 g = *(const f32x4*)(gp + 4 * k4);
                    *(f32x4*)(op + 4 * k4) = (f32x4){acc2[i][2 * k4].x * rf * g[0], acc2[i][2 * k4].y * rf * g[1], acc2[i][2 * k4 + 1].x * rf * g[2], acc2[i][2 * k4 + 1].y * rf * g[3]}; } } }
#else
        unsigned xp[8][4];
#pragma unroll
        for (int i = 0; i < 8; ++i) { const u32x4 hw = *(const u32x4*)(HB + (size_t)t * DM + 128 * i + 8 * p16); const f32x4 ga = *(const f32x4*)(p.g2 + 128 * i + 8 * p16), gb = *(const f32x4*)(p.g2 + 128 * i + 8 * p16 + 4);
            xp[i][0] = pk2(bf_lo(hw.x) * rstd * ga[0], bf_hi(hw.x) * rstd * ga[1]); xp[i][1] = pk2(bf_lo(hw.y) * rstd * ga[2], bf_hi(hw.y) * rstd * ga[3]);
            xp[i][2] = pk2(bf_lo(hw.z) * rstd * gb[0], bf_hi(hw.z) * rstd * gb[1]); xp[i][3] = pk2(bf_lo(hw.w) * rstd * gb[2], bf_hi(hw.w) * rstd * gb[3]); }
        float act[2] = {0.f, 0.f};
#pragma unroll
        for (int sl = 0; sl < 2; ++sl) {
#pragma unroll 2
            for (int b16 = 0; b16 < 16; ++b16) {
                const int e = 64 * sl + 16 * rg4 + b16; const int ex = E_i[e];
                const unsigned char* rowp = UB + (size_t)ex * 2048 + 16 * p16;
                float s = 0.f;
#pragma unroll
                for (int i = 0; i < 8; ++i) { const u32x4 uw = *(const u32x4*)(rowp + 256 * i);
                    s = dot2_bf16(uw.x, xp[i][0], s); s = dot2_bf16(uw.y, xp[i][1], s); s = dot2_bf16(uw.z, xp[i][2], s); s = dot2_bf16(uw.w, xp[i][3], s); }
                s = row_sum_x(s);
                act[sl] = (p16 == b16) ? s : act[sl];
            }
        }
        float coef[2];
#pragma unroll
        for (int sl = 0; sl < 2; ++sl) coef[sl] = gsm[sl] * gelu_exact(act[sl]);
        float acc[8][8];
#pragma unroll
        for (int i = 0; i < 8; ++i)
#pragma unroll
            for (int k = 0; k < 8; ++k) acc[i][k] = 0.f;
#pragma unroll
        for (int sl = 0; sl < 2; ++sl) {
#pragma unroll 2
            for (int b16 = 0; b16 < 16; ++b16) {
                const int srcl = (lane & 48) + b16;
                const float cf = __shfl(coef[sl], srcl); const int ex = __shfl(eidx[sl], srcl);
                const unsigned char* rowp = VB + (size_t)ex * 2048 + 16 * p16;
#pragma unroll
                for (int i = 0; i < 8; ++i) { const u32x4 vw = *(const u32x4*)(rowp + 256 * i);
                    acc[i][0] += cf * bf_lo(vw.x); acc[i][1] += cf * bf_hi(vw.x); acc[i][2] += cf * bf_lo(vw.y); acc[i][3] += cf * bf_hi(vw.y);
                    acc[i][4] += cf * bf_lo(vw.z); acc[i][5] += cf * bf_hi(vw.z); acc[i][6] += cf * bf_lo(vw.w); acc[i][7] += cf * bf_hi(vw.w); }
            }
        }
        float ss = 0.f;
#pragma unroll
        for (int i = 0; i < 8; ++i) { const u32x4 hw = *(const u32x4*)(HB + (size_t)t * DM + 128 * i + 8 * p16); const unsigned hv[4] = {hw.x, hw.y, hw.z, hw.w};
#pragma unroll
            for (int k = 0; k < 8; ++k) { float a = acc[i][k]; a += __shfl_xor(a, 16); a += __shfl_xor(a, 32);
                a += (k & 1) ? bf_hi(hv[k >> 1]) : bf_lo(hv[k >> 1]); acc[i][k] = a; ss += a * a; } }
        ss = row_sum_x(ss);
        const float rf = 1.0f / sqrtf(ss * (1.0f / DM) + EPS);
#pragma unroll
        for (int i = 0; i < 8; ++i) { if ((i >> 1) == rg4) { const f32x4 ga = *(const f32x4*)(p.gfin + 128 * i + 8 * p16), gb = *(const f32x4*)(p.gfin + 128 * i + 8 * p16 + 4);
                float* op = p.out + (size_t)t * DM + 128 * i + 8 * p16;
                *(f32x4*)op = (f32x4){acc[i][0] * rf * ga[0], acc[i][1] * rf * ga[1], acc[i][2] * rf * ga[2], acc[i][3] * rf * ga[3]};
                *(f32x4*)(op + 4) = (f32x4){acc[i][4] * rf * gb[0], acc[i][5] * rf * gb[1], acc[i][6] * rf * gb[2], acc[i][7] * rf * gb[3]}; } }
#endif
        LDS_WAIT();
    }
}


__device__ __forceinline__ void row_max4(unsigned k0, unsigned k1, unsigned k2, unsigned k3, unsigned& w0, unsigned& w1, unsigned& w2, unsigned& w3) {
    asm volatile("s_nop 1\n\t"
                 "v_max_u32_dpp %0, %4, %4 quad_perm:[1,0,3,2] row_mask:0xf bank_mask:0xf\n\t"
                 "v_max_u32_dpp %1, %5, %5 quad_perm:[1,0,3,2] row_mask:0xf bank_mask:0xf\n\t"
                 "v_max_u32_dpp %2, %6, %6 quad_perm:[1,0,3,2] row_mask:0xf bank_mask:0xf\n\t"
                 "v_max_u32_dpp %3, %7, %7 quad_perm:[1,0,3,2] row_mask:0xf bank_mask:0xf\n\t"
                 "v_max_u32_dpp %0, %0, %0 quad_perm:[2,3,0,1] row_mask:0xf bank_mask:0xf\n\t"
                 "v_max_u32_dpp %1, %1, %1 quad_perm:[2,3,0,1] row_mask:0xf bank_mask:0xf\n\t"
                 "v_max_u32_dpp %2, %2, %2 quad_perm:[2,3,0,1] row_mask:0xf bank_mask:0xf\n\t"
                 "v_max_u32_dpp %3, %3, %3 quad_perm:[2,3,0,1] row_mask:0xf bank_mask:0xf\n\t"
                 "v_max_u32_dpp %0, %0, %0 row_ror:4 row_mask:0xf bank_mask:0xf\n\t"
                 "v_max_u32_dpp %1, %1, %1 row_ror:4 row_mask:0xf bank_mask:0xf\n\t"
                 "v_max_u32_dpp %2, %2, %2 row_ror:4 row_mask:0xf bank_mask:0xf\n\t"
                 "v_max_u32_dpp %3, %3, %3 row_ror:4 row_mask:0xf bank_mask:0xf\n\t"
                 "v_max_u32_dpp %0, %0, %0 row_ror:8 row_mask:0xf bank_mask:0xf\n\t"
                 "v_max_u32_dpp %1, %1, %1 row_ror:8 row_mask:0xf bank_mask:0xf\n\t"
                 "v_max_u32_dpp %2, %2, %2 row_ror:8 row_mask:0xf bank_mask:0xf\n\t"
                 "v_max_u32_dpp %3, %3, %3 row_ror:8 row_mask:0xf bank_mask:0xf\n\t"
                 "s_nop 1"
                 : "=&v"(w0), "=&v"(w1), "=&v"(w2), "=&v"(w3) : "v"(k0), "v"(k1), "v"(k2), "v"(k3));
}
__device__ __forceinline__ unsigned pkadd_h2(unsigned a, unsigned b) { const h2v x = __builtin_bit_cast(h2v, a), y = __builtin_bit_cast(h2v, b); const h2v s = x + y; return __builtin_bit_cast(unsigned, s); }
constexpr int NT6 = 8;
constexpr int W6_BYTES = 16640;
__device__ __forceinline__ float dpp_f(float v, int ctrl_dummy);
#define DPPF(v, ctrl) __builtin_bit_cast(float, __builtin_amdgcn_update_dpp(0, __builtin_bit_cast(int, (v)), (ctrl), 0xf, 0xf, false))

__device__ __forceinline__ void phase_peer2(const Params& p, LAS unsigned char* lds, int bid, int nb) {
    const int tid = threadIdx.x, lane = tid & 63, wave = __builtin_amdgcn_readfirstlane(tid >> 6);
    const int p16 = lane & 15, rg4 = lane >> 4, q8 = lane >> 3, p8 = lane & 7;
    const bool b0 = lane & 1, b1 = lane & 2, b2 = lane & 4, c0 = lane & 8, c1 = lane & 16, c2 = lane & 32;
    unsigned char* ws = p.ws;
    const _Float16* SC = (const _Float16*)(ws + WS_PROJ); const bf16_t* HB = (const bf16_t*)(ws + WS_XN); const float* SSQ = (const float*)(ws + WS_SSQ);
    const unsigned char* UB = (const unsigned char*)(ws + WS_UB); const unsigned char* VB = (const unsigned char*)(ws + WS_VB); unsigned char* XQ = ws + WS_XQ;
    LAS unsigned char* wl = lds + wave * W6_BYTES;
    LAS unsigned char* CQ = wl;
    LAS unsigned short* E16 = (LAS unsigned short*)(wl + 6144);
    LAS float* GC = (LAS float*)(wl + 8192);
    LAS float* ACT = (LAS float*)(wl + 12288);
    LAS float* RS = (LAS float*)(wl + 16384);
    int ci = 0, cj = 0; bool cvalid = lane < 50;
    { int l = lane;
      if (l < 16) { ci = 0; cj = l; } else if (l < 24) { ci = 1; cj = l - 16; } else if (l < 29) { ci = 2; cj = l - 24; } else if (l < 33) { ci = 3; cj = l - 29; }
      else if (l < 36) { ci = 4; cj = l - 33; } else if (l < 42) { ci = 5 + (l - 36) / 2; cj = (l - 36) & 1; } else { ci = 8 + (l - 42); cj = 0; } if (!cvalid) { ci = 0; cj = 0; } }
    const int gw = bid * 8 + wave, NGW = nb * 8;
#define TOK6(k) min(base + (k) * NGW, NTOK - 1)
    for (int base = gw; base < NTOK; base += NT6 * NGW) {
#pragma unroll 1
        for (int rep_r = 0; rep_r < PROBE_R; ++rep_r)
#pragma unroll 1
        for (int k = 0; k < NT6; k += 2) {
            u32x4 raw[2][4]; float rstd[2];
#pragma unroll
            for (int v = 0; v < 2; ++v) { const int t = TOK6(k + v);
#pragma unroll
                for (int q = 0; q < 4; ++q) raw[v][q] = *(const u32x4*)(SC + (size_t)t * 2048 + 512 * q + 8 * lane);
                float ssq = (lane < 16) ? SSQ[(size_t)t * 16 + lane] : 0.f; ssq = wave_sum(ssq);
                rstd[v] = 1.0f / sqrtf(ssq * (1.0f / DM) + EPS);
                { const u32x4 ha = *(const u32x4*)(HB + (size_t)t * DM + 16 * lane), hb = *(const u32x4*)(HB + (size_t)t * DM + 16 * lane + 8); const float sc = rstd[v] * 16.0f;
                  const unsigned hv[8] = {ha.x, ha.y, ha.z, ha.w, hb.x, hb.y, hb.z, hb.w}; unsigned xw[4];
#pragma unroll
                  for (int w = 0; w < 4; ++w) { int pk = __builtin_amdgcn_cvt_pk_fp8_f32(bf_lo(hv[2 * w]) * sc, bf_hi(hv[2 * w]) * sc, 0, false);
                      pk = __builtin_amdgcn_cvt_pk_fp8_f32(bf_lo(hv[2 * w + 1]) * sc, bf_hi(hv[2 * w + 1]) * sc, pk, true); xw[w] = (unsigned)pk; }
                  *(u32x4*)(XQ + (size_t)t * DM + 16 * lane) = (u32x4){xw[0], xw[1], xw[2], xw[3]}; } }
#pragma unroll
            for (int qq = 0; qq < 2; ++qq) {
                unsigned ka[4][8];
#pragma unroll
                for (int c = 0; c < 4; ++c) { const u32x4 rv = raw[c >> 1][2 * qq + (c & 1)]; const unsigned rw[4] = {rv.x, rv.y, rv.z, rv.w};
#pragma unroll
                    for (int e = 0; e < 8; ++e) { const unsigned hbits = (e & 1) ? (rw[e >> 1] >> 16) : (rw[e >> 1] & 0xffffu);
                        const float f = (float)__builtin_bit_cast(_Float16, (unsigned short)hbits);
                        ka[c][e] = (ord32(f) & ~0x7fu) | (unsigned)(127 - (8 * p16 + e)); } }
#define CE6(u, i, j) do { const unsigned _a = ka[u][i], _b = ka[u][j]; ka[u][i] = _a > _b ? _a : _b; ka[u][j] = _a > _b ? _b : _a; } while (0)
#pragma unroll
                for (int u = 0; u < 4; ++u) {
                    CE6(u, 0, 1); CE6(u, 2, 3); CE6(u, 4, 5); CE6(u, 6, 7);
                    CE6(u, 0, 2); CE6(u, 1, 3); CE6(u, 4, 6); CE6(u, 5, 7);
                    CE6(u, 1, 2); CE6(u, 5, 6);
                    CE6(u, 0, 4); CE6(u, 1, 5); CE6(u, 2, 6); CE6(u, 3, 7);
                    CE6(u, 2, 4); CE6(u, 3, 5);
                    CE6(u, 1, 2); CE6(u, 3, 4); CE6(u, 5, 6);
                }
#undef CE6
                unsigned mine[4] = {0u, 0u, 0u, 0u};
#pragma unroll 1
                for (int it = 0; it < 16; ++it) {
                    unsigned Wv[4]; row_max4(ka[0][0], ka[1][0], ka[2][0], ka[3][0], Wv[0], Wv[1], Wv[2], Wv[3]);
#pragma unroll
                    for (int c = 0; c < 4; ++c) {
                        const unsigned W = Wv[c];
                        mine[c] = (p16 == it) ? W : mine[c];
                        const bool win = (ka[c][0] == W);
#pragma unroll
                        for (int e = 0; e < 7; ++e) ka[c][e] = win ? ka[c][e + 1] : ka[c][e];
                        ka[c][7] = win ? 0u : ka[c][7];
                    }
                }
#pragma unroll
                for (int c = 0; c < 4; ++c) { const int g = 4 * (2 * qq + (c & 1)) + rg4; LAS float* A_s = (LAS float*)(wl + 3072 * (c >> 1)); LAS int* A_i = (LAS int*)(wl + 3072 * (c >> 1) + 1024);
                    A_s[g * 16 + p16] = unord32(mine[c] & ~0x7fu); A_i[g * 16 + p16] = 127 - (int)(mine[c] & 0x7fu); }
            }
            LDS_WAIT();
            {
                float av[4], bc[4]; int iav[4], ibc[4], jp[4], hh[4], bb[4]; unsigned key[4];
#pragma unroll
                for (int c = 0; c < 4; ++c) { const LAS float* A_s = (const LAS float*)(wl + 3072 * (c >> 1)); const LAS int* A_i = (const LAS int*)(wl + 3072 * (c >> 1) + 1024);
                    hh[c] = 4 * (c & 1) + rg4; bb[c] = (2 * hh[c] + 1) * 16; av[c] = A_s[(2 * hh[c]) * 16 + p16]; iav[c] = A_i[(2 * hh[c]) * 16 + p16] * 128; jp[c] = 0; bc[c] = A_s[bb[c]]; ibc[c] = A_i[bb[c]];
                    key[c] = (ord32(av[c] + bc[c]) & ~0xfu) | (unsigned)(15 - p16); }
#pragma unroll 1
                for (int it = 0; it < 16; ++it) {
                    unsigned Wv[4]; row_max4(key[0], key[1], key[2], key[3], Wv[0], Wv[1], Wv[2], Wv[3]);
#pragma unroll
                    for (int c = 0; c < 4; ++c) {
                        const LAS float* A_s = (const LAS float*)(wl + 3072 * (c >> 1)); const LAS int* A_i = (const LAS int*)(wl + 3072 * (c >> 1) + 1024);
                        LAS int* E_i = (LAS int*)(wl + 3072 * (c >> 1) + 2048); LAS float* E_s = (LAS float*)(wl + 3072 * (c >> 1) + 2560);
                        const bool win = (key[c] == Wv[c]);
                        if (win) { E_i[hh[c] * 16 + it] = iav[c] + ibc[c]; E_s[hh[c] * 16 + it] = av[c] + bc[c]; }
                        jp[c] += win ? 1 : 0;
                        const int jr = jp[c] < 16 ? jp[c] : 15;
                        bc[c] = A_s[bb[c] + jr]; ibc[c] = A_i[bb[c] + jr];
                        key[c] = jp[c] < 16 ? ((ord32(av[c] + bc[c]) & ~0xfu) | (unsigned)(15 - p16)) : 0u;
                    }
                }
            }
            LDS_WAIT();
#pragma unroll
            for (int v = 0; v < 2; ++v) { const LAS int* E_i = (const LAS int*)(wl + 3072 * v + 2048); const LAS float* E_s = (const LAS float*)(wl + 3072 * v + 2560);
#pragma unroll
                for (int sl = 0; sl < 2; ++sl) { const int e = lane + 64 * sl; const float s = E_s[e] * rstd[v], mx = E_s[e & ~15] * rstd[v]; const float pe = __expf(s - mx); const float den = row_sum_x(pe);
                    const int pos = 16 * (e & 7) + (e >> 3);
                    GC[(k + v) * 128 + pos] = pe / den; E16[(k + v) * 128 + pos] = (unsigned short)E_i[e]; }
                if (lane == 0) RS[k + v] = rstd[v]; }
            LDS_WAIT();
        }
#define P6_LOADH(buf, TAB, jj, kk, hh) do { const u32x4 _iv = *(const LAS u32x4*)(E16 + (kk) * 128 + 16 * q8 + 8 * (hh)); const unsigned _iw[4] = {_iv.x, _iv.y, _iv.z, _iv.w}; \
            _Pragma("unroll") for (int c = 0; c < 8; ++c) { const unsigned _idx = (c & 1) ? (_iw[c >> 1] >> 16) : (_iw[c >> 1] & 0xffffu); \
                buf[c] = *(const u32x4*)((TAB) + (((size_t)(jj) * NEXP + _idx) << 7) + 16 * p8); } } while (0)
#define P6_LOADX(hb, jj, kk) do { const bf16_t* _hp = HB + (size_t)TOK6(kk) * DM + 128 * (jj) + 16 * p8; hb[0] = *(const u32x4*)_hp; hb[1] = *(const u32x4*)(_hp + 8); } while (0)
        asm volatile("s_waitcnt vmcnt(0)" ::: "memory");
#pragma unroll 1
        for (int rep_u = 0; rep_u < PROBE_U; ++rep_u) {
            for (int k = 0; k < NT6; ++k) { ACT[k * 128 + lane] = 0.f; ACT[k * 128 + 64 + lane] = 0.f; }
            LDS_WAIT();
            const int n16 = lane & 15, g4 = lane >> 4, c4 = lane & 3, r16 = 4 * g4 + (n16 >> 2);
            const int eoff = 2 * (16 * (r16 & 7) + (r16 >> 3));
            const bool xkeep = (g4 == (n16 >> 2));
            u32x4 bfP[16], bfQ[16], xP[2], xQ2[2];
#define P6_ULOAD(buf, xb, nn) do { const int _j = (nn) / NT6, _k = (nn) % NT6; const LAS unsigned char* _ip = (const LAS unsigned char*)(E16 + _k * 128) + eoff; \
                { const unsigned char* _xp = XQ + (size_t)TOK6(_k) * DM + 128 * _j + 16 * c4; xb[0] = *(const u32x4*)_xp; xb[1] = *(const u32x4*)(_xp + 64); } \
                asm volatile("" ::: "memory"); \
                _Pragma("unroll") for (int T = 0; T < 8; ++T) { const unsigned _idx = *(const LAS unsigned short*)(_ip + 4 * T); \
                    const unsigned char* _rp = UB + (((size_t)_j * NEXP + _idx) << 7) + 16 * c4; buf[2 * T] = *(const u32x4*)_rp; buf[2 * T + 1] = *(const u32x4*)(_rp + 64); } } while (0)
#define P6_PK64(lo, hi) ((long)(((unsigned long long)(hi) << 32) | (unsigned long long)(lo)))
#define P6_UMMA(buf, xb, nn) do { const int k = (nn) % NT6; \
                const unsigned x0 = xkeep ? xb[0].x : 0u, x1 = xkeep ? xb[0].y : 0u, x2 = xkeep ? xb[0].z : 0u, x3 = xkeep ? xb[0].w : 0u, \
                               x4 = xkeep ? xb[1].x : 0u, x5 = xkeep ? xb[1].y : 0u, x6 = xkeep ? xb[1].z : 0u, x7 = xkeep ? xb[1].w : 0u; \
                const long xa[4] = {P6_PK64(x0, x1), P6_PK64(x2, x3), P6_PK64(x4, x5), P6_PK64(x6, x7)}; \
                float dsel[2] = {0.f, 0.f}; \
                _Pragma("unroll") for (int T = 0; T < 8; ++T) { f32x4 d = (f32x4){0.f, 0.f, 0.f, 0.f}; \
                    const long bb[4] = {P6_PK64(buf[2 * T].x, buf[2 * T].y), P6_PK64(buf[2 * T].z, buf[2 * T].w), P6_PK64(buf[2 * T + 1].x, buf[2 * T + 1].y), P6_PK64(buf[2 * T + 1].z, buf[2 * T + 1].w)}; \
                    _Pragma("unroll") for (int s = 0; s < 4; ++s) d = __builtin_amdgcn_mfma_f32_16x16x32_fp8_fp8(xa[s], bb[s], d, 0, 0, 0); \
                    float pv = (c4 == 0) ? d[0] : ((c4 == 1) ? d[1] : ((c4 == 2) ? d[2] : d[3])); \
                    pv += DPPF(pv, 0xB1); pv += DPPF(pv, 0x4E);                         \
                    dsel[T >> 2] = ((T & 3) == c4) ? pv : dsel[T >> 2]; } \
                  \
                ACT[k * 128 + 16 * c4 + r16] += dsel[0]; ACT[k * 128 + 16 * (c4 + 4) + r16] += dsel[1]; } while (0)
            P6_ULOAD(bfP, xP, 0);
#pragma unroll 1
            for (int n = 0; n < 8 * NT6; n += 2) {
                P6_ULOAD(bfQ, xQ2, n + 1); asm volatile("" ::: "memory"); __builtin_amdgcn_sched_barrier(0);
                P6_UMMA(bfP, xP, n); __builtin_amdgcn_sched_barrier(0);
                if (n + 2 < 8 * NT6) P6_ULOAD(bfP, xP, n + 2);
                asm volatile("" ::: "memory"); __builtin_amdgcn_sched_barrier(0);
                P6_UMMA(bfQ, xQ2, n + 1); __builtin_amdgcn_sched_barrier(0);
            }
#undef P6_ULOAD
#undef P6_UMMA
#undef P6_PK64
        }
        LDS_WAIT();
#pragma unroll 1
        for (int k = 0; k < NT6; ++k) {
#pragma unroll
            for (int sl = 0; sl < 2; ++sl) { const int e = lane + 64 * sl, pos = 16 * (e & 7) + (e >> 3); const float a = ACT[k * 128 + e] * (1.0f / 8192.0f);
                const float cfv = GC[k * 128 + pos] * gelu_exact(a);
                CQ[k * 128 + pos] = (unsigned char)(__builtin_amdgcn_cvt_pk_fp8_f32(cfv * 32.0f, 0.f, 0, false) & 0xff); } }
        LDS_WAIT();
#pragma unroll 1
        for (int k = 0; k < NT6; ++k) ACT[k * 64 + lane] = 0.f;
        LDS_WAIT();
#pragma unroll 1
        for (int rep_v = 0; rep_v < PROBE_V; ++rep_v) {
            for (int k = 0; k < NT6; ++k) ACT[k * 64 + lane] = 0.f;
            LDS_WAIT();
            u32x4 bfP[16], bfQ[16];
#define P6_LOADI(buf, TAB, nn) do { const int _j = (nn) / NT6, _k = (nn) % NT6; P6_LOADH(buf, TAB, _j, _k, 0); P6_LOADH((buf + 8), TAB, _j, _k, 1); } while (0)
            const int n16 = lane & 15, g4 = lane >> 4;
            const int ash = 8 * (n16 & 3); const bool ahi = (n16 & 4) != 0;
            const int c0 = 16 * (n16 & 7) + 4 * (g4 & 1);
            const bool fin = (n16 < 8) && (g4 < 2);
#define P6_LOADR2(hb, nn) do { const bf16_t* _hp = HB + (size_t)TOK6((nn) % NT6) * DM + 128 * ((nn) / NT6) + c0; hb[0] = *(const u32x2*)_hp; hb[1] = *(const u32x2*)(_hp + 8); } while (0)
#define P6_VBODY(buf, nn, hb) do { const int j = (nn) / NT6, k = (nn) % NT6; const int t = TOK6(k); \
                const u32x4 cqv = *(const LAS u32x4*)(CQ + k * 128 + 16 * q8); const unsigned cqw[4] = {cqv.x, cqv.y, cqv.z, cqv.w}; \
                f32x4 d0 = (f32x4){0.f, 0.f, 0.f, 0.f}, d1 = (f32x4){0.f, 0.f, 0.f, 0.f}; \
                _Pragma("unroll") for (int c = 0; c < 16; ++c) { const unsigned cb = (cqw[c >> 2] >> (8 * (c & 3))) & 0xffu; const unsigned tt = cb << ash; \
                    const long av = P6_PK64(ahi ? 0u : tt, ahi ? tt : 0u); \
                    d0 = __builtin_amdgcn_mfma_f32_16x16x32_fp8_fp8(av, P6_PK64(buf[c].x, buf[c].y), d0, 0, 0, 0); \
                    d1 = __builtin_amdgcn_mfma_f32_16x16x32_fp8_fp8(av, P6_PK64(buf[c].z, buf[c].w), d1, 0, 0, 0); } \
                float o[8]; \
                _Pragma("unroll") for (int r = 0; r < 4; ++r) { o[r] = d0[r] + __shfl_xor(d0[r], 40); o[4 + r] = d1[r] + __shfl_xor(d1[r], 40); } \
                const unsigned hw[4] = {hb[0].x, hb[0].y, hb[1].x, hb[1].y}; float ss = 0.f; \
                _Pragma("unroll") for (int r = 0; r < 8; ++r) { const float hv = (r & 1) ? bf_hi(hw[r >> 1]) : bf_lo(hw[r >> 1]); o[r] = o[r] * (1.0f / 1024.0f) + hv; ss += o[r] * o[r]; } \
                if (fin) { float* op = p.out + (size_t)t * DM + 128 * j + c0; *(f32x4*)op = (f32x4){o[0], o[1], o[2], o[3]}; *(f32x4*)(op + 8) = (f32x4){o[4], o[5], o[6], o[7]}; \
                    ACT[k * 64 + lane] += ss; } \
                } while (0)
#define P6_PK64(lo, hi) ((long)(((unsigned long long)(hi) << 32) | (unsigned long long)(lo)))
            P6_LOADI(bfP, VB, 0);
#pragma unroll 1
            for (int n = 0; n < 8 * NT6; n += 2) {
                u32x2 hr0[2], hr1[2]; P6_LOADR2(hr0, n); P6_LOADR2(hr1, n + 1);
                asm volatile("" ::: "memory");
                P6_LOADI(bfQ, VB, n + 1); asm volatile("" ::: "memory"); __builtin_amdgcn_sched_barrier(0);
                P6_VBODY(bfP, n, hr0); __builtin_amdgcn_sched_barrier(0);
                if (n + 2 < 8 * NT6) P6_LOADI(bfP, VB, n + 2);
                asm volatile("" ::: "memory"); __builtin_amdgcn_sched_barrier(0);
                P6_VBODY(bfQ, n + 1, hr1); __builtin_amdgcn_sched_barrier(0);
            }
            LDS_WAIT(); asm volatile("s_waitcnt vmcnt(0)" ::: "memory");
            f32x4 gfv[4];
#pragma unroll
            for (int i = 0; i < 4; ++i) gfv[i] = *(const f32x4*)(p.gfin + 256 * i + 4 * lane);
#pragma unroll 1
            for (int k = 0; k < NT6; ++k) { const float sst = wave_sum(ACT[k * 64 + lane]); const float rf = __builtin_amdgcn_rsqf(sst * (1.0f / DM) + EPS);
                float* op = p.out + (size_t)TOK6(k) * DM + 4 * lane; f32x4 ov[4];
#pragma unroll
                for (int i = 0; i < 4; ++i) ov[i] = *(const f32x4*)(op + 256 * i);
#pragma unroll
                for (int i = 0; i < 4; ++i) *(f32x4*)(op + 256 * i) = ov[i] * rf * gfv[i]; }
        }
        LDS_WAIT();
    }
#undef P6_LOADH
#undef P6_LOADX
#undef P6_LOADI
#undef P6_VBODY
#undef P6_LOADR2
#undef P6_PK64
#undef TOK6
}

#define XB_TMO      128
#define XB_XCNT(j)  (256  + 64 * (j))
#define XB_XSUB(j)  (1280 + 64 * (j))
#define XB_XGEN(j)  (2304 + 64 * (j))
#define XB_TOP      3328
#define XB_TOPGEN   3392
#define XCD_BAR_WORDS 3456
#define XB_SPIN_CAP (1u << 18)

__device__ __forceinline__ unsigned xb_ld(unsigned* p)              { return __hip_atomic_load(p, __ATOMIC_RELAXED, __HIP_MEMORY_SCOPE_AGENT); }
__device__ __forceinline__ unsigned xb_add(unsigned* p, unsigned v) { return __hip_atomic_fetch_add(p, v, __ATOMIC_RELAXED, __HIP_MEMORY_SCOPE_AGENT); }
__device__ __forceinline__ unsigned xb_xcc_id() { return (unsigned)__builtin_amdgcn_s_getreg((3 << 11) | 20) & 0xFu; }
#define XB_SPIN(cond, bar) do { unsigned _sp = 0; while (cond) { __builtin_amdgcn_s_sleep(1); \
    if ((++_sp & 255u) == 0u) { if (xb_ld(&(bar)[XB_TMO])) break; if (_sp > XB_SPIN_CAP) { atomicAdd(&(bar)[XB_TMO], 1u); break; } } } } while (0)

struct XcdBarrier {
    unsigned* bar; unsigned x;
    volatile LAS unsigned* st;
};

__device__ __forceinline__ XcdBarrier xcd_barrier_post(unsigned* bar, volatile LAS unsigned* st) {
    XcdBarrier b; b.bar = bar; b.x = xb_xcc_id(); b.st = st;
    if (threadIdx.x == 0) (void)xb_add(&bar[XB_XCNT(b.x)], 1u);
    return b;
}
__device__ __forceinline__ void xcd_barrier_complete(unsigned* bar, unsigned x, unsigned& nloc, unsigned& nx) {
    const unsigned G = gridDim.x * gridDim.y * gridDim.z;
    unsigned sum, cnt, mine, sp = 0u;
    for (;;) {
        sum = 0u; cnt = 0u; mine = 0u;
#pragma unroll
        for (unsigned j = 0; j < 16; ++j) { const unsigned c = xb_ld(&bar[XB_XCNT(j)]); sum += c; cnt += (c > 0u) ? 1u : 0u; mine = (j == x) ? c : mine; }
        if (sum == G) break;
        __builtin_amdgcn_s_sleep(1);
        if ((++sp & 255u) == 0u) { if (xb_ld(&bar[XB_TMO])) break; if (sp > XB_SPIN_CAP) { atomicAdd(&bar[XB_TMO], 1u); break; } }
    }
    nloc = mine > 0u ? mine : 1u; nx = cnt > 0u ? cnt : 1u;
}

__device__ __forceinline__ void xcd_barrier(const XcdBarrier& b) {
    asm volatile("s_waitcnt vmcnt(0)" ::: "memory");
    __syncthreads();
    if (threadIdx.x == 0) {
        unsigned* bar = b.bar;
        __builtin_amdgcn_s_waitcnt(0);
        unsigned nloc = b.st[0], nx = b.st[1];
        if (nloc == 0u) { xcd_barrier_complete(bar, b.x, nloc, nx); b.st[0] = nloc; b.st[1] = nx; }
        const unsigned old = xb_add(&bar[XB_XSUB(b.x)], 1u);
        const unsigned gen = old / nloc;
        if (old + 1u == (gen + 1u) * nloc) {
            __builtin_amdgcn_fence(__ATOMIC_RELEASE, "agent");
            asm volatile("s_waitcnt vmcnt(0)" ::: "memory");
            const unsigned og = xb_add(&bar[XB_TOP], 1u);
            const unsigned tg = og / nx;
            if (og + 1u == (tg + 1u) * nx) xb_add(&bar[XB_TOPGEN], 1u);
            else XB_SPIN(xb_ld(&bar[XB_TOPGEN]) == tg, bar);
            __builtin_amdgcn_fence(__ATOMIC_ACQUIRE, "agent");
            xb_add(&bar[XB_XGEN(b.x)], 1u);
            asm volatile("s_waitcnt vmcnt(0)" ::: "memory");
        } else {
            XB_SPIN(xb_ld(&bar[XB_XGEN(b.x)]) == gen, bar);
            __builtin_amdgcn_fence(__ATOMIC_ACQUIRE, "agent");
            asm volatile("s_waitcnt vmcnt(0)" ::: "memory");
        }
    }
    __syncthreads();
}

__global__ void __launch_bounds__(512, 2) mk_fwd(Params p) {
    extern __shared__ __attribute__((aligned(16))) unsigned char lds_raw[];
    LAS unsigned char* lds = (LAS unsigned char*)lds_raw;
    const int bid = blockIdx.x, nb = gridDim.x;
    unsigned char* ws = p.ws;
#define IN(k) (p.ph_lo <= (k) && (k) < p.ph_hi)
#define SEAM(k) do { if (IN(k) && IN((k) + 1)) { if ((k) == 0) cg::this_grid().sync(); else xcd_barrier(bar); } } while (0)
    if (threadIdx.x < 4) ((volatile LAS unsigned*)(lds + LDS_BYTES - 16))[threadIdx.x] = 0u;
    __syncthreads();
    const XcdBarrier bar = xcd_barrier_post((unsigned*)(ws + WS_CTL) + 4096, (volatile LAS unsigned*)(lds + LDS_BYTES - 16));
    if (IN(0)) phase0(p, lds, bid, nb);
    SEAM(0);
    if (IN(1)) {
        pg8::Gemm g{(const bf16_t*)(ws + WS_XN), (const bf16_t*)(ws + WS_WIN), MROWS, NP1, DM}; pg8::StaticOrder S; S.init(MROWS, NP1, nb, bid);
        EpiProj E{(bf16_t*)(ws + WS_PROJ), (float*)(ws + WS_LA), p.gb, (const float2*)(ws + WS_ROPE)};
        pg8::gemm_phase<EpiProj, pg8::StaticOrder, true, true>(lds, g, S, E);
    }
    SEAM(1);
    if (IN(2)) attn_pass<false>(p, lds, bid, nb);
    SEAM(2);
    if (IN(3)) attn_pass<true>(p, lds, bid, nb);
    SEAM(3);
    if (IN(4)) {
        pg8::Gemm g{(const bf16_t*)(ws + WS_O), (const bf16_t*)(ws + WS_WOUT), NTOK, DM, DM}; pg8::StaticOrder S; S.init(NTOK, DM, nb, bid);
        EpiRes E{p.x, (bf16_t*)(ws + WS_XN), (float*)(ws + WS_SSQ)};
        pg8::gemm_phase<EpiRes, pg8::StaticOrder, true, true>(lds, g, S, E);
    }
    SEAM(4);
    if (IN(5)) {
        pg8::Gemm g{(const bf16_t*)(ws + WS_XN), (const bf16_t*)(ws + WS_WS), NTOK, 2048, DM}; pg8::StaticOrder S; S.init(NTOK, 2048, nb, bid);
        EpiF16 E{(_Float16*)(ws + WS_PROJ)};
        pg8::gemm_phase<EpiF16, pg8::StaticOrder, true, true>(lds, g, S, E);
    }
    SEAM(5);
    if (IN(6)) phase_peer2(p, lds, bid, nb);
#undef IN
#undef SEAM
}

#ifndef MK_FUSED
#define MK_FUSED 1
#endif
extern "C" void kernel_launch(void* const* d_in, const int* in_sizes, int n_in, void* d_out, int out_size, void* d_ws, size_t ws_size, hipStream_t stream) {
    static int grid = 0;
    if (grid == 0) {
        if (n_in != 16 || in_sizes[0] != NTOK * DM || out_size != NTOK * DM || ws_size < WS_END) {
            fprintf(stderr, "kernel_launch: unexpected shapes (n_in %d, in0 %d, out %d, ws %zu); nothing launched\n", n_in, n_in > 0 ? in_sizes[0] : -1, out_size, ws_size); grid = -1; return; }
        int dev = 0, cus = 0, per_cu = 0;
        hipGetDevice(&dev); hipDeviceGetAttribute(&cus, hipDeviceAttributeMultiprocessorCount, dev);
        if (hipFuncSetAttribute((const void*)mk_fwd, hipFuncAttributeMaxDynamicSharedMemorySize, LDS_BYTES) != hipSuccess) { fprintf(stderr, "kernel_launch: hipFuncSetAttribute failed\n"); grid = -1; return; }
        if (hipOccupancyMaxActiveBlocksPerMultiprocessor(&per_cu, (const void*)mk_fwd, 512, LDS_BYTES) != hipSuccess || per_cu < 1) { fprintf(stderr, "kernel_launch: occupancy query failed (%d)\n", per_cu); (void)hipGetLastError(); per_cu = 1; }
        grid = cus * (per_cu < 1 ? 1 : 1);
        fprintf(stderr, "kernel_launch: %d CUs, occupancy %d/CU, grid %d\n", cus, per_cu, grid);
    }
    if (grid < 0) return;
    (void)hipMemsetAsync((char*)d_ws + WS_CTL, 0, 65536, stream);
    Params p{};
    p.x = (const float*)d_in[0]; p.meta = (const float*)d_in[1]; p.g1 = (const float*)d_in[2]; p.w_in = (const float*)d_in[3]; p.gw2 = (const float*)d_in[4]; p.gb = (const float*)d_in[5];
    p.gla_gain = (const float*)d_in[6]; p.ret_gain = (const float*)d_in[7]; p.ret_bias = (const float*)d_in[8]; p.w_out = (const float*)d_in[9]; p.g2 = (const float*)d_in[10];
    p.w_q = (const float*)d_in[11]; p.subkeys = (const float*)d_in[12]; p.pu = (const float*)d_in[13]; p.pv = (const float*)d_in[14]; p.gfin = (const float*)d_in[15];
    p.out = (float*)d_out; p.ws = (unsigned char*)d_ws;
#if MK_FUSED
    p.ph_lo = 0; p.ph_hi = NPHASE;
    void* args[] = {&p};
    hipError_t e = hipLaunchCooperativeKernel((const void*)mk_fwd, dim3(grid), dim3(512), args, LDS_BYTES, stream);
    if (e != hipSuccess) fprintf(stderr, "kernel_launch: cooperative launch failed: %s (grid %d)\n", hipGetErrorString(e), grid);
#else
    { const int order[7] = {0, 1, 2, 3, 4, 5, 6}; for (int i = 0; i < 7; ++i) { p.ph_lo = order[i]; p.ph_hi = order[i] + 1; hipLaunchKernelGGL(mk_fwd, dim3(grid), dim3(512), LDS_BYTES, stream, p); } }
#endif
}
```

```cpp
#include <hip/hip_runtime.h>
#include <hip/hip_cooperative_groups.h>
#include <cstdio>
#include <cstdint>
namespace cg = cooperative_groups;
namespace pg8 {
#define PG8_LAS __attribute__((address_space(3)))
typedef unsigned short bf16_t;
typedef short bf16x8 __attribute__((ext_vector_type(8)));
typedef float f32x4 __attribute__((ext_vector_type(4)));
typedef unsigned u32x4 __attribute__((ext_vector_type(4)));
constexpr int BM = 256, BK = 64, HALF = 128, HTB = HALF * BK * 2  , STAGE_BYTES = 8 * HTB, NXCD = 8, WGM = 8;

__host__ __device__ __forceinline__ int lds_byte(int r, int c) { const int st = (r >> 4) * 2 + (c >> 5), rr = r & 15, cc = c & 31, ob = rr * 64 + cc * 2; return st * 1024 + (ob ^ (((ob >> 9) & 1) << 5)); }
__host__ __device__ __forceinline__ void stage_rc(int b, int& R, int& C) { const int st = b / 1024, sb = b % 1024, swz = sb ^ (((sb >> 9) & 1) << 5); R = (st >> 1) * 16 + swz / 64; C = (st & 1) * 32 + (swz % 64) / 2; }
__host__ __device__ __forceinline__ int perm32(int rho) { const int n = rho >> 4, i = rho & 15; return 8 * (i >> 2) + 4 * n + (i & 3); }

struct Unit { int pm, pn; };
struct Gemm { const bf16_t* A; const bf16_t* Bt; int M, N, K; };

struct StaticOrder {
    int nM, nN, nwg, G, c;
    __host__ __device__ void init(int M, int N, int G_, int c_) { nM = M / BM; nN = N / BM; nwg = nM * nN; G = G_; c = c_; }
    __host__ __device__ bool next(int i, Unit& u) const {
        const long L = (long)i * G + c; if (L >= nwg) return false;
        int wgid = (int)L; { const int q = nwg / NXCD, r = nwg % NXCD, xcd = wgid % NXCD, off = wgid / NXCD; wgid = (xcd < r ? xcd * (q + 1) : r * (q + 1) + (xcd - r) * q) + off; }
        const int nig = WGM * nN, gid = wgid / nig, fm = gid * WGM, gsz = (nM - fm) < WGM ? (nM - fm) : WGM;
        u.pm = fm + ((wgid % nig) % gsz); u.pn = (wgid % nig) / gsz; return true;
    }
    __device__ __forceinline__ void a_ready(const Unit&) const {}
    __device__ __forceinline__ void done(const Unit&) const {}
};

__device__ __forceinline__ unsigned cvt_pk_bf16(float lo, float hi) { unsigned r; asm volatile("v_cvt_pk_bf16_f32 %0, %1, %2" : "=v"(r) : "v"(lo), "v"(hi)); return r; }
typedef float f32x2 __attribute__((ext_vector_type(2)));
template <class Epi, class Sched, bool ALIGN_EPI = false, bool SP2 = false>
__device__ __forceinline__ void gemm_phase(PG8_LAS unsigned char* lds, const Gemm g, const Sched& S, const Epi& E) {
    const int tid = threadIdx.x, wid = __builtin_amdgcn_readfirstlane(tid >> 6), lane = tid & 63, wr = wid >> 2, wc = wid & 3, fr = lane & 15, fq = lane >> 4;
    const int K = g.K, nt = K / BK;
    unsigned voffA[2], voffB[2];
#pragma unroll
    for (int i = 0; i < 2; ++i) { int R, C; stage_rc(tid * 16 + i * 8192, R, C); const int Rb = Epi::PERM ? ((R & ~31) + perm32(R & 31)) : R;
        voffA[i] = (unsigned)(R * K + C) * 2u; voffB[i] = (unsigned)(Rb * K + C) * 2u; }
    const size_t kstep = (size_t)(BK * 2);
    const size_t hstep = (size_t)HALF * K * 2;
    const size_t tstep = 2 * hstep;
    const unsigned ldsw = (unsigned)wid * 1024u;
    const int aoff = lds_byte(wr * 64 + fr, fq * 8), boff = lds_byte(wc * 32 + fr, fq * 8);
#define PG8_SA(b, h) (((b) * 2 + (h)) * HTB)
#define PG8_SB(b, h) ((4 + (b) * 2 + (h)) * HTB)
#define PG8_STAGE(bufoff, gbase, voff) do { _Pragma("unroll") for (int _i = 0; _i < 2; ++_i) \
        __builtin_amdgcn_global_load_lds((const unsigned*)((const char*)(gbase) + (voff)[_i]), (PG8_LAS unsigned*)(lds + (bufoff) + ldsw + _i * 8192), 16, 0, 0); } while (0)
#define PG8_LDA(dst, b, h) do { _Pragma("unroll") for (int m = 0; m < 4; ++m) _Pragma("unroll") for (int k = 0; k < 2; ++k) dst[m][k] = *(const PG8_LAS bf16x8*)(lds + PG8_SA(b, h) + aoff + m * 2048 + k * 1024); } while (0)
#define PG8_LDB(dst, b, h) do { _Pragma("unroll") for (int n = 0; n < 2; ++n) _Pragma("unroll") for (int k = 0; k < 2; ++k) dst[n][k] = *(const PG8_LAS bf16x8*)(lds + PG8_SB(b, h) + boff + n * 2048 + k * 1024); } while (0)
#define PG8_MMA(ai, bj, At, Bt) do { __builtin_amdgcn_s_setprio(1); _Pragma("unroll") for (int m = 0; m < 4; ++m) _Pragma("unroll") for (int n = 0; n < 2; ++n) _Pragma("unroll") for (int k = 0; k < 2; ++k) \
        acc[ai][bj][m][n] = __builtin_amdgcn_mfma_f32_16x16x32_bf16(Bt[n][k], At[m][k], acc[ai][bj][m][n], 0, 0, 0); __builtin_amdgcn_s_setprio(0); } while (0)
#define PG8_WAIT_V(n) asm volatile("s_waitcnt vmcnt(" #n ")" ::: "memory")
#define PG8_WAIT_L(n) asm volatile("s_waitcnt lgkmcnt(" #n ")" ::: "memory")
#define PG8_BAR __builtin_amdgcn_s_barrier()
#define PG8_SCHED __builtin_amdgcn_sched_barrier(0)
    Unit cur, nxt; int ui = 0;
    if (!S.next(0, cur)) return;
    f32x4 acc[2][2][4][2];
#pragma unroll
    for (int a = 0; a < 2; ++a)
#pragma unroll
        for (int b = 0; b < 2; ++b)
#pragma unroll
            for (int m = 0; m < 4; ++m)
#pragma unroll
                for (int n = 0; n < 2; ++n) acc[a][b][m][n] = (f32x4){0.f, 0.f, 0.f, 0.f};
    bf16x8 At[4][2], B0[2][2], B1[2][2];
    const char* cA = (const char*)g.A + (size_t)cur.pm * tstep; const char* cB = (const char*)g.Bt + (size_t)cur.pn * tstep;
    S.a_ready(cur);
    if constexpr (SP2) {
        PG8_STAGE(PG8_SB(0, 0), cB, voffB); PG8_STAGE(PG8_SB(0, 1), cB + hstep, voffB); PG8_STAGE(PG8_SA(0, 0), cA, voffA); PG8_STAGE(PG8_SA(0, 1), cA + hstep, voffA);
        if (wr == 1) PG8_BAR;
        PG8_WAIT_V(2); PG8_BAR;
        PG8_STAGE(PG8_SB(1, 0), cB + kstep, voffB); PG8_STAGE(PG8_SA(1, 0), cA + kstep, voffA); PG8_STAGE(PG8_SB(1, 1), cB + hstep + kstep, voffB);
        PG8_WAIT_V(6); PG8_BAR;
    } else {
        PG8_STAGE(PG8_SB(0, 0), cB, voffB); PG8_STAGE(PG8_SA(0, 0), cA, voffA); PG8_STAGE(PG8_SB(0, 1), cB + hstep, voffB); PG8_STAGE(PG8_SA(0, 1), cA + hstep, voffA);
        if (wr == 1) PG8_BAR;
        PG8_WAIT_V(4); PG8_BAR;
        PG8_STAGE(PG8_SB(1, 0), cB + kstep, voffB); PG8_STAGE(PG8_SA(1, 0), cA + kstep, voffA); PG8_STAGE(PG8_SB(1, 1), cB + hstep + kstep, voffB);
        PG8_WAIT_V(6); PG8_BAR;
    }
    for (;;) {
        const bool has_next = S.next(ui + 1, nxt);
        const char* nA = has_next ? (const char*)g.A + (size_t)nxt.pm * tstep : cA; const char* nB = has_next ? (const char*)g.Bt + (size_t)nxt.pn * tstep : cB;
        for (int t = 0; t < nt; t += 2) {
            const bool last = (t == nt - 2);
            const char* a1 = cA + (size_t)(t + 1) * kstep;
            const char* a2 = last ? nA : cA + (size_t)(t + 2) * kstep; const char* b2 = last ? nB : cB + (size_t)(t + 2) * kstep;
            const char* a3 = a2 + kstep; const char* b3 = b2 + kstep;
            if (last && has_next) S.a_ready(nxt);
            if constexpr (SP2) {
            PG8_LDB(B0, 0, 0); PG8_LDB(B1, 0, 1); PG8_SCHED; PG8_LDA(At, 0, 0); PG8_STAGE(PG8_SA(1, 1), a1 + hstep, voffA);
            PG8_WAIT_V(8); PG8_WAIT_L(0); PG8_BAR; PG8_MMA(0, 0, At, B0); PG8_MMA(0, 1, At, B1); PG8_BAR; PG8_SCHED;
            PG8_LDA(At, 0, 1); PG8_STAGE(PG8_SB(0, 0), b2, voffB); PG8_STAGE(PG8_SB(0, 1), b2 + hstep, voffB); PG8_STAGE(PG8_SA(0, 0), a2, voffA);
            PG8_WAIT_V(8); PG8_WAIT_L(0); PG8_BAR; PG8_MMA(1, 0, At, B0); PG8_MMA(1, 1, At, B1); PG8_BAR; PG8_SCHED;
            PG8_LDB(B0, 1, 0); PG8_LDB(B1, 1, 1); PG8_SCHED; PG8_LDA(At, 1, 0); PG8_STAGE(PG8_SA(0, 1), a2 + hstep, voffA);
            PG8_WAIT_V(8); PG8_WAIT_L(0); PG8_BAR; PG8_MMA(0, 0, At, B0); PG8_MMA(0, 1, At, B1); PG8_BAR; PG8_SCHED;
            PG8_LDA(At, 1, 1); PG8_STAGE(PG8_SB(1, 0), b3, voffB); PG8_STAGE(PG8_SB(1, 1), b3 + hstep, voffB); PG8_STAGE(PG8_SA(1, 0), a3, voffA);
            PG8_WAIT_V(8); PG8_WAIT_L(0); PG8_BAR; PG8_MMA(1, 0, At, B0); PG8_MMA(1, 1, At, B1); PG8_BAR; PG8_SCHED;
            } else {
            PG8_LDB(B0, 0, 0); PG8_SCHED; PG8_LDA(At, 0, 0); PG8_STAGE(PG8_SA(1, 1), a1 + hstep, voffA);
            PG8_WAIT_L(8); PG8_BAR; PG8_WAIT_L(0); PG8_MMA(0, 0, At, B0); PG8_BAR; PG8_SCHED;
            PG8_LDB(B1, 0, 1); PG8_STAGE(PG8_SB(0, 0), b2, voffB);
            PG8_BAR; PG8_WAIT_L(0); PG8_MMA(0, 1, At, B1); PG8_BAR;
            PG8_LDA(At, 0, 1); PG8_STAGE(PG8_SA(0, 0), a2, voffA);
            PG8_BAR; PG8_WAIT_L(0); PG8_MMA(1, 0, At, B0); PG8_BAR; PG8_SCHED;
            PG8_STAGE(PG8_SB(0, 1), b2 + hstep, voffB);
            PG8_WAIT_V(6); PG8_BAR; PG8_MMA(1, 1, At, B1); PG8_BAR;
            PG8_LDB(B0, 1, 0); PG8_SCHED; PG8_LDA(At, 1, 0); PG8_STAGE(PG8_SA(0, 1), a2 + hstep, voffA);
            PG8_WAIT_L(8); PG8_BAR; PG8_WAIT_L(0); PG8_MMA(0, 0, At, B0); PG8_BAR; PG8_SCHED;
            PG8_LDB(B1, 1, 1); PG8_STAGE(PG8_SB(1, 0), b3, voffB);
            PG8_BAR; PG8_WAIT_L(0); PG8_MMA(0, 1, At, B1); PG8_BAR;
            PG8_LDA(At, 1, 1); PG8_STAGE(PG8_SA(1, 0), a3, voffA);
            PG8_BAR; PG8_WAIT_L(0); PG8_MMA(1, 0, At, B0); PG8_BAR; PG8_SCHED;
            PG8_STAGE(PG8_SB(1, 1), b3 + hstep, voffB);
            PG8_WAIT_V(6); PG8_BAR; PG8_MMA(1, 1, At, B1); PG8_BAR;
            }
        }
        if constexpr (ALIGN_EPI) { if (wr == 0) PG8_BAR; }
        if constexpr (!Epi::AFTER_DRAIN) { E(acc, cur, wr, wc, fr, fq); S.done(cur); }
        if (!has_next) break;
#pragma unroll
        for (int a = 0; a < 2; ++a)
#pragma unroll
            for (int b = 0; b < 2; ++b)
#pragma unroll
                for (int m = 0; m < 4; ++m)
#pragma unroll
                    for (int n = 0; n < 2; ++n) acc[a][b][m][n] = (f32x4){0.f, 0.f, 0.f, 0.f};
        cur = nxt; cA = nA; cB = nB; ++ui;
        if constexpr (ALIGN_EPI) { if (wr == 1) PG8_BAR; }
    }
    PG8_WAIT_V(0);
    if constexpr (!ALIGN_EPI) { if (wr == 0) PG8_BAR; }
    PG8_BAR;
    if constexpr (Epi::AFTER_DRAIN) { E.fused(acc, cur, wr, wc, fr, fq, lds, wid, lane); S.done(cur); }
#undef PG8_SA
#undef PG8_SB
#undef PG8_STAGE
#undef PG8_LDA
#undef PG8_LDB
#undef PG8_MMA
#undef PG8_WAIT_V
#undef PG8_WAIT_L
#undef PG8_BAR
#undef PG8_SCHED
}
}

#define LAS __attribute__((address_space(3)))
typedef unsigned short bf16_t;
typedef float f32x4 __attribute__((ext_vector_type(4)));
typedef unsigned u32x4 __attribute__((ext_vector_type(4)));
typedef unsigned u32x2 __attribute__((ext_vector_type(2)));
typedef short bf16x8 __attribute__((ext_vector_type(8)));
typedef short s16x4 __attribute__((ext_vector_type(4)));
typedef __bf16 bf16x2_t __attribute__((ext_vector_type(2)));
typedef _Float16 f16x2_t __attribute__((ext_vector_type(2)));
typedef float f32x2v __attribute__((ext_vector_type(2)));
typedef _Float16 h2v __attribute__((ext_vector_type(2)));

constexpr int DM = 1024, NB = 4, SEQ = 8192, NTOK = NB * SEQ;
constexpr int MROWS = NTOK + 256;
constexpr int INW = 3088;
constexpr int NPROJ = 3072, NP1 = 3328;
constexpr int NEXP = 16384;
constexpr float EPS = 1e-6f;
constexpr int C_GQ = 0, C_GK = 256, C_GV = 512, C_GG = 1024, C_RQ = 1536, C_RK = 1792, C_RV = 2048, C_RG = 2560;
constexpr int S_GA = 1536, S_RQ = 1552, S_RV = 2064;

constexpr size_t MiB = 1u << 20;
constexpr size_t WS_CTL = 0, WS_WIN = 1 * MiB, WS_WOUT = 8 * MiB, WS_WS = 10 * MiB, WS_ROPE = 14 * MiB, WS_SSQ = 17 * MiB, WS_SEG = 19 * MiB, WS_ASEG = 27 * MiB,
                 WS_UB = 28 * MiB, WS_VB = 60 * MiB, WS_XN = 92 * MiB, WS_O = 157 * MiB, WS_LA = 221 * MiB, WS_PROJ = 254 * MiB, WS_XQ = 448 * MiB, WS_END = 480 * MiB;
static_assert(WS_WIN + (size_t)NP1 * DM * 2 <= WS_WOUT && WS_ROPE + (size_t)(SEQ + 64) * 32 * 8 <= WS_SSQ && WS_XN + (size_t)MROWS * DM * 2 <= WS_O &&
              WS_LA + (size_t)MROWS * 256 * 4 <= WS_PROJ && WS_PROJ + (size_t)MROWS * NPROJ * 2 <= WS_END && WS_PROJ + (size_t)NTOK * 2048 * 2 <= WS_END, "ws map");

constexpr int LDS_BYTES = 147456;
constexpr int NPHASE = 7;
#ifndef PROBE_R
#define PROBE_R 1
#define PROBE_U 1
#define PROBE_V 1
#endif
#ifndef PEER_FP8
#define PEER_FP8 1
#endif

struct Params {
    const float *x, *meta, *g1, *w_in, *gw2, *gb, *gla_gain, *ret_gain, *ret_bias, *w_out, *g2, *w_q, *subkeys, *pu, *pv, *gfin;
    float* out; unsigned char* ws;
    int ph_lo, ph_hi;
};

#define LDS_WAIT() asm volatile("s_waitcnt lgkmcnt(0)" ::: "memory")
__device__ __forceinline__ unsigned f2bf(float f) { unsigned u = __builtin_bit_cast(unsigned, f); return (u + 0x7fffu + ((u >> 16) & 1u)) >> 16; }
__device__ __forceinline__ unsigned pk2(float lo, float hi) { return f2bf(lo) | (f2bf(hi) << 16); }
__device__ __forceinline__ float bf_lo(unsigned w) { return __builtin_bit_cast(float, w << 16); }
__device__ __forceinline__ float bf_hi(unsigned w) { return __builtin_bit_cast(float, w & 0xffff0000u); }
__device__ __forceinline__ float bf1(bf16_t h) { return __builtin_bit_cast(float, (unsigned)h << 16); }
__device__ __forceinline__ float wave_sum(float v) {
#pragma unroll
    for (int o = 1; o < 64; o <<= 1) v += __shfl_xor(v, o);
    return v;
}

struct MapIn {
    __device__ __forceinline__ void operator()(int j, int& src, float& sc) const {
        if (j < C_RQ) { src = j; sc = (j < 256) ? 0.125f : 1.0f; }
        else if (j < C_RV) { const int jj = j - C_RQ, which = jj >> 8, within = jj & 255, head = within >> 6, p = within & 63;
            const int a = p >> 3, n = (p >> 2) & 1, i = p & 3; src = S_RQ + which * 256 + head * 64 + 32 * n + 4 * a + i; sc = which ? 0.125f : 1.0f; }
        else { src = S_RV + (j - C_RV); sc = 1.0f; }
    }
};
struct MapId { __device__ __forceinline__ void operator()(int j, int& src, float& sc) const { src = j; sc = 1.0f; } };

template <class Map>
__device__ __forceinline__ void transpose_item(const float* W, int K, int N, bf16_t* WT, LAS float* scr, int item, int nblk, int lane, const Map map) {
    const int kb = item / nblk, nb = item % nblk, k0 = 64 * kb, n0 = 32 * nb;
    int src; float sc; map(n0 + (lane & 31), src, sc);
#pragma unroll 8
    for (int i = 0; i < 32; ++i) { const int kk = 2 * i + (lane >> 5); scr[kk * 33 + (lane & 31)] = W[(size_t)(k0 + kk) * N + src] * sc; }
    LDS_WAIT();
    const int c = lane & 7;
#pragma unroll
    for (int j = 0; j < 4; ++j) { const int n = (lane >> 3) + 8 * j; const LAS float* s = scr + (8 * c) * 33 + n;
        u32x4 o; o.x = pk2(s[0 * 33], s[1 * 33]); o.y = pk2(s[2 * 33], s[3 * 33]); o.z = pk2(s[4 * 33], s[5 * 33]); o.w = pk2(s[6 * 33], s[7 * 33]);
        *(u32x4*)(WT + (size_t)(n0 + n) * K + k0 + 8 * c) = o; }
    LDS_WAIT();
}

__device__ __forceinline__ void phase0(const Params& p, LAS unsigned char* lds, int bid, int nb) {
    const int tid = threadIdx.x, lane = tid & 63, wave = __builtin_amdgcn_readfirstlane(tid >> 6);
    unsigned char* ws = p.ws;
    bf16_t* XN = (bf16_t*)(ws + WS_XN); bf16_t* WinT = (bf16_t*)(ws + WS_WIN); bf16_t* WoutT = (bf16_t*)(ws + WS_WOUT); bf16_t* WsT = (bf16_t*)(ws + WS_WS);
    const int gw = bid * 8 + wave, NGW = nb * 8;
    const int gt = bid * 512 + tid, NGT = nb * 512;

    {
        LAS float* SKT = (LAS float*)lds;
        LAS float* WQT = (LAS float*)(lds + 128 * 132 * 4);
        for (int item = bid; item < 256; item += nb) {
            const int hc = item >> 4, kb = item & 15;
            __syncthreads();
            for (int e = tid; e < 128 * 128; e += 512) { const int n = e >> 7, d = e & 127; SKT[d * 132 + n] = p.subkeys[(size_t)hc * 16384 + e]; }
            for (int e = tid; e < 64 * 128; e += 512) { const int k = e >> 7, d = e & 127; WQT[d * 68 + k] = p.w_q[(size_t)(kb * 64 + k) * 2048 + hc * 128 + d]; }
            __syncthreads();
            const int tn = tid & 31, tk = tid >> 5;
            f32x4 acc[4];
#pragma unroll
            for (int i = 0; i < 4; ++i) acc[i] = (f32x4){0.f, 0.f, 0.f, 0.f};
#pragma unroll 4
            for (int d = 0; d < 128; ++d) {
                const f32x4 sk = *(const LAS f32x4*)(SKT + d * 132 + 4 * tn); const f32x4 wq = *(const LAS f32x4*)(WQT + d * 68 + 4 * tk);
#pragma unroll
                for (int i = 0; i < 4; ++i) acc[i] += sk[i] * wq;
            }
            const f32x4 gg = *(const f32x4*)(p.g2 + kb * 64 + 4 * tk);
#pragma unroll
            for (int i = 0; i < 4; ++i) { const f32x4 v = acc[i] * gg; u32x2 o; o.x = pk2(v[0], v[1]); o.y = pk2(v[2], v[3]);
                *(u32x2*)(WsT + (size_t)(hc * 128 + 4 * tn + i) * DM + kb * 64 + 4 * tk) = o; }
        }
        __syncthreads();
    }
    {
        LAS float* scr = (LAS float*)(lds + wave * 16384);
        constexpr int I_IN = (DM / 64) * (NPROJ / 32), I_OUT = (DM / 64) * (DM / 32);
        for (int it = gw; it < I_IN + I_OUT; it += NGW) {
            if (it < I_IN) transpose_item(p.w_in, DM, INW, WinT, scr, it, NPROJ / 32, lane, MapIn());
            else transpose_item(p.w_out, DM, DM, WoutT, scr, it - I_IN, DM / 32, lane, MapId());
        }
    }
    for (int e = gt; e < 256 * DM; e += NGT) {
        const int n = e >> 10, k = e & 1023; const float* wr = p.w_in + (size_t)k * INW + S_GA; float s = 0.f;
#pragma unroll
        for (int r = 0; r < 16; ++r) s += wr[r] * p.gw2[r * 256 + n];
        WinT[(size_t)(NPROJ + n) * DM + k] = (bf16_t)f2bf(s);
    }
#if PEER_FP8
    {
        u32x4* U8 = (u32x4*)(ws + WS_UB); u32x4* V8 = (u32x4*)(ws + WS_VB);
        for (int e = gt; e < NEXP * DM / 16; e += NGT) {
            const f32x4* us = (const f32x4*)p.pu + 4 * (size_t)e; const f32x4* vs = (const f32x4*)p.pv + 4 * (size_t)e;
            u32x4 wu, wv; unsigned tu[4], tv[4];
            const f32x4* g2s = (const f32x4*)p.g2 + 4 * (e & 63);
#pragma unroll
            for (int j = 0; j < 4; ++j) { const f32x4 a = us[j] * g2s[j] * 512.0f, b = vs[j] * 32.0f;
                int w = __builtin_amdgcn_cvt_pk_fp8_f32(a[0], a[1], 0, false); w = __builtin_amdgcn_cvt_pk_fp8_f32(a[2], a[3], w, true); tu[j] = (unsigned)w;
                int x = __builtin_amdgcn_cvt_pk_fp8_f32(b[0], b[1], 0, false); x = __builtin_amdgcn_cvt_pk_fp8_f32(b[2], b[3], x, true); tv[j] = (unsigned)x; }
            wu = (u32x4){tu[0], tu[1], tu[2], tu[3]}; wv = (u32x4){tv[0], tv[1], tv[2], tv[3]};
            const int row = e >> 6, c16 = e & 63;
            const size_t dst = ((size_t)(c16 >> 3) * NEXP + row) * 8 + (c16 & 7);
            U8[dst] = wu; V8[dst] = wv; }
    }
#else
    {
        u32x2* UB = (u32x2*)(ws + WS_UB); u32x2* VB = (u32x2*)(ws + WS_VB);
        const f32x4* u4 = (const f32x4*)p.pu; const f32x4* v4 = (const f32x4*)p.pv;
        for (int e = gt; e < NEXP * DM / 4; e += NGT) { const f32x4 a = u4[e]; u32x2 o; o.x = pk2(a[0], a[1]); o.y = pk2(a[2], a[3]); UB[e] = o;
            const f32x4 b = v4[e]; u32x2 q; q.x = pk2(b[0], b[1]); q.y = pk2(b[2], b[3]); VB[e] = q; }
    }
#endif
    {
        float2* rope = (float2*)(ws + WS_ROPE);
        for (int e = gt; e < (SEQ + 64) * 32; e += NGT) { const int pi = e >> 5, d = e & 31;
            const float invf = (float)pow(10000.0, -(double)d / 32.0); const float ang = (float)(pi - 48) * invf;
            rope[e] = make_float2((float)cos((double)ang), (float)sin((double)ang)); }
    }
    for (int m0 = gw; m0 < MROWS; m0 += 2 * NGW) {
        const float* srcp[2]; f32x4 v[2][4];
#pragma unroll
        for (int u = 0; u < 2; ++u) { const int m = m0 + u * NGW; srcp[u] = nullptr;
            if (m < MROWS) { if (m >= 256) srcp[u] = p.x + (size_t)(m - 256) * DM; else if (m >= 48 && m < 64) srcp[u] = p.meta + (size_t)(m - 48) * DM; }
            if (srcp[u] != nullptr) { const f32x4* xr = (const f32x4*)srcp[u] + lane;
#pragma unroll
                for (int j = 0; j < 4; ++j) v[u][j] = xr[64 * j]; }
            else {
#pragma unroll
                for (int j = 0; j < 4; ++j) v[u][j] = (f32x4){0.f, 0.f, 0.f, 0.f}; } }
        f32x4 gg[4];
#pragma unroll
        for (int j = 0; j < 4; ++j) gg[j] = ((const f32x4*)p.g1 + lane)[64 * j];
#pragma unroll
        for (int u = 0; u < 2; ++u) { const int m = m0 + u * NGW; if (m >= MROWS) continue;
            float s = 0.f;
#pragma unroll
            for (int j = 0; j < 4; ++j) s += (v[u][j].x * v[u][j].x + v[u][j].y * v[u][j].y) + (v[u][j].z * v[u][j].z + v[u][j].w * v[u][j].w);
            const float r = (srcp[u] != nullptr) ? __builtin_amdgcn_rsqf(wave_sum(s) * (1.0f / DM) + EPS) : 0.f;
            unsigned long long* o8 = (unsigned long long*)(XN + (size_t)m * DM) + lane;
#pragma unroll
            for (int j = 0; j < 4; ++j) { const f32x4 y = v[u][j] * r * gg[j]; o8[64 * j] = (unsigned long long)pk2(y.x, y.y) | ((unsigned long long)pk2(y.z, y.w) << 32); } }
    }
}

struct EpiProj {
    static constexpr bool PERM = true, AFTER_DRAIN = false;
    bf16_t* PROJ; float* LA; const float* gb; const float2* rope;
    __device__ __forceinline__ void operator()(const pg8::f32x4 (&acc)[2][2][4][2], const pg8::Unit& u, int wr, int wc, int fr, int fq) const {
        const int row0 = u.pm * 256 + wr * 64 + fr, cb0 = wc * 32 + 8 * fq;
        if (u.pn == 12) {
#pragma unroll
            for (int bj = 0; bj < 2; ++bj) { const int c = cb0 + 128 * bj; const f32x4 b0 = *(const f32x4*)(gb + c), b1 = *(const f32x4*)(gb + c + 4);
#pragma unroll
                for (int ai = 0; ai < 2; ++ai)
#pragma unroll
                    for (int m = 0; m < 4; ++m) { const int row = row0 + ai * 128 + m * 16; f32x4 v0 = acc[ai][bj][m][0] + b0, v1 = acc[ai][bj][m][1] + b1;
#pragma unroll
                        for (int i = 0; i < 4; ++i) { v0[i] = (fminf(v0[i], 0.f) - __logf(1.0f + __expf(-fabsf(v0[i])))) * 0.0625f; v1[i] = (fminf(v1[i], 0.f) - __logf(1.0f + __expf(-fabsf(v1[i])))) * 0.0625f; }
                        float* o = LA + (size_t)row * 256 + c; *(f32x4*)o = v0; *(f32x4*)(o + 4) = v1; } }
        } else if (u.pn == 6 || u.pn == 7) {
#pragma unroll
            for (int ai = 0; ai < 2; ++ai)
#pragma unroll
                for (int m = 0; m < 4; ++m) { const int row = row0 + ai * 128 + m * 16; const int pidx = (row < 256) ? row : 64 + ((row - 256) & (SEQ - 1));
#pragma unroll
                    for (int bj = 0; bj < 2; ++bj) { const int c = cb0 + 128 * bj, d0 = (c & 63) >> 1;
                        const f32x4 cs0 = *(const f32x4*)(rope + (size_t)pidx * 32 + d0), cs1 = *(const f32x4*)(rope + (size_t)pidx * 32 + d0 + 2);
                        const f32x4 t1 = acc[ai][bj][m][0], t2 = acc[ai][bj][m][1];
                        const float co[4] = {cs0[0], cs0[2], cs1[0], cs1[2]}, si[4] = {cs0[1], cs0[3], cs1[1], cs1[3]};
                        float o1[4], o2[4];
#pragma unroll
                        for (int i = 0; i < 4; ++i) { o1[i] = t1[i] * co[i] - t2[i] * si[i]; o2[i] = t1[i] * si[i] + t2[i] * co[i]; }
                        u32x4 w; w.x = pg8::cvt_pk_bf16(o1[0], o1[1]); w.y = pg8::cvt_pk_bf16(o1[2], o1[3]); w.z = pg8::cvt_pk_bf16(o2[0], o2[1]); w.w = pg8::cvt_pk_bf16(o2[2], o2[3]);
                        *(u32x4*)(PROJ + (size_t)row * NPROJ + u.pn * 256 + c) = w; } }
        } else {
#pragma unroll
            for (int ai = 0; ai < 2; ++ai)
#pragma unroll
                for (int m = 0; m < 4; ++m) { bf16_t* rowp = PROJ + (size_t)(row0 + ai * 128 + m * 16) * NPROJ + u.pn * 256 + cb0;
#pragma unroll
                    for (int bj = 0; bj < 2; ++bj) { const f32x4 v0 = acc[ai][bj][m][0], v1 = acc[ai][bj][m][1];
                        u32x4 w; w.x = pg8::cvt_pk_bf16(v0[0], v0[1]); w.y = pg8::cvt_pk_bf16(v0[2], v0[3]); w.z = pg8::cvt_pk_bf16(v1[0], v1[1]); w.w = pg8::cvt_pk_bf16(v1[2], v1[3]);
                        *(u32x4*)(rowp + bj * 128) = w; } }
        }
    }
};
struct EpiRes {
    static constexpr bool PERM = true, AFTER_DRAIN = false;
    const float* x; bf16_t* HB; float* SSQ;
    __device__ __forceinline__ void operator()(const pg8::f32x4 (&acc)[2][2][4][2], const pg8::Unit& u, int wr, int wc, int fr, int fq) const {
        const int row0 = u.pm * 256 + wr * 64 + fr, col0 = u.pn * 256 + wc * 32 + 8 * fq;
#pragma unroll
        for (int ai = 0; ai < 2; ++ai)
#pragma unroll
            for (int m = 0; m < 4; ++m) { const int row = row0 + ai * 128 + m * 16; const float* xr = x + (size_t)row * DM + col0; bf16_t* hr = HB + (size_t)row * DM + col0; float ss = 0.f;
#pragma unroll
                for (int bj = 0; bj < 2; ++bj) { const f32x4 v0 = acc[ai][bj][m][0] + *(const f32x4*)(xr + bj * 128), v1 = acc[ai][bj][m][1] + *(const f32x4*)(xr + bj * 128 + 4);
                    ss += (v0[0] * v0[0] + v0[1] * v0[1]) + (v0[2] * v0[2] + v0[3] * v0[3]) + (v1[0] * v1[0] + v1[1] * v1[1]) + (v1[2] * v1[2] + v1[3] * v1[3]);
                    u32x4 w; w.x = pg8::cvt_pk_bf16(v0[0], v0[1]); w.y = pg8::cvt_pk_bf16(v0[2], v0[3]); w.z = pg8::cvt_pk_bf16(v1[0], v1[1]); w.w = pg8::cvt_pk_bf16(v1[2], v1[3]);
                    *(u32x4*)(hr + bj * 128) = w; }
                ss += __shfl_xor(ss, 16); ss += __shfl_xor(ss, 32);
                if (fq == 0) SSQ[(size_t)row * 16 + u.pn * 4 + wc] = ss; }
    }
};
struct EpiF16 {
    static constexpr bool PERM = true, AFTER_DRAIN = false;
    _Float16* SC;
    __device__ __forceinline__ void operator()(const pg8::f32x4 (&acc)[2][2][4][2], const pg8::Unit& u, int wr, int wc, int fr, int fq) const {
        const int row0 = u.pm * 256 + wr * 64 + fr, col0 = u.pn * 256 + wc * 32 + 8 * fq;
#pragma unroll
        for (int ai = 0; ai < 2; ++ai)
#pragma unroll
            for (int m = 0; m < 4; ++m) { _Float16* rowp = SC + (size_t)(row0 + ai * 128 + m * 16) * 2048 + col0;
#pragma unroll
                for (int bj = 0; bj < 2; ++bj) { const f32x4 v0 = acc[ai][bj][m][0], v1 = acc[ai][bj][m][1];
                    u32x4 w;
                    w.x = __builtin_bit_cast(unsigned, (f16x2_t){(_Float16)v0[0], (_Float16)v0[1]}); w.y = __builtin_bit_cast(unsigned, (f16x2_t){(_Float16)v0[2], (_Float16)v0[3]});
                    w.z = __builtin_bit_cast(unsigned, (f16x2_t){(_Float16)v1[0], (_Float16)v1[1]}); w.w = __builtin_bit_cast(unsigned, (f16x2_t){(_Float16)v1[2], (_Float16)v1[3]});
                    *(u32x4*)(rowp + bj * 128) = w; } }
    }
};

constexpr int A_QT = 0, A_KT = 9216, A_KE = 18432, A_V = 27648, A_ST = 45056, A_STSZ = 18432, A_OB = 81920, A_DEC = 115712, A_CS = 115968;
constexpr int PQ = 72, PV = 136, POB = 132;

__device__ __forceinline__ bf16x8 tr2(const LAS bf16_t* p0, const LAS bf16_t* p1) {
    const s16x4 a = __builtin_amdgcn_ds_read_tr16_b64_v4i16((LAS s16x4*)p0), b = __builtin_amdgcn_ds_read_tr16_b64_v4i16((LAS s16x4*)p1);
    return (bf16x8){a[0], a[1], a[2], a[3], b[0], b[1], b[2], b[3]};
}
__device__ __forceinline__ float ln_gamma(int hr) { return log1pf(-exp2f(-5.0f - (float)hr)); }

template <bool FULL>
__device__ __forceinline__ void attn_pass(const Params& p, LAS unsigned char* lds, int bid, int nb) {
    const int tid = threadIdx.x, lane = tid & 63, wave = __builtin_amdgcn_readfirstlane(tid >> 6);
    const int r16 = lane & 15, g4 = lane >> 4, q4 = (lane & 15) >> 2, p4 = lane & 3;
    unsigned char* ws = p.ws;
    const bf16_t* PROJ = (const bf16_t*)(ws + WS_PROJ); const float* LA = (const float*)(ws + WS_LA);
    float* SEG = (float*)(ws + WS_SEG); float* ASEG = (float*)(ws + WS_ASEG); bf16_t* OUT = (bf16_t*)(ws + WS_O);
    LAS bf16_t* QT = (LAS bf16_t*)(lds + A_QT); LAS bf16_t* KT = (LAS bf16_t*)(lds + A_KT); LAS bf16_t* KE = (LAS bf16_t*)(lds + A_KE); LAS bf16_t* VS = (LAS bf16_t*)(lds + A_V);
    LAS float* OB = (LAS float*)(lds + A_OB); LAS float* DEC = (LAS float*)(lds + A_DEC); LAS float* CS = (LAS float*)(lds + A_CS);

    for (int item = bid; item < 256; item += nb) {
        const int seg = item & 7, h8 = (item >> 3) & 7, b = item >> 6;
        if (!FULL && seg == 7) continue;
        const bool gla = h8 < 4; const int hr = h8 & 3;
        const float lng = ln_gamma(hr);
        const int qcol = gla ? C_GQ + hr * 64 : C_RQ + hr * 64, kcol = gla ? C_GK + hr * 64 : C_RK + hr * 64;
        const int vcol = gla ? C_GV + hr * 128 : C_RV + hr * 128, gcol = gla ? C_GG + hr * 128 : C_RG + hr * 128;
        const int nch = (seg == 0) ? 17 : 16;

        f32x4 accS[8];
#pragma unroll
        for (int cb = 0; cb < 8; ++cb) accS[cb] = (f32x4){0.f, 0.f, 0.f, 0.f};
        float blsum = 0.f;
        __syncthreads();
        if (FULL) {
            if (wave >= 4) {
                const int wq = wave - 4;
                for (int sp = 0; sp < seg; ++sp) { const int it2 = (item & ~7) + sp; const float* Sg = SEG + (size_t)it2 * 8192; const float* Ag = ASEG + it2 * 64;
                    float dec[4];
#pragma unroll
                    for (int rg = 0; rg < 4; ++rg) dec[rg] = Ag[16 * wq + 4 * g4 + rg];
#pragma unroll
                    for (int cb = 0; cb < 8; ++cb)
#pragma unroll
                        for (int rg = 0; rg < 4; ++rg) accS[cb][rg] = dec[rg] * accS[cb][rg] + Sg[(16 * wq + 4 * g4 + rg) * 128 + 16 * cb + r16]; }
                LAS bf16_t* ST0 = (LAS bf16_t*)(lds + A_ST);
#pragma unroll
                for (int cb = 0; cb < 8; ++cb) { u32x2 w; w.x = pk2(accS[cb][0], accS[cb][1]); w.y = pk2(accS[cb][2], accS[cb][3]); *(LAS u32x2*)(ST0 + (16 * cb + r16) * PQ + 16 * wq + 4 * g4) = w; }
            }
        }
#define A_ROWBASE(ci_) (((seg == 0 && (ci_) == 0)) ? 0 : 256 + b * SEQ + ((seg == 0) ? (ci_) - 1 : 16 * seg + (ci_)) * 64)
        const int d = tid & 63, sg = tid >> 6;
        float lav[8]; bf16_t qv[8], kv[8]; u32x4 vreg[2];
#define A_LOADCHUNK(ci_) do { const int _rb = A_ROWBASE(ci_); \
            if (gla) { _Pragma("unroll") for (int k = 0; k < 8; ++k) lav[k] = LA[(size_t)(_rb + 8 * sg + k) * 256 + hr * 64 + d]; } \
            else { _Pragma("unroll") for (int k = 0; k < 8; ++k) lav[k] = lng; } \
            _Pragma("unroll") for (int k = 0; k < 8; ++k) { const size_t row = (size_t)(_rb + 8 * sg + k); \
                if (FULL) qv[k] = PROJ[row * NPROJ + qcol + d]; kv[k] = PROJ[row * NPROJ + kcol + d]; } \
            { const int vr = tid >> 3, cc = tid & 7; const u32x4* src = (const u32x4*)(PROJ + (size_t)(_rb + vr) * NPROJ + vcol + cc * 16); vreg[0] = src[0]; vreg[1] = src[1]; } } while (0)
#define A_LBAR() do { asm volatile("s_waitcnt lgkmcnt(0)" ::: "memory"); __builtin_amdgcn_s_barrier(); asm volatile("" ::: "memory"); } while (0)
        A_LOADCHUNK(0);
        f32x4 gnv[4], bsv[4];
        { const float* gptr = (gla ? p.gla_gain : p.ret_gain) + 16 * (tid & 7); const float* bptr = p.ret_bias + 16 * (tid & 7); const float bsc = gla ? 0.f : 1.f;
#pragma unroll
          for (int k4 = 0; k4 < 4; ++k4) { gnv[k4] = *(const f32x4*)(gptr + 4 * k4); bsv[k4] = *(const f32x4*)(bptr + 4 * k4) * bsc; } }
        for (int ci = 0; ci < nch; ++ci) {
            const bool metac = (seg == 0 && ci == 0);
            const int rowbase = A_ROWBASE(ci);
            const LAS bf16_t* STr = (const LAS bf16_t*)(lds + A_ST + (ci & 1) * A_STSZ); LAS bf16_t* STw = (LAS bf16_t*)(lds + A_ST + ((ci + 1) & 1) * A_STSZ);
            u32x4 gpre[2] = {(u32x4){0u, 0u, 0u, 0u}, (u32x4){0u, 0u, 0u, 0u}};
            if (FULL && !metac) { const u32x4* gp = (const u32x4*)(PROJ + (size_t)(rowbase + (tid >> 3)) * NPROJ + gcol + 16 * (tid & 7)); gpre[0] = gp[0]; gpre[1] = gp[1]; }
            float pre[8];
            {
                float run = 0.f;
#pragma unroll
                for (int k = 0; k < 8; ++k) { run += lav[k]; pre[k] = run; }
                CS[sg * 64 + d] = run;
            }
            A_LBAR();
            {
                float off = 0.f, tot = 0.f;
#pragma unroll
                for (int s = 0; s < 8; ++s) { const float c = CS[s * 64 + d]; tot += c; off += (s < sg) ? c : 0.f; }
#pragma unroll
                for (int k = 0; k < 8; ++k) { const float bc = off + pre[k]; const int i = 8 * sg + k; const float kf = bf1(kv[k]);
                    if (FULL) { QT[i * PQ + d] = (bf16_t)f2bf(bf1(qv[k]) * __expf(bc)); KT[i * PQ + d] = (bf16_t)f2bf(kf * __expf(-bc)); }
                    KE[i * PQ + d] = (bf16_t)f2bf(kf * __expf(tot - bc)); }
                if (sg == 0) { DEC[d] = __expf(tot); blsum += tot; }
                const int vr = tid >> 3, cc = tid & 7; LAS u32x4* dst = (LAS u32x4*)(VS + vr * PV + cc * 16); dst[0] = vreg[0]; dst[1] = vreg[1];
            }
            if (ci + 1 < nch) A_LOADCHUNK(ci + 1);
            A_LBAR();
            if (wave < 4) {
                if (FULL && !metac) {
                    const int w = wave;
                    bf16x8 qf[2];
#pragma unroll
                    for (int s = 0; s < 2; ++s) qf[s] = *(const LAS bf16x8*)(QT + (16 * w + r16) * PQ + 32 * s + 8 * g4);
                    f32x4 att[4];
#pragma unroll
                    for (int jb = 0; jb < 4; ++jb) { att[jb] = (f32x4){0.f, 0.f, 0.f, 0.f};
                        if (jb <= w) {
#pragma unroll
                            for (int s = 0; s < 2; ++s) { const bf16x8 kf = *(const LAS bf16x8*)(KT + (16 * jb + r16) * PQ + 32 * s + 8 * g4);
                                att[jb] = __builtin_amdgcn_mfma_f32_16x16x32_bf16(kf, qf[s], att[jb], 0, 0, 0); }
                            if (jb == w) {
#pragma unroll
                                for (int rg = 0; rg < 4; ++rg) att[jb][rg] = (4 * g4 + rg <= r16) ? att[jb][rg] : 0.f;
                            }
                        } }
                    bf16x8 af[2];
#pragma unroll
                    for (int s = 0; s < 2; ++s) { u32x4 t; t.x = pk2(att[2 * s][0], att[2 * s][1]); t.y = pk2(att[2 * s][2], att[2 * s][3]); t.z = pk2(att[2 * s + 1][0], att[2 * s + 1][1]); t.w = pk2(att[2 * s + 1][2], att[2 * s + 1][3]);
                        af[s] = __builtin_bit_cast(bf16x8, t); }
#pragma unroll
                    for (int cb = 0; cb < 8; ++cb) { f32x4 o = (f32x4){0.f, 0.f, 0.f, 0.f};
#pragma unroll
                        for (int s = 0; s < 2; ++s) {
                            const bf16x8 vf = tr2(VS + (32 * s + 4 * g4 + q4) * PV + 16 * cb + 4 * p4, VS + (32 * s + 16 + 4 * g4 + q4) * PV + 16 * cb + 4 * p4);
                            o = __builtin_amdgcn_mfma_f32_16x16x32_bf16(af[s], vf, o, 0, 0, 0);
                            const bf16x8 sf = *(const LAS bf16x8*)(STr + (16 * cb + r16) * PQ + 32 * s + 8 * g4);
                            o = __builtin_amdgcn_mfma_f32_16x16x32_bf16(qf[s], sf, o, 0, 0, 0); }
#pragma unroll
                        for (int rg = 0; rg < 4; ++rg) OB[(16 * w + 4 * g4 + rg) * POB + 16 * cb + r16] = o[rg]; }
                }
            } else {
                const int wq = wave - 4;
                float dec[4];
#pragma unroll
                for (int rg = 0; rg < 4; ++rg) dec[rg] = DEC[16 * wq + 4 * g4 + rg];
                bf16x8 kef[2];
#pragma unroll
                for (int s = 0; s < 2; ++s) kef[s] = tr2(KE + (32 * s + 8 * g4 + q4) * PQ + 16 * wq + 4 * p4, KE + (32 * s + 8 * g4 + 4 + q4) * PQ + 16 * wq + 4 * p4);
#pragma unroll
                for (int cb = 0; cb < 8; ++cb) {
#pragma unroll
                    for (int rg = 0; rg < 4; ++rg) accS[cb][rg] *= dec[rg];
#pragma unroll
                    for (int s = 0; s < 2; ++s) { const bf16x8 vf = tr2(VS + (32 * s + 8 * g4 + q4) * PV + 16 * cb + 4 * p4, VS + (32 * s + 8 * g4 + 4 + q4) * PV + 16 * cb + 4 * p4);
                        accS[cb] = __builtin_amdgcn_mfma_f32_16x16x32_bf16(kef[s], vf, accS[cb], 0, 0, 0); }
                    if (FULL) { u32x2 w; w.x = pk2(accS[cb][0], accS[cb][1]); w.y = pk2(accS[cb][2], accS[cb][3]); *(LAS u32x2*)(STw + (16 * cb + r16) * PQ + 16 * wq + 4 * g4) = w; }
                }
            }
            A_LBAR();
            if (FULL && !metac) {
                const int i = tid >> 3, cc = tid & 7;
                float o[16];
#pragma unroll
                for (int k4 = 0; k4 < 4; ++k4) { const f32x4 t = *(const LAS f32x4*)(OB + i * POB + 16 * cc + 4 * k4); o[4 * k4] = t[0]; o[4 * k4 + 1] = t[1]; o[4 * k4 + 2] = t[2]; o[4 * k4 + 3] = t[3]; }
                const size_t row = (size_t)(rowbase + i);
                const u32x4 ga = gpre[0], gb2 = gpre[1];
                const unsigned gw[8] = {ga.x, ga.y, ga.z, ga.w, gb2.x, gb2.y, gb2.z, gb2.w};
                float s1 = 0.f, s2 = 0.f;
#pragma unroll
                for (int k = 0; k < 16; ++k) { s1 += o[k]; s2 += o[k] * o[k]; }
#pragma unroll
                for (int m = 1; m < 8; m <<= 1) { s1 += __shfl_xor(s1, m); s2 += __shfl_xor(s2, m); }
                const float mu = gla ? 0.f : s1 * (1.0f / 128.0f);
                const float rs = __builtin_amdgcn_rsqf(fmaxf(s2 * (1.0f / 128.0f) - mu * mu, 0.f) + EPS);
                unsigned ow[8];
#pragma unroll
                for (int k2 = 0; k2 < 8; ++k2) { float y[2];
#pragma unroll
                    for (int e = 0; e < 2; ++e) { const int k = 2 * k2 + e; const float v = (o[k] - mu) * rs * gnv[k >> 2][k & 3] + bsv[k >> 2][k & 3];
                        const float gt = e ? bf_hi(gw[k2]) : bf_lo(gw[k2]); y[e] = v * gt * __builtin_amdgcn_rcpf(1.0f + __expf(-gt)); }
                    ow[k2] = pk2(y[0], y[1]); }
                u32x4* op = (u32x4*)(OUT + (row - 256) * DM + h8 * 128 + 16 * cc);
                op[0] = (u32x4){ow[0], ow[1], ow[2], ow[3]}; op[1] = (u32x4){ow[4], ow[5], ow[6], ow[7]};
            }
        }
        if (!FULL) {
            if (wave >= 4) { const int wq = wave - 4; float* Sg = SEG + (size_t)item * 8192;
#pragma unroll
                for (int cb = 0; cb < 8; ++cb)
#pragma unroll
                    for (int rg = 0; rg < 4; ++rg) Sg[(16 * wq + 4 * g4 + rg) * 128 + 16 * cb + r16] = accS[cb][rg]; }
            if (tid < 64) ASEG[item * 64 + tid] = __expf(blsum);
        }
#undef A_LBAR
#undef A_ROWBASE
#undef A_LOADCHUNK
    }
}

__device__ __forceinline__ unsigned ord32(float f) { const unsigned b = __builtin_bit_cast(unsigned, f); return b ^ ((b >> 31) ? 0xffffffffu : 0x80000000u); }
__device__ __forceinline__ float unord32(unsigned o) { const unsigned b = (o >> 31) ? (o ^ 0x80000000u) : ~o; return __builtin_bit_cast(float, b); }
#define DPP_MAXU(v, ctrl, rmask) do { const unsigned _t = (unsigned)__builtin_amdgcn_update_dpp((int)(v), (int)(v), (ctrl), (rmask), 0xf, false); (v) = (v) > _t ? (v) : _t; } while (0)
#define DPP_ADDF(v, ctrl) do { const float _t = __builtin_bit_cast(float, __builtin_amdgcn_update_dpp(0, __builtin_bit_cast(int, (v)), (ctrl), 0xf, 0xf, false)); (v) += _t; } while (0)
__device__ __forceinline__ unsigned row_max_u(unsigned v) { DPP_MAXU(v, 0xB1, 0xf); DPP_MAXU(v, 0x4E, 0xf); DPP_MAXU(v, 0x124, 0xf); DPP_MAXU(v, 0x128, 0xf); return v; }
__device__ __forceinline__ float row_sum_f(float v) { DPP_ADDF(v, 0xB1); DPP_ADDF(v, 0x4E); DPP_ADDF(v, 0x124); DPP_ADDF(v, 0x128); return v; }
__device__ __forceinline__ unsigned wave_max_u(unsigned v) { v = row_max_u(v); DPP_MAXU(v, 0x142, 0xa); DPP_MAXU(v, 0x143, 0xc); return (unsigned)__builtin_amdgcn_readlane((int)v, 63); }

__device__ __forceinline__ float row_sum_x(float v) { return row_sum_f(v); }
__device__ __forceinline__ float dot2_bf16(unsigned w, unsigned x, float acc) { return __builtin_amdgcn_fdot2_f32_bf16(__builtin_bit_cast(bf16x2_t, w), __builtin_bit_cast(bf16x2_t, x), acc, false); }
__device__ __forceinline__ float gelu_exact(float v) { return 0.5f * v * (1.0f + erff(v * 0.70710678118654752f)); }

__device__ __forceinline__ void phase_peer(const Params& p, LAS unsigned char* lds, int bid, int nb) {
    const int tid = threadIdx.x, lane = tid & 63, wave = __builtin_amdgcn_readfirstlane(tid >> 6);
    const int p16 = lane & 15, rg4 = lane >> 4;
    unsigned char* ws = p.ws;
    const _Float16* SC = (const _Float16*)(ws + WS_PROJ); const bf16_t* HB = (const bf16_t*)(ws + WS_XN); const float* SSQ = (const float*)(ws + WS_SSQ);
    const unsigned char* UB = (const unsigned char*)(ws + WS_UB); const unsigned char* VB = (const unsigned char*)(ws + WS_VB);
    LAS float* A_s = (LAS float*)(lds + wave * 4096);
    LAS int* A_i = (LAS int*)(lds + wave * 4096 + 1024);
    LAS int* E_i = (LAS int*)(lds + wave * 4096 + 2048);
    LAS float* E_s = (LAS float*)(lds + wave * 4096 + 2560);
    int ci = 0, cj = 0; bool cvalid = lane < 50;
    { int l = lane;
      if (l < 16) { ci = 0; cj = l; } else if (l < 24) { ci = 1; cj = l - 16; } else if (l < 29) { ci = 2; cj = l - 24; } else if (l < 33) { ci = 3; cj = l - 29; }
      else if (l < 36) { ci = 4; cj = l - 33; } else if (l < 42) { ci = 5 + (l - 36) / 2; cj = (l - 36) & 1; } else { ci = 8 + (l - 42); cj = 0; } if (!cvalid) { ci = 0; cj = 0; } }
    const int gw = bid * 8 + wave, NGW = nb * 8;
    for (int t = gw; t < NTOK; t += NGW) {
        float ssq = (lane < 16) ? SSQ[(size_t)t * 16 + lane] : 0.f; ssq = wave_sum(ssq);
        const float rstd = 1.0f / sqrtf(ssq * (1.0f / DM) + EPS);
#pragma unroll 1
        for (int q = 0; q < 4; ++q) {
            const u32x4 raw = *(const u32x4*)(SC + (size_t)t * 2048 + 512 * q + 8 * lane);
            const unsigned rw[4] = {raw.x, raw.y, raw.z, raw.w};
            unsigned key[8];
#pragma unroll
            for (int e = 0; e < 8; ++e) { const unsigned hbits = (e & 1) ? (rw[e >> 1] >> 16) : (rw[e >> 1] & 0xffffu);
                const float f = (float)__builtin_bit_cast(_Float16, (unsigned short)hbits);
                key[e] = (ord32(f) & ~0x7fu) | (unsigned)(127 - (8 * p16 + e)); }
            unsigned mine = 0u;
#pragma unroll 1
            for (int it = 0; it < 16; ++it) {
                unsigned m = key[0];
#pragma unroll
                for (int e = 1; e < 8; ++e) m = m > key[e] ? m : key[e];
                const unsigned W = row_max_u(m);
                mine = (p16 == it) ? W : mine;
#pragma unroll
                for (int e = 0; e < 8; ++e) key[e] = (key[e] == W) ? 0u : key[e];
            }
            const int g = 4 * q + rg4;
            A_s[g * 16 + p16] = unord32(mine & ~0x7fu); A_i[g * 16 + p16] = 127 - (int)(mine & 0x7fu);
        }
        LDS_WAIT();
#pragma unroll 1
        for (int h = 0; h < 8; ++h) {
            const float sa = A_s[(2 * h) * 16 + ci], sb = A_s[(2 * h + 1) * 16 + cj];
            const int ia = A_i[(2 * h) * 16 + ci], ib = A_i[(2 * h + 1) * 16 + cj];
            const float sum = sa + sb;
            unsigned key = cvalid ? ((ord32(sum) & ~0x3fu) | (unsigned)(63 - lane)) : 0u;
            int rank = -1;
#pragma unroll 1
            for (int it = 0; it < 16; ++it) { const unsigned W = wave_max_u(key); if (key == W) { rank = it; key = 0u; } }
            if (rank >= 0) { E_i[h * 16 + rank] = ia * 128 + ib; E_s[h * 16 + rank] = sum; }
        }
        LDS_WAIT();
        float gsm[2]; int eidx[2];
#pragma unroll
        for (int sl = 0; sl < 2; ++sl) { const int e = lane + 64 * sl; const float s = E_s[e] * rstd, mx = E_s[e & ~15] * rstd; const float pe = __expf(s - mx); const float den = row_sum_x(pe);
            gsm[sl] = pe / den; eidx[sl] = E_i[e]; }
#if PEER_FP8
        f32x2v xf[4][8];
#pragma unroll
        for (int i = 0; i < 4; ++i) { const u32x4 h0 = *(const u32x4*)(HB + (size_t)t * DM + 256 * i + 16 * p16), h1 = *(const u32x4*)(HB + (size_t)t * DM + 256 * i + 16 * p16 + 8);
            const unsigned hv[8] = {h0.x, h0.y, h0.z, h0.w, h1.x, h1.y, h1.z, h1.w}; const float* gp = p.g2 + 256 * i + 16 * p16;
#pragma unroll
            for (int k2 = 0; k2 < 8; ++k2) { const f32x2v g = *(const f32x2v*)(gp + 2 * k2); xf[i][k2] = (f32x2v){bf_lo(hv[k2]) * rstd * g.x, bf_hi(hv[k2]) * rstd * g.y}; } }
        constexpr int NBB = 2;
#define P6_LOADB(buf, TAB, bt0) do { _Pragma("unroll") for (int j = 0; j < NBB; ++j) { const int bt = (bt0) + j; const int ex = E_i[64 * (bt >> 4) + 16 * rg4 + (bt & 15)]; \
            const unsigned char* rp = (TAB) + (size_t)ex * 1024 + 16 * p16; _Pragma("unroll") for (int i = 0; i < 4; ++i) buf[j][i] = *(const u32x4*)(rp + 256 * i); } } while (0)
        u32x4 bA[NBB][4], bB[NBB][4];
        float act0 = 0.f, act1 = 0.f;
#define P6_COMPU(buf, bt0) do { _Pragma("unroll") for (int j = 0; j < NBB; ++j) { const int bt = (bt0) + j; f32x2v s2 = (f32x2v){0.f, 0.f}; \
            _Pragma("unroll") for (int i = 0; i < 4; ++i) { const unsigned uu[4] = {buf[j][i].x, buf[j][i].y, buf[j][i].z, buf[j][i].w}; \
                _Pragma("unroll") for (int w = 0; w < 4; ++w) { const f32x2v lo = __builtin_amdgcn_cvt_pk_f32_fp8((int)uu[w], false), hi = __builtin_amdgcn_cvt_pk_f32_fp8((int)uu[w], true); \
                    s2 = __builtin_elementwise_fma(lo, xf[i][2 * w], s2); s2 = __builtin_elementwise_fma(hi, xf[i][2 * w + 1], s2); } } \
            const float s = row_sum_x(s2.x + s2.y); const bool mine = (p16 == (bt & 15)); act0 = (mine && bt < 16) ? s : act0; act1 = (mine && bt >= 16) ? s : act1; } } while (0)
        P6_LOADB(bA, UB, 0);
#pragma unroll 1
        for (int g = 0; g < 32; g += 2 * NBB) { P6_LOADB(bB, UB, g + NBB); P6_COMPU(bA, g); if (g + 2 * NBB < 32) P6_LOADB(bA, UB, g + 2 * NBB); P6_COMPU(bB, g + NBB); }
        P6_LOADB(bA, VB, 0);
        LAS float* E_c = E_s;
        { const float c0 = gsm[0] * gelu_exact(act0 * (1.0f / 512.0f)) * (1.0f / 32.0f), c1 = gsm[1] * gelu_exact(act1 * (1.0f / 512.0f)) * (1.0f / 32.0f);
          LDS_WAIT(); E_c[lane] = c0; E_c[lane + 64] = c1; LDS_WAIT(); }
        f32x2v acc2[4][8];
#pragma unroll
        for (int i = 0; i < 4; ++i)
#pragma unroll
            for (int k = 0; k < 8; ++k) acc2[i][k] = (f32x2v){0.f, 0.f};
#define P6_COMPV(buf, bt0) do { _Pragma("unroll") for (int j = 0; j < NBB; ++j) { const int bt = (bt0) + j; const float cf = E_c[64 * (bt >> 4) + 16 * rg4 + (bt & 15)]; const f32x2v cf2 = (f32x2v){cf, cf}; \
            _Pragma("unroll") for (int i = 0; i < 4; ++i) { const unsigned vv[4] = {buf[j][i].x, buf[j][i].y, buf[j][i].z, buf[j][i].w}; \
                _Pragma("unroll") for (int w = 0; w < 4; ++w) { const f32x2v lo = __builtin_amdgcn_cvt_pk_f32_fp8((int)vv[w], false), hi = __builtin_amdgcn_cvt_pk_f32_fp8((int)vv[w], true); \
                    acc2[i][2 * w] = __builtin_elementwise_fma(lo, cf2, acc2[i][2 * w]); acc2[i][2 * w + 1] = __builtin_elementwise_fma(hi, cf2, acc2[i][2 * w + 1]); } } } } while (0)
#pragma unroll 1
        for (int g = 0; g < 32; g += 2 * NBB) { P6_LOADB(bB, VB, g + NBB); P6_COMPV(bA, g); if (g + 2 * NBB < 32) P6_LOADB(bA, VB, g + 2 * NBB); P6_COMPV(bB, g + NBB); }
#undef P6_LOADB
#undef P6_COMPU
#undef P6_COMPV
        float ss = 0.f;
#pragma unroll
        for (int i = 0; i < 4; ++i) { const u32x4 h0 = *(const u32x4*)(HB + (size_t)t * DM + 256 * i + 16 * p16), h1 = *(const u32x4*)(HB + (size_t)t * DM + 256 * i + 16 * p16 + 8);
            const unsigned hv[8] = {h0.x, h0.y, h0.z, h0.w, h1.x, h1.y, h1.z, h1.w};
#pragma unroll
            for (int k2 = 0; k2 < 8; ++k2) { float ax = acc2[i][k2].x, ay = acc2[i][k2].y;
                ax += __shfl_xor(ax, 16); ax += __shfl_xor(ax, 32); ay += __shfl_xor(ay, 16); ay += __shfl_xor(ay, 32);
                ax += bf_lo(hv[k2]); ay += bf_hi(hv[k2]); acc2[i][k2] = (f32x2v){ax, ay}; ss += ax * ax + ay * ay; } }
        ss = row_sum_x(ss);
        const float rf = 1.0f / sqrtf(ss * (1.0f / DM) + EPS);
#pragma unroll
        for (int i = 0; i < 4; ++i) { if (i == rg4) { const float* gp = p.gfin + 256 * i + 16 * p16; float* op = p.out + (size_t)t * DM + 256 * i + 16 * p16;
#pragma unroll
                for (int k4 = 0; k4 < 4; ++k4) { const f32x4 g = *(const f32x4*)(gp + 4 * k4);
                    *(f32x4*)(op + 4 * k4) = (f32x4){acc2[i][2 * k4].x * rf * g[0], acc2[i][2 * k4].y * rf * g[1], acc2[i][2 * k4 + 1].x * rf * g[2], acc2[i][2 * k4 + 1].y * rf * g[3]}; } } }
#else
        unsigned xp[8][4];
#pragma unroll
        for (int i = 0; i < 8; ++i) { const u32x4 hw = *(const u32x4*)(HB + (size_t)t * DM + 128 * i + 8 * p16); const f32x4 ga = *(const f32x4*)(p.g2 + 128 * i + 8 * p16), gb = *(const f32x4*)(p.g2 + 128 * i + 8 * p16 + 4);
            xp[i][0] = pk2(bf_lo(hw.x) * rstd * ga[0], bf_hi(hw.x) * rstd * ga[1]); xp[i][1] = pk2(bf_lo(hw.y) * rstd * ga[2], bf_hi(hw.y) * rstd * ga[3]);
            xp[i][2] = pk2(bf_lo(hw.z) * rstd * gb[0], bf_hi(hw.z) * rstd * gb[1]); xp[i][3] = pk2(bf_lo(hw.w) * rstd * gb[2], bf_hi(hw.w) * rstd * gb[3]); }
        float act[2] = {0.f, 0.f};
#pragma unroll
        for (int sl = 0; sl < 2; ++sl) {
#pragma unroll 2
            for (int b16 = 0; b16 < 16; ++b16) {
                const int e = 64 * sl + 16 * rg4 + b16; const int ex = E_i[e];
                const unsigned char* rowp = UB + (size_t)ex * 2048 + 16 * p16;
                float s = 0.f;
#pragma unroll
                for (int i = 0; i < 8; ++i) { const u32x4 uw = *(const u32x4*)(rowp + 256 * i);
                    s = dot2_bf16(uw.x, xp[i][0], s); s = dot2_bf16(uw.y, xp[i][1], s); s = dot2_bf16(uw.z, xp[i][2], s); s = dot2_bf16(uw.w, xp[i][3], s); }
                s = row_sum_x(s);
                act[sl] = (p16 == b16) ? s : act[sl];
            }
        }
        float coef[2];
#pragma unroll
        for (int sl = 0; sl < 2; ++sl) coef[sl] = gsm[sl] * gelu_exact(act[sl]);
        float acc[8][8];
#pragma unroll
        for (int i = 0; i < 8; ++i)
#pragma unroll
            for (int k = 0; k < 8; ++k) acc[i][k] = 0.f;
#pragma unroll
        for (int sl = 0; sl < 2; ++sl) {
#pragma unroll 2
            for (int b16 = 0; b16 < 16; ++b16) {
                const int srcl = (lane & 48) + b16;
                const float cf = __shfl(coef[sl], srcl); const int ex = __shfl(eidx[sl], srcl);
                const unsigned char* rowp = VB + (size_t)ex * 2048 + 16 * p16;
#pragma unroll
                for (int i = 0; i < 8; ++i) { const u32x4 vw = *(const u32x4*)(rowp + 256 * i);
                    acc[i][0] += cf * bf_lo(vw.x); acc[i][1] += cf * bf_hi(vw.x); acc[i][2] += cf * bf_lo(vw.y); acc[i][3] += cf * bf_hi(vw.y);
                    acc[i][4] += cf * bf_lo(vw.z); acc[i][5] += cf * bf_hi(vw.z); acc[i][6] += cf * bf_lo(vw.w); acc[i][7] += cf * bf_hi(vw.w); }
            }
        }
        float ss = 0.f;
#pragma unroll
        for (int i = 0; i < 8; ++i) { const u32x4 hw = *(const u32x4*)(HB + (size_t)t * DM + 128 * i + 8 * p16); const unsigned hv[4] = {hw.x, hw.y, hw.z, hw.w};
#pragma unroll
            for (int k = 0; k < 8; ++k) { float a = acc[i][k]; a += __shfl_xor(a, 16); a += __shfl_xor(a, 32);
                a += (k & 1) ? bf_hi(hv[k >> 1]) : bf_lo(hv[k >> 1]); acc[i][k] = a; ss += a * a; } }
        ss = row_sum_x(ss);
        const float rf = 1.0f / sqrtf(ss * (1.0f / DM) + EPS);
#pragma unroll
        for (int i = 0; i < 8; ++i) { if ((i >> 1) == rg4) { const f32x4 ga = *(const f32x4*)(p.gfin + 128 * i + 8 * p16), gb = *(const f32x4*)(p.gfin + 128 * i + 8 * p16 + 4);
                float* op = p.out + (size_t)t * DM + 128 * i + 8 * p16;
                *(f32x4*)op = (f32x4){acc[i][0] * rf * ga[0], acc[i][1] * rf * ga[1], acc[i][2] * rf * ga[2], acc[i][3] * rf * ga[3]};
                *(f32x4*)(op + 4) = (f32x4){acc[i][4] * rf * gb[0], acc[i][5] * rf * gb[1], acc[i][6] * rf * gb[2], acc[i][7] * rf * gb[3]}; } }
#endif
        LDS_WAIT();
    }
}


__device__ __forceinline__ void row_max4(unsigned k0, unsigned k1, unsigned k2, unsigned k3, unsigned& w0, unsigned& w1, unsigned& w2, unsigned& w3) {
    asm volatile("s_nop 1\n\t"
                 "v_max_u32_dpp %0, %4, %4 quad_perm:[1,0,3,2] row_mask:0xf bank_mask:0xf\n\t"
                 "v_max_u32_dpp %1, %5, %5 quad_perm:[1,0,3,2] row_mask:0xf bank_mask:0xf\n\t"
                 "v_max_u32_dpp %2, %6, %6 quad_perm:[1,0,3,2] row_mask:0xf bank_mask:0xf\n\t"
                 "v_max_u32_dpp %3, %7, %7 quad_perm:[1,0,3,2] row_mask:0xf bank_mask:0xf\n\t"
                 "v_max_u32_dpp %0, %0, %0 quad_perm:[2,3,0,1] row_mask:0xf bank_mask:0xf\n\t"
                 "v_max_u32_dpp %1, %1, %1 quad_perm:[2,3,0,1] row_mask:0xf bank_mask:0xf\n\t"
                 "v_max_u32_dpp %2, %2, %2 quad_perm:[2,3,0,1] row_mask:0xf bank_mask:0xf\n\t"
                 "v_max_u32_dpp %3, %3, %3 quad_perm:[2,3,0,1] row_mask:0xf bank_mask:0xf\n\t"
                 "v_max_u32_dpp %0, %0, %0 row_ror:4 row_mask:0xf bank_mask:0xf\n\t"
                 "v_max_u32_dpp %1, %1, %1 row_ror:4 row_mask:0xf bank_mask:0xf\n\t"
                 "v_max_u32_dpp %2, %2, %2 row_ror:4 row_mask:0xf bank_mask:0xf\n\t"
                 "v_max_u32_dpp %3, %3, %3 row_ror:4 row_mask:0xf bank_mask:0xf\n\t"
                 "v_max_u32_dpp %0, %0, %0 row_ror:8 row_mask:0xf bank_mask:0xf\n\t"
                 "v_max_u32_dpp %1, %1, %1 row_ror:8 row_mask:0xf bank_mask:0xf\n\t"
                 "v_max_u32_dpp %2, %2, %2 row_ror:8 row_mask:0xf bank_mask:0xf\n\t"
                 "v_max_u32_dpp %3, %3, %3 row_ror:8 row_mask:0xf bank_mask:0xf\n\t"
                 "s_nop 1"
                 : "=&v"(w0), "=&v"(w1), "=&v"(w2), "=&v"(w3) : "v"(k0), "v"(k1), "v"(k2), "v"(k3));
}
__device__ __forceinline__ unsigned pkadd_h2(unsigned a, unsigned b) { const h2v x = __builtin_bit_cast(h2v, a), y = __builtin_bit_cast(h2v, b); const h2v s = x + y; return __builtin_bit_cast(unsigned, s); }
constexpr int NT6 = 8;
constexpr int W6_BYTES = 16640;
__device__ __forceinline__ float dpp_f(float v, int ctrl_dummy);
#define DPPF(v, ctrl) __builtin_bit_cast(float, __builtin_amdgcn_update_dpp(0, __builtin_bit_cast(int, (v)), (ctrl), 0xf, 0xf, false))

__device__ __forceinline__ void phase_peer2(const Params& p, LAS unsigned char* lds, int bid, int nb) {
    const int tid = threadIdx.x, lane = tid & 63, wave = __builtin_amdgcn_readfirstlane(tid >> 6);
    const int p16 = lane & 15, rg4 = lane >> 4, q8 = lane >> 3, p8 = lane & 7;
    const bool b0 = lane & 1, b1 = lane & 2, b2 = lane & 4, c0 = lane & 8, c1 = lane & 16, c2 = lane & 32;
    unsigned char* ws = p.ws;
    const _Float16* SC = (const _Float16*)(ws + WS_PROJ); const bf16_t* HB = (const bf16_t*)(ws + WS_XN); const float* SSQ = (const float*)(ws + WS_SSQ);
    const unsigned char* UB = (const unsigned char*)(ws + WS_UB); const unsigned char* VB = (const unsigned char*)(ws + WS_VB); unsigned char* XQ = ws + WS_XQ;
    LAS unsigned char* wl = lds + wave * W6_BYTES;
    LAS unsigned char* CQ = wl;
    LAS unsigned short* E16 = (LAS unsigned short*)(wl + 6144);
    LAS float* GC = (LAS float*)(wl + 8192);
    LAS float* ACT = (LAS float*)(wl + 12288);
    LAS float* RS = (LAS float*)(wl + 16384);
    int ci = 0, cj = 0; bool cvalid = lane < 50;
    { int l = lane;
      if (l < 16) { ci = 0; cj = l; } else if (l < 24) { ci = 1; cj = l - 16; } else if (l < 29) { ci = 2; cj = l - 24; } else if (l < 33) { ci = 3; cj = l - 29; }
      else if (l < 36) { ci = 4; cj = l - 33; } else if (l < 42) { ci = 5 + (l - 36) / 2; cj = (l - 36) & 1; } else { ci = 8 + (l - 42); cj = 0; } if (!cvalid) { ci = 0; cj = 0; } }
    const int gw = bid * 8 + wave, NGW = nb * 8;
#define TOK6(k) min(base + (k) * NGW, NTOK - 1)
    for (int base = gw; base < NTOK; base += NT6 * NGW) {
#pragma unroll 1
        for (int rep_r = 0; rep_r < PROBE_R; ++rep_r)
#pragma unroll 1
        for (int k = 0; k < NT6; k += 2) {
            u32x4 raw[2][4]; float rstd[2];
#pragma unroll
            for (int v = 0; v < 2; ++v) { const int t = TOK6(k + v);
#pragma unroll
                for (int q = 0; q < 4; ++q) raw[v][q] = *(const u32x4*)(SC + (size_t)t * 2048 + 512 * q + 8 * lane);
                float ssq = (lane < 16) ? SSQ[(size_t)t * 16 + lane] : 0.f; ssq = wave_sum(ssq);
                rstd[v] = 1.0f / sqrtf(ssq * (1.0f / DM) + EPS);
                { const u32x4 ha = *(const u32x4*)(HB + (size_t)t * DM + 16 * lane), hb = *(const u32x4*)(HB + (size_t)t * DM + 16 * lane + 8); const float sc = rstd[v] * 16.0f;
                  const unsigned hv[8] = {ha.x, ha.y, ha.z, ha.w, hb.x, hb.y, hb.z, hb.w}; unsigned xw[4];
#pragma unroll
                  for (int w = 0; w < 4; ++w) { int pk = __builtin_amdgcn_cvt_pk_fp8_f32(bf_lo(hv[2 * w]) * sc, bf_hi(hv[2 * w]) * sc, 0, false);
                      pk = __builtin_amdgcn_cvt_pk_fp8_f32(bf_lo(hv[2 * w + 1]) * sc, bf_hi(hv[2 * w + 1]) * sc, pk, true); xw[w] = (unsigned)pk; }
                  *(u32x4*)(XQ + (size_t)t * DM + 16 * lane) = (u32x4){xw[0], xw[1], xw[2], xw[3]}; } }
#pragma unroll
            for (int qq = 0; qq < 2; ++qq) {
                unsigned ka[4][8];
#pragma unroll
                for (int c = 0; c < 4; ++c) { const u32x4 rv = raw[c >> 1][2 * qq + (c & 1)]; const unsigned rw[4] = {rv.x, rv.y, rv.z, rv.w};
#pragma unroll
                    for (int e = 0; e < 8; ++e) { const unsigned hbits = (e & 1) ? (rw[e >> 1] >> 16) : (rw[e >> 1] & 0xffffu);
                        const float f = (float)__builtin_bit_cast(_Float16, (unsigned short)hbits);
                        ka[c][e] = (ord32(f) & ~0x7fu) | (unsigned)(127 - (8 * p16 + e)); } }
#define CE6(u, i, j) do { const unsigned _a = ka[u][i], _b = ka[u][j]; ka[u][i] = _a > _b ? _a : _b; ka[u][j] = _a > _b ? _b : _a; } while (0)
#pragma unroll
                for (int u = 0; u < 4; ++u) {
                    CE6(u, 0, 1); CE6(u, 2, 3); CE6(u, 4, 5); CE6(u, 6, 7);
                    CE6(u, 0, 2); CE6(u, 1, 3); CE6(u, 4, 6); CE6(u, 5, 7);
                    CE6(u, 1, 2); CE6(u, 5, 6);
                    CE6(u, 0, 4); CE6(u, 1, 5); CE6(u, 2, 6); CE6(u, 3, 7);
                    CE6(u, 2, 4); CE6(u, 3, 5);
                    CE6(u, 1, 2); CE6(u, 3, 4); CE6(u, 5, 6);
                }
#undef CE6
                unsigned mine[4] = {0u, 0u, 0u, 0u};
#pragma unroll 1
                for (int it = 0; it < 16; ++it) {
                    unsigned Wv[4]; row_max4(ka[0][0], ka[1][0], ka[2][0], ka[3][0], Wv[0], Wv[1], Wv[2], Wv[3]);
#pragma unroll
                    for (int c = 0; c < 4; ++c) {
                        const unsigned W = Wv[c];
                        mine[c] = (p16 == it) ? W : mine[c];
                        const bool win = (ka[c][0] == W);
#pragma unroll
                        for (int e = 0; e < 7; ++e) ka[c][e] = win ? ka[c][e + 1] : ka[c][e];
                        ka[c][7] = win ? 0u : ka[c][7];
                    }
                }
#pragma unroll
                for (int c = 0; c < 4; ++c) { const int g = 4 * (2 * qq + (c & 1)) + rg4; LAS float* A_s = (LAS float*)(wl + 3072 * (c >> 1)); LAS int* A_i = (LAS int*)(wl + 3072 * (c >> 1) + 1024);
                    A_s[g * 16 + p16] = unord32(mine[c] & ~0x7fu); A_i[g * 16 + p16] = 127 - (int)(mine[c] & 0x7fu); }
            }
            LDS_WAIT();
            {
                float av[4], bc[4]; int iav[4], ibc[4], jp[4], hh[4], bb[4]; unsigned key[4];
#pragma unroll
                for (int c = 0; c < 4; ++c) { const LAS float* A_s = (const LAS float*)(wl + 3072 * (c >> 1)); const LAS int* A_i = (const LAS int*)(wl + 3072 * (c >> 1) + 1024);
                    hh[c] = 4 * (c & 1) + rg4; bb[c] = (2 * hh[c] + 1) * 16; av[c] = A_s[(2 * hh[c]) * 16 + p16]; iav[c] = A_i[(2 * hh[c]) * 16 + p16] * 128; jp[c] = 0; bc[c] = A_s[bb[c]]; ibc[c] = A_i[bb[c]];
                    key[c] = (ord32(av[c] + bc[c]) & ~0xfu) | (unsigned)(15 - p16); }
#pragma unroll 1
                for (int it = 0; it < 16; ++it) {
                    unsigned Wv[4]; row_max4(key[0], key[1], key[2], key[3], Wv[0], Wv[1], Wv[2], Wv[3]);
#pragma unroll
                    for (int c = 0; c < 4; ++c) {
                        const LAS float* A_s = (const LAS float*)(wl + 3072 * (c >> 1)); const LAS int* A_i = (const LAS int*)(wl + 3072 * (c >> 1) + 1024);
                        LAS int* E_i = (LAS int*)(wl + 3072 * (c >> 1) + 2048); LAS float* E_s = (LAS float*)(wl + 3072 * (c >> 1) + 2560);
                        const bool win = (key[c] == Wv[c]);
                        if (win) { E_i[hh[c] * 16 + it] = iav[c] + ibc[c]; E_s[hh[c] * 16 + it] = av[c] + bc[c]; }
                        jp[c] += win ? 1 : 0;
                        const int jr = jp[c] < 16 ? jp[c] : 15;
                        bc[c] = A_s[bb[c] + jr]; ibc[c] = A_i[bb[c] + jr];
                        key[c] = jp[c] < 16 ? ((ord32(av[c] + bc[c]) & ~0xfu) | (unsigned)(15 - p16)) : 0u;
                    }
                }
            }
            LDS_WAIT();
#pragma unroll
            for (int v = 0; v < 2; ++v) { const LAS int* E_i = (const LAS int*)(wl + 3072 * v + 2048); const LAS float* E_s = (const LAS float*)(wl + 3072 * v + 2560);
#pragma unroll
                for (int sl = 0; sl < 2; ++sl) { const int e = lane + 64 * sl; const float s = E_s[e] * rstd[v], mx = E_s[e & ~15] * rstd[v]; const float pe = __expf(s - mx); const float den = row_sum_x(pe);
                    const int pos = 16 * (e & 7) + (e >> 3);
                    GC[(k + v) * 128 + pos] = pe / den; E16[(k + v) * 128 + pos] = (unsigned short)E_i[e]; }
                if (lane == 0) RS[k + v] = rstd[v]; }
            LDS_WAIT();
        }
#define P6_LOADH(buf, TAB, jj, kk, hh) do { const u32x4 _iv = *(const LAS u32x4*)(E16 + (kk) * 128 + 16 * q8 + 8 * (hh)); const unsigned _iw[4] = {_iv.x, _iv.y, _iv.z, _iv.w}; \
            _Pragma("unroll") for (int c = 0; c < 8; ++c) { const unsigned _idx = (c & 1) ? (_iw[c >> 1] >> 16) : (_iw[c >> 1] & 0xffffu); \
                buf[c] = *(const u32x4*)((TAB) + (((size_t)(jj) * NEXP + _idx) << 7) + 16 * p8); } } while (0)
#define P6_LOADX(hb, jj, kk) do { const bf16_t* _hp = HB + (size_t)TOK6(kk) * DM + 128 * (jj) + 16 * p8; hb[0] = *(const u32x4*)_hp; hb[1] = *(const u32x4*)(_hp + 8); } while (0)
        asm volatile("s_waitcnt vmcnt(0)" ::: "memory");
#pragma unroll 1
        for (int rep_u = 0; rep_u < PROBE_U; ++rep_u) {
            for (int k = 0; k < NT6; ++k) { ACT[k * 128 + lane] = 0.f; ACT[k * 128 + 64 + lane] = 0.f; }
            LDS_WAIT();
            const int n16 = lane & 15, g4 = lane >> 4, c4 = lane & 3, r16 = 4 * g4 + (n16 >> 2);
            const int eoff = 2 * (16 * (r16 & 7) + (r16 >> 3));
            const bool xkeep = (g4 == (n16 >> 2));
            u32x4 bfP[16], bfQ[16], xP[2], xQ2[2];
#define P6_ULOAD(buf, xb, nn) do { const int _j = (nn) / NT6, _k = (nn) % NT6; const LAS unsigned char* _ip = (const LAS unsigned char*)(E16 + _k * 128) + eoff; \
                { const unsigned char* _xp = XQ + (size_t)TOK6(_k) * DM + 128 * _j + 16 * c4; xb[0] = *(const u32x4*)_xp; xb[1] = *(const u32x4*)(_xp + 64); } \
                asm volatile("" ::: "memory"); \
                _Pragma("unroll") for (int T = 0; T < 8; ++T) { const unsigned _idx = *(const LAS unsigned short*)(_ip + 4 * T); \
                    const unsigned char* _rp = UB + (((size_t)_j * NEXP + _idx) << 7) + 16 * c4; buf[2 * T] = *(const u32x4*)_rp; buf[2 * T + 1] = *(const u32x4*)(_rp + 64); } } while (0)
#define P6_PK64(lo, hi) ((long)(((unsigned long long)(hi) << 32) | (unsigned long long)(lo)))
#define P6_UMMA(buf, xb, nn) do { const int k = (nn) % NT6; \
                const unsigned x0 = xkeep ? xb[0].x : 0u, x1 = xkeep ? xb[0].y : 0u, x2 = xkeep ? xb[0].z : 0u, x3 = xkeep ? xb[0].w : 0u, \
                               x4 = xkeep ? xb[1].x : 0u, x5 = xkeep ? xb[1].y : 0u, x6 = xkeep ? xb[1].z : 0u, x7 = xkeep ? xb[1].w : 0u; \
                const long xa[4] = {P6_PK64(x0, x1), P6_PK64(x2, x3), P6_PK64(x4, x5), P6_PK64(x6, x7)}; \
                float dsel[2] = {0.f, 0.f}; \
                _Pragma("unroll") for (int T = 0; T < 8; ++T) { f32x4 d = (f32x4){0.f, 0.f, 0.f, 0.f}; \
                    const long bb[4] = {P6_PK64(buf[2 * T].x, buf[2 * T].y), P6_PK64(buf[2 * T].z, buf[2 * T].w), P6_PK64(buf[2 * T + 1].x, buf[2 * T + 1].y), P6_PK64(buf[2 * T + 1].z, buf[2 * T + 1].w)}; \
                    _Pragma("unroll") for (int s = 0; s < 4; ++s) d = __builtin_amdgcn_mfma_f32_16x16x32_fp8_fp8(xa[s], bb[s], d, 0, 0, 0); \
                    float pv = (c4 == 0) ? d[0] : ((c4 == 1) ? d[1] : ((c4 == 2) ? d[2] : d[3])); \
                    pv += DPPF(pv, 0xB1); pv += DPPF(pv, 0x4E);                         \
                    dsel[T >> 2] = ((T & 3) == c4) ? pv : dsel[T >> 2]; } \
                  \
                ACT[k * 128 + 16 * c4 + r16] += dsel[0]; ACT[k * 128 + 16 * (c4 + 4) + r16] += dsel[1]; } while (0)
            P6_ULOAD(bfP, xP, 0);
#pragma unroll 1
            for (int n = 0; n < 8 * NT6; n += 2) {
                P6_ULOAD(bfQ, xQ2, n + 1); asm volatile("" ::: "memory"); __builtin_amdgcn_sched_barrier(0);
                P6_UMMA(bfP, xP, n); __builtin_amdgcn_sched_barrier(0);
                if (n + 2 < 8 * NT6) P6_ULOAD(bfP, xP, n + 2);
                asm volatile("" ::: "memory"); __builtin_amdgcn_sched_barrier(0);
                P6_UMMA(bfQ, xQ2, n + 1); __builtin_amdgcn_sched_barrier(0);
            }
#undef P6_ULOAD
#undef P6_UMMA
#undef P6_PK64
        }
        LDS_WAIT();
#pragma unroll 1
        for (int k = 0; k < NT6; ++k) {
#pragma unroll
            for (int sl = 0; sl < 2; ++sl) { const int e = lane + 64 * sl, pos = 16 * (e & 7) + (e >> 3); const float a = ACT[k * 128 + e] * (1.0f / 8192.0f);
                const float cfv = GC[k * 128 + pos] * gelu_exact(a);
                CQ[k * 128 + pos] = (unsigned char)(__builtin_amdgcn_cvt_pk_fp8_f32(cfv * 32.0f, 0.f, 0, false) & 0xff); } }
        LDS_WAIT();
#pragma unroll 1
        for (int k = 0; k < NT6; ++k) ACT[k * 64 + lane] = 0.f;
        LDS_WAIT();
#pragma unroll 1
        for (int rep_v = 0; rep_v < PROBE_V; ++rep_v) {
            for (int k = 0; k < NT6; ++k) ACT[k * 64 + lane] = 0.f;
            LDS_WAIT();
            u32x4 bfP[16], bfQ[16];
#define P6_LOADI(buf, TAB, nn) do { const int _j = (nn) / NT6, _k = (nn) % NT6; P6_LOADH(buf, TAB, _j, _k, 0); P6_LOADH((buf + 8), TAB, _j, _k, 1); } while (0)
            const int n16 = lane & 15, g4 = lane >> 4;
            const int ash = 8 * (n16 & 3); const bool ahi = (n16 & 4) != 0;
            const int c0 = 16 * (n16 & 7) + 4 * (g4 & 1);
            const bool fin = (n16 < 8) && (g4 < 2);
#define P6_LOADR2(hb, nn) do { const bf16_t* _hp = HB + (size_t)TOK6((nn) % NT6) * DM + 128 * ((nn) / NT6) + c0; hb[0] = *(const u32x2*)_hp; hb[1] = *(const u32x2*)(_hp + 8); } while (0)
#define P6_VBODY(buf, nn, hb) do { const int j = (nn) / NT6, k = (nn) % NT6; const int t = TOK6(k); \
                const u32x4 cqv = *(const LAS u32x4*)(CQ + k * 128 + 16 * q8); const unsigned cqw[4] = {cqv.x, cqv.y, cqv.z, cqv.w}; \
                f32x4 d0 = (f32x4){0.f, 0.f, 0.f, 0.f}, d1 = (f32x4){0.f, 0.f, 0.f, 0.f}; \
                _Pragma("unroll") for (int c = 0; c < 16; ++c) { const unsigned cb = (cqw[c >> 2] >> (8 * (c & 3))) & 0xffu; const unsigned tt = cb << ash; \
                    const long av = P6_PK64(ahi ? 0u : tt, ahi ? tt : 0u); \
                    d0 = __builtin_amdgcn_mfma_f32_16x16x32_fp8_fp8(av, P6_PK64(buf[c].x, buf[c].y), d0, 0, 0, 0); \
                    d1 = __builtin_amdgcn_mfma_f32_16x16x32_fp8_fp8(av, P6_PK64(buf[c].z, buf[c].w), d1, 0, 0, 0); } \
                float o[8]; \
                _Pragma("unroll") for (int r = 0; r < 4; ++r) { o[r] = d0[r] + __shfl_xor(d0[r], 40); o[4 + r] = d1[r] + __shfl_xor(d1[r], 40); } \
                const unsigned hw[4] = {hb[0].x, hb[0].y, hb[1].x, hb[1].y}; float ss = 0.f; \
                _Pragma("unroll") for (int r = 0; r < 8; ++r) { const float hv = (r & 1) ? bf_hi(hw[r >> 1]) : bf_lo(hw[r >> 1]); o[r] = o[r] * (1.0f / 1024.0f) + hv; ss += o[r] * o[r]; } \
                if (fin) { float* op = p.out + (size_t)t * DM + 128 * j + c0; *(f32x4*)op = (f32x4){o[0], o[1], o[2], o[3]}; *(f32x4*)(op + 8) = (f32x4){o[4], o[5], o[6], o[7]}; \
                    ACT[k * 64 + lane] += ss; } \
                } while (0)
#define P6_PK64(lo, hi) ((long)(((unsigned long long)(hi) << 32) | (unsigned long long)(lo)))
            P6_LOADI(bfP, VB, 0);
#pragma unroll 1
            for (int n = 0; n < 8 * NT6; n += 2) {
                u32x2 hr0[2], hr1[2]; P6_LOADR2(hr0, n); P6_LOADR2(hr1, n + 1);
                asm volatile("" ::: "memory");
                P6_LOADI(bfQ, VB, n + 1); asm volatile("" ::: "memory"); __builtin_amdgcn_sched_barrier(0);
                P6_VBODY(bfP, n, hr0); __builtin_amdgcn_sched_barrier(0);
                if (n + 2 < 8 * NT6) P6_LOADI(bfP, VB, n + 2);
                asm volatile("" ::: "memory"); __builtin_amdgcn_sched_barrier(0);
                P6_VBODY(bfQ, n + 1, hr1); __builtin_amdgcn_sched_barrier(0);
            }
            LDS_WAIT(); asm volatile("s_waitcnt vmcnt(0)" ::: "memory");
            f32x4 gfv[4];
#pragma unroll
            for (int i = 0; i < 4; ++i) gfv[i] = *(const f32x4*)(p.gfin + 256 * i + 4 * lane);
#pragma unroll 1
            for (int k = 0; k < NT6; ++k) { const float sst = wave_sum(ACT[k * 64 + lane]); const float rf = __builtin_amdgcn_rsqf(sst * (1.0f / DM) + EPS);
                float* op = p.out + (size_t)TOK6(k) * DM + 4 * lane; f32x4 ov[4];
#pragma unroll
                for (int i = 0; i < 4; ++i) ov[i] = *(const f32x4*)(op + 256 * i);
#pragma unroll
                for (int i = 0; i < 4; ++i) *(f32x4*)(op + 256 * i) = ov[i] * rf * gfv[i]; }
        }
        LDS_WAIT();
    }
#undef P6_LOADH
#undef P6_LOADX
#undef P6_LOADI
#undef P6_VBODY
#undef P6_LOADR2
#undef P6_PK64
#undef TOK6
}

#define XB_TMO      128
#define XB_XCNT(j)  (256  + 64 * (j))
#define XB_XSUB(j)  (1280 + 64 * (j))
#define XB_XGEN(j)  (2304 + 64 * (j))
#define XB_TOP      3328
#define XB_TOPGEN   3392
#define XCD_BAR_WORDS 3456
#define XB_SPIN_CAP (1u << 18)

__device__ __forceinline__ unsigned xb_ld(unsigned* p)              { return __hip_atomic_load(p, __ATOMIC_RELAXED, __HIP_MEMORY_SCOPE_AGENT); }
__device__ __forceinline__ unsigned xb_add(unsigned* p, unsigned v) { return __hip_atomic_fetch_add(p, v, __ATOMIC_RELAXED, __HIP_MEMORY_SCOPE_AGENT); }
__device__ __forceinline__ unsigned xb_xcc_id() { return (unsigned)__builtin_amdgcn_s_getreg((3 << 11) | 20) & 0xFu; }
#define XB_SPIN(cond, bar) do { unsigned _sp = 0; while (cond) { __builtin_amdgcn_s_sleep(1); \
    if ((++_sp & 255u) == 0u) { if (xb_ld(&(bar)[XB_TMO])) break; if (_sp > XB_SPIN_CAP) { atomicAdd(&(bar)[XB_TMO], 1u); break; } } } } while (0)

struct XcdBarrier {
    unsigned* bar; unsigned x;
    volatile LAS unsigned* st;
};

__device__ __forceinline__ XcdBarrier xcd_barrier_post(unsigned* bar, volatile LAS unsigned* st) {
    XcdBarrier b; b.bar = bar; b.x = xb_xcc_id(); b.st = st;
    if (threadIdx.x == 0) (void)xb_add(&bar[XB_XCNT(b.x)], 1u);
    return b;
}
__device__ __forceinline__ void xcd_barrier_complete(unsigned* bar, unsigned x, unsigned& nloc, unsigned& nx) {
    const unsigned G = gridDim.x * gridDim.y * gridDim.z;
    unsigned sum, cnt, mine, sp = 0u;
    for (;;) {
        sum = 0u; cnt = 0u; mine = 0u;
#pragma unroll
        for (unsigned j = 0; j < 16; ++j) { const unsigned c = xb_ld(&bar[XB_XCNT(j)]); sum += c; cnt += (c > 0u) ? 1u : 0u; mine = (j == x) ? c : mine; }
        if (sum == G) break;
        __builtin_amdgcn_s_sleep(1);
        if ((++sp & 255u) == 0u) { if (xb_ld(&bar[XB_TMO])) break; if (sp > XB_SPIN_CAP) { atomicAdd(&bar[XB_TMO], 1u); break; } }
    }
    nloc = mine > 0u ? mine : 1u; nx = cnt > 0u ? cnt : 1u;
}

__device__ __forceinline__ void xcd_barrier(const XcdBarrier& b) {
    asm volatile("s_waitcnt vmcnt(0)" ::: "memory");
    __syncthreads();
    if (threadIdx.x == 0) {
        unsigned* bar = b.bar;
        __builtin_amdgcn_s_waitcnt(0);
        unsigned nloc = b.st[0], nx = b.st[1];
        if (nloc == 0u) { xcd_barrier_complete(bar, b.x, nloc, nx); b.st[0] = nloc; b.st[1] = nx; }
        const unsigned old = xb_add(&bar[XB_XSUB(b.x)], 1u);
        const unsigned gen = old / nloc;
        if (old + 1u == (gen + 1u) * nloc) {
            __builtin_amdgcn_fence(__ATOMIC_RELEASE, "agent");
            asm volatile("s_waitcnt vmcnt(0)" ::: "memory");
            const unsigned og = xb_add(&bar[XB_TOP], 1u);
            const unsigned tg = og / nx;
            if (og + 1u == (tg + 1u) * nx) xb_add(&bar[XB_TOPGEN], 1u);
            else XB_SPIN(xb_ld(&bar[XB_TOPGEN]) == tg, bar);
            __builtin_amdgcn_fence(__ATOMIC_ACQUIRE, "agent");
            xb_add(&bar[XB_XGEN(b.x)], 1u);
            asm volatile("s_waitcnt vmcnt(0)" ::: "memory");
        } else {
            XB_SPIN(xb_ld(&bar[XB_XGEN(b.x)]) == gen, bar);
            __builtin_amdgcn_fence(__ATOMIC_ACQUIRE, "agent");
            asm volatile("s_waitcnt vmcnt(0)" ::: "memory");
        }
    }
    __syncthreads();
}

__global__ void __launch_bounds__(512, 2) mk_fwd(Params p) {
    extern __shared__ __attribute__((aligned(16))) unsigned char lds_raw[];
    LAS unsigned char* lds = (LAS unsigned char*)lds_raw;
    const int bid = blockIdx.x, nb = gridDim.x;
    unsigned char* ws = p.ws;
#define IN(k) (p.ph_lo <= (k) && (k) < p.ph_hi)
#define SEAM(k) do { if (IN(k) && IN((k) + 1)) { xcd_barrier(bar); } } while (0)
    if (threadIdx.x < 4) ((volatile LAS unsigned*)(lds + LDS_BYTES - 16))[threadIdx.x] = 0u;
    __syncthreads();
    const XcdBarrier bar = xcd_barrier_post((unsigned*)(ws + WS_CTL) + 4096, (volatile LAS unsigned*)(lds + LDS_BYTES - 16));
    if (IN(0)) phase0(p, lds, bid, nb);
    SEAM(0);
    if (IN(1)) {
        pg8::Gemm g{(const bf16_t*)(ws + WS_XN), (const bf16_t*)(ws + WS_WIN), MROWS, NP1, DM}; pg8::StaticOrder S; S.init(MROWS, NP1, nb, bid);
        EpiProj E{(bf16_t*)(ws + WS_PROJ), (float*)(ws + WS_LA), p.gb, (const float2*)(ws + WS_ROPE)};
        pg8::gemm_phase<EpiProj, pg8::StaticOrder, true, true>(lds, g, S, E);
    }
    SEAM(1);
    if (IN(2)) attn_pass<false>(p, lds, bid, nb);
    SEAM(2);
    if (IN(3)) attn_pass<true>(p, lds, bid, nb);
    SEAM(3);
    if (IN(4)) {
        pg8::Gemm g{(const bf16_t*)(ws + WS_O), (const bf16_t*)(ws + WS_WOUT), NTOK, DM, DM}; pg8::StaticOrder S; S.init(NTOK, DM, nb, bid);
        EpiRes E{p.x, (bf16_t*)(ws + WS_XN), (float*)(ws + WS_SSQ)};
        pg8::gemm_phase<EpiRes, pg8::StaticOrder, true, true>(lds, g, S, E);
    }
    SEAM(4);
    if (IN(5)) {
        pg8::Gemm g{(const bf16_t*)(ws + WS_XN), (const bf16_t*)(ws + WS_WS), NTOK, 2048, DM}; pg8::StaticOrder S; S.init(NTOK, 2048, nb, bid);
        EpiF16 E{(_Float16*)(ws + WS_PROJ)};
        pg8::gemm_phase<EpiF16, pg8::StaticOrder, true, true>(lds, g, S, E);
    }
    SEAM(5);
    if (IN(6)) phase_peer2(p, lds, bid, nb);
#undef IN
#undef SEAM
}

#ifndef MK_FUSED
#define MK_FUSED 1
#endif
extern "C" void kernel_launch(void* const* d_in, const int* in_sizes, int n_in, void* d_out, int out_size, void* d_ws, size_t ws_size, hipStream_t stream) {
    static int grid = 0;
    if (grid == 0) {
        if (n_in != 16 || in_sizes[0] != NTOK * DM || out_size != NTOK * DM || ws_size < WS_END) {
            fprintf(stderr, "kernel_launch: unexpected shapes (n_in %d, in0 %d, out %d, ws %zu); nothing launched\n", n_in, n_in > 0 ? in_sizes[0] : -1, out_size, ws_size); grid = -1; return; }
        int dev = 0, cus = 0, per_cu = 0;
        hipGetDevice(&dev); hipDeviceGetAttribute(&cus, hipDeviceAttributeMultiprocessorCount, dev);
        if (hipFuncSetAttribute((const void*)mk_fwd, hipFuncAttributeMaxDynamicSharedMemorySize, LDS_BYTES) != hipSuccess) { fprintf(stderr, "kernel_launch: hipFuncSetAttribute failed\n"); grid = -1; return; }
        if (hipOccupancyMaxActiveBlocksPerMultiprocessor(&per_cu, (const void*)mk_fwd, 512, LDS_BYTES) != hipSuccess || per_cu < 1) { fprintf(stderr, "kernel_launch: occupancy query failed (%d)\n", per_cu); (void)hipGetLastError(); per_cu = 1; }
        grid = cus * (per_cu < 1 ? 1 : 1);
        fprintf(stderr, "kernel_launch: %d CUs, occupancy %d/CU, grid %d\n", cus, per_cu, grid);
    }
    if (grid < 0) return;
    (void)hipMemsetAsync((char*)d_ws + WS_CTL, 0, 65536, stream);
    Params p{};
    p.x = (const float*)d_in[0]; p.meta = (const float*)d_in[1]; p.g1 = (const float*)d_in[2]; p.w_in = (const float*)d_in[3]; p.gw2 = (const float*)d_in[4]; p.gb = (const float*)d_in[5];
    p.gla_gain = (const float*)d_in[6]; p.ret_gain = (const float*)d_in[7]; p.ret_bias = (const float*)d_in[8]; p.w_out = (const float*)d_in[9]; p.g2 = (const float*)d_in[10];
    p.w_q = (const float*)d_in[11]; p.subkeys = (const float*)d_in[12]; p.pu = (const float*)d_in[13]; p.pv = (const float*)d_in[14]; p.gfin = (const float*)d_in[15];
    p.out = (float*)d_out; p.ws = (unsigned char*)d_ws;
#if MK_FUSED
    p.ph_lo = 0; p.ph_hi = NPHASE;
    void* args[] = {&p};
    hipError_t e = hipLaunchCooperativeKernel((const void*)mk_fwd, dim3(grid), dim3(512), args, LDS_BYTES, stream);
    if (e != hipSuccess) fprintf(stderr, "kernel_launch: cooperative launch failed: %s (grid %d)\n", hipGetErrorString(e), grid);
#else
    { const int order[7] = {0, 1, 2, 3, 4, 5, 6}; for (int i = 0; i < 7; ++i) { p.ph_lo = order[i]; p.ph_hi = order[i] + 1; hipLaunchKernelGGL(mk_fwd, dim3(grid), dim3(512), LDS_BYTES, stream, p); } }
#endif
}
```

```cpp
#include <hip/hip_runtime.h>
#include <hip/hip_cooperative_groups.h>
#include <cstdio>
#include <cstdint>
namespace cg = cooperative_groups;
namespace pg8 {
#define PG8_LAS __attribute__((address_space(3)))
typedef unsigned short bf16_t;
typedef short bf16x8 __attribute__((ext_vector_type(8)));
typedef float f32x4 __attribute__((ext_vector_type(4)));
typedef unsigned u32x4 __attribute__((ext_vector_type(4)));
constexpr int BM = 256, BK = 64, HALF = 128, HTB = HALF * BK * 2  , STAGE_BYTES = 8 * HTB, NXCD = 8, WGM = 8;

__host__ __device__ __forceinline__ int lds_byte(int r, int c) { const int st = (r >> 4) * 2 + (c >> 5), rr = r & 15, cc = c & 31, ob = rr * 64 + cc * 2; return st * 1024 + (ob ^ (((ob >> 9) & 1) << 5)); }
__host__ __device__ __forceinline__ void stage_rc(int b, int& R, int& C) { const int st = b / 1024, sb = b % 1024, swz = sb ^ (((sb >> 9) & 1) << 5); R = (st >> 1) * 16 + swz / 64; C = (st & 1) * 32 + (swz % 64) / 2; }
__host__ __device__ __forceinline__ int perm32(int rho) { const int n = rho >> 4, i = rho & 15; return 8 * (i >> 2) + 4 * n + (i & 3); }

struct Unit { int pm, pn; };
struct Gemm { const bf16_t* A; const bf16_t* Bt; int M, N, K; };

struct StaticOrder {
    int nM, nN, nwg, G, c;
    __host__ __device__ void init(int M, int N, int G_, int c_) { nM = M / BM; nN = N / BM; nwg = nM * nN; G = G_; c = c_; }
    __host__ __device__ bool next(int i, Unit& u) const {
        const long L = (long)i * G + c; if (L >= nwg) return false;
        int wgid = (int)L; { const int q = nwg / NXCD, r = nwg % NXCD, xcd = wgid % NXCD, off = wgid / NXCD; wgid = (xcd < r ? xcd * (q + 1) : r * (q + 1) + (xcd - r) * q) + off; }
        const int nig = WGM * nN, gid = wgid / nig, fm = gid * WGM, gsz = (nM - fm) < WGM ? (nM - fm) : WGM;
        u.pm = fm + ((wgid % nig) % gsz); u.pn = (wgid % nig) / gsz; return true;
    }
    __device__ __forceinline__ void a_ready(const Unit&) const {}
    __device__ __forceinline__ void done(const Unit&) const {}
};

__device__ __forceinline__ unsigned cvt_pk_bf16(float lo, float hi) { unsigned r; asm volatile("v_cvt_pk_bf16_f32 %0, %1, %2" : "=v"(r) : "v"(lo), "v"(hi)); return r; }
typedef float f32x2 __attribute__((ext_vector_type(2)));
template <class Epi, class Sched, bool ALIGN_EPI = false, bool SP2 = false>
__device__ __forceinline__ void gemm_phase(PG8_LAS unsigned char* lds, const Gemm g, const Sched& S, const Epi& E) {
    const int tid = threadIdx.x, wid = __builtin_amdgcn_readfirstlane(tid >> 6), lane = tid & 63, wr = wid >> 2, wc = wid & 3, fr = lane & 15, fq = lane >> 4;
    const int K = g.K, nt = K / BK;
    unsigned voffA[2], voffB[2];
#pragma unroll
    for (int i = 0; i < 2; ++i) { int R, C; stage_rc(tid * 16 + i * 8192, R, C); const int Rb = Epi::PERM ? ((R & ~31) + perm32(R & 31)) : R;
        voffA[i] = (unsigned)(R * K + C) * 2u; voffB[i] = (unsigned)(Rb * K + C) * 2u; }
    const size_t kstep = (size_t)(BK * 2);
    const size_t hstep = (size_t)HALF * K * 2;
    const size_t tstep = 2 * hstep;
    const unsigned ldsw = (unsigned)wid * 1024u;
    const int aoff = lds_byte(wr * 64 + fr, fq * 8), boff = lds_byte(wc * 32 + fr, fq * 8);
#define PG8_SA(b, h) (((b) * 2 + (h)) * HTB)
#define PG8_SB(b, h) ((4 + (b) * 2 + (h)) * HTB)
#define PG8_STAGE(bufoff, gbase, voff) do { _Pragma("unroll") for (int _i = 0; _i < 2; ++_i) \
        __builtin_amdgcn_global_load_lds((const unsigned*)((const char*)(gbase) + (voff)[_i]), (PG8_LAS unsigned*)(lds + (bufoff) + ldsw + _i * 8192), 16, 0, 0); } while (0)
#define PG8_LDA(dst, b, h) do { _Pragma("unroll") for (int m = 0; m < 4; ++m) _Pragma("unroll") for (int k = 0; k < 2; ++k) dst[m][k] = *(const PG8_LAS bf16x8*)(lds + PG8_SA(b, h) + aoff + m * 2048 + k * 1024); } while (0)
#define PG8_LDB(dst, b, h) do { _Pragma("unroll") for (int n = 0; n < 2; ++n) _Pragma("unroll") for (int k = 0; k < 2; ++k) dst[n][k] = *(const PG8_LAS bf16x8*)(lds + PG8_SB(b, h) + boff + n * 2048 + k * 1024); } while (0)
#define PG8_MMA(ai, bj, At, Bt) do { __builtin_amdgcn_s_setprio(1); _Pragma("unroll") for (int m = 0; m < 4; ++m) _Pragma("unroll") for (int n = 0; n < 2; ++n) _Pragma("unroll") for (int k = 0; k < 2; ++k) \
        acc[ai][bj][m][n] = __builtin_amdgcn_mfma_f32_16x16x32_bf16(Bt[n][k], At[m][k], acc[ai][bj][m][n], 0, 0, 0); __builtin_amdgcn_s_setprio(0); } while (0)
#define PG8_WAIT_V(n) asm volatile("s_waitcnt vmcnt(" #n ")" ::: "memory")
#define PG8_WAIT_L(n) asm volatile("s_waitcnt lgkmcnt(" #n ")" ::: "memory")
#define PG8_BAR __builtin_amdgcn_s_barrier()
#define PG8_SCHED __builtin_amdgcn_sched_barrier(0)
    Unit cur, nxt; int ui = 0;
    if (!S.next(0, cur)) return;
    f32x4 acc[2][2][4][2];
#pragma unroll
    for (int a = 0; a < 2; ++a)
#pragma unroll
        for (int b = 0; b < 2; ++b)
#pragma unroll
            for (int m = 0; m < 4; ++m)
#pragma unroll
                for (int n = 0; n < 2; ++n) acc[a][b][m][n] = (f32x4){0.f, 0.f, 0.f, 0.f};
    bf16x8 At[4][2], B0[2][2], B1[2][2];
    const char* cA = (const char*)g.A + (size_t)cur.pm * tstep; const char* cB = (const char*)g.Bt + (size_t)cur.pn * tstep;
    S.a_ready(cur);
    if constexpr (SP2) {
        PG8_STAGE(PG8_SB(0, 0), cB, voffB); PG8_STAGE(PG8_SB(0, 1), cB + hstep, voffB); PG8_STAGE(PG8_SA(0, 0), cA, voffA); PG8_STAGE(PG8_SA(0, 1), cA + hstep, voffA);
        if (wr == 1) PG8_BAR;
        PG8_WAIT_V(2); PG8_BAR;
        PG8_STAGE(PG8_SB(1, 0), cB + kstep, voffB); PG8_STAGE(PG8_SA(1, 0), cA + kstep, voffA); PG8_STAGE(PG8_SB(1, 1), cB + hstep + kstep, voffB);
        PG8_WAIT_V(6); PG8_BAR;
    } else {
        PG8_STAGE(PG8_SB(0, 0), cB, voffB); PG8_STAGE(PG8_SA(0, 0), cA, voffA); PG8_STAGE(PG8_SB(0, 1), cB + hstep, voffB); PG8_STAGE(PG8_SA(0, 1), cA + hstep, voffA);
        if (wr == 1) PG8_BAR;
        PG8_WAIT_V(4); PG8_BAR;
        PG8_STAGE(PG8_SB(1, 0), cB + kstep, voffB); PG8_STAGE(PG8_SA(1, 0), cA + kstep, voffA); PG8_STAGE(PG8_SB(1, 1), cB + hstep + kstep, voffB);
        PG8_WAIT_V(6); PG8_BAR;
    }
    for (;;) {
        const bool has_next = S.next(ui + 1, nxt);
        const char* nA = has_next ? (const char*)g.A + (size_t)nxt.pm * tstep : cA; const char* nB = has_next ? (const char*)g.Bt + (size_t)nxt.pn * tstep : cB;
        for (int t = 0; t < nt; t += 2) {
            const bool last = (t == nt - 2);
            const char* a1 = cA + (size_t)(t + 1) * kstep;
            const char* a2 = last ? nA : cA + (size_t)(t + 2) * kstep; const char* b2 = last ? nB : cB + (size_t)(t + 2) * kstep;
            const char* a3 = a2 + kstep; const char* b3 = b2 + kstep;
            if (last && has_next) S.a_ready(nxt);
            if constexpr (SP2) {
            PG8_LDB(B0, 0, 0); PG8_LDB(B1, 0, 1); PG8_SCHED; PG8_LDA(At, 0, 0); PG8_STAGE(PG8_SA(1, 1), a1 + hstep, voffA);
            PG8_WAIT_V(8); PG8_WAIT_L(0); PG8_BAR; PG8_MMA(0, 0, At, B0); PG8_MMA(0, 1, At, B1); PG8_BAR; PG8_SCHED;
            PG8_LDA(At, 0, 1); PG8_STAGE(PG8_SB(0, 0), b2, voffB); PG8_STAGE(PG8_SB(0, 1), b2 + hstep, voffB); PG8_STAGE(PG8_SA(0, 0), a2, voffA);
            PG8_WAIT_V(8); PG8_WAIT_L(0); PG8_BAR; PG8_MMA(1, 0, At, B0); PG8_MMA(1, 1, At, B1); PG8_BAR; PG8_SCHED;
            PG8_LDB(B0, 1, 0); PG8_LDB(B1, 1, 1); PG8_SCHED; PG8_LDA(At, 1, 0); PG8_STAGE(PG8_SA(0, 1), a2 + hstep, voffA);
            PG8_WAIT_V(8); PG8_WAIT_L(0); PG8_BAR; PG8_MMA(0, 0, At, B0); PG8_MMA(0, 1, At, B1); PG8_BAR; PG8_SCHED;
            PG8_LDA(At, 1, 1); PG8_STAGE(PG8_SB(1, 0), b3, voffB); PG8_STAGE(PG8_SB(1, 1), b3 + hstep, voffB); PG8_STAGE(PG8_SA(1, 0), a3, voffA);
            PG8_WAIT_V(8); PG8_WAIT_L(0); PG8_BAR; PG8_MMA(1, 0, At, B0); PG8_MMA(1, 1, At, B1); PG8_BAR; PG8_SCHED;
            } else {
            PG8_LDB(B0, 0, 0); PG8_SCHED; PG8_LDA(At, 0, 0); PG8_STAGE(PG8_SA(1, 1), a1 + hstep, voffA);
            PG8_WAIT_L(8); PG8_BAR; PG8_WAIT_L(0); PG8_MMA(0, 0, At, B0); PG8_BAR; PG8_SCHED;
            PG8_LDB(B1, 0, 1); PG8_STAGE(PG8_SB(0, 0), b2, voffB);
            PG8_BAR; PG8_WAIT_L(0); PG8_MMA(0, 1, At, B1); PG8_BAR;
            PG8_LDA(At, 0, 1); PG8_STAGE(PG8_SA(0, 0), a2, voffA);
            PG8_BAR; PG8_WAIT_L(0); PG8_MMA(1, 0, At, B0); PG8_BAR; PG8_SCHED;
            PG8_STAGE(PG8_SB(0, 1), b2 + hstep, voffB);
            PG8_WAIT_V(6); PG8_BAR; PG8_MMA(1, 1, At, B1); PG8_BAR;
            PG8_LDB(B0, 1, 0); PG8_SCHED; PG8_LDA(At, 1, 0); PG8_STAGE(PG8_SA(0, 1), a2 + hstep, voffA);
            PG8_WAIT_L(8); PG8_BAR; PG8_WAIT_L(0); PG8_MMA(0, 0, At, B0); PG8_BAR; PG8_SCHED;
            PG8_LDB(B1, 1, 1); PG8_STAGE(PG8_SB(1, 0), b3, voffB);
            PG8_BAR; PG8_WAIT_L(0); PG8_MMA(0, 1, At, B1); PG8_BAR;
            PG8_LDA(At, 1, 1); PG8_STAGE(PG8_SA(1, 0), a3, voffA);
            PG8_BAR; PG8_WAIT_L(0); PG8_MMA(1, 0, At, B0); PG8_BAR; PG8_SCHED;
            PG8_STAGE(PG8_SB(1, 1), b3 + hstep, voffB);
            PG8_WAIT_V(6); PG8_BAR; PG8_MMA(1, 1, At, B1); PG8_BAR;
            }
        }
        if constexpr (ALIGN_EPI) { if (wr == 0) PG8_BAR; }
        if constexpr (!Epi::AFTER_DRAIN) { E(acc, cur, wr, wc, fr, fq); S.done(cur); }
        if (!has_next) break;
#pragma unroll
        for (int a = 0; a < 2; ++a)
#pragma unroll
            for (int b = 0; b < 2; ++b)
#pragma unroll
                for (int m = 0; m < 4; ++m)
#pragma unroll
                    for (int n = 0; n < 2; ++n) acc[a][b][m][n] = (f32x4){0.f, 0.f, 0.f, 0.f};
        cur = nxt; cA = nA; cB = nB; ++ui;
        if constexpr (ALIGN_EPI) { if (wr == 1) PG8_BAR; }
    }
    PG8_WAIT_V(0);
    if constexpr (!ALIGN_EPI) { if (wr == 0) PG8_BAR; }
    PG8_BAR;
    if constexpr (Epi::AFTER_DRAIN) { E.fused(acc, cur, wr, wc, fr, fq, lds, wid, lane); S.done(cur); }
#undef PG8_SA
#undef PG8_SB
#undef PG8_STAGE
#undef PG8_LDA
#undef PG8_LDB
#undef PG8_MMA
#undef PG8_WAIT_V
#undef PG8_WAIT_L
#undef PG8_BAR
#undef PG8_SCHED
}
}

#define LAS __attribute__((address_space(3)))
typedef unsigned short bf16_t;
typedef float f32x4 __attribute__((ext_vector_type(4)));
typedef unsigned u32x4 __attribute__((ext_vector_type(4)));
typedef unsigned u32x2 __attribute__((ext_vector_type(2)));
typedef short bf16x8 __attribute__((ext_vector_type(8)));
typedef short s16x4 __attribute__((ext_vector_type(4)));
typedef __bf16 bf16x2_t __attribute__((ext_vector_type(2)));
typedef _Float16 f16x2_t __attribute__((ext_vector_type(2)));
typedef float f32x2v __attribute__((ext_vector_type(2)));
typedef _Float16 h2v __attribute__((ext_vector_type(2)));

constexpr int DM = 1024, NB = 4, SEQ = 8192, NTOK = NB * SEQ;
constexpr int MROWS = NTOK + 256;
constexpr int INW = 3088;
constexpr int NPROJ = 3072, NP1 = 3328;
constexpr int NEXP = 16384;
constexpr float EPS = 1e-6f;
constexpr int C_GQ = 0, C_GK = 256, C_GV = 512, C_GG = 1024, C_RQ = 1536, C_RK = 1792, C_RV = 2048, C_RG = 2560;
constexpr int S_GA = 1536, S_RQ = 1552, S_RV = 2064;

constexpr size_t MiB = 1u << 20;
constexpr size_t WS_CTL = 0, WS_WIN = 1 * MiB, WS_WOUT = 8 * MiB, WS_WS = 10 * MiB, WS_ROPE = 14 * MiB, WS_SSQ = 17 * MiB, WS_SEG = 19 * MiB, WS_ASEG = 27 * MiB,
                 WS_UB = 28 * MiB, WS_VB = 60 * MiB, WS_XN = 92 * MiB, WS_O = 157 * MiB, WS_LA = 221 * MiB, WS_PROJ = 254 * MiB, WS_XQ = 448 * MiB, WS_END = 480 * MiB;
static_assert(WS_WIN + (size_t)NP1 * DM * 2 <= WS_WOUT && WS_ROPE + (size_t)(SEQ + 64) * 32 * 8 <= WS_SSQ && WS_XN + (size_t)MROWS * DM * 2 <= WS_O &&
              WS_LA + (size_t)MROWS * 256 * 4 <= WS_PROJ && WS_PROJ + (size_t)MROWS * NPROJ * 2 <= WS_END && WS_PROJ + (size_t)NTOK * 2048 * 2 <= WS_END, "ws map");

constexpr int LDS_BYTES = 147456;
constexpr int NPHASE = 7;
#ifndef PROBE_R
#define PROBE_R 1
#define PROBE_U 1
#define PROBE_V 1
#endif
#ifndef PEER_FP8
#define PEER_FP8 1
#endif

struct Params {
    const float *x, *meta, *g1, *w_in, *gw2, *gb, *gla_gain, *ret_gain, *ret_bias, *w_out, *g2, *w_q, *subkeys, *pu, *pv, *gfin;
    float* out; unsigned char* ws;
    int ph_lo, ph_hi;
};

#define LDS_WAIT() asm volatile("s_waitcnt lgkmcnt(0)" ::: "memory")
__device__ __forceinline__ unsigned pk2(float lo, float hi) { const bf16x2_t v = {(__bf16)lo, (__bf16)hi}; return __builtin_bit_cast(unsigned, v); }
__device__ __forceinline__ unsigned f2bf(float f) { return (unsigned)__builtin_bit_cast(unsigned short, (__bf16)f); }

__device__ __forceinline__ float bf_lo(unsigned w) { return __builtin_bit_cast(float, w << 16); }
__device__ __forceinline__ float bf_hi(unsigned w) { return __builtin_bit_cast(float, w & 0xffff0000u); }
__device__ __forceinline__ float bf1(bf16_t h) { return __builtin_bit_cast(float, (unsigned)h << 16); }
__device__ __forceinline__ float wave_sum(float v) {
#pragma unroll
    for (int o = 1; o < 64; o <<= 1) v += __shfl_xor(v, o);
    return v;
}

struct MapIn {
    __device__ __forceinline__ void operator()(int j, int& src, float& sc) const {
        if (j < C_RQ) { src = j; sc = (j < 256) ? 0.125f : 1.0f; }
        else if (j < C_RV) { const int jj = j - C_RQ, which = jj >> 8, within = jj & 255, head = within >> 6, p = within & 63;
            const int a = p >> 3, n = (p >> 2) & 1, i = p & 3; src = S_RQ + which * 256 + head * 64 + 32 * n + 4 * a + i; sc = which ? 0.125f : 1.0f; }
        else { src = S_RV + (j - C_RV); sc = 1.0f; }
    }
};
struct MapId { __device__ __forceinline__ void operator()(int j, int& src, float& sc) const { src = j; sc = 1.0f; } };

template <class Map>
__device__ __forceinline__ void transpose_item(const float* W, int K, int N, bf16_t* WT, LAS float* scr, int item, int nblk, int lane, const Map map) {
    const int kb = item / nblk, nb = item % nblk, k0 = 64 * kb, n0 = 32 * nb;
    int src; float sc; map(n0 + (lane & 31), src, sc);
#pragma unroll 8
    for (int i = 0; i < 32; ++i) { const int kk = 2 * i + (lane >> 5); scr[kk * 33 + (lane & 31)] = W[(size_t)(k0 + kk) * N + src] * sc; }
    LDS_WAIT();
    const int c = lane & 7;
#pragma unroll
    for (int j = 0; j < 4; ++j) { const int n = (lane >> 3) + 8 * j; const LAS float* s = scr + (8 * c) * 33 + n;
        u32x4 o; o.x = pk2(s[0 * 33], s[1 * 33]); o.y = pk2(s[2 * 33], s[3 * 33]); o.z = pk2(s[4 * 33], s[5 * 33]); o.w = pk2(s[6 * 33], s[7 * 33]);
        *(u32x4*)(WT + (size_t)(n0 + n) * K + k0 + 8 * c) = o; }
    LDS_WAIT();
}

__device__ __forceinline__ void phase0(const Params& p, LAS unsigned char* lds, int bid, int nb) {
    const int tid = threadIdx.x, lane = tid & 63, wave = __builtin_amdgcn_readfirstlane(tid >> 6);
    unsigned char* ws = p.ws;
    bf16_t* XN = (bf16_t*)(ws + WS_XN); bf16_t* WinT = (bf16_t*)(ws + WS_WIN); bf16_t* WoutT = (bf16_t*)(ws + WS_WOUT); bf16_t* WsT = (bf16_t*)(ws + WS_WS);
    const int gw = bid * 8 + wave, NGW = nb * 8;
    const int gt = bid * 512 + tid, NGT = nb * 512;

    {
        LAS float* SKT = (LAS float*)lds;
        LAS float* WQT = (LAS float*)(lds + 128 * 132 * 4);
        for (int item = bid; item < 256; item += nb) {
            const int hc = item >> 4, kb = item & 15;
            __syncthreads();
            for (int e = tid; e < 128 * 128; e += 512) { const int n = e >> 7, d = e & 127; SKT[d * 132 + n] = p.subkeys[(size_t)hc * 16384 + e]; }
            for (int e = tid; e < 64 * 128; e += 512) { const int k = e >> 7, d = e & 127; WQT[d * 68 + k] = p.w_q[(size_t)(kb * 64 + k) * 2048 + hc * 128 + d]; }
            __syncthreads();
            const int tn = tid & 31, tk = tid >> 5;
            f32x4 acc[4];
#pragma unroll
            for (int i = 0; i < 4; ++i) acc[i] = (f32x4){0.f, 0.f, 0.f, 0.f};
#pragma unroll 4
            for (int d = 0; d < 128; ++d) {
                const f32x4 sk = *(const LAS f32x4*)(SKT + d * 132 + 4 * tn); const f32x4 wq = *(const LAS f32x4*)(WQT + d * 68 + 4 * tk);
#pragma unroll
                for (int i = 0; i < 4; ++i) acc[i] += sk[i] * wq;
            }
            const f32x4 gg = *(const f32x4*)(p.g2 + kb * 64 + 4 * tk);
#pragma unroll
            for (int i = 0; i < 4; ++i) { const f32x4 v = acc[i] * gg; u32x2 o; o.x = pk2(v[0], v[1]); o.y = pk2(v[2], v[3]);
                *(u32x2*)(WsT + (size_t)(hc * 128 + 4 * tn + i) * DM + kb * 64 + 4 * tk) = o; }
        }
        __syncthreads();
    }
    {
        LAS float* scr = (LAS float*)(lds + wave * 16384);
        constexpr int I_IN = (DM / 64) * (NPROJ / 32), I_OUT = (DM / 64) * (DM / 32);
        for (int it = gw; it < I_IN + I_OUT; it += NGW) {
            if (it < I_IN) transpose_item(p.w_in, DM, INW, WinT, scr, it, NPROJ / 32, lane, MapIn());
            else transpose_item(p.w_out, DM, DM, WoutT, scr, it - I_IN, DM / 32, lane, MapId());
        }
    }
    for (int e = gt; e < 256 * DM; e += NGT) {
        const int n = e >> 10, k = e & 1023; const float* wr = p.w_in + (size_t)k * INW + S_GA; float s = 0.f;
#pragma unroll
        for (int r = 0; r < 16; ++r) s += wr[r] * p.gw2[r * 256 + n];
        WinT[(size_t)(NPROJ + n) * DM + k] = (bf16_t)f2bf(s);
    }
#if PEER_FP8
    {
        u32x4* U8 = (u32x4*)(ws + WS_UB); u32x4* V8 = (u32x4*)(ws + WS_VB);
        for (int e = gt; e < NEXP * DM / 16; e += NGT) {
            const f32x4* us = (const f32x4*)p.pu + 4 * (size_t)e; const f32x4* vs = (const f32x4*)p.pv + 4 * (size_t)e;
            u32x4 wu, wv; unsigned tu[4], tv[4];
            const f32x4* g2s = (const f32x4*)p.g2 + 4 * (e & 63);
#pragma unroll
            for (int j = 0; j < 4; ++j) { const f32x4 a = us[j] * g2s[j] * 512.0f, b = vs[j] * 32.0f;
                int w = __builtin_amdgcn_cvt_pk_fp8_f32(a[0], a[1], 0, false); w = __builtin_amdgcn_cvt_pk_fp8_f32(a[2], a[3], w, true); tu[j] = (unsigned)w;
                int x = __builtin_amdgcn_cvt_pk_fp8_f32(b[0], b[1], 0, false); x = __builtin_amdgcn_cvt_pk_fp8_f32(b[2], b[3], x, true); tv[j] = (unsigned)x; }
            wu = (u32x4){tu[0], tu[1], tu[2], tu[3]}; wv = (u32x4){tv[0], tv[1], tv[2], tv[3]};
            const int row = e >> 6, c16 = e & 63;
            const size_t dst = ((size_t)(c16 >> 3) * NEXP + row) * 8 + (c16 & 7);
            U8[dst] = wu; V8[dst] = wv; }
    }
#else
    {
        u32x2* UB = (u32x2*)(ws + WS_UB); u32x2* VB = (u32x2*)(ws + WS_VB);
        const f32x4* u4 = (const f32x4*)p.pu; const f32x4* v4 = (const f32x4*)p.pv;
        for (int e = gt; e < NEXP * DM / 4; e += NGT) { const f32x4 a = u4[e]; u32x2 o; o.x = pk2(a[0], a[1]); o.y = pk2(a[2], a[3]); UB[e] = o;
            const f32x4 b = v4[e]; u32x2 q; q.x = pk2(b[0], b[1]); q.y = pk2(b[2], b[3]); VB[e] = q; }
    }
#endif
    {
        float2* rope = (float2*)(ws + WS_ROPE);
        for (int e = gt; e < (SEQ + 64) * 32; e += NGT) { const int pi = e >> 5, d = e & 31;
            const float invf = (float)pow(10000.0, -(double)d / 32.0); const float ang = (float)(pi - 48) * invf;
            rope[e] = make_float2((float)cos((double)ang), (float)sin((double)ang)); }
    }
    for (int m0 = gw; m0 < MROWS; m0 += 2 * NGW) {
        const float* srcp[2]; f32x4 v[2][4];
#pragma unroll
        for (int u = 0; u < 2; ++u) { const int m = m0 + u * NGW; srcp[u] = nullptr;
            if (m < MROWS) { if (m >= 256) srcp[u] = p.x + (size_t)(m - 256) * DM; else if (m >= 48 && m < 64) srcp[u] = p.meta + (size_t)(m - 48) * DM; }
            if (srcp[u] != nullptr) { const f32x4* xr = (const f32x4*)srcp[u] + lane;
#pragma unroll
                for (int j = 0; j < 4; ++j) v[u][j] = xr[64 * j]; }
            else {
#pragma unroll
                for (int j = 0; j < 4; ++j) v[u][j] = (f32x4){0.f, 0.f, 0.f, 0.f}; } }
        f32x4 gg[4];
#pragma unroll
        for (int j = 0; j < 4; ++j) gg[j] = ((const f32x4*)p.g1 + lane)[64 * j];
#pragma unroll
        for (int u = 0; u < 2; ++u) { const int m = m0 + u * NGW; if (m >= MROWS) continue;
            float s = 0.f;
#pragma unroll
            for (int j = 0; j < 4; ++j) s += (v[u][j].x * v[u][j].x + v[u][j].y * v[u][j].y) + (v[u][j].z * v[u][j].z + v[u][j].w * v[u][j].w);
            const float r = (srcp[u] != nullptr) ? __builtin_amdgcn_rsqf(wave_sum(s) * (1.0f / DM) + EPS) : 0.f;
            unsigned long long* o8 = (unsigned long long*)(XN + (size_t)m * DM) + lane;
#pragma unroll
            for (int j = 0; j < 4; ++j) { const f32x4 y = v[u][j] * r * gg[j]; o8[64 * j] = (unsigned long long)pk2(y.x, y.y) | ((unsigned long long)pk2(y.z, y.w) << 32); } }
    }
}

struct EpiProj {
    static constexpr bool PERM = true, AFTER_DRAIN = false;
    bf16_t* PROJ; float* LA; const float* gb; const float2* rope;
    __device__ __forceinline__ void operator()(const pg8::f32x4 (&acc)[2][2][4][2], const pg8::Unit& u, int wr, int wc, int fr, int fq) const {
        const int row0 = u.pm * 256 + wr * 64 + fr, cb0 = wc * 32 + 8 * fq;
        if (u.pn == 12) {
#pragma unroll
            for (int bj = 0; bj < 2; ++bj) { const int c = cb0 + 128 * bj; const f32x4 b0 = *(const f32x4*)(gb + c), b1 = *(const f32x4*)(gb + c + 4);
#pragma unroll
                for (int ai = 0; ai < 2; ++ai)
#pragma unroll
                    for (int m = 0; m < 4; ++m) { const int row = row0 + ai * 128 + m * 16; f32x4 v0 = acc[ai][bj][m][0] + b0, v1 = acc[ai][bj][m][1] + b1;
#pragma unroll
                        for (int i = 0; i < 4; ++i) { v0[i] = (fminf(v0[i], 0.f) - __logf(1.0f + __expf(-fabsf(v0[i])))) * 0.0625f; v1[i] = (fminf(v1[i], 0.f) - __logf(1.0f + __expf(-fabsf(v1[i])))) * 0.0625f; }
                        float* o = LA + (size_t)row * 256 + c; *(f32x4*)o = v0; *(f32x4*)(o + 4) = v1; } }
        } else if (u.pn == 6 || u.pn == 7) {
#pragma unroll
            for (int ai = 0; ai < 2; ++ai)
#pragma unroll
                for (int m = 0; m < 4; ++m) { const int row = row0 + ai * 128 + m * 16; const int pidx = (row < 256) ? row : 64 + ((row - 256) & (SEQ - 1));
#pragma unroll
                    for (int bj = 0; bj < 2; ++bj) { const int c = cb0 + 128 * bj, d0 = (c & 63) >> 1;
                        const f32x4 cs0 = *(const f32x4*)(rope + (size_t)pidx * 32 + d0), cs1 = *(const f32x4*)(rope + (size_t)pidx * 32 + d0 + 2);
                        const f32x4 t1 = acc[ai][bj][m][0], t2 = acc[ai][bj][m][1];
                        const float co[4] = {cs0[0], cs0[2], cs1[0], cs1[2]}, si[4] = {cs0[1], cs0[3], cs1[1], cs1[3]};
                        float o1[4], o2[4];
#pragma unroll
                        for (int i = 0; i < 4; ++i) { o1[i] = t1[i] * co[i] - t2[i] * si[i]; o2[i] = t1[i] * si[i] + t2[i] * co[i]; }
                        u32x4 w; w.x = pg8::cvt_pk_bf16(o1[0], o1[1]); w.y = pg8::cvt_pk_bf16(o1[2], o1[3]); w.z = pg8::cvt_pk_bf16(o2[0], o2[1]); w.w = pg8::cvt_pk_bf16(o2[2], o2[3]);
                        *(u32x4*)(PROJ + (size_t)row * NPROJ + u.pn * 256 + c) = w; } }
        } else {
#pragma unroll
            for (int ai = 0; ai < 2; ++ai)
#pragma unroll
                for (int m = 0; m < 4; ++m) { bf16_t* rowp = PROJ + (size_t)(row0 + ai * 128 + m * 16) * NPROJ + u.pn * 256 + cb0;
#pragma unroll
                    for (int bj = 0; bj < 2; ++bj) { const f32x4 v0 = acc[ai][bj][m][0], v1 = acc[ai][bj][m][1];
                        u32x4 w; w.x = pg8::cvt_pk_bf16(v0[0], v0[1]); w.y = pg8::cvt_pk_bf16(v0[2], v0[3]); w.z = pg8::cvt_pk_bf16(v1[0], v1[1]); w.w = pg8::cvt_pk_bf16(v1[2], v1[3]);
                        *(u32x4*)(rowp + bj * 128) = w; } }
        }
    }
};
struct EpiRes {
    static constexpr bool PERM = true, AFTER_DRAIN = false;
    const float* x; bf16_t* HB; float* SSQ;
    __device__ __forceinline__ void operator()(const pg8::f32x4 (&acc)[2][2][4][2], const pg8::Unit& u, int wr, int wc, int fr, int fq) const {
        const int row0 = u.pm * 256 + wr * 64 + fr, col0 = u.pn * 256 + wc * 32 + 8 * fq;
#pragma unroll
        for (int ai = 0; ai < 2; ++ai)
#pragma unroll
            for (int m = 0; m < 4; ++m) { const int row = row0 + ai * 128 + m * 16; const float* xr = x + (size_t)row * DM + col0; bf16_t* hr = HB + (size_t)row * DM + col0; float ss = 0.f;
#pragma unroll
                for (int bj = 0; bj < 2; ++bj) { const f32x4 v0 = acc[ai][bj][m][0] + *(const f32x4*)(xr + bj * 128), v1 = acc[ai][bj][m][1] + *(const f32x4*)(xr + bj * 128 + 4);
                    ss += (v0[0] * v0[0] + v0[1] * v0[1]) + (v0[2] * v0[2] + v0[3] * v0[3]) + (v1[0] * v1[0] + v1[1] * v1[1]) + (v1[2] * v1[2] + v1[3] * v1[3]);
                    u32x4 w; w.x = pg8::cvt_pk_bf16(v0[0], v0[1]); w.y = pg8::cvt_pk_bf16(v0[2], v0[3]); w.z = pg8::cvt_pk_bf16(v1[0], v1[1]); w.w = pg8::cvt_pk_bf16(v1[2], v1[3]);
                    *(u32x4*)(hr + bj * 128) = w; }
                ss += __shfl_xor(ss, 16); ss += __shfl_xor(ss, 32);
                if (fq == 0) SSQ[(size_t)row * 16 + u.pn * 4 + wc] = ss; }
    }
};
struct EpiF16 {
    static constexpr bool PERM = true, AFTER_DRAIN = false;
    _Float16* SC;
    __device__ __forceinline__ void operator()(const pg8::f32x4 (&acc)[2][2][4][2], const pg8::Unit& u, int wr, int wc, int fr, int fq) const {
        const int row0 = u.pm * 256 + wr * 64 + fr, col0 = u.pn * 256 + wc * 32 + 8 * fq;
#pragma unroll
        for (int ai = 0; ai < 2; ++ai)
#pragma unroll
            for (int m = 0; m < 4; ++m) { _Float16* rowp = SC + (size_t)(row0 + ai * 128 + m * 16) * 2048 + col0;
#pragma unroll
                for (int bj = 0; bj < 2; ++bj) { const f32x4 v0 = acc[ai][bj][m][0], v1 = acc[ai][bj][m][1];
                    u32x4 w;
                    w.x = __builtin_bit_cast(unsigned, (f16x2_t){(_Float16)v0[0], (_Float16)v0[1]}); w.y = __builtin_bit_cast(unsigned, (f16x2_t){(_Float16)v0[2], (_Float16)v0[3]});
                    w.z = __builtin_bit_cast(unsigned, (f16x2_t){(_Float16)v1[0], (_Float16)v1[1]}); w.w = __builtin_bit_cast(unsigned, (f16x2_t){(_Float16)v1[2], (_Float16)v1[3]});
                    *(u32x4*)(rowp + bj * 128) = w; } }
    }
};

constexpr int A_QT = 0, A_KT = 9216, A_KE = 18432, A_V = 27648, A_ST = 45056, A_STSZ = 18432, A_OB = 81920, A_DEC = 115712, A_CS = 115968;
constexpr int PQ = 72, PV = 136, POB = 132;

__device__ __forceinline__ bf16x8 tr2(const LAS bf16_t* p0, const LAS bf16_t* p1) {
    const s16x4 a = __builtin_amdgcn_ds_read_tr16_b64_v4i16((LAS s16x4*)p0), b = __builtin_amdgcn_ds_read_tr16_b64_v4i16((LAS s16x4*)p1);
    return (bf16x8){a[0], a[1], a[2], a[3], b[0], b[1], b[2], b[3]};
}
__device__ __forceinline__ float ln_gamma(int hr) { return log1pf(-exp2f(-5.0f - (float)hr)); }

template <bool FULL>
__device__ __forceinline__ void attn_pass(const Params& p, LAS unsigned char* lds, int bid, int nb) {
    const int tid = threadIdx.x, lane = tid & 63, wave = __builtin_amdgcn_readfirstlane(tid >> 6);
    const int r16 = lane & 15, g4 = lane >> 4, q4 = (lane & 15) >> 2, p4 = lane & 3;
    unsigned char* ws = p.ws;
    const bf16_t* PROJ = (const bf16_t*)(ws + WS_PROJ); const float* LA = (const float*)(ws + WS_LA);
    float* SEG = (float*)(ws + WS_SEG); float* ASEG = (float*)(ws + WS_ASEG); bf16_t* OUT = (bf16_t*)(ws + WS_O);
    LAS bf16_t* QT = (LAS bf16_t*)(lds + A_QT); LAS bf16_t* KT = (LAS bf16_t*)(lds + A_KT); LAS bf16_t* KE = (LAS bf16_t*)(lds + A_KE); LAS bf16_t* VS = (LAS bf16_t*)(lds + A_V);
    LAS float* OB = (LAS float*)(lds + A_OB); LAS float* DEC = (LAS float*)(lds + A_DEC); LAS float* CS = (LAS float*)(lds + A_CS);

    for (int item = bid; item < 256; item += nb) {
        const int seg = item & 7, h8 = (item >> 3) & 7, b = item >> 6;
        if (!FULL && seg == 7) continue;
        const bool gla = h8 < 4; const int hr = h8 & 3;
        const float lng = ln_gamma(hr);
        const int qcol = gla ? C_GQ + hr * 64 : C_RQ + hr * 64, kcol = gla ? C_GK + hr * 64 : C_RK + hr * 64;
        const int vcol = gla ? C_GV + hr * 128 : C_RV + hr * 128, gcol = gla ? C_GG + hr * 128 : C_RG + hr * 128;
        const int nch = (seg == 0) ? 17 : 16;

        f32x4 accS[8];
#pragma unroll
        for (int cb = 0; cb < 8; ++cb) accS[cb] = (f32x4){0.f, 0.f, 0.f, 0.f};
        float blsum = 0.f;
        __syncthreads();
        if (FULL) {
            if (wave >= 4) {
                const int wq = wave - 4;
                for (int sp = 0; sp < seg; ++sp) { const int it2 = (item & ~7) + sp; const float* Sg = SEG + (size_t)it2 * 8192; const float* Ag = ASEG + it2 * 64;
                    float dec[4];
#pragma unroll
                    for (int rg = 0; rg < 4; ++rg) dec[rg] = Ag[16 * wq + 4 * g4 + rg];
#pragma unroll
                    for (int cb = 0; cb < 8; ++cb)
#pragma unroll
                        for (int rg = 0; rg < 4; ++rg) accS[cb][rg] = dec[rg] * accS[cb][rg] + Sg[(16 * wq + 4 * g4 + rg) * 128 + 16 * cb + r16]; }
                LAS bf16_t* ST0 = (LAS bf16_t*)(lds + A_ST);
#pragma unroll
                for (int cb = 0; cb < 8; ++cb) { u32x2 w; w.x = pk2(accS[cb][0], accS[cb][1]); w.y = pk2(accS[cb][2], accS[cb][3]); *(LAS u32x2*)(ST0 + (16 * cb + r16) * PQ + 16 * wq + 4 * g4) = w; }
            }
        }
#define A_ROWBASE(ci_) (((seg == 0 && (ci_) == 0)) ? 0 : 256 + b * SEQ + ((seg == 0) ? (ci_) - 1 : 16 * seg + (ci_)) * 64)
        const int d = tid & 63, sg = tid >> 6;
        float lav[8]; bf16_t qv[8], kv[8]; u32x4 vreg[2];
#define A_LOADCHUNK(ci_) do { const int _rb = A_ROWBASE(ci_); \
            if (gla) { _Pragma("unroll") for (int k = 0; k < 8; ++k) lav[k] = LA[(size_t)(_rb + 8 * sg + k) * 256 + hr * 64 + d]; } \
            else { _Pragma("unroll") for (int k = 0; k < 8; ++k) lav[k] = lng; } \
            _Pragma("unroll") for (int k = 0; k < 8; ++k) { const size_t row = (size_t)(_rb + 8 * sg + k); \
                if (FULL) qv[k] = PROJ[row * NPROJ + qcol + d]; kv[k] = PROJ[row * NPROJ + kcol + d]; } \
            { const int vr = tid >> 3, cc = tid & 7; const u32x4* src = (const u32x4*)(PROJ + (size_t)(_rb + vr) * NPROJ + vcol + cc * 16); vreg[0] = src[0]; vreg[1] = src[1]; } } while (0)
#define A_LBAR() do { asm volatile("s_waitcnt lgkmcnt(0)" ::: "memory"); __builtin_amdgcn_s_barrier(); asm volatile("" ::: "memory"); } while (0)
        A_LOADCHUNK(0);
        f32x4 gnv[4], bsv[4];
        { const float* gptr = (gla ? p.gla_gain : p.ret_gain) + 16 * (tid & 7); const float* bptr = p.ret_bias + 16 * (tid & 7); const float bsc = gla ? 0.f : 1.f;
#pragma unroll
          for (int k4 = 0; k4 < 4; ++k4) { gnv[k4] = *(const f32x4*)(gptr + 4 * k4); bsv[k4] = *(const f32x4*)(bptr + 4 * k4) * bsc; } }
        for (int ci = 0; ci < nch; ++ci) {
            const bool metac = (seg == 0 && ci == 0);
            const int rowbase = A_ROWBASE(ci);
            const LAS bf16_t* STr = (const LAS bf16_t*)(lds + A_ST + (ci & 1) * A_STSZ); LAS bf16_t* STw = (LAS bf16_t*)(lds + A_ST + ((ci + 1) & 1) * A_STSZ);
            u32x4 gpre[2] = {(u32x4){0u, 0u, 0u, 0u}, (u32x4){0u, 0u, 0u, 0u}};
            if (FULL && !metac) { const u32x4* gp = (const u32x4*)(PROJ + (size_t)(rowbase + (tid >> 3)) * NPROJ + gcol + 16 * (tid & 7)); gpre[0] = gp[0]; gpre[1] = gp[1]; }
            float pre[8];
            {
                float run = 0.f;
#pragma unroll
                for (int k = 0; k < 8; ++k) { run += lav[k]; pre[k] = run; }
                CS[sg * 64 + d] = run;
            }
            A_LBAR();
            {
                float off = 0.f, tot = 0.f;
#pragma unroll
                for (int s = 0; s < 8; ++s) { const float c = CS[s * 64 + d]; tot += c; off += (s < sg) ? c : 0.f; }
#pragma unroll
                for (int k = 0; k < 8; ++k) { const float bc = off + pre[k]; const int i = 8 * sg + k; const float kf = bf1(kv[k]);
                    if (FULL) { QT[i * PQ + d] = (bf16_t)f2bf(bf1(qv[k]) * __expf(bc)); KT[i * PQ + d] = (bf16_t)f2bf(kf * __expf(-bc)); }
                    KE[i * PQ + d] = (bf16_t)f2bf(kf * __expf(tot - bc)); }
                if (sg == 0) { DEC[d] = __expf(tot); blsum += tot; }
                const int vr = tid >> 3, cc = tid & 7; LAS u32x4* dst = (LAS u32x4*)(VS + vr * PV + cc * 16); dst[0] = vreg[0]; dst[1] = vreg[1];
            }
            if (ci + 1 < nch) A_LOADCHUNK(ci + 1);
            A_LBAR();
            if (wave < 4) {
                if (FULL && !metac) {
                    const int w = wave;
                    bf16x8 qf[2];
#pragma unroll
                    for (int s = 0; s < 2; ++s) qf[s] = *(const LAS bf16x8*)(QT + (16 * w + r16) * PQ + 32 * s + 8 * g4);
                    f32x4 att[4];
#pragma unroll
                    for (int jb = 0; jb < 4; ++jb) { att[jb] = (f32x4){0.f, 0.f, 0.f, 0.f};
                        if (jb <= w) {
#pragma unroll
                            for (int s = 0; s < 2; ++s) { const bf16x8 kf = *(const LAS bf16x8*)(KT + (16 * jb + r16) * PQ + 32 * s + 8 * g4);
                                att[jb] = __builtin_amdgcn_mfma_f32_16x16x32_bf16(kf, qf[s], att[jb], 0, 0, 0); }
                            if (jb == w) {
#pragma unroll
                                for (int rg = 0; rg < 4; ++rg) att[jb][rg] = (4 * g4 + rg <= r16) ? att[jb][rg] : 0.f;
                            }
                        } }
                    bf16x8 af[2];
#pragma unroll
                    for (int s = 0; s < 2; ++s) { u32x4 t; t.x = pk2(att[2 * s][0], att[2 * s][1]); t.y = pk2(att[2 * s][2], att[2 * s][3]); t.z = pk2(att[2 * s + 1][0], att[2 * s + 1][1]); t.w = pk2(att[2 * s + 1][2], att[2 * s + 1][3]);
                        af[s] = __builtin_bit_cast(bf16x8, t); }
#pragma unroll
                    for (int cb = 0; cb < 8; ++cb) { f32x4 o = (f32x4){0.f, 0.f, 0.f, 0.f};
#pragma unroll
                        for (int s = 0; s < 2; ++s) {
                            const bf16x8 vf = tr2(VS + (32 * s + 4 * g4 + q4) * PV + 16 * cb + 4 * p4, VS + (32 * s + 16 + 4 * g4 + q4) * PV + 16 * cb + 4 * p4);
                            o = __builtin_amdgcn_mfma_f32_16x16x32_bf16(af[s], vf, o, 0, 0, 0);
                            const bf16x8 sf = *(const LAS bf16x8*)(STr + (16 * cb + r16) * PQ + 32 * s + 8 * g4);
                            o = __builtin_amdgcn_mfma_f32_16x16x32_bf16(qf[s], sf, o, 0, 0, 0); }
#pragma unroll
                        for (int rg = 0; rg < 4; ++rg) OB[(16 * w + 4 * g4 + rg) * POB + 16 * cb + r16] = o[rg]; }
                }
            } else {
                const int wq = wave - 4;
                float dec[4];
#pragma unroll
                for (int rg = 0; rg < 4; ++rg) dec[rg] = DEC[16 * wq + 4 * g4 + rg];
                bf16x8 kef[2];
#pragma unroll
                for (int s = 0; s < 2; ++s) kef[s] = tr2(KE + (32 * s + 8 * g4 + q4) * PQ + 16 * wq + 4 * p4, KE + (32 * s + 8 * g4 + 4 + q4) * PQ + 16 * wq + 4 * p4);
#pragma unroll
                for (int cb = 0; cb < 8; ++cb) {
#pragma unroll
                    for (int rg = 0; rg < 4; ++rg) accS[cb][rg] *= dec[rg];
#pragma unroll
                    for (int s = 0; s < 2; ++s) { const bf16x8 vf = tr2(VS + (32 * s + 8 * g4 + q4) * PV + 16 * cb + 4 * p4, VS + (32 * s + 8 * g4 + 4 + q4) * PV + 16 * cb + 4 * p4);
                        accS[cb] = __builtin_amdgcn_mfma_f32_16x16x32_bf16(kef[s], vf, accS[cb], 0, 0, 0); }
                    if (FULL) { u32x2 w; w.x = pk2(accS[cb][0], accS[cb][1]); w.y = pk2(accS[cb][2], accS[cb][3]); *(LAS u32x2*)(STw + (16 * cb + r16) * PQ + 16 * wq + 4 * g4) = w; }
                }
            }
            A_LBAR();
            if (FULL && !metac) {
                const int i = tid >> 3, cc = tid & 7;
                float o[16];
#pragma unroll
                for (int k4 = 0; k4 < 4; ++k4) { const f32x4 t = *(const LAS f32x4*)(OB + i * POB + 16 * cc + 4 * k4); o[4 * k4] = t[0]; o[4 * k4 + 1] = t[1]; o[4 * k4 + 2] = t[2]; o[4 * k4 + 3] = t[3]; }
                const size_t row = (size_t)(rowbase + i);
                const u32x4 ga = gpre[0], gb2 = gpre[1];
                const unsigned gw[8] = {ga.x, ga.y, ga.z, ga.w, gb2.x, gb2.y, gb2.z, gb2.w};
                float s1 = 0.f, s2 = 0.f;
#pragma unroll
                for (int k = 0; k < 16; ++k) { s1 += o[k]; s2 += o[k] * o[k]; }
#pragma unroll
                for (int m = 1; m < 8; m <<= 1) { s1 += __shfl_xor(s1, m); s2 += __shfl_xor(s2, m); }
                const float mu = gla ? 0.f : s1 * (1.0f / 128.0f);
                const float rs = __builtin_amdgcn_rsqf(fmaxf(s2 * (1.0f / 128.0f) - mu * mu, 0.f) + EPS);
                unsigned ow[8];
#pragma unroll
                for (int k2 = 0; k2 < 8; ++k2) { float y[2];
#pragma unroll
                    for (int e = 0; e < 2; ++e) { const int k = 2 * k2 + e; const float v = (o[k] - mu) * rs * gnv[k >> 2][k & 3] + bsv[k >> 2][k & 3];
                        const float gt = e ? bf_hi(gw[k2]) : bf_lo(gw[k2]); y[e] = v * gt * __builtin_amdgcn_rcpf(1.0f + __expf(-gt)); }
                    ow[k2] = pk2(y[0], y[1]); }
                u32x4* op = (u32x4*)(OUT + (row - 256) * DM + h8 * 128 + 16 * cc);
                op[0] = (u32x4){ow[0], ow[1], ow[2], ow[3]}; op[1] = (u32x4){ow[4], ow[5], ow[6], ow[7]};
            }
        }
        if (!FULL) {
            if (wave >= 4) { const int wq = wave - 4; float* Sg = SEG + (size_t)item * 8192;
#pragma unroll
                for (int cb = 0; cb < 8; ++cb)
#pragma unroll
                    for (int rg = 0; rg < 4; ++rg) Sg[(16 * wq + 4 * g4 + rg) * 128 + 16 * cb + r16] = accS[cb][rg]; }
            if (tid < 64) ASEG[item * 64 + tid] = __expf(blsum);
        }
#undef A_LBAR
#undef A_ROWBASE
#undef A_LOADCHUNK
    }
}

__device__ __forceinline__ unsigned ord32(float f) { const unsigned b = __builtin_bit_cast(unsigned, f); return b ^ ((b >> 31) ? 0xffffffffu : 0x80000000u); }
__device__ __forceinline__ float unord32(unsigned o) { const unsigned b = (o >> 31) ? (o ^ 0x80000000u) : ~o; return __builtin_bit_cast(float, b); }
#define DPP_MAXU(v, ctrl, rmask) do { const unsigned _t = (unsigned)__builtin_amdgcn_update_dpp((int)(v), (int)(v), (ctrl), (rmask), 0xf, false); (v) = (v) > _t ? (v) : _t; } while (0)
#define DPP_ADDF(v, ctrl) do { const float _t = __builtin_bit_cast(float, __builtin_amdgcn_update_dpp(0, __builtin_bit_cast(int, (v)), (ctrl), 0xf, 0xf, false)); (v) += _t; } while (0)
__device__ __forceinline__ unsigned row_max_u(unsigned v) { DPP_MAXU(v, 0xB1, 0xf); DPP_MAXU(v, 0x4E, 0xf); DPP_MAXU(v, 0x124, 0xf); DPP_MAXU(v, 0x128, 0xf); return v; }
__device__ __forceinline__ float row_sum_f(float v) { DPP_ADDF(v, 0xB1); DPP_ADDF(v, 0x4E); DPP_ADDF(v, 0x124); DPP_ADDF(v, 0x128); return v; }
__device__ __forceinline__ unsigned wave_max_u(unsigned v) { v = row_max_u(v); DPP_MAXU(v, 0x142, 0xa); DPP_MAXU(v, 0x143, 0xc); return (unsigned)__builtin_amdgcn_readlane((int)v, 63); }

__device__ __forceinline__ float row_sum_x(float v) { return row_sum_f(v); }
__device__ __forceinline__ float dot2_bf16(unsigned w, unsigned x, float acc) { return __builtin_amdgcn_fdot2_f32_bf16(__builtin_bit_cast(bf16x2_t, w), __builtin_bit_cast(bf16x2_t, x), acc, false); }
__device__ __forceinline__ float gelu_exact(float v) { return 0.5f * v * (1.0f + erff(v * 0.70710678118654752f)); }

__device__ __forceinline__ void phase_peer(const Params& p, LAS unsigned char* lds, int bid, int nb) {
    const int tid = threadIdx.x, lane = tid & 63, wave = __builtin_amdgcn_readfirstlane(tid >> 6);
    const int p16 = lane & 15, rg4 = lane >> 4;
    unsigned char* ws = p.ws;
    const _Float16* SC = (const _Float16*)(ws + WS_PROJ); const bf16_t* HB = (const bf16_t*)(ws + WS_XN); const float* SSQ = (const float*)(ws + WS_SSQ);
    const unsigned char* UB = (const unsigned char*)(ws + WS_UB); const unsigned char* VB = (const unsigned char*)(ws + WS_VB);
    LAS float* A_s = (LAS float*)(lds + wave * 4096);
    LAS int* A_i = (LAS int*)(lds + wave * 4096 + 1024);
    LAS int* E_i = (LAS int*)(lds + wave * 4096 + 2048);
    LAS float* E_s = (LAS float*)(lds + wave * 4096 + 2560);
    int ci = 0, cj = 0; bool cvalid = lane < 50;
    { int l = lane;
      if (l < 16) { ci = 0; cj = l; } else if (l < 24) { ci = 1; cj = l - 16; } else if (l < 29) { ci = 2; cj = l - 24; } else if (l < 33) { ci = 3; cj = l - 29; }
      else if (l < 36) { ci = 4; cj = l - 33; } else if (l < 42) { ci = 5 + (l - 36) / 2; cj = (l - 36) & 1; } else { ci = 8 + (l - 42); cj = 0; } if (!cvalid) { ci = 0; cj = 0; } }
    const int gw = bid * 8 + wave, NGW = nb * 8;
    for (int t = gw; t < NTOK; t += NGW) {
        float ssq = (lane < 16) ? SSQ[(size_t)t * 16 + lane] : 0.f; ssq = wave_sum(ssq);
        const float rstd = 1.0f / sqrtf(ssq * (1.0f / DM) + EPS);
#pragma unroll 1
        for (int q = 0; q < 4; ++q) {
            const u32x4 raw = *(const u32x4*)(SC + (size_t)t * 2048 + 512 * q + 8 * lane);
            const unsigned rw[4] = {raw.x, raw.y, raw.z, raw.w};
            unsigned key[8];
#pragma unroll
            for (int e = 0; e < 8; ++e) { const unsigned hbits = (e & 1) ? (rw[e >> 1] >> 16) : (rw[e >> 1] & 0xffffu);
                const float f = (float)__builtin_bit_cast(_Float16, (unsigned short)hbits);
                key[e] = (ord32(f) & ~0x7fu) | (unsigned)(127 - (8 * p16 + e)); }
            unsigned mine = 0u;
#pragma unroll 1
            for (int it = 0; it < 16; ++it) {
                unsigned m = key[0];
#pragma unroll
                for (int e = 1; e < 8; ++e) m = m > key[e] ? m : key[e];
                const unsigned W = row_max_u(m);
                mine = (p16 == it) ? W : mine;
#pragma unroll
                for (int e = 0; e < 8; ++e) key[e] = (key[e] == W) ? 0u : key[e];
            }
            const int g = 4 * q + rg4;
            A_s[g * 16 + p16] = unord32(mine & ~0x7fu); A_i[g * 16 + p16] = 127 - (int)(mine & 0x7fu);
        }
        LDS_WAIT();
#pragma unroll 1
        for (int h = 0; h < 8; ++h) {
            const float sa = A_s[(2 * h) * 16 + ci], sb = A_s[(2 * h + 1) * 16 + cj];
            const int ia = A_i[(2 * h) * 16 + ci], ib = A_i[(2 * h + 1) * 16 + cj];
            const float sum = sa + sb;
            unsigned key = cvalid ? ((ord32(sum) & ~0x3fu) | (unsigned)(63 - lane)) : 0u;
            int rank = -1;
#pragma unroll 1
            for (int it = 0; it < 16; ++it) { const unsigned W = wave_max_u(key); if (key == W) { rank = it; key = 0u; } }
            if (rank >= 0) { E_i[h * 16 + rank] = ia * 128 + ib; E_s[h * 16 + rank] = sum; }
        }
        LDS_WAIT();
        float gsm[2]; int eidx[2];
#pragma unroll
        for (int sl = 0; sl < 2; ++sl) { const int e = lane + 64 * sl; const float s = E_s[e] * rstd, mx = E_s[e & ~15] * rstd; const float pe = __expf(s - mx); const float den = row_sum_x(pe);
            gsm[sl] = pe / den; eidx[sl] = E_i[e]; }
#if PEER_FP8
        f32x2v xf[4][8];
#pragma unroll
        for (int i = 0; i < 4; ++i) { const u32x4 h0 = *(const u32x4*)(HB + (size_t)t * DM + 256 * i + 16 * p16), h1 = *(const u32x4*)(HB + (size_t)t * DM + 256 * i + 16 * p16 + 8);
            const unsigned hv[8] = {h0.x, h0.y, h0.z, h0.w, h1.x, h1.y, h1.z, h1.w}; const float* gp = p.g2 + 256 * i + 16 * p16;
#pragma unroll
            for (int k2 = 0; k2 < 8; ++k2) { const f32x2v g = *(const f32x2v*)(gp + 2 * k2); xf[i][k2] = (f32x2v){bf_lo(hv[k2]) * rstd * g.x, bf_hi(hv[k2]) * rstd * g.y}; } }
        constexpr int NBB = 2;
#define P6_LOADB(buf, TAB, bt0) do { _Pragma("unroll") for (int j = 0; j < NBB; ++j) { const int bt = (bt0) + j; const int ex = E_i[64 * (bt >> 4) + 16 * rg4 + (bt & 15)]; \
            const unsigned char* rp = (TAB) + (size_t)ex * 1024 + 16 * p16; _Pragma("unroll") for (int i = 0; i < 4; ++i) buf[j][i] = *(const u32x4*)(rp + 256 * i); } } while (0)
        u32x4 bA[NBB][4], bB[NBB][4];
        float act0 = 0.f, act1 = 0.f;
#define P6_COMPU(buf, bt0) do { _Pragma("unroll") for (int j = 0; j < NBB; ++j) { const int bt = (bt0) + j; f32x2v s2 = (f32x2v){0.f, 0.f}; \
            _Pragma("unroll") for (int i = 0; i < 4; ++i) { const unsigned uu[4] = {buf[j][i].x, buf[j][i].y, buf[j][i].z, buf[j][i].w}; \
                _Pragma("unroll") for (int w = 0; w < 4; ++w) { const f32x2v lo = __builtin_amdgcn_cvt_pk_f32_fp8((int)uu[w], false), hi = __builtin_amdgcn_cvt_pk_f32_fp8((int)uu[w], true); \
                    s2 = __builtin_elementwise_fma(lo, xf[i][2 * w], s2); s2 = __builtin_elementwise_fma(hi, xf[i][2 * w + 1], s2); } } \
            const float s = row_sum_x(s2.x + s2.y); const bool mine = (p16 == (bt & 15)); act0 = (mine && bt < 16) ? s : act0; act1 = (mine && bt >= 16) ? s : act1; } } while (0)
        P6_LOADB(bA, UB, 0);
#pragma unroll 1
        for (int g = 0; g < 32; g += 2 * NBB) { P6_LOADB(bB, UB, g + NBB); P6_COMPU(bA, g); if (g + 2 * NBB < 32) P6_LOADB(bA, UB, g + 2 * NBB); P6_COMPU(bB, g + NBB); }
        P6_LOADB(bA, VB, 0);
        LAS float* E_c = E_s;
        { const float c0 = gsm[0] * gelu_exact(act0 * (1.0f / 512.0f)) * (1.0f / 32.0f), c1 = gsm[1] * gelu_exact(act1 * (1.0f / 512.0f)) * (1.0f / 32.0f);
          LDS_WAIT(); E_c[lane] = c0; E_c[lane + 64] = c1; LDS_WAIT(); }
        f32x2v acc2[4][8];
#pragma unroll
        for (int i = 0; i < 4; ++i)
#pragma unroll
            for (int k = 0; k < 8; ++k) acc2[i][k] = (f32x2v){0.f, 0.f};
#define P6_COMPV(buf, bt0) do { _Pragma("unroll") for (int j = 0; j < NBB; ++j) { const int bt = (bt0) + j; const float cf = E_c[64 * (bt >> 4) + 16 * rg4 + (bt & 15)]; const f32x2v cf2 = (f32x2v){cf, cf}; \
            _Pragma("unroll") for (int i = 0; i < 4; ++i) { const unsigned vv[4] = {buf[j][i].x, buf[j][i].y, buf[j][i].z, buf[j][i].w}; \
                _Pragma("unroll") for (int w = 0; w < 4; ++w) { const f32x2v lo = __builtin_amdgcn_cvt_pk_f32_fp8((int)vv[w], false), hi = __builtin_amdgcn_cvt_pk_f32_fp8((int)vv[w], true); \
                    acc2[i][2 * w] = __builtin_elementwise_fma(lo, cf2, acc2[i][2 * w]); acc2[i][2 * w + 1] = __builtin_elementwise_fma(hi, cf2, acc2[i][2 * w + 1]); } } } } while (0)
#pragma unroll 1
        for (int g = 0; g < 32; g += 2 * NBB) { P6_LOADB(bB, VB, g + NBB); P6_COMPV(bA, g); if (g + 2 * NBB < 32) P6_LOADB(bA, VB, g + 2 * NBB); P6_COMPV(bB, g + NBB); }
#undef P6_LOADB
#undef P6_COMPU
#undef P6_COMPV
        float ss = 0.f;
#pragma unroll
        for (int i = 0; i < 4; ++i) { const u32x4 h0 = *(const u32x4*)(HB + (size_t)t * DM + 256 * i + 16 * p16), h1 = *(const u32x4*)(HB + (size_t)t * DM + 256 * i + 16 * p16 + 8);
            const unsigned hv[8] = {h0.x, h0.y, h0.z, h0.w, h1.x, h1.y, h1.z, h1.w};
#pragma unroll
            for (int k2 = 0; k2 < 8; ++k2) { float ax = acc2[i][k2].x, ay = acc2[i][k2].y;
                ax += __shfl_xor(ax, 16); ax += __shfl_xor(ax, 32); ay += __shfl_xor(ay, 16); ay += __shfl_xor(ay, 32);
                ax += bf_lo(hv[k2]); ay += bf_hi(hv[k2]); acc2[i][k2] = (f32x2v){ax, ay}; ss += ax * ax + ay * ay; } }
        ss = row_sum_x(ss);
        const float rf = 1.0f / sqrtf(ss * (1.0f / DM) + EPS);
#pragma unroll
        for (int i = 0; i < 4; ++i) { if (i == rg4) { const float* gp = p.gfin + 256 * i + 16 * p16; float* op = p.out + (size_t)t * DM + 256 * i + 16 * p16;
#pragma unroll
                for (int k4 = 0; k4 < 4; ++k4) { const f32x4 g = *(const f32x4*)(gp + 4 * k4);
                    *(f32x4*)(op + 4 * k4) = (f32x4){acc2[i][2 * k4].x * rf * g[0], acc2[i][2 * k4].y * rf * g[1], acc2[i][2 * k4 + 1].x * rf * g[2], acc2[i][2 * k4 + 1].y * rf * g[3]}; } } }
#else
        unsigned xp[8][4];
#pragma unroll
        for (int i = 0; i < 8; ++i) { const u32x4 hw = *(const u32x4*)(HB + (size_t)t * DM + 128 * i + 8 * p16); const f32x4 ga = *(const f32x4*)(p.g2 + 128 * i + 8 * p16), gb = *(const f32x4*)(p.g2 + 128 * i + 8 * p16 + 4);
            xp[i][0] = pk2(bf_lo(hw.x) * rstd * ga[0], bf_hi(hw.x) * rstd * ga[1]); xp[i][1] = pk2(bf_lo(hw.y) * rstd * ga[2], bf_hi(hw.y) * rstd * ga[3]);
            xp[i][2] = pk2(bf_lo(hw.z) * rstd * gb[0], bf_hi(hw.z) * rstd * gb[1]); xp[i][3] = pk2(bf_lo(hw.w) * rstd * gb[2], bf_hi(hw.w) * rstd * gb[3]); }
        float act[2] = {0.f, 0.f};
#pragma unroll
        for (int sl = 0; sl < 2; ++sl) {
#pragma unroll 2
            for (int b16 = 0; b16 < 16; ++b16) {
                const int e = 64 * sl + 16 * rg4 + b16; const int ex = E_i[e];
                const unsigned char* rowp = UB + (size_t)ex * 2048 + 16 * p16;
                float s = 0.f;
#pragma unroll
                for (int i = 0; i < 8; ++i) { const u32x4 uw = *(const u32x4*)(rowp + 256 * i);
                    s = dot2_bf16(uw.x, xp[i][0], s); s = dot2_bf16(uw.y, xp[i][1], s); s = dot2_bf16(uw.z, xp[i][2], s); s = dot2_bf16(uw.w, xp[i][3], s); }
                s = row_sum_x(s);
                act[sl] = (p16 == b16) ? s : act[sl];
            }
        }
        float coef[2];
#pragma unroll
        for (int sl = 0; sl < 2; ++sl) coef[sl] = gsm[sl] * gelu_exact(act[sl]);
        float acc[8][8];
#pragma unroll
        for (int i = 0; i < 8; ++i)
#pragma unroll
            for (int k = 0; k < 8; ++k) acc[i][k] = 0.f;
#pragma unroll
        for (int sl = 0; sl < 2; ++sl) {
#pragma unroll 2
            for (int b16 = 0; b16 < 16; ++b16) {
                const int srcl = (lane & 48) + b16;
                const float cf = __shfl(coef[sl], srcl); const int ex = __shfl(eidx[sl], srcl);
                const unsigned char* rowp = VB + (size_t)ex * 2048 + 16 * p16;
#pragma unroll
                for (int i = 0; i < 8; ++i) { const u32x4 vw = *(const u32x4*)(rowp + 256 * i);
                    acc[i][0] += cf * bf_lo(vw.x); acc[i][1] += cf * bf_hi(vw.x); acc[i][2] += cf * bf_lo(vw.y); acc[i][3] += cf * bf_hi(vw.y);
                    acc[i][4] += cf * bf_lo(vw.z); acc[i][5] += cf * bf_hi(vw.z); acc[i][6] += cf * bf_lo(vw.w); acc[i][7] += cf * bf_hi(vw.w); }
            }
        }
        float ss = 0.f;
#pragma unroll
        for (int i = 0; i < 8; ++i) { const u32x4 hw = *(const u32x4*)(HB + (size_t)t * DM + 128 * i + 8 * p16); const unsigned hv[4] = {hw.x, hw.y, hw.z, hw.w};
#pragma unroll
            for (int k = 0; k < 8; ++k) { float a = acc[i][k]; a += __shfl_xor(a, 16); a += __shfl_xor(a, 32);
                a += (k & 1) ? bf_hi(hv[k >> 1]) : bf_lo(hv[k >> 1]); acc[i][k] = a; ss += a * a; } }
        ss = row_sum_x(ss);
        const float rf = 1.0f / sqrtf(ss * (1.0f / DM) + EPS);
#pragma unroll
        for (int i = 0; i < 8; ++i) { if ((i >> 1) == rg4) { const f32x4 ga = *(const f32x4*)(p.gfin + 128 * i + 8 * p16), gb = *(const f32x4*)(p.gfin + 128 * i + 8 * p16 + 4);
                float* op = p.out + (size_t)t * DM + 128 * i + 8 * p16;
                *(f32x4*)op = (f32x4){acc[i][0] * rf * ga[0], acc[i][1] * rf * ga[1], acc[i][2] * rf * ga[2], acc[i][3] * rf * ga[3]};
                *(f32x4*)(op + 4) = (f32x4){acc[i][4] * rf * gb[0], acc[i][5] * rf * gb[1], acc[i][6] * rf * gb[2], acc[i][7] * rf * gb[3]}; } }
#endif
        LDS_WAIT();
    }
}


__device__ __forceinline__ void row_max4(unsigned k0, unsigned k1, unsigned k2, unsigned k3, unsigned& w0, unsigned& w1, unsigned& w2, unsigned& w3) {
    asm volatile("s_nop 1\n\t"
                 "v_max_u32_dpp %0, %4, %4 quad_perm:[1,0,3,2] row_mask:0xf bank_mask:0xf\n\t"
                 "v_max_u32_dpp %1, %5, %5 quad_perm:[1,0,3,2] row_mask:0xf bank_mask:0xf\n\t"
                 "v_max_u32_dpp %2, %6, %6 quad_perm:[1,0,3,2] row_mask:0xf bank_mask:0xf\n\t"
                 "v_max_u32_dpp %3, %7, %7 quad_perm:[1,0,3,2] row_mask:0xf bank_mask:0xf\n\t"
                 "v_max_u32_dpp %0, %0, %0 quad_perm:[2,3,0,1] row_mask:0xf bank_mask:0xf\n\t"
                 "v_max_u32_dpp %1, %1, %1 quad_perm:[2,3,0,1] row_mask:0xf bank_mask:0xf\n\t"
                 "v_max_u32_dpp %2, %2, %2 quad_perm:[2,3,0,1] row_mask:0xf bank_mask:0xf\n\t"
                 "v_max_u32_dpp %3, %3, %3 quad_perm:[2,3,0,1] row_mask:0xf bank_mask:0xf\n\t"
                 "v_max_u32_dpp %0, %0, %0 row_ror:4 row_mask:0xf bank_mask:0xf\n\t"
                 "v_max_u32_dpp %1, %1, %1 row_ror:4 row_mask:0xf bank_mask:0xf\n\t"
                 "v_max_u32_dpp %2, %2, %2 row_ror:4 row_mask:0xf bank_mask:0xf\n\t"
                 "v_max_u32_dpp %3, %3, %3 row_ror:4 row_mask:0xf bank_mask:0xf\n\t"
                 "v_max_u32_dpp %0, %0, %0 row_ror:8 row_mask:0xf bank_mask:0xf\n\t"
                 "v_max_u32_dpp %1, %1, %1 row_ror:8 row_mask:0xf bank_mask:0xf\n\t"
                 "v_max_u32_dpp %2, %2, %2 row_ror:8 row_mask:0xf bank_mask:0xf\n\t"
                 "v_max_u32_dpp %3, %3, %3 row_ror:8 row_mask:0xf bank_mask:0xf\n\t"
                 "s_nop 1"
                 : "=&v"(w0), "=&v"(w1), "=&v"(w2), "=&v"(w3) : "v"(k0), "v"(k1), "v"(k2), "v"(k3));
}
__device__ __forceinline__ unsigned pkadd_h2(unsigned a, unsigned b) { const h2v x = __builtin_bit_cast(h2v, a), y = __builtin_bit_cast(h2v, b); const h2v s = x + y; return __builtin_bit_cast(unsigned, s); }
constexpr int NT6 = 8;
constexpr int W6_BYTES = 16640;
__device__ __forceinline__ float dpp_f(float v, int ctrl_dummy);
#define DPPF(v, ctrl) __builtin_bit_cast(float, __builtin_amdgcn_update_dpp(0, __builtin_bit_cast(int, (v)), (ctrl), 0xf, 0xf, false))

__device__ __forceinline__ void phase_peer2(const Params& p, LAS unsigned char* lds, int bid, int nb) {
    const int tid = threadIdx.x, lane = tid & 63, wave = __builtin_amdgcn_readfirstlane(tid >> 6);
    const int p16 = lane & 15, rg4 = lane >> 4, q8 = lane >> 3, p8 = lane & 7;
    const bool b0 = lane & 1, b1 = lane & 2, b2 = lane & 4, c0 = lane & 8, c1 = lane & 16, c2 = lane & 32;
    unsigned char* ws = p.ws;
    const _Float16* SC = (const _Float16*)(ws + WS_PROJ); const bf16_t* HB = (const bf16_t*)(ws + WS_XN); const float* SSQ = (const float*)(ws + WS_SSQ);
    const unsigned char* UB = (const unsigned char*)(ws + WS_UB); const unsigned char* VB = (const unsigned char*)(ws + WS_VB); unsigned char* XQ = ws + WS_XQ;
    LAS unsigned char* wl = lds + wave * W6_BYTES;
    LAS unsigned char* CQ = wl;
    LAS unsigned short* E16 = (LAS unsigned short*)(wl + 6144);
    LAS float* GC = (LAS float*)(wl + 8192);
    LAS float* ACT = (LAS float*)(wl + 12288);
    LAS float* RS = (LAS float*)(wl + 16384);
    int ci = 0, cj = 0; bool cvalid = lane < 50;
    { int l = lane;
      if (l < 16) { ci = 0; cj = l; } else if (l < 24) { ci = 1; cj = l - 16; } else if (l < 29) { ci = 2; cj = l - 24; } else if (l < 33) { ci = 3; cj = l - 29; }
      else if (l < 36) { ci = 4; cj = l - 33; } else if (l < 42) { ci = 5 + (l - 36) / 2; cj = (l - 36) & 1; } else { ci = 8 + (l - 42); cj = 0; } if (!cvalid) { ci = 0; cj = 0; } }
    const int gw = bid * 8 + wave, NGW = nb * 8;
#define TOK6(k) min(base + (k) * NGW, NTOK - 1)
    for (int base = gw; base < NTOK; base += NT6 * NGW) {
#pragma unroll 1
        for (int rep_r = 0; rep_r < PROBE_R; ++rep_r)
#pragma unroll 1
        for (int k = 0; k < NT6; k += 2) {
            u32x4 raw[2][4]; float rstd[2];
#pragma unroll
            for (int v = 0; v < 2; ++v) { const int t = TOK6(k + v);
#pragma unroll
                for (int q = 0; q < 4; ++q) raw[v][q] = *(const u32x4*)(SC + (size_t)t * 2048 + 512 * q + 8 * lane);
                float ssq = (lane < 16) ? SSQ[(size_t)t * 16 + lane] : 0.f; ssq = wave_sum(ssq);
                rstd[v] = 1.0f / sqrtf(ssq * (1.0f / DM) + EPS);
                { const u32x4 ha = *(const u32x4*)(HB + (size_t)t * DM + 16 * lane), hb = *(const u32x4*)(HB + (size_t)t * DM + 16 * lane + 8); const float sc = rstd[v] * 16.0f;
                  const unsigned hv[8] = {ha.x, ha.y, ha.z, ha.w, hb.x, hb.y, hb.z, hb.w}; unsigned xw[4];
#pragma unroll
                  for (int w = 0; w < 4; ++w) { int pk = __builtin_amdgcn_cvt_pk_fp8_f32(bf_lo(hv[2 * w]) * sc, bf_hi(hv[2 * w]) * sc, 0, false);
                      pk = __builtin_amdgcn_cvt_pk_fp8_f32(bf_lo(hv[2 * w + 1]) * sc, bf_hi(hv[2 * w + 1]) * sc, pk, true); xw[w] = (unsigned)pk; }
                  *(u32x4*)(XQ + (size_t)t * DM + 16 * lane) = (u32x4){xw[0], xw[1], xw[2], xw[3]}; } }
#pragma unroll
            for (int qq = 0; qq < 2; ++qq) {
                unsigned ka[4][8];
#pragma unroll
                for (int c = 0; c < 4; ++c) { const u32x4 rv = raw[c >> 1][2 * qq + (c & 1)]; const unsigned rw[4] = {rv.x, rv.y, rv.z, rv.w};
#pragma unroll
                    for (int e = 0; e < 8; ++e) { const unsigned hbits = (e & 1) ? (rw[e >> 1] >> 16) : (rw[e >> 1] & 0xffffu);
                        const float f = (float)__builtin_bit_cast(_Float16, (unsigned short)hbits);
                        ka[c][e] = (ord32(f) & ~0x7fu) | (unsigned)(127 - (8 * p16 + e)); } }
#define CE6(u, i, j) do { const unsigned _a = ka[u][i], _b = ka[u][j]; ka[u][i] = _a > _b ? _a : _b; ka[u][j] = _a > _b ? _b : _a; } while (0)
#pragma unroll
                for (int u = 0; u < 4; ++u) {
                    CE6(u, 0, 1); CE6(u, 2, 3); CE6(u, 4, 5); CE6(u, 6, 7);
                    CE6(u, 0, 2); CE6(u, 1, 3); CE6(u, 4, 6); CE6(u, 5, 7);
                    CE6(u, 1, 2); CE6(u, 5, 6);
                    CE6(u, 0, 4); CE6(u, 1, 5); CE6(u, 2, 6); CE6(u, 3, 7);
                    CE6(u, 2, 4); CE6(u, 3, 5);
                    CE6(u, 1, 2); CE6(u, 3, 4); CE6(u, 5, 6);
                }
#undef CE6
                unsigned mine[4] = {0u, 0u, 0u, 0u};
#pragma unroll 1
                for (int it = 0; it < 16; ++it) {
                    unsigned Wv[4]; row_max4(ka[0][0], ka[1][0], ka[2][0], ka[3][0], Wv[0], Wv[1], Wv[2], Wv[3]);
#pragma unroll
                    for (int c = 0; c < 4; ++c) {
                        const unsigned W = Wv[c];
                        mine[c] = (p16 == it) ? W : mine[c];
                        const bool win = (ka[c][0] == W);
#pragma unroll
                        for (int e = 0; e < 7; ++e) ka[c][e] = win ? ka[c][e + 1] : ka[c][e];
                        ka[c][7] = win ? 0u : ka[c][7];
                    }
                }
#pragma unroll
                for (int c = 0; c < 4; ++c) { const int g = 4 * (2 * qq + (c & 1)) + rg4; LAS float* A_s = (LAS float*)(wl + 3072 * (c >> 1)); LAS int* A_i = (LAS int*)(wl + 3072 * (c >> 1) + 1024);
                    A_s[g * 16 + p16] = unord32(mine[c] & ~0x7fu); A_i[g * 16 + p16] = 127 - (int)(mine[c] & 0x7fu); }
            }
            LDS_WAIT();
            {
                float av[4], bc[4]; int iav[4], ibc[4], jp[4], hh[4], bb[4]; unsigned key[4];
#pragma unroll
                for (int c = 0; c < 4; ++c) { const LAS float* A_s = (const LAS float*)(wl + 3072 * (c >> 1)); const LAS int* A_i = (const LAS int*)(wl + 3072 * (c >> 1) + 1024);
                    hh[c] = 4 * (c & 1) + rg4; bb[c] = (2 * hh[c] + 1) * 16; av[c] = A_s[(2 * hh[c]) * 16 + p16]; iav[c] = A_i[(2 * hh[c]) * 16 + p16] * 128; jp[c] = 0; bc[c] = A_s[bb[c]]; ibc[c] = A_i[bb[c]];
                    key[c] = (ord32(av[c] + bc[c]) & ~0xfu) | (unsigned)(15 - p16); }
#pragma unroll 1
                for (int it = 0; it < 16; ++it) {
                    unsigned Wv[4]; row_max4(key[0], key[1], key[2], key[3], Wv[0], Wv[1], Wv[2], Wv[3]);
#pragma unroll
                    for (int c = 0; c < 4; ++c) {
                        const LAS float* A_s = (const LAS float*)(wl + 3072 * (c >> 1)); const LAS int* A_i = (const LAS int*)(wl + 3072 * (c >> 1) + 1024);
                        LAS int* E_i = (LAS int*)(wl + 3072 * (c >> 1) + 2048); LAS float* E_s = (LAS float*)(wl + 3072 * (c >> 1) + 2560);
                        const bool win = (key[c] == Wv[c]);
                        if (win) { E_i[hh[c] * 16 + it] = iav[c] + ibc[c]; E_s[hh[c] * 16 + it] = av[c] + bc[c]; }
                        jp[c] += win ? 1 : 0;
                        const int jr = jp[c] < 16 ? jp[c] : 15;
                        bc[c] = A_s[bb[c] + jr]; ibc[c] = A_i[bb[c] + jr];
                        key[c] = jp[c] < 16 ? ((ord32(av[c] + bc[c]) & ~0xfu) | (unsigned)(15 - p16)) : 0u;
                    }
                }
            }
            LDS_WAIT();
#pragma unroll
            for (int v = 0; v < 2; ++v) { const LAS int* E_i = (const LAS int*)(wl + 3072 * v + 2048); const LAS float* E_s = (const LAS float*)(wl + 3072 * v + 2560);
#pragma unroll
                for (int sl = 0; sl < 2; ++sl) { const int e = lane + 64 * sl; const float s = E_s[e] * rstd[v], mx = E_s[e & ~15] * rstd[v]; const float pe = __expf(s - mx); const float den = row_sum_x(pe);
                    const int pos = 16 * (e & 7) + (e >> 3);
                    GC[(k + v) * 128 + pos] = pe / den; E16[(k + v) * 128 + pos] = (unsigned short)E_i[e]; }
                if (lane == 0) RS[k + v] = rstd[v]; }
            LDS_WAIT();
        }
#define P6_LOADH(buf, TAB, jj, kk, hh) do { const u32x4 _iv = *(const LAS u32x4*)(E16 + (kk) * 128 + 16 * q8 + 8 * (hh)); const unsigned _iw[4] = {_iv.x, _iv.y, _iv.z, _iv.w}; \
            _Pragma("unroll") for (int c = 0; c < 8; ++c) { const unsigned _idx = (c & 1) ? (_iw[c >> 1] >> 16) : (_iw[c >> 1] & 0xffffu); \
                buf[c] = *(const u32x4*)((TAB) + (((size_t)(jj) * NEXP + _idx) << 7) + 16 * p8); } } while (0)
#define P6_LOADX(hb, jj, kk) do { const bf16_t* _hp = HB + (size_t)TOK6(kk) * DM + 128 * (jj) + 16 * p8; hb[0] = *(const u32x4*)_hp; hb[1] = *(const u32x4*)(_hp + 8); } while (0)
        asm volatile("s_waitcnt vmcnt(0)" ::: "memory");
#pragma unroll 1
        for (int rep_u = 0; rep_u < PROBE_U; ++rep_u) {
            for (int k = 0; k < NT6; ++k) { ACT[k * 128 + lane] = 0.f; ACT[k * 128 + 64 + lane] = 0.f; }
            LDS_WAIT();
            const int n16 = lane & 15, g4 = lane >> 4, c4 = lane & 3, r16 = 4 * g4 + (n16 >> 2);
            const int eoff = 2 * (16 * (r16 & 7) + (r16 >> 3));
            const bool xkeep = (g4 == (n16 >> 2));
            u32x4 bfP[16], bfQ[16], xP[2], xQ2[2];
#define P6_ULOAD(buf, xb, nn) do { const int _j = (nn) / NT6, _k = (nn) % NT6; const LAS unsigned char* _ip = (const LAS unsigned char*)(E16 + _k * 128) + eoff; \
                { const unsigned char* _xp = XQ + (size_t)TOK6(_k) * DM + 128 * _j + 16 * c4; xb[0] = *(const u32x4*)_xp; xb[1] = *(const u32x4*)(_xp + 64); } \
                asm volatile("" ::: "memory"); \
                _Pragma("unroll") for (int T = 0; T < 8; ++T) { const unsigned _idx = *(const LAS unsigned short*)(_ip + 4 * T); \
                    const unsigned char* _rp = UB + (((size_t)_j * NEXP + _idx) << 7) + 16 * c4; buf[2 * T] = *(const u32x4*)_rp; buf[2 * T + 1] = *(const u32x4*)(_rp + 64); } } while (0)
#define P6_PK64(lo, hi) ((long)(((unsigned long long)(hi) << 32) | (unsigned long long)(lo)))
#define P6_UMMA(buf, xb, nn) do { const int k = (nn) % NT6; \
                const unsigned x0 = xkeep ? xb[0].x : 0u, x1 = xkeep ? xb[0].y : 0u, x2 = xkeep ? xb[0].z : 0u, x3 = xkeep ? xb[0].w : 0u, \
                               x4 = xkeep ? xb[1].x : 0u, x5 = xkeep ? xb[1].y : 0u, x6 = xkeep ? xb[1].z : 0u, x7 = xkeep ? xb[1].w : 0u; \
                const long xa[4] = {P6_PK64(x0, x1), P6_PK64(x2, x3), P6_PK64(x4, x5), P6_PK64(x6, x7)}; \
                float dsel[2] = {0.f, 0.f}; \
                _Pragma("unroll") for (int T = 0; T < 8; ++T) { f32x4 d = (f32x4){0.f, 0.f, 0.f, 0.f}; \
                    const long bb[4] = {P6_PK64(buf[2 * T].x, buf[2 * T].y), P6_PK64(buf[2 * T].z, buf[2 * T].w), P6_PK64(buf[2 * T + 1].x, buf[2 * T + 1].y), P6_PK64(buf[2 * T + 1].z, buf[2 * T + 1].w)}; \
                    _Pragma("unroll") for (int s = 0; s < 4; ++s) d = __builtin_amdgcn_mfma_f32_16x16x32_fp8_fp8(xa[s], bb[s], d, 0, 0, 0); \
                    float pv = (c4 == 0) ? d[0] : ((c4 == 1) ? d[1] : ((c4 == 2) ? d[2] : d[3])); \
                    pv += DPPF(pv, 0xB1); pv += DPPF(pv, 0x4E);                         \
                    dsel[T >> 2] = ((T & 3) == c4) ? pv : dsel[T >> 2]; } \
                  \
                ACT[k * 128 + 16 * c4 + r16] += dsel[0]; ACT[k * 128 + 16 * (c4 + 4) + r16] += dsel[1]; } while (0)
            P6_ULOAD(bfP, xP, 0);
#pragma unroll 1
            for (int n = 0; n < 8 * NT6; n += 2) {
                P6_ULOAD(bfQ, xQ2, n + 1); asm volatile("" ::: "memory"); __builtin_amdgcn_sched_barrier(0);
                P6_UMMA(bfP, xP, n); __builtin_amdgcn_sched_barrier(0);
                if (n + 2 < 8 * NT6) P6_ULOAD(bfP, xP, n + 2);
                asm volatile("" ::: "memory"); __builtin_amdgcn_sched_barrier(0);
                P6_UMMA(bfQ, xQ2, n + 1); __builtin_amdgcn_sched_barrier(0);
            }
#undef P6_ULOAD
#undef P6_UMMA
#undef P6_PK64
        }
        LDS_WAIT();
#pragma unroll 1
        for (int k = 0; k < NT6; ++k) {
#pragma unroll
            for (int sl = 0; sl < 2; ++sl) { const int e = lane + 64 * sl, pos = 16 * (e & 7) + (e >> 3); const float a = ACT[k * 128 + e] * (1.0f / 8192.0f);
                const float cfv = GC[k * 128 + pos] * gelu_exact(a);
                CQ[k * 128 + pos] = (unsigned char)(__builtin_amdgcn_cvt_pk_fp8_f32(cfv * 32.0f, 0.f, 0, false) & 0xff); } }
        LDS_WAIT();
#pragma unroll 1
        for (int k = 0; k < NT6; ++k) ACT[k * 64 + lane] = 0.f;
        LDS_WAIT();
#pragma unroll 1
        for (int rep_v = 0; rep_v < PROBE_V; ++rep_v) {
            for (int k = 0; k < NT6; ++k) ACT[k * 64 + lane] = 0.f;
            LDS_WAIT();
            u32x4 bfP[16], bfQ[16];
#define P6_LOADI(buf, TAB, nn) do { const int _j = (nn) / NT6, _k = (nn) % NT6; P6_LOADH(buf, TAB, _j, _k, 0); P6_LOADH((buf + 8), TAB, _j, _k, 1); } while (0)
            const int n16 = lane & 15, g4 = lane >> 4;
            const int ash = 8 * (n16 & 3); const bool ahi = (n16 & 4) != 0;
            const int c0 = 16 * (n16 & 7) + 4 * (g4 & 1);
            const bool fin = (n16 < 8) && (g4 < 2);
#define P6_LOADR2(hb, nn) do { const bf16_t* _hp = HB + (size_t)TOK6((nn) % NT6) * DM + 128 * ((nn) / NT6) + c0; hb[0] = *(const u32x2*)_hp; hb[1] = *(const u32x2*)(_hp + 8); } while (0)
#define P6_VBODY(buf, nn, hb) do { const int j = (nn) / NT6, k = (nn) % NT6; const int t = TOK6(k); \
                const u32x4 cqv = *(const LAS u32x4*)(CQ + k * 128 + 16 * q8); const unsigned cqw[4] = {cqv.x, cqv.y, cqv.z, cqv.w}; \
                f32x4 d0 = (f32x4){0.f, 0.f, 0.f, 0.f}, d1 = (f32x4){0.f, 0.f, 0.f, 0.f}; \
                _Pragma("unroll") for (int c = 0; c < 16; ++c) { const unsigned cb = (cqw[c >> 2] >> (8 * (c & 3))) & 0xffu; const unsigned tt = cb << ash; \
                    const long av = P6_PK64(ahi ? 0u : tt, ahi ? tt : 0u); \
                    d0 = __builtin_amdgcn_mfma_f32_16x16x32_fp8_fp8(av, P6_PK64(buf[c].x, buf[c].y), d0, 0, 0, 0); \
                    d1 = __builtin_amdgcn_mfma_f32_16x16x32_fp8_fp8(av, P6_PK64(buf[c].z, buf[c].w), d1, 0, 0, 0); } \
                float o[8]; \
                _Pragma("unroll") for (int r = 0; r < 4; ++r) { o[r] = d0[r] + __shfl_xor(d0[r], 40); o[4 + r] = d1[r] + __shfl_xor(d1[r], 40); } \
                const unsigned hw[4] = {hb[0].x, hb[0].y, hb[1].x, hb[1].y}; float ss = 0.f; \
                _Pragma("unroll") for (int r = 0; r < 8; ++r) { const float hv = (r & 1) ? bf_hi(hw[r >> 1]) : bf_lo(hw[r >> 1]); o[r] = o[r] * (1.0f / 1024.0f) + hv; ss += o[r] * o[r]; } \
                if (fin) { float* op = p.out + (size_t)t * DM + 128 * j + c0; *(f32x4*)op = (f32x4){o[0], o[1], o[2], o[3]}; *(f32x4*)(op + 8) = (f32x4){o[4], o[5], o[6], o[7]}; \
                    ACT[k * 64 + lane] += ss; } \
                } while (0)
#define P6_PK64(lo, hi) ((long)(((unsigned long long)(hi) << 32) | (unsigned long long)(lo)))
            P6_LOADI(bfP, VB, 0);
#pragma unroll 1
            for (int n = 0; n < 8 * NT6; n += 2) {
                u32x2 hr0[2], hr1[2]; P6_LOADR2(hr0, n); P6_LOADR2(hr1, n + 1);
                asm volatile("" ::: "memory");
                P6_LOADI(bfQ, VB, n + 1); asm volatile("" ::: "memory"); __builtin_amdgcn_sched_barrier(0);
                P6_VBODY(bfP, n, hr0); __builtin_amdgcn_sched_barrier(0);
                if (n + 2 < 8 * NT6) P6_LOADI(bfP, VB, n + 2);
                asm volatile("" ::: "memory"); __builtin_amdgcn_sched_barrier(0);
                P6_VBODY(bfQ, n + 1, hr1); __builtin_amdgcn_sched_barrier(0);
            }
            LDS_WAIT(); asm volatile("s_waitcnt vmcnt(0)" ::: "memory");
            f32x4 gfv[4];
#pragma unroll
            for (int i = 0; i < 4; ++i) gfv[i] = *(const f32x4*)(p.gfin + 256 * i + 4 * lane);
#pragma unroll 1
            for (int k = 0; k < NT6; ++k) { const float sst = wave_sum(ACT[k * 64 + lane]); const float rf = __builtin_amdgcn_rsqf(sst * (1.0f / DM) + EPS);
                float* op = p.out + (size_t)TOK6(k) * DM + 4 * lane; f32x4 ov[4];
#pragma unroll
                for (int i = 0; i < 4; ++i) ov[i] = *(const f32x4*)(op + 256 * i);
#pragma unroll
                for (int i = 0; i < 4; ++i) *(f32x4*)(op + 256 * i) = ov[i] * rf * gfv[i]; }
        }
        LDS_WAIT();
    }
#undef P6_LOADH
#undef P6_LOADX
#undef P6_LOADI
#undef P6_VBODY
#undef P6_LOADR2
#undef P6_PK64
#undef TOK6
}

#define XB_TMO      128
#define XB_XCNT(j)  (256  + 64 * (j))
#define XB_XSUB(j)  (1280 + 64 * (j))
#define XB_XGEN(j)  (2304 + 64 * (j))
#define XB_TOP      3328
#define XB_TOPGEN   3392
#define XCD_BAR_WORDS 3456
#define XB_SPIN_CAP (1u << 18)

__device__ __forceinline__ unsigned xb_ld(unsigned* p)              { return __hip_atomic_load(p, __ATOMIC_RELAXED, __HIP_MEMORY_SCOPE_AGENT); }
__device__ __forceinline__ unsigned xb_add(unsigned* p, unsigned v) { return __hip_atomic_fetch_add(p, v, __ATOMIC_RELAXED, __HIP_MEMORY_SCOPE_AGENT); }
__device__ __forceinline__ unsigned xb_xcc_id() { return (unsigned)__builtin_amdgcn_s_getreg((3 << 11) | 20) & 0xFu; }
#define XB_SPIN(cond, bar) do { unsigned _sp = 0; while (cond) { __builtin_amdgcn_s_sleep(1); \
    if ((++_sp & 255u) == 0u) { if (xb_ld(&(bar)[XB_TMO])) break; if (_sp > XB_SPIN_CAP) { atomicAdd(&(bar)[XB_TMO], 1u); break; } } } } while (0)

struct XcdBarrier {
    unsigned* bar; unsigned x;
    volatile LAS unsigned* st;
};

__device__ __forceinline__ XcdBarrier xcd_barrier_post(unsigned* bar, volatile LAS unsigned* st) {
    XcdBarrier b; b.bar = bar; b.x = xb_xcc_id(); b.st = st;
    if (threadIdx.x == 0) (void)xb_add(&bar[XB_XCNT(b.x)], 1u);
    return b;
}
__device__ __forceinline__ void xcd_barrier_complete(unsigned* bar, unsigned x, unsigned& nloc, unsigned& nx) {
    const unsigned G = gridDim.x * gridDim.y * gridDim.z;
    unsigned sum, cnt, mine, sp = 0u;
    for (;;) {
        sum = 0u; cnt = 0u; mine = 0u;
#pragma unroll
        for (unsigned j = 0; j < 16; ++j) { const unsigned c = xb_ld(&bar[XB_XCNT(j)]); sum += c; cnt += (c > 0u) ? 1u : 0u; mine = (j == x) ? c : mine; }
        if (sum == G) break;
        __builtin_amdgcn_s_sleep(1);
        if ((++sp & 255u) == 0u) { if (xb_ld(&bar[XB_TMO])) break; if (sp > XB_SPIN_CAP) { atomicAdd(&bar[XB_TMO], 1u); break; } }
    }
    nloc = mine > 0u ? mine : 1u; nx = cnt > 0u ? cnt : 1u;
}

__device__ __forceinline__ void xcd_barrier(const XcdBarrier& b) {
    asm volatile("s_waitcnt vmcnt(0)" ::: "memory");
    __syncthreads();
    if (threadIdx.x == 0) {
        unsigned* bar = b.bar;
        __builtin_amdgcn_s_waitcnt(0);
        unsigned nloc = b.st[0], nx = b.st[1];
        if (nloc == 0u) { xcd_barrier_complete(bar, b.x, nloc, nx); b.st[0] = nloc; b.st[1] = nx; }
        const unsigned old = xb_add(&bar[XB_XSUB(b.x)], 1u);
        const unsigned gen = old / nloc;
        if (old + 1u == (gen + 1u) * nloc) {
            __builtin_amdgcn_fence(__ATOMIC_RELEASE, "agent");
            asm volatile("s_waitcnt vmcnt(0)" ::: "memory");
            const unsigned og = xb_add(&bar[XB_TOP], 1u);
            const unsigned tg = og / nx;
            if (og + 1u == (tg + 1u) * nx) xb_add(&bar[XB_TOPGEN], 1u);
            else XB_SPIN(xb_ld(&bar[XB_TOPGEN]) == tg, bar);
            __builtin_amdgcn_fence(__ATOMIC_ACQUIRE, "agent");
            xb_add(&bar[XB_XGEN(b.x)], 1u);
            asm volatile("s_waitcnt vmcnt(0)" ::: "memory");
        } else {
            XB_SPIN(xb_ld(&bar[XB_XGEN(b.x)]) == gen, bar);
            __builtin_amdgcn_fence(__ATOMIC_ACQUIRE, "agent");
            asm volatile("s_waitcnt vmcnt(0)" ::: "memory");
        }
    }
    __syncthreads();
}

__global__ void __launch_bounds__(512, 2) mk_fwd(Params p) {
    extern __shared__ __attribute__((aligned(16))) unsigned char lds_raw[];
    LAS unsigned char* lds = (LAS unsigned char*)lds_raw;
    const int bid = blockIdx.x, nb = gridDim.x;
    unsigned char* ws = p.ws;
#define IN(k) (p.ph_lo <= (k) && (k) < p.ph_hi)
#define SEAM(k) do { if (IN(k) && IN((k) + 1)) { xcd_barrier(bar); } } while (0)
    if (threadIdx.x < 4) ((volatile LAS unsigned*)(lds + LDS_BYTES - 16))[threadIdx.x] = 0u;
    __syncthreads();
    const XcdBarrier bar = xcd_barrier_post((unsigned*)(ws + WS_CTL) + 4096, (volatile LAS unsigned*)(lds + LDS_BYTES - 16));
    if (IN(0)) phase0(p, lds, bid, nb);
    SEAM(0);
    if (IN(1)) {
        pg8::Gemm g{(const bf16_t*)(ws + WS_XN), (const bf16_t*)(ws + WS_WIN), MROWS, NP1, DM}; pg8::StaticOrder S; S.init(MROWS, NP1, nb, bid);
        EpiProj E{(bf16_t*)(ws + WS_PROJ), (float*)(ws + WS_LA), p.gb, (const float2*)(ws + WS_ROPE)};
        pg8::gemm_phase<EpiProj, pg8::StaticOrder, true, true>(lds, g, S, E);
    }
    SEAM(1);
    if (IN(2)) attn_pass<false>(p, lds, bid, nb);
    SEAM(2);
    if (IN(3)) attn_pass<true>(p, lds, bid, nb);
    SEAM(3);
    if (IN(4)) {
        pg8::Gemm g{(const bf16_t*)(ws + WS_O), (const bf16_t*)(ws + WS_WOUT), NTOK, DM, DM}; pg8::StaticOrder S; S.init(NTOK, DM, nb, bid);
        EpiRes E{p.x, (bf16_t*)(ws + WS_XN), (float*)(ws + WS_SSQ)};
        pg8::gemm_phase<EpiRes, pg8::StaticOrder, true, true>(lds, g, S, E);
    }
    SEAM(4);
    if (IN(5)) {
        pg8::Gemm g{(const bf16_t*)(ws + WS_XN), (const bf16_t*)(ws + WS_WS), NTOK, 2048, DM}; pg8::StaticOrder S; S.init(NTOK, 2048, nb, bid);
        EpiF16 E{(_Float16*)(ws + WS_PROJ)};
        pg8::gemm_phase<EpiF16, pg8::StaticOrder, true, true>(lds, g, S, E);
    }
    SEAM(5);
    if (IN(6)) phase_peer2(p, lds, bid, nb);
#undef IN
#undef SEAM
}

#ifndef MK_FUSED
#define MK_FUSED 1
#endif
extern "C" void kernel_launch(void* const* d_in, const int* in_sizes, int n_in, void* d_out, int out_size, void* d_ws, size_t ws_size, hipStream_t stream) {
    static int grid = 0;
    if (grid == 0) {
        if (n_in != 16 || in_sizes[0] != NTOK * DM || out_size != NTOK * DM || ws_size < WS_END) {
            fprintf(stderr, "kernel_launch: unexpected shapes (n_in %d, in0 %d, out %d, ws %zu); nothing launched\n", n_in, n_in > 0 ? in_sizes[0] : -1, out_size, ws_size); grid = -1; return; }
        int dev = 0, cus = 0, per_cu = 0;
        hipGetDevice(&dev); hipDeviceGetAttribute(&cus, hipDeviceAttributeMultiprocessorCount, dev);
        if (hipFuncSetAttribute((const void*)mk_fwd, hipFuncAttributeMaxDynamicSharedMemorySize, LDS_BYTES) != hipSuccess) { fprintf(stderr, "kernel_launch: hipFuncSetAttribute failed\n"); grid = -1; return; }
        if (hipOccupancyMaxActiveBlocksPerMultiprocessor(&per_cu, (const void*)mk_fwd, 512, LDS_BYTES) != hipSuccess || per_cu < 1) { fprintf(stderr, "kernel_launch: occupancy query failed (%d)\n", per_cu); (void)hipGetLastError(); per_cu = 1; }
        grid = cus * (per_cu < 1 ? 1 : 1);
        fprintf(stderr, "kernel_launch: %d CUs, occupancy %d/CU, grid %d\n", cus, per_cu, grid);
    }
    if (grid < 0) return;
    (void)hipMemsetAsync((char*)d_ws + WS_CTL, 0, 65536, stream);
    Params p{};
    p.x = (const float*)d_in[0]; p.meta = (const float*)d_in[1]; p.g1 = (const float*)d_in[2]; p.w_in = (const float*)d_in[3]; p.gw2 = (const float*)d_in[4]; p.gb = (const float*)d_in[5];
    p.gla_gain = (const float*)d_in[6]; p.ret_gain = (const float*)d_in[7]; p.ret_bias = (const float*)d_in[8]; p.w_out = (const float*)d_in[9]; p.g2 = (const float*)d_in[10];
    p.w_q = (const float*)d_in[11]; p.subkeys = (const float*)d_in[12]; p.pu = (const float*)d_in[13]; p.pv = (const float*)d_in[14]; p.gfin = (const float*)d_in[15];
    p.out = (float*)d_out; p.ws = (unsigned char*)d_ws;
#if MK_FUSED
    p.ph_lo = 0; p.ph_hi = NPHASE;
    void* args[] = {&p};
    hipError_t e = hipLaunchCooperativeKernel((const void*)mk_fwd, dim3(grid), dim3(512), args, LDS_BYTES, stream);
    if (e != hipSuccess) fprintf(stderr, "kernel_launch: cooperative launch failed: %s (grid %d)\n", hipGetErrorString(e), grid);
#else
    { const int order[7] = {0, 1, 2, 3, 4, 5, 6}; for (int i = 0; i < 7; ++i) { p.ph_lo = order[i]; p.ph_hi = order[i] + 1; hipLaunchKernelGGL(mk_fwd, dim3(grid), dim3(512), LDS_BYTES, stream, p); } }
#endif
}
```

```cpp
#include <hip/hip_runtime.h>
#include <hip/hip_cooperative_groups.h>
#include <cstdio>
#include <cstdint>
namespace cg = cooperative_groups;
namespace pg8 {
#define PG8_LAS __attribute__((address_space(3)))
typedef unsigned short bf16_t;
typedef short bf16x8 __attribute__((ext_vector_type(8)));
typedef float f32x4 __attribute__((ext_vector_type(4)));
typedef unsigned u32x4 __attribute__((ext_vector_type(4)));
constexpr int BM = 256, BK = 64, HALF = 128, HTB = HALF * BK * 2  , STAGE_BYTES = 8 * HTB, NXCD = 8, WGM = 8;

__host__ __device__ __forceinline__ int lds_byte(int r, int c) { const int st = (r >> 4) * 2 + (c >> 5), rr = r & 15, cc = c & 31, ob = rr * 64 + cc * 2; return st * 1024 + (ob ^ (((ob >> 9) & 1) << 5)); }
__host__ __device__ __forceinline__ void stage_rc(int b, int& R, int& C) { const int st = b / 1024, sb = b % 1024, swz = sb ^ (((sb >> 9) & 1) << 5); R = (st >> 1) * 16 + swz / 64; C = (st & 1) * 32 + (swz % 64) / 2; }
__host__ __device__ __forceinline__ int perm32(int rho) { const int n = rho >> 4, i = rho & 15; return 8 * (i >> 2) + 4 * n + (i & 3); }

struct Unit { int pm, pn; };
struct Gemm { const bf16_t* A; const bf16_t* Bt; int M, N, K; };

struct StaticOrder {
    int nM, nN, nwg, G, c;
    __host__ __device__ void init(int M, int N, int G_, int c_) { nM = M / BM; nN = N / BM; nwg = nM * nN; G = G_; c = c_; }
    __host__ __device__ bool next(int i, Unit& u) const {
        const long L = (long)i * G + c; if (L >= nwg) return false;
        int wgid = (int)L; { const int q = nwg / NXCD, r = nwg % NXCD, xcd = wgid % NXCD, off = wgid / NXCD; wgid = (xcd < r ? xcd * (q + 1) : r * (q + 1) + (xcd - r) * q) + off; }
        const int nig = WGM * nN, gid = wgid / nig, fm = gid * WGM, gsz = (nM - fm) < WGM ? (nM - fm) : WGM;
        u.pm = fm + ((wgid % nig) % gsz); u.pn = (wgid % nig) / gsz; return true;
    }
    __device__ __forceinline__ void a_ready(const Unit&) const {}
    __device__ __forceinline__ void done(const Unit&) const {}
};

__device__ __forceinline__ unsigned cvt_pk_bf16(float lo, float hi) { unsigned r; asm volatile("v_cvt_pk_bf16_f32 %0, %1, %2" : "=v"(r) : "v"(lo), "v"(hi)); return r; }
typedef float f32x2 __attribute__((ext_vector_type(2)));
template <class Epi, class Sched, bool ALIGN_EPI = false, bool SP2 = false>
__device__ __forceinline__ void gemm_phase(PG8_LAS unsigned char* lds, const Gemm g, const Sched& S, const Epi& E) {
    const int tid = threadIdx.x, wid = __builtin_amdgcn_readfirstlane(tid >> 6), lane = tid & 63, wr = wid >> 2, wc = wid & 3, fr = lane & 15, fq = lane >> 4;
    const int K = g.K, nt = K / BK;
    unsigned voffA[2], voffB[2];
#pragma unroll
    for (int i = 0; i < 2; ++i) { int R, C; stage_rc(tid * 16 + i * 8192, R, C); const int Rb = Epi::PERM ? ((R & ~31) + perm32(R & 31)) : R;
        voffA[i] = (unsigned)(R * K + C) * 2u; voffB[i] = (unsigned)(Rb * K + C) * 2u; }
    const size_t kstep = (size_t)(BK * 2);
    const size_t hstep = (size_t)HALF * K * 2;
    const size_t tstep = 2 * hstep;
    const unsigned ldsw = (unsigned)wid * 1024u;
    const int aoff = lds_byte(wr * 64 + fr, fq * 8), boff = lds_byte(wc * 32 + fr, fq * 8);
#define PG8_SA(b, h) (((b) * 2 + (h)) * HTB)
#define PG8_SB(b, h) ((4 + (b) * 2 + (h)) * HTB)
#define PG8_STAGE(bufoff, gbase, voff) do { _Pragma("unroll") for (int _i = 0; _i < 2; ++_i) \
        __builtin_amdgcn_global_load_lds((const unsigned*)((const char*)(gbase) + (voff)[_i]), (PG8_LAS unsigned*)(lds + (bufoff) + ldsw + _i * 8192), 16, 0, 0); } while (0)
#define PG8_LDA(dst, b, h) do { _Pragma("unroll") for (int m = 0; m < 4; ++m) _Pragma("unroll") for (int k = 0; k < 2; ++k) dst[m][k] = *(const PG8_LAS bf16x8*)(lds + PG8_SA(b, h) + aoff + m * 2048 + k * 1024); } while (0)
#define PG8_LDB(dst, b, h) do { _Pragma("unroll") for (int n = 0; n < 2; ++n) _Pragma("unroll") for (int k = 0; k < 2; ++k) dst[n][k] = *(const PG8_LAS bf16x8*)(lds + PG8_SB(b, h) + boff + n * 2048 + k * 1024); } while (0)
#define PG8_MMA(ai, bj, At, Bt) do { __builtin_amdgcn_s_setprio(1); _Pragma("unroll") for (int m = 0; m < 4; ++m) _Pragma("unroll") for (int n = 0; n < 2; ++n) _Pragma("unroll") for (int k = 0; k < 2; ++k) \
        acc[ai][bj][m][n] = __builtin_amdgcn_mfma_f32_16x16x32_bf16(Bt[n][k], At[m][k], acc[ai][bj][m][n], 0, 0, 0); __builtin_amdgcn_s_setprio(0); } while (0)
#define PG8_WAIT_V(n) asm volatile("s_waitcnt vmcnt(" #n ")" ::: "memory")
#define PG8_WAIT_L(n) asm volatile("s_waitcnt lgkmcnt(" #n ")" ::: "memory")
#define PG8_BAR __builtin_amdgcn_s_barrier()
#define PG8_SCHED __builtin_amdgcn_sched_barrier(0)
    Unit cur, nxt; int ui = 0;
    if (!S.next(0, cur)) return;
    f32x4 acc[2][2][4][2];
#pragma unroll
    for (int a = 0; a < 2; ++a)
#pragma unroll
        for (int b = 0; b < 2; ++b)
#pragma unroll
            for (int m = 0; m < 4; ++m)
#pragma unroll
                for (int n = 0; n < 2; ++n) acc[a][b][m][n] = (f32x4){0.f, 0.f, 0.f, 0.f};
    bf16x8 At[4][2], B0[2][2], B1[2][2];
    const char* cA = (const char*)g.A + (size_t)cur.pm * tstep; const char* cB = (const char*)g.Bt + (size_t)cur.pn * tstep;
    S.a_ready(cur);
    if constexpr (SP2) {
        PG8_STAGE(PG8_SB(0, 0), cB, voffB); PG8_STAGE(PG8_SB(0, 1), cB + hstep, voffB); PG8_STAGE(PG8_SA(0, 0), cA, voffA); PG8_STAGE(PG8_SA(0, 1), cA + hstep, voffA);
        if (wr == 1) PG8_BAR;
        PG8_WAIT_V(2); PG8_BAR;
        PG8_STAGE(PG8_SB(1, 0), cB + kstep, voffB); PG8_STAGE(PG8_SA(1, 0), cA + kstep, voffA); PG8_STAGE(PG8_SB(1, 1), cB + hstep + kstep, voffB);
        PG8_WAIT_V(6); PG8_BAR;
    } else {
        PG8_STAGE(PG8_SB(0, 0), cB, voffB); PG8_STAGE(PG8_SA(0, 0), cA, voffA); PG8_STAGE(PG8_SB(0, 1), cB + hstep, voffB); PG8_STAGE(PG8_SA(0, 1), cA + hstep, voffA);
        if (wr == 1) PG8_BAR;
        PG8_WAIT_V(4); PG8_BAR;
        PG8_STAGE(PG8_SB(1, 0), cB + kstep, voffB); PG8_STAGE(PG8_SA(1, 0), cA + kstep, voffA); PG8_STAGE(PG8_SB(1, 1), cB + hstep + kstep, voffB);
        PG8_WAIT_V(6); PG8_BAR;
    }
    for (;;) {
        const bool has_next = S.next(ui + 1, nxt);
        const char* nA = has_next ? (const char*)g.A + (size_t)nxt.pm * tstep : cA; const char* nB = has_next ? (const char*)g.Bt + (size_t)nxt.pn * tstep : cB;
        for (int t = 0; t < nt; t += 2) {
            const bool last = (t == nt - 2);
            const char* a1 = cA + (size_t)(t + 1) * kstep;
            const char* a2 = last ? nA : cA + (size_t)(t + 2) * kstep; const char* b2 = last ? nB : cB + (size_t)(t + 2) * kstep;
            const char* a3 = a2 + kstep; const char* b3 = b2 + kstep;
            if (last && has_next) S.a_ready(nxt);
            if constexpr (SP2) {
            PG8_LDB(B0, 0, 0); PG8_LDB(B1, 0, 1); PG8_SCHED; PG8_LDA(At, 0, 0); PG8_STAGE(PG8_SA(1, 1), a1 + hstep, voffA);
            PG8_WAIT_V(8); PG8_WAIT_L(0); PG8_BAR; PG8_MMA(0, 0, At, B0); PG8_MMA(0, 1, At, B1); PG8_BAR; PG8_SCHED;
            PG8_LDA(At, 0, 1); PG8_STAGE(PG8_SB(0, 0), b2, voffB); PG8_STAGE(PG8_SB(0, 1), b2 + hstep, voffB); PG8_STAGE(PG8_SA(0, 0), a2, voffA);
            PG8_WAIT_V(8); PG8_WAIT_L(0); PG8_BAR; PG8_MMA(1, 0, At, B0); PG8_MMA(1, 1, At, B1); PG8_BAR; PG8_SCHED;
            PG8_LDB(B0, 1, 0); PG8_LDB(B1, 1, 1); PG8_SCHED; PG8_LDA(At, 1, 0); PG8_STAGE(PG8_SA(0, 1), a2 + hstep, voffA);
            PG8_WAIT_V(8); PG8_WAIT_L(0); PG8_BAR; PG8_MMA(0, 0, At, B0); PG8_MMA(0, 1, At, B1); PG8_BAR; PG8_SCHED;
            PG8_LDA(At, 1, 1); PG8_STAGE(PG8_SB(1, 0), b3, voffB); PG8_STAGE(PG8_SB(1, 1), b3 + hstep, voffB); PG8_STAGE(PG8_SA(1, 0), a3, voffA);
            PG8_WAIT_V(8); PG8_WAIT_L(0); PG8_BAR; PG8_MMA(1, 0, At, B0); PG8_MMA(1, 1, At, B1); PG8_BAR; PG8_SCHED;
            } else {
            PG8_LDB(B0, 0, 0); PG8_SCHED; PG8_LDA(At, 0, 0); PG8_STAGE(PG8_SA(1, 1), a1 + hstep, voffA);
            PG8_WAIT_L(8); PG8_BAR; PG8_WAIT_L(0); PG8_MMA(0, 0, At, B0); PG8_BAR; PG8_SCHED;
            PG8_LDB(B1, 0, 1); PG8_STAGE(PG8_SB(0, 0), b2, voffB);
            PG8_BAR; PG8_WAIT_L(0); PG8_MMA(0, 1, At, B1); PG8_BAR;
            PG8_LDA(At, 0, 1); PG8_STAGE(PG8_SA(0, 0), a2, voffA);
            PG8_BAR; PG8_WAIT_L(0); PG8_MMA(1, 0, At, B0); PG8_BAR; PG8_SCHED;
            PG8_STAGE(PG8_SB(0, 1), b2 + hstep, voffB);
            PG8_WAIT_V(6); PG8_BAR; PG8_MMA(1, 1, At, B1); PG8_BAR;
            PG8_LDB(B0, 1, 0); PG8_SCHED; PG8_LDA(At, 1, 0); PG8_STAGE(PG8_SA(0, 1), a2 + hstep, voffA);
            PG8_WAIT_L(8); PG8_BAR; PG8_WAIT_L(0); PG8_MMA(0, 0, At, B0); PG8_BAR; PG8_SCHED;
            PG8_LDB(B1, 1, 1); PG8_STAGE(PG8_SB(1, 0), b3, voffB);
            PG8_BAR; PG8_WAIT_L(0); PG8_MMA(0, 1, At, B1); PG8_BAR;
            PG8_LDA(At, 1, 1); PG8_STAGE(PG8_SA(1, 0), a3, voffA);
            PG8_BAR; PG8_WAIT_L(0); PG8_MMA(1, 0, At, B0); PG8_BAR; PG8_SCHED;
            PG8_STAGE(PG8_SB(1, 1), b3 + hstep, voffB);
            PG8_WAIT_V(6); PG8_BAR; PG8_MMA(1, 1, At, B1); PG8_BAR;
            }
        }
        if constexpr (ALIGN_EPI) { if (wr == 0) PG8_BAR; }
        if constexpr (!Epi::AFTER_DRAIN) { E(acc, cur, wr, wc, fr, fq); S.done(cur); }
        if (!has_next) break;
#pragma unroll
        for (int a = 0; a < 2; ++a)
#pragma unroll
            for (int b = 0; b < 2; ++b)
#pragma unroll
                for (int m = 0; m < 4; ++m)
#pragma unroll
                    for (int n = 0; n < 2; ++n) acc[a][b][m][n] = (f32x4){0.f, 0.f, 0.f, 0.f};
        cur = nxt; cA = nA; cB = nB; ++ui;
        if constexpr (ALIGN_EPI) { if (wr == 1) PG8_BAR; }
    }
    PG8_WAIT_V(0);
    if constexpr (!ALIGN_EPI) { if (wr == 0) PG8_BAR; }
    PG8_BAR;
    if constexpr (Epi::AFTER_DRAIN) { E.fused(acc, cur, wr, wc, fr, fq, lds, wid, lane); S.done(cur); }
#undef PG8_SA
#undef PG8_SB
#undef PG8_STAGE
#undef PG8_LDA
#undef PG8_LDB
#undef PG8_MMA
#undef PG8_WAIT_V
#undef PG8_WAIT_L
#undef PG8_BAR
#undef PG8_SCHED
}
}

#define LAS __attribute__((address_space(3)))
typedef unsigned short bf16_t;
typedef float f32x4 __attribute__((ext_vector_type(4)));
typedef unsigned u32x4 __attribute__((ext_vector_type(4)));
typedef unsigned u32x2 __attribute__((ext_vector_type(2)));
typedef short bf16x8 __attribute__((ext_vector_type(8)));
typedef short s16x4 __attribute__((ext_vector_type(4)));
typedef __bf16 bf16x2_t __attribute__((ext_vector_type(2)));
typedef _Float16 f16x2_t __attribute__((ext_vector_type(2)));
typedef float f32x2v __attribute__((ext_vector_type(2)));
typedef _Float16 h2v __attribute__((ext_vector_type(2)));

constexpr int DM = 1024, NB = 4, SEQ = 8192, NTOK = NB * SEQ;
constexpr int MROWS = NTOK + 256;
constexpr int INW = 3088;
constexpr int NPROJ = 3072, NP1 = 3328;
constexpr int NEXP = 16384;
constexpr float EPS = 1e-6f;
constexpr int C_GQ = 0, C_GK = 256, C_GV = 512, C_GG = 1024, C_RQ = 1536, C_RK = 1792, C_RV = 2048, C_RG = 2560;
constexpr int S_GA = 1536, S_RQ = 1552, S_RV = 2064;

constexpr int NVG = 2048;
constexpr int NCH = (NTOK + 256) / 64;
constexpr size_t QK_ARR = (size_t)NCH * 4 * 8 * 64 * 8;
constexpr size_t MiB = 1u << 20;
constexpr size_t WS_CTL = 0, WS_WIN = 1 * MiB, WS_WOUT = 8 * MiB, WS_WS = 10 * MiB, WS_ROPE = 14 * MiB, WS_SSQ = 17 * MiB, WS_SEG = 19 * MiB, WS_ASEG = 27 * MiB,
                 WS_UB = 28 * MiB, WS_VB = 60 * MiB, WS_XN = 92 * MiB, WS_O = 157 * MiB, WS_LA = 221 * MiB, WS_PROJ = 254 * MiB, WS_QK = 383 * MiB, WS_XQ = 448 * MiB, WS_END = 480 * MiB;
static_assert(WS_WIN + (size_t)NP1 * DM * 2 <= WS_WOUT && WS_ROPE + (size_t)(SEQ + 64) * 32 * 8 <= WS_SSQ && WS_XN + (size_t)MROWS * DM * 2 <= WS_O &&
              WS_LA + QK_ARR * 4 <= WS_PROJ && WS_PROJ + (size_t)MROWS * NVG * 2 <= WS_QK && WS_QK + 4 * QK_ARR * 2 <= WS_XQ && WS_PROJ + (size_t)NTOK * 2048 * 2 <= WS_QK, "ws map");

constexpr int LDS_BYTES = 147456;
constexpr int NPHASE = 7;
#ifndef PROBE_R
#define PROBE_R 1
#define PROBE_U 1
#define PROBE_V 1
#endif
#ifndef PEER_FP8
#define PEER_FP8 1
#endif

struct Params {
    const float *x, *meta, *g1, *w_in, *gw2, *gb, *gla_gain, *ret_gain, *ret_bias, *w_out, *g2, *w_q, *subkeys, *pu, *pv, *gfin;
    float* out; unsigned char* ws;
    int ph_lo, ph_hi;
};

#define LDS_WAIT() asm volatile("s_waitcnt lgkmcnt(0)" ::: "memory")
__device__ __forceinline__ unsigned pk2(float lo, float hi) { const bf16x2_t v = {(__bf16)lo, (__bf16)hi}; return __builtin_bit_cast(unsigned, v); }
__device__ __forceinline__ unsigned f2bf(float f) { return (unsigned)__builtin_bit_cast(unsigned short, (__bf16)f); }

__device__ __forceinline__ float bf_lo(unsigned w) { return __builtin_bit_cast(float, w << 16); }
__device__ __forceinline__ float bf_hi(unsigned w) { return __builtin_bit_cast(float, w & 0xffff0000u); }
__device__ __forceinline__ float bf1(bf16_t h) { return __builtin_bit_cast(float, (unsigned)h << 16); }
__device__ __forceinline__ float wave_sum(float v) {
#pragma unroll
    for (int o = 1; o < 64; o <<= 1) v += __shfl_xor(v, o);
    return v;
}

struct MapIn {
    __device__ __forceinline__ void operator()(int j, int& src, float& sc) const {
        if (j < C_RQ) { src = j; sc = (j < 256) ? 0.125f : 1.0f; }
        else if (j < C_RV) { const int jj = j - C_RQ, which = jj >> 8, within = jj & 255, head = within >> 6, p = within & 63;
            const int a = p >> 3, n = (p >> 2) & 1, i = p & 3; src = S_RQ + which * 256 + head * 64 + 32 * n + 4 * a + i; sc = which ? 0.125f : 1.0f; }
        else { src = S_RV + (j - C_RV); sc = 1.0f; }
    }
};
struct MapId { __device__ __forceinline__ void operator()(int j, int& src, float& sc) const { src = j; sc = 1.0f; } };

template <class Map>
__device__ __forceinline__ void transpose_item(const float* W, int K, int N, bf16_t* WT, LAS float* scr, int item, int nblk, int lane, const Map map) {
    const int kb = item / nblk, nb = item % nblk, k0 = 64 * kb, n0 = 32 * nb;
    int src; float sc; map(n0 + (lane & 31), src, sc);
#pragma unroll 8
    for (int i = 0; i < 32; ++i) { const int kk = 2 * i + (lane >> 5); scr[kk * 33 + (lane & 31)] = W[(size_t)(k0 + kk) * N + src] * sc; }
    LDS_WAIT();
    const int c = lane & 7;
#pragma unroll
    for (int j = 0; j < 4; ++j) { const int n = (lane >> 3) + 8 * j; const LAS float* s = scr + (8 * c) * 33 + n;
        u32x4 o; o.x = pk2(s[0 * 33], s[1 * 33]); o.y = pk2(s[2 * 33], s[3 * 33]); o.z = pk2(s[4 * 33], s[5 * 33]); o.w = pk2(s[6 * 33], s[7 * 33]);
        *(u32x4*)(WT + (size_t)(n0 + n) * K + k0 + 8 * c) = o; }
    LDS_WAIT();
}

__device__ __forceinline__ void phase0(const Params& p, LAS unsigned char* lds, int bid, int nb) {
    const int tid = threadIdx.x, lane = tid & 63, wave = __builtin_amdgcn_readfirstlane(tid >> 6);
    unsigned char* ws = p.ws;
    bf16_t* XN = (bf16_t*)(ws + WS_XN); bf16_t* WinT = (bf16_t*)(ws + WS_WIN); bf16_t* WoutT = (bf16_t*)(ws + WS_WOUT); bf16_t* WsT = (bf16_t*)(ws + WS_WS);
    const int gw = bid * 8 + wave, NGW = nb * 8;
    const int gt = bid * 512 + tid, NGT = nb * 512;

    {
        LAS float* SKT = (LAS float*)lds;
        LAS float* WQT = (LAS float*)(lds + 128 * 132 * 4);
        for (int item = bid; item < 256; item += nb) {
            const int hc = item >> 4, kb = item & 15;
            __syncthreads();
            for (int e = tid; e < 128 * 128; e += 512) { const int n = e >> 7, d = e & 127; SKT[d * 132 + n] = p.subkeys[(size_t)hc * 16384 + e]; }
            for (int e = tid; e < 64 * 128; e += 512) { const int k = e >> 7, d = e & 127; WQT[d * 68 + k] = p.w_q[(size_t)(kb * 64 + k) * 2048 + hc * 128 + d]; }
            __syncthreads();
            const int tn = tid & 31, tk = tid >> 5;
            f32x4 acc[4];
#pragma unroll
            for (int i = 0; i < 4; ++i) acc[i] = (f32x4){0.f, 0.f, 0.f, 0.f};
#pragma unroll 4
            for (int d = 0; d < 128; ++d) {
                const f32x4 sk = *(const LAS f32x4*)(SKT + d * 132 + 4 * tn); const f32x4 wq = *(const LAS f32x4*)(WQT + d * 68 + 4 * tk);
#pragma unroll
                for (int i = 0; i < 4; ++i) acc[i] += sk[i] * wq;
            }
            const f32x4 gg = *(const f32x4*)(p.g2 + kb * 64 + 4 * tk);
#pragma unroll
            for (int i = 0; i < 4; ++i) { const f32x4 v = acc[i] * gg; u32x2 o; o.x = pk2(v[0], v[1]); o.y = pk2(v[2], v[3]);
                *(u32x2*)(WsT + (size_t)(hc * 128 + 4 * tn + i) * DM + kb * 64 + 4 * tk) = o; }
        }
        __syncthreads();
    }
    {
        LAS float* scr = (LAS float*)(lds + wave * 16384);
        constexpr int I_IN = (DM / 64) * (NPROJ / 32), I_OUT = (DM / 64) * (DM / 32);
        for (int it = gw; it < I_IN + I_OUT; it += NGW) {
            if (it < I_IN) transpose_item(p.w_in, DM, INW, WinT, scr, it, NPROJ / 32, lane, MapIn());
            else transpose_item(p.w_out, DM, DM, WoutT, scr, it - I_IN, DM / 32, lane, MapId());
        }
    }
    for (int e = gt; e < 256 * DM; e += NGT) {
        const int n = e >> 10, k = e & 1023; const float* wr = p.w_in + (size_t)k * INW + S_GA; float s = 0.f;
#pragma unroll
        for (int r = 0; r < 16; ++r) s += wr[r] * p.gw2[r * 256 + n];
        WinT[(size_t)(NPROJ + n) * DM + k] = (bf16_t)f2bf(s);
    }
#if PEER_FP8
    {
        u32x4* U8 = (u32x4*)(ws + WS_UB); u32x4* V8 = (u32x4*)(ws + WS_VB);
        for (int e = gt; e < NEXP * DM / 16; e += NGT) {
            const f32x4* us = (const f32x4*)p.pu + 4 * (size_t)e; const f32x4* vs = (const f32x4*)p.pv + 4 * (size_t)e;
            u32x4 wu, wv; unsigned tu[4], tv[4];
            const f32x4* g2s = (const f32x4*)p.g2 + 4 * (e & 63);
#pragma unroll
            for (int j = 0; j < 4; ++j) { const f32x4 a = us[j] * g2s[j] * 512.0f, b = vs[j] * 32.0f;
                int w = __builtin_amdgcn_cvt_pk_fp8_f32(a[0], a[1], 0, false); w = __builtin_amdgcn_cvt_pk_fp8_f32(a[2], a[3], w, true); tu[j] = (unsigned)w;
                int x = __builtin_amdgcn_cvt_pk_fp8_f32(b[0], b[1], 0, false); x = __builtin_amdgcn_cvt_pk_fp8_f32(b[2], b[3], x, true); tv[j] = (unsigned)x; }
            wu = (u32x4){tu[0], tu[1], tu[2], tu[3]}; wv = (u32x4){tv[0], tv[1], tv[2], tv[3]};
            const int row = e >> 6, c16 = e & 63;
            const size_t dst = ((size_t)(c16 >> 3) * NEXP + row) * 8 + (c16 & 7);
            U8[dst] = wu; V8[dst] = wv; }
    }
#else
    {
        u32x2* UB = (u32x2*)(ws + WS_UB); u32x2* VB = (u32x2*)(ws + WS_VB);
        const f32x4* u4 = (const f32x4*)p.pu; const f32x4* v4 = (const f32x4*)p.pv;
        for (int e = gt; e < NEXP * DM / 4; e += NGT) { const f32x4 a = u4[e]; u32x2 o; o.x = pk2(a[0], a[1]); o.y = pk2(a[2], a[3]); UB[e] = o;
            const f32x4 b = v4[e]; u32x2 q; q.x = pk2(b[0], b[1]); q.y = pk2(b[2], b[3]); VB[e] = q; }
    }
#endif
    {
        float2* rope = (float2*)(ws + WS_ROPE);
        for (int e = gt; e < (SEQ + 64) * 32; e += NGT) { const int pi = e >> 5, d = e & 31;
            const float invf = (float)pow(10000.0, -(double)d / 32.0); const float ang = (float)(pi - 48) * invf;
            rope[e] = make_float2((float)cos((double)ang), (float)sin((double)ang)); }
    }
    for (int m0 = gw; m0 < MROWS; m0 += 4 * NGW) {
        const float* srcp[4]; f32x4 v[4][4];
#pragma unroll
        for (int u = 0; u < 4; ++u) { const int m = m0 + u * NGW; srcp[u] = nullptr;
            if (m < MROWS) { if (m >= 256) srcp[u] = p.x + (size_t)(m - 256) * DM; else if (m >= 48 && m < 64) srcp[u] = p.meta + (size_t)(m - 48) * DM; }
            if (srcp[u] != nullptr) { const f32x4* xr = (const f32x4*)srcp[u] + lane;
#pragma unroll
                for (int j = 0; j < 4; ++j) v[u][j] = xr[64 * j]; }
            else {
#pragma unroll
                for (int j = 0; j < 4; ++j) v[u][j] = (f32x4){0.f, 0.f, 0.f, 0.f}; } }
        f32x4 gg[4];
#pragma unroll
        for (int j = 0; j < 4; ++j) gg[j] = ((const f32x4*)p.g1 + lane)[64 * j];
#pragma unroll
        for (int u = 0; u < 4; ++u) { const int m = m0 + u * NGW; if (m >= MROWS) continue;
            float s = 0.f;
#pragma unroll
            for (int j = 0; j < 4; ++j) s += (v[u][j].x * v[u][j].x + v[u][j].y * v[u][j].y) + (v[u][j].z * v[u][j].z + v[u][j].w * v[u][j].w);
            const float r = (srcp[u] != nullptr) ? __builtin_amdgcn_rsqf(wave_sum(s) * (1.0f / DM) + EPS) : 0.f;
            unsigned long long* o8 = (unsigned long long*)(XN + (size_t)m * DM) + lane;
#pragma unroll
            for (int j = 0; j < 4; ++j) { const f32x4 y = v[u][j] * r * gg[j]; o8[64 * j] = (unsigned long long)pk2(y.x, y.y) | ((unsigned long long)pk2(y.z, y.w) << 32); } }
    }
}

struct EpiProj {
    static constexpr bool PERM = true, AFTER_DRAIN = false;
    bf16_t* VG; bf16_t* QK; float* LAT; const float* gb; const float2* rope;
    __device__ __forceinline__ static size_t tile_off(int r, int head, int dg) { return ((((size_t)(r >> 6) * 4 + head) * 8 + dg) * 64 + (r & 63)) * 8; }
    __device__ __forceinline__ void operator()(const pg8::f32x4 (&acc)[2][2][4][2], const pg8::Unit& u, int wr, int wc, int fr, int fq) const {
        const int row0 = u.pm * 256 + wr * 64 + fr, cb0 = wc * 32 + 8 * fq;
        if (u.pn == 12) {
#pragma unroll
            for (int bj = 0; bj < 2; ++bj) { const int c = cb0 + 128 * bj; const f32x4 b0 = *(const f32x4*)(gb + c), b1 = *(const f32x4*)(gb + c + 4);
#pragma unroll
                for (int ai = 0; ai < 2; ++ai)
#pragma unroll
                    for (int m = 0; m < 4; ++m) { const int row = row0 + ai * 128 + m * 16; f32x4 v0 = acc[ai][bj][m][0] + b0, v1 = acc[ai][bj][m][1] + b1;
#pragma unroll
                        for (int i = 0; i < 4; ++i) { v0[i] = (fminf(v0[i], 0.f) - __logf(1.0f + __expf(-fabsf(v0[i])))) * 0.0625f; v1[i] = (fminf(v1[i], 0.f) - __logf(1.0f + __expf(-fabsf(v1[i])))) * 0.0625f; }
                        float* o = LAT + tile_off(row, c >> 6, (c & 63) >> 3); *(f32x4*)o = v0; *(f32x4*)(o + 4) = v1; } }
        } else if (u.pn == 6 || u.pn == 7) {
            bf16_t* QA = QK + (size_t)(u.pn - 4) * QK_ARR;
#pragma unroll
            for (int ai = 0; ai < 2; ++ai)
#pragma unroll
                for (int m = 0; m < 4; ++m) { const int row = row0 + ai * 128 + m * 16; const int pidx = (row < 256) ? row : 64 + ((row - 256) & (SEQ - 1));
#pragma unroll
                    for (int bj = 0; bj < 2; ++bj) { const int c = cb0 + 128 * bj, d0 = (c & 63) >> 1;
                        const f32x4 cs0 = *(const f32x4*)(rope + (size_t)pidx * 32 + d0), cs1 = *(const f32x4*)(rope + (size_t)pidx * 32 + d0 + 2);
                        const f32x4 t1 = acc[ai][bj][m][0], t2 = acc[ai][bj][m][1];
                        const float co[4] = {cs0[0], cs0[2], cs1[0], cs1[2]}, si[4] = {cs0[1], cs0[3], cs1[1], cs1[3]};
                        float o1[4], o2[4];
#pragma unroll
                        for (int i = 0; i < 4; ++i) { o1[i] = t1[i] * co[i] - t2[i] * si[i]; o2[i] = t1[i] * si[i] + t2[i] * co[i]; }
                        u32x4 w; w.x = pg8::cvt_pk_bf16(o1[0], o1[1]); w.y = pg8::cvt_pk_bf16(o1[2], o1[3]); w.z = pg8::cvt_pk_bf16(o2[0], o2[1]); w.w = pg8::cvt_pk_bf16(o2[2], o2[3]);
                        *(u32x4*)(QA + tile_off(row, c >> 6, (c & 63) >> 3)) = w; } }
        } else if (u.pn <= 1) {
            bf16_t* QA = QK + (size_t)u.pn * QK_ARR;
#pragma unroll
            for (int ai = 0; ai < 2; ++ai)
#pragma unroll
                for (int m = 0; m < 4; ++m) { const int row = row0 + ai * 128 + m * 16;
#pragma unroll
                    for (int bj = 0; bj < 2; ++bj) { const int c = cb0 + 128 * bj; const f32x4 v0 = acc[ai][bj][m][0], v1 = acc[ai][bj][m][1];
                        u32x4 w; w.x = pg8::cvt_pk_bf16(v0[0], v0[1]); w.y = pg8::cvt_pk_bf16(v0[2], v0[3]); w.z = pg8::cvt_pk_bf16(v1[0], v1[1]); w.w = pg8::cvt_pk_bf16(v1[2], v1[3]);
                        *(u32x4*)(QA + tile_off(row, c >> 6, (c & 63) >> 3)) = w; } }
        } else {
            const int cdst = (u.pn < 6 ? (u.pn - 2) : (u.pn - 4)) * 256;
#pragma unroll
            for (int ai = 0; ai < 2; ++ai)
#pragma unroll
                for (int m = 0; m < 4; ++m) { bf16_t* rowp = VG + (size_t)(row0 + ai * 128 + m * 16) * NVG + cdst + cb0;
#pragma unroll
                    for (int bj = 0; bj < 2; ++bj) { const f32x4 v0 = acc[ai][bj][m][0], v1 = acc[ai][bj][m][1];
                        u32x4 w; w.x = pg8::cvt_pk_bf16(v0[0], v0[1]); w.y = pg8::cvt_pk_bf16(v0[2], v0[3]); w.z = pg8::cvt_pk_bf16(v1[0], v1[1]); w.w = pg8::cvt_pk_bf16(v1[2], v1[3]);
                        *(u32x4*)(rowp + bj * 128) = w; } }
        }
    }
};
struct EpiRes {
    static constexpr bool PERM = true, AFTER_DRAIN = false;
    const float* x; bf16_t* HB; float* SSQ;
    __device__ __forceinline__ void operator()(const pg8::f32x4 (&acc)[2][2][4][2], const pg8::Unit& u, int wr, int wc, int fr, int fq) const {
        const int row0 = u.pm * 256 + wr * 64 + fr, col0 = u.pn * 256 + wc * 32 + 8 * fq;
#pragma unroll
        for (int ai = 0; ai < 2; ++ai)
#pragma unroll
            for (int m = 0; m < 4; ++m) { const int row = row0 + ai * 128 + m * 16; const float* xr = x + (size_t)row * DM + col0; bf16_t* hr = HB + (size_t)row * DM + col0; float ss = 0.f;
#pragma unroll
                for (int bj = 0; bj < 2; ++bj) { const f32x4 v0 = acc[ai][bj][m][0] + *(const f32x4*)(xr + bj * 128), v1 = acc[ai][bj][m][1] + *(const f32x4*)(xr + bj * 128 + 4);
                    ss += (v0[0] * v0[0] + v0[1] * v0[1]) + (v0[2] * v0[2] + v0[3] * v0[3]) + (v1[0] * v1[0] + v1[1] * v1[1]) + (v1[2] * v1[2] + v1[3] * v1[3]);
                    u32x4 w; w.x = pg8::cvt_pk_bf16(v0[0], v0[1]); w.y = pg8::cvt_pk_bf16(v0[2], v0[3]); w.z = pg8::cvt_pk_bf16(v1[0], v1[1]); w.w = pg8::cvt_pk_bf16(v1[2], v1[3]);
                    *(u32x4*)(hr + bj * 128) = w; }
                ss += __shfl_xor(ss, 16); ss += __shfl_xor(ss, 32);
                if (fq == 0) SSQ[(size_t)row * 16 + u.pn * 4 + wc] = ss; }
    }
};
struct EpiF16 {
    static constexpr bool PERM = true, AFTER_DRAIN = false;
    _Float16* SC;
    __device__ __forceinline__ void operator()(const pg8::f32x4 (&acc)[2][2][4][2], const pg8::Unit& u, int wr, int wc, int fr, int fq) const {
        const int row0 = u.pm * 256 + wr * 64 + fr, col0 = u.pn * 256 + wc * 32 + 8 * fq;
#pragma unroll
        for (int ai = 0; ai < 2; ++ai)
#pragma unroll
            for (int m = 0; m < 4; ++m) { _Float16* rowp = SC + (size_t)(row0 + ai * 128 + m * 16) * 2048 + col0;
#pragma unroll
                for (int bj = 0; bj < 2; ++bj) { const f32x4 v0 = acc[ai][bj][m][0], v1 = acc[ai][bj][m][1];
                    u32x4 w;
                    w.x = __builtin_bit_cast(unsigned, (f16x2_t){(_Float16)v0[0], (_Float16)v0[1]}); w.y = __builtin_bit_cast(unsigned, (f16x2_t){(_Float16)v0[2], (_Float16)v0[3]});
                    w.z = __builtin_bit_cast(unsigned, (f16x2_t){(_Float16)v1[0], (_Float16)v1[1]}); w.w = __builtin_bit_cast(unsigned, (f16x2_t){(_Float16)v1[2], (_Float16)v1[3]});
                    *(u32x4*)(rowp + bj * 128) = w; } }
    }
};

constexpr int A_QT = 0, A_KT = 9216, A_KE = 18432, A_V = 27648, A_ST = 45056, A_STSZ = 18432, A_OB = 81920, A_DEC = 115712, A_CS = 115968;
constexpr int PQ = 72, PV = 136, POB = 132;

__device__ __forceinline__ bf16x8 tr2(const LAS bf16_t* p0, const LAS bf16_t* p1) {
    const s16x4 a = __builtin_amdgcn_ds_read_tr16_b64_v4i16((LAS s16x4*)p0), b = __builtin_amdgcn_ds_read_tr16_b64_v4i16((LAS s16x4*)p1);
    return (bf16x8){a[0], a[1], a[2], a[3], b[0], b[1], b[2], b[3]};
}
__device__ __forceinline__ float ln_gamma(int hr) { return log1pf(-exp2f(-5.0f - (float)hr)); }

template <bool FULL>
__device__ __forceinline__ void attn_pass(const Params& p, LAS unsigned char* lds, int bid, int nb) {
    const int tid = threadIdx.x, lane = tid & 63, wave = __builtin_amdgcn_readfirstlane(tid >> 6);
    const int r16 = lane & 15, g4 = lane >> 4, q4 = (lane & 15) >> 2, p4 = lane & 3;
    unsigned char* ws = p.ws;
    const bf16_t* PROJ = (const bf16_t*)(ws + WS_PROJ); const float* LA = (const float*)(ws + WS_LA); const bf16_t* QK = (const bf16_t*)(ws + WS_QK);
    float* SEG = (float*)(ws + WS_SEG); float* ASEG = (float*)(ws + WS_ASEG); bf16_t* OUT = (bf16_t*)(ws + WS_O);
    LAS bf16_t* QT = (LAS bf16_t*)(lds + A_QT); LAS bf16_t* KT = (LAS bf16_t*)(lds + A_KT); LAS bf16_t* KE = (LAS bf16_t*)(lds + A_KE); LAS bf16_t* VS = (LAS bf16_t*)(lds + A_V);
    LAS float* OB = (LAS float*)(lds + A_OB); LAS float* DEC = (LAS float*)(lds + A_DEC); LAS float* CS = (LAS float*)(lds + A_CS);

    for (int item = bid; item < 256; item += nb) {
        const int seg = item & 7, h8 = (item >> 3) & 7, b = item >> 6;
        if (!FULL && seg == 7) continue;
        const bool gla = h8 < 4; const int hr = h8 & 3;
        const float lng = ln_gamma(hr);
        const bf16_t* QAq = QK + (size_t)(gla ? 0 : 2) * QK_ARR; const bf16_t* QAk = QK + (size_t)(gla ? 1 : 3) * QK_ARR;
        const int vcol = (gla ? 0 : 1024) + hr * 128, gcol = (gla ? 512 : 1536) + hr * 128;
        const int nch = (seg == 0) ? 17 : 16;

        f32x4 accS[8];
#pragma unroll
        for (int cb = 0; cb < 8; ++cb) accS[cb] = (f32x4){0.f, 0.f, 0.f, 0.f};
        float blsum[8] = {0.f, 0.f, 0.f, 0.f, 0.f, 0.f, 0.f, 0.f};
        __syncthreads();
        if (FULL) {
            if (wave >= 4) {
                const int wq = wave - 4;
                for (int sp = 0; sp < seg; ++sp) { const int it2 = (item & ~7) + sp; const float* Sg = SEG + (size_t)it2 * 8192; const float* Ag = ASEG + it2 * 64;
                    float dec[4];
#pragma unroll
                    for (int rg = 0; rg < 4; ++rg) dec[rg] = Ag[16 * wq + 4 * g4 + rg];
#pragma unroll
                    for (int cb = 0; cb < 8; ++cb)
#pragma unroll
                        for (int rg = 0; rg < 4; ++rg) accS[cb][rg] = dec[rg] * accS[cb][rg] + Sg[(16 * wq + 4 * g4 + rg) * 128 + 16 * cb + r16]; }
                LAS bf16_t* ST0 = (LAS bf16_t*)(lds + A_ST);
#pragma unroll
                for (int cb = 0; cb < 8; ++cb) { u32x2 w; w.x = pk2(accS[cb][0], accS[cb][1]); w.y = pk2(accS[cb][2], accS[cb][3]); *(LAS u32x2*)(ST0 + (16 * cb + r16) * PQ + 16 * wq + 4 * g4) = w; }
            }
        }
#define A_ROWBASE(ci_) (((seg == 0 && (ci_) == 0)) ? 0 : 256 + b * SEQ + ((seg == 0) ? (ci_) - 1 : 16 * seg + (ci_)) * 64)
        f32x4 lav[2]; u32x4 qv8, kv8; u32x4 vreg[2];
        qv8 = (u32x4){0u, 0u, 0u, 0u};
#define A_LOADCHUNK(ci_) do { const int _rb = A_ROWBASE(ci_); \
            const size_t _to = ((((size_t)(_rb >> 6) * 4 + hr) * 8 + wave) * 64 + lane) * 8;       \
            if (gla) { const f32x4* _lp = (const f32x4*)(LA + _to); lav[0] = _lp[0]; lav[1] = _lp[1]; } \
            else { lav[0] = (f32x4){lng, lng, lng, lng}; lav[1] = lav[0]; } \
            if (FULL) qv8 = *(const u32x4*)(QAq + _to); \
            kv8 = *(const u32x4*)(QAk + _to); \
            { const int vr = tid >> 3, cc = tid & 7; const u32x4* src = (const u32x4*)(PROJ + (size_t)(_rb + vr) * NVG + vcol + cc * 16); vreg[0] = src[0]; vreg[1] = src[1]; } } while (0)
#define A_LBAR() do { asm volatile("s_waitcnt lgkmcnt(0)" ::: "memory"); __builtin_amdgcn_s_barrier(); asm volatile("" ::: "memory"); } while (0)
        A_LOADCHUNK(0);
        f32x4 gnv[4], bsv[4];
        { const float* gptr = (gla ? p.gla_gain : p.ret_gain) + 16 * (tid & 7); const float* bptr = p.ret_bias + 16 * (tid & 7); const float bsc = gla ? 0.f : 1.f;
#pragma unroll
          for (int k4 = 0; k4 < 4; ++k4) { gnv[k4] = *(const f32x4*)(gptr + 4 * k4); bsv[k4] = *(const f32x4*)(bptr + 4 * k4) * bsc; } }
        for (int ci = 0; ci < nch; ++ci) {
            const bool metac = (seg == 0 && ci == 0);
            const int rowbase = A_ROWBASE(ci);
            const LAS bf16_t* STr = (const LAS bf16_t*)(lds + A_ST + (ci & 1) * A_STSZ); LAS bf16_t* STw = (LAS bf16_t*)(lds + A_ST + ((ci + 1) & 1) * A_STSZ);
            u32x4 gpre[2] = {(u32x4){0u, 0u, 0u, 0u}, (u32x4){0u, 0u, 0u, 0u}};
            if (FULL && !metac) { const u32x4* gp = (const u32x4*)(PROJ + (size_t)(rowbase + (tid >> 3)) * NVG + gcol + 16 * (tid & 7)); gpre[0] = gp[0]; gpre[1] = gp[1]; }
            {
                float bc[8];
#pragma unroll
                for (int c = 0; c < 8; ++c) { float v = lav[c >> 2][c & 3];
                    v += __builtin_bit_cast(float, __builtin_amdgcn_update_dpp(0, __builtin_bit_cast(int, v), 0x111, 0xf, 0xf, true));
                    v += __builtin_bit_cast(float, __builtin_amdgcn_update_dpp(0, __builtin_bit_cast(int, v), 0x112, 0xf, 0xf, true));
                    v += __builtin_bit_cast(float, __builtin_amdgcn_update_dpp(0, __builtin_bit_cast(int, v), 0x114, 0xf, 0xf, true));
                    v += __builtin_bit_cast(float, __builtin_amdgcn_update_dpp(0, __builtin_bit_cast(int, v), 0x118, 0xf, 0xf, true));
                    v += __builtin_bit_cast(float, __builtin_amdgcn_update_dpp(0, __builtin_bit_cast(int, v), 0x142, 0xa, 0xf, false));
                    v += __builtin_bit_cast(float, __builtin_amdgcn_update_dpp(0, __builtin_bit_cast(int, v), 0x143, 0xc, 0xf, false));
                    bc[c] = v; }
                float tot[8];
#pragma unroll
                for (int c = 0; c < 8; ++c) { tot[c] = __builtin_bit_cast(float, __builtin_amdgcn_readlane(__builtin_bit_cast(int, bc[c]), 63)); blsum[c] += tot[c]; }
                const unsigned qw[4] = {qv8.x, qv8.y, qv8.z, qv8.w}, kw[4] = {kv8.x, kv8.y, kv8.z, kv8.w};
                unsigned oq[4], ok[4], oe[4];
#pragma unroll
                for (int c2 = 0; c2 < 4; ++c2) { const float k0 = bf_lo(kw[c2]), k1 = bf_hi(kw[c2]);
                    if (FULL) { oq[c2] = pk2(bf_lo(qw[c2]) * __expf(bc[2 * c2]), bf_hi(qw[c2]) * __expf(bc[2 * c2 + 1])); ok[c2] = pk2(k0 * __expf(-bc[2 * c2]), k1 * __expf(-bc[2 * c2 + 1])); }
                    oe[c2] = pk2(k0 * __expf(tot[2 * c2] - bc[2 * c2]), k1 * __expf(tot[2 * c2 + 1] - bc[2 * c2 + 1])); }
                if (FULL) { *(LAS u32x4*)(QT + lane * PQ + 8 * wave) = (u32x4){oq[0], oq[1], oq[2], oq[3]}; *(LAS u32x4*)(KT + lane * PQ + 8 * wave) = (u32x4){ok[0], ok[1], ok[2], ok[3]}; }
                *(LAS u32x4*)(KE + lane * PQ + 8 * wave) = (u32x4){oe[0], oe[1], oe[2], oe[3]};
                if (lane == 63) { *(LAS f32x4*)(DEC + 8 * wave) = (f32x4){__expf(tot[0]), __expf(tot[1]), __expf(tot[2]), __expf(tot[3])};
                                  *(LAS f32x4*)(DEC + 8 * wave + 4) = (f32x4){__expf(tot[4]), __expf(tot[5]), __expf(tot[6]), __expf(tot[7])}; }
                const int vr = tid >> 3, cc = tid & 7; LAS u32x4* dst = (LAS u32x4*)(VS + vr * PV + cc * 16); dst[0] = vreg[0]; dst[1] = vreg[1];
            }
            if (ci + 1 < nch) A_LOADCHUNK(ci + 1);
            A_LBAR();
            if (wave < 4) {
                if (FULL && !metac) {
                    const int w = wave;
                    bf16x8 qf[2];
#pragma unroll
                    for (int s = 0; s < 2; ++s) qf[s] = *(const LAS bf16x8*)(QT + (16 * w + r16) * PQ + 32 * s + 8 * g4);
                    f32x4 att[4];
#pragma unroll
                    for (int jb = 0; jb < 4; ++jb) { att[jb] = (f32x4){0.f, 0.f, 0.f, 0.f};
                        if (jb <= w) {
#pragma unroll
                            for (int s = 0; s < 2; ++s) { const bf16x8 kf = *(const LAS bf16x8*)(KT + (16 * jb + r16) * PQ + 32 * s + 8 * g4);
                                att[jb] = __builtin_amdgcn_mfma_f32_16x16x32_bf16(kf, qf[s], att[jb], 0, 0, 0); }
                            if (jb == w) {
#pragma unroll
                                for (int rg = 0; rg < 4; ++rg) att[jb][rg] = (4 * g4 + rg <= r16) ? att[jb][rg] : 0.f;
                            }
                        } }
                    bf16x8 af[2];
#pragma unroll
                    for (int s = 0; s < 2; ++s) { u32x4 t; t.x = pk2(att[2 * s][0], att[2 * s][1]); t.y = pk2(att[2 * s][2], att[2 * s][3]); t.z = pk2(att[2 * s + 1][0], att[2 * s + 1][1]); t.w = pk2(att[2 * s + 1][2], att[2 * s + 1][3]);
                        af[s] = __builtin_bit_cast(bf16x8, t); }
#pragma unroll
                    for (int cb = 0; cb < 8; ++cb) { f32x4 o = (f32x4){0.f, 0.f, 0.f, 0.f};
#pragma unroll
                        for (int s = 0; s < 2; ++s) {
                            const bf16x8 vf = tr2(VS + (32 * s + 4 * g4 + q4) * PV + 16 * cb + 4 * p4, VS + (32 * s + 16 + 4 * g4 + q4) * PV + 16 * cb + 4 * p4);
                            o = __builtin_amdgcn_mfma_f32_16x16x32_bf16(af[s], vf, o, 0, 0, 0);
                            const bf16x8 sf = *(const LAS bf16x8*)(STr + (16 * cb + r16) * PQ + 32 * s + 8 * g4);
                            o = __builtin_amdgcn_mfma_f32_16x16x32_bf16(qf[s], sf, o, 0, 0, 0); }
#pragma unroll
                        for (int rg = 0; rg < 4; ++rg) OB[(16 * w + 4 * g4 + rg) * POB + 16 * cb + r16] = o[rg]; }
                }
            } else {
                const int wq = wave - 4;
                float dec[4];
#pragma unroll
                for (int rg = 0; rg < 4; ++rg) dec[rg] = DEC[16 * wq + 4 * g4 + rg];
                bf16x8 kef[2];
#pragma unroll
                for (int s = 0; s < 2; ++s) kef[s] = tr2(KE + (32 * s + 8 * g4 + q4) * PQ + 16 * wq + 4 * p4, KE + (32 * s + 8 * g4 + 4 + q4) * PQ + 16 * wq + 4 * p4);
#pragma unroll
                for (int cb = 0; cb < 8; ++cb) {
#pragma unroll
                    for (int rg = 0; rg < 4; ++rg) accS[cb][rg] *= dec[rg];
#pragma unroll
                    for (int s = 0; s < 2; ++s) { const bf16x8 vf = tr2(VS + (32 * s + 8 * g4 + q4) * PV + 16 * cb + 4 * p4, VS + (32 * s + 8 * g4 + 4 + q4) * PV + 16 * cb + 4 * p4);
                        accS[cb] = __builtin_amdgcn_mfma_f32_16x16x32_bf16(kef[s], vf, accS[cb], 0, 0, 0); }
                    if (FULL) { u32x2 w; w.x = pk2(accS[cb][0], accS[cb][1]); w.y = pk2(accS[cb][2], accS[cb][3]); *(LAS u32x2*)(STw + (16 * cb + r16) * PQ + 16 * wq + 4 * g4) = w; }
                }
            }
            A_LBAR();
            if (FULL && !metac) {
                const int i = tid >> 3, cc = tid & 7;
                float o[16];
#pragma unroll
                for (int k4 = 0; k4 < 4; ++k4) { const f32x4 t = *(const LAS f32x4*)(OB + i * POB + 16 * cc + 4 * k4); o[4 * k4] = t[0]; o[4 * k4 + 1] = t[1]; o[4 * k4 + 2] = t[2]; o[4 * k4 + 3] = t[3]; }
                const size_t row = (size_t)(rowbase + i);
                const u32x4 ga = gpre[0], gb2 = gpre[1];
                const unsigned gw[8] = {ga.x, ga.y, ga.z, ga.w, gb2.x, gb2.y, gb2.z, gb2.w};
                float s1 = 0.f, s2 = 0.f;
#pragma unroll
                for (int k = 0; k < 16; ++k) { s1 += o[k]; s2 += o[k] * o[k]; }
#pragma unroll
                for (int m = 1; m < 8; m <<= 1) { s1 += __shfl_xor(s1, m); s2 += __shfl_xor(s2, m); }
                const float mu = gla ? 0.f : s1 * (1.0f / 128.0f);
                const float rs = __builtin_amdgcn_rsqf(fmaxf(s2 * (1.0f / 128.0f) - mu * mu, 0.f) + EPS);
                unsigned ow[8];
#pragma unroll
                for (int k2 = 0; k2 < 8; ++k2) { float y[2];
#pragma unroll
                    for (int e = 0; e < 2; ++e) { const int k = 2 * k2 + e; const float v = (o[k] - mu) * rs * gnv[k >> 2][k & 3] + bsv[k >> 2][k & 3];
                        const float gt = e ? bf_hi(gw[k2]) : bf_lo(gw[k2]); y[e] = v * gt * __builtin_amdgcn_rcpf(1.0f + __expf(-gt)); }
                    ow[k2] = pk2(y[0], y[1]); }
                u32x4* op = (u32x4*)(OUT + (row - 256) * DM + h8 * 128 + 16 * cc);
                op[0] = (u32x4){ow[0], ow[1], ow[2], ow[3]}; op[1] = (u32x4){ow[4], ow[5], ow[6], ow[7]};
            }
        }
        if (!FULL) {
            if (wave >= 4) { const int wq = wave - 4; float* Sg = SEG + (size_t)item * 8192;
#pragma unroll
                for (int cb = 0; cb < 8; ++cb)
#pragma unroll
                    for (int rg = 0; rg < 4; ++rg) Sg[(16 * wq + 4 * g4 + rg) * 128 + 16 * cb + r16] = accS[cb][rg]; }
            if (lane < 8) { float bl = blsum[0];
#pragma unroll
                for (int c = 1; c < 8; ++c) bl = (lane == c) ? blsum[c] : bl;
                ASEG[item * 64 + 8 * wave + lane] = __expf(bl); }
        }
#undef A_LBAR
#undef A_ROWBASE
#undef A_LOADCHUNK
    }
}

__device__ __forceinline__ unsigned ord32(float f) { const unsigned b = __builtin_bit_cast(unsigned, f); return b ^ ((b >> 31) ? 0xffffffffu : 0x80000000u); }
__device__ __forceinline__ float unord32(unsigned o) { const unsigned b = (o >> 31) ? (o ^ 0x80000000u) : ~o; return __builtin_bit_cast(float, b); }
#define DPP_MAXU(v, ctrl, rmask) do { const unsigned _t = (unsigned)__builtin_amdgcn_update_dpp((int)(v), (int)(v), (ctrl), (rmask), 0xf, false); (v) = (v) > _t ? (v) : _t; } while (0)
#define DPP_ADDF(v, ctrl) do { const float _t = __builtin_bit_cast(float, __builtin_amdgcn_update_dpp(0, __builtin_bit_cast(int, (v)), (ctrl), 0xf, 0xf, false)); (v) += _t; } while (0)
__device__ __forceinline__ unsigned row_max_u(unsigned v) { DPP_MAXU(v, 0xB1, 0xf); DPP_MAXU(v, 0x4E, 0xf); DPP_MAXU(v, 0x124, 0xf); DPP_MAXU(v, 0x128, 0xf); return v; }
__device__ __forceinline__ float row_sum_f(float v) { DPP_ADDF(v, 0xB1); DPP_ADDF(v, 0x4E); DPP_ADDF(v, 0x124); DPP_ADDF(v, 0x128); return v; }
__device__ __forceinline__ unsigned wave_max_u(unsigned v) { v = row_max_u(v); DPP_MAXU(v, 0x142, 0xa); DPP_MAXU(v, 0x143, 0xc); return (unsigned)__builtin_amdgcn_readlane((int)v, 63); }

__device__ __forceinline__ float row_sum_x(float v) { return row_sum_f(v); }
__device__ __forceinline__ float dot2_bf16(unsigned w, unsigned x, float acc) { return __builtin_amdgcn_fdot2_f32_bf16(__builtin_bit_cast(bf16x2_t, w), __builtin_bit_cast(bf16x2_t, x), acc, false); }
__device__ __forceinline__ float gelu_exact(float v) { return 0.5f * v * (1.0f + erff(v * 0.70710678118654752f)); }

__device__ __forceinline__ void phase_peer(const Params& p, LAS unsigned char* lds, int bid, int nb) {
    const int tid = threadIdx.x, lane = tid & 63, wave = __builtin_amdgcn_readfirstlane(tid >> 6);
    const int p16 = lane & 15, rg4 = lane >> 4;
    unsigned char* ws = p.ws;
    const _Float16* SC = (const _Float16*)(ws + WS_PROJ); const bf16_t* HB = (const bf16_t*)(ws + WS_XN); const float* SSQ = (const float*)(ws + WS_SSQ);
    const unsigned char* UB = (const unsigned char*)(ws + WS_UB); const unsigned char* VB = (const unsigned char*)(ws + WS_VB);
    LAS float* A_s = (LAS float*)(lds + wave * 4096);
    LAS int* A_i = (LAS int*)(lds + wave * 4096 + 1024);
    LAS int* E_i = (LAS int*)(lds + wave * 4096 + 2048);
    LAS float* E_s = (LAS float*)(lds + wave * 4096 + 2560);
    int ci = 0, cj = 0; bool cvalid = lane < 50;
    { int l = lane;
      if (l < 16) { ci = 0; cj = l; } else if (l < 24) { ci = 1; cj = l - 16; } else if (l < 29) { ci = 2; cj = l - 24; } else if (l < 33) { ci = 3; cj = l - 29; }
      else if (l < 36) { ci = 4; cj = l - 33; } else if (l < 42) { ci = 5 + (l - 36) / 2; cj = (l - 36) & 1; } else { ci = 8 + (l - 42); cj = 0; } if (!cvalid) { ci = 0; cj = 0; } }
    const int gw = bid * 8 + wave, NGW = nb * 8;
    for (int t = gw; t < NTOK; t += NGW) {
        float ssq = (lane < 16) ? SSQ[(size_t)t * 16 + lane] : 0.f; ssq = wave_sum(ssq);
        const float rstd = 1.0f / sqrtf(ssq * (1.0f / DM) + EPS);
#pragma unroll 1
        for (int q = 0; q < 4; ++q) {
            const u32x4 raw = *(const u32x4*)(SC + (size_t)t * 2048 + 512 * q + 8 * lane);
            const unsigned rw[4] = {raw.x, raw.y, raw.z, raw.w};
            unsigned key[8];
#pragma unroll
            for (int e = 0; e < 8; ++e) { const unsigned hbits = (e & 1) ? (rw[e >> 1] >> 16) : (rw[e >> 1] & 0xffffu);
                const float f = (float)__builtin_bit_cast(_Float16, (unsigned short)hbits);
                key[e] = (ord32(f) & ~0x7fu) | (unsigned)(127 - (8 * p16 + e)); }
            unsigned mine = 0u;
#pragma unroll 1
            for (int it = 0; it < 16; ++it) {
                unsigned m = key[0];
#pragma unroll
                for (int e = 1; e < 8; ++e) m = m > key[e] ? m : key[e];
                const unsigned W = row_max_u(m);
                mine = (p16 == it) ? W : mine;
#pragma unroll
                for (int e = 0; e < 8; ++e) key[e] = (key[e] == W) ? 0u : key[e];
            }
            const int g = 4 * q + rg4;
            A_s[g * 16 + p16] = unord32(mine & ~0x7fu); A_i[g * 16 + p16] = 127 - (int)(mine & 0x7fu);
        }
        LDS_WAIT();
#pragma unroll 1
        for (int h = 0; h < 8; ++h) {
            const float sa = A_s[(2 * h) * 16 + ci], sb = A_s[(2 * h + 1) * 16 + cj];
            const int ia = A_i[(2 * h) * 16 + ci], ib = A_i[(2 * h + 1) * 16 + cj];
            const float sum = sa + sb;
            unsigned key = cvalid ? ((ord32(sum) & ~0x3fu) | (unsigned)(63 - lane)) : 0u;
            int rank = -1;
#pragma unroll 1
            for (int it = 0; it < 16; ++it) { const unsigned W = wave_max_u(key); if (key == W) { rank = it; key = 0u; } }
            if (rank >= 0) { E_i[h * 16 + rank] = ia * 128 + ib; E_s[h * 16 + rank] = sum; }
        }
        LDS_WAIT();
        float gsm[2]; int eidx[2];
#pragma unroll
        for (int sl = 0; sl < 2; ++sl) { const int e = lane + 64 * sl; const float s = E_s[e] * rstd, mx = E_s[e & ~15] * rstd; const float pe = __expf(s - mx); const float den = row_sum_x(pe);
            gsm[sl] = pe / den; eidx[sl] = E_i[e]; }
#if PEER_FP8
        f32x2v xf[4][8];
#pragma unroll
        for (int i = 0; i < 4; ++i) { const u32x4 h0 = *(const u32x4*)(HB + (size_t)t * DM + 256 * i + 16 * p16), h1 = *(const u32x4*)(HB + (size_t)t * DM + 256 * i + 16 * p16 + 8);
            const unsigned hv[8] = {h0.x, h0.y, h0.z, h0.w, h1.x, h1.y, h1.z, h1.w}; const float* gp = p.g2 + 256 * i + 16 * p16;
#pragma unroll
            for (int k2 = 0; k2 < 8; ++k2) { const f32x2v g = *(const f32x2v*)(gp + 2 * k2); xf[i][k2] = (f32x2v){bf_lo(hv[k2]) * rstd * g.x, bf_hi(hv[k2]) * rstd * g.y}; } }
        constexpr int NBB = 2;
#define P6_LOADB(buf, TAB, bt0) do { _Pragma("unroll") for (int j = 0; j < NBB; ++j) { const int bt = (bt0) + j; const int ex = E_i[64 * (bt >> 4) + 16 * rg4 + (bt & 15)]; \
            const unsigned char* rp = (TAB) + (size_t)ex * 1024 + 16 * p16; _Pragma("unroll") for (int i = 0; i < 4; ++i) buf[j][i] = *(const u32x4*)(rp + 256 * i); } } while (0)
        u32x4 bA[NBB][4], bB[NBB][4];
        float act0 = 0.f, act1 = 0.f;
#define P6_COMPU(buf, bt0) do { _Pragma("unroll") for (int j = 0; j < NBB; ++j) { const int bt = (bt0) + j; f32x2v s2 = (f32x2v){0.f, 0.f}; \
            _Pragma("unroll") for (int i = 0; i < 4; ++i) { const unsigned uu[4] = {buf[j][i].x, buf[j][i].y, buf[j][i].z, buf[j][i].w}; \
                _Pragma("unroll") for (int w = 0; w < 4; ++w) { const f32x2v lo = __builtin_amdgcn_cvt_pk_f32_fp8((int)uu[w], false), hi = __builtin_amdgcn_cvt_pk_f32_fp8((int)uu[w], true); \
                    s2 = __builtin_elementwise_fma(lo, xf[i][2 * w], s2); s2 = __builtin_elementwise_fma(hi, xf[i][2 * w + 1], s2); } } \
            const float s = row_sum_x(s2.x + s2.y); const bool mine = (p16 == (bt & 15)); act0 = (mine && bt < 16) ? s : act0; act1 = (mine && bt >= 16) ? s : act1; } } while (0)
        P6_LOADB(bA, UB, 0);
#pragma unroll 1
        for (int g = 0; g < 32; g += 2 * NBB) { P6_LOADB(bB, UB, g + NBB); P6_COMPU(bA, g); if (g + 2 * NBB < 32) P6_LOADB(bA, UB, g + 2 * NBB); P6_COMPU(bB, g + NBB); }
        P6_LOADB(bA, VB, 0);
        LAS float* E_c = E_s;
        { const float c0 = gsm[0] * gelu_exact(act0 * (1.0f / 512.0f)) * (1.0f / 32.0f), c1 = gsm[1] * gelu_exact(act1 * (1.0f / 512.0f)) * (1.0f / 32.0f);
          LDS_WAIT(); E_c[lane] = c0; E_c[lane + 64] = c1; LDS_WAIT(); }
        f32x2v acc2[4][8];
#pragma unroll
        for (int i = 0; i < 4; ++i)
#pragma unroll
            for (int k = 0; k < 8; ++k) acc2[i][k] = (f32x2v){0.f, 0.f};
#define P6_COMPV(buf, bt0) do { _Pragma("unroll") for (int j = 0; j < NBB; ++j) { const int bt = (bt0) + j; const float cf = E_c[64 * (bt >> 4) + 16 * rg4 + (bt & 15)]; const f32x2v cf2 = (f32x2v){cf, cf}; \
            _Pragma("unroll") for (int i = 0; i < 4; ++i) { const unsigned vv[4] = {buf[j][i].x, buf[j][i].y, buf[j][i].z, buf[j][i].w}; \
                _Pragma("unroll") for (int w = 0; w < 4; ++w) { const f32x2v lo = __builtin_amdgcn_cvt_pk_f32_fp8((int)vv[w], false), hi = __builtin_amdgcn_cvt_pk_f32_fp8((int)vv[w], true); \
                    acc2[i][2 * w] = __builtin_elementwise_fma(lo, cf2, acc2[i][2 * w]); acc2[i][2 * w + 1] = __builtin_elementwise_fma(hi, cf2, acc2[i][2 * w + 1]); } } } } while (0)
#pragma unroll 1
        for (int g = 0; g < 32; g += 2 * NBB) { P6_LOADB(bB, VB, g + NBB); P6_COMPV(bA, g); if (g + 2 * NBB < 32) P6_LOADB(bA, VB, g + 2 * NBB); P6_COMPV(bB, g + NBB); }
#undef P6_LOADB
#undef P6_COMPU
#undef P6_COMPV
        float ss = 0.f;
#pragma unroll
        for (int i = 0; i < 4; ++i) { const u32x4 h0 = *(const u32x4*)(HB + (size_t)t * DM + 256 * i + 16 * p16), h1 = *(const u32x4*)(HB + (size_t)t * DM + 256 * i + 16 * p16 + 8);
            const unsigned hv[8] = {h0.x, h0.y, h0.z, h0.w, h1.x, h1.y, h1.z, h1.w};
#pragma unroll
            for (int k2 = 0; k2 < 8; ++k2) { float ax = acc2[i][k2].x, ay = acc2[i][k2].y;
                ax += __shfl_xor(ax, 16); ax += __shfl_xor(ax, 32); ay += __shfl_xor(ay, 16); ay += __shfl_xor(ay, 32);
                ax += bf_lo(hv[k2]); ay += bf_hi(hv[k2]); acc2[i][k2] = (f32x2v){ax, ay}; ss += ax * ax + ay * ay; } }
        ss = row_sum_x(ss);
        const float rf = 1.0f / sqrtf(ss * (1.0f / DM) + EPS);
#pragma unroll
        for (int i = 0; i < 4; ++i) { if (i == rg4) { const float* gp = p.gfin + 256 * i + 16 * p16; float* op = p.out + (size_t)t * DM + 256 * i + 16 * p16;
#pragma unroll
                for (int k4 = 0; k4 < 4; ++k4) { const f32x4 g = *(const f32x4*)(gp + 4 * k4);
                    *(f32x4*)(op + 4 * k4) = (f32x4){acc2[i][2 * k4].x * rf * g[0], acc2[i][2 * k4].y * rf * g[1], acc2[i][2 * k4 + 1].x * rf * g[2], acc2[i][2 * k4 + 1].y * rf * g[3]}; } } }
#else
        unsigned xp[8][4];
#pragma unroll
        for (int i = 0; i < 8; ++i) { const u32x4 hw = *(const u32x4*)(HB + (size_t)t * DM + 128 * i + 8 * p16); const f32x4 ga = *(const f32x4*)(p.g2 + 128 * i + 8 * p16), gb = *(const f32x4*)(p.g2 + 128 * i + 8 * p16 + 4);
            xp[i][0] = pk2(bf_lo(hw.x) * rstd * ga[0], bf_hi(hw.x) * rstd * ga[1]); xp[i][1] = pk2(bf_lo(hw.y) * rstd * ga[2], bf_hi(hw.y) * rstd * ga[3]);
            xp[i][2] = pk2(bf_lo(hw.z) * rstd * gb[0], bf_hi(hw.z) * rstd * gb[1]); xp[i][3] = pk2(bf_lo(hw.w) * rstd * gb[2], bf_hi(hw.w) * rstd * gb[3]); }
        float act[2] = {0.f, 0.f};
#pragma unroll
        for (int sl = 0; sl < 2; ++sl) {
#pragma unroll 2
            for (int b16 = 0; b16 < 16; ++b16) {
                const int e = 64 * sl + 16 * rg4 + b16; const int ex = E_i[e];
                const unsigned char* rowp = UB + (size_t)ex * 2048 + 16 * p16;
                float s = 0.f;
#pragma unroll
                for (int i = 0; i < 8; ++i) { const u32x4 uw = *(const u32x4*)(rowp + 256 * i);
                    s = dot2_bf16(uw.x, xp[i][0], s); s = dot2_bf16(uw.y, xp[i][1], s); s = dot2_bf16(uw.z, xp[i][2], s); s = dot2_bf16(uw.w, xp[i][3], s); }
                s = row_sum_x(s);
                act[sl] = (p16 == b16) ? s : act[sl];
            }
        }
        float coef[2];
#pragma unroll
        for (int sl = 0; sl < 2; ++sl) coef[sl] = gsm[sl] * gelu_exact(act[sl]);
        float acc[8][8];
#pragma unroll
        for (int i = 0; i < 8; ++i)
#pragma unroll
            for (int k = 0; k < 8; ++k) acc[i][k] = 0.f;
#pragma unroll
        for (int sl = 0; sl < 2; ++sl) {
#pragma unroll 2
            for (int b16 = 0; b16 < 16; ++b16) {
                const int srcl = (lane & 48) + b16;
                const float cf = __shfl(coef[sl], srcl); const int ex = __shfl(eidx[sl], srcl);
                const unsigned char* rowp = VB + (size_t)ex * 2048 + 16 * p16;
#pragma unroll
                for (int i = 0; i < 8; ++i) { const u32x4 vw = *(const u32x4*)(rowp + 256 * i);
                    acc[i][0] += cf * bf_lo(vw.x); acc[i][1] += cf * bf_hi(vw.x); acc[i][2] += cf * bf_lo(vw.y); acc[i][3] += cf * bf_hi(vw.y);
                    acc[i][4] += cf * bf_lo(vw.z); acc[i][5] += cf * bf_hi(vw.z); acc[i][6] += cf * bf_lo(vw.w); acc[i][7] += cf * bf_hi(vw.w); }
            }
        }
        float ss = 0.f;
#pragma unroll
        for (int i = 0; i < 8; ++i) { const u32x4 hw = *(const u32x4*)(HB + (size_t)t * DM + 128 * i + 8 * p16); const unsigned hv[4] = {hw.x, hw.y, hw.z, hw.w};
#pragma unroll
            for (int k = 0; k < 8; ++k) { float a = acc[i][k]; a += __shfl_xor(a, 16); a += __shfl_xor(a, 32);
                a += (k & 1) ? bf_hi(hv[k >> 1]) : bf_lo(hv[k >> 1]); acc[i][k] = a; ss += a * a; } }
        ss = row_sum_x(ss);
        const float rf = 1.0f / sqrtf(ss * (1.0f / DM) + EPS);
#pragma unroll
        for (int i = 0; i < 8; ++i) { if ((i >> 1) == rg4) { const f32x4 ga = *(const f32x4*)(p.gfin + 128 * i + 8 * p16), gb = *(const f32x4*)(p.gfin + 128 * i + 8 * p16 + 4);
                float* op = p.out + (size_t)t * DM + 128 * i + 8 * p16;
                *(f32x4*)op = (f32x4){acc[i][0] * rf * ga[0], acc[i][1] * rf * ga[1], acc[i][2] * rf * ga[2], acc[i][3] * rf * ga[3]};
                *(f32x4*)(op + 4) = (f32x4){acc[i][4] * rf * gb[0], acc[i][5] * rf * gb[1], acc[i][6] * rf * gb[2], acc[i][7] * rf * gb[3]}; } }
#endif
        LDS_WAIT();
    }
}


__device__ __forceinline__ void row_max4(unsigned k0, unsigned k1, unsigned k2, unsigned k3, unsigned& w0, unsigned& w1, unsigned& w2, unsigned& w3) {
    asm volatile("s_nop 1\n\t"
                 "v_max_u32_dpp %0, %4, %4 quad_perm:[1,0,3,2] row_mask:0xf bank_mask:0xf\n\t"
                 "v_max_u32_dpp %1, %5, %5 quad_perm:[1,0,3,2] row_mask:0xf bank_mask:0xf\n\t"
                 "v_max_u32_dpp %2, %6, %6 quad_perm:[1,0,3,2] row_mask:0xf bank_mask:0xf\n\t"
                 "v_max_u32_dpp %3, %7, %7 quad_perm:[1,0,3,2] row_mask:0xf bank_mask:0xf\n\t"
                 "v_max_u32_dpp %0, %0, %0 quad_perm:[2,3,0,1] row_mask:0xf bank_mask:0xf\n\t"
                 "v_max_u32_dpp %1, %1, %1 quad_perm:[2,3,0,1] row_mask:0xf bank_mask:0xf\n\t"
                 "v_max_u32_dpp %2, %2, %2 quad_perm:[2,3,0,1] row_mask:0xf bank_mask:0xf\n\t"
                 "v_max_u32_dpp %3, %3, %3 quad_perm:[2,3,0,1] row_mask:0xf bank_mask:0xf\n\t"
                 "v_max_u32_dpp %0, %0, %0 row_ror:4 row_mask:0xf bank_mask:0xf\n\t"
                 "v_max_u32_dpp %1, %1, %1 row_ror:4 row_mask:0xf bank_mask:0xf\n\t"
                 "v_max_u32_dpp %2, %2, %2 row_ror:4 row_mask:0xf bank_mask:0xf\n\t"
                 "v_max_u32_dpp %3, %3, %3 row_ror:4 row_mask:0xf bank_mask:0xf\n\t"
                 "v_max_u32_dpp %0, %0, %0 row_ror:8 row_mask:0xf bank_mask:0xf\n\t"
                 "v_max_u32_dpp %1, %1, %1 row_ror:8 row_mask:0xf bank_mask:0xf\n\t"
                 "v_max_u32_dpp %2, %2, %2 row_ror:8 row_mask:0xf bank_mask:0xf\n\t"
                 "v_max_u32_dpp %3, %3, %3 row_ror:8 row_mask:0xf bank_mask:0xf\n\t"
                 "s_nop 1"
                 : "=&v"(w0), "=&v"(w1), "=&v"(w2), "=&v"(w3) : "v"(k0), "v"(k1), "v"(k2), "v"(k3));
}
__device__ __forceinline__ unsigned pkadd_h2(unsigned a, unsigned b) { const h2v x = __builtin_bit_cast(h2v, a), y = __builtin_bit_cast(h2v, b); const h2v s = x + y; return __builtin_bit_cast(unsigned, s); }
constexpr int NT6 = 8;
constexpr int W6_BYTES = 16640;
__device__ __forceinline__ float dpp_f(float v, int ctrl_dummy);
#define DPPF(v, ctrl) __builtin_bit_cast(float, __builtin_amdgcn_update_dpp(0, __builtin_bit_cast(int, (v)), (ctrl), 0xf, 0xf, false))

__device__ __forceinline__ void phase_peer2(const Params& p, LAS unsigned char* lds, int bid, int nb) {
    const int tid = threadIdx.x, lane = tid & 63, wave = __builtin_amdgcn_readfirstlane(tid >> 6);
    const int p16 = lane & 15, rg4 = lane >> 4, q8 = lane >> 3, p8 = lane & 7;
    const bool b0 = lane & 1, b1 = lane & 2, b2 = lane & 4, c0 = lane & 8, c1 = lane & 16, c2 = lane & 32;
    unsigned char* ws = p.ws;
    const _Float16* SC = (const _Float16*)(ws + WS_PROJ); const bf16_t* HB = (const bf16_t*)(ws + WS_XN); const float* SSQ = (const float*)(ws + WS_SSQ);
    const unsigned char* UB = (const unsigned char*)(ws + WS_UB); const unsigned char* VB = (const unsigned char*)(ws + WS_VB); unsigned char* XQ = ws + WS_XQ;
    LAS unsigned char* wl = lds + wave * W6_BYTES;
    LAS unsigned char* CQ = wl;
    LAS unsigned short* E16 = (LAS unsigned short*)(wl + 6144);
    LAS float* GC = (LAS float*)(wl + 8192);
    LAS float* ACT = (LAS float*)(wl + 12288);
    LAS float* RS = (LAS float*)(wl + 16384);
    int ci = 0, cj = 0; bool cvalid = lane < 50;
    { int l = lane;
      if (l < 16) { ci = 0; cj = l; } else if (l < 24) { ci = 1; cj = l - 16; } else if (l < 29) { ci = 2; cj = l - 24; } else if (l < 33) { ci = 3; cj = l - 29; }
      else if (l < 36) { ci = 4; cj = l - 33; } else if (l < 42) { ci = 5 + (l - 36) / 2; cj = (l - 36) & 1; } else { ci = 8 + (l - 42); cj = 0; } if (!cvalid) { ci = 0; cj = 0; } }
    const int gw = bid * 8 + wave, NGW = nb * 8;
#define TOK6(k) min(base + (k) * NGW, NTOK - 1)
    for (int base = gw; base < NTOK; base += NT6 * NGW) {
#pragma unroll 1
        for (int rep_r = 0; rep_r < PROBE_R; ++rep_r)
#pragma unroll 1
        for (int k = 0; k < NT6; k += 2) {
            u32x4 raw[2][4]; float rstd[2];
#pragma unroll
            for (int v = 0; v < 2; ++v) { const int t = TOK6(k + v);
#pragma unroll
                for (int q = 0; q < 4; ++q) raw[v][q] = *(const u32x4*)(SC + (size_t)t * 2048 + 512 * q + 8 * lane);
                float ssq = (lane < 16) ? SSQ[(size_t)t * 16 + lane] : 0.f; ssq = wave_sum(ssq);
                rstd[v] = 1.0f / sqrtf(ssq * (1.0f / DM) + EPS);
                { const u32x4 ha = *(const u32x4*)(HB + (size_t)t * DM + 16 * lane), hb = *(const u32x4*)(HB + (size_t)t * DM + 16 * lane + 8); const float sc = rstd[v] * 16.0f;
                  const unsigned hv[8] = {ha.x, ha.y, ha.z, ha.w, hb.x, hb.y, hb.z, hb.w}; unsigned xw[4];
#pragma unroll
                  for (int w = 0; w < 4; ++w) { int pk = __builtin_amdgcn_cvt_pk_fp8_f32(bf_lo(hv[2 * w]) * sc, bf_hi(hv[2 * w]) * sc, 0, false);
                      pk = __builtin_amdgcn_cvt_pk_fp8_f32(bf_lo(hv[2 * w + 1]) * sc, bf_hi(hv[2 * w + 1]) * sc, pk, true); xw[w] = (unsigned)pk; }
                  *(u32x4*)(XQ + (size_t)t * DM + 16 * lane) = (u32x4){xw[0], xw[1], xw[2], xw[3]}; } }
#pragma unroll
            for (int qq = 0; qq < 2; ++qq) {
                unsigned ka[4][8];
#pragma unroll
                for (int c = 0; c < 4; ++c) { const u32x4 rv = raw[c >> 1][2 * qq + (c & 1)]; const unsigned rw[4] = {rv.x, rv.y, rv.z, rv.w};
#pragma unroll
                    for (int e = 0; e < 8; ++e) { const unsigned hbits = (e & 1) ? (rw[e >> 1] >> 16) : (rw[e >> 1] & 0xffffu);
                        const float f = (float)__builtin_bit_cast(_Float16, (unsigned short)hbits);
                        ka[c][e] = (ord32(f) & ~0x7fu) | (unsigned)(127 - (8 * p16 + e)); } }
#define CE6(u, i, j) do { const unsigned _a = ka[u][i], _b = ka[u][j]; ka[u][i] = _a > _b ? _a : _b; ka[u][j] = _a > _b ? _b : _a; } while (0)
#pragma unroll
                for (int u = 0; u < 4; ++u) {
                    CE6(u, 0, 1); CE6(u, 2, 3); CE6(u, 4, 5); CE6(u, 6, 7);
                    CE6(u, 0, 2); CE6(u, 1, 3); CE6(u, 4, 6); CE6(u, 5, 7);
                    CE6(u, 1, 2); CE6(u, 5, 6);
                    CE6(u, 0, 4); CE6(u, 1, 5); CE6(u, 2, 6); CE6(u, 3, 7);
                    CE6(u, 2, 4); CE6(u, 3, 5);
                    CE6(u, 1, 2); CE6(u, 3, 4); CE6(u, 5, 6);
                }
#undef CE6
                unsigned mine[4] = {0u, 0u, 0u, 0u};
#pragma unroll 1
                for (int it = 0; it < 16; ++it) {
                    unsigned Wv[4]; row_max4(ka[0][0], ka[1][0], ka[2][0], ka[3][0], Wv[0], Wv[1], Wv[2], Wv[3]);
#pragma unroll
                    for (int c = 0; c < 4; ++c) {
                        const unsigned W = Wv[c];
                        mine[c] = (p16 == it) ? W : mine[c];
                        const bool win = (ka[c][0] == W);
#pragma unroll
                        for (int e = 0; e < 7; ++e) ka[c][e] = win ? ka[c][e + 1] : ka[c][e];
                        ka[c][7] = win ? 0u : ka[c][7];
                    }
                }
#pragma unroll
                for (int c = 0; c < 4; ++c) { const int g = 4 * (2 * qq + (c & 1)) + rg4; LAS float* A_s = (LAS float*)(wl + 3072 * (c >> 1)); LAS int* A_i = (LAS int*)(wl + 3072 * (c >> 1) + 1024);
                    A_s[g * 16 + p16] = unord32(mine[c] & ~0x7fu); A_i[g * 16 + p16] = 127 - (int)(mine[c] & 0x7fu); }
            }
            LDS_WAIT();
            {
                float av[4], bc[4]; int iav[4], ibc[4], jp[4], hh[4], bb[4]; unsigned key[4];
#pragma unroll
                for (int c = 0; c < 4; ++c) { const LAS float* A_s = (const LAS float*)(wl + 3072 * (c >> 1)); const LAS int* A_i = (const LAS int*)(wl + 3072 * (c >> 1) + 1024);
                    hh[c] = 4 * (c & 1) + rg4; bb[c] = (2 * hh[c] + 1) * 16; av[c] = A_s[(2 * hh[c]) * 16 + p16]; iav[c] = A_i[(2 * hh[c]) * 16 + p16] * 128; jp[c] = 0; bc[c] = A_s[bb[c]]; ibc[c] = A_i[bb[c]];
                    key[c] = (ord32(av[c] + bc[c]) & ~0xfu) | (unsigned)(15 - p16); }
#pragma unroll 1
                for (int it = 0; it < 16; ++it) {
                    unsigned Wv[4]; row_max4(key[0], key[1], key[2], key[3], Wv[0], Wv[1], Wv[2], Wv[3]);
#pragma unroll
                    for (int c = 0; c < 4; ++c) {
                        const LAS float* A_s = (const LAS float*)(wl + 3072 * (c >> 1)); const LAS int* A_i = (const LAS int*)(wl + 3072 * (c >> 1) + 1024);
                        LAS int* E_i = (LAS int*)(wl + 3072 * (c >> 1) + 2048); LAS float* E_s = (LAS float*)(wl + 3072 * (c >> 1) + 2560);
                        const bool win = (key[c] == Wv[c]);
                        if (win) { E_i[hh[c] * 16 + it] = iav[c] + ibc[c]; E_s[hh[c] * 16 + it] = av[c] + bc[c]; }
                        jp[c] += win ? 1 : 0;
                        const int jr = jp[c] < 16 ? jp[c] : 15;
                        bc[c] = A_s[bb[c] + jr]; ibc[c] = A_i[bb[c] + jr];
                        key[c] = jp[c] < 16 ? ((ord32(av[c] + bc[c]) & ~0xfu) | (unsigned)(15 - p16)) : 0u;
                    }
                }
            }
            LDS_WAIT();
#pragma unroll
            for (int v = 0; v < 2; ++v) { const LAS int* E_i = (const LAS int*)(wl + 3072 * v + 2048); const LAS float* E_s = (const LAS float*)(wl + 3072 * v + 2560);
#pragma unroll
                for (int sl = 0; sl < 2; ++sl) { const int e = lane + 64 * sl; const float s = E_s[e] * rstd[v], mx = E_s[e & ~15] * rstd[v]; const float pe = __expf(s - mx); const float den = row_sum_x(pe);
                    const int pos = 16 * (e & 7) + (e >> 3);
                    GC[(k + v) * 128 + pos] = pe / den; E16[(k + v) * 128 + pos] = (unsigned short)E_i[e]; }
                if (lane == 0) RS[k + v] = rstd[v]; }
            LDS_WAIT();
        }
#define P6_LOADH(buf, TAB, jj, kk, hh) do { const u32x4 _iv = *(const LAS u32x4*)(E16 + (kk) * 128 + 16 * q8 + 8 * (hh)); const unsigned _iw[4] = {_iv.x, _iv.y, _iv.z, _iv.w}; \
            _Pragma("unroll") for (int c = 0; c < 8; ++c) { const unsigned _idx = (c & 1) ? (_iw[c >> 1] >> 16) : (_iw[c >> 1] & 0xffffu); \
                buf[c] = *(const u32x4*)((TAB) + (((size_t)(jj) * NEXP + _idx) << 7) + 16 * p8); } } while (0)
#define P6_LOADX(hb, jj, kk) do { const bf16_t* _hp = HB + (size_t)TOK6(kk) * DM + 128 * (jj) + 16 * p8; hb[0] = *(const u32x4*)_hp; hb[1] = *(const u32x4*)(_hp + 8); } while (0)
        asm volatile("s_waitcnt vmcnt(0)" ::: "memory");
#pragma unroll 1
        for (int rep_u = 0; rep_u < PROBE_U; ++rep_u) {
            for (int k = 0; k < NT6; ++k) { ACT[k * 128 + lane] = 0.f; ACT[k * 128 + 64 + lane] = 0.f; }
            LDS_WAIT();
            const int n16 = lane & 15, g4 = lane >> 4, c4 = lane & 3, r16 = 4 * g4 + (n16 >> 2);
            const int eoff = 2 * (16 * (r16 & 7) + (r16 >> 3));
            const bool xkeep = (g4 == (n16 >> 2));
            u32x4 bfP[16], bfQ[16], xP[2], xQ2[2];
#define P6_ULOAD(buf, xb, nn) do { const int _j = (nn) / NT6, _k = (nn) % NT6; const LAS unsigned char* _ip = (const LAS unsigned char*)(E16 + _k * 128) + eoff; \
                { const unsigned char* _xp = XQ + (size_t)TOK6(_k) * DM + 128 * _j + 16 * c4; xb[0] = *(const u32x4*)_xp; xb[1] = *(const u32x4*)(_xp + 64); } \
                asm volatile("" ::: "memory"); \
                _Pragma("unroll") for (int T = 0; T < 8; ++T) { const unsigned _idx = *(const LAS unsigned short*)(_ip + 4 * T); \
                    const unsigned char* _rp = UB + (((size_t)_j * NEXP + _idx) << 7) + 16 * c4; buf[2 * T] = *(const u32x4*)_rp; buf[2 * T + 1] = *(const u32x4*)(_rp + 64); } } while (0)
#define P6_PK64(lo, hi) ((long)(((unsigned long long)(hi) << 32) | (unsigned long long)(lo)))
#define P6_UMMA(buf, xb, nn) do { const int k = (nn) % NT6; \
                const unsigned x0 = xkeep ? xb[0].x : 0u, x1 = xkeep ? xb[0].y : 0u, x2 = xkeep ? xb[0].z : 0u, x3 = xkeep ? xb[0].w : 0u, \
                               x4 = xkeep ? xb[1].x : 0u, x5 = xkeep ? xb[1].y : 0u, x6 = xkeep ? xb[1].z : 0u, x7 = xkeep ? xb[1].w : 0u; \
                const long xa[4] = {P6_PK64(x0, x1), P6_PK64(x2, x3), P6_PK64(x4, x5), P6_PK64(x6, x7)}; \
                float dsel[2] = {0.f, 0.f}; \
                _Pragma("unroll") for (int T = 0; T < 8; ++T) { f32x4 d = (f32x4){0.f, 0.f, 0.f, 0.f}; \
                    const long bb[4] = {P6_PK64(buf[2 * T].x, buf[2 * T].y), P6_PK64(buf[2 * T].z, buf[2 * T].w), P6_PK64(buf[2 * T + 1].x, buf[2 * T + 1].y), P6_PK64(buf[2 * T + 1].z, buf[2 * T + 1].w)}; \
                    _Pragma("unroll") for (int s = 0; s < 4; ++s) d = __builtin_amdgcn_mfma_f32_16x16x32_fp8_fp8(xa[s], bb[s], d, 0, 0, 0); \
                    float pv = (c4 == 0) ? d[0] : ((c4 == 1) ? d[1] : ((c4 == 2) ? d[2] : d[3])); \
                    pv += DPPF(pv, 0xB1); pv += DPPF(pv, 0x4E);                         \
                    dsel[T >> 2] = ((T & 3) == c4) ? pv : dsel[T >> 2]; } \
                  \
                ACT[k * 128 + 16 * c4 + r16] += dsel[0]; ACT[k * 128 + 16 * (c4 + 4) + r16] += dsel[1]; } while (0)
            P6_ULOAD(bfP, xP, 0);
#pragma unroll 1
            for (int n = 0; n < 8 * NT6; n += 2) {
                P6_ULOAD(bfQ, xQ2, n + 1); asm volatile("" ::: "memory"); __builtin_amdgcn_sched_barrier(0);
                P6_UMMA(bfP, xP, n); __builtin_amdgcn_sched_barrier(0);
                if (n + 2 < 8 * NT6) P6_ULOAD(bfP, xP, n + 2);
                asm volatile("" ::: "memory"); __builtin_amdgcn_sched_barrier(0);
                P6_UMMA(bfQ, xQ2, n + 1); __builtin_amdgcn_sched_barrier(0);
            }
#undef P6_ULOAD
#undef P6_UMMA
#undef P6_PK64
        }
        LDS_WAIT();
#pragma unroll 1
        for (int k = 0; k < NT6; ++k) {
#pragma unroll
            for (int sl = 0; sl < 2; ++sl) { const int e = lane + 64 * sl, pos = 16 * (e & 7) + (e >> 3); const float a = ACT[k * 128 + e] * (1.0f / 8192.0f);
                const float cfv = GC[k * 128 + pos] * gelu_exact(a);
                CQ[k * 128 + pos] = (unsigned char)(__builtin_amdgcn_cvt_pk_fp8_f32(cfv * 32.0f, 0.f, 0, false) & 0xff); } }
        LDS_WAIT();
#pragma unroll 1
        for (int k = 0; k < NT6; ++k) ACT[k * 64 + lane] = 0.f;
        LDS_WAIT();
#pragma unroll 1
        for (int rep_v = 0; rep_v < PROBE_V; ++rep_v) {
            for (int k = 0; k < NT6; ++k) ACT[k * 64 + lane] = 0.f;
            LDS_WAIT();
            u32x4 bfP[16], bfQ[16];
#define P6_LOADI(buf, TAB, nn) do { const int _j = (nn) / NT6, _k = (nn) % NT6; P6_LOADH(buf, TAB, _j, _k, 0); P6_LOADH((buf + 8), TAB, _j, _k, 1); } while (0)
            const int n16 = lane & 15, g4 = lane >> 4;
            const int ash = 8 * (n16 & 3); const bool ahi = (n16 & 4) != 0;
            const int c0 = 16 * (n16 & 7) + 4 * (g4 & 1);
            const bool fin = (n16 < 8) && (g4 < 2);
#define P6_LOADR2(hb, nn) do { const bf16_t* _hp = HB + (size_t)TOK6((nn) % NT6) * DM + 128 * ((nn) / NT6) + c0; hb[0] = *(const u32x2*)_hp; hb[1] = *(const u32x2*)(_hp + 8); } while (0)
#define P6_VBODY(buf, nn, hb) do { const int j = (nn) / NT6, k = (nn) % NT6; const int t = TOK6(k); \
                const u32x4 cqv = *(const LAS u32x4*)(CQ + k * 128 + 16 * q8); const unsigned cqw[4] = {cqv.x, cqv.y, cqv.z, cqv.w}; \
                f32x4 d0 = (f32x4){0.f, 0.f, 0.f, 0.f}, d1 = (f32x4){0.f, 0.f, 0.f, 0.f}; \
                _Pragma("unroll") for (int c = 0; c < 16; ++c) { const unsigned cb = (cqw[c >> 2] >> (8 * (c & 3))) & 0xffu; const unsigned tt = cb << ash; \
                    const long av = P6_PK64(ahi ? 0u : tt, ahi ? tt : 0u); \
                    d0 = __builtin_amdgcn_mfma_f32_16x16x32_fp8_fp8(av, P6_PK64(buf[c].x, buf[c].y), d0, 0, 0, 0); \
                    d1 = __builtin_amdgcn_mfma_f32_16x16x32_fp8_fp8(av, P6_PK64(buf[c].z, buf[c].w), d1, 0, 0, 0); } \
                float o[8]; \
                _Pragma("unroll") for (int r = 0; r < 4; ++r) { o[r] = d0[r] + __shfl_xor(d0[r], 40); o[4 + r] = d1[r] + __shfl_xor(d1[r], 40); } \
                const unsigned hw[4] = {hb[0].x, hb[0].y, hb[1].x, hb[1].y}; float ss = 0.f; \
                _Pragma("unroll") for (int r = 0; r < 8; ++r) { const float hv = (r & 1) ? bf_hi(hw[r >> 1]) : bf_lo(hw[r >> 1]); o[r] = o[r] * (1.0f / 1024.0f) + hv; ss += o[r] * o[r]; } \
                if (fin) { float* op = p.out + (size_t)t * DM + 128 * j + c0; *(f32x4*)op = (f32x4){o[0], o[1], o[2], o[3]}; *(f32x4*)(op + 8) = (f32x4){o[4], o[5], o[6], o[7]}; \
                    ACT[k * 64 + lane] += ss; } \
                } while (0)
#define P6_PK64(lo, hi) ((long)(((unsigned long long)(hi) << 32) | (unsigned long long)(lo)))
            P6_LOADI(bfP, VB, 0);
#pragma unroll 1
            for (int n = 0; n < 8 * NT6; n += 2) {
                u32x2 hr0[2], hr1[2]; P6_LOADR2(hr0, n); P6_LOADR2(hr1, n + 1);
                asm volatile("" ::: "memory");
                P6_LOADI(bfQ, VB, n + 1); asm volatile("" ::: "memory"); __builtin_amdgcn_sched_barrier(0);
                P6_VBODY(bfP, n, hr0); __builtin_amdgcn_sched_barrier(0);
                if (n + 2 < 8 * NT6) P6_LOADI(bfP, VB, n + 2);
                asm volatile("" ::: "memory"); __builtin_amdgcn_sched_barrier(0);
                P6_VBODY(bfQ, n + 1, hr1); __builtin_amdgcn_sched_barrier(0);
            }
            LDS_WAIT(); asm volatile("s_waitcnt vmcnt(0)" ::: "memory");
            f32x4 gfv[4];
#pragma unroll
            for (int i = 0; i < 4; ++i) gfv[i] = *(const f32x4*)(p.gfin + 256 * i + 4 * lane);
#pragma unroll 1
            for (int k = 0; k < NT6; ++k) { const float sst = wave_sum(ACT[k * 64 + lane]); const float rf = __builtin_amdgcn_rsqf(sst * (1.0f / DM) + EPS);
                float* op = p.out + (size_t)TOK6(k) * DM + 4 * lane; f32x4 ov[4];
#pragma unroll
                for (int i = 0; i < 4; ++i) ov[i] = *(const f32x4*)(op + 256 * i);
#pragma unroll
                for (int i = 0; i < 4; ++i) *(f32x4*)(op + 256 * i) = ov[i] * rf * gfv[i]; }
        }
        LDS_WAIT();
    }
#undef P6_LOADH
#undef P6_LOADX
#undef P6_LOADI
#undef P6_VBODY
#undef P6_LOADR2
#undef P6_PK64
#undef TOK6
}

#define XB_TMO      128
#define XB_XCNT(j)  (256  + 64 * (j))
#define XB_XSUB(j)  (1280 + 64 * (j))
#define XB_XGEN(j)  (2304 + 64 * (j))
#define XB_TOP      3328
#define XB_TOPGEN   3392
#define XCD_BAR_WORDS 3456
#define XB_SPIN_CAP (1u << 18)

__device__ __forceinline__ unsigned xb_ld(unsigned* p)              { return __hip_atomic_load(p, __ATOMIC_RELAXED, __HIP_MEMORY_SCOPE_AGENT); }
__device__ __forceinline__ unsigned xb_add(unsigned* p, unsigned v) { return __hip_atomic_fetch_add(p, v, __ATOMIC_RELAXED, __HIP_MEMORY_SCOPE_AGENT); }
__device__ __forceinline__ unsigned xb_xcc_id() { return (unsigned)__builtin_amdgcn_s_getreg((3 << 11) | 20) & 0xFu; }
#define XB_SPIN(cond, bar) do { unsigned _sp = 0; while (cond) { __builtin_amdgcn_s_sleep(1); \
    if ((++_sp & 255u) == 0u) { if (xb_ld(&(bar)[XB_TMO])) break; if (_sp > XB_SPIN_CAP) { atomicAdd(&(bar)[XB_TMO], 1u); break; } } } } while (0)

struct XcdBarrier {
    unsigned* bar; unsigned x;
    volatile LAS unsigned* st;
};

__device__ __forceinline__ XcdBarrier xcd_barrier_post(unsigned* bar, volatile LAS unsigned* st) {
    XcdBarrier b; b.bar = bar; b.x = xb_xcc_id(); b.st = st;
    if (threadIdx.x == 0) (void)xb_add(&bar[XB_XCNT(b.x)], 1u);
    return b;
}
__device__ __forceinline__ void xcd_barrier_complete(unsigned* bar, unsigned x, unsigned& nloc, unsigned& nx) {
    const unsigned G = gridDim.x * gridDim.y * gridDim.z;
    unsigned sum, cnt, mine, sp = 0u;
    for (;;) {
        sum = 0u; cnt = 0u; mine = 0u;
#pragma unroll
        for (unsigned j = 0; j < 16; ++j) { const unsigned c = xb_ld(&bar[XB_XCNT(j)]); sum += c; cnt += (c > 0u) ? 1u : 0u; mine = (j == x) ? c : mine; }
        if (sum == G) break;
        __builtin_amdgcn_s_sleep(1);
        if ((++sp & 255u) == 0u) { if (xb_ld(&bar[XB_TMO])) break; if (sp > XB_SPIN_CAP) { atomicAdd(&bar[XB_TMO], 1u); break; } }
    }
    nloc = mine > 0u ? mine : 1u; nx = cnt > 0u ? cnt : 1u;
}

__device__ __forceinline__ void xcd_barrier(const XcdBarrier& b) {
    asm volatile("s_waitcnt vmcnt(0)" ::: "memory");
    __syncthreads();
    if (threadIdx.x == 0) {
        unsigned* bar = b.bar;
        __builtin_amdgcn_s_waitcnt(0);
        unsigned nloc = b.st[0], nx = b.st[1];
        if (nloc == 0u) { xcd_barrier_complete(bar, b.x, nloc, nx); b.st[0] = nloc; b.st[1] = nx; }
        const unsigned old = xb_add(&bar[XB_XSUB(b.x)], 1u);
        const unsigned gen = old / nloc;
        if (old + 1u == (gen + 1u) * nloc) {
            __builtin_amdgcn_fence(__ATOMIC_RELEASE, "agent");
            asm volatile("s_waitcnt vmcnt(0)" ::: "memory");
            const unsigned og = xb_add(&bar[XB_TOP], 1u);
            const unsigned tg = og / nx;
            if (og + 1u == (tg + 1u) * nx) xb_add(&bar[XB_TOPGEN], 1u);
            else XB_SPIN(xb_ld(&bar[XB_TOPGEN]) == tg, bar);
            __builtin_amdgcn_fence(__ATOMIC_ACQUIRE, "agent");
            xb_add(&bar[XB_XGEN(b.x)], 1u);
            asm volatile("s_waitcnt vmcnt(0)" ::: "memory");
        } else {
            XB_SPIN(xb_ld(&bar[XB_XGEN(b.x)]) == gen, bar);
            __builtin_amdgcn_fence(__ATOMIC_ACQUIRE, "agent");
            asm volatile("s_waitcnt vmcnt(0)" ::: "memory");
        }
    }
    __syncthreads();
}

__global__ void __launch_bounds__(512, 2) mk_fwd(Params p) {
    extern __shared__ __attribute__((aligned(16))) unsigned char lds_raw[];
    LAS unsigned char* lds = (LAS unsigned char*)lds_raw;
    const int bid = blockIdx.x, nb = gridDim.x;
    unsigned char* ws = p.ws;
#define IN(k) (p.ph_lo <= (k) && (k) < p.ph_hi)
#define SEAM(k) do { if (IN(k) && IN((k) + 1)) { xcd_barrier(bar); } } while (0)
    if (threadIdx.x < 4) ((volatile LAS unsigned*)(lds + LDS_BYTES - 16))[threadIdx.x] = 0u;
    __syncthreads();
    const XcdBarrier bar = xcd_barrier_post((unsigned*)(ws + WS_CTL) + 4096, (volatile LAS unsigned*)(lds + LDS_BYTES - 16));
    if (IN(0)) phase0(p, lds, bid, nb);
    SEAM(0);
    if (IN(1)) {
        pg8::Gemm g{(const bf16_t*)(ws + WS_XN), (const bf16_t*)(ws + WS_WIN), MROWS, NP1, DM}; pg8::StaticOrder S; S.init(MROWS, NP1, nb, bid);
        EpiProj E{(bf16_t*)(ws + WS_PROJ), (bf16_t*)(ws + WS_QK), (float*)(ws + WS_LA), p.gb, (const float2*)(ws + WS_ROPE)};
        pg8::gemm_phase<EpiProj, pg8::StaticOrder, true, true>(lds, g, S, E);
    }
    SEAM(1);
    if (IN(2)) attn_pass<false>(p, lds, bid, nb);
    SEAM(2);
    if (IN(3)) attn_pass<true>(p, lds, bid, nb);
    SEAM(3);
    if (IN(4)) {
        pg8::Gemm g{(const bf16_t*)(ws + WS_O), (const bf16_t*)(ws + WS_WOUT), NTOK, DM, DM}; pg8::StaticOrder S; S.init(NTOK, DM, nb, bid);
        EpiRes E{p.x, (bf16_t*)(ws + WS_XN), (float*)(ws + WS_SSQ)};
        pg8::gemm_phase<EpiRes, pg8::StaticOrder, true, true>(lds, g, S, E);
    }
    SEAM(4);
    if (IN(5)) {
        pg8::Gemm g{(const bf16_t*)(ws + WS_XN), (const bf16_t*)(ws + WS_WS), NTOK, 2048, DM}; pg8::StaticOrder S; S.init(NTOK, 2048, nb, bid);
        EpiF16 E{(_Float16*)(ws + WS_PROJ)};
        pg8::gemm_phase<EpiF16, pg8::StaticOrder, true, true>(lds, g, S, E);
    }
    SEAM(5);
    if (IN(6)) phase_peer2(p, lds, bid, nb);
#undef IN
#undef SEAM
}

#ifndef MK_FUSED
#define MK_FUSED 1
#endif
extern "C" void kernel_launch(void* const* d_in, const int* in_sizes, int n_in, void* d_out, int out_size, void* d_ws, size_t ws_size, hipStream_t stream) {
    static int grid = 0;
    if (grid == 0) {
        if (n_in != 16 || in_sizes[0] != NTOK * DM || out_size != NTOK * DM || ws_size < WS_END) {
            fprintf(stderr, "kernel_launch: unexpected shapes (n_in %d, in0 %d, out %d, ws %zu); nothing launched\n", n_in, n_in > 0 ? in_sizes[0] : -1, out_size, ws_size); grid = -1; return; }
        int dev = 0, cus = 0, per_cu = 0;
        hipGetDevice(&dev); hipDeviceGetAttribute(&cus, hipDeviceAttributeMultiprocessorCount, dev);
        if (hipFuncSetAttribute((const void*)mk_fwd, hipFuncAttributeMaxDynamicSharedMemorySize, LDS_BYTES) != hipSuccess) { fprintf(stderr, "kernel_launch: hipFuncSetAttribute failed\n"); grid = -1; return; }
        if (hipOccupancyMaxActiveBlocksPerMultiprocessor(&per_cu, (const void*)mk_fwd, 512, LDS_BYTES) != hipSuccess || per_cu < 1) { fprintf(stderr, "kernel_launch: occupancy query failed (%d)\n", per_cu); (void)hipGetLastError(); per_cu = 1; }
        grid = cus * (per_cu < 1 ? 1 : 1);
        fprintf(stderr, "kernel_launch: %d CUs, occupancy %d/CU, grid %d\n", cus, per_cu, grid);
    }
    if (grid < 0) return;
    (void)hipMemsetAsync((char*)d_ws + WS_CTL, 0, 65536, stream);
    Params p{};
    p.x = (const float*)d_in[0]; p.meta = (const float*)d_in[1]; p.g1 = (const float*)d_in[2]; p.w_in = (const float*)d_in[3]; p.gw2 = (const float*)d_in[4]; p.gb = (const float*)d_in[5];
    p.gla_gain = (const float*)d_in[6]; p.ret_gain = (const float*)d_in[7]; p.ret_bias = (const float*)d_in[8]; p.w_out = (const float*)d_in[9]; p.g2 = (const float*)d_in[10];
    p.w_q = (const float*)d_in[11]; p.subkeys = (const float*)d_in[12]; p.pu = (const float*)d_in[13]; p.pv = (const float*)d_in[14]; p.gfin = (const float*)d_in[15];
    p.out = (float*)d_out; p.ws = (unsigned char*)d_ws;
#if MK_FUSED
    p.ph_lo = 0; p.ph_hi = NPHASE;
    void* args[] = {&p};
    hipError_t e = hipLaunchCooperativeKernel((const void*)mk_fwd, dim3(grid), dim3(512), args, LDS_BYTES, stream);
    if (e != hipSuccess) fprintf(stderr, "kernel_launch: cooperative launch failed: %s (grid %d)\n", hipGetErrorString(e), grid);
#else
    { const int order[7] = {0, 1, 2, 3, 4, 5, 6}; for (int i = 0; i < 7; ++i) { p.ph_lo = order[i]; p.ph_hi = order[i] + 1; hipLaunchKernelGGL(mk_fwd, dim3(grid), dim3(512), LDS_BYTES, stream, p); } }
#endif
}
```

```cpp
#include <hip/hip_runtime.h>
#include <hip/hip_cooperative_groups.h>
#include <cstdio>
#include <cstdint>
namespace cg = cooperative_groups;
namespace pg8 {
#define PG8_LAS __attribute__((address_space(3)))
typedef unsigned short bf16_t;
typedef short bf16x8 __attribute__((ext_vector_type(8)));
typedef float f32x4 __attribute__((ext_vector_type(4)));
typedef unsigned u32x4 __attribute__((ext_vector_type(4)));
constexpr int BM = 256, BK = 64, HALF = 128, HTB = HALF * BK * 2  , STAGE_BYTES = 8 * HTB, NXCD = 8, WGM = 8;

__host__ __device__ __forceinline__ int lds_byte(int r, int c) { const int st = (r >> 4) * 2 + (c >> 5), rr = r & 15, cc = c & 31, ob = rr * 64 + cc * 2; return st * 1024 + (ob ^ (((ob >> 9) & 1) << 5)); }
__host__ __device__ __forceinline__ void stage_rc(int b, int& R, int& C) { const int st = b / 1024, sb = b % 1024, swz = sb ^ (((sb >> 9) & 1) << 5); R = (st >> 1) * 16 + swz / 64; C = (st & 1) * 32 + (swz % 64) / 2; }
__host__ __device__ __forceinline__ int perm32(int rho) { const int n = rho >> 4, i = rho & 15; return 8 * (i >> 2) + 4 * n + (i & 3); }

struct Unit { int pm, pn; };
struct Gemm { const bf16_t* A; const bf16_t* Bt; int M, N, K; };

struct StaticOrder {
    int nM, nN, nwg, G, c;
    __host__ __device__ void init(int M, int N, int G_, int c_) { nM = M / BM; nN = N / BM; nwg = nM * nN; G = G_; c = c_; }
    __host__ __device__ bool next(int i, Unit& u) const {
        const long L = (long)i * G + c; if (L >= nwg) return false;
        int wgid = (int)L; { const int q = nwg / NXCD, r = nwg % NXCD, xcd = wgid % NXCD, off = wgid / NXCD; wgid = (xcd < r ? xcd * (q + 1) : r * (q + 1) + (xcd - r) * q) + off; }
        const int nig = WGM * nN, gid = wgid / nig, fm = gid * WGM, gsz = (nM - fm) < WGM ? (nM - fm) : WGM;
        u.pm = fm + ((wgid % nig) % gsz); u.pn = (wgid % nig) / gsz; return true;
    }
    __device__ __forceinline__ void a_ready(const Unit&) const {}
    __device__ __forceinline__ void done(const Unit&) const {}
};

__device__ __forceinline__ unsigned cvt_pk_bf16(float lo, float hi) { unsigned r; asm volatile("v_cvt_pk_bf16_f32 %0, %1, %2" : "=v"(r) : "v"(lo), "v"(hi)); return r; }
typedef float f32x2 __attribute__((ext_vector_type(2)));
template <class Epi, class Sched, bool ALIGN_EPI = false, bool SP2 = false>
__device__ __forceinline__ void gemm_phase(PG8_LAS unsigned char* lds, const Gemm g, const Sched& S, const Epi& E) {
    const int tid = threadIdx.x, wid = __builtin_amdgcn_readfirstlane(tid >> 6), lane = tid & 63, wr = wid >> 2, wc = wid & 3, fr = lane & 15, fq = lane >> 4;
    const int K = g.K, nt = K / BK;
    unsigned voffA[2], voffB[2];
#pragma unroll
    for (int i = 0; i < 2; ++i) { int R, C; stage_rc(tid * 16 + i * 8192, R, C); const int Rb = Epi::PERM ? ((R & ~31) + perm32(R & 31)) : R;
        voffA[i] = (unsigned)(R * K + C) * 2u; voffB[i] = (unsigned)(Rb * K + C) * 2u; }
    const size_t kstep = (size_t)(BK * 2);
    const size_t hstep = (size_t)HALF * K * 2;
    const size_t tstep = 2 * hstep;
    const unsigned ldsw = (unsigned)wid * 1024u;
    const int aoff = lds_byte(wr * 64 + fr, fq * 8), boff = lds_byte(wc * 32 + fr, fq * 8);
#define PG8_SA(b, h) (((b) * 2 + (h)) * HTB)
#define PG8_SB(b, h) ((4 + (b) * 2 + (h)) * HTB)
#define PG8_STAGE(bufoff, gbase, voff) do { _Pragma("unroll") for (int _i = 0; _i < 2; ++_i) \
        __builtin_amdgcn_global_load_lds((const unsigned*)((const char*)(gbase) + (voff)[_i]), (PG8_LAS unsigned*)(lds + (bufoff) + ldsw + _i * 8192), 16, 0, 0); } while (0)
#define PG8_LDA(dst, b, h) do { _Pragma("unroll") for (int m = 0; m < 4; ++m) _Pragma("unroll") for (int k = 0; k < 2; ++k) dst[m][k] = *(const PG8_LAS bf16x8*)(lds + PG8_SA(b, h) + aoff + m * 2048 + k * 1024); } while (0)
#define PG8_LDB(dst, b, h) do { _Pragma("unroll") for (int n = 0; n < 2; ++n) _Pragma("unroll") for (int k = 0; k < 2; ++k) dst[n][k] = *(const PG8_LAS bf16x8*)(lds + PG8_SB(b, h) + boff + n * 2048 + k * 1024); } while (0)
#define PG8_MMA(ai, bj, At, Bt) do { __builtin_amdgcn_s_setprio(1); _Pragma("unroll") for (int m = 0; m < 4; ++m) _Pragma("unroll") for (int n = 0; n < 2; ++n) _Pragma("unroll") for (int k = 0; k < 2; ++k) \
        acc[ai][bj][m][n] = __builtin_amdgcn_mfma_f32_16x16x32_bf16(Bt[n][k], At[m][k], acc[ai][bj][m][n], 0, 0, 0); __builtin_amdgcn_s_setprio(0); } while (0)
#define PG8_WAIT_V(n) asm volatile("s_waitcnt vmcnt(" #n ")" ::: "memory")
#define PG8_WAIT_L(n) asm volatile("s_waitcnt lgkmcnt(" #n ")" ::: "memory")
#define PG8_BAR __builtin_amdgcn_s_barrier()
#define PG8_SCHED __builtin_amdgcn_sched_barrier(0)
    Unit cur, nxt; int ui = 0;
    if (!S.next(0, cur)) return;
    f32x4 acc[2][2][4][2];
#pragma unroll
    for (int a = 0; a < 2; ++a)
#pragma unroll
        for (int b = 0; b < 2; ++b)
#pragma unroll
            for (int m = 0; m < 4; ++m)
#pragma unroll
                for (int n = 0; n < 2; ++n) acc[a][b][m][n] = (f32x4){0.f, 0.f, 0.f, 0.f};
    bf16x8 At[4][2], B0[2][2], B1[2][2];
    const char* cA = (const char*)g.A + (size_t)cur.pm * tstep; const char* cB = (const char*)g.Bt + (size_t)cur.pn * tstep;
    S.a_ready(cur);
    if constexpr (SP2) {
        PG8_STAGE(PG8_SB(0, 0), cB, voffB); PG8_STAGE(PG8_SB(0, 1), cB + hstep, voffB); PG8_STAGE(PG8_SA(0, 0), cA, voffA); PG8_STAGE(PG8_SA(0, 1), cA + hstep, voffA);
        if (wr == 1) PG8_BAR;
        PG8_WAIT_V(2); PG8_BAR;
        PG8_STAGE(PG8_SB(1, 0), cB + kstep, voffB); PG8_STAGE(PG8_SA(1, 0), cA + kstep, voffA); PG8_STAGE(PG8_SB(1, 1), cB + hstep + kstep, voffB);
        PG8_WAIT_V(6); PG8_BAR;
    } else {
        PG8_STAGE(PG8_SB(0, 0), cB, voffB); PG8_STAGE(PG8_SA(0, 0), cA, voffA); PG8_STAGE(PG8_SB(0, 1), cB + hstep, voffB); PG8_STAGE(PG8_SA(0, 1), cA + hstep, voffA);
        if (wr == 1) PG8_BAR;
        PG8_WAIT_V(4); PG8_BAR;
        PG8_STAGE(PG8_SB(1, 0), cB + kstep, voffB); PG8_STAGE(PG8_SA(1, 0), cA + kstep, voffA); PG8_STAGE(PG8_SB(1, 1), cB + hstep + kstep, voffB);
        PG8_WAIT_V(6); PG8_BAR;
    }
    for (;;) {
        const bool has_next = S.next(ui + 1, nxt);
        const char* nA = has_next ? (const char*)g.A + (size_t)nxt.pm * tstep : cA; const char* nB = has_next ? (const char*)g.Bt + (size_t)nxt.pn * tstep : cB;
        for (int t = 0; t < nt; t += 2) {
            const bool last = (t == nt - 2);
            const char* a1 = cA + (size_t)(t + 1) * kstep;
            const char* a2 = last ? nA : cA + (size_t)(t + 2) * kstep; const char* b2 = last ? nB : cB + (size_t)(t + 2) * kstep;
            const char* a3 = a2 + kstep; const char* b3 = b2 + kstep;
            if (last && has_next) S.a_ready(nxt);
            if constexpr (SP2) {
            PG8_LDB(B0, 0, 0); PG8_LDB(B1, 0, 1); PG8_SCHED; PG8_LDA(At, 0, 0); PG8_STAGE(PG8_SA(1, 1), a1 + hstep, voffA);
            PG8_WAIT_V(8); PG8_WAIT_L(0); PG8_BAR; PG8_MMA(0, 0, At, B0); PG8_MMA(0, 1, At, B1); PG8_BAR; PG8_SCHED;
            PG8_LDA(At, 0, 1); PG8_STAGE(PG8_SB(0, 0), b2, voffB); PG8_STAGE(PG8_SB(0, 1), b2 + hstep, voffB); PG8_STAGE(PG8_SA(0, 0), a2, voffA);
            PG8_WAIT_V(8); PG8_WAIT_L(0); PG8_BAR; PG8_MMA(1, 0, At, B0); PG8_MMA(1, 1, At, B1); PG8_BAR; PG8_SCHED;
            PG8_LDB(B0, 1, 0); PG8_LDB(B1, 1, 1); PG8_SCHED; PG8_LDA(At, 1, 0); PG8_STAGE(PG8_SA(0, 1), a2 + hstep, voffA);
            PG8_WAIT_V(8); PG8_WAIT_L(0); PG8_BAR; PG8_MMA(0, 0, At, B0); PG8_MMA(0, 1, At, B1); PG8_BAR; PG8_SCHED;
            PG8_LDA(At, 1, 1); PG8_STAGE(PG8_SB(1, 0), b3, voffB); PG8_STAGE(PG8_SB(1, 1), b3 + hstep, voffB); PG8_STAGE(PG8_SA(1, 0), a3, voffA);
            PG8_WAIT_V(8); PG8_WAIT_L(0); PG8_BAR; PG8_MMA(1, 0, At, B0); PG8_MMA(1, 1, At, B1); PG8_BAR; PG8_SCHED;
            } else {
            PG8_LDB(B0, 0, 0); PG8_SCHED; PG8_LDA(At, 0, 0); PG8_STAGE(PG8_SA(1, 1), a1 + hstep, voffA);
            PG8_WAIT_L(8); PG8_BAR; PG8_WAIT_L(0); PG8_MMA(0, 0, At, B0); PG8_BAR; PG8_SCHED;
            PG8_LDB(B1, 0, 1); PG8_STAGE(PG8_SB(0, 0), b2, voffB);
            PG8_BAR; PG8_WAIT_L(0); PG8_MMA(0, 1, At, B1); PG8_BAR;
            PG8_LDA(At, 0, 1); PG8_STAGE(PG8_SA(0, 0), a2, voffA);
            PG8_BAR; PG8_WAIT_L(0); PG8_MMA(1, 0, At, B0); PG8_BAR; PG8_SCHED;
            PG8_STAGE(PG8_SB(0, 1), b2 + hstep, voffB);
            PG8_WAIT_V(6); PG8_BAR; PG8_MMA(1, 1, At, B1); PG8_BAR;
            PG8_LDB(B0, 1, 0); PG8_SCHED; PG8_LDA(At, 1, 0); PG8_STAGE(PG8_SA(0, 1), a2 + hstep, voffA);
            PG8_WAIT_L(8); PG8_BAR; PG8_WAIT_L(0); PG8_MMA(0, 0, At, B0); PG8_BAR; PG8_SCHED;
            PG8_LDB(B1, 1, 1); PG8_STAGE(PG8_SB(1, 0), b3, voffB);
            PG8_BAR; PG8_WAIT_L(0); PG8_MMA(0, 1, At, B1); PG8_BAR;
            PG8_LDA(At, 1, 1); PG8_STAGE(PG8_SA(1, 0), a3, voffA);
            PG8_BAR; PG8_WAIT_L(0); PG8_MMA(1, 0, At, B0); PG8_BAR; PG8_SCHED;
            PG8_STAGE(PG8_SB(1, 1), b3 + hstep, voffB);
            PG8_WAIT_V(6); PG8_BAR; PG8_MMA(1, 1, At, B1); PG8_BAR;
            }
        }
        if constexpr (ALIGN_EPI) { if (wr == 0) PG8_BAR; }
        if constexpr (!Epi::AFTER_DRAIN) { E(acc, cur, wr, wc, fr, fq); S.done(cur); }
        if (!has_next) break;
#pragma unroll
        for (int a = 0; a < 2; ++a)
#pragma unroll
            for (int b = 0; b < 2; ++b)
#pragma unroll
                for (int m = 0; m < 4; ++m)
#pragma unroll
                    for (int n = 0; n < 2; ++n) acc[a][b][m][n] = (f32x4){0.f, 0.f, 0.f, 0.f};
        cur = nxt; cA = nA; cB = nB; ++ui;
        if constexpr (ALIGN_EPI) { if (wr == 1) PG8_BAR; }
    }
    PG8_WAIT_V(0);
    if constexpr (!ALIGN_EPI) { if (wr == 0) PG8_BAR; }
    PG8_BAR;
    if constexpr (Epi::AFTER_DRAIN) { E.fused(acc, cur, wr, wc, fr, fq, lds, wid, lane); S.done(cur); }
#undef PG8_SA
#undef PG8_SB
#undef PG8_STAGE
#undef PG8_LDA
#undef PG8_LDB
#undef PG8_MMA
#undef PG8_WAIT_V
#undef PG8_WAIT_L
#undef PG8_BAR
#undef PG8_SCHED
}
}

#define LAS __attribute__((address_space(3)))
typedef unsigned short bf16_t;
typedef float f32x4 __attribute__((ext_vector_type(4)));
typedef unsigned u32x4 __attribute__((ext_vector_type(4)));
typedef unsigned u32x2 __attribute__((ext_vector_type(2)));
typedef short bf16x8 __attribute__((ext_vector_type(8)));
typedef short s16x4 __attribute__((ext_vector_type(4)));
typedef __bf16 bf16x2_t __attribute__((ext_vector_type(2)));
typedef _Float16 f16x2_t __attribute__((ext_vector_type(2)));
typedef float f32x2v __attribute__((ext_vector_type(2)));
typedef _Float16 h2v __attribute__((ext_vector_type(2)));

constexpr int DM = 1024, NB = 4, SEQ = 8192, NTOK = NB * SEQ;
constexpr int MROWS = NTOK + 256;
constexpr int INW = 3088;
constexpr int NPROJ = 3072, NP1 = 3328;
constexpr int NEXP = 16384;
constexpr float EPS = 1e-6f;
constexpr int C_GQ = 0, C_GK = 256, C_GV = 512, C_GG = 1024, C_RQ = 1536, C_RK = 1792, C_RV = 2048, C_RG = 2560;
constexpr int S_GA = 1536, S_RQ = 1552, S_RV = 2064;

constexpr int NVG = 2048;
constexpr int NCH = (NTOK + 256) / 64;
constexpr size_t QK_ARR = (size_t)NCH * 4 * 8 * 64 * 8;
constexpr size_t MiB = 1u << 20;
constexpr size_t WS_CTL = 0, WS_WIN = 1 * MiB, WS_WOUT = 8 * MiB, WS_WS = 10 * MiB, WS_ROPE = 14 * MiB, WS_SSQ = 17 * MiB, WS_SEG = 19 * MiB, WS_ASEG = 27 * MiB,
                 WS_UB = 28 * MiB, WS_VB = 60 * MiB, WS_XN = 92 * MiB, WS_O = 157 * MiB, WS_LA = 221 * MiB, WS_PROJ = 254 * MiB, WS_QK = 383 * MiB, WS_XQ = 448 * MiB, WS_END = 480 * MiB;
static_assert(WS_WIN + (size_t)NP1 * DM * 2 <= WS_WOUT && WS_ROPE + (size_t)(SEQ + 64) * 32 * 8 <= WS_SSQ && WS_XN + (size_t)MROWS * DM * 2 <= WS_O &&
              WS_LA + QK_ARR * 4 <= WS_PROJ && WS_PROJ + (size_t)MROWS * NVG * 2 <= WS_QK && WS_QK + 4 * QK_ARR * 2 <= WS_XQ && WS_PROJ + (size_t)NTOK * 2048 * 2 <= WS_QK, "ws map");

constexpr int LDS_BYTES = 147456;
constexpr int NPHASE = 7;
#ifndef PROBE_R
#define PROBE_R 1
#define PROBE_U 1
#define PROBE_V 1
#endif
#ifndef PEER_FP8
#define PEER_FP8 1
#endif

struct Params {
    const float *x, *meta, *g1, *w_in, *gw2, *gb, *gla_gain, *ret_gain, *ret_bias, *w_out, *g2, *w_q, *subkeys, *pu, *pv, *gfin;
    float* out; unsigned char* ws;
    int ph_lo, ph_hi;
};

#define LDS_WAIT() asm volatile("s_waitcnt lgkmcnt(0)" ::: "memory")
__device__ __forceinline__ unsigned pk2(float lo, float hi) { const bf16x2_t v = {(__bf16)lo, (__bf16)hi}; return __builtin_bit_cast(unsigned, v); }
__device__ __forceinline__ unsigned f2bf(float f) { return (unsigned)__builtin_bit_cast(unsigned short, (__bf16)f); }

__device__ __forceinline__ float bf_lo(unsigned w) { return __builtin_bit_cast(float, w << 16); }
__device__ __forceinline__ float bf_hi(unsigned w) { return __builtin_bit_cast(float, w & 0xffff0000u); }
__device__ __forceinline__ float bf1(bf16_t h) { return __builtin_bit_cast(float, (unsigned)h << 16); }
__device__ __forceinline__ float wave_sum(float v) {
#pragma unroll
    for (int o = 1; o < 64; o <<= 1) v += __shfl_xor(v, o);
    return v;
}

struct MapIn {
    __device__ __forceinline__ void operator()(int j, int& src, float& sc) const {
        if (j < C_RQ) { src = j; sc = (j < 256) ? 0.125f : 1.0f; }
        else if (j < C_RV) { const int jj = j - C_RQ, which = jj >> 8, within = jj & 255, head = within >> 6, p = within & 63;
            const int a = p >> 3, n = (p >> 2) & 1, i = p & 3; src = S_RQ + which * 256 + head * 64 + 32 * n + 4 * a + i; sc = which ? 0.125f : 1.0f; }
        else { src = S_RV + (j - C_RV); sc = 1.0f; }
    }
};
struct MapId { __device__ __forceinline__ void operator()(int j, int& src, float& sc) const { src = j; sc = 1.0f; } };

template <class Map>
__device__ __forceinline__ void transpose_item(const float* W, int K, int N, bf16_t* WT, LAS float* scr, int item, int nblk, int lane, const Map map) {
    const int kb = item / nblk, nb = item % nblk, k0 = 64 * kb, n0 = 32 * nb;
    int src; float sc; map(n0 + (lane & 31), src, sc);
#pragma unroll 8
    for (int i = 0; i < 32; ++i) { const int kk = 2 * i + (lane >> 5); scr[kk * 33 + (lane & 31)] = W[(size_t)(k0 + kk) * N + src] * sc; }
    LDS_WAIT();
    const int c = lane & 7;
#pragma unroll
    for (int j = 0; j < 4; ++j) { const int n = (lane >> 3) + 8 * j; const LAS float* s = scr + (8 * c) * 33 + n;
        u32x4 o; o.x = pk2(s[0 * 33], s[1 * 33]); o.y = pk2(s[2 * 33], s[3 * 33]); o.z = pk2(s[4 * 33], s[5 * 33]); o.w = pk2(s[6 * 33], s[7 * 33]);
        *(u32x4*)(WT + (size_t)(n0 + n) * K + k0 + 8 * c) = o; }
    LDS_WAIT();
}

__device__ __forceinline__ void phase0(const Params& p, LAS unsigned char* lds, int bid, int nb) {
    const int tid = threadIdx.x, lane = tid & 63, wave = __builtin_amdgcn_readfirstlane(tid >> 6);
    unsigned char* ws = p.ws;
    bf16_t* XN = (bf16_t*)(ws + WS_XN); bf16_t* WinT = (bf16_t*)(ws + WS_WIN); bf16_t* WoutT = (bf16_t*)(ws + WS_WOUT); bf16_t* WsT = (bf16_t*)(ws + WS_WS);
    const int gw = bid * 8 + wave, NGW = nb * 8;
    const int gt = bid * 512 + tid, NGT = nb * 512;

    {
        LAS float* SKT = (LAS float*)lds;
        LAS float* WQT = (LAS float*)(lds + 128 * 132 * 4);
        for (int item = bid; item < 256; item += nb) {
            const int hc = item >> 4, kb = item & 15;
            __syncthreads();
            for (int e = tid; e < 128 * 128; e += 512) { const int n = e >> 7, d = e & 127; SKT[d * 132 + n] = p.subkeys[(size_t)hc * 16384 + e]; }
            for (int e = tid; e < 64 * 128; e += 512) { const int k = e >> 7, d = e & 127; WQT[d * 68 + k] = p.w_q[(size_t)(kb * 64 + k) * 2048 + hc * 128 + d]; }
            __syncthreads();
            const int tn = tid & 31, tk = tid >> 5;
            f32x4 acc[4];
#pragma unroll
            for (int i = 0; i < 4; ++i) acc[i] = (f32x4){0.f, 0.f, 0.f, 0.f};
#pragma unroll 4
            for (int d = 0; d < 128; ++d) {
                const f32x4 sk = *(const LAS f32x4*)(SKT + d * 132 + 4 * tn); const f32x4 wq = *(const LAS f32x4*)(WQT + d * 68 + 4 * tk);
#pragma unroll
                for (int i = 0; i < 4; ++i) acc[i] += sk[i] * wq;
            }
            const f32x4 gg = *(const f32x4*)(p.g2 + kb * 64 + 4 * tk);
#pragma unroll
            for (int i = 0; i < 4; ++i) { const f32x4 v = acc[i] * gg; u32x2 o; o.x = pk2(v[0], v[1]); o.y = pk2(v[2], v[3]);
                *(u32x2*)(WsT + (size_t)(hc * 128 + 4 * tn + i) * DM + kb * 64 + 4 * tk) = o; }
        }
        __syncthreads();
    }
    {
        LAS float* scr = (LAS float*)(lds + wave * 16384);
        constexpr int I_IN = (DM / 64) * (NPROJ / 32), I_OUT = (DM / 64) * (DM / 32);
        for (int it = gw; it < I_IN + I_OUT; it += NGW) {
            if (it < I_IN) transpose_item(p.w_in, DM, INW, WinT, scr, it, NPROJ / 32, lane, MapIn());
            else transpose_item(p.w_out, DM, DM, WoutT, scr, it - I_IN, DM / 32, lane, MapId());
        }
    }
    for (int e = gt; e < 256 * DM; e += NGT) {
        const int n = e >> 10, k = e & 1023; const float* wr = p.w_in + (size_t)k * INW + S_GA; float s = 0.f;
#pragma unroll
        for (int r = 0; r < 16; ++r) s += wr[r] * p.gw2[r * 256 + n];
        WinT[(size_t)(NPROJ + n) * DM + k] = (bf16_t)f2bf(s);
    }
#if PEER_FP8
    {
        u32x4* U8 = (u32x4*)(ws + WS_UB); u32x4* V8 = (u32x4*)(ws + WS_VB);
        for (int e = gt; e < NEXP * DM / 16; e += NGT) {
            const f32x4* us = (const f32x4*)p.pu + 4 * (size_t)e; const f32x4* vs = (const f32x4*)p.pv + 4 * (size_t)e;
            u32x4 wu, wv; unsigned tu[4], tv[4];
            const f32x4* g2s = (const f32x4*)p.g2 + 4 * (e & 63);
#pragma unroll
            for (int j = 0; j < 4; ++j) { const f32x4 a = us[j] * g2s[j] * 512.0f, b = vs[j] * 32.0f;
                int w = __builtin_amdgcn_cvt_pk_fp8_f32(a[0], a[1], 0, false); w = __builtin_amdgcn_cvt_pk_fp8_f32(a[2], a[3], w, true); tu[j] = (unsigned)w;
                int x = __builtin_amdgcn_cvt_pk_fp8_f32(b[0], b[1], 0, false); x = __builtin_amdgcn_cvt_pk_fp8_f32(b[2], b[3], x, true); tv[j] = (unsigned)x; }
            wu = (u32x4){tu[0], tu[1], tu[2], tu[3]}; wv = (u32x4){tv[0], tv[1], tv[2], tv[3]};
            const int row = e >> 6, c16 = e & 63;
            const size_t dst = ((size_t)(c16 >> 3) * NEXP + row) * 8 + (c16 & 7);
            U8[dst] = wu; V8[dst] = wv; }
    }
#else
    {
        u32x2* UB = (u32x2*)(ws + WS_UB); u32x2* VB = (u32x2*)(ws + WS_VB);
        const f32x4* u4 = (const f32x4*)p.pu; const f32x4* v4 = (const f32x4*)p.pv;
        for (int e = gt; e < NEXP * DM / 4; e += NGT) { const f32x4 a = u4[e]; u32x2 o; o.x = pk2(a[0], a[1]); o.y = pk2(a[2], a[3]); UB[e] = o;
            const f32x4 b = v4[e]; u32x2 q; q.x = pk2(b[0], b[1]); q.y = pk2(b[2], b[3]); VB[e] = q; }
    }
#endif
    {
        float2* rope = (float2*)(ws + WS_ROPE);
        for (int e = gt; e < (SEQ + 64) * 32; e += NGT) { const int pi = e >> 5, d = e & 31;
            const float invf = (float)pow(10000.0, -(double)d / 32.0); const float ang = (float)(pi - 48) * invf;
            rope[e] = make_float2((float)cos((double)ang), (float)sin((double)ang)); }
    }
    for (int m0 = gw; m0 < MROWS; m0 += 4 * NGW) {
        const float* srcp[4]; f32x4 v[4][4];
#pragma unroll
        for (int u = 0; u < 4; ++u) { const int m = m0 + u * NGW; srcp[u] = nullptr;
            if (m < MROWS) { if (m >= 256) srcp[u] = p.x + (size_t)(m - 256) * DM; else if (m >= 48 && m < 64) srcp[u] = p.meta + (size_t)(m - 48) * DM; }
            if (srcp[u] != nullptr) { const f32x4* xr = (const f32x4*)srcp[u] + lane;
#pragma unroll
                for (int j = 0; j < 4; ++j) v[u][j] = xr[64 * j]; }
            else {
#pragma unroll
                for (int j = 0; j < 4; ++j) v[u][j] = (f32x4){0.f, 0.f, 0.f, 0.f}; } }
        f32x4 gg[4];
#pragma unroll
        for (int j = 0; j < 4; ++j) gg[j] = ((const f32x4*)p.g1 + lane)[64 * j];
#pragma unroll
        for (int u = 0; u < 4; ++u) { const int m = m0 + u * NGW; if (m >= MROWS) continue;
            float s = 0.f;
#pragma unroll
            for (int j = 0; j < 4; ++j) s += (v[u][j].x * v[u][j].x + v[u][j].y * v[u][j].y) + (v[u][j].z * v[u][j].z + v[u][j].w * v[u][j].w);
            const float r = (srcp[u] != nullptr) ? __builtin_amdgcn_rsqf(wave_sum(s) * (1.0f / DM) + EPS) : 0.f;
            unsigned long long* o8 = (unsigned long long*)(XN + (size_t)m * DM) + lane;
#pragma unroll
            for (int j = 0; j < 4; ++j) { const f32x4 y = v[u][j] * r * gg[j]; o8[64 * j] = (unsigned long long)pk2(y.x, y.y) | ((unsigned long long)pk2(y.z, y.w) << 32); } }
    }
}

struct EpiProj {
    static constexpr bool PERM = true, AFTER_DRAIN = false;
    bf16_t* VG; bf16_t* QK; float* LAT; const float* gb; const float2* rope;
    __device__ __forceinline__ static size_t tile_off(int r, int head, int dg) { return ((((size_t)(r >> 6) * 4 + head) * 8 + dg) * 64 + (r & 63)) * 8; }
    __device__ __forceinline__ void operator()(const pg8::f32x4 (&acc)[2][2][4][2], const pg8::Unit& u, int wr, int wc, int fr, int fq) const {
        const int row0 = u.pm * 256 + wr * 64 + fr, cb0 = wc * 32 + 8 * fq;
        if (u.pn == 12) {
#pragma unroll
            for (int bj = 0; bj < 2; ++bj) { const int c = cb0 + 128 * bj; const f32x4 b0 = *(const f32x4*)(gb + c), b1 = *(const f32x4*)(gb + c + 4);
#pragma unroll
                for (int ai = 0; ai < 2; ++ai)
#pragma unroll
                    for (int m = 0; m < 4; ++m) { const int row = row0 + ai * 128 + m * 16; f32x4 v0 = acc[ai][bj][m][0] + b0, v1 = acc[ai][bj][m][1] + b1;
#pragma unroll
                        for (int i = 0; i < 4; ++i) { v0[i] = (fminf(v0[i], 0.f) - __logf(1.0f + __expf(-fabsf(v0[i])))) * 0.0625f; v1[i] = (fminf(v1[i], 0.f) - __logf(1.0f + __expf(-fabsf(v1[i])))) * 0.0625f; }
                        float* o = LAT + tile_off(row, c >> 6, (c & 63) >> 3); *(f32x4*)o = v0; *(f32x4*)(o + 4) = v1; } }
        } else if (u.pn == 6 || u.pn == 7) {
            bf16_t* QA = QK + (size_t)(u.pn - 4) * QK_ARR;
#pragma unroll
            for (int ai = 0; ai < 2; ++ai)
#pragma unroll
                for (int m = 0; m < 4; ++m) { const int row = row0 + ai * 128 + m * 16; const int pidx = (row < 256) ? row : 64 + ((row - 256) & (SEQ - 1));
#pragma unroll
                    for (int bj = 0; bj < 2; ++bj) { const int c = cb0 + 128 * bj, d0 = (c & 63) >> 1;
                        const f32x4 cs0 = *(const f32x4*)(rope + (size_t)pidx * 32 + d0), cs1 = *(const f32x4*)(rope + (size_t)pidx * 32 + d0 + 2);
                        const f32x4 t1 = acc[ai][bj][m][0], t2 = acc[ai][bj][m][1];
                        const float co[4] = {cs0[0], cs0[2], cs1[0], cs1[2]}, si[4] = {cs0[1], cs0[3], cs1[1], cs1[3]};
                        float o1[4], o2[4];
#pragma unroll
                        for (int i = 0; i < 4; ++i) { o1[i] = t1[i] * co[i] - t2[i] * si[i]; o2[i] = t1[i] * si[i] + t2[i] * co[i]; }
                        u32x4 w; w.x = pg8::cvt_pk_bf16(o1[0], o1[1]); w.y = pg8::cvt_pk_bf16(o1[2], o1[3]); w.z = pg8::cvt_pk_bf16(o2[0], o2[1]); w.w = pg8::cvt_pk_bf16(o2[2], o2[3]);
                        *(u32x4*)(QA + tile_off(row, c >> 6, (c & 63) >> 3)) = w; } }
        } else if (u.pn <= 1) {
            bf16_t* QA = QK + (size_t)u.pn * QK_ARR;
#pragma unroll
            for (int ai = 0; ai < 2; ++ai)
#pragma unroll
                for (int m = 0; m < 4; ++m) { const int row = row0 + ai * 128 + m * 16;
#pragma unroll
                    for (int bj = 0; bj < 2; ++bj) { const int c = cb0 + 128 * bj; const f32x4 v0 = acc[ai][bj][m][0], v1 = acc[ai][bj][m][1];
                        u32x4 w; w.x = pg8::cvt_pk_bf16(v0[0], v0[1]); w.y = pg8::cvt_pk_bf16(v0[2], v0[3]); w.z = pg8::cvt_pk_bf16(v1[0], v1[1]); w.w = pg8::cvt_pk_bf16(v1[2], v1[3]);
                        *(u32x4*)(QA + tile_off(row, c >> 6, (c & 63) >> 3)) = w; } }
        } else {
            const int cdst = (u.pn < 6 ? (u.pn - 2) : (u.pn - 4)) * 256;
#pragma unroll
            for (int ai = 0; ai < 2; ++ai)
#pragma unroll
                for (int m = 0; m < 4; ++m) { bf16_t* rowp = VG + (size_t)(row0 + ai * 128 + m * 16) * NVG + cdst + cb0;
#pragma unroll
                    for (int bj = 0; bj < 2; ++bj) { const f32x4 v0 = acc[ai][bj][m][0], v1 = acc[ai][bj][m][1];
                        u32x4 w; w.x = pg8::cvt_pk_bf16(v0[0], v0[1]); w.y = pg8::cvt_pk_bf16(v0[2], v0[3]); w.z = pg8::cvt_pk_bf16(v1[0], v1[1]); w.w = pg8::cvt_pk_bf16(v1[2], v1[3]);
                        *(u32x4*)(rowp + bj * 128) = w; } }
        }
    }
};
struct EpiRes {
    static constexpr bool PERM = true, AFTER_DRAIN = false;
    const float* x; bf16_t* HB; float* SSQ;
    __device__ __forceinline__ void operator()(const pg8::f32x4 (&acc)[2][2][4][2], const pg8::Unit& u, int wr, int wc, int fr, int fq) const {
        const int row0 = u.pm * 256 + wr * 64 + fr, col0 = u.pn * 256 + wc * 32 + 8 * fq;
#pragma unroll
        for (int ai = 0; ai < 2; ++ai)
#pragma unroll
            for (int m = 0; m < 4; ++m) { const int row = row0 + ai * 128 + m * 16; const float* xr = x + (size_t)row * DM + col0; bf16_t* hr = HB + (size_t)row * DM + col0; float ss = 0.f;
#pragma unroll
                for (int bj = 0; bj < 2; ++bj) { const f32x4 v0 = acc[ai][bj][m][0] + *(const f32x4*)(xr + bj * 128), v1 = acc[ai][bj][m][1] + *(const f32x4*)(xr + bj * 128 + 4);
                    ss += (v0[0] * v0[0] + v0[1] * v0[1]) + (v0[2] * v0[2] + v0[3] * v0[3]) + (v1[0] * v1[0] + v1[1] * v1[1]) + (v1[2] * v1[2] + v1[3] * v1[3]);
                    u32x4 w; w.x = pg8::cvt_pk_bf16(v0[0], v0[1]); w.y = pg8::cvt_pk_bf16(v0[2], v0[3]); w.z = pg8::cvt_pk_bf16(v1[0], v1[1]); w.w = pg8::cvt_pk_bf16(v1[2], v1[3]);
                    *(u32x4*)(hr + bj * 128) = w; }
                ss += __shfl_xor(ss, 16); ss += __shfl_xor(ss, 32);
                if (fq == 0) SSQ[(size_t)row * 16 + u.pn * 4 + wc] = ss; }
    }
};
struct EpiF16 {
    static constexpr bool PERM = true, AFTER_DRAIN = false;
    _Float16* SC;
    __device__ __forceinline__ void operator()(const pg8::f32x4 (&acc)[2][2][4][2], const pg8::Unit& u, int wr, int wc, int fr, int fq) const {
        const int row0 = u.pm * 256 + wr * 64 + fr, col0 = u.pn * 256 + wc * 32 + 8 * fq;
#pragma unroll
        for (int ai = 0; ai < 2; ++ai)
#pragma unroll
            for (int m = 0; m < 4; ++m) { _Float16* rowp = SC + (size_t)(row0 + ai * 128 + m * 16) * 2048 + col0;
#pragma unroll
                for (int bj = 0; bj < 2; ++bj) { const f32x4 v0 = acc[ai][bj][m][0], v1 = acc[ai][bj][m][1];
                    u32x4 w;
                    w.x = __builtin_bit_cast(unsigned, (f16x2_t){(_Float16)v0[0], (_Float16)v0[1]}); w.y = __builtin_bit_cast(unsigned, (f16x2_t){(_Float16)v0[2], (_Float16)v0[3]});
                    w.z = __builtin_bit_cast(unsigned, (f16x2_t){(_Float16)v1[0], (_Float16)v1[1]}); w.w = __builtin_bit_cast(unsigned, (f16x2_t){(_Float16)v1[2], (_Float16)v1[3]});
                    *(u32x4*)(rowp + bj * 128) = w; } }
    }
};

constexpr int A_QT = 0, A_KT = 9216, A_KE = 18432, A_V = 27648, A_ST = 45056, A_STSZ = 18432, A_OB = 81920, A_DEC = 115712, A_CS = 115968;
constexpr int PQ = 72, PV = 136, POB = 132;

__device__ __forceinline__ bf16x8 tr2(const LAS bf16_t* p0, const LAS bf16_t* p1) {
    const s16x4 a = __builtin_amdgcn_ds_read_tr16_b64_v4i16((LAS s16x4*)p0), b = __builtin_amdgcn_ds_read_tr16_b64_v4i16((LAS s16x4*)p1);
    return (bf16x8){a[0], a[1], a[2], a[3], b[0], b[1], b[2], b[3]};
}
__device__ __forceinline__ float ln_gamma(int hr) { return log1pf(-exp2f(-5.0f - (float)hr)); }

template <bool FULL>
__device__ __forceinline__ void attn_pass(const Params& p, LAS unsigned char* lds, int bid, int nb) {
    const int tid = threadIdx.x, lane = tid & 63, wave = __builtin_amdgcn_readfirstlane(tid >> 6);
    const int r16 = lane & 15, g4 = lane >> 4, q4 = (lane & 15) >> 2, p4 = lane & 3;
    unsigned char* ws = p.ws;
    const bf16_t* PROJ = (const bf16_t*)(ws + WS_PROJ); const float* LA = (const float*)(ws + WS_LA); const bf16_t* QK = (const bf16_t*)(ws + WS_QK);
    float* SEG = (float*)(ws + WS_SEG); float* ASEG = (float*)(ws + WS_ASEG); float* SEGM = (float*)(ws + WS_ASEG + 65536); bf16_t* OUT = (bf16_t*)(ws + WS_O);
    LAS bf16_t* QT = (LAS bf16_t*)(lds + A_QT); LAS bf16_t* KT = (LAS bf16_t*)(lds + A_KT); LAS bf16_t* KE = (LAS bf16_t*)(lds + A_KE); LAS bf16_t* VS = (LAS bf16_t*)(lds + A_V);
    LAS float* OB = (LAS float*)(lds + A_OB); LAS float* DEC = (LAS float*)(lds + A_DEC); LAS float* CS = (LAS float*)(lds + A_CS);

    for (int item = bid; item < 256; item += nb) {
        const int seg = item & 7, h8 = (item >> 3) & 7, b = item >> 6;
        const bool metaitem = !FULL && seg == 7 && b == 0;
        if (!FULL && seg == 7 && !metaitem) continue;
        const bool gla = h8 < 4; const int hr = h8 & 3;
        const float lng = ln_gamma(hr);
        const bf16_t* QAq = QK + (size_t)(gla ? 0 : 2) * QK_ARR; const bf16_t* QAk = QK + (size_t)(gla ? 1 : 3) * QK_ARR;
        const int vcol = (gla ? 0 : 1024) + hr * 128, gcol = (gla ? 512 : 1536) + hr * 128;
        const int nch = metaitem ? 1 : 16;

        f32x4 accS[8];
#pragma unroll
        for (int cb = 0; cb < 8; ++cb) accS[cb] = (f32x4){0.f, 0.f, 0.f, 0.f};
        float blsum[8] = {0.f, 0.f, 0.f, 0.f, 0.f, 0.f, 0.f, 0.f};
        __syncthreads();
        if (FULL) {
            if (wave >= 4) {
                const int wq = wave - 4;
                { const float* Sm = SEGM + (size_t)h8 * 8192;
#pragma unroll
                  for (int cb = 0; cb < 8; ++cb)
#pragma unroll
                      for (int rg = 0; rg < 4; ++rg) accS[cb][rg] = Sm[(16 * wq + 4 * g4 + rg) * 128 + 16 * cb + r16]; }
                for (int sp = 0; sp < seg; ++sp) { const int it2 = (item & ~7) + sp; const float* Sg = SEG + (size_t)it2 * 8192; const float* Ag = ASEG + it2 * 64;
                    float dec[4];
#pragma unroll
                    for (int rg = 0; rg < 4; ++rg) dec[rg] = Ag[16 * wq + 4 * g4 + rg];
#pragma unroll
                    for (int cb = 0; cb < 8; ++cb)
#pragma unroll
                        for (int rg = 0; rg < 4; ++rg) accS[cb][rg] = dec[rg] * accS[cb][rg] + Sg[(16 * wq + 4 * g4 + rg) * 128 + 16 * cb + r16]; }
                LAS bf16_t* ST0 = (LAS bf16_t*)(lds + A_ST);
#pragma unroll
                for (int cb = 0; cb < 8; ++cb) { u32x2 w; w.x = pk2(accS[cb][0], accS[cb][1]); w.y = pk2(accS[cb][2], accS[cb][3]); *(LAS u32x2*)(ST0 + (16 * cb + r16) * PQ + 16 * wq + 4 * g4) = w; }
            }
        }
#define A_ROWBASE(ci_) (metaitem ? 0 : 256 + b * SEQ + (16 * seg + (ci_)) * 64)
        f32x4 lav[2]; u32x4 qv8, kv8; u32x4 vreg[2];
        qv8 = (u32x4){0u, 0u, 0u, 0u};
#define A_LOADCHUNK(ci_) do { const int _rb = A_ROWBASE(ci_); \
            const size_t _to = ((((size_t)(_rb >> 6) * 4 + hr) * 8 + wave) * 64 + lane) * 8;       \
            if (gla) { const f32x4* _lp = (const f32x4*)(LA + _to); lav[0] = _lp[0]; lav[1] = _lp[1]; } \
            else { lav[0] = (f32x4){lng, lng, lng, lng}; lav[1] = lav[0]; } \
            if (FULL) qv8 = *(const u32x4*)(QAq + _to); \
            kv8 = *(const u32x4*)(QAk + _to); \
            { const int vr = tid >> 3, cc = tid & 7; const u32x4* src = (const u32x4*)(PROJ + (size_t)(_rb + vr) * NVG + vcol + cc * 16); vreg[0] = src[0]; vreg[1] = src[1]; } } while (0)
#define A_LBAR() do { asm volatile("s_waitcnt lgkmcnt(0)" ::: "memory"); __builtin_amdgcn_s_barrier(); asm volatile("" ::: "memory"); } while (0)
        A_LOADCHUNK(0);
        f32x4 gnv[4], bsv[4];
        { const float* gptr = (gla ? p.gla_gain : p.ret_gain) + 16 * (tid & 7); const float* bptr = p.ret_bias + 16 * (tid & 7); const float bsc = gla ? 0.f : 1.f;
#pragma unroll
          for (int k4 = 0; k4 < 4; ++k4) { gnv[k4] = *(const f32x4*)(gptr + 4 * k4); bsv[k4] = *(const f32x4*)(bptr + 4 * k4) * bsc; } }
        for (int ci = 0; ci < nch; ++ci) {
            const bool metac = metaitem;
            const int rowbase = A_ROWBASE(ci);
            const LAS bf16_t* STr = (const LAS bf16_t*)(lds + A_ST + (ci & 1) * A_STSZ); LAS bf16_t* STw = (LAS bf16_t*)(lds + A_ST + ((ci + 1) & 1) * A_STSZ);
            u32x4 gpre[2] = {(u32x4){0u, 0u, 0u, 0u}, (u32x4){0u, 0u, 0u, 0u}};
            if (FULL && !metac) { const u32x4* gp = (const u32x4*)(PROJ + (size_t)(rowbase + (tid >> 3)) * NVG + gcol + 16 * (tid & 7)); gpre[0] = gp[0]; gpre[1] = gp[1]; }
            {
                float bc[8];
#pragma unroll
                for (int c = 0; c < 8; ++c) { float v = lav[c >> 2][c & 3];
                    v += __builtin_bit_cast(float, __builtin_amdgcn_update_dpp(0, __builtin_bit_cast(int, v), 0x111, 0xf, 0xf, true));
                    v += __builtin_bit_cast(float, __builtin_amdgcn_update_dpp(0, __builtin_bit_cast(int, v), 0x112, 0xf, 0xf, true));
                    v += __builtin_bit_cast(float, __builtin_amdgcn_update_dpp(0, __builtin_bit_cast(int, v), 0x114, 0xf, 0xf, true));
                    v += __builtin_bit_cast(float, __builtin_amdgcn_update_dpp(0, __builtin_bit_cast(int, v), 0x118, 0xf, 0xf, true));
                    v += __builtin_bit_cast(float, __builtin_amdgcn_update_dpp(0, __builtin_bit_cast(int, v), 0x142, 0xa, 0xf, false));
                    v += __builtin_bit_cast(float, __builtin_amdgcn_update_dpp(0, __builtin_bit_cast(int, v), 0x143, 0xc, 0xf, false));
                    bc[c] = v; }
                float tot[8];
#pragma unroll
                for (int c = 0; c < 8; ++c) { tot[c] = __builtin_bit_cast(float, __builtin_amdgcn_readlane(__builtin_bit_cast(int, bc[c]), 63)); blsum[c] += tot[c]; }
                const unsigned qw[4] = {qv8.x, qv8.y, qv8.z, qv8.w}, kw[4] = {kv8.x, kv8.y, kv8.z, kv8.w};
                unsigned oq[4], ok[4], oe[4];
#pragma unroll
                for (int c2 = 0; c2 < 4; ++c2) { const float k0 = bf_lo(kw[c2]), k1 = bf_hi(kw[c2]);
                    if (FULL) { oq[c2] = pk2(bf_lo(qw[c2]) * __expf(bc[2 * c2]), bf_hi(qw[c2]) * __expf(bc[2 * c2 + 1])); ok[c2] = pk2(k0 * __expf(-bc[2 * c2]), k1 * __expf(-bc[2 * c2 + 1])); }
                    oe[c2] = pk2(k0 * __expf(tot[2 * c2] - bc[2 * c2]), k1 * __expf(tot[2 * c2 + 1] - bc[2 * c2 + 1])); }
                if (FULL) { *(LAS u32x4*)(QT + lane * PQ + 8 * wave) = (u32x4){oq[0], oq[1], oq[2], oq[3]}; *(LAS u32x4*)(KT + lane * PQ + 8 * wave) = (u32x4){ok[0], ok[1], ok[2], ok[3]}; }
                *(LAS u32x4*)(KE + lane * PQ + 8 * wave) = (u32x4){oe[0], oe[1], oe[2], oe[3]};
                if (lane == 63) { *(LAS f32x4*)(DEC + 8 * wave) = (f32x4){__expf(tot[0]), __expf(tot[1]), __expf(tot[2]), __expf(tot[3])};
                                  *(LAS f32x4*)(DEC + 8 * wave + 4) = (f32x4){__expf(tot[4]), __expf(tot[5]), __expf(tot[6]), __expf(tot[7])}; }
                const int vr = tid >> 3, cc = tid & 7; LAS u32x4* dst = (LAS u32x4*)(VS + vr * PV + cc * 16); dst[0] = vreg[0]; dst[1] = vreg[1];
            }
            if (ci + 1 < nch) A_LOADCHUNK(ci + 1);
            A_LBAR();
            if (wave < 4) {
                if (FULL && !metac) {
                    const int w = wave;
                    bf16x8 qf[2];
#pragma unroll
                    for (int s = 0; s < 2; ++s) qf[s] = *(const LAS bf16x8*)(QT + (16 * w + r16) * PQ + 32 * s + 8 * g4);
                    f32x4 att[4];
#pragma unroll
                    for (int jb = 0; jb < 4; ++jb) { att[jb] = (f32x4){0.f, 0.f, 0.f, 0.f};
                        if (jb <= w) {
#pragma unroll
                            for (int s = 0; s < 2; ++s) { const bf16x8 kf = *(const LAS bf16x8*)(KT + (16 * jb + r16) * PQ + 32 * s + 8 * g4);
                                att[jb] = __builtin_amdgcn_mfma_f32_16x16x32_bf16(kf, qf[s], att[jb], 0, 0, 0); }
                            if (jb == w) {
#pragma unroll
                                for (int rg = 0; rg < 4; ++rg) att[jb][rg] = (4 * g4 + rg <= r16) ? att[jb][rg] : 0.f;
                            }
                        } }
                    bf16x8 af[2];
#pragma unroll
                    for (int s = 0; s < 2; ++s) { u32x4 t; t.x = pk2(att[2 * s][0], att[2 * s][1]); t.y = pk2(att[2 * s][2], att[2 * s][3]); t.z = pk2(att[2 * s + 1][0], att[2 * s + 1][1]); t.w = pk2(att[2 * s + 1][2], att[2 * s + 1][3]);
                        af[s] = __builtin_bit_cast(bf16x8, t); }
#pragma unroll
                    for (int cb = 0; cb < 8; ++cb) { f32x4 o = (f32x4){0.f, 0.f, 0.f, 0.f};
#pragma unroll
                        for (int s = 0; s < 2; ++s) {
                            const bf16x8 vf = tr2(VS + (32 * s + 4 * g4 + q4) * PV + 16 * cb + 4 * p4, VS + (32 * s + 16 + 4 * g4 + q4) * PV + 16 * cb + 4 * p4);
                            o = __builtin_amdgcn_mfma_f32_16x16x32_bf16(af[s], vf, o, 0, 0, 0);
                            const bf16x8 sf = *(const LAS bf16x8*)(STr + (16 * cb + r16) * PQ + 32 * s + 8 * g4);
                            o = __builtin_amdgcn_mfma_f32_16x16x32_bf16(qf[s], sf, o, 0, 0, 0); }
#pragma unroll
                        for (int rg = 0; rg < 4; ++rg) OB[(16 * w + 4 * g4 + rg) * POB + 16 * cb + r16] = o[rg]; }
                }
            } else {
                const int wq = wave - 4;
                float dec[4];
#pragma unroll
                for (int rg = 0; rg < 4; ++rg) dec[rg] = DEC[16 * wq + 4 * g4 + rg];
                bf16x8 kef[2];
#pragma unroll
                for (int s = 0; s < 2; ++s) kef[s] = tr2(KE + (32 * s + 8 * g4 + q4) * PQ + 16 * wq + 4 * p4, KE + (32 * s + 8 * g4 + 4 + q4) * PQ + 16 * wq + 4 * p4);
#pragma unroll
                for (int cb = 0; cb < 8; ++cb) {
#pragma unroll
                    for (int rg = 0; rg < 4; ++rg) accS[cb][rg] *= dec[rg];
#pragma unroll
                    for (int s = 0; s < 2; ++s) { const bf16x8 vf = tr2(VS + (32 * s + 8 * g4 + q4) * PV + 16 * cb + 4 * p4, VS + (32 * s + 8 * g4 + 4 + q4) * PV + 16 * cb + 4 * p4);
                        accS[cb] = __builtin_amdgcn_mfma_f32_16x16x32_bf16(kef[s], vf, accS[cb], 0, 0, 0); }
                    if (FULL) { u32x2 w; w.x = pk2(accS[cb][0], accS[cb][1]); w.y = pk2(accS[cb][2], accS[cb][3]); *(LAS u32x2*)(STw + (16 * cb + r16) * PQ + 16 * wq + 4 * g4) = w; }
                }
            }
            A_LBAR();
            if (FULL && !metac) {
                const int i = tid >> 3, cc = tid & 7;
                float o[16];
#pragma unroll
                for (int k4 = 0; k4 < 4; ++k4) { const f32x4 t = *(const LAS f32x4*)(OB + i * POB + 16 * cc + 4 * k4); o[4 * k4] = t[0]; o[4 * k4 + 1] = t[1]; o[4 * k4 + 2] = t[2]; o[4 * k4 + 3] = t[3]; }
                const size_t row = (size_t)(rowbase + i);
                const u32x4 ga = gpre[0], gb2 = gpre[1];
                const unsigned gw[8] = {ga.x, ga.y, ga.z, ga.w, gb2.x, gb2.y, gb2.z, gb2.w};
                float s1 = 0.f, s2 = 0.f;
#pragma unroll
                for (int k = 0; k < 16; ++k) { s1 += o[k]; s2 += o[k] * o[k]; }
#pragma unroll
                for (int m = 1; m < 8; m <<= 1) { s1 += __shfl_xor(s1, m); s2 += __shfl_xor(s2, m); }
                const float mu = gla ? 0.f : s1 * (1.0f / 128.0f);
                const float rs = __builtin_amdgcn_rsqf(fmaxf(s2 * (1.0f / 128.0f) - mu * mu, 0.f) + EPS);
                unsigned ow[8];
#pragma unroll
                for (int k2 = 0; k2 < 8; ++k2) { float y[2];
#pragma unroll
                    for (int e = 0; e < 2; ++e) { const int k = 2 * k2 + e; const float v = (o[k] - mu) * rs * gnv[k >> 2][k & 3] + bsv[k >> 2][k & 3];
                        const float gt = e ? bf_hi(gw[k2]) : bf_lo(gw[k2]); y[e] = v * gt * __builtin_amdgcn_rcpf(1.0f + __expf(-gt)); }
                    ow[k2] = pk2(y[0], y[1]); }
                u32x4* op = (u32x4*)(OUT + (row - 256) * DM + h8 * 128 + 16 * cc);
                op[0] = (u32x4){ow[0], ow[1], ow[2], ow[3]}; op[1] = (u32x4){ow[4], ow[5], ow[6], ow[7]};
            }
        }
        if (!FULL) {
            if (wave >= 4) { const int wq = wave - 4; float* Sg = metaitem ? SEGM + (size_t)h8 * 8192 : SEG + (size_t)item * 8192;
#pragma unroll
                for (int cb = 0; cb < 8; ++cb)
#pragma unroll
                    for (int rg = 0; rg < 4; ++rg) Sg[(16 * wq + 4 * g4 + rg) * 128 + 16 * cb + r16] = accS[cb][rg]; }
            if (lane < 8 && !metaitem) { float bl = blsum[0];
#pragma unroll
                for (int c = 1; c < 8; ++c) bl = (lane == c) ? blsum[c] : bl;
                ASEG[item * 64 + 8 * wave + lane] = __expf(bl); }
        }
#undef A_LBAR
#undef A_ROWBASE
#undef A_LOADCHUNK
    }
}

__device__ __forceinline__ unsigned ord32(float f) { const unsigned b = __builtin_bit_cast(unsigned, f); return b ^ ((b >> 31) ? 0xffffffffu : 0x80000000u); }
__device__ __forceinline__ float unord32(unsigned o) { const unsigned b = (o >> 31) ? (o ^ 0x80000000u) : ~o; return __builtin_bit_cast(float, b); }
#define DPP_MAXU(v, ctrl, rmask) do { const unsigned _t = (unsigned)__builtin_amdgcn_update_dpp((int)(v), (int)(v), (ctrl), (rmask), 0xf, false); (v) = (v) > _t ? (v) : _t; } while (0)
#define DPP_ADDF(v, ctrl) do { const float _t = __builtin_bit_cast(float, __builtin_amdgcn_update_dpp(0, __builtin_bit_cast(int, (v)), (ctrl), 0xf, 0xf, false)); (v) += _t; } while (0)
__device__ __forceinline__ unsigned row_max_u(unsigned v) { DPP_MAXU(v, 0xB1, 0xf); DPP_MAXU(v, 0x4E, 0xf); DPP_MAXU(v, 0x124, 0xf); DPP_MAXU(v, 0x128, 0xf); return v; }
__device__ __forceinline__ float row_sum_f(float v) { DPP_ADDF(v, 0xB1); DPP_ADDF(v, 0x4E); DPP_ADDF(v, 0x124); DPP_ADDF(v, 0x128); return v; }
__device__ __forceinline__ unsigned wave_max_u(unsigned v) { v = row_max_u(v); DPP_MAXU(v, 0x142, 0xa); DPP_MAXU(v, 0x143, 0xc); return (unsigned)__builtin_amdgcn_readlane((int)v, 63); }

__device__ __forceinline__ float row_sum_x(float v) { return row_sum_f(v); }
__device__ __forceinline__ float dot2_bf16(unsigned w, unsigned x, float acc) { return __builtin_amdgcn_fdot2_f32_bf16(__builtin_bit_cast(bf16x2_t, w), __builtin_bit_cast(bf16x2_t, x), acc, false); }
__device__ __forceinline__ float gelu_exact(float v) { return 0.5f * v * (1.0f + erff(v * 0.70710678118654752f)); }

__device__ __forceinline__ void phase_peer(const Params& p, LAS unsigned char* lds, int bid, int nb) {
    const int tid = threadIdx.x, lane = tid & 63, wave = __builtin_amdgcn_readfirstlane(tid >> 6);
    const int p16 = lane & 15, rg4 = lane >> 4;
    unsigned char* ws = p.ws;
    const _Float16* SC = (const _Float16*)(ws + WS_PROJ); const bf16_t* HB = (const bf16_t*)(ws + WS_XN); const float* SSQ = (const float*)(ws + WS_SSQ);
    const unsigned char* UB = (const unsigned char*)(ws + WS_UB); const unsigned char* VB = (const unsigned char*)(ws + WS_VB);
    LAS float* A_s = (LAS float*)(lds + wave * 4096);
    LAS int* A_i = (LAS int*)(lds + wave * 4096 + 1024);
    LAS int* E_i = (LAS int*)(lds + wave * 4096 + 2048);
    LAS float* E_s = (LAS float*)(lds + wave * 4096 + 2560);
    int ci = 0, cj = 0; bool cvalid = lane < 50;
    { int l = lane;
      if (l < 16) { ci = 0; cj = l; } else if (l < 24) { ci = 1; cj = l - 16; } else if (l < 29) { ci = 2; cj = l - 24; } else if (l < 33) { ci = 3; cj = l - 29; }
      else if (l < 36) { ci = 4; cj = l - 33; } else if (l < 42) { ci = 5 + (l - 36) / 2; cj = (l - 36) & 1; } else { ci = 8 + (l - 42); cj = 0; } if (!cvalid) { ci = 0; cj = 0; } }
    const int gw = bid * 8 + wave, NGW = nb * 8;
    for (int t = gw; t < NTOK; t += NGW) {
        float ssq = (lane < 16) ? SSQ[(size_t)t * 16 + lane] : 0.f; ssq = wave_sum(ssq);
        const float rstd = 1.0f / sqrtf(ssq * (1.0f / DM) + EPS);
#pragma unroll 1
        for (int q = 0; q < 4; ++q) {
            const u32x4 raw = *(const u32x4*)(SC + (size_t)t * 2048 + 512 * q + 8 * lane);
            const unsigned rw[4] = {raw.x, raw.y, raw.z, raw.w};
            unsigned key[8];
#pragma unroll
            for (int e = 0; e < 8; ++e) { const unsigned hbits = (e & 1) ? (rw[e >> 1] >> 16) : (rw[e >> 1] & 0xffffu);
                const float f = (float)__builtin_bit_cast(_Float16, (unsigned short)hbits);
                key[e] = (ord32(f) & ~0x7fu) | (unsigned)(127 - (8 * p16 + e)); }
            unsigned mine = 0u;
#pragma unroll 1
            for (int it = 0; it < 16; ++it) {
                unsigned m = key[0];
#pragma unroll
                for (int e = 1; e < 8; ++e) m = m > key[e] ? m : key[e];
                const unsigned W = row_max_u(m);
                mine = (p16 == it) ? W : mine;
#pragma unroll
                for (int e = 0; e < 8; ++e) key[e] = (key[e] == W) ? 0u : key[e];
            }
            const int g = 4 * q + rg4;
            A_s[g * 16 + p16] = unord32(mine & ~0x7fu); A_i[g * 16 + p16] = 127 - (int)(mine & 0x7fu);
        }
        LDS_WAIT();
#pragma unroll 1
        for (int h = 0; h < 8; ++h) {
            const float sa = A_s[(2 * h) * 16 + ci], sb = A_s[(2 * h + 1) * 16 + cj];
            const int ia = A_i[(2 * h) * 16 + ci], ib = A_i[(2 * h + 1) * 16 + cj];
            const float sum = sa + sb;
            unsigned key = cvalid ? ((ord32(sum) & ~0x3fu) | (unsigned)(63 - lane)) : 0u;
            int rank = -1;
#pragma unroll 1
            for (int it = 0; it < 16; ++it) { const unsigned W = wave_max_u(key); if (key == W) { rank = it; key = 0u; } }
            if (rank >= 0) { E_i[h * 16 + rank] = ia * 128 + ib; E_s[h * 16 + rank] = sum; }
        }
        LDS_WAIT();
        float gsm[2]; int eidx[2];
#pragma unroll
        for (int sl = 0; sl < 2; ++sl) { const int e = lane + 64 * sl; const float s = E_s[e] * rstd, mx = E_s[e & ~15] * rstd; const float pe = __expf(s - mx); const float den = row_sum_x(pe);
            gsm[sl] = pe / den; eidx[sl] = E_i[e]; }
#if PEER_FP8
        f32x2v xf[4][8];
#pragma unroll
        for (int i = 0; i < 4; ++i) { const u32x4 h0 = *(const u32x4*)(HB + (size_t)t * DM + 256 * i + 16 * p16), h1 = *(const u32x4*)(HB + (size_t)t * DM + 256 * i + 16 * p16 + 8);
            const unsigned hv[8] = {h0.x, h0.y, h0.z, h0.w, h1.x, h1.y, h1.z, h1.w}; const float* gp = p.g2 + 256 * i + 16 * p16;
#pragma unroll
            for (int k2 = 0; k2 < 8; ++k2) { const f32x2v g = *(const f32x2v*)(gp + 2 * k2); xf[i][k2] = (f32x2v){bf_lo(hv[k2]) * rstd * g.x, bf_hi(hv[k2]) * rstd * g.y}; } }
        constexpr int NBB = 2;
#define P6_LOADB(buf, TAB, bt0) do { _Pragma("unroll") for (int j = 0; j < NBB; ++j) { const int bt = (bt0) + j; const int ex = E_i[64 * (bt >> 4) + 16 * rg4 + (bt & 15)]; \
            const unsigned char* rp = (TAB) + (size_t)ex * 1024 + 16 * p16; _Pragma("unroll") for (int i = 0; i < 4; ++i) buf[j][i] = *(const u32x4*)(rp + 256 * i); } } while (0)
        u32x4 bA[NBB][4], bB[NBB][4];
        float act0 = 0.f, act1 = 0.f;
#define P6_COMPU(buf, bt0) do { _Pragma("unroll") for (int j = 0; j < NBB; ++j) { const int bt = (bt0) + j; f32x2v s2 = (f32x2v){0.f, 0.f}; \
            _Pragma("unroll") for (int i = 0; i < 4; ++i) { const unsigned uu[4] = {buf[j][i].x, buf[j][i].y, buf[j][i].z, buf[j][i].w}; \
                _Pragma("unroll") for (int w = 0; w < 4; ++w) { const f32x2v lo = __builtin_amdgcn_cvt_pk_f32_fp8((int)uu[w], false), hi = __builtin_amdgcn_cvt_pk_f32_fp8((int)uu[w], true); \
                    s2 = __builtin_elementwise_fma(lo, xf[i][2 * w], s2); s2 = __builtin_elementwise_fma(hi, xf[i][2 * w + 1], s2); } } \
            const float s = row_sum_x(s2.x + s2.y); const bool mine = (p16 == (bt & 15)); act0 = (mine && bt < 16) ? s : act0; act1 = (mine && bt >= 16) ? s : act1; } } while (0)
        P6_LOADB(bA, UB, 0);
#pragma unroll 1
        for (int g = 0; g < 32; g += 2 * NBB) { P6_LOADB(bB, UB, g + NBB); P6_COMPU(bA, g); if (g + 2 * NBB < 32) P6_LOADB(bA, UB, g + 2 * NBB); P6_COMPU(bB, g + NBB); }
        P6_LOADB(bA, VB, 0);
        LAS float* E_c = E_s;
        { const float c0 = gsm[0] * gelu_exact(act0 * (1.0f / 512.0f)) * (1.0f / 32.0f), c1 = gsm[1] * gelu_exact(act1 * (1.0f / 512.0f)) * (1.0f / 32.0f);
          LDS_WAIT(); E_c[lane] = c0; E_c[lane + 64] = c1; LDS_WAIT(); }
        f32x2v acc2[4][8];
#pragma unroll
        for (int i = 0; i < 4; ++i)
#pragma unroll
            for (int k = 0; k < 8; ++k) acc2[i][k] = (f32x2v){0.f, 0.f};
#define P6_COMPV(buf, bt0) do { _Pragma("unroll") for (int j = 0; j < NBB; ++j) { const int bt = (bt0) + j; const float cf = E_c[64 * (bt >> 4) + 16 * rg4 + (bt & 15)]; const f32x2v cf2 = (f32x2v){cf, cf}; \
            _Pragma("unroll") for (int i = 0; i < 4; ++i) { const unsigned vv[4] = {buf[j][i].x, buf[j][i].y, buf[j][i].z, buf[j][i].w}; \
                _Pragma("unroll") for (int w = 0; w < 4; ++w) { const f32x2v lo = __builtin_amdgcn_cvt_pk_f32_fp8((int)vv[w], false), hi = __builtin_amdgcn_cvt_pk_f32_fp8((int)vv[w], true); \
                    acc2[i][2 * w] = __builtin_elementwise_fma(lo, cf2, acc2[i][2 * w]); acc2[i][2 * w + 1] = __builtin_elementwise_fma(hi, cf2, acc2[i][2 * w + 1]); } } } } while (0)
#pragma unroll 1
        for (int g = 0; g < 32; g += 2 * NBB) { P6_LOADB(bB, VB, g + NBB); P6_COMPV(bA, g); if (g + 2 * NBB < 32) P6_LOADB(bA, VB, g + 2 * NBB); P6_COMPV(bB, g + NBB); }
#undef P6_LOADB
#undef P6_COMPU
#undef P6_COMPV
        float ss = 0.f;
#pragma unroll
        for (int i = 0; i < 4; ++i) { const u32x4 h0 = *(const u32x4*)(HB + (size_t)t * DM + 256 * i + 16 * p16), h1 = *(const u32x4*)(HB + (size_t)t * DM + 256 * i + 16 * p16 + 8);
            const unsigned hv[8] = {h0.x, h0.y, h0.z, h0.w, h1.x, h1.y, h1.z, h1.w};
#pragma unroll
            for (int k2 = 0; k2 < 8; ++k2) { float ax = acc2[i][k2].x, ay = acc2[i][k2].y;
                ax += __shfl_xor(ax, 16); ax += __shfl_xor(ax, 32); ay += __shfl_xor(ay, 16); ay += __shfl_xor(ay, 32);
                ax += bf_lo(hv[k2]); ay += bf_hi(hv[k2]); acc2[i][k2] = (f32x2v){ax, ay}; ss += ax * ax + ay * ay; } }
        ss = row_sum_x(ss);
        const float rf = 1.0f / sqrtf(ss * (1.0f / DM) + EPS);
#pragma unroll
        for (int i = 0; i < 4; ++i) { if (i == rg4) { const float* gp = p.gfin + 256 * i + 16 * p16; float* op = p.out + (size_t)t * DM + 256 * i + 16 * p16;
#pragma unroll
                for (int k4 = 0; k4 < 4; ++k4) { const f32x4 g = *(const f32x4*)(gp + 4 * k4);
                    *(f32x4*)(op + 4 * k4) = (f32x4){acc2[i][2 * k4].x * rf * g[0], acc2[i][2 * k4].y * rf * g[1], acc2[i][2 * k4 + 1].x * rf * g[2], acc2[i][2 * k4 + 1].y * rf * g[3]}; } } }
#else
        unsigned xp[8][4];
#pragma unroll
        for (int i = 0; i < 8; ++i) { const u32x4 hw = *(const u32x4*)(HB + (size_t)t * DM + 128 * i + 8 * p16); const f32x4 ga = *(const f32x4*)(p.g2 + 128 * i + 8 * p16), gb = *(const f32x4*)(p.g2 + 128 * i + 8 * p16 + 4);
            xp[i][0] = pk2(bf_lo(hw.x) * rstd * ga[0], bf_hi(hw.x) * rstd * ga[1]); xp[i][1] = pk2(bf_lo(hw.y) * rstd * ga[2], bf_hi(hw.y) * rstd * ga[3]);
            xp[i][2] = pk2(bf_lo(hw.z) * rstd * gb[0], bf_hi(hw.z) * rstd * gb[1]); xp[i][3] = pk2(bf_lo(hw.w) * rstd * gb[2], bf_hi(hw.w) * rstd * gb[3]); }
        float act[2] = {0.f, 0.f};
#pragma unroll
        for (int sl = 0; sl < 2; ++sl) {
#pragma unroll 2
            for (int b16 = 0; b16 < 16; ++b16) {
                const int e = 64 * sl + 16 * rg4 + b16; const int ex = E_i[e];
                const unsigned char* rowp = UB + (size_t)ex * 2048 + 16 * p16;
                float s = 0.f;
#pragma unroll
                for (int i = 0; i < 8; ++i) { const u32x4 uw = *(const u32x4*)(rowp + 256 * i);
                    s = dot2_bf16(uw.x, xp[i][0], s); s = dot2_bf16(uw.y, xp[i][1], s); s = dot2_bf16(uw.z, xp[i][2], s); s = dot2_bf16(uw.w, xp[i][3], s); }
                s = row_sum_x(s);
                act[sl] = (p16 == b16) ? s : act[sl];
            }
        }
        float coef[2];
#pragma unroll
        for (int sl = 0; sl < 2; ++sl) coef[sl] = gsm[sl] * gelu_exact(act[sl]);
        float acc[8][8];
#pragma unroll
        for (int i = 0; i < 8; ++i)
#pragma unroll
            for (int k = 0; k < 8; ++k) acc[i][k] = 0.f;
#pragma unroll
        for (int sl = 0; sl < 2; ++sl) {
#pragma unroll 2
            for (int b16 = 0; b16 < 16; ++b16) {
                const int srcl = (lane & 48) + b16;
                const float cf = __shfl(coef[sl], srcl); const int ex = __shfl(eidx[sl], srcl);
                const unsigned char* rowp = VB + (size_t)ex * 2048 + 16 * p16;
#pragma unroll
                for (int i = 0; i < 8; ++i) { const u32x4 vw = *(const u32x4*)(rowp + 256 * i);
                    acc[i][0] += cf * bf_lo(vw.x); acc[i][1] += cf * bf_hi(vw.x); acc[i][2] += cf * bf_lo(vw.y); acc[i][3] += cf * bf_hi(vw.y);
                    acc[i][4] += cf * bf_lo(vw.z); acc[i][5] += cf * bf_hi(vw.z); acc[i][6] += cf * bf_lo(vw.w); acc[i][7] += cf * bf_hi(vw.w); }
            }
        }
        float ss = 0.f;
#pragma unroll
        for (int i = 0; i < 8; ++i) { const u32x4 hw = *(const u32x4*)(HB + (size_t)t * DM + 128 * i + 8 * p16); const unsigned hv[4] = {hw.x, hw.y, hw.z, hw.w};
#pragma unroll
            for (int k = 0; k < 8; ++k) { float a = acc[i][k]; a += __shfl_xor(a, 16); a += __shfl_xor(a, 32);
                a += (k & 1) ? bf_hi(hv[k >> 1]) : bf_lo(hv[k >> 1]); acc[i][k] = a; ss += a * a; } }
        ss = row_sum_x(ss);
        const float rf = 1.0f / sqrtf(ss * (1.0f / DM) + EPS);
#pragma unroll
        for (int i = 0; i < 8; ++i) { if ((i >> 1) == rg4) { const f32x4 ga = *(const f32x4*)(p.gfin + 128 * i + 8 * p16), gb = *(const f32x4*)(p.gfin + 128 * i + 8 * p16 + 4);
                float* op = p.out + (size_t)t * DM + 128 * i + 8 * p16;
                *(f32x4*)op = (f32x4){acc[i][0] * rf * ga[0], acc[i][1] * rf * ga[1], acc[i][2] * rf * ga[2], acc[i][3] * rf * ga[3]};
                *(f32x4*)(op + 4) = (f32x4){acc[i][4] * rf * gb[0], acc[i][5] * rf * gb[1], acc[i][6] * rf * gb[2], acc[i][7] * rf * gb[3]}; } }
#endif
        LDS_WAIT();
    }
}


__device__ __forceinline__ void row_max4(unsigned k0, unsigned k1, unsigned k2, unsigned k3, unsigned& w0, unsigned& w1, unsigned& w2, unsigned& w3) {
    asm volatile("s_nop 1\n\t"
                 "v_max_u32_dpp %0, %4, %4 quad_perm:[1,0,3,2] row_mask:0xf bank_mask:0xf\n\t"
                 "v_max_u32_dpp %1, %5, %5 quad_perm:[1,0,3,2] row_mask:0xf bank_mask:0xf\n\t"
                 "v_max_u32_dpp %2, %6, %6 quad_perm:[1,0,3,2] row_mask:0xf bank_mask:0xf\n\t"
                 "v_max_u32_dpp %3, %7, %7 quad_perm:[1,0,3,2] row_mask:0xf bank_mask:0xf\n\t"
                 "v_max_u32_dpp %0, %0, %0 quad_perm:[2,3,0,1] row_mask:0xf bank_mask:0xf\n\t"
                 "v_max_u32_dpp %1, %1, %1 quad_perm:[2,3,0,1] row_mask:0xf bank_mask:0xf\n\t"
                 "v_max_u32_dpp %2, %2, %2 quad_perm:[2,3,0,1] row_mask:0xf bank_mask:0xf\n\t"
                 "v_max_u32_dpp %3, %3, %3 quad_perm:[2,3,0,1] row_mask:0xf bank_mask:0xf\n\t"
                 "v_max_u32_dpp %0, %0, %0 row_ror:4 row_mask:0xf bank_mask:0xf\n\t"
                 "v_max_u32_dpp %1, %1, %1 row_ror:4 row_mask:0xf bank_mask:0xf\n\t"
                 "v_max_u32_dpp %2, %2, %2 row_ror:4 row_mask:0xf bank_mask:0xf\n\t"
                 "v_max_u32_dpp %3, %3, %3 row_ror:4 row_mask:0xf bank_mask:0xf\n\t"
                 "v_max_u32_dpp %0, %0, %0 row_ror:8 row_mask:0xf bank_mask:0xf\n\t"
                 "v_max_u32_dpp %1, %1, %1 row_ror:8 row_mask:0xf bank_mask:0xf\n\t"
                 "v_max_u32_dpp %2, %2, %2 row_ror:8 row_mask:0xf bank_mask:0xf\n\t"
                 "v_max_u32_dpp %3, %3, %3 row_ror:8 row_mask:0xf bank_mask:0xf\n\t"
                 "s_nop 1"
                 : "=&v"(w0), "=&v"(w1), "=&v"(w2), "=&v"(w3) : "v"(k0), "v"(k1), "v"(k2), "v"(k3));
}
__device__ __forceinline__ unsigned pkadd_h2(unsigned a, unsigned b) { const h2v x = __builtin_bit_cast(h2v, a), y = __builtin_bit_cast(h2v, b); const h2v s = x + y; return __builtin_bit_cast(unsigned, s); }
constexpr int NT6 = 8;
constexpr int W6_BYTES = 16640;
__device__ __forceinline__ float dpp_f(float v, int ctrl_dummy);
#define DPPF(v, ctrl) __builtin_bit_cast(float, __builtin_amdgcn_update_dpp(0, __builtin_bit_cast(int, (v)), (ctrl), 0xf, 0xf, false))

__device__ __forceinline__ void phase_peer2(const Params& p, LAS unsigned char* lds, int bid, int nb) {
    const int tid = threadIdx.x, lane = tid & 63, wave = __builtin_amdgcn_readfirstlane(tid >> 6);
    const int p16 = lane & 15, rg4 = lane >> 4, q8 = lane >> 3, p8 = lane & 7;
    const bool b0 = lane & 1, b1 = lane & 2, b2 = lane & 4, c0 = lane & 8, c1 = lane & 16, c2 = lane & 32;
    unsigned char* ws = p.ws;
    const _Float16* SC = (const _Float16*)(ws + WS_PROJ); const bf16_t* HB = (const bf16_t*)(ws + WS_XN); const float* SSQ = (const float*)(ws + WS_SSQ);
    const unsigned char* UB = (const unsigned char*)(ws + WS_UB); const unsigned char* VB = (const unsigned char*)(ws + WS_VB); unsigned char* XQ = ws + WS_XQ;
    LAS unsigned char* wl = lds + wave * W6_BYTES;
    LAS unsigned char* CQ = wl;
    LAS unsigned short* E16 = (LAS unsigned short*)(wl + 6144);
    LAS float* GC = (LAS float*)(wl + 8192);
    LAS float* ACT = (LAS float*)(wl + 12288);
    LAS float* RS = (LAS float*)(wl + 16384);
    int ci = 0, cj = 0; bool cvalid = lane < 50;
    { int l = lane;
      if (l < 16) { ci = 0; cj = l; } else if (l < 24) { ci = 1; cj = l - 16; } else if (l < 29) { ci = 2; cj = l - 24; } else if (l < 33) { ci = 3; cj = l - 29; }
      else if (l < 36) { ci = 4; cj = l - 33; } else if (l < 42) { ci = 5 + (l - 36) / 2; cj = (l - 36) & 1; } else { ci = 8 + (l - 42); cj = 0; } if (!cvalid) { ci = 0; cj = 0; } }
    const int gw = bid * 8 + wave, NGW = nb * 8;
#define TOK6(k) min(base + (k) * NGW, NTOK - 1)
    for (int base = gw; base < NTOK; base += NT6 * NGW) {
#pragma unroll 1
        for (int rep_r = 0; rep_r < PROBE_R; ++rep_r)
#pragma unroll 1
        for (int k = 0; k < NT6; k += 2) {
            u32x4 raw[2][4]; float rstd[2];
#pragma unroll
            for (int v = 0; v < 2; ++v) { const int t = TOK6(k + v);
#pragma unroll
                for (int q = 0; q < 4; ++q) raw[v][q] = *(const u32x4*)(SC + (size_t)t * 2048 + 512 * q + 8 * lane);
                float ssq = (lane < 16) ? SSQ[(size_t)t * 16 + lane] : 0.f; ssq = wave_sum(ssq);
                rstd[v] = 1.0f / sqrtf(ssq * (1.0f / DM) + EPS);
                { const u32x4 ha = *(const u32x4*)(HB + (size_t)t * DM + 16 * lane), hb = *(const u32x4*)(HB + (size_t)t * DM + 16 * lane + 8); const float sc = rstd[v] * 16.0f;
                  const unsigned hv[8] = {ha.x, ha.y, ha.z, ha.w, hb.x, hb.y, hb.z, hb.w}; unsigned xw[4];
#pragma unroll
                  for (int w = 0; w < 4; ++w) { int pk = __builtin_amdgcn_cvt_pk_fp8_f32(bf_lo(hv[2 * w]) * sc, bf_hi(hv[2 * w]) * sc, 0, false);
                      pk = __builtin_amdgcn_cvt_pk_fp8_f32(bf_lo(hv[2 * w + 1]) * sc, bf_hi(hv[2 * w + 1]) * sc, pk, true); xw[w] = (unsigned)pk; }
                  *(u32x4*)(XQ + (size_t)t * DM + 16 * lane) = (u32x4){xw[0], xw[1], xw[2], xw[3]}; } }
#pragma unroll
            for (int qq = 0; qq < 2; ++qq) {
                unsigned ka[4][8];
#pragma unroll
                for (int c = 0; c < 4; ++c) { const u32x4 rv = raw[c >> 1][2 * qq + (c & 1)]; const unsigned rw[4] = {rv.x, rv.y, rv.z, rv.w};
#pragma unroll
                    for (int e = 0; e < 8; ++e) { const unsigned hbits = (e & 1) ? (rw[e >> 1] >> 16) : (rw[e >> 1] & 0xffffu);
                        const float f = (float)__builtin_bit_cast(_Float16, (unsigned short)hbits);
                        ka[c][e] = (ord32(f) & ~0x7fu) | (unsigned)(127 - (8 * p16 + e)); } }
#define CE6(u, i, j) do { const unsigned _a = ka[u][i], _b = ka[u][j]; ka[u][i] = _a > _b ? _a : _b; ka[u][j] = _a > _b ? _b : _a; } while (0)
#pragma unroll
                for (int u = 0; u < 4; ++u) {
                    CE6(u, 0, 1); CE6(u, 2, 3); CE6(u, 4, 5); CE6(u, 6, 7);
                    CE6(u, 0, 2); CE6(u, 1, 3); CE6(u, 4, 6); CE6(u, 5, 7);
                    CE6(u, 1, 2); CE6(u, 5, 6);
                    CE6(u, 0, 4); CE6(u, 1, 5); CE6(u, 2, 6); CE6(u, 3, 7);
                    CE6(u, 2, 4); CE6(u, 3, 5);
                    CE6(u, 1, 2); CE6(u, 3, 4); CE6(u, 5, 6);
                }
#undef CE6
                unsigned mine[4] = {0u, 0u, 0u, 0u};
#pragma unroll 1
                for (int it = 0; it < 16; ++it) {
                    unsigned Wv[4]; row_max4(ka[0][0], ka[1][0], ka[2][0], ka[3][0], Wv[0], Wv[1], Wv[2], Wv[3]);
#pragma unroll
                    for (int c = 0; c < 4; ++c) {
                        const unsigned W = Wv[c];
                        mine[c] = (p16 == it) ? W : mine[c];
                        const bool win = (ka[c][0] == W);
#pragma unroll
                        for (int e = 0; e < 7; ++e) ka[c][e] = win ? ka[c][e + 1] : ka[c][e];
                        ka[c][7] = win ? 0u : ka[c][7];
                    }
                }
#pragma unroll
                for (int c = 0; c < 4; ++c) { const int g = 4 * (2 * qq + (c & 1)) + rg4; LAS float* A_s = (LAS float*)(wl + 3072 * (c >> 1)); LAS int* A_i = (LAS int*)(wl + 3072 * (c >> 1) + 1024);
                    A_s[g * 16 + p16] = unord32(mine[c] & ~0x7fu); A_i[g * 16 + p16] = 127 - (int)(mine[c] & 0x7fu); }
            }
            LDS_WAIT();
            {
                float av[4], bc[4]; int iav[4], ibc[4], jp[4], hh[4], bb[4]; unsigned key[4];
#pragma unroll
                for (int c = 0; c < 4; ++c) { const LAS float* A_s = (const LAS float*)(wl + 3072 * (c >> 1)); const LAS int* A_i = (const LAS int*)(wl + 3072 * (c >> 1) + 1024);
                    hh[c] = 4 * (c & 1) + rg4; bb[c] = (2 * hh[c] + 1) * 16; av[c] = A_s[(2 * hh[c]) * 16 + p16]; iav[c] = A_i[(2 * hh[c]) * 16 + p16] * 128; jp[c] = 0; bc[c] = A_s[bb[c]]; ibc[c] = A_i[bb[c]];
                    key[c] = (ord32(av[c] + bc[c]) & ~0xfu) | (unsigned)(15 - p16); }
#pragma unroll 1
                for (int it = 0; it < 16; ++it) {
                    unsigned Wv[4]; row_max4(key[0], key[1], key[2], key[3], Wv[0], Wv[1], Wv[2], Wv[3]);
#pragma unroll
                    for (int c = 0; c < 4; ++c) {
                        const LAS float* A_s = (const LAS float*)(wl + 3072 * (c >> 1)); const LAS int* A_i = (const LAS int*)(wl + 3072 * (c >> 1) + 1024);
                        LAS int* E_i = (LAS int*)(wl + 3072 * (c >> 1) + 2048); LAS float* E_s = (LAS float*)(wl + 3072 * (c >> 1) + 2560);
                        const bool win = (key[c] == Wv[c]);
                        if (win) { E_i[hh[c] * 16 + it] = iav[c] + ibc[c]; E_s[hh[c] * 16 + it] = av[c] + bc[c]; }
                        jp[c] += win ? 1 : 0;
                        const int jr = jp[c] < 16 ? jp[c] : 15;
                        bc[c] = A_s[bb[c] + jr]; ibc[c] = A_i[bb[c] + jr];
                        key[c] = jp[c] < 16 ? ((ord32(av[c] + bc[c]) & ~0xfu) | (unsigned)(15 - p16)) : 0u;
                    }
                }
            }
            LDS_WAIT();
#pragma unroll
            for (int v = 0; v < 2; ++v) { const LAS int* E_i = (const LAS int*)(wl + 3072 * v + 2048); const LAS float* E_s = (const LAS float*)(wl + 3072 * v + 2560);
#pragma unroll
                for (int sl = 0; sl < 2; ++sl) { const int e = lane + 64 * sl; const float s = E_s[e] * rstd[v], mx = E_s[e & ~15] * rstd[v]; const float pe = __expf(s - mx); const float den = row_sum_x(pe);
                    const int pos = 16 * (e & 7) + (e >> 3);
                    GC[(k + v) * 128 + pos] = pe / den; E16[(k + v) * 128 + pos] = (unsigned short)E_i[e]; }
                if (lane == 0) RS[k + v] = rstd[v]; }
            LDS_WAIT();
        }
#define P6_LOADH(buf, TAB, jj, kk, hh) do { const u32x4 _iv = *(const LAS u32x4*)(E16 + (kk) * 128 + 16 * q8 + 8 * (hh)); const unsigned _iw[4] = {_iv.x, _iv.y, _iv.z, _iv.w}; \
            _Pragma("unroll") for (int c = 0; c < 8; ++c) { const unsigned _idx = (c & 1) ? (_iw[c >> 1] >> 16) : (_iw[c >> 1] & 0xffffu); \
                buf[c] = *(const u32x4*)((TAB) + (((size_t)(jj) * NEXP + _idx) << 7) + 16 * p8); } } while (0)
#define P6_LOADX(hb, jj, kk) do { const bf16_t* _hp = HB + (size_t)TOK6(kk) * DM + 128 * (jj) + 16 * p8; hb[0] = *(const u32x4*)_hp; hb[1] = *(const u32x4*)(_hp + 8); } while (0)
        asm volatile("s_waitcnt vmcnt(0)" ::: "memory");
#pragma unroll 1
        for (int rep_u = 0; rep_u < PROBE_U; ++rep_u) {
            for (int k = 0; k < NT6; ++k) { ACT[k * 128 + lane] = 0.f; ACT[k * 128 + 64 + lane] = 0.f; }
            LDS_WAIT();
            const int n16 = lane & 15, g4 = lane >> 4, c4 = lane & 3, r16 = 4 * g4 + (n16 >> 2);
            const int eoff = 2 * (16 * (r16 & 7) + (r16 >> 3));
            const bool xkeep = (g4 == (n16 >> 2));
            u32x4 bfP[16], bfQ[16], xP[2], xQ2[2];
#define P6_ULOAD(buf, xb, nn) do { const int _j = (nn) / NT6, _k = (nn) % NT6; const LAS unsigned char* _ip = (const LAS unsigned char*)(E16 + _k * 128) + eoff; \
                { const unsigned char* _xp = XQ + (size_t)TOK6(_k) * DM + 128 * _j + 16 * c4; xb[0] = *(const u32x4*)_xp; xb[1] = *(const u32x4*)(_xp + 64); } \
                asm volatile("" ::: "memory"); \
                _Pragma("unroll") for (int T = 0; T < 8; ++T) { const unsigned _idx = *(const LAS unsigned short*)(_ip + 4 * T); \
                    const unsigned char* _rp = UB + (((size_t)_j * NEXP + _idx) << 7) + 16 * c4; buf[2 * T] = *(const u32x4*)_rp; buf[2 * T + 1] = *(const u32x4*)(_rp + 64); } } while (0)
#define P6_PK64(lo, hi) ((long)(((unsigned long long)(hi) << 32) | (unsigned long long)(lo)))
#define P6_UMMA(buf, xb, nn) do { const int k = (nn) % NT6; \
                const unsigned x0 = xkeep ? xb[0].x : 0u, x1 = xkeep ? xb[0].y : 0u, x2 = xkeep ? xb[0].z : 0u, x3 = xkeep ? xb[0].w : 0u, \
                               x4 = xkeep ? xb[1].x : 0u, x5 = xkeep ? xb[1].y : 0u, x6 = xkeep ? xb[1].z : 0u, x7 = xkeep ? xb[1].w : 0u; \
                const long xa[4] = {P6_PK64(x0, x1), P6_PK64(x2, x3), P6_PK64(x4, x5), P6_PK64(x6, x7)}; \
                float dsel[2] = {0.f, 0.f}; \
                _Pragma("unroll") for (int T = 0; T < 8; ++T) { f32x4 d = (f32x4){0.f, 0.f, 0.f, 0.f}; \
                    const long bb[4] = {P6_PK64(buf[2 * T].x, buf[2 * T].y), P6_PK64(buf[2 * T].z, buf[2 * T].w), P6_PK64(buf[2 * T + 1].x, buf[2 * T + 1].y), P6_PK64(buf[2 * T + 1].z, buf[2 * T + 1].w)}; \
                    _Pragma("unroll") for (int s = 0; s < 4; ++s) d = __builtin_amdgcn_mfma_f32_16x16x32_fp8_fp8(xa[s], bb[s], d, 0, 0, 0); \
                    float pv = (c4 == 0) ? d[0] : ((c4 == 1) ? d[1] : ((c4 == 2) ? d[2] : d[3])); \
                    pv += DPPF(pv, 0xB1); pv += DPPF(pv, 0x4E);                         \
                    dsel[T >> 2] = ((T & 3) == c4) ? pv : dsel[T >> 2]; } \
                  \
                ACT[k * 128 + 16 * c4 + r16] += dsel[0]; ACT[k * 128 + 16 * (c4 + 4) + r16] += dsel[1]; } while (0)
            P6_ULOAD(bfP, xP, 0);
#pragma unroll 1
            for (int n = 0; n < 8 * NT6; n += 2) {
                P6_ULOAD(bfQ, xQ2, n + 1); asm volatile("" ::: "memory"); __builtin_amdgcn_sched_barrier(0);
                P6_UMMA(bfP, xP, n); __builtin_amdgcn_sched_barrier(0);
                if (n + 2 < 8 * NT6) P6_ULOAD(bfP, xP, n + 2);
                asm volatile("" ::: "memory"); __builtin_amdgcn_sched_barrier(0);
                P6_UMMA(bfQ, xQ2, n + 1); __builtin_amdgcn_sched_barrier(0);
            }
#undef P6_ULOAD
#undef P6_UMMA
#undef P6_PK64
        }
        LDS_WAIT();
#pragma unroll 1
        for (int k = 0; k < NT6; ++k) {
#pragma unroll
            for (int sl = 0; sl < 2; ++sl) { const int e = lane + 64 * sl, pos = 16 * (e & 7) + (e >> 3); const float a = ACT[k * 128 + e] * (1.0f / 8192.0f);
                const float cfv = GC[k * 128 + pos] * gelu_exact(a);
                CQ[k * 128 + pos] = (unsigned char)(__builtin_amdgcn_cvt_pk_fp8_f32(cfv * 32.0f, 0.f, 0, false) & 0xff); } }
        LDS_WAIT();
#pragma unroll 1
        for (int k = 0; k < NT6; ++k) ACT[k * 64 + lane] = 0.f;
        LDS_WAIT();
#pragma unroll 1
        for (int rep_v = 0; rep_v < PROBE_V; ++rep_v) {
            for (int k = 0; k < NT6; ++k) ACT[k * 64 + lane] = 0.f;
            LDS_WAIT();
            u32x4 bfP[16], bfQ[16];
#define P6_LOADI(buf, TAB, nn) do { const int _j = (nn) / NT6, _k = (nn) % NT6; P6_LOADH(buf, TAB, _j, _k, 0); P6_LOADH((buf + 8), TAB, _j, _k, 1); } while (0)
            const int n16 = lane & 15, g4 = lane >> 4;
            const int ash = 8 * (n16 & 3); const bool ahi = (n16 & 4) != 0;
            const int c0 = 16 * (n16 & 7) + 4 * (g4 & 1);
            const bool fin = (n16 < 8) && (g4 < 2);
#define P6_LOADR2(hb, nn) do { const bf16_t* _hp = HB + (size_t)TOK6((nn) % NT6) * DM + 128 * ((nn) / NT6) + c0; hb[0] = *(const u32x2*)_hp; hb[1] = *(const u32x2*)(_hp + 8); } while (0)
#define P6_VBODY(buf, nn, hb) do { const int j = (nn) / NT6, k = (nn) % NT6; const int t = TOK6(k); \
                const u32x4 cqv = *(const LAS u32x4*)(CQ + k * 128 + 16 * q8); const unsigned cqw[4] = {cqv.x, cqv.y, cqv.z, cqv.w}; \
                f32x4 d0 = (f32x4){0.f, 0.f, 0.f, 0.f}, d1 = (f32x4){0.f, 0.f, 0.f, 0.f}; \
                _Pragma("unroll") for (int c = 0; c < 16; ++c) { const unsigned cb = (cqw[c >> 2] >> (8 * (c & 3))) & 0xffu; const unsigned tt = cb << ash; \
                    const long av = P6_PK64(ahi ? 0u : tt, ahi ? tt : 0u); \
                    d0 = __builtin_amdgcn_mfma_f32_16x16x32_fp8_fp8(av, P6_PK64(buf[c].x, buf[c].y), d0, 0, 0, 0); \
                    d1 = __builtin_amdgcn_mfma_f32_16x16x32_fp8_fp8(av, P6_PK64(buf[c].z, buf[c].w), d1, 0, 0, 0); } \
                float o[8]; \
                _Pragma("unroll") for (int r = 0; r < 4; ++r) { o[r] = d0[r] + __shfl_xor(d0[r], 40); o[4 + r] = d1[r] + __shfl_xor(d1[r], 40); } \
                const unsigned hw[4] = {hb[0].x, hb[0].y, hb[1].x, hb[1].y}; float ss = 0.f; \
                _Pragma("unroll") for (int r = 0; r < 8; ++r) { const float hv = (r & 1) ? bf_hi(hw[r >> 1]) : bf_lo(hw[r >> 1]); o[r] = o[r] * (1.0f / 1024.0f) + hv; ss += o[r] * o[r]; } \
                if (fin) { float* op = p.out + (size_t)t * DM + 128 * j + c0; *(f32x4*)op = (f32x4){o[0], o[1], o[2], o[3]}; *(f32x4*)(op + 8) = (f32x4){o[4], o[5], o[6], o[7]}; \
                    ACT[k * 64 + lane] += ss; } \
                } while (0)
#define P6_PK64(lo, hi) ((long)(((unsigned long long)(hi) << 32) | (unsigned long long)(lo)))
            P6_LOADI(bfP, VB, 0);
#pragma unroll 1
            for (int n = 0; n < 8 * NT6; n += 2) {
                u32x2 hr0[2], hr1[2]; P6_LOADR2(hr0, n); P6_LOADR2(hr1, n + 1);
                asm volatile("" ::: "memory");
                P6_LOADI(bfQ, VB, n + 1); asm volatile("" ::: "memory"); __builtin_amdgcn_sched_barrier(0);
                P6_VBODY(bfP, n, hr0); __builtin_amdgcn_sched_barrier(0);
                if (n + 2 < 8 * NT6) P6_LOADI(bfP, VB, n + 2);
                asm volatile("" ::: "memory"); __builtin_amdgcn_sched_barrier(0);
                P6_VBODY(bfQ, n + 1, hr1); __builtin_amdgcn_sched_barrier(0);
            }
            LDS_WAIT(); asm volatile("s_waitcnt vmcnt(0)" ::: "memory");
            f32x4 gfv[4];
#pragma unroll
            for (int i = 0; i < 4; ++i) gfv[i] = *(const f32x4*)(p.gfin + 256 * i + 4 * lane);
#pragma unroll 1
            for (int k = 0; k < NT6; ++k) { const float sst = wave_sum(ACT[k * 64 + lane]); const float rf = __builtin_amdgcn_rsqf(sst * (1.0f / DM) + EPS);
                float* op = p.out + (size_t)TOK6(k) * DM + 4 * lane; f32x4 ov[4];
#pragma unroll
                for (int i = 0; i < 4; ++i) ov[i] = *(const f32x4*)(op + 256 * i);
#pragma unroll
                for (int i = 0; i < 4; ++i) *(f32x4*)(op + 256 * i) = ov[i] * rf * gfv[i]; }
        }
        LDS_WAIT();
    }
#undef P6_LOADH
#undef P6_LOADX
#undef P6_LOADI
#undef P6_VBODY
#undef P6_LOADR2
#undef P6_PK64
#undef TOK6
}

#define XB_TMO      128
#define XB_XCNT(j)  (256  + 64 * (j))
#define XB_XSUB(j)  (1280 + 64 * (j))
#define XB_XGEN(j)  (2304 + 64 * (j))
#define XB_TOP      3328
#define XB_TOPGEN   3392
#define XCD_BAR_WORDS 3456
#define XB_SPIN_CAP (1u << 18)

__device__ __forceinline__ unsigned xb_ld(unsigned* p)              { return __hip_atomic_load(p, __ATOMIC_RELAXED, __HIP_MEMORY_SCOPE_AGENT); }
__device__ __forceinline__ unsigned xb_add(unsigned* p, unsigned v) { return __hip_atomic_fetch_add(p, v, __ATOMIC_RELAXED, __HIP_MEMORY_SCOPE_AGENT); }
__device__ __forceinline__ unsigned xb_xcc_id() { return (unsigned)__builtin_amdgcn_s_getreg((3 << 11) | 20) & 0xFu; }
#define XB_SPIN(cond, bar) do { unsigned _sp = 0; while (cond) { __builtin_amdgcn_s_sleep(1); \
    if ((++_sp & 255u) == 0u) { if (xb_ld(&(bar)[XB_TMO])) break; if (_sp > XB_SPIN_CAP) { atomicAdd(&(bar)[XB_TMO], 1u); break; } } } } while (0)

struct XcdBarrier {
    unsigned* bar; unsigned x;
    volatile LAS unsigned* st;
};

__device__ __forceinline__ XcdBarrier xcd_barrier_post(unsigned* bar, volatile LAS unsigned* st) {
    XcdBarrier b; b.bar = bar; b.x = xb_xcc_id(); b.st = st;
    if (threadIdx.x == 0) (void)xb_add(&bar[XB_XCNT(b.x)], 1u);
    return b;
}
__device__ __forceinline__ void xcd_barrier_complete(unsigned* bar, unsigned x, unsigned& nloc, unsigned& nx) {
    const unsigned G = gridDim.x * gridDim.y * gridDim.z;
    unsigned sum, cnt, mine, sp = 0u;
    for (;;) {
        sum = 0u; cnt = 0u; mine = 0u;
#pragma unroll
        for (unsigned j = 0; j < 16; ++j) { const unsigned c = xb_ld(&bar[XB_XCNT(j)]); sum += c; cnt += (c > 0u) ? 1u : 0u; mine = (j == x) ? c : mine; }
        if (sum == G) break;
        __builtin_amdgcn_s_sleep(1);
        if ((++sp & 255u) == 0u) { if (xb_ld(&bar[XB_TMO])) break; if (sp > XB_SPIN_CAP) { atomicAdd(&bar[XB_TMO], 1u); break; } }
    }
    nloc = mine > 0u ? mine : 1u; nx = cnt > 0u ? cnt : 1u;
}

__device__ __forceinline__ void xcd_barrier(const XcdBarrier& b) {
    asm volatile("s_waitcnt vmcnt(0)" ::: "memory");
    __syncthreads();
    if (threadIdx.x == 0) {
        unsigned* bar = b.bar;
        __builtin_amdgcn_s_waitcnt(0);
        unsigned nloc = b.st[0], nx = b.st[1];
        if (nloc == 0u) { xcd_barrier_complete(bar, b.x, nloc, nx); b.st[0] = nloc; b.st[1] = nx; }
        const unsigned old = xb_add(&bar[XB_XSUB(b.x)], 1u);
        const unsigned gen = old / nloc;
        if (old + 1u == (gen + 1u) * nloc) {
            __builtin_amdgcn_fence(__ATOMIC_RELEASE, "agent");
            asm volatile("s_waitcnt vmcnt(0)" ::: "memory");
            const unsigned og = xb_add(&bar[XB_TOP], 1u);
            const unsigned tg = og / nx;
            if (og + 1u == (tg + 1u) * nx) xb_add(&bar[XB_TOPGEN], 1u);
            else XB_SPIN(xb_ld(&bar[XB_TOPGEN]) == tg, bar);
            __builtin_amdgcn_fence(__ATOMIC_ACQUIRE, "agent");
            xb_add(&bar[XB_XGEN(b.x)], 1u);
            asm volatile("s_waitcnt vmcnt(0)" ::: "memory");
        } else {
            XB_SPIN(xb_ld(&bar[XB_XGEN(b.x)]) == gen, bar);
            __builtin_amdgcn_fence(__ATOMIC_ACQUIRE, "agent");
            asm volatile("s_waitcnt vmcnt(0)" ::: "memory");
        }
    }
    __syncthreads();
}

__global__ void __launch_bounds__(512, 2) mk_fwd(Params p) {
    extern __shared__ __attribute__((aligned(16))) unsigned char lds_raw[];
    LAS unsigned char* lds = (LAS unsigned char*)lds_raw;
    const int bid = blockIdx.x, nb = gridDim.x;
    unsigned char* ws = p.ws;
#define IN(k) (p.ph_lo <= (k) && (k) < p.ph_hi)
#define SEAM(k) do { if (IN(k) && IN((k) + 1)) { xcd_barrier(bar); } } while (0)
    if (threadIdx.x < 4) ((volatile LAS unsigned*)(lds + LDS_BYTES - 16))[threadIdx.x] = 0u;
    __syncthreads();
    const XcdBarrier bar = xcd_barrier_post((unsigned*)(ws + WS_CTL) + 4096, (volatile LAS unsigned*)(lds + LDS_BYTES - 16));
    if (IN(0)) phase0(p, lds, bid, nb);
    SEAM(0);
    if (IN(1)) {
        pg8::Gemm g{(const bf16_t*)(ws + WS_XN), (const bf16_t*)(ws + WS_WIN), MROWS, NP1, DM}; pg8::StaticOrder S; S.init(MROWS, NP1, nb, bid);
        EpiProj E{(bf16_t*)(ws + WS_PROJ), (bf16_t*)(ws + WS_QK), (float*)(ws + WS_LA), p.gb, (const float2*)(ws + WS_ROPE)};
        pg8::gemm_phase<EpiProj, pg8::StaticOrder, true, true>(lds, g, S, E);
    }
    SEAM(1);
    if (IN(2)) attn_pass<false>(p, lds, bid, nb);
    SEAM(2);
    if (IN(3)) attn_pass<true>(p, lds, bid, nb);
    SEAM(3);
    if (IN(4)) {
        pg8::Gemm g{(const bf16_t*)(ws + WS_O), (const bf16_t*)(ws + WS_WOUT), NTOK, DM, DM}; pg8::StaticOrder S; S.init(NTOK, DM, nb, bid);
        EpiRes E{p.x, (bf16_t*)(ws + WS_XN), (float*)(ws + WS_SSQ)};
        pg8::gemm_phase<EpiRes, pg8::StaticOrder, true, true>(lds, g, S, E);
    }
    SEAM(4);
    if (IN(5)) {
        pg8::Gemm g{(const bf16_t*)(ws + WS_XN), (const bf16_t*)(ws + WS_WS), NTOK, 2048, DM}; pg8::StaticOrder S; S.init(NTOK, 2048, nb, bid);
        EpiF16 E{(_Float16*)(ws + WS_PROJ)};
        pg8::gemm_phase<EpiF16, pg8::StaticOrder, true, true>(lds, g, S, E);
    }
    SEAM(5);
    if (IN(6)) phase_peer2(p, lds, bid, nb);
#undef IN
#undef SEAM
}

#ifndef MK_FUSED
#define MK_FUSED 1
#endif
extern "C" void kernel_launch(void* const* d_in, const int* in_sizes, int n_in, void* d_out, int out_size, void* d_ws, size_t ws_size, hipStream_t stream) {
    static int grid = 0;
    if (grid == 0) {
        if (n_in != 16 || in_sizes[0] != NTOK * DM || out_size != NTOK * DM || ws_size < WS_END) {
            fprintf(stderr, "kernel_launch: unexpected shapes (n_in %d, in0 %d, out %d, ws %zu); nothing launched\n", n_in, n_in > 0 ? in_sizes[0] : -1, out_size, ws_size); grid = -1; return; }
        int dev = 0, cus = 0, per_cu = 0;
        hipGetDevice(&dev); hipDeviceGetAttribute(&cus, hipDeviceAttributeMultiprocessorCount, dev);
        if (hipFuncSetAttribute((const void*)mk_fwd, hipFuncAttributeMaxDynamicSharedMemorySize, LDS_BYTES) != hipSuccess) { fprintf(stderr, "kernel_launch: hipFuncSetAttribute failed\n"); grid = -1; return; }
        if (hipOccupancyMaxActiveBlocksPerMultiprocessor(&per_cu, (const void*)mk_fwd, 512, LDS_BYTES) != hipSuccess || per_cu < 1) { fprintf(stderr, "kernel_launch: occupancy query failed (%d)\n", per_cu); (void)hipGetLastError(); per_cu = 1; }
        grid = cus * (per_cu < 1 ? 1 : 1);
        fprintf(stderr, "kernel_launch: %d CUs, occupancy %d/CU, grid %d\n", cus, per_cu, grid);
    }
    if (grid < 0) return;
    (void)hipMemsetAsync((char*)d_ws + WS_CTL, 0, 65536, stream);
    Params p{};
    p.x = (const float*)d_in[0]; p.meta = (const float*)d_in[1]; p.g1 = (const float*)d_in[2]; p.w_in = (const float*)d_in[3]; p.gw2 = (const float*)d_in[4]; p.gb = (const float*)d_in[5];
    p.gla_gain = (const float*)d_in[6]; p.ret_gain = (const float*)d_in[7]; p.ret_bias = (const float*)d_in[8]; p.w_out = (const float*)d_in[9]; p.g2 = (const float*)d_in[10];
    p.w_q = (const float*)d_in[11]; p.subkeys = (const float*)d_in[12]; p.pu = (const float*)d_in[13]; p.pv = (const float*)d_in[14]; p.gfin = (const float*)d_in[15];
    p.out = (float*)d_out; p.ws = (unsigned char*)d_ws;
#if MK_FUSED
    p.ph_lo = 0; p.ph_hi = NPHASE;
    void* args[] = {&p};
    hipError_t e = hipLaunchCooperativeKernel((const void*)mk_fwd, dim3(grid), dim3(512), args, LDS_BYTES, stream);
    if (e != hipSuccess) fprintf(stderr, "kernel_launch: cooperative launch failed: %s (grid %d)\n", hipGetErrorString(e), grid);
#else
    { const int order[7] = {0, 1, 2, 3, 4, 5, 6}; for (int i = 0; i < 7; ++i) { p.ph_lo = order[i]; p.ph_hi = order[i] + 1; hipLaunchKernelGGL(mk_fwd, dim3(grid), dim3(512), LDS_BYTES, stream, p); } }
#endif
}
```

```cpp
#include <hip/hip_runtime.h>
#include <hip/hip_cooperative_groups.h>
#include <cstdio>
#include <cstdint>
namespace cg = cooperative_groups;
namespace pg8 {
#define PG8_LAS __attribute__((address_space(3)))
typedef unsigned short bf16_t;
typedef short bf16x8 __attribute__((ext_vector_type(8)));
typedef float f32x4 __attribute__((ext_vector_type(4)));
typedef unsigned u32x4 __attribute__((ext_vector_type(4)));
constexpr int BM = 256, BK = 64, HALF = 128, HTB = HALF * BK * 2  , STAGE_BYTES = 8 * HTB, NXCD = 8, WGM = 8;

__host__ __device__ __forceinline__ int lds_byte(int r, int c) { const int st = (r >> 4) * 2 + (c >> 5), rr = r & 15, cc = c & 31, ob = rr * 64 + cc * 2; return st * 1024 + (ob ^ (((ob >> 9) & 1) << 5)); }
__host__ __device__ __forceinline__ void stage_rc(int b, int& R, int& C) { const int st = b / 1024, sb = b % 1024, swz = sb ^ (((sb >> 9) & 1) << 5); R = (st >> 1) * 16 + swz / 64; C = (st & 1) * 32 + (swz % 64) / 2; }
__host__ __device__ __forceinline__ int perm32(int rho) { const int n = rho >> 4, i = rho & 15; return 8 * (i >> 2) + 4 * n + (i & 3); }

struct Unit { int pm, pn; };
struct Gemm { const bf16_t* A; const bf16_t* Bt; int M, N, K; };

struct StaticOrder {
    int nM, nN, nwg, G, c;
    __host__ __device__ void init(int M, int N, int G_, int c_) { nM = M / BM; nN = N / BM; nwg = nM * nN; G = G_; c = c_; }
    __host__ __device__ bool next(int i, Unit& u) const {
        const long L = (long)i * G + c; if (L >= nwg) return false;
        int wgid = (int)L; { const int q = nwg / NXCD, r = nwg % NXCD, xcd = wgid % NXCD, off = wgid / NXCD; wgid = (xcd < r ? xcd * (q + 1) : r * (q + 1) + (xcd - r) * q) + off; }
        const int nig = WGM * nN, gid = wgid / nig, fm = gid * WGM, gsz = (nM - fm) < WGM ? (nM - fm) : WGM;
        u.pm = fm + ((wgid % nig) % gsz); u.pn = (wgid % nig) / gsz; return true;
    }
    __device__ __forceinline__ void a_ready(const Unit&) const {}
    __device__ __forceinline__ void done(const Unit&) const {}
};

__device__ __forceinline__ unsigned cvt_pk_bf16(float lo, float hi) { unsigned r; asm volatile("v_cvt_pk_bf16_f32 %0, %1, %2" : "=v"(r) : "v"(lo), "v"(hi)); return r; }
typedef float f32x2 __attribute__((ext_vector_type(2)));
template <class Epi, class Sched, bool ALIGN_EPI = false, bool SP2 = false>
__device__ __forceinline__ void gemm_phase(PG8_LAS unsigned char* lds, const Gemm g, const Sched& S, const Epi& E) {
    const int tid = threadIdx.x, wid = __builtin_amdgcn_readfirstlane(tid >> 6), lane = tid & 63, wr = wid >> 2, wc = wid & 3, fr = lane & 15, fq = lane >> 4;
    const int K = g.K, nt = K / BK;
    unsigned voffA[2], voffB[2];
#pragma unroll
    for (int i = 0; i < 2; ++i) { int R, C; stage_rc(tid * 16 + i * 8192, R, C); const int Rb = Epi::PERM ? ((R & ~31) + perm32(R & 31)) : R;
        voffA[i] = (unsigned)(R * K + C) * 2u; voffB[i] = (unsigned)(Rb * K + C) * 2u; }
    const size_t kstep = (size_t)(BK * 2);
    const size_t hstep = (size_t)HALF * K * 2;
    const size_t tstep = 2 * hstep;
    const unsigned ldsw = (unsigned)wid * 1024u;
    const int aoff = lds_byte(wr * 64 + fr, fq * 8), boff = lds_byte(wc * 32 + fr, fq * 8);
#define PG8_SA(b, h) (((b) * 2 + (h)) * HTB)
#define PG8_SB(b, h) ((4 + (b) * 2 + (h)) * HTB)
#define PG8_STAGE(bufoff, gbase, voff) do { _Pragma("unroll") for (int _i = 0; _i < 2; ++_i) \
        __builtin_amdgcn_global_load_lds((const unsigned*)((const char*)(gbase) + (voff)[_i]), (PG8_LAS unsigned*)(lds + (bufoff) + ldsw + _i * 8192), 16, 0, 0); } while (0)
#define PG8_LDA(dst, b, h) do { _Pragma("unroll") for (int m = 0; m < 4; ++m) _Pragma("unroll") for (int k = 0; k < 2; ++k) dst[m][k] = *(const PG8_LAS bf16x8*)(lds + PG8_SA(b, h) + aoff + m * 2048 + k * 1024); } while (0)
#define PG8_LDB(dst, b, h) do { _Pragma("unroll") for (int n = 0; n < 2; ++n) _Pragma("unroll") for (int k = 0; k < 2; ++k) dst[n][k] = *(const PG8_LAS bf16x8*)(lds + PG8_SB(b, h) + boff + n * 2048 + k * 1024); } while (0)
#define PG8_MMA(ai, bj, At, Bt) do { __builtin_amdgcn_s_setprio(1); _Pragma("unroll") for (int m = 0; m < 4; ++m) _Pragma("unroll") for (int n = 0; n < 2; ++n) _Pragma("unroll") for (int k = 0; k < 2; ++k) \
        acc[ai][bj][m][n] = __builtin_amdgcn_mfma_f32_16x16x32_bf16(Bt[n][k], At[m][k], acc[ai][bj][m][n], 0, 0, 0); __builtin_amdgcn_s_setprio(0); } while (0)
#define PG8_WAIT_V(n) asm volatile("s_waitcnt vmcnt(" #n ")" ::: "memory")
#define PG8_WAIT_L(n) asm volatile("s_waitcnt lgkmcnt(" #n ")" ::: "memory")
#define PG8_BAR __builtin_amdgcn_s_barrier()
#define PG8_SCHED __builtin_amdgcn_sched_barrier(0)
    Unit cur, nxt; int ui = 0;
    if (!S.next(0, cur)) return;
    f32x4 acc[2][2][4][2];
#pragma unroll
    for (int a = 0; a < 2; ++a)
#pragma unroll
        for (int b = 0; b < 2; ++b)
#pragma unroll
            for (int m = 0; m < 4; ++m)
#pragma unroll
                for (int n = 0; n < 2; ++n) acc[a][b][m][n] = (f32x4){0.f, 0.f, 0.f, 0.f};
    bf16x8 At[4][2], B0[2][2], B1[2][2];
    const char* cA = (const char*)g.A + (size_t)cur.pm * tstep; const char* cB = (const char*)g.Bt + (size_t)cur.pn * tstep;
    S.a_ready(cur);
    if constexpr (SP2) {
        PG8_STAGE(PG8_SB(0, 0), cB, voffB); PG8_STAGE(PG8_SB(0, 1), cB + hstep, voffB); PG8_STAGE(PG8_SA(0, 0), cA, voffA); PG8_STAGE(PG8_SA(0, 1), cA + hstep, voffA);
        if (wr == 1) PG8_BAR;
        PG8_WAIT_V(2); PG8_BAR;
        PG8_STAGE(PG8_SB(1, 0), cB + kstep, voffB); PG8_STAGE(PG8_SA(1, 0), cA + kstep, voffA); PG8_STAGE(PG8_SB(1, 1), cB + hstep + kstep, voffB);
        PG8_WAIT_V(6); PG8_BAR;
    } else {
        PG8_STAGE(PG8_SB(0, 0), cB, voffB); PG8_STAGE(PG8_SA(0, 0), cA, voffA); PG8_STAGE(PG8_SB(0, 1), cB + hstep, voffB); PG8_STAGE(PG8_SA(0, 1), cA + hstep, voffA);
        if (wr == 1) PG8_BAR;
        PG8_WAIT_V(4); PG8_BAR;
        PG8_STAGE(PG8_SB(1, 0), cB + kstep, voffB); PG8_STAGE(PG8_SA(1, 0), cA + kstep, voffA); PG8_STAGE(PG8_SB(1, 1), cB + hstep + kstep, voffB);
        PG8_WAIT_V(6); PG8_BAR;
    }
    for (;;) {
        const bool has_next = S.next(ui + 1, nxt);
        const char* nA = has_next ? (const char*)g.A + (size_t)nxt.pm * tstep : cA; const char* nB = has_next ? (const char*)g.Bt + (size_t)nxt.pn * tstep : cB;
        for (int t = 0; t < nt; t += 2) {
            const bool last = (t == nt - 2);
            const char* a1 = cA + (size_t)(t + 1) * kstep;
            const char* a2 = last ? nA : cA + (size_t)(t + 2) * kstep; const char* b2 = last ? nB : cB + (size_t)(t + 2) * kstep;
            const char* a3 = a2 + kstep; const char* b3 = b2 + kstep;
            if (last && has_next) S.a_ready(nxt);
            if constexpr (SP2) {
            PG8_LDB(B0, 0, 0); PG8_LDB(B1, 0, 1); PG8_SCHED; PG8_LDA(At, 0, 0); PG8_STAGE(PG8_SA(1, 1), a1 + hstep, voffA);
            PG8_WAIT_V(8); PG8_WAIT_L(0); PG8_BAR; PG8_MMA(0, 0, At, B0); PG8_MMA(0, 1, At, B1); PG8_BAR; PG8_SCHED;
            PG8_LDA(At, 0, 1); PG8_STAGE(PG8_SB(0, 0), b2, voffB); PG8_STAGE(PG8_SB(0, 1), b2 + hstep, voffB); PG8_STAGE(PG8_SA(0, 0), a2, voffA);
            PG8_WAIT_V(8); PG8_WAIT_L(0); PG8_BAR; PG8_MMA(1, 0, At, B0); PG8_MMA(1, 1, At, B1); PG8_BAR; PG8_SCHED;
            PG8_LDB(B0, 1, 0); PG8_LDB(B1, 1, 1); PG8_SCHED; PG8_LDA(At, 1, 0); PG8_STAGE(PG8_SA(0, 1), a2 + hstep, voffA);
            PG8_WAIT_V(8); PG8_WAIT_L(0); PG8_BAR; PG8_MMA(0, 0, At, B0); PG8_MMA(0, 1, At, B1); PG8_BAR; PG8_SCHED;
            PG8_LDA(At, 1, 1); PG8_STAGE(PG8_SB(1, 0), b3, voffB); PG8_STAGE(PG8_SB(1, 1), b3 + hstep, voffB); PG8_STAGE(PG8_SA(1, 0), a3, voffA);
            PG8_WAIT_V(8); PG8_WAIT_L(0); PG8_BAR; PG8_MMA(1, 0, At, B0); PG8_MMA(1, 1, At, B1); PG8_BAR; PG8_SCHED;
            } else {
            PG8_LDB(B0, 0, 0); PG8_SCHED; PG8_LDA(At, 0, 0); PG8_STAGE(PG8_SA(1, 1), a1 + hstep, voffA);
            PG8_WAIT_L(8); PG8_BAR; PG8_WAIT_L(0); PG8_MMA(0, 0, At, B0); PG8_BAR; PG8_SCHED;
            PG8_LDB(B1, 0, 1); PG8_STAGE(PG8_SB(0, 0), b2, voffB);
            PG8_BAR; PG8_WAIT_L(0); PG8_MMA(0, 1, At, B1); PG8_BAR;
            PG8_LDA(At, 0, 1); PG8_STAGE(PG8_SA(0, 0), a2, voffA);
            PG8_BAR; PG8_WAIT_L(0); PG8_MMA(1, 0, At, B0); PG8_BAR; PG8_SCHED;
            PG8_STAGE(PG8_SB(0, 1), b2 + hstep, voffB);
            PG8_WAIT_V(6); PG8_BAR; PG8_MMA(1, 1, At, B1); PG8_BAR;
            PG8_LDB(B0, 1, 0); PG8_SCHED; PG8_LDA(At, 1, 0); PG8_STAGE(PG8_SA(0, 1), a2 + hstep, voffA);
            PG8_WAIT_L(8); PG8_BAR; PG8_WAIT_L(0); PG8_MMA(0, 0, At, B0); PG8_BAR; PG8_SCHED;
            PG8_LDB(B1, 1, 1); PG8_STAGE(PG8_SB(1, 0), b3, voffB);
            PG8_BAR; PG8_WAIT_L(0); PG8_MMA(0, 1, At, B1); PG8_BAR;
            PG8_LDA(At, 1, 1); PG8_STAGE(PG8_SA(1, 0), a3, voffA);
            PG8_BAR; PG8_WAIT_L(0); PG8_MMA(1, 0, At, B0); PG8_BAR; PG8_SCHED;
            PG8_STAGE(PG8_SB(1, 1), b3 + hstep, voffB);
            PG8_WAIT_V(6); PG8_BAR; PG8_MMA(1, 1, At, B1); PG8_BAR;
            }
        }
        if constexpr (ALIGN_EPI) { if (wr == 0) PG8_BAR; }
        if constexpr (!Epi::AFTER_DRAIN) { E(acc, cur, wr, wc, fr, fq); S.done(cur); }
        if (!has_next) break;
#pragma unroll
        for (int a = 0; a < 2; ++a)
#pragma unroll
            for (int b = 0; b < 2; ++b)
#pragma unroll
                for (int m = 0; m < 4; ++m)
#pragma unroll
                    for (int n = 0; n < 2; ++n) acc[a][b][m][n] = (f32x4){0.f, 0.f, 0.f, 0.f};
        cur = nxt; cA = nA; cB = nB; ++ui;
        if constexpr (ALIGN_EPI) { if (wr == 1) PG8_BAR; }
    }
    PG8_WAIT_V(0);
    if constexpr (!ALIGN_EPI) { if (wr == 0) PG8_BAR; }
    PG8_BAR;
    if constexpr (Epi::AFTER_DRAIN) { E.fused(acc, cur, wr, wc, fr, fq, lds, wid, lane); S.done(cur); }
#undef PG8_SA
#undef PG8_SB
#undef PG8_STAGE
#undef PG8_LDA
#undef PG8_LDB
#undef PG8_MMA
#undef PG8_WAIT_V
#undef PG8_WAIT_L
#undef PG8_BAR
#undef PG8_SCHED
}
}

#define LAS __attribute__((address_space(3)))
typedef unsigned short bf16_t;
typedef float f32x4 __attribute__((ext_vector_type(4)));
typedef unsigned u32x4 __attribute__((ext_vector_type(4)));
typedef unsigned u32x2 __attribute__((ext_vector_type(2)));
typedef int i32x8 __attribute__((ext_vector_type(8)));
#define MX_ONE 0x7f7f7f7f
typedef short bf16x8 __attribute__((ext_vector_type(8)));
typedef short s16x4 __attribute__((ext_vector_type(4)));
typedef __bf16 bf16x2_t __attribute__((ext_vector_type(2)));
typedef _Float16 f16x2_t __attribute__((ext_vector_type(2)));
typedef float f32x2v __attribute__((ext_vector_type(2)));
typedef _Float16 h2v __attribute__((ext_vector_type(2)));

constexpr int DM = 1024, NB = 4, SEQ = 8192, NTOK = NB * SEQ;
constexpr int MROWS = NTOK + 256;
constexpr int INW = 3088;
constexpr int NPROJ = 3072, NP1 = 3328;
constexpr int NEXP = 16384;
constexpr float EPS = 1e-6f;
constexpr int C_GQ = 0, C_GK = 256, C_GV = 512, C_GG = 1024, C_RQ = 1536, C_RK = 1792, C_RV = 2048, C_RG = 2560;
constexpr int S_GA = 1536, S_RQ = 1552, S_RV = 2064;

constexpr int NVG = 2048;
constexpr int NCH = (NTOK + 256) / 64;
constexpr size_t QK_ARR = (size_t)NCH * 4 * 8 * 64 * 8;
constexpr size_t MiB = 1u << 20;
constexpr size_t WS_CTL = 0, WS_WIN = 1 * MiB, WS_WOUT = 8 * MiB, WS_WS = 10 * MiB, WS_ROPE = 14 * MiB, WS_SSQ = 17 * MiB, WS_SEG = 19 * MiB, WS_ASEG = 27 * MiB,
                 WS_UB = 28 * MiB, WS_VB = 60 * MiB, WS_XN = 92 * MiB, WS_O = 157 * MiB, WS_LA = 221 * MiB, WS_PROJ = 254 * MiB, WS_QK = 383 * MiB, WS_XQ = 448 * MiB, WS_END = 480 * MiB;
static_assert(WS_WIN + (size_t)NP1 * DM * 2 <= WS_WOUT && WS_ROPE + (size_t)(SEQ + 64) * 32 * 8 <= WS_SSQ && WS_XN + (size_t)MROWS * DM * 2 <= WS_O &&
              WS_LA + QK_ARR * 4 <= WS_PROJ && WS_PROJ + (size_t)MROWS * NVG * 2 <= WS_QK && WS_QK + 4 * QK_ARR * 2 <= WS_XQ && WS_PROJ + (size_t)NTOK * 2048 * 2 <= WS_QK, "ws map");

constexpr int LDS_BYTES = 147456;
constexpr int NPHASE = 7;
#ifndef PROBE_R
#define PROBE_R 1
#define PROBE_U 1
#define PROBE_V 1
#endif
#ifndef PEER_FP8
#define PEER_FP8 1
#endif

struct Params {
    const float *x, *meta, *g1, *w_in, *gw2, *gb, *gla_gain, *ret_gain, *ret_bias, *w_out, *g2, *w_q, *subkeys, *pu, *pv, *gfin;
    float* out; unsigned char* ws;
    int ph_lo, ph_hi;
};

#define LDS_WAIT() asm volatile("s_waitcnt lgkmcnt(0)" ::: "memory")
__device__ __forceinline__ unsigned pk2(float lo, float hi) { const bf16x2_t v = {(__bf16)lo, (__bf16)hi}; return __builtin_bit_cast(unsigned, v); }
__device__ __forceinline__ unsigned f2bf(float f) { return (unsigned)__builtin_bit_cast(unsigned short, (__bf16)f); }

__device__ __forceinline__ float bf_lo(unsigned w) { return __builtin_bit_cast(float, w << 16); }
__device__ __forceinline__ float bf_hi(unsigned w) { return __builtin_bit_cast(float, w & 0xffff0000u); }
__device__ __forceinline__ float bf1(bf16_t h) { return __builtin_bit_cast(float, (unsigned)h << 16); }
__device__ __forceinline__ float wave_sum(float v) {
#pragma unroll
    for (int o = 1; o < 64; o <<= 1) v += __shfl_xor(v, o);
    return v;
}

struct MapIn {
    __device__ __forceinline__ void operator()(int j, int& src, float& sc) const {
        if (j < C_RQ) { src = j; sc = (j < 256) ? 0.125f : 1.0f; }
        else if (j < C_RV) { const int jj = j - C_RQ, which = jj >> 8, within = jj & 255, head = within >> 6, p = within & 63;
            const int a = p >> 3, n = (p >> 2) & 1, i = p & 3; src = S_RQ + which * 256 + head * 64 + 32 * n + 4 * a + i; sc = which ? 0.125f : 1.0f; }
        else { src = S_RV + (j - C_RV); sc = 1.0f; }
    }
};
struct MapId { __device__ __forceinline__ void operator()(int j, int& src, float& sc) const { src = j; sc = 1.0f; } };

template <class Map>
__device__ __forceinline__ void transpose_item(const float* W, int K, int N, bf16_t* WT, LAS float* scr, int item, int nblk, int lane, const Map map) {
    const int kb = item / nblk, nb = item % nblk, k0 = 64 * kb, n0 = 32 * nb;
    int src; float sc; map(n0 + (lane & 31), src, sc);
#pragma unroll 8
    for (int i = 0; i < 32; ++i) { const int kk = 2 * i + (lane >> 5); scr[kk * 33 + (lane & 31)] = W[(size_t)(k0 + kk) * N + src] * sc; }
    LDS_WAIT();
    const int c = lane & 7;
#pragma unroll
    for (int j = 0; j < 4; ++j) { const int n = (lane >> 3) + 8 * j; const LAS float* s = scr + (8 * c) * 33 + n;
        u32x4 o; o.x = pk2(s[0 * 33], s[1 * 33]); o.y = pk2(s[2 * 33], s[3 * 33]); o.z = pk2(s[4 * 33], s[5 * 33]); o.w = pk2(s[6 * 33], s[7 * 33]);
        *(u32x4*)(WT + (size_t)(n0 + n) * K + k0 + 8 * c) = o; }
    LDS_WAIT();
}

__device__ __forceinline__ void phase0(const Params& p, LAS unsigned char* lds, int bid, int nb) {
    const int tid = threadIdx.x, lane = tid & 63, wave = __builtin_amdgcn_readfirstlane(tid >> 6);
    unsigned char* ws = p.ws;
    bf16_t* XN = (bf16_t*)(ws + WS_XN); bf16_t* WinT = (bf16_t*)(ws + WS_WIN); bf16_t* WoutT = (bf16_t*)(ws + WS_WOUT); bf16_t* WsT = (bf16_t*)(ws + WS_WS);
    const int gw = bid * 8 + wave, NGW = nb * 8;
    const int gt = bid * 512 + tid, NGT = nb * 512;

    {
        LAS float* SKT = (LAS float*)lds;
        LAS float* WQT = (LAS float*)(lds + 128 * 132 * 4);
        for (int item = bid; item < 256; item += nb) {
            const int hc = item >> 4, kb = item & 15;
            __syncthreads();
            for (int e = tid; e < 128 * 128; e += 512) { const int n = e >> 7, d = e & 127; SKT[d * 132 + n] = p.subkeys[(size_t)hc * 16384 + e]; }
            for (int e = tid; e < 64 * 128; e += 512) { const int k = e >> 7, d = e & 127; WQT[d * 68 + k] = p.w_q[(size_t)(kb * 64 + k) * 2048 + hc * 128 + d]; }
            __syncthreads();
            const int tn = tid & 31, tk = tid >> 5;
            f32x4 acc[4];
#pragma unroll
            for (int i = 0; i < 4; ++i) acc[i] = (f32x4){0.f, 0.f, 0.f, 0.f};
#pragma unroll 4
            for (int d = 0; d < 128; ++d) {
                const f32x4 sk = *(const LAS f32x4*)(SKT + d * 132 + 4 * tn); const f32x4 wq = *(const LAS f32x4*)(WQT + d * 68 + 4 * tk);
#pragma unroll
                for (int i = 0; i < 4; ++i) acc[i] += sk[i] * wq;
            }
            const f32x4 gg = *(const f32x4*)(p.g2 + kb * 64 + 4 * tk);
#pragma unroll
            for (int i = 0; i < 4; ++i) { const f32x4 v = acc[i] * gg; u32x2 o; o.x = pk2(v[0], v[1]); o.y = pk2(v[2], v[3]);
                *(u32x2*)(WsT + (size_t)(hc * 128 + 4 * tn + i) * DM + kb * 64 + 4 * tk) = o; }
        }
        __syncthreads();
    }
    {
        LAS float* scr = (LAS float*)(lds + wave * 16384);
        constexpr int I_IN = (DM / 64) * (NPROJ / 32), I_OUT = (DM / 64) * (DM / 32);
        for (int it = gw; it < I_IN + I_OUT; it += NGW) {
            if (it < I_IN) transpose_item(p.w_in, DM, INW, WinT, scr, it, NPROJ / 32, lane, MapIn());
            else transpose_item(p.w_out, DM, DM, WoutT, scr, it - I_IN, DM / 32, lane, MapId());
        }
    }
    for (int e = gt; e < 256 * DM; e += NGT) {
        const int n = e >> 10, k = e & 1023; const float* wr = p.w_in + (size_t)k * INW + S_GA; float s = 0.f;
#pragma unroll
        for (int r = 0; r < 16; ++r) s += wr[r] * p.gw2[r * 256 + n];
        WinT[(size_t)(NPROJ + n) * DM + k] = (bf16_t)f2bf(s);
    }
#if PEER_FP8
    {
        u32x4* U4 = (u32x4*)(ws + WS_UB); u32x4* V8 = (u32x4*)(ws + WS_VB);
        for (int e = gt; e < NEXP * DM / 32; e += NGT) {
            const f32x4* us = (const f32x4*)p.pu + 8 * (size_t)e; const f32x4* vs = (const f32x4*)p.pv + 8 * (size_t)e;
            const f32x4* g2s = (const f32x4*)p.g2 + 8 * (e & 31);
            unsigned tu[4], tv[8];
#pragma unroll
            for (int j = 0; j < 4; ++j) { const f32x4 a0 = us[2 * j] * g2s[2 * j] * 64.0f, a1 = us[2 * j + 1] * g2s[2 * j + 1] * 64.0f;
                unsigned w = 0u;
                w = __builtin_amdgcn_cvt_scalef32_pk_fp4_f32(w, a0[0], a0[1], 1.0f, 0); w = __builtin_amdgcn_cvt_scalef32_pk_fp4_f32(w, a0[2], a0[3], 1.0f, 1);
                w = __builtin_amdgcn_cvt_scalef32_pk_fp4_f32(w, a1[0], a1[1], 1.0f, 2); w = __builtin_amdgcn_cvt_scalef32_pk_fp4_f32(w, a1[2], a1[3], 1.0f, 3); tu[j] = w; }
#pragma unroll
            for (int j = 0; j < 8; ++j) { const f32x4 b = vs[j] * 32.0f;
                int x = __builtin_amdgcn_cvt_pk_fp8_f32(b[0], b[1], 0, false); x = __builtin_amdgcn_cvt_pk_fp8_f32(b[2], b[3], x, true); tv[j] = (unsigned)x; }
            const int row = e >> 5, c32 = e & 31;
            U4[((size_t)(c32 >> 3) * NEXP + row) * 8 + (c32 & 7)] = (u32x4){tu[0], tu[1], tu[2], tu[3]};
            const int c16 = 2 * c32; const size_t dv = ((size_t)(c16 >> 3) * NEXP + row) * 8 + (c16 & 7);
            V8[dv] = (u32x4){tv[0], tv[1], tv[2], tv[3]}; V8[dv + 1] = (u32x4){tv[4], tv[5], tv[6], tv[7]}; }
    }
#else
    {
        u32x2* UB = (u32x2*)(ws + WS_UB); u32x2* VB = (u32x2*)(ws + WS_VB);
        const f32x4* u4 = (const f32x4*)p.pu; const f32x4* v4 = (const f32x4*)p.pv;
        for (int e = gt; e < NEXP * DM / 4; e += NGT) { const f32x4 a = u4[e]; u32x2 o; o.x = pk2(a[0], a[1]); o.y = pk2(a[2], a[3]); UB[e] = o;
            const f32x4 b = v4[e]; u32x2 q; q.x = pk2(b[0], b[1]); q.y = pk2(b[2], b[3]); VB[e] = q; }
    }
#endif
    {
        float2* rope = (float2*)(ws + WS_ROPE);
        for (int e = gt; e < (SEQ + 64) * 32; e += NGT) { const int pi = e >> 5, d = e & 31;
            const float invf = (float)pow(10000.0, -(double)d / 32.0); const float ang = (float)(pi - 48) * invf;
            rope[e] = make_float2((float)cos((double)ang), (float)sin((double)ang)); }
    }
    for (int m0 = gw; m0 < MROWS; m0 += 4 * NGW) {
        const float* srcp[4]; f32x4 v[4][4];
#pragma unroll
        for (int u = 0; u < 4; ++u) { const int m = m0 + u * NGW; srcp[u] = nullptr;
            if (m < MROWS) { if (m >= 256) srcp[u] = p.x + (size_t)(m - 256) * DM; else if (m >= 48 && m < 64) srcp[u] = p.meta + (size_t)(m - 48) * DM; }
            if (srcp[u] != nullptr) { const f32x4* xr = (const f32x4*)srcp[u] + lane;
#pragma unroll
                for (int j = 0; j < 4; ++j) v[u][j] = xr[64 * j]; }
            else {
#pragma unroll
                for (int j = 0; j < 4; ++j) v[u][j] = (f32x4){0.f, 0.f, 0.f, 0.f}; } }
        f32x4 gg[4];
#pragma unroll
        for (int j = 0; j < 4; ++j) gg[j] = ((const f32x4*)p.g1 + lane)[64 * j];
#pragma unroll
        for (int u = 0; u < 4; ++u) { const int m = m0 + u * NGW; if (m >= MROWS) continue;
            float s = 0.f;
#pragma unroll
            for (int j = 0; j < 4; ++j) s += (v[u][j].x * v[u][j].x + v[u][j].y * v[u][j].y) + (v[u][j].z * v[u][j].z + v[u][j].w * v[u][j].w);
            const float r = (srcp[u] != nullptr) ? __builtin_amdgcn_rsqf(wave_sum(s) * (1.0f / DM) + EPS) : 0.f;
            unsigned long long* o8 = (unsigned long long*)(XN + (size_t)m * DM) + lane;
#pragma unroll
            for (int j = 0; j < 4; ++j) { const f32x4 y = v[u][j] * r * gg[j]; o8[64 * j] = (unsigned long long)pk2(y.x, y.y) | ((unsigned long long)pk2(y.z, y.w) << 32); } }
    }
}

struct EpiProj {
    static constexpr bool PERM = true, AFTER_DRAIN = false;
    bf16_t* VG; bf16_t* QK; float* LAT; const float* gb; const float2* rope;
    __device__ __forceinline__ static size_t tile_off(int r, int head, int dg) { return ((((size_t)(r >> 6) * 4 + head) * 8 + dg) * 64 + (r & 63)) * 8; }
    __device__ __forceinline__ void operator()(const pg8::f32x4 (&acc)[2][2][4][2], const pg8::Unit& u, int wr, int wc, int fr, int fq) const {
        const int row0 = u.pm * 256 + wr * 64 + fr, cb0 = wc * 32 + 8 * fq;
        if (u.pn == 12) {
#pragma unroll
            for (int bj = 0; bj < 2; ++bj) { const int c = cb0 + 128 * bj; const f32x4 b0 = *(const f32x4*)(gb + c), b1 = *(const f32x4*)(gb + c + 4);
#pragma unroll
                for (int ai = 0; ai < 2; ++ai)
#pragma unroll
                    for (int m = 0; m < 4; ++m) { const int row = row0 + ai * 128 + m * 16; f32x4 v0 = acc[ai][bj][m][0] + b0, v1 = acc[ai][bj][m][1] + b1;
#pragma unroll
                        for (int i = 0; i < 4; ++i) { v0[i] = (fminf(v0[i], 0.f) - __logf(1.0f + __expf(-fabsf(v0[i])))) * 0.0625f; v1[i] = (fminf(v1[i], 0.f) - __logf(1.0f + __expf(-fabsf(v1[i])))) * 0.0625f; }
                        float* o = LAT + tile_off(row, c >> 6, (c & 63) >> 3); *(f32x4*)o = v0; *(f32x4*)(o + 4) = v1; } }
        } else if (u.pn == 6 || u.pn == 7) {
            bf16_t* QA = QK + (size_t)(u.pn - 4) * QK_ARR;
#pragma unroll
            for (int ai = 0; ai < 2; ++ai)
#pragma unroll
                for (int m = 0; m < 4; ++m) { const int row = row0 + ai * 128 + m * 16; const int pidx = (row < 256) ? row : 64 + ((row - 256) & (SEQ - 1));
#pragma unroll
                    for (int bj = 0; bj < 2; ++bj) { const int c = cb0 + 128 * bj, d0 = (c & 63) >> 1;
                        const f32x4 cs0 = *(const f32x4*)(rope + (size_t)pidx * 32 + d0), cs1 = *(const f32x4*)(rope + (size_t)pidx * 32 + d0 + 2);
                        const f32x4 t1 = acc[ai][bj][m][0], t2 = acc[ai][bj][m][1];
                        const float co[4] = {cs0[0], cs0[2], cs1[0], cs1[2]}, si[4] = {cs0[1], cs0[3], cs1[1], cs1[3]};
                        float o1[4], o2[4];
#pragma unroll
                        for (int i = 0; i < 4; ++i) { o1[i] = t1[i] * co[i] - t2[i] * si[i]; o2[i] = t1[i] * si[i] + t2[i] * co[i]; }
                        u32x4 w; w.x = pg8::cvt_pk_bf16(o1[0], o1[1]); w.y = pg8::cvt_pk_bf16(o1[2], o1[3]); w.z = pg8::cvt_pk_bf16(o2[0], o2[1]); w.w = pg8::cvt_pk_bf16(o2[2], o2[3]);
                        *(u32x4*)(QA + tile_off(row, c >> 6, (c & 63) >> 3)) = w; } }
        } else if (u.pn <= 1) {
            bf16_t* QA = QK + (size_t)u.pn * QK_ARR;
#pragma unroll
            for (int ai = 0; ai < 2; ++ai)
#pragma unroll
                for (int m = 0; m < 4; ++m) { const int row = row0 + ai * 128 + m * 16;
#pragma unroll
                    for (int bj = 0; bj < 2; ++bj) { const int c = cb0 + 128 * bj; const f32x4 v0 = acc[ai][bj][m][0], v1 = acc[ai][bj][m][1];
                        u32x4 w; w.x = pg8::cvt_pk_bf16(v0[0], v0[1]); w.y = pg8::cvt_pk_bf16(v0[2], v0[3]); w.z = pg8::cvt_pk_bf16(v1[0], v1[1]); w.w = pg8::cvt_pk_bf16(v1[2], v1[3]);
                        *(u32x4*)(QA + tile_off(row, c >> 6, (c & 63) >> 3)) = w; } }
        } else {
            const int cdst = (u.pn < 6 ? (u.pn - 2) : (u.pn - 4)) * 256;
#pragma unroll
            for (int ai = 0; ai < 2; ++ai)
#pragma unroll
                for (int m = 0; m < 4; ++m) { bf16_t* rowp = VG + (size_t)(row0 + ai * 128 + m * 16) * NVG + cdst + cb0;
#pragma unroll
                    for (int bj = 0; bj < 2; ++bj) { const f32x4 v0 = acc[ai][bj][m][0], v1 = acc[ai][bj][m][1];
                        u32x4 w; w.x = pg8::cvt_pk_bf16(v0[0], v0[1]); w.y = pg8::cvt_pk_bf16(v0[2], v0[3]); w.z = pg8::cvt_pk_bf16(v1[0], v1[1]); w.w = pg8::cvt_pk_bf16(v1[2], v1[3]);
                        *(u32x4*)(rowp + bj * 128) = w; } }
        }
    }
};
struct EpiRes {
    static constexpr bool PERM = true, AFTER_DRAIN = false;
    const float* x; bf16_t* HB; float* SSQ;
    __device__ __forceinline__ void operator()(const pg8::f32x4 (&acc)[2][2][4][2], const pg8::Unit& u, int wr, int wc, int fr, int fq) const {
        const int row0 = u.pm * 256 + wr * 64 + fr, col0 = u.pn * 256 + wc * 32 + 8 * fq;
#pragma unroll
        for (int ai = 0; ai < 2; ++ai)
#pragma unroll
            for (int m = 0; m < 4; ++m) { const int row = row0 + ai * 128 + m * 16; const float* xr = x + (size_t)row * DM + col0; bf16_t* hr = HB + (size_t)row * DM + col0; float ss = 0.f;
#pragma unroll
                for (int bj = 0; bj < 2; ++bj) { const f32x4 v0 = acc[ai][bj][m][0] + *(const f32x4*)(xr + bj * 128), v1 = acc[ai][bj][m][1] + *(const f32x4*)(xr + bj * 128 + 4);
                    ss += (v0[0] * v0[0] + v0[1] * v0[1]) + (v0[2] * v0[2] + v0[3] * v0[3]) + (v1[0] * v1[0] + v1[1] * v1[1]) + (v1[2] * v1[2] + v1[3] * v1[3]);
                    u32x4 w; w.x = pg8::cvt_pk_bf16(v0[0], v0[1]); w.y = pg8::cvt_pk_bf16(v0[2], v0[3]); w.z = pg8::cvt_pk_bf16(v1[0], v1[1]); w.w = pg8::cvt_pk_bf16(v1[2], v1[3]);
                    *(u32x4*)(hr + bj * 128) = w; }
                ss += __shfl_xor(ss, 16); ss += __shfl_xor(ss, 32);
                if (fq == 0) SSQ[(size_t)row * 16 + u.pn * 4 + wc] = ss; }
    }
};
struct EpiF16 {
    static constexpr bool PERM = true, AFTER_DRAIN = false;
    _Float16* SC;
    __device__ __forceinline__ void operator()(const pg8::f32x4 (&acc)[2][2][4][2], const pg8::Unit& u, int wr, int wc, int fr, int fq) const {
        const int row0 = u.pm * 256 + wr * 64 + fr, col0 = u.pn * 256 + wc * 32 + 8 * fq;
#pragma unroll
        for (int ai = 0; ai < 2; ++ai)
#pragma unroll
            for (int m = 0; m < 4; ++m) { _Float16* rowp = SC + (size_t)(row0 + ai * 128 + m * 16) * 2048 + col0;
#pragma unroll
                for (int bj = 0; bj < 2; ++bj) { const f32x4 v0 = acc[ai][bj][m][0], v1 = acc[ai][bj][m][1];
                    u32x4 w;
                    w.x = __builtin_bit_cast(unsigned, (f16x2_t){(_Float16)v0[0], (_Float16)v0[1]}); w.y = __builtin_bit_cast(unsigned, (f16x2_t){(_Float16)v0[2], (_Float16)v0[3]});
                    w.z = __builtin_bit_cast(unsigned, (f16x2_t){(_Float16)v1[0], (_Float16)v1[1]}); w.w = __builtin_bit_cast(unsigned, (f16x2_t){(_Float16)v1[2], (_Float16)v1[3]});
                    *(u32x4*)(rowp + bj * 128) = w; } }
    }
};

constexpr int A_QT = 0, A_KT = 9216, A_KE = 18432, A_V = 27648, A_ST = 45056, A_STSZ = 18432, A_OB = 81920, A_DEC = 115712, A_CS = 115968;
constexpr int PQ = 72, PV = 136, POB = 132;

__device__ __forceinline__ bf16x8 tr2(const LAS bf16_t* p0, const LAS bf16_t* p1) {
    const s16x4 a = __builtin_amdgcn_ds_read_tr16_b64_v4i16((LAS s16x4*)p0), b = __builtin_amdgcn_ds_read_tr16_b64_v4i16((LAS s16x4*)p1);
    return (bf16x8){a[0], a[1], a[2], a[3], b[0], b[1], b[2], b[3]};
}
__device__ __forceinline__ float ln_gamma(int hr) { return log1pf(-exp2f(-5.0f - (float)hr)); }

template <bool FULL>
__device__ __forceinline__ void attn_pass(const Params& p, LAS unsigned char* lds, int bid, int nb) {
    const int tid = threadIdx.x, lane = tid & 63, wave = __builtin_amdgcn_readfirstlane(tid >> 6);
    const int r16 = lane & 15, g4 = lane >> 4, q4 = (lane & 15) >> 2, p4 = lane & 3;
    unsigned char* ws = p.ws;
    const bf16_t* PROJ = (const bf16_t*)(ws + WS_PROJ); const float* LA = (const float*)(ws + WS_LA); const bf16_t* QK = (const bf16_t*)(ws + WS_QK);
    float* SEG = (float*)(ws + WS_SEG); float* ASEG = (float*)(ws + WS_ASEG); float* SEGM = (float*)(ws + WS_ASEG + 65536); bf16_t* OUT = (bf16_t*)(ws + WS_O);
    LAS bf16_t* QT = (LAS bf16_t*)(lds + A_QT); LAS bf16_t* KT = (LAS bf16_t*)(lds + A_KT); LAS bf16_t* KE = (LAS bf16_t*)(lds + A_KE); LAS bf16_t* VS = (LAS bf16_t*)(lds + A_V);
    LAS float* OB = (LAS float*)(lds + A_OB); LAS float* DEC = (LAS float*)(lds + A_DEC); LAS float* CS = (LAS float*)(lds + A_CS);

    for (int item = bid; item < 256; item += nb) {
        const int seg = item & 7, h8 = (item >> 3) & 7, b = item >> 6;
        const bool metaitem = !FULL && seg == 7 && b == 0;
        if (!FULL && seg == 7 && !metaitem) continue;
        const bool gla = h8 < 4; const int hr = h8 & 3;
        const float lng = ln_gamma(hr);
        const bf16_t* QAq = QK + (size_t)(gla ? 0 : 2) * QK_ARR; const bf16_t* QAk = QK + (size_t)(gla ? 1 : 3) * QK_ARR;
        const int vcol = (gla ? 0 : 1024) + hr * 128, gcol = (gla ? 512 : 1536) + hr * 128;
        const int nch = metaitem ? 1 : 16;

        f32x4 accS[8];
#pragma unroll
        for (int cb = 0; cb < 8; ++cb) accS[cb] = (f32x4){0.f, 0.f, 0.f, 0.f};
        float blsum[8] = {0.f, 0.f, 0.f, 0.f, 0.f, 0.f, 0.f, 0.f};
        __syncthreads();
        if (FULL) {
            if (wave >= 4) {
                const int wq = wave - 4;
                { const float* Sm = SEGM + (size_t)h8 * 8192;
#pragma unroll
                  for (int cb = 0; cb < 8; ++cb)
#pragma unroll
                      for (int rg = 0; rg < 4; ++rg) accS[cb][rg] = Sm[(16 * wq + 4 * g4 + rg) * 128 + 16 * cb + r16]; }
                for (int sp = 0; sp < seg; ++sp) { const int it2 = (item & ~7) + sp; const float* Sg = SEG + (size_t)it2 * 8192; const float* Ag = ASEG + it2 * 64;
                    float dec[4];
#pragma unroll
                    for (int rg = 0; rg < 4; ++rg) dec[rg] = Ag[16 * wq + 4 * g4 + rg];
#pragma unroll
                    for (int cb = 0; cb < 8; ++cb)
#pragma unroll
                        for (int rg = 0; rg < 4; ++rg) accS[cb][rg] = dec[rg] * accS[cb][rg] + Sg[(16 * wq + 4 * g4 + rg) * 128 + 16 * cb + r16]; }
                LAS bf16_t* ST0 = (LAS bf16_t*)(lds + A_ST);
#pragma unroll
                for (int cb = 0; cb < 8; ++cb) { u32x2 w; w.x = pk2(accS[cb][0], accS[cb][1]); w.y = pk2(accS[cb][2], accS[cb][3]); *(LAS u32x2*)(ST0 + (16 * cb + r16) * PQ + 16 * wq + 4 * g4) = w; }
            }
        }
#define A_ROWBASE(ci_) (metaitem ? 0 : 256 + b * SEQ + (16 * seg + (ci_)) * 64)
        f32x4 lav[2]; u32x4 qv8, kv8; u32x4 vreg[2];
        qv8 = (u32x4){0u, 0u, 0u, 0u};
#define A_LOADCHUNK(ci_) do { const int _rb = A_ROWBASE(ci_); \
            const size_t _to = ((((size_t)(_rb >> 6) * 4 + hr) * 8 + wave) * 64 + lane) * 8;       \
            if (gla) { const f32x4* _lp = (const f32x4*)(LA + _to); lav[0] = _lp[0]; lav[1] = _lp[1]; } \
            else { lav[0] = (f32x4){lng, lng, lng, lng}; lav[1] = lav[0]; } \
            if (FULL) qv8 = *(const u32x4*)(QAq + _to); \
            kv8 = *(const u32x4*)(QAk + _to); \
            { const int vr = tid >> 3, cc = tid & 7; const u32x4* src = (const u32x4*)(PROJ + (size_t)(_rb + vr) * NVG + vcol + cc * 16); vreg[0] = src[0]; vreg[1] = src[1]; } } while (0)
#define A_LBAR() do { asm volatile("s_waitcnt lgkmcnt(0)" ::: "memory"); __builtin_amdgcn_s_barrier(); asm volatile("" ::: "memory"); } while (0)
        A_LOADCHUNK(0);
        f32x4 gnv[4], bsv[4];
        { const float* gptr = (gla ? p.gla_gain : p.ret_gain) + 16 * (tid & 7); const float* bptr = p.ret_bias + 16 * (tid & 7); const float bsc = gla ? 0.f : 1.f;
#pragma unroll
          for (int k4 = 0; k4 < 4; ++k4) { gnv[k4] = *(const f32x4*)(gptr + 4 * k4); bsv[k4] = *(const f32x4*)(bptr + 4 * k4) * bsc; } }
        for (int ci = 0; ci < nch; ++ci) {
            const bool metac = metaitem;
            const int rowbase = A_ROWBASE(ci);
            const LAS bf16_t* STr = (const LAS bf16_t*)(lds + A_ST + (ci & 1) * A_STSZ); LAS bf16_t* STw = (LAS bf16_t*)(lds + A_ST + ((ci + 1) & 1) * A_STSZ);
            u32x4 gpre[2] = {(u32x4){0u, 0u, 0u, 0u}, (u32x4){0u, 0u, 0u, 0u}};
            if (FULL && !metac) { const u32x4* gp = (const u32x4*)(PROJ + (size_t)(rowbase + (tid >> 3)) * NVG + gcol + 16 * (tid & 7)); gpre[0] = gp[0]; gpre[1] = gp[1]; }
            {
                float bc[8];
#pragma unroll
                for (int c = 0; c < 8; ++c) { float v = lav[c >> 2][c & 3];
                    v += __builtin_bit_cast(float, __builtin_amdgcn_update_dpp(0, __builtin_bit_cast(int, v), 0x111, 0xf, 0xf, true));
                    v += __builtin_bit_cast(float, __builtin_amdgcn_update_dpp(0, __builtin_bit_cast(int, v), 0x112, 0xf, 0xf, true));
                    v += __builtin_bit_cast(float, __builtin_amdgcn_update_dpp(0, __builtin_bit_cast(int, v), 0x114, 0xf, 0xf, true));
                    v += __builtin_bit_cast(float, __builtin_amdgcn_update_dpp(0, __builtin_bit_cast(int, v), 0x118, 0xf, 0xf, true));
                    v += __builtin_bit_cast(float, __builtin_amdgcn_update_dpp(0, __builtin_bit_cast(int, v), 0x142, 0xa, 0xf, false));
                    v += __builtin_bit_cast(float, __builtin_amdgcn_update_dpp(0, __builtin_bit_cast(int, v), 0x143, 0xc, 0xf, false));
                    bc[c] = v; }
                float tot[8];
#pragma unroll
                for (int c = 0; c < 8; ++c) { tot[c] = __builtin_bit_cast(float, __builtin_amdgcn_readlane(__builtin_bit_cast(int, bc[c]), 63)); blsum[c] += tot[c]; }
                const unsigned qw[4] = {qv8.x, qv8.y, qv8.z, qv8.w}, kw[4] = {kv8.x, kv8.y, kv8.z, kv8.w};
                unsigned oq[4], ok[4], oe[4];
#pragma unroll
                for (int c2 = 0; c2 < 4; ++c2) { const float k0 = bf_lo(kw[c2]), k1 = bf_hi(kw[c2]);
                    if (FULL) { oq[c2] = pk2(bf_lo(qw[c2]) * __expf(bc[2 * c2]), bf_hi(qw[c2]) * __expf(bc[2 * c2 + 1])); ok[c2] = pk2(k0 * __expf(-bc[2 * c2]), k1 * __expf(-bc[2 * c2 + 1])); }
                    oe[c2] = pk2(k0 * __expf(tot[2 * c2] - bc[2 * c2]), k1 * __expf(tot[2 * c2 + 1] - bc[2 * c2 + 1])); }
                if (FULL) { *(LAS u32x4*)(QT + lane * PQ + 8 * wave) = (u32x4){oq[0], oq[1], oq[2], oq[3]}; *(LAS u32x4*)(KT + lane * PQ + 8 * wave) = (u32x4){ok[0], ok[1], ok[2], ok[3]}; }
                *(LAS u32x4*)(KE + lane * PQ + 8 * wave) = (u32x4){oe[0], oe[1], oe[2], oe[3]};
                if (lane == 63) { *(LAS f32x4*)(DEC + 8 * wave) = (f32x4){__expf(tot[0]), __expf(tot[1]), __expf(tot[2]), __expf(tot[3])};
                                  *(LAS f32x4*)(DEC + 8 * wave + 4) = (f32x4){__expf(tot[4]), __expf(tot[5]), __expf(tot[6]), __expf(tot[7])}; }
                const int vr = tid >> 3, cc = tid & 7; LAS u32x4* dst = (LAS u32x4*)(VS + vr * PV + cc * 16); dst[0] = vreg[0]; dst[1] = vreg[1];
            }
            if (ci + 1 < nch) A_LOADCHUNK(ci + 1);
            A_LBAR();
            if (wave < 4) {
                if (FULL && !metac) {
                    const int w = wave;
                    bf16x8 qf[2];
#pragma unroll
                    for (int s = 0; s < 2; ++s) qf[s] = *(const LAS bf16x8*)(QT + (16 * w + r16) * PQ + 32 * s + 8 * g4);
                    f32x4 att[4];
#pragma unroll
                    for (int jb = 0; jb < 4; ++jb) { att[jb] = (f32x4){0.f, 0.f, 0.f, 0.f};
                        if (jb <= w) {
#pragma unroll
                            for (int s = 0; s < 2; ++s) { const bf16x8 kf = *(const LAS bf16x8*)(KT + (16 * jb + r16) * PQ + 32 * s + 8 * g4);
                                att[jb] = __builtin_amdgcn_mfma_f32_16x16x32_bf16(kf, qf[s], att[jb], 0, 0, 0); }
                            if (jb == w) {
#pragma unroll
                                for (int rg = 0; rg < 4; ++rg) att[jb][rg] = (4 * g4 + rg <= r16) ? att[jb][rg] : 0.f;
                            }
                        } }
                    bf16x8 af[2];
#pragma unroll
                    for (int s = 0; s < 2; ++s) { u32x4 t; t.x = pk2(att[2 * s][0], att[2 * s][1]); t.y = pk2(att[2 * s][2], att[2 * s][3]); t.z = pk2(att[2 * s + 1][0], att[2 * s + 1][1]); t.w = pk2(att[2 * s + 1][2], att[2 * s + 1][3]);
                        af[s] = __builtin_bit_cast(bf16x8, t); }
#pragma unroll
                    for (int cb = 0; cb < 8; ++cb) { f32x4 o = (f32x4){0.f, 0.f, 0.f, 0.f};
#pragma unroll
                        for (int s = 0; s < 2; ++s) {
                            const bf16x8 vf = tr2(VS + (32 * s + 4 * g4 + q4) * PV + 16 * cb + 4 * p4, VS + (32 * s + 16 + 4 * g4 + q4) * PV + 16 * cb + 4 * p4);
                            o = __builtin_amdgcn_mfma_f32_16x16x32_bf16(af[s], vf, o, 0, 0, 0);
                            const bf16x8 sf = *(const LAS bf16x8*)(STr + (16 * cb + r16) * PQ + 32 * s + 8 * g4);
                            o = __builtin_amdgcn_mfma_f32_16x16x32_bf16(qf[s], sf, o, 0, 0, 0); }
#pragma unroll
                        for (int rg = 0; rg < 4; ++rg) OB[(16 * w + 4 * g4 + rg) * POB + 16 * cb + r16] = o[rg]; }
                }
            } else {
                const int wq = wave - 4;
                float dec[4];
#pragma unroll
                for (int rg = 0; rg < 4; ++rg) dec[rg] = DEC[16 * wq + 4 * g4 + rg];
                bf16x8 kef[2];
#pragma unroll
                for (int s = 0; s < 2; ++s) kef[s] = tr2(KE + (32 * s + 8 * g4 + q4) * PQ + 16 * wq + 4 * p4, KE + (32 * s + 8 * g4 + 4 + q4) * PQ + 16 * wq + 4 * p4);
#pragma unroll
                for (int cb = 0; cb < 8; ++cb) {
#pragma unroll
                    for (int rg = 0; rg < 4; ++rg) accS[cb][rg] *= dec[rg];
#pragma unroll
                    for (int s = 0; s < 2; ++s) { const bf16x8 vf = tr2(VS + (32 * s + 8 * g4 + q4) * PV + 16 * cb + 4 * p4, VS + (32 * s + 8 * g4 + 4 + q4) * PV + 16 * cb + 4 * p4);
                        accS[cb] = __builtin_amdgcn_mfma_f32_16x16x32_bf16(kef[s], vf, accS[cb], 0, 0, 0); }
                    if (FULL) { u32x2 w; w.x = pk2(accS[cb][0], accS[cb][1]); w.y = pk2(accS[cb][2], accS[cb][3]); *(LAS u32x2*)(STw + (16 * cb + r16) * PQ + 16 * wq + 4 * g4) = w; }
                }
            }
            A_LBAR();
            if (FULL && !metac) {
                const int i = tid >> 3, cc = tid & 7;
                float o[16];
#pragma unroll
                for (int k4 = 0; k4 < 4; ++k4) { const f32x4 t = *(const LAS f32x4*)(OB + i * POB + 16 * cc + 4 * k4); o[4 * k4] = t[0]; o[4 * k4 + 1] = t[1]; o[4 * k4 + 2] = t[2]; o[4 * k4 + 3] = t[3]; }
                const size_t row = (size_t)(rowbase + i);
                const u32x4 ga = gpre[0], gb2 = gpre[1];
                const unsigned gw[8] = {ga.x, ga.y, ga.z, ga.w, gb2.x, gb2.y, gb2.z, gb2.w};
                float s1 = 0.f, s2 = 0.f;
#pragma unroll
                for (int k = 0; k < 16; ++k) { s1 += o[k]; s2 += o[k] * o[k]; }
#pragma unroll
                for (int m = 1; m < 8; m <<= 1) { s1 += __shfl_xor(s1, m); s2 += __shfl_xor(s2, m); }
                const float mu = gla ? 0.f : s1 * (1.0f / 128.0f);
                const float rs = __builtin_amdgcn_rsqf(fmaxf(s2 * (1.0f / 128.0f) - mu * mu, 0.f) + EPS);
                unsigned ow[8];
#pragma unroll
                for (int k2 = 0; k2 < 8; ++k2) { float y[2];
#pragma unroll
                    for (int e = 0; e < 2; ++e) { const int k = 2 * k2 + e; const float v = (o[k] - mu) * rs * gnv[k >> 2][k & 3] + bsv[k >> 2][k & 3];
                        const float gt = e ? bf_hi(gw[k2]) : bf_lo(gw[k2]); y[e] = v * gt * __builtin_amdgcn_rcpf(1.0f + __expf(-gt)); }
                    ow[k2] = pk2(y[0], y[1]); }
                u32x4* op = (u32x4*)(OUT + (row - 256) * DM + h8 * 128 + 16 * cc);
                op[0] = (u32x4){ow[0], ow[1], ow[2], ow[3]}; op[1] = (u32x4){ow[4], ow[5], ow[6], ow[7]};
            }
        }
        if (!FULL) {
            if (wave >= 4) { const int wq = wave - 4; float* Sg = metaitem ? SEGM + (size_t)h8 * 8192 : SEG + (size_t)item * 8192;
#pragma unroll
                for (int cb = 0; cb < 8; ++cb)
#pragma unroll
                    for (int rg = 0; rg < 4; ++rg) Sg[(16 * wq + 4 * g4 + rg) * 128 + 16 * cb + r16] = accS[cb][rg]; }
            if (lane < 8 && !metaitem) { float bl = blsum[0];
#pragma unroll
                for (int c = 1; c < 8; ++c) bl = (lane == c) ? blsum[c] : bl;
                ASEG[item * 64 + 8 * wave + lane] = __expf(bl); }
        }
#undef A_LBAR
#undef A_ROWBASE
#undef A_LOADCHUNK
    }
}

__device__ __forceinline__ unsigned ord32(float f) { const unsigned b = __builtin_bit_cast(unsigned, f); return b ^ ((b >> 31) ? 0xffffffffu : 0x80000000u); }
__device__ __forceinline__ float unord32(unsigned o) { const unsigned b = (o >> 31) ? (o ^ 0x80000000u) : ~o; return __builtin_bit_cast(float, b); }
#define DPP_MAXU(v, ctrl, rmask) do { const unsigned _t = (unsigned)__builtin_amdgcn_update_dpp((int)(v), (int)(v), (ctrl), (rmask), 0xf, false); (v) = (v) > _t ? (v) : _t; } while (0)
#define DPP_ADDF(v, ctrl) do { const float _t = __builtin_bit_cast(float, __builtin_amdgcn_update_dpp(0, __builtin_bit_cast(int, (v)), (ctrl), 0xf, 0xf, false)); (v) += _t; } while (0)
__device__ __forceinline__ unsigned row_max_u(unsigned v) { DPP_MAXU(v, 0xB1, 0xf); DPP_MAXU(v, 0x4E, 0xf); DPP_MAXU(v, 0x124, 0xf); DPP_MAXU(v, 0x128, 0xf); return v; }
__device__ __forceinline__ float row_sum_f(float v) { DPP_ADDF(v, 0xB1); DPP_ADDF(v, 0x4E); DPP_ADDF(v, 0x124); DPP_ADDF(v, 0x128); return v; }
__device__ __forceinline__ unsigned wave_max_u(unsigned v) { v = row_max_u(v); DPP_MAXU(v, 0x142, 0xa); DPP_MAXU(v, 0x143, 0xc); return (unsigned)__builtin_amdgcn_readlane((int)v, 63); }

__device__ __forceinline__ float row_sum_x(float v) { return row_sum_f(v); }
__device__ __forceinline__ float dot2_bf16(unsigned w, unsigned x, float acc) { return __builtin_amdgcn_fdot2_f32_bf16(__builtin_bit_cast(bf16x2_t, w), __builtin_bit_cast(bf16x2_t, x), acc, false); }
__device__ __forceinline__ float gelu_exact(float v) { return 0.5f * v * (1.0f + erff(v * 0.70710678118654752f)); }

__device__ __forceinline__ void phase_peer(const Params& p, LAS unsigned char* lds, int bid, int nb) {
    const int tid = threadIdx.x, lane = tid & 63, wave = __builtin_amdgcn_readfirstlane(tid >> 6);
    const int p16 = lane & 15, rg4 = lane >> 4;
    unsigned char* ws = p.ws;
    const _Float16* SC = (const _Float16*)(ws + WS_PROJ); const bf16_t* HB = (const bf16_t*)(ws + WS_XN); const float* SSQ = (const float*)(ws + WS_SSQ);
    const unsigned char* UB = (const unsigned char*)(ws + WS_UB); const unsigned char* VB = (const unsigned char*)(ws + WS_VB);
    LAS float* A_s = (LAS float*)(lds + wave * 4096);
    LAS int* A_i = (LAS int*)(lds + wave * 4096 + 1024);
    LAS int* E_i = (LAS int*)(lds + wave * 4096 + 2048);
    LAS float* E_s = (LAS float*)(lds + wave * 4096 + 2560);
    int ci = 0, cj = 0; bool cvalid = lane < 50;
    { int l = lane;
      if (l < 16) { ci = 0; cj = l; } else if (l < 24) { ci = 1; cj = l - 16; } else if (l < 29) { ci = 2; cj = l - 24; } else if (l < 33) { ci = 3; cj = l - 29; }
      else if (l < 36) { ci = 4; cj = l - 33; } else if (l < 42) { ci = 5 + (l - 36) / 2; cj = (l - 36) & 1; } else { ci = 8 + (l - 42); cj = 0; } if (!cvalid) { ci = 0; cj = 0; } }
    const int gw = bid * 8 + wave, NGW = nb * 8;
    for (int t = gw; t < NTOK; t += NGW) {
        float ssq = (lane < 16) ? SSQ[(size_t)t * 16 + lane] : 0.f; ssq = wave_sum(ssq);
        const float rstd = 1.0f / sqrtf(ssq * (1.0f / DM) + EPS);
#pragma unroll 1
        for (int q = 0; q < 4; ++q) {
            const u32x4 raw = *(const u32x4*)(SC + (size_t)t * 2048 + 512 * q + 8 * lane);
            const unsigned rw[4] = {raw.x, raw.y, raw.z, raw.w};
            unsigned key[8];
#pragma unroll
            for (int e = 0; e < 8; ++e) { const unsigned hbits = (e & 1) ? (rw[e >> 1] >> 16) : (rw[e >> 1] & 0xffffu);
                const float f = (float)__builtin_bit_cast(_Float16, (unsigned short)hbits);
                key[e] = (ord32(f) & ~0x7fu) | (unsigned)(127 - (8 * p16 + e)); }
            unsigned mine = 0u;
#pragma unroll 1
            for (int it = 0; it < 16; ++it) {
                unsigned m = key[0];
#pragma unroll
                for (int e = 1; e < 8; ++e) m = m > key[e] ? m : key[e];
                const unsigned W = row_max_u(m);
                mine = (p16 == it) ? W : mine;
#pragma unroll
                for (int e = 0; e < 8; ++e) key[e] = (key[e] == W) ? 0u : key[e];
            }
            const int g = 4 * q + rg4;
            A_s[g * 16 + p16] = unord32(mine & ~0x7fu); A_i[g * 16 + p16] = 127 - (int)(mine & 0x7fu);
        }
        LDS_WAIT();
#pragma unroll 1
        for (int h = 0; h < 8; ++h) {
            const float sa = A_s[(2 * h) * 16 + ci], sb = A_s[(2 * h + 1) * 16 + cj];
            const int ia = A_i[(2 * h) * 16 + ci], ib = A_i[(2 * h + 1) * 16 + cj];
            const float sum = sa + sb;
            unsigned key = cvalid ? ((ord32(sum) & ~0x3fu) | (unsigned)(63 - lane)) : 0u;
            int rank = -1;
#pragma unroll 1
            for (int it = 0; it < 16; ++it) { const unsigned W = wave_max_u(key); if (key == W) { rank = it; key = 0u; } }
            if (rank >= 0) { E_i[h * 16 + rank] = ia * 128 + ib; E_s[h * 16 + rank] = sum; }
        }
        LDS_WAIT();
        float gsm[2]; int eidx[2];
#pragma unroll
        for (int sl = 0; sl < 2; ++sl) { const int e = lane + 64 * sl; const float s = E_s[e] * rstd, mx = E_s[e & ~15] * rstd; const float pe = __expf(s - mx); const float den = row_sum_x(pe);
            gsm[sl] = pe / den; eidx[sl] = E_i[e]; }
#if PEER_FP8
        f32x2v xf[4][8];
#pragma unroll
        for (int i = 0; i < 4; ++i) { const u32x4 h0 = *(const u32x4*)(HB + (size_t)t * DM + 256 * i + 16 * p16), h1 = *(const u32x4*)(HB + (size_t)t * DM + 256 * i + 16 * p16 + 8);
            const unsigned hv[8] = {h0.x, h0.y, h0.z, h0.w, h1.x, h1.y, h1.z, h1.w}; const float* gp = p.g2 + 256 * i + 16 * p16;
#pragma unroll
            for (int k2 = 0; k2 < 8; ++k2) { const f32x2v g = *(const f32x2v*)(gp + 2 * k2); xf[i][k2] = (f32x2v){bf_lo(hv[k2]) * rstd * g.x, bf_hi(hv[k2]) * rstd * g.y}; } }
        constexpr int NBB = 2;
#define P6_LOADB(buf, TAB, bt0) do { _Pragma("unroll") for (int j = 0; j < NBB; ++j) { const int bt = (bt0) + j; const int ex = E_i[64 * (bt >> 4) + 16 * rg4 + (bt & 15)]; \
            const unsigned char* rp = (TAB) + (size_t)ex * 1024 + 16 * p16; _Pragma("unroll") for (int i = 0; i < 4; ++i) buf[j][i] = *(const u32x4*)(rp + 256 * i); } } while (0)
        u32x4 bA[NBB][4], bB[NBB][4];
        float act0 = 0.f, act1 = 0.f;
#define P6_COMPU(buf, bt0) do { _Pragma("unroll") for (int j = 0; j < NBB; ++j) { const int bt = (bt0) + j; f32x2v s2 = (f32x2v){0.f, 0.f}; \
            _Pragma("unroll") for (int i = 0; i < 4; ++i) { const unsigned uu[4] = {buf[j][i].x, buf[j][i].y, buf[j][i].z, buf[j][i].w}; \
                _Pragma("unroll") for (int w = 0; w < 4; ++w) { const f32x2v lo = __builtin_amdgcn_cvt_pk_f32_fp8((int)uu[w], false), hi = __builtin_amdgcn_cvt_pk_f32_fp8((int)uu[w], true); \
                    s2 = __builtin_elementwise_fma(lo, xf[i][2 * w], s2); s2 = __builtin_elementwise_fma(hi, xf[i][2 * w + 1], s2); } } \
            const float s = row_sum_x(s2.x + s2.y); const bool mine = (p16 == (bt & 15)); act0 = (mine && bt < 16) ? s : act0; act1 = (mine && bt >= 16) ? s : act1; } } while (0)
        P6_LOADB(bA, UB, 0);
#pragma unroll 1
        for (int g = 0; g < 32; g += 2 * NBB) { P6_LOADB(bB, UB, g + NBB); P6_COMPU(bA, g); if (g + 2 * NBB < 32) P6_LOADB(bA, UB, g + 2 * NBB); P6_COMPU(bB, g + NBB); }
        P6_LOADB(bA, VB, 0);
        LAS float* E_c = E_s;
        { const float c0 = gsm[0] * gelu_exact(act0 * (1.0f / 512.0f)) * (1.0f / 32.0f), c1 = gsm[1] * gelu_exact(act1 * (1.0f / 512.0f)) * (1.0f / 32.0f);
          LDS_WAIT(); E_c[lane] = c0; E_c[lane + 64] = c1; LDS_WAIT(); }
        f32x2v acc2[4][8];
#pragma unroll
        for (int i = 0; i < 4; ++i)
#pragma unroll
            for (int k = 0; k < 8; ++k) acc2[i][k] = (f32x2v){0.f, 0.f};
#define P6_COMPV(buf, bt0) do { _Pragma("unroll") for (int j = 0; j < NBB; ++j) { const int bt = (bt0) + j; const float cf = E_c[64 * (bt >> 4) + 16 * rg4 + (bt & 15)]; const f32x2v cf2 = (f32x2v){cf, cf}; \
            _Pragma("unroll") for (int i = 0; i < 4; ++i) { const unsigned vv[4] = {buf[j][i].x, buf[j][i].y, buf[j][i].z, buf[j][i].w}; \
                _Pragma("unroll") for (int w = 0; w < 4; ++w) { const f32x2v lo = __builtin_amdgcn_cvt_pk_f32_fp8((int)vv[w], false), hi = __builtin_amdgcn_cvt_pk_f32_fp8((int)vv[w], true); \
                    acc2[i][2 * w] = __builtin_elementwise_fma(lo, cf2, acc2[i][2 * w]); acc2[i][2 * w + 1] = __builtin_elementwise_fma(hi, cf2, acc2[i][2 * w + 1]); } } } } while (0)
#pragma unroll 1
        for (int g = 0; g < 32; g += 2 * NBB) { P6_LOADB(bB, VB, g + NBB); P6_COMPV(bA, g); if (g + 2 * NBB < 32) P6_LOADB(bA, VB, g + 2 * NBB); P6_COMPV(bB, g + NBB); }
#undef P6_LOADB
#undef P6_COMPU
#undef P6_COMPV
        float ss = 0.f;
#pragma unroll
        for (int i = 0; i < 4; ++i) { const u32x4 h0 = *(const u32x4*)(HB + (size_t)t * DM + 256 * i + 16 * p16), h1 = *(const u32x4*)(HB + (size_t)t * DM + 256 * i + 16 * p16 + 8);
            const unsigned hv[8] = {h0.x, h0.y, h0.z, h0.w, h1.x, h1.y, h1.z, h1.w};
#pragma unroll
            for (int k2 = 0; k2 < 8; ++k2) { float ax = acc2[i][k2].x, ay = acc2[i][k2].y;
                ax += __shfl_xor(ax, 16); ax += __shfl_xor(ax, 32); ay += __shfl_xor(ay, 16); ay += __shfl_xor(ay, 32);
                ax += bf_lo(hv[k2]); ay += bf_hi(hv[k2]); acc2[i][k2] = (f32x2v){ax, ay}; ss += ax * ax + ay * ay; } }
        ss = row_sum_x(ss);
        const float rf = 1.0f / sqrtf(ss * (1.0f / DM) + EPS);
#pragma unroll
        for (int i = 0; i < 4; ++i) { if (i == rg4) { const float* gp = p.gfin + 256 * i + 16 * p16; float* op = p.out + (size_t)t * DM + 256 * i + 16 * p16;
#pragma unroll
                for (int k4 = 0; k4 < 4; ++k4) { const f32x4 g = *(const f32x4*)(gp + 4 * k4);
                    *(f32x4*)(op + 4 * k4) = (f32x4){acc2[i][2 * k4].x * rf * g[0], acc2[i][2 * k4].y * rf * g[1], acc2[i][2 * k4 + 1].x * rf * g[2], acc2[i][2 * k4 + 1].y * rf * g[3]}; } } }
#else
        unsigned xp[8][4];
#pragma unroll
        for (int i = 0; i < 8; ++i) { const u32x4 hw = *(const u32x4*)(HB + (size_t)t * DM + 128 * i + 8 * p16); const f32x4 ga = *(const f32x4*)(p.g2 + 128 * i + 8 * p16), gb = *(const f32x4*)(p.g2 + 128 * i + 8 * p16 + 4);
            xp[i][0] = pk2(bf_lo(hw.x) * rstd * ga[0], bf_hi(hw.x) * rstd * ga[1]); xp[i][1] = pk2(bf_lo(hw.y) * rstd * ga[2], bf_hi(hw.y) * rstd * ga[3]);
            xp[i][2] = pk2(bf_lo(hw.z) * rstd * gb[0], bf_hi(hw.z) * rstd * gb[1]); xp[i][3] = pk2(bf_lo(hw.w) * rstd * gb[2], bf_hi(hw.w) * rstd * gb[3]); }
        float act[2] = {0.f, 0.f};
#pragma unroll
        for (int sl = 0; sl < 2; ++sl) {
#pragma unroll 2
            for (int b16 = 0; b16 < 16; ++b16) {
                const int e = 64 * sl + 16 * rg4 + b16; const int ex = E_i[e];
                const unsigned char* rowp = UB + (size_t)ex * 2048 + 16 * p16;
                float s = 0.f;
#pragma unroll
                for (int i = 0; i < 8; ++i) { const u32x4 uw = *(const u32x4*)(rowp + 256 * i);
                    s = dot2_bf16(uw.x, xp[i][0], s); s = dot2_bf16(uw.y, xp[i][1], s); s = dot2_bf16(uw.z, xp[i][2], s); s = dot2_bf16(uw.w, xp[i][3], s); }
                s = row_sum_x(s);
                act[sl] = (p16 == b16) ? s : act[sl];
            }
        }
        float coef[2];
#pragma unroll
        for (int sl = 0; sl < 2; ++sl) coef[sl] = gsm[sl] * gelu_exact(act[sl]);
        float acc[8][8];
#pragma unroll
        for (int i = 0; i < 8; ++i)
#pragma unroll
            for (int k = 0; k < 8; ++k) acc[i][k] = 0.f;
#pragma unroll
        for (int sl = 0; sl < 2; ++sl) {
#pragma unroll 2
            for (int b16 = 0; b16 < 16; ++b16) {
                const int srcl = (lane & 48) + b16;
                const float cf = __shfl(coef[sl], srcl); const int ex = __shfl(eidx[sl], srcl);
                const unsigned char* rowp = VB + (size_t)ex * 2048 + 16 * p16;
#pragma unroll
                for (int i = 0; i < 8; ++i) { const u32x4 vw = *(const u32x4*)(rowp + 256 * i);
                    acc[i][0] += cf * bf_lo(vw.x); acc[i][1] += cf * bf_hi(vw.x); acc[i][2] += cf * bf_lo(vw.y); acc[i][3] += cf * bf_hi(vw.y);
                    acc[i][4] += cf * bf_lo(vw.z); acc[i][5] += cf * bf_hi(vw.z); acc[i][6] += cf * bf_lo(vw.w); acc[i][7] += cf * bf_hi(vw.w); }
            }
        }
        float ss = 0.f;
#pragma unroll
        for (int i = 0; i < 8; ++i) { const u32x4 hw = *(const u32x4*)(HB + (size_t)t * DM + 128 * i + 8 * p16); const unsigned hv[4] = {hw.x, hw.y, hw.z, hw.w};
#pragma unroll
            for (int k = 0; k < 8; ++k) { float a = acc[i][k]; a += __shfl_xor(a, 16); a += __shfl_xor(a, 32);
                a += (k & 1) ? bf_hi(hv[k >> 1]) : bf_lo(hv[k >> 1]); acc[i][k] = a; ss += a * a; } }
        ss = row_sum_x(ss);
        const float rf = 1.0f / sqrtf(ss * (1.0f / DM) + EPS);
#pragma unroll
        for (int i = 0; i < 8; ++i) { if ((i >> 1) == rg4) { const f32x4 ga = *(const f32x4*)(p.gfin + 128 * i + 8 * p16), gb = *(const f32x4*)(p.gfin + 128 * i + 8 * p16 + 4);
                float* op = p.out + (size_t)t * DM + 128 * i + 8 * p16;
                *(f32x4*)op = (f32x4){acc[i][0] * rf * ga[0], acc[i][1] * rf * ga[1], acc[i][2] * rf * ga[2], acc[i][3] * rf * ga[3]};
                *(f32x4*)(op + 4) = (f32x4){acc[i][4] * rf * gb[0], acc[i][5] * rf * gb[1], acc[i][6] * rf * gb[2], acc[i][7] * rf * gb[3]}; } }
#endif
        LDS_WAIT();
    }
}


__device__ __forceinline__ void row_max4(unsigned k0, unsigned k1, unsigned k2, unsigned k3, unsigned& w0, unsigned& w1, unsigned& w2, unsigned& w3) {
    asm volatile("s_nop 1\n\t"
                 "v_max_u32_dpp %0, %4, %4 quad_perm:[1,0,3,2] row_mask:0xf bank_mask:0xf\n\t"
                 "v_max_u32_dpp %1, %5, %5 quad_perm:[1,0,3,2] row_mask:0xf bank_mask:0xf\n\t"
                 "v_max_u32_dpp %2, %6, %6 quad_perm:[1,0,3,2] row_mask:0xf bank_mask:0xf\n\t"
                 "v_max_u32_dpp %3, %7, %7 quad_perm:[1,0,3,2] row_mask:0xf bank_mask:0xf\n\t"
                 "v_max_u32_dpp %0, %0, %0 quad_perm:[2,3,0,1] row_mask:0xf bank_mask:0xf\n\t"
                 "v_max_u32_dpp %1, %1, %1 quad_perm:[2,3,0,1] row_mask:0xf bank_mask:0xf\n\t"
                 "v_max_u32_dpp %2, %2, %2 quad_perm:[2,3,0,1] row_mask:0xf bank_mask:0xf\n\t"
                 "v_max_u32_dpp %3, %3, %3 quad_perm:[2,3,0,1] row_mask:0xf bank_mask:0xf\n\t"
                 "v_max_u32_dpp %0, %0, %0 row_ror:4 row_mask:0xf bank_mask:0xf\n\t"
                 "v_max_u32_dpp %1, %1, %1 row_ror:4 row_mask:0xf bank_mask:0xf\n\t"
                 "v_max_u32_dpp %2, %2, %2 row_ror:4 row_mask:0xf bank_mask:0xf\n\t"
                 "v_max_u32_dpp %3, %3, %3 row_ror:4 row_mask:0xf bank_mask:0xf\n\t"
                 "v_max_u32_dpp %0, %0, %0 row_ror:8 row_mask:0xf bank_mask:0xf\n\t"
                 "v_max_u32_dpp %1, %1, %1 row_ror:8 row_mask:0xf bank_mask:0xf\n\t"
                 "v_max_u32_dpp %2, %2, %2 row_ror:8 row_mask:0xf bank_mask:0xf\n\t"
                 "v_max_u32_dpp %3, %3, %3 row_ror:8 row_mask:0xf bank_mask:0xf\n\t"
                 "s_nop 1"
                 : "=&v"(w0), "=&v"(w1), "=&v"(w2), "=&v"(w3) : "v"(k0), "v"(k1), "v"(k2), "v"(k3));
}
__device__ __forceinline__ unsigned pkadd_h2(unsigned a, unsigned b) { const h2v x = __builtin_bit_cast(h2v, a), y = __builtin_bit_cast(h2v, b); const h2v s = x + y; return __builtin_bit_cast(unsigned, s); }
constexpr int NT6 = 8;
constexpr int W6_BYTES = 16640;
__device__ __forceinline__ float dpp_f(float v, int ctrl_dummy);
#define DPPF(v, ctrl) __builtin_bit_cast(float, __builtin_amdgcn_update_dpp(0, __builtin_bit_cast(int, (v)), (ctrl), 0xf, 0xf, false))

__device__ __forceinline__ void phase_peer2(const Params& p, LAS unsigned char* lds, int bid, int nb) {
    const int tid = threadIdx.x, lane = tid & 63, wave = __builtin_amdgcn_readfirstlane(tid >> 6);
    const int p16 = lane & 15, rg4 = lane >> 4, q8 = lane >> 3, p8 = lane & 7;
    const bool b0 = lane & 1, b1 = lane & 2, b2 = lane & 4, c0 = lane & 8, c1 = lane & 16, c2 = lane & 32;
    unsigned char* ws = p.ws;
    const _Float16* SC = (const _Float16*)(ws + WS_PROJ); const bf16_t* HB = (const bf16_t*)(ws + WS_XN); const float* SSQ = (const float*)(ws + WS_SSQ);
    const unsigned char* UB = (const unsigned char*)(ws + WS_UB); const unsigned char* VB = (const unsigned char*)(ws + WS_VB); unsigned char* XQ = ws + WS_XQ;
    LAS unsigned char* wl = lds + wave * W6_BYTES;
    LAS unsigned char* CQ = wl;
    LAS unsigned char* XL = wl;
    LAS unsigned short* E16 = (LAS unsigned short*)(wl + 8192);
    LAS _Float16* GC = (LAS _Float16*)(wl + 10240);
    LAS float* ACT = (LAS float*)(wl + 12288);
    LAS float* RS = (LAS float*)(wl + 16384);
    int ci = 0, cj = 0; bool cvalid = lane < 50;
    { int l = lane;
      if (l < 16) { ci = 0; cj = l; } else if (l < 24) { ci = 1; cj = l - 16; } else if (l < 29) { ci = 2; cj = l - 24; } else if (l < 33) { ci = 3; cj = l - 29; }
      else if (l < 36) { ci = 4; cj = l - 33; } else if (l < 42) { ci = 5 + (l - 36) / 2; cj = (l - 36) & 1; } else { ci = 8 + (l - 42); cj = 0; } if (!cvalid) { ci = 0; cj = 0; } }
    const int gw = bid * 8 + wave, NGW = nb * 8;
#define TOK6(k) min(base + (k) * NGW, NTOK - 1)
    for (int base = gw; base < NTOK; base += NT6 * NGW) {
#pragma unroll 1
        for (int rep_r = 0; rep_r < PROBE_R; ++rep_r)
#pragma unroll 1
        for (int k = 0; k < NT6; k += 2) {
            u32x4 raw[2][4]; float rstd[2];
#pragma unroll
            for (int v = 0; v < 2; ++v) { const int t = TOK6(k + v);
#pragma unroll
                for (int q = 0; q < 4; ++q) raw[v][q] = *(const u32x4*)(SC + (size_t)t * 2048 + 512 * q + 8 * lane);
                float ssq = (lane < 16) ? SSQ[(size_t)t * 16 + lane] : 0.f; ssq = wave_sum(ssq);
                rstd[v] = 1.0f / sqrtf(ssq * (1.0f / DM) + EPS);
                { const u32x4 ha = *(const u32x4*)(HB + (size_t)t * DM + 16 * lane), hb = *(const u32x4*)(HB + (size_t)t * DM + 16 * lane + 8); const float sc = rstd[v] * 16.0f;
                  const unsigned hv[8] = {ha.x, ha.y, ha.z, ha.w, hb.x, hb.y, hb.z, hb.w}; unsigned xw[4];
#pragma unroll
                  for (int w = 0; w < 4; ++w) { int pk = __builtin_amdgcn_cvt_pk_fp8_f32(bf_lo(hv[2 * w]) * sc, bf_hi(hv[2 * w]) * sc, 0, false);
                      pk = __builtin_amdgcn_cvt_pk_fp8_f32(bf_lo(hv[2 * w + 1]) * sc, bf_hi(hv[2 * w + 1]) * sc, pk, true); xw[w] = (unsigned)pk; }
                  *(u32x4*)(XQ + (size_t)t * DM + 16 * lane) = (u32x4){xw[0], xw[1], xw[2], xw[3]}; } }
#pragma unroll
            for (int qq = 0; qq < 2; ++qq) {
                unsigned ka[4][8];
#pragma unroll
                for (int c = 0; c < 4; ++c) { const u32x4 rv = raw[c >> 1][2 * qq + (c & 1)]; const unsigned rw[4] = {rv.x, rv.y, rv.z, rv.w};
#pragma unroll
                    for (int e = 0; e < 8; ++e) { const unsigned hbits = (e & 1) ? (rw[e >> 1] >> 16) : (rw[e >> 1] & 0xffffu);
                        const float f = (float)__builtin_bit_cast(_Float16, (unsigned short)hbits);
                        ka[c][e] = (ord32(f) & ~0x7fu) | (unsigned)(127 - (8 * p16 + e)); } }
#define CE6(u, i, j) do { const unsigned _a = ka[u][i], _b = ka[u][j]; ka[u][i] = _a > _b ? _a : _b; ka[u][j] = _a > _b ? _b : _a; } while (0)
#pragma unroll
                for (int u = 0; u < 4; ++u) {
                    CE6(u, 0, 1); CE6(u, 2, 3); CE6(u, 4, 5); CE6(u, 6, 7);
                    CE6(u, 0, 2); CE6(u, 1, 3); CE6(u, 4, 6); CE6(u, 5, 7);
                    CE6(u, 1, 2); CE6(u, 5, 6);
                    CE6(u, 0, 4); CE6(u, 1, 5); CE6(u, 2, 6); CE6(u, 3, 7);
                    CE6(u, 2, 4); CE6(u, 3, 5);
                    CE6(u, 1, 2); CE6(u, 3, 4); CE6(u, 5, 6);
                }
#undef CE6
                unsigned mine[4] = {0u, 0u, 0u, 0u};
#pragma unroll 1
                for (int it = 0; it < 16; ++it) {
                    unsigned Wv[4]; row_max4(ka[0][0], ka[1][0], ka[2][0], ka[3][0], Wv[0], Wv[1], Wv[2], Wv[3]);
#pragma unroll
                    for (int c = 0; c < 4; ++c) {
                        const unsigned W = Wv[c];
                        mine[c] = (p16 == it) ? W : mine[c];
                        const bool win = (ka[c][0] == W);
#pragma unroll
                        for (int e = 0; e < 7; ++e) ka[c][e] = win ? ka[c][e + 1] : ka[c][e];
                        ka[c][7] = win ? 0u : ka[c][7];
                    }
                }
#pragma unroll
                for (int c = 0; c < 4; ++c) { const int g = 4 * (2 * qq + (c & 1)) + rg4; LAS float* A_s = (LAS float*)(wl + 3072 * (c >> 1)); LAS int* A_i = (LAS int*)(wl + 3072 * (c >> 1) + 1024);
                    A_s[g * 16 + p16] = unord32(mine[c] & ~0x7fu); A_i[g * 16 + p16] = 127 - (int)(mine[c] & 0x7fu); }
            }
            LDS_WAIT();
            {
                float av[4], bc[4]; int iav[4], ibc[4], jp[4], hh[4], bb[4]; unsigned key[4];
#pragma unroll
                for (int c = 0; c < 4; ++c) { const LAS float* A_s = (const LAS float*)(wl + 3072 * (c >> 1)); const LAS int* A_i = (const LAS int*)(wl + 3072 * (c >> 1) + 1024);
                    hh[c] = 4 * (c & 1) + rg4; bb[c] = (2 * hh[c] + 1) * 16; av[c] = A_s[(2 * hh[c]) * 16 + p16]; iav[c] = A_i[(2 * hh[c]) * 16 + p16] * 128; jp[c] = 0; bc[c] = A_s[bb[c]]; ibc[c] = A_i[bb[c]];
                    key[c] = (ord32(av[c] + bc[c]) & ~0xfu) | (unsigned)(15 - p16); }
#pragma unroll 1
                for (int it = 0; it < 16; ++it) {
                    unsigned Wv[4]; row_max4(key[0], key[1], key[2], key[3], Wv[0], Wv[1], Wv[2], Wv[3]);
#pragma unroll
                    for (int c = 0; c < 4; ++c) {
                        const LAS float* A_s = (const LAS float*)(wl + 3072 * (c >> 1)); const LAS int* A_i = (const LAS int*)(wl + 3072 * (c >> 1) + 1024);
                        LAS int* E_i = (LAS int*)(wl + 3072 * (c >> 1) + 2048); LAS float* E_s = (LAS float*)(wl + 3072 * (c >> 1) + 2560);
                        const bool win = (key[c] == Wv[c]);
                        if (win) { E_i[hh[c] * 16 + it] = iav[c] + ibc[c]; E_s[hh[c] * 16 + it] = av[c] + bc[c]; }
                        jp[c] += win ? 1 : 0;
                        const int jr = jp[c] < 16 ? jp[c] : 15;
                        bc[c] = A_s[bb[c] + jr]; ibc[c] = A_i[bb[c] + jr];
                        key[c] = jp[c] < 16 ? ((ord32(av[c] + bc[c]) & ~0xfu) | (unsigned)(15 - p16)) : 0u;
                    }
                }
            }
            LDS_WAIT();
#pragma unroll
            for (int v = 0; v < 2; ++v) { const LAS int* E_i = (const LAS int*)(wl + 3072 * v + 2048); const LAS float* E_s = (const LAS float*)(wl + 3072 * v + 2560);
#pragma unroll
                for (int sl = 0; sl < 2; ++sl) { const int e = lane + 64 * sl; const float s = E_s[e] * rstd[v], mx = E_s[e & ~15] * rstd[v]; const float pe = __expf(s - mx); const float den = row_sum_x(pe);
                    const int pos = 16 * (e & 7) + (e >> 3);
                    GC[(k + v) * 128 + pos] = (_Float16)(pe / den); E16[(k + v) * 128 + pos] = (unsigned short)E_i[e]; }
                if (lane == 0) RS[k + v] = rstd[v]; }
            LDS_WAIT();
        }
#define P6_LOADH(buf, TAB, jj, kk, hh) do { const u32x4 _iv = *(const LAS u32x4*)(E16 + (kk) * 128 + 16 * q8 + 8 * (hh)); const unsigned _iw[4] = {_iv.x, _iv.y, _iv.z, _iv.w}; \
            _Pragma("unroll") for (int c = 0; c < 8; ++c) { const unsigned _idx = (c & 1) ? (_iw[c >> 1] >> 16) : (_iw[c >> 1] & 0xffffu); \
                buf[c] = *(const u32x4*)((TAB) + (((size_t)(jj) * NEXP + _idx) << 7) + 16 * p8); } } while (0)
#define P6_LOADX(hb, jj, kk) do { const bf16_t* _hp = HB + (size_t)TOK6(kk) * DM + 128 * (jj) + 16 * p8; hb[0] = *(const u32x4*)_hp; hb[1] = *(const u32x4*)(_hp + 8); } while (0)
        asm volatile("s_waitcnt vmcnt(0)" ::: "memory");
        { u32x4 xr[NT6];
#pragma unroll
          for (int k = 0; k < NT6; ++k) xr[k] = *(const u32x4*)(XQ + (size_t)TOK6(k) * DM + 16 * lane);
#pragma unroll
          for (int k = 0; k < NT6; ++k) *(LAS u32x4*)(XL + k * 1024 + 16 * lane) = xr[k]; }
        LDS_WAIT();
#pragma unroll 1
        for (int rep_u = 0; rep_u < PROBE_U; ++rep_u) {
            for (int k = 0; k < NT6; ++k) { ACT[k * 128 + lane] = 0.f; ACT[k * 128 + 64 + lane] = 0.f; }
            LDS_WAIT();
            const int n16 = lane & 15, g4 = lane >> 4, c4 = lane & 3, r16 = 4 * g4 + (n16 >> 2);
            const int eoff = 2 * (16 * (r16 & 7) + (r16 >> 3));
            const bool xkeep = ((g4 >> 1) == ((n16 >> 2) & 1)); const bool klo = xkeep && (n16 < 8), khi = xkeep && (n16 >= 8);
            u32x4 bfP[16], bfQ[16];
#define P6_ULOAD(buf, nn) do { const int _j = (nn) / NT6, _k = (nn) % NT6; const LAS unsigned char* _ip = (const LAS unsigned char*)(E16 + _k * 128) + eoff; \
                _Pragma("unroll") for (int T = 0; T < 8; ++T) { const unsigned _idx = *(const LAS unsigned short*)(_ip + 4 * T); \
                    const unsigned char* _rp = UB + (((size_t)_j * NEXP + _idx) << 7) + 16 * c4; buf[2 * T] = *(const u32x4*)_rp; buf[2 * T + 1] = *(const u32x4*)(_rp + 64); } } while (0)
#define P6_PK64(lo, hi) ((long)(((unsigned long long)(hi) << 32) | (unsigned long long)(lo)))
#define P6_UMMA(buf, nn) do { const int k = (nn) % NT6; const LAS unsigned char* _xl = XL + k * 1024 + 256 * ((nn) / NT6) + 32 * c4 + 16 * (g4 & 1); \
                const u32x4 xv0 = *(const LAS u32x4*)_xl, xv1 = *(const LAS u32x4*)(_xl + 128); \
                const i32x8 xa0 = {(int)(klo ? xv0.x : 0u), (int)(klo ? xv0.y : 0u), (int)(klo ? xv0.z : 0u), (int)(klo ? xv0.w : 0u), \
                                   (int)(khi ? xv0.x : 0u), (int)(khi ? xv0.y : 0u), (int)(khi ? xv0.z : 0u), (int)(khi ? xv0.w : 0u)}; \
                const i32x8 xa1 = {(int)(klo ? xv1.x : 0u), (int)(klo ? xv1.y : 0u), (int)(klo ? xv1.z : 0u), (int)(klo ? xv1.w : 0u), \
                                   (int)(khi ? xv1.x : 0u), (int)(khi ? xv1.y : 0u), (int)(khi ? xv1.z : 0u), (int)(khi ? xv1.w : 0u)}; \
                float dsel[2] = {0.f, 0.f}; \
                _Pragma("unroll") for (int T = 0; T < 8; ++T) { f32x4 d = (f32x4){0.f, 0.f, 0.f, 0.f}; \
                    const i32x8 bb0 = {(int)buf[2 * T].x, (int)buf[2 * T].y, (int)buf[2 * T].z, (int)buf[2 * T].w, 0, 0, 0, 0}; \
                    const i32x8 bb1 = {(int)buf[2 * T + 1].x, (int)buf[2 * T + 1].y, (int)buf[2 * T + 1].z, (int)buf[2 * T + 1].w, 0, 0, 0, 0}; \
                    d = __builtin_amdgcn_mfma_scale_f32_16x16x128_f8f6f4(xa0, bb0, d, 0, 4, 0, MX_ONE, 0, MX_ONE); \
                    d = __builtin_amdgcn_mfma_scale_f32_16x16x128_f8f6f4(xa1, bb1, d, 0, 4, 0, MX_ONE, 0, MX_ONE); \
                    float pv = (c4 == 0) ? d[0] : ((c4 == 1) ? d[1] : ((c4 == 2) ? d[2] : d[3])); \
                    pv += DPPF(pv, 0xB1); pv += DPPF(pv, 0x4E);                         \
                    dsel[T >> 2] = ((T & 3) == c4) ? pv : dsel[T >> 2]; } \
                  \
                ACT[k * 128 + 16 * c4 + r16] += dsel[0]; ACT[k * 128 + 16 * (c4 + 4) + r16] += dsel[1]; } while (0)
            P6_ULOAD(bfP, 0);
#pragma unroll 1
            for (int n = 0; n < 4 * NT6; n += 2) {
                P6_ULOAD(bfQ, n + 1); asm volatile("" ::: "memory"); __builtin_amdgcn_sched_barrier(0);
                P6_UMMA(bfP, n); __builtin_amdgcn_sched_barrier(0);
                if (n + 2 < 4 * NT6) P6_ULOAD(bfP, n + 2);
                asm volatile("" ::: "memory"); __builtin_amdgcn_sched_barrier(0);
                P6_UMMA(bfQ, n + 1); __builtin_amdgcn_sched_barrier(0);
            }
#undef P6_ULOAD
#undef P6_UMMA
#undef P6_PK64
        }
        LDS_WAIT();
#pragma unroll 1
        for (int k = 0; k < NT6; ++k) {
#pragma unroll
            for (int sl = 0; sl < 2; ++sl) { const int e = lane + 64 * sl, pos = 16 * (e & 7) + (e >> 3); const float a = ACT[k * 128 + e] * (1.0f / 1024.0f);
                const float cfv = (float)GC[k * 128 + pos] * gelu_exact(a);
                CQ[k * 128 + pos] = (unsigned char)(__builtin_amdgcn_cvt_pk_fp8_f32(cfv * 32.0f, 0.f, 0, false) & 0xff); } }
        LDS_WAIT();
#pragma unroll 1
        for (int k = 0; k < NT6; ++k) ACT[k * 64 + lane] = 0.f;
        LDS_WAIT();
#pragma unroll 1
        for (int rep_v = 0; rep_v < PROBE_V; ++rep_v) {
            for (int k = 0; k < NT6; ++k) ACT[k * 64 + lane] = 0.f;
            LDS_WAIT();
            u32x4 bfP[16], bfQ[16];
#define P6_LOADI(buf, TAB, nn) do { const int _j = (nn) / NT6, _k = (nn) % NT6; P6_LOADH(buf, TAB, _j, _k, 0); P6_LOADH((buf + 8), TAB, _j, _k, 1); } while (0)
            const int n16 = lane & 15, g4 = lane >> 4;
            const int ash = 8 * (n16 & 3); const bool ahi = (n16 & 4) != 0;
            const int c0 = 16 * (n16 & 7) + 4 * (g4 & 1);
            const bool fin = (n16 < 8) && (g4 < 2);
#define P6_LOADR2(hb, nn) do { const bf16_t* _hp = HB + (size_t)TOK6((nn) % NT6) * DM + 128 * ((nn) / NT6) + c0; hb[0] = *(const u32x2*)_hp; hb[1] = *(const u32x2*)(_hp + 8); } while (0)
#define P6_VBODY(buf, nn, hb) do { const int j = (nn) / NT6, k = (nn) % NT6; const int t = TOK6(k); \
                const u32x4 cqv = *(const LAS u32x4*)(CQ + k * 128 + 16 * q8); const unsigned cqw[4] = {cqv.x, cqv.y, cqv.z, cqv.w}; \
                f32x4 d0 = (f32x4){0.f, 0.f, 0.f, 0.f}, d1 = (f32x4){0.f, 0.f, 0.f, 0.f}; \
                _Pragma("unroll") for (int c = 0; c < 16; ++c) { const unsigned cb = (cqw[c >> 2] >> (8 * (c & 3))) & 0xffu; const unsigned tt = cb << ash; \
                    const long av = P6_PK64(ahi ? 0u : tt, ahi ? tt : 0u); \
                    d0 = __builtin_amdgcn_mfma_f32_16x16x32_fp8_fp8(av, P6_PK64(buf[c].x, buf[c].y), d0, 0, 0, 0); \
                    d1 = __builtin_amdgcn_mfma_f32_16x16x32_fp8_fp8(av, P6_PK64(buf[c].z, buf[c].w), d1, 0, 0, 0); } \
                float o[8]; \
                _Pragma("unroll") for (int r = 0; r < 4; ++r) { o[r] = d0[r] + __shfl_xor(d0[r], 40); o[4 + r] = d1[r] + __shfl_xor(d1[r], 40); } \
                const unsigned hw[4] = {hb[0].x, hb[0].y, hb[1].x, hb[1].y}; float ss = 0.f; \
                _Pragma("unroll") for (int r = 0; r < 8; ++r) { const float hv = (r & 1) ? bf_hi(hw[r >> 1]) : bf_lo(hw[r >> 1]); o[r] = o[r] * (1.0f / 1024.0f) + hv; ss += o[r] * o[r]; } \
                if (fin) { float* op = p.out + (size_t)t * DM + 128 * j + c0; *(f32x4*)op = (f32x4){o[0], o[1], o[2], o[3]}; *(f32x4*)(op + 8) = (f32x4){o[4], o[5], o[6], o[7]}; \
                    ACT[k * 64 + lane] += ss; } \
                } while (0)
#define P6_PK64(lo, hi) ((long)(((unsigned long long)(hi) << 32) | (unsigned long long)(lo)))
            P6_LOADI(bfP, VB, 0);
#pragma unroll 1
            for (int n = 0; n < 8 * NT6; n += 2) {
                u32x2 hr0[2], hr1[2]; P6_LOADR2(hr0, n); P6_LOADR2(hr1, n + 1);
                asm volatile("" ::: "memory");
                P6_LOADI(bfQ, VB, n + 1); asm volatile("" ::: "memory"); __builtin_amdgcn_sched_barrier(0);
                P6_VBODY(bfP, n, hr0); __builtin_amdgcn_sched_barrier(0);
                if (n + 2 < 8 * NT6) P6_LOADI(bfP, VB, n + 2);
                asm volatile("" ::: "memory"); __builtin_amdgcn_sched_barrier(0);
                P6_VBODY(bfQ, n + 1, hr1); __builtin_amdgcn_sched_barrier(0);
            }
            LDS_WAIT(); asm volatile("s_waitcnt vmcnt(0)" ::: "memory");
            f32x4 gfv[4];
#pragma unroll
            for (int i = 0; i < 4; ++i) gfv[i] = *(const f32x4*)(p.gfin + 256 * i + 4 * lane);
#pragma unroll 1
            for (int k = 0; k < NT6; ++k) { const float sst = wave_sum(ACT[k * 64 + lane]); const float rf = __builtin_amdgcn_rsqf(sst * (1.0f / DM) + EPS);
                float* op = p.out + (size_t)TOK6(k) * DM + 4 * lane; f32x4 ov[4];
#pragma unroll
                for (int i = 0; i < 4; ++i) ov[i] = *(const f32x4*)(op + 256 * i);
#pragma unroll
                for (int i = 0; i < 4; ++i) *(f32x4*)(op + 256 * i) = ov[i] * rf * gfv[i]; }
        }
        LDS_WAIT();
    }
#undef P6_LOADH
#undef P6_LOADX
#undef P6_LOADI
#undef P6_VBODY
#undef P6_LOADR2
#undef P6_PK64
#undef TOK6
}

#define XB_TMO      128
#define XB_XCNT(j)  (256  + 64 * (j))
#define XB_XSUB(j)  (1280 + 64 * (j))
#define XB_XGEN(j)  (2304 + 64 * (j))
#define XB_TOP      3328
#define XB_TOPGEN   3392
#define XCD_BAR_WORDS 3456
#define XB_SPIN_CAP (1u << 18)

__device__ __forceinline__ unsigned xb_ld(unsigned* p)              { return __hip_atomic_load(p, __ATOMIC_RELAXED, __HIP_MEMORY_SCOPE_AGENT); }
__device__ __forceinline__ unsigned xb_add(unsigned* p, unsigned v) { return __hip_atomic_fetch_add(p, v, __ATOMIC_RELAXED, __HIP_MEMORY_SCOPE_AGENT); }
__device__ __forceinline__ unsigned xb_xcc_id() { return (unsigned)__builtin_amdgcn_s_getreg((3 << 11) | 20) & 0xFu; }
#define XB_SPIN(cond, bar) do { unsigned _sp = 0; while (cond) { __builtin_amdgcn_s_sleep(1); \
    if ((++_sp & 255u) == 0u) { if (xb_ld(&(bar)[XB_TMO])) break; if (_sp > XB_SPIN_CAP) { atomicAdd(&(bar)[XB_TMO], 1u); break; } } } } while (0)

struct XcdBarrier {
    unsigned* bar; unsigned x;
    volatile LAS unsigned* st;
};

__device__ __forceinline__ XcdBarrier xcd_barrier_post(unsigned* bar, volatile LAS unsigned* st) {
    XcdBarrier b; b.bar = bar; b.x = xb_xcc_id(); b.st = st;
    if (threadIdx.x == 0) (void)xb_add(&bar[XB_XCNT(b.x)], 1u);
    return b;
}
__device__ __forceinline__ void xcd_barrier_complete(unsigned* bar, unsigned x, unsigned& nloc, unsigned& nx) {
    const unsigned G = gridDim.x * gridDim.y * gridDim.z;
    unsigned sum, cnt, mine, sp = 0u;
    for (;;) {
        sum = 0u; cnt = 0u; mine = 0u;
#pragma unroll
        for (unsigned j = 0; j < 16; ++j) { const unsigned c = xb_ld(&bar[XB_XCNT(j)]); sum += c; cnt += (c > 0u) ? 1u : 0u; mine = (j == x) ? c : mine; }
        if (sum == G) break;
        __builtin_amdgcn_s_sleep(1);
        if ((++sp & 255u) == 0u) { if (xb_ld(&bar[XB_TMO])) break; if (sp > XB_SPIN_CAP) { atomicAdd(&bar[XB_TMO], 1u); break; } }
    }
    nloc = mine > 0u ? mine : 1u; nx = cnt > 0u ? cnt : 1u;
}

__device__ __forceinline__ void xcd_barrier(const XcdBarrier& b) {
    asm volatile("s_waitcnt vmcnt(0)" ::: "memory");
    __syncthreads();
    if (threadIdx.x == 0) {
        unsigned* bar = b.bar;
        __builtin_amdgcn_s_waitcnt(0);
        unsigned nloc = b.st[0], nx = b.st[1];
        if (nloc == 0u) { xcd_barrier_complete(bar, b.x, nloc, nx); b.st[0] = nloc; b.st[1] = nx; }
        const unsigned old = xb_add(&bar[XB_XSUB(b.x)], 1u);
        const unsigned gen = old / nloc;
        if (old + 1u == (gen + 1u) * nloc) {
            __builtin_amdgcn_fence(__ATOMIC_RELEASE, "agent");
            asm volatile("s_waitcnt vmcnt(0)" ::: "memory");
            const unsigned og = xb_add(&bar[XB_TOP], 1u);
            const unsigned tg = og / nx;
            if (og + 1u == (tg + 1u) * nx) xb_add(&bar[XB_TOPGEN], 1u);
            else XB_SPIN(xb_ld(&bar[XB_TOPGEN]) == tg, bar);
            __builtin_amdgcn_fence(__ATOMIC_ACQUIRE, "agent");
            xb_add(&bar[XB_XGEN(b.x)], 1u);
            asm volatile("s_waitcnt vmcnt(0)" ::: "memory");
        } else {
            XB_SPIN(xb_ld(&bar[XB_XGEN(b.x)]) == gen, bar);
            __builtin_amdgcn_fence(__ATOMIC_ACQUIRE, "agent");
            asm volatile("s_waitcnt vmcnt(0)" ::: "memory");
        }
    }
    __syncthreads();
}

__global__ void __launch_bounds__(512, 2) mk_fwd(Params p) {
    extern __shared__ __attribute__((aligned(16))) unsigned char lds_raw[];
    LAS unsigned char* lds = (LAS unsigned char*)lds_raw;
    const int bid = blockIdx.x, nb = gridDim.x;
    unsigned char* ws = p.ws;
#define IN(k) (p.ph_lo <= (k) && (k) < p.ph_hi)
#define SEAM(k) do { if (IN(k) && IN((k) + 1)) { xcd_barrier(bar); } } while (0)
    if (threadIdx.x < 4) ((volatile LAS unsigned*)(lds + LDS_BYTES - 16))[threadIdx.x] = 0u;
    __syncthreads();
    const XcdBarrier bar = xcd_barrier_post((unsigned*)(ws + WS_CTL) + 4096, (volatile LAS unsigned*)(lds + LDS_BYTES - 16));
    if (IN(0)) phase0(p, lds, bid, nb);
    SEAM(0);
    if (IN(1)) {
        pg8::Gemm g{(const bf16_t*)(ws + WS_XN), (const bf16_t*)(ws + WS_WIN), MROWS, NP1, DM}; pg8::StaticOrder S; S.init(MROWS, NP1, nb, bid);
        EpiProj E{(bf16_t*)(ws + WS_PROJ), (bf16_t*)(ws + WS_QK), (float*)(ws + WS_LA), p.gb, (const float2*)(ws + WS_ROPE)};
        pg8::gemm_phase<EpiProj, pg8::StaticOrder, true, true>(lds, g, S, E);
    }
    SEAM(1);
    if (IN(2)) attn_pass<false>(p, lds, bid, nb);
    SEAM(2);
    if (IN(3)) attn_pass<true>(p, lds, bid, nb);
    SEAM(3);
    if (IN(4)) {
        pg8::Gemm g{(const bf16_t*)(ws + WS_O), (const bf16_t*)(ws + WS_WOUT), NTOK, DM, DM}; pg8::StaticOrder S; S.init(NTOK, DM, nb, bid);
        EpiRes E{p.x, (bf16_t*)(ws + WS_XN), (float*)(ws + WS_SSQ)};
        pg8::gemm_phase<EpiRes, pg8::StaticOrder, true, true>(lds, g, S, E);
    }
    SEAM(4);
    if (IN(5)) {
        pg8::Gemm g{(const bf16_t*)(ws + WS_XN), (const bf16_t*)(ws + WS_WS), NTOK, 2048, DM}; pg8::StaticOrder S; S.init(NTOK, 2048, nb, bid);
        EpiF16 E{(_Float16*)(ws + WS_PROJ)};
        pg8::gemm_phase<EpiF16, pg8::StaticOrder, true, true>(lds, g, S, E);
    }
    SEAM(5);
    if (IN(6)) phase_peer2(p, lds, bid, nb);
#undef IN
#undef SEAM
}

#ifndef MK_FUSED
#define MK_FUSED 1
#endif
extern "C" void kernel_launch(void* const* d_in, const int* in_sizes, int n_in, void* d_out, int out_size, void* d_ws, size_t ws_size, hipStream_t stream) {
    static int grid = 0;
    if (grid == 0) {
        if (n_in != 16 || in_sizes[0] != NTOK * DM || out_size != NTOK * DM || ws_size < WS_END) {
            fprintf(stderr, "kernel_launch: unexpected shapes (n_in %d, in0 %d, out %d, ws %zu); nothing launched\n", n_in, n_in > 0 ? in_sizes[0] : -1, out_size, ws_size); grid = -1; return; }
        int dev = 0, cus = 0, per_cu = 0;
        hipGetDevice(&dev); hipDeviceGetAttribute(&cus, hipDeviceAttributeMultiprocessorCount, dev);
        if (hipFuncSetAttribute((const void*)mk_fwd, hipFuncAttributeMaxDynamicSharedMemorySize, LDS_BYTES) != hipSuccess) { fprintf(stderr, "kernel_launch: hipFuncSetAttribute failed\n"); grid = -1; return; }
        if (hipOccupancyMaxActiveBlocksPerMultiprocessor(&per_cu, (const void*)mk_fwd, 512, LDS_BYTES) != hipSuccess || per_cu < 1) { fprintf(stderr, "kernel_launch: occupancy query failed (%d)\n", per_cu); (void)hipGetLastError(); per_cu = 1; }
        grid = cus * (per_cu < 1 ? 1 : 1);
        fprintf(stderr, "kernel_launch: %d CUs, occupancy %d/CU, grid %d\n", cus, per_cu, grid);
    }
    if (grid < 0) return;
    (void)hipMemsetAsync((char*)d_ws + WS_CTL, 0, 65536, stream);
    Params p{};
    p.x = (const float*)d_in[0]; p.meta = (const float*)d_in[1]; p.g1 = (const float*)d_in[2]; p.w_in = (const float*)d_in[3]; p.gw2 = (const float*)d_in[4]; p.gb = (const float*)d_in[5];
    p.gla_gain = (const float*)d_in[6]; p.ret_gain = (const float*)d_in[7]; p.ret_bias = (const float*)d_in[8]; p.w_out = (const float*)d_in[9]; p.g2 = (const float*)d_in[10];
    p.w_q = (const float*)d_in[11]; p.subkeys = (const float*)d_in[12]; p.pu = (const float*)d_in[13]; p.pv = (const float*)d_in[14]; p.gfin = (const float*)d_in[15];
    p.out = (float*)d_out; p.ws = (unsigned char*)d_ws;
#if MK_FUSED
    p.ph_lo = 0; p.ph_hi = NPHASE;
    void* args[] = {&p};
    hipError_t e = hipLaunchCooperativeKernel((const void*)mk_fwd, dim3(grid), dim3(512), args, LDS_BYTES, stream);
    if (e != hipSuccess) fprintf(stderr, "kernel_launch: cooperative launch failed: %s (grid %d)\n", hipGetErrorString(e), grid);
#else
    { const int order[7] = {0, 1, 2, 3, 4, 5, 6}; for (int i = 0; i < 7; ++i) { p.ph_lo = order[i]; p.ph_hi = order[i] + 1; hipLaunchKernelGGL(mk_fwd, dim3(grid), dim3(512), LDS_BYTES, stream, p); } }
#endif
}
```

```cpp
#include <hip/hip_runtime.h>
#include <hip/hip_cooperative_groups.h>
#include <cstdio>
#include <cstdint>
namespace cg = cooperative_groups;
namespace pg8 {
#define PG8_LAS __attribute__((address_space(3)))
typedef unsigned short bf16_t;
typedef short bf16x8 __attribute__((ext_vector_type(8)));
typedef float f32x4 __attribute__((ext_vector_type(4)));
typedef unsigned u32x4 __attribute__((ext_vector_type(4)));
constexpr int BM = 256, BK = 64, HALF = 128, HTB = HALF * BK * 2  , STAGE_BYTES = 8 * HTB, NXCD = 8, WGM = 8;

__host__ __device__ __forceinline__ int lds_byte(int r, int c) { const int st = (r >> 4) * 2 + (c >> 5), rr = r & 15, cc = c & 31, ob = rr * 64 + cc * 2; return st * 1024 + (ob ^ (((ob >> 9) & 1) << 5)); }
__host__ __device__ __forceinline__ void stage_rc(int b, int& R, int& C) { const int st = b / 1024, sb = b % 1024, swz = sb ^ (((sb >> 9) & 1) << 5); R = (st >> 1) * 16 + swz / 64; C = (st & 1) * 32 + (swz % 64) / 2; }
__host__ __device__ __forceinline__ int perm32(int rho) { const int n = rho >> 4, i = rho & 15; return 8 * (i >> 2) + 4 * n + (i & 3); }

struct Unit { int pm, pn; };
struct Gemm { const bf16_t* A; const bf16_t* Bt; int M, N, K; };

struct StaticOrder {
    int nM, nN, nwg, G, c;
    __host__ __device__ void init(int M, int N, int G_, int c_) { nM = M / BM; nN = N / BM; nwg = nM * nN; G = G_; c = c_; }
    __host__ __device__ bool next(int i, Unit& u) const {
        const long L = (long)i * G + c; if (L >= nwg) return false;
        int wgid = (int)L; { const int q = nwg / NXCD, r = nwg % NXCD, xcd = wgid % NXCD, off = wgid / NXCD; wgid = (xcd < r ? xcd * (q + 1) : r * (q + 1) + (xcd - r) * q) + off; }
        const int nig = WGM * nN, gid = wgid / nig, fm = gid * WGM, gsz = (nM - fm) < WGM ? (nM - fm) : WGM;
        u.pm = fm + ((wgid % nig) % gsz); u.pn = (wgid % nig) / gsz; return true;
    }
    __device__ __forceinline__ void a_ready(const Unit&) const {}
    __device__ __forceinline__ void done(const Unit&) const {}
};

__device__ __forceinline__ unsigned cvt_pk_bf16(float lo, float hi) { unsigned r; asm volatile("v_cvt_pk_bf16_f32 %0, %1, %2" : "=v"(r) : "v"(lo), "v"(hi)); return r; }
typedef float f32x2 __attribute__((ext_vector_type(2)));
template <class Epi, class Sched, bool ALIGN_EPI = false, bool SP2 = false>
__device__ __forceinline__ void gemm_phase(PG8_LAS unsigned char* lds, const Gemm g, const Sched& S, const Epi& E) {
    const int tid = threadIdx.x, wid = __builtin_amdgcn_readfirstlane(tid >> 6), lane = tid & 63, wr = wid >> 2, wc = wid & 3, fr = lane & 15, fq = lane >> 4;
    const int K = g.K, nt = K / BK;
    unsigned voffA[2], voffB[2];
#pragma unroll
    for (int i = 0; i < 2; ++i) { int R, C; stage_rc(tid * 16 + i * 8192, R, C); const int Rb = Epi::PERM ? ((R & ~31) + perm32(R & 31)) : R;
        voffA[i] = (unsigned)(R * K + C) * 2u; voffB[i] = (unsigned)(Rb * K + C) * 2u; }
    const size_t kstep = (size_t)(BK * 2);
    const size_t hstep = (size_t)HALF * K * 2;
    const size_t tstep = 2 * hstep;
    const unsigned ldsw = (unsigned)wid * 1024u;
    const int aoff = lds_byte(wr * 64 + fr, fq * 8), boff = lds_byte(wc * 32 + fr, fq * 8);
#define PG8_SA(b, h) (((b) * 2 + (h)) * HTB)
#define PG8_SB(b, h) ((4 + (b) * 2 + (h)) * HTB)
#define PG8_STAGE(bufoff, gbase, voff) do { _Pragma("unroll") for (int _i = 0; _i < 2; ++_i) \
        __builtin_amdgcn_global_load_lds((const unsigned*)((const char*)(gbase) + (voff)[_i]), (PG8_LAS unsigned*)(lds + (bufoff) + ldsw + _i * 8192), 16, 0, 0); } while (0)
#define PG8_LDA(dst, b, h) do { _Pragma("unroll") for (int m = 0; m < 4; ++m) _Pragma("unroll") for (int k = 0; k < 2; ++k) dst[m][k] = *(const PG8_LAS bf16x8*)(lds + PG8_SA(b, h) + aoff + m * 2048 + k * 1024); } while (0)
#define PG8_LDB(dst, b, h) do { _Pragma("unroll") for (int n = 0; n < 2; ++n) _Pragma("unroll") for (int k = 0; k < 2; ++k) dst[n][k] = *(const PG8_LAS bf16x8*)(lds + PG8_SB(b, h) + boff + n * 2048 + k * 1024); } while (0)
#define PG8_MMA(ai, bj, At, Bt) do { __builtin_amdgcn_s_setprio(1); _Pragma("unroll") for (int m = 0; m < 4; ++m) _Pragma("unroll") for (int n = 0; n < 2; ++n) _Pragma("unroll") for (int k = 0; k < 2; ++k) \
        acc[ai][bj][m][n] = __builtin_amdgcn_mfma_f32_16x16x32_bf16(Bt[n][k], At[m][k], acc[ai][bj][m][n], 0, 0, 0); __builtin_amdgcn_s_setprio(0); } while (0)
#define PG8_WAIT_V(n) asm volatile("s_waitcnt vmcnt(" #n ")" ::: "memory")
#define PG8_WAIT_L(n) asm volatile("s_waitcnt lgkmcnt(" #n ")" ::: "memory")
#define PG8_BAR __builtin_amdgcn_s_barrier()
#define PG8_SCHED __builtin_amdgcn_sched_barrier(0)
    Unit cur, nxt; int ui = 0;
    if (!S.next(0, cur)) return;
    f32x4 acc[2][2][4][2];
#pragma unroll
    for (int a = 0; a < 2; ++a)
#pragma unroll
        for (int b = 0; b < 2; ++b)
#pragma unroll
            for (int m = 0; m < 4; ++m)
#pragma unroll
                for (int n = 0; n < 2; ++n) acc[a][b][m][n] = (f32x4){0.f, 0.f, 0.f, 0.f};
    bf16x8 At[4][2], B0[2][2], B1[2][2];
    const char* cA = (const char*)g.A + (size_t)cur.pm * tstep; const char* cB = (const char*)g.Bt + (size_t)cur.pn * tstep;
    S.a_ready(cur);
    if constexpr (SP2) {
        PG8_STAGE(PG8_SB(0, 0), cB, voffB); PG8_STAGE(PG8_SB(0, 1), cB + hstep, voffB); PG8_STAGE(PG8_SA(0, 0), cA, voffA); PG8_STAGE(PG8_SA(0, 1), cA + hstep, voffA);
        if (wr == 1) PG8_BAR;
        PG8_WAIT_V(2); PG8_BAR;
        PG8_STAGE(PG8_SB(1, 0), cB + kstep, voffB); PG8_STAGE(PG8_SA(1, 0), cA + kstep, voffA); PG8_STAGE(PG8_SB(1, 1), cB + hstep + kstep, voffB);
        PG8_WAIT_V(6); PG8_BAR;
    } else {
        PG8_STAGE(PG8_SB(0, 0), cB, voffB); PG8_STAGE(PG8_SA(0, 0), cA, voffA); PG8_STAGE(PG8_SB(0, 1), cB + hstep, voffB); PG8_STAGE(PG8_SA(0, 1), cA + hstep, voffA);
        if (wr == 1) PG8_BAR;
        PG8_WAIT_V(4); PG8_BAR;
        PG8_STAGE(PG8_SB(1, 0), cB + kstep, voffB); PG8_STAGE(PG8_SA(1, 0), cA + kstep, voffA); PG8_STAGE(PG8_SB(1, 1), cB + hstep + kstep, voffB);
        PG8_WAIT_V(6); PG8_BAR;
    }
    for (;;) {
        const bool has_next = S.next(ui + 1, nxt);
        const char* nA = has_next ? (const char*)g.A + (size_t)nxt.pm * tstep : cA; const char* nB = has_next ? (const char*)g.Bt + (size_t)nxt.pn * tstep : cB;
        for (int t = 0; t < nt; t += 2) {
            const bool last = (t == nt - 2);
            const char* a1 = cA + (size_t)(t + 1) * kstep;
            const char* a2 = last ? nA : cA + (size_t)(t + 2) * kstep; const char* b2 = last ? nB : cB + (size_t)(t + 2) * kstep;
            const char* a3 = a2 + kstep; const char* b3 = b2 + kstep;
            if (last && has_next) S.a_ready(nxt);
            if constexpr (SP2) {
            PG8_LDB(B0, 0, 0); PG8_LDB(B1, 0, 1); PG8_SCHED; PG8_LDA(At, 0, 0); PG8_STAGE(PG8_SA(1, 1), a1 + hstep, voffA);
            PG8_WAIT_V(8); PG8_WAIT_L(0); PG8_BAR; PG8_MMA(0, 0, At, B0); PG8_MMA(0, 1, At, B1); PG8_BAR; PG8_SCHED;
            PG8_LDA(At, 0, 1); PG8_STAGE(PG8_SB(0, 0), b2, voffB); PG8_STAGE(PG8_SB(0, 1), b2 + hstep, voffB); PG8_STAGE(PG8_SA(0, 0), a2, voffA);
            PG8_WAIT_V(8); PG8_WAIT_L(0); PG8_BAR; PG8_MMA(1, 0, At, B0); PG8_MMA(1, 1, At, B1); PG8_BAR; PG8_SCHED;
            PG8_LDB(B0, 1, 0); PG8_LDB(B1, 1, 1); PG8_SCHED; PG8_LDA(At, 1, 0); PG8_STAGE(PG8_SA(0, 1), a2 + hstep, voffA);
            PG8_WAIT_V(8); PG8_WAIT_L(0); PG8_BAR; PG8_MMA(0, 0, At, B0); PG8_MMA(0, 1, At, B1); PG8_BAR; PG8_SCHED;
            PG8_LDA(At, 1, 1); PG8_STAGE(PG8_SB(1, 0), b3, voffB); PG8_STAGE(PG8_SB(1, 1), b3 + hstep, voffB); PG8_STAGE(PG8_SA(1, 0), a3, voffA);
            PG8_WAIT_V(8); PG8_WAIT_L(0); PG8_BAR; PG8_MMA(1, 0, At, B0); PG8_MMA(1, 1, At, B1); PG8_BAR; PG8_SCHED;
            } else {
            PG8_LDB(B0, 0, 0); PG8_SCHED; PG8_LDA(At, 0, 0); PG8_STAGE(PG8_SA(1, 1), a1 + hstep, voffA);
            PG8_WAIT_L(8); PG8_BAR; PG8_WAIT_L(0); PG8_MMA(0, 0, At, B0); PG8_BAR; PG8_SCHED;
            PG8_LDB(B1, 0, 1); PG8_STAGE(PG8_SB(0, 0), b2, voffB);
            PG8_BAR; PG8_WAIT_L(0); PG8_MMA(0, 1, At, B1); PG8_BAR;
            PG8_LDA(At, 0, 1); PG8_STAGE(PG8_SA(0, 0), a2, voffA);
            PG8_BAR; PG8_WAIT_L(0); PG8_MMA(1, 0, At, B0); PG8_BAR; PG8_SCHED;
            PG8_STAGE(PG8_SB(0, 1), b2 + hstep, voffB);
            PG8_WAIT_V(6); PG8_BAR; PG8_MMA(1, 1, At, B1); PG8_BAR;
            PG8_LDB(B0, 1, 0); PG8_SCHED; PG8_LDA(At, 1, 0); PG8_STAGE(PG8_SA(0, 1), a2 + hstep, voffA);
            PG8_WAIT_L(8); PG8_BAR; PG8_WAIT_L(0); PG8_MMA(0, 0, At, B0); PG8_BAR; PG8_SCHED;
            PG8_LDB(B1, 1, 1); PG8_STAGE(PG8_SB(1, 0), b3, voffB);
            PG8_BAR; PG8_WAIT_L(0); PG8_MMA(0, 1, At, B1); PG8_BAR;
            PG8_LDA(At, 1, 1); PG8_STAGE(PG8_SA(1, 0), a3, voffA);
            PG8_BAR; PG8_WAIT_L(0); PG8_MMA(1, 0, At, B0); PG8_BAR; PG8_SCHED;
            PG8_STAGE(PG8_SB(1, 1), b3 + hstep, voffB);
            PG8_WAIT_V(6); PG8_BAR; PG8_MMA(1, 1, At, B1); PG8_BAR;
            }
        }
        if constexpr (ALIGN_EPI) { if (wr == 0) PG8_BAR; }
        if constexpr (!Epi::AFTER_DRAIN) { E(acc, cur, wr, wc, fr, fq); S.done(cur); }
        if (!has_next) break;
#pragma unroll
        for (int a = 0; a < 2; ++a)
#pragma unroll
            for (int b = 0; b < 2; ++b)
#pragma unroll
                for (int m = 0; m < 4; ++m)
#pragma unroll
                    for (int n = 0; n < 2; ++n) acc[a][b][m][n] = (f32x4){0.f, 0.f, 0.f, 0.f};
        cur = nxt; cA = nA; cB = nB; ++ui;
        if constexpr (ALIGN_EPI) { if (wr == 1) PG8_BAR; }
    }
    PG8_WAIT_V(0);
    if constexpr (!ALIGN_EPI) { if (wr == 0) PG8_BAR; }
    PG8_BAR;
    if constexpr (Epi::AFTER_DRAIN) { E.fused(acc, cur, wr, wc, fr, fq, lds, wid, lane); S.done(cur); }
#undef PG8_SA
#undef PG8_SB
#undef PG8_STAGE
#undef PG8_LDA
#undef PG8_LDB
#undef PG8_MMA
#undef PG8_WAIT_V
#undef PG8_WAIT_L
#undef PG8_BAR
#undef PG8_SCHED
}
}

#define LAS __attribute__((address_space(3)))
typedef unsigned short bf16_t;
typedef float f32x4 __attribute__((ext_vector_type(4)));
typedef unsigned u32x4 __attribute__((ext_vector_type(4)));
typedef unsigned u32x2 __attribute__((ext_vector_type(2)));
typedef int i32x8 __attribute__((ext_vector_type(8)));
#define MX_ONE 0x7f7f7f7f
#define V4_SCALE 5.656854f
typedef short bf16x8 __attribute__((ext_vector_type(8)));
typedef short s16x4 __attribute__((ext_vector_type(4)));
typedef __bf16 bf16x2_t __attribute__((ext_vector_type(2)));
typedef _Float16 f16x2_t __attribute__((ext_vector_type(2)));
typedef float f32x2v __attribute__((ext_vector_type(2)));
typedef _Float16 h2v __attribute__((ext_vector_type(2)));

constexpr int DM = 1024, NB = 4, SEQ = 8192, NTOK = NB * SEQ;
constexpr int MROWS = NTOK + 256;
constexpr int INW = 3088;
constexpr int NPROJ = 3072, NP1 = 3328;
constexpr int NEXP = 16384;
constexpr float EPS = 1e-6f;
constexpr int C_GQ = 0, C_GK = 256, C_GV = 512, C_GG = 1024, C_RQ = 1536, C_RK = 1792, C_RV = 2048, C_RG = 2560;
constexpr int S_GA = 1536, S_RQ = 1552, S_RV = 2064;

constexpr int NVG = 2048;
constexpr int NCH = (NTOK + 256) / 64;
constexpr size_t QK_ARR = (size_t)NCH * 4 * 8 * 64 * 8;
constexpr size_t MiB = 1u << 20;
constexpr size_t WS_CTL = 0, WS_WIN = 1 * MiB, WS_WOUT = 8 * MiB, WS_WS = 10 * MiB, WS_ROPE = 14 * MiB, WS_SSQ = 17 * MiB, WS_SEG = 19 * MiB, WS_ASEG = 27 * MiB,
                 WS_UB = 28 * MiB, WS_VB = 60 * MiB, WS_XN = 92 * MiB, WS_O = 157 * MiB, WS_LA = 221 * MiB, WS_PROJ = 254 * MiB, WS_QK = 383 * MiB, WS_XQ = 448 * MiB, WS_END = 480 * MiB;
static_assert(WS_WIN + (size_t)NP1 * DM * 2 <= WS_WOUT && WS_ROPE + (size_t)(SEQ + 64) * 32 * 8 <= WS_SSQ && WS_XN + (size_t)MROWS * DM * 2 <= WS_O &&
              WS_LA + QK_ARR * 4 <= WS_PROJ && WS_PROJ + (size_t)MROWS * NVG * 2 <= WS_QK && WS_QK + 4 * QK_ARR * 2 <= WS_XQ && WS_PROJ + (size_t)NTOK * 2048 * 2 <= WS_QK, "ws map");

constexpr int LDS_BYTES = 147456;
constexpr int NPHASE = 7;
#ifndef PROBE_R
#define PROBE_R 1
#define PROBE_U 1
#define PROBE_V 1
#endif
#ifndef PEER_FP8
#define PEER_FP8 1
#endif

struct Params {
    const float *x, *meta, *g1, *w_in, *gw2, *gb, *gla_gain, *ret_gain, *ret_bias, *w_out, *g2, *w_q, *subkeys, *pu, *pv, *gfin;
    float* out; unsigned char* ws;
    int ph_lo, ph_hi;
};

#define LDS_WAIT() asm volatile("s_waitcnt lgkmcnt(0)" ::: "memory")
__device__ __forceinline__ unsigned pk2(float lo, float hi) { const bf16x2_t v = {(__bf16)lo, (__bf16)hi}; return __builtin_bit_cast(unsigned, v); }
__device__ __forceinline__ unsigned f2bf(float f) { return (unsigned)__builtin_bit_cast(unsigned short, (__bf16)f); }

__device__ __forceinline__ float bf_lo(unsigned w) { return __builtin_bit_cast(float, w << 16); }
__device__ __forceinline__ float bf_hi(unsigned w) { return __builtin_bit_cast(float, w & 0xffff0000u); }
__device__ __forceinline__ float bf1(bf16_t h) { return __builtin_bit_cast(float, (unsigned)h << 16); }
__device__ __forceinline__ float wave_sum(float v) {
#pragma unroll
    for (int o = 1; o < 64; o <<= 1) v += __shfl_xor(v, o);
    return v;
}

struct MapIn {
    __device__ __forceinline__ void operator()(int j, int& src, float& sc) const {
        if (j < C_RQ) { src = j; sc = (j < 256) ? 0.125f : 1.0f; }
        else if (j < C_RV) { const int jj = j - C_RQ, which = jj >> 8, within = jj & 255, head = within >> 6, p = within & 63;
            const int a = p >> 3, n = (p >> 2) & 1, i = p & 3; src = S_RQ + which * 256 + head * 64 + 32 * n + 4 * a + i; sc = which ? 0.125f : 1.0f; }
        else { src = S_RV + (j - C_RV); sc = 1.0f; }
    }
};
struct MapId { __device__ __forceinline__ void operator()(int j, int& src, float& sc) const { src = j; sc = 1.0f; } };

template <class Map>
__device__ __forceinline__ void transpose_item(const float* W, int K, int N, bf16_t* WT, LAS float* scr, int item, int nblk, int lane, const Map map) {
    const int kb = item / nblk, nb = item % nblk, k0 = 64 * kb, n0 = 32 * nb;
    int src; float sc; map(n0 + (lane & 31), src, sc);
#pragma unroll 8
    for (int i = 0; i < 32; ++i) { const int kk = 2 * i + (lane >> 5); scr[kk * 33 + (lane & 31)] = W[(size_t)(k0 + kk) * N + src] * sc; }
    LDS_WAIT();
    const int c = lane & 7;
#pragma unroll
    for (int j = 0; j < 4; ++j) { const int n = (lane >> 3) + 8 * j; const LAS float* s = scr + (8 * c) * 33 + n;
        u32x4 o; o.x = pk2(s[0 * 33], s[1 * 33]); o.y = pk2(s[2 * 33], s[3 * 33]); o.z = pk2(s[4 * 33], s[5 * 33]); o.w = pk2(s[6 * 33], s[7 * 33]);
        *(u32x4*)(WT + (size_t)(n0 + n) * K + k0 + 8 * c) = o; }
    LDS_WAIT();
}

__device__ __forceinline__ void phase0(const Params& p, LAS unsigned char* lds, int bid, int nb) {
    const int tid = threadIdx.x, lane = tid & 63, wave = __builtin_amdgcn_readfirstlane(tid >> 6);
    unsigned char* ws = p.ws;
    bf16_t* XN = (bf16_t*)(ws + WS_XN); bf16_t* WinT = (bf16_t*)(ws + WS_WIN); bf16_t* WoutT = (bf16_t*)(ws + WS_WOUT); bf16_t* WsT = (bf16_t*)(ws + WS_WS);
    const int gw = bid * 8 + wave, NGW = nb * 8;
    const int gt = bid * 512 + tid, NGT = nb * 512;

    {
        LAS float* SKT = (LAS float*)lds;
        LAS float* WQT = (LAS float*)(lds + 128 * 132 * 4);
        for (int item = bid; item < 256; item += nb) {
            const int hc = item >> 4, kb = item & 15;
            __syncthreads();
            for (int e = tid; e < 128 * 128; e += 512) { const int n = e >> 7, d = e & 127; SKT[d * 132 + n] = p.subkeys[(size_t)hc * 16384 + e]; }
            for (int e = tid; e < 64 * 128; e += 512) { const int k = e >> 7, d = e & 127; WQT[d * 68 + k] = p.w_q[(size_t)(kb * 64 + k) * 2048 + hc * 128 + d]; }
            __syncthreads();
            const int tn = tid & 31, tk = tid >> 5;
            f32x4 acc[4];
#pragma unroll
            for (int i = 0; i < 4; ++i) acc[i] = (f32x4){0.f, 0.f, 0.f, 0.f};
#pragma unroll 4
            for (int d = 0; d < 128; ++d) {
                const f32x4 sk = *(const LAS f32x4*)(SKT + d * 132 + 4 * tn); const f32x4 wq = *(const LAS f32x4*)(WQT + d * 68 + 4 * tk);
#pragma unroll
                for (int i = 0; i < 4; ++i) acc[i] += sk[i] * wq;
            }
            const f32x4 gg = *(const f32x4*)(p.g2 + kb * 64 + 4 * tk);
#pragma unroll
            for (int i = 0; i < 4; ++i) { const f32x4 v = acc[i] * gg; u32x2 o; o.x = pk2(v[0], v[1]); o.y = pk2(v[2], v[3]);
                *(u32x2*)(WsT + (size_t)(hc * 128 + 4 * tn + i) * DM + kb * 64 + 4 * tk) = o; }
        }
        __syncthreads();
    }
    {
        LAS float* scr = (LAS float*)(lds + wave * 16384);
        constexpr int I_IN = (DM / 64) * (NPROJ / 32), I_OUT = (DM / 64) * (DM / 32);
        for (int it = gw; it < I_IN + I_OUT; it += NGW) {
            if (it < I_IN) transpose_item(p.w_in, DM, INW, WinT, scr, it, NPROJ / 32, lane, MapIn());
            else transpose_item(p.w_out, DM, DM, WoutT, scr, it - I_IN, DM / 32, lane, MapId());
        }
    }
    for (int e = gt; e < 256 * DM; e += NGT) {
        const int n = e >> 10, k = e & 1023; const float* wr = p.w_in + (size_t)k * INW + S_GA; float s = 0.f;
#pragma unroll
        for (int r = 0; r < 16; ++r) s += wr[r] * p.gw2[r * 256 + n];
        WinT[(size_t)(NPROJ + n) * DM + k] = (bf16_t)f2bf(s);
    }
#if PEER_FP8
    {
        u32x4* U4 = (u32x4*)(ws + WS_UB); u32x4* V4 = (u32x4*)(ws + WS_VB);
        for (int e = gt; e < NEXP * DM / 32; e += NGT) {
            const f32x4* us = (const f32x4*)p.pu + 8 * (size_t)e; const f32x4* vs = (const f32x4*)p.pv + 8 * (size_t)e;
            const f32x4* g2s = (const f32x4*)p.g2 + 8 * (e & 31);
            unsigned tu[4], tv[4];
#pragma unroll
            for (int j = 0; j < 4; ++j) { const f32x4 a0 = us[2 * j] * g2s[2 * j] * 64.0f, a1 = us[2 * j + 1] * g2s[2 * j + 1] * 64.0f;
                const f32x4 b0 = vs[2 * j] * V4_SCALE, b1 = vs[2 * j + 1] * V4_SCALE;
                unsigned w = 0u, x = 0u;
                w = __builtin_amdgcn_cvt_scalef32_pk_fp4_f32(w, a0[0], a0[1], 1.0f, 0); w = __builtin_amdgcn_cvt_scalef32_pk_fp4_f32(w, a0[2], a0[3], 1.0f, 1);
                w = __builtin_amdgcn_cvt_scalef32_pk_fp4_f32(w, a1[0], a1[1], 1.0f, 2); w = __builtin_amdgcn_cvt_scalef32_pk_fp4_f32(w, a1[2], a1[3], 1.0f, 3); tu[j] = w;
                x = __builtin_amdgcn_cvt_scalef32_pk_fp4_f32(x, b0[0], b0[1], 1.0f, 0); x = __builtin_amdgcn_cvt_scalef32_pk_fp4_f32(x, b0[2], b0[3], 1.0f, 1);
                x = __builtin_amdgcn_cvt_scalef32_pk_fp4_f32(x, b1[0], b1[1], 1.0f, 2); x = __builtin_amdgcn_cvt_scalef32_pk_fp4_f32(x, b1[2], b1[3], 1.0f, 3); tv[j] = x; }
            const int row = e >> 5, c32 = e & 31;
            const size_t dst = ((size_t)(c32 >> 3) * NEXP + row) * 8 + (c32 & 7);
            U4[dst] = (u32x4){tu[0], tu[1], tu[2], tu[3]}; V4[dst] = (u32x4){tv[0], tv[1], tv[2], tv[3]}; }
    }
#else
    {
        u32x2* UB = (u32x2*)(ws + WS_UB); u32x2* VB = (u32x2*)(ws + WS_VB);
        const f32x4* u4 = (const f32x4*)p.pu; const f32x4* v4 = (const f32x4*)p.pv;
        for (int e = gt; e < NEXP * DM / 4; e += NGT) { const f32x4 a = u4[e]; u32x2 o; o.x = pk2(a[0], a[1]); o.y = pk2(a[2], a[3]); UB[e] = o;
            const f32x4 b = v4[e]; u32x2 q; q.x = pk2(b[0], b[1]); q.y = pk2(b[2], b[3]); VB[e] = q; }
    }
#endif
    {
        float2* rope = (float2*)(ws + WS_ROPE);
        for (int e = gt; e < (SEQ + 64) * 32; e += NGT) { const int pi = e >> 5, d = e & 31;
            const float invf = (float)pow(10000.0, -(double)d / 32.0); const float ang = (float)(pi - 48) * invf;
            rope[e] = make_float2((float)cos((double)ang), (float)sin((double)ang)); }
    }
    for (int m0 = gw; m0 < MROWS; m0 += 4 * NGW) {
        const float* srcp[4]; f32x4 v[4][4];
#pragma unroll
        for (int u = 0; u < 4; ++u) { const int m = m0 + u * NGW; srcp[u] = nullptr;
            if (m < MROWS) { if (m >= 256) srcp[u] = p.x + (size_t)(m - 256) * DM; else if (m >= 48 && m < 64) srcp[u] = p.meta + (size_t)(m - 48) * DM; }
            if (srcp[u] != nullptr) { const f32x4* xr = (const f32x4*)srcp[u] + lane;
#pragma unroll
                for (int j = 0; j < 4; ++j) v[u][j] = xr[64 * j]; }
            else {
#pragma unroll
                for (int j = 0; j < 4; ++j) v[u][j] = (f32x4){0.f, 0.f, 0.f, 0.f}; } }
        f32x4 gg[4];
#pragma unroll
        for (int j = 0; j < 4; ++j) gg[j] = ((const f32x4*)p.g1 + lane)[64 * j];
#pragma unroll
        for (int u = 0; u < 4; ++u) { const int m = m0 + u * NGW; if (m >= MROWS) continue;
            float s = 0.f;
#pragma unroll
            for (int j = 0; j < 4; ++j) s += (v[u][j].x * v[u][j].x + v[u][j].y * v[u][j].y) + (v[u][j].z * v[u][j].z + v[u][j].w * v[u][j].w);
            const float r = (srcp[u] != nullptr) ? __builtin_amdgcn_rsqf(wave_sum(s) * (1.0f / DM) + EPS) : 0.f;
            unsigned long long* o8 = (unsigned long long*)(XN + (size_t)m * DM) + lane;
#pragma unroll
            for (int j = 0; j < 4; ++j) { const f32x4 y = v[u][j] * r * gg[j]; o8[64 * j] = (unsigned long long)pk2(y.x, y.y) | ((unsigned long long)pk2(y.z, y.w) << 32); } }
    }
}

struct EpiProj {
    static constexpr bool PERM = true, AFTER_DRAIN = false;
    bf16_t* VG; bf16_t* QK; float* LAT; const float* gb; const float2* rope;
    __device__ __forceinline__ static size_t tile_off(int r, int head, int dg) { return ((((size_t)(r >> 6) * 4 + head) * 8 + dg) * 64 + (r & 63)) * 8; }
    __device__ __forceinline__ void operator()(const pg8::f32x4 (&acc)[2][2][4][2], const pg8::Unit& u, int wr, int wc, int fr, int fq) const {
        const int row0 = u.pm * 256 + wr * 64 + fr, cb0 = wc * 32 + 8 * fq;
        if (u.pn == 12) {
#pragma unroll
            for (int bj = 0; bj < 2; ++bj) { const int c = cb0 + 128 * bj; const f32x4 b0 = *(const f32x4*)(gb + c), b1 = *(const f32x4*)(gb + c + 4);
#pragma unroll
                for (int ai = 0; ai < 2; ++ai)
#pragma unroll
                    for (int m = 0; m < 4; ++m) { const int row = row0 + ai * 128 + m * 16; f32x4 v0 = acc[ai][bj][m][0] + b0, v1 = acc[ai][bj][m][1] + b1;
#pragma unroll
                        for (int i = 0; i < 4; ++i) { v0[i] = (fminf(v0[i], 0.f) - __logf(1.0f + __expf(-fabsf(v0[i])))) * 0.0625f; v1[i] = (fminf(v1[i], 0.f) - __logf(1.0f + __expf(-fabsf(v1[i])))) * 0.0625f; }
                        float* o = LAT + tile_off(row, c >> 6, (c & 63) >> 3); *(f32x4*)o = v0; *(f32x4*)(o + 4) = v1; } }
        } else if (u.pn == 6 || u.pn == 7) {
            bf16_t* QA = QK + (size_t)(u.pn - 4) * QK_ARR;
#pragma unroll
            for (int ai = 0; ai < 2; ++ai)
#pragma unroll
                for (int m = 0; m < 4; ++m) { const int row = row0 + ai * 128 + m * 16; const int pidx = (row < 256) ? row : 64 + ((row - 256) & (SEQ - 1));
#pragma unroll
                    for (int bj = 0; bj < 2; ++bj) { const int c = cb0 + 128 * bj, d0 = (c & 63) >> 1;
                        const f32x4 cs0 = *(const f32x4*)(rope + (size_t)pidx * 32 + d0), cs1 = *(const f32x4*)(rope + (size_t)pidx * 32 + d0 + 2);
                        const f32x4 t1 = acc[ai][bj][m][0], t2 = acc[ai][bj][m][1];
                        const float co[4] = {cs0[0], cs0[2], cs1[0], cs1[2]}, si[4] = {cs0[1], cs0[3], cs1[1], cs1[3]};
                        float o1[4], o2[4];
#pragma unroll
                        for (int i = 0; i < 4; ++i) { o1[i] = t1[i] * co[i] - t2[i] * si[i]; o2[i] = t1[i] * si[i] + t2[i] * co[i]; }
                        u32x4 w; w.x = pg8::cvt_pk_bf16(o1[0], o1[1]); w.y = pg8::cvt_pk_bf16(o1[2], o1[3]); w.z = pg8::cvt_pk_bf16(o2[0], o2[1]); w.w = pg8::cvt_pk_bf16(o2[2], o2[3]);
                        *(u32x4*)(QA + tile_off(row, c >> 6, (c & 63) >> 3)) = w; } }
        } else if (u.pn <= 1) {
            bf16_t* QA = QK + (size_t)u.pn * QK_ARR;
#pragma unroll
            for (int ai = 0; ai < 2; ++ai)
#pragma unroll
                for (int m = 0; m < 4; ++m) { const int row = row0 + ai * 128 + m * 16;
#pragma unroll
                    for (int bj = 0; bj < 2; ++bj) { const int c = cb0 + 128 * bj; const f32x4 v0 = acc[ai][bj][m][0], v1 = acc[ai][bj][m][1];
                        u32x4 w; w.x = pg8::cvt_pk_bf16(v0[0], v0[1]); w.y = pg8::cvt_pk_bf16(v0[2], v0[3]); w.z = pg8::cvt_pk_bf16(v1[0], v1[1]); w.w = pg8::cvt_pk_bf16(v1[2], v1[3]);
                        *(u32x4*)(QA + tile_off(row, c >> 6, (c & 63) >> 3)) = w; } }
        } else {
            const int cdst = (u.pn < 6 ? (u.pn - 2) : (u.pn - 4)) * 256;
#pragma unroll
            for (int ai = 0; ai < 2; ++ai)
#pragma unroll
                for (int m = 0; m < 4; ++m) { bf16_t* rowp = VG + (size_t)(row0 + ai * 128 + m * 16) * NVG + cdst + cb0;
#pragma unroll
                    for (int bj = 0; bj < 2; ++bj) { const f32x4 v0 = acc[ai][bj][m][0], v1 = acc[ai][bj][m][1];
                        u32x4 w; w.x = pg8::cvt_pk_bf16(v0[0], v0[1]); w.y = pg8::cvt_pk_bf16(v0[2], v0[3]); w.z = pg8::cvt_pk_bf16(v1[0], v1[1]); w.w = pg8::cvt_pk_bf16(v1[2], v1[3]);
                        *(u32x4*)(rowp + bj * 128) = w; } }
        }
    }
};
struct EpiRes {
    static constexpr bool PERM = true, AFTER_DRAIN = false;
    const float* x; bf16_t* HB; float* SSQ;
    __device__ __forceinline__ void operator()(const pg8::f32x4 (&acc)[2][2][4][2], const pg8::Unit& u, int wr, int wc, int fr, int fq) const {
        const int row0 = u.pm * 256 + wr * 64 + fr, col0 = u.pn * 256 + wc * 32 + 8 * fq;
#pragma unroll
        for (int ai = 0; ai < 2; ++ai)
#pragma unroll
            for (int m = 0; m < 4; ++m) { const int row = row0 + ai * 128 + m * 16; const float* xr = x + (size_t)row * DM + col0; bf16_t* hr = HB + (size_t)row * DM + col0; float ss = 0.f;
#pragma unroll
                for (int bj = 0; bj < 2; ++bj) { const f32x4 v0 = acc[ai][bj][m][0] + *(const f32x4*)(xr + bj * 128), v1 = acc[ai][bj][m][1] + *(const f32x4*)(xr + bj * 128 + 4);
                    ss += (v0[0] * v0[0] + v0[1] * v0[1]) + (v0[2] * v0[2] + v0[3] * v0[3]) + (v1[0] * v1[0] + v1[1] * v1[1]) + (v1[2] * v1[2] + v1[3] * v1[3]);
                    u32x4 w; w.x = pg8::cvt_pk_bf16(v0[0], v0[1]); w.y = pg8::cvt_pk_bf16(v0[2], v0[3]); w.z = pg8::cvt_pk_bf16(v1[0], v1[1]); w.w = pg8::cvt_pk_bf16(v1[2], v1[3]);
                    *(u32x4*)(hr + bj * 128) = w; }
                ss += __shfl_xor(ss, 16); ss += __shfl_xor(ss, 32);
                if (fq == 0) SSQ[(size_t)row * 16 + u.pn * 4 + wc] = ss; }
    }
};
struct EpiF16 {
    static constexpr bool PERM = true, AFTER_DRAIN = false;
    _Float16* SC;
    __device__ __forceinline__ void operator()(const pg8::f32x4 (&acc)[2][2][4][2], const pg8::Unit& u, int wr, int wc, int fr, int fq) const {
        const int row0 = u.pm * 256 + wr * 64 + fr, col0 = u.pn * 256 + wc * 32 + 8 * fq;
#pragma unroll
        for (int ai = 0; ai < 2; ++ai)
#pragma unroll
            for (int m = 0; m < 4; ++m) { _Float16* rowp = SC + (size_t)(row0 + ai * 128 + m * 16) * 2048 + col0;
#pragma unroll
                for (int bj = 0; bj < 2; ++bj) { const f32x4 v0 = acc[ai][bj][m][0], v1 = acc[ai][bj][m][1];
                    u32x4 w;
                    w.x = __builtin_bit_cast(unsigned, (f16x2_t){(_Float16)v0[0], (_Float16)v0[1]}); w.y = __builtin_bit_cast(unsigned, (f16x2_t){(_Float16)v0[2], (_Float16)v0[3]});
                    w.z = __builtin_bit_cast(unsigned, (f16x2_t){(_Float16)v1[0], (_Float16)v1[1]}); w.w = __builtin_bit_cast(unsigned, (f16x2_t){(_Float16)v1[2], (_Float16)v1[3]});
                    *(u32x4*)(rowp + bj * 128) = w; } }
    }
};

constexpr int A_QT = 0, A_KT = 9216, A_KE = 18432, A_V = 27648, A_ST = 45056, A_STSZ = 18432, A_OB = 81920, A_DEC = 115712, A_CS = 115968;
constexpr int PQ = 72, PV = 136, POB = 132;

__device__ __forceinline__ bf16x8 tr2(const LAS bf16_t* p0, const LAS bf16_t* p1) {
    const s16x4 a = __builtin_amdgcn_ds_read_tr16_b64_v4i16((LAS s16x4*)p0), b = __builtin_amdgcn_ds_read_tr16_b64_v4i16((LAS s16x4*)p1);
    return (bf16x8){a[0], a[1], a[2], a[3], b[0], b[1], b[2], b[3]};
}
__device__ __forceinline__ float ln_gamma(int hr) { return log1pf(-exp2f(-5.0f - (float)hr)); }

template <bool FULL>
__device__ __forceinline__ void attn_pass(const Params& p, LAS unsigned char* lds, int bid, int nb) {
    const int tid = threadIdx.x, lane = tid & 63, wave = __builtin_amdgcn_readfirstlane(tid >> 6);
    const int r16 = lane & 15, g4 = lane >> 4, q4 = (lane & 15) >> 2, p4 = lane & 3;
    unsigned char* ws = p.ws;
    const bf16_t* PROJ = (const bf16_t*)(ws + WS_PROJ); const float* LA = (const float*)(ws + WS_LA); const bf16_t* QK = (const bf16_t*)(ws + WS_QK);
    float* SEG = (float*)(ws + WS_SEG); float* ASEG = (float*)(ws + WS_ASEG); float* SEGM = (float*)(ws + WS_ASEG + 65536); bf16_t* OUT = (bf16_t*)(ws + WS_O);
    LAS bf16_t* QT = (LAS bf16_t*)(lds + A_QT); LAS bf16_t* KT = (LAS bf16_t*)(lds + A_KT); LAS bf16_t* KE = (LAS bf16_t*)(lds + A_KE); LAS bf16_t* VS = (LAS bf16_t*)(lds + A_V);
    LAS float* OB = (LAS float*)(lds + A_OB); LAS float* DEC = (LAS float*)(lds + A_DEC); LAS float* CS = (LAS float*)(lds + A_CS);

    for (int item = bid; item < 256; item += nb) {
        const int seg = item & 7, h8 = (item >> 3) & 7, b = item >> 6;
        const bool metaitem = !FULL && seg == 7 && b == 0;
        if (!FULL && seg == 7 && !metaitem) continue;
        const bool gla = h8 < 4; const int hr = h8 & 3;
        const float lng = ln_gamma(hr);
        const bf16_t* QAq = QK + (size_t)(gla ? 0 : 2) * QK_ARR; const bf16_t* QAk = QK + (size_t)(gla ? 1 : 3) * QK_ARR;
        const int vcol = (gla ? 0 : 1024) + hr * 128, gcol = (gla ? 512 : 1536) + hr * 128;
        const int nch = metaitem ? 1 : 16;

        f32x4 accS[8];
#pragma unroll
        for (int cb = 0; cb < 8; ++cb) accS[cb] = (f32x4){0.f, 0.f, 0.f, 0.f};
        float blsum[8] = {0.f, 0.f, 0.f, 0.f, 0.f, 0.f, 0.f, 0.f};
        __syncthreads();
        if (FULL) {
            if (wave >= 4) {
                const int wq = wave - 4;
                { const float* Sm = SEGM + (size_t)h8 * 8192;
#pragma unroll
                  for (int cb = 0; cb < 8; ++cb)
#pragma unroll
                      for (int rg = 0; rg < 4; ++rg) accS[cb][rg] = Sm[(16 * wq + 4 * g4 + rg) * 128 + 16 * cb + r16]; }
                for (int sp = 0; sp < seg; ++sp) { const int it2 = (item & ~7) + sp; const float* Sg = SEG + (size_t)it2 * 8192; const float* Ag = ASEG + it2 * 64;
                    float dec[4];
#pragma unroll
                    for (int rg = 0; rg < 4; ++rg) dec[rg] = Ag[16 * wq + 4 * g4 + rg];
#pragma unroll
                    for (int cb = 0; cb < 8; ++cb)
#pragma unroll
                        for (int rg = 0; rg < 4; ++rg) accS[cb][rg] = dec[rg] * accS[cb][rg] + Sg[(16 * wq + 4 * g4 + rg) * 128 + 16 * cb + r16]; }
                LAS bf16_t* ST0 = (LAS bf16_t*)(lds + A_ST);
#pragma unroll
                for (int cb = 0; cb < 8; ++cb) { u32x2 w; w.x = pk2(accS[cb][0], accS[cb][1]); w.y = pk2(accS[cb][2], accS[cb][3]); *(LAS u32x2*)(ST0 + (16 * cb + r16) * PQ + 16 * wq + 4 * g4) = w; }
            }
        }
#define A_ROWBASE(ci_) (metaitem ? 0 : 256 + b * SEQ + (16 * seg + (ci_)) * 64)
        f32x4 lav[2]; u32x4 qv8, kv8; u32x4 vreg[2];
        qv8 = (u32x4){0u, 0u, 0u, 0u};
#define A_LOADCHUNK(ci_) do { const int _rb = A_ROWBASE(ci_); \
            const size_t _to = ((((size_t)(_rb >> 6) * 4 + hr) * 8 + wave) * 64 + lane) * 8;       \
            if (gla) { const f32x4* _lp = (const f32x4*)(LA + _to); lav[0] = _lp[0]; lav[1] = _lp[1]; } \
            else { lav[0] = (f32x4){lng, lng, lng, lng}; lav[1] = lav[0]; } \
            if (FULL) qv8 = *(const u32x4*)(QAq + _to); \
            kv8 = *(const u32x4*)(QAk + _to); \
            { const int vr = tid >> 3, cc = tid & 7; const u32x4* src = (const u32x4*)(PROJ + (size_t)(_rb + vr) * NVG + vcol + cc * 16); vreg[0] = src[0]; vreg[1] = src[1]; } } while (0)
#define A_LBAR() do { asm volatile("s_waitcnt lgkmcnt(0)" ::: "memory"); __builtin_amdgcn_s_barrier(); asm volatile("" ::: "memory"); } while (0)
        A_LOADCHUNK(0);
        f32x4 gnv[4], bsv[4];
        { const float* gptr = (gla ? p.gla_gain : p.ret_gain) + 16 * (tid & 7); const float* bptr = p.ret_bias + 16 * (tid & 7); const float bsc = gla ? 0.f : 1.f;
#pragma unroll
          for (int k4 = 0; k4 < 4; ++k4) { gnv[k4] = *(const f32x4*)(gptr + 4 * k4); bsv[k4] = *(const f32x4*)(bptr + 4 * k4) * bsc; } }
        for (int ci = 0; ci < nch; ++ci) {
            const bool metac = metaitem;
            const int rowbase = A_ROWBASE(ci);
            const LAS bf16_t* STr = (const LAS bf16_t*)(lds + A_ST + (ci & 1) * A_STSZ); LAS bf16_t* STw = (LAS bf16_t*)(lds + A_ST + ((ci + 1) & 1) * A_STSZ);
            u32x4 gpre[2] = {(u32x4){0u, 0u, 0u, 0u}, (u32x4){0u, 0u, 0u, 0u}};
            if (FULL && !metac) { const u32x4* gp = (const u32x4*)(PROJ + (size_t)(rowbase + (tid >> 3)) * NVG + gcol + 16 * (tid & 7)); gpre[0] = gp[0]; gpre[1] = gp[1]; }
            {
                float bc[8];
#pragma unroll
                for (int c = 0; c < 8; ++c) { float v = lav[c >> 2][c & 3];
                    v += __builtin_bit_cast(float, __builtin_amdgcn_update_dpp(0, __builtin_bit_cast(int, v), 0x111, 0xf, 0xf, true));
                    v += __builtin_bit_cast(float, __builtin_amdgcn_update_dpp(0, __builtin_bit_cast(int, v), 0x112, 0xf, 0xf, true));
                    v += __builtin_bit_cast(float, __builtin_amdgcn_update_dpp(0, __builtin_bit_cast(int, v), 0x114, 0xf, 0xf, true));
                    v += __builtin_bit_cast(float, __builtin_amdgcn_update_dpp(0, __builtin_bit_cast(int, v), 0x118, 0xf, 0xf, true));
                    v += __builtin_bit_cast(float, __builtin_amdgcn_update_dpp(0, __builtin_bit_cast(int, v), 0x142, 0xa, 0xf, false));
                    v += __builtin_bit_cast(float, __builtin_amdgcn_update_dpp(0, __builtin_bit_cast(int, v), 0x143, 0xc, 0xf, false));
                    bc[c] = v; }
                float tot[8];
#pragma unroll
                for (int c = 0; c < 8; ++c) { tot[c] = __builtin_bit_cast(float, __builtin_amdgcn_readlane(__builtin_bit_cast(int, bc[c]), 63)); blsum[c] += tot[c]; }
                const unsigned qw[4] = {qv8.x, qv8.y, qv8.z, qv8.w}, kw[4] = {kv8.x, kv8.y, kv8.z, kv8.w};
                unsigned oq[4], ok[4], oe[4];
#pragma unroll
                for (int c2 = 0; c2 < 4; ++c2) { const float k0 = bf_lo(kw[c2]), k1 = bf_hi(kw[c2]);
                    if (FULL) { oq[c2] = pk2(bf_lo(qw[c2]) * __expf(bc[2 * c2]), bf_hi(qw[c2]) * __expf(bc[2 * c2 + 1])); ok[c2] = pk2(k0 * __expf(-bc[2 * c2]), k1 * __expf(-bc[2 * c2 + 1])); }
                    oe[c2] = pk2(k0 * __expf(tot[2 * c2] - bc[2 * c2]), k1 * __expf(tot[2 * c2 + 1] - bc[2 * c2 + 1])); }
                if (FULL) { *(LAS u32x4*)(QT + lane * PQ + 8 * wave) = (u32x4){oq[0], oq[1], oq[2], oq[3]}; *(LAS u32x4*)(KT + lane * PQ + 8 * wave) = (u32x4){ok[0], ok[1], ok[2], ok[3]}; }
                *(LAS u32x4*)(KE + lane * PQ + 8 * wave) = (u32x4){oe[0], oe[1], oe[2], oe[3]};
                if (lane == 63) { *(LAS f32x4*)(DEC + 8 * wave) = (f32x4){__expf(tot[0]), __expf(tot[1]), __expf(tot[2]), __expf(tot[3])};
                                  *(LAS f32x4*)(DEC + 8 * wave + 4) = (f32x4){__expf(tot[4]), __expf(tot[5]), __expf(tot[6]), __expf(tot[7])}; }
                const int vr = tid >> 3, cc = tid & 7; LAS u32x4* dst = (LAS u32x4*)(VS + vr * PV + cc * 16); dst[0] = vreg[0]; dst[1] = vreg[1];
            }
            if (ci + 1 < nch) A_LOADCHUNK(ci + 1);
            A_LBAR();
            if (wave < 4) {
                if (FULL && !metac) {
                    const int w = wave;
                    bf16x8 qf[2];
#pragma unroll
                    for (int s = 0; s < 2; ++s) qf[s] = *(const LAS bf16x8*)(QT + (16 * w + r16) * PQ + 32 * s + 8 * g4);
                    f32x4 att[4];
#pragma unroll
                    for (int jb = 0; jb < 4; ++jb) { att[jb] = (f32x4){0.f, 0.f, 0.f, 0.f};
                        if (jb <= w) {
#pragma unroll
                            for (int s = 0; s < 2; ++s) { const bf16x8 kf = *(const LAS bf16x8*)(KT + (16 * jb + r16) * PQ + 32 * s + 8 * g4);
                                att[jb] = __builtin_amdgcn_mfma_f32_16x16x32_bf16(kf, qf[s], att[jb], 0, 0, 0); }
                            if (jb == w) {
#pragma unroll
                                for (int rg = 0; rg < 4; ++rg) att[jb][rg] = (4 * g4 + rg <= r16) ? att[jb][rg] : 0.f;
                            }
                        } }
                    bf16x8 af[2];
#pragma unroll
                    for (int s = 0; s < 2; ++s) { u32x4 t; t.x = pk2(att[2 * s][0], att[2 * s][1]); t.y = pk2(att[2 * s][2], att[2 * s][3]); t.z = pk2(att[2 * s + 1][0], att[2 * s + 1][1]); t.w = pk2(att[2 * s + 1][2], att[2 * s + 1][3]);
                        af[s] = __builtin_bit_cast(bf16x8, t); }
#pragma unroll
                    for (int cb = 0; cb < 8; ++cb) { f32x4 o = (f32x4){0.f, 0.f, 0.f, 0.f};
#pragma unroll
                        for (int s = 0; s < 2; ++s) {
                            const bf16x8 vf = tr2(VS + (32 * s + 4 * g4 + q4) * PV + 16 * cb + 4 * p4, VS + (32 * s + 16 + 4 * g4 + q4) * PV + 16 * cb + 4 * p4);
                            o = __builtin_amdgcn_mfma_f32_16x16x32_bf16(af[s], vf, o, 0, 0, 0);
                            const bf16x8 sf = *(const LAS bf16x8*)(STr + (16 * cb + r16) * PQ + 32 * s + 8 * g4);
                            o = __builtin_amdgcn_mfma_f32_16x16x32_bf16(qf[s], sf, o, 0, 0, 0); }
#pragma unroll
                        for (int rg = 0; rg < 4; ++rg) OB[(16 * w + 4 * g4 + rg) * POB + 16 * cb + r16] = o[rg]; }
                }
            } else {
                const int wq = wave - 4;
                float dec[4];
#pragma unroll
                for (int rg = 0; rg < 4; ++rg) dec[rg] = DEC[16 * wq + 4 * g4 + rg];
                bf16x8 kef[2];
#pragma unroll
                for (int s = 0; s < 2; ++s) kef[s] = tr2(KE + (32 * s + 8 * g4 + q4) * PQ + 16 * wq + 4 * p4, KE + (32 * s + 8 * g4 + 4 + q4) * PQ + 16 * wq + 4 * p4);
#pragma unroll
                for (int cb = 0; cb < 8; ++cb) {
#pragma unroll
                    for (int rg = 0; rg < 4; ++rg) accS[cb][rg] *= dec[rg];
#pragma unroll
                    for (int s = 0; s < 2; ++s) { const bf16x8 vf = tr2(VS + (32 * s + 8 * g4 + q4) * PV + 16 * cb + 4 * p4, VS + (32 * s + 8 * g4 + 4 + q4) * PV + 16 * cb + 4 * p4);
                        accS[cb] = __builtin_amdgcn_mfma_f32_16x16x32_bf16(kef[s], vf, accS[cb], 0, 0, 0); }
                    if (FULL) { u32x2 w; w.x = pk2(accS[cb][0], accS[cb][1]); w.y = pk2(accS[cb][2], accS[cb][3]); *(LAS u32x2*)(STw + (16 * cb + r16) * PQ + 16 * wq + 4 * g4) = w; }
                }
            }
            A_LBAR();
            if (FULL && !metac) {
                const int i = tid >> 3, cc = tid & 7;
                float o[16];
#pragma unroll
                for (int k4 = 0; k4 < 4; ++k4) { const f32x4 t = *(const LAS f32x4*)(OB + i * POB + 16 * cc + 4 * k4); o[4 * k4] = t[0]; o[4 * k4 + 1] = t[1]; o[4 * k4 + 2] = t[2]; o[4 * k4 + 3] = t[3]; }
                const size_t row = (size_t)(rowbase + i);
                const u32x4 ga = gpre[0], gb2 = gpre[1];
                const unsigned gw[8] = {ga.x, ga.y, ga.z, ga.w, gb2.x, gb2.y, gb2.z, gb2.w};
                float s1 = 0.f, s2 = 0.f;
#pragma unroll
                for (int k = 0; k < 16; ++k) { s1 += o[k]; s2 += o[k] * o[k]; }
#pragma unroll
                for (int m = 1; m < 8; m <<= 1) { s1 += __shfl_xor(s1, m); s2 += __shfl_xor(s2, m); }
                const float mu = gla ? 0.f : s1 * (1.0f / 128.0f);
                const float rs = __builtin_amdgcn_rsqf(fmaxf(s2 * (1.0f / 128.0f) - mu * mu, 0.f) + EPS);
                unsigned ow[8];
#pragma unroll
                for (int k2 = 0; k2 < 8; ++k2) { float y[2];
#pragma unroll
                    for (int e = 0; e < 2; ++e) { const int k = 2 * k2 + e; const float v = (o[k] - mu) * rs * gnv[k >> 2][k & 3] + bsv[k >> 2][k & 3];
                        const float gt = e ? bf_hi(gw[k2]) : bf_lo(gw[k2]); y[e] = v * gt * __builtin_amdgcn_rcpf(1.0f + __expf(-gt)); }
                    ow[k2] = pk2(y[0], y[1]); }
                u32x4* op = (u32x4*)(OUT + (row - 256) * DM + h8 * 128 + 16 * cc);
                op[0] = (u32x4){ow[0], ow[1], ow[2], ow[3]}; op[1] = (u32x4){ow[4], ow[5], ow[6], ow[7]};
            }
        }
        if (!FULL) {
            if (wave >= 4) { const int wq = wave - 4; float* Sg = metaitem ? SEGM + (size_t)h8 * 8192 : SEG + (size_t)item * 8192;
#pragma unroll
                for (int cb = 0; cb < 8; ++cb)
#pragma unroll
                    for (int rg = 0; rg < 4; ++rg) Sg[(16 * wq + 4 * g4 + rg) * 128 + 16 * cb + r16] = accS[cb][rg]; }
            if (lane < 8 && !metaitem) { float bl = blsum[0];
#pragma unroll
                for (int c = 1; c < 8; ++c) bl = (lane == c) ? blsum[c] : bl;
                ASEG[item * 64 + 8 * wave + lane] = __expf(bl); }
        }
#undef A_LBAR
#undef A_ROWBASE
#undef A_LOADCHUNK
    }
}

__device__ __forceinline__ unsigned ord32(float f) { const unsigned b = __builtin_bit_cast(unsigned, f); return b ^ ((b >> 31) ? 0xffffffffu : 0x80000000u); }
__device__ __forceinline__ float unord32(unsigned o) { const unsigned b = (o >> 31) ? (o ^ 0x80000000u) : ~o; return __builtin_bit_cast(float, b); }
#define DPP_MAXU(v, ctrl, rmask) do { const unsigned _t = (unsigned)__builtin_amdgcn_update_dpp((int)(v), (int)(v), (ctrl), (rmask), 0xf, false); (v) = (v) > _t ? (v) : _t; } while (0)
#define DPP_ADDF(v, ctrl) do { const float _t = __builtin_bit_cast(float, __builtin_amdgcn_update_dpp(0, __builtin_bit_cast(int, (v)), (ctrl), 0xf, 0xf, false)); (v) += _t; } while (0)
__device__ __forceinline__ unsigned row_max_u(unsigned v) { DPP_MAXU(v, 0xB1, 0xf); DPP_MAXU(v, 0x4E, 0xf); DPP_MAXU(v, 0x124, 0xf); DPP_MAXU(v, 0x128, 0xf); return v; }
__device__ __forceinline__ float row_sum_f(float v) { DPP_ADDF(v, 0xB1); DPP_ADDF(v, 0x4E); DPP_ADDF(v, 0x124); DPP_ADDF(v, 0x128); return v; }
__device__ __forceinline__ unsigned wave_max_u(unsigned v) { v = row_max_u(v); DPP_MAXU(v, 0x142, 0xa); DPP_MAXU(v, 0x143, 0xc); return (unsigned)__builtin_amdgcn_readlane((int)v, 63); }

__device__ __forceinline__ float row_sum_x(float v) { return row_sum_f(v); }
__device__ __forceinline__ float dot2_bf16(unsigned w, unsigned x, float acc) { return __builtin_amdgcn_fdot2_f32_bf16(__builtin_bit_cast(bf16x2_t, w), __builtin_bit_cast(bf16x2_t, x), acc, false); }
__device__ __forceinline__ float gelu_exact(float v) { return 0.5f * v * (1.0f + erff(v * 0.70710678118654752f)); }

__device__ __forceinline__ void phase_peer(const Params& p, LAS unsigned char* lds, int bid, int nb) {
    const int tid = threadIdx.x, lane = tid & 63, wave = __builtin_amdgcn_readfirstlane(tid >> 6);
    const int p16 = lane & 15, rg4 = lane >> 4;
    unsigned char* ws = p.ws;
    const _Float16* SC = (const _Float16*)(ws + WS_PROJ); const bf16_t* HB = (const bf16_t*)(ws + WS_XN); const float* SSQ = (const float*)(ws + WS_SSQ);
    const unsigned char* UB = (const unsigned char*)(ws + WS_UB); const unsigned char* VB = (const unsigned char*)(ws + WS_VB);
    LAS float* A_s = (LAS float*)(lds + wave * 4096);
    LAS int* A_i = (LAS int*)(lds + wave * 4096 + 1024);
    LAS int* E_i = (LAS int*)(lds + wave * 4096 + 2048);
    LAS float* E_s = (LAS float*)(lds + wave * 4096 + 2560);
    int ci = 0, cj = 0; bool cvalid = lane < 50;
    { int l = lane;
      if (l < 16) { ci = 0; cj = l; } else if (l < 24) { ci = 1; cj = l - 16; } else if (l < 29) { ci = 2; cj = l - 24; } else if (l < 33) { ci = 3; cj = l - 29; }
      else if (l < 36) { ci = 4; cj = l - 33; } else if (l < 42) { ci = 5 + (l - 36) / 2; cj = (l - 36) & 1; } else { ci = 8 + (l - 42); cj = 0; } if (!cvalid) { ci = 0; cj = 0; } }
    const int gw = bid * 8 + wave, NGW = nb * 8;
    for (int t = gw; t < NTOK; t += NGW) {
        float ssq = (lane < 16) ? SSQ[(size_t)t * 16 + lane] : 0.f; ssq = wave_sum(ssq);
        const float rstd = 1.0f / sqrtf(ssq * (1.0f / DM) + EPS);
#pragma unroll 1
        for (int q = 0; q < 4; ++q) {
            const u32x4 raw = *(const u32x4*)(SC + (size_t)t * 2048 + 512 * q + 8 * lane);
            const unsigned rw[4] = {raw.x, raw.y, raw.z, raw.w};
            unsigned key[8];
#pragma unroll
            for (int e = 0; e < 8; ++e) { const unsigned hbits = (e & 1) ? (rw[e >> 1] >> 16) : (rw[e >> 1] & 0xffffu);
                const float f = (float)__builtin_bit_cast(_Float16, (unsigned short)hbits);
                key[e] = (ord32(f) & ~0x7fu) | (unsigned)(127 - (8 * p16 + e)); }
            unsigned mine = 0u;
#pragma unroll 1
            for (int it = 0; it < 16; ++it) {
                unsigned m = key[0];
#pragma unroll
                for (int e = 1; e < 8; ++e) m = m > key[e] ? m : key[e];
                const unsigned W = row_max_u(m);
                mine = (p16 == it) ? W : mine;
#pragma unroll
                for (int e = 0; e < 8; ++e) key[e] = (key[e] == W) ? 0u : key[e];
            }
            const int g = 4 * q + rg4;
            A_s[g * 16 + p16] = unord32(mine & ~0x7fu); A_i[g * 16 + p16] = 127 - (int)(mine & 0x7fu);
        }
        LDS_WAIT();
#pragma unroll 1
        for (int h = 0; h < 8; ++h) {
            const float sa = A_s[(2 * h) * 16 + ci], sb = A_s[(2 * h + 1) * 16 + cj];
            const int ia = A_i[(2 * h) * 16 + ci], ib = A_i[(2 * h + 1) * 16 + cj];
            const float sum = sa + sb;
            unsigned key = cvalid ? ((ord32(sum) & ~0x3fu) | (unsigned)(63 - lane)) : 0u;
            int rank = -1;
#pragma unroll 1
            for (int it = 0; it < 16; ++it) { const unsigned W = wave_max_u(key); if (key == W) { rank = it; key = 0u; } }
            if (rank >= 0) { E_i[h * 16 + rank] = ia * 128 + ib; E_s[h * 16 + rank] = sum; }
        }
        LDS_WAIT();
        float gsm[2]; int eidx[2];
#pragma unroll
        for (int sl = 0; sl < 2; ++sl) { const int e = lane + 64 * sl; const float s = E_s[e] * rstd, mx = E_s[e & ~15] * rstd; const float pe = __expf(s - mx); const float den = row_sum_x(pe);
            gsm[sl] = pe / den; eidx[sl] = E_i[e]; }
#if PEER_FP8
        f32x2v xf[4][8];
#pragma unroll
        for (int i = 0; i < 4; ++i) { const u32x4 h0 = *(const u32x4*)(HB + (size_t)t * DM + 256 * i + 16 * p16), h1 = *(const u32x4*)(HB + (size_t)t * DM + 256 * i + 16 * p16 + 8);
            const unsigned hv[8] = {h0.x, h0.y, h0.z, h0.w, h1.x, h1.y, h1.z, h1.w}; const float* gp = p.g2 + 256 * i + 16 * p16;
#pragma unroll
            for (int k2 = 0; k2 < 8; ++k2) { const f32x2v g = *(const f32x2v*)(gp + 2 * k2); xf[i][k2] = (f32x2v){bf_lo(hv[k2]) * rstd * g.x, bf_hi(hv[k2]) * rstd * g.y}; } }
        constexpr int NBB = 2;
#define P6_LOADB(buf, TAB, bt0) do { _Pragma("unroll") for (int j = 0; j < NBB; ++j) { const int bt = (bt0) + j; const int ex = E_i[64 * (bt >> 4) + 16 * rg4 + (bt & 15)]; \
            const unsigned char* rp = (TAB) + (size_t)ex * 1024 + 16 * p16; _Pragma("unroll") for (int i = 0; i < 4; ++i) buf[j][i] = *(const u32x4*)(rp + 256 * i); } } while (0)
        u32x4 bA[NBB][4], bB[NBB][4];
        float act0 = 0.f, act1 = 0.f;
#define P6_COMPU(buf, bt0) do { _Pragma("unroll") for (int j = 0; j < NBB; ++j) { const int bt = (bt0) + j; f32x2v s2 = (f32x2v){0.f, 0.f}; \
            _Pragma("unroll") for (int i = 0; i < 4; ++i) { const unsigned uu[4] = {buf[j][i].x, buf[j][i].y, buf[j][i].z, buf[j][i].w}; \
                _Pragma("unroll") for (int w = 0; w < 4; ++w) { const f32x2v lo = __builtin_amdgcn_cvt_pk_f32_fp8((int)uu[w], false), hi = __builtin_amdgcn_cvt_pk_f32_fp8((int)uu[w], true); \
                    s2 = __builtin_elementwise_fma(lo, xf[i][2 * w], s2); s2 = __builtin_elementwise_fma(hi, xf[i][2 * w + 1], s2); } } \
            const float s = row_sum_x(s2.x + s2.y); const bool mine = (p16 == (bt & 15)); act0 = (mine && bt < 16) ? s : act0; act1 = (mine && bt >= 16) ? s : act1; } } while (0)
        P6_LOADB(bA, UB, 0);
#pragma unroll 1
        for (int g = 0; g < 32; g += 2 * NBB) { P6_LOADB(bB, UB, g + NBB); P6_COMPU(bA, g); if (g + 2 * NBB < 32) P6_LOADB(bA, UB, g + 2 * NBB); P6_COMPU(bB, g + NBB); }
        P6_LOADB(bA, VB, 0);
        LAS float* E_c = E_s;
        { const float c0 = gsm[0] * gelu_exact(act0 * (1.0f / 512.0f)) * (1.0f / 32.0f), c1 = gsm[1] * gelu_exact(act1 * (1.0f / 512.0f)) * (1.0f / 32.0f);
          LDS_WAIT(); E_c[lane] = c0; E_c[lane + 64] = c1; LDS_WAIT(); }
        f32x2v acc2[4][8];
#pragma unroll
        for (int i = 0; i < 4; ++i)
#pragma unroll
            for (int k = 0; k < 8; ++k) acc2[i][k] = (f32x2v){0.f, 0.f};
#define P6_COMPV(buf, bt0) do { _Pragma("unroll") for (int j = 0; j < NBB; ++j) { const int bt = (bt0) + j; const float cf = E_c[64 * (bt >> 4) + 16 * rg4 + (bt & 15)]; const f32x2v cf2 = (f32x2v){cf, cf}; \
            _Pragma("unroll") for (int i = 0; i < 4; ++i) { const unsigned vv[4] = {buf[j][i].x, buf[j][i].y, buf[j][i].z, buf[j][i].w}; \
                _Pragma("unroll") for (int w = 0; w < 4; ++w) { const f32x2v lo = __builtin_amdgcn_cvt_pk_f32_fp8((int)vv[w], false), hi = __builtin_amdgcn_cvt_pk_f32_fp8((int)vv[w], true); \
                    acc2[i][2 * w] = __builtin_elementwise_fma(lo, cf2, acc2[i][2 * w]); acc2[i][2 * w + 1] = __builtin_elementwise_fma(hi, cf2, acc2[i][2 * w + 1]); } } } } while (0)
#pragma unroll 1
        for (int g = 0; g < 32; g += 2 * NBB) { P6_LOADB(bB, VB, g + NBB); P6_COMPV(bA, g); if (g + 2 * NBB < 32) P6_LOADB(bA, VB, g + 2 * NBB); P6_COMPV(bB, g + NBB); }
#undef P6_LOADB
#undef P6_COMPU
#undef P6_COMPV
        float ss = 0.f;
#pragma unroll
        for (int i = 0; i < 4; ++i) { const u32x4 h0 = *(const u32x4*)(HB + (size_t)t * DM + 256 * i + 16 * p16), h1 = *(const u32x4*)(HB + (size_t)t * DM + 256 * i + 16 * p16 + 8);
            const unsigned hv[8] = {h0.x, h0.y, h0.z, h0.w, h1.x, h1.y, h1.z, h1.w};
#pragma unroll
            for (int k2 = 0; k2 < 8; ++k2) { float ax = acc2[i][k2].x, ay = acc2[i][k2].y;
                ax += __shfl_xor(ax, 16); ax += __shfl_xor(ax, 32); ay += __shfl_xor(ay, 16); ay += __shfl_xor(ay, 32);
                ax += bf_lo(hv[k2]); ay += bf_hi(hv[k2]); acc2[i][k2] = (f32x2v){ax, ay}; ss += ax * ax + ay * ay; } }
        ss = row_sum_x(ss);
        const float rf = 1.0f / sqrtf(ss * (1.0f / DM) + EPS);
#pragma unroll
        for (int i = 0; i < 4; ++i) { if (i == rg4) { const float* gp = p.gfin + 256 * i + 16 * p16; float* op = p.out + (size_t)t * DM + 256 * i + 16 * p16;
#pragma unroll
                for (int k4 = 0; k4 < 4; ++k4) { const f32x4 g = *(const f32x4*)(gp + 4 * k4);
                    *(f32x4*)(op + 4 * k4) = (f32x4){acc2[i][2 * k4].x * rf * g[0], acc2[i][2 * k4].y * rf * g[1], acc2[i][2 * k4 + 1].x * rf * g[2], acc2[i][2 * k4 + 1].y * rf * g[3]}; } } }
#else
        unsigned xp[8][4];
#pragma unroll
        for (int i = 0; i < 8; ++i) { const u32x4 hw = *(const u32x4*)(HB + (size_t)t * DM + 128 * i + 8 * p16); const f32x4 ga = *(const f32x4*)(p.g2 + 128 * i + 8 * p16), gb = *(const f32x4*)(p.g2 + 128 * i + 8 * p16 + 4);
            xp[i][0] = pk2(bf_lo(hw.x) * rstd * ga[0], bf_hi(hw.x) * rstd * ga[1]); xp[i][1] = pk2(bf_lo(hw.y) * rstd * ga[2], bf_hi(hw.y) * rstd * ga[3]);
            xp[i][2] = pk2(bf_lo(hw.z) * rstd * gb[0], bf_hi(hw.z) * rstd * gb[1]); xp[i][3] = pk2(bf_lo(hw.w) * rstd * gb[2], bf_hi(hw.w) * rstd * gb[3]); }
        float act[2] = {0.f, 0.f};
#pragma unroll
        for (int sl = 0; sl < 2; ++sl) {
#pragma unroll 2
            for (int b16 = 0; b16 < 16; ++b16) {
                const int e = 64 * sl + 16 * rg4 + b16; const int ex = E_i[e];
                const unsigned char* rowp = UB + (size_t)ex * 2048 + 16 * p16;
                float s = 0.f;
#pragma unroll
                for (int i = 0; i < 8; ++i) { const u32x4 uw = *(const u32x4*)(rowp + 256 * i);
                    s = dot2_bf16(uw.x, xp[i][0], s); s = dot2_bf16(uw.y, xp[i][1], s); s = dot2_bf16(uw.z, xp[i][2], s); s = dot2_bf16(uw.w, xp[i][3], s); }
                s = row_sum_x(s);
                act[sl] = (p16 == b16) ? s : act[sl];
            }
        }
        float coef[2];
#pragma unroll
        for (int sl = 0; sl < 2; ++sl) coef[sl] = gsm[sl] * gelu_exact(act[sl]);
        float acc[8][8];
#pragma unroll
        for (int i = 0; i < 8; ++i)
#pragma unroll
            for (int k = 0; k < 8; ++k) acc[i][k] = 0.f;
#pragma unroll
        for (int sl = 0; sl < 2; ++sl) {
#pragma unroll 2
            for (int b16 = 0; b16 < 16; ++b16) {
                const int srcl = (lane & 48) + b16;
                const float cf = __shfl(coef[sl], srcl); const int ex = __shfl(eidx[sl], srcl);
                const unsigned char* rowp = VB + (size_t)ex * 2048 + 16 * p16;
#pragma unroll
                for (int i = 0; i < 8; ++i) { const u32x4 vw = *(const u32x4*)(rowp + 256 * i);
                    acc[i][0] += cf * bf_lo(vw.x); acc[i][1] += cf * bf_hi(vw.x); acc[i][2] += cf * bf_lo(vw.y); acc[i][3] += cf * bf_hi(vw.y);
                    acc[i][4] += cf * bf_lo(vw.z); acc[i][5] += cf * bf_hi(vw.z); acc[i][6] += cf * bf_lo(vw.w); acc[i][7] += cf * bf_hi(vw.w); }
            }
        }
        float ss = 0.f;
#pragma unroll
        for (int i = 0; i < 8; ++i) { const u32x4 hw = *(const u32x4*)(HB + (size_t)t * DM + 128 * i + 8 * p16); const unsigned hv[4] = {hw.x, hw.y, hw.z, hw.w};
#pragma unroll
            for (int k = 0; k < 8; ++k) { float a = acc[i][k]; a += __shfl_xor(a, 16); a += __shfl_xor(a, 32);
                a += (k & 1) ? bf_hi(hv[k >> 1]) : bf_lo(hv[k >> 1]); acc[i][k] = a; ss += a * a; } }
        ss = row_sum_x(ss);
        const float rf = 1.0f / sqrtf(ss * (1.0f / DM) + EPS);
#pragma unroll
        for (int i = 0; i < 8; ++i) { if ((i >> 1) == rg4) { const f32x4 ga = *(const f32x4*)(p.gfin + 128 * i + 8 * p16), gb = *(const f32x4*)(p.gfin + 128 * i + 8 * p16 + 4);
                float* op = p.out + (size_t)t * DM + 128 * i + 8 * p16;
                *(f32x4*)op = (f32x4){acc[i][0] * rf * ga[0], acc[i][1] * rf * ga[1], acc[i][2] * rf * ga[2], acc[i][3] * rf * ga[3]};
                *(f32x4*)(op + 4) = (f32x4){acc[i][4] * rf * gb[0], acc[i][5] * rf * gb[1], acc[i][6] * rf * gb[2], acc[i][7] * rf * gb[3]}; } }
#endif
        LDS_WAIT();
    }
}


__device__ __forceinline__ void row_max4(unsigned k0, unsigned k1, unsigned k2, unsigned k3, unsigned& w0, unsigned& w1, unsigned& w2, unsigned& w3) {
    asm volatile("s_nop 1\n\t"
                 "v_max_u32_dpp %0, %4, %4 quad_perm:[1,0,3,2] row_mask:0xf bank_mask:0xf\n\t"
                 "v_max_u32_dpp %1, %5, %5 quad_perm:[1,0,3,2] row_mask:0xf bank_mask:0xf\n\t"
                 "v_max_u32_dpp %2, %6, %6 quad_perm:[1,0,3,2] row_mask:0xf bank_mask:0xf\n\t"
                 "v_max_u32_dpp %3, %7, %7 quad_perm:[1,0,3,2] row_mask:0xf bank_mask:0xf\n\t"
                 "v_max_u32_dpp %0, %0, %0 quad_perm:[2,3,0,1] row_mask:0xf bank_mask:0xf\n\t"
                 "v_max_u32_dpp %1, %1, %1 quad_perm:[2,3,0,1] row_mask:0xf bank_mask:0xf\n\t"
                 "v_max_u32_dpp %2, %2, %2 quad_perm:[2,3,0,1] row_mask:0xf bank_mask:0xf\n\t"
                 "v_max_u32_dpp %3, %3, %3 quad_perm:[2,3,0,1] row_mask:0xf bank_mask:0xf\n\t"
                 "v_max_u32_dpp %0, %0, %0 row_ror:4 row_mask:0xf bank_mask:0xf\n\t"
                 "v_max_u32_dpp %1, %1, %1 row_ror:4 row_mask:0xf bank_mask:0xf\n\t"
                 "v_max_u32_dpp %2, %2, %2 row_ror:4 row_mask:0xf bank_mask:0xf\n\t"
                 "v_max_u32_dpp %3, %3, %3 row_ror:4 row_mask:0xf bank_mask:0xf\n\t"
                 "v_max_u32_dpp %0, %0, %0 row_ror:8 row_mask:0xf bank_mask:0xf\n\t"
                 "v_max_u32_dpp %1, %1, %1 row_ror:8 row_mask:0xf bank_mask:0xf\n\t"
                 "v_max_u32_dpp %2, %2, %2 row_ror:8 row_mask:0xf bank_mask:0xf\n\t"
                 "v_max_u32_dpp %3, %3, %3 row_ror:8 row_mask:0xf bank_mask:0xf\n\t"
                 "s_nop 1"
                 : "=&v"(w0), "=&v"(w1), "=&v"(w2), "=&v"(w3) : "v"(k0), "v"(k1), "v"(k2), "v"(k3));
}
__device__ __forceinline__ unsigned pkadd_h2(unsigned a, unsigned b) { const h2v x = __builtin_bit_cast(h2v, a), y = __builtin_bit_cast(h2v, b); const h2v s = x + y; return __builtin_bit_cast(unsigned, s); }
constexpr int NT6 = 8;
constexpr int W6_BYTES = 16640;
__device__ __forceinline__ float dpp_f(float v, int ctrl_dummy);
#define DPPF(v, ctrl) __builtin_bit_cast(float, __builtin_amdgcn_update_dpp(0, __builtin_bit_cast(int, (v)), (ctrl), 0xf, 0xf, false))

__device__ __forceinline__ void phase_peer2(const Params& p, LAS unsigned char* lds, int bid, int nb) {
    const int tid = threadIdx.x, lane = tid & 63, wave = __builtin_amdgcn_readfirstlane(tid >> 6);
    const int p16 = lane & 15, rg4 = lane >> 4, q8 = lane >> 3, p8 = lane & 7;
    const bool b0 = lane & 1, b1 = lane & 2, b2 = lane & 4, c0 = lane & 8, c1 = lane & 16, c2 = lane & 32;
    unsigned char* ws = p.ws;
    const _Float16* SC = (const _Float16*)(ws + WS_PROJ); const bf16_t* HB = (const bf16_t*)(ws + WS_XN); const float* SSQ = (const float*)(ws + WS_SSQ);
    const unsigned char* UB = (const unsigned char*)(ws + WS_UB); const unsigned char* VB = (const unsigned char*)(ws + WS_VB); unsigned char* XQ = ws + WS_XQ;
    LAS unsigned char* wl = lds + wave * W6_BYTES;
    LAS unsigned* CW = (LAS unsigned*)wl;
    LAS unsigned char* XL = wl;
    LAS unsigned short* E16 = (LAS unsigned short*)(wl + 8192);
    LAS _Float16* GC = (LAS _Float16*)(wl + 10240);
    LAS unsigned* E32 = (LAS unsigned*)(wl + 4096);
    LAS float* ACT = (LAS float*)(wl + 12288);
    LAS float* RS = (LAS float*)(wl + 16384);
    int ci = 0, cj = 0; bool cvalid = lane < 50;
    { int l = lane;
      if (l < 16) { ci = 0; cj = l; } else if (l < 24) { ci = 1; cj = l - 16; } else if (l < 29) { ci = 2; cj = l - 24; } else if (l < 33) { ci = 3; cj = l - 29; }
      else if (l < 36) { ci = 4; cj = l - 33; } else if (l < 42) { ci = 5 + (l - 36) / 2; cj = (l - 36) & 1; } else { ci = 8 + (l - 42); cj = 0; } if (!cvalid) { ci = 0; cj = 0; } }
    const int gw = bid * 8 + wave, NGW = nb * 8;
#define TOK6(k) min(base + (k) * NGW, NTOK - 1)
    for (int base = gw; base < NTOK; base += NT6 * NGW) {
#pragma unroll 1
        for (int rep_r = 0; rep_r < PROBE_R; ++rep_r)
#pragma unroll 1
        for (int k = 0; k < NT6; k += 2) {
            u32x4 raw[2][4]; float rstd[2];
#pragma unroll
            for (int v = 0; v < 2; ++v) { const int t = TOK6(k + v);
#pragma unroll
                for (int q = 0; q < 4; ++q) raw[v][q] = *(const u32x4*)(SC + (size_t)t * 2048 + 512 * q + 8 * lane);
                float ssq = (lane < 16) ? SSQ[(size_t)t * 16 + lane] : 0.f; ssq = wave_sum(ssq);
                rstd[v] = 1.0f / sqrtf(ssq * (1.0f / DM) + EPS);
                { const u32x4 ha = *(const u32x4*)(HB + (size_t)t * DM + 16 * lane), hb = *(const u32x4*)(HB + (size_t)t * DM + 16 * lane + 8); const float sc = rstd[v] * 16.0f;
                  const unsigned hv[8] = {ha.x, ha.y, ha.z, ha.w, hb.x, hb.y, hb.z, hb.w}; unsigned xw[4];
#pragma unroll
                  for (int w = 0; w < 4; ++w) { int pk = __builtin_amdgcn_cvt_pk_fp8_f32(bf_lo(hv[2 * w]) * sc, bf_hi(hv[2 * w]) * sc, 0, false);
                      pk = __builtin_amdgcn_cvt_pk_fp8_f32(bf_lo(hv[2 * w + 1]) * sc, bf_hi(hv[2 * w + 1]) * sc, pk, true); xw[w] = (unsigned)pk; }
                  *(u32x4*)(XQ + (size_t)t * DM + 16 * lane) = (u32x4){xw[0], xw[1], xw[2], xw[3]}; } }
#pragma unroll
            for (int qq = 0; qq < 2; ++qq) {
                unsigned ka[4][8];
#pragma unroll
                for (int c = 0; c < 4; ++c) { const u32x4 rv = raw[c >> 1][2 * qq + (c & 1)]; const unsigned rw[4] = {rv.x, rv.y, rv.z, rv.w};
#pragma unroll
                    for (int e = 0; e < 8; ++e) { const unsigned hbits = (e & 1) ? (rw[e >> 1] >> 16) : (rw[e >> 1] & 0xffffu);
                        const float f = (float)__builtin_bit_cast(_Float16, (unsigned short)hbits);
                        ka[c][e] = (ord32(f) & ~0x7fu) | (unsigned)(127 - (8 * p16 + e)); } }
#define CE6(u, i, j) do { const unsigned _a = ka[u][i], _b = ka[u][j]; ka[u][i] = _a > _b ? _a : _b; ka[u][j] = _a > _b ? _b : _a; } while (0)
#pragma unroll
                for (int u = 0; u < 4; ++u) {
                    CE6(u, 0, 1); CE6(u, 2, 3); CE6(u, 4, 5); CE6(u, 6, 7);
                    CE6(u, 0, 2); CE6(u, 1, 3); CE6(u, 4, 6); CE6(u, 5, 7);
                    CE6(u, 1, 2); CE6(u, 5, 6);
                    CE6(u, 0, 4); CE6(u, 1, 5); CE6(u, 2, 6); CE6(u, 3, 7);
                    CE6(u, 2, 4); CE6(u, 3, 5);
                    CE6(u, 1, 2); CE6(u, 3, 4); CE6(u, 5, 6);
                }
#undef CE6
                unsigned mine[4] = {0u, 0u, 0u, 0u};
#pragma unroll 1
                for (int it = 0; it < 16; ++it) {
                    unsigned Wv[4]; row_max4(ka[0][0], ka[1][0], ka[2][0], ka[3][0], Wv[0], Wv[1], Wv[2], Wv[3]);
#pragma unroll
                    for (int c = 0; c < 4; ++c) {
                        const unsigned W = Wv[c];
                        mine[c] = (p16 == it) ? W : mine[c];
                        const bool win = (ka[c][0] == W);
#pragma unroll
                        for (int e = 0; e < 7; ++e) ka[c][e] = win ? ka[c][e + 1] : ka[c][e];
                        ka[c][7] = win ? 0u : ka[c][7];
                    }
                }
#pragma unroll
                for (int c = 0; c < 4; ++c) { const int g = 4 * (2 * qq + (c & 1)) + rg4; LAS float* A_s = (LAS float*)(wl + 3072 * (c >> 1)); LAS int* A_i = (LAS int*)(wl + 3072 * (c >> 1) + 1024);
                    A_s[g * 16 + p16] = unord32(mine[c] & ~0x7fu); A_i[g * 16 + p16] = 127 - (int)(mine[c] & 0x7fu); }
            }
            LDS_WAIT();
            {
                float av[4], bc[4]; int iav[4], ibc[4], jp[4], hh[4], bb[4]; unsigned key[4];
#pragma unroll
                for (int c = 0; c < 4; ++c) { const LAS float* A_s = (const LAS float*)(wl + 3072 * (c >> 1)); const LAS int* A_i = (const LAS int*)(wl + 3072 * (c >> 1) + 1024);
                    hh[c] = 4 * (c & 1) + rg4; bb[c] = (2 * hh[c] + 1) * 16; av[c] = A_s[(2 * hh[c]) * 16 + p16]; iav[c] = A_i[(2 * hh[c]) * 16 + p16] * 128; jp[c] = 0; bc[c] = A_s[bb[c]]; ibc[c] = A_i[bb[c]];
                    key[c] = (ord32(av[c] + bc[c]) & ~0xfu) | (unsigned)(15 - p16); }
#pragma unroll 1
                for (int it = 0; it < 16; ++it) {
                    unsigned Wv[4]; row_max4(key[0], key[1], key[2], key[3], Wv[0], Wv[1], Wv[2], Wv[3]);
#pragma unroll
                    for (int c = 0; c < 4; ++c) {
                        const LAS float* A_s = (const LAS float*)(wl + 3072 * (c >> 1)); const LAS int* A_i = (const LAS int*)(wl + 3072 * (c >> 1) + 1024);
                        LAS int* E_i = (LAS int*)(wl + 3072 * (c >> 1) + 2048); LAS float* E_s = (LAS float*)(wl + 3072 * (c >> 1) + 2560);
                        const bool win = (key[c] == Wv[c]);
                        if (win) { E_i[hh[c] * 16 + it] = iav[c] + ibc[c]; E_s[hh[c] * 16 + it] = av[c] + bc[c]; }
                        jp[c] += win ? 1 : 0;
                        const int jr = jp[c] < 16 ? jp[c] : 15;
                        bc[c] = A_s[bb[c] + jr]; ibc[c] = A_i[bb[c] + jr];
                        key[c] = jp[c] < 16 ? ((ord32(av[c] + bc[c]) & ~0xfu) | (unsigned)(15 - p16)) : 0u;
                    }
                }
            }
            LDS_WAIT();
#pragma unroll
            for (int v = 0; v < 2; ++v) { const LAS int* E_i = (const LAS int*)(wl + 3072 * v + 2048); const LAS float* E_s = (const LAS float*)(wl + 3072 * v + 2560);
#pragma unroll
                for (int sl = 0; sl < 2; ++sl) { const int e = lane + 64 * sl; const float s = E_s[e] * rstd[v], mx = E_s[e & ~15] * rstd[v]; const float pe = __expf(s - mx); const float den = row_sum_x(pe);
                    const int pos = 16 * (e & 7) + (e >> 3);
                    GC[(k + v) * 128 + pos] = (_Float16)(pe / den); E16[(k + v) * 128 + pos] = (unsigned short)E_i[e]; }
                if (lane == 0) RS[k + v] = rstd[v]; }
            LDS_WAIT();
        }
#define P6_LOADH(buf, TAB, jj, kk, hh) do { const u32x4 _iv = *(const LAS u32x4*)(E16 + (kk) * 128 + 16 * q8 + 8 * (hh)); const unsigned _iw[4] = {_iv.x, _iv.y, _iv.z, _iv.w}; \
            _Pragma("unroll") for (int c = 0; c < 8; ++c) { const unsigned _idx = (c & 1) ? (_iw[c >> 1] >> 16) : (_iw[c >> 1] & 0xffffu); \
                buf[c] = *(const u32x4*)((TAB) + (((size_t)(jj) * NEXP + _idx) << 7) + 16 * p8); } } while (0)
#define P6_LOADX(hb, jj, kk) do { const bf16_t* _hp = HB + (size_t)TOK6(kk) * DM + 128 * (jj) + 16 * p8; hb[0] = *(const u32x4*)_hp; hb[1] = *(const u32x4*)(_hp + 8); } while (0)
        asm volatile("s_waitcnt vmcnt(0)" ::: "memory");
        { u32x4 xr[NT6];
#pragma unroll
          for (int k = 0; k < NT6; ++k) xr[k] = *(const u32x4*)(XQ + (size_t)TOK6(k) * DM + 16 * lane);
#pragma unroll
          for (int k = 0; k < NT6; ++k) *(LAS u32x4*)(XL + k * 1024 + 16 * lane) = xr[k]; }
        LDS_WAIT();
#pragma unroll 1
        for (int rep_u = 0; rep_u < PROBE_U; ++rep_u) {
            for (int k = 0; k < NT6; ++k) { ACT[k * 128 + lane] = 0.f; ACT[k * 128 + 64 + lane] = 0.f; }
            LDS_WAIT();
            const int n16 = lane & 15, g4 = lane >> 4, c4 = lane & 3, r16 = 4 * g4 + (n16 >> 2);
            const int eoff = 2 * (16 * (r16 & 7) + (r16 >> 3));
            const bool xkeep = ((g4 >> 1) == ((n16 >> 2) & 1)); const bool klo = xkeep && (n16 < 8), khi = xkeep && (n16 >= 8);
            u32x4 bfP[16], bfQ[16];
#define P6_ULOAD(buf, nn) do { const int _j = (nn) / NT6, _k = (nn) % NT6; const LAS unsigned char* _ip = (const LAS unsigned char*)(E16 + _k * 128) + eoff; \
                _Pragma("unroll") for (int T = 0; T < 8; ++T) { const unsigned _idx = *(const LAS unsigned short*)(_ip + 4 * T); \
                    const unsigned char* _rp = UB + (((size_t)_j * NEXP + _idx) << 7) + 16 * c4; buf[2 * T] = *(const u32x4*)_rp; buf[2 * T + 1] = *(const u32x4*)(_rp + 64); } } while (0)
#define P6_PK64(lo, hi) ((long)(((unsigned long long)(hi) << 32) | (unsigned long long)(lo)))
#define P6_UMMA(buf, nn) do { const int k = (nn) % NT6; const LAS unsigned char* _xl = XL + k * 1024 + 256 * ((nn) / NT6) + 32 * c4 + 16 * (g4 & 1); \
                const u32x4 xv0 = *(const LAS u32x4*)_xl, xv1 = *(const LAS u32x4*)(_xl + 128); \
                const i32x8 xa0 = {(int)(klo ? xv0.x : 0u), (int)(klo ? xv0.y : 0u), (int)(klo ? xv0.z : 0u), (int)(klo ? xv0.w : 0u), \
                                   (int)(khi ? xv0.x : 0u), (int)(khi ? xv0.y : 0u), (int)(khi ? xv0.z : 0u), (int)(khi ? xv0.w : 0u)}; \
                const i32x8 xa1 = {(int)(klo ? xv1.x : 0u), (int)(klo ? xv1.y : 0u), (int)(klo ? xv1.z : 0u), (int)(klo ? xv1.w : 0u), \
                                   (int)(khi ? xv1.x : 0u), (int)(khi ? xv1.y : 0u), (int)(khi ? xv1.z : 0u), (int)(khi ? xv1.w : 0u)}; \
                float dsel[2] = {0.f, 0.f}; \
                _Pragma("unroll") for (int T = 0; T < 8; ++T) { f32x4 d = (f32x4){0.f, 0.f, 0.f, 0.f}; \
                    const i32x8 bb0 = {(int)buf[2 * T].x, (int)buf[2 * T].y, (int)buf[2 * T].z, (int)buf[2 * T].w, 0, 0, 0, 0}; \
                    const i32x8 bb1 = {(int)buf[2 * T + 1].x, (int)buf[2 * T + 1].y, (int)buf[2 * T + 1].z, (int)buf[2 * T + 1].w, 0, 0, 0, 0}; \
                    d = __builtin_amdgcn_mfma_scale_f32_16x16x128_f8f6f4(xa0, bb0, d, 0, 4, 0, MX_ONE, 0, MX_ONE); \
                    d = __builtin_amdgcn_mfma_scale_f32_16x16x128_f8f6f4(xa1, bb1, d, 0, 4, 0, MX_ONE, 0, MX_ONE); \
                    float pv = (c4 == 0) ? d[0] : ((c4 == 1) ? d[1] : ((c4 == 2) ? d[2] : d[3])); \
                    pv += DPPF(pv, 0xB1); pv += DPPF(pv, 0x4E);                         \
                    dsel[T >> 2] = ((T & 3) == c4) ? pv : dsel[T >> 2]; } \
                  \
                ACT[k * 128 + 16 * c4 + r16] += dsel[0]; ACT[k * 128 + 16 * (c4 + 4) + r16] += dsel[1]; } while (0)
            P6_ULOAD(bfP, 0);
#pragma unroll 1
            for (int n = 0; n < 4 * NT6; n += 2) {
                P6_ULOAD(bfQ, n + 1); asm volatile("" ::: "memory"); __builtin_amdgcn_sched_barrier(0);
                P6_UMMA(bfP, n); __builtin_amdgcn_sched_barrier(0);
                if (n + 2 < 4 * NT6) P6_ULOAD(bfP, n + 2);
                asm volatile("" ::: "memory"); __builtin_amdgcn_sched_barrier(0);
                P6_UMMA(bfQ, n + 1); __builtin_amdgcn_sched_barrier(0);
            }
#undef P6_ULOAD
#undef P6_UMMA
#undef P6_PK64
        }
        LDS_WAIT();
#pragma unroll 1
        for (int k = 0; k < NT6; ++k) {
#pragma unroll
            for (int sl = 0; sl < 2; ++sl) { const int e = lane + 64 * sl, pos = 16 * (e & 7) + (e >> 3); const float a = ACT[k * 128 + e] * (1.0f / 1024.0f);
                const float cfv = (float)GC[k * 128 + pos] * gelu_exact(a);
                CW[k * 128 + pos] = (unsigned)(__builtin_amdgcn_cvt_pk_fp8_f32(cfv * 32.0f, 0.f, 0, false) & 0xff) * 0x01010101u; E32[k * 128 + pos] = (unsigned)E16[k * 128 + pos] << 7; } }
        LDS_WAIT();
#pragma unroll 1
        for (int k = 0; k < NT6; ++k) ACT[k * 64 + lane] = 0.f;
        LDS_WAIT();
#pragma unroll 1
        for (int rep_v = 0; rep_v < PROBE_V; ++rep_v) {
            for (int k = 0; k < NT6; ++k) ACT[k * 64 + lane] = 0.f;
            LDS_WAIT();
            u32x4 bfP[16], bfQ[16];
            const int n16 = lane & 15, g4 = lane >> 4;
            const unsigned bsel = 0xffu << (8 * (n16 & 3));
            const unsigned M0 = (n16 >> 2) == 0 ? bsel : 0u, M1 = (n16 >> 2) == 1 ? bsel : 0u, M2 = (n16 >> 2) == 2 ? bsel : 0u, M3 = (n16 >> 2) == 3 ? bsel : 0u;
            const int c0 = 16 * n16 + 4 * g4;
            const unsigned loff = 8u * (unsigned)n16;
#define P6_VLOAD(buf, nn) do { const int _j = (nn) / NT6, _k = (nn) % NT6; const LAS unsigned* _ip = E32 + _k * 128 + 32 * g4; \
                const unsigned char* _tb = VB + (size_t)_j * NEXP * 128; \
                _Pragma("unroll") for (int q = 0; q < 4; ++q) { const u32x4 _o0 = *(const LAS u32x4*)(_ip + 4 * q), _o1 = *(const LAS u32x4*)(_ip + 16 + 4 * q); \
                    const unsigned _ow0[4] = {_o0.x, _o0.y, _o0.z, _o0.w}, _ow1[4] = {_o1.x, _o1.y, _o1.z, _o1.w}; \
                    _Pragma("unroll") for (int cc = 0; cc < 4; ++cc) { \
                        const u32x2 _t0 = *(const u32x2*)(_tb + (size_t)(_ow0[cc] + loff)), _t1 = *(const u32x2*)(_tb + (size_t)(_ow1[cc] + loff)); \
                        buf[4 * q + cc] = (u32x4){_t0.x, _t0.y, _t1.x, _t1.y}; } } } while (0)
#define P6_LOADR2(hb, nn) do { hb = *(const u32x2*)(HB + (size_t)TOK6((nn) % NT6) * DM + 256 * ((nn) / NT6) + c0); } while (0)
#define P6_VBODY(buf, nn, hb) do { const int j = (nn) / NT6, k = (nn) % NT6; const int t = TOK6(k); \
                const LAS unsigned* _cp = CW + k * 128 + 16 * g4; \
                const u32x4 _c0 = *(const LAS u32x4*)_cp, _c1 = *(const LAS u32x4*)(_cp + 4), _c2 = *(const LAS u32x4*)(_cp + 8), _c3 = *(const LAS u32x4*)(_cp + 12); \
                const u32x4 _d0 = *(const LAS u32x4*)(_cp + 64), _d1 = *(const LAS u32x4*)(_cp + 68), _d2 = *(const LAS u32x4*)(_cp + 72), _d3 = *(const LAS u32x4*)(_cp + 76); \
                const unsigned _cl[16] = {_c0.x, _c0.y, _c0.z, _c0.w, _c1.x, _c1.y, _c1.z, _c1.w, _c2.x, _c2.y, _c2.z, _c2.w, _c3.x, _c3.y, _c3.z, _c3.w}; \
                const unsigned _ch[16] = {_d0.x, _d0.y, _d0.z, _d0.w, _d1.x, _d1.y, _d1.z, _d1.w, _d2.x, _d2.y, _d2.z, _d2.w, _d3.x, _d3.y, _d3.z, _d3.w}; \
                f32x4 dA = (f32x4){0.f, 0.f, 0.f, 0.f}, dB = (f32x4){0.f, 0.f, 0.f, 0.f}; \
                _Pragma("unroll") for (int c = 0; c < 16; ++c) { const unsigned _l = _cl[c], _h = _ch[c]; \
                    const i32x8 av = {(int)(_l & M0), (int)(_l & M1), (int)(_l & M2), (int)(_l & M3), (int)(_h & M0), (int)(_h & M1), (int)(_h & M2), (int)(_h & M3)}; \
                    const i32x8 bv = {(int)buf[c].x, (int)buf[c].y, (int)buf[c].z, (int)buf[c].w, 0, 0, 0, 0}; \
                    if (c & 1) dB = __builtin_amdgcn_mfma_scale_f32_16x16x128_f8f6f4(av, bv, dB, 0, 4, 0, MX_ONE, 0, MX_ONE); \
                    else       dA = __builtin_amdgcn_mfma_scale_f32_16x16x128_f8f6f4(av, bv, dA, 0, 4, 0, MX_ONE, 0, MX_ONE); } \
                const float hv[4] = {bf_lo(hb.x), bf_hi(hb.x), bf_lo(hb.y), bf_hi(hb.y)}; float o[4]; float ss = 0.f; \
                _Pragma("unroll") for (int r = 0; r < 4; ++r) { o[r] = (dA[r] + dB[r]) * (1.0f / (32.0f * V4_SCALE)) + hv[r]; ss += o[r] * o[r]; } \
                *(f32x4*)(p.out + (size_t)t * DM + 256 * j + c0) = (f32x4){o[0], o[1], o[2], o[3]}; \
                ACT[k * 64 + lane] += ss; \
                } while (0)
            P6_VLOAD(bfP, 0);
#pragma unroll 1
            for (int n = 0; n < 4 * NT6; n += 2) {
                u32x2 hr0, hr1; P6_LOADR2(hr0, n); P6_LOADR2(hr1, n + 1);
                asm volatile("" ::: "memory");
                P6_VLOAD(bfQ, n + 1); asm volatile("" ::: "memory"); __builtin_amdgcn_sched_barrier(0);
                P6_VBODY(bfP, n, hr0); __builtin_amdgcn_sched_barrier(0);
                if (n + 2 < 4 * NT6) P6_VLOAD(bfP, n + 2);
                asm volatile("" ::: "memory"); __builtin_amdgcn_sched_barrier(0);
                P6_VBODY(bfQ, n + 1, hr1); __builtin_amdgcn_sched_barrier(0);
            }
            LDS_WAIT(); asm volatile("s_waitcnt vmcnt(0)" ::: "memory");
            f32x4 gfv[4];
#pragma unroll
            for (int i = 0; i < 4; ++i) gfv[i] = *(const f32x4*)(p.gfin + 256 * i + 4 * lane);
#pragma unroll 1
            for (int k = 0; k < NT6; ++k) { const float sst = wave_sum(ACT[k * 64 + lane]); const float rf = __builtin_amdgcn_rsqf(sst * (1.0f / DM) + EPS);
                float* op = p.out + (size_t)TOK6(k) * DM + 4 * lane; f32x4 ov[4];
#pragma unroll
                for (int i = 0; i < 4; ++i) ov[i] = *(const f32x4*)(op + 256 * i);
#pragma unroll
                for (int i = 0; i < 4; ++i) *(f32x4*)(op + 256 * i) = ov[i] * rf * gfv[i]; }
        }
        LDS_WAIT();
    }
#undef P6_LOADH
#undef P6_LOADX
#undef P6_VLOAD
#undef P6_VBODY
#undef P6_LOADR2
#undef P6_PK64
#undef TOK6
}

#define XB_TMO      128
#define XB_XCNT(j)  (256  + 64 * (j))
#define XB_XSUB(j)  (1280 + 64 * (j))
#define XB_XGEN(j)  (2304 + 64 * (j))
#define XB_TOP      3328
#define XB_TOPGEN   3392
#define XCD_BAR_WORDS 3456
#define XB_SPIN_CAP (1u << 18)

__device__ __forceinline__ unsigned xb_ld(unsigned* p)              { return __hip_atomic_load(p, __ATOMIC_RELAXED, __HIP_MEMORY_SCOPE_AGENT); }
__device__ __forceinline__ unsigned xb_add(unsigned* p, unsigned v) { return __hip_atomic_fetch_add(p, v, __ATOMIC_RELAXED, __HIP_MEMORY_SCOPE_AGENT); }
__device__ __forceinline__ unsigned xb_xcc_id() { return (unsigned)__builtin_amdgcn_s_getreg((3 << 11) | 20) & 0xFu; }
#define XB_SPIN(cond, bar) do { unsigned _sp = 0; while (cond) { __builtin_amdgcn_s_sleep(1); \
    if ((++_sp & 255u) == 0u) { if (xb_ld(&(bar)[XB_TMO])) break; if (_sp > XB_SPIN_CAP) { atomicAdd(&(bar)[XB_TMO], 1u); break; } } } } while (0)

struct XcdBarrier {
    unsigned* bar; unsigned x;
    volatile LAS unsigned* st;
};

__device__ __forceinline__ XcdBarrier xcd_barrier_post(unsigned* bar, volatile LAS unsigned* st) {
    XcdBarrier b; b.bar = bar; b.x = xb_xcc_id(); b.st = st;
    if (threadIdx.x == 0) (void)xb_add(&bar[XB_XCNT(b.x)], 1u);
    return b;
}
__device__ __forceinline__ void xcd_barrier_complete(unsigned* bar, unsigned x, unsigned& nloc, unsigned& nx) {
    const unsigned G = gridDim.x * gridDim.y * gridDim.z;
    unsigned sum, cnt, mine, sp = 0u;
    for (;;) {
        sum = 0u; cnt = 0u; mine = 0u;
#pragma unroll
        for (unsigned j = 0; j < 16; ++j) { const unsigned c = xb_ld(&bar[XB_XCNT(j)]); sum += c; cnt += (c > 0u) ? 1u : 0u; mine = (j == x) ? c : mine; }
        if (sum == G) break;
        __builtin_amdgcn_s_sleep(1);
        if ((++sp & 255u) == 0u) { if (xb_ld(&bar[XB_TMO])) break; if (sp > XB_SPIN_CAP) { atomicAdd(&bar[XB_TMO], 1u); break; } }
    }
    nloc = mine > 0u ? mine : 1u; nx = cnt > 0u ? cnt : 1u;
}

__device__ __forceinline__ void xcd_barrier(const XcdBarrier& b) {
    asm volatile("s_waitcnt vmcnt(0)" ::: "memory");
    __syncthreads();
    if (threadIdx.x == 0) {
        unsigned* bar = b.bar;
        __builtin_amdgcn_s_waitcnt(0);
        unsigned nloc = b.st[0], nx = b.st[1];
        if (nloc == 0u) { xcd_barrier_complete(bar, b.x, nloc, nx); b.st[0] = nloc; b.st[1] = nx; }
        const unsigned old = xb_add(&bar[XB_XSUB(b.x)], 1u);
        const unsigned gen = old / nloc;
        if (old + 1u == (gen + 1u) * nloc) {
            __builtin_amdgcn_fence(__ATOMIC_RELEASE, "agent");
            asm volatile("s_waitcnt vmcnt(0)" ::: "memory");
            const unsigned og = xb_add(&bar[XB_TOP], 1u);
            const unsigned tg = og / nx;
            if (og + 1u == (tg + 1u) * nx) xb_add(&bar[XB_TOPGEN], 1u);
            else XB_SPIN(xb_ld(&bar[XB_TOPGEN]) == tg, bar);
            __builtin_amdgcn_fence(__ATOMIC_ACQUIRE, "agent");
            xb_add(&bar[XB_XGEN(b.x)], 1u);
            asm volatile("s_waitcnt vmcnt(0)" ::: "memory");
        } else {
            XB_SPIN(xb_ld(&bar[XB_XGEN(b.x)]) == gen, bar);
            __builtin_amdgcn_fence(__ATOMIC_ACQUIRE, "agent");
            asm volatile("s_waitcnt vmcnt(0)" ::: "memory");
        }
    }
    __syncthreads();
}

__global__ void __launch_bounds__(512, 2) mk_fwd(Params p) {
    extern __shared__ __attribute__((aligned(16))) unsigned char lds_raw[];
    LAS unsigned char* lds = (LAS unsigned char*)lds_raw;
    const int bid = blockIdx.x, nb = gridDim.x;
    unsigned char* ws = p.ws;
#define IN(k) (p.ph_lo <= (k) && (k) < p.ph_hi)
#define SEAM(k) do { if (IN(k) && IN((k) + 1)) { xcd_barrier(bar); } } while (0)
    if (threadIdx.x < 4) ((volatile LAS unsigned*)(lds + LDS_BYTES - 16))[threadIdx.x] = 0u;
    __syncthreads();
    const XcdBarrier bar = xcd_barrier_post((unsigned*)(ws + WS_CTL) + 4096, (volatile LAS unsigned*)(lds + LDS_BYTES - 16));
    if (IN(0)) phase0(p, lds, bid, nb);
    SEAM(0);
    if (IN(1)) {
        pg8::Gemm g{(const bf16_t*)(ws + WS_XN), (const bf16_t*)(ws + WS_WIN), MROWS, NP1, DM}; pg8::StaticOrder S; S.init(MROWS, NP1, nb, bid);
        EpiProj E{(bf16_t*)(ws + WS_PROJ), (bf16_t*)(ws + WS_QK), (float*)(ws + WS_LA), p.gb, (const float2*)(ws + WS_ROPE)};
        pg8::gemm_phase<EpiProj, pg8::StaticOrder, true, true>(lds, g, S, E);
    }
    SEAM(1);
    if (IN(2)) attn_pass<false>(p, lds, bid, nb);
    SEAM(2);
    if (IN(3)) attn_pass<true>(p, lds, bid, nb);
    SEAM(3);
    if (IN(4)) {
        pg8::Gemm g{(const bf16_t*)(ws + WS_O), (const bf16_t*)(ws + WS_WOUT), NTOK, DM, DM}; pg8::StaticOrder S; S.init(NTOK, DM, nb, bid);
        EpiRes E{p.x, (bf16_t*)(ws + WS_XN), (float*)(ws + WS_SSQ)};
        pg8::gemm_phase<EpiRes, pg8::StaticOrder, true, true>(lds, g, S, E);
    }
    SEAM(4);
    if (IN(5)) {
        pg8::Gemm g{(const bf16_t*)(ws + WS_XN), (const bf16_t*)(ws + WS_WS), NTOK, 2048, DM}; pg8::StaticOrder S; S.init(NTOK, 2048, nb, bid);
        EpiF16 E{(_Float16*)(ws + WS_PROJ)};
        pg8::gemm_phase<EpiF16, pg8::StaticOrder, true, true>(lds, g, S, E);
    }
    SEAM(5);
    if (IN(6)) phase_peer2(p, lds, bid, nb);
#undef IN
#undef SEAM
}

#ifndef MK_FUSED
#define MK_FUSED 1
#endif
extern "C" void kernel_launch(void* const* d_in, const int* in_sizes, int n_in, void* d_out, int out_size, void* d_ws, size_t ws_size, hipStream_t stream) {
    static int grid = 0;
    if (grid == 0) {
        if (n_in != 16 || in_sizes[0] != NTOK * DM || out_size != NTOK * DM || ws_size < WS_END) {
            fprintf(stderr, "kernel_launch: unexpected shapes (n_in %d, in0 %d, out %d, ws %zu); nothing launched\n", n_in, n_in > 0 ? in_sizes[0] : -1, out_size, ws_size); grid = -1; return; }
        int dev = 0, cus = 0, per_cu = 0;
        hipGetDevice(&dev); hipDeviceGetAttribute(&cus, hipDeviceAttributeMultiprocessorCount, dev);
        if (hipFuncSetAttribute((const void*)mk_fwd, hipFuncAttributeMaxDynamicSharedMemorySize, LDS_BYTES) != hipSuccess) { fprintf(stderr, "kernel_launch: hipFuncSetAttribute failed\n"); grid = -1; return; }
        if (hipOccupancyMaxActiveBlocksPerMultiprocessor(&per_cu, (const void*)mk_fwd, 512, LDS_BYTES) != hipSuccess || per_cu < 1) { fprintf(stderr, "kernel_launch: occupancy query failed (%d)\n", per_cu); (void)hipGetLastError(); per_cu = 1; }
        grid = cus * (per_cu < 1 ? 1 : 1);
        fprintf(stderr, "kernel_launch: %d CUs, occupancy %d/CU, grid %d\n", cus, per_cu, grid);
    }
    if (grid < 0) return;
    (void)hipMemsetAsync((char*)d_ws + WS_CTL, 0, 65536, stream);
    Params p{};
    p.x = (const float*)d_in[0]; p.meta = (const float*)d_in[1]; p.g1 = (const float*)d_in[2]; p.w_in = (const float*)d_in[3]; p.gw2 = (const float*)d_in[4]; p.gb = (const float*)d_in[5];
    p.gla_gain = (const float*)d_in[6]; p.ret_gain = (const float*)d_in[7]; p.ret_bias = (const float*)d_in[8]; p.w_out = (const float*)d_in[9]; p.g2 = (const float*)d_in[10];
    p.w_q = (const float*)d_in[11]; p.subkeys = (const float*)d_in[12]; p.pu = (const float*)d_in[13]; p.pv = (const float*)d_in[14]; p.gfin = (const float*)d_in[15];
    p.out = (float*)d_out; p.ws = (unsigned char*)d_ws;
#if MK_FUSED
    p.ph_lo = 0; p.ph_hi = NPHASE;
    void* args[] = {&p};
    hipError_t e = hipLaunchCooperativeKernel((const void*)mk_fwd, dim3(grid), dim3(512), args, LDS_BYTES, stream);
    if (e != hipSuccess) fprintf(stderr, "kernel_launch: cooperative launch failed: %s (grid %d)\n", hipGetErrorString(e), grid);
#else
    { const int order[7] = {0, 1, 2, 3, 4, 5, 6}; for (int i = 0; i < 7; ++i) { p.ph_lo = order[i]; p.ph_hi = order[i] + 1; hipLaunchKernelGGL(mk_fwd, dim3(grid), dim3(512), LDS_BYTES, stream, p); } }
#endif
}
```

```cpp
#include <hip/hip_runtime.h>
#include <hip/hip_cooperative_groups.h>
#include <cstdio>
#include <cstdint>
namespace cg = cooperative_groups;
namespace pg8 {
#define PG8_LAS __attribute__((address_space(3)))
typedef unsigned short bf16_t;
typedef short bf16x8 __attribute__((ext_vector_type(8)));
typedef float f32x4 __attribute__((ext_vector_type(4)));
typedef unsigned u32x4 __attribute__((ext_vector_type(4)));
constexpr int BM = 256, BK = 64, HALF = 128, HTB = HALF * BK * 2  , STAGE_BYTES = 8 * HTB, NXCD = 8, WGM = 8;

__host__ __device__ __forceinline__ int lds_byte(int r, int c) { const int st = (r >> 4) * 2 + (c >> 5), rr = r & 15, cc = c & 31, ob = rr * 64 + cc * 2; return st * 1024 + (ob ^ (((ob >> 9) & 1) << 5)); }
__host__ __device__ __forceinline__ void stage_rc(int b, int& R, int& C) { const int st = b / 1024, sb = b % 1024, swz = sb ^ (((sb >> 9) & 1) << 5); R = (st >> 1) * 16 + swz / 64; C = (st & 1) * 32 + (swz % 64) / 2; }
__host__ __device__ __forceinline__ int perm32(int rho) { const int n = rho >> 4, i = rho & 15; return 8 * (i >> 2) + 4 * n + (i & 3); }

struct Unit { int pm, pn; };
struct Gemm { const bf16_t* A; const bf16_t* Bt; int M, N, K; };

struct StaticOrder {
    int nM, nN, nwg, G, c;
    __host__ __device__ void init(int M, int N, int G_, int c_) { nM = M / BM; nN = N / BM; nwg = nM * nN; G = G_; c = c_; }
    __host__ __device__ bool next(int i, Unit& u) const {
        const long L = (long)i * G + c; if (L >= nwg) return false;
        int wgid = (int)L; { const int q = nwg / NXCD, r = nwg % NXCD, xcd = wgid % NXCD, off = wgid / NXCD; wgid = (xcd < r ? xcd * (q + 1) : r * (q + 1) + (xcd - r) * q) + off; }
        const int nig = WGM * nN, gid = wgid / nig, fm = gid * WGM, gsz = (nM - fm) < WGM ? (nM - fm) : WGM;
        u.pm = fm + ((wgid % nig) % gsz); u.pn = (wgid % nig) / gsz; return true;
    }
    __device__ __forceinline__ void a_ready(const Unit&) const {}
    __device__ __forceinline__ void done(const Unit&) const {}
};

__device__ __forceinline__ unsigned cvt_pk_bf16(float lo, float hi) { unsigned r; asm volatile("v_cvt_pk_bf16_f32 %0, %1, %2" : "=v"(r) : "v"(lo), "v"(hi)); return r; }
typedef float f32x2 __attribute__((ext_vector_type(2)));
template <class Epi, class Sched, bool ALIGN_EPI = false, bool SP2 = false>
__device__ __forceinline__ void gemm_phase(PG8_LAS unsigned char* lds, const Gemm g, const Sched& S, const Epi& E) {
    const int tid = threadIdx.x, wid = __builtin_amdgcn_readfirstlane(tid >> 6), lane = tid & 63, wr = wid >> 2, wc = wid & 3, fr = lane & 15, fq = lane >> 4;
    const int K = g.K, nt = K / BK;
    unsigned voffA[2], voffB[2];
#pragma unroll
    for (int i = 0; i < 2; ++i) { int R, C; stage_rc(tid * 16 + i * 8192, R, C); const int Rb = Epi::PERM ? ((R & ~31) + perm32(R & 31)) : R;
        voffA[i] = (unsigned)(R * K + C) * 2u; voffB[i] = (unsigned)(Rb * K + C) * 2u; }
    const size_t kstep = (size_t)(BK * 2);
    const size_t hstep = (size_t)HALF * K * 2;
    const size_t tstep = 2 * hstep;
    const unsigned ldsw = (unsigned)wid * 1024u;
    const int aoff = lds_byte(wr * 64 + fr, fq * 8), boff = lds_byte(wc * 32 + fr, fq * 8);
#define PG8_SA(b, h) (((b) * 2 + (h)) * HTB)
#define PG8_SB(b, h) ((4 + (b) * 2 + (h)) * HTB)
#define PG8_STAGE(bufoff, gbase, voff) do { _Pragma("unroll") for (int _i = 0; _i < 2; ++_i) \
        __builtin_amdgcn_global_load_lds((const unsigned*)((const char*)(gbase) + (voff)[_i]), (PG8_LAS unsigned*)(lds + (bufoff) + ldsw + _i * 8192), 16, 0, 0); } while (0)
#define PG8_LDA(dst, b, h) do { _Pragma("unroll") for (int m = 0; m < 4; ++m) _Pragma("unroll") for (int k = 0; k < 2; ++k) dst[m][k] = *(const PG8_LAS bf16x8*)(lds + PG8_SA(b, h) + aoff + m * 2048 + k * 1024); } while (0)
#define PG8_LDB(dst, b, h) do { _Pragma("unroll") for (int n = 0; n < 2; ++n) _Pragma("unroll") for (int k = 0; k < 2; ++k) dst[n][k] = *(const PG8_LAS bf16x8*)(lds + PG8_SB(b, h) + boff + n * 2048 + k * 1024); } while (0)
#define PG8_MMA(ai, bj, At, Bt) do { __builtin_amdgcn_s_setprio(1); _Pragma("unroll") for (int m = 0; m < 4; ++m) _Pragma("unroll") for (int n = 0; n < 2; ++n) _Pragma("unroll") for (int k = 0; k < 2; ++k) \
        acc[ai][bj][m][n] = __builtin_amdgcn_mfma_f32_16x16x32_bf16(Bt[n][k], At[m][k], acc[ai][bj][m][n], 0, 0, 0); __builtin_amdgcn_s_setprio(0); } while (0)
#define PG8_WAIT_V(n) asm volatile("s_waitcnt vmcnt(" #n ")" ::: "memory")
#define PG8_WAIT_L(n) asm volatile("s_waitcnt lgkmcnt(" #n ")" ::: "memory")
#define PG8_BAR __builtin_amdgcn_s_barrier()
#define PG8_SCHED __builtin_amdgcn_sched_barrier(0)
    Unit cur, nxt; int ui = 0;
    if (!S.next(0, cur)) return;
    f32x4 acc[2][2][4][2];
#pragma unroll
    for (int a = 0; a < 2; ++a)
#pragma unroll
        for (int b = 0; b < 2; ++b)
#pragma unroll
            for (int m = 0; m < 4; ++m)
#pragma unroll
                for (int n = 0; n < 2; ++n) acc[a][b][m][n] = (f32x4){0.f, 0.f, 0.f, 0.f};
    bf16x8 At[4][2], B0[2][2], B1[2][2];
    const char* cA = (const char*)g.A + (size_t)cur.pm * tstep; const char* cB = (const char*)g.Bt + (size_t)cur.pn * tstep;
    S.a_ready(cur);
    if constexpr (SP2) {
        PG8_STAGE(PG8_SB(0, 0), cB, voffB); PG8_STAGE(PG8_SB(0, 1), cB + hstep, voffB); PG8_STAGE(PG8_SA(0, 0), cA, voffA); PG8_STAGE(PG8_SA(0, 1), cA + hstep, voffA);
        if (wr == 1) PG8_BAR;
        PG8_WAIT_V(2); PG8_BAR;
        PG8_STAGE(PG8_SB(1, 0), cB + kstep, voffB); PG8_STAGE(PG8_SA(1, 0), cA + kstep, voffA); PG8_STAGE(PG8_SB(1, 1), cB + hstep + kstep, voffB);
        PG8_WAIT_V(6); PG8_BAR;
    } else {
        PG8_STAGE(PG8_SB(0, 0), cB, voffB); PG8_STAGE(PG8_SA(0, 0), cA, voffA); PG8_STAGE(PG8_SB(0, 1), cB + hstep, voffB); PG8_STAGE(PG8_SA(0, 1), cA + hstep, voffA);
        if (wr == 1) PG8_BAR;
        PG8_WAIT_V(4); PG8_BAR;
        PG8_STAGE(PG8_SB(1, 0), cB + kstep, voffB); PG8_STAGE(PG8_SA(1, 0), cA + kstep, voffA); PG8_STAGE(PG8_SB(1, 1), cB + hstep + kstep, voffB);
        PG8_WAIT_V(6); PG8_BAR;
    }
    for (;;) {
        const bool has_next = S.next(ui + 1, nxt);
        const char* nA = has_next ? (const char*)g.A + (size_t)nxt.pm * tstep : cA; const char* nB = has_next ? (const char*)g.Bt + (size_t)nxt.pn * tstep : cB;
        for (int t = 0; t < nt; t += 2) {
            const bool last = (t == nt - 2);
            const char* a1 = cA + (size_t)(t + 1) * kstep;
            const char* a2 = last ? nA : cA + (size_t)(t + 2) * kstep; const char* b2 = last ? nB : cB + (size_t)(t + 2) * kstep;
            const char* a3 = a2 + kstep; const char* b3 = b2 + kstep;
            if (last && has_next) S.a_ready(nxt);
            if constexpr (SP2) {
            PG8_LDB(B0, 0, 0); PG8_LDB(B1, 0, 1); PG8_SCHED; PG8_LDA(At, 0, 0); PG8_STAGE(PG8_SA(1, 1), a1 + hstep, voffA);
            PG8_WAIT_V(8); PG8_WAIT_L(0); PG8_BAR; PG8_MMA(0, 0, At, B0); PG8_MMA(0, 1, At, B1); PG8_BAR; PG8_SCHED;
            PG8_LDA(At, 0, 1); PG8_STAGE(PG8_SB(0, 0), b2, voffB); PG8_STAGE(PG8_SB(0, 1), b2 + hstep, voffB); PG8_STAGE(PG8_SA(0, 0), a2, voffA);
            PG8_WAIT_V(8); PG8_WAIT_L(0); PG8_BAR; PG8_MMA(1, 0, At, B0); PG8_MMA(1, 1, At, B1); PG8_BAR; PG8_SCHED;
            PG8_LDB(B0, 1, 0); PG8_LDB(B1, 1, 1); PG8_SCHED; PG8_LDA(At, 1, 0); PG8_STAGE(PG8_SA(0, 1), a2 + hstep, voffA);
            PG8_WAIT_V(8); PG8_WAIT_L(0); PG8_BAR; PG8_MMA(0, 0, At, B0); PG8_MMA(0, 1, At, B1); PG8_BAR; PG8_SCHED;
            PG8_LDA(At, 1, 1); PG8_STAGE(PG8_SB(1, 0), b3, voffB); PG8_STAGE(PG8_SB(1, 1), b3 + hstep, voffB); PG8_STAGE(PG8_SA(1, 0), a3, voffA);
            PG8_WAIT_V(8); PG8_WAIT_L(0); PG8_BAR; PG8_MMA(1, 0, At, B0); PG8_MMA(1, 1, At, B1); PG8_BAR; PG8_SCHED;
            } else {
            PG8_LDB(B0, 0, 0); PG8_SCHED; PG8_LDA(At, 0, 0); PG8_STAGE(PG8_SA(1, 1), a1 + hstep, voffA);
            PG8_WAIT_L(8); PG8_BAR; PG8_WAIT_L(0); PG8_MMA(0, 0, At, B0); PG8_BAR; PG8_SCHED;
            PG8_LDB(B1, 0, 1); PG8_STAGE(PG8_SB(0, 0), b2, voffB);
            PG8_BAR; PG8_WAIT_L(0); PG8_MMA(0, 1, At, B1); PG8_BAR;
            PG8_LDA(At, 0, 1); PG8_STAGE(PG8_SA(0, 0), a2, voffA);
            PG8_BAR; PG8_WAIT_L(0); PG8_MMA(1, 0, At, B0); PG8_BAR; PG8_SCHED;
            PG8_STAGE(PG8_SB(0, 1), b2 + hstep, voffB);
            PG8_WAIT_V(6); PG8_BAR; PG8_MMA(1, 1, At, B1); PG8_BAR;
            PG8_LDB(B0, 1, 0); PG8_SCHED; PG8_LDA(At, 1, 0); PG8_STAGE(PG8_SA(0, 1), a2 + hstep, voffA);
            PG8_WAIT_L(8); PG8_BAR; PG8_WAIT_L(0); PG8_MMA(0, 0, At, B0); PG8_BAR; PG8_SCHED;
            PG8_LDB(B1, 1, 1); PG8_STAGE(PG8_SB(1, 0), b3, voffB);
            PG8_BAR; PG8_WAIT_L(0); PG8_MMA(0, 1, At, B1); PG8_BAR;
            PG8_LDA(At, 1, 1); PG8_STAGE(PG8_SA(1, 0), a3, voffA);
            PG8_BAR; PG8_WAIT_L(0); PG8_MMA(1, 0, At, B0); PG8_BAR; PG8_SCHED;
            PG8_STAGE(PG8_SB(1, 1), b3 + hstep, voffB);
            PG8_WAIT_V(6); PG8_BAR; PG8_MMA(1, 1, At, B1); PG8_BAR;
            }
        }
        if constexpr (ALIGN_EPI) { if (wr == 0) PG8_BAR; }
        if constexpr (!Epi::AFTER_DRAIN) { E(acc, cur, wr, wc, fr, fq); S.done(cur); }
        if (!has_next) break;
#pragma unroll
        for (int a = 0; a < 2; ++a)
#pragma unroll
            for (int b = 0; b < 2; ++b)
#pragma unroll
                for (int m = 0; m < 4; ++m)
#pragma unroll
                    for (int n = 0; n < 2; ++n) acc[a][b][m][n] = (f32x4){0.f, 0.f, 0.f, 0.f};
        cur = nxt; cA = nA; cB = nB; ++ui;
        if constexpr (ALIGN_EPI) { if (wr == 1) PG8_BAR; }
    }
    PG8_WAIT_V(0);
    if constexpr (!ALIGN_EPI) { if (wr == 0) PG8_BAR; }
    PG8_BAR;
    if constexpr (Epi::AFTER_DRAIN) { E.fused(acc, cur, wr, wc, fr, fq, lds, wid, lane); S.done(cur); }
#undef PG8_SA
#undef PG8_SB
#undef PG8_STAGE
#undef PG8_LDA
#undef PG8_LDB
#undef PG8_MMA
#undef PG8_WAIT_V
#undef PG8_WAIT_L
#undef PG8_BAR
#undef PG8_SCHED
}
}

#define LAS __attribute__((address_space(3)))
typedef unsigned short bf16_t;
typedef float f32x4 __attribute__((ext_vector_type(4)));
typedef unsigned u32x4 __attribute__((ext_vector_type(4)));
typedef unsigned u32x2 __attribute__((ext_vector_type(2)));
typedef int i32x8 __attribute__((ext_vector_type(8)));
typedef short s16x2 __attribute__((ext_vector_type(2)));
#define MX_ONE 0x7f7f7f7f
#define V4_SCALE 5.656854f
typedef short bf16x8 __attribute__((ext_vector_type(8)));
typedef short s16x4 __attribute__((ext_vector_type(4)));
typedef __bf16 bf16x2_t __attribute__((ext_vector_type(2)));
typedef _Float16 f16x2_t __attribute__((ext_vector_type(2)));
typedef float f32x2v __attribute__((ext_vector_type(2)));
typedef _Float16 h2v __attribute__((ext_vector_type(2)));

constexpr int DM = 1024, NB = 4, SEQ = 8192, NTOK = NB * SEQ;
constexpr int MROWS = NTOK + 256;
constexpr int INW = 3088;
constexpr int NPROJ = 3072, NP1 = 3328;
constexpr int NEXP = 16384;
constexpr float EPS = 1e-6f;
constexpr int C_GQ = 0, C_GK = 256, C_GV = 512, C_GG = 1024, C_RQ = 1536, C_RK = 1792, C_RV = 2048, C_RG = 2560;
constexpr int S_GA = 1536, S_RQ = 1552, S_RV = 2064;

constexpr int NVG = 2048;
constexpr int NCH = (NTOK + 256) / 64;
constexpr size_t QK_ARR = (size_t)NCH * 4 * 8 * 64 * 8;
constexpr size_t MiB = 1u << 20;
constexpr size_t WS_CTL = 0, WS_WIN = 1 * MiB, WS_WOUT = 8 * MiB, WS_WS = 10 * MiB, WS_ROPE = 14 * MiB, WS_SSQ = 17 * MiB, WS_SEG = 19 * MiB, WS_ASEG = 27 * MiB,
                 WS_UB = 28 * MiB, WS_VB = 60 * MiB, WS_XN = 92 * MiB, WS_O = 157 * MiB, WS_LA = 221 * MiB, WS_PROJ = 254 * MiB, WS_QK = 383 * MiB, WS_XQ = 448 * MiB, WS_END = 480 * MiB;
static_assert(WS_WIN + (size_t)NP1 * DM * 2 <= WS_WOUT && WS_ROPE + (size_t)(SEQ + 64) * 32 * 8 <= WS_SSQ && WS_XN + (size_t)MROWS * DM * 2 <= WS_O &&
              WS_LA + QK_ARR * 4 <= WS_PROJ && WS_PROJ + (size_t)MROWS * NVG * 2 <= WS_QK && WS_QK + 4 * QK_ARR * 2 <= WS_XQ && WS_PROJ + (size_t)NTOK * 2048 * 2 <= WS_QK, "ws map");

constexpr int LDS_BYTES = 147456;
constexpr int NPHASE = 7;
#ifndef PROBE_R
#define PROBE_R 1
#define PROBE_U 1
#define PROBE_V 1
#endif
#ifndef PEER_FP8
#define PEER_FP8 1
#endif

struct Params {
    const float *x, *meta, *g1, *w_in, *gw2, *gb, *gla_gain, *ret_gain, *ret_bias, *w_out, *g2, *w_q, *subkeys, *pu, *pv, *gfin;
    float* out; unsigned char* ws;
    int ph_lo, ph_hi;
};

#define LDS_WAIT() asm volatile("s_waitcnt lgkmcnt(0)" ::: "memory")
__device__ __forceinline__ unsigned pk2(float lo, float hi) { const bf16x2_t v = {(__bf16)lo, (__bf16)hi}; return __builtin_bit_cast(unsigned, v); }
__device__ __forceinline__ unsigned f2bf(float f) { return (unsigned)__builtin_bit_cast(unsigned short, (__bf16)f); }

__device__ __forceinline__ float bf_lo(unsigned w) { return __builtin_bit_cast(float, w << 16); }
__device__ __forceinline__ float bf_hi(unsigned w) { return __builtin_bit_cast(float, w & 0xffff0000u); }
__device__ __forceinline__ float bf1(bf16_t h) { return __builtin_bit_cast(float, (unsigned)h << 16); }
__device__ __forceinline__ float wave_sum(float v) {
#pragma unroll
    for (int o = 1; o < 64; o <<= 1) v += __shfl_xor(v, o);
    return v;
}

struct MapIn {
    __device__ __forceinline__ void operator()(int j, int& src, float& sc) const {
        if (j < C_RQ) { src = j; sc = (j < 256) ? 0.125f : 1.0f; }
        else if (j < C_RV) { const int jj = j - C_RQ, which = jj >> 8, within = jj & 255, head = within >> 6, p = within & 63;
            const int a = p >> 3, n = (p >> 2) & 1, i = p & 3; src = S_RQ + which * 256 + head * 64 + 32 * n + 4 * a + i; sc = which ? 0.125f : 1.0f; }
        else { src = S_RV + (j - C_RV); sc = 1.0f; }
    }
};
struct MapId { __device__ __forceinline__ void operator()(int j, int& src, float& sc) const { src = j; sc = 1.0f; } };

template <class Map>
__device__ __forceinline__ void transpose_item(const float* W, int K, int N, bf16_t* WT, LAS float* scr, int item, int nblk, int lane, const Map map) {
    const int kb = item / nblk, nb = item % nblk, k0 = 64 * kb, n0 = 32 * nb;
    int src; float sc; map(n0 + (lane & 31), src, sc);
#pragma unroll 8
    for (int i = 0; i < 32; ++i) { const int kk = 2 * i + (lane >> 5); scr[kk * 33 + (lane & 31)] = W[(size_t)(k0 + kk) * N + src] * sc; }
    LDS_WAIT();
    const int c = lane & 7;
#pragma unroll
    for (int j = 0; j < 4; ++j) { const int n = (lane >> 3) + 8 * j; const LAS float* s = scr + (8 * c) * 33 + n;
        u32x4 o; o.x = pk2(s[0 * 33], s[1 * 33]); o.y = pk2(s[2 * 33], s[3 * 33]); o.z = pk2(s[4 * 33], s[5 * 33]); o.w = pk2(s[6 * 33], s[7 * 33]);
        *(u32x4*)(WT + (size_t)(n0 + n) * K + k0 + 8 * c) = o; }
    LDS_WAIT();
}

__device__ __forceinline__ void phase0(const Params& p, LAS unsigned char* lds, int bid, int nb) {
    const int tid = threadIdx.x, lane = tid & 63, wave = __builtin_amdgcn_readfirstlane(tid >> 6);
    unsigned char* ws = p.ws;
    bf16_t* XN = (bf16_t*)(ws + WS_XN); bf16_t* WinT = (bf16_t*)(ws + WS_WIN); bf16_t* WoutT = (bf16_t*)(ws + WS_WOUT); bf16_t* WsT = (bf16_t*)(ws + WS_WS);
    const int gw = bid * 8 + wave, NGW = nb * 8;
    const int gt = bid * 512 + tid, NGT = nb * 512;

    {
        LAS float* SKT = (LAS float*)lds;
        LAS float* WQT = (LAS float*)(lds + 128 * 132 * 4);
        for (int item = bid; item < 256; item += nb) {
            const int hc = item >> 4, kb = item & 15;
            __syncthreads();
            for (int e = tid; e < 128 * 128; e += 512) { const int n = e >> 7, d = e & 127; SKT[d * 132 + n] = p.subkeys[(size_t)hc * 16384 + e]; }
            for (int e = tid; e < 64 * 128; e += 512) { const int k = e >> 7, d = e & 127; WQT[d * 68 + k] = p.w_q[(size_t)(kb * 64 + k) * 2048 + hc * 128 + d]; }
            __syncthreads();
            const int tn = tid & 31, tk = tid >> 5;
            f32x4 acc[4];
#pragma unroll
            for (int i = 0; i < 4; ++i) acc[i] = (f32x4){0.f, 0.f, 0.f, 0.f};
#pragma unroll 4
            for (int d = 0; d < 128; ++d) {
                const f32x4 sk = *(const LAS f32x4*)(SKT + d * 132 + 4 * tn); const f32x4 wq = *(const LAS f32x4*)(WQT + d * 68 + 4 * tk);
#pragma unroll
                for (int i = 0; i < 4; ++i) acc[i] += sk[i] * wq;
            }
            const f32x4 gg = *(const f32x4*)(p.g2 + kb * 64 + 4 * tk);
#pragma unroll
            for (int i = 0; i < 4; ++i) { const f32x4 v = acc[i] * gg; u32x2 o; o.x = pk2(v[0], v[1]); o.y = pk2(v[2], v[3]);
                *(u32x2*)(WsT + (size_t)(hc * 128 + 4 * tn + i) * DM + kb * 64 + 4 * tk) = o; }
        }
        __syncthreads();
    }
    {
        LAS float* scr = (LAS float*)(lds + wave * 16384);
        constexpr int I_IN = (DM / 64) * (NPROJ / 32), I_OUT = (DM / 64) * (DM / 32);
        for (int it = gw; it < I_IN + I_OUT; it += NGW) {
            if (it < I_IN) transpose_item(p.w_in, DM, INW, WinT, scr, it, NPROJ / 32, lane, MapIn());
            else transpose_item(p.w_out, DM, DM, WoutT, scr, it - I_IN, DM / 32, lane, MapId());
        }
    }
    for (int e = gt; e < 256 * DM; e += NGT) {
        const int n = e >> 10, k = e & 1023; const float* wr = p.w_in + (size_t)k * INW + S_GA; float s = 0.f;
#pragma unroll
        for (int r = 0; r < 16; ++r) s += wr[r] * p.gw2[r * 256 + n];
        WinT[(size_t)(NPROJ + n) * DM + k] = (bf16_t)f2bf(s);
    }
#if PEER_FP8
    {
        u32x4* U4 = (u32x4*)(ws + WS_UB); u32x4* V4 = (u32x4*)(ws + WS_VB);
        for (int e = gt; e < NEXP * DM / 32; e += NGT) {
            const f32x4* us = (const f32x4*)p.pu + 8 * (size_t)e; const f32x4* vs = (const f32x4*)p.pv + 8 * (size_t)e;
            const f32x4* g2s = (const f32x4*)p.g2 + 8 * (e & 31);
            unsigned tu[4], tv[4];
#pragma unroll
            for (int j = 0; j < 4; ++j) { const f32x4 a0 = us[2 * j] * g2s[2 * j] * 64.0f, a1 = us[2 * j + 1] * g2s[2 * j + 1] * 64.0f;
                const f32x4 b0 = vs[2 * j] * V4_SCALE, b1 = vs[2 * j + 1] * V4_SCALE;
                unsigned w = 0u, x = 0u;
                w = __builtin_amdgcn_cvt_scalef32_pk_fp4_f32(w, a0[0], a0[1], 1.0f, 0); w = __builtin_amdgcn_cvt_scalef32_pk_fp4_f32(w, a0[2], a0[3], 1.0f, 1);
                w = __builtin_amdgcn_cvt_scalef32_pk_fp4_f32(w, a1[0], a1[1], 1.0f, 2); w = __builtin_amdgcn_cvt_scalef32_pk_fp4_f32(w, a1[2], a1[3], 1.0f, 3); tu[j] = w;
                x = __builtin_amdgcn_cvt_scalef32_pk_fp4_f32(x, b0[0], b0[1], 1.0f, 0); x = __builtin_amdgcn_cvt_scalef32_pk_fp4_f32(x, b0[2], b0[3], 1.0f, 1);
                x = __builtin_amdgcn_cvt_scalef32_pk_fp4_f32(x, b1[0], b1[1], 1.0f, 2); x = __builtin_amdgcn_cvt_scalef32_pk_fp4_f32(x, b1[2], b1[3], 1.0f, 3); tv[j] = x; }
            const int row = e >> 5, c32 = e & 31;
            const size_t dst = ((size_t)(c32 >> 3) * NEXP + row) * 8 + (c32 & 7);
            U4[dst] = (u32x4){tu[0], tu[1], tu[2], tu[3]}; V4[dst] = (u32x4){tv[0], tv[1], tv[2], tv[3]}; }
    }
#else
    {
        u32x2* UB = (u32x2*)(ws + WS_UB); u32x2* VB = (u32x2*)(ws + WS_VB);
        const f32x4* u4 = (const f32x4*)p.pu; const f32x4* v4 = (const f32x4*)p.pv;
        for (int e = gt; e < NEXP * DM / 4; e += NGT) { const f32x4 a = u4[e]; u32x2 o; o.x = pk2(a[0], a[1]); o.y = pk2(a[2], a[3]); UB[e] = o;
            const f32x4 b = v4[e]; u32x2 q; q.x = pk2(b[0], b[1]); q.y = pk2(b[2], b[3]); VB[e] = q; }
    }
#endif
    {
        float2* rope = (float2*)(ws + WS_ROPE);
        for (int e = gt; e < (SEQ + 64) * 32; e += NGT) { const int pi = e >> 5, d = e & 31;
            const float invf = (float)pow(10000.0, -(double)d / 32.0); const float ang = (float)(pi - 48) * invf;
            rope[e] = make_float2((float)cos((double)ang), (float)sin((double)ang)); }
    }
    for (int m0 = gw; m0 < MROWS; m0 += 4 * NGW) {
        const float* srcp[4]; f32x4 v[4][4];
#pragma unroll
        for (int u = 0; u < 4; ++u) { const int m = m0 + u * NGW; srcp[u] = nullptr;
            if (m < MROWS) { if (m >= 256) srcp[u] = p.x + (size_t)(m - 256) * DM; else if (m >= 48 && m < 64) srcp[u] = p.meta + (size_t)(m - 48) * DM; }
            if (srcp[u] != nullptr) { const f32x4* xr = (const f32x4*)srcp[u] + lane;
#pragma unroll
                for (int j = 0; j < 4; ++j) v[u][j] = xr[64 * j]; }
            else {
#pragma unroll
                for (int j = 0; j < 4; ++j) v[u][j] = (f32x4){0.f, 0.f, 0.f, 0.f}; } }
        f32x4 gg[4];
#pragma unroll
        for (int j = 0; j < 4; ++j) gg[j] = ((const f32x4*)p.g1 + lane)[64 * j];
#pragma unroll
        for (int u = 0; u < 4; ++u) { const int m = m0 + u * NGW; if (m >= MROWS) continue;
            float s = 0.f;
#pragma unroll
            for (int j = 0; j < 4; ++j) s += (v[u][j].x * v[u][j].x + v[u][j].y * v[u][j].y) + (v[u][j].z * v[u][j].z + v[u][j].w * v[u][j].w);
            const float r = (srcp[u] != nullptr) ? __builtin_amdgcn_rsqf(wave_sum(s) * (1.0f / DM) + EPS) : 0.f;
            unsigned long long* o8 = (unsigned long long*)(XN + (size_t)m * DM) + lane;
#pragma unroll
            for (int j = 0; j < 4; ++j) { const f32x4 y = v[u][j] * r * gg[j]; o8[64 * j] = (unsigned long long)pk2(y.x, y.y) | ((unsigned long long)pk2(y.z, y.w) << 32); } }
    }
}

struct EpiProj {
    static constexpr bool PERM = true, AFTER_DRAIN = false;
    bf16_t* VG; bf16_t* QK; float* LAT; const float* gb; const float2* rope;
    __device__ __forceinline__ static size_t tile_off(int r, int head, int dg) { return ((((size_t)(r >> 6) * 4 + head) * 8 + dg) * 64 + (r & 63)) * 8; }
    __device__ __forceinline__ void operator()(const pg8::f32x4 (&acc)[2][2][4][2], const pg8::Unit& u, int wr, int wc, int fr, int fq) const {
        const int row0 = u.pm * 256 + wr * 64 + fr, cb0 = wc * 32 + 8 * fq;
        if (u.pn == 12) {
#pragma unroll
            for (int bj = 0; bj < 2; ++bj) { const int c = cb0 + 128 * bj; const f32x4 b0 = *(const f32x4*)(gb + c), b1 = *(const f32x4*)(gb + c + 4);
#pragma unroll
                for (int ai = 0; ai < 2; ++ai)
#pragma unroll
                    for (int m = 0; m < 4; ++m) { const int row = row0 + ai * 128 + m * 16; f32x4 v0 = acc[ai][bj][m][0] + b0, v1 = acc[ai][bj][m][1] + b1;
#pragma unroll
                        for (int i = 0; i < 4; ++i) { v0[i] = (fminf(v0[i], 0.f) - __logf(1.0f + __expf(-fabsf(v0[i])))) * 0.0625f; v1[i] = (fminf(v1[i], 0.f) - __logf(1.0f + __expf(-fabsf(v1[i])))) * 0.0625f; }
                        float* o = LAT + tile_off(row, c >> 6, (c & 63) >> 3); *(f32x4*)o = v0; *(f32x4*)(o + 4) = v1; } }
        } else if (u.pn == 6 || u.pn == 7) {
            bf16_t* QA = QK + (size_t)(u.pn - 4) * QK_ARR;
#pragma unroll
            for (int ai = 0; ai < 2; ++ai)
#pragma unroll
                for (int m = 0; m < 4; ++m) { const int row = row0 + ai * 128 + m * 16; const int pidx = (row < 256) ? row : 64 + ((row - 256) & (SEQ - 1));
#pragma unroll
                    for (int bj = 0; bj < 2; ++bj) { const int c = cb0 + 128 * bj, d0 = (c & 63) >> 1;
                        const f32x4 cs0 = *(const f32x4*)(rope + (size_t)pidx * 32 + d0), cs1 = *(const f32x4*)(rope + (size_t)pidx * 32 + d0 + 2);
                        const f32x4 t1 = acc[ai][bj][m][0], t2 = acc[ai][bj][m][1];
                        const float co[4] = {cs0[0], cs0[2], cs1[0], cs1[2]}, si[4] = {cs0[1], cs0[3], cs1[1], cs1[3]};
                        float o1[4], o2[4];
#pragma unroll
                        for (int i = 0; i < 4; ++i) { o1[i] = t1[i] * co[i] - t2[i] * si[i]; o2[i] = t1[i] * si[i] + t2[i] * co[i]; }
                        u32x4 w; w.x = pg8::cvt_pk_bf16(o1[0], o1[1]); w.y = pg8::cvt_pk_bf16(o1[2], o1[3]); w.z = pg8::cvt_pk_bf16(o2[0], o2[1]); w.w = pg8::cvt_pk_bf16(o2[2], o2[3]);
                        *(u32x4*)(QA + tile_off(row, c >> 6, (c & 63) >> 3)) = w; } }
        } else if (u.pn <= 1) {
            bf16_t* QA = QK + (size_t)u.pn * QK_ARR;
#pragma unroll
            for (int ai = 0; ai < 2; ++ai)
#pragma unroll
                for (int m = 0; m < 4; ++m) { const int row = row0 + ai * 128 + m * 16;
#pragma unroll
                    for (int bj = 0; bj < 2; ++bj) { const int c = cb0 + 128 * bj; const f32x4 v0 = acc[ai][bj][m][0], v1 = acc[ai][bj][m][1];
                        u32x4 w; w.x = pg8::cvt_pk_bf16(v0[0], v0[1]); w.y = pg8::cvt_pk_bf16(v0[2], v0[3]); w.z = pg8::cvt_pk_bf16(v1[0], v1[1]); w.w = pg8::cvt_pk_bf16(v1[2], v1[3]);
                        *(u32x4*)(QA + tile_off(row, c >> 6, (c & 63) >> 3)) = w; } }
        } else {
            const int cdst = (u.pn < 6 ? (u.pn - 2) : (u.pn - 4)) * 256;
#pragma unroll
            for (int ai = 0; ai < 2; ++ai)
#pragma unroll
                for (int m = 0; m < 4; ++m) { bf16_t* rowp = VG + (size_t)(row0 + ai * 128 + m * 16) * NVG + cdst + cb0;
#pragma unroll
                    for (int bj = 0; bj < 2; ++bj) { const f32x4 v0 = acc[ai][bj][m][0], v1 = acc[ai][bj][m][1];
                        u32x4 w; w.x = pg8::cvt_pk_bf16(v0[0], v0[1]); w.y = pg8::cvt_pk_bf16(v0[2], v0[3]); w.z = pg8::cvt_pk_bf16(v1[0], v1[1]); w.w = pg8::cvt_pk_bf16(v1[2], v1[3]);
                        *(u32x4*)(rowp + bj * 128) = w; } }
        }
    }
};
struct EpiRes {
    static constexpr bool PERM = true, AFTER_DRAIN = false;
    const float* x; bf16_t* HB; float* SSQ;
    __device__ __forceinline__ void operator()(const pg8::f32x4 (&acc)[2][2][4][2], const pg8::Unit& u, int wr, int wc, int fr, int fq) const {
        const int row0 = u.pm * 256 + wr * 64 + fr, col0 = u.pn * 256 + wc * 32 + 8 * fq;
#pragma unroll
        for (int ai = 0; ai < 2; ++ai)
#pragma unroll
            for (int m = 0; m < 4; ++m) { const int row = row0 + ai * 128 + m * 16; const float* xr = x + (size_t)row * DM + col0; bf16_t* hr = HB + (size_t)row * DM + col0; float ss = 0.f;
#pragma unroll
                for (int bj = 0; bj < 2; ++bj) { const f32x4 v0 = acc[ai][bj][m][0] + *(const f32x4*)(xr + bj * 128), v1 = acc[ai][bj][m][1] + *(const f32x4*)(xr + bj * 128 + 4);
                    ss += (v0[0] * v0[0] + v0[1] * v0[1]) + (v0[2] * v0[2] + v0[3] * v0[3]) + (v1[0] * v1[0] + v1[1] * v1[1]) + (v1[2] * v1[2] + v1[3] * v1[3]);
                    u32x4 w; w.x = pg8::cvt_pk_bf16(v0[0], v0[1]); w.y = pg8::cvt_pk_bf16(v0[2], v0[3]); w.z = pg8::cvt_pk_bf16(v1[0], v1[1]); w.w = pg8::cvt_pk_bf16(v1[2], v1[3]);
                    *(u32x4*)(hr + bj * 128) = w; }
                ss += __shfl_xor(ss, 16); ss += __shfl_xor(ss, 32);
                if (fq == 0) SSQ[(size_t)row * 16 + u.pn * 4 + wc] = ss; }
    }
};
struct EpiF16 {
    static constexpr bool PERM = true, AFTER_DRAIN = false;
    _Float16* SC;
    __device__ __forceinline__ void operator()(const pg8::f32x4 (&acc)[2][2][4][2], const pg8::Unit& u, int wr, int wc, int fr, int fq) const {
        const int row0 = u.pm * 256 + wr * 64 + fr, col0 = u.pn * 256 + wc * 32 + 8 * fq;
#pragma unroll
        for (int ai = 0; ai < 2; ++ai)
#pragma unroll
            for (int m = 0; m < 4; ++m) { _Float16* rowp = SC + (size_t)(row0 + ai * 128 + m * 16) * 2048 + col0;
#pragma unroll
                for (int bj = 0; bj < 2; ++bj) { const f32x4 v0 = acc[ai][bj][m][0], v1 = acc[ai][bj][m][1];
                    u32x4 w;
                    w.x = __builtin_bit_cast(unsigned, (f16x2_t){(_Float16)v0[0], (_Float16)v0[1]}); w.y = __builtin_bit_cast(unsigned, (f16x2_t){(_Float16)v0[2], (_Float16)v0[3]});
                    w.z = __builtin_bit_cast(unsigned, (f16x2_t){(_Float16)v1[0], (_Float16)v1[1]}); w.w = __builtin_bit_cast(unsigned, (f16x2_t){(_Float16)v1[2], (_Float16)v1[3]});
                    *(u32x4*)(rowp + bj * 128) = w; } }
    }
};

constexpr int A_QT = 0, A_KT = 9216, A_KE = 18432, A_V = 27648, A_ST = 45056, A_STSZ = 18432, A_OB = 81920, A_DEC = 115712, A_CS = 115968;
constexpr int PQ = 72, PV = 136, POB = 132;

__device__ __forceinline__ bf16x8 tr2(const LAS bf16_t* p0, const LAS bf16_t* p1) {
    const s16x4 a = __builtin_amdgcn_ds_read_tr16_b64_v4i16((LAS s16x4*)p0), b = __builtin_amdgcn_ds_read_tr16_b64_v4i16((LAS s16x4*)p1);
    return (bf16x8){a[0], a[1], a[2], a[3], b[0], b[1], b[2], b[3]};
}
__device__ __forceinline__ float ln_gamma(int hr) { return log1pf(-exp2f(-5.0f - (float)hr)); }

template <bool FULL>
__device__ __forceinline__ void attn_pass(const Params& p, LAS unsigned char* lds, int bid, int nb) {
    const int tid = threadIdx.x, lane = tid & 63, wave = __builtin_amdgcn_readfirstlane(tid >> 6);
    const int r16 = lane & 15, g4 = lane >> 4, q4 = (lane & 15) >> 2, p4 = lane & 3;
    unsigned char* ws = p.ws;
    const bf16_t* PROJ = (const bf16_t*)(ws + WS_PROJ); const float* LA = (const float*)(ws + WS_LA); const bf16_t* QK = (const bf16_t*)(ws + WS_QK);
    float* SEG = (float*)(ws + WS_SEG); float* ASEG = (float*)(ws + WS_ASEG); float* SEGM = (float*)(ws + WS_ASEG + 65536); bf16_t* OUT = (bf16_t*)(ws + WS_O);
    LAS bf16_t* QT = (LAS bf16_t*)(lds + A_QT); LAS bf16_t* KT = (LAS bf16_t*)(lds + A_KT); LAS bf16_t* KE = (LAS bf16_t*)(lds + A_KE); LAS bf16_t* VS = (LAS bf16_t*)(lds + A_V);
    LAS float* OB = (LAS float*)(lds + A_OB); LAS float* DEC = (LAS float*)(lds + A_DEC); LAS float* CS = (LAS float*)(lds + A_CS);

    for (int item = bid; item < 256; item += nb) {
        const int seg = item & 7, h8 = (item >> 3) & 7, b = item >> 6;
        const bool metaitem = !FULL && seg == 7 && b == 0;
        if (!FULL && seg == 7 && !metaitem) continue;
        const bool gla = h8 < 4; const int hr = h8 & 3;
        const float lng = ln_gamma(hr);
        const bf16_t* QAq = QK + (size_t)(gla ? 0 : 2) * QK_ARR; const bf16_t* QAk = QK + (size_t)(gla ? 1 : 3) * QK_ARR;
        const int vcol = (gla ? 0 : 1024) + hr * 128, gcol = (gla ? 512 : 1536) + hr * 128;
        const int nch = metaitem ? 1 : 16;

        f32x4 accS[8];
#pragma unroll
        for (int cb = 0; cb < 8; ++cb) accS[cb] = (f32x4){0.f, 0.f, 0.f, 0.f};
        float blsum[8] = {0.f, 0.f, 0.f, 0.f, 0.f, 0.f, 0.f, 0.f};
        __syncthreads();
        if (FULL) {
            if (wave >= 4) {
                const int wq = wave - 4;
                { const float* Sm = SEGM + (size_t)h8 * 8192;
#pragma unroll
                  for (int cb = 0; cb < 8; ++cb)
#pragma unroll
                      for (int rg = 0; rg < 4; ++rg) accS[cb][rg] = Sm[(16 * wq + 4 * g4 + rg) * 128 + 16 * cb + r16]; }
                for (int sp = 0; sp < seg; ++sp) { const int it2 = (item & ~7) + sp; const float* Sg = SEG + (size_t)it2 * 8192; const float* Ag = ASEG + it2 * 64;
                    float dec[4];
#pragma unroll
                    for (int rg = 0; rg < 4; ++rg) dec[rg] = Ag[16 * wq + 4 * g4 + rg];
#pragma unroll
                    for (int cb = 0; cb < 8; ++cb)
#pragma unroll
                        for (int rg = 0; rg < 4; ++rg) accS[cb][rg] = dec[rg] * accS[cb][rg] + Sg[(16 * wq + 4 * g4 + rg) * 128 + 16 * cb + r16]; }
                LAS bf16_t* ST0 = (LAS bf16_t*)(lds + A_ST);
#pragma unroll
                for (int cb = 0; cb < 8; ++cb) { u32x2 w; w.x = pk2(accS[cb][0], accS[cb][1]); w.y = pk2(accS[cb][2], accS[cb][3]); *(LAS u32x2*)(ST0 + (16 * cb + r16) * PQ + 16 * wq + 4 * g4) = w; }
            }
        }
#define A_ROWBASE(ci_) (metaitem ? 0 : 256 + b * SEQ + (16 * seg + (ci_)) * 64)
        f32x4 lav[2]; u32x4 qv8, kv8; u32x4 vreg[2];
        qv8 = (u32x4){0u, 0u, 0u, 0u};
#define A_LOADCHUNK(ci_) do { const int _rb = A_ROWBASE(ci_); \
            const size_t _to = ((((size_t)(_rb >> 6) * 4 + hr) * 8 + wave) * 64 + lane) * 8;       \
            if (gla) { const f32x4* _lp = (const f32x4*)(LA + _to); lav[0] = _lp[0]; lav[1] = _lp[1]; } \
            else { lav[0] = (f32x4){lng, lng, lng, lng}; lav[1] = lav[0]; } \
            if (FULL) qv8 = *(const u32x4*)(QAq + _to); \
            kv8 = *(const u32x4*)(QAk + _to); \
            { const int vr = tid >> 3, cc = tid & 7; const u32x4* src = (const u32x4*)(PROJ + (size_t)(_rb + vr) * NVG + vcol + cc * 16); vreg[0] = src[0]; vreg[1] = src[1]; } } while (0)
#define A_LBAR() do { asm volatile("s_waitcnt lgkmcnt(0)" ::: "memory"); __builtin_amdgcn_s_barrier(); asm volatile("" ::: "memory"); } while (0)
        A_LOADCHUNK(0);
        f32x4 gnv[4], bsv[4];
        { const float* gptr = (gla ? p.gla_gain : p.ret_gain) + 16 * (tid & 7); const float* bptr = p.ret_bias + 16 * (tid & 7); const float bsc = gla ? 0.f : 1.f;
#pragma unroll
          for (int k4 = 0; k4 < 4; ++k4) { gnv[k4] = *(const f32x4*)(gptr + 4 * k4); bsv[k4] = *(const f32x4*)(bptr + 4 * k4) * bsc; } }
        for (int ci = 0; ci < nch; ++ci) {
            const bool metac = metaitem;
            const int rowbase = A_ROWBASE(ci);
            const LAS bf16_t* STr = (const LAS bf16_t*)(lds + A_ST + (ci & 1) * A_STSZ); LAS bf16_t* STw = (LAS bf16_t*)(lds + A_ST + ((ci + 1) & 1) * A_STSZ);
            u32x4 gpre[2] = {(u32x4){0u, 0u, 0u, 0u}, (u32x4){0u, 0u, 0u, 0u}};
            if (FULL && !metac) { const u32x4* gp = (const u32x4*)(PROJ + (size_t)(rowbase + (tid >> 3)) * NVG + gcol + 16 * (tid & 7)); gpre[0] = gp[0]; gpre[1] = gp[1]; }
            {
                float bc[8];
#pragma unroll
                for (int c = 0; c < 8; ++c) { float v = lav[c >> 2][c & 3];
                    v += __builtin_bit_cast(float, __builtin_amdgcn_update_dpp(0, __builtin_bit_cast(int, v), 0x111, 0xf, 0xf, true));
                    v += __builtin_bit_cast(float, __builtin_amdgcn_update_dpp(0, __builtin_bit_cast(int, v), 0x112, 0xf, 0xf, true));
                    v += __builtin_bit_cast(float, __builtin_amdgcn_update_dpp(0, __builtin_bit_cast(int, v), 0x114, 0xf, 0xf, true));
                    v += __builtin_bit_cast(float, __builtin_amdgcn_update_dpp(0, __builtin_bit_cast(int, v), 0x118, 0xf, 0xf, true));
                    v += __builtin_bit_cast(float, __builtin_amdgcn_update_dpp(0, __builtin_bit_cast(int, v), 0x142, 0xa, 0xf, false));
                    v += __builtin_bit_cast(float, __builtin_amdgcn_update_dpp(0, __builtin_bit_cast(int, v), 0x143, 0xc, 0xf, false));
                    bc[c] = v; }
                float tot[8];
#pragma unroll
                for (int c = 0; c < 8; ++c) { tot[c] = __builtin_bit_cast(float, __builtin_amdgcn_readlane(__builtin_bit_cast(int, bc[c]), 63)); blsum[c] += tot[c]; }
                const unsigned qw[4] = {qv8.x, qv8.y, qv8.z, qv8.w}, kw[4] = {kv8.x, kv8.y, kv8.z, kv8.w};
                unsigned oq[4], ok[4], oe[4];
#pragma unroll
                for (int c2 = 0; c2 < 4; ++c2) { const float k0 = bf_lo(kw[c2]), k1 = bf_hi(kw[c2]);
                    if (FULL) { oq[c2] = pk2(bf_lo(qw[c2]) * __expf(bc[2 * c2]), bf_hi(qw[c2]) * __expf(bc[2 * c2 + 1])); ok[c2] = pk2(k0 * __expf(-bc[2 * c2]), k1 * __expf(-bc[2 * c2 + 1])); }
                    oe[c2] = pk2(k0 * __expf(tot[2 * c2] - bc[2 * c2]), k1 * __expf(tot[2 * c2 + 1] - bc[2 * c2 + 1])); }
                if (FULL) { *(LAS u32x4*)(QT + lane * PQ + 8 * wave) = (u32x4){oq[0], oq[1], oq[2], oq[3]}; *(LAS u32x4*)(KT + lane * PQ + 8 * wave) = (u32x4){ok[0], ok[1], ok[2], ok[3]}; }
                *(LAS u32x4*)(KE + lane * PQ + 8 * wave) = (u32x4){oe[0], oe[1], oe[2], oe[3]};
                if (lane == 63) { *(LAS f32x4*)(DEC + 8 * wave) = (f32x4){__expf(tot[0]), __expf(tot[1]), __expf(tot[2]), __expf(tot[3])};
                                  *(LAS f32x4*)(DEC + 8 * wave + 4) = (f32x4){__expf(tot[4]), __expf(tot[5]), __expf(tot[6]), __expf(tot[7])}; }
                const int vr = tid >> 3, cc = tid & 7; LAS u32x4* dst = (LAS u32x4*)(VS + vr * PV + cc * 16); dst[0] = vreg[0]; dst[1] = vreg[1];
            }
            if (ci + 1 < nch) A_LOADCHUNK(ci + 1);
            A_LBAR();
            if (wave < 4) {
                if (FULL && !metac) {
                    const int w = wave;
                    bf16x8 qf[2];
#pragma unroll
                    for (int s = 0; s < 2; ++s) qf[s] = *(const LAS bf16x8*)(QT + (16 * w + r16) * PQ + 32 * s + 8 * g4);
                    f32x4 att[4];
#pragma unroll
                    for (int jb = 0; jb < 4; ++jb) { att[jb] = (f32x4){0.f, 0.f, 0.f, 0.f};
                        if (jb <= w) {
#pragma unroll
                            for (int s = 0; s < 2; ++s) { const bf16x8 kf = *(const LAS bf16x8*)(KT + (16 * jb + r16) * PQ + 32 * s + 8 * g4);
                                att[jb] = __builtin_amdgcn_mfma_f32_16x16x32_bf16(kf, qf[s], att[jb], 0, 0, 0); }
                            if (jb == w) {
#pragma unroll
                                for (int rg = 0; rg < 4; ++rg) att[jb][rg] = (4 * g4 + rg <= r16) ? att[jb][rg] : 0.f;
                            }
                        } }
                    bf16x8 af[2];
#pragma unroll
                    for (int s = 0; s < 2; ++s) { u32x4 t; t.x = pk2(att[2 * s][0], att[2 * s][1]); t.y = pk2(att[2 * s][2], att[2 * s][3]); t.z = pk2(att[2 * s + 1][0], att[2 * s + 1][1]); t.w = pk2(att[2 * s + 1][2], att[2 * s + 1][3]);
                        af[s] = __builtin_bit_cast(bf16x8, t); }
#pragma unroll
                    for (int cb = 0; cb < 8; ++cb) { f32x4 o = (f32x4){0.f, 0.f, 0.f, 0.f};
#pragma unroll
                        for (int s = 0; s < 2; ++s) {
                            const bf16x8 vf = tr2(VS + (32 * s + 4 * g4 + q4) * PV + 16 * cb + 4 * p4, VS + (32 * s + 16 + 4 * g4 + q4) * PV + 16 * cb + 4 * p4);
                            o = __builtin_amdgcn_mfma_f32_16x16x32_bf16(af[s], vf, o, 0, 0, 0);
                            const bf16x8 sf = *(const LAS bf16x8*)(STr + (16 * cb + r16) * PQ + 32 * s + 8 * g4);
                            o = __builtin_amdgcn_mfma_f32_16x16x32_bf16(qf[s], sf, o, 0, 0, 0); }
#pragma unroll
                        for (int rg = 0; rg < 4; ++rg) OB[(16 * w + 4 * g4 + rg) * POB + 16 * cb + r16] = o[rg]; }
                }
            } else {
                const int wq = wave - 4;
                float dec[4];
#pragma unroll
                for (int rg = 0; rg < 4; ++rg) dec[rg] = DEC[16 * wq + 4 * g4 + rg];
                bf16x8 kef[2];
#pragma unroll
                for (int s = 0; s < 2; ++s) kef[s] = tr2(KE + (32 * s + 8 * g4 + q4) * PQ + 16 * wq + 4 * p4, KE + (32 * s + 8 * g4 + 4 + q4) * PQ + 16 * wq + 4 * p4);
#pragma unroll
                for (int cb = 0; cb < 8; ++cb) {
#pragma unroll
                    for (int rg = 0; rg < 4; ++rg) accS[cb][rg] *= dec[rg];
#pragma unroll
                    for (int s = 0; s < 2; ++s) { const bf16x8 vf = tr2(VS + (32 * s + 8 * g4 + q4) * PV + 16 * cb + 4 * p4, VS + (32 * s + 8 * g4 + 4 + q4) * PV + 16 * cb + 4 * p4);
                        accS[cb] = __builtin_amdgcn_mfma_f32_16x16x32_bf16(kef[s], vf, accS[cb], 0, 0, 0); }
                    if (FULL) { u32x2 w; w.x = pk2(accS[cb][0], accS[cb][1]); w.y = pk2(accS[cb][2], accS[cb][3]); *(LAS u32x2*)(STw + (16 * cb + r16) * PQ + 16 * wq + 4 * g4) = w; }
                }
            }
            A_LBAR();
            if (FULL && !metac) {
                const int i = tid >> 3, cc = tid & 7;
                float o[16];
#pragma unroll
                for (int k4 = 0; k4 < 4; ++k4) { const f32x4 t = *(const LAS f32x4*)(OB + i * POB + 16 * cc + 4 * k4); o[4 * k4] = t[0]; o[4 * k4 + 1] = t[1]; o[4 * k4 + 2] = t[2]; o[4 * k4 + 3] = t[3]; }
                const size_t row = (size_t)(rowbase + i);
                const u32x4 ga = gpre[0], gb2 = gpre[1];
                const unsigned gw[8] = {ga.x, ga.y, ga.z, ga.w, gb2.x, gb2.y, gb2.z, gb2.w};
                float s1 = 0.f, s2 = 0.f;
#pragma unroll
                for (int k = 0; k < 16; ++k) { s1 += o[k]; s2 += o[k] * o[k]; }
#pragma unroll
                for (int m = 1; m < 8; m <<= 1) { s1 += __shfl_xor(s1, m); s2 += __shfl_xor(s2, m); }
                const float mu = gla ? 0.f : s1 * (1.0f / 128.0f);
                const float rs = __builtin_amdgcn_rsqf(fmaxf(s2 * (1.0f / 128.0f) - mu * mu, 0.f) + EPS);
                unsigned ow[8];
#pragma unroll
                for (int k2 = 0; k2 < 8; ++k2) { float y[2];
#pragma unroll
                    for (int e = 0; e < 2; ++e) { const int k = 2 * k2 + e; const float v = (o[k] - mu) * rs * gnv[k >> 2][k & 3] + bsv[k >> 2][k & 3];
                        const float gt = e ? bf_hi(gw[k2]) : bf_lo(gw[k2]); y[e] = v * gt * __builtin_amdgcn_rcpf(1.0f + __expf(-gt)); }
                    ow[k2] = pk2(y[0], y[1]); }
                u32x4* op = (u32x4*)(OUT + (row - 256) * DM + h8 * 128 + 16 * cc);
                op[0] = (u32x4){ow[0], ow[1], ow[2], ow[3]}; op[1] = (u32x4){ow[4], ow[5], ow[6], ow[7]};
            }
        }
        if (!FULL) {
            if (wave >= 4) { const int wq = wave - 4; float* Sg = metaitem ? SEGM + (size_t)h8 * 8192 : SEG + (size_t)item * 8192;
#pragma unroll
                for (int cb = 0; cb < 8; ++cb)
#pragma unroll
                    for (int rg = 0; rg < 4; ++rg) Sg[(16 * wq + 4 * g4 + rg) * 128 + 16 * cb + r16] = accS[cb][rg]; }
            if (lane < 8 && !metaitem) { float bl = blsum[0];
#pragma unroll
                for (int c = 1; c < 8; ++c) bl = (lane == c) ? blsum[c] : bl;
                ASEG[item * 64 + 8 * wave + lane] = __expf(bl); }
        }
#undef A_LBAR
#undef A_ROWBASE
#undef A_LOADCHUNK
    }
}

__device__ __forceinline__ unsigned ord32(float f) { const unsigned b = __builtin_bit_cast(unsigned, f); return b ^ ((b >> 31) ? 0xffffffffu : 0x80000000u); }
__device__ __forceinline__ float unord32(unsigned o) { const unsigned b = (o >> 31) ? (o ^ 0x80000000u) : ~o; return __builtin_bit_cast(float, b); }
#define DPP_MAXU(v, ctrl, rmask) do { const unsigned _t = (unsigned)__builtin_amdgcn_update_dpp((int)(v), (int)(v), (ctrl), (rmask), 0xf, false); (v) = (v) > _t ? (v) : _t; } while (0)
#define DPP_ADDF(v, ctrl) do { const float _t = __builtin_bit_cast(float, __builtin_amdgcn_update_dpp(0, __builtin_bit_cast(int, (v)), (ctrl), 0xf, 0xf, false)); (v) += _t; } while (0)
__device__ __forceinline__ unsigned row_max_u(unsigned v) { DPP_MAXU(v, 0xB1, 0xf); DPP_MAXU(v, 0x4E, 0xf); DPP_MAXU(v, 0x124, 0xf); DPP_MAXU(v, 0x128, 0xf); return v; }
__device__ __forceinline__ float row_sum_f(float v) { DPP_ADDF(v, 0xB1); DPP_ADDF(v, 0x4E); DPP_ADDF(v, 0x124); DPP_ADDF(v, 0x128); return v; }
__device__ __forceinline__ unsigned wave_max_u(unsigned v) { v = row_max_u(v); DPP_MAXU(v, 0x142, 0xa); DPP_MAXU(v, 0x143, 0xc); return (unsigned)__builtin_amdgcn_readlane((int)v, 63); }

__device__ __forceinline__ float row_sum_x(float v) { return row_sum_f(v); }
__device__ __forceinline__ float dot2_bf16(unsigned w, unsigned x, float acc) { return __builtin_amdgcn_fdot2_f32_bf16(__builtin_bit_cast(bf16x2_t, w), __builtin_bit_cast(bf16x2_t, x), acc, false); }
__device__ __forceinline__ float gelu_exact(float v) { return 0.5f * v * (1.0f + erff(v * 0.70710678118654752f)); }

__device__ __forceinline__ void phase_peer(const Params& p, LAS unsigned char* lds, int bid, int nb) {
    const int tid = threadIdx.x, lane = tid & 63, wave = __builtin_amdgcn_readfirstlane(tid >> 6);
    const int p16 = lane & 15, rg4 = lane >> 4;
    unsigned char* ws = p.ws;
    const _Float16* SC = (const _Float16*)(ws + WS_PROJ); const bf16_t* HB = (const bf16_t*)(ws + WS_XN); const float* SSQ = (const float*)(ws + WS_SSQ);
    const unsigned char* UB = (const unsigned char*)(ws + WS_UB); const unsigned char* VB = (const unsigned char*)(ws + WS_VB);
    LAS float* A_s = (LAS float*)(lds + wave * 4096);
    LAS int* A_i = (LAS int*)(lds + wave * 4096 + 1024);
    LAS int* E_i = (LAS int*)(lds + wave * 4096 + 2048);
    LAS float* E_s = (LAS float*)(lds + wave * 4096 + 2560);
    int ci = 0, cj = 0; bool cvalid = lane < 50;
    { int l = lane;
      if (l < 16) { ci = 0; cj = l; } else if (l < 24) { ci = 1; cj = l - 16; } else if (l < 29) { ci = 2; cj = l - 24; } else if (l < 33) { ci = 3; cj = l - 29; }
      else if (l < 36) { ci = 4; cj = l - 33; } else if (l < 42) { ci = 5 + (l - 36) / 2; cj = (l - 36) & 1; } else { ci = 8 + (l - 42); cj = 0; } if (!cvalid) { ci = 0; cj = 0; } }
    const int gw = bid * 8 + wave, NGW = nb * 8;
    for (int t = gw; t < NTOK; t += NGW) {
        float ssq = (lane < 16) ? SSQ[(size_t)t * 16 + lane] : 0.f; ssq = wave_sum(ssq);
        const float rstd = 1.0f / sqrtf(ssq * (1.0f / DM) + EPS);
#pragma unroll 1
        for (int q = 0; q < 4; ++q) {
            const u32x4 raw = *(const u32x4*)(SC + (size_t)t * 2048 + 512 * q + 8 * lane);
            const unsigned rw[4] = {raw.x, raw.y, raw.z, raw.w};
            unsigned key[8];
#pragma unroll
            for (int e = 0; e < 8; ++e) { const unsigned hbits = (e & 1) ? (rw[e >> 1] >> 16) : (rw[e >> 1] & 0xffffu);
                const float f = (float)__builtin_bit_cast(_Float16, (unsigned short)hbits);
                key[e] = (ord32(f) & ~0x7fu) | (unsigned)(127 - (8 * p16 + e)); }
            unsigned mine = 0u;
#pragma unroll 1
            for (int it = 0; it < 16; ++it) {
                unsigned m = key[0];
#pragma unroll
                for (int e = 1; e < 8; ++e) m = m > key[e] ? m : key[e];
                const unsigned W = row_max_u(m);
                mine = (p16 == it) ? W : mine;
#pragma unroll
                for (int e = 0; e < 8; ++e) key[e] = (key[e] == W) ? 0u : key[e];
            }
            const int g = 4 * q + rg4;
            A_s[g * 16 + p16] = unord32(mine & ~0x7fu); A_i[g * 16 + p16] = 127 - (int)(mine & 0x7fu);
        }
        LDS_WAIT();
#pragma unroll 1
        for (int h = 0; h < 8; ++h) {
            const float sa = A_s[(2 * h) * 16 + ci], sb = A_s[(2 * h + 1) * 16 + cj];
            const int ia = A_i[(2 * h) * 16 + ci], ib = A_i[(2 * h + 1) * 16 + cj];
            const float sum = sa + sb;
            unsigned key = cvalid ? ((ord32(sum) & ~0x3fu) | (unsigned)(63 - lane)) : 0u;
            int rank = -1;
#pragma unroll 1
            for (int it = 0; it < 16; ++it) { const unsigned W = wave_max_u(key); if (key == W) { rank = it; key = 0u; } }
            if (rank >= 0) { E_i[h * 16 + rank] = ia * 128 + ib; E_s[h * 16 + rank] = sum; }
        }
        LDS_WAIT();
        float gsm[2]; int eidx[2];
#pragma unroll
        for (int sl = 0; sl < 2; ++sl) { const int e = lane + 64 * sl; const float s = E_s[e] * rstd, mx = E_s[e & ~15] * rstd; const float pe = __expf(s - mx); const float den = row_sum_x(pe);
            gsm[sl] = pe / den; eidx[sl] = E_i[e]; }
#if PEER_FP8
        f32x2v xf[4][8];
#pragma unroll
        for (int i = 0; i < 4; ++i) { const u32x4 h0 = *(const u32x4*)(HB + (size_t)t * DM + 256 * i + 16 * p16), h1 = *(const u32x4*)(HB + (size_t)t * DM + 256 * i + 16 * p16 + 8);
            const unsigned hv[8] = {h0.x, h0.y, h0.z, h0.w, h1.x, h1.y, h1.z, h1.w}; const float* gp = p.g2 + 256 * i + 16 * p16;
#pragma unroll
            for (int k2 = 0; k2 < 8; ++k2) { const f32x2v g = *(const f32x2v*)(gp + 2 * k2); xf[i][k2] = (f32x2v){bf_lo(hv[k2]) * rstd * g.x, bf_hi(hv[k2]) * rstd * g.y}; } }
        constexpr int NBB = 2;
#define P6_LOADB(buf, TAB, bt0) do { _Pragma("unroll") for (int j = 0; j < NBB; ++j) { const int bt = (bt0) + j; const int ex = E_i[64 * (bt >> 4) + 16 * rg4 + (bt & 15)]; \
            const unsigned char* rp = (TAB) + (size_t)ex * 1024 + 16 * p16; _Pragma("unroll") for (int i = 0; i < 4; ++i) buf[j][i] = *(const u32x4*)(rp + 256 * i); } } while (0)
        u32x4 bA[NBB][4], bB[NBB][4];
        float act0 = 0.f, act1 = 0.f;
#define P6_COMPU(buf, bt0) do { _Pragma("unroll") for (int j = 0; j < NBB; ++j) { const int bt = (bt0) + j; f32x2v s2 = (f32x2v){0.f, 0.f}; \
            _Pragma("unroll") for (int i = 0; i < 4; ++i) { const unsigned uu[4] = {buf[j][i].x, buf[j][i].y, buf[j][i].z, buf[j][i].w}; \
                _Pragma("unroll") for (int w = 0; w < 4; ++w) { const f32x2v lo = __builtin_amdgcn_cvt_pk_f32_fp8((int)uu[w], false), hi = __builtin_amdgcn_cvt_pk_f32_fp8((int)uu[w], true); \
                    s2 = __builtin_elementwise_fma(lo, xf[i][2 * w], s2); s2 = __builtin_elementwise_fma(hi, xf[i][2 * w + 1], s2); } } \
            const float s = row_sum_x(s2.x + s2.y); const bool mine = (p16 == (bt & 15)); act0 = (mine && bt < 16) ? s : act0; act1 = (mine && bt >= 16) ? s : act1; } } while (0)
        P6_LOADB(bA, UB, 0);
#pragma unroll 1
        for (int g = 0; g < 32; g += 2 * NBB) { P6_LOADB(bB, UB, g + NBB); P6_COMPU(bA, g); if (g + 2 * NBB < 32) P6_LOADB(bA, UB, g + 2 * NBB); P6_COMPU(bB, g + NBB); }
        P6_LOADB(bA, VB, 0);
        LAS float* E_c = E_s;
        { const float c0 = gsm[0] * gelu_exact(act0 * (1.0f / 512.0f)) * (1.0f / 32.0f), c1 = gsm[1] * gelu_exact(act1 * (1.0f / 512.0f)) * (1.0f / 32.0f);
          LDS_WAIT(); E_c[lane] = c0; E_c[lane + 64] = c1; LDS_WAIT(); }
        f32x2v acc2[4][8];
#pragma unroll
        for (int i = 0; i < 4; ++i)
#pragma unroll
            for (int k = 0; k < 8; ++k) acc2[i][k] = (f32x2v){0.f, 0.f};
#define P6_COMPV(buf, bt0) do { _Pragma("unroll") for (int j = 0; j < NBB; ++j) { const int bt = (bt0) + j; const float cf = E_c[64 * (bt >> 4) + 16 * rg4 + (bt & 15)]; const f32x2v cf2 = (f32x2v){cf, cf}; \
            _Pragma("unroll") for (int i = 0; i < 4; ++i) { const unsigned vv[4] = {buf[j][i].x, buf[j][i].y, buf[j][i].z, buf[j][i].w}; \
                _Pragma("unroll") for (int w = 0; w < 4; ++w) { const f32x2v lo = __builtin_amdgcn_cvt_pk_f32_fp8((int)vv[w], false), hi = __builtin_amdgcn_cvt_pk_f32_fp8((int)vv[w], true); \
                    acc2[i][2 * w] = __builtin_elementwise_fma(lo, cf2, acc2[i][2 * w]); acc2[i][2 * w + 1] = __builtin_elementwise_fma(hi, cf2, acc2[i][2 * w + 1]); } } } } while (0)
#pragma unroll 1
        for (int g = 0; g < 32; g += 2 * NBB) { P6_LOADB(bB, VB, g + NBB); P6_COMPV(bA, g); if (g + 2 * NBB < 32) P6_LOADB(bA, VB, g + 2 * NBB); P6_COMPV(bB, g + NBB); }
#undef P6_LOADB
#undef P6_COMPU
#undef P6_COMPV
        float ss = 0.f;
#pragma unroll
        for (int i = 0; i < 4; ++i) { const u32x4 h0 = *(const u32x4*)(HB + (size_t)t * DM + 256 * i + 16 * p16), h1 = *(const u32x4*)(HB + (size_t)t * DM + 256 * i + 16 * p16 + 8);
            const unsigned hv[8] = {h0.x, h0.y, h0.z, h0.w, h1.x, h1.y, h1.z, h1.w};
#pragma unroll
            for (int k2 = 0; k2 < 8; ++k2) { float ax = acc2[i][k2].x, ay = acc2[i][k2].y;
                ax += __shfl_xor(ax, 16); ax += __shfl_xor(ax, 32); ay += __shfl_xor(ay, 16); ay += __shfl_xor(ay, 32);
                ax += bf_lo(hv[k2]); ay += bf_hi(hv[k2]); acc2[i][k2] = (f32x2v){ax, ay}; ss += ax * ax + ay * ay; } }
        ss = row_sum_x(ss);
        const float rf = 1.0f / sqrtf(ss * (1.0f / DM) + EPS);
#pragma unroll
        for (int i = 0; i < 4; ++i) { if (i == rg4) { const float* gp = p.gfin + 256 * i + 16 * p16; float* op = p.out + (size_t)t * DM + 256 * i + 16 * p16;
#pragma unroll
                for (int k4 = 0; k4 < 4; ++k4) { const f32x4 g = *(const f32x4*)(gp + 4 * k4);
                    *(f32x4*)(op + 4 * k4) = (f32x4){acc2[i][2 * k4].x * rf * g[0], acc2[i][2 * k4].y * rf * g[1], acc2[i][2 * k4 + 1].x * rf * g[2], acc2[i][2 * k4 + 1].y * rf * g[3]}; } } }
#else
        unsigned xp[8][4];
#pragma unroll
        for (int i = 0; i < 8; ++i) { const u32x4 hw = *(const u32x4*)(HB + (size_t)t * DM + 128 * i + 8 * p16); const f32x4 ga = *(const f32x4*)(p.g2 + 128 * i + 8 * p16), gb = *(const f32x4*)(p.g2 + 128 * i + 8 * p16 + 4);
            xp[i][0] = pk2(bf_lo(hw.x) * rstd * ga[0], bf_hi(hw.x) * rstd * ga[1]); xp[i][1] = pk2(bf_lo(hw.y) * rstd * ga[2], bf_hi(hw.y) * rstd * ga[3]);
            xp[i][2] = pk2(bf_lo(hw.z) * rstd * gb[0], bf_hi(hw.z) * rstd * gb[1]); xp[i][3] = pk2(bf_lo(hw.w) * rstd * gb[2], bf_hi(hw.w) * rstd * gb[3]); }
        float act[2] = {0.f, 0.f};
#pragma unroll
        for (int sl = 0; sl < 2; ++sl) {
#pragma unroll 2
            for (int b16 = 0; b16 < 16; ++b16) {
                const int e = 64 * sl + 16 * rg4 + b16; const int ex = E_i[e];
                const unsigned char* rowp = UB + (size_t)ex * 2048 + 16 * p16;
                float s = 0.f;
#pragma unroll
                for (int i = 0; i < 8; ++i) { const u32x4 uw = *(const u32x4*)(rowp + 256 * i);
                    s = dot2_bf16(uw.x, xp[i][0], s); s = dot2_bf16(uw.y, xp[i][1], s); s = dot2_bf16(uw.z, xp[i][2], s); s = dot2_bf16(uw.w, xp[i][3], s); }
                s = row_sum_x(s);
                act[sl] = (p16 == b16) ? s : act[sl];
            }
        }
        float coef[2];
#pragma unroll
        for (int sl = 0; sl < 2; ++sl) coef[sl] = gsm[sl] * gelu_exact(act[sl]);
        float acc[8][8];
#pragma unroll
        for (int i = 0; i < 8; ++i)
#pragma unroll
            for (int k = 0; k < 8; ++k) acc[i][k] = 0.f;
#pragma unroll
        for (int sl = 0; sl < 2; ++sl) {
#pragma unroll 2
            for (int b16 = 0; b16 < 16; ++b16) {
                const int srcl = (lane & 48) + b16;
                const float cf = __shfl(coef[sl], srcl); const int ex = __shfl(eidx[sl], srcl);
                const unsigned char* rowp = VB + (size_t)ex * 2048 + 16 * p16;
#pragma unroll
                for (int i = 0; i < 8; ++i) { const u32x4 vw = *(const u32x4*)(rowp + 256 * i);
                    acc[i][0] += cf * bf_lo(vw.x); acc[i][1] += cf * bf_hi(vw.x); acc[i][2] += cf * bf_lo(vw.y); acc[i][3] += cf * bf_hi(vw.y);
                    acc[i][4] += cf * bf_lo(vw.z); acc[i][5] += cf * bf_hi(vw.z); acc[i][6] += cf * bf_lo(vw.w); acc[i][7] += cf * bf_hi(vw.w); }
            }
        }
        float ss = 0.f;
#pragma unroll
        for (int i = 0; i < 8; ++i) { const u32x4 hw = *(const u32x4*)(HB + (size_t)t * DM + 128 * i + 8 * p16); const unsigned hv[4] = {hw.x, hw.y, hw.z, hw.w};
#pragma unroll
            for (int k = 0; k < 8; ++k) { float a = acc[i][k]; a += __shfl_xor(a, 16); a += __shfl_xor(a, 32);
                a += (k & 1) ? bf_hi(hv[k >> 1]) : bf_lo(hv[k >> 1]); acc[i][k] = a; ss += a * a; } }
        ss = row_sum_x(ss);
        const float rf = 1.0f / sqrtf(ss * (1.0f / DM) + EPS);
#pragma unroll
        for (int i = 0; i < 8; ++i) { if ((i >> 1) == rg4) { const f32x4 ga = *(const f32x4*)(p.gfin + 128 * i + 8 * p16), gb = *(const f32x4*)(p.gfin + 128 * i + 8 * p16 + 4);
                float* op = p.out + (size_t)t * DM + 128 * i + 8 * p16;
                *(f32x4*)op = (f32x4){acc[i][0] * rf * ga[0], acc[i][1] * rf * ga[1], acc[i][2] * rf * ga[2], acc[i][3] * rf * ga[3]};
                *(f32x4*)(op + 4) = (f32x4){acc[i][4] * rf * gb[0], acc[i][5] * rf * gb[1], acc[i][6] * rf * gb[2], acc[i][7] * rf * gb[3]}; } }
#endif
        LDS_WAIT();
    }
}


__device__ __forceinline__ void row_max4(unsigned k0, unsigned k1, unsigned k2, unsigned k3, unsigned& w0, unsigned& w1, unsigned& w2, unsigned& w3) {
    asm volatile("s_nop 1\n\t"
                 "v_max_u32_dpp %0, %4, %4 quad_perm:[1,0,3,2] row_mask:0xf bank_mask:0xf\n\t"
                 "v_max_u32_dpp %1, %5, %5 quad_perm:[1,0,3,2] row_mask:0xf bank_mask:0xf\n\t"
                 "v_max_u32_dpp %2, %6, %6 quad_perm:[1,0,3,2] row_mask:0xf bank_mask:0xf\n\t"
                 "v_max_u32_dpp %3, %7, %7 quad_perm:[1,0,3,2] row_mask:0xf bank_mask:0xf\n\t"
                 "v_max_u32_dpp %0, %0, %0 quad_perm:[2,3,0,1] row_mask:0xf bank_mask:0xf\n\t"
                 "v_max_u32_dpp %1, %1, %1 quad_perm:[2,3,0,1] row_mask:0xf bank_mask:0xf\n\t"
                 "v_max_u32_dpp %2, %2, %2 quad_perm:[2,3,0,1] row_mask:0xf bank_mask:0xf\n\t"
                 "v_max_u32_dpp %3, %3, %3 quad_perm:[2,3,0,1] row_mask:0xf bank_mask:0xf\n\t"
                 "v_max_u32_dpp %0, %0, %0 row_ror:4 row_mask:0xf bank_mask:0xf\n\t"
                 "v_max_u32_dpp %1, %1, %1 row_ror:4 row_mask:0xf bank_mask:0xf\n\t"
                 "v_max_u32_dpp %2, %2, %2 row_ror:4 row_mask:0xf bank_mask:0xf\n\t"
                 "v_max_u32_dpp %3, %3, %3 row_ror:4 row_mask:0xf bank_mask:0xf\n\t"
                 "v_max_u32_dpp %0, %0, %0 row_ror:8 row_mask:0xf bank_mask:0xf\n\t"
                 "v_max_u32_dpp %1, %1, %1 row_ror:8 row_mask:0xf bank_mask:0xf\n\t"
                 "v_max_u32_dpp %2, %2, %2 row_ror:8 row_mask:0xf bank_mask:0xf\n\t"
                 "v_max_u32_dpp %3, %3, %3 row_ror:8 row_mask:0xf bank_mask:0xf\n\t"
                 "s_nop 1"
                 : "=&v"(w0), "=&v"(w1), "=&v"(w2), "=&v"(w3) : "v"(k0), "v"(k1), "v"(k2), "v"(k3));
}
__device__ __forceinline__ unsigned pkadd_h2(unsigned a, unsigned b) { const h2v x = __builtin_bit_cast(h2v, a), y = __builtin_bit_cast(h2v, b); const h2v s = x + y; return __builtin_bit_cast(unsigned, s); }
constexpr int NT6 = 8;
constexpr int W6_BYTES = 16640;
__device__ __forceinline__ float dpp_f(float v, int ctrl_dummy);
#define DPPF(v, ctrl) __builtin_bit_cast(float, __builtin_amdgcn_update_dpp(0, __builtin_bit_cast(int, (v)), (ctrl), 0xf, 0xf, false))

__device__ __forceinline__ void phase_peer2(const Params& p, LAS unsigned char* lds, int bid, int nb) {
    const int tid = threadIdx.x, lane = tid & 63, wave = __builtin_amdgcn_readfirstlane(tid >> 6);
    const int p16 = lane & 15, rg4 = lane >> 4, q8 = lane >> 3, p8 = lane & 7;
    const bool b0 = lane & 1, b1 = lane & 2, b2 = lane & 4, c0 = lane & 8, c1 = lane & 16, c2 = lane & 32;
    unsigned char* ws = p.ws;
    const _Float16* SC = (const _Float16*)(ws + WS_PROJ); const bf16_t* HB = (const bf16_t*)(ws + WS_XN); const float* SSQ = (const float*)(ws + WS_SSQ);
    const unsigned char* UB = (const unsigned char*)(ws + WS_UB); const unsigned char* VB = (const unsigned char*)(ws + WS_VB); unsigned char* XQ = ws + WS_XQ;
    LAS unsigned char* wl = lds + wave * W6_BYTES;
    LAS unsigned* CW = (LAS unsigned*)wl;
    LAS unsigned char* XL = wl;
    LAS unsigned short* E16 = (LAS unsigned short*)(wl + 8192);
    LAS _Float16* GC = (LAS _Float16*)(wl + 10240);
    LAS unsigned* E32 = (LAS unsigned*)(wl + 4096);
    LAS float* ACT = (LAS float*)(wl + 12288);
    LAS float* RS = (LAS float*)(wl + 16384);
    unsigned ixc[8];
#pragma unroll
    for (int e = 0; e < 8; ++e) ixc[e] = (unsigned)(127 - (8 * p16 + e));
    int ci = 0, cj = 0; bool cvalid = lane < 50;
    { int l = lane;
      if (l < 16) { ci = 0; cj = l; } else if (l < 24) { ci = 1; cj = l - 16; } else if (l < 29) { ci = 2; cj = l - 24; } else if (l < 33) { ci = 3; cj = l - 29; }
      else if (l < 36) { ci = 4; cj = l - 33; } else if (l < 42) { ci = 5 + (l - 36) / 2; cj = (l - 36) & 1; } else { ci = 8 + (l - 42); cj = 0; } if (!cvalid) { ci = 0; cj = 0; } }
    const int gw = bid * 8 + wave, NGW = nb * 8;
#define TOK6(k) min(base + (k) * NGW, NTOK - 1)
    for (int base = gw; base < NTOK; base += NT6 * NGW) {
#pragma unroll 1
        for (int rep_r = 0; rep_r < PROBE_R; ++rep_r)
#pragma unroll 1
        for (int k = 0; k < NT6; k += 2) {
            u32x4 raw[2][4]; float rstd[2];
#pragma unroll
            for (int v = 0; v < 2; ++v) { const int t = TOK6(k + v);
#pragma unroll
                for (int q = 0; q < 4; ++q) raw[v][q] = *(const u32x4*)(SC + (size_t)t * 2048 + 512 * q + 8 * lane);
                float ssq = (lane < 16) ? SSQ[(size_t)t * 16 + lane] : 0.f; ssq = wave_sum(ssq);
                rstd[v] = 1.0f / sqrtf(ssq * (1.0f / DM) + EPS);
                { const u32x4 ha = *(const u32x4*)(HB + (size_t)t * DM + 16 * lane), hb = *(const u32x4*)(HB + (size_t)t * DM + 16 * lane + 8); const float sc = rstd[v] * 16.0f;
                  const unsigned hv[8] = {ha.x, ha.y, ha.z, ha.w, hb.x, hb.y, hb.z, hb.w}; unsigned xw[4];
#pragma unroll
                  for (int w = 0; w < 4; ++w) { int pk = __builtin_amdgcn_cvt_pk_fp8_f32(bf_lo(hv[2 * w]) * sc, bf_hi(hv[2 * w]) * sc, 0, false);
                      pk = __builtin_amdgcn_cvt_pk_fp8_f32(bf_lo(hv[2 * w + 1]) * sc, bf_hi(hv[2 * w + 1]) * sc, pk, true); xw[w] = (unsigned)pk; }
                  *(u32x4*)(XQ + (size_t)t * DM + 16 * lane) = (u32x4){xw[0], xw[1], xw[2], xw[3]}; } }
#pragma unroll
            for (int qq = 0; qq < 2; ++qq) {
                unsigned ka[4][8];
#pragma unroll
                for (int c = 0; c < 4; ++c) { const u32x4 rv = raw[c >> 1][2 * qq + (c & 1)]; const unsigned rw[4] = {rv.x, rv.y, rv.z, rv.w};
#pragma unroll
                    for (int i = 0; i < 4; ++i) {
                        const s16x2 hv2 = __builtin_bit_cast(s16x2, rw[i]); const s16x2 sg = hv2 >> 15; const unsigned kk = rw[i] ^ (__builtin_bit_cast(unsigned, sg) | 0x80008000u);
                        ka[c][2 * i] = (kk << 16) | ixc[2 * i]; ka[c][2 * i + 1] = (kk & 0xffff0000u) | ixc[2 * i + 1]; } }
#define CE6(u, i, j) do { const unsigned _a = ka[u][i], _b = ka[u][j]; ka[u][i] = _a > _b ? _a : _b; ka[u][j] = _a > _b ? _b : _a; } while (0)
#pragma unroll
                for (int u = 0; u < 4; ++u) {
                    CE6(u, 0, 1); CE6(u, 2, 3); CE6(u, 4, 5); CE6(u, 6, 7);
                    CE6(u, 0, 2); CE6(u, 1, 3); CE6(u, 4, 6); CE6(u, 5, 7);
                    CE6(u, 1, 2); CE6(u, 5, 6);
                    CE6(u, 0, 4); CE6(u, 1, 5); CE6(u, 2, 6); CE6(u, 3, 7);
                    CE6(u, 2, 4); CE6(u, 3, 5);
                    CE6(u, 1, 2); CE6(u, 3, 4); CE6(u, 5, 6);
                }
#undef CE6
                unsigned mine[4] = {0u, 0u, 0u, 0u};
#pragma unroll 1
                for (int it = 0; it < 16; ++it) {
                    unsigned Wv[4]; row_max4(ka[0][0], ka[1][0], ka[2][0], ka[3][0], Wv[0], Wv[1], Wv[2], Wv[3]);
#pragma unroll
                    for (int c = 0; c < 4; ++c) {
                        const unsigned W = Wv[c];
                        mine[c] = (p16 == it) ? W : mine[c];
                        const bool win = (ka[c][0] == W);
#pragma unroll
                        for (int e = 0; e < 7; ++e) ka[c][e] = win ? ka[c][e + 1] : ka[c][e];
                        ka[c][7] = win ? 0u : ka[c][7];
                    }
                }
#pragma unroll
                for (int c = 0; c < 4; ++c) { const int g = 4 * (2 * qq + (c & 1)) + rg4; LAS int* A_s = (LAS int*)(wl + 3072 * (c >> 1)); LAS int* A_i = (LAS int*)(wl + 3072 * (c >> 1) + 1024);
                    const unsigned k16 = mine[c] >> 16; const unsigned hbits = k16 ^ ((k16 & 0x8000u) ? 0x8000u : 0xffffu);
                    const float fs = (float)__builtin_bit_cast(_Float16, (unsigned short)hbits);
                    A_s[g * 16 + p16] = (int)__builtin_rintf(fs * 16384.0f); A_i[g * 16 + p16] = 127 - (int)(mine[c] & 0x7fu); }
            }
            LDS_WAIT();
            {
                int av[4], bc[4]; int iav[4], ibc[4], jp[4], hh[4], bb[4]; unsigned key[4];
#pragma unroll
                for (int c = 0; c < 4; ++c) { const LAS int* A_s = (const LAS int*)(wl + 3072 * (c >> 1)); const LAS int* A_i = (const LAS int*)(wl + 3072 * (c >> 1) + 1024);
                    hh[c] = 4 * (c & 1) + rg4; bb[c] = (2 * hh[c] + 1) * 16; av[c] = A_s[(2 * hh[c]) * 16 + p16] + (1 << 20); iav[c] = A_i[(2 * hh[c]) * 16 + p16] * 128; jp[c] = 0; bc[c] = A_s[bb[c]]; ibc[c] = A_i[bb[c]];
                    key[c] = ((unsigned)(av[c] + bc[c]) << 4) | (unsigned)(15 - p16); }
#pragma unroll 1
                for (int it = 0; it < 16; ++it) {
                    unsigned Wv[4]; row_max4(key[0], key[1], key[2], key[3], Wv[0], Wv[1], Wv[2], Wv[3]);
#pragma unroll
                    for (int c = 0; c < 4; ++c) {
                        const LAS int* A_s = (const LAS int*)(wl + 3072 * (c >> 1)); const LAS int* A_i = (const LAS int*)(wl + 3072 * (c >> 1) + 1024);
                        LAS int* E_i = (LAS int*)(wl + 3072 * (c >> 1) + 2048); LAS int* E_s = (LAS int*)(wl + 3072 * (c >> 1) + 2560);
                        const bool win = (key[c] == Wv[c]);
                        if (win) { E_i[hh[c] * 16 + it] = iav[c] + ibc[c]; E_s[hh[c] * 16 + it] = av[c] + bc[c]; }
                        jp[c] += win ? 1 : 0;
                        const int jr = jp[c] < 16 ? jp[c] : 15;
                        bc[c] = A_s[bb[c] + jr]; ibc[c] = A_i[bb[c] + jr];
                        key[c] = jp[c] < 16 ? (((unsigned)(av[c] + bc[c]) << 4) | (unsigned)(15 - p16)) : 0u;
                    }
                }
            }
            LDS_WAIT();
#pragma unroll
            for (int v = 0; v < 2; ++v) { const LAS int* E_i = (const LAS int*)(wl + 3072 * v + 2048); const LAS int* E_s = (const LAS int*)(wl + 3072 * v + 2560);
#pragma unroll
                for (int sl = 0; sl < 2; ++sl) { const int e = lane + 64 * sl; const float pe = __expf((float)(E_s[e] - E_s[e & ~15]) * (rstd[v] * (1.0f / 16384.0f))); const float den = row_sum_x(pe);
                    const int pos = 16 * (e & 7) + (e >> 3);
                    GC[(k + v) * 128 + pos] = (_Float16)(pe / den); E16[(k + v) * 128 + pos] = (unsigned short)E_i[e]; }
                if (lane == 0) RS[k + v] = rstd[v]; }
            LDS_WAIT();
        }
#define P6_LOADH(buf, TAB, jj, kk, hh) do { const u32x4 _iv = *(const LAS u32x4*)(E16 + (kk) * 128 + 16 * q8 + 8 * (hh)); const unsigned _iw[4] = {_iv.x, _iv.y, _iv.z, _iv.w}; \
            _Pragma("unroll") for (int c = 0; c < 8; ++c) { const unsigned _idx = (c & 1) ? (_iw[c >> 1] >> 16) : (_iw[c >> 1] & 0xffffu); \
                buf[c] = *(const u32x4*)((TAB) + (((size_t)(jj) * NEXP + _idx) << 7) + 16 * p8); } } while (0)
#define P6_LOADX(hb, jj, kk) do { const bf16_t* _hp = HB + (size_t)TOK6(kk) * DM + 128 * (jj) + 16 * p8; hb[0] = *(const u32x4*)_hp; hb[1] = *(const u32x4*)(_hp + 8); } while (0)
        asm volatile("s_waitcnt vmcnt(0)" ::: "memory");
        { u32x4 xr[NT6];
#pragma unroll
          for (int k = 0; k < NT6; ++k) xr[k] = *(const u32x4*)(XQ + (size_t)TOK6(k) * DM + 16 * lane);
#pragma unroll
          for (int k = 0; k < NT6; ++k) *(LAS u32x4*)(XL + k * 1024 + 16 * lane) = xr[k]; }
        LDS_WAIT();
#pragma unroll 1
        for (int rep_u = 0; rep_u < PROBE_U; ++rep_u) {
            for (int k = 0; k < NT6; ++k) { ACT[k * 128 + lane] = 0.f; ACT[k * 128 + 64 + lane] = 0.f; }
            LDS_WAIT();
            const int n16 = lane & 15, g4 = lane >> 4, c4 = lane & 3, r16 = 4 * g4 + (n16 >> 2);
            const int eoff = 2 * (16 * (r16 & 7) + (r16 >> 3));
            const bool xkeep = ((g4 >> 1) == ((n16 >> 2) & 1)); const bool klo = xkeep && (n16 < 8), khi = xkeep && (n16 >= 8);
            u32x4 bfP[16], bfQ[16];
#define P6_ULOAD(buf, nn) do { const int _j = (nn) / NT6, _k = (nn) % NT6; const LAS unsigned char* _ip = (const LAS unsigned char*)(E16 + _k * 128) + eoff; \
                _Pragma("unroll") for (int T = 0; T < 8; ++T) { const unsigned _idx = *(const LAS unsigned short*)(_ip + 4 * T); \
                    const unsigned char* _rp = UB + (((size_t)_j * NEXP + _idx) << 7) + 16 * c4; buf[2 * T] = *(const u32x4*)_rp; buf[2 * T + 1] = *(const u32x4*)(_rp + 64); } } while (0)
#define P6_PK64(lo, hi) ((long)(((unsigned long long)(hi) << 32) | (unsigned long long)(lo)))
#define P6_UMMA(buf, nn) do { const int k = (nn) % NT6; const LAS unsigned char* _xl = XL + k * 1024 + 256 * ((nn) / NT6) + 32 * c4 + 16 * (g4 & 1); \
                const u32x4 xv0 = *(const LAS u32x4*)_xl, xv1 = *(const LAS u32x4*)(_xl + 128); \
                const i32x8 xa0 = {(int)(klo ? xv0.x : 0u), (int)(klo ? xv0.y : 0u), (int)(klo ? xv0.z : 0u), (int)(klo ? xv0.w : 0u), \
                                   (int)(khi ? xv0.x : 0u), (int)(khi ? xv0.y : 0u), (int)(khi ? xv0.z : 0u), (int)(khi ? xv0.w : 0u)}; \
                const i32x8 xa1 = {(int)(klo ? xv1.x : 0u), (int)(klo ? xv1.y : 0u), (int)(klo ? xv1.z : 0u), (int)(klo ? xv1.w : 0u), \
                                   (int)(khi ? xv1.x : 0u), (int)(khi ? xv1.y : 0u), (int)(khi ? xv1.z : 0u), (int)(khi ? xv1.w : 0u)}; \
                float dsel[2] = {0.f, 0.f}; \
                _Pragma("unroll") for (int T = 0; T < 8; ++T) { f32x4 d = (f32x4){0.f, 0.f, 0.f, 0.f}; \
                    const i32x8 bb0 = {(int)buf[2 * T].x, (int)buf[2 * T].y, (int)buf[2 * T].z, (int)buf[2 * T].w, 0, 0, 0, 0}; \
                    const i32x8 bb1 = {(int)buf[2 * T + 1].x, (int)buf[2 * T + 1].y, (int)buf[2 * T + 1].z, (int)buf[2 * T + 1].w, 0, 0, 0, 0}; \
                    d = __builtin_amdgcn_mfma_scale_f32_16x16x128_f8f6f4(xa0, bb0, d, 0, 4, 0, MX_ONE, 0, MX_ONE); \
                    d = __builtin_amdgcn_mfma_scale_f32_16x16x128_f8f6f4(xa1, bb1, d, 0, 4, 0, MX_ONE, 0, MX_ONE); \
                    float pv = (c4 == 0) ? d[0] : ((c4 == 1) ? d[1] : ((c4 == 2) ? d[2] : d[3])); \
                    pv += DPPF(pv, 0xB1); pv += DPPF(pv, 0x4E);                         \
                    dsel[T >> 2] = ((T & 3) == c4) ? pv : dsel[T >> 2]; } \
                  \
                ACT[k * 128 + 16 * c4 + r16] += dsel[0]; ACT[k * 128 + 16 * (c4 + 4) + r16] += dsel[1]; } while (0)
            P6_ULOAD(bfP, 0);
#pragma unroll 1
            for (int n = 0; n < 4 * NT6; n += 2) {
                P6_ULOAD(bfQ, n + 1); asm volatile("" ::: "memory"); __builtin_amdgcn_sched_barrier(0);
                P6_UMMA(bfP, n); __builtin_amdgcn_sched_barrier(0);
                if (n + 2 < 4 * NT6) P6_ULOAD(bfP, n + 2);
                asm volatile("" ::: "memory"); __builtin_amdgcn_sched_barrier(0);
                P6_UMMA(bfQ, n + 1); __builtin_amdgcn_sched_barrier(0);
            }
#undef P6_ULOAD
#undef P6_UMMA
#undef P6_PK64
        }
        LDS_WAIT();
#pragma unroll 1
        for (int k = 0; k < NT6; ++k) {
#pragma unroll
            for (int sl = 0; sl < 2; ++sl) { const int e = lane + 64 * sl, pos = 16 * (e & 7) + (e >> 3); const float a = ACT[k * 128 + e] * (1.0f / 1024.0f);
                const float cfv = (float)GC[k * 128 + pos] * gelu_exact(a);
                CW[k * 128 + pos] = (unsigned)(__builtin_amdgcn_cvt_pk_fp8_f32(cfv * 32.0f, 0.f, 0, false) & 0xff) * 0x01010101u; E32[k * 128 + pos] = (unsigned)E16[k * 128 + pos] << 7; } }
        LDS_WAIT();
#pragma unroll 1
        for (int k = 0; k < NT6; ++k) ACT[k * 64 + lane] = 0.f;
        LDS_WAIT();
#pragma unroll 1
        for (int rep_v = 0; rep_v < PROBE_V; ++rep_v) {
            for (int k = 0; k < NT6; ++k) ACT[k * 64 + lane] = 0.f;
            LDS_WAIT();
            u32x4 bfP[16], bfQ[16];
            const int n16 = lane & 15, g4 = lane >> 4;
            const unsigned bsel = 0xffu << (8 * (n16 & 3));
            const unsigned M0 = (n16 >> 2) == 0 ? bsel : 0u, M1 = (n16 >> 2) == 1 ? bsel : 0u, M2 = (n16 >> 2) == 2 ? bsel : 0u, M3 = (n16 >> 2) == 3 ? bsel : 0u;
            const int c0 = 16 * n16 + 4 * g4;
            const unsigned loff = 8u * (unsigned)n16;
#define P6_VLOAD(buf, nn) do { const int _j = (nn) / NT6, _k = (nn) % NT6; const LAS unsigned* _ip = E32 + _k * 128 + 32 * g4; \
                const unsigned char* _tb = VB + (size_t)_j * NEXP * 128; \
                _Pragma("unroll") for (int q = 0; q < 4; ++q) { const u32x4 _o0 = *(const LAS u32x4*)(_ip + 4 * q), _o1 = *(const LAS u32x4*)(_ip + 16 + 4 * q); \
                    const unsigned _ow0[4] = {_o0.x, _o0.y, _o0.z, _o0.w}, _ow1[4] = {_o1.x, _o1.y, _o1.z, _o1.w}; \
                    _Pragma("unroll") for (int cc = 0; cc < 4; ++cc) { \
                        const u32x2 _t0 = *(const u32x2*)(_tb + (size_t)(_ow0[cc] + loff)), _t1 = *(const u32x2*)(_tb + (size_t)(_ow1[cc] + loff)); \
                        buf[4 * q + cc] = (u32x4){_t0.x, _t0.y, _t1.x, _t1.y}; } } } while (0)
#define P6_LOADR2(hb, nn) do { hb = *(const u32x2*)(HB + (size_t)TOK6((nn) % NT6) * DM + 256 * ((nn) / NT6) + c0); } while (0)
#define P6_VBODY(buf, nn, hb) do { const int j = (nn) / NT6, k = (nn) % NT6; const int t = TOK6(k); \
                const LAS unsigned* _cp = CW + k * 128 + 16 * g4; \
                const u32x4 _c0 = *(const LAS u32x4*)_cp, _c1 = *(const LAS u32x4*)(_cp + 4), _c2 = *(const LAS u32x4*)(_cp + 8), _c3 = *(const LAS u32x4*)(_cp + 12); \
                const u32x4 _d0 = *(const LAS u32x4*)(_cp + 64), _d1 = *(const LAS u32x4*)(_cp + 68), _d2 = *(const LAS u32x4*)(_cp + 72), _d3 = *(const LAS u32x4*)(_cp + 76); \
                const unsigned _cl[16] = {_c0.x, _c0.y, _c0.z, _c0.w, _c1.x, _c1.y, _c1.z, _c1.w, _c2.x, _c2.y, _c2.z, _c2.w, _c3.x, _c3.y, _c3.z, _c3.w}; \
                const unsigned _ch[16] = {_d0.x, _d0.y, _d0.z, _d0.w, _d1.x, _d1.y, _d1.z, _d1.w, _d2.x, _d2.y, _d2.z, _d2.w, _d3.x, _d3.y, _d3.z, _d3.w}; \
                f32x4 dA = (f32x4){0.f, 0.f, 0.f, 0.f}, dB = (f32x4){0.f, 0.f, 0.f, 0.f}; \
                _Pragma("unroll") for (int c = 0; c < 16; ++c) { const unsigned _l = _cl[c], _h = _ch[c]; \
                    const i32x8 av = {(int)(_l & M0), (int)(_l & M1), (int)(_l & M2), (int)(_l & M3), (int)(_h & M0), (int)(_h & M1), (int)(_h & M2), (int)(_h & M3)}; \
                    const i32x8 bv = {(int)buf[c].x, (int)buf[c].y, (int)buf[c].z, (int)buf[c].w, 0, 0, 0, 0}; \
                    if (c & 1) dB = __builtin_amdgcn_mfma_scale_f32_16x16x128_f8f6f4(av, bv, dB, 0, 4, 0, MX_ONE, 0, MX_ONE); \
                    else       dA = __builtin_amdgcn_mfma_scale_f32_16x16x128_f8f6f4(av, bv, dA, 0, 4, 0, MX_ONE, 0, MX_ONE); } \
                const float hv[4] = {bf_lo(hb.x), bf_hi(hb.x), bf_lo(hb.y), bf_hi(hb.y)}; float o[4]; float ss = 0.f; \
                _Pragma("unroll") for (int r = 0; r < 4; ++r) { o[r] = (dA[r] + dB[r]) * (1.0f / (32.0f * V4_SCALE)) + hv[r]; ss += o[r] * o[r]; } \
                *(f32x4*)(p.out + (size_t)t * DM + 256 * j + c0) = (f32x4){o[0], o[1], o[2], o[3]}; \
                ACT[k * 64 + lane] += ss; \
                } while (0)
            P6_VLOAD(bfP, 0);
#pragma unroll 1
            for (int n = 0; n < 4 * NT6; n += 2) {
                u32x2 hr0, hr1; P6_LOADR2(hr0, n); P6_LOADR2(hr1, n + 1);
                asm volatile("" ::: "memory");
                P6_VLOAD(bfQ, n + 1); asm volatile("" ::: "memory"); __builtin_amdgcn_sched_barrier(0);
                P6_VBODY(bfP, n, hr0); __builtin_amdgcn_sched_barrier(0);
                if (n + 2 < 4 * NT6) P6_VLOAD(bfP, n + 2);
                asm volatile("" ::: "memory"); __builtin_amdgcn_sched_barrier(0);
                P6_VBODY(bfQ, n + 1, hr1); __builtin_amdgcn_sched_barrier(0);
            }
            LDS_WAIT(); asm volatile("s_waitcnt vmcnt(0)" ::: "memory");
            f32x4 gfv[4];
#pragma unroll
            for (int i = 0; i < 4; ++i) gfv[i] = *(const f32x4*)(p.gfin + 256 * i + 4 * lane);
#pragma unroll 1
            for (int k = 0; k < NT6; ++k) { const float sst = wave_sum(ACT[k * 64 + lane]); const float rf = __builtin_amdgcn_rsqf(sst * (1.0f / DM) + EPS);
                float* op = p.out + (size_t)TOK6(k) * DM + 4 * lane; f32x4 ov[4];
#pragma unroll
                for (int i = 0; i < 4; ++i) ov[i] = *(const f32x4*)(op + 256 * i);
#pragma unroll
                for (int i = 0; i < 4; ++i) *(f32x4*)(op + 256 * i) = ov[i] * rf * gfv[i]; }
        }
        LDS_WAIT();
    }
#undef P6_LOADH
#undef P6_LOADX
#undef P6_VLOAD
#undef P6_VBODY
#undef P6_LOADR2
#undef P6_PK64
#undef TOK6
}

#define XB_TMO      128
#define XB_XCNT(j)  (256  + 64 * (j))
#define XB_XSUB(j)  (1280 + 64 * (j))
#define XB_XGEN(j)  (2304 + 64 * (j))
#define XB_TOP      3328
#define XB_TOPGEN   3392
#define XCD_BAR_WORDS 3456
#define XB_SPIN_CAP (1u << 18)

__device__ __forceinline__ unsigned xb_ld(unsigned* p)              { return __hip_atomic_load(p, __ATOMIC_RELAXED, __HIP_MEMORY_SCOPE_AGENT); }
__device__ __forceinline__ unsigned xb_add(unsigned* p, unsigned v) { return __hip_atomic_fetch_add(p, v, __ATOMIC_RELAXED, __HIP_MEMORY_SCOPE_AGENT); }
__device__ __forceinline__ unsigned xb_xcc_id() { return (unsigned)__builtin_amdgcn_s_getreg((3 << 11) | 20) & 0xFu; }
#define XB_SPIN(cond, bar) do { unsigned _sp = 0; while (cond) { __builtin_amdgcn_s_sleep(1); \
    if ((++_sp & 255u) == 0u) { if (xb_ld(&(bar)[XB_TMO])) break; if (_sp > XB_SPIN_CAP) { atomicAdd(&(bar)[XB_TMO], 1u); break; } } } } while (0)

struct XcdBarrier {
    unsigned* bar; unsigned x;
    volatile LAS unsigned* st;
};

__device__ __forceinline__ XcdBarrier xcd_barrier_post(unsigned* bar, volatile LAS unsigned* st) {
    XcdBarrier b; b.bar = bar; b.x = xb_xcc_id(); b.st = st;
    if (threadIdx.x == 0) (void)xb_add(&bar[XB_XCNT(b.x)], 1u);
    return b;
}
__device__ __forceinline__ void xcd_barrier_complete(unsigned* bar, unsigned x, unsigned& nloc, unsigned& nx) {
    const unsigned G = gridDim.x * gridDim.y * gridDim.z;
    unsigned sum, cnt, mine, sp = 0u;
    for (;;) {
        sum = 0u; cnt = 0u; mine = 0u;
#pragma unroll
        for (unsigned j = 0; j < 16; ++j) { const unsigned c = xb_ld(&bar[XB_XCNT(j)]); sum += c; cnt += (c > 0u) ? 1u : 0u; mine = (j == x) ? c : mine; }
        if (sum == G) break;
        __builtin_amdgcn_s_sleep(1);
        if ((++sp & 255u) == 0u) { if (xb_ld(&bar[XB_TMO])) break; if (sp > XB_SPIN_CAP) { atomicAdd(&bar[XB_TMO], 1u); break; } }
    }
    nloc = mine > 0u ? mine : 1u; nx = cnt > 0u ? cnt : 1u;
}

__device__ __forceinline__ void xcd_barrier(const XcdBarrier& b) {
    asm volatile("s_waitcnt vmcnt(0)" ::: "memory");
    __syncthreads();
    if (threadIdx.x == 0) {
        unsigned* bar = b.bar;
        __builtin_amdgcn_s_waitcnt(0);
        unsigned nloc = b.st[0], nx = b.st[1];
        if (nloc == 0u) { xcd_barrier_complete(bar, b.x, nloc, nx); b.st[0] = nloc; b.st[1] = nx; }
        const unsigned old = xb_add(&bar[XB_XSUB(b.x)], 1u);
        const unsigned gen = old / nloc;
        if (old + 1u == (gen + 1u) * nloc) {
            __builtin_amdgcn_fence(__ATOMIC_RELEASE, "agent");
            asm volatile("s_waitcnt vmcnt(0)" ::: "memory");
            const unsigned og = xb_add(&bar[XB_TOP], 1u);
            const unsigned tg = og / nx;
            if (og + 1u == (tg + 1u) * nx) xb_add(&bar[XB_TOPGEN], 1u);
            else XB_SPIN(xb_ld(&bar[XB_TOPGEN]) == tg, bar);
            __builtin_amdgcn_fence(__ATOMIC_ACQUIRE, "agent");
            xb_add(&bar[XB_XGEN(b.x)], 1u);
            asm volatile("s_waitcnt vmcnt(0)" ::: "memory");
        } else {
            XB_SPIN(xb_ld(&bar[XB_XGEN(b.x)]) == gen, bar);
            __builtin_amdgcn_fence(__ATOMIC_ACQUIRE, "agent");
            asm volatile("s_waitcnt vmcnt(0)" ::: "memory");
        }
    }
    __syncthreads();
}

__global__ void __launch_bounds__(512, 2) mk_fwd(Params p) {
    extern __shared__ __attribute__((aligned(16))) unsigned char lds_raw[];
    LAS unsigned char* lds = (LAS unsigned char*)lds_raw;
    const int bid = blockIdx.x, nb = gridDim.x;
    unsigned char* ws = p.ws;
#define IN(k) (p.ph_lo <= (k) && (k) < p.ph_hi)
#define SEAM(k) do { if (IN(k) && IN((k) + 1)) { xcd_barrier(bar); } } while (0)
    if (threadIdx.x < 4) ((volatile LAS unsigned*)(lds + LDS_BYTES - 16))[threadIdx.x] = 0u;
    __syncthreads();
    const XcdBarrier bar = xcd_barrier_post((unsigned*)(ws + WS_CTL) + 4096, (volatile LAS unsigned*)(lds + LDS_BYTES - 16));
    if (IN(0)) phase0(p, lds, bid, nb);
    SEAM(0);
    if (IN(1)) {
        pg8::Gemm g{(const bf16_t*)(ws + WS_XN), (const bf16_t*)(ws + WS_WIN), MROWS, NP1, DM}; pg8::StaticOrder S; S.init(MROWS, NP1, nb, bid);
        EpiProj E{(bf16_t*)(ws + WS_PROJ), (bf16_t*)(ws + WS_QK), (float*)(ws + WS_LA), p.gb, (const float2*)(ws + WS_ROPE)};
        pg8::gemm_phase<EpiProj, pg8::StaticOrder, true, true>(lds, g, S, E);
    }
    SEAM(1);
    if (IN(2)) attn_pass<false>(p, lds, bid, nb);
    SEAM(2);
    if (IN(3)) attn_pass<true>(p, lds, bid, nb);
    SEAM(3);
    if (IN(4)) {
        pg8::Gemm g{(const bf16_t*)(ws + WS_O), (const bf16_t*)(ws + WS_WOUT), NTOK, DM, DM}; pg8::StaticOrder S; S.init(NTOK, DM, nb, bid);
        EpiRes E{p.x, (bf16_t*)(ws + WS_XN), (float*)(ws + WS_SSQ)};
        pg8::gemm_phase<EpiRes, pg8::StaticOrder, true, true>(lds, g, S, E);
    }
    SEAM(4);
    if (IN(5)) {
        pg8::Gemm g{(const bf16_t*)(ws + WS_XN), (const bf16_t*)(ws + WS_WS), NTOK, 2048, DM}; pg8::StaticOrder S; S.init(NTOK, 2048, nb, bid);
        EpiF16 E{(_Float16*)(ws + WS_PROJ)};
        pg8::gemm_phase<EpiF16, pg8::StaticOrder, true, true>(lds, g, S, E);
    }
    SEAM(5);
    if (IN(6)) phase_peer2(p, lds, bid, nb);
#undef IN
#undef SEAM
}

#ifndef MK_FUSED
#define MK_FUSED 1
#endif
extern "C" void kernel_launch(void* const* d_in, const int* in_sizes, int n_in, void* d_out, int out_size, void* d_ws, size_t ws_size, hipStream_t stream) {
    static int grid = 0;
    if (grid == 0) {
        if (n_in != 16 || in_sizes[0] != NTOK * DM || out_size != NTOK * DM || ws_size < WS_END) {
            fprintf(stderr, "kernel_launch: unexpected shapes (n_in %d, in0 %d, out %d, ws %zu); nothing launched\n", n_in, n_in > 0 ? in_sizes[0] : -1, out_size, ws_size); grid = -1; return; }
        int dev = 0, cus = 0, per_cu = 0;
        hipGetDevice(&dev); hipDeviceGetAttribute(&cus, hipDeviceAttributeMultiprocessorCount, dev);
        if (hipFuncSetAttribute((const void*)mk_fwd, hipFuncAttributeMaxDynamicSharedMemorySize, LDS_BYTES) != hipSuccess) { fprintf(stderr, "kernel_launch: hipFuncSetAttribute failed\n"); grid = -1; return; }
        if (hipOccupancyMaxActiveBlocksPerMultiprocessor(&per_cu, (const void*)mk_fwd, 512, LDS_BYTES) != hipSuccess || per_cu < 1) { fprintf(stderr, "kernel_launch: occupancy query failed (%d)\n", per_cu); (void)hipGetLastError(); per_cu = 1; }
        grid = cus * (per_cu < 1 ? 1 : 1);
        fprintf(stderr, "kernel_launch: %d CUs, occupancy %d/CU, grid %d\n", cus, per_cu, grid);
    }
    if (grid < 0) return;
    (void)hipMemsetAsync((char*)d_ws + WS_CTL, 0, 65536, stream);
    Params p{};
    p.x = (const float*)d_in[0]; p.meta = (const float*)d_in[1]; p.g1 = (const float*)d_in[2]; p.w_in = (const float*)d_in[3]; p.gw2 = (const float*)d_in[4]; p.gb = (const float*)d_in[5];
    p.gla_gain = (const float*)d_in[6]; p.ret_gain = (const float*)d_in[7]; p.ret_bias = (const float*)d_in[8]; p.w_out = (const float*)d_in[9]; p.g2 = (const float*)d_in[10];
    p.w_q = (const float*)d_in[11]; p.subkeys = (const float*)d_in[12]; p.pu = (const float*)d_in[13]; p.pv = (const float*)d_in[14]; p.gfin = (const float*)d_in[15];
    p.out = (float*)d_out; p.ws = (unsigned char*)d_ws;
#if MK_FUSED
    p.ph_lo = 0; p.ph_hi = NPHASE;
    void* args[] = {&p};
    hipError_t e = hipLaunchCooperativeKernel((const void*)mk_fwd, dim3(grid), dim3(512), args, LDS_BYTES, stream);
    if (e != hipSuccess) fprintf(stderr, "kernel_launch: cooperative launch failed: %s (grid %d)\n", hipGetErrorString(e), grid);
#else
    { const int order[7] = {0, 1, 2, 3, 4, 5, 6}; for (int i = 0; i < 7; ++i) { p.ph_lo = order[i]; p.ph_hi = order[i] + 1; hipLaunchKernelGGL(mk_fwd, dim3(grid), dim3(512), LDS_BYTES, stream, p); } }
#endif
}
```

```cpp
#include <hip/hip_runtime.h>
#include <hip/hip_cooperative_groups.h>
#include <cstdio>
#include <cstdint>
namespace cg = cooperative_groups;
namespace pg8 {
#define PG8_LAS __attribute__((address_space(3)))
typedef unsigned short bf16_t;
typedef short bf16x8 __attribute__((ext_vector_type(8)));
typedef float f32x4 __attribute__((ext_vector_type(4)));
typedef unsigned u32x4 __attribute__((ext_vector_type(4)));
constexpr int BM = 256, BK = 64, HALF = 128, HTB = HALF * BK * 2  , STAGE_BYTES = 8 * HTB, NXCD = 8, WGM = 8;

__host__ __device__ __forceinline__ int lds_byte(int r, int c) { const int st = (r >> 4) * 2 + (c >> 5), rr = r & 15, cc = c & 31, ob = rr * 64 + cc * 2; return st * 1024 + (ob ^ (((ob >> 9) & 1) << 5)); }
__host__ __device__ __forceinline__ void stage_rc(int b, int& R, int& C) { const int st = b / 1024, sb = b % 1024, swz = sb ^ (((sb >> 9) & 1) << 5); R = (st >> 1) * 16 + swz / 64; C = (st & 1) * 32 + (swz % 64) / 2; }
__host__ __device__ __forceinline__ int perm32(int rho) { const int n = rho >> 4, i = rho & 15; return 8 * (i >> 2) + 4 * n + (i & 3); }

struct Unit { int pm, pn; };
struct Gemm { const bf16_t* A; const bf16_t* Bt; int M, N, K; };

struct StaticOrder {
    int nM, nN, nwg, G, c;
    __host__ __device__ void init(int M, int N, int G_, int c_) { nM = M / BM; nN = N / BM; nwg = nM * nN; G = G_; c = c_; }
    __host__ __device__ bool next(int i, Unit& u) const {
        const long L = (long)i * G + c; if (L >= nwg) return false;
        int wgid = (int)L; { const int q = nwg / NXCD, r = nwg % NXCD, xcd = wgid % NXCD, off = wgid / NXCD; wgid = (xcd < r ? xcd * (q + 1) : r * (q + 1) + (xcd - r) * q) + off; }
        const int nig = WGM * nN, gid = wgid / nig, fm = gid * WGM, gsz = (nM - fm) < WGM ? (nM - fm) : WGM;
        u.pm = fm + ((wgid % nig) % gsz); u.pn = (wgid % nig) / gsz; return true;
    }
    __device__ __forceinline__ void a_ready(const Unit&) const {}
    __device__ __forceinline__ void done(const Unit&) const {}
};

__device__ __forceinline__ unsigned cvt_pk_bf16(float lo, float hi) { unsigned r; asm volatile("v_cvt_pk_bf16_f32 %0, %1, %2" : "=v"(r) : "v"(lo), "v"(hi)); return r; }
typedef float f32x2 __attribute__((ext_vector_type(2)));
template <class Epi, class Sched, bool ALIGN_EPI = false, bool SP2 = false>
__device__ __forceinline__ void gemm_phase(PG8_LAS unsigned char* lds, const Gemm g, const Sched& S, const Epi& E) {
    const int tid = threadIdx.x, wid = __builtin_amdgcn_readfirstlane(tid >> 6), lane = tid & 63, wr = wid >> 2, wc = wid & 3, fr = lane & 15, fq = lane >> 4;
    const int K = g.K, nt = K / BK;
    unsigned voffA[2], voffB[2];
#pragma unroll
    for (int i = 0; i < 2; ++i) { int R, C; stage_rc(tid * 16 + i * 8192, R, C); const int Rb = Epi::PERM ? ((R & ~31) + perm32(R & 31)) : R;
        voffA[i] = (unsigned)(R * K + C) * 2u; voffB[i] = (unsigned)(Rb * K + C) * 2u; }
    const size_t kstep = (size_t)(BK * 2);
    const size_t hstep = (size_t)HALF * K * 2;
    const size_t tstep = 2 * hstep;
    const unsigned ldsw = (unsigned)wid * 1024u;
    const int aoff = lds_byte(wr * 64 + fr, fq * 8), boff = lds_byte(wc * 32 + fr, fq * 8);
#define PG8_SA(b, h) (((b) * 2 + (h)) * HTB)
#define PG8_SB(b, h) ((4 + (b) * 2 + (h)) * HTB)
#define PG8_STAGE(bufoff, gbase, voff) do { _Pragma("unroll") for (int _i = 0; _i < 2; ++_i) \
        __builtin_amdgcn_global_load_lds((const unsigned*)((const char*)(gbase) + (voff)[_i]), (PG8_LAS unsigned*)(lds + (bufoff) + ldsw + _i * 8192), 16, 0, 0); } while (0)
#define PG8_LDA(dst, b, h) do { _Pragma("unroll") for (int m = 0; m < 4; ++m) _Pragma("unroll") for (int k = 0; k < 2; ++k) dst[m][k] = *(const PG8_LAS bf16x8*)(lds + PG8_SA(b, h) + aoff + m * 2048 + k * 1024); } while (0)
#define PG8_LDB(dst, b, h) do { _Pragma("unroll") for (int n = 0; n < 2; ++n) _Pragma("unroll") for (int k = 0; k < 2; ++k) dst[n][k] = *(const PG8_LAS bf16x8*)(lds + PG8_SB(b, h) + boff + n * 2048 + k * 1024); } while (0)
#define PG8_MMA(ai, bj, At, Bt) do { __builtin_amdgcn_s_setprio(1); _Pragma("unroll") for (int m = 0; m < 4; ++m) _Pragma("unroll") for (int n = 0; n < 2; ++n) _Pragma("unroll") for (int k = 0; k < 2; ++k) \
        acc[ai][bj][m][n] = __builtin_amdgcn_mfma_f32_16x16x32_bf16(Bt[n][k], At[m][k], acc[ai][bj][m][n], 0, 0, 0); __builtin_amdgcn_s_setprio(0); } while (0)
#define PG8_WAIT_V(n) asm volatile("s_waitcnt vmcnt(" #n ")" ::: "memory")
#define PG8_WAIT_L(n) asm volatile("s_waitcnt lgkmcnt(" #n ")" ::: "memory")
#define PG8_BAR __builtin_amdgcn_s_barrier()
#define PG8_SCHED __builtin_amdgcn_sched_barrier(0)
    Unit cur, nxt; int ui = 0;
    if (!S.next(0, cur)) return;
    f32x4 acc[2][2][4][2];
#pragma unroll
    for (int a = 0; a < 2; ++a)
#pragma unroll
        for (int b = 0; b < 2; ++b)
#pragma unroll
            for (int m = 0; m < 4; ++m)
#pragma unroll
                for (int n = 0; n < 2; ++n) acc[a][b][m][n] = (f32x4){0.f, 0.f, 0.f, 0.f};
    bf16x8 At[4][2], B0[2][2], B1[2][2];
    const char* cA = (const char*)g.A + (size_t)cur.pm * tstep; const char* cB = (const char*)g.Bt + (size_t)cur.pn * tstep;
    S.a_ready(cur);
    if constexpr (SP2) {
        PG8_STAGE(PG8_SB(0, 0), cB, voffB); PG8_STAGE(PG8_SB(0, 1), cB + hstep, voffB); PG8_STAGE(PG8_SA(0, 0), cA, voffA); PG8_STAGE(PG8_SA(0, 1), cA + hstep, voffA);
        if (wr == 1) PG8_BAR;
        PG8_WAIT_V(2); PG8_BAR;
        PG8_STAGE(PG8_SB(1, 0), cB + kstep, voffB); PG8_STAGE(PG8_SA(1, 0), cA + kstep, voffA); PG8_STAGE(PG8_SB(1, 1), cB + hstep + kstep, voffB);
        PG8_WAIT_V(6); PG8_BAR;
    } else {
        PG8_STAGE(PG8_SB(0, 0), cB, voffB); PG8_STAGE(PG8_SA(0, 0), cA, voffA); PG8_STAGE(PG8_SB(0, 1), cB + hstep, voffB); PG8_STAGE(PG8_SA(0, 1), cA + hstep, voffA);
        if (wr == 1) PG8_BAR;
        PG8_WAIT_V(4); PG8_BAR;
        PG8_STAGE(PG8_SB(1, 0), cB + kstep, voffB); PG8_STAGE(PG8_SA(1, 0), cA + kstep, voffA); PG8_STAGE(PG8_SB(1, 1), cB + hstep + kstep, voffB);
        PG8_WAIT_V(6); PG8_BAR;
    }
    for (;;) {
        const bool has_next = S.next(ui + 1, nxt);
        const char* nA = has_next ? (const char*)g.A + (size_t)nxt.pm * tstep : cA; const char* nB = has_next ? (const char*)g.Bt + (size_t)nxt.pn * tstep : cB;
        for (int t = 0; t < nt; t += 2) {
            const bool last = (t == nt - 2);
            const char* a1 = cA + (size_t)(t + 1) * kstep;
            const char* a2 = last ? nA : cA + (size_t)(t + 2) * kstep; const char* b2 = last ? nB : cB + (size_t)(t + 2) * kstep;
            const char* a3 = a2 + kstep; const char* b3 = b2 + kstep;
            if (last && has_next) S.a_ready(nxt);
            if constexpr (SP2) {
            PG8_LDB(B0, 0, 0); PG8_LDB(B1, 0, 1); PG8_SCHED; PG8_LDA(At, 0, 0); PG8_STAGE(PG8_SA(1, 1), a1 + hstep, voffA);
            PG8_WAIT_V(8); PG8_WAIT_L(0); PG8_BAR; PG8_MMA(0, 0, At, B0); PG8_MMA(0, 1, At, B1); PG8_BAR; PG8_SCHED;
            PG8_LDA(At, 0, 1); PG8_STAGE(PG8_SB(0, 0), b2, voffB); PG8_STAGE(PG8_SB(0, 1), b2 + hstep, voffB); PG8_STAGE(PG8_SA(0, 0), a2, voffA);
            PG8_WAIT_V(8); PG8_WAIT_L(0); PG8_BAR; PG8_MMA(1, 0, At, B0); PG8_MMA(1, 1, At, B1); PG8_BAR; PG8_SCHED;
            PG8_LDB(B0, 1, 0); PG8_LDB(B1, 1, 1); PG8_SCHED; PG8_LDA(At, 1, 0); PG8_STAGE(PG8_SA(0, 1), a2 + hstep, voffA);
            PG8_WAIT_V(8); PG8_WAIT_L(0); PG8_BAR; PG8_MMA(0, 0, At, B0); PG8_MMA(0, 1, At, B1); PG8_BAR; PG8_SCHED;
            PG8_LDA(At, 1, 1); PG8_STAGE(PG8_SB(1, 0), b3, voffB); PG8_STAGE(PG8_SB(1, 1), b3 + hstep, voffB); PG8_STAGE(PG8_SA(1, 0), a3, voffA);
            PG8_WAIT_V(8); PG8_WAIT_L(0); PG8_BAR; PG8_MMA(1, 0, At, B0); PG8_MMA(1, 1, At, B1); PG8_BAR; PG8_SCHED;
            } else {
            PG8_LDB(B0, 0, 0); PG8_SCHED; PG8_LDA(At, 0, 0); PG8_STAGE(PG8_SA(1, 1), a1 + hstep, voffA);
            PG8_WAIT_L(8); PG8_BAR; PG8_WAIT_L(0); PG8_MMA(0, 0, At, B0); PG8_BAR; PG8_SCHED;
            PG8_LDB(B1, 0, 1); PG8_STAGE(PG8_SB(0, 0), b2, voffB);
            PG8_BAR; PG8_WAIT_L(0); PG8_MMA(0, 1, At, B1); PG8_BAR;
            PG8_LDA(At, 0, 1); PG8_STAGE(PG8_SA(0, 0), a2, voffA);
            PG8_BAR; PG8_WAIT_L(0); PG8_MMA(1, 0, At, B0); PG8_BAR; PG8_SCHED;
            PG8_STAGE(PG8_SB(0, 1), b2 + hstep, voffB);
            PG8_WAIT_V(6); PG8_BAR; PG8_MMA(1, 1, At, B1); PG8_BAR;
            PG8_LDB(B0, 1, 0); PG8_SCHED; PG8_LDA(At, 1, 0); PG8_STAGE(PG8_SA(0, 1), a2 + hstep, voffA);
            PG8_WAIT_L(8); PG8_BAR; PG8_WAIT_L(0); PG8_MMA(0, 0, At, B0); PG8_BAR; PG8_SCHED;
            PG8_LDB(B1, 1, 1); PG8_STAGE(PG8_SB(1, 0), b3, voffB);
            PG8_BAR; PG8_WAIT_L(0); PG8_MMA(0, 1, At, B1); PG8_BAR;
            PG8_LDA(At, 1, 1); PG8_STAGE(PG8_SA(1, 0), a3, voffA);
            PG8_BAR; PG8_WAIT_L(0); PG8_MMA(1, 0, At, B0); PG8_BAR; PG8_SCHED;
            PG8_STAGE(PG8_SB(1, 1), b3 + hstep, voffB);
            PG8_WAIT_V(6); PG8_BAR; PG8_MMA(1, 1, At, B1); PG8_BAR;
            }
        }
        if constexpr (ALIGN_EPI) { if (wr == 0) PG8_BAR; }
        if constexpr (!Epi::AFTER_DRAIN) { E(acc, cur, wr, wc, fr, fq); S.done(cur); }
        if (!has_next) break;
#pragma unroll
        for (int a = 0; a < 2; ++a)
#pragma unroll
            for (int b = 0; b < 2; ++b)
#pragma unroll
                for (int m = 0; m < 4; ++m)
#pragma unroll
                    for (int n = 0; n < 2; ++n) acc[a][b][m][n] = (f32x4){0.f, 0.f, 0.f, 0.f};
        cur = nxt; cA = nA; cB = nB; ++ui;
        if constexpr (ALIGN_EPI) { if (wr == 1) PG8_BAR; }
    }
    PG8_WAIT_V(0);
    if constexpr (!ALIGN_EPI) { if (wr == 0) PG8_BAR; }
    PG8_BAR;
    if constexpr (Epi::AFTER_DRAIN) { E.fused(acc, cur, wr, wc, fr, fq, lds, wid, lane); S.done(cur); }
#undef PG8_SA
#undef PG8_SB
#undef PG8_STAGE
#undef PG8_LDA
#undef PG8_LDB
#undef PG8_MMA
#undef PG8_WAIT_V
#undef PG8_WAIT_L
#undef PG8_BAR
#undef PG8_SCHED
}
}

#define LAS __attribute__((address_space(3)))
typedef unsigned short bf16_t;
typedef float f32x4 __attribute__((ext_vector_type(4)));
typedef unsigned u32x4 __attribute__((ext_vector_type(4)));
typedef unsigned u32x2 __attribute__((ext_vector_type(2)));
typedef int i32x8 __attribute__((ext_vector_type(8)));
typedef short s16x2 __attribute__((ext_vector_type(2)));
#define MX_ONE 0x7f7f7f7f
#define V4_SCALE 5.656854f
typedef short bf16x8 __attribute__((ext_vector_type(8)));
typedef short s16x4 __attribute__((ext_vector_type(4)));
typedef __bf16 bf16x2_t __attribute__((ext_vector_type(2)));
typedef _Float16 f16x2_t __attribute__((ext_vector_type(2)));
typedef float f32x2v __attribute__((ext_vector_type(2)));
typedef _Float16 h2v __attribute__((ext_vector_type(2)));

constexpr int DM = 1024, NB = 4, SEQ = 8192, NTOK = NB * SEQ;
constexpr int MROWS = NTOK + 256;
constexpr int INW = 3088;
constexpr int NPROJ = 3072, NP1 = 3328;
constexpr int NEXP = 16384;
constexpr float EPS = 1e-6f;
constexpr int C_GQ = 0, C_GK = 256, C_GV = 512, C_GG = 1024, C_RQ = 1536, C_RK = 1792, C_RV = 2048, C_RG = 2560;
constexpr int S_GA = 1536, S_RQ = 1552, S_RV = 2064;

constexpr int NVG = 2048;
constexpr int NCH = (NTOK + 256) / 64;
constexpr size_t QK_ARR = (size_t)NCH * 4 * 8 * 64 * 8;
constexpr size_t MiB = 1u << 20;
constexpr size_t WS_CTL = 0, WS_WIN = 1 * MiB, WS_WOUT = 8 * MiB, WS_WS = 10 * MiB, WS_ROPE = 14 * MiB, WS_SSQ = 17 * MiB, WS_SEG = 19 * MiB, WS_ASEG = 27 * MiB,
                 WS_UB = 28 * MiB, WS_VB = 60 * MiB, WS_XN = 92 * MiB, WS_O = 157 * MiB, WS_LA = 221 * MiB, WS_PROJ = 254 * MiB, WS_QK = 383 * MiB, WS_XQ = 448 * MiB, WS_END = 480 * MiB;
static_assert(WS_WIN + (size_t)NP1 * DM * 2 <= WS_WOUT && WS_ROPE + (size_t)(SEQ + 64) * 32 * 8 <= WS_SSQ && WS_XN + (size_t)MROWS * DM * 2 <= WS_O &&
              WS_LA + QK_ARR * 4 <= WS_PROJ && WS_PROJ + (size_t)MROWS * NVG * 2 <= WS_QK && WS_QK + 4 * QK_ARR * 2 <= WS_XQ && WS_PROJ + (size_t)NTOK * 2048 * 2 <= WS_QK, "ws map");

constexpr int LDS_BYTES = 147456;
constexpr int NPHASE = 7;
#ifndef PROBE_R
#define PROBE_R 1
#define PROBE_U 1
#define PROBE_V 1
#endif
#ifndef PEER_FP8
#define PEER_FP8 1
#endif

struct Params {
    const float *x, *meta, *g1, *w_in, *gw2, *gb, *gla_gain, *ret_gain, *ret_bias, *w_out, *g2, *w_q, *subkeys, *pu, *pv, *gfin;
    float* out; unsigned char* ws;
    int ph_lo, ph_hi;
};

#define LDS_WAIT() asm volatile("s_waitcnt lgkmcnt(0)" ::: "memory")
__device__ __forceinline__ unsigned pk2(float lo, float hi) { const bf16x2_t v = {(__bf16)lo, (__bf16)hi}; return __builtin_bit_cast(unsigned, v); }
__device__ __forceinline__ unsigned f2bf(float f) { return (unsigned)__builtin_bit_cast(unsigned short, (__bf16)f); }

__device__ __forceinline__ float bf_lo(unsigned w) { return __builtin_bit_cast(float, w << 16); }
__device__ __forceinline__ float bf_hi(unsigned w) { return __builtin_bit_cast(float, w & 0xffff0000u); }
__device__ __forceinline__ float bf1(bf16_t h) { return __builtin_bit_cast(float, (unsigned)h << 16); }
__device__ __forceinline__ float wave_sum(float v) {
#pragma unroll
    for (int o = 1; o < 64; o <<= 1) v += __shfl_xor(v, o);
    return v;
}

struct MapIn {
    __device__ __forceinline__ void operator()(int j, int& src, float& sc) const {
        if (j < C_RQ) { src = j; sc = (j < 256) ? 0.125f : 1.0f; }
        else if (j < C_RV) { const int jj = j - C_RQ, which = jj >> 8, within = jj & 255, head = within >> 6, p = within & 63;
            const int a = p >> 3, n = (p >> 2) & 1, i = p & 3; src = S_RQ + which * 256 + head * 64 + 32 * n + 4 * a + i; sc = which ? 0.125f : 1.0f; }
        else { src = S_RV + (j - C_RV); sc = 1.0f; }
    }
};
struct MapId { __device__ __forceinline__ void operator()(int j, int& src, float& sc) const { src = j; sc = 1.0f; } };

template <class Map>
__device__ __forceinline__ void transpose_item(const float* W, int K, int N, bf16_t* WT, LAS float* scr, int item, int nblk, int lane, const Map map) {
    const int kb = item / nblk, nb = item % nblk, k0 = 64 * kb, n0 = 32 * nb;
    int src; float sc; map(n0 + (lane & 31), src, sc);
#pragma unroll 8
    for (int i = 0; i < 32; ++i) { const int kk = 2 * i + (lane >> 5); scr[kk * 33 + (lane & 31)] = W[(size_t)(k0 + kk) * N + src] * sc; }
    LDS_WAIT();
    const int c = lane & 7;
#pragma unroll
    for (int j = 0; j < 4; ++j) { const int n = (lane >> 3) + 8 * j; const LAS float* s = scr + (8 * c) * 33 + n;
        u32x4 o; o.x = pk2(s[0 * 33], s[1 * 33]); o.y = pk2(s[2 * 33], s[3 * 33]); o.z = pk2(s[4 * 33], s[5 * 33]); o.w = pk2(s[6 * 33], s[7 * 33]);
        *(u32x4*)(WT + (size_t)(n0 + n) * K + k0 + 8 * c) = o; }
    LDS_WAIT();
}

__device__ __forceinline__ void phase0(const Params& p, LAS unsigned char* lds, int bid, int nb) {
    const int tid = threadIdx.x, lane = tid & 63, wave = __builtin_amdgcn_readfirstlane(tid >> 6);
    unsigned char* ws = p.ws;
    bf16_t* XN = (bf16_t*)(ws + WS_XN); bf16_t* WinT = (bf16_t*)(ws + WS_WIN); bf16_t* WoutT = (bf16_t*)(ws + WS_WOUT); bf16_t* WsT = (bf16_t*)(ws + WS_WS);
    const int gw = bid * 8 + wave, NGW = nb * 8;
    const int gt = bid * 512 + tid, NGT = nb * 512;

    {
        LAS float* SKT = (LAS float*)lds;
        LAS float* WQT = (LAS float*)(lds + 128 * 132 * 4);
        for (int item = bid; item < 256; item += nb) {
            const int hc = item >> 4, kb = item & 15;
            __syncthreads();
            for (int e = tid; e < 128 * 128; e += 512) { const int n = e >> 7, d = e & 127; SKT[d * 132 + n] = p.subkeys[(size_t)hc * 16384 + e]; }
            for (int e = tid; e < 64 * 128; e += 512) { const int k = e >> 7, d = e & 127; WQT[d * 68 + k] = p.w_q[(size_t)(kb * 64 + k) * 2048 + hc * 128 + d]; }
            __syncthreads();
            const int tn = tid & 31, tk = tid >> 5;
            f32x4 acc[4];
#pragma unroll
            for (int i = 0; i < 4; ++i) acc[i] = (f32x4){0.f, 0.f, 0.f, 0.f};
#pragma unroll 4
            for (int d = 0; d < 128; ++d) {
                const f32x4 sk = *(const LAS f32x4*)(SKT + d * 132 + 4 * tn); const f32x4 wq = *(const LAS f32x4*)(WQT + d * 68 + 4 * tk);
#pragma unroll
                for (int i = 0; i < 4; ++i) acc[i] += sk[i] * wq;
            }
            const f32x4 gg = *(const f32x4*)(p.g2 + kb * 64 + 4 * tk);
#pragma unroll
            for (int i = 0; i < 4; ++i) { const f32x4 v = acc[i] * gg; u32x2 o; o.x = pk2(v[0], v[1]); o.y = pk2(v[2], v[3]);
                *(u32x2*)(WsT + (size_t)(hc * 128 + 4 * tn + i) * DM + kb * 64 + 4 * tk) = o; }
        }
        __syncthreads();
    }
    {
        LAS float* scr = (LAS float*)(lds + wave * 16384);
        constexpr int I_IN = (DM / 64) * (NPROJ / 32), I_OUT = (DM / 64) * (DM / 32);
        for (int it = gw; it < I_IN + I_OUT; it += NGW) {
            if (it < I_IN) transpose_item(p.w_in, DM, INW, WinT, scr, it, NPROJ / 32, lane, MapIn());
            else transpose_item(p.w_out, DM, DM, WoutT, scr, it - I_IN, DM / 32, lane, MapId());
        }
    }
    for (int e = gt; e < 256 * DM; e += NGT) {
        const int n = e >> 10, k = e & 1023; const float* wr = p.w_in + (size_t)k * INW + S_GA; float s = 0.f;
#pragma unroll
        for (int r = 0; r < 16; ++r) s += wr[r] * p.gw2[r * 256 + n];
        WinT[(size_t)(NPROJ + n) * DM + k] = (bf16_t)f2bf(s);
    }
#if PEER_FP8
    {
        u32x4* U4 = (u32x4*)(ws + WS_UB); u32x4* V4 = (u32x4*)(ws + WS_VB);
        for (int e = gt; e < NEXP * DM / 32; e += NGT) {
            const f32x4* us = (const f32x4*)p.pu + 8 * (size_t)e; const f32x4* vs = (const f32x4*)p.pv + 8 * (size_t)e;
            const f32x4* g2s = (const f32x4*)p.g2 + 8 * (e & 31);
            unsigned tu[4], tv[4];
#pragma unroll
            for (int j = 0; j < 4; ++j) { const f32x4 a0 = us[2 * j] * g2s[2 * j] * 64.0f, a1 = us[2 * j + 1] * g2s[2 * j + 1] * 64.0f;
                const f32x4 b0 = vs[2 * j] * V4_SCALE, b1 = vs[2 * j + 1] * V4_SCALE;
                unsigned w = 0u, x = 0u;
                w = __builtin_amdgcn_cvt_scalef32_pk_fp4_f32(w, a0[0], a0[1], 1.0f, 0); w = __builtin_amdgcn_cvt_scalef32_pk_fp4_f32(w, a0[2], a0[3], 1.0f, 1);
                w = __builtin_amdgcn_cvt_scalef32_pk_fp4_f32(w, a1[0], a1[1], 1.0f, 2); w = __builtin_amdgcn_cvt_scalef32_pk_fp4_f32(w, a1[2], a1[3], 1.0f, 3); tu[j] = w;
                x = __builtin_amdgcn_cvt_scalef32_pk_fp4_f32(x, b0[0], b0[1], 1.0f, 0); x = __builtin_amdgcn_cvt_scalef32_pk_fp4_f32(x, b0[2], b0[3], 1.0f, 1);
                x = __builtin_amdgcn_cvt_scalef32_pk_fp4_f32(x, b1[0], b1[1], 1.0f, 2); x = __builtin_amdgcn_cvt_scalef32_pk_fp4_f32(x, b1[2], b1[3], 1.0f, 3); tv[j] = x; }
            const int row = e >> 5, c32 = e & 31;
            const size_t dst = ((size_t)(c32 >> 3) * NEXP + row) * 8 + (c32 & 7);
            U4[dst] = (u32x4){tu[0], tu[1], tu[2], tu[3]}; V4[dst] = (u32x4){tv[0], tv[1], tv[2], tv[3]}; }
    }
#else
    {
        u32x2* UB = (u32x2*)(ws + WS_UB); u32x2* VB = (u32x2*)(ws + WS_VB);
        const f32x4* u4 = (const f32x4*)p.pu; const f32x4* v4 = (const f32x4*)p.pv;
        for (int e = gt; e < NEXP * DM / 4; e += NGT) { const f32x4 a = u4[e]; u32x2 o; o.x = pk2(a[0], a[1]); o.y = pk2(a[2], a[3]); UB[e] = o;
            const f32x4 b = v4[e]; u32x2 q; q.x = pk2(b[0], b[1]); q.y = pk2(b[2], b[3]); VB[e] = q; }
    }
#endif
    {
        float2* rope = (float2*)(ws + WS_ROPE);
        for (int e = gt; e < (SEQ + 64) * 32; e += NGT) { const int pi = e >> 5, d = e & 31;
            const float invf = (float)pow(10000.0, -(double)d / 32.0); const float ang = (float)(pi - 48) * invf;
            rope[e] = make_float2((float)cos((double)ang), (float)sin((double)ang)); }
    }
    for (int m0 = gw; m0 < MROWS; m0 += 4 * NGW) {
        const float* srcp[4]; f32x4 v[4][4];
#pragma unroll
        for (int u = 0; u < 4; ++u) { const int m = m0 + u * NGW; srcp[u] = nullptr;
            if (m < MROWS) { if (m >= 256) srcp[u] = p.x + (size_t)(m - 256) * DM; else if (m >= 48 && m < 64) srcp[u] = p.meta + (size_t)(m - 48) * DM; }
            if (srcp[u] != nullptr) { const f32x4* xr = (const f32x4*)srcp[u] + lane;
#pragma unroll
                for (int j = 0; j < 4; ++j) v[u][j] = xr[64 * j]; }
            else {
#pragma unroll
                for (int j = 0; j < 4; ++j) v[u][j] = (f32x4){0.f, 0.f, 0.f, 0.f}; } }
        f32x4 gg[4];
#pragma unroll
        for (int j = 0; j < 4; ++j) gg[j] = ((const f32x4*)p.g1 + lane)[64 * j];
#pragma unroll
        for (int u = 0; u < 4; ++u) { const int m = m0 + u * NGW; if (m >= MROWS) continue;
            float s = 0.f;
#pragma unroll
            for (int j = 0; j < 4; ++j) s += (v[u][j].x * v[u][j].x + v[u][j].y * v[u][j].y) + (v[u][j].z * v[u][j].z + v[u][j].w * v[u][j].w);
            const float r = (srcp[u] != nullptr) ? __builtin_amdgcn_rsqf(wave_sum(s) * (1.0f / DM) + EPS) : 0.f;
            unsigned long long* o8 = (unsigned long long*)(XN + (size_t)m * DM) + lane;
#pragma unroll
            for (int j = 0; j < 4; ++j) { const f32x4 y = v[u][j] * r * gg[j]; o8[64 * j] = (unsigned long long)pk2(y.x, y.y) | ((unsigned long long)pk2(y.z, y.w) << 32); } }
    }
}

struct EpiProj {
    static constexpr bool PERM = true, AFTER_DRAIN = false;
    bf16_t* VG; bf16_t* QK; float* LAT; const float* gb; const float2* rope;
    __device__ __forceinline__ static size_t tile_off(int r, int head, int dg) { return ((((size_t)(r >> 6) * 4 + head) * 8 + dg) * 64 + (r & 63)) * 8; }
    __device__ __forceinline__ void operator()(const pg8::f32x4 (&acc)[2][2][4][2], const pg8::Unit& u, int wr, int wc, int fr, int fq) const {
        const int row0 = u.pm * 256 + wr * 64 + fr, cb0 = wc * 32 + 8 * fq;
        if (u.pn == 12) {
#pragma unroll
            for (int bj = 0; bj < 2; ++bj) { const int c = cb0 + 128 * bj; const f32x4 b0 = *(const f32x4*)(gb + c), b1 = *(const f32x4*)(gb + c + 4);
#pragma unroll
                for (int ai = 0; ai < 2; ++ai)
#pragma unroll
                    for (int m = 0; m < 4; ++m) { const int row = row0 + ai * 128 + m * 16; f32x4 v0 = acc[ai][bj][m][0] + b0, v1 = acc[ai][bj][m][1] + b1;
#pragma unroll
                        for (int i = 0; i < 4; ++i) { v0[i] = (fminf(v0[i], 0.f) - __logf(1.0f + __expf(-fabsf(v0[i])))) * 0.0625f; v1[i] = (fminf(v1[i], 0.f) - __logf(1.0f + __expf(-fabsf(v1[i])))) * 0.0625f; }
                        float* o = LAT + tile_off(row, c >> 6, (c & 63) >> 3); *(f32x4*)o = v0; *(f32x4*)(o + 4) = v1; } }
        } else if (u.pn == 6 || u.pn == 7) {
            bf16_t* QA = QK + (size_t)(u.pn - 4) * QK_ARR;
#pragma unroll
            for (int ai = 0; ai < 2; ++ai)
#pragma unroll
                for (int m = 0; m < 4; ++m) { const int row = row0 + ai * 128 + m * 16; const int pidx = (row < 256) ? row : 64 + ((row - 256) & (SEQ - 1));
#pragma unroll
                    for (int bj = 0; bj < 2; ++bj) { const int c = cb0 + 128 * bj, d0 = (c & 63) >> 1;
                        const f32x4 cs0 = *(const f32x4*)(rope + (size_t)pidx * 32 + d0), cs1 = *(const f32x4*)(rope + (size_t)pidx * 32 + d0 + 2);
                        const f32x4 t1 = acc[ai][bj][m][0], t2 = acc[ai][bj][m][1];
                        const float co[4] = {cs0[0], cs0[2], cs1[0], cs1[2]}, si[4] = {cs0[1], cs0[3], cs1[1], cs1[3]};
                        float o1[4], o2[4];
#pragma unroll
                        for (int i = 0; i < 4; ++i) { o1[i] = t1[i] * co[i] - t2[i] * si[i]; o2[i] = t1[i] * si[i] + t2[i] * co[i]; }
                        u32x4 w; w.x = pg8::cvt_pk_bf16(o1[0], o1[1]); w.y = pg8::cvt_pk_bf16(o1[2], o1[3]); w.z = pg8::cvt_pk_bf16(o2[0], o2[1]); w.w = pg8::cvt_pk_bf16(o2[2], o2[3]);
                        *(u32x4*)(QA + tile_off(row, c >> 6, (c & 63) >> 3)) = w; } }
        } else if (u.pn <= 1) {
            bf16_t* QA = QK + (size_t)u.pn * QK_ARR;
#pragma unroll
            for (int ai = 0; ai < 2; ++ai)
#pragma unroll
                for (int m = 0; m < 4; ++m) { const int row = row0 + ai * 128 + m * 16;
#pragma unroll
                    for (int bj = 0; bj < 2; ++bj) { const int c = cb0 + 128 * bj; const f32x4 v0 = acc[ai][bj][m][0], v1 = acc[ai][bj][m][1];
                        u32x4 w; w.x = pg8::cvt_pk_bf16(v0[0], v0[1]); w.y = pg8::cvt_pk_bf16(v0[2], v0[3]); w.z = pg8::cvt_pk_bf16(v1[0], v1[1]); w.w = pg8::cvt_pk_bf16(v1[2], v1[3]);
                        *(u32x4*)(QA + tile_off(row, c >> 6, (c & 63) >> 3)) = w; } }
        } else {
            const int cdst = (u.pn < 6 ? (u.pn - 2) : (u.pn - 4)) * 256;
#pragma unroll
            for (int ai = 0; ai < 2; ++ai)
#pragma unroll
                for (int m = 0; m < 4; ++m) { bf16_t* rowp = VG + (size_t)(row0 + ai * 128 + m * 16) * NVG + cdst + cb0;
#pragma unroll
                    for (int bj = 0; bj < 2; ++bj) { const f32x4 v0 = acc[ai][bj][m][0], v1 = acc[ai][bj][m][1];
                        u32x4 w; w.x = pg8::cvt_pk_bf16(v0[0], v0[1]); w.y = pg8::cvt_pk_bf16(v0[2], v0[3]); w.z = pg8::cvt_pk_bf16(v1[0], v1[1]); w.w = pg8::cvt_pk_bf16(v1[2], v1[3]);
                        *(u32x4*)(rowp + bj * 128) = w; } }
        }
    }
};
struct EpiRes {
    static constexpr bool PERM = true, AFTER_DRAIN = false;
    const float* x; bf16_t* HB; float* SSQ;
    __device__ __forceinline__ void operator()(const pg8::f32x4 (&acc)[2][2][4][2], const pg8::Unit& u, int wr, int wc, int fr, int fq) const {
        const int row0 = u.pm * 256 + wr * 64 + fr, col0 = u.pn * 256 + wc * 32 + 8 * fq;
#pragma unroll
        for (int ai = 0; ai < 2; ++ai)
#pragma unroll
            for (int m = 0; m < 4; ++m) { const int row = row0 + ai * 128 + m * 16; const float* xr = x + (size_t)row * DM + col0; bf16_t* hr = HB + (size_t)row * DM + col0; float ss = 0.f;
#pragma unroll
                for (int bj = 0; bj < 2; ++bj) { const f32x4 v0 = acc[ai][bj][m][0] + *(const f32x4*)(xr + bj * 128), v1 = acc[ai][bj][m][1] + *(const f32x4*)(xr + bj * 128 + 4);
                    ss += (v0[0] * v0[0] + v0[1] * v0[1]) + (v0[2] * v0[2] + v0[3] * v0[3]) + (v1[0] * v1[0] + v1[1] * v1[1]) + (v1[2] * v1[2] + v1[3] * v1[3]);
                    u32x4 w; w.x = pg8::cvt_pk_bf16(v0[0], v0[1]); w.y = pg8::cvt_pk_bf16(v0[2], v0[3]); w.z = pg8::cvt_pk_bf16(v1[0], v1[1]); w.w = pg8::cvt_pk_bf16(v1[2], v1[3]);
                    *(u32x4*)(hr + bj * 128) = w; }
                ss += __shfl_xor(ss, 16); ss += __shfl_xor(ss, 32);
                if (fq == 0) SSQ[(size_t)row * 16 + u.pn * 4 + wc] = ss; }
    }
};
struct EpiF16 {
    static constexpr bool PERM = true, AFTER_DRAIN = false;
    _Float16* SC;
    __device__ __forceinline__ void operator()(const pg8::f32x4 (&acc)[2][2][4][2], const pg8::Unit& u, int wr, int wc, int fr, int fq) const {
        const int row0 = u.pm * 256 + wr * 64 + fr, col0 = u.pn * 256 + wc * 32 + 8 * fq;
#pragma unroll
        for (int ai = 0; ai < 2; ++ai)
#pragma unroll
            for (int m = 0; m < 4; ++m) { _Float16* rowp = SC + (size_t)(row0 + ai * 128 + m * 16) * 2048 + col0;
#pragma unroll
                for (int bj = 0; bj < 2; ++bj) { const f32x4 v0 = acc[ai][bj][m][0], v1 = acc[ai][bj][m][1];
                    u32x4 w;
                    w.x = __builtin_bit_cast(unsigned, (f16x2_t){(_Float16)v0[0], (_Float16)v0[1]}); w.y = __builtin_bit_cast(unsigned, (f16x2_t){(_Float16)v0[2], (_Float16)v0[3]});
                    w.z = __builtin_bit_cast(unsigned, (f16x2_t){(_Float16)v1[0], (_Float16)v1[1]}); w.w = __builtin_bit_cast(unsigned, (f16x2_t){(_Float16)v1[2], (_Float16)v1[3]});
                    *(u32x4*)(rowp + bj * 128) = w; } }
    }
};

constexpr int A_QT = 0, A_KT = 9216, A_KE = 18432, A_V = 27648, A_ST = 45056, A_STSZ = 18432, A_OB = 81920, A_DEC = 115712, A_CS = 115968;
constexpr int PQ = 72, PV = 136, POB = 132;

__device__ __forceinline__ bf16x8 tr2(const LAS bf16_t* p0, const LAS bf16_t* p1) {
    const s16x4 a = __builtin_amdgcn_ds_read_tr16_b64_v4i16((LAS s16x4*)p0), b = __builtin_amdgcn_ds_read_tr16_b64_v4i16((LAS s16x4*)p1);
    return (bf16x8){a[0], a[1], a[2], a[3], b[0], b[1], b[2], b[3]};
}
__device__ __forceinline__ float ln_gamma(int hr) { return log1pf(-exp2f(-5.0f - (float)hr)); }

template <bool FULL>
__device__ __forceinline__ void attn_pass(const Params& p, LAS unsigned char* lds, int bid, int nb) {
    const int tid = threadIdx.x, lane = tid & 63, wave = __builtin_amdgcn_readfirstlane(tid >> 6);
    const int r16 = lane & 15, g4 = lane >> 4, q4 = (lane & 15) >> 2, p4 = lane & 3;
    unsigned char* ws = p.ws;
    const bf16_t* PROJ = (const bf16_t*)(ws + WS_PROJ); const float* LA = (const float*)(ws + WS_LA); const bf16_t* QK = (const bf16_t*)(ws + WS_QK);
    float* SEG = (float*)(ws + WS_SEG); float* ASEG = (float*)(ws + WS_ASEG); float* SEGM = (float*)(ws + WS_ASEG + 65536); bf16_t* OUT = (bf16_t*)(ws + WS_O);
    LAS bf16_t* QT = (LAS bf16_t*)(lds + A_QT); LAS bf16_t* KT = (LAS bf16_t*)(lds + A_KT); LAS bf16_t* KE = (LAS bf16_t*)(lds + A_KE); LAS bf16_t* VS = (LAS bf16_t*)(lds + A_V);
    LAS float* OB = (LAS float*)(lds + A_OB); LAS float* DEC = (LAS float*)(lds + A_DEC); LAS float* CS = (LAS float*)(lds + A_CS);

    for (int item = bid; item < 256; item += nb) {
        const int seg = item & 7, h8 = (item >> 3) & 7, b = item >> 6;
        const bool metaitem = !FULL && seg == 7 && b == 0;
        if (!FULL && seg == 7 && !metaitem) continue;
        const bool gla = h8 < 4; const int hr = h8 & 3;
        const float lng = ln_gamma(hr);
        const bf16_t* QAq = QK + (size_t)(gla ? 0 : 2) * QK_ARR; const bf16_t* QAk = QK + (size_t)(gla ? 1 : 3) * QK_ARR;
        const int vcol = (gla ? 0 : 1024) + hr * 128, gcol = (gla ? 512 : 1536) + hr * 128;
        const int nch = metaitem ? 1 : 16;

        f32x4 accS[8];
#pragma unroll
        for (int cb = 0; cb < 8; ++cb) accS[cb] = (f32x4){0.f, 0.f, 0.f, 0.f};
        float blsum[8] = {0.f, 0.f, 0.f, 0.f, 0.f, 0.f, 0.f, 0.f};
        __syncthreads();
        if (FULL) {
            if (wave >= 4) {
                const int wq = wave - 4;
                { const float* Sm = SEGM + (size_t)h8 * 8192;
#pragma unroll
                  for (int cb = 0; cb < 8; ++cb)
#pragma unroll
                      for (int rg = 0; rg < 4; ++rg) accS[cb][rg] = Sm[(16 * wq + 4 * g4 + rg) * 128 + 16 * cb + r16]; }
                for (int sp = 0; sp < seg; ++sp) { const int it2 = (item & ~7) + sp; const float* Sg = SEG + (size_t)it2 * 8192; const float* Ag = ASEG + it2 * 64;
                    float dec[4];
#pragma unroll
                    for (int rg = 0; rg < 4; ++rg) dec[rg] = Ag[16 * wq + 4 * g4 + rg];
#pragma unroll
                    for (int cb = 0; cb < 8; ++cb)
#pragma unroll
                        for (int rg = 0; rg < 4; ++rg) accS[cb][rg] = dec[rg] * accS[cb][rg] + Sg[(16 * wq + 4 * g4 + rg) * 128 + 16 * cb + r16]; }
                LAS bf16_t* ST0 = (LAS bf16_t*)(lds + A_ST);
#pragma unroll
                for (int cb = 0; cb < 8; ++cb) { u32x2 w; w.x = pk2(accS[cb][0], accS[cb][1]); w.y = pk2(accS[cb][2], accS[cb][3]); *(LAS u32x2*)(ST0 + (16 * cb + r16) * PQ + 16 * wq + 4 * g4) = w; }
            }
        }
#define A_ROWBASE(ci_) (metaitem ? 0 : 256 + b * SEQ + (16 * seg + (ci_)) * 64)
        f32x4 lav[2]; u32x4 qv8, kv8; u32x4 vreg[2];
        qv8 = (u32x4){0u, 0u, 0u, 0u};
#define A_LOADCHUNK(ci_) do { const int _rb = A_ROWBASE(ci_); \
            const size_t _to = ((((size_t)(_rb >> 6) * 4 + hr) * 8 + wave) * 64 + lane) * 8;       \
            if (gla) { const f32x4* _lp = (const f32x4*)(LA + _to); lav[0] = _lp[0]; lav[1] = _lp[1]; } \
            else { lav[0] = (f32x4){lng, lng, lng, lng}; lav[1] = lav[0]; } \
            if (FULL) qv8 = *(const u32x4*)(QAq + _to); \
            kv8 = *(const u32x4*)(QAk + _to); \
            { const int vr = tid >> 3, cc = tid & 7; const u32x4* src = (const u32x4*)(PROJ + (size_t)(_rb + vr) * NVG + vcol + cc * 16); vreg[0] = src[0]; vreg[1] = src[1]; } } while (0)
#define A_LBAR() do { asm volatile("s_waitcnt lgkmcnt(0)" ::: "memory"); __builtin_amdgcn_s_barrier(); asm volatile("" ::: "memory"); } while (0)
        A_LOADCHUNK(0);
        f32x4 gnv[4], bsv[4];
        { const float* gptr = (gla ? p.gla_gain : p.ret_gain) + 16 * (tid & 7); const float* bptr = p.ret_bias + 16 * (tid & 7); const float bsc = gla ? 0.f : 1.f;
#pragma unroll
          for (int k4 = 0; k4 < 4; ++k4) { gnv[k4] = *(const f32x4*)(gptr + 4 * k4); bsv[k4] = *(const f32x4*)(bptr + 4 * k4) * bsc; } }
        for (int ci = 0; ci < nch; ++ci) {
            const bool metac = metaitem;
            const int rowbase = A_ROWBASE(ci);
            const LAS bf16_t* STr = (const LAS bf16_t*)(lds + A_ST + (ci & 1) * A_STSZ); LAS bf16_t* STw = (LAS bf16_t*)(lds + A_ST + ((ci + 1) & 1) * A_STSZ);
            u32x4 gpre[2] = {(u32x4){0u, 0u, 0u, 0u}, (u32x4){0u, 0u, 0u, 0u}};
            if (FULL && !metac) { const u32x4* gp = (const u32x4*)(PROJ + (size_t)(rowbase + (tid >> 3)) * NVG + gcol + 16 * (tid & 7)); gpre[0] = gp[0]; gpre[1] = gp[1]; }
            {
                float bc[8];
#pragma unroll
                for (int c = 0; c < 8; ++c) { float v = lav[c >> 2][c & 3];
                    v += __builtin_bit_cast(float, __builtin_amdgcn_update_dpp(0, __builtin_bit_cast(int, v), 0x111, 0xf, 0xf, true));
                    v += __builtin_bit_cast(float, __builtin_amdgcn_update_dpp(0, __builtin_bit_cast(int, v), 0x112, 0xf, 0xf, true));
                    v += __builtin_bit_cast(float, __builtin_amdgcn_update_dpp(0, __builtin_bit_cast(int, v), 0x114, 0xf, 0xf, true));
                    v += __builtin_bit_cast(float, __builtin_amdgcn_update_dpp(0, __builtin_bit_cast(int, v), 0x118, 0xf, 0xf, true));
                    v += __builtin_bit_cast(float, __builtin_amdgcn_update_dpp(0, __builtin_bit_cast(int, v), 0x142, 0xa, 0xf, false));
                    v += __builtin_bit_cast(float, __builtin_amdgcn_update_dpp(0, __builtin_bit_cast(int, v), 0x143, 0xc, 0xf, false));
                    bc[c] = v; }
                float tot[8];
#pragma unroll
                for (int c = 0; c < 8; ++c) { tot[c] = __builtin_bit_cast(float, __builtin_amdgcn_readlane(__builtin_bit_cast(int, bc[c]), 63)); blsum[c] += tot[c]; }
                const unsigned qw[4] = {qv8.x, qv8.y, qv8.z, qv8.w}, kw[4] = {kv8.x, kv8.y, kv8.z, kv8.w};
                unsigned oq[4], ok[4], oe[4];
#pragma unroll
                for (int c2 = 0; c2 < 4; ++c2) { const float k0 = bf_lo(kw[c2]), k1 = bf_hi(kw[c2]);
                    if (FULL) { oq[c2] = pk2(bf_lo(qw[c2]) * __expf(bc[2 * c2]), bf_hi(qw[c2]) * __expf(bc[2 * c2 + 1])); ok[c2] = pk2(k0 * __expf(-bc[2 * c2]), k1 * __expf(-bc[2 * c2 + 1])); }
                    oe[c2] = pk2(k0 * __expf(tot[2 * c2] - bc[2 * c2]), k1 * __expf(tot[2 * c2 + 1] - bc[2 * c2 + 1])); }
                if (FULL) { *(LAS u32x4*)(QT + lane * PQ + 8 * wave) = (u32x4){oq[0], oq[1], oq[2], oq[3]}; *(LAS u32x4*)(KT + lane * PQ + 8 * wave) = (u32x4){ok[0], ok[1], ok[2], ok[3]}; }
                *(LAS u32x4*)(KE + lane * PQ + 8 * wave) = (u32x4){oe[0], oe[1], oe[2], oe[3]};
                if (lane == 63) { *(LAS f32x4*)(DEC + 8 * wave) = (f32x4){__expf(tot[0]), __expf(tot[1]), __expf(tot[2]), __expf(tot[3])};
                                  *(LAS f32x4*)(DEC + 8 * wave + 4) = (f32x4){__expf(tot[4]), __expf(tot[5]), __expf(tot[6]), __expf(tot[7])}; }
                const int vr = tid >> 3, cc = tid & 7; LAS u32x4* dst = (LAS u32x4*)(VS + vr * PV + cc * 16); dst[0] = vreg[0]; dst[1] = vreg[1];
            }
            if (ci + 1 < nch) A_LOADCHUNK(ci + 1);
            A_LBAR();
            if (wave < 4) {
                if (FULL && !metac) {
                    const int w = wave;
                    bf16x8 qf[2];
#pragma unroll
                    for (int s = 0; s < 2; ++s) qf[s] = *(const LAS bf16x8*)(QT + (16 * w + r16) * PQ + 32 * s + 8 * g4);
                    f32x4 att[4];
#pragma unroll
                    for (int jb = 0; jb < 4; ++jb) { att[jb] = (f32x4){0.f, 0.f, 0.f, 0.f};
                        if (jb <= w) {
#pragma unroll
                            for (int s = 0; s < 2; ++s) { const bf16x8 kf = *(const LAS bf16x8*)(KT + (16 * jb + r16) * PQ + 32 * s + 8 * g4);
                                att[jb] = __builtin_amdgcn_mfma_f32_16x16x32_bf16(kf, qf[s], att[jb], 0, 0, 0); }
                            if (jb == w) {
#pragma unroll
                                for (int rg = 0; rg < 4; ++rg) att[jb][rg] = (4 * g4 + rg <= r16) ? att[jb][rg] : 0.f;
                            }
                        } }
                    bf16x8 af[2];
#pragma unroll
                    for (int s = 0; s < 2; ++s) { u32x4 t; t.x = pk2(att[2 * s][0], att[2 * s][1]); t.y = pk2(att[2 * s][2], att[2 * s][3]); t.z = pk2(att[2 * s + 1][0], att[2 * s + 1][1]); t.w = pk2(att[2 * s + 1][2], att[2 * s + 1][3]);
                        af[s] = __builtin_bit_cast(bf16x8, t); }
#pragma unroll
                    for (int cb = 0; cb < 8; ++cb) { f32x4 o = (f32x4){0.f, 0.f, 0.f, 0.f};
#pragma unroll
                        for (int s = 0; s < 2; ++s) {
                            const bf16x8 vf = tr2(VS + (32 * s + 4 * g4 + q4) * PV + 16 * cb + 4 * p4, VS + (32 * s + 16 + 4 * g4 + q4) * PV + 16 * cb + 4 * p4);
                            o = __builtin_amdgcn_mfma_f32_16x16x32_bf16(af[s], vf, o, 0, 0, 0);
                            const bf16x8 sf = *(const LAS bf16x8*)(STr + (16 * cb + r16) * PQ + 32 * s + 8 * g4);
                            o = __builtin_amdgcn_mfma_f32_16x16x32_bf16(qf[s], sf, o, 0, 0, 0); }
#pragma unroll
                        for (int rg = 0; rg < 4; ++rg) OB[(16 * w + 4 * g4 + rg) * POB + 16 * cb + r16] = o[rg]; }
                }
            } else {
                const int wq = wave - 4;
                float dec[4];
#pragma unroll
                for (int rg = 0; rg < 4; ++rg) dec[rg] = DEC[16 * wq + 4 * g4 + rg];
                bf16x8 kef[2];
#pragma unroll
                for (int s = 0; s < 2; ++s) kef[s] = tr2(KE + (32 * s + 8 * g4 + q4) * PQ + 16 * wq + 4 * p4, KE + (32 * s + 8 * g4 + 4 + q4) * PQ + 16 * wq + 4 * p4);
#pragma unroll
                for (int cb = 0; cb < 8; ++cb) {
#pragma unroll
                    for (int rg = 0; rg < 4; ++rg) accS[cb][rg] *= dec[rg];
#pragma unroll
                    for (int s = 0; s < 2; ++s) { const bf16x8 vf = tr2(VS + (32 * s + 8 * g4 + q4) * PV + 16 * cb + 4 * p4, VS + (32 * s + 8 * g4 + 4 + q4) * PV + 16 * cb + 4 * p4);
                        accS[cb] = __builtin_amdgcn_mfma_f32_16x16x32_bf16(kef[s], vf, accS[cb], 0, 0, 0); }
                    if (FULL) { u32x2 w; w.x = pk2(accS[cb][0], accS[cb][1]); w.y = pk2(accS[cb][2], accS[cb][3]); *(LAS u32x2*)(STw + (16 * cb + r16) * PQ + 16 * wq + 4 * g4) = w; }
                }
            }
            A_LBAR();
            if (FULL && !metac) {
                const int i = tid >> 3, cc = tid & 7;
                float o[16];
#pragma unroll
                for (int k4 = 0; k4 < 4; ++k4) { const f32x4 t = *(const LAS f32x4*)(OB + i * POB + 16 * cc + 4 * k4); o[4 * k4] = t[0]; o[4 * k4 + 1] = t[1]; o[4 * k4 + 2] = t[2]; o[4 * k4 + 3] = t[3]; }
                const size_t row = (size_t)(rowbase + i);
                const u32x4 ga = gpre[0], gb2 = gpre[1];
                const unsigned gw[8] = {ga.x, ga.y, ga.z, ga.w, gb2.x, gb2.y, gb2.z, gb2.w};
                float s1 = 0.f, s2 = 0.f;
#pragma unroll
                for (int k = 0; k < 16; ++k) { s1 += o[k]; s2 += o[k] * o[k]; }
#pragma unroll
                for (int m = 1; m < 8; m <<= 1) { s1 += __shfl_xor(s1, m); s2 += __shfl_xor(s2, m); }
                const float mu = gla ? 0.f : s1 * (1.0f / 128.0f);
                const float rs = __builtin_amdgcn_rsqf(fmaxf(s2 * (1.0f / 128.0f) - mu * mu, 0.f) + EPS);
                unsigned ow[8];
#pragma unroll
                for (int k2 = 0; k2 < 8; ++k2) { float y[2];
#pragma unroll
                    for (int e = 0; e < 2; ++e) { const int k = 2 * k2 + e; const float v = (o[k] - mu) * rs * gnv[k >> 2][k & 3] + bsv[k >> 2][k & 3];
                        const float gt = e ? bf_hi(gw[k2]) : bf_lo(gw[k2]); y[e] = v * gt * __builtin_amdgcn_rcpf(1.0f + __expf(-gt)); }
                    ow[k2] = pk2(y[0], y[1]); }
                u32x4* op = (u32x4*)(OUT + (row - 256) * DM + h8 * 128 + 16 * cc);
                op[0] = (u32x4){ow[0], ow[1], ow[2], ow[3]}; op[1] = (u32x4){ow[4], ow[5], ow[6], ow[7]};
            }
        }
        if (!FULL) {
            if (wave >= 4) { const int wq = wave - 4; float* Sg = metaitem ? SEGM + (size_t)h8 * 8192 : SEG + (size_t)item * 8192;
#pragma unroll
                for (int cb = 0; cb < 8; ++cb)
#pragma unroll
                    for (int rg = 0; rg < 4; ++rg) Sg[(16 * wq + 4 * g4 + rg) * 128 + 16 * cb + r16] = accS[cb][rg]; }
            if (lane < 8 && !metaitem) { float bl = blsum[0];
#pragma unroll
                for (int c = 1; c < 8; ++c) bl = (lane == c) ? blsum[c] : bl;
                ASEG[item * 64 + 8 * wave + lane] = __expf(bl); }
        }
#undef A_LBAR
#undef A_ROWBASE
#undef A_LOADCHUNK
    }
}

__device__ __forceinline__ unsigned ord32(float f) { const unsigned b = __builtin_bit_cast(unsigned, f); return b ^ ((b >> 31) ? 0xffffffffu : 0x80000000u); }
__device__ __forceinline__ float unord32(unsigned o) { const unsigned b = (o >> 31) ? (o ^ 0x80000000u) : ~o; return __builtin_bit_cast(float, b); }
#define DPP_MAXU(v, ctrl, rmask) do { const unsigned _t = (unsigned)__builtin_amdgcn_update_dpp((int)(v), (int)(v), (ctrl), (rmask), 0xf, false); (v) = (v) > _t ? (v) : _t; } while (0)
#define DPP_ADDF(v, ctrl) do { const float _t = __builtin_bit_cast(float, __builtin_amdgcn_update_dpp(0, __builtin_bit_cast(int, (v)), (ctrl), 0xf, 0xf, false)); (v) += _t; } while (0)
__device__ __forceinline__ unsigned row_max_u(unsigned v) { DPP_MAXU(v, 0xB1, 0xf); DPP_MAXU(v, 0x4E, 0xf); DPP_MAXU(v, 0x124, 0xf); DPP_MAXU(v, 0x128, 0xf); return v; }
__device__ __forceinline__ float row_sum_f(float v) { DPP_ADDF(v, 0xB1); DPP_ADDF(v, 0x4E); DPP_ADDF(v, 0x124); DPP_ADDF(v, 0x128); return v; }
__device__ __forceinline__ unsigned wave_max_u(unsigned v) { v = row_max_u(v); DPP_MAXU(v, 0x142, 0xa); DPP_MAXU(v, 0x143, 0xc); return (unsigned)__builtin_amdgcn_readlane((int)v, 63); }

__device__ __forceinline__ float row_sum_x(float v) { return row_sum_f(v); }
__device__ __forceinline__ float dot2_bf16(unsigned w, unsigned x, float acc) { return __builtin_amdgcn_fdot2_f32_bf16(__builtin_bit_cast(bf16x2_t, w), __builtin_bit_cast(bf16x2_t, x), acc, false); }
__device__ __forceinline__ float gelu_exact(float v) { return 0.5f * v * (1.0f + erff(v * 0.70710678118654752f)); }

__device__ __forceinline__ void phase_peer(const Params& p, LAS unsigned char* lds, int bid, int nb) {
    const int tid = threadIdx.x, lane = tid & 63, wave = __builtin_amdgcn_readfirstlane(tid >> 6);
    const int p16 = lane & 15, rg4 = lane >> 4;
    unsigned char* ws = p.ws;
    const _Float16* SC = (const _Float16*)(ws + WS_PROJ); const bf16_t* HB = (const bf16_t*)(ws + WS_XN); const float* SSQ = (const float*)(ws + WS_SSQ);
    const unsigned char* UB = (const unsigned char*)(ws + WS_UB); const unsigned char* VB = (const unsigned char*)(ws + WS_VB);
    LAS float* A_s = (LAS float*)(lds + wave * 4096);
    LAS int* A_i = (LAS int*)(lds + wave * 4096 + 1024);
    LAS int* E_i = (LAS int*)(lds + wave * 4096 + 2048);
    LAS float* E_s = (LAS float*)(lds + wave * 4096 + 2560);
    int ci = 0, cj = 0; bool cvalid = lane < 50;
    { int l = lane;
      if (l < 16) { ci = 0; cj = l; } else if (l < 24) { ci = 1; cj = l - 16; } else if (l < 29) { ci = 2; cj = l - 24; } else if (l < 33) { ci = 3; cj = l - 29; }
      else if (l < 36) { ci = 4; cj = l - 33; } else if (l < 42) { ci = 5 + (l - 36) / 2; cj = (l - 36) & 1; } else { ci = 8 + (l - 42); cj = 0; } if (!cvalid) { ci = 0; cj = 0; } }
    const int gw = bid * 8 + wave, NGW = nb * 8;
    for (int t = gw; t < NTOK; t += NGW) {
        float ssq = (lane < 16) ? SSQ[(size_t)t * 16 + lane] : 0.f; ssq = wave_sum(ssq);
        const float rstd = 1.0f / sqrtf(ssq * (1.0f / DM) + EPS);
#pragma unroll 1
        for (int q = 0; q < 4; ++q) {
            const u32x4 raw = *(const u32x4*)(SC + (size_t)t * 2048 + 512 * q + 8 * lane);
            const unsigned rw[4] = {raw.x, raw.y, raw.z, raw.w};
            unsigned key[8];
#pragma unroll
            for (int e = 0; e < 8; ++e) { const unsigned hbits = (e & 1) ? (rw[e >> 1] >> 16) : (rw[e >> 1] & 0xffffu);
                const float f = (float)__builtin_bit_cast(_Float16, (unsigned short)hbits);
                key[e] = (ord32(f) & ~0x7fu) | (unsigned)(127 - (8 * p16 + e)); }
            unsigned mine = 0u;
#pragma unroll 1
            for (int it = 0; it < 16; ++it) {
                unsigned m = key[0];
#pragma unroll
                for (int e = 1; e < 8; ++e) m = m > key[e] ? m : key[e];
                const unsigned W = row_max_u(m);
                mine = (p16 == it) ? W : mine;
#pragma unroll
                for (int e = 0; e < 8; ++e) key[e] = (key[e] == W) ? 0u : key[e];
            }
            const int g = 4 * q + rg4;
            A_s[g * 16 + p16] = unord32(mine & ~0x7fu); A_i[g * 16 + p16] = 127 - (int)(mine & 0x7fu);
        }
        LDS_WAIT();
#pragma unroll 1
        for (int h = 0; h < 8; ++h) {
            const float sa = A_s[(2 * h) * 16 + ci], sb = A_s[(2 * h + 1) * 16 + cj];
            const int ia = A_i[(2 * h) * 16 + ci], ib = A_i[(2 * h + 1) * 16 + cj];
            const float sum = sa + sb;
            unsigned key = cvalid ? ((ord32(sum) & ~0x3fu) | (unsigned)(63 - lane)) : 0u;
            int rank = -1;
#pragma unroll 1
            for (int it = 0; it < 16; ++it) { const unsigned W = wave_max_u(key); if (key == W) { rank = it; key = 0u; } }
            if (rank >= 0) { E_i[h * 16 + rank] = ia * 128 + ib; E_s[h * 16 + rank] = sum; }
        }
        LDS_WAIT();
        float gsm[2]; int eidx[2];
#pragma unroll
        for (int sl = 0; sl < 2; ++sl) { const int e = lane + 64 * sl; const float s = E_s[e] * rstd, mx = E_s[e & ~15] * rstd; const float pe = __expf(s - mx); const float den = row_sum_x(pe);
            gsm[sl] = pe / den; eidx[sl] = E_i[e]; }
#if PEER_FP8
        f32x2v xf[4][8];
#pragma unroll
        for (int i = 0; i < 4; ++i) { const u32x4 h0 = *(const u32x4*)(HB + (size_t)t * DM + 256 * i + 16 * p16), h1 = *(const u32x4*)(HB + (size_t)t * DM + 256 * i + 16 * p16 + 8);
            const unsigned hv[8] = {h0.x, h0.y, h0.z, h0.w, h1.x, h1.y, h1.z, h1.w}; const float* gp = p.g2 + 256 * i + 16 * p16;
#pragma unroll
            for (int k2 = 0; k2 < 8; ++k2) { const f32x2v g = *(const f32x2v*)(gp + 2 * k2); xf[i][k2] = (f32x2v){bf_lo(hv[k2]) * rstd * g.x, bf_hi(hv[k2]) * rstd * g.y}; } }
        constexpr int NBB = 2;
#define P6_LOADB(buf, TAB, bt0) do { _Pragma("unroll") for (int j = 0; j < NBB; ++j) { const int bt = (bt0) + j; const int ex = E_i[64 * (bt >> 4) + 16 * rg4 + (bt & 15)]; \
            const unsigned char* rp = (TAB) + (size_t)ex * 1024 + 16 * p16; _Pragma("unroll") for (int i = 0; i < 4; ++i) buf[j][i] = *(const u32x4*)(rp + 256 * i); } } while (0)
        u32x4 bA[NBB][4], bB[NBB][4];
        float act0 = 0.f, act1 = 0.f;
#define P6_COMPU(buf, bt0) do { _Pragma("unroll") for (int j = 0; j < NBB; ++j) { const int bt = (bt0) + j; f32x2v s2 = (f32x2v){0.f, 0.f}; \
            _Pragma("unroll") for (int i = 0; i < 4; ++i) { const unsigned uu[4] = {buf[j][i].x, buf[j][i].y, buf[j][i].z, buf[j][i].w}; \
                _Pragma("unroll") for (int w = 0; w < 4; ++w) { const f32x2v lo = __builtin_amdgcn_cvt_pk_f32_fp8((int)uu[w], false), hi = __builtin_amdgcn_cvt_pk_f32_fp8((int)uu[w], true); \
                    s2 = __builtin_elementwise_fma(lo, xf[i][2 * w], s2); s2 = __builtin_elementwise_fma(hi, xf[i][2 * w + 1], s2); } } \
            const float s = row_sum_x(s2.x + s2.y); const bool mine = (p16 == (bt & 15)); act0 = (mine && bt < 16) ? s : act0; act1 = (mine && bt >= 16) ? s : act1; } } while (0)
        P6_LOADB(bA, UB, 0);
#pragma unroll 1
        for (int g = 0; g < 32; g += 2 * NBB) { P6_LOADB(bB, UB, g + NBB); P6_COMPU(bA, g); if (g + 2 * NBB < 32) P6_LOADB(bA, UB, g + 2 * NBB); P6_COMPU(bB, g + NBB); }
        P6_LOADB(bA, VB, 0);
        LAS float* E_c = E_s;
        { const float c0 = gsm[0] * gelu_exact(act0 * (1.0f / 512.0f)) * (1.0f / 32.0f), c1 = gsm[1] * gelu_exact(act1 * (1.0f / 512.0f)) * (1.0f / 32.0f);
          LDS_WAIT(); E_c[lane] = c0; E_c[lane + 64] = c1; LDS_WAIT(); }
        f32x2v acc2[4][8];
#pragma unroll
        for (int i = 0; i < 4; ++i)
#pragma unroll
            for (int k = 0; k < 8; ++k) acc2[i][k] = (f32x2v){0.f, 0.f};
#define P6_COMPV(buf, bt0) do { _Pragma("unroll") for (int j = 0; j < NBB; ++j) { const int bt = (bt0) + j; const float cf = E_c[64 * (bt >> 4) + 16 * rg4 + (bt & 15)]; const f32x2v cf2 = (f32x2v){cf, cf}; \
            _Pragma("unroll") for (int i = 0; i < 4; ++i) { const unsigned vv[4] = {buf[j][i].x, buf[j][i].y, buf[j][i].z, buf[j][i].w}; \
                _Pragma("unroll") for (int w = 0; w < 4; ++w) { const f32x2v lo = __builtin_amdgcn_cvt_pk_f32_fp8((int)vv[w], false), hi = __builtin_amdgcn_cvt_pk_f32_fp8((int)vv[w], true); \
                    acc2[i][2 * w] = __builtin_elementwise_fma(lo, cf2, acc2[i][2 * w]); acc2[i][2 * w + 1] = __builtin_elementwise_fma(hi, cf2, acc2[i][2 * w + 1]); } } } } while (0)
#pragma unroll 1
        for (int g = 0; g < 32; g += 2 * NBB) { P6_LOADB(bB, VB, g + NBB); P6_COMPV(bA, g); if (g + 2 * NBB < 32) P6_LOADB(bA, VB, g + 2 * NBB); P6_COMPV(bB, g + NBB); }
#undef P6_LOADB
#undef P6_COMPU
#undef P6_COMPV
        float ss = 0.f;
#pragma unroll
        for (int i = 0; i < 4; ++i) { const u32x4 h0 = *(const u32x4*)(HB + (size_t)t * DM + 256 * i + 16 * p16), h1 = *(const u32x4*)(HB + (size_t)t * DM + 256 * i + 16 * p16 + 8);
            const unsigned hv[8] = {h0.x, h0.y, h0.z, h0.w, h1.x, h1.y, h1.z, h1.w};
#pragma unroll
            for (int k2 = 0; k2 < 8; ++k2) { float ax = acc2[i][k2].x, ay = acc2[i][k2].y;
                ax += __shfl_xor(ax, 16); ax += __shfl_xor(ax, 32); ay += __shfl_xor(ay, 16); ay += __shfl_xor(ay, 32);
                ax += bf_lo(hv[k2]); ay += bf_hi(hv[k2]); acc2[i][k2] = (f32x2v){ax, ay}; ss += ax * ax + ay * ay; } }
        ss = row_sum_x(ss);
        const float rf = 1.0f / sqrtf(ss * (1.0f / DM) + EPS);
#pragma unroll
        for (int i = 0; i < 4; ++i) { if (i == rg4) { const float* gp = p.gfin + 256 * i + 16 * p16; float* op = p.out + (size_t)t * DM + 256 * i + 16 * p16;
#pragma unroll
                for (int k4 = 0; k4 < 4; ++k4) { const f32x4 g = *(const f32x4*)(gp + 4 * k4);
                    *(f32x4*)(op + 4 * k4) = (f32x4){acc2[i][2 * k4].x * rf * g[0], acc2[i][2 * k4].y * rf * g[1], acc2[i][2 * k4 + 1].x * rf * g[2], acc2[i][2 * k4 + 1].y * rf * g[3]}; } } }
#else
        unsigned xp[8][4];
#pragma unroll
        for (int i = 0; i < 8; ++i) { const u32x4 hw = *(const u32x4*)(HB + (size_t)t * DM + 128 * i + 8 * p16); const f32x4 ga = *(const f32x4*)(p.g2 + 128 * i + 8 * p16), gb = *(const f32x4*)(p.g2 + 128 * i + 8 * p16 + 4);
            xp[i][0] = pk2(bf_lo(hw.x) * rstd * ga[0], bf_hi(hw.x) * rstd * ga[1]); xp[i][1] = pk2(bf_lo(hw.y) * rstd * ga[2], bf_hi(hw.y) * rstd * ga[3]);
            xp[i][2] = pk2(bf_lo(hw.z) * rstd * gb[0], bf_hi(hw.z) * rstd * gb[1]); xp[i][3] = pk2(bf_lo(hw.w) * rstd * gb[2], bf_hi(hw.w) * rstd * gb[3]); }
        float act[2] = {0.f, 0.f};
#pragma unroll
        for (int sl = 0; sl < 2; ++sl) {
#pragma unroll 2
            for (int b16 = 0; b16 < 16; ++b16) {
                const int e = 64 * sl + 16 * rg4 + b16; const int ex = E_i[e];
                const unsigned char* rowp = UB + (size_t)ex * 2048 + 16 * p16;
                float s = 0.f;
#pragma unroll
                for (int i = 0; i < 8; ++i) { const u32x4 uw = *(const u32x4*)(rowp + 256 * i);
                    s = dot2_bf16(uw.x, xp[i][0], s); s = dot2_bf16(uw.y, xp[i][1], s); s = dot2_bf16(uw.z, xp[i][2], s); s = dot2_bf16(uw.w, xp[i][3], s); }
                s = row_sum_x(s);
                act[sl] = (p16 == b16) ? s : act[sl];
            }
        }
        float coef[2];
#pragma unroll
        for (int sl = 0; sl < 2; ++sl) coef[sl] = gsm[sl] * gelu_exact(act[sl]);
        float acc[8][8];
#pragma unroll
        for (int i = 0; i < 8; ++i)
#pragma unroll
            for (int k = 0; k < 8; ++k) acc[i][k] = 0.f;
#pragma unroll
        for (int sl = 0; sl < 2; ++sl) {
#pragma unroll 2
            for (int b16 = 0; b16 < 16; ++b16) {
                const int srcl = (lane & 48) + b16;
                const float cf = __shfl(coef[sl], srcl); const int ex = __shfl(eidx[sl], srcl);
                const unsigned char* rowp = VB + (size_t)ex * 2048 + 16 * p16;
#pragma unroll
                for (int i = 0; i < 8; ++i) { const u32x4 vw = *(const u32x4*)(rowp + 256 * i);
                    acc[i][0] += cf * bf_lo(vw.x); acc[i][1] += cf * bf_hi(vw.x); acc[i][2] += cf * bf_lo(vw.y); acc[i][3] += cf * bf_hi(vw.y);
                    acc[i][4] += cf * bf_lo(vw.z); acc[i][5] += cf * bf_hi(vw.z); acc[i][6] += cf * bf_lo(vw.w); acc[i][7] += cf * bf_hi(vw.w); }
            }
        }
        float ss = 0.f;
#pragma unroll
        for (int i = 0; i < 8; ++i) { const u32x4 hw = *(const u32x4*)(HB + (size_t)t * DM + 128 * i + 8 * p16); const unsigned hv[4] = {hw.x, hw.y, hw.z, hw.w};
#pragma unroll
            for (int k = 0; k < 8; ++k) { float a = acc[i][k]; a += __shfl_xor(a, 16); a += __shfl_xor(a, 32);
                a += (k & 1) ? bf_hi(hv[k >> 1]) : bf_lo(hv[k >> 1]); acc[i][k] = a; ss += a * a; } }
        ss = row_sum_x(ss);
        const float rf = 1.0f / sqrtf(ss * (1.0f / DM) + EPS);
#pragma unroll
        for (int i = 0; i < 8; ++i) { if ((i >> 1) == rg4) { const f32x4 ga = *(const f32x4*)(p.gfin + 128 * i + 8 * p16), gb = *(const f32x4*)(p.gfin + 128 * i + 8 * p16 + 4);
                float* op = p.out + (size_t)t * DM + 128 * i + 8 * p16;
                *(f32x4*)op = (f32x4){acc[i][0] * rf * ga[0], acc[i][1] * rf * ga[1], acc[i][2] * rf * ga[2], acc[i][3] * rf * ga[3]};
                *(f32x4*)(op + 4) = (f32x4){acc[i][4] * rf * gb[0], acc[i][5] * rf * gb[1], acc[i][6] * rf * gb[2], acc[i][7] * rf * gb[3]}; } }
#endif
        LDS_WAIT();
    }
}


__device__ __forceinline__ void row_max4(unsigned k0, unsigned k1, unsigned k2, unsigned k3, unsigned& w0, unsigned& w1, unsigned& w2, unsigned& w3) {
    asm volatile("s_nop 1\n\t"
                 "v_max_u32_dpp %0, %4, %4 quad_perm:[1,0,3,2] row_mask:0xf bank_mask:0xf\n\t"
                 "v_max_u32_dpp %1, %5, %5 quad_perm:[1,0,3,2] row_mask:0xf bank_mask:0xf\n\t"
                 "v_max_u32_dpp %2, %6, %6 quad_perm:[1,0,3,2] row_mask:0xf bank_mask:0xf\n\t"
                 "v_max_u32_dpp %3, %7, %7 quad_perm:[1,0,3,2] row_mask:0xf bank_mask:0xf\n\t"
                 "v_max_u32_dpp %0, %0, %0 quad_perm:[2,3,0,1] row_mask:0xf bank_mask:0xf\n\t"
                 "v_max_u32_dpp %1, %1, %1 quad_perm:[2,3,0,1] row_mask:0xf bank_mask:0xf\n\t"
                 "v_max_u32_dpp %2, %2, %2 quad_perm:[2,3,0,1] row_mask:0xf bank_mask:0xf\n\t"
                 "v_max_u32_dpp %3, %3, %3 quad_perm:[2,3,0,1] row_mask:0xf bank_mask:0xf\n\t"
                 "v_max_u32_dpp %0, %0, %0 row_ror:4 row_mask:0xf bank_mask:0xf\n\t"
                 "v_max_u32_dpp %1, %1, %1 row_ror:4 row_mask:0xf bank_mask:0xf\n\t"
                 "v_max_u32_dpp %2, %2, %2 row_ror:4 row_mask:0xf bank_mask:0xf\n\t"
                 "v_max_u32_dpp %3, %3, %3 row_ror:4 row_mask:0xf bank_mask:0xf\n\t"
                 "v_max_u32_dpp %0, %0, %0 row_ror:8 row_mask:0xf bank_mask:0xf\n\t"
                 "v_max_u32_dpp %1, %1, %1 row_ror:8 row_mask:0xf bank_mask:0xf\n\t"
                 "v_max_u32_dpp %2, %2, %2 row_ror:8 row_mask:0xf bank_mask:0xf\n\t"
                 "v_max_u32_dpp %3, %3, %3 row_ror:8 row_mask:0xf bank_mask:0xf\n\t"
                 "s_nop 1"
                 : "=&v"(w0), "=&v"(w1), "=&v"(w2), "=&v"(w3) : "v"(k0), "v"(k1), "v"(k2), "v"(k3));
}
__device__ __forceinline__ unsigned pkadd_h2(unsigned a, unsigned b) { const h2v x = __builtin_bit_cast(h2v, a), y = __builtin_bit_cast(h2v, b); const h2v s = x + y; return __builtin_bit_cast(unsigned, s); }
constexpr int NT6 = 8;
constexpr int W6_BYTES = 16640;
__device__ __forceinline__ float dpp_f(float v, int ctrl_dummy);
#define DPPF(v, ctrl) __builtin_bit_cast(float, __builtin_amdgcn_update_dpp(0, __builtin_bit_cast(int, (v)), (ctrl), 0xf, 0xf, false))

__device__ __forceinline__ void phase_peer2(const Params& p, LAS unsigned char* lds, int bid, int nb) {
    const int tid = threadIdx.x, lane = tid & 63, wave = __builtin_amdgcn_readfirstlane(tid >> 6);
    const int p16 = lane & 15, rg4 = lane >> 4, q8 = lane >> 3, p8 = lane & 7;
    const bool b0 = lane & 1, b1 = lane & 2, b2 = lane & 4, c0 = lane & 8, c1 = lane & 16, c2 = lane & 32;
    unsigned char* ws = p.ws;
    const _Float16* SC = (const _Float16*)(ws + WS_PROJ); const bf16_t* HB = (const bf16_t*)(ws + WS_XN); const float* SSQ = (const float*)(ws + WS_SSQ);
    const unsigned char* UB = (const unsigned char*)(ws + WS_UB); const unsigned char* VB = (const unsigned char*)(ws + WS_VB); unsigned char* XQ = ws + WS_XQ;
    LAS unsigned char* wl = lds + wave * W6_BYTES;
    LAS unsigned* CW = (LAS unsigned*)wl;
    LAS unsigned char* XL = wl;
    LAS unsigned short* E16 = (LAS unsigned short*)(wl + 8192);
    LAS _Float16* GC = (LAS _Float16*)(wl + 10240);
    LAS unsigned* E32 = (LAS unsigned*)(wl + 4096);
    LAS float* ACT = (LAS float*)(wl + 12288);
    LAS float* RS = (LAS float*)(wl + 16384);
    const unsigned kbase[4] = {12288u + 4u * lane, 14336u + 4u * lane, 6144u + 4u * lane, ((lane >> 5) ? 5120u : 2048u) + 4u * (lane & 31)};
    constexpr unsigned kshift[4] = {8u, 8u, 8u, 7u};
    unsigned ixc[8];
#pragma unroll
    for (int e = 0; e < 8; ++e) ixc[e] = (unsigned)(127 - (8 * p16 + e));
    int ci = 0, cj = 0; bool cvalid = lane < 50;
    { int l = lane;
      if (l < 16) { ci = 0; cj = l; } else if (l < 24) { ci = 1; cj = l - 16; } else if (l < 29) { ci = 2; cj = l - 24; } else if (l < 33) { ci = 3; cj = l - 29; }
      else if (l < 36) { ci = 4; cj = l - 33; } else if (l < 42) { ci = 5 + (l - 36) / 2; cj = (l - 36) & 1; } else { ci = 8 + (l - 42); cj = 0; } if (!cvalid) { ci = 0; cj = 0; } }
    const int gw = bid * 8 + wave, NGW = nb * 8;
#define TOK6(k) min(base + (k) * NGW, NTOK - 1)
    for (int base = gw; base < NTOK; base += NT6 * NGW) {
#pragma unroll 1
        for (int rep_r = 0; rep_r < PROBE_R; ++rep_r)
#pragma unroll 1
        for (int k = 0; k < NT6; k += 2) {
            u32x4 raw[2][4]; float rstd[2];
#pragma unroll
            for (int v = 0; v < 2; ++v) { const int t = TOK6(k + v);
#pragma unroll
                for (int q = 0; q < 4; ++q) raw[v][q] = *(const u32x4*)(SC + (size_t)t * 2048 + 512 * q + 8 * lane);
                float ssq = (lane < 16) ? SSQ[(size_t)t * 16 + lane] : 0.f; ssq = wave_sum(ssq);
                rstd[v] = 1.0f / sqrtf(ssq * (1.0f / DM) + EPS);
                { const u32x4 ha = *(const u32x4*)(HB + (size_t)t * DM + 16 * lane), hb = *(const u32x4*)(HB + (size_t)t * DM + 16 * lane + 8); const float sc = rstd[v] * 16.0f;
                  const unsigned hv[8] = {ha.x, ha.y, ha.z, ha.w, hb.x, hb.y, hb.z, hb.w}; unsigned xw[4];
#pragma unroll
                  for (int w = 0; w < 4; ++w) { int pk = __builtin_amdgcn_cvt_pk_fp8_f32(bf_lo(hv[2 * w]) * sc, bf_hi(hv[2 * w]) * sc, 0, false);
                      pk = __builtin_amdgcn_cvt_pk_fp8_f32(bf_lo(hv[2 * w + 1]) * sc, bf_hi(hv[2 * w + 1]) * sc, pk, true); xw[w] = (unsigned)pk; }
                  *(u32x4*)(XQ + (size_t)t * DM + 16 * lane) = (u32x4){xw[0], xw[1], xw[2], xw[3]}; } }
#pragma unroll
            for (int qq = 0; qq < 2; ++qq) {
                unsigned ka[4][8];
#pragma unroll
                for (int c = 0; c < 4; ++c) { const u32x4 rv = raw[c >> 1][2 * qq + (c & 1)]; const unsigned rw[4] = {rv.x, rv.y, rv.z, rv.w};
#pragma unroll
                    for (int i = 0; i < 4; ++i) {
                        const s16x2 hv2 = __builtin_bit_cast(s16x2, rw[i]); const s16x2 sg = hv2 >> 15; const unsigned kk = rw[i] ^ (__builtin_bit_cast(unsigned, sg) | 0x80008000u);
                        ka[c][2 * i] = (kk << 16) | ixc[2 * i]; ka[c][2 * i + 1] = (kk & 0xffff0000u) | ixc[2 * i + 1]; } }
#define CE6(u, i, j) do { const unsigned _a = ka[u][i], _b = ka[u][j]; ka[u][i] = _a > _b ? _a : _b; ka[u][j] = _a > _b ? _b : _a; } while (0)
#pragma unroll
                for (int u = 0; u < 4; ++u) {
                    CE6(u, 0, 1); CE6(u, 2, 3); CE6(u, 4, 5); CE6(u, 6, 7);
                    CE6(u, 0, 2); CE6(u, 1, 3); CE6(u, 4, 6); CE6(u, 5, 7);
                    CE6(u, 1, 2); CE6(u, 5, 6);
                    CE6(u, 0, 4); CE6(u, 1, 5); CE6(u, 2, 6); CE6(u, 3, 7);
                    CE6(u, 2, 4); CE6(u, 3, 5);
                    CE6(u, 1, 2); CE6(u, 3, 4); CE6(u, 5, 6);
                }
#undef CE6
                unsigned mine[4] = {0u, 0u, 0u, 0u};
                unsigned head[4], nxt[4], kptr[4] = {0u, 0u, 0u, 0u};
#pragma unroll
                for (int c = 0; c < 4; ++c) { head[c] = ka[c][0]; nxt[c] = ka[c][1];
#pragma unroll
                    for (int j = 0; j < 8; ++j) *(LAS unsigned*)(wl + kbase[c] + (j << kshift[c])) = (j < 7) ? ka[c][j + 1] : 0u; }
#pragma unroll 1
                for (int it = 0; it < 16; ++it) {
                    unsigned Wv[4]; row_max4(head[0], head[1], head[2], head[3], Wv[0], Wv[1], Wv[2], Wv[3]);
#pragma unroll
                    for (int c = 0; c < 4; ++c) {
                        const unsigned W = Wv[c];
                        mine[c] = (p16 == it) ? W : mine[c];
                        const bool win = (head[c] == W);
                        head[c] = win ? nxt[c] : head[c];
                        kptr[c] += win ? 1u : 0u;
                        nxt[c] = *(const LAS unsigned*)(wl + kbase[c] + (kptr[c] << kshift[c]));
                    }
                }
#pragma unroll
                for (int c = 0; c < 4; ++c) { const int g = 4 * (2 * qq + (c & 1)) + rg4; LAS int* A_s = (LAS int*)(wl + 3072 * (c >> 1)); LAS int* A_i = (LAS int*)(wl + 3072 * (c >> 1) + 1024);
                    const unsigned k16 = mine[c] >> 16; const unsigned hbits = k16 ^ ((k16 & 0x8000u) ? 0x8000u : 0xffffu);
                    const float fs = (float)__builtin_bit_cast(_Float16, (unsigned short)hbits);
                    A_s[g * 16 + p16] = (int)__builtin_rintf(fs * 16384.0f); A_i[g * 16 + p16] = 127 - (int)(mine[c] & 0x7fu); }
            }
            LDS_WAIT();
            {
                int av[4], bc[4]; int iav[4], ibc[4], jp[4], hh[4], bb[4]; unsigned key[4];
#pragma unroll
                for (int c = 0; c < 4; ++c) { const LAS int* A_s = (const LAS int*)(wl + 3072 * (c >> 1)); const LAS int* A_i = (const LAS int*)(wl + 3072 * (c >> 1) + 1024);
                    hh[c] = 4 * (c & 1) + rg4; bb[c] = (2 * hh[c] + 1) * 16; av[c] = A_s[(2 * hh[c]) * 16 + p16] + (1 << 20); iav[c] = A_i[(2 * hh[c]) * 16 + p16] * 128; jp[c] = 0; bc[c] = A_s[bb[c]]; ibc[c] = A_i[bb[c]];
                    key[c] = ((unsigned)(av[c] + bc[c]) << 4) | (unsigned)(15 - p16); }
#pragma unroll 1
                for (int it = 0; it < 16; ++it) {
                    unsigned Wv[4]; row_max4(key[0], key[1], key[2], key[3], Wv[0], Wv[1], Wv[2], Wv[3]);
#pragma unroll
                    for (int c = 0; c < 4; ++c) {
                        const LAS int* A_s = (const LAS int*)(wl + 3072 * (c >> 1)); const LAS int* A_i = (const LAS int*)(wl + 3072 * (c >> 1) + 1024);
                        LAS int* E_i = (LAS int*)(wl + 3072 * (c >> 1) + 2048); LAS int* E_s = (LAS int*)(wl + 3072 * (c >> 1) + 2560);
                        const bool win = (key[c] == Wv[c]);
                        if (win) { E_i[hh[c] * 16 + it] = iav[c] + ibc[c]; E_s[hh[c] * 16 + it] = av[c] + bc[c]; }
                        jp[c] += win ? 1 : 0;
                        const int jr = jp[c] < 16 ? jp[c] : 15;
                        bc[c] = A_s[bb[c] + jr]; ibc[c] = A_i[bb[c] + jr];
                        key[c] = jp[c] < 16 ? (((unsigned)(av[c] + bc[c]) << 4) | (unsigned)(15 - p16)) : 0u;
                    }
                }
            }
            LDS_WAIT();
#pragma unroll
            for (int v = 0; v < 2; ++v) { const LAS int* E_i = (const LAS int*)(wl + 3072 * v + 2048); const LAS int* E_s = (const LAS int*)(wl + 3072 * v + 2560);
#pragma unroll
                for (int sl = 0; sl < 2; ++sl) { const int e = lane + 64 * sl; const float pe = __expf((float)(E_s[e] - E_s[e & ~15]) * (rstd[v] * (1.0f / 16384.0f))); const float den = row_sum_x(pe);
                    const int pos = 16 * (e & 7) + (e >> 3);
                    GC[(k + v) * 128 + pos] = (_Float16)(pe / den); E16[(k + v) * 128 + pos] = (unsigned short)E_i[e]; }
                if (lane == 0) RS[k + v] = rstd[v]; }
            LDS_WAIT();
        }
#define P6_LOADH(buf, TAB, jj, kk, hh) do { const u32x4 _iv = *(const LAS u32x4*)(E16 + (kk) * 128 + 16 * q8 + 8 * (hh)); const unsigned _iw[4] = {_iv.x, _iv.y, _iv.z, _iv.w}; \
            _Pragma("unroll") for (int c = 0; c < 8; ++c) { const unsigned _idx = (c & 1) ? (_iw[c >> 1] >> 16) : (_iw[c >> 1] & 0xffffu); \
                buf[c] = *(const u32x4*)((TAB) + (((size_t)(jj) * NEXP + _idx) << 7) + 16 * p8); } } while (0)
#define P6_LOADX(hb, jj, kk) do { const bf16_t* _hp = HB + (size_t)TOK6(kk) * DM + 128 * (jj) + 16 * p8; hb[0] = *(const u32x4*)_hp; hb[1] = *(const u32x4*)(_hp + 8); } while (0)
        asm volatile("s_waitcnt vmcnt(0)" ::: "memory");
        { u32x4 xr[NT6];
#pragma unroll
          for (int k = 0; k < NT6; ++k) xr[k] = *(const u32x4*)(XQ + (size_t)TOK6(k) * DM + 16 * lane);
#pragma unroll
          for (int k = 0; k < NT6; ++k) *(LAS u32x4*)(XL + k * 1024 + 16 * lane) = xr[k]; }
        LDS_WAIT();
#pragma unroll 1
        for (int rep_u = 0; rep_u < PROBE_U; ++rep_u) {
            for (int k = 0; k < NT6; ++k) { ACT[k * 128 + lane] = 0.f; ACT[k * 128 + 64 + lane] = 0.f; }
            LDS_WAIT();
            const int n16 = lane & 15, g4 = lane >> 4, c4 = lane & 3, r16 = 4 * g4 + (n16 >> 2);
            const int eoff = 2 * (16 * (r16 & 7) + (r16 >> 3));
            const bool xkeep = ((g4 >> 1) == ((n16 >> 2) & 1)); const bool klo = xkeep && (n16 < 8), khi = xkeep && (n16 >= 8);
            u32x4 bfP[16], bfQ[16];
#define P6_ULOAD(buf, nn) do { const int _j = (nn) / NT6, _k = (nn) % NT6; const LAS unsigned char* _ip = (const LAS unsigned char*)(E16 + _k * 128) + eoff; \
                _Pragma("unroll") for (int T = 0; T < 8; ++T) { const unsigned _idx = *(const LAS unsigned short*)(_ip + 4 * T); \
                    const unsigned char* _rp = UB + (((size_t)_j * NEXP + _idx) << 7) + 16 * c4; buf[2 * T] = *(const u32x4*)_rp; buf[2 * T + 1] = *(const u32x4*)(_rp + 64); } } while (0)
#define P6_PK64(lo, hi) ((long)(((unsigned long long)(hi) << 32) | (unsigned long long)(lo)))
#define P6_UMMA(buf, nn) do { const int k = (nn) % NT6; const LAS unsigned char* _xl = XL + k * 1024 + 256 * ((nn) / NT6) + 32 * c4 + 16 * (g4 & 1); \
                const u32x4 xv0 = *(const LAS u32x4*)_xl, xv1 = *(const LAS u32x4*)(_xl + 128); \
                const i32x8 xa0 = {(int)(klo ? xv0.x : 0u), (int)(klo ? xv0.y : 0u), (int)(klo ? xv0.z : 0u), (int)(klo ? xv0.w : 0u), \
                                   (int)(khi ? xv0.x : 0u), (int)(khi ? xv0.y : 0u), (int)(khi ? xv0.z : 0u), (int)(khi ? xv0.w : 0u)}; \
                const i32x8 xa1 = {(int)(klo ? xv1.x : 0u), (int)(klo ? xv1.y : 0u), (int)(klo ? xv1.z : 0u), (int)(klo ? xv1.w : 0u), \
                                   (int)(khi ? xv1.x : 0u), (int)(khi ? xv1.y : 0u), (int)(khi ? xv1.z : 0u), (int)(khi ? xv1.w : 0u)}; \
                float dsel[2] = {0.f, 0.f}; \
                _Pragma("unroll") for (int T = 0; T < 8; ++T) { f32x4 d = (f32x4){0.f, 0.f, 0.f, 0.f}; \
                    const i32x8 bb0 = {(int)buf[2 * T].x, (int)buf[2 * T].y, (int)buf[2 * T].z, (int)buf[2 * T].w, 0, 0, 0, 0}; \
                    const i32x8 bb1 = {(int)buf[2 * T + 1].x, (int)buf[2 * T + 1].y, (int)buf[2 * T + 1].z, (int)buf[2 * T + 1].w, 0, 0, 0, 0}; \
                    d = __builtin_amdgcn_mfma_scale_f32_16x16x128_f8f6f4(xa0, bb0, d, 0, 4, 0, MX_ONE, 0, MX_ONE); \
                    d = __builtin_amdgcn_mfma_scale_f32_16x16x128_f8f6f4(xa1, bb1, d, 0, 4, 0, MX_ONE, 0, MX_ONE); \
                    float pv = (c4 == 0) ? d[0] : ((c4 == 1) ? d[1] : ((c4 == 2) ? d[2] : d[3])); \
                    pv += DPPF(pv, 0xB1); pv += DPPF(pv, 0x4E);                         \
                    dsel[T >> 2] = ((T & 3) == c4) ? pv : dsel[T >> 2]; } \
                  \
                ACT[k * 128 + 16 * c4 + r16] += dsel[0]; ACT[k * 128 + 16 * (c4 + 4) + r16] += dsel[1]; } while (0)
            P6_ULOAD(bfP, 0);
#pragma unroll 1
            for (int n = 0; n < 4 * NT6; n += 2) {
                P6_ULOAD(bfQ, n + 1); asm volatile("" ::: "memory"); __builtin_amdgcn_sched_barrier(0);
                P6_UMMA(bfP, n); __builtin_amdgcn_sched_barrier(0);
                if (n + 2 < 4 * NT6) P6_ULOAD(bfP, n + 2);
                asm volatile("" ::: "memory"); __builtin_amdgcn_sched_barrier(0);
                P6_UMMA(bfQ, n + 1); __builtin_amdgcn_sched_barrier(0);
            }
#undef P6_ULOAD
#undef P6_UMMA
#undef P6_PK64
        }
        LDS_WAIT();
#pragma unroll 1
        for (int k = 0; k < NT6; ++k) {
#pragma unroll
            for (int sl = 0; sl < 2; ++sl) { const int e = lane + 64 * sl, pos = 16 * (e & 7) + (e >> 3); const float a = ACT[k * 128 + e] * (1.0f / 1024.0f);
                const float cfv = (float)GC[k * 128 + pos] * gelu_exact(a);
                CW[k * 128 + pos] = (unsigned)(__builtin_amdgcn_cvt_pk_fp8_f32(cfv * 32.0f, 0.f, 0, false) & 0xff) * 0x01010101u; E32[k * 128 + pos] = (unsigned)E16[k * 128 + pos] << 7; } }
        LDS_WAIT();
#pragma unroll 1
        for (int k = 0; k < NT6; ++k) ACT[k * 64 + lane] = 0.f;
        LDS_WAIT();
#pragma unroll 1
        for (int rep_v = 0; rep_v < PROBE_V; ++rep_v) {
            for (int k = 0; k < NT6; ++k) ACT[k * 64 + lane] = 0.f;
            LDS_WAIT();
            u32x4 bfP[16], bfQ[16];
            const int n16 = lane & 15, g4 = lane >> 4;
            const unsigned bsel = 0xffu << (8 * (n16 & 3));
            const unsigned M0 = (n16 >> 2) == 0 ? bsel : 0u, M1 = (n16 >> 2) == 1 ? bsel : 0u, M2 = (n16 >> 2) == 2 ? bsel : 0u, M3 = (n16 >> 2) == 3 ? bsel : 0u;
            const int c0 = 16 * n16 + 4 * g4;
            const unsigned loff = 8u * (unsigned)n16;
#define P6_VLOAD(buf, nn) do { const int _j = (nn) / NT6, _k = (nn) % NT6; const LAS unsigned* _ip = E32 + _k * 128 + 32 * g4; \
                const unsigned char* _tb = VB + (size_t)_j * NEXP * 128; \
                _Pragma("unroll") for (int q = 0; q < 4; ++q) { const u32x4 _o0 = *(const LAS u32x4*)(_ip + 4 * q), _o1 = *(const LAS u32x4*)(_ip + 16 + 4 * q); \
                    const unsigned _ow0[4] = {_o0.x, _o0.y, _o0.z, _o0.w}, _ow1[4] = {_o1.x, _o1.y, _o1.z, _o1.w}; \
                    _Pragma("unroll") for (int cc = 0; cc < 4; ++cc) { \
                        const u32x2 _t0 = *(const u32x2*)(_tb + (size_t)(_ow0[cc] + loff)), _t1 = *(const u32x2*)(_tb + (size_t)(_ow1[cc] + loff)); \
                        buf[4 * q + cc] = (u32x4){_t0.x, _t0.y, _t1.x, _t1.y}; } } } while (0)
#define P6_LOADR2(hb, nn) do { hb = *(const u32x2*)(HB + (size_t)TOK6((nn) % NT6) * DM + 256 * ((nn) / NT6) + c0); } while (0)
#define P6_VBODY(buf, nn, hb) do { const int j = (nn) / NT6, k = (nn) % NT6; const int t = TOK6(k); \
                const LAS unsigned* _cp = CW + k * 128 + 16 * g4; \
                const u32x4 _c0 = *(const LAS u32x4*)_cp, _c1 = *(const LAS u32x4*)(_cp + 4), _c2 = *(const LAS u32x4*)(_cp + 8), _c3 = *(const LAS u32x4*)(_cp + 12); \
                const u32x4 _d0 = *(const LAS u32x4*)(_cp + 64), _d1 = *(const LAS u32x4*)(_cp + 68), _d2 = *(const LAS u32x4*)(_cp + 72), _d3 = *(const LAS u32x4*)(_cp + 76); \
                const unsigned _cl[16] = {_c0.x, _c0.y, _c0.z, _c0.w, _c1.x, _c1.y, _c1.z, _c1.w, _c2.x, _c2.y, _c2.z, _c2.w, _c3.x, _c3.y, _c3.z, _c3.w}; \
                const unsigned _ch[16] = {_d0.x, _d0.y, _d0.z, _d0.w, _d1.x, _d1.y, _d1.z, _d1.w, _d2.x, _d2.y, _d2.z, _d2.w, _d3.x, _d3.y, _d3.z, _d3.w}; \
                f32x4 dA = (f32x4){0.f, 0.f, 0.f, 0.f}, dB = (f32x4){0.f, 0.f, 0.f, 0.f}; \
                _Pragma("unroll") for (int c = 0; c < 16; ++c) { const unsigned _l = _cl[c], _h = _ch[c]; \
                    const i32x8 av = {(int)(_l & M0), (int)(_l & M1), (int)(_l & M2), (int)(_l & M3), (int)(_h & M0), (int)(_h & M1), (int)(_h & M2), (int)(_h & M3)}; \
                    const i32x8 bv = {(int)buf[c].x, (int)buf[c].y, (int)buf[c].z, (int)buf[c].w, 0, 0, 0, 0}; \
                    if (c & 1) dB = __builtin_amdgcn_mfma_scale_f32_16x16x128_f8f6f4(av, bv, dB, 0, 4, 0, MX_ONE, 0, MX_ONE); \
                    else       dA = __builtin_amdgcn_mfma_scale_f32_16x16x128_f8f6f4(av, bv, dA, 0, 4, 0, MX_ONE, 0, MX_ONE); } \
                const float hv[4] = {bf_lo(hb.x), bf_hi(hb.x), bf_lo(hb.y), bf_hi(hb.y)}; float o[4]; float ss = 0.f; \
                _Pragma("unroll") for (int r = 0; r < 4; ++r) { o[r] = (dA[r] + dB[r]) * (1.0f / (32.0f * V4_SCALE)) + hv[r]; ss += o[r] * o[r]; } \
                *(f32x4*)(p.out + (size_t)t * DM + 256 * j + c0) = (f32x4){o[0], o[1], o[2], o[3]}; \
                ACT[k * 64 + lane] += ss; \
                } while (0)
            P6_VLOAD(bfP, 0);
#pragma unroll 1
            for (int n = 0; n < 4 * NT6; n += 2) {
                u32x2 hr0, hr1; P6_LOADR2(hr0, n); P6_LOADR2(hr1, n + 1);
                asm volatile("" ::: "memory");
                P6_VLOAD(bfQ, n + 1); asm volatile("" ::: "memory"); __builtin_amdgcn_sched_barrier(0);
                P6_VBODY(bfP, n, hr0); __builtin_amdgcn_sched_barrier(0);
                if (n + 2 < 4 * NT6) P6_VLOAD(bfP, n + 2);
                asm volatile("" ::: "memory"); __builtin_amdgcn_sched_barrier(0);
                P6_VBODY(bfQ, n + 1, hr1); __builtin_amdgcn_sched_barrier(0);
            }
            LDS_WAIT(); asm volatile("s_waitcnt vmcnt(0)" ::: "memory");
            f32x4 gfv[4];
#pragma unroll
            for (int i = 0; i < 4; ++i) gfv[i] = *(const f32x4*)(p.gfin + 256 * i + 4 * lane);
#pragma unroll 1
            for (int k = 0; k < NT6; ++k) { const float sst = wave_sum(ACT[k * 64 + lane]); const float rf = __builtin_amdgcn_rsqf(sst * (1.0f / DM) + EPS);
                float* op = p.out + (size_t)TOK6(k) * DM + 4 * lane; f32x4 ov[4];
#pragma unroll
                for (int i = 0; i < 4; ++i) ov[i] = *(const f32x4*)(op + 256 * i);
#pragma unroll
                for (int i = 0; i < 4; ++i) *(f32x4*)(op + 256 * i) = ov[i] * rf * gfv[i]; }
        }
        LDS_WAIT();
    }
#undef P6_LOADH
#undef P6_LOADX
#undef P6_VLOAD
#undef P6_VBODY
#undef P6_LOADR2
#undef P6_PK64
#undef TOK6
}

#define XB_TMO      128
#define XB_XCNT(j)  (256  + 64 * (j))
#define XB_XSUB(j)  (1280 + 64 * (j))
#define XB_XGEN(j)  (2304 + 64 * (j))
#define XB_TOP      3328
#define XB_TOPGEN   3392
#define XCD_BAR_WORDS 3456
#define XB_SPIN_CAP (1u << 18)

__device__ __forceinline__ unsigned xb_ld(unsigned* p)              { return __hip_atomic_load(p, __ATOMIC_RELAXED, __HIP_MEMORY_SCOPE_AGENT); }
__device__ __forceinline__ unsigned xb_add(unsigned* p, unsigned v) { return __hip_atomic_fetch_add(p, v, __ATOMIC_RELAXED, __HIP_MEMORY_SCOPE_AGENT); }
__device__ __forceinline__ unsigned xb_xcc_id() { return (unsigned)__builtin_amdgcn_s_getreg((3 << 11) | 20) & 0xFu; }
#define XB_SPIN(cond, bar) do { unsigned _sp = 0; while (cond) { __builtin_amdgcn_s_sleep(1); \
    if ((++_sp & 255u) == 0u) { if (xb_ld(&(bar)[XB_TMO])) break; if (_sp > XB_SPIN_CAP) { atomicAdd(&(bar)[XB_TMO], 1u); break; } } } } while (0)

struct XcdBarrier {
    unsigned* bar; unsigned x;
    volatile LAS unsigned* st;
};

__device__ __forceinline__ XcdBarrier xcd_barrier_post(unsigned* bar, volatile LAS unsigned* st) {
    XcdBarrier b; b.bar = bar; b.x = xb_xcc_id(); b.st = st;
    if (threadIdx.x == 0) (void)xb_add(&bar[XB_XCNT(b.x)], 1u);
    return b;
}
__device__ __forceinline__ void xcd_barrier_complete(unsigned* bar, unsigned x, unsigned& nloc, unsigned& nx) {
    const unsigned G = gridDim.x * gridDim.y * gridDim.z;
    unsigned sum, cnt, mine, sp = 0u;
    for (;;) {
        sum = 0u; cnt = 0u; mine = 0u;
#pragma unroll
        for (unsigned j = 0; j < 16; ++j) { const unsigned c = xb_ld(&bar[XB_XCNT(j)]); sum += c; cnt += (c > 0u) ? 1u : 0u; mine = (j == x) ? c : mine; }
        if (sum == G) break;
        __builtin_amdgcn_s_sleep(1);
        if ((++sp & 255u) == 0u) { if (xb_ld(&bar[XB_TMO])) break; if (sp > XB_SPIN_CAP) { atomicAdd(&bar[XB_TMO], 1u); break; } }
    }
    nloc = mine > 0u ? mine : 1u; nx = cnt > 0u ? cnt : 1u;
}

__device__ __forceinline__ void xcd_barrier(const XcdBarrier& b) {
    asm volatile("s_waitcnt vmcnt(0)" ::: "memory");
    __syncthreads();
    if (threadIdx.x == 0) {
        unsigned* bar = b.bar;
        __builtin_amdgcn_s_waitcnt(0);
        unsigned nloc = b.st[0], nx = b.st[1];
        if (nloc == 0u) { xcd_barrier_complete(bar, b.x, nloc, nx); b.st[0] = nloc; b.st[1] = nx; }
        const unsigned old = xb_add(&bar[XB_XSUB(b.x)], 1u);
        const unsigned gen = old / nloc;
        if (old + 1u == (gen + 1u) * nloc) {
            __builtin_amdgcn_fence(__ATOMIC_RELEASE, "agent");
            asm volatile("s_waitcnt vmcnt(0)" ::: "memory");
            const unsigned og = xb_add(&bar[XB_TOP], 1u);
            const unsigned tg = og / nx;
            if (og + 1u == (tg + 1u) * nx) xb_add(&bar[XB_TOPGEN], 1u);
            else XB_SPIN(xb_ld(&bar[XB_TOPGEN]) == tg, bar);
            __builtin_amdgcn_fence(__ATOMIC_ACQUIRE, "agent");
            xb_add(&bar[XB_XGEN(b.x)], 1u);
            asm volatile("s_waitcnt vmcnt(0)" ::: "memory");
        } else {
            XB_SPIN(xb_ld(&bar[XB_XGEN(b.x)]) == gen, bar);
            __builtin_amdgcn_fence(__ATOMIC_ACQUIRE, "agent");
            asm volatile("s_waitcnt vmcnt(0)" ::: "memory");
        }
    }
    __syncthreads();
}

__global__ void __launch_bounds__(512, 2) mk_fwd(Params p) {
    extern __shared__ __attribute__((aligned(16))) unsigned char lds_raw[];
    LAS unsigned char* lds = (LAS unsigned char*)lds_raw;
    const int bid = blockIdx.x, nb = gridDim.x;
    unsigned char* ws = p.ws;
#define IN(k) (p.ph_lo <= (k) && (k) < p.ph_hi)
#define SEAM(k) do { if (IN(k) && IN((k) + 1)) { xcd_barrier(bar); } } while (0)
    if (threadIdx.x < 4) ((volatile LAS unsigned*)(lds + LDS_BYTES - 16))[threadIdx.x] = 0u;
    __syncthreads();
    const XcdBarrier bar = xcd_barrier_post((unsigned*)(ws + WS_CTL) + 4096, (volatile LAS unsigned*)(lds + LDS_BYTES - 16));
    if (IN(0)) phase0(p, lds, bid, nb);
    SEAM(0);
    if (IN(1)) {
        pg8::Gemm g{(const bf16_t*)(ws + WS_XN), (const bf16_t*)(ws + WS_WIN), MROWS, NP1, DM}; pg8::StaticOrder S; S.init(MROWS, NP1, nb, bid);
        EpiProj E{(bf16_t*)(ws + WS_PROJ), (bf16_t*)(ws + WS_QK), (float*)(ws + WS_LA), p.gb, (const float2*)(ws + WS_ROPE)};
        pg8::gemm_phase<EpiProj, pg8::StaticOrder, true, true>(lds, g, S, E);
    }
    SEAM(1);
    if (IN(2)) attn_pass<false>(p, lds, bid, nb);
    SEAM(2);
    if (IN(3)) attn_pass<true>(p, lds, bid, nb);
    SEAM(3);
    if (IN(4)) {
        pg8::Gemm g{(const bf16_t*)(ws + WS_O), (const bf16_t*)(ws + WS_WOUT), NTOK, DM, DM}; pg8::StaticOrder S; S.init(NTOK, DM, nb, bid);
        EpiRes E{p.x, (bf16_t*)(ws + WS_XN), (float*)(ws + WS_SSQ)};
        pg8::gemm_phase<EpiRes, pg8::StaticOrder, true, true>(lds, g, S, E);
    }
    SEAM(4);
    if (IN(5)) {
        pg8::Gemm g{(const bf16_t*)(ws + WS_XN), (const bf16_t*)(ws + WS_WS), NTOK, 2048, DM}; pg8::StaticOrder S; S.init(NTOK, 2048, nb, bid);
        EpiF16 E{(_Float16*)(ws + WS_PROJ)};
        pg8::gemm_phase<EpiF16, pg8::StaticOrder, true, true>(lds, g, S, E);
    }
    SEAM(5);
    if (IN(6)) phase_peer2(p, lds, bid, nb);
#undef IN
#undef SEAM
}

#ifndef MK_FUSED
#define MK_FUSED 1
#endif
extern "C" void kernel_launch(void* const* d_in, const int* in_sizes, int n_in, void* d_out, int out_size, void* d_ws, size_t ws_size, hipStream_t stream) {
    static int grid = 0;
    if (grid == 0) {
        if (n_in != 16 || in_sizes[0] != NTOK * DM || out_size != NTOK * DM || ws_size < WS_END) {
            fprintf(stderr, "kernel_launch: unexpected shapes (n_in %d, in0 %d, out %d, ws %zu); nothing launched\n", n_in, n_in > 0 ? in_sizes[0] : -1, out_size, ws_size); grid = -1; return; }
        int dev = 0, cus = 0, per_cu = 0;
        hipGetDevice(&dev); hipDeviceGetAttribute(&cus, hipDeviceAttributeMultiprocessorCount, dev);
        if (hipFuncSetAttribute((const void*)mk_fwd, hipFuncAttributeMaxDynamicSharedMemorySize, LDS_BYTES) != hipSuccess) { fprintf(stderr, "kernel_launch: hipFuncSetAttribute failed\n"); grid = -1; return; }
        if (hipOccupancyMaxActiveBlocksPerMultiprocessor(&per_cu, (const void*)mk_fwd, 512, LDS_BYTES) != hipSuccess || per_cu < 1) { fprintf(stderr, "kernel_launch: occupancy query failed (%d)\n", per_cu); (void)hipGetLastError(); per_cu = 1; }
        grid = cus * (per_cu < 1 ? 1 : 1);
        fprintf(stderr, "kernel_launch: %d CUs, occupancy %d/CU, grid %d\n", cus, per_cu, grid);
    }
    if (grid < 0) return;
    (void)hipMemsetAsync((char*)d_ws + WS_CTL, 0, 65536, stream);
    Params p{};
    p.x = (const float*)d_in[0]; p.meta = (const float*)d_in[1]; p.g1 = (const float*)d_in[2]; p.w_in = (const float*)d_in[3]; p.gw2 = (const float*)d_in[4]; p.gb = (const float*)d_in[5];
    p.gla_gain = (const float*)d_in[6]; p.ret_gain = (const float*)d_in[7]; p.ret_bias = (const float*)d_in[8]; p.w_out = (const float*)d_in[9]; p.g2 = (const float*)d_in[10];
    p.w_q = (const float*)d_in[11]; p.subkeys = (const float*)d_in[12]; p.pu = (const float*)d_in[13]; p.pv = (const float*)d_in[14]; p.gfin = (const float*)d_in[15];
    p.out = (float*)d_out; p.ws = (unsigned char*)d_ws;
#if MK_FUSED
    p.ph_lo = 0; p.ph_hi = NPHASE;
    void* args[] = {&p};
    hipError_t e = hipLaunchCooperativeKernel((const void*)mk_fwd, dim3(grid), dim3(512), args, LDS_BYTES, stream);
    if (e != hipSuccess) fprintf(stderr, "kernel_launch: cooperative launch failed: %s (grid %d)\n", hipGetErrorString(e), grid);
#else
    { const int order[7] = {0, 1, 2, 3, 4, 5, 6}; for (int i = 0; i < 7; ++i) { p.ph_lo = order[i]; p.ph_hi = order[i] + 1; hipLaunchKernelGGL(mk_fwd, dim3(grid), dim3(512), LDS_BYTES, stream, p); } }
#endif
}
```

```cpp
#include <hip/hip_runtime.h>
#include <hip/hip_cooperative_groups.h>
#include <cstdio>
#include <cstdint>
namespace cg = cooperative_groups;
namespace pg8 {
#define PG8_LAS __attribute__((address_space(3)))
typedef unsigned short bf16_t;
typedef short bf16x8 __attribute__((ext_vector_type(8)));
typedef float f32x4 __attribute__((ext_vector_type(4)));
typedef unsigned u32x4 __attribute__((ext_vector_type(4)));
constexpr int BM = 256, BK = 64, HALF = 128, HTB = HALF * BK * 2  , STAGE_BYTES = 8 * HTB, NXCD = 8, WGM = 8;

__host__ __device__ __forceinline__ int lds_byte(int r, int c) { const int st = (r >> 4) * 2 + (c >> 5), rr = r & 15, cc = c & 31, ob = rr * 64 + cc * 2; return st * 1024 + (ob ^ (((ob >> 9) & 1) << 5)); }
__host__ __device__ __forceinline__ void stage_rc(int b, int& R, int& C) { const int st = b / 1024, sb = b % 1024, swz = sb ^ (((sb >> 9) & 1) << 5); R = (st >> 1) * 16 + swz / 64; C = (st & 1) * 32 + (swz % 64) / 2; }
__host__ __device__ __forceinline__ int perm32(int rho) { const int n = rho >> 4, i = rho & 15; return 8 * (i >> 2) + 4 * n + (i & 3); }

struct Unit { int pm, pn; };
struct Gemm { const bf16_t* A; const bf16_t* Bt; int M, N, K; };

struct StaticOrder {
    int nM, nN, nwg, G, c;
    __host__ __device__ void init(int M, int N, int G_, int c_) { nM = M / BM; nN = N / BM; nwg = nM * nN; G = G_; c = c_; }
    __host__ __device__ bool next(int i, Unit& u) const {
        const long L = (long)i * G + c; if (L >= nwg) return false;
        int wgid = (int)L; { const int q = nwg / NXCD, r = nwg % NXCD, xcd = wgid % NXCD, off = wgid / NXCD; wgid = (xcd < r ? xcd * (q + 1) : r * (q + 1) + (xcd - r) * q) + off; }
        const int nig = WGM * nN, gid = wgid / nig, fm = gid * WGM, gsz = (nM - fm) < WGM ? (nM - fm) : WGM;
        u.pm = fm + ((wgid % nig) % gsz); u.pn = (wgid % nig) / gsz; return true;
    }
    __device__ __forceinline__ void a_ready(const Unit&) const {}
    __device__ __forceinline__ void done(const Unit&) const {}
};

__device__ __forceinline__ unsigned cvt_pk_bf16(float lo, float hi) { unsigned r; asm volatile("v_cvt_pk_bf16_f32 %0, %1, %2" : "=v"(r) : "v"(lo), "v"(hi)); return r; }
typedef float f32x2 __attribute__((ext_vector_type(2)));
template <class Epi, class Sched, bool ALIGN_EPI = false, bool SP2 = false>
__device__ __forceinline__ void gemm_phase(PG8_LAS unsigned char* lds, const Gemm g, const Sched& S, const Epi& E) {
    const int tid = threadIdx.x, wid = __builtin_amdgcn_readfirstlane(tid >> 6), lane = tid & 63, wr = wid >> 2, wc = wid & 3, fr = lane & 15, fq = lane >> 4;
    const int K = g.K, nt = K / BK;
    unsigned voffA[2], voffB[2];
#pragma unroll
    for (int i = 0; i < 2; ++i) { int R, C; stage_rc(tid * 16 + i * 8192, R, C); const int Rb = Epi::PERM ? ((R & ~31) + perm32(R & 31)) : R;
        voffA[i] = (unsigned)(R * K + C) * 2u; voffB[i] = (unsigned)(Rb * K + C) * 2u; }
    const size_t kstep = (size_t)(BK * 2);
    const size_t hstep = (size_t)HALF * K * 2;
    const size_t tstep = 2 * hstep;
    const unsigned ldsw = (unsigned)wid * 1024u;
    const int aoff = lds_byte(wr * 64 + fr, fq * 8), boff = lds_byte(wc * 32 + fr, fq * 8);
#define PG8_SA(b, h) (((b) * 2 + (h)) * HTB)
#define PG8_SB(b, h) ((4 + (b) * 2 + (h)) * HTB)
#define PG8_STAGE(bufoff, gbase, voff) do { _Pragma("unroll") for (int _i = 0; _i < 2; ++_i) \
        __builtin_amdgcn_global_load_lds((const unsigned*)((const char*)(gbase) + (voff)[_i]), (PG8_LAS unsigned*)(lds + (bufoff) + ldsw + _i * 8192), 16, 0, 0); } while (0)
#define PG8_LDA(dst, b, h) do { _Pragma("unroll") for (int m = 0; m < 4; ++m) _Pragma("unroll") for (int k = 0; k < 2; ++k) dst[m][k] = *(const PG8_LAS bf16x8*)(lds + PG8_SA(b, h) + aoff + m * 2048 + k * 1024); } while (0)
#define PG8_LDB(dst, b, h) do { _Pragma("unroll") for (int n = 0; n < 2; ++n) _Pragma("unroll") for (int k = 0; k < 2; ++k) dst[n][k] = *(const PG8_LAS bf16x8*)(lds + PG8_SB(b, h) + boff + n * 2048 + k * 1024); } while (0)
#define PG8_MMA(ai, bj, At, Bt) do { __builtin_amdgcn_s_setprio(1); _Pragma("unroll") for (int m = 0; m < 4; ++m) _Pragma("unroll") for (int n = 0; n < 2; ++n) _Pragma("unroll") for (int k = 0; k < 2; ++k) \
        acc[ai][bj][m][n] = __builtin_amdgcn_mfma_f32_16x16x32_bf16(Bt[n][k], At[m][k], acc[ai][bj][m][n], 0, 0, 0); __builtin_amdgcn_s_setprio(0); } while (0)
#define PG8_WAIT_V(n) asm volatile("s_waitcnt vmcnt(" #n ")" ::: "memory")
#define PG8_WAIT_L(n) asm volatile("s_waitcnt lgkmcnt(" #n ")" ::: "memory")
#define PG8_BAR __builtin_amdgcn_s_barrier()
#define PG8_SCHED __builtin_amdgcn_sched_barrier(0)
    Unit cur, nxt; int ui = 0;
    if (!S.next(0, cur)) return;
    f32x4 acc[2][2][4][2];
#pragma unroll
    for (int a = 0; a < 2; ++a)
#pragma unroll
        for (int b = 0; b < 2; ++b)
#pragma unroll
            for (int m = 0; m < 4; ++m)
#pragma unroll
                for (int n = 0; n < 2; ++n) acc[a][b][m][n] = (f32x4){0.f, 0.f, 0.f, 0.f};
    bf16x8 At[4][2], B0[2][2], B1[2][2];
    const char* cA = (const char*)g.A + (size_t)cur.pm * tstep; const char* cB = (const char*)g.Bt + (size_t)cur.pn * tstep;
    S.a_ready(cur);
    if constexpr (SP2) {
        PG8_STAGE(PG8_SB(0, 0), cB, voffB); PG8_STAGE(PG8_SB(0, 1), cB + hstep, voffB); PG8_STAGE(PG8_SA(0, 0), cA, voffA); PG8_STAGE(PG8_SA(0, 1), cA + hstep, voffA);
        if (wr == 1) PG8_BAR;
        PG8_WAIT_V(2); PG8_BAR;
        PG8_STAGE(PG8_SB(1, 0), cB + kstep, voffB); PG8_STAGE(PG8_SA(1, 0), cA + kstep, voffA); PG8_STAGE(PG8_SB(1, 1), cB + hstep + kstep, voffB);
        PG8_WAIT_V(6); PG8_BAR;
    } else {
        PG8_STAGE(PG8_SB(0, 0), cB, voffB); PG8_STAGE(PG8_SA(0, 0), cA, voffA); PG8_STAGE(PG8_SB(0, 1), cB + hstep, voffB); PG8_STAGE(PG8_SA(0, 1), cA + hstep, voffA);
        if (wr == 1) PG8_BAR;
        PG8_WAIT_V(4); PG8_BAR;
        PG8_STAGE(PG8_SB(1, 0), cB + kstep, voffB); PG8_STAGE(PG8_SA(1, 0), cA + kstep, voffA); PG8_STAGE(PG8_SB(1, 1), cB + hstep + kstep, voffB);
        PG8_WAIT_V(6); PG8_BAR;
    }
    for (;;) {
        const bool has_next = S.next(ui + 1, nxt);
        const char* nA = has_next ? (const char*)g.A + (size_t)nxt.pm * tstep : cA; const char* nB = has_next ? (const char*)g.Bt + (size_t)nxt.pn * tstep : cB;
        for (int t = 0; t < nt; t += 2) {
            const bool last = (t == nt - 2);
            const char* a1 = cA + (size_t)(t + 1) * kstep;
            const char* a2 = last ? nA : cA + (size_t)(t + 2) * kstep; const char* b2 = last ? nB : cB + (size_t)(t + 2) * kstep;
            const char* a3 = a2 + kstep; const char* b3 = b2 + kstep;
            if (last && has_next) S.a_ready(nxt);
            if constexpr (SP2) {
            PG8_LDB(B0, 0, 0); PG8_LDB(B1, 0, 1); PG8_SCHED; PG8_LDA(At, 0, 0); PG8_STAGE(PG8_SA(1, 1), a1 + hstep, voffA);
            PG8_WAIT_V(8); PG8_WAIT_L(0); PG8_BAR; PG8_MMA(0, 0, At, B0); PG8_MMA(0, 1, At, B1); PG8_BAR; PG8_SCHED;
            PG8_LDA(At, 0, 1); PG8_STAGE(PG8_SB(0, 0), b2, voffB); PG8_STAGE(PG8_SB(0, 1), b2 + hstep, voffB); PG8_STAGE(PG8_SA(0, 0), a2, voffA);
            PG8_WAIT_V(8); PG8_WAIT_L(0); PG8_BAR; PG8_MMA(1, 0, At, B0); PG8_MMA(1, 1, At, B1); PG8_BAR; PG8_SCHED;
            PG8_LDB(B0, 1, 0); PG8_LDB(B1, 1, 1); PG8_SCHED; PG8_LDA(At, 1, 0); PG8_STAGE(PG8_SA(0, 1), a2 + hstep, voffA);
            PG8_WAIT_V(8); PG8_WAIT_L(0); PG8_BAR; PG8_MMA(0, 0, At, B0); PG8_MMA(0, 1, At, B1); PG8_BAR; PG8_SCHED;
            PG8_LDA(At, 1, 1); PG8_STAGE(PG8_SB(1, 0), b3, voffB); PG8_STAGE(PG8_SB(1, 1), b3 + hstep, voffB); PG8_STAGE(PG8_SA(1, 0), a3, voffA);
            PG8_WAIT_V(8); PG8_WAIT_L(0); PG8_BAR; PG8_MMA(1, 0, At, B0); PG8_MMA(1, 1, At, B1); PG8_BAR; PG8_SCHED;
            } else {
            PG8_LDB(B0, 0, 0); PG8_SCHED; PG8_LDA(At, 0, 0); PG8_STAGE(PG8_SA(1, 1), a1 + hstep, voffA);
            PG8_WAIT_L(8); PG8_BAR; PG8_WAIT_L(0); PG8_MMA(0, 0, At, B0); PG8_BAR; PG8_SCHED;
            PG8_LDB(B1, 0, 1); PG8_STAGE(PG8_SB(0, 0), b2, voffB);
            PG8_BAR; PG8_WAIT_L(0); PG8_MMA(0, 1, At, B1); PG8_BAR;
            PG8_LDA(At, 0, 1); PG8_STAGE(PG8_SA(0, 0), a2, voffA);
            PG8_BAR; PG8_WAIT_L(0); PG8_MMA(1, 0, At, B0); PG8_BAR; PG8_SCHED;
            PG8_STAGE(PG8_SB(0, 1), b2 + hstep, voffB);
            PG8_WAIT_V(6); PG8_BAR; PG8_MMA(1, 1, At, B1); PG8_BAR;
            PG8_LDB(B0, 1, 0); PG8_SCHED; PG8_LDA(At, 1, 0); PG8_STAGE(PG8_SA(0, 1), a2 + hstep, voffA);
            PG8_WAIT_L(8); PG8_BAR; PG8_WAIT_L(0); PG8_MMA(0, 0, At, B0); PG8_BAR; PG8_SCHED;
            PG8_LDB(B1, 1, 1); PG8_STAGE(PG8_SB(1, 0), b3, voffB);
            PG8_BAR; PG8_WAIT_L(0); PG8_MMA(0, 1, At, B1); PG8_BAR;
            PG8_LDA(At, 1, 1); PG8_STAGE(PG8_SA(1, 0), a3, voffA);
            PG8_BAR; PG8_WAIT_L(0); PG8_MMA(1, 0, At, B0); PG8_BAR; PG8_SCHED;
            PG8_STAGE(PG8_SB(1, 1), b3 + hstep, voffB);
            PG8_WAIT_V(6); PG8_BAR; PG8_MMA(1, 1, At, B1); PG8_BAR;
            }
        }
        if constexpr (ALIGN_EPI) { if (wr == 0) PG8_BAR; }
        if constexpr (!Epi::AFTER_DRAIN) { E(acc, cur, wr, wc, fr, fq); S.done(cur); }
        if (!has_next) break;
#pragma unroll
        for (int a = 0; a < 2; ++a)
#pragma unroll
            for (int b = 0; b < 2; ++b)
#pragma unroll
                for (int m = 0; m < 4; ++m)
#pragma unroll
                    for (int n = 0; n < 2; ++n) acc[a][b][m][n] = (f32x4){0.f, 0.f, 0.f, 0.f};
        cur = nxt; cA = nA; cB = nB; ++ui;
        if constexpr (ALIGN_EPI) { if (wr == 1) PG8_BAR; }
    }
    PG8_WAIT_V(0);
    if constexpr (!ALIGN_EPI) { if (wr == 0) PG8_BAR; }
    PG8_BAR;
    if constexpr (Epi::AFTER_DRAIN) { E.fused(acc, cur, wr, wc, fr, fq, lds, wid, lane); S.done(cur); }
#undef PG8_SA
#undef PG8_SB
#undef PG8_STAGE
#undef PG8_LDA
#undef PG8_LDB
#undef PG8_MMA
#undef PG8_WAIT_V
#undef PG8_WAIT_L
#undef PG8_BAR
#undef PG8_SCHED
}
}

#define LAS __attribute__((address_space(3)))
typedef unsigned short bf16_t;
typedef float f32x4 __attribute__((ext_vector_type(4)));
typedef unsigned u32x4 __attribute__((ext_vector_type(4)));
typedef unsigned u32x2 __attribute__((ext_vector_type(2)));
typedef int i32x8 __attribute__((ext_vector_type(8)));
typedef short s16x2 __attribute__((ext_vector_type(2)));
#define MX_ONE 0x7f7f7f7f
#define V4_SCALE 5.656854f
typedef short bf16x8 __attribute__((ext_vector_type(8)));
typedef short s16x4 __attribute__((ext_vector_type(4)));
typedef __bf16 bf16x2_t __attribute__((ext_vector_type(2)));
typedef _Float16 f16x2_t __attribute__((ext_vector_type(2)));
typedef float f32x2v __attribute__((ext_vector_type(2)));
typedef _Float16 h2v __attribute__((ext_vector_type(2)));

constexpr int DM = 1024, NB = 4, SEQ = 8192, NTOK = NB * SEQ;
constexpr int MROWS = NTOK + 256;
constexpr int INW = 3088;
constexpr int NPROJ = 3072, NP1 = 3328;
constexpr int NEXP = 16384;
constexpr float EPS = 1e-6f;
constexpr int C_GQ = 0, C_GK = 256, C_GV = 512, C_GG = 1024, C_RQ = 1536, C_RK = 1792, C_RV = 2048, C_RG = 2560;
constexpr int S_GA = 1536, S_RQ = 1552, S_RV = 2064;

constexpr int NVG = 2048;
constexpr int NCH = (NTOK + 256) / 64;
constexpr size_t QK_ARR = (size_t)NCH * 4 * 8 * 64 * 8;
constexpr size_t MiB = 1u << 20;
constexpr size_t WS_CTL = 0, WS_WIN = 1 * MiB, WS_WOUT = 8 * MiB, WS_WS = 10 * MiB, WS_ROPE = 14 * MiB, WS_SSQ = 17 * MiB, WS_SEG = 19 * MiB, WS_ASEG = 27 * MiB,
                 WS_UB = 28 * MiB, WS_VB = 60 * MiB, WS_XN = 92 * MiB, WS_O = 157 * MiB, WS_LA = 221 * MiB, WS_PROJ = 254 * MiB, WS_QK = 383 * MiB, WS_XQ = 448 * MiB, WS_END = 480 * MiB;
static_assert(WS_WIN + (size_t)NP1 * DM * 2 <= WS_WOUT && WS_ROPE + (size_t)(SEQ + 64) * 32 * 8 <= WS_SSQ && WS_XN + (size_t)MROWS * DM * 2 <= WS_O &&
              WS_LA + QK_ARR * 4 <= WS_PROJ && WS_PROJ + (size_t)MROWS * NVG * 2 <= WS_QK && WS_QK + 4 * QK_ARR * 2 <= WS_XQ && WS_PROJ + (size_t)NTOK * 2048 * 2 <= WS_QK, "ws map");

constexpr size_t WS_HB = WS_XN + (size_t)256 * DM * 2;
constexpr size_t WS_RINV = WS_CTL + 131072, WS_GINV = WS_CTL + 262144;
constexpr int LDS_BYTES = 147456;
constexpr int NPHASE = 7;
#ifndef PROBE_R
#define PROBE_R 1
#define PROBE_U 1
#define PROBE_V 1
#endif
#ifndef PEER_FP8
#define PEER_FP8 1
#endif

struct Params {
    const float *x, *meta, *g1, *w_in, *gw2, *gb, *gla_gain, *ret_gain, *ret_bias, *w_out, *g2, *w_q, *subkeys, *pu, *pv, *gfin;
    float* out; unsigned char* ws;
    int ph_lo, ph_hi;
};

#define LDS_WAIT() asm volatile("s_waitcnt lgkmcnt(0)" ::: "memory")
__device__ __forceinline__ unsigned pk2(float lo, float hi) { const bf16x2_t v = {(__bf16)lo, (__bf16)hi}; return __builtin_bit_cast(unsigned, v); }
__device__ __forceinline__ unsigned f2bf(float f) { return (unsigned)__builtin_bit_cast(unsigned short, (__bf16)f); }

__device__ __forceinline__ float bf_lo(unsigned w) { return __builtin_bit_cast(float, w << 16); }
__device__ __forceinline__ float bf_hi(unsigned w) { return __builtin_bit_cast(float, w & 0xffff0000u); }
__device__ __forceinline__ float bf1(bf16_t h) { return __builtin_bit_cast(float, (unsigned)h << 16); }
__device__ __forceinline__ float wave_sum(float v) {
#pragma unroll
    for (int o = 1; o < 64; o <<= 1) v += __shfl_xor(v, o);
    return v;
}

struct MapIn {
    __device__ __forceinline__ void operator()(int j, int& src, float& sc) const {
        if (j < C_RQ) { src = j; sc = (j < 256) ? 0.125f : 1.0f; }
        else if (j < C_RV) { const int jj = j - C_RQ, which = jj >> 8, within = jj & 255, head = within >> 6, p = within & 63;
            const int a = p >> 3, n = (p >> 2) & 1, i = p & 3; src = S_RQ + which * 256 + head * 64 + 32 * n + 4 * a + i; sc = which ? 0.125f : 1.0f; }
        else { src = S_RV + (j - C_RV); sc = 1.0f; }
    }
};
struct MapId { __device__ __forceinline__ void operator()(int j, int& src, float& sc) const { src = j; sc = 1.0f; } };

template <class Map>
__device__ __forceinline__ void transpose_item(const float* W, int K, int N, bf16_t* WT, LAS float* scr, int item, int nblk, int lane, const Map map) {
    const int kb = item / nblk, nb = item % nblk, k0 = 64 * kb, n0 = 32 * nb;
    int src; float sc; map(n0 + (lane & 31), src, sc);
#pragma unroll 8
    for (int i = 0; i < 32; ++i) { const int kk = 2 * i + (lane >> 5); scr[kk * 33 + (lane & 31)] = W[(size_t)(k0 + kk) * N + src] * sc; }
    LDS_WAIT();
    const int c = lane & 7;
#pragma unroll
    for (int j = 0; j < 4; ++j) { const int n = (lane >> 3) + 8 * j; const LAS float* s = scr + (8 * c) * 33 + n;
        u32x4 o; o.x = pk2(s[0 * 33], s[1 * 33]); o.y = pk2(s[2 * 33], s[3 * 33]); o.z = pk2(s[4 * 33], s[5 * 33]); o.w = pk2(s[6 * 33], s[7 * 33]);
        *(u32x4*)(WT + (size_t)(n0 + n) * K + k0 + 8 * c) = o; }
    LDS_WAIT();
}

__device__ __forceinline__ void phase0(const Params& p, LAS unsigned char* lds, int bid, int nb) {
    const int tid = threadIdx.x, lane = tid & 63, wave = __builtin_amdgcn_readfirstlane(tid >> 6);
    unsigned char* ws = p.ws;
    bf16_t* XN = (bf16_t*)(ws + WS_XN); bf16_t* WinT = (bf16_t*)(ws + WS_WIN); bf16_t* WoutT = (bf16_t*)(ws + WS_WOUT); bf16_t* WsT = (bf16_t*)(ws + WS_WS);
    const int gw = bid * 8 + wave, NGW = nb * 8;
    const int gt = bid * 512 + tid, NGT = nb * 512;

    {
        LAS float* SKT = (LAS float*)lds;
        LAS float* WQT = (LAS float*)(lds + 128 * 132 * 4);
        for (int item = bid; item < 256; item += nb) {
            const int hc = item >> 4, kb = item & 15;
            __syncthreads();
            for (int e = tid; e < 128 * 128; e += 512) { const int n = e >> 7, d = e & 127; SKT[d * 132 + n] = p.subkeys[(size_t)hc * 16384 + e]; }
            for (int e = tid; e < 64 * 128; e += 512) { const int k = e >> 7, d = e & 127; WQT[d * 68 + k] = p.w_q[(size_t)(kb * 64 + k) * 2048 + hc * 128 + d]; }
            __syncthreads();
            const int tn = tid & 31, tk = tid >> 5;
            f32x4 acc[4];
#pragma unroll
            for (int i = 0; i < 4; ++i) acc[i] = (f32x4){0.f, 0.f, 0.f, 0.f};
#pragma unroll 4
            for (int d = 0; d < 128; ++d) {
                const f32x4 sk = *(const LAS f32x4*)(SKT + d * 132 + 4 * tn); const f32x4 wq = *(const LAS f32x4*)(WQT + d * 68 + 4 * tk);
#pragma unroll
                for (int i = 0; i < 4; ++i) acc[i] += sk[i] * wq;
            }
            const f32x4 gg = *(const f32x4*)(p.g2 + kb * 64 + 4 * tk);
#pragma unroll
            for (int i = 0; i < 4; ++i) { const f32x4 v = acc[i] * gg; u32x2 o; o.x = pk2(v[0], v[1]); o.y = pk2(v[2], v[3]);
                *(u32x2*)(WsT + (size_t)(hc * 128 + 4 * tn + i) * DM + kb * 64 + 4 * tk) = o; }
        }
        __syncthreads();
    }
    {
        LAS float* scr = (LAS float*)(lds + wave * 16384);
        constexpr int I_IN = (DM / 64) * (NPROJ / 32), I_OUT = (DM / 64) * (DM / 32);
        for (int it = gw; it < I_IN + I_OUT; it += NGW) {
            if (it < I_IN) transpose_item(p.w_in, DM, INW, WinT, scr, it, NPROJ / 32, lane, MapIn());
            else transpose_item(p.w_out, DM, DM, WoutT, scr, it - I_IN, DM / 32, lane, MapId());
        }
    }
    for (int e = gt; e < 256 * DM; e += NGT) {
        const int n = e >> 10, k = e & 1023; const float* wr = p.w_in + (size_t)k * INW + S_GA; float s = 0.f;
#pragma unroll
        for (int r = 0; r < 16; ++r) s += wr[r] * p.gw2[r * 256 + n];
        WinT[(size_t)(NPROJ + n) * DM + k] = (bf16_t)f2bf(s);
    }
#if PEER_FP8
    {
        u32x4* U4 = (u32x4*)(ws + WS_UB); u32x4* V4 = (u32x4*)(ws + WS_VB);
        for (int e = gt; e < NEXP * DM / 32; e += NGT) {
            const f32x4* us = (const f32x4*)p.pu + 8 * (size_t)e; const f32x4* vs = (const f32x4*)p.pv + 8 * (size_t)e;
            const f32x4* g2s = (const f32x4*)p.g2 + 8 * (e & 31);
            unsigned tu[4], tv[4];
#pragma unroll
            for (int j = 0; j < 4; ++j) { const f32x4 a0 = us[2 * j] * g2s[2 * j] * 64.0f, a1 = us[2 * j + 1] * g2s[2 * j + 1] * 64.0f;
                const f32x4 b0 = vs[2 * j] * V4_SCALE, b1 = vs[2 * j + 1] * V4_SCALE;
                unsigned w = 0u, x = 0u;
                w = __builtin_amdgcn_cvt_scalef32_pk_fp4_f32(w, a0[0], a0[1], 1.0f, 0); w = __builtin_amdgcn_cvt_scalef32_pk_fp4_f32(w, a0[2], a0[3], 1.0f, 1);
                w = __builtin_amdgcn_cvt_scalef32_pk_fp4_f32(w, a1[0], a1[1], 1.0f, 2); w = __builtin_amdgcn_cvt_scalef32_pk_fp4_f32(w, a1[2], a1[3], 1.0f, 3); tu[j] = w;
                x = __builtin_amdgcn_cvt_scalef32_pk_fp4_f32(x, b0[0], b0[1], 1.0f, 0); x = __builtin_amdgcn_cvt_scalef32_pk_fp4_f32(x, b0[2], b0[3], 1.0f, 1);
                x = __builtin_amdgcn_cvt_scalef32_pk_fp4_f32(x, b1[0], b1[1], 1.0f, 2); x = __builtin_amdgcn_cvt_scalef32_pk_fp4_f32(x, b1[2], b1[3], 1.0f, 3); tv[j] = x; }
            const int row = e >> 5, c32 = e & 31;
            const size_t dst = ((size_t)(c32 >> 3) * NEXP + row) * 8 + (c32 & 7);
            U4[dst] = (u32x4){tu[0], tu[1], tu[2], tu[3]}; V4[dst] = (u32x4){tv[0], tv[1], tv[2], tv[3]}; }
    }
#else
    {
        u32x2* UB = (u32x2*)(ws + WS_UB); u32x2* VB = (u32x2*)(ws + WS_VB);
        const f32x4* u4 = (const f32x4*)p.pu; const f32x4* v4 = (const f32x4*)p.pv;
        for (int e = gt; e < NEXP * DM / 4; e += NGT) { const f32x4 a = u4[e]; u32x2 o; o.x = pk2(a[0], a[1]); o.y = pk2(a[2], a[3]); UB[e] = o;
            const f32x4 b = v4[e]; u32x2 q; q.x = pk2(b[0], b[1]); q.y = pk2(b[2], b[3]); VB[e] = q; }
    }
#endif
    if (gt < DM) ((float*)(ws + WS_GINV))[gt] = 1.0f / p.g1[gt];
    {
        float2* rope = (float2*)(ws + WS_ROPE);
        for (int e = gt; e < (SEQ + 64) * 32; e += NGT) { const int pi = e >> 5, d = e & 31;
            const float invf = (float)pow(10000.0, -(double)d / 32.0); const float ang = (float)(pi - 48) * invf;
            rope[e] = make_float2((float)cos((double)ang), (float)sin((double)ang)); }
    }
    for (int m0 = gw; m0 < MROWS; m0 += 4 * NGW) {
        const float* srcp[4]; f32x4 v[4][4];
#pragma unroll
        for (int u = 0; u < 4; ++u) { const int m = m0 + u * NGW; srcp[u] = nullptr;
            if (m < MROWS) { if (m >= 256) srcp[u] = p.x + (size_t)(m - 256) * DM; else if (m >= 48 && m < 64) srcp[u] = p.meta + (size_t)(m - 48) * DM; }
            if (srcp[u] != nullptr) { const f32x4* xr = (const f32x4*)srcp[u] + lane;
#pragma unroll
                for (int j = 0; j < 4; ++j) v[u][j] = xr[64 * j]; }
            else {
#pragma unroll
                for (int j = 0; j < 4; ++j) v[u][j] = (f32x4){0.f, 0.f, 0.f, 0.f}; } }
        f32x4 gg[4];
#pragma unroll
        for (int j = 0; j < 4; ++j) gg[j] = ((const f32x4*)p.g1 + lane)[64 * j];
#pragma unroll
        for (int u = 0; u < 4; ++u) { const int m = m0 + u * NGW; if (m >= MROWS) continue;
            float s = 0.f;
#pragma unroll
            for (int j = 0; j < 4; ++j) s += (v[u][j].x * v[u][j].x + v[u][j].y * v[u][j].y) + (v[u][j].z * v[u][j].z + v[u][j].w * v[u][j].w);
            const float r = (srcp[u] != nullptr) ? __builtin_amdgcn_rsqf(wave_sum(s) * (1.0f / DM) + EPS) : 0.f;
            if (lane == 0 && m >= 256) ((float*)(ws + WS_RINV))[m - 256] = 1.0f / r;
            unsigned long long* o8 = (unsigned long long*)(XN + (size_t)m * DM) + lane;
#pragma unroll
            for (int j = 0; j < 4; ++j) { const f32x4 y = v[u][j] * r * gg[j]; o8[64 * j] = (unsigned long long)pk2(y.x, y.y) | ((unsigned long long)pk2(y.z, y.w) << 32); } }
    }
}

struct EpiProj {
    static constexpr bool PERM = true, AFTER_DRAIN = false;
    bf16_t* VG; bf16_t* QK; float* LAT; const float* gb; const float2* rope;
    __device__ __forceinline__ static size_t tile_off(int r, int head, int dg) { return ((((size_t)(r >> 6) * 4 + head) * 8 + dg) * 64 + (r & 63)) * 8; }
    __device__ __forceinline__ void operator()(const pg8::f32x4 (&acc)[2][2][4][2], const pg8::Unit& u, int wr, int wc, int fr, int fq) const {
        const int row0 = u.pm * 256 + wr * 64 + fr, cb0 = wc * 32 + 8 * fq;
        if (u.pn == 12) {
#pragma unroll
            for (int bj = 0; bj < 2; ++bj) { const int c = cb0 + 128 * bj; const f32x4 b0 = *(const f32x4*)(gb + c), b1 = *(const f32x4*)(gb + c + 4);
#pragma unroll
                for (int ai = 0; ai < 2; ++ai)
#pragma unroll
                    for (int m = 0; m < 4; ++m) { const int row = row0 + ai * 128 + m * 16; f32x4 v0 = acc[ai][bj][m][0] + b0, v1 = acc[ai][bj][m][1] + b1;
#pragma unroll
                        for (int i = 0; i < 4; ++i) { v0[i] = (fminf(v0[i], 0.f) - __logf(1.0f + __expf(-fabsf(v0[i])))) * 0.0625f; v1[i] = (fminf(v1[i], 0.f) - __logf(1.0f + __expf(-fabsf(v1[i])))) * 0.0625f; }
                        float* o = LAT + tile_off(row, c >> 6, (c & 63) >> 3); *(f32x4*)o = v0; *(f32x4*)(o + 4) = v1; } }
        } else if (u.pn == 6 || u.pn == 7) {
            bf16_t* QA = QK + (size_t)(u.pn - 4) * QK_ARR;
#pragma unroll
            for (int ai = 0; ai < 2; ++ai)
#pragma unroll
                for (int m = 0; m < 4; ++m) { const int row = row0 + ai * 128 + m * 16; const int pidx = (row < 256) ? row : 64 + ((row - 256) & (SEQ - 1));
#pragma unroll
                    for (int bj = 0; bj < 2; ++bj) { const int c = cb0 + 128 * bj, d0 = (c & 63) >> 1;
                        const f32x4 cs0 = *(const f32x4*)(rope + (size_t)pidx * 32 + d0), cs1 = *(const f32x4*)(rope + (size_t)pidx * 32 + d0 + 2);
                        const f32x4 t1 = acc[ai][bj][m][0], t2 = acc[ai][bj][m][1];
                        const float co[4] = {cs0[0], cs0[2], cs1[0], cs1[2]}, si[4] = {cs0[1], cs0[3], cs1[1], cs1[3]};
                        float o1[4], o2[4];
#pragma unroll
                        for (int i = 0; i < 4; ++i) { o1[i] = t1[i] * co[i] - t2[i] * si[i]; o2[i] = t1[i] * si[i] + t2[i] * co[i]; }
                        u32x4 w; w.x = pg8::cvt_pk_bf16(o1[0], o1[1]); w.y = pg8::cvt_pk_bf16(o1[2], o1[3]); w.z = pg8::cvt_pk_bf16(o2[0], o2[1]); w.w = pg8::cvt_pk_bf16(o2[2], o2[3]);
                        *(u32x4*)(QA + tile_off(row, c >> 6, (c & 63) >> 3)) = w; } }
        } else if (u.pn <= 1) {
            bf16_t* QA = QK + (size_t)u.pn * QK_ARR;
#pragma unroll
            for (int ai = 0; ai < 2; ++ai)
#pragma unroll
                for (int m = 0; m < 4; ++m) { const int row = row0 + ai * 128 + m * 16;
#pragma unroll
                    for (int bj = 0; bj < 2; ++bj) { const int c = cb0 + 128 * bj; const f32x4 v0 = acc[ai][bj][m][0], v1 = acc[ai][bj][m][1];
                        u32x4 w; w.x = pg8::cvt_pk_bf16(v0[0], v0[1]); w.y = pg8::cvt_pk_bf16(v0[2], v0[3]); w.z = pg8::cvt_pk_bf16(v1[0], v1[1]); w.w = pg8::cvt_pk_bf16(v1[2], v1[3]);
                        *(u32x4*)(QA + tile_off(row, c >> 6, (c & 63) >> 3)) = w; } }
        } else {
            const int cdst = (u.pn < 6 ? (u.pn - 2) : (u.pn - 4)) * 256;
#pragma unroll
            for (int ai = 0; ai < 2; ++ai)
#pragma unroll
                for (int m = 0; m < 4; ++m) { bf16_t* rowp = VG + (size_t)(row0 + ai * 128 + m * 16) * NVG + cdst + cb0;
#pragma unroll
                    for (int bj = 0; bj < 2; ++bj) { const f32x4 v0 = acc[ai][bj][m][0], v1 = acc[ai][bj][m][1];
                        u32x4 w; w.x = pg8::cvt_pk_bf16(v0[0], v0[1]); w.y = pg8::cvt_pk_bf16(v0[2], v0[3]); w.z = pg8::cvt_pk_bf16(v1[0], v1[1]); w.w = pg8::cvt_pk_bf16(v1[2], v1[3]);
                        *(u32x4*)(rowp + bj * 128) = w; } }
        }
    }
};
struct EpiRes {
    static constexpr bool PERM = true, AFTER_DRAIN = false;
    bf16_t* HB; float* SSQ; const float* RINV; const float* GINV;
    __device__ __forceinline__ void operator()(const pg8::f32x4 (&acc)[2][2][4][2], const pg8::Unit& u, int wr, int wc, int fr, int fq) const {
        const int row0 = u.pm * 256 + wr * 64 + fr, col0 = u.pn * 256 + wc * 32 + 8 * fq;
        f32x4 gi[2][2];
#pragma unroll
        for (int bj = 0; bj < 2; ++bj) { gi[bj][0] = *(const f32x4*)(GINV + col0 + bj * 128); gi[bj][1] = *(const f32x4*)(GINV + col0 + bj * 128 + 4); }
#pragma unroll
        for (int ai = 0; ai < 2; ++ai)
#pragma unroll
            for (int m = 0; m < 4; ++m) { const int row = row0 + ai * 128 + m * 16; bf16_t* hr = HB + (size_t)row * DM + col0; float ss = 0.f; const float ri = RINV[row];
#pragma unroll
                for (int bj = 0; bj < 2; ++bj) { const u32x4 xn = *(const u32x4*)(hr + bj * 128);
                    const f32x4 x0 = (f32x4){bf_lo(xn.x), bf_hi(xn.x), bf_lo(xn.y), bf_hi(xn.y)} * ri * gi[bj][0], x1 = (f32x4){bf_lo(xn.z), bf_hi(xn.z), bf_lo(xn.w), bf_hi(xn.w)} * ri * gi[bj][1];
                    const f32x4 v0 = acc[ai][bj][m][0] + x0, v1 = acc[ai][bj][m][1] + x1;
                    ss += (v0[0] * v0[0] + v0[1] * v0[1]) + (v0[2] * v0[2] + v0[3] * v0[3]) + (v1[0] * v1[0] + v1[1] * v1[1]) + (v1[2] * v1[2] + v1[3] * v1[3]);
                    u32x4 w; w.x = pg8::cvt_pk_bf16(v0[0], v0[1]); w.y = pg8::cvt_pk_bf16(v0[2], v0[3]); w.z = pg8::cvt_pk_bf16(v1[0], v1[1]); w.w = pg8::cvt_pk_bf16(v1[2], v1[3]);
                    *(u32x4*)(hr + bj * 128) = w; }
                ss += __shfl_xor(ss, 16); ss += __shfl_xor(ss, 32);
                if (fq == 0) SSQ[(size_t)row * 16 + u.pn * 4 + wc] = ss; }
    }
};
struct EpiF16 {
    static constexpr bool PERM = true, AFTER_DRAIN = false;
    _Float16* SC;
    __device__ __forceinline__ void operator()(const pg8::f32x4 (&acc)[2][2][4][2], const pg8::Unit& u, int wr, int wc, int fr, int fq) const {
        const int row0 = u.pm * 256 + wr * 64 + fr, col0 = u.pn * 256 + wc * 32 + 8 * fq;
#pragma unroll
        for (int ai = 0; ai < 2; ++ai)
#pragma unroll
            for (int m = 0; m < 4; ++m) { _Float16* rowp = SC + (size_t)(row0 + ai * 128 + m * 16) * 2048 + col0;
#pragma unroll
                for (int bj = 0; bj < 2; ++bj) { const f32x4 v0 = acc[ai][bj][m][0], v1 = acc[ai][bj][m][1];
                    u32x4 w;
                    w.x = __builtin_bit_cast(unsigned, (f16x2_t){(_Float16)v0[0], (_Float16)v0[1]}); w.y = __builtin_bit_cast(unsigned, (f16x2_t){(_Float16)v0[2], (_Float16)v0[3]});
                    w.z = __builtin_bit_cast(unsigned, (f16x2_t){(_Float16)v1[0], (_Float16)v1[1]}); w.w = __builtin_bit_cast(unsigned, (f16x2_t){(_Float16)v1[2], (_Float16)v1[3]});
                    *(u32x4*)(rowp + bj * 128) = w; } }
    }
};

constexpr int A_QT = 0, A_KT = 9216, A_KE = 18432, A_V = 27648, A_ST = 45056, A_STSZ = 18432, A_OB = 81920, A_DEC = 115712, A_CS = 115968;
constexpr int PQ = 72, PV = 136, POB = 132;

__device__ __forceinline__ bf16x8 tr2(const LAS bf16_t* p0, const LAS bf16_t* p1) {
    const s16x4 a = __builtin_amdgcn_ds_read_tr16_b64_v4i16((LAS s16x4*)p0), b = __builtin_amdgcn_ds_read_tr16_b64_v4i16((LAS s16x4*)p1);
    return (bf16x8){a[0], a[1], a[2], a[3], b[0], b[1], b[2], b[3]};
}
__device__ __forceinline__ float ln_gamma(int hr) { return log1pf(-exp2f(-5.0f - (float)hr)); }

template <bool FULL>
__device__ __forceinline__ void attn_pass(const Params& p, LAS unsigned char* lds, int bid, int nb) {
    const int tid = threadIdx.x, lane = tid & 63, wave = __builtin_amdgcn_readfirstlane(tid >> 6);
    const int r16 = lane & 15, g4 = lane >> 4, q4 = (lane & 15) >> 2, p4 = lane & 3;
    unsigned char* ws = p.ws;
    const bf16_t* PROJ = (const bf16_t*)(ws + WS_PROJ); const float* LA = (const float*)(ws + WS_LA); const bf16_t* QK = (const bf16_t*)(ws + WS_QK);
    float* SEG = (float*)(ws + WS_SEG); float* ASEG = (float*)(ws + WS_ASEG); float* SEGM = (float*)(ws + WS_ASEG + 65536); bf16_t* OUT = (bf16_t*)(ws + WS_O);
    LAS bf16_t* QT = (LAS bf16_t*)(lds + A_QT); LAS bf16_t* KT = (LAS bf16_t*)(lds + A_KT); LAS bf16_t* KE = (LAS bf16_t*)(lds + A_KE); LAS bf16_t* VS = (LAS bf16_t*)(lds + A_V);
    LAS float* OB = (LAS float*)(lds + A_OB); LAS float* DEC = (LAS float*)(lds + A_DEC); LAS float* CS = (LAS float*)(lds + A_CS);

    for (int item = bid; item < 256; item += nb) {
        const int seg = item & 7, h8 = (item >> 3) & 7, b = item >> 6;
        const bool metaitem = !FULL && seg == 7 && b == 0;
        if (!FULL && seg == 7 && !metaitem) continue;
        const bool gla = h8 < 4; const int hr = h8 & 3;
        const float lng = ln_gamma(hr);
        const bf16_t* QAq = QK + (size_t)(gla ? 0 : 2) * QK_ARR; const bf16_t* QAk = QK + (size_t)(gla ? 1 : 3) * QK_ARR;
        const int vcol = (gla ? 0 : 1024) + hr * 128, gcol = (gla ? 512 : 1536) + hr * 128;
        const int nch = metaitem ? 1 : 16;

        f32x4 accS[8];
#pragma unroll
        for (int cb = 0; cb < 8; ++cb) accS[cb] = (f32x4){0.f, 0.f, 0.f, 0.f};
        float blsum[8] = {0.f, 0.f, 0.f, 0.f, 0.f, 0.f, 0.f, 0.f};
        __syncthreads();
        if (FULL) {
            if (wave >= 4) {
                const int wq = wave - 4;
                { const float* Sm = SEGM + (size_t)h8 * 8192;
#pragma unroll
                  for (int cb = 0; cb < 8; ++cb)
#pragma unroll
                      for (int rg = 0; rg < 4; ++rg) accS[cb][rg] = Sm[(16 * wq + 4 * g4 + rg) * 128 + 16 * cb + r16]; }
                for (int sp = 0; sp < seg; ++sp) { const int it2 = (item & ~7) + sp; const float* Sg = SEG + (size_t)it2 * 8192; const float* Ag = ASEG + it2 * 64;
                    float dec[4];
#pragma unroll
                    for (int rg = 0; rg < 4; ++rg) dec[rg] = Ag[16 * wq + 4 * g4 + rg];
#pragma unroll
                    for (int cb = 0; cb < 8; ++cb)
#pragma unroll
                        for (int rg = 0; rg < 4; ++rg) accS[cb][rg] = dec[rg] * accS[cb][rg] + Sg[(16 * wq + 4 * g4 + rg) * 128 + 16 * cb + r16]; }
                LAS bf16_t* ST0 = (LAS bf16_t*)(lds + A_ST);
#pragma unroll
                for (int cb = 0; cb < 8; ++cb) { u32x2 w; w.x = pk2(accS[cb][0], accS[cb][1]); w.y = pk2(accS[cb][2], accS[cb][3]); *(LAS u32x2*)(ST0 + (16 * cb + r16) * PQ + 16 * wq + 4 * g4) = w; }
            }
        }
#define A_ROWBASE(ci_) (metaitem ? 0 : 256 + b * SEQ + (16 * seg + (ci_)) * 64)
        f32x4 lav[2]; u32x4 qv8, kv8; u32x4 vreg[2];
        qv8 = (u32x4){0u, 0u, 0u, 0u};
#define A_LOADCHUNK(ci_) do { const int _rb = A_ROWBASE(ci_); \
            const size_t _to = ((((size_t)(_rb >> 6) * 4 + hr) * 8 + wave) * 64 + lane) * 8;       \
            if (gla) { const f32x4* _lp = (const f32x4*)(LA + _to); lav[0] = _lp[0]; lav[1] = _lp[1]; } \
            else { lav[0] = (f32x4){lng, lng, lng, lng}; lav[1] = lav[0]; } \
            if (FULL) qv8 = *(const u32x4*)(QAq + _to); \
            kv8 = *(const u32x4*)(QAk + _to); \
            { const int vr = tid >> 3, cc = tid & 7; const u32x4* src = (const u32x4*)(PROJ + (size_t)(_rb + vr) * NVG + vcol + cc * 16); vreg[0] = src[0]; vreg[1] = src[1]; } } while (0)
#define A_LBAR() do { asm volatile("s_waitcnt lgkmcnt(0)" ::: "memory"); __builtin_amdgcn_s_barrier(); asm volatile("" ::: "memory"); } while (0)
        A_LOADCHUNK(0);
        f32x4 gnv[4], bsv[4];
        { const float* gptr = (gla ? p.gla_gain : p.ret_gain) + 16 * (tid & 7); const float* bptr = p.ret_bias + 16 * (tid & 7); const float bsc = gla ? 0.f : 1.f;
#pragma unroll
          for (int k4 = 0; k4 < 4; ++k4) { gnv[k4] = *(const f32x4*)(gptr + 4 * k4); bsv[k4] = *(const f32x4*)(bptr + 4 * k4) * bsc; } }
        for (int ci = 0; ci < nch; ++ci) {
            const bool metac = metaitem;
            const int rowbase = A_ROWBASE(ci);
            const LAS bf16_t* STr = (const LAS bf16_t*)(lds + A_ST + (ci & 1) * A_STSZ); LAS bf16_t* STw = (LAS bf16_t*)(lds + A_ST + ((ci + 1) & 1) * A_STSZ);
            u32x4 gpre[2] = {(u32x4){0u, 0u, 0u, 0u}, (u32x4){0u, 0u, 0u, 0u}};
            if (FULL && !metac) { const u32x4* gp = (const u32x4*)(PROJ + (size_t)(rowbase + (tid >> 3)) * NVG + gcol + 16 * (tid & 7)); gpre[0] = gp[0]; gpre[1] = gp[1]; }
            {
                float bc[8];
#pragma unroll
                for (int c = 0; c < 8; ++c) { float v = lav[c >> 2][c & 3];
                    v += __builtin_bit_cast(float, __builtin_amdgcn_update_dpp(0, __builtin_bit_cast(int, v), 0x111, 0xf, 0xf, true));
                    v += __builtin_bit_cast(float, __builtin_amdgcn_update_dpp(0, __builtin_bit_cast(int, v), 0x112, 0xf, 0xf, true));
                    v += __builtin_bit_cast(float, __builtin_amdgcn_update_dpp(0, __builtin_bit_cast(int, v), 0x114, 0xf, 0xf, true));
                    v += __builtin_bit_cast(float, __builtin_amdgcn_update_dpp(0, __builtin_bit_cast(int, v), 0x118, 0xf, 0xf, true));
                    v += __builtin_bit_cast(float, __builtin_amdgcn_update_dpp(0, __builtin_bit_cast(int, v), 0x142, 0xa, 0xf, false));
                    v += __builtin_bit_cast(float, __builtin_amdgcn_update_dpp(0, __builtin_bit_cast(int, v), 0x143, 0xc, 0xf, false));
                    bc[c] = v; }
                float tot[8];
#pragma unroll
                for (int c = 0; c < 8; ++c) { tot[c] = __builtin_bit_cast(float, __builtin_amdgcn_readlane(__builtin_bit_cast(int, bc[c]), 63)); blsum[c] += tot[c]; }
                const unsigned qw[4] = {qv8.x, qv8.y, qv8.z, qv8.w}, kw[4] = {kv8.x, kv8.y, kv8.z, kv8.w};
                unsigned oq[4], ok[4], oe[4];
#pragma unroll
                for (int c2 = 0; c2 < 4; ++c2) { const float k0 = bf_lo(kw[c2]), k1 = bf_hi(kw[c2]);
                    if (FULL) { oq[c2] = pk2(bf_lo(qw[c2]) * __expf(bc[2 * c2]), bf_hi(qw[c2]) * __expf(bc[2 * c2 + 1])); ok[c2] = pk2(k0 * __expf(-bc[2 * c2]), k1 * __expf(-bc[2 * c2 + 1])); }
                    oe[c2] = pk2(k0 * __expf(tot[2 * c2] - bc[2 * c2]), k1 * __expf(tot[2 * c2 + 1] - bc[2 * c2 + 1])); }
                if (FULL) { *(LAS u32x4*)(QT + lane * PQ + 8 * wave) = (u32x4){oq[0], oq[1], oq[2], oq[3]}; *(LAS u32x4*)(KT + lane * PQ + 8 * wave) = (u32x4){ok[0], ok[1], ok[2], ok[3]}; }
                *(LAS u32x4*)(KE + lane * PQ + 8 * wave) = (u32x4){oe[0], oe[1], oe[2], oe[3]};
                if (lane == 63) { *(LAS f32x4*)(DEC + 8 * wave) = (f32x4){__expf(tot[0]), __expf(tot[1]), __expf(tot[2]), __expf(tot[3])};
                                  *(LAS f32x4*)(DEC + 8 * wave + 4) = (f32x4){__expf(tot[4]), __expf(tot[5]), __expf(tot[6]), __expf(tot[7])}; }
                const int vr = tid >> 3, cc = tid & 7; LAS u32x4* dst = (LAS u32x4*)(VS + vr * PV + cc * 16); dst[0] = vreg[0]; dst[1] = vreg[1];
            }
            if (ci + 1 < nch) A_LOADCHUNK(ci + 1);
            A_LBAR();
            if (wave < 4) {
                if (FULL && !metac) {
                    const int w = wave;
                    bf16x8 qf[2];
#pragma unroll
                    for (int s = 0; s < 2; ++s) qf[s] = *(const LAS bf16x8*)(QT + (16 * w + r16) * PQ + 32 * s + 8 * g4);
                    f32x4 att[4];
#pragma unroll
                    for (int jb = 0; jb < 4; ++jb) { att[jb] = (f32x4){0.f, 0.f, 0.f, 0.f};
                        if (jb <= w) {
#pragma unroll
                            for (int s = 0; s < 2; ++s) { const bf16x8 kf = *(const LAS bf16x8*)(KT + (16 * jb + r16) * PQ + 32 * s + 8 * g4);
                                att[jb] = __builtin_amdgcn_mfma_f32_16x16x32_bf16(kf, qf[s], att[jb], 0, 0, 0); }
                            if (jb == w) {
#pragma unroll
                                for (int rg = 0; rg < 4; ++rg) att[jb][rg] = (4 * g4 + rg <= r16) ? att[jb][rg] : 0.f;
                            }
                        } }
                    bf16x8 af[2];
#pragma unroll
                    for (int s = 0; s < 2; ++s) { u32x4 t; t.x = pk2(att[2 * s][0], att[2 * s][1]); t.y = pk2(att[2 * s][2], att[2 * s][3]); t.z = pk2(att[2 * s + 1][0], att[2 * s + 1][1]); t.w = pk2(att[2 * s + 1][2], att[2 * s + 1][3]);
                        af[s] = __builtin_bit_cast(bf16x8, t); }
#pragma unroll
                    for (int cb = 0; cb < 8; ++cb) { f32x4 o = (f32x4){0.f, 0.f, 0.f, 0.f};
#pragma unroll
                        for (int s = 0; s < 2; ++s) {
                            const bf16x8 vf = tr2(VS + (32 * s + 4 * g4 + q4) * PV + 16 * cb + 4 * p4, VS + (32 * s + 16 + 4 * g4 + q4) * PV + 16 * cb + 4 * p4);
                            o = __builtin_amdgcn_mfma_f32_16x16x32_bf16(af[s], vf, o, 0, 0, 0);
                            const bf16x8 sf = *(const LAS bf16x8*)(STr + (16 * cb + r16) * PQ + 32 * s + 8 * g4);
                            o = __builtin_amdgcn_mfma_f32_16x16x32_bf16(qf[s], sf, o, 0, 0, 0); }
#pragma unroll
                        for (int rg = 0; rg < 4; ++rg) OB[(16 * w + 4 * g4 + rg) * POB + 16 * cb + r16] = o[rg]; }
                }
            } else {
                const int wq = wave - 4;
                float dec[4];
#pragma unroll
                for (int rg = 0; rg < 4; ++rg) dec[rg] = DEC[16 * wq + 4 * g4 + rg];
                bf16x8 kef[2];
#pragma unroll
                for (int s = 0; s < 2; ++s) kef[s] = tr2(KE + (32 * s + 8 * g4 + q4) * PQ + 16 * wq + 4 * p4, KE + (32 * s + 8 * g4 + 4 + q4) * PQ + 16 * wq + 4 * p4);
#pragma unroll
                for (int cb = 0; cb < 8; ++cb) {
#pragma unroll
                    for (int rg = 0; rg < 4; ++rg) accS[cb][rg] *= dec[rg];
#pragma unroll
                    for (int s = 0; s < 2; ++s) { const bf16x8 vf = tr2(VS + (32 * s + 8 * g4 + q4) * PV + 16 * cb + 4 * p4, VS + (32 * s + 8 * g4 + 4 + q4) * PV + 16 * cb + 4 * p4);
                        accS[cb] = __builtin_amdgcn_mfma_f32_16x16x32_bf16(kef[s], vf, accS[cb], 0, 0, 0); }
                    if (FULL) { u32x2 w; w.x = pk2(accS[cb][0], accS[cb][1]); w.y = pk2(accS[cb][2], accS[cb][3]); *(LAS u32x2*)(STw + (16 * cb + r16) * PQ + 16 * wq + 4 * g4) = w; }
                }
            }
            A_LBAR();
            if (FULL && !metac) {
                const int i = tid >> 3, cc = tid & 7;
                float o[16];
#pragma unroll
                for (int k4 = 0; k4 < 4; ++k4) { const f32x4 t = *(const LAS f32x4*)(OB + i * POB + 16 * cc + 4 * k4); o[4 * k4] = t[0]; o[4 * k4 + 1] = t[1]; o[4 * k4 + 2] = t[2]; o[4 * k4 + 3] = t[3]; }
                const size_t row = (size_t)(rowbase + i);
                const u32x4 ga = gpre[0], gb2 = gpre[1];
                const unsigned gw[8] = {ga.x, ga.y, ga.z, ga.w, gb2.x, gb2.y, gb2.z, gb2.w};
                float s1 = 0.f, s2 = 0.f;
#pragma unroll
                for (int k = 0; k < 16; ++k) { s1 += o[k]; s2 += o[k] * o[k]; }
#pragma unroll
                for (int m = 1; m < 8; m <<= 1) { s1 += __shfl_xor(s1, m); s2 += __shfl_xor(s2, m); }
                const float mu = gla ? 0.f : s1 * (1.0f / 128.0f);
                const float rs = __builtin_amdgcn_rsqf(fmaxf(s2 * (1.0f / 128.0f) - mu * mu, 0.f) + EPS);
                unsigned ow[8];
#pragma unroll
                for (int k2 = 0; k2 < 8; ++k2) { float y[2];
#pragma unroll
                    for (int e = 0; e < 2; ++e) { const int k = 2 * k2 + e; const float v = (o[k] - mu) * rs * gnv[k >> 2][k & 3] + bsv[k >> 2][k & 3];
                        const float gt = e ? bf_hi(gw[k2]) : bf_lo(gw[k2]); y[e] = v * gt * __builtin_amdgcn_rcpf(1.0f + __expf(-gt)); }
                    ow[k2] = pk2(y[0], y[1]); }
                u32x4* op = (u32x4*)(OUT + (row - 256) * DM + h8 * 128 + 16 * cc);
                op[0] = (u32x4){ow[0], ow[1], ow[2], ow[3]}; op[1] = (u32x4){ow[4], ow[5], ow[6], ow[7]};
            }
        }
        if (!FULL) {
            if (wave >= 4) { const int wq = wave - 4; float* Sg = metaitem ? SEGM + (size_t)h8 * 8192 : SEG + (size_t)item * 8192;
#pragma unroll
                for (int cb = 0; cb < 8; ++cb)
#pragma unroll
                    for (int rg = 0; rg < 4; ++rg) Sg[(16 * wq + 4 * g4 + rg) * 128 + 16 * cb + r16] = accS[cb][rg]; }
            if (lane < 8 && !metaitem) { float bl = blsum[0];
#pragma unroll
                for (int c = 1; c < 8; ++c) bl = (lane == c) ? blsum[c] : bl;
                ASEG[item * 64 + 8 * wave + lane] = __expf(bl); }
        }
#undef A_LBAR
#undef A_ROWBASE
#undef A_LOADCHUNK
    }
}

__device__ __forceinline__ unsigned ord32(float f) { const unsigned b = __builtin_bit_cast(unsigned, f); return b ^ ((b >> 31) ? 0xffffffffu : 0x80000000u); }
__device__ __forceinline__ float unord32(unsigned o) { const unsigned b = (o >> 31) ? (o ^ 0x80000000u) : ~o; return __builtin_bit_cast(float, b); }
#define DPP_MAXU(v, ctrl, rmask) do { const unsigned _t = (unsigned)__builtin_amdgcn_update_dpp((int)(v), (int)(v), (ctrl), (rmask), 0xf, false); (v) = (v) > _t ? (v) : _t; } while (0)
#define DPP_ADDF(v, ctrl) do { const float _t = __builtin_bit_cast(float, __builtin_amdgcn_update_dpp(0, __builtin_bit_cast(int, (v)), (ctrl), 0xf, 0xf, false)); (v) += _t; } while (0)
__device__ __forceinline__ unsigned row_max_u(unsigned v) { DPP_MAXU(v, 0xB1, 0xf); DPP_MAXU(v, 0x4E, 0xf); DPP_MAXU(v, 0x124, 0xf); DPP_MAXU(v, 0x128, 0xf); return v; }
__device__ __forceinline__ float row_sum_f(float v) { DPP_ADDF(v, 0xB1); DPP_ADDF(v, 0x4E); DPP_ADDF(v, 0x124); DPP_ADDF(v, 0x128); return v; }
__device__ __forceinline__ unsigned wave_max_u(unsigned v) { v = row_max_u(v); DPP_MAXU(v, 0x142, 0xa); DPP_MAXU(v, 0x143, 0xc); return (unsigned)__builtin_amdgcn_readlane((int)v, 63); }

__device__ __forceinline__ float row_sum_x(float v) { return row_sum_f(v); }
__device__ __forceinline__ float dot2_bf16(unsigned w, unsigned x, float acc) { return __builtin_amdgcn_fdot2_f32_bf16(__builtin_bit_cast(bf16x2_t, w), __builtin_bit_cast(bf16x2_t, x), acc, false); }
__device__ __forceinline__ float gelu_exact(float v) { return 0.5f * v * (1.0f + erff(v * 0.70710678118654752f)); }

__device__ __forceinline__ void phase_peer(const Params& p, LAS unsigned char* lds, int bid, int nb) {
    const int tid = threadIdx.x, lane = tid & 63, wave = __builtin_amdgcn_readfirstlane(tid >> 6);
    const int p16 = lane & 15, rg4 = lane >> 4;
    unsigned char* ws = p.ws;
    const _Float16* SC = (const _Float16*)(ws + WS_PROJ); const bf16_t* HB = (const bf16_t*)(ws + WS_HB); const float* SSQ = (const float*)(ws + WS_SSQ);
    const unsigned char* UB = (const unsigned char*)(ws + WS_UB); const unsigned char* VB = (const unsigned char*)(ws + WS_VB);
    LAS float* A_s = (LAS float*)(lds + wave * 4096);
    LAS int* A_i = (LAS int*)(lds + wave * 4096 + 1024);
    LAS int* E_i = (LAS int*)(lds + wave * 4096 + 2048);
    LAS float* E_s = (LAS float*)(lds + wave * 4096 + 2560);
    int ci = 0, cj = 0; bool cvalid = lane < 50;
    { int l = lane;
      if (l < 16) { ci = 0; cj = l; } else if (l < 24) { ci = 1; cj = l - 16; } else if (l < 29) { ci = 2; cj = l - 24; } else if (l < 33) { ci = 3; cj = l - 29; }
      else if (l < 36) { ci = 4; cj = l - 33; } else if (l < 42) { ci = 5 + (l - 36) / 2; cj = (l - 36) & 1; } else { ci = 8 + (l - 42); cj = 0; } if (!cvalid) { ci = 0; cj = 0; } }
    const int gw = bid * 8 + wave, NGW = nb * 8;
    for (int t = gw; t < NTOK; t += NGW) {
        float ssq = (lane < 16) ? SSQ[(size_t)t * 16 + lane] : 0.f; ssq = wave_sum(ssq);
        const float rstd = 1.0f / sqrtf(ssq * (1.0f / DM) + EPS);
#pragma unroll 1
        for (int q = 0; q < 4; ++q) {
            const u32x4 raw = *(const u32x4*)(SC + (size_t)t * 2048 + 512 * q + 8 * lane);
            const unsigned rw[4] = {raw.x, raw.y, raw.z, raw.w};
            unsigned key[8];
#pragma unroll
            for (int e = 0; e < 8; ++e) { const unsigned hbits = (e & 1) ? (rw[e >> 1] >> 16) : (rw[e >> 1] & 0xffffu);
                const float f = (float)__builtin_bit_cast(_Float16, (unsigned short)hbits);
                key[e] = (ord32(f) & ~0x7fu) | (unsigned)(127 - (8 * p16 + e)); }
            unsigned mine = 0u;
#pragma unroll 1
            for (int it = 0; it < 16; ++it) {
                unsigned m = key[0];
#pragma unroll
                for (int e = 1; e < 8; ++e) m = m > key[e] ? m : key[e];
                const unsigned W = row_max_u(m);
                mine = (p16 == it) ? W : mine;
#pragma unroll
                for (int e = 0; e < 8; ++e) key[e] = (key[e] == W) ? 0u : key[e];
            }
            const int g = 4 * q + rg4;
            A_s[g * 16 + p16] = unord32(mine & ~0x7fu); A_i[g * 16 + p16] = 127 - (int)(mine & 0x7fu);
        }
        LDS_WAIT();
#pragma unroll 1
        for (int h = 0; h < 8; ++h) {
            const float sa = A_s[(2 * h) * 16 + ci], sb = A_s[(2 * h + 1) * 16 + cj];
            const int ia = A_i[(2 * h) * 16 + ci], ib = A_i[(2 * h + 1) * 16 + cj];
            const float sum = sa + sb;
            unsigned key = cvalid ? ((ord32(sum) & ~0x3fu) | (unsigned)(63 - lane)) : 0u;
            int rank = -1;
#pragma unroll 1
            for (int it = 0; it < 16; ++it) { const unsigned W = wave_max_u(key); if (key == W) { rank = it; key = 0u; } }
            if (rank >= 0) { E_i[h * 16 + rank] = ia * 128 + ib; E_s[h * 16 + rank] = sum; }
        }
        LDS_WAIT();
        float gsm[2]; int eidx[2];
#pragma unroll
        for (int sl = 0; sl < 2; ++sl) { const int e = lane + 64 * sl; const float s = E_s[e] * rstd, mx = E_s[e & ~15] * rstd; const float pe = __expf(s - mx); const float den = row_sum_x(pe);
            gsm[sl] = pe / den; eidx[sl] = E_i[e]; }
#if PEER_FP8
        f32x2v xf[4][8];
#pragma unroll
        for (int i = 0; i < 4; ++i) { const u32x4 h0 = *(const u32x4*)(HB + (size_t)t * DM + 256 * i + 16 * p16), h1 = *(const u32x4*)(HB + (size_t)t * DM + 256 * i + 16 * p16 + 8);
            const unsigned hv[8] = {h0.x, h0.y, h0.z, h0.w, h1.x, h1.y, h1.z, h1.w}; const float* gp = p.g2 + 256 * i + 16 * p16;
#pragma unroll
            for (int k2 = 0; k2 < 8; ++k2) { const f32x2v g = *(const f32x2v*)(gp + 2 * k2); xf[i][k2] = (f32x2v){bf_lo(hv[k2]) * rstd * g.x, bf_hi(hv[k2]) * rstd * g.y}; } }
        constexpr int NBB = 2;
#define P6_LOADB(buf, TAB, bt0) do { _Pragma("unroll") for (int j = 0; j < NBB; ++j) { const int bt = (bt0) + j; const int ex = E_i[64 * (bt >> 4) + 16 * rg4 + (bt & 15)]; \
            const unsigned char* rp = (TAB) + (size_t)ex * 1024 + 16 * p16; _Pragma("unroll") for (int i = 0; i < 4; ++i) buf[j][i] = *(const u32x4*)(rp + 256 * i); } } while (0)
        u32x4 bA[NBB][4], bB[NBB][4];
        float act0 = 0.f, act1 = 0.f;
#define P6_COMPU(buf, bt0) do { _Pragma("unroll") for (int j = 0; j < NBB; ++j) { const int bt = (bt0) + j; f32x2v s2 = (f32x2v){0.f, 0.f}; \
            _Pragma("unroll") for (int i = 0; i < 4; ++i) { const unsigned uu[4] = {buf[j][i].x, buf[j][i].y, buf[j][i].z, buf[j][i].w}; \
                _Pragma("unroll") for (int w = 0; w < 4; ++w) { const f32x2v lo = __builtin_amdgcn_cvt_pk_f32_fp8((int)uu[w], false), hi = __builtin_amdgcn_cvt_pk_f32_fp8((int)uu[w], true); \
                    s2 = __builtin_elementwise_fma(lo, xf[i][2 * w], s2); s2 = __builtin_elementwise_fma(hi, xf[i][2 * w + 1], s2); } } \
            const float s = row_sum_x(s2.x + s2.y); const bool mine = (p16 == (bt & 15)); act0 = (mine && bt < 16) ? s : act0; act1 = (mine && bt >= 16) ? s : act1; } } while (0)
        P6_LOADB(bA, UB, 0);
#pragma unroll 1
        for (int g = 0; g < 32; g += 2 * NBB) { P6_LOADB(bB, UB, g + NBB); P6_COMPU(bA, g); if (g + 2 * NBB < 32) P6_LOADB(bA, UB, g + 2 * NBB); P6_COMPU(bB, g + NBB); }
        P6_LOADB(bA, VB, 0);
        LAS float* E_c = E_s;
        { const float c0 = gsm[0] * gelu_exact(act0 * (1.0f / 512.0f)) * (1.0f / 32.0f), c1 = gsm[1] * gelu_exact(act1 * (1.0f / 512.0f)) * (1.0f / 32.0f);
          LDS_WAIT(); E_c[lane] = c0; E_c[lane + 64] = c1; LDS_WAIT(); }
        f32x2v acc2[4][8];
#pragma unroll
        for (int i = 0; i < 4; ++i)
#pragma unroll
            for (int k = 0; k < 8; ++k) acc2[i][k] = (f32x2v){0.f, 0.f};
#define P6_COMPV(buf, bt0) do { _Pragma("unroll") for (int j = 0; j < NBB; ++j) { const int bt = (bt0) + j; const float cf = E_c[64 * (bt >> 4) + 16 * rg4 + (bt & 15)]; const f32x2v cf2 = (f32x2v){cf, cf}; \
            _Pragma("unroll") for (int i = 0; i < 4; ++i) { const unsigned vv[4] = {buf[j][i].x, buf[j][i].y, buf[j][i].z, buf[j][i].w}; \
                _Pragma("unroll") for (int w = 0; w < 4; ++w) { const f32x2v lo = __builtin_amdgcn_cvt_pk_f32_fp8((int)vv[w], false), hi = __builtin_amdgcn_cvt_pk_f32_fp8((int)vv[w], true); \
                    acc2[i][2 * w] = __builtin_elementwise_fma(lo, cf2, acc2[i][2 * w]); acc2[i][2 * w + 1] = __builtin_elementwise_fma(hi, cf2, acc2[i][2 * w + 1]); } } } } while (0)
#pragma unroll 1
        for (int g = 0; g < 32; g += 2 * NBB) { P6_LOADB(bB, VB, g + NBB); P6_COMPV(bA, g); if (g + 2 * NBB < 32) P6_LOADB(bA, VB, g + 2 * NBB); P6_COMPV(bB, g + NBB); }
#undef P6_LOADB
#undef P6_COMPU
#undef P6_COMPV
        float ss = 0.f;
#pragma unroll
        for (int i = 0; i < 4; ++i) { const u32x4 h0 = *(const u32x4*)(HB + (size_t)t * DM + 256 * i + 16 * p16), h1 = *(const u32x4*)(HB + (size_t)t * DM + 256 * i + 16 * p16 + 8);
            const unsigned hv[8] = {h0.x, h0.y, h0.z, h0.w, h1.x, h1.y, h1.z, h1.w};
#pragma unroll
            for (int k2 = 0; k2 < 8; ++k2) { float ax = acc2[i][k2].x, ay = acc2[i][k2].y;
                ax += __shfl_xor(ax, 16); ax += __shfl_xor(ax, 32); ay += __shfl_xor(ay, 16); ay += __shfl_xor(ay, 32);
                ax += bf_lo(hv[k2]); ay += bf_hi(hv[k2]); acc2[i][k2] = (f32x2v){ax, ay}; ss += ax * ax + ay * ay; } }
        ss = row_sum_x(ss);
        const float rf = 1.0f / sqrtf(ss * (1.0f / DM) + EPS);
#pragma unroll
        for (int i = 0; i < 4; ++i) { if (i == rg4) { const float* gp = p.gfin + 256 * i + 16 * p16; float* op = p.out + (size_t)t * DM + 256 * i + 16 * p16;
#pragma unroll
                for (int k4 = 0; k4 < 4; ++k4) { const f32x4 g = *(const f32x4*)(gp + 4 * k4);
                    *(f32x4*)(op + 4 * k4) = (f32x4){acc2[i][2 * k4].x * rf * g[0], acc2[i][2 * k4].y * rf * g[1], acc2[i][2 * k4 + 1].x * rf * g[2], acc2[i][2 * k4 + 1].y * rf * g[3]}; } } }
#else
        unsigned xp[8][4];
#pragma unroll
        for (int i = 0; i < 8; ++i) { const u32x4 hw = *(const u32x4*)(HB + (size_t)t * DM + 128 * i + 8 * p16); const f32x4 ga = *(const f32x4*)(p.g2 + 128 * i + 8 * p16), gb = *(const f32x4*)(p.g2 + 128 * i + 8 * p16 + 4);
            xp[i][0] = pk2(bf_lo(hw.x) * rstd * ga[0], bf_hi(hw.x) * rstd * ga[1]); xp[i][1] = pk2(bf_lo(hw.y) * rstd * ga[2], bf_hi(hw.y) * rstd * ga[3]);
            xp[i][2] = pk2(bf_lo(hw.z) * rstd * gb[0], bf_hi(hw.z) * rstd * gb[1]); xp[i][3] = pk2(bf_lo(hw.w) * rstd * gb[2], bf_hi(hw.w) * rstd * gb[3]); }
        float act[2] = {0.f, 0.f};
#pragma unroll
        for (int sl = 0; sl < 2; ++sl) {
#pragma unroll 2
            for (int b16 = 0; b16 < 16; ++b16) {
                const int e = 64 * sl + 16 * rg4 + b16; const int ex = E_i[e];
                const unsigned char* rowp = UB + (size_t)ex * 2048 + 16 * p16;
                float s = 0.f;
#pragma unroll
                for (int i = 0; i < 8; ++i) { const u32x4 uw = *(const u32x4*)(rowp + 256 * i);
                    s = dot2_bf16(uw.x, xp[i][0], s); s = dot2_bf16(uw.y, xp[i][1], s); s = dot2_bf16(uw.z, xp[i][2], s); s = dot2_bf16(uw.w, xp[i][3], s); }
                s = row_sum_x(s);
                act[sl] = (p16 == b16) ? s : act[sl];
            }
        }
        float coef[2];
#pragma unroll
        for (int sl = 0; sl < 2; ++sl) coef[sl] = gsm[sl] * gelu_exact(act[sl]);
        float acc[8][8];
#pragma unroll
        for (int i = 0; i < 8; ++i)
#pragma unroll
            for (int k = 0; k < 8; ++k) acc[i][k] = 0.f;
#pragma unroll
        for (int sl = 0; sl < 2; ++sl) {
#pragma unroll 2
            for (int b16 = 0; b16 < 16; ++b16) {
                const int srcl = (lane & 48) + b16;
                const float cf = __shfl(coef[sl], srcl); const int ex = __shfl(eidx[sl], srcl);
                const unsigned char* rowp = VB + (size_t)ex * 2048 + 16 * p16;
#pragma unroll
                for (int i = 0; i < 8; ++i) { const u32x4 vw = *(const u32x4*)(rowp + 256 * i);
                    acc[i][0] += cf * bf_lo(vw.x); acc[i][1] += cf * bf_hi(vw.x); acc[i][2] += cf * bf_lo(vw.y); acc[i][3] += cf * bf_hi(vw.y);
                    acc[i][4] += cf * bf_lo(vw.z); acc[i][5] += cf * bf_hi(vw.z); acc[i][6] += cf * bf_lo(vw.w); acc[i][7] += cf * bf_hi(vw.w); }
            }
        }
        float ss = 0.f;
#pragma unroll
        for (int i = 0; i < 8; ++i) { const u32x4 hw = *(const u32x4*)(HB + (size_t)t * DM + 128 * i + 8 * p16); const unsigned hv[4] = {hw.x, hw.y, hw.z, hw.w};
#pragma unroll
            for (int k = 0; k < 8; ++k) { float a = acc[i][k]; a += __shfl_xor(a, 16); a += __shfl_xor(a, 32);
                a += (k & 1) ? bf_hi(hv[k >> 1]) : bf_lo(hv[k >> 1]); acc[i][k] = a; ss += a * a; } }
        ss = row_sum_x(ss);
        const float rf = 1.0f / sqrtf(ss * (1.0f / DM) + EPS);
#pragma unroll
        for (int i = 0; i < 8; ++i) { if ((i >> 1) == rg4) { const f32x4 ga = *(const f32x4*)(p.gfin + 128 * i + 8 * p16), gb = *(const f32x4*)(p.gfin + 128 * i + 8 * p16 + 4);
                float* op = p.out + (size_t)t * DM + 128 * i + 8 * p16;
                *(f32x4*)op = (f32x4){acc[i][0] * rf * ga[0], acc[i][1] * rf * ga[1], acc[i][2] * rf * ga[2], acc[i][3] * rf * ga[3]};
                *(f32x4*)(op + 4) = (f32x4){acc[i][4] * rf * gb[0], acc[i][5] * rf * gb[1], acc[i][6] * rf * gb[2], acc[i][7] * rf * gb[3]}; } }
#endif
        LDS_WAIT();
    }
}


__device__ __forceinline__ void row_max4(unsigned k0, unsigned k1, unsigned k2, unsigned k3, unsigned& w0, unsigned& w1, unsigned& w2, unsigned& w3) {
    asm volatile("s_nop 1\n\t"
                 "v_max_u32_dpp %0, %4, %4 quad_perm:[1,0,3,2] row_mask:0xf bank_mask:0xf\n\t"
                 "v_max_u32_dpp %1, %5, %5 quad_perm:[1,0,3,2] row_mask:0xf bank_mask:0xf\n\t"
                 "v_max_u32_dpp %2, %6, %6 quad_perm:[1,0,3,2] row_mask:0xf bank_mask:0xf\n\t"
                 "v_max_u32_dpp %3, %7, %7 quad_perm:[1,0,3,2] row_mask:0xf bank_mask:0xf\n\t"
                 "v_max_u32_dpp %0, %0, %0 quad_perm:[2,3,0,1] row_mask:0xf bank_mask:0xf\n\t"
                 "v_max_u32_dpp %1, %1, %1 quad_perm:[2,3,0,1] row_mask:0xf bank_mask:0xf\n\t"
                 "v_max_u32_dpp %2, %2, %2 quad_perm:[2,3,0,1] row_mask:0xf bank_mask:0xf\n\t"
                 "v_max_u32_dpp %3, %3, %3 quad_perm:[2,3,0,1] row_mask:0xf bank_mask:0xf\n\t"
                 "v_max_u32_dpp %0, %0, %0 row_ror:4 row_mask:0xf bank_mask:0xf\n\t"
                 "v_max_u32_dpp %1, %1, %1 row_ror:4 row_mask:0xf bank_mask:0xf\n\t"
                 "v_max_u32_dpp %2, %2, %2 row_ror:4 row_mask:0xf bank_mask:0xf\n\t"
                 "v_max_u32_dpp %3, %3, %3 row_ror:4 row_mask:0xf bank_mask:0xf\n\t"
                 "v_max_u32_dpp %0, %0, %0 row_ror:8 row_mask:0xf bank_mask:0xf\n\t"
                 "v_max_u32_dpp %1, %1, %1 row_ror:8 row_mask:0xf bank_mask:0xf\n\t"
                 "v_max_u32_dpp %2, %2, %2 row_ror:8 row_mask:0xf bank_mask:0xf\n\t"
                 "v_max_u32_dpp %3, %3, %3 row_ror:8 row_mask:0xf bank_mask:0xf\n\t"
                 "s_nop 1"
                 : "=&v"(w0), "=&v"(w1), "=&v"(w2), "=&v"(w3) : "v"(k0), "v"(k1), "v"(k2), "v"(k3));
}
__device__ __forceinline__ unsigned pkadd_h2(unsigned a, unsigned b) { const h2v x = __builtin_bit_cast(h2v, a), y = __builtin_bit_cast(h2v, b); const h2v s = x + y; return __builtin_bit_cast(unsigned, s); }
constexpr int NT6 = 8;
constexpr int W6_BYTES = 16640;
__device__ __forceinline__ float dpp_f(float v, int ctrl_dummy);
#define DPPF(v, ctrl) __builtin_bit_cast(float, __builtin_amdgcn_update_dpp(0, __builtin_bit_cast(int, (v)), (ctrl), 0xf, 0xf, false))

__device__ __forceinline__ void phase_peer2(const Params& p, LAS unsigned char* lds, int bid, int nb) {
    const int tid = threadIdx.x, lane = tid & 63, wave = __builtin_amdgcn_readfirstlane(tid >> 6);
    const int p16 = lane & 15, rg4 = lane >> 4, q8 = lane >> 3, p8 = lane & 7;
    const bool b0 = lane & 1, b1 = lane & 2, b2 = lane & 4, c0 = lane & 8, c1 = lane & 16, c2 = lane & 32;
    unsigned char* ws = p.ws;
    const _Float16* SC = (const _Float16*)(ws + WS_PROJ); const bf16_t* HB = (const bf16_t*)(ws + WS_HB); const float* SSQ = (const float*)(ws + WS_SSQ);
    const unsigned char* UB = (const unsigned char*)(ws + WS_UB); const unsigned char* VB = (const unsigned char*)(ws + WS_VB); unsigned char* XQ = ws + WS_XQ; bf16_t* OS = (bf16_t*)(ws + WS_O);
    LAS unsigned char* wl = lds + wave * W6_BYTES;
    LAS unsigned* CW = (LAS unsigned*)wl;
    LAS unsigned char* XL = wl;
    LAS unsigned short* E16 = (LAS unsigned short*)(wl + 8192);
    LAS _Float16* GC = (LAS _Float16*)(wl + 10240);
    LAS unsigned* E32 = (LAS unsigned*)(wl + 4096);
    LAS float* ACT = (LAS float*)(wl + 12288);
    LAS float* RS = (LAS float*)(wl + 16384);
    const unsigned kbase[4] = {12288u + 4u * lane, 14336u + 4u * lane, 6144u + 4u * lane, ((lane >> 5) ? 5120u : 2048u) + 4u * (lane & 31)};
    constexpr unsigned kshift[4] = {8u, 8u, 8u, 7u};
    unsigned ixc[8];
#pragma unroll
    for (int e = 0; e < 8; ++e) ixc[e] = (unsigned)(127 - (8 * p16 + e));
    int ci = 0, cj = 0; bool cvalid = lane < 50;
    { int l = lane;
      if (l < 16) { ci = 0; cj = l; } else if (l < 24) { ci = 1; cj = l - 16; } else if (l < 29) { ci = 2; cj = l - 24; } else if (l < 33) { ci = 3; cj = l - 29; }
      else if (l < 36) { ci = 4; cj = l - 33; } else if (l < 42) { ci = 5 + (l - 36) / 2; cj = (l - 36) & 1; } else { ci = 8 + (l - 42); cj = 0; } if (!cvalid) { ci = 0; cj = 0; } }
    const int gw = bid * 8 + wave, NGW = nb * 8;
#define TOK6(k) min(base + (k) * NGW, NTOK - 1)
    for (int base = gw; base < NTOK; base += NT6 * NGW) {
#pragma unroll 1
        for (int rep_r = 0; rep_r < PROBE_R; ++rep_r)
#pragma unroll 1
        for (int k = 0; k < NT6; k += 2) {
            u32x4 raw[2][4]; float rstd[2];
#pragma unroll
            for (int v = 0; v < 2; ++v) { const int t = TOK6(k + v);
#pragma unroll
                for (int q = 0; q < 4; ++q) raw[v][q] = *(const u32x4*)(SC + (size_t)t * 2048 + 512 * q + 8 * lane);
                float ssq = (lane < 16) ? SSQ[(size_t)t * 16 + lane] : 0.f; ssq = wave_sum(ssq);
                rstd[v] = 1.0f / sqrtf(ssq * (1.0f / DM) + EPS);
                { const u32x4 ha = *(const u32x4*)(HB + (size_t)t * DM + 16 * lane), hb = *(const u32x4*)(HB + (size_t)t * DM + 16 * lane + 8); const float sc = rstd[v] * 16.0f;
                  const unsigned hv[8] = {ha.x, ha.y, ha.z, ha.w, hb.x, hb.y, hb.z, hb.w}; unsigned xw[4];
#pragma unroll
                  for (int w = 0; w < 4; ++w) { int pk = __builtin_amdgcn_cvt_pk_fp8_f32(bf_lo(hv[2 * w]) * sc, bf_hi(hv[2 * w]) * sc, 0, false);
                      pk = __builtin_amdgcn_cvt_pk_fp8_f32(bf_lo(hv[2 * w + 1]) * sc, bf_hi(hv[2 * w + 1]) * sc, pk, true); xw[w] = (unsigned)pk; }
                  *(u32x4*)(XQ + (size_t)t * DM + 16 * lane) = (u32x4){xw[0], xw[1], xw[2], xw[3]}; } }
#pragma unroll
            for (int qq = 0; qq < 2; ++qq) {
                unsigned ka[4][8];
#pragma unroll
                for (int c = 0; c < 4; ++c) { const u32x4 rv = raw[c >> 1][2 * qq + (c & 1)]; const unsigned rw[4] = {rv.x, rv.y, rv.z, rv.w};
#pragma unroll
                    for (int i = 0; i < 4; ++i) {
                        const s16x2 hv2 = __builtin_bit_cast(s16x2, rw[i]); const s16x2 sg = hv2 >> 15; const unsigned kk = rw[i] ^ (__builtin_bit_cast(unsigned, sg) | 0x80008000u);
                        ka[c][2 * i] = (kk << 16) | ixc[2 * i]; ka[c][2 * i + 1] = (kk & 0xffff0000u) | ixc[2 * i + 1]; } }
#define CE6(u, i, j) do { const unsigned _a = ka[u][i], _b = ka[u][j]; ka[u][i] = _a > _b ? _a : _b; ka[u][j] = _a > _b ? _b : _a; } while (0)
#pragma unroll
                for (int u = 0; u < 4; ++u) {
                    CE6(u, 0, 1); CE6(u, 2, 3); CE6(u, 4, 5); CE6(u, 6, 7);
                    CE6(u, 0, 2); CE6(u, 1, 3); CE6(u, 4, 6); CE6(u, 5, 7);
                    CE6(u, 1, 2); CE6(u, 5, 6);
                    CE6(u, 0, 4); CE6(u, 1, 5); CE6(u, 2, 6); CE6(u, 3, 7);
                    CE6(u, 2, 4); CE6(u, 3, 5);
                    CE6(u, 1, 2); CE6(u, 3, 4); CE6(u, 5, 6);
                }
#undef CE6
                unsigned mine[4] = {0u, 0u, 0u, 0u};
                unsigned head[4], nxt[4], kptr[4] = {0u, 0u, 0u, 0u};
#pragma unroll
                for (int c = 0; c < 4; ++c) { head[c] = ka[c][0]; nxt[c] = ka[c][1];
#pragma unroll
                    for (int j = 0; j < 8; ++j) *(LAS unsigned*)(wl + kbase[c] + (j << kshift[c])) = (j < 7) ? ka[c][j + 1] : 0u; }
#pragma unroll 1
                for (int it = 0; it < 16; ++it) {
                    unsigned Wv[4]; row_max4(head[0], head[1], head[2], head[3], Wv[0], Wv[1], Wv[2], Wv[3]);
#pragma unroll
                    for (int c = 0; c < 4; ++c) {
                        const unsigned W = Wv[c];
                        mine[c] = (p16 == it) ? W : mine[c];
                        const bool win = (head[c] == W);
                        head[c] = win ? nxt[c] : head[c];
                        kptr[c] += win ? 1u : 0u;
                        nxt[c] = *(const LAS unsigned*)(wl + kbase[c] + (kptr[c] << kshift[c]));
                    }
                }
#pragma unroll
                for (int c = 0; c < 4; ++c) { const int g = 4 * (2 * qq + (c & 1)) + rg4; LAS int* A_s = (LAS int*)(wl + 3072 * (c >> 1)); LAS int* A_i = (LAS int*)(wl + 3072 * (c >> 1) + 1024);
                    const unsigned k16 = mine[c] >> 16; const unsigned hbits = k16 ^ ((k16 & 0x8000u) ? 0x8000u : 0xffffu);
                    const float fs = (float)__builtin_bit_cast(_Float16, (unsigned short)hbits);
                    A_s[g * 16 + p16] = (int)__builtin_rintf(fs * 16384.0f); A_i[g * 16 + p16] = 127 - (int)(mine[c] & 0x7fu); }
            }
            LDS_WAIT();
            {
                int av[4], bc[4]; int iav[4], ibc[4], jp[4], hh[4], bb[4]; unsigned key[4];
#pragma unroll
                for (int c = 0; c < 4; ++c) { const LAS int* A_s = (const LAS int*)(wl + 3072 * (c >> 1)); const LAS int* A_i = (const LAS int*)(wl + 3072 * (c >> 1) + 1024);
                    hh[c] = 4 * (c & 1) + rg4; bb[c] = (2 * hh[c] + 1) * 16; av[c] = A_s[(2 * hh[c]) * 16 + p16] + (1 << 20); iav[c] = A_i[(2 * hh[c]) * 16 + p16] * 128; jp[c] = 0; bc[c] = A_s[bb[c]]; ibc[c] = A_i[bb[c]];
                    key[c] = ((unsigned)(av[c] + bc[c]) << 4) | (unsigned)(15 - p16); }
#pragma unroll 1
                for (int it = 0; it < 16; ++it) {
                    unsigned Wv[4]; row_max4(key[0], key[1], key[2], key[3], Wv[0], Wv[1], Wv[2], Wv[3]);
#pragma unroll
                    for (int c = 0; c < 4; ++c) {
                        const LAS int* A_s = (const LAS int*)(wl + 3072 * (c >> 1)); const LAS int* A_i = (const LAS int*)(wl + 3072 * (c >> 1) + 1024);
                        LAS int* E_i = (LAS int*)(wl + 3072 * (c >> 1) + 2048); LAS int* E_s = (LAS int*)(wl + 3072 * (c >> 1) + 2560);
                        const bool win = (key[c] == Wv[c]);
                        if (win) { E_i[hh[c] * 16 + it] = iav[c] + ibc[c]; E_s[hh[c] * 16 + it] = av[c] + bc[c]; }
                        jp[c] += win ? 1 : 0;
                        const int jr = jp[c] < 16 ? jp[c] : 15;
                        bc[c] = A_s[bb[c] + jr]; ibc[c] = A_i[bb[c] + jr];
                        key[c] = jp[c] < 16 ? (((unsigned)(av[c] + bc[c]) << 4) | (unsigned)(15 - p16)) : 0u;
                    }
                }
            }
            LDS_WAIT();
#pragma unroll
            for (int v = 0; v < 2; ++v) { const LAS int* E_i = (const LAS int*)(wl + 3072 * v + 2048); const LAS int* E_s = (const LAS int*)(wl + 3072 * v + 2560);
#pragma unroll
                for (int sl = 0; sl < 2; ++sl) { const int e = lane + 64 * sl; const float pe = __expf((float)(E_s[e] - E_s[e & ~15]) * (rstd[v] * (1.0f / 16384.0f))); const float den = row_sum_x(pe);
                    const int pos = 16 * (e & 7) + (e >> 3);
                    GC[(k + v) * 128 + pos] = (_Float16)(pe / den); E16[(k + v) * 128 + pos] = (unsigned short)E_i[e]; }
                if (lane == 0) RS[k + v] = rstd[v]; }
            LDS_WAIT();
        }
#define P6_LOADH(buf, TAB, jj, kk, hh) do { const u32x4 _iv = *(const LAS u32x4*)(E16 + (kk) * 128 + 16 * q8 + 8 * (hh)); const unsigned _iw[4] = {_iv.x, _iv.y, _iv.z, _iv.w}; \
            _Pragma("unroll") for (int c = 0; c < 8; ++c) { const unsigned _idx = (c & 1) ? (_iw[c >> 1] >> 16) : (_iw[c >> 1] & 0xffffu); \
                buf[c] = *(const u32x4*)((TAB) + (((size_t)(jj) * NEXP + _idx) << 7) + 16 * p8); } } while (0)
#define P6_LOADX(hb, jj, kk) do { const bf16_t* _hp = HB + (size_t)TOK6(kk) * DM + 128 * (jj) + 16 * p8; hb[0] = *(const u32x4*)_hp; hb[1] = *(const u32x4*)(_hp + 8); } while (0)
        asm volatile("s_waitcnt vmcnt(0)" ::: "memory");
        { u32x4 xr[NT6];
#pragma unroll
          for (int k = 0; k < NT6; ++k) xr[k] = *(const u32x4*)(XQ + (size_t)TOK6(k) * DM + 16 * lane);
#pragma unroll
          for (int k = 0; k < NT6; ++k) *(LAS u32x4*)(XL + k * 1024 + 16 * lane) = xr[k]; }
        LDS_WAIT();
#pragma unroll 1
        for (int rep_u = 0; rep_u < PROBE_U; ++rep_u) {
            for (int k = 0; k < NT6; ++k) { ACT[k * 128 + lane] = 0.f; ACT[k * 128 + 64 + lane] = 0.f; }
            LDS_WAIT();
            const int n16 = lane & 15, g4 = lane >> 4, c4 = lane & 3, r16 = 4 * g4 + (n16 >> 2);
            const int eoff = 2 * (16 * (r16 & 7) + (r16 >> 3));
            const bool xkeep = ((g4 >> 1) == ((n16 >> 2) & 1)); const bool klo = xkeep && (n16 < 8), khi = xkeep && (n16 >= 8);
            u32x4 bfP[16], bfQ[16];
#define P6_ULOAD(buf, nn) do { const int _j = (nn) / NT6, _k = (nn) % NT6; const LAS unsigned char* _ip = (const LAS unsigned char*)(E16 + _k * 128) + eoff; \
                _Pragma("unroll") for (int T = 0; T < 8; ++T) { const unsigned _idx = *(const LAS unsigned short*)(_ip + 4 * T); \
                    const unsigned char* _rp = UB + (((size_t)_j * NEXP + _idx) << 7) + 16 * c4; buf[2 * T] = *(const u32x4*)_rp; buf[2 * T + 1] = *(const u32x4*)(_rp + 64); } } while (0)
#define P6_PK64(lo, hi) ((long)(((unsigned long long)(hi) << 32) | (unsigned long long)(lo)))
#define P6_UMMA(buf, nn) do { const int k = (nn) % NT6; const LAS unsigned char* _xl = XL + k * 1024 + 256 * ((nn) / NT6) + 32 * c4 + 16 * (g4 & 1); \
                const u32x4 xv0 = *(const LAS u32x4*)_xl, xv1 = *(const LAS u32x4*)(_xl + 128); \
                const i32x8 xa0 = {(int)(klo ? xv0.x : 0u), (int)(klo ? xv0.y : 0u), (int)(klo ? xv0.z : 0u), (int)(klo ? xv0.w : 0u), \
                                   (int)(khi ? xv0.x : 0u), (int)(khi ? xv0.y : 0u), (int)(khi ? xv0.z : 0u), (int)(khi ? xv0.w : 0u)}; \
                const i32x8 xa1 = {(int)(klo ? xv1.x : 0u), (int)(klo ? xv1.y : 0u), (int)(klo ? xv1.z : 0u), (int)(klo ? xv1.w : 0u), \
                                   (int)(khi ? xv1.x : 0u), (int)(khi ? xv1.y : 0u), (int)(khi ? xv1.z : 0u), (int)(khi ? xv1.w : 0u)}; \
                float dsel[2] = {0.f, 0.f}; \
                _Pragma("unroll") for (int T = 0; T < 8; ++T) { f32x4 d = (f32x4){0.f, 0.f, 0.f, 0.f}; \
                    const i32x8 bb0 = {(int)buf[2 * T].x, (int)buf[2 * T].y, (int)buf[2 * T].z, (int)buf[2 * T].w, 0, 0, 0, 0}; \
                    const i32x8 bb1 = {(int)buf[2 * T + 1].x, (int)buf[2 * T + 1].y, (int)buf[2 * T + 1].z, (int)buf[2 * T + 1].w, 0, 0, 0, 0}; \
                    d = __builtin_amdgcn_mfma_scale_f32_16x16x128_f8f6f4(xa0, bb0, d, 0, 4, 0, MX_ONE, 0, MX_ONE); \
                    d = __builtin_amdgcn_mfma_scale_f32_16x16x128_f8f6f4(xa1, bb1, d, 0, 4, 0, MX_ONE, 0, MX_ONE); \
                    float pv = (c4 == 0) ? d[0] : ((c4 == 1) ? d[1] : ((c4 == 2) ? d[2] : d[3])); \
                    pv += DPPF(pv, 0xB1); pv += DPPF(pv, 0x4E);                         \
                    dsel[T >> 2] = ((T & 3) == c4) ? pv : dsel[T >> 2]; } \
                  \
                ACT[k * 128 + 16 * c4 + r16] += dsel[0]; ACT[k * 128 + 16 * (c4 + 4) + r16] += dsel[1]; } while (0)
            P6_ULOAD(bfP, 0);
#pragma unroll 1
            for (int n = 0; n < 4 * NT6; n += 2) {
                P6_ULOAD(bfQ, n + 1); asm volatile("" ::: "memory"); __builtin_amdgcn_sched_barrier(0);
                P6_UMMA(bfP, n); __builtin_amdgcn_sched_barrier(0);
                if (n + 2 < 4 * NT6) P6_ULOAD(bfP, n + 2);
                asm volatile("" ::: "memory"); __builtin_amdgcn_sched_barrier(0);
                P6_UMMA(bfQ, n + 1); __builtin_amdgcn_sched_barrier(0);
            }
#undef P6_ULOAD
#undef P6_UMMA
#undef P6_PK64
        }
        LDS_WAIT();
#pragma unroll 1
        for (int k = 0; k < NT6; ++k) {
#pragma unroll
            for (int sl = 0; sl < 2; ++sl) { const int e = lane + 64 * sl, pos = 16 * (e & 7) + (e >> 3); const float a = ACT[k * 128 + e] * (1.0f / 1024.0f);
                const float cfv = (float)GC[k * 128 + pos] * gelu_exact(a);
                CW[k * 128 + pos] = (unsigned)(__builtin_amdgcn_cvt_pk_fp8_f32(cfv * 32.0f, 0.f, 0, false) & 0xff) * 0x01010101u; E32[k * 128 + pos] = (unsigned)E16[k * 128 + pos] << 7; } }
        LDS_WAIT();
#pragma unroll 1
        for (int k = 0; k < NT6; ++k) ACT[k * 64 + lane] = 0.f;
        LDS_WAIT();
#pragma unroll 1
        for (int rep_v = 0; rep_v < PROBE_V; ++rep_v) {
            for (int k = 0; k < NT6; ++k) ACT[k * 64 + lane] = 0.f;
            LDS_WAIT();
            u32x4 bfP[16], bfQ[16];
            const int n16 = lane & 15, g4 = lane >> 4;
            const unsigned bsel = 0xffu << (8 * (n16 & 3));
            const unsigned M0 = (n16 >> 2) == 0 ? bsel : 0u, M1 = (n16 >> 2) == 1 ? bsel : 0u, M2 = (n16 >> 2) == 2 ? bsel : 0u, M3 = (n16 >> 2) == 3 ? bsel : 0u;
            const int c0 = 16 * n16 + 4 * g4;
            const unsigned loff = 8u * (unsigned)n16;
#define P6_VLOAD(buf, nn) do { const int _j = (nn) / NT6, _k = (nn) % NT6; const LAS unsigned* _ip = E32 + _k * 128 + 32 * g4; \
                const unsigned char* _tb = VB + (size_t)_j * NEXP * 128; \
                _Pragma("unroll") for (int q = 0; q < 4; ++q) { const u32x4 _o0 = *(const LAS u32x4*)(_ip + 4 * q), _o1 = *(const LAS u32x4*)(_ip + 16 + 4 * q); \
                    const unsigned _ow0[4] = {_o0.x, _o0.y, _o0.z, _o0.w}, _ow1[4] = {_o1.x, _o1.y, _o1.z, _o1.w}; \
                    _Pragma("unroll") for (int cc = 0; cc < 4; ++cc) { \
                        const u32x2 _t0 = *(const u32x2*)(_tb + (size_t)(_ow0[cc] + loff)), _t1 = *(const u32x2*)(_tb + (size_t)(_ow1[cc] + loff)); \
                        buf[4 * q + cc] = (u32x4){_t0.x, _t0.y, _t1.x, _t1.y}; } } } while (0)
#define P6_LOADR2(hb, nn) do { hb = *(const u32x2*)(HB + (size_t)TOK6((nn) % NT6) * DM + 256 * ((nn) / NT6) + c0); } while (0)
#define P6_VBODY(buf, nn, hb) do { const int j = (nn) / NT6, k = (nn) % NT6; const int t = TOK6(k); \
                const LAS unsigned* _cp = CW + k * 128 + 16 * g4; \
                const u32x4 _c0 = *(const LAS u32x4*)_cp, _c1 = *(const LAS u32x4*)(_cp + 4), _c2 = *(const LAS u32x4*)(_cp + 8), _c3 = *(const LAS u32x4*)(_cp + 12); \
                const u32x4 _d0 = *(const LAS u32x4*)(_cp + 64), _d1 = *(const LAS u32x4*)(_cp + 68), _d2 = *(const LAS u32x4*)(_cp + 72), _d3 = *(const LAS u32x4*)(_cp + 76); \
                const unsigned _cl[16] = {_c0.x, _c0.y, _c0.z, _c0.w, _c1.x, _c1.y, _c1.z, _c1.w, _c2.x, _c2.y, _c2.z, _c2.w, _c3.x, _c3.y, _c3.z, _c3.w}; \
                const unsigned _ch[16] = {_d0.x, _d0.y, _d0.z, _d0.w, _d1.x, _d1.y, _d1.z, _d1.w, _d2.x, _d2.y, _d2.z, _d2.w, _d3.x, _d3.y, _d3.z, _d3.w}; \
                f32x4 dA = (f32x4){0.f, 0.f, 0.f, 0.f}, dB = (f32x4){0.f, 0.f, 0.f, 0.f}; \
                _Pragma("unroll") for (int c = 0; c < 16; ++c) { const unsigned _l = _cl[c], _h = _ch[c]; \
                    const i32x8 av = {(int)(_l & M0), (int)(_l & M1), (int)(_l & M2), (int)(_l & M3), (int)(_h & M0), (int)(_h & M1), (int)(_h & M2), (int)(_h & M3)}; \
                    const i32x8 bv = {(int)buf[c].x, (int)buf[c].y, (int)buf[c].z, (int)buf[c].w, 0, 0, 0, 0}; \
                    if (c & 1) dB = __builtin_amdgcn_mfma_scale_f32_16x16x128_f8f6f4(av, bv, dB, 0, 4, 0, MX_ONE, 0, MX_ONE); \
                    else       dA = __builtin_amdgcn_mfma_scale_f32_16x16x128_f8f6f4(av, bv, dA, 0, 4, 0, MX_ONE, 0, MX_ONE); } \
                const float hv[4] = {bf_lo(hb.x), bf_hi(hb.x), bf_lo(hb.y), bf_hi(hb.y)}; float o[4]; float ss = 0.f; \
                _Pragma("unroll") for (int r = 0; r < 4; ++r) { o[r] = (dA[r] + dB[r]) * (1.0f / (32.0f * V4_SCALE)) + hv[r]; ss += o[r] * o[r]; } \
                *(u32x2*)(OS + (size_t)t * DM + 256 * j + c0) = (u32x2){pk2(o[0], o[1]), pk2(o[2], o[3])};     \
                ACT[k * 64 + lane] += ss; \
                } while (0)
            P6_VLOAD(bfP, 0);
#pragma unroll 1
            for (int n = 0; n < 4 * NT6; n += 2) {
                u32x2 hr0, hr1; P6_LOADR2(hr0, n); P6_LOADR2(hr1, n + 1);
                asm volatile("" ::: "memory");
                P6_VLOAD(bfQ, n + 1); asm volatile("" ::: "memory"); __builtin_amdgcn_sched_barrier(0);
                P6_VBODY(bfP, n, hr0); __builtin_amdgcn_sched_barrier(0);
                if (n + 2 < 4 * NT6) P6_VLOAD(bfP, n + 2);
                asm volatile("" ::: "memory"); __builtin_amdgcn_sched_barrier(0);
                P6_VBODY(bfQ, n + 1, hr1); __builtin_amdgcn_sched_barrier(0);
            }
            LDS_WAIT(); asm volatile("s_waitcnt vmcnt(0)" ::: "memory");
            f32x4 gfv[4];
#pragma unroll
            for (int i = 0; i < 4; ++i) gfv[i] = *(const f32x4*)(p.gfin + 256 * i + 4 * lane);
#pragma unroll 1
            for (int k = 0; k < NT6; ++k) { const float sst = wave_sum(ACT[k * 64 + lane]); const float rf = __builtin_amdgcn_rsqf(sst * (1.0f / DM) + EPS);
                float* op = p.out + (size_t)TOK6(k) * DM + 4 * lane; const bf16_t* sp = OS + (size_t)TOK6(k) * DM + 4 * lane; u32x2 ov[4];
#pragma unroll
                for (int i = 0; i < 4; ++i) ov[i] = *(const u32x2*)(sp + 256 * i);
#pragma unroll
                for (int i = 0; i < 4; ++i) *(f32x4*)(op + 256 * i) = (f32x4){bf_lo(ov[i].x), bf_hi(ov[i].x), bf_lo(ov[i].y), bf_hi(ov[i].y)} * rf * gfv[i]; }
        }
        LDS_WAIT();
    }
#undef P6_LOADH
#undef P6_LOADX
#undef P6_VLOAD
#undef P6_VBODY
#undef P6_LOADR2
#undef P6_PK64
#undef TOK6
}

#define XB_TMO      128
#define XB_XCNT(j)  (256  + 64 * (j))
#define XB_XSUB(j)  (1280 + 64 * (j))
#define XB_XGEN(j)  (2304 + 64 * (j))
#define XB_TOP      3328
#define XB_TOPGEN   3392
#define XCD_BAR_WORDS 3456
#define XB_SPIN_CAP (1u << 18)

__device__ __forceinline__ unsigned xb_ld(unsigned* p)              { return __hip_atomic_load(p, __ATOMIC_RELAXED, __HIP_MEMORY_SCOPE_AGENT); }
__device__ __forceinline__ unsigned xb_add(unsigned* p, unsigned v) { return __hip_atomic_fetch_add(p, v, __ATOMIC_RELAXED, __HIP_MEMORY_SCOPE_AGENT); }
__device__ __forceinline__ unsigned xb_xcc_id() { return (unsigned)__builtin_amdgcn_s_getreg((3 << 11) | 20) & 0xFu; }
#define XB_SPIN(cond, bar) do { unsigned _sp = 0; while (cond) { __builtin_amdgcn_s_sleep(1); \
    if ((++_sp & 255u) == 0u) { if (xb_ld(&(bar)[XB_TMO])) break; if (_sp > XB_SPIN_CAP) { atomicAdd(&(bar)[XB_TMO], 1u); break; } } } } while (0)

struct XcdBarrier {
    unsigned* bar; unsigned x;
    volatile LAS unsigned* st;
};

__device__ __forceinline__ XcdBarrier xcd_barrier_post(unsigned* bar, volatile LAS unsigned* st) {
    XcdBarrier b; b.bar = bar; b.x = xb_xcc_id(); b.st = st;
    if (threadIdx.x == 0) (void)xb_add(&bar[XB_XCNT(b.x)], 1u);
    return b;
}
__device__ __forceinline__ void xcd_barrier_complete(unsigned* bar, unsigned x, unsigned& nloc, unsigned& nx) {
    const unsigned G = gridDim.x * gridDim.y * gridDim.z;
    unsigned sum, cnt, mine, sp = 0u;
    for (;;) {
        sum = 0u; cnt = 0u; mine = 0u;
#pragma unroll
        for (unsigned j = 0; j < 16; ++j) { const unsigned c = xb_ld(&bar[XB_XCNT(j)]); sum += c; cnt += (c > 0u) ? 1u : 0u; mine = (j == x) ? c : mine; }
        if (sum == G) break;
        __builtin_amdgcn_s_sleep(1);
        if ((++sp & 255u) == 0u) { if (xb_ld(&bar[XB_TMO])) break; if (sp > XB_SPIN_CAP) { atomicAdd(&bar[XB_TMO], 1u); break; } }
    }
    nloc = mine > 0u ? mine : 1u; nx = cnt > 0u ? cnt : 1u;
}

__device__ __forceinline__ void xcd_barrier(const XcdBarrier& b) {
    asm volatile("s_waitcnt vmcnt(0)" ::: "memory");
    __syncthreads();
    if (threadIdx.x == 0) {
        unsigned* bar = b.bar;
        __builtin_amdgcn_s_waitcnt(0);
        unsigned nloc = b.st[0], nx = b.st[1];
        if (nloc == 0u) { xcd_barrier_complete(bar, b.x, nloc, nx); b.st[0] = nloc; b.st[1] = nx; }
        const unsigned old = xb_add(&bar[XB_XSUB(b.x)], 1u);
        const unsigned gen = old / nloc;
        if (old + 1u == (gen + 1u) * nloc) {
            __builtin_amdgcn_fence(__ATOMIC_RELEASE, "agent");
            asm volatile("s_waitcnt vmcnt(0)" ::: "memory");
            const unsigned og = xb_add(&bar[XB_TOP], 1u);
            const unsigned tg = og / nx;
            if (og + 1u == (tg + 1u) * nx) xb_add(&bar[XB_TOPGEN], 1u);
            else XB_SPIN(xb_ld(&bar[XB_TOPGEN]) == tg, bar);
            __builtin_amdgcn_fence(__ATOMIC_ACQUIRE, "agent");
            xb_add(&bar[XB_XGEN(b.x)], 1u);
            asm volatile("s_waitcnt vmcnt(0)" ::: "memory");
        } else {
            XB_SPIN(xb_ld(&bar[XB_XGEN(b.x)]) == gen, bar);
            __builtin_amdgcn_fence(__ATOMIC_ACQUIRE, "agent");
            asm volatile("s_waitcnt vmcnt(0)" ::: "memory");
        }
    }
    __syncthreads();
}

__global__ void __launch_bounds__(512, 2) mk_fwd(Params p) {
    extern __shared__ __attribute__((aligned(16))) unsigned char lds_raw[];
    LAS unsigned char* lds = (LAS unsigned char*)lds_raw;
    const int bid = blockIdx.x, nb = gridDim.x;
    unsigned char* ws = p.ws;
#define IN(k) (p.ph_lo <= (k) && (k) < p.ph_hi)
#define SEAM(k) do { if (IN(k) && IN((k) + 1)) { xcd_barrier(bar); } } while (0)
    if (threadIdx.x < 4) ((volatile LAS unsigned*)(lds + LDS_BYTES - 16))[threadIdx.x] = 0u;
    __syncthreads();
    const XcdBarrier bar = xcd_barrier_post((unsigned*)(ws + WS_CTL) + 4096, (volatile LAS unsigned*)(lds + LDS_BYTES - 16));
    if (IN(0)) phase0(p, lds, bid, nb);
    SEAM(0);
    if (IN(1)) {
        pg8::Gemm g{(const bf16_t*)(ws + WS_XN), (const bf16_t*)(ws + WS_WIN), MROWS, NP1, DM}; pg8::StaticOrder S; S.init(MROWS, NP1, nb, bid);
        EpiProj E{(bf16_t*)(ws + WS_PROJ), (bf16_t*)(ws + WS_QK), (float*)(ws + WS_LA), p.gb, (const float2*)(ws + WS_ROPE)};
        pg8::gemm_phase<EpiProj, pg8::StaticOrder, true, true>(lds, g, S, E);
    }
    SEAM(1);
    if (IN(2)) attn_pass<false>(p, lds, bid, nb);
    SEAM(2);
    if (IN(3)) attn_pass<true>(p, lds, bid, nb);
    SEAM(3);
    if (IN(4)) {
        pg8::Gemm g{(const bf16_t*)(ws + WS_O), (const bf16_t*)(ws + WS_WOUT), NTOK, DM, DM}; pg8::StaticOrder S; S.init(NTOK, DM, nb, bid);
        EpiRes E{(bf16_t*)(ws + WS_HB), (float*)(ws + WS_SSQ), (const float*)(ws + WS_RINV), (const float*)(ws + WS_GINV)};
        pg8::gemm_phase<EpiRes, pg8::StaticOrder, true, true>(lds, g, S, E);
    }
    SEAM(4);
    if (IN(5)) {
        pg8::Gemm g{(const bf16_t*)(ws + WS_HB), (const bf16_t*)(ws + WS_WS), NTOK, 2048, DM}; pg8::StaticOrder S; S.init(NTOK, 2048, nb, bid);
        EpiF16 E{(_Float16*)(ws + WS_PROJ)};
        pg8::gemm_phase<EpiF16, pg8::StaticOrder, true, true>(lds, g, S, E);
    }
    SEAM(5);
    if (IN(6)) phase_peer2(p, lds, bid, nb);
#undef IN
#undef SEAM
}

#ifndef MK_FUSED
#define MK_FUSED 1
#endif
extern "C" void kernel_launch(void* const* d_in, const int* in_sizes, int n_in, void* d_out, int out_size, void* d_ws, size_t ws_size, hipStream_t stream) {
    static int grid = 0;
    if (grid == 0) {
        if (n_in != 16 || in_sizes[0] != NTOK * DM || out_size != NTOK * DM || ws_size < WS_END) {
            fprintf(stderr, "kernel_launch: unexpected shapes (n_in %d, in0 %d, out %d, ws %zu); nothing launched\n", n_in, n_in > 0 ? in_sizes[0] : -1, out_size, ws_size); grid = -1; return; }
        int dev = 0, cus = 0, per_cu = 0;
        hipGetDevice(&dev); hipDeviceGetAttribute(&cus, hipDeviceAttributeMultiprocessorCount, dev);
        if (hipFuncSetAttribute((const void*)mk_fwd, hipFuncAttributeMaxDynamicSharedMemorySize, LDS_BYTES) != hipSuccess) { fprintf(stderr, "kernel_launch: hipFuncSetAttribute failed\n"); grid = -1; return; }
        if (hipOccupancyMaxActiveBlocksPerMultiprocessor(&per_cu, (const void*)mk_fwd, 512, LDS_BYTES) != hipSuccess || per_cu < 1) { fprintf(stderr, "kernel_launch: occupancy query failed (%d)\n", per_cu); (void)hipGetLastError(); per_cu = 1; }
        grid = cus * (per_cu < 1 ? 1 : 1);
        fprintf(stderr, "kernel_launch: %d CUs, occupancy %d/CU, grid %d\n", cus, per_cu, grid);
    }
    if (grid < 0) return;
    (void)hipMemsetAsync((char*)d_ws + WS_CTL, 0, 65536, stream);
    Params p{};
    p.x = (const float*)d_in[0]; p.meta = (const float*)d_in[1]; p.g1 = (const float*)d_in[2]; p.w_in = (const float*)d_in[3]; p.gw2 = (const float*)d_in[4]; p.gb = (const float*)d_in[5];
    p.gla_gain = (const float*)d_in[6]; p.ret_gain = (const float*)d_in[7]; p.ret_bias = (const float*)d_in[8]; p.w_out = (const float*)d_in[9]; p.g2 = (const float*)d_in[10];
    p.w_q = (const float*)d_in[11]; p.subkeys = (const float*)d_in[12]; p.pu = (const float*)d_in[13]; p.pv = (const float*)d_in[14]; p.gfin = (const float*)d_in[15];
    p.out = (float*)d_out; p.ws = (unsigned char*)d_ws;
#if MK_FUSED
    p.ph_lo = 0; p.ph_hi = NPHASE;
    void* args[] = {&p};
    hipError_t e = hipLaunchCooperativeKernel((const void*)mk_fwd, dim3(grid), dim3(512), args, LDS_BYTES, stream);
    if (e != hipSuccess) fprintf(stderr, "kernel_launch: cooperative launch failed: %s (grid %d)\n", hipGetErrorString(e), grid);
#else
    { const int order[7] = {0, 1, 2, 3, 4, 5, 6}; for (int i = 0; i < 7; ++i) { p.ph_lo = order[i]; p.ph_hi = order[i] + 1; hipLaunchKernelGGL(mk_fwd, dim3(grid), dim3(512), LDS_BYTES, stream, p); } }
#endif
}
```

```cpp
#include <hip/hip_runtime.h>
#include <hip/hip_cooperative_groups.h>
#include <cstdio>
#include <cstdint>
namespace cg = cooperative_groups;
namespace pg8 {
#define PG8_LAS __attribute__((address_space(3)))
typedef unsigned short bf16_t;
typedef short bf16x8 __attribute__((ext_vector_type(8)));
typedef float f32x4 __attribute__((ext_vector_type(4)));
typedef unsigned u32x4 __attribute__((ext_vector_type(4)));
constexpr int BM = 256, BK = 64, HALF = 128, HTB = HALF * BK * 2  , STAGE_BYTES = 8 * HTB, NXCD = 8, WGM = 8;

__host__ __device__ __forceinline__ int lds_byte(int r, int c) { const int st = (r >> 4) * 2 + (c >> 5), rr = r & 15, cc = c & 31, ob = rr * 64 + cc * 2; return st * 1024 + (ob ^ (((ob >> 9) & 1) << 5)); }
__host__ __device__ __forceinline__ void stage_rc(int b, int& R, int& C) { const int st = b / 1024, sb = b % 1024, swz = sb ^ (((sb >> 9) & 1) << 5); R = (st >> 1) * 16 + swz / 64; C = (st & 1) * 32 + (swz % 64) / 2; }
__host__ __device__ __forceinline__ int perm32(int rho) { const int n = rho >> 4, i = rho & 15; return 8 * (i >> 2) + 4 * n + (i & 3); }

struct Unit { int pm, pn; };
struct Gemm { const bf16_t* A; const bf16_t* Bt; int M, N, K; };

struct StaticOrder {
    int nM, nN, nwg, G, c;
    __host__ __device__ void init(int M, int N, int G_, int c_) { nM = M / BM; nN = N / BM; nwg = nM * nN; G = G_; c = c_; }
    __host__ __device__ bool next(int i, Unit& u) const {
        const long L = (long)i * G + c; if (L >= nwg) return false;
        int wgid = (int)L; { const int q = nwg / NXCD, r = nwg % NXCD, xcd = wgid % NXCD, off = wgid / NXCD; wgid = (xcd < r ? xcd * (q + 1) : r * (q + 1) + (xcd - r) * q) + off; }
        const int nig = WGM * nN, gid = wgid / nig, fm = gid * WGM, gsz = (nM - fm) < WGM ? (nM - fm) : WGM;
        u.pm = fm + ((wgid % nig) % gsz); u.pn = (wgid % nig) / gsz; return true;
    }
    __device__ __forceinline__ void a_ready(const Unit&) const {}
    __device__ __forceinline__ void done(const Unit&) const {}
};

__device__ __forceinline__ unsigned cvt_pk_bf16(float lo, float hi) { unsigned r; asm volatile("v_cvt_pk_bf16_f32 %0, %1, %2" : "=v"(r) : "v"(lo), "v"(hi)); return r; }
typedef float f32x2 __attribute__((ext_vector_type(2)));
template <class Epi, class Sched, bool ALIGN_EPI = false, bool SP2 = false>
__device__ __forceinline__ void gemm_phase(PG8_LAS unsigned char* lds, const Gemm g, const Sched& S, const Epi& E) {
    const int tid = threadIdx.x, wid = __builtin_amdgcn_readfirstlane(tid >> 6), lane = tid & 63, wr = wid >> 2, wc = wid & 3, fr = lane & 15, fq = lane >> 4;
    const int K = g.K, nt = K / BK;
    unsigned voffA[2], voffB[2];
#pragma unroll
    for (int i = 0; i < 2; ++i) { int R, C; stage_rc(tid * 16 + i * 8192, R, C); const int Rb = Epi::PERM ? ((R & ~31) + perm32(R & 31)) : R;
        voffA[i] = (unsigned)(R * K + C) * 2u; voffB[i] = (unsigned)(Rb * K + C) * 2u; }
    const size_t kstep = (size_t)(BK * 2);
    const size_t hstep = (size_t)HALF * K * 2;
    const size_t tstep = 2 * hstep;
    const unsigned ldsw = (unsigned)wid * 1024u;
    const int aoff = lds_byte(wr * 64 + fr, fq * 8), boff = lds_byte(wc * 32 + fr, fq * 8);
#define PG8_SA(b, h) (((b) * 2 + (h)) * HTB)
#define PG8_SB(b, h) ((4 + (b) * 2 + (h)) * HTB)
#define PG8_STAGE(bufoff, gbase, voff) do { _Pragma("unroll") for (int _i = 0; _i < 2; ++_i) \
        __builtin_amdgcn_global_load_lds((const unsigned*)((const char*)(gbase) + (voff)[_i]), (PG8_LAS unsigned*)(lds + (bufoff) + ldsw + _i * 8192), 16, 0, 0); } while (0)
#define PG8_LDA(dst, b, h) do { _Pragma("unroll") for (int m = 0; m < 4; ++m) _Pragma("unroll") for (int k = 0; k < 2; ++k) dst[m][k] = *(const PG8_LAS bf16x8*)(lds + PG8_SA(b, h) + aoff + m * 2048 + k * 1024); } while (0)
#define PG8_LDB(dst, b, h) do { _Pragma("unroll") for (int n = 0; n < 2; ++n) _Pragma("unroll") for (int k = 0; k < 2; ++k) dst[n][k] = *(const PG8_LAS bf16x8*)(lds + PG8_SB(b, h) + boff + n * 2048 + k * 1024); } while (0)
#define PG8_MMA(ai, bj, At, Bt) do { __builtin_amdgcn_s_setprio(1); _Pragma("unroll") for (int m = 0; m < 4; ++m) _Pragma("unroll") for (int n = 0; n < 2; ++n) _Pragma("unroll") for (int k = 0; k < 2; ++k) \
        acc[ai][bj][m][n] = __builtin_amdgcn_mfma_f32_16x16x32_bf16(Bt[n][k], At[m][k], acc[ai][bj][m][n], 0, 0, 0); __builtin_amdgcn_s_setprio(0); } while (0)
#define PG8_WAIT_V(n) asm volatile("s_waitcnt vmcnt(" #n ")" ::: "memory")
#define PG8_WAIT_L(n) asm volatile("s_waitcnt lgkmcnt(" #n ")" ::: "memory")
#define PG8_BAR __builtin_amdgcn_s_barrier()
#define PG8_SCHED __builtin_amdgcn_sched_barrier(0)
    Unit cur, nxt; int ui = 0;
    if (!S.next(0, cur)) return;
    f32x4 acc[2][2][4][2];
#pragma unroll
    for (int a = 0; a < 2; ++a)
#pragma unroll
        for (int b = 0; b < 2; ++b)
#pragma unroll
            for (int m = 0; m < 4; ++m)
#pragma unroll
                for (int n = 0; n < 2; ++n) acc[a][b][m][n] = (f32x4){0.f, 0.f, 0.f, 0.f};
    bf16x8 At[4][2], B0[2][2], B1[2][2];
    const char* cA = (const char*)g.A + (size_t)cur.pm * tstep; const char* cB = (const char*)g.Bt + (size_t)cur.pn * tstep;
    S.a_ready(cur);
    if constexpr (SP2) {
        PG8_STAGE(PG8_SB(0, 0), cB, voffB); PG8_STAGE(PG8_SB(0, 1), cB + hstep, voffB); PG8_STAGE(PG8_SA(0, 0), cA, voffA); PG8_STAGE(PG8_SA(0, 1), cA + hstep, voffA);
        if (wr == 1) PG8_BAR;
        PG8_WAIT_V(2); PG8_BAR;
        PG8_STAGE(PG8_SB(1, 0), cB + kstep, voffB); PG8_STAGE(PG8_SA(1, 0), cA + kstep, voffA); PG8_STAGE(PG8_SB(1, 1), cB + hstep + kstep, voffB);
        PG8_WAIT_V(6); PG8_BAR;
    } else {
        PG8_STAGE(PG8_SB(0, 0), cB, voffB); PG8_STAGE(PG8_SA(0, 0), cA, voffA); PG8_STAGE(PG8_SB(0, 1), cB + hstep, voffB); PG8_STAGE(PG8_SA(0, 1), cA + hstep, voffA);
        if (wr == 1) PG8_BAR;
        PG8_WAIT_V(4); PG8_BAR;
        PG8_STAGE(PG8_SB(1, 0), cB + kstep, voffB); PG8_STAGE(PG8_SA(1, 0), cA + kstep, voffA); PG8_STAGE(PG8_SB(1, 1), cB + hstep + kstep, voffB);
        PG8_WAIT_V(6); PG8_BAR;
    }
    for (;;) {
        const bool has_next = S.next(ui + 1, nxt);
        const char* nA = has_next ? (const char*)g.A + (size_t)nxt.pm * tstep : cA; const char* nB = has_next ? (const char*)g.Bt + (size_t)nxt.pn * tstep : cB;
        for (int t = 0; t < nt; t += 2) {
            const bool last = (t == nt - 2);
            const char* a1 = cA + (size_t)(t + 1) * kstep;
            const char* a2 = last ? nA : cA + (size_t)(t + 2) * kstep; const char* b2 = last ? nB : cB + (size_t)(t + 2) * kstep;
            const char* a3 = a2 + kstep; const char* b3 = b2 + kstep;
            if (last && has_next) S.a_ready(nxt);
            if constexpr (SP2) {
            PG8_LDB(B0, 0, 0); PG8_LDB(B1, 0, 1); PG8_SCHED; PG8_LDA(At, 0, 0); PG8_STAGE(PG8_SA(1, 1), a1 + hstep, voffA);
            PG8_WAIT_V(8); PG8_WAIT_L(0); PG8_BAR; PG8_MMA(0, 0, At, B0); PG8_MMA(0, 1, At, B1); PG8_BAR; PG8_SCHED;
            PG8_LDA(At, 0, 1); PG8_STAGE(PG8_SB(0, 0), b2, voffB); PG8_STAGE(PG8_SB(0, 1), b2 + hstep, voffB); PG8_STAGE(PG8_SA(0, 0), a2, voffA);
            PG8_WAIT_V(8); PG8_WAIT_L(0); PG8_BAR; PG8_MMA(1, 0, At, B0); PG8_MMA(1, 1, At, B1); PG8_BAR; PG8_SCHED;
            PG8_LDB(B0, 1, 0); PG8_LDB(B1, 1, 1); PG8_SCHED; PG8_LDA(At, 1, 0); PG8_STAGE(PG8_SA(0, 1), a2 + hstep, voffA);
            PG8_WAIT_V(8); PG8_WAIT_L(0); PG8_BAR; PG8_MMA(0, 0, At, B0); PG8_MMA(0, 1, At, B1); PG8_BAR; PG8_SCHED;
            PG8_LDA(At, 1, 1); PG8_STAGE(PG8_SB(1, 0), b3, voffB); PG8_STAGE(PG8_SB(1, 1), b3 + hstep, voffB); PG8_STAGE(PG8_SA(1, 0), a3, voffA);
            PG8_WAIT_V(8); PG8_WAIT_L(0); PG8_BAR; PG8_MMA(1, 0, At, B0); PG8_MMA(1, 1, At, B1); PG8_BAR; PG8_SCHED;
            } else {
            PG8_LDB(B0, 0, 0); PG8_SCHED; PG8_LDA(At, 0, 0); PG8_STAGE(PG8_SA(1, 1), a1 + hstep, voffA);
            PG8_WAIT_L(8); PG8_BAR; PG8_WAIT_L(0); PG8_MMA(0, 0, At, B0); PG8_BAR; PG8_SCHED;
            PG8_LDB(B1, 0, 1); PG8_STAGE(PG8_SB(0, 0), b2, voffB);
            PG8_BAR; PG8_WAIT_L(0); PG8_MMA(0, 1, At, B1); PG8_BAR;
            PG8_LDA(At, 0, 1); PG8_STAGE(PG8_SA(0, 0), a2, voffA);
            PG8_BAR; PG8_WAIT_L(0); PG8_MMA(1, 0, At, B0); PG8_BAR; PG8_SCHED;
            PG8_STAGE(PG8_SB(0, 1), b2 + hstep, voffB);
            PG8_WAIT_V(6); PG8_BAR; PG8_MMA(1, 1, At, B1); PG8_BAR;
            PG8_LDB(B0, 1, 0); PG8_SCHED; PG8_LDA(At, 1, 0); PG8_STAGE(PG8_SA(0, 1), a2 + hstep, voffA);
            PG8_WAIT_L(8); PG8_BAR; PG8_WAIT_L(0); PG8_MMA(0, 0, At, B0); PG8_BAR; PG8_SCHED;
            PG8_LDB(B1, 1, 1); PG8_STAGE(PG8_SB(1, 0), b3, voffB);
            PG8_BAR; PG8_WAIT_L(0); PG8_MMA(0, 1, At, B1); PG8_BAR;
            PG8_LDA(At, 1, 1); PG8_STAGE(PG8_SA(1, 0), a3, voffA);
            PG8_BAR; PG8_WAIT_L(0); PG8_MMA(1, 0, At, B0); PG8_BAR; PG8_SCHED;
            PG8_STAGE(PG8_SB(1, 1), b3 + hstep, voffB);
            PG8_WAIT_V(6); PG8_BAR; PG8_MMA(1, 1, At, B1); PG8_BAR;
            }
        }
        if constexpr (ALIGN_EPI) { if (wr == 0) PG8_BAR; }
        if constexpr (!Epi::AFTER_DRAIN) { E(acc, cur, wr, wc, fr, fq); S.done(cur); }
        if (!has_next) break;
#pragma unroll
        for (int a = 0; a < 2; ++a)
#pragma unroll
            for (int b = 0; b < 2; ++b)
#pragma unroll
                for (int m = 0; m < 4; ++m)
#pragma unroll
                    for (int n = 0; n < 2; ++n) acc[a][b][m][n] = (f32x4){0.f, 0.f, 0.f, 0.f};
        cur = nxt; cA = nA; cB = nB; ++ui;
        if constexpr (ALIGN_EPI) { if (wr == 1) PG8_BAR; }
    }
    PG8_WAIT_V(0);
    if constexpr (!ALIGN_EPI) { if (wr == 0) PG8_BAR; }
    PG8_BAR;
    if constexpr (Epi::AFTER_DRAIN) { E.fused(acc, cur, wr, wc, fr, fq, lds, wid, lane); S.done(cur); }
#undef PG8_SA
#undef PG8_SB
#undef PG8_STAGE
#undef PG8_LDA
#undef PG8_LDB
#undef PG8_MMA
#undef PG8_WAIT_V
#undef PG8_WAIT_L
#undef PG8_BAR
#undef PG8_SCHED
}
}

#define LAS __attribute__((address_space(3)))
typedef unsigned short bf16_t;
typedef float f32x4 __attribute__((ext_vector_type(4)));
typedef unsigned u32x4 __attribute__((ext_vector_type(4)));
typedef unsigned u32x2 __attribute__((ext_vector_type(2)));
typedef int i32x8 __attribute__((ext_vector_type(8)));
typedef short s16x2 __attribute__((ext_vector_type(2)));
#define MX_ONE 0x7f7f7f7f
#define V4_SCALE 5.656854f
typedef short bf16x8 __attribute__((ext_vector_type(8)));
typedef short s16x4 __attribute__((ext_vector_type(4)));
typedef __bf16 bf16x2_t __attribute__((ext_vector_type(2)));
typedef _Float16 f16x2_t __attribute__((ext_vector_type(2)));
typedef float f32x2v __attribute__((ext_vector_type(2)));
typedef _Float16 h2v __attribute__((ext_vector_type(2)));

constexpr int DM = 1024, NB = 4, SEQ = 8192, NTOK = NB * SEQ;
constexpr int MROWS = NTOK + 256;
constexpr int INW = 3088;
constexpr int NPROJ = 3072, NP1 = 3328;
constexpr int NEXP = 16384;
constexpr float EPS = 1e-6f;
constexpr int C_GQ = 0, C_GK = 256, C_GV = 512, C_GG = 1024, C_RQ = 1536, C_RK = 1792, C_RV = 2048, C_RG = 2560;
constexpr int S_GA = 1536, S_RQ = 1552, S_RV = 2064;

constexpr int NVG = 2048;
constexpr int NCH = (NTOK + 256) / 64;
constexpr size_t QK_ARR = (size_t)NCH * 4 * 8 * 64 * 8;
constexpr size_t MiB = 1u << 20;
constexpr size_t WS_CTL = 0, WS_WIN = 1 * MiB, WS_WOUT = 8 * MiB, WS_WS = 10 * MiB, WS_ROPE = 14 * MiB, WS_SSQ = 17 * MiB, WS_SEG = 19 * MiB, WS_ASEG = 27 * MiB,
                 WS_UB = 28 * MiB, WS_VB = 60 * MiB, WS_XN = 92 * MiB, WS_O = 157 * MiB, WS_LA = 221 * MiB, WS_PROJ = 254 * MiB, WS_QK = 383 * MiB, WS_XQ = 448 * MiB, WS_END = 480 * MiB;
static_assert(WS_WIN + (size_t)NP1 * DM * 2 <= WS_WOUT && WS_ROPE + (size_t)(SEQ + 64) * 32 * 8 <= WS_SSQ && WS_XN + (size_t)MROWS * DM * 2 <= WS_O &&
              WS_LA + QK_ARR * 4 <= WS_PROJ && WS_PROJ + (size_t)MROWS * NVG * 2 <= WS_QK && WS_QK + 4 * QK_ARR * 2 <= WS_XQ && WS_PROJ + (size_t)NTOK * 2048 * 2 <= WS_QK, "ws map");

constexpr size_t WS_HB = WS_XN + (size_t)256 * DM * 2;
constexpr size_t WS_RINV = WS_CTL + 131072, WS_GINV = WS_CTL + 262144;
constexpr int LDS_BYTES = 147456;
constexpr int NPHASE = 7;
#ifndef PROBE_R
#define PROBE_R 1
#define PROBE_U 1
#define PROBE_V 1
#endif
#ifndef PEER_FP8
#define PEER_FP8 1
#endif

struct Params {
    const float *x, *meta, *g1, *w_in, *gw2, *gb, *gla_gain, *ret_gain, *ret_bias, *w_out, *g2, *w_q, *subkeys, *pu, *pv, *gfin;
    float* out; unsigned char* ws;
    int ph_lo, ph_hi;
};

#define LDS_WAIT() asm volatile("s_waitcnt lgkmcnt(0)" ::: "memory")
__device__ __forceinline__ unsigned pk2(float lo, float hi) { const bf16x2_t v = {(__bf16)lo, (__bf16)hi}; return __builtin_bit_cast(unsigned, v); }
__device__ __forceinline__ unsigned f2bf(float f) { return (unsigned)__builtin_bit_cast(unsigned short, (__bf16)f); }

__device__ __forceinline__ float bf_lo(unsigned w) { return __builtin_bit_cast(float, w << 16); }
__device__ __forceinline__ float bf_hi(unsigned w) { return __builtin_bit_cast(float, w & 0xffff0000u); }
__device__ __forceinline__ float bf1(bf16_t h) { return __builtin_bit_cast(float, (unsigned)h << 16); }
__device__ __forceinline__ float wave_sum(float v) {
#pragma unroll
    for (int o = 1; o < 64; o <<= 1) v += __shfl_xor(v, o);
    return v;
}

struct MapIn {
    __device__ __forceinline__ void operator()(int j, int& src, float& sc) const {
        if (j < C_RQ) { src = j; sc = (j < 256) ? 0.125f : 1.0f; }
        else if (j < C_RV) { const int jj = j - C_RQ, which = jj >> 8, within = jj & 255, head = within >> 6, p = within & 63;
            const int a = p >> 3, n = (p >> 2) & 1, i = p & 3; src = S_RQ + which * 256 + head * 64 + 32 * n + 4 * a + i; sc = which ? 0.125f : 1.0f; }
        else { src = S_RV + (j - C_RV); sc = 1.0f; }
    }
};
struct MapId { __device__ __forceinline__ void operator()(int j, int& src, float& sc) const { src = j; sc = 1.0f; } };

template <class Map>
__device__ __forceinline__ void transpose_item(const float* W, int K, int N, bf16_t* WT, LAS float* scr, int item, int nblk, int lane, const Map map) {
    const int kb = item / nblk, nb = item % nblk, k0 = 64 * kb, n0 = 32 * nb;
    int src; float sc; map(n0 + (lane & 31), src, sc);
#pragma unroll 8
    for (int i = 0; i < 32; ++i) { const int kk = 2 * i + (lane >> 5); scr[kk * 33 + (lane & 31)] = W[(size_t)(k0 + kk) * N + src] * sc; }
    LDS_WAIT();
    const int c = lane & 7;
#pragma unroll
    for (int j = 0; j < 4; ++j) { const int n = (lane >> 3) + 8 * j; const LAS float* s = scr + (8 * c) * 33 + n;
        u32x4 o; o.x = pk2(s[0 * 33], s[1 * 33]); o.y = pk2(s[2 * 33], s[3 * 33]); o.z = pk2(s[4 * 33], s[5 * 33]); o.w = pk2(s[6 * 33], s[7 * 33]);
        *(u32x4*)(WT + (size_t)(n0 + n) * K + k0 + 8 * c) = o; }
    LDS_WAIT();
}

__device__ __forceinline__ void phase0(const Params& p, LAS unsigned char* lds, int bid, int nb) {
    const int tid = threadIdx.x, lane = tid & 63, wave = __builtin_amdgcn_readfirstlane(tid >> 6);
    unsigned char* ws = p.ws;
    bf16_t* XN = (bf16_t*)(ws + WS_XN); bf16_t* WinT = (bf16_t*)(ws + WS_WIN); bf16_t* WoutT = (bf16_t*)(ws + WS_WOUT); bf16_t* WsT = (bf16_t*)(ws + WS_WS);
    const int gw = bid * 8 + wave, NGW = nb * 8;
    const int gt = bid * 512 + tid, NGT = nb * 512;

    {
        LAS float* SKT = (LAS float*)lds;
        LAS float* WQT = (LAS float*)(lds + 128 * 132 * 4);
        for (int item = bid; item < 256; item += nb) {
            const int hc = item >> 4, kb = item & 15;
            __syncthreads();
            for (int e = tid; e < 128 * 128; e += 512) { const int n = e >> 7, d = e & 127; SKT[d * 132 + n] = p.subkeys[(size_t)hc * 16384 + e]; }
            for (int e = tid; e < 64 * 128; e += 512) { const int k = e >> 7, d = e & 127; WQT[d * 68 + k] = p.w_q[(size_t)(kb * 64 + k) * 2048 + hc * 128 + d]; }
            __syncthreads();
            const int tn = tid & 31, tk = tid >> 5;
            f32x4 acc[4];
#pragma unroll
            for (int i = 0; i < 4; ++i) acc[i] = (f32x4){0.f, 0.f, 0.f, 0.f};
#pragma unroll 4
            for (int d = 0; d < 128; ++d) {
                const f32x4 sk = *(const LAS f32x4*)(SKT + d * 132 + 4 * tn); const f32x4 wq = *(const LAS f32x4*)(WQT + d * 68 + 4 * tk);
#pragma unroll
                for (int i = 0; i < 4; ++i) acc[i] += sk[i] * wq;
            }
            const f32x4 gg = *(const f32x4*)(p.g2 + kb * 64 + 4 * tk);
#pragma unroll
            for (int i = 0; i < 4; ++i) { const f32x4 v = acc[i] * gg; u32x2 o; o.x = pk2(v[0], v[1]); o.y = pk2(v[2], v[3]);
                *(u32x2*)(WsT + (size_t)(hc * 128 + 4 * tn + i) * DM + kb * 64 + 4 * tk) = o; }
        }
        __syncthreads();
    }
    {
        LAS float* scr = (LAS float*)(lds + wave * 16384);
        constexpr int I_IN = (DM / 64) * (NPROJ / 32), I_OUT = (DM / 64) * (DM / 32);
        for (int it = gw; it < I_IN + I_OUT; it += NGW) {
            if (it < I_IN) transpose_item(p.w_in, DM, INW, WinT, scr, it, NPROJ / 32, lane, MapIn());
            else transpose_item(p.w_out, DM, DM, WoutT, scr, it - I_IN, DM / 32, lane, MapId());
        }
    }
    for (int e = gt; e < 256 * DM; e += NGT) {
        const int n = e >> 10, k = e & 1023; const float* wr = p.w_in + (size_t)k * INW + S_GA; float s = 0.f;
#pragma unroll
        for (int r = 0; r < 16; ++r) s += wr[r] * p.gw2[r * 256 + n];
        WinT[(size_t)(NPROJ + n) * DM + k] = (bf16_t)f2bf(s);
    }
#if PEER_FP8
    {
        u32x4* U4 = (u32x4*)(ws + WS_UB); u32x4* V4 = (u32x4*)(ws + WS_VB);
        for (int e = gt; e < NEXP * DM / 32; e += NGT) {
            const f32x4* us = (const f32x4*)p.pu + 8 * (size_t)e; const f32x4* vs = (const f32x4*)p.pv + 8 * (size_t)e;
            const f32x4* g2s = (const f32x4*)p.g2 + 8 * (e & 31);
            unsigned tu[4], tv[4];
#pragma unroll
            for (int j = 0; j < 4; ++j) { const f32x4 a0 = us[2 * j] * g2s[2 * j] * 64.0f, a1 = us[2 * j + 1] * g2s[2 * j + 1] * 64.0f;
                const f32x4 b0 = vs[2 * j] * V4_SCALE, b1 = vs[2 * j + 1] * V4_SCALE;
                unsigned w = 0u, x = 0u;
                w = __builtin_amdgcn_cvt_scalef32_pk_fp4_f32(w, a0[0], a0[1], 1.0f, 0); w = __builtin_amdgcn_cvt_scalef32_pk_fp4_f32(w, a0[2], a0[3], 1.0f, 1);
                w = __builtin_amdgcn_cvt_scalef32_pk_fp4_f32(w, a1[0], a1[1], 1.0f, 2); w = __builtin_amdgcn_cvt_scalef32_pk_fp4_f32(w, a1[2], a1[3], 1.0f, 3); tu[j] = w;
                x = __builtin_amdgcn_cvt_scalef32_pk_fp4_f32(x, b0[0], b0[1], 1.0f, 0); x = __builtin_amdgcn_cvt_scalef32_pk_fp4_f32(x, b0[2], b0[3], 1.0f, 1);
                x = __builtin_amdgcn_cvt_scalef32_pk_fp4_f32(x, b1[0], b1[1], 1.0f, 2); x = __builtin_amdgcn_cvt_scalef32_pk_fp4_f32(x, b1[2], b1[3], 1.0f, 3); tv[j] = x; }
            const int row = e >> 5, c32 = e & 31;
            const size_t dst = ((size_t)(c32 >> 3) * NEXP + row) * 8 + (c32 & 7);
            U4[dst] = (u32x4){tu[0], tu[1], tu[2], tu[3]}; V4[dst] = (u32x4){tv[0], tv[1], tv[2], tv[3]}; }
    }
#else
    {
        u32x2* UB = (u32x2*)(ws + WS_UB); u32x2* VB = (u32x2*)(ws + WS_VB);
        const f32x4* u4 = (const f32x4*)p.pu; const f32x4* v4 = (const f32x4*)p.pv;
        for (int e = gt; e < NEXP * DM / 4; e += NGT) { const f32x4 a = u4[e]; u32x2 o; o.x = pk2(a[0], a[1]); o.y = pk2(a[2], a[3]); UB[e] = o;
            const f32x4 b = v4[e]; u32x2 q; q.x = pk2(b[0], b[1]); q.y = pk2(b[2], b[3]); VB[e] = q; }
    }
#endif
    if (gt < DM) ((float*)(ws + WS_GINV))[gt] = 1.0f / p.g1[gt];
    {
        float2* rope = (float2*)(ws + WS_ROPE);
        for (int e = gt; e < (SEQ + 64) * 32; e += NGT) { const int pi = e >> 5, d = e & 31;
            const float invf = (float)pow(10000.0, -(double)d / 32.0); const float ang = (float)(pi - 48) * invf;
            rope[e] = make_float2((float)cos((double)ang), (float)sin((double)ang)); }
    }
    for (int m0 = gw; m0 < MROWS; m0 += 4 * NGW) {
        const float* srcp[4]; f32x4 v[4][4];
#pragma unroll
        for (int u = 0; u < 4; ++u) { const int m = m0 + u * NGW; srcp[u] = nullptr;
            if (m < MROWS) { if (m >= 256) srcp[u] = p.x + (size_t)(m - 256) * DM; else if (m >= 48 && m < 64) srcp[u] = p.meta + (size_t)(m - 48) * DM; }
            if (srcp[u] != nullptr) { const f32x4* xr = (const f32x4*)srcp[u] + lane;
#pragma unroll
                for (int j = 0; j < 4; ++j) v[u][j] = xr[64 * j]; }
            else {
#pragma unroll
                for (int j = 0; j < 4; ++j) v[u][j] = (f32x4){0.f, 0.f, 0.f, 0.f}; } }
        f32x4 gg[4];
#pragma unroll
        for (int j = 0; j < 4; ++j) gg[j] = ((const f32x4*)p.g1 + lane)[64 * j];
#pragma unroll
        for (int u = 0; u < 4; ++u) { const int m = m0 + u * NGW; if (m >= MROWS) continue;
            float s = 0.f;
#pragma unroll
            for (int j = 0; j < 4; ++j) s += (v[u][j].x * v[u][j].x + v[u][j].y * v[u][j].y) + (v[u][j].z * v[u][j].z + v[u][j].w * v[u][j].w);
            const float r = (srcp[u] != nullptr) ? __builtin_amdgcn_rsqf(wave_sum(s) * (1.0f / DM) + EPS) : 0.f;
            if (lane == 0 && m >= 256) ((float*)(ws + WS_RINV))[m - 256] = 1.0f / r;
            unsigned long long* o8 = (unsigned long long*)(XN + (size_t)m * DM) + lane;
#pragma unroll
            for (int j = 0; j < 4; ++j) { const f32x4 y = v[u][j] * r * gg[j]; o8[64 * j] = (unsigned long long)pk2(y.x, y.y) | ((unsigned long long)pk2(y.z, y.w) << 32); } }
    }
}

struct EpiProj {
    static constexpr bool PERM = true, AFTER_DRAIN = false;
    bf16_t* VG; bf16_t* QK; _Float16* LAT; const float* gb; const float2* rope;
    __device__ __forceinline__ static size_t tile_off(int r, int head, int dg) { return ((((size_t)(r >> 6) * 4 + head) * 8 + dg) * 64 + (r & 63)) * 8; }
    __device__ __forceinline__ void operator()(const pg8::f32x4 (&acc)[2][2][4][2], const pg8::Unit& u, int wr, int wc, int fr, int fq) const {
        const int row0 = u.pm * 256 + wr * 64 + fr, cb0 = wc * 32 + 8 * fq;
        if (u.pn == 12) {
#pragma unroll
            for (int bj = 0; bj < 2; ++bj) { const int c = cb0 + 128 * bj; const f32x4 b0 = *(const f32x4*)(gb + c), b1 = *(const f32x4*)(gb + c + 4);
#pragma unroll
                for (int ai = 0; ai < 2; ++ai)
#pragma unroll
                    for (int m = 0; m < 4; ++m) { const int row = row0 + ai * 128 + m * 16; f32x4 v0 = acc[ai][bj][m][0] + b0, v1 = acc[ai][bj][m][1] + b1;
#pragma unroll
                        for (int i = 0; i < 4; ++i) { v0[i] = (fminf(v0[i], 0.f) - __logf(1.0f + __expf(-fabsf(v0[i])))) * 0.0625f; v1[i] = (fminf(v1[i], 0.f) - __logf(1.0f + __expf(-fabsf(v1[i])))) * 0.0625f; }
                        const f16x2_t h0 = {(_Float16)v0[0], (_Float16)v0[1]}, h1 = {(_Float16)v0[2], (_Float16)v0[3]}, h2 = {(_Float16)v1[0], (_Float16)v1[1]}, h3 = {(_Float16)v1[2], (_Float16)v1[3]};
                        *(u32x4*)(LAT + tile_off(row, c >> 6, (c & 63) >> 3)) = (u32x4){__builtin_bit_cast(unsigned, h0), __builtin_bit_cast(unsigned, h1), __builtin_bit_cast(unsigned, h2), __builtin_bit_cast(unsigned, h3)}; } }
        } else if (u.pn == 6 || u.pn == 7) {
            bf16_t* QA = QK + (size_t)(u.pn - 4) * QK_ARR;
#pragma unroll
            for (int ai = 0; ai < 2; ++ai)
#pragma unroll
                for (int m = 0; m < 4; ++m) { const int row = row0 + ai * 128 + m * 16; const int pidx = (row < 256) ? row : 64 + ((row - 256) & (SEQ - 1));
#pragma unroll
                    for (int bj = 0; bj < 2; ++bj) { const int c = cb0 + 128 * bj, d0 = (c & 63) >> 1;
                        const f32x4 cs0 = *(const f32x4*)(rope + (size_t)pidx * 32 + d0), cs1 = *(const f32x4*)(rope + (size_t)pidx * 32 + d0 + 2);
                        const f32x4 t1 = acc[ai][bj][m][0], t2 = acc[ai][bj][m][1];
                        const float co[4] = {cs0[0], cs0[2], cs1[0], cs1[2]}, si[4] = {cs0[1], cs0[3], cs1[1], cs1[3]};
                        float o1[4], o2[4];
#pragma unroll
                        for (int i = 0; i < 4; ++i) { o1[i] = t1[i] * co[i] - t2[i] * si[i]; o2[i] = t1[i] * si[i] + t2[i] * co[i]; }
                        u32x4 w; w.x = pg8::cvt_pk_bf16(o1[0], o1[1]); w.y = pg8::cvt_pk_bf16(o1[2], o1[3]); w.z = pg8::cvt_pk_bf16(o2[0], o2[1]); w.w = pg8::cvt_pk_bf16(o2[2], o2[3]);
                        *(u32x4*)(QA + tile_off(row, c >> 6, (c & 63) >> 3)) = w; } }
        } else if (u.pn <= 1) {
            bf16_t* QA = QK + (size_t)u.pn * QK_ARR;
#pragma unroll
            for (int ai = 0; ai < 2; ++ai)
#pragma unroll
                for (int m = 0; m < 4; ++m) { const int row = row0 + ai * 128 + m * 16;
#pragma unroll
                    for (int bj = 0; bj < 2; ++bj) { const int c = cb0 + 128 * bj; const f32x4 v0 = acc[ai][bj][m][0], v1 = acc[ai][bj][m][1];
                        u32x4 w; w.x = pg8::cvt_pk_bf16(v0[0], v0[1]); w.y = pg8::cvt_pk_bf16(v0[2], v0[3]); w.z = pg8::cvt_pk_bf16(v1[0], v1[1]); w.w = pg8::cvt_pk_bf16(v1[2], v1[3]);
                        *(u32x4*)(QA + tile_off(row, c >> 6, (c & 63) >> 3)) = w; } }
        } else {
            const int cdst = (u.pn < 6 ? (u.pn - 2) : (u.pn - 4)) * 256;
#pragma unroll
            for (int ai = 0; ai < 2; ++ai)
#pragma unroll
                for (int m = 0; m < 4; ++m) { bf16_t* rowp = VG + (size_t)(row0 + ai * 128 + m * 16) * NVG + cdst + cb0;
#pragma unroll
                    for (int bj = 0; bj < 2; ++bj) { const f32x4 v0 = acc[ai][bj][m][0], v1 = acc[ai][bj][m][1];
                        u32x4 w; w.x = pg8::cvt_pk_bf16(v0[0], v0[1]); w.y = pg8::cvt_pk_bf16(v0[2], v0[3]); w.z = pg8::cvt_pk_bf16(v1[0], v1[1]); w.w = pg8::cvt_pk_bf16(v1[2], v1[3]);
                        *(u32x4*)(rowp + bj * 128) = w; } }
        }
    }
};
struct EpiRes {
    static constexpr bool PERM = true, AFTER_DRAIN = false;
    bf16_t* HB; float* SSQ; const float* RINV; const float* GINV;
    __device__ __forceinline__ void operator()(const pg8::f32x4 (&acc)[2][2][4][2], const pg8::Unit& u, int wr, int wc, int fr, int fq) const {
        const int row0 = u.pm * 256 + wr * 64 + fr, col0 = u.pn * 256 + wc * 32 + 8 * fq;
        f32x4 gi[2][2];
#pragma unroll
        for (int bj = 0; bj < 2; ++bj) { gi[bj][0] = *(const f32x4*)(GINV + col0 + bj * 128); gi[bj][1] = *(const f32x4*)(GINV + col0 + bj * 128 + 4); }
#pragma unroll
        for (int ai = 0; ai < 2; ++ai)
#pragma unroll
            for (int m = 0; m < 4; ++m) { const int row = row0 + ai * 128 + m * 16; bf16_t* hr = HB + (size_t)row * DM + col0; float ss = 0.f; const float ri = RINV[row];
#pragma unroll
                for (int bj = 0; bj < 2; ++bj) { const u32x4 xn = *(const u32x4*)(hr + bj * 128);
                    const f32x4 x0 = (f32x4){bf_lo(xn.x), bf_hi(xn.x), bf_lo(xn.y), bf_hi(xn.y)} * ri * gi[bj][0], x1 = (f32x4){bf_lo(xn.z), bf_hi(xn.z), bf_lo(xn.w), bf_hi(xn.w)} * ri * gi[bj][1];
                    const f32x4 v0 = acc[ai][bj][m][0] + x0, v1 = acc[ai][bj][m][1] + x1;
                    ss += (v0[0] * v0[0] + v0[1] * v0[1]) + (v0[2] * v0[2] + v0[3] * v0[3]) + (v1[0] * v1[0] + v1[1] * v1[1]) + (v1[2] * v1[2] + v1[3] * v1[3]);
                    u32x4 w; w.x = pg8::cvt_pk_bf16(v0[0], v0[1]); w.y = pg8::cvt_pk_bf16(v0[2], v0[3]); w.z = pg8::cvt_pk_bf16(v1[0], v1[1]); w.w = pg8::cvt_pk_bf16(v1[2], v1[3]);
                    *(u32x4*)(hr + bj * 128) = w; }
                ss += __shfl_xor(ss, 16); ss += __shfl_xor(ss, 32);
                if (fq == 0) SSQ[(size_t)row * 16 + u.pn * 4 + wc] = ss; }
    }
};
struct EpiF16 {
    static constexpr bool PERM = true, AFTER_DRAIN = false;
    _Float16* SC;
    __device__ __forceinline__ void operator()(const pg8::f32x4 (&acc)[2][2][4][2], const pg8::Unit& u, int wr, int wc, int fr, int fq) const {
        const int row0 = u.pm * 256 + wr * 64 + fr, col0 = u.pn * 256 + wc * 32 + 8 * fq;
#pragma unroll
        for (int ai = 0; ai < 2; ++ai)
#pragma unroll
            for (int m = 0; m < 4; ++m) { _Float16* rowp = SC + (size_t)(row0 + ai * 128 + m * 16) * 2048 + col0;
#pragma unroll
                for (int bj = 0; bj < 2; ++bj) { const f32x4 v0 = acc[ai][bj][m][0], v1 = acc[ai][bj][m][1];
                    u32x4 w;
                    w.x = __builtin_bit_cast(unsigned, (f16x2_t){(_Float16)v0[0], (_Float16)v0[1]}); w.y = __builtin_bit_cast(unsigned, (f16x2_t){(_Float16)v0[2], (_Float16)v0[3]});
                    w.z = __builtin_bit_cast(unsigned, (f16x2_t){(_Float16)v1[0], (_Float16)v1[1]}); w.w = __builtin_bit_cast(unsigned, (f16x2_t){(_Float16)v1[2], (_Float16)v1[3]});
                    *(u32x4*)(rowp + bj * 128) = w; } }
    }
};

constexpr int A_QT = 0, A_KT = 9216, A_KE = 18432, A_V = 27648, A_ST = 45056, A_STSZ = 18432, A_OB = 81920, A_DEC = 115712, A_CS = 115968;
constexpr int PQ = 72, PV = 136, POB = 132;

__device__ __forceinline__ bf16x8 tr2(const LAS bf16_t* p0, const LAS bf16_t* p1) {
    const s16x4 a = __builtin_amdgcn_ds_read_tr16_b64_v4i16((LAS s16x4*)p0), b = __builtin_amdgcn_ds_read_tr16_b64_v4i16((LAS s16x4*)p1);
    return (bf16x8){a[0], a[1], a[2], a[3], b[0], b[1], b[2], b[3]};
}
__device__ __forceinline__ float ln_gamma(int hr) { return log1pf(-exp2f(-5.0f - (float)hr)); }

template <bool FULL>
__device__ __forceinline__ void attn_pass(const Params& p, LAS unsigned char* lds, int bid, int nb) {
    const int tid = threadIdx.x, lane = tid & 63, wave = __builtin_amdgcn_readfirstlane(tid >> 6);
    const int r16 = lane & 15, g4 = lane >> 4, q4 = (lane & 15) >> 2, p4 = lane & 3;
    unsigned char* ws = p.ws;
    const bf16_t* PROJ = (const bf16_t*)(ws + WS_PROJ); const _Float16* LA = (const _Float16*)(ws + WS_LA); const bf16_t* QK = (const bf16_t*)(ws + WS_QK);
    float* SEG = (float*)(ws + WS_SEG); float* ASEG = (float*)(ws + WS_ASEG); float* SEGM = (float*)(ws + WS_ASEG + 65536); bf16_t* OUT = (bf16_t*)(ws + WS_O);
    LAS bf16_t* QT = (LAS bf16_t*)(lds + A_QT); LAS bf16_t* KT = (LAS bf16_t*)(lds + A_KT); LAS bf16_t* KE = (LAS bf16_t*)(lds + A_KE); LAS bf16_t* VS = (LAS bf16_t*)(lds + A_V);
    LAS float* OB = (LAS float*)(lds + A_OB); LAS float* DEC = (LAS float*)(lds + A_DEC); LAS float* CS = (LAS float*)(lds + A_CS);

    for (int item = bid; item < 256; item += nb) {
        const int seg = item & 7, h8 = (item >> 3) & 7, b = item >> 6;
        const bool metaitem = !FULL && seg == 7 && b == 0;
        if (!FULL && seg == 7 && !metaitem) continue;
        const bool gla = h8 < 4; const int hr = h8 & 3;
        const float lng = ln_gamma(hr);
        const bf16_t* QAq = QK + (size_t)(gla ? 0 : 2) * QK_ARR; const bf16_t* QAk = QK + (size_t)(gla ? 1 : 3) * QK_ARR;
        const int vcol = (gla ? 0 : 1024) + hr * 128, gcol = (gla ? 512 : 1536) + hr * 128;
        const int nch = metaitem ? 1 : 16;

        f32x4 accS[8];
#pragma unroll
        for (int cb = 0; cb < 8; ++cb) accS[cb] = (f32x4){0.f, 0.f, 0.f, 0.f};
        float blsum[8] = {0.f, 0.f, 0.f, 0.f, 0.f, 0.f, 0.f, 0.f};
        __syncthreads();
        if (FULL) {
            if (wave >= 4) {
                const int wq = wave - 4;
                { const float* Sm = SEGM + (size_t)h8 * 8192;
#pragma unroll
                  for (int cb = 0; cb < 8; ++cb)
#pragma unroll
                      for (int rg = 0; rg < 4; ++rg) accS[cb][rg] = Sm[(16 * wq + 4 * g4 + rg) * 128 + 16 * cb + r16]; }
                for (int sp = 0; sp < seg; ++sp) { const int it2 = (item & ~7) + sp; const float* Sg = SEG + (size_t)it2 * 8192; const float* Ag = ASEG + it2 * 64;
                    float dec[4];
#pragma unroll
                    for (int rg = 0; rg < 4; ++rg) dec[rg] = Ag[16 * wq + 4 * g4 + rg];
#pragma unroll
                    for (int cb = 0; cb < 8; ++cb)
#pragma unroll
                        for (int rg = 0; rg < 4; ++rg) accS[cb][rg] = dec[rg] * accS[cb][rg] + Sg[(16 * wq + 4 * g4 + rg) * 128 + 16 * cb + r16]; }
                LAS bf16_t* ST0 = (LAS bf16_t*)(lds + A_ST);
#pragma unroll
                for (int cb = 0; cb < 8; ++cb) { u32x2 w; w.x = pk2(accS[cb][0], accS[cb][1]); w.y = pk2(accS[cb][2], accS[cb][3]); *(LAS u32x2*)(ST0 + (16 * cb + r16) * PQ + 16 * wq + 4 * g4) = w; }
            }
        }
#define A_ROWBASE(ci_) (metaitem ? 0 : 256 + b * SEQ + (16 * seg + (ci_)) * 64)
        u32x4 lav8; u32x4 qv8, kv8; u32x4 vreg[2];
        qv8 = (u32x4){0u, 0u, 0u, 0u};
#define A_LOADCHUNK(ci_) do { const int _rb = A_ROWBASE(ci_); \
            const size_t _to = ((((size_t)(_rb >> 6) * 4 + hr) * 8 + wave) * 64 + lane) * 8;       \
            if (gla) lav8 = *(const u32x4*)(LA + _to); else lav8 = (u32x4){0u, 0u, 0u, 0u}; \
            if (FULL) qv8 = *(const u32x4*)(QAq + _to); \
            kv8 = *(const u32x4*)(QAk + _to); \
            { const int vr = tid >> 3, cc = tid & 7; const u32x4* src = (const u32x4*)(PROJ + (size_t)(_rb + vr) * NVG + vcol + cc * 16); vreg[0] = src[0]; vreg[1] = src[1]; } } while (0)
#define A_LBAR() do { asm volatile("s_waitcnt lgkmcnt(0)" ::: "memory"); __builtin_amdgcn_s_barrier(); asm volatile("" ::: "memory"); } while (0)
        A_LOADCHUNK(0);
        f32x4 gnv[4], bsv[4];
        { const float* gptr = (gla ? p.gla_gain : p.ret_gain) + 16 * (tid & 7); const float* bptr = p.ret_bias + 16 * (tid & 7); const float bsc = gla ? 0.f : 1.f;
#pragma unroll
          for (int k4 = 0; k4 < 4; ++k4) { gnv[k4] = *(const f32x4*)(gptr + 4 * k4); bsv[k4] = *(const f32x4*)(bptr + 4 * k4) * bsc; } }
        for (int ci = 0; ci < nch; ++ci) {
            const bool metac = metaitem;
            const int rowbase = A_ROWBASE(ci);
            const LAS bf16_t* STr = (const LAS bf16_t*)(lds + A_ST + (ci & 1) * A_STSZ); LAS bf16_t* STw = (LAS bf16_t*)(lds + A_ST + ((ci + 1) & 1) * A_STSZ);
            u32x4 gpre[2] = {(u32x4){0u, 0u, 0u, 0u}, (u32x4){0u, 0u, 0u, 0u}};
            if (FULL && !metac) { const u32x4* gp = (const u32x4*)(PROJ + (size_t)(rowbase + (tid >> 3)) * NVG + gcol + 16 * (tid & 7)); gpre[0] = gp[0]; gpre[1] = gp[1]; }
            {
                float bc[8];
                const unsigned lw[4] = {lav8.x, lav8.y, lav8.z, lav8.w};
#pragma unroll
                for (int c = 0; c < 8; ++c) { float v = gla ? (float)__builtin_bit_cast(_Float16, (unsigned short)((c & 1) ? (lw[c >> 1] >> 16) : (lw[c >> 1] & 0xffffu))) : lng;
                    v += __builtin_bit_cast(float, __builtin_amdgcn_update_dpp(0, __builtin_bit_cast(int, v), 0x111, 0xf, 0xf, true));
                    v += __builtin_bit_cast(float, __builtin_amdgcn_update_dpp(0, __builtin_bit_cast(int, v), 0x112, 0xf, 0xf, true));
                    v += __builtin_bit_cast(float, __builtin_amdgcn_update_dpp(0, __builtin_bit_cast(int, v), 0x114, 0xf, 0xf, true));
                    v += __builtin_bit_cast(float, __builtin_amdgcn_update_dpp(0, __builtin_bit_cast(int, v), 0x118, 0xf, 0xf, true));
                    v += __builtin_bit_cast(float, __builtin_amdgcn_update_dpp(0, __builtin_bit_cast(int, v), 0x142, 0xa, 0xf, false));
                    v += __builtin_bit_cast(float, __builtin_amdgcn_update_dpp(0, __builtin_bit_cast(int, v), 0x143, 0xc, 0xf, false));
                    bc[c] = v; }
                float tot[8];
#pragma unroll
                for (int c = 0; c < 8; ++c) { tot[c] = __builtin_bit_cast(float, __builtin_amdgcn_readlane(__builtin_bit_cast(int, bc[c]), 63)); blsum[c] += tot[c]; }
                const unsigned qw[4] = {qv8.x, qv8.y, qv8.z, qv8.w}, kw[4] = {kv8.x, kv8.y, kv8.z, kv8.w};
                unsigned oq[4], ok[4], oe[4];
#pragma unroll
                for (int c2 = 0; c2 < 4; ++c2) { const float k0 = bf_lo(kw[c2]), k1 = bf_hi(kw[c2]);
                    if (FULL) { oq[c2] = pk2(bf_lo(qw[c2]) * __expf(bc[2 * c2]), bf_hi(qw[c2]) * __expf(bc[2 * c2 + 1])); ok[c2] = pk2(k0 * __expf(-bc[2 * c2]), k1 * __expf(-bc[2 * c2 + 1])); }
                    oe[c2] = pk2(k0 * __expf(tot[2 * c2] - bc[2 * c2]), k1 * __expf(tot[2 * c2 + 1] - bc[2 * c2 + 1])); }
                if (FULL) { *(LAS u32x4*)(QT + lane * PQ + 8 * wave) = (u32x4){oq[0], oq[1], oq[2], oq[3]}; *(LAS u32x4*)(KT + lane * PQ + 8 * wave) = (u32x4){ok[0], ok[1], ok[2], ok[3]}; }
                *(LAS u32x4*)(KE + lane * PQ + 8 * wave) = (u32x4){oe[0], oe[1], oe[2], oe[3]};
                if (lane == 63) { *(LAS f32x4*)(DEC + 8 * wave) = (f32x4){__expf(tot[0]), __expf(tot[1]), __expf(tot[2]), __expf(tot[3])};
                                  *(LAS f32x4*)(DEC + 8 * wave + 4) = (f32x4){__expf(tot[4]), __expf(tot[5]), __expf(tot[6]), __expf(tot[7])}; }
                const int vr = tid >> 3, cc = tid & 7; LAS u32x4* dst = (LAS u32x4*)(VS + vr * PV + cc * 16); dst[0] = vreg[0]; dst[1] = vreg[1];
            }
            if (ci + 1 < nch) A_LOADCHUNK(ci + 1);
            A_LBAR();
            if (wave < 4) {
                if (FULL && !metac) {
                    const int w = wave;
                    bf16x8 qf[2];
#pragma unroll
                    for (int s = 0; s < 2; ++s) qf[s] = *(const LAS bf16x8*)(QT + (16 * w + r16) * PQ + 32 * s + 8 * g4);
                    f32x4 att[4];
#pragma unroll
                    for (int jb = 0; jb < 4; ++jb) { att[jb] = (f32x4){0.f, 0.f, 0.f, 0.f};
                        if (jb <= w) {
#pragma unroll
                            for (int s = 0; s < 2; ++s) { const bf16x8 kf = *(const LAS bf16x8*)(KT + (16 * jb + r16) * PQ + 32 * s + 8 * g4);
                                att[jb] = __builtin_amdgcn_mfma_f32_16x16x32_bf16(kf, qf[s], att[jb], 0, 0, 0); }
                            if (jb == w) {
#pragma unroll
                                for (int rg = 0; rg < 4; ++rg) att[jb][rg] = (4 * g4 + rg <= r16) ? att[jb][rg] : 0.f;
                            }
                        } }
                    bf16x8 af[2];
#pragma unroll
                    for (int s = 0; s < 2; ++s) { u32x4 t; t.x = pk2(att[2 * s][0], att[2 * s][1]); t.y = pk2(att[2 * s][2], att[2 * s][3]); t.z = pk2(att[2 * s + 1][0], att[2 * s + 1][1]); t.w = pk2(att[2 * s + 1][2], att[2 * s + 1][3]);
                        af[s] = __builtin_bit_cast(bf16x8, t); }
#pragma unroll
                    for (int cb = 0; cb < 8; ++cb) { f32x4 o = (f32x4){0.f, 0.f, 0.f, 0.f};
#pragma unroll
                        for (int s = 0; s < 2; ++s) {
                            const bf16x8 vf = tr2(VS + (32 * s + 4 * g4 + q4) * PV + 16 * cb + 4 * p4, VS + (32 * s + 16 + 4 * g4 + q4) * PV + 16 * cb + 4 * p4);
                            o = __builtin_amdgcn_mfma_f32_16x16x32_bf16(af[s], vf, o, 0, 0, 0);
                            const bf16x8 sf = *(const LAS bf16x8*)(STr + (16 * cb + r16) * PQ + 32 * s + 8 * g4);
                            o = __builtin_amdgcn_mfma_f32_16x16x32_bf16(qf[s], sf, o, 0, 0, 0); }
#pragma unroll
                        for (int rg = 0; rg < 4; ++rg) OB[(16 * w + 4 * g4 + rg) * POB + 16 * cb + r16] = o[rg]; }
                }
            } else {
                const int wq = wave - 4;
                float dec[4];
#pragma unroll
                for (int rg = 0; rg < 4; ++rg) dec[rg] = DEC[16 * wq + 4 * g4 + rg];
                bf16x8 kef[2];
#pragma unroll
                for (int s = 0; s < 2; ++s) kef[s] = tr2(KE + (32 * s + 8 * g4 + q4) * PQ + 16 * wq + 4 * p4, KE + (32 * s + 8 * g4 + 4 + q4) * PQ + 16 * wq + 4 * p4);
#pragma unroll
                for (int cb = 0; cb < 8; ++cb) {
#pragma unroll
                    for (int rg = 0; rg < 4; ++rg) accS[cb][rg] *= dec[rg];
#pragma unroll
                    for (int s = 0; s < 2; ++s) { const bf16x8 vf = tr2(VS + (32 * s + 8 * g4 + q4) * PV + 16 * cb + 4 * p4, VS + (32 * s + 8 * g4 + 4 + q4) * PV + 16 * cb + 4 * p4);
                        accS[cb] = __builtin_amdgcn_mfma_f32_16x16x32_bf16(kef[s], vf, accS[cb], 0, 0, 0); }
                    if (FULL) { u32x2 w; w.x = pk2(accS[cb][0], accS[cb][1]); w.y = pk2(accS[cb][2], accS[cb][3]); *(LAS u32x2*)(STw + (16 * cb + r16) * PQ + 16 * wq + 4 * g4) = w; }
                }
            }
            A_LBAR();
            if (FULL && !metac) {
                const int i = tid >> 3, cc = tid & 7;
                float o[16];
#pragma unroll
                for (int k4 = 0; k4 < 4; ++k4) { const f32x4 t = *(const LAS f32x4*)(OB + i * POB + 16 * cc + 4 * k4); o[4 * k4] = t[0]; o[4 * k4 + 1] = t[1]; o[4 * k4 + 2] = t[2]; o[4 * k4 + 3] = t[3]; }
                const size_t row = (size_t)(rowbase + i);
                const u32x4 ga = gpre[0], gb2 = gpre[1];
                const unsigned gw[8] = {ga.x, ga.y, ga.z, ga.w, gb2.x, gb2.y, gb2.z, gb2.w};
                float s1 = 0.f, s2 = 0.f;
#pragma unroll
                for (int k = 0; k < 16; ++k) { s1 += o[k]; s2 += o[k] * o[k]; }
#pragma unroll
                for (int m = 1; m < 8; m <<= 1) { s1 += __shfl_xor(s1, m); s2 += __shfl_xor(s2, m); }
                const float mu = gla ? 0.f : s1 * (1.0f / 128.0f);
                const float rs = __builtin_amdgcn_rsqf(fmaxf(s2 * (1.0f / 128.0f) - mu * mu, 0.f) + EPS);
                unsigned ow[8];
#pragma unroll
                for (int k2 = 0; k2 < 8; ++k2) { float y[2];
#pragma unroll
                    for (int e = 0; e < 2; ++e) { const int k = 2 * k2 + e; const float v = (o[k] - mu) * rs * gnv[k >> 2][k & 3] + bsv[k >> 2][k & 3];
                        const float gt = e ? bf_hi(gw[k2]) : bf_lo(gw[k2]); y[e] = v * gt * __builtin_amdgcn_rcpf(1.0f + __expf(-gt)); }
                    ow[k2] = pk2(y[0], y[1]); }
                u32x4* op = (u32x4*)(OUT + (row - 256) * DM + h8 * 128 + 16 * cc);
                op[0] = (u32x4){ow[0], ow[1], ow[2], ow[3]}; op[1] = (u32x4){ow[4], ow[5], ow[6], ow[7]};
            }
        }
        if (!FULL) {
            if (wave >= 4) { const int wq = wave - 4; float* Sg = metaitem ? SEGM + (size_t)h8 * 8192 : SEG + (size_t)item * 8192;
#pragma unroll
                for (int cb = 0; cb < 8; ++cb)
#pragma unroll
                    for (int rg = 0; rg < 4; ++rg) Sg[(16 * wq + 4 * g4 + rg) * 128 + 16 * cb + r16] = accS[cb][rg]; }
            if (lane < 8 && !metaitem) { float bl = blsum[0];
#pragma unroll
                for (int c = 1; c < 8; ++c) bl = (lane == c) ? blsum[c] : bl;
                ASEG[item * 64 + 8 * wave + lane] = __expf(bl); }
        }
#undef A_LBAR
#undef A_ROWBASE
#undef A_LOADCHUNK
    }
}

__device__ __forceinline__ unsigned ord32(float f) { const unsigned b = __builtin_bit_cast(unsigned, f); return b ^ ((b >> 31) ? 0xffffffffu : 0x80000000u); }
__device__ __forceinline__ float unord32(unsigned o) { const unsigned b = (o >> 31) ? (o ^ 0x80000000u) : ~o; return __builtin_bit_cast(float, b); }
#define DPP_MAXU(v, ctrl, rmask) do { const unsigned _t = (unsigned)__builtin_amdgcn_update_dpp((int)(v), (int)(v), (ctrl), (rmask), 0xf, false); (v) = (v) > _t ? (v) : _t; } while (0)
#define DPP_ADDF(v, ctrl) do { const float _t = __builtin_bit_cast(float, __builtin_amdgcn_update_dpp(0, __builtin_bit_cast(int, (v)), (ctrl), 0xf, 0xf, false)); (v) += _t; } while (0)
__device__ __forceinline__ unsigned row_max_u(unsigned v) { DPP_MAXU(v, 0xB1, 0xf); DPP_MAXU(v, 0x4E, 0xf); DPP_MAXU(v, 0x124, 0xf); DPP_MAXU(v, 0x128, 0xf); return v; }
__device__ __forceinline__ float row_sum_f(float v) { DPP_ADDF(v, 0xB1); DPP_ADDF(v, 0x4E); DPP_ADDF(v, 0x124); DPP_ADDF(v, 0x128); return v; }
__device__ __forceinline__ unsigned wave_max_u(unsigned v) { v = row_max_u(v); DPP_MAXU(v, 0x142, 0xa); DPP_MAXU(v, 0x143, 0xc); return (unsigned)__builtin_amdgcn_readlane((int)v, 63); }

__device__ __forceinline__ float row_sum_x(float v) { return row_sum_f(v); }
__device__ __forceinline__ float dot2_bf16(unsigned w, unsigned x, float acc) { return __builtin_amdgcn_fdot2_f32_bf16(__builtin_bit_cast(bf16x2_t, w), __builtin_bit_cast(bf16x2_t, x), acc, false); }
__device__ __forceinline__ float gelu_exact(float v) { return 0.5f * v * (1.0f + erff(v * 0.70710678118654752f)); }

__device__ __forceinline__ void phase_peer(const Params& p, LAS unsigned char* lds, int bid, int nb) {
    const int tid = threadIdx.x, lane = tid & 63, wave = __builtin_amdgcn_readfirstlane(tid >> 6);
    const int p16 = lane & 15, rg4 = lane >> 4;
    unsigned char* ws = p.ws;
    const _Float16* SC = (const _Float16*)(ws + WS_PROJ); const bf16_t* HB = (const bf16_t*)(ws + WS_HB); const float* SSQ = (const float*)(ws + WS_SSQ);
    const unsigned char* UB = (const unsigned char*)(ws + WS_UB); const unsigned char* VB = (const unsigned char*)(ws + WS_VB);
    LAS float* A_s = (LAS float*)(lds + wave * 4096);
    LAS int* A_i = (LAS int*)(lds + wave * 4096 + 1024);
    LAS int* E_i = (LAS int*)(lds + wave * 4096 + 2048);
    LAS float* E_s = (LAS float*)(lds + wave * 4096 + 2560);
    int ci = 0, cj = 0; bool cvalid = lane < 50;
    { int l = lane;
      if (l < 16) { ci = 0; cj = l; } else if (l < 24) { ci = 1; cj = l - 16; } else if (l < 29) { ci = 2; cj = l - 24; } else if (l < 33) { ci = 3; cj = l - 29; }
      else if (l < 36) { ci = 4; cj = l - 33; } else if (l < 42) { ci = 5 + (l - 36) / 2; cj = (l - 36) & 1; } else { ci = 8 + (l - 42); cj = 0; } if (!cvalid) { ci = 0; cj = 0; } }
    const int gw = bid * 8 + wave, NGW = nb * 8;
    for (int t = gw; t < NTOK; t += NGW) {
        float ssq = (lane < 16) ? SSQ[(size_t)t * 16 + lane] : 0.f; ssq = wave_sum(ssq);
        const float rstd = 1.0f / sqrtf(ssq * (1.0f / DM) + EPS);
#pragma unroll 1
        for (int q = 0; q < 4; ++q) {
            const u32x4 raw = *(const u32x4*)(SC + (size_t)t * 2048 + 512 * q + 8 * lane);
            const unsigned rw[4] = {raw.x, raw.y, raw.z, raw.w};
            unsigned key[8];
#pragma unroll
            for (int e = 0; e < 8; ++e) { const unsigned hbits = (e & 1) ? (rw[e >> 1] >> 16) : (rw[e >> 1] & 0xffffu);
                const float f = (float)__builtin_bit_cast(_Float16, (unsigned short)hbits);
                key[e] = (ord32(f) & ~0x7fu) | (unsigned)(127 - (8 * p16 + e)); }
            unsigned mine = 0u;
#pragma unroll 1
            for (int it = 0; it < 16; ++it) {
                unsigned m = key[0];
#pragma unroll
                for (int e = 1; e < 8; ++e) m = m > key[e] ? m : key[e];
                const unsigned W = row_max_u(m);
                mine = (p16 == it) ? W : mine;
#pragma unroll
                for (int e = 0; e < 8; ++e) key[e] = (key[e] == W) ? 0u : key[e];
            }
            const int g = 4 * q + rg4;
            A_s[g * 16 + p16] = unord32(mine & ~0x7fu); A_i[g * 16 + p16] = 127 - (int)(mine & 0x7fu);
        }
        LDS_WAIT();
#pragma unroll 1
        for (int h = 0; h < 8; ++h) {
            const float sa = A_s[(2 * h) * 16 + ci], sb = A_s[(2 * h + 1) * 16 + cj];
            const int ia = A_i[(2 * h) * 16 + ci], ib = A_i[(2 * h + 1) * 16 + cj];
            const float sum = sa + sb;
            unsigned key = cvalid ? ((ord32(sum) & ~0x3fu) | (unsigned)(63 - lane)) : 0u;
            int rank = -1;
#pragma unroll 1
            for (int it = 0; it < 16; ++it) { const unsigned W = wave_max_u(key); if (key == W) { rank = it; key = 0u; } }
            if (rank >= 0) { E_i[h * 16 + rank] = ia * 128 + ib; E_s[h * 16 + rank] = sum; }
        }
        LDS_WAIT();
        float gsm[2]; int eidx[2];
#pragma unroll
        for (int sl = 0; sl < 2; ++sl) { const int e = lane + 64 * sl; const float s = E_s[e] * rstd, mx = E_s[e & ~15] * rstd; const float pe = __expf(s - mx); const float den = row_sum_x(pe);
            gsm[sl] = pe / den; eidx[sl] = E_i[e]; }
#if PEER_FP8
        f32x2v xf[4][8];
#pragma unroll
        for (int i = 0; i < 4; ++i) { const u32x4 h0 = *(const u32x4*)(HB + (size_t)t * DM + 256 * i + 16 * p16), h1 = *(const u32x4*)(HB + (size_t)t * DM + 256 * i + 16 * p16 + 8);
            const unsigned hv[8] = {h0.x, h0.y, h0.z, h0.w, h1.x, h1.y, h1.z, h1.w}; const float* gp = p.g2 + 256 * i + 16 * p16;
#pragma unroll
            for (int k2 = 0; k2 < 8; ++k2) { const f32x2v g = *(const f32x2v*)(gp + 2 * k2); xf[i][k2] = (f32x2v){bf_lo(hv[k2]) * rstd * g.x, bf_hi(hv[k2]) * rstd * g.y}; } }
        constexpr int NBB = 2;
#define P6_LOADB(buf, TAB, bt0) do { _Pragma("unroll") for (int j = 0; j < NBB; ++j) { const int bt = (bt0) + j; const int ex = E_i[64 * (bt >> 4) + 16 * rg4 + (bt & 15)]; \
            const unsigned char* rp = (TAB) + (size_t)ex * 1024 + 16 * p16; _Pragma("unroll") for (int i = 0; i < 4; ++i) buf[j][i] = *(const u32x4*)(rp + 256 * i); } } while (0)
        u32x4 bA[NBB][4], bB[NBB][4];
        float act0 = 0.f, act1 = 0.f;
#define P6_COMPU(buf, bt0) do { _Pragma("unroll") for (int j = 0; j < NBB; ++j) { const int bt = (bt0) + j; f32x2v s2 = (f32x2v){0.f, 0.f}; \
            _Pragma("unroll") for (int i = 0; i < 4; ++i) { const unsigned uu[4] = {buf[j][i].x, buf[j][i].y, buf[j][i].z, buf[j][i].w}; \
                _Pragma("unroll") for (int w = 0; w < 4; ++w) { const f32x2v lo = __builtin_amdgcn_cvt_pk_f32_fp8((int)uu[w], false), hi = __builtin_amdgcn_cvt_pk_f32_fp8((int)uu[w], true); \
                    s2 = __builtin_elementwise_fma(lo, xf[i][2 * w], s2); s2 = __builtin_elementwise_fma(hi, xf[i][2 * w + 1], s2); } } \
            const float s = row_sum_x(s2.x + s2.y); const bool mine = (p16 == (bt & 15)); act0 = (mine && bt < 16) ? s : act0; act1 = (mine && bt >= 16) ? s : act1; } } while (0)
        P6_LOADB(bA, UB, 0);
#pragma unroll 1
        for (int g = 0; g < 32; g += 2 * NBB) { P6_LOADB(bB, UB, g + NBB); P6_COMPU(bA, g); if (g + 2 * NBB < 32) P6_LOADB(bA, UB, g + 2 * NBB); P6_COMPU(bB, g + NBB); }
        P6_LOADB(bA, VB, 0);
        LAS float* E_c = E_s;
        { const float c0 = gsm[0] * gelu_exact(act0 * (1.0f / 512.0f)) * (1.0f / 32.0f), c1 = gsm[1] * gelu_exact(act1 * (1.0f / 512.0f)) * (1.0f / 32.0f);
          LDS_WAIT(); E_c[lane] = c0; E_c[lane + 64] = c1; LDS_WAIT(); }
        f32x2v acc2[4][8];
#pragma unroll
        for (int i = 0; i < 4; ++i)
#pragma unroll
            for (int k = 0; k < 8; ++k) acc2[i][k] = (f32x2v){0.f, 0.f};
#define P6_COMPV(buf, bt0) do { _Pragma("unroll") for (int j = 0; j < NBB; ++j) { const int bt = (bt0) + j; const float cf = E_c[64 * (bt >> 4) + 16 * rg4 + (bt & 15)]; const f32x2v cf2 = (f32x2v){cf, cf}; \
            _Pragma("unroll") for (int i = 0; i < 4; ++i) { const unsigned vv[4] = {buf[j][i].x, buf[j][i].y, buf[j][i].z, buf[j][i].w}; \
                _Pragma("unroll") for (int w = 0; w < 4; ++w) { const f32x2v lo = __builtin_amdgcn_cvt_pk_f32_fp8((int)vv[w], false), hi = __builtin_amdgcn_cvt_pk_f32_fp8((int)vv[w], true); \
                    acc2[i][2 * w] = __builtin_elementwise_fma(lo, cf2, acc2[i][2 * w]); acc2[i][2 * w + 1] = __builtin_elementwise_fma(hi, cf2, acc2[i][2 * w + 1]); } } } } while (0)
#pragma unroll 1
        for (int g = 0; g < 32; g += 2 * NBB) { P6_LOADB(bB, VB, g + NBB); P6_COMPV(bA, g); if (g + 2 * NBB < 32) P6_LOADB(bA, VB, g + 2 * NBB); P6_COMPV(bB, g + NBB); }
#undef P6_LOADB
#undef P6_COMPU
#undef P6_COMPV
        float ss = 0.f;
#pragma unroll
        for (int i = 0; i < 4; ++i) { const u32x4 h0 = *(const u32x4*)(HB + (size_t)t * DM + 256 * i + 16 * p16), h1 = *(const u32x4*)(HB + (size_t)t * DM + 256 * i + 16 * p16 + 8);
            const unsigned hv[8] = {h0.x, h0.y, h0.z, h0.w, h1.x, h1.y, h1.z, h1.w};
#pragma unroll
            for (int k2 = 0; k2 < 8; ++k2) { float ax = acc2[i][k2].x, ay = acc2[i][k2].y;
                ax += __shfl_xor(ax, 16); ax += __shfl_xor(ax, 32); ay += __shfl_xor(ay, 16); ay += __shfl_xor(ay, 32);
                ax += bf_lo(hv[k2]); ay += bf_hi(hv[k2]); acc2[i][k2] = (f32x2v){ax, ay}; ss += ax * ax + ay * ay; } }
        ss = row_sum_x(ss);
        const float rf = 1.0f / sqrtf(ss * (1.0f / DM) + EPS);
#pragma unroll
        for (int i = 0; i < 4; ++i) { if (i == rg4) { const float* gp = p.gfin + 256 * i + 16 * p16; float* op = p.out + (size_t)t * DM + 256 * i + 16 * p16;
#pragma unroll
                for (int k4 = 0; k4 < 4; ++k4) { const f32x4 g = *(const f32x4*)(gp + 4 * k4);
                    *(f32x4*)(op + 4 * k4) = (f32x4){acc2[i][2 * k4].x * rf * g[0], acc2[i][2 * k4].y * rf * g[1], acc2[i][2 * k4 + 1].x * rf * g[2], acc2[i][2 * k4 + 1].y * rf * g[3]}; } } }
#else
        unsigned xp[8][4];
#pragma unroll
        for (int i = 0; i < 8; ++i) { const u32x4 hw = *(const u32x4*)(HB + (size_t)t * DM + 128 * i + 8 * p16); const f32x4 ga = *(const f32x4*)(p.g2 + 128 * i + 8 * p16), gb = *(const f32x4*)(p.g2 + 128 * i + 8 * p16 + 4);
            xp[i][0] = pk2(bf_lo(hw.x) * rstd * ga[0], bf_hi(hw.x) * rstd * ga[1]); xp[i][1] = pk2(bf_lo(hw.y) * rstd * ga[2], bf_hi(hw.y) * rstd * ga[3]);
            xp[i][2] = pk2(bf_lo(hw.z) * rstd * gb[0], bf_hi(hw.z) * rstd * gb[1]); xp[i][3] = pk2(bf_lo(hw.w) * rstd * gb[2], bf_hi(hw.w) * rstd * gb[3]); }
        float act[2] = {0.f, 0.f};
#pragma unroll
        for (int sl = 0; sl < 2; ++sl) {
#pragma unroll 2
            for (int b16 = 0; b16 < 16; ++b16) {
                const int e = 64 * sl + 16 * rg4 + b16; const int ex = E_i[e];
                const unsigned char* rowp = UB + (size_t)ex * 2048 + 16 * p16;
                float s = 0.f;
#pragma unroll
                for (int i = 0; i < 8; ++i) { const u32x4 uw = *(const u32x4*)(rowp + 256 * i);
                    s = dot2_bf16(uw.x, xp[i][0], s); s = dot2_bf16(uw.y, xp[i][1], s); s = dot2_bf16(uw.z, xp[i][2], s); s = dot2_bf16(uw.w, xp[i][3], s); }
                s = row_sum_x(s);
                act[sl] = (p16 == b16) ? s : act[sl];
            }
        }
        float coef[2];
#pragma unroll
        for (int sl = 0; sl < 2; ++sl) coef[sl] = gsm[sl] * gelu_exact(act[sl]);
        float acc[8][8];
#pragma unroll
        for (int i = 0; i < 8; ++i)
#pragma unroll
            for (int k = 0; k < 8; ++k) acc[i][k] = 0.f;
#pragma unroll
        for (int sl = 0; sl < 2; ++sl) {
#pragma unroll 2
            for (int b16 = 0; b16 < 16; ++b16) {
                const int srcl = (lane & 48) + b16;
                const float cf = __shfl(coef[sl], srcl); const int ex = __shfl(eidx[sl], srcl);
                const unsigned char* rowp = VB + (size_t)ex * 2048 + 16 * p16;
#pragma unroll
                for (int i = 0; i < 8; ++i) { const u32x4 vw = *(const u32x4*)(rowp + 256 * i);
                    acc[i][0] += cf * bf_lo(vw.x); acc[i][1] += cf * bf_hi(vw.x); acc[i][2] += cf * bf_lo(vw.y); acc[i][3] += cf * bf_hi(vw.y);
                    acc[i][4] += cf * bf_lo(vw.z); acc[i][5] += cf * bf_hi(vw.z); acc[i][6] += cf * bf_lo(vw.w); acc[i][7] += cf * bf_hi(vw.w); }
            }
        }
        float ss = 0.f;
#pragma unroll
        for (int i = 0; i < 8; ++i) { const u32x4 hw = *(const u32x4*)(HB + (size_t)t * DM + 128 * i + 8 * p16); const unsigned hv[4] = {hw.x, hw.y, hw.z, hw.w};
#pragma unroll
            for (int k = 0; k < 8; ++k) { float a = acc[i][k]; a += __shfl_xor(a, 16); a += __shfl_xor(a, 32);
                a += (k & 1) ? bf_hi(hv[k >> 1]) : bf_lo(hv[k >> 1]); acc[i][k] = a; ss += a * a; } }
        ss = row_sum_x(ss);
        const float rf = 1.0f / sqrtf(ss * (1.0f / DM) + EPS);
#pragma unroll
        for (int i = 0; i < 8; ++i) { if ((i >> 1) == rg4) { const f32x4 ga = *(const f32x4*)(p.gfin + 128 * i + 8 * p16), gb = *(const f32x4*)(p.gfin + 128 * i + 8 * p16 + 4);
                float* op = p.out + (size_t)t * DM + 128 * i + 8 * p16;
                *(f32x4*)op = (f32x4){acc[i][0] * rf * ga[0], acc[i][1] * rf * ga[1], acc[i][2] * rf * ga[2], acc[i][3] * rf * ga[3]};
                *(f32x4*)(op + 4) = (f32x4){acc[i][4] * rf * gb[0], acc[i][5] * rf * gb[1], acc[i][6] * rf * gb[2], acc[i][7] * rf * gb[3]}; } }
#endif
        LDS_WAIT();
    }
}


__device__ __forceinline__ void row_max4(unsigned k0, unsigned k1, unsigned k2, unsigned k3, unsigned& w0, unsigned& w1, unsigned& w2, unsigned& w3) {
    asm volatile("s_nop 1\n\t"
                 "v_max_u32_dpp %0, %4, %4 quad_perm:[1,0,3,2] row_mask:0xf bank_mask:0xf\n\t"
                 "v_max_u32_dpp %1, %5, %5 quad_perm:[1,0,3,2] row_mask:0xf bank_mask:0xf\n\t"
                 "v_max_u32_dpp %2, %6, %6 quad_perm:[1,0,3,2] row_mask:0xf bank_mask:0xf\n\t"
                 "v_max_u32_dpp %3, %7, %7 quad_perm:[1,0,3,2] row_mask:0xf bank_mask:0xf\n\t"
                 "v_max_u32_dpp %0, %0, %0 quad_perm:[2,3,0,1] row_mask:0xf bank_mask:0xf\n\t"
                 "v_max_u32_dpp %1, %1, %1 quad_perm:[2,3,0,1] row_mask:0xf bank_mask:0xf\n\t"
                 "v_max_u32_dpp %2, %2, %2 quad_perm:[2,3,0,1] row_mask:0xf bank_mask:0xf\n\t"
                 "v_max_u32_dpp %3, %3, %3 quad_perm:[2,3,0,1] row_mask:0xf bank_mask:0xf\n\t"
                 "v_max_u32_dpp %0, %0, %0 row_ror:4 row_mask:0xf bank_mask:0xf\n\t"
                 "v_max_u32_dpp %1, %1, %1 row_ror:4 row_mask:0xf bank_mask:0xf\n\t"
                 "v_max_u32_dpp %2, %2, %2 row_ror:4 row_mask:0xf bank_mask:0xf\n\t"
                 "v_max_u32_dpp %3, %3, %3 row_ror:4 row_mask:0xf bank_mask:0xf\n\t"
                 "v_max_u32_dpp %0, %0, %0 row_ror:8 row_mask:0xf bank_mask:0xf\n\t"
                 "v_max_u32_dpp %1, %1, %1 row_ror:8 row_mask:0xf bank_mask:0xf\n\t"
                 "v_max_u32_dpp %2, %2, %2 row_ror:8 row_mask:0xf bank_mask:0xf\n\t"
                 "v_max_u32_dpp %3, %3, %3 row_ror:8 row_mask:0xf bank_mask:0xf\n\t"
                 "s_nop 1"
                 : "=&v"(w0), "=&v"(w1), "=&v"(w2), "=&v"(w3) : "v"(k0), "v"(k1), "v"(k2), "v"(k3));
}
__device__ __forceinline__ unsigned pkadd_h2(unsigned a, unsigned b) { const h2v x = __builtin_bit_cast(h2v, a), y = __builtin_bit_cast(h2v, b); const h2v s = x + y; return __builtin_bit_cast(unsigned, s); }
constexpr int NT6 = 8;
constexpr int W6_BYTES = 16640;
__device__ __forceinline__ float dpp_f(float v, int ctrl_dummy);
#define DPPF(v, ctrl) __builtin_bit_cast(float, __builtin_amdgcn_update_dpp(0, __builtin_bit_cast(int, (v)), (ctrl), 0xf, 0xf, false))

__device__ __forceinline__ void phase_peer2(const Params& p, LAS unsigned char* lds, int bid, int nb) {
    const int tid = threadIdx.x, lane = tid & 63, wave = __builtin_amdgcn_readfirstlane(tid >> 6);
    const int p16 = lane & 15, rg4 = lane >> 4, q8 = lane >> 3, p8 = lane & 7;
    const bool b0 = lane & 1, b1 = lane & 2, b2 = lane & 4, c0 = lane & 8, c1 = lane & 16, c2 = lane & 32;
    unsigned char* ws = p.ws;
    const _Float16* SC = (const _Float16*)(ws + WS_PROJ); const bf16_t* HB = (const bf16_t*)(ws + WS_HB); const float* SSQ = (const float*)(ws + WS_SSQ);
    const unsigned char* UB = (const unsigned char*)(ws + WS_UB); const unsigned char* VB = (const unsigned char*)(ws + WS_VB); unsigned char* XQ = ws + WS_XQ; bf16_t* OS = (bf16_t*)(ws + WS_O);
    LAS unsigned char* wl = lds + wave * W6_BYTES;
    LAS unsigned* CW = (LAS unsigned*)wl;
    LAS unsigned char* XL = wl;
    LAS unsigned short* E16 = (LAS unsigned short*)(wl + 8192);
    LAS _Float16* GC = (LAS _Float16*)(wl + 10240);
    LAS unsigned* E32 = (LAS unsigned*)(wl + 4096);
    LAS float* ACT = (LAS float*)(wl + 12288);
    LAS float* RS = (LAS float*)(wl + 16384);
    const unsigned kbase[4] = {12288u + 4u * lane, 14336u + 4u * lane, 6144u + 4u * lane, ((lane >> 5) ? 5120u : 2048u) + 4u * (lane & 31)};
    constexpr unsigned kshift[4] = {8u, 8u, 8u, 7u};
    unsigned ixc[8];
#pragma unroll
    for (int e = 0; e < 8; ++e) ixc[e] = (unsigned)(127 - (8 * p16 + e));
    int ci = 0, cj = 0; bool cvalid = lane < 50;
    { int l = lane;
      if (l < 16) { ci = 0; cj = l; } else if (l < 24) { ci = 1; cj = l - 16; } else if (l < 29) { ci = 2; cj = l - 24; } else if (l < 33) { ci = 3; cj = l - 29; }
      else if (l < 36) { ci = 4; cj = l - 33; } else if (l < 42) { ci = 5 + (l - 36) / 2; cj = (l - 36) & 1; } else { ci = 8 + (l - 42); cj = 0; } if (!cvalid) { ci = 0; cj = 0; } }
    const int gw = bid * 8 + wave, NGW = nb * 8;
#define TOK6(k) min(base + (k) * NGW, NTOK - 1)
    for (int base = gw; base < NTOK; base += NT6 * NGW) {
#pragma unroll 1
        for (int rep_r = 0; rep_r < PROBE_R; ++rep_r)
#pragma unroll 1
        for (int k = 0; k < NT6; k += 2) {
            u32x4 raw[2][4]; float rstd[2];
#pragma unroll
            for (int v = 0; v < 2; ++v) { const int t = TOK6(k + v);
#pragma unroll
                for (int q = 0; q < 4; ++q) raw[v][q] = *(const u32x4*)(SC + (size_t)t * 2048 + 512 * q + 8 * lane);
                float ssq = (lane < 16) ? SSQ[(size_t)t * 16 + lane] : 0.f; ssq = wave_sum(ssq);
                rstd[v] = 1.0f / sqrtf(ssq * (1.0f / DM) + EPS);
                { const u32x4 ha = *(const u32x4*)(HB + (size_t)t * DM + 16 * lane), hb = *(const u32x4*)(HB + (size_t)t * DM + 16 * lane + 8); const float sc = rstd[v] * 16.0f;
                  const unsigned hv[8] = {ha.x, ha.y, ha.z, ha.w, hb.x, hb.y, hb.z, hb.w}; unsigned xw[4];
#pragma unroll
                  for (int w = 0; w < 4; ++w) { int pk = __builtin_amdgcn_cvt_pk_fp8_f32(bf_lo(hv[2 * w]) * sc, bf_hi(hv[2 * w]) * sc, 0, false);
                      pk = __builtin_amdgcn_cvt_pk_fp8_f32(bf_lo(hv[2 * w + 1]) * sc, bf_hi(hv[2 * w + 1]) * sc, pk, true); xw[w] = (unsigned)pk; }
                  *(u32x4*)(XQ + (size_t)t * DM + 16 * lane) = (u32x4){xw[0], xw[1], xw[2], xw[3]}; } }
#pragma unroll
            for (int qq = 0; qq < 2; ++qq) {
                unsigned ka[4][8];
#pragma unroll
                for (int c = 0; c < 4; ++c) { const u32x4 rv = raw[c >> 1][2 * qq + (c & 1)]; const unsigned rw[4] = {rv.x, rv.y, rv.z, rv.w};
#pragma unroll
                    for (int i = 0; i < 4; ++i) {
                        const s16x2 hv2 = __builtin_bit_cast(s16x2, rw[i]); const s16x2 sg = hv2 >> 15; const unsigned kk = rw[i] ^ (__builtin_bit_cast(unsigned, sg) | 0x80008000u);
                        ka[c][2 * i] = (kk << 16) | ixc[2 * i]; ka[c][2 * i + 1] = (kk & 0xffff0000u) | ixc[2 * i + 1]; } }
#define CE6(u, i, j) do { const unsigned _a = ka[u][i], _b = ka[u][j]; ka[u][i] = _a > _b ? _a : _b; ka[u][j] = _a > _b ? _b : _a; } while (0)
#pragma unroll
                for (int u = 0; u < 4; ++u) {
                    CE6(u, 0, 1); CE6(u, 2, 3); CE6(u, 4, 5); CE6(u, 6, 7);
                    CE6(u, 0, 2); CE6(u, 1, 3); CE6(u, 4, 6); CE6(u, 5, 7);
                    CE6(u, 1, 2); CE6(u, 5, 6);
                    CE6(u, 0, 4); CE6(u, 1, 5); CE6(u, 2, 6); CE6(u, 3, 7);
                    CE6(u, 2, 4); CE6(u, 3, 5);
                    CE6(u, 1, 2); CE6(u, 3, 4); CE6(u, 5, 6);
                }
#undef CE6
                unsigned mine[4] = {0u, 0u, 0u, 0u};
                unsigned head[4], nxt[4], kptr[4] = {0u, 0u, 0u, 0u};
#pragma unroll
                for (int c = 0; c < 4; ++c) { head[c] = ka[c][0]; nxt[c] = ka[c][1];
#pragma unroll
                    for (int j = 0; j < 8; ++j) *(LAS unsigned*)(wl + kbase[c] + (j << kshift[c])) = (j < 7) ? ka[c][j + 1] : 0u; }
#pragma unroll 1
                for (int it = 0; it < 16; ++it) {
                    unsigned Wv[4]; row_max4(head[0], head[1], head[2], head[3], Wv[0], Wv[1], Wv[2], Wv[3]);
#pragma unroll
                    for (int c = 0; c < 4; ++c) {
                        const unsigned W = Wv[c];
                        mine[c] = (p16 == it) ? W : mine[c];
                        const bool win = (head[c] == W);
                        head[c] = win ? nxt[c] : head[c];
                        kptr[c] += win ? 1u : 0u;
                        nxt[c] = *(const LAS unsigned*)(wl + kbase[c] + (kptr[c] << kshift[c]));
                    }
                }
#pragma unroll
                for (int c = 0; c < 4; ++c) { const int g = 4 * (2 * qq + (c & 1)) + rg4; LAS int* A_s = (LAS int*)(wl + 3072 * (c >> 1)); LAS int* A_i = (LAS int*)(wl + 3072 * (c >> 1) + 1024);
                    const unsigned k16 = mine[c] >> 16; const unsigned hbits = k16 ^ ((k16 & 0x8000u) ? 0x8000u : 0xffffu);
                    const float fs = (float)__builtin_bit_cast(_Float16, (unsigned short)hbits);
                    A_s[g * 16 + p16] = (int)__builtin_rintf(fs * 16384.0f); A_i[g * 16 + p16] = 127 - (int)(mine[c] & 0x7fu); }
            }
            LDS_WAIT();
            {
                int av[4], bc[4]; int iav[4], ibc[4], jp[4], hh[4], bb[4]; unsigned key[4];
#pragma unroll
                for (int c = 0; c < 4; ++c) { const LAS int* A_s = (const LAS int*)(wl + 3072 * (c >> 1)); const LAS int* A_i = (const LAS int*)(wl + 3072 * (c >> 1) + 1024);
                    hh[c] = 4 * (c & 1) + rg4; bb[c] = (2 * hh[c] + 1) * 16; av[c] = A_s[(2 * hh[c]) * 16 + p16] + (1 << 20); iav[c] = A_i[(2 * hh[c]) * 16 + p16] * 128; jp[c] = 0; bc[c] = A_s[bb[c]]; ibc[c] = A_i[bb[c]];
                    key[c] = ((unsigned)(av[c] + bc[c]) << 4) | (unsigned)(15 - p16); }
#pragma unroll 1
                for (int it = 0; it < 16; ++it) {
                    unsigned Wv[4]; row_max4(key[0], key[1], key[2], key[3], Wv[0], Wv[1], Wv[2], Wv[3]);
#pragma unroll
                    for (int c = 0; c < 4; ++c) {
                        const LAS int* A_s = (const LAS int*)(wl + 3072 * (c >> 1)); const LAS int* A_i = (const LAS int*)(wl + 3072 * (c >> 1) + 1024);
                        LAS int* E_i = (LAS int*)(wl + 3072 * (c >> 1) + 2048); LAS int* E_s = (LAS int*)(wl + 3072 * (c >> 1) + 2560);
                        const bool win = (key[c] == Wv[c]);
                        if (win) { E_i[hh[c] * 16 + it] = iav[c] + ibc[c]; E_s[hh[c] * 16 + it] = av[c] + bc[c]; }
                        jp[c] += win ? 1 : 0;
                        bc[c] = A_s[bb[c] + jp[c]]; ibc[c] = A_i[bb[c] + jp[c]];
                        key[c] = ((unsigned)(av[c] + bc[c]) << 4) | (unsigned)(15 - p16);
                    }
                }
            }
            LDS_WAIT();
#pragma unroll
            for (int v = 0; v < 2; ++v) { const LAS int* E_i = (const LAS int*)(wl + 3072 * v + 2048); const LAS int* E_s = (const LAS int*)(wl + 3072 * v + 2560);
#pragma unroll
                for (int sl = 0; sl < 2; ++sl) { const int e = lane + 64 * sl; const float pe = __expf((float)(E_s[e] - E_s[e & ~15]) * (rstd[v] * (1.0f / 16384.0f))); const float den = row_sum_x(pe);
                    const int pos = 16 * (e & 7) + (e >> 3);
                    GC[(k + v) * 128 + pos] = (_Float16)(pe / den); E16[(k + v) * 128 + pos] = (unsigned short)E_i[e]; }
                if (lane == 0) RS[k + v] = rstd[v]; }
            LDS_WAIT();
        }
#define P6_LOADH(buf, TAB, jj, kk, hh) do { const u32x4 _iv = *(const LAS u32x4*)(E16 + (kk) * 128 + 16 * q8 + 8 * (hh)); const unsigned _iw[4] = {_iv.x, _iv.y, _iv.z, _iv.w}; \
            _Pragma("unroll") for (int c = 0; c < 8; ++c) { const unsigned _idx = (c & 1) ? (_iw[c >> 1] >> 16) : (_iw[c >> 1] & 0xffffu); \
                buf[c] = *(const u32x4*)((TAB) + (((size_t)(jj) * NEXP + _idx) << 7) + 16 * p8); } } while (0)
#define P6_LOADX(hb, jj, kk) do { const bf16_t* _hp = HB + (size_t)TOK6(kk) * DM + 128 * (jj) + 16 * p8; hb[0] = *(const u32x4*)_hp; hb[1] = *(const u32x4*)(_hp + 8); } while (0)
        asm volatile("s_waitcnt vmcnt(0)" ::: "memory");
        { u32x4 xr[NT6];
#pragma unroll
          for (int k = 0; k < NT6; ++k) xr[k] = *(const u32x4*)(XQ + (size_t)TOK6(k) * DM + 16 * lane);
#pragma unroll
          for (int k = 0; k < NT6; ++k) *(LAS u32x4*)(XL + k * 1024 + 16 * lane) = xr[k]; }
        LDS_WAIT();
#pragma unroll 1
        for (int rep_u = 0; rep_u < PROBE_U; ++rep_u) {
            for (int k = 0; k < NT6; ++k) { ACT[k * 128 + lane] = 0.f; ACT[k * 128 + 64 + lane] = 0.f; }
            LDS_WAIT();
            const int n16 = lane & 15, g4 = lane >> 4, c4 = lane & 3, r16 = 4 * g4 + (n16 >> 2);
            const int eoff = 2 * (16 * (r16 & 7) + (r16 >> 3));
            const bool xkeep = ((g4 >> 1) == ((n16 >> 2) & 1)); const bool klo = xkeep && (n16 < 8), khi = xkeep && (n16 >= 8);
            u32x4 bfP[16], bfQ[16];
#define P6_ULOAD(buf, nn) do { const int _j = (nn) / NT6, _k = (nn) % NT6; const LAS unsigned char* _ip = (const LAS unsigned char*)(E16 + _k * 128) + eoff; \
                _Pragma("unroll") for (int T = 0; T < 8; ++T) { const unsigned _idx = *(const LAS unsigned short*)(_ip + 4 * T); \
                    const unsigned char* _rp = UB + (((size_t)_j * NEXP + _idx) << 7) + 16 * c4; buf[2 * T] = *(const u32x4*)_rp; buf[2 * T + 1] = *(const u32x4*)(_rp + 64); } } while (0)
#define P6_PK64(lo, hi) ((long)(((unsigned long long)(hi) << 32) | (unsigned long long)(lo)))
#define P6_UMMA(buf, nn) do { const int k = (nn) % NT6; const LAS unsigned char* _xl = XL + k * 1024 + 256 * ((nn) / NT6) + 32 * c4 + 16 * (g4 & 1); \
                const u32x4 xv0 = *(const LAS u32x4*)_xl, xv1 = *(const LAS u32x4*)(_xl + 128); \
                const i32x8 xa0 = {(int)(klo ? xv0.x : 0u), (int)(klo ? xv0.y : 0u), (int)(klo ? xv0.z : 0u), (int)(klo ? xv0.w : 0u), \
                                   (int)(khi ? xv0.x : 0u), (int)(khi ? xv0.y : 0u), (int)(khi ? xv0.z : 0u), (int)(khi ? xv0.w : 0u)}; \
                const i32x8 xa1 = {(int)(klo ? xv1.x : 0u), (int)(klo ? xv1.y : 0u), (int)(klo ? xv1.z : 0u), (int)(klo ? xv1.w : 0u), \
                                   (int)(khi ? xv1.x : 0u), (int)(khi ? xv1.y : 0u), (int)(khi ? xv1.z : 0u), (int)(khi ? xv1.w : 0u)}; \
                float dsel[2] = {0.f, 0.f}; \
                _Pragma("unroll") for (int T = 0; T < 8; ++T) { f32x4 d = (f32x4){0.f, 0.f, 0.f, 0.f}; \
                    const i32x8 bb0 = {(int)buf[2 * T].x, (int)buf[2 * T].y, (int)buf[2 * T].z, (int)buf[2 * T].w, 0, 0, 0, 0}; \
                    const i32x8 bb1 = {(int)buf[2 * T + 1].x, (int)buf[2 * T + 1].y, (int)buf[2 * T + 1].z, (int)buf[2 * T + 1].w, 0, 0, 0, 0}; \
                    d = __builtin_amdgcn_mfma_scale_f32_16x16x128_f8f6f4(xa0, bb0, d, 0, 4, 0, MX_ONE, 0, MX_ONE); \
                    d = __builtin_amdgcn_mfma_scale_f32_16x16x128_f8f6f4(xa1, bb1, d, 0, 4, 0, MX_ONE, 0, MX_ONE); \
                    float pv = (c4 == 0) ? d[0] : ((c4 == 1) ? d[1] : ((c4 == 2) ? d[2] : d[3])); \
                    pv += DPPF(pv, 0xB1); pv += DPPF(pv, 0x4E);                         \
                    dsel[T >> 2] = ((T & 3) == c4) ? pv : dsel[T >> 2]; } \
                  \
                ACT[k * 128 + 16 * c4 + r16] += dsel[0]; ACT[k * 128 + 16 * (c4 + 4) + r16] += dsel[1]; } while (0)
            P6_ULOAD(bfP, 0);
#pragma unroll 1
            for (int n = 0; n < 4 * NT6; n += 2) {
                P6_ULOAD(bfQ, n + 1); asm volatile("" ::: "memory"); __builtin_amdgcn_sched_barrier(0);
                P6_UMMA(bfP, n); __builtin_amdgcn_sched_barrier(0);
                if (n + 2 < 4 * NT6) P6_ULOAD(bfP, n + 2);
                asm volatile("" ::: "memory"); __builtin_amdgcn_sched_barrier(0);
                P6_UMMA(bfQ, n + 1); __builtin_amdgcn_sched_barrier(0);
            }
#undef P6_ULOAD
#undef P6_UMMA
#undef P6_PK64
        }
        LDS_WAIT();
#pragma unroll 1
        for (int k = 0; k < NT6; ++k) {
#pragma unroll
            for (int sl = 0; sl < 2; ++sl) { const int e = lane + 64 * sl, pos = 16 * (e & 7) + (e >> 3); const float a = ACT[k * 128 + e] * (1.0f / 1024.0f);
                const float cfv = (float)GC[k * 128 + pos] * gelu_exact(a);
                CW[k * 128 + pos] = (unsigned)(__builtin_amdgcn_cvt_pk_fp8_f32(cfv * 32.0f, 0.f, 0, false) & 0xff) * 0x01010101u; E32[k * 128 + pos] = (unsigned)E16[k * 128 + pos] << 7; } }
        LDS_WAIT();
#pragma unroll 1
        for (int k = 0; k < NT6; ++k) ACT[k * 64 + lane] = 0.f;
        LDS_WAIT();
#pragma unroll 1
        for (int rep_v = 0; rep_v < PROBE_V; ++rep_v) {
            for (int k = 0; k < NT6; ++k) ACT[k * 64 + lane] = 0.f;
            LDS_WAIT();
            u32x4 bfP[16], bfQ[16];
            const int n16 = lane & 15, g4 = lane >> 4;
            const unsigned bsel = 0xffu << (8 * (n16 & 3));
            const unsigned M0 = (n16 >> 2) == 0 ? bsel : 0u, M1 = (n16 >> 2) == 1 ? bsel : 0u, M2 = (n16 >> 2) == 2 ? bsel : 0u, M3 = (n16 >> 2) == 3 ? bsel : 0u;
            const int c0 = 16 * n16 + 4 * g4;
            const unsigned loff = 8u * (unsigned)n16;
#define P6_VLOAD(buf, nn) do { const int _j = (nn) / NT6, _k = (nn) % NT6; const LAS unsigned* _ip = E32 + _k * 128 + 32 * g4; \
                const unsigned char* _tb = VB + (size_t)_j * NEXP * 128; \
                _Pragma("unroll") for (int q = 0; q < 4; ++q) { const u32x4 _o0 = *(const LAS u32x4*)(_ip + 4 * q), _o1 = *(const LAS u32x4*)(_ip + 16 + 4 * q); \
                    const unsigned _ow0[4] = {_o0.x, _o0.y, _o0.z, _o0.w}, _ow1[4] = {_o1.x, _o1.y, _o1.z, _o1.w}; \
                    _Pragma("unroll") for (int cc = 0; cc < 4; ++cc) { \
                        const u32x2 _t0 = *(const u32x2*)(_tb + (size_t)(_ow0[cc] + loff)), _t1 = *(const u32x2*)(_tb + (size_t)(_ow1[cc] + loff)); \
                        buf[4 * q + cc] = (u32x4){_t0.x, _t0.y, _t1.x, _t1.y}; } } } while (0)
#define P6_LOADR2(hb, nn) do { hb = *(const u32x2*)(HB + (size_t)TOK6((nn) % NT6) * DM + 256 * ((nn) / NT6) + c0); } while (0)
#define P6_VBODY(buf, nn, hb) do { const int j = (nn) / NT6, k = (nn) % NT6; const int t = TOK6(k); \
                const LAS unsigned* _cp = CW + k * 128 + 16 * g4; \
                const u32x4 _c0 = *(const LAS u32x4*)_cp, _c1 = *(const LAS u32x4*)(_cp + 4), _c2 = *(const LAS u32x4*)(_cp + 8), _c3 = *(const LAS u32x4*)(_cp + 12); \
                const u32x4 _d0 = *(const LAS u32x4*)(_cp + 64), _d1 = *(const LAS u32x4*)(_cp + 68), _d2 = *(const LAS u32x4*)(_cp + 72), _d3 = *(const LAS u32x4*)(_cp + 76); \
                const unsigned _cl[16] = {_c0.x, _c0.y, _c0.z, _c0.w, _c1.x, _c1.y, _c1.z, _c1.w, _c2.x, _c2.y, _c2.z, _c2.w, _c3.x, _c3.y, _c3.z, _c3.w}; \
                const unsigned _ch[16] = {_d0.x, _d0.y, _d0.z, _d0.w, _d1.x, _d1.y, _d1.z, _d1.w, _d2.x, _d2.y, _d2.z, _d2.w, _d3.x, _d3.y, _d3.z, _d3.w}; \
                f32x4 dA = (f32x4){0.f, 0.f, 0.f, 0.f}, dB = (f32x4){0.f, 0.f, 0.f, 0.f}; \
                _Pragma("unroll") for (int c = 0; c < 16; ++c) { const unsigned _l = _cl[c], _h = _ch[c]; \
                    const i32x8 av = {(int)(_l & M0), (int)(_l & M1), (int)(_l & M2), (int)(_l & M3), (int)(_h & M0), (int)(_h & M1), (int)(_h & M2), (int)(_h & M3)}; \
                    const i32x8 bv = {(int)buf[c].x, (int)buf[c].y, (int)buf[c].z, (int)buf[c].w, 0, 0, 0, 0}; \
                    if (c & 1) dB = __builtin_amdgcn_mfma_scale_f32_16x16x128_f8f6f4(av, bv, dB, 0, 4, 0, MX_ONE, 0, MX_ONE); \
                    else       dA = __builtin_amdgcn_mfma_scale_f32_16x16x128_f8f6f4(av, bv, dA, 0, 4, 0, MX_ONE, 0, MX_ONE); } \
                const float hv[4] = {bf_lo(hb.x), bf_hi(hb.x), bf_lo(hb.y), bf_hi(hb.y)}; float o[4]; float ss = 0.f; \
                _Pragma("unroll") for (int r = 0; r < 4; ++r) { o[r] = (dA[r] + dB[r]) * (1.0f / (32.0f * V4_SCALE)) + hv[r]; ss += o[r] * o[r]; } \
                *(u32x2*)(OS + (size_t)t * DM + 256 * j + c0) = (u32x2){pk2(o[0], o[1]), pk2(o[2], o[3])};     \
                ACT[k * 64 + lane] += ss; \
                } while (0)
            P6_VLOAD(bfP, 0);
#pragma unroll 1
            for (int n = 0; n < 4 * NT6; n += 2) {
                u32x2 hr0, hr1; P6_LOADR2(hr0, n); P6_LOADR2(hr1, n + 1);
                asm volatile("" ::: "memory");
                P6_VLOAD(bfQ, n + 1); asm volatile("" ::: "memory"); __builtin_amdgcn_sched_barrier(0);
                P6_VBODY(bfP, n, hr0); __builtin_amdgcn_sched_barrier(0);
                if (n + 2 < 4 * NT6) P6_VLOAD(bfP, n + 2);
                asm volatile("" ::: "memory"); __builtin_amdgcn_sched_barrier(0);
                P6_VBODY(bfQ, n + 1, hr1); __builtin_amdgcn_sched_barrier(0);
            }
            LDS_WAIT(); asm volatile("s_waitcnt vmcnt(0)" ::: "memory");
            f32x4 gfv[4];
#pragma unroll
            for (int i = 0; i < 4; ++i) gfv[i] = *(const f32x4*)(p.gfin + 256 * i + 4 * lane);
#pragma unroll 1
            for (int k = 0; k < NT6; ++k) { const float sst = wave_sum(ACT[k * 64 + lane]); const float rf = __builtin_amdgcn_rsqf(sst * (1.0f / DM) + EPS);
                float* op = p.out + (size_t)TOK6(k) * DM + 4 * lane; const bf16_t* sp = OS + (size_t)TOK6(k) * DM + 4 * lane; u32x2 ov[4];
#pragma unroll
                for (int i = 0; i < 4; ++i) ov[i] = *(const u32x2*)(sp + 256 * i);
#pragma unroll
                for (int i = 0; i < 4; ++i) *(f32x4*)(op + 256 * i) = (f32x4){bf_lo(ov[i].x), bf_hi(ov[i].x), bf_lo(ov[i].y), bf_hi(ov[i].y)} * rf * gfv[i]; }
        }
        LDS_WAIT();
    }
#undef P6_LOADH
#undef P6_LOADX
#undef P6_VLOAD
#undef P6_VBODY
#undef P6_LOADR2
#undef P6_PK64
#undef TOK6
}

#define XB_TMO      128
#define XB_XCNT(j)  (256  + 64 * (j))
#define XB_XSUB(j)  (1280 + 64 * (j))
#define XB_XGEN(j)  (2304 + 64 * (j))
#define XB_TOP      3328
#define XB_TOPGEN   3392
#define XCD_BAR_WORDS 3456
#define XB_SPIN_CAP (1u << 18)

__device__ __forceinline__ unsigned xb_ld(unsigned* p)              { return __hip_atomic_load(p, __ATOMIC_RELAXED, __HIP_MEMORY_SCOPE_AGENT); }
__device__ __forceinline__ unsigned xb_add(unsigned* p, unsigned v) { return __hip_atomic_fetch_add(p, v, __ATOMIC_RELAXED, __HIP_MEMORY_SCOPE_AGENT); }
__device__ __forceinline__ unsigned xb_xcc_id() { return (unsigned)__builtin_amdgcn_s_getreg((3 << 11) | 20) & 0xFu; }
#define XB_SPIN(cond, bar) do { unsigned _sp = 0; while (cond) { __builtin_amdgcn_s_sleep(1); \
    if ((++_sp & 255u) == 0u) { if (xb_ld(&(bar)[XB_TMO])) break; if (_sp > XB_SPIN_CAP) { atomicAdd(&(bar)[XB_TMO], 1u); break; } } } } while (0)

struct XcdBarrier {
    unsigned* bar; unsigned x;
    volatile LAS unsigned* st;
};

__device__ __forceinline__ XcdBarrier xcd_barrier_post(unsigned* bar, volatile LAS unsigned* st) {
    XcdBarrier b; b.bar = bar; b.x = xb_xcc_id(); b.st = st;
    if (threadIdx.x == 0) (void)xb_add(&bar[XB_XCNT(b.x)], 1u);
    return b;
}
__device__ __forceinline__ void xcd_barrier_complete(unsigned* bar, unsigned x, unsigned& nloc, unsigned& nx) {
    const unsigned G = gridDim.x * gridDim.y * gridDim.z;
    unsigned sum, cnt, mine, sp = 0u;
    for (;;) {
        sum = 0u; cnt = 0u; mine = 0u;
#pragma unroll
        for (unsigned j = 0; j < 16; ++j) { const unsigned c = xb_ld(&bar[XB_XCNT(j)]); sum += c; cnt += (c > 0u) ? 1u : 0u; mine = (j == x) ? c : mine; }
        if (sum == G) break;
        __builtin_amdgcn_s_sleep(1);
        if ((++sp & 255u) == 0u) { if (xb_ld(&bar[XB_TMO])) break; if (sp > XB_SPIN_CAP) { atomicAdd(&bar[XB_TMO], 1u); break; } }
    }
    nloc = mine > 0u ? mine : 1u; nx = cnt > 0u ? cnt : 1u;
}

__device__ __forceinline__ void xcd_barrier(const XcdBarrier& b) {
    asm volatile("s_waitcnt vmcnt(0)" ::: "memory");
    __syncthreads();
    if (threadIdx.x == 0) {
        unsigned* bar = b.bar;
        __builtin_amdgcn_s_waitcnt(0);
        unsigned nloc = b.st[0], nx = b.st[1];
        if (nloc == 0u) { xcd_barrier_complete(bar, b.x, nloc, nx); b.st[0] = nloc; b.st[1] = nx; }
        const unsigned old = xb_add(&bar[XB_XSUB(b.x)], 1u);
        const unsigned gen = old / nloc;
        if (old + 1u == (gen + 1u) * nloc) {
            __builtin_amdgcn_fence(__ATOMIC_RELEASE, "agent");
            asm volatile("s_waitcnt vmcnt(0)" ::: "memory");
            const unsigned og = xb_add(&bar[XB_TOP], 1u);
            const unsigned tg = og / nx;
            if (og + 1u == (tg + 1u) * nx) xb_add(&bar[XB_TOPGEN], 1u);
            else XB_SPIN(xb_ld(&bar[XB_TOPGEN]) == tg, bar);
            __builtin_amdgcn_fence(__ATOMIC_ACQUIRE, "agent");
            xb_add(&bar[XB_XGEN(b.x)], 1u);
            asm volatile("s_waitcnt vmcnt(0)" ::: "memory");
        } else {
            XB_SPIN(xb_ld(&bar[XB_XGEN(b.x)]) == gen, bar);
            __builtin_amdgcn_fence(__ATOMIC_ACQUIRE, "agent");
            asm volatile("s_waitcnt vmcnt(0)" ::: "memory");
        }
    }
    __syncthreads();
}

__global__ void __launch_bounds__(512, 2) mk_fwd(Params p) {
    extern __shared__ __attribute__((aligned(16))) unsigned char lds_raw[];
    LAS unsigned char* lds = (LAS unsigned char*)lds_raw;
    const int bid = blockIdx.x, nb = gridDim.x;
    unsigned char* ws = p.ws;
#define IN(k) (p.ph_lo <= (k) && (k) < p.ph_hi)
#define SEAM(k) do { if (IN(k) && IN((k) + 1)) { xcd_barrier(bar); } } while (0)
    if (threadIdx.x < 4) ((volatile LAS unsigned*)(lds + LDS_BYTES - 16))[threadIdx.x] = 0u;
    __syncthreads();
    const XcdBarrier bar = xcd_barrier_post((unsigned*)(ws + WS_CTL) + 4096, (volatile LAS unsigned*)(lds + LDS_BYTES - 16));
    if (IN(0)) phase0(p, lds, bid, nb);
    SEAM(0);
    if (IN(1)) {
        pg8::Gemm g{(const bf16_t*)(ws + WS_XN), (const bf16_t*)(ws + WS_WIN), MROWS, NP1, DM}; pg8::StaticOrder S; S.init(MROWS, NP1, nb, bid);
        EpiProj E{(bf16_t*)(ws + WS_PROJ), (bf16_t*)(ws + WS_QK), (_Float16*)(ws + WS_LA), p.gb, (const float2*)(ws + WS_ROPE)};
        pg8::gemm_phase<EpiProj, pg8::StaticOrder, true, true>(lds, g, S, E);
    }
    SEAM(1);
    if (IN(2)) attn_pass<false>(p, lds, bid, nb);
    SEAM(2);
    if (IN(3)) attn_pass<true>(p, lds, bid, nb);
    SEAM(3);
    if (IN(4)) {
        pg8::Gemm g{(const bf16_t*)(ws + WS_O), (const bf16_t*)(ws + WS_WOUT), NTOK, DM, DM}; pg8::StaticOrder S; S.init(NTOK, DM, nb, bid);
        EpiRes E{(bf16_t*)(ws + WS_HB), (float*)(ws + WS_SSQ), (const float*)(ws + WS_RINV), (const float*)(ws + WS_GINV)};
        pg8::gemm_phase<EpiRes, pg8::StaticOrder, true, true>(lds, g, S, E);
    }
    SEAM(4);
    if (IN(5)) {
        pg8::Gemm g{(const bf16_t*)(ws + WS_HB), (const bf16_t*)(ws + WS_WS), NTOK, 2048, DM}; pg8::StaticOrder S; S.init(NTOK, 2048, nb, bid);
        EpiF16 E{(_Float16*)(ws + WS_PROJ)};
        pg8::gemm_phase<EpiF16, pg8::StaticOrder, true, true>(lds, g, S, E);
    }
    SEAM(5);
    if (IN(6)) phase_peer2(p, lds, bid, nb);
#undef IN
#undef SEAM
}

#ifndef MK_FUSED
#define MK_FUSED 1
#endif
extern "C" void kernel_launch(void* const* d_in, const int* in_sizes, int n_in, void* d_out, int out_size, void* d_ws, size_t ws_size, hipStream_t stream) {
    static int grid = 0;
    if (grid == 0) {
        if (n_in != 16 || in_sizes[0] != NTOK * DM || out_size != NTOK * DM || ws_size < WS_END) {
            fprintf(stderr, "kernel_launch: unexpected shapes (n_in %d, in0 %d, out %d, ws %zu); nothing launched\n", n_in, n_in > 0 ? in_sizes[0] : -1, out_size, ws_size); grid = -1; return; }
        int dev = 0, cus = 0, per_cu = 0;
        hipGetDevice(&dev); hipDeviceGetAttribute(&cus, hipDeviceAttributeMultiprocessorCount, dev);
        if (hipFuncSetAttribute((const void*)mk_fwd, hipFuncAttributeMaxDynamicSharedMemorySize, LDS_BYTES) != hipSuccess) { fprintf(stderr, "kernel_launch: hipFuncSetAttribute failed\n"); grid = -1; return; }
        if (hipOccupancyMaxActiveBlocksPerMultiprocessor(&per_cu, (const void*)mk_fwd, 512, LDS_BYTES) != hipSuccess || per_cu < 1) { fprintf(stderr, "kernel_launch: occupancy query failed (%d)\n", per_cu); (void)hipGetLastError(); per_cu = 1; }
        grid = cus * (per_cu < 1 ? 1 : 1);
        fprintf(stderr, "kernel_launch: %d CUs, occupancy %d/CU, grid %d\n", cus, per_cu, grid);
    }
    if (grid < 0) return;
    (void)hipMemsetAsync((char*)d_ws + WS_CTL, 0, 65536, stream);
    Params p{};
    p.x = (const float*)d_in[0]; p.meta = (const float*)d_in[1]; p.g1 = (const float*)d_in[2]; p.w_in = (const float*)d_in[3]; p.gw2 = (const float*)d_in[4]; p.gb = (const float*)d_in[5];
    p.gla_gain = (const float*)d_in[6]; p.ret_gain = (const float*)d_in[7]; p.ret_bias = (const float*)d_in[8]; p.w_out = (const float*)d_in[9]; p.g2 = (const float*)d_in[10];
    p.w_q = (const float*)d_in[11]; p.subkeys = (const float*)d_in[12]; p.pu = (const float*)d_in[13]; p.pv = (const float*)d_in[14]; p.gfin = (const float*)d_in[15];
    p.out = (float*)d_out; p.ws = (unsigned char*)d_ws;
#if MK_FUSED
    p.ph_lo = 0; p.ph_hi = NPHASE;
    void* args[] = {&p};
    hipError_t e = hipLaunchCooperativeKernel((const void*)mk_fwd, dim3(grid), dim3(512), args, LDS_BYTES, stream);
    if (e != hipSuccess) fprintf(stderr, "kernel_launch: cooperative launch failed: %s (grid %d)\n", hipGetErrorString(e), grid);
#else
    { const int order[7] = {0, 1, 2, 3, 4, 5, 6}; for (int i = 0; i < 7; ++i) { p.ph_lo = order[i]; p.ph_hi = order[i] + 1; hipLaunchKernelGGL(mk_fwd, dim3(grid), dim3(512), LDS_BYTES, stream, p); } }
#endif
}
```

```cpp
#include <hip/hip_runtime.h>
#include <hip/hip_cooperative_groups.h>
#include <cstdio>
#include <cstdint>
namespace cg = cooperative_groups;
namespace pg8 {
#define PG8_LAS __attribute__((address_space(3)))
typedef unsigned short bf16_t;
typedef short bf16x8 __attribute__((ext_vector_type(8)));
typedef float f32x4 __attribute__((ext_vector_type(4)));
typedef unsigned u32x4 __attribute__((ext_vector_type(4)));
constexpr int BM = 256, BK = 64, HALF = 128, HTB = HALF * BK * 2  , STAGE_BYTES = 8 * HTB, NXCD = 8, WGM = 8;

__host__ __device__ __forceinline__ int lds_byte(int r, int c) { const int st = (r >> 4) * 2 + (c >> 5), rr = r & 15, cc = c & 31, ob = rr * 64 + cc * 2; return st * 1024 + (ob ^ (((ob >> 9) & 1) << 5)); }
__host__ __device__ __forceinline__ void stage_rc(int b, int& R, int& C) { const int st = b / 1024, sb = b % 1024, swz = sb ^ (((sb >> 9) & 1) << 5); R = (st >> 1) * 16 + swz / 64; C = (st & 1) * 32 + (swz % 64) / 2; }
__host__ __device__ __forceinline__ int perm32(int rho) { const int n = rho >> 4, i = rho & 15; return 8 * (i >> 2) + 4 * n + (i & 3); }

struct Unit { int pm, pn; };
struct Gemm { const bf16_t* A; const bf16_t* Bt; int M, N, K; };

struct StaticOrder {
    int nM, nN, nwg, G, c;
    __host__ __device__ void init(int M, int N, int G_, int c_) { nM = M / BM; nN = N / BM; nwg = nM * nN; G = G_; c = c_; }
    __host__ __device__ bool next(int i, Unit& u) const {
        const long L = (long)i * G + c; if (L >= nwg) return false;
        int wgid = (int)L; { const int q = nwg / NXCD, r = nwg % NXCD, xcd = wgid % NXCD, off = wgid / NXCD; wgid = (xcd < r ? xcd * (q + 1) : r * (q + 1) + (xcd - r) * q) + off; }
        const int nig = WGM * nN, gid = wgid / nig, fm = gid * WGM, gsz = (nM - fm) < WGM ? (nM - fm) : WGM;
        u.pm = fm + ((wgid % nig) % gsz); u.pn = (wgid % nig) / gsz; return true;
    }
    __device__ __forceinline__ void a_ready(const Unit&) const {}
    __device__ __forceinline__ void done(const Unit&) const {}
};

__device__ __forceinline__ unsigned cvt_pk_bf16(float lo, float hi) { unsigned r; asm volatile("v_cvt_pk_bf16_f32 %0, %1, %2" : "=v"(r) : "v"(lo), "v"(hi)); return r; }
typedef float f32x2 __attribute__((ext_vector_type(2)));
template <class Epi, class Sched, bool ALIGN_EPI = false, bool SP2 = false>
__device__ __forceinline__ void gemm_phase(PG8_LAS unsigned char* lds, const Gemm g, const Sched& S, const Epi& E) {
    const int tid = threadIdx.x, wid = __builtin_amdgcn_readfirstlane(tid >> 6), lane = tid & 63, wr = wid >> 2, wc = wid & 3, fr = lane & 15, fq = lane >> 4;
    const int K = g.K, nt = K / BK;
    unsigned voffA[2], voffB[2];
#pragma unroll
    for (int i = 0; i < 2; ++i) { int R, C; stage_rc(tid * 16 + i * 8192, R, C); const int Rb = Epi::PERM ? ((R & ~31) + perm32(R & 31)) : R;
        voffA[i] = (unsigned)(R * K + C) * 2u; voffB[i] = (unsigned)(Rb * K + C) * 2u; }
    const size_t kstep = (size_t)(BK * 2);
    const size_t hstep = (size_t)HALF * K * 2;
    const size_t tstep = 2 * hstep;
    const unsigned ldsw = (unsigned)wid * 1024u;
    const int aoff = lds_byte(wr * 64 + fr, fq * 8), boff = lds_byte(wc * 32 + fr, fq * 8);
#define PG8_SA(b, h) (((b) * 2 + (h)) * HTB)
#define PG8_SB(b, h) ((4 + (b) * 2 + (h)) * HTB)
#define PG8_STAGE(bufoff, gbase, voff) do { _Pragma("unroll") for (int _i = 0; _i < 2; ++_i) \
        __builtin_amdgcn_global_load_lds((const unsigned*)((const char*)(gbase) + (voff)[_i]), (PG8_LAS unsigned*)(lds + (bufoff) + ldsw + _i * 8192), 16, 0, 0); } while (0)
#define PG8_LDA(dst, b, h) do { _Pragma("unroll") for (int m = 0; m < 4; ++m) _Pragma("unroll") for (int k = 0; k < 2; ++k) dst[m][k] = *(const PG8_LAS bf16x8*)(lds + PG8_SA(b, h) + aoff + m * 2048 + k * 1024); } while (0)
#define PG8_LDB(dst, b, h) do { _Pragma("unroll") for (int n = 0; n < 2; ++n) _Pragma("unroll") for (int k = 0; k < 2; ++k) dst[n][k] = *(const PG8_LAS bf16x8*)(lds + PG8_SB(b, h) + boff + n * 2048 + k * 1024); } while (0)
#define PG8_MMA(ai, bj, At, Bt) do { __builtin_amdgcn_s_setprio(1); _Pragma("unroll") for (int m = 0; m < 4; ++m) _Pragma("unroll") for (int n = 0; n < 2; ++n) _Pragma("unroll") for (int k = 0; k < 2; ++k) \
        acc[ai][bj][m][n] = __builtin_amdgcn_mfma_f32_16x16x32_bf16(Bt[n][k], At[m][k], acc[ai][bj][m][n], 0, 0, 0); __builtin_amdgcn_s_setprio(0); } while (0)
#define PG8_WAIT_V(n) asm volatile("s_waitcnt vmcnt(" #n ")" ::: "memory")
#define PG8_WAIT_L(n) asm volatile("s_waitcnt lgkmcnt(" #n ")" ::: "memory")
#define PG8_BAR __builtin_amdgcn_s_barrier()
#define PG8_SCHED __builtin_amdgcn_sched_barrier(0)
    Unit cur, nxt; int ui = 0;
    if (!S.next(0, cur)) return;
    f32x4 acc[2][2][4][2];
#pragma unroll
    for (int a = 0; a < 2; ++a)
#pragma unroll
        for (int b = 0; b < 2; ++b)
#pragma unroll
            for (int m = 0; m < 4; ++m)
#pragma unroll
                for (int n = 0; n < 2; ++n) acc[a][b][m][n] = (f32x4){0.f, 0.f, 0.f, 0.f};
    bf16x8 At[4][2], B0[2][2], B1[2][2];
    const char* cA = (const char*)g.A + (size_t)cur.pm * tstep; const char* cB = (const char*)g.Bt + (size_t)cur.pn * tstep;
    S.a_ready(cur);
    if constexpr (SP2) {
        PG8_STAGE(PG8_SB(0, 0), cB, voffB); PG8_STAGE(PG8_SB(0, 1), cB + hstep, voffB); PG8_STAGE(PG8_SA(0, 0), cA, voffA); PG8_STAGE(PG8_SA(0, 1), cA + hstep, voffA);
        if (wr == 1) PG8_BAR;
        PG8_WAIT_V(2); PG8_BAR;
        PG8_STAGE(PG8_SB(1, 0), cB + kstep, voffB); PG8_STAGE(PG8_SA(1, 0), cA + kstep, voffA); PG8_STAGE(PG8_SB(1, 1), cB + hstep + kstep, voffB);
        PG8_WAIT_V(6); PG8_BAR;
    } else {
        PG8_STAGE(PG8_SB(0, 0), cB, voffB); PG8_STAGE(PG8_SA(0, 0), cA, voffA); PG8_STAGE(PG8_SB(0, 1), cB + hstep, voffB); PG8_STAGE(PG8_SA(0, 1), cA + hstep, voffA);
        if (wr == 1) PG8_BAR;
        PG8_WAIT_V(4); PG8_BAR;
        PG8_STAGE(PG8_SB(1, 0), cB + kstep, voffB); PG8_STAGE(PG8_SA(1, 0), cA + kstep, voffA); PG8_STAGE(PG8_SB(1, 1), cB + hstep + kstep, voffB);
        PG8_WAIT_V(6); PG8_BAR;
    }
    for (;;) {
        const bool has_next = S.next(ui + 1, nxt);
        const char* nA = has_next ? (const char*)g.A + (size_t)nxt.pm * tstep : cA; const char* nB = has_next ? (const char*)g.Bt + (size_t)nxt.pn * tstep : cB;
        for (int t = 0; t < nt; t += 2) {
            const bool last = (t == nt - 2);
            const char* a1 = cA + (size_t)(t + 1) * kstep;
            const char* a2 = last ? nA : cA + (size_t)(t + 2) * kstep; const char* b2 = last ? nB : cB + (size_t)(t + 2) * kstep;
            const char* a3 = a2 + kstep; const char* b3 = b2 + kstep;
            if (last && has_next) S.a_ready(nxt);
            if constexpr (SP2) {
            PG8_LDB(B0, 0, 0); PG8_LDB(B1, 0, 1); PG8_SCHED; PG8_LDA(At, 0, 0); PG8_STAGE(PG8_SA(1, 1), a1 + hstep, voffA);
            PG8_WAIT_V(8); PG8_WAIT_L(0); PG8_BAR; PG8_MMA(0, 0, At, B0); PG8_MMA(0, 1, At, B1); PG8_BAR; PG8_SCHED;
            PG8_LDA(At, 0, 1); PG8_STAGE(PG8_SB(0, 0), b2, voffB); PG8_STAGE(PG8_SB(0, 1), b2 + hstep, voffB); PG8_STAGE(PG8_SA(0, 0), a2, voffA);
            PG8_WAIT_V(8); PG8_WAIT_L(0); PG8_BAR; PG8_MMA(1, 0, At, B0); PG8_MMA(1, 1, At, B1); PG8_BAR; PG8_SCHED;
            PG8_LDB(B0, 1, 0); PG8_LDB(B1, 1, 1); PG8_SCHED; PG8_LDA(At, 1, 0); PG8_STAGE(PG8_SA(0, 1), a2 + hstep, voffA);
            PG8_WAIT_V(8); PG8_WAIT_L(0); PG8_BAR; PG8_MMA(0, 0, At, B0); PG8_MMA(0, 1, At, B1); PG8_BAR; PG8_SCHED;
            PG8_LDA(At, 1, 1); PG8_STAGE(PG8_SB(1, 0), b3, voffB); PG8_STAGE(PG8_SB(1, 1), b3 + hstep, voffB); PG8_STAGE(PG8_SA(1, 0), a3, voffA);
            PG8_WAIT_V(8); PG8_WAIT_L(0); PG8_BAR; PG8_MMA(1, 0, At, B0); PG8_MMA(1, 1, At, B1); PG8_BAR; PG8_SCHED;
            } else {
            PG8_LDB(B0, 0, 0); PG8_SCHED; PG8_LDA(At, 0, 0); PG8_STAGE(PG8_SA(1, 1), a1 + hstep, voffA);
            PG8_WAIT_L(8); PG8_BAR; PG8_WAIT_L(0); PG8_MMA(0, 0, At, B0); PG8_BAR; PG8_SCHED;
            PG8_LDB(B1, 0, 1); PG8_STAGE(PG8_SB(0, 0), b2, voffB);
            PG8_BAR; PG8_WAIT_L(0); PG8_MMA(0, 1, At, B1); PG8_BAR;
            PG8_LDA(At, 0, 1); PG8_STAGE(PG8_SA(0, 0), a2, voffA);
            PG8_BAR; PG8_WAIT_L(0); PG8_MMA(1, 0, At, B0); PG8_BAR; PG8_SCHED;
            PG8_STAGE(PG8_SB(0, 1), b2 + hstep, voffB);
            PG8_WAIT_V(6); PG8_BAR; PG8_MMA(1, 1, At, B1); PG8_BAR;
            PG8_LDB(B0, 1, 0); PG8_SCHED; PG8_LDA(At, 1, 0); PG8_STAGE(PG8_SA(0, 1), a2 + hstep, voffA);
            PG8_WAIT_L(8); PG8_BAR; PG8_WAIT_L(0); PG8_MMA(0, 0, At, B0); PG8_BAR; PG8_SCHED;
            PG8_LDB(B1, 1, 1); PG8_STAGE(PG8_SB(1, 0), b3, voffB);
            PG8_BAR; PG8_WAIT_L(0); PG8_MMA(0, 1, At, B1); PG8_BAR;
            PG8_LDA(At, 1, 1); PG8_STAGE(PG8_SA(1, 0), a3, voffA);
            PG8_BAR; PG8_WAIT_L(0); PG8_MMA(1, 0, At, B0); PG8_BAR; PG8_SCHED;
            PG8_STAGE(PG8_SB(1, 1), b3 + hstep, voffB);
            PG8_WAIT_V(6); PG8_BAR; PG8_MMA(1, 1, At, B1); PG8_BAR;
            }
        }
        if constexpr (ALIGN_EPI) { if (wr == 0) PG8_BAR; }
        if constexpr (!Epi::AFTER_DRAIN) { E(acc, cur, wr, wc, fr, fq); S.done(cur); }
        if (!has_next) break;
#pragma unroll
        for (int a = 0; a < 2; ++a)
#pragma unroll
            for (int b = 0; b < 2; ++b)
#pragma unroll
                for (int m = 0; m < 4; ++m)
#pragma unroll
                    for (int n = 0; n < 2; ++n) acc[a][b][m][n] = (f32x4){0.f, 0.f, 0.f, 0.f};
        cur = nxt; cA = nA; cB = nB; ++ui;
        if constexpr (ALIGN_EPI) { if (wr == 1) PG8_BAR; }
    }
    PG8_WAIT_V(0);
    if constexpr (!ALIGN_EPI) { if (wr == 0) PG8_BAR; }
    PG8_BAR;
    if constexpr (Epi::AFTER_DRAIN) { E.fused(acc, cur, wr, wc, fr, fq, lds, wid, lane); S.done(cur); }
#undef PG8_SA
#undef PG8_SB
#undef PG8_STAGE
#undef PG8_LDA
#undef PG8_LDB
#undef PG8_MMA
#undef PG8_WAIT_V
#undef PG8_WAIT_L
#undef PG8_BAR
#undef PG8_SCHED
}
}

#define LAS __attribute__((address_space(3)))
typedef unsigned short bf16_t;
typedef float f32x4 __attribute__((ext_vector_type(4)));
typedef unsigned u32x4 __attribute__((ext_vector_type(4)));
typedef unsigned u32x2 __attribute__((ext_vector_type(2)));
typedef int i32x8 __attribute__((ext_vector_type(8)));
typedef short s16x2 __attribute__((ext_vector_type(2)));
#define MX_ONE 0x7f7f7f7f
#define V4_SCALE 5.656854f
typedef short bf16x8 __attribute__((ext_vector_type(8)));
typedef short s16x4 __attribute__((ext_vector_type(4)));
typedef __bf16 bf16x2_t __attribute__((ext_vector_type(2)));
typedef _Float16 f16x2_t __attribute__((ext_vector_type(2)));
typedef float f32x2v __attribute__((ext_vector_type(2)));
typedef _Float16 h2v __attribute__((ext_vector_type(2)));

constexpr int DM = 1024, NB = 4, SEQ = 8192, NTOK = NB * SEQ;
constexpr int MROWS = NTOK + 256;
constexpr int INW = 3088;
constexpr int NPROJ = 3072, NP1 = 3328;
constexpr int NEXP = 16384;
constexpr float EPS = 1e-6f;
constexpr int C_GQ = 0, C_GK = 256, C_GV = 512, C_GG = 1024, C_RQ = 1536, C_RK = 1792, C_RV = 2048, C_RG = 2560;
constexpr int S_GA = 1536, S_RQ = 1552, S_RV = 2064;

constexpr int NVG = 2048;
constexpr int NCH = (NTOK + 256) / 64;
constexpr size_t QK_ARR = (size_t)NCH * 4 * 8 * 64 * 8;
constexpr size_t MiB = 1u << 20;
constexpr size_t WS_CTL = 0, WS_WIN = 1 * MiB, WS_WOUT = 8 * MiB, WS_WS = 10 * MiB, WS_ROPE = 14 * MiB, WS_SSQ = 17 * MiB, WS_SEG = 19 * MiB, WS_ASEG = 27 * MiB,
                 WS_UB = 28 * MiB, WS_VB = 60 * MiB, WS_XN = 92 * MiB, WS_O = 157 * MiB, WS_LA = 221 * MiB, WS_PROJ = 254 * MiB, WS_QK = 383 * MiB, WS_XQ = 448 * MiB, WS_END = 480 * MiB;
static_assert(WS_WIN + (size_t)NP1 * DM * 2 <= WS_WOUT && WS_ROPE + (size_t)(SEQ + 64) * 32 * 8 <= WS_SSQ && WS_XN + (size_t)MROWS * DM * 2 <= WS_O &&
              WS_LA + QK_ARR * 4 <= WS_PROJ && WS_PROJ + (size_t)MROWS * NVG * 2 <= WS_QK && WS_QK + 4 * QK_ARR * 2 <= WS_XQ && WS_PROJ + (size_t)NTOK * 2048 * 2 <= WS_QK, "ws map");

constexpr size_t WS_HB = WS_XN + (size_t)256 * DM * 2;
constexpr size_t WS_RINV = WS_CTL + 131072, WS_GINV = WS_CTL + 262144;
constexpr int LDS_BYTES = 147456;
constexpr int NPHASE = 7;
#ifndef PROBE_R
#define PROBE_R 1
#define PROBE_U 1
#define PROBE_V 1
#endif
#ifndef PEER_FP8
#define PEER_FP8 1
#endif

struct Params {
    const float *x, *meta, *g1, *w_in, *gw2, *gb, *gla_gain, *ret_gain, *ret_bias, *w_out, *g2, *w_q, *subkeys, *pu, *pv, *gfin;
    float* out; unsigned char* ws;
    int ph_lo, ph_hi;
};

#define LDS_WAIT() asm volatile("s_waitcnt lgkmcnt(0)" ::: "memory")
__device__ __forceinline__ unsigned pk2(float lo, float hi) { const bf16x2_t v = {(__bf16)lo, (__bf16)hi}; return __builtin_bit_cast(unsigned, v); }
__device__ __forceinline__ unsigned f2bf(float f) { return (unsigned)__builtin_bit_cast(unsigned short, (__bf16)f); }

__device__ __forceinline__ float bf_lo(unsigned w) { return __builtin_bit_cast(float, w << 16); }
__device__ __forceinline__ float bf_hi(unsigned w) { return __builtin_bit_cast(float, w & 0xffff0000u); }
__device__ __forceinline__ float bf1(bf16_t h) { return __builtin_bit_cast(float, (unsigned)h << 16); }
__device__ __forceinline__ float wave_sum(float v) {
#pragma unroll
    for (int o = 1; o < 64; o <<= 1) v += __shfl_xor(v, o);
    return v;
}

struct MapIn {
    __device__ __forceinline__ void operator()(int j, int& src, float& sc) const {
        if (j < C_RQ) { src = j; sc = (j < 256) ? 0.125f : 1.0f; }
        else if (j < C_RV) { const int jj = j - C_RQ, which = jj >> 8, within = jj & 255, head = within >> 6, p = within & 63;
            const int a = p >> 3, n = (p >> 2) & 1, i = p & 3; src = S_RQ + which * 256 + head * 64 + 32 * n + 4 * a + i; sc = which ? 0.125f : 1.0f; }
        else { src = S_RV + (j - C_RV); sc = 1.0f; }
    }
};
struct MapId { __device__ __forceinline__ void operator()(int j, int& src, float& sc) const { src = j; sc = 1.0f; } };

template <class Map>
__device__ __forceinline__ void transpose_item(const float* W, int K, int N, bf16_t* WT, LAS float* scr, int item, int nblk, int lane, const Map map) {
    const int kb = item / nblk, nb = item % nblk, k0 = 64 * kb, n0 = 32 * nb;
    int src; float sc; map(n0 + (lane & 31), src, sc);
#pragma unroll 8
    for (int i = 0; i < 32; ++i) { const int kk = 2 * i + (lane >> 5); scr[kk * 33 + (lane & 31)] = W[(size_t)(k0 + kk) * N + src] * sc; }
    LDS_WAIT();
    const int c = lane & 7;
#pragma unroll
    for (int j = 0; j < 4; ++j) { const int n = (lane >> 3) + 8 * j; const LAS float* s = scr + (8 * c) * 33 + n;
        u32x4 o; o.x = pk2(s[0 * 33], s[1 * 33]); o.y = pk2(s[2 * 33], s[3 * 33]); o.z = pk2(s[4 * 33], s[5 * 33]); o.w = pk2(s[6 * 33], s[7 * 33]);
        *(u32x4*)(WT + (size_t)(n0 + n) * K + k0 + 8 * c) = o; }
    LDS_WAIT();
}

__device__ __forceinline__ void phase0(const Params& p, LAS unsigned char* lds, int bid, int nb) {
    const int tid = threadIdx.x, lane = tid & 63, wave = __builtin_amdgcn_readfirstlane(tid >> 6);
    unsigned char* ws = p.ws;
    bf16_t* XN = (bf16_t*)(ws + WS_XN); bf16_t* WinT = (bf16_t*)(ws + WS_WIN); bf16_t* WoutT = (bf16_t*)(ws + WS_WOUT); bf16_t* WsT = (bf16_t*)(ws + WS_WS);
    const int gw = bid * 8 + wave, NGW = nb * 8;
    const int gt = bid * 512 + tid, NGT = nb * 512;

#pragma unroll 1
    for (int ti = 0; ti < 4; ++ti) { const int task = (bid & 1) ? 3 - ti : ti;
    if (task == 0) {
    {
        LAS float* SKT = (LAS float*)lds;
        LAS float* WQT = (LAS float*)(lds + 128 * 132 * 4);
        for (int item = bid; item < 256; item += nb) {
            const int hc = item >> 4, kb = item & 15;
            __syncthreads();
            for (int e = tid; e < 128 * 128; e += 512) { const int n = e >> 7, d = e & 127; SKT[d * 132 + n] = p.subkeys[(size_t)hc * 16384 + e]; }
            for (int e = tid; e < 64 * 128; e += 512) { const int k = e >> 7, d = e & 127; WQT[d * 68 + k] = p.w_q[(size_t)(kb * 64 + k) * 2048 + hc * 128 + d]; }
            __syncthreads();
            const int tn = tid & 31, tk = tid >> 5;
            f32x4 acc[4];
#pragma unroll
            for (int i = 0; i < 4; ++i) acc[i] = (f32x4){0.f, 0.f, 0.f, 0.f};
#pragma unroll 4
            for (int d = 0; d < 128; ++d) {
                const f32x4 sk = *(const LAS f32x4*)(SKT + d * 132 + 4 * tn); const f32x4 wq = *(const LAS f32x4*)(WQT + d * 68 + 4 * tk);
#pragma unroll
                for (int i = 0; i < 4; ++i) acc[i] += sk[i] * wq;
            }
            const f32x4 gg = *(const f32x4*)(p.g2 + kb * 64 + 4 * tk);
#pragma unroll
            for (int i = 0; i < 4; ++i) { const f32x4 v = acc[i] * gg; u32x2 o; o.x = pk2(v[0], v[1]); o.y = pk2(v[2], v[3]);
                *(u32x2*)(WsT + (size_t)(hc * 128 + 4 * tn + i) * DM + kb * 64 + 4 * tk) = o; }
        }
        __syncthreads();
    }
    {
        LAS float* scr = (LAS float*)(lds + wave * 16384);
        constexpr int I_IN = (DM / 64) * (NPROJ / 32), I_OUT = (DM / 64) * (DM / 32);
        for (int it = gw; it < I_IN + I_OUT; it += NGW) {
            if (it < I_IN) transpose_item(p.w_in, DM, INW, WinT, scr, it, NPROJ / 32, lane, MapIn());
            else transpose_item(p.w_out, DM, DM, WoutT, scr, it - I_IN, DM / 32, lane, MapId());
        }
    }
    for (int e = gt; e < 256 * DM; e += NGT) {
        const int n = e >> 10, k = e & 1023; const float* wr = p.w_in + (size_t)k * INW + S_GA; float s = 0.f;
#pragma unroll
        for (int r = 0; r < 16; ++r) s += wr[r] * p.gw2[r * 256 + n];
        WinT[(size_t)(NPROJ + n) * DM + k] = (bf16_t)f2bf(s);
    }
    } else if (task == 1) {
#if PEER_FP8
    {
        u32x4* U4 = (u32x4*)(ws + WS_UB); u32x4* V4 = (u32x4*)(ws + WS_VB);
        for (int e = gt; e < NEXP * DM / 32; e += NGT) {
            const f32x4* us = (const f32x4*)p.pu + 8 * (size_t)e; const f32x4* vs = (const f32x4*)p.pv + 8 * (size_t)e;
            const f32x4* g2s = (const f32x4*)p.g2 + 8 * (e & 31);
            unsigned tu[4], tv[4];
#pragma unroll
            for (int j = 0; j < 4; ++j) { const f32x4 a0 = us[2 * j] * g2s[2 * j] * 64.0f, a1 = us[2 * j + 1] * g2s[2 * j + 1] * 64.0f;
                const f32x4 b0 = vs[2 * j] * V4_SCALE, b1 = vs[2 * j + 1] * V4_SCALE;
                unsigned w = 0u, x = 0u;
                w = __builtin_amdgcn_cvt_scalef32_pk_fp4_f32(w, a0[0], a0[1], 1.0f, 0); w = __builtin_amdgcn_cvt_scalef32_pk_fp4_f32(w, a0[2], a0[3], 1.0f, 1);
                w = __builtin_amdgcn_cvt_scalef32_pk_fp4_f32(w, a1[0], a1[1], 1.0f, 2); w = __builtin_amdgcn_cvt_scalef32_pk_fp4_f32(w, a1[2], a1[3], 1.0f, 3); tu[j] = w;
                x = __builtin_amdgcn_cvt_scalef32_pk_fp4_f32(x, b0[0], b0[1], 1.0f, 0); x = __builtin_amdgcn_cvt_scalef32_pk_fp4_f32(x, b0[2], b0[3], 1.0f, 1);
                x = __builtin_amdgcn_cvt_scalef32_pk_fp4_f32(x, b1[0], b1[1], 1.0f, 2); x = __builtin_amdgcn_cvt_scalef32_pk_fp4_f32(x, b1[2], b1[3], 1.0f, 3); tv[j] = x; }
            const int row = e >> 5, c32 = e & 31;
            const size_t dst = ((size_t)(c32 >> 3) * NEXP + row) * 8 + (c32 & 7);
            U4[dst] = (u32x4){tu[0], tu[1], tu[2], tu[3]}; V4[dst] = (u32x4){tv[0], tv[1], tv[2], tv[3]}; }
    }
#else
    {
        u32x2* UB = (u32x2*)(ws + WS_UB); u32x2* VB = (u32x2*)(ws + WS_VB);
        const f32x4* u4 = (const f32x4*)p.pu; const f32x4* v4 = (const f32x4*)p.pv;
        for (int e = gt; e < NEXP * DM / 4; e += NGT) { const f32x4 a = u4[e]; u32x2 o; o.x = pk2(a[0], a[1]); o.y = pk2(a[2], a[3]); UB[e] = o;
            const f32x4 b = v4[e]; u32x2 q; q.x = pk2(b[0], b[1]); q.y = pk2(b[2], b[3]); VB[e] = q; }
    }
#endif
    } else if (task == 2) {
    if (gt < DM) ((float*)(ws + WS_GINV))[gt] = 1.0f / p.g1[gt];
    {
        float2* rope = (float2*)(ws + WS_ROPE);
        for (int e = gt; e < (SEQ + 64) * 32; e += NGT) { const int pi = e >> 5, d = e & 31;
            const float invf = (float)pow(10000.0, -(double)d / 32.0); const float ang = (float)(pi - 48) * invf;
            rope[e] = make_float2((float)cos((double)ang), (float)sin((double)ang)); }
    }
    } else {
    for (int m0 = gw; m0 < MROWS; m0 += 4 * NGW) {
        const float* srcp[4]; f32x4 v[4][4];
#pragma unroll
        for (int u = 0; u < 4; ++u) { const int m = m0 + u * NGW; srcp[u] = nullptr;
            if (m < MROWS) { if (m >= 256) srcp[u] = p.x + (size_t)(m - 256) * DM; else if (m >= 48 && m < 64) srcp[u] = p.meta + (size_t)(m - 48) * DM; }
            if (srcp[u] != nullptr) { const f32x4* xr = (const f32x4*)srcp[u] + lane;
#pragma unroll
                for (int j = 0; j < 4; ++j) v[u][j] = xr[64 * j]; }
            else {
#pragma unroll
                for (int j = 0; j < 4; ++j) v[u][j] = (f32x4){0.f, 0.f, 0.f, 0.f}; } }
        f32x4 gg[4];
#pragma unroll
        for (int j = 0; j < 4; ++j) gg[j] = ((const f32x4*)p.g1 + lane)[64 * j];
#pragma unroll
        for (int u = 0; u < 4; ++u) { const int m = m0 + u * NGW; if (m >= MROWS) continue;
            float s = 0.f;
#pragma unroll
            for (int j = 0; j < 4; ++j) s += (v[u][j].x * v[u][j].x + v[u][j].y * v[u][j].y) + (v[u][j].z * v[u][j].z + v[u][j].w * v[u][j].w);
            const float r = (srcp[u] != nullptr) ? __builtin_amdgcn_rsqf(wave_sum(s) * (1.0f / DM) + EPS) : 0.f;
            if (lane == 0 && m >= 256) ((float*)(ws + WS_RINV))[m - 256] = 1.0f / r;
            unsigned long long* o8 = (unsigned long long*)(XN + (size_t)m * DM) + lane;
#pragma unroll
            for (int j = 0; j < 4; ++j) { const f32x4 y = v[u][j] * r * gg[j]; o8[64 * j] = (unsigned long long)pk2(y.x, y.y) | ((unsigned long long)pk2(y.z, y.w) << 32); } }
    }
    } }
}

struct EpiProj {
    static constexpr bool PERM = true, AFTER_DRAIN = false;
    bf16_t* VG; bf16_t* QK; _Float16* LAT; const float* gb; const float2* rope;
    __device__ __forceinline__ static size_t tile_off(int r, int head, int dg) { return ((((size_t)(r >> 6) * 4 + head) * 8 + dg) * 64 + (r & 63)) * 8; }
    __device__ __forceinline__ void operator()(const pg8::f32x4 (&acc)[2][2][4][2], const pg8::Unit& u, int wr, int wc, int fr, int fq) const {
        const int row0 = u.pm * 256 + wr * 64 + fr, cb0 = wc * 32 + 8 * fq;
        if (u.pn == 12) {
#pragma unroll
            for (int bj = 0; bj < 2; ++bj) { const int c = cb0 + 128 * bj; const f32x4 b0 = *(const f32x4*)(gb + c), b1 = *(const f32x4*)(gb + c + 4);
#pragma unroll
                for (int ai = 0; ai < 2; ++ai)
#pragma unroll
                    for (int m = 0; m < 4; ++m) { const int row = row0 + ai * 128 + m * 16; f32x4 v0 = acc[ai][bj][m][0] + b0, v1 = acc[ai][bj][m][1] + b1;
#pragma unroll
                        for (int i = 0; i < 4; ++i) { v0[i] = (fminf(v0[i], 0.f) - __logf(1.0f + __expf(-fabsf(v0[i])))) * 0.0625f; v1[i] = (fminf(v1[i], 0.f) - __logf(1.0f + __expf(-fabsf(v1[i])))) * 0.0625f; }
                        const f16x2_t h0 = {(_Float16)v0[0], (_Float16)v0[1]}, h1 = {(_Float16)v0[2], (_Float16)v0[3]}, h2 = {(_Float16)v1[0], (_Float16)v1[1]}, h3 = {(_Float16)v1[2], (_Float16)v1[3]};
                        *(u32x4*)(LAT + tile_off(row, c >> 6, (c & 63) >> 3)) = (u32x4){__builtin_bit_cast(unsigned, h0), __builtin_bit_cast(unsigned, h1), __builtin_bit_cast(unsigned, h2), __builtin_bit_cast(unsigned, h3)}; } }
        } else if (u.pn == 6 || u.pn == 7) {
            bf16_t* QA = QK + (size_t)(u.pn - 4) * QK_ARR;
#pragma unroll
            for (int ai = 0; ai < 2; ++ai)
#pragma unroll
                for (int m = 0; m < 4; ++m) { const int row = row0 + ai * 128 + m * 16; const int pidx = (row < 256) ? row : 64 + ((row - 256) & (SEQ - 1));
#pragma unroll
                    for (int bj = 0; bj < 2; ++bj) { const int c = cb0 + 128 * bj, d0 = (c & 63) >> 1;
                        const f32x4 cs0 = *(const f32x4*)(rope + (size_t)pidx * 32 + d0), cs1 = *(const f32x4*)(rope + (size_t)pidx * 32 + d0 + 2);
                        const f32x4 t1 = acc[ai][bj][m][0], t2 = acc[ai][bj][m][1];
                        const float co[4] = {cs0[0], cs0[2], cs1[0], cs1[2]}, si[4] = {cs0[1], cs0[3], cs1[1], cs1[3]};
                        float o1[4], o2[4];
#pragma unroll
                        for (int i = 0; i < 4; ++i) { o1[i] = t1[i] * co[i] - t2[i] * si[i]; o2[i] = t1[i] * si[i] + t2[i] * co[i]; }
                        u32x4 w; w.x = pg8::cvt_pk_bf16(o1[0], o1[1]); w.y = pg8::cvt_pk_bf16(o1[2], o1[3]); w.z = pg8::cvt_pk_bf16(o2[0], o2[1]); w.w = pg8::cvt_pk_bf16(o2[2], o2[3]);
                        *(u32x4*)(QA + tile_off(row, c >> 6, (c & 63) >> 3)) = w; } }
        } else if (u.pn <= 1) {
            bf16_t* QA = QK + (size_t)u.pn * QK_ARR;
#pragma unroll
            for (int ai = 0; ai < 2; ++ai)
#pragma unroll
                for (int m = 0; m < 4; ++m) { const int row = row0 + ai * 128 + m * 16;
#pragma unroll
                    for (int bj = 0; bj < 2; ++bj) { const int c = cb0 + 128 * bj; const f32x4 v0 = acc[ai][bj][m][0], v1 = acc[ai][bj][m][1];
                        u32x4 w; w.x = pg8::cvt_pk_bf16(v0[0], v0[1]); w.y = pg8::cvt_pk_bf16(v0[2], v0[3]); w.z = pg8::cvt_pk_bf16(v1[0], v1[1]); w.w = pg8::cvt_pk_bf16(v1[2], v1[3]);
                        *(u32x4*)(QA + tile_off(row, c >> 6, (c & 63) >> 3)) = w; } }
        } else {
            const int cdst = (u.pn < 6 ? (u.pn - 2) : (u.pn - 4)) * 256;
#pragma unroll
            for (int ai = 0; ai < 2; ++ai)
#pragma unroll
                for (int m = 0; m < 4; ++m) { bf16_t* rowp = VG + (size_t)(row0 + ai * 128 + m * 16) * NVG + cdst + cb0;
#pragma unroll
                    for (int bj = 0; bj < 2; ++bj) { const f32x4 v0 = acc[ai][bj][m][0], v1 = acc[ai][bj][m][1];
                        u32x4 w; w.x = pg8::cvt_pk_bf16(v0[0], v0[1]); w.y = pg8::cvt_pk_bf16(v0[2], v0[3]); w.z = pg8::cvt_pk_bf16(v1[0], v1[1]); w.w = pg8::cvt_pk_bf16(v1[2], v1[3]);
                        *(u32x4*)(rowp + bj * 128) = w; } }
        }
    }
};
struct EpiRes {
    static constexpr bool PERM = true, AFTER_DRAIN = false;
    bf16_t* HB; float* SSQ; const float* RINV; const float* GINV;
    __device__ __forceinline__ void operator()(const pg8::f32x4 (&acc)[2][2][4][2], const pg8::Unit& u, int wr, int wc, int fr, int fq) const {
        const int row0 = u.pm * 256 + wr * 64 + fr, col0 = u.pn * 256 + wc * 32 + 8 * fq;
        f32x4 gi[2][2];
#pragma unroll
        for (int bj = 0; bj < 2; ++bj) { gi[bj][0] = *(const f32x4*)(GINV + col0 + bj * 128); gi[bj][1] = *(const f32x4*)(GINV + col0 + bj * 128 + 4); }
#pragma unroll
        for (int ai = 0; ai < 2; ++ai)
#pragma unroll
            for (int m = 0; m < 4; ++m) { const int row = row0 + ai * 128 + m * 16; bf16_t* hr = HB + (size_t)row * DM + col0; float ss = 0.f; const float ri = RINV[row];
#pragma unroll
                for (int bj = 0; bj < 2; ++bj) { const u32x4 xn = *(const u32x4*)(hr + bj * 128);
                    const f32x4 x0 = (f32x4){bf_lo(xn.x), bf_hi(xn.x), bf_lo(xn.y), bf_hi(xn.y)} * ri * gi[bj][0], x1 = (f32x4){bf_lo(xn.z), bf_hi(xn.z), bf_lo(xn.w), bf_hi(xn.w)} * ri * gi[bj][1];
                    const f32x4 v0 = acc[ai][bj][m][0] + x0, v1 = acc[ai][bj][m][1] + x1;
                    ss += (v0[0] * v0[0] + v0[1] * v0[1]) + (v0[2] * v0[2] + v0[3] * v0[3]) + (v1[0] * v1[0] + v1[1] * v1[1]) + (v1[2] * v1[2] + v1[3] * v1[3]);
                    u32x4 w; w.x = pg8::cvt_pk_bf16(v0[0], v0[1]); w.y = pg8::cvt_pk_bf16(v0[2], v0[3]); w.z = pg8::cvt_pk_bf16(v1[0], v1[1]); w.w = pg8::cvt_pk_bf16(v1[2], v1[3]);
                    *(u32x4*)(hr + bj * 128) = w; }
                ss += __shfl_xor(ss, 16); ss += __shfl_xor(ss, 32);
                if (fq == 0) SSQ[(size_t)row * 16 + u.pn * 4 + wc] = ss; }
    }
};
struct EpiF16 {
    static constexpr bool PERM = true, AFTER_DRAIN = false;
    _Float16* SC;
    __device__ __forceinline__ void operator()(const pg8::f32x4 (&acc)[2][2][4][2], const pg8::Unit& u, int wr, int wc, int fr, int fq) const {
        const int row0 = u.pm * 256 + wr * 64 + fr, col0 = u.pn * 256 + wc * 32 + 8 * fq;
#pragma unroll
        for (int ai = 0; ai < 2; ++ai)
#pragma unroll
            for (int m = 0; m < 4; ++m) { _Float16* rowp = SC + (size_t)(row0 + ai * 128 + m * 16) * 2048 + col0;
#pragma unroll
                for (int bj = 0; bj < 2; ++bj) { const f32x4 v0 = acc[ai][bj][m][0], v1 = acc[ai][bj][m][1];
                    u32x4 w;
                    w.x = __builtin_bit_cast(unsigned, (f16x2_t){(_Float16)v0[0], (_Float16)v0[1]}); w.y = __builtin_bit_cast(unsigned, (f16x2_t){(_Float16)v0[2], (_Float16)v0[3]});
                    w.z = __builtin_bit_cast(unsigned, (f16x2_t){(_Float16)v1[0], (_Float16)v1[1]}); w.w = __builtin_bit_cast(unsigned, (f16x2_t){(_Float16)v1[2], (_Float16)v1[3]});
                    *(u32x4*)(rowp + bj * 128) = w; } }
    }
};

constexpr int A_QT = 0, A_KT = 9216, A_KE = 18432, A_V = 27648, A_ST = 45056, A_STSZ = 18432, A_OB = 81920, A_DEC = 115712, A_CS = 115968;
constexpr int PQ = 72, PV = 136, POB = 132;

__device__ __forceinline__ bf16x8 tr2(const LAS bf16_t* p0, const LAS bf16_t* p1) {
    const s16x4 a = __builtin_amdgcn_ds_read_tr16_b64_v4i16((LAS s16x4*)p0), b = __builtin_amdgcn_ds_read_tr16_b64_v4i16((LAS s16x4*)p1);
    return (bf16x8){a[0], a[1], a[2], a[3], b[0], b[1], b[2], b[3]};
}
__device__ __forceinline__ float ln_gamma(int hr) { return log1pf(-exp2f(-5.0f - (float)hr)); }

template <bool FULL>
__device__ __forceinline__ void attn_pass(const Params& p, LAS unsigned char* lds, int bid, int nb) {
    const int tid = threadIdx.x, lane = tid & 63, wave = __builtin_amdgcn_readfirstlane(tid >> 6);
    const int r16 = lane & 15, g4 = lane >> 4, q4 = (lane & 15) >> 2, p4 = lane & 3;
    unsigned char* ws = p.ws;
    const bf16_t* PROJ = (const bf16_t*)(ws + WS_PROJ); const _Float16* LA = (const _Float16*)(ws + WS_LA); const bf16_t* QK = (const bf16_t*)(ws + WS_QK);
    float* SEG = (float*)(ws + WS_SEG); float* ASEG = (float*)(ws + WS_ASEG); float* SEGM = (float*)(ws + WS_ASEG + 65536); bf16_t* OUT = (bf16_t*)(ws + WS_O);
    LAS bf16_t* QT = (LAS bf16_t*)(lds + A_QT); LAS bf16_t* KT = (LAS bf16_t*)(lds + A_KT); LAS bf16_t* KE = (LAS bf16_t*)(lds + A_KE); LAS bf16_t* VS = (LAS bf16_t*)(lds + A_V);
    LAS float* OB = (LAS float*)(lds + A_OB); LAS float* DEC = (LAS float*)(lds + A_DEC); LAS float* CS = (LAS float*)(lds + A_CS);

    for (int item = bid; item < 256; item += nb) {
        const int seg = item & 7, h8 = (item >> 3) & 7, b = item >> 6;
        const bool metaitem = !FULL && seg == 7 && b == 0;
        if (!FULL && seg == 7 && !metaitem) continue;
        const bool gla = h8 < 4; const int hr = h8 & 3;
        const float lng = ln_gamma(hr);
        const bf16_t* QAq = QK + (size_t)(gla ? 0 : 2) * QK_ARR; const bf16_t* QAk = QK + (size_t)(gla ? 1 : 3) * QK_ARR;
        const int vcol = (gla ? 0 : 1024) + hr * 128, gcol = (gla ? 512 : 1536) + hr * 128;
        const int nch = metaitem ? 1 : 16;

        f32x4 accS[8];
#pragma unroll
        for (int cb = 0; cb < 8; ++cb) accS[cb] = (f32x4){0.f, 0.f, 0.f, 0.f};
        float blsum[8] = {0.f, 0.f, 0.f, 0.f, 0.f, 0.f, 0.f, 0.f};
        __syncthreads();
        if (FULL) {
            if (wave >= 4) {
                const int wq = wave - 4;
                { const float* Sm = SEGM + (size_t)h8 * 8192;
#pragma unroll
                  for (int cb = 0; cb < 8; ++cb)
#pragma unroll
                      for (int rg = 0; rg < 4; ++rg) accS[cb][rg] = Sm[(16 * wq + 4 * g4 + rg) * 128 + 16 * cb + r16]; }
                for (int sp = 0; sp < seg; ++sp) { const int it2 = (item & ~7) + sp; const float* Sg = SEG + (size_t)it2 * 8192; const float* Ag = ASEG + it2 * 64;
                    float dec[4];
#pragma unroll
                    for (int rg = 0; rg < 4; ++rg) dec[rg] = Ag[16 * wq + 4 * g4 + rg];
#pragma unroll
                    for (int cb = 0; cb < 8; ++cb)
#pragma unroll
                        for (int rg = 0; rg < 4; ++rg) accS[cb][rg] = dec[rg] * accS[cb][rg] + Sg[(16 * wq + 4 * g4 + rg) * 128 + 16 * cb + r16]; }
                LAS bf16_t* ST0 = (LAS bf16_t*)(lds + A_ST);
#pragma unroll
                for (int cb = 0; cb < 8; ++cb) { u32x2 w; w.x = pk2(accS[cb][0], accS[cb][1]); w.y = pk2(accS[cb][2], accS[cb][3]); *(LAS u32x2*)(ST0 + (16 * cb + r16) * PQ + 16 * wq + 4 * g4) = w; }
            }
        }
#define A_ROWBASE(ci_) (metaitem ? 0 : 256 + b * SEQ + (16 * seg + (ci_)) * 64)
        u32x4 lav8; u32x4 qv8, kv8; u32x4 vreg[2];
        qv8 = (u32x4){0u, 0u, 0u, 0u};
#define A_LOADCHUNK(ci_) do { const int _rb = A_ROWBASE(ci_); \
            const size_t _to = ((((size_t)(_rb >> 6) * 4 + hr) * 8 + wave) * 64 + lane) * 8;       \
            if (gla) lav8 = *(const u32x4*)(LA + _to); else lav8 = (u32x4){0u, 0u, 0u, 0u}; \
            if (FULL) qv8 = *(const u32x4*)(QAq + _to); \
            kv8 = *(const u32x4*)(QAk + _to); \
            { const int vr = tid >> 3, cc = tid & 7; const u32x4* src = (const u32x4*)(PROJ + (size_t)(_rb + vr) * NVG + vcol + cc * 16); vreg[0] = src[0]; vreg[1] = src[1]; } } while (0)
#define A_LBAR() do { asm volatile("s_waitcnt lgkmcnt(0)" ::: "memory"); __builtin_amdgcn_s_barrier(); asm volatile("" ::: "memory"); } while (0)
        A_LOADCHUNK(0);
        f32x4 gnv[4], bsv[4];
        { const float* gptr = (gla ? p.gla_gain : p.ret_gain) + 16 * (tid & 7); const float* bptr = p.ret_bias + 16 * (tid & 7); const float bsc = gla ? 0.f : 1.f;
#pragma unroll
          for (int k4 = 0; k4 < 4; ++k4) { gnv[k4] = *(const f32x4*)(gptr + 4 * k4); bsv[k4] = *(const f32x4*)(bptr + 4 * k4) * bsc; } }
        for (int ci = 0; ci < nch; ++ci) {
            const bool metac = metaitem;
            const int rowbase = A_ROWBASE(ci);
            const LAS bf16_t* STr = (const LAS bf16_t*)(lds + A_ST + (ci & 1) * A_STSZ); LAS bf16_t* STw = (LAS bf16_t*)(lds + A_ST + ((ci + 1) & 1) * A_STSZ);
            u32x4 gpre[2] = {(u32x4){0u, 0u, 0u, 0u}, (u32x4){0u, 0u, 0u, 0u}};
            if (FULL && !metac) { const u32x4* gp = (const u32x4*)(PROJ + (size_t)(rowbase + (tid >> 3)) * NVG + gcol + 16 * (tid & 7)); gpre[0] = gp[0]; gpre[1] = gp[1]; }
            {
                float bc[8];
                const unsigned lw[4] = {lav8.x, lav8.y, lav8.z, lav8.w};
#pragma unroll
                for (int c = 0; c < 8; ++c) { float v = gla ? (float)__builtin_bit_cast(_Float16, (unsigned short)((c & 1) ? (lw[c >> 1] >> 16) : (lw[c >> 1] & 0xffffu))) : lng;
                    v += __builtin_bit_cast(float, __builtin_amdgcn_update_dpp(0, __builtin_bit_cast(int, v), 0x111, 0xf, 0xf, true));
                    v += __builtin_bit_cast(float, __builtin_amdgcn_update_dpp(0, __builtin_bit_cast(int, v), 0x112, 0xf, 0xf, true));
                    v += __builtin_bit_cast(float, __builtin_amdgcn_update_dpp(0, __builtin_bit_cast(int, v), 0x114, 0xf, 0xf, true));
                    v += __builtin_bit_cast(float, __builtin_amdgcn_update_dpp(0, __builtin_bit_cast(int, v), 0x118, 0xf, 0xf, true));
                    v += __builtin_bit_cast(float, __builtin_amdgcn_update_dpp(0, __builtin_bit_cast(int, v), 0x142, 0xa, 0xf, false));
                    v += __builtin_bit_cast(float, __builtin_amdgcn_update_dpp(0, __builtin_bit_cast(int, v), 0x143, 0xc, 0xf, false));
                    bc[c] = v; }
                float tot[8];
#pragma unroll
                for (int c = 0; c < 8; ++c) { tot[c] = __builtin_bit_cast(float, __builtin_amdgcn_readlane(__builtin_bit_cast(int, bc[c]), 63)); blsum[c] += tot[c]; }
                const unsigned qw[4] = {qv8.x, qv8.y, qv8.z, qv8.w}, kw[4] = {kv8.x, kv8.y, kv8.z, kv8.w};
                unsigned oq[4], ok[4], oe[4];
#pragma unroll
                for (int c2 = 0; c2 < 4; ++c2) { const float k0 = bf_lo(kw[c2]), k1 = bf_hi(kw[c2]);
                    if (FULL) { oq[c2] = pk2(bf_lo(qw[c2]) * __expf(bc[2 * c2]), bf_hi(qw[c2]) * __expf(bc[2 * c2 + 1])); ok[c2] = pk2(k0 * __expf(-bc[2 * c2]), k1 * __expf(-bc[2 * c2 + 1])); }
                    oe[c2] = pk2(k0 * __expf(tot[2 * c2] - bc[2 * c2]), k1 * __expf(tot[2 * c2 + 1] - bc[2 * c2 + 1])); }
                if (FULL) { *(LAS u32x4*)(QT + lane * PQ + 8 * wave) = (u32x4){oq[0], oq[1], oq[2], oq[3]}; *(LAS u32x4*)(KT + lane * PQ + 8 * wave) = (u32x4){ok[0], ok[1], ok[2], ok[3]}; }
                *(LAS u32x4*)(KE + lane * PQ + 8 * wave) = (u32x4){oe[0], oe[1], oe[2], oe[3]};
                if (lane == 63) { *(LAS f32x4*)(DEC + 8 * wave) = (f32x4){__expf(tot[0]), __expf(tot[1]), __expf(tot[2]), __expf(tot[3])};
                                  *(LAS f32x4*)(DEC + 8 * wave + 4) = (f32x4){__expf(tot[4]), __expf(tot[5]), __expf(tot[6]), __expf(tot[7])}; }
                const int vr = tid >> 3, cc = tid & 7; LAS u32x4* dst = (LAS u32x4*)(VS + vr * PV + cc * 16); dst[0] = vreg[0]; dst[1] = vreg[1];
            }
            if (ci + 1 < nch) A_LOADCHUNK(ci + 1);
            A_LBAR();
            if (wave < 4) {
                if (FULL && !metac) {
                    const int w = wave;
                    bf16x8 qf[2];
#pragma unroll
                    for (int s = 0; s < 2; ++s) qf[s] = *(const LAS bf16x8*)(QT + (16 * w + r16) * PQ + 32 * s + 8 * g4);
                    f32x4 att[4];
#pragma unroll
                    for (int jb = 0; jb < 4; ++jb) { att[jb] = (f32x4){0.f, 0.f, 0.f, 0.f};
                        if (jb <= w) {
#pragma unroll
                            for (int s = 0; s < 2; ++s) { const bf16x8 kf = *(const LAS bf16x8*)(KT + (16 * jb + r16) * PQ + 32 * s + 8 * g4);
                                att[jb] = __builtin_amdgcn_mfma_f32_16x16x32_bf16(kf, qf[s], att[jb], 0, 0, 0); }
                            if (jb == w) {
#pragma unroll
                                for (int rg = 0; rg < 4; ++rg) att[jb][rg] = (4 * g4 + rg <= r16) ? att[jb][rg] : 0.f;
                            }
                        } }
                    bf16x8 af[2];
#pragma unroll
                    for (int s = 0; s < 2; ++s) { u32x4 t; t.x = pk2(att[2 * s][0], att[2 * s][1]); t.y = pk2(att[2 * s][2], att[2 * s][3]); t.z = pk2(att[2 * s + 1][0], att[2 * s + 1][1]); t.w = pk2(att[2 * s + 1][2], att[2 * s + 1][3]);
                        af[s] = __builtin_bit_cast(bf16x8, t); }
#pragma unroll
                    for (int cb = 0; cb < 8; ++cb) { f32x4 o = (f32x4){0.f, 0.f, 0.f, 0.f};
#pragma unroll
                        for (int s = 0; s < 2; ++s) {
                            const bf16x8 vf = tr2(VS + (32 * s + 4 * g4 + q4) * PV + 16 * cb + 4 * p4, VS + (32 * s + 16 + 4 * g4 + q4) * PV + 16 * cb + 4 * p4);
                            o = __builtin_amdgcn_mfma_f32_16x16x32_bf16(af[s], vf, o, 0, 0, 0);
                            const bf16x8 sf = *(const LAS bf16x8*)(STr + (16 * cb + r16) * PQ + 32 * s + 8 * g4);
                            o = __builtin_amdgcn_mfma_f32_16x16x32_bf16(qf[s], sf, o, 0, 0, 0); }
#pragma unroll
                        for (int rg = 0; rg < 4; ++rg) OB[(16 * w + 4 * g4 + rg) * POB + 16 * cb + r16] = o[rg]; }
                }
            } else {
                const int wq = wave - 4;
                float dec[4];
#pragma unroll
                for (int rg = 0; rg < 4; ++rg) dec[rg] = DEC[16 * wq + 4 * g4 + rg];
                bf16x8 kef[2];
#pragma unroll
                for (int s = 0; s < 2; ++s) kef[s] = tr2(KE + (32 * s + 8 * g4 + q4) * PQ + 16 * wq + 4 * p4, KE + (32 * s + 8 * g4 + 4 + q4) * PQ + 16 * wq + 4 * p4);
#pragma unroll
                for (int cb = 0; cb < 8; ++cb) {
#pragma unroll
                    for (int rg = 0; rg < 4; ++rg) accS[cb][rg] *= dec[rg];
#pragma unroll
                    for (int s = 0; s < 2; ++s) { const bf16x8 vf = tr2(VS + (32 * s + 8 * g4 + q4) * PV + 16 * cb + 4 * p4, VS + (32 * s + 8 * g4 + 4 + q4) * PV + 16 * cb + 4 * p4);
                        accS[cb] = __builtin_amdgcn_mfma_f32_16x16x32_bf16(kef[s], vf, accS[cb], 0, 0, 0); }
                    if (FULL) { u32x2 w; w.x = pk2(accS[cb][0], accS[cb][1]); w.y = pk2(accS[cb][2], accS[cb][3]); *(LAS u32x2*)(STw + (16 * cb + r16) * PQ + 16 * wq + 4 * g4) = w; }
                }
            }
            A_LBAR();
            if (FULL && !metac) {
                const int i = tid >> 3, cc = tid & 7;
                float o[16];
#pragma unroll
                for (int k4 = 0; k4 < 4; ++k4) { const f32x4 t = *(const LAS f32x4*)(OB + i * POB + 16 * cc + 4 * k4); o[4 * k4] = t[0]; o[4 * k4 + 1] = t[1]; o[4 * k4 + 2] = t[2]; o[4 * k4 + 3] = t[3]; }
                const size_t row = (size_t)(rowbase + i);
                const u32x4 ga = gpre[0], gb2 = gpre[1];
                const unsigned gw[8] = {ga.x, ga.y, ga.z, ga.w, gb2.x, gb2.y, gb2.z, gb2.w};
                float s1 = 0.f, s2 = 0.f;
#pragma unroll
                for (int k = 0; k < 16; ++k) { s1 += o[k]; s2 += o[k] * o[k]; }
#pragma unroll
                for (int m = 1; m < 8; m <<= 1) { s1 += __shfl_xor(s1, m); s2 += __shfl_xor(s2, m); }
                const float mu = gla ? 0.f : s1 * (1.0f / 128.0f);
                const float rs = __builtin_amdgcn_rsqf(fmaxf(s2 * (1.0f / 128.0f) - mu * mu, 0.f) + EPS);
                unsigned ow[8];
#pragma unroll
                for (int k2 = 0; k2 < 8; ++k2) { float y[2];
#pragma unroll
                    for (int e = 0; e < 2; ++e) { const int k = 2 * k2 + e; const float v = (o[k] - mu) * rs * gnv[k >> 2][k & 3] + bsv[k >> 2][k & 3];
                        const float gt = e ? bf_hi(gw[k2]) : bf_lo(gw[k2]); y[e] = v * gt * __builtin_amdgcn_rcpf(1.0f + __expf(-gt)); }
                    ow[k2] = pk2(y[0], y[1]); }
                u32x4* op = (u32x4*)(OUT + (row - 256) * DM + h8 * 128 + 16 * cc);
                op[0] = (u32x4){ow[0], ow[1], ow[2], ow[3]}; op[1] = (u32x4){ow[4], ow[5], ow[6], ow[7]};
            }
        }
        if (!FULL) {
            if (wave >= 4) { const int wq = wave - 4; float* Sg = metaitem ? SEGM + (size_t)h8 * 8192 : SEG + (size_t)item * 8192;
#pragma unroll
                for (int cb = 0; cb < 8; ++cb)
#pragma unroll
                    for (int rg = 0; rg < 4; ++rg) Sg[(16 * wq + 4 * g4 + rg) * 128 + 16 * cb + r16] = accS[cb][rg]; }
            if (lane < 8 && !metaitem) { float bl = blsum[0];
#pragma unroll
                for (int c = 1; c < 8; ++c) bl = (lane == c) ? blsum[c] : bl;
                ASEG[item * 64 + 8 * wave + lane] = __expf(bl); }
        }
#undef A_LBAR
#undef A_ROWBASE
#undef A_LOADCHUNK
    }
}

__device__ __forceinline__ unsigned ord32(float f) { const unsigned b = __builtin_bit_cast(unsigned, f); return b ^ ((b >> 31) ? 0xffffffffu : 0x80000000u); }
__device__ __forceinline__ float unord32(unsigned o) { const unsigned b = (o >> 31) ? (o ^ 0x80000000u) : ~o; return __builtin_bit_cast(float, b); }
#define DPP_MAXU(v, ctrl, rmask) do { const unsigned _t = (unsigned)__builtin_amdgcn_update_dpp((int)(v), (int)(v), (ctrl), (rmask), 0xf, false); (v) = (v) > _t ? (v) : _t; } while (0)
#define DPP_ADDF(v, ctrl) do { const float _t = __builtin_bit_cast(float, __builtin_amdgcn_update_dpp(0, __builtin_bit_cast(int, (v)), (ctrl), 0xf, 0xf, false)); (v) += _t; } while (0)
__device__ __forceinline__ unsigned row_max_u(unsigned v) { DPP_MAXU(v, 0xB1, 0xf); DPP_MAXU(v, 0x4E, 0xf); DPP_MAXU(v, 0x124, 0xf); DPP_MAXU(v, 0x128, 0xf); return v; }
__device__ __forceinline__ float row_sum_f(float v) { DPP_ADDF(v, 0xB1); DPP_ADDF(v, 0x4E); DPP_ADDF(v, 0x124); DPP_ADDF(v, 0x128); return v; }
__device__ __forceinline__ unsigned wave_max_u(unsigned v) { v = row_max_u(v); DPP_MAXU(v, 0x142, 0xa); DPP_MAXU(v, 0x143, 0xc); return (unsigned)__builtin_amdgcn_readlane((int)v, 63); }

__device__ __forceinline__ float row_sum_x(float v) { return row_sum_f(v); }
__device__ __forceinline__ float dot2_bf16(unsigned w, unsigned x, float acc) { return __builtin_amdgcn_fdot2_f32_bf16(__builtin_bit_cast(bf16x2_t, w), __builtin_bit_cast(bf16x2_t, x), acc, false); }
__device__ __forceinline__ float gelu_exact(float v) { return 0.5f * v * (1.0f + erff(v * 0.70710678118654752f)); }

__device__ __forceinline__ void phase_peer(const Params& p, LAS unsigned char* lds, int bid, int nb) {
    const int tid = threadIdx.x, lane = tid & 63, wave = __builtin_amdgcn_readfirstlane(tid >> 6);
    const int p16 = lane & 15, rg4 = lane >> 4;
    unsigned char* ws = p.ws;
    const _Float16* SC = (const _Float16*)(ws + WS_PROJ); const bf16_t* HB = (const bf16_t*)(ws + WS_HB); const float* SSQ = (const float*)(ws + WS_SSQ);
    const unsigned char* UB = (const unsigned char*)(ws + WS_UB); const unsigned char* VB = (const unsigned char*)(ws + WS_VB);
    LAS float* A_s = (LAS float*)(lds + wave * 4096);
    LAS int* A_i = (LAS int*)(lds + wave * 4096 + 1024);
    LAS int* E_i = (LAS int*)(lds + wave * 4096 + 2048);
    LAS float* E_s = (LAS float*)(lds + wave * 4096 + 2560);
    int ci = 0, cj = 0; bool cvalid = lane < 50;
    { int l = lane;
      if (l < 16) { ci = 0; cj = l; } else if (l < 24) { ci = 1; cj = l - 16; } else if (l < 29) { ci = 2; cj = l - 24; } else if (l < 33) { ci = 3; cj = l - 29; }
      else if (l < 36) { ci = 4; cj = l - 33; } else if (l < 42) { ci = 5 + (l - 36) / 2; cj = (l - 36) & 1; } else { ci = 8 + (l - 42); cj = 0; } if (!cvalid) { ci = 0; cj = 0; } }
    const int gw = bid * 8 + wave, NGW = nb * 8;
    for (int t = gw; t < NTOK; t += NGW) {
        float ssq = (lane < 16) ? SSQ[(size_t)t * 16 + lane] : 0.f; ssq = wave_sum(ssq);
        const float rstd = 1.0f / sqrtf(ssq * (1.0f / DM) + EPS);
#pragma unroll 1
        for (int q = 0; q < 4; ++q) {
            const u32x4 raw = *(const u32x4*)(SC + (size_t)t * 2048 + 512 * q + 8 * lane);
            const unsigned rw[4] = {raw.x, raw.y, raw.z, raw.w};
            unsigned key[8];
#pragma unroll
            for (int e = 0; e < 8; ++e) { const unsigned hbits = (e & 1) ? (rw[e >> 1] >> 16) : (rw[e >> 1] & 0xffffu);
                const float f = (float)__builtin_bit_cast(_Float16, (unsigned short)hbits);
                key[e] = (ord32(f) & ~0x7fu) | (unsigned)(127 - (8 * p16 + e)); }
            unsigned mine = 0u;
#pragma unroll 1
            for (int it = 0; it < 16; ++it) {
                unsigned m = key[0];
#pragma unroll
                for (int e = 1; e < 8; ++e) m = m > key[e] ? m : key[e];
                const unsigned W = row_max_u(m);
                mine = (p16 == it) ? W : mine;
#pragma unroll
                for (int e = 0; e < 8; ++e) key[e] = (key[e] == W) ? 0u : key[e];
            }
            const int g = 4 * q + rg4;
            A_s[g * 16 + p16] = unord32(mine & ~0x7fu); A_i[g * 16 + p16] = 127 - (int)(mine & 0x7fu);
        }
        LDS_WAIT();
#pragma unroll 1
        for (int h = 0; h < 8; ++h) {
            const float sa = A_s[(2 * h) * 16 + ci], sb = A_s[(2 * h + 1) * 16 + cj];
            const int ia = A_i[(2 * h) * 16 + ci], ib = A_i[(2 * h + 1) * 16 + cj];
            const float sum = sa + sb;
            unsigned key = cvalid ? ((ord32(sum) & ~0x3fu) | (unsigned)(63 - lane)) : 0u;
            int rank = -1;
#pragma unroll 1
            for (int it = 0; it < 16; ++it) { const unsigned W = wave_max_u(key); if (key == W) { rank = it; key = 0u; } }
            if (rank >= 0) { E_i[h * 16 + rank] = ia * 128 + ib; E_s[h * 16 + rank] = sum; }
        }
        LDS_WAIT();
        float gsm[2]; int eidx[2];
#pragma unroll
        for (int sl = 0; sl < 2; ++sl) { const int e = lane + 64 * sl; const float s = E_s[e] * rstd, mx = E_s[e & ~15] * rstd; const float pe = __expf(s - mx); const float den = row_sum_x(pe);
            gsm[sl] = pe / den; eidx[sl] = E_i[e]; }
#if PEER_FP8
        f32x2v xf[4][8];
#pragma unroll
        for (int i = 0; i < 4; ++i) { const u32x4 h0 = *(const u32x4*)(HB + (size_t)t * DM + 256 * i + 16 * p16), h1 = *(const u32x4*)(HB + (size_t)t * DM + 256 * i + 16 * p16 + 8);
            const unsigned hv[8] = {h0.x, h0.y, h0.z, h0.w, h1.x, h1.y, h1.z, h1.w}; const float* gp = p.g2 + 256 * i + 16 * p16;
#pragma unroll
            for (int k2 = 0; k2 < 8; ++k2) { const f32x2v g = *(const f32x2v*)(gp + 2 * k2); xf[i][k2] = (f32x2v){bf_lo(hv[k2]) * rstd * g.x, bf_hi(hv[k2]) * rstd * g.y}; } }
        constexpr int NBB = 2;
#define P6_LOADB(buf, TAB, bt0) do { _Pragma("unroll") for (int j = 0; j < NBB; ++j) { const int bt = (bt0) + j; const int ex = E_i[64 * (bt >> 4) + 16 * rg4 + (bt & 15)]; \
            const unsigned char* rp = (TAB) + (size_t)ex * 1024 + 16 * p16; _Pragma("unroll") for (int i = 0; i < 4; ++i) buf[j][i] = *(const u32x4*)(rp + 256 * i); } } while (0)
        u32x4 bA[NBB][4], bB[NBB][4];
        float act0 = 0.f, act1 = 0.f;
#define P6_COMPU(buf, bt0) do { _Pragma("unroll") for (int j = 0; j < NBB; ++j) { const int bt = (bt0) + j; f32x2v s2 = (f32x2v){0.f, 0.f}; \
            _Pragma("unroll") for (int i = 0; i < 4; ++i) { const unsigned uu[4] = {buf[j][i].x, buf[j][i].y, buf[j][i].z, buf[j][i].w}; \
                _Pragma("unroll") for (int w = 0; w < 4; ++w) { const f32x2v lo = __builtin_amdgcn_cvt_pk_f32_fp8((int)uu[w], false), hi = __builtin_amdgcn_cvt_pk_f32_fp8((int)uu[w], true); \
                    s2 = __builtin_elementwise_fma(lo, xf[i][2 * w], s2); s2 = __builtin_elementwise_fma(hi, xf[i][2 * w + 1], s2); } } \
            const float s = row_sum_x(s2.x + s2.y); const bool mine = (p16 == (bt & 15)); act0 = (mine && bt < 16) ? s : act0; act1 = (mine && bt >= 16) ? s : act1; } } while (0)
        P6_LOADB(bA, UB, 0);
#pragma unroll 1
        for (int g = 0; g < 32; g += 2 * NBB) { P6_LOADB(bB, UB, g + NBB); P6_COMPU(bA, g); if (g + 2 * NBB < 32) P6_LOADB(bA, UB, g + 2 * NBB); P6_COMPU(bB, g + NBB); }
        P6_LOADB(bA, VB, 0);
        LAS float* E_c = E_s;
        { const float c0 = gsm[0] * gelu_exact(act0 * (1.0f / 512.0f)) * (1.0f / 32.0f), c1 = gsm[1] * gelu_exact(act1 * (1.0f / 512.0f)) * (1.0f / 32.0f);
          LDS_WAIT(); E_c[lane] = c0; E_c[lane + 64] = c1; LDS_WAIT(); }
        f32x2v acc2[4][8];
#pragma unroll
        for (int i = 0; i < 4; ++i)
#pragma unroll
            for (int k = 0; k < 8; ++k) acc2[i][k] = (f32x2v){0.f, 0.f};
#define P6_COMPV(buf, bt0) do { _Pragma("unroll") for (int j = 0; j < NBB; ++j) { const int bt = (bt0) + j; const float cf = E_c[64 * (bt >> 4) + 16 * rg4 + (bt & 15)]; const f32x2v cf2 = (f32x2v){cf, cf}; \
            _Pragma("unroll") for (int i = 0; i < 4; ++i) { const unsigned vv[4] = {buf[j][i].x, buf[j][i].y, buf[j][i].z, buf[j][i].w}; \
                _Pragma("unroll") for (int w = 0; w < 4; ++w) { const f32x2v lo = __builtin_amdgcn_cvt_pk_f32_fp8((int)vv[w], false), hi = __builtin_amdgcn_cvt_pk_f32_fp8((int)vv[w], true); \
                    acc2[i][2 * w] = __builtin_elementwise_fma(lo, cf2, acc2[i][2 * w]); acc2[i][2 * w + 1] = __builtin_elementwise_fma(hi, cf2, acc2[i][2 * w + 1]); } } } } while (0)
#pragma unroll 1
        for (int g = 0; g < 32; g += 2 * NBB) { P6_LOADB(bB, VB, g + NBB); P6_COMPV(bA, g); if (g + 2 * NBB < 32) P6_LOADB(bA, VB, g + 2 * NBB); P6_COMPV(bB, g + NBB); }
#undef P6_LOADB
#undef P6_COMPU
#undef P6_COMPV
        float ss = 0.f;
#pragma unroll
        for (int i = 0; i < 4; ++i) { const u32x4 h0 = *(const u32x4*)(HB + (size_t)t * DM + 256 * i + 16 * p16), h1 = *(const u32x4*)(HB + (size_t)t * DM + 256 * i + 16 * p16 + 8);
            const unsigned hv[8] = {h0.x, h0.y, h0.z, h0.w, h1.x, h1.y, h1.z, h1.w};
#pragma unroll
            for (int k2 = 0; k2 < 8; ++k2) { float ax = acc2[i][k2].x, ay = acc2[i][k2].y;
                ax += __shfl_xor(ax, 16); ax += __shfl_xor(ax, 32); ay += __shfl_xor(ay, 16); ay += __shfl_xor(ay, 32);
                ax += bf_lo(hv[k2]); ay += bf_hi(hv[k2]); acc2[i][k2] = (f32x2v){ax, ay}; ss += ax * ax + ay * ay; } }
        ss = row_sum_x(ss);
        const float rf = 1.0f / sqrtf(ss * (1.0f / DM) + EPS);
#pragma unroll
        for (int i = 0; i < 4; ++i) { if (i == rg4) { const float* gp = p.gfin + 256 * i + 16 * p16; float* op = p.out + (size_t)t * DM + 256 * i + 16 * p16;
#pragma unroll
                for (int k4 = 0; k4 < 4; ++k4) { const f32x4 g = *(const f32x4*)(gp + 4 * k4);
                    *(f32x4*)(op + 4 * k4) = (f32x4){acc2[i][2 * k4].x * rf * g[0], acc2[i][2 * k4].y * rf * g[1], acc2[i][2 * k4 + 1].x * rf * g[2], acc2[i][2 * k4 + 1].y * rf * g[3]}; } } }
#else
        unsigned xp[8][4];
#pragma unroll
        for (int i = 0; i < 8; ++i) { const u32x4 hw = *(const u32x4*)(HB + (size_t)t * DM + 128 * i + 8 * p16); const f32x4 ga = *(const f32x4*)(p.g2 + 128 * i + 8 * p16), gb = *(const f32x4*)(p.g2 + 128 * i + 8 * p16 + 4);
            xp[i][0] = pk2(bf_lo(hw.x) * rstd * ga[0], bf_hi(hw.x) * rstd * ga[1]); xp[i][1] = pk2(bf_lo(hw.y) * rstd * ga[2], bf_hi(hw.y) * rstd * ga[3]);
            xp[i][2] = pk2(bf_lo(hw.z) * rstd * gb[0], bf_hi(hw.z) * rstd * gb[1]); xp[i][3] = pk2(bf_lo(hw.w) * rstd * gb[2], bf_hi(hw.w) * rstd * gb[3]); }
        float act[2] = {0.f, 0.f};
#pragma unroll
        for (int sl = 0; sl < 2; ++sl) {
#pragma unroll 2
            for (int b16 = 0; b16 < 16; ++b16) {
                const int e = 64 * sl + 16 * rg4 + b16; const int ex = E_i[e];
                const unsigned char* rowp = UB + (size_t)ex * 2048 + 16 * p16;
                float s = 0.f;
#pragma unroll
                for (int i = 0; i < 8; ++i) { const u32x4 uw = *(const u32x4*)(rowp + 256 * i);
                    s = dot2_bf16(uw.x, xp[i][0], s); s = dot2_bf16(uw.y, xp[i][1], s); s = dot2_bf16(uw.z, xp[i][2], s); s = dot2_bf16(uw.w, xp[i][3], s); }
                s = row_sum_x(s);
                act[sl] = (p16 == b16) ? s : act[sl];
            }
        }
        float coef[2];
#pragma unroll
        for (int sl = 0; sl < 2; ++sl) coef[sl] = gsm[sl] * gelu_exact(act[sl]);
        float acc[8][8];
#pragma unroll
        for (int i = 0; i < 8; ++i)
#pragma unroll
            for (int k = 0; k < 8; ++k) acc[i][k] = 0.f;
#pragma unroll
        for (int sl = 0; sl < 2; ++sl) {
#pragma unroll 2
            for (int b16 = 0; b16 < 16; ++b16) {
                const int srcl = (lane & 48) + b16;
                const float cf = __shfl(coef[sl], srcl); const int ex = __shfl(eidx[sl], srcl);
                const unsigned char* rowp = VB + (size_t)ex * 2048 + 16 * p16;
#pragma unroll
                for (int i = 0; i < 8; ++i) { const u32x4 vw = *(const u32x4*)(rowp + 256 * i);
                    acc[i][0] += cf * bf_lo(vw.x); acc[i][1] += cf * bf_hi(vw.x); acc[i][2] += cf * bf_lo(vw.y); acc[i][3] += cf * bf_hi(vw.y);
                    acc[i][4] += cf * bf_lo(vw.z); acc[i][5] += cf * bf_hi(vw.z); acc[i][6] += cf * bf_lo(vw.w); acc[i][7] += cf * bf_hi(vw.w); }
            }
        }
        float ss = 0.f;
#pragma unroll
        for (int i = 0; i < 8; ++i) { const u32x4 hw = *(const u32x4*)(HB + (size_t)t * DM + 128 * i + 8 * p16); const unsigned hv[4] = {hw.x, hw.y, hw.z, hw.w};
#pragma unroll
            for (int k = 0; k < 8; ++k) { float a = acc[i][k]; a += __shfl_xor(a, 16); a += __shfl_xor(a, 32);
                a += (k & 1) ? bf_hi(hv[k >> 1]) : bf_lo(hv[k >> 1]); acc[i][k] = a; ss += a * a; } }
        ss = row_sum_x(ss);
        const float rf = 1.0f / sqrtf(ss * (1.0f / DM) + EPS);
#pragma unroll
        for (int i = 0; i < 8; ++i) { if ((i >> 1) == rg4) { const f32x4 ga = *(const f32x4*)(p.gfin + 128 * i + 8 * p16), gb = *(const f32x4*)(p.gfin + 128 * i + 8 * p16 + 4);
                float* op = p.out + (size_t)t * DM + 128 * i + 8 * p16;
                *(f32x4*)op = (f32x4){acc[i][0] * rf * ga[0], acc[i][1] * rf * ga[1], acc[i][2] * rf * ga[2], acc[i][3] * rf * ga[3]};
                *(f32x4*)(op + 4) = (f32x4){acc[i][4] * rf * gb[0], acc[i][5] * rf * gb[1], acc[i][6] * rf * gb[2], acc[i][7] * rf * gb[3]}; } }
#endif
        LDS_WAIT();
    }
}


__device__ __forceinline__ void row_max4(unsigned k0, unsigned k1, unsigned k2, unsigned k3, unsigned& w0, unsigned& w1, unsigned& w2, unsigned& w3) {
    asm volatile("s_nop 1\n\t"
                 "v_max_u32_dpp %0, %4, %4 quad_perm:[1,0,3,2] row_mask:0xf bank_mask:0xf\n\t"
                 "v_max_u32_dpp %1, %5, %5 quad_perm:[1,0,3,2] row_mask:0xf bank_mask:0xf\n\t"
                 "v_max_u32_dpp %2, %6, %6 quad_perm:[1,0,3,2] row_mask:0xf bank_mask:0xf\n\t"
                 "v_max_u32_dpp %3, %7, %7 quad_perm:[1,0,3,2] row_mask:0xf bank_mask:0xf\n\t"
                 "v_max_u32_dpp %0, %0, %0 quad_perm:[2,3,0,1] row_mask:0xf bank_mask:0xf\n\t"
                 "v_max_u32_dpp %1, %1, %1 quad_perm:[2,3,0,1] row_mask:0xf bank_mask:0xf\n\t"
                 "v_max_u32_dpp %2, %2, %2 quad_perm:[2,3,0,1] row_mask:0xf bank_mask:0xf\n\t"
                 "v_max_u32_dpp %3, %3, %3 quad_perm:[2,3,0,1] row_mask:0xf bank_mask:0xf\n\t"
                 "v_max_u32_dpp %0, %0, %0 row_ror:4 row_mask:0xf bank_mask:0xf\n\t"
                 "v_max_u32_dpp %1, %1, %1 row_ror:4 row_mask:0xf bank_mask:0xf\n\t"
                 "v_max_u32_dpp %2, %2, %2 row_ror:4 row_mask:0xf bank_mask:0xf\n\t"
                 "v_max_u32_dpp %3, %3, %3 row_ror:4 row_mask:0xf bank_mask:0xf\n\t"
                 "v_max_u32_dpp %0, %0, %0 row_ror:8 row_mask:0xf bank_mask:0xf\n\t"
                 "v_max_u32_dpp %1, %1, %1 row_ror:8 row_mask:0xf bank_mask:0xf\n\t"
                 "v_max_u32_dpp %2, %2, %2 row_ror:8 row_mask:0xf bank_mask:0xf\n\t"
                 "v_max_u32_dpp %3, %3, %3 row_ror:8 row_mask:0xf bank_mask:0xf\n\t"
                 "s_nop 1"
                 : "=&v"(w0), "=&v"(w1), "=&v"(w2), "=&v"(w3) : "v"(k0), "v"(k1), "v"(k2), "v"(k3));
}
__device__ __forceinline__ unsigned pkadd_h2(unsigned a, unsigned b) { const h2v x = __builtin_bit_cast(h2v, a), y = __builtin_bit_cast(h2v, b); const h2v s = x + y; return __builtin_bit_cast(unsigned, s); }
constexpr int NT6 = 8;
constexpr int W6_BYTES = 16640;
__device__ __forceinline__ float dpp_f(float v, int ctrl_dummy);
#define DPPF(v, ctrl) __builtin_bit_cast(float, __builtin_amdgcn_update_dpp(0, __builtin_bit_cast(int, (v)), (ctrl), 0xf, 0xf, false))

__device__ __forceinline__ void phase_peer2(const Params& p, LAS unsigned char* lds, int bid, int nb) {
    const int tid = threadIdx.x, lane = tid & 63, wave = __builtin_amdgcn_readfirstlane(tid >> 6);
    const int p16 = lane & 15, rg4 = lane >> 4, q8 = lane >> 3, p8 = lane & 7;
    const bool b0 = lane & 1, b1 = lane & 2, b2 = lane & 4, c0 = lane & 8, c1 = lane & 16, c2 = lane & 32;
    unsigned char* ws = p.ws;
    const _Float16* SC = (const _Float16*)(ws + WS_PROJ); const bf16_t* HB = (const bf16_t*)(ws + WS_HB); const float* SSQ = (const float*)(ws + WS_SSQ);
    const unsigned char* UB = (const unsigned char*)(ws + WS_UB); const unsigned char* VB = (const unsigned char*)(ws + WS_VB); unsigned char* XQ = ws + WS_XQ; bf16_t* OS = (bf16_t*)(ws + WS_O);
    LAS unsigned char* wl = lds + wave * W6_BYTES;
    LAS unsigned* CW = (LAS unsigned*)wl;
    LAS unsigned char* XL = wl;
    LAS unsigned short* E16 = (LAS unsigned short*)(wl + 8192);
    LAS _Float16* GC = (LAS _Float16*)(wl + 10240);
    LAS unsigned* E32 = (LAS unsigned*)(wl + 4096);
    LAS float* ACT = (LAS float*)(wl + 12288);
    LAS float* RS = (LAS float*)(wl + 16384);
    const unsigned kbase[4] = {12288u + 4u * lane, 14336u + 4u * lane, 6144u + 4u * lane, ((lane >> 5) ? 5120u : 2048u) + 4u * (lane & 31)};
    constexpr unsigned kshift[4] = {8u, 8u, 8u, 7u};
    unsigned ixc[8];
#pragma unroll
    for (int e = 0; e < 8; ++e) ixc[e] = (unsigned)(127 - (8 * p16 + e));
    int ci = 0, cj = 0; bool cvalid = lane < 50;
    { int l = lane;
      if (l < 16) { ci = 0; cj = l; } else if (l < 24) { ci = 1; cj = l - 16; } else if (l < 29) { ci = 2; cj = l - 24; } else if (l < 33) { ci = 3; cj = l - 29; }
      else if (l < 36) { ci = 4; cj = l - 33; } else if (l < 42) { ci = 5 + (l - 36) / 2; cj = (l - 36) & 1; } else { ci = 8 + (l - 42); cj = 0; } if (!cvalid) { ci = 0; cj = 0; } }
    const int gw = bid * 8 + wave, NGW = nb * 8;
#define TOK6(k) min(base + (k) * NGW, NTOK - 1)
    for (int base = gw; base < NTOK; base += NT6 * NGW) {
#pragma unroll 1
        for (int rep_r = 0; rep_r < PROBE_R; ++rep_r)
#pragma unroll 1
        for (int k = 0; k < NT6; k += 2) {
            u32x4 raw[2][4]; float rstd[2];
#pragma unroll
            for (int v = 0; v < 2; ++v) { const int t = TOK6(k + v);
#pragma unroll
                for (int q = 0; q < 4; ++q) raw[v][q] = *(const u32x4*)(SC + (size_t)t * 2048 + 512 * q + 8 * lane);
                float ssq = (lane < 16) ? SSQ[(size_t)t * 16 + lane] : 0.f; ssq = wave_sum(ssq);
                rstd[v] = 1.0f / sqrtf(ssq * (1.0f / DM) + EPS);
                { const u32x4 ha = *(const u32x4*)(HB + (size_t)t * DM + 16 * lane), hb = *(const u32x4*)(HB + (size_t)t * DM + 16 * lane + 8); const float sc = rstd[v] * 16.0f;
                  const unsigned hv[8] = {ha.x, ha.y, ha.z, ha.w, hb.x, hb.y, hb.z, hb.w}; unsigned xw[4];
#pragma unroll
                  for (int w = 0; w < 4; ++w) { int pk = __builtin_amdgcn_cvt_pk_fp8_f32(bf_lo(hv[2 * w]) * sc, bf_hi(hv[2 * w]) * sc, 0, false);
                      pk = __builtin_amdgcn_cvt_pk_fp8_f32(bf_lo(hv[2 * w + 1]) * sc, bf_hi(hv[2 * w + 1]) * sc, pk, true); xw[w] = (unsigned)pk; }
                  *(u32x4*)(XQ + (size_t)t * DM + 16 * lane) = (u32x4){xw[0], xw[1], xw[2], xw[3]}; } }
#pragma unroll
            for (int qq = 0; qq < 2; ++qq) {
                unsigned ka[4][8];
#pragma unroll
                for (int c = 0; c < 4; ++c) { const u32x4 rv = raw[c >> 1][2 * qq + (c & 1)]; const unsigned rw[4] = {rv.x, rv.y, rv.z, rv.w};
#pragma unroll
                    for (int i = 0; i < 4; ++i) {
                        const s16x2 hv2 = __builtin_bit_cast(s16x2, rw[i]); const s16x2 sg = hv2 >> 15; const unsigned kk = rw[i] ^ (__builtin_bit_cast(unsigned, sg) | 0x80008000u);
                        ka[c][2 * i] = (kk << 16) | ixc[2 * i]; ka[c][2 * i + 1] = (kk & 0xffff0000u) | ixc[2 * i + 1]; } }
#define CE6(u, i, j) do { const unsigned _a = ka[u][i], _b = ka[u][j]; ka[u][i] = _a > _b ? _a : _b; ka[u][j] = _a > _b ? _b : _a; } while (0)
#pragma unroll
                for (int u = 0; u < 4; ++u) {
                    CE6(u, 0, 1); CE6(u, 2, 3); CE6(u, 4, 5); CE6(u, 6, 7);
                    CE6(u, 0, 2); CE6(u, 1, 3); CE6(u, 4, 6); CE6(u, 5, 7);
                    CE6(u, 1, 2); CE6(u, 5, 6);
                    CE6(u, 0, 4); CE6(u, 1, 5); CE6(u, 2, 6); CE6(u, 3, 7);
                    CE6(u, 2, 4); CE6(u, 3, 5);
                    CE6(u, 1, 2); CE6(u, 3, 4); CE6(u, 5, 6);
                }
#undef CE6
                unsigned mine[4] = {0u, 0u, 0u, 0u};
                unsigned head[4], nxt[4], kptr[4] = {0u, 0u, 0u, 0u};
#pragma unroll
                for (int c = 0; c < 4; ++c) { head[c] = ka[c][0]; nxt[c] = ka[c][1];
#pragma unroll
                    for (int j = 0; j < 8; ++j) *(LAS unsigned*)(wl + kbase[c] + (j << kshift[c])) = (j < 7) ? ka[c][j + 1] : 0u; }
#pragma unroll 1
                for (int it = 0; it < 16; ++it) {
                    unsigned Wv[4]; row_max4(head[0], head[1], head[2], head[3], Wv[0], Wv[1], Wv[2], Wv[3]);
#pragma unroll
                    for (int c = 0; c < 4; ++c) {
                        const unsigned W = Wv[c];
                        mine[c] = (p16 == it) ? W : mine[c];
                        const bool win = (head[c] == W);
                        head[c] = win ? nxt[c] : head[c];
                        kptr[c] += win ? 1u : 0u;
                        nxt[c] = *(const LAS unsigned*)(wl + kbase[c] + (kptr[c] << kshift[c]));
                    }
                }
#pragma unroll
                for (int c = 0; c < 4; ++c) { const int g = 4 * (2 * qq + (c & 1)) + rg4; LAS int* A_s = (LAS int*)(wl + 3072 * (c >> 1)); LAS int* A_i = (LAS int*)(wl + 3072 * (c >> 1) + 1024);
                    const unsigned k16 = mine[c] >> 16; const unsigned hbits = k16 ^ ((k16 & 0x8000u) ? 0x8000u : 0xffffu);
                    const float fs = (float)__builtin_bit_cast(_Float16, (unsigned short)hbits);
                    A_s[g * 16 + p16] = (int)__builtin_rintf(fs * 16384.0f); A_i[g * 16 + p16] = 127 - (int)(mine[c] & 0x7fu); }
            }
            LDS_WAIT();
            {
                int av[4], bc[4]; int iav[4], ibc[4], jp[4], hh[4], bb[4]; unsigned key[4];
#pragma unroll
                for (int c = 0; c < 4; ++c) { const LAS int* A_s = (const LAS int*)(wl + 3072 * (c >> 1)); const LAS int* A_i = (const LAS int*)(wl + 3072 * (c >> 1) + 1024);
                    hh[c] = 4 * (c & 1) + rg4; bb[c] = (2 * hh[c] + 1) * 16; av[c] = A_s[(2 * hh[c]) * 16 + p16] + (1 << 20); iav[c] = A_i[(2 * hh[c]) * 16 + p16] * 128; jp[c] = 0; bc[c] = A_s[bb[c]]; ibc[c] = A_i[bb[c]];
                    key[c] = ((unsigned)(av[c] + bc[c]) << 4) | (unsigned)(15 - p16); }
#pragma unroll 1
                for (int it = 0; it < 16; ++it) {
                    unsigned Wv[4]; row_max4(key[0], key[1], key[2], key[3], Wv[0], Wv[1], Wv[2], Wv[3]);
#pragma unroll
                    for (int c = 0; c < 4; ++c) {
                        const LAS int* A_s = (const LAS int*)(wl + 3072 * (c >> 1)); const LAS int* A_i = (const LAS int*)(wl + 3072 * (c >> 1) + 1024);
                        LAS int* E_i = (LAS int*)(wl + 3072 * (c >> 1) + 2048); LAS int* E_s = (LAS int*)(wl + 3072 * (c >> 1) + 2560);
                        const bool win = (key[c] == Wv[c]);
                        if (win) { E_i[hh[c] * 16 + it] = iav[c] + ibc[c]; E_s[hh[c] * 16 + it] = av[c] + bc[c]; }
                        jp[c] += win ? 1 : 0;
                        bc[c] = A_s[bb[c] + jp[c]]; ibc[c] = A_i[bb[c] + jp[c]];
                        key[c] = ((unsigned)(av[c] + bc[c]) << 4) | (unsigned)(15 - p16);
                    }
                }
            }
            LDS_WAIT();
#pragma unroll
            for (int v = 0; v < 2; ++v) { const LAS int* E_i = (const LAS int*)(wl + 3072 * v + 2048); const LAS int* E_s = (const LAS int*)(wl + 3072 * v + 2560);
#pragma unroll
                for (int sl = 0; sl < 2; ++sl) { const int e = lane + 64 * sl; const float pe = __expf((float)(E_s[e] - E_s[e & ~15]) * (rstd[v] * (1.0f / 16384.0f))); const float den = row_sum_x(pe);
                    const int pos = 16 * (e & 7) + (e >> 3);
                    GC[(k + v) * 128 + pos] = (_Float16)(pe / den); E16[(k + v) * 128 + pos] = (unsigned short)E_i[e]; }
                if (lane == 0) RS[k + v] = rstd[v]; }
            LDS_WAIT();
        }
#define P6_LOADH(buf, TAB, jj, kk, hh) do { const u32x4 _iv = *(const LAS u32x4*)(E16 + (kk) * 128 + 16 * q8 + 8 * (hh)); const unsigned _iw[4] = {_iv.x, _iv.y, _iv.z, _iv.w}; \
            _Pragma("unroll") for (int c = 0; c < 8; ++c) { const unsigned _idx = (c & 1) ? (_iw[c >> 1] >> 16) : (_iw[c >> 1] & 0xffffu); \
                buf[c] = *(const u32x4*)((TAB) + (((size_t)(jj) * NEXP + _idx) << 7) + 16 * p8); } } while (0)
#define P6_LOADX(hb, jj, kk) do { const bf16_t* _hp = HB + (size_t)TOK6(kk) * DM + 128 * (jj) + 16 * p8; hb[0] = *(const u32x4*)_hp; hb[1] = *(const u32x4*)(_hp + 8); } while (0)
        asm volatile("s_waitcnt vmcnt(0)" ::: "memory");
        { u32x4 xr[NT6];
#pragma unroll
          for (int k = 0; k < NT6; ++k) xr[k] = *(const u32x4*)(XQ + (size_t)TOK6(k) * DM + 16 * lane);
#pragma unroll
          for (int k = 0; k < NT6; ++k) *(LAS u32x4*)(XL + k * 1024 + 16 * lane) = xr[k]; }
        LDS_WAIT();
#pragma unroll 1
        for (int rep_u = 0; rep_u < PROBE_U; ++rep_u) {
            for (int k = 0; k < NT6; ++k) { ACT[k * 128 + lane] = 0.f; ACT[k * 128 + 64 + lane] = 0.f; }
            LDS_WAIT();
            const int n16 = lane & 15, g4 = lane >> 4, c4 = lane & 3, r16 = 4 * g4 + (n16 >> 2);
            const int eoff = 2 * (16 * (r16 & 7) + (r16 >> 3));
            const bool xkeep = ((g4 >> 1) == ((n16 >> 2) & 1)); const bool klo = xkeep && (n16 < 8), khi = xkeep && (n16 >= 8);
            u32x4 bfP[16], bfQ[16];
#define P6_ULOAD(buf, nn) do { const int _j = (nn) / NT6, _k = (nn) % NT6; const LAS unsigned char* _ip = (const LAS unsigned char*)(E16 + _k * 128) + eoff; \
                _Pragma("unroll") for (int T = 0; T < 8; ++T) { const unsigned _idx = *(const LAS unsigned short*)(_ip + 4 * T); \
                    const unsigned char* _rp = UB + (((size_t)_j * NEXP + _idx) << 7) + 16 * c4; buf[2 * T] = *(const u32x4*)_rp; buf[2 * T + 1] = *(const u32x4*)(_rp + 64); } } while (0)
#define P6_PK64(lo, hi) ((long)(((unsigned long long)(hi) << 32) | (unsigned long long)(lo)))
#define P6_UMMA(buf, nn) do { const int k = (nn) % NT6; const LAS unsigned char* _xl = XL + k * 1024 + 256 * ((nn) / NT6) + 32 * c4 + 16 * (g4 & 1); \
                const u32x4 xv0 = *(const LAS u32x4*)_xl, xv1 = *(const LAS u32x4*)(_xl + 128); \
                const i32x8 xa0 = {(int)(klo ? xv0.x : 0u), (int)(klo ? xv0.y : 0u), (int)(klo ? xv0.z : 0u), (int)(klo ? xv0.w : 0u), \
                                   (int)(khi ? xv0.x : 0u), (int)(khi ? xv0.y : 0u), (int)(khi ? xv0.z : 0u), (int)(khi ? xv0.w : 0u)}; \
                const i32x8 xa1 = {(int)(klo ? xv1.x : 0u), (int)(klo ? xv1.y : 0u), (int)(klo ? xv1.z : 0u), (int)(klo ? xv1.w : 0u), \
                                   (int)(khi ? xv1.x : 0u), (int)(khi ? xv1.y : 0u), (int)(khi ? xv1.z : 0u), (int)(khi ? xv1.w : 0u)}; \
                float dsel[2] = {0.f, 0.f}; \
                _Pragma("unroll") for (int T = 0; T < 8; ++T) { f32x4 d = (f32x4){0.f, 0.f, 0.f, 0.f}; \
                    const i32x8 bb0 = {(int)buf[2 * T].x, (int)buf[2 * T].y, (int)buf[2 * T].z, (int)buf[2 * T].w, 0, 0, 0, 0}; \
                    const i32x8 bb1 = {(int)buf[2 * T + 1].x, (int)buf[2 * T + 1].y, (int)buf[2 * T + 1].z, (int)buf[2 * T + 1].w, 0, 0, 0, 0}; \
                    d = __builtin_amdgcn_mfma_scale_f32_16x16x128_f8f6f4(xa0, bb0, d, 0, 4, 0, MX_ONE, 0, MX_ONE); \
                    d = __builtin_amdgcn_mfma_scale_f32_16x16x128_f8f6f4(xa1, bb1, d, 0, 4, 0, MX_ONE, 0, MX_ONE); \
                    float pv = (c4 == 0) ? d[0] : ((c4 == 1) ? d[1] : ((c4 == 2) ? d[2] : d[3])); \
                    pv += DPPF(pv, 0xB1); pv += DPPF(pv, 0x4E);                         \
                    dsel[T >> 2] = ((T & 3) == c4) ? pv : dsel[T >> 2]; } \
                  \
                ACT[k * 128 + 16 * c4 + r16] += dsel[0]; ACT[k * 128 + 16 * (c4 + 4) + r16] += dsel[1]; } while (0)
            P6_ULOAD(bfP, 0);
#pragma unroll 1
            for (int n = 0; n < 4 * NT6; n += 2) {
                P6_ULOAD(bfQ, n + 1); asm volatile("" ::: "memory"); __builtin_amdgcn_sched_barrier(0);
                P6_UMMA(bfP, n); __builtin_amdgcn_sched_barrier(0);
                if (n + 2 < 4 * NT6) P6_ULOAD(bfP, n + 2);
                asm volatile("" ::: "memory"); __builtin_amdgcn_sched_barrier(0);
                P6_UMMA(bfQ, n + 1); __builtin_amdgcn_sched_barrier(0);
            }
#undef P6_ULOAD
#undef P6_UMMA
#undef P6_PK64
        }
        LDS_WAIT();
#pragma unroll 1
        for (int k = 0; k < NT6; ++k) {
#pragma unroll
            for (int sl = 0; sl < 2; ++sl) { const int e = lane + 64 * sl, pos = 16 * (e & 7) + (e >> 3); const float a = ACT[k * 128 + e] * (1.0f / 1024.0f);
                const float cfv = (float)GC[k * 128 + pos] * gelu_exact(a);
                CW[k * 128 + pos] = (unsigned)(__builtin_amdgcn_cvt_pk_fp8_f32(cfv * 32.0f, 0.f, 0, false) & 0xff) * 0x01010101u; E32[k * 128 + pos] = (unsigned)E16[k * 128 + pos] << 7; } }
        LDS_WAIT();
#pragma unroll 1
        for (int k = 0; k < NT6; ++k) ACT[k * 64 + lane] = 0.f;
        LDS_WAIT();
#pragma unroll 1
        for (int rep_v = 0; rep_v < PROBE_V; ++rep_v) {
            for (int k = 0; k < NT6; ++k) ACT[k * 64 + lane] = 0.f;
            LDS_WAIT();
            u32x4 bfP[16], bfQ[16];
            const int n16 = lane & 15, g4 = lane >> 4;
            const unsigned bsel = 0xffu << (8 * (n16 & 3));
            const unsigned M0 = (n16 >> 2) == 0 ? bsel : 0u, M1 = (n16 >> 2) == 1 ? bsel : 0u, M2 = (n16 >> 2) == 2 ? bsel : 0u, M3 = (n16 >> 2) == 3 ? bsel : 0u;
            const int c0 = 16 * n16 + 4 * g4;
            const unsigned loff = 8u * (unsigned)n16;
#define P6_VLOAD(buf, nn) do { const int _j = (nn) / NT6, _k = (nn) % NT6; const LAS unsigned* _ip = E32 + _k * 128 + 32 * g4; \
                const unsigned char* _tb = VB + (size_t)_j * NEXP * 128; \
                _Pragma("unroll") for (int q = 0; q < 4; ++q) { const u32x4 _o0 = *(const LAS u32x4*)(_ip + 4 * q), _o1 = *(const LAS u32x4*)(_ip + 16 + 4 * q); \
                    const unsigned _ow0[4] = {_o0.x, _o0.y, _o0.z, _o0.w}, _ow1[4] = {_o1.x, _o1.y, _o1.z, _o1.w}; \
                    _Pragma("unroll") for (int cc = 0; cc < 4; ++cc) { \
                        const u32x2 _t0 = *(const u32x2*)(_tb + (size_t)(_ow0[cc] + loff)), _t1 = *(const u32x2*)(_tb + (size_t)(_ow1[cc] + loff)); \
                        buf[4 * q + cc] = (u32x4){_t0.x, _t0.y, _t1.x, _t1.y}; } } } while (0)
#define P6_LOADR2(hb, nn) do { hb = *(const u32x2*)(HB + (size_t)TOK6((nn) % NT6) * DM + 256 * ((nn) / NT6) + c0); } while (0)
#define P6_VBODY(buf, nn, hb) do { const int j = (nn) / NT6, k = (nn) % NT6; const int t = TOK6(k); \
                const LAS unsigned* _cp = CW + k * 128 + 16 * g4; \
                const u32x4 _c0 = *(const LAS u32x4*)_cp, _c1 = *(const LAS u32x4*)(_cp + 4), _c2 = *(const LAS u32x4*)(_cp + 8), _c3 = *(const LAS u32x4*)(_cp + 12); \
                const u32x4 _d0 = *(const LAS u32x4*)(_cp + 64), _d1 = *(const LAS u32x4*)(_cp + 68), _d2 = *(const LAS u32x4*)(_cp + 72), _d3 = *(const LAS u32x4*)(_cp + 76); \
                const unsigned _cl[16] = {_c0.x, _c0.y, _c0.z, _c0.w, _c1.x, _c1.y, _c1.z, _c1.w, _c2.x, _c2.y, _c2.z, _c2.w, _c3.x, _c3.y, _c3.z, _c3.w}; \
                const unsigned _ch[16] = {_d0.x, _d0.y, _d0.z, _d0.w, _d1.x, _d1.y, _d1.z, _d1.w, _d2.x, _d2.y, _d2.z, _d2.w, _d3.x, _d3.y, _d3.z, _d3.w}; \
                f32x4 dA = (f32x4){0.f, 0.f, 0.f, 0.f}, dB = (f32x4){0.f, 0.f, 0.f, 0.f}; \
                _Pragma("unroll") for (int c = 0; c < 16; ++c) { const unsigned _l = _cl[c], _h = _ch[c]; \
                    const i32x8 av = {(int)(_l & M0), (int)(_l & M1), (int)(_l & M2), (int)(_l & M3), (int)(_h & M0), (int)(_h & M1), (int)(_h & M2), (int)(_h & M3)}; \
                    const i32x8 bv = {(int)buf[c].x, (int)buf[c].y, (int)buf[c].z, (int)buf[c].w, 0, 0, 0, 0}; \
                    if (c & 1) dB = __builtin_amdgcn_mfma_scale_f32_16x16x128_f8f6f4(av, bv, dB, 0, 4, 0, MX_ONE, 0, MX_ONE); \
                    else       dA = __builtin_amdgcn_mfma_scale_f32_16x16x128_f8f6f4(av, bv, dA, 0, 4, 0, MX_ONE, 0, MX_ONE); } \
                const float hv[4] = {bf_lo(hb.x), bf_hi(hb.x), bf_lo(hb.y), bf_hi(hb.y)}; float o[4]; float ss = 0.f; \
                _Pragma("unroll") for (int r = 0; r < 4; ++r) { o[r] = (dA[r] + dB[r]) * (1.0f / (32.0f * V4_SCALE)) + hv[r]; ss += o[r] * o[r]; } \
                *(u32x2*)(OS + (size_t)t * DM + 256 * j + c0) = (u32x2){pk2(o[0], o[1]), pk2(o[2], o[3])};     \
                ACT[k * 64 + lane] += ss; \
                } while (0)
            P6_VLOAD(bfP, 0);
#pragma unroll 1
            for (int n = 0; n < 4 * NT6; n += 2) {
                u32x2 hr0, hr1; P6_LOADR2(hr0, n); P6_LOADR2(hr1, n + 1);
                asm volatile("" ::: "memory");
                P6_VLOAD(bfQ, n + 1); asm volatile("" ::: "memory"); __builtin_amdgcn_sched_barrier(0);
                P6_VBODY(bfP, n, hr0); __builtin_amdgcn_sched_barrier(0);
                if (n + 2 < 4 * NT6) P6_VLOAD(bfP, n + 2);
                asm volatile("" ::: "memory"); __builtin_amdgcn_sched_barrier(0);
                P6_VBODY(bfQ, n + 1, hr1); __builtin_amdgcn_sched_barrier(0);
            }
            LDS_WAIT(); asm volatile("s_waitcnt vmcnt(0)" ::: "memory");
            f32x4 gfv[4];
#pragma unroll
            for (int i = 0; i < 4; ++i) gfv[i] = *(const f32x4*)(p.gfin + 256 * i + 4 * lane);
#pragma unroll 1
            for (int k = 0; k < NT6; ++k) { const float sst = wave_sum(ACT[k * 64 + lane]); const float rf = __builtin_amdgcn_rsqf(sst * (1.0f / DM) + EPS);
                float* op = p.out + (size_t)TOK6(k) * DM + 4 * lane; const bf16_t* sp = OS + (size_t)TOK6(k) * DM + 4 * lane; u32x2 ov[4];
#pragma unroll
                for (int i = 0; i < 4; ++i) ov[i] = *(const u32x2*)(sp + 256 * i);
#pragma unroll
                for (int i = 0; i < 4; ++i) *(f32x4*)(op + 256 * i) = (f32x4){bf_lo(ov[i].x), bf_hi(ov[i].x), bf_lo(ov[i].y), bf_hi(ov[i].y)} * rf * gfv[i]; }
        }
        LDS_WAIT();
    }
#undef P6_LOADH
#undef P6_LOADX
#undef P6_VLOAD
#undef P6_VBODY
#undef P6_LOADR2
#undef P6_PK64
#undef TOK6
}

#define XB_TMO      128
#define XB_XCNT(j)  (256  + 64 * (j))
#define XB_XSUB(j)  (1280 + 64 * (j))
#define XB_XGEN(j)  (2304 + 64 * (j))
#define XB_TOP      3328
#define XB_TOPGEN   3392
#define XCD_BAR_WORDS 3456
#define XB_SPIN_CAP (1u << 18)

__device__ __forceinline__ unsigned xb_ld(unsigned* p)              { return __hip_atomic_load(p, __ATOMIC_RELAXED, __HIP_MEMORY_SCOPE_AGENT); }
__device__ __forceinline__ unsigned xb_add(unsigned* p, unsigned v) { return __hip_atomic_fetch_add(p, v, __ATOMIC_RELAXED, __HIP_MEMORY_SCOPE_AGENT); }
__device__ __forceinline__ unsigned xb_xcc_id() { return (unsigned)__builtin_amdgcn_s_getreg((3 << 11) | 20) & 0xFu; }
#define XB_SPIN(cond, bar) do { unsigned _sp = 0; while (cond) { __builtin_amdgcn_s_sleep(1); \
    if ((++_sp & 255u) == 0u) { if (xb_ld(&(bar)[XB_TMO])) break; if (_sp > XB_SPIN_CAP) { atomicAdd(&(bar)[XB_TMO], 1u); break; } } } } while (0)

struct XcdBarrier {
    unsigned* bar; unsigned x;
    volatile LAS unsigned* st;
};

__device__ __forceinline__ XcdBarrier xcd_barrier_post(unsigned* bar, volatile LAS unsigned* st) {
    XcdBarrier b; b.bar = bar; b.x = xb_xcc_id(); b.st = st;
    if (threadIdx.x == 0) (void)xb_add(&bar[XB_XCNT(b.x)], 1u);
    return b;
}
__device__ __forceinline__ void xcd_barrier_complete(unsigned* bar, unsigned x, unsigned& nloc, unsigned& nx) {
    const unsigned G = gridDim.x * gridDim.y * gridDim.z;
    unsigned sum, cnt, mine, sp = 0u;
    for (;;) {
        sum = 0u; cnt = 0u; mine = 0u;
#pragma unroll
        for (unsigned j = 0; j < 16; ++j) { const unsigned c = xb_ld(&bar[XB_XCNT(j)]); sum += c; cnt += (c > 0u) ? 1u : 0u; mine = (j == x) ? c : mine; }
        if (sum == G) break;
        __builtin_amdgcn_s_sleep(1);
        if ((++sp & 255u) == 0u) { if (xb_ld(&bar[XB_TMO])) break; if (sp > XB_SPIN_CAP) { atomicAdd(&bar[XB_TMO], 1u); break; } }
    }
    nloc = mine > 0u ? mine : 1u; nx = cnt > 0u ? cnt : 1u;
}

__device__ __forceinline__ void xcd_barrier(const XcdBarrier& b) {
    asm volatile("s_waitcnt vmcnt(0)" ::: "memory");
    __syncthreads();
    if (threadIdx.x == 0) {
        unsigned* bar = b.bar;
        __builtin_amdgcn_s_waitcnt(0);
        unsigned nloc = b.st[0], nx = b.st[1];
        if (nloc == 0u) { xcd_barrier_complete(bar, b.x, nloc, nx); b.st[0] = nloc; b.st[1] = nx; }
        const unsigned old = xb_add(&bar[XB_XSUB(b.x)], 1u);
        const unsigned gen = old / nloc;
        if (old + 1u == (gen + 1u) * nloc) {
            __builtin_amdgcn_fence(__ATOMIC_RELEASE, "agent");
            asm volatile("s_waitcnt vmcnt(0)" ::: "memory");
            const unsigned og = xb_add(&bar[XB_TOP], 1u);
            const unsigned tg = og / nx;
            if (og + 1u == (tg + 1u) * nx) xb_add(&bar[XB_TOPGEN], 1u);
            else XB_SPIN(xb_ld(&bar[XB_TOPGEN]) == tg, bar);
            __builtin_amdgcn_fence(__ATOMIC_ACQUIRE, "agent");
            xb_add(&bar[XB_XGEN(b.x)], 1u);
            asm volatile("s_waitcnt vmcnt(0)" ::: "memory");
        } else {
            XB_SPIN(xb_ld(&bar[XB_XGEN(b.x)]) == gen, bar);
            __builtin_amdgcn_fence(__ATOMIC_ACQUIRE, "agent");
            asm volatile("s_waitcnt vmcnt(0)" ::: "memory");
        }
    }
    __syncthreads();
}

__global__ void __launch_bounds__(512, 2) mk_fwd(Params p) {
    extern __shared__ __attribute__((aligned(16))) unsigned char lds_raw[];
    LAS unsigned char* lds = (LAS unsigned char*)lds_raw;
    const int bid = blockIdx.x, nb = gridDim.x;
    unsigned char* ws = p.ws;
#define IN(k) (p.ph_lo <= (k) && (k) < p.ph_hi)
#define SEAM(k) do { if (IN(k) && IN((k) + 1)) { xcd_barrier(bar); } } while (0)
    if (threadIdx.x < 4) ((volatile LAS unsigned*)(lds + LDS_BYTES - 16))[threadIdx.x] = 0u;
    __syncthreads();
    const XcdBarrier bar = xcd_barrier_post((unsigned*)(ws + WS_CTL) + 4096, (volatile LAS unsigned*)(lds + LDS_BYTES - 16));
    if (IN(0)) phase0(p, lds, bid, nb);
    SEAM(0);
    if (IN(1)) {
        pg8::Gemm g{(const bf16_t*)(ws + WS_XN), (const bf16_t*)(ws + WS_WIN), MROWS, NP1, DM}; pg8::StaticOrder S; S.init(MROWS, NP1, nb, bid);
        EpiProj E{(bf16_t*)(ws + WS_PROJ), (bf16_t*)(ws + WS_QK), (_Float16*)(ws + WS_LA), p.gb, (const float2*)(ws + WS_ROPE)};
        pg8::gemm_phase<EpiProj, pg8::StaticOrder, true, true>(lds, g, S, E);
    }
    SEAM(1);
    if (IN(2)) attn_pass<false>(p, lds, bid, nb);
    SEAM(2);
    if (IN(3)) attn_pass<true>(p, lds, bid, nb);
    SEAM(3);
    if (IN(4)) {
        pg8::Gemm g{(const bf16_t*)(ws + WS_O), (const bf16_t*)(ws + WS_WOUT), NTOK, DM, DM}; pg8::StaticOrder S; S.init(NTOK, DM, nb, bid);
        EpiRes E{(bf16_t*)(ws + WS_HB), (float*)(ws + WS_SSQ), (const float*)(ws + WS_RINV), (const float*)(ws + WS_GINV)};
        pg8::gemm_phase<EpiRes, pg8::StaticOrder, true, true>(lds, g, S, E);
    }
    SEAM(4);
    if (IN(5)) {
        pg8::Gemm g{(const bf16_t*)(ws + WS_HB), (const bf16_t*)(ws + WS_WS), NTOK, 2048, DM}; pg8::StaticOrder S; S.init(NTOK, 2048, nb, bid);
        EpiF16 E{(_Float16*)(ws + WS_PROJ)};
        pg8::gemm_phase<EpiF16, pg8::StaticOrder, true, true>(lds, g, S, E);
    }
    SEAM(5);
    if (IN(6)) phase_peer2(p, lds, bid, nb);
#undef IN
#undef SEAM
}

#ifndef MK_FUSED
#define MK_FUSED 1
#endif
extern "C" void kernel_launch(void* const* d_in, const int* in_sizes, int n_in, void* d_out, int out_size, void* d_ws, size_t ws_size, hipStream_t stream) {
    static int grid = 0;
    if (grid == 0) {
        if (n_in != 16 || in_sizes[0] != NTOK * DM || out_size != NTOK * DM || ws_size < WS_END) {
            fprintf(stderr, "kernel_launch: unexpected shapes (n_in %d, in0 %d, out %d, ws %zu); nothing launched\n", n_in, n_in > 0 ? in_sizes[0] : -1, out_size, ws_size); grid = -1; return; }
        int dev = 0, cus = 0, per_cu = 0;
        hipGetDevice(&dev); hipDeviceGetAttribute(&cus, hipDeviceAttributeMultiprocessorCount, dev);
        if (hipFuncSetAttribute((const void*)mk_fwd, hipFuncAttributeMaxDynamicSharedMemorySize, LDS_BYTES) != hipSuccess) { fprintf(stderr, "kernel_launch: hipFuncSetAttribute failed\n"); grid = -1; return; }
        if (hipOccupancyMaxActiveBlocksPerMultiprocessor(&per_cu, (const void*)mk_fwd, 512, LDS_BYTES) != hipSuccess || per_cu < 1) { fprintf(stderr, "kernel_launch: occupancy query failed (%d)\n", per_cu); (void)hipGetLastError(); per_cu = 1; }
        grid = cus * (per_cu < 1 ? 1 : 1);
        fprintf(stderr, "kernel_launch: %d CUs, occupancy %d/CU, grid %d\n", cus, per_cu, grid);
    }
    if (grid < 0) return;
    (void)hipMemsetAsync((char*)d_ws + WS_CTL, 0, 65536, stream);
    Params p{};
    p.x = (const float*)d_in[0]; p.meta = (const float*)d_in[1]; p.g1 = (const float*)d_in[2]; p.w_in = (const float*)d_in[3]; p.gw2 = (const float*)d_in[4]; p.gb = (const float*)d_in[5];
    p.gla_gain = (const float*)d_in[6]; p.ret_gain = (const float*)d_in[7]; p.ret_bias = (const float*)d_in[8]; p.w_out = (const float*)d_in[9]; p.g2 = (const float*)d_in[10];
    p.w_q = (const float*)d_in[11]; p.subkeys = (const float*)d_in[12]; p.pu = (const float*)d_in[13]; p.pv = (const float*)d_in[14]; p.gfin = (const float*)d_in[15];
    p.out = (float*)d_out; p.ws = (unsigned char*)d_ws;
#if MK_FUSED
    p.ph_lo = 0; p.ph_hi = NPHASE;
    void* args[] = {&p};
    hipError_t e = hipLaunchCooperativeKernel((const void*)mk_fwd, dim3(grid), dim3(512), args, LDS_BYTES, stream);
    if (e != hipSuccess) fprintf(stderr, "kernel_launch: cooperative launch failed: %s (grid %d)\n", hipGetErrorString(e), grid);
#else
    { const int order[7] = {0, 1, 2, 3, 4, 5, 6}; for (int i = 0; i < 7; ++i) { p.ph_lo = order[i]; p.ph_hi = order[i] + 1; hipLaunchKernelGGL(mk_fwd, dim3(grid), dim3(512), LDS_BYTES, stream, p); } }
#endif
}
```

```cpp
#include <hip/hip_runtime.h>
#include <hip/hip_cooperative_groups.h>
#include <cstdio>
#include <cstdint>
namespace cg = cooperative_groups;
namespace pg8 {
#define PG8_LAS __attribute__((address_space(3)))
typedef unsigned short bf16_t;
typedef short bf16x8 __attribute__((ext_vector_type(8)));
typedef float f32x4 __attribute__((ext_vector_type(4)));
typedef unsigned u32x4 __attribute__((ext_vector_type(4)));
constexpr int BM = 256, BK = 64, HALF = 128, HTB = HALF * BK * 2  , STAGE_BYTES = 8 * HTB, NXCD = 8, WGM = 8;

__host__ __device__ __forceinline__ int lds_byte(int r, int c) { const int st = (r >> 4) * 2 + (c >> 5), rr = r & 15, cc = c & 31, ob = rr * 64 + cc * 2; return st * 1024 + (ob ^ (((ob >> 9) & 1) << 5)); }
__host__ __device__ __forceinline__ void stage_rc(int b, int& R, int& C) { const int st = b / 1024, sb = b % 1024, swz = sb ^ (((sb >> 9) & 1) << 5); R = (st >> 1) * 16 + swz / 64; C = (st & 1) * 32 + (swz % 64) / 2; }
__host__ __device__ __forceinline__ int perm32(int rho) { const int n = rho >> 4, i = rho & 15; return 8 * (i >> 2) + 4 * n + (i & 3); }

struct Unit { int pm, pn; };
struct Gemm { const bf16_t* A; const bf16_t* Bt; int M, N, K; };

struct StaticOrder {
    int nM, nN, nwg, G, c;
    __host__ __device__ void init(int M, int N, int G_, int c_) { nM = M / BM; nN = N / BM; nwg = nM * nN; G = G_; c = c_; }
    __host__ __device__ bool next(int i, Unit& u) const {
        const long L = (long)i * G + c; if (L >= nwg) return false;
        int wgid = (int)L; { const int q = nwg / NXCD, r = nwg % NXCD, xcd = wgid % NXCD, off = wgid / NXCD; wgid = (xcd < r ? xcd * (q + 1) : r * (q + 1) + (xcd - r) * q) + off; }
        const int nig = WGM * nN, gid = wgid / nig, fm = gid * WGM, gsz = (nM - fm) < WGM ? (nM - fm) : WGM;
        u.pm = fm + ((wgid % nig) % gsz); u.pn = (wgid % nig) / gsz; return true;
    }
    __device__ __forceinline__ void a_ready(const Unit&) const {}
    __device__ __forceinline__ void done(const Unit&) const {}
};

__device__ __forceinline__ unsigned cvt_pk_bf16(float lo, float hi) { unsigned r; asm volatile("v_cvt_pk_bf16_f32 %0, %1, %2" : "=v"(r) : "v"(lo), "v"(hi)); return r; }
typedef float f32x2 __attribute__((ext_vector_type(2)));
template <class Epi, class Sched, bool ALIGN_EPI = false, bool SP2 = false>
__device__ __forceinline__ void gemm_phase(PG8_LAS unsigned char* lds, const Gemm g, const Sched& S, const Epi& E) {
    const int tid = threadIdx.x, wid = __builtin_amdgcn_readfirstlane(tid >> 6), lane = tid & 63, wr = wid >> 2, wc = wid & 3, fr = lane & 15, fq = lane >> 4;
    const int K = g.K, nt = K / BK;
    unsigned voffA[2], voffB[2];
#pragma unroll
    for (int i = 0; i < 2; ++i) { int R, C; stage_rc(tid * 16 + i * 8192, R, C); const int Rb = Epi::PERM ? ((R & ~31) + perm32(R & 31)) : R;
        voffA[i] = (unsigned)(R * K + C) * 2u; voffB[i] = (unsigned)(Rb * K + C) * 2u; }
    const size_t kstep = (size_t)(BK * 2);
    const size_t hstep = (size_t)HALF * K * 2;
    const size_t tstep = 2 * hstep;
    const unsigned ldsw = (unsigned)wid * 1024u;
    const int aoff = lds_byte(wr * 64 + fr, fq * 8), boff = lds_byte(wc * 32 + fr, fq * 8);
#define PG8_SA(b, h) (((b) * 2 + (h)) * HTB)
#define PG8_SB(b, h) ((4 + (b) * 2 + (h)) * HTB)
#define PG8_STAGE(bufoff, gbase, voff) do { _Pragma("unroll") for (int _i = 0; _i < 2; ++_i) \
        __builtin_amdgcn_global_load_lds((const unsigned*)((const char*)(gbase) + (voff)[_i]), (PG8_LAS unsigned*)(lds + (bufoff) + ldsw + _i * 8192), 16, 0, 0); } while (0)
#define PG8_LDA(dst, b, h) do { _Pragma("unroll") for (int m = 0; m < 4; ++m) _Pragma("unroll") for (int k = 0; k < 2; ++k) dst[m][k] = *(const PG8_LAS bf16x8*)(lds + PG8_SA(b, h) + aoff + m * 2048 + k * 1024); } while (0)
#define PG8_LDB(dst, b, h) do { _Pragma("unroll") for (int n = 0; n < 2; ++n) _Pragma("unroll") for (int k = 0; k < 2; ++k) dst[n][k] = *(const PG8_LAS bf16x8*)(lds + PG8_SB(b, h) + boff + n * 2048 + k * 1024); } while (0)
#define PG8_MMA(ai, bj, At, Bt) do { __builtin_amdgcn_s_setprio(1); _Pragma("unroll") for (int m = 0; m < 4; ++m) _Pragma("unroll") for (int n = 0; n < 2; ++n) _Pragma("unroll") for (int k = 0; k < 2; ++k) \
        acc[ai][bj][m][n] = __builtin_amdgcn_mfma_f32_16x16x32_bf16(Bt[n][k], At[m][k], acc[ai][bj][m][n], 0, 0, 0); __builtin_amdgcn_s_setprio(0); } while (0)
#define PG8_WAIT_V(n) asm volatile("s_waitcnt vmcnt(" #n ")" ::: "memory")
#define PG8_WAIT_L(n) asm volatile("s_waitcnt lgkmcnt(" #n ")" ::: "memory")
#define PG8_BAR __builtin_amdgcn_s_barrier()
#define PG8_SCHED __builtin_amdgcn_sched_barrier(0)
    Unit cur, nxt; int ui = 0;
    if (!S.next(0, cur)) return;
    f32x4 acc[2][2][4][2];
#pragma unroll
    for (int a = 0; a < 2; ++a)
#pragma unroll
        for (int b = 0; b < 2; ++b)
#pragma unroll
            for (int m = 0; m < 4; ++m)
#pragma unroll
                for (int n = 0; n < 2; ++n) acc[a][b][m][n] = (f32x4){0.f, 0.f, 0.f, 0.f};
    bf16x8 At[4][2], B0[2][2], B1[2][2];
    const char* cA = (const char*)g.A + (size_t)cur.pm * tstep; const char* cB = (const char*)g.Bt + (size_t)cur.pn * tstep;
    S.a_ready(cur);
    if constexpr (SP2) {
        PG8_STAGE(PG8_SB(0, 0), cB, voffB); PG8_STAGE(PG8_SB(0, 1), cB + hstep, voffB); PG8_STAGE(PG8_SA(0, 0), cA, voffA); PG8_STAGE(PG8_SA(0, 1), cA + hstep, voffA);
        if (wr == 1) PG8_BAR;
        PG8_WAIT_V(2); PG8_BAR;
        PG8_STAGE(PG8_SB(1, 0), cB + kstep, voffB); PG8_STAGE(PG8_SA(1, 0), cA + kstep, voffA); PG8_STAGE(PG8_SB(1, 1), cB + hstep + kstep, voffB);
        PG8_WAIT_V(6); PG8_BAR;
    } else {
        PG8_STAGE(PG8_SB(0, 0), cB, voffB); PG8_STAGE(PG8_SA(0, 0), cA, voffA); PG8_STAGE(PG8_SB(0, 1), cB + hstep, voffB); PG8_STAGE(PG8_SA(0, 1), cA + hstep, voffA);
        if (wr == 1) PG8_BAR;
        PG8_WAIT_V(4); PG8_BAR;
        PG8_STAGE(PG8_SB(1, 0), cB + kstep, voffB); PG8_STAGE(PG8_SA(1, 0), cA + kstep, voffA); PG8_STAGE(PG8_SB(1, 1), cB + hstep + kstep, voffB);
        PG8_WAIT_V(6); PG8_BAR;
    }
    for (;;) {
        const bool has_next = S.next(ui + 1, nxt);
        const char* nA = has_next ? (const char*)g.A + (size_t)nxt.pm * tstep : cA; const char* nB = has_next ? (const char*)g.Bt + (size_t)nxt.pn * tstep : cB;
        for (int t = 0; t < nt; t += 2) {
            const bool last = (t == nt - 2);
            const char* a1 = cA + (size_t)(t + 1) * kstep;
            const char* a2 = last ? nA : cA + (size_t)(t + 2) * kstep; const char* b2 = last ? nB : cB + (size_t)(t + 2) * kstep;
            const char* a3 = a2 + kstep; const char* b3 = b2 + kstep;
            if (last && has_next) S.a_ready(nxt);
            if constexpr (SP2) {
            PG8_LDB(B0, 0, 0); PG8_LDB(B1, 0, 1); PG8_SCHED; PG8_LDA(At, 0, 0); PG8_STAGE(PG8_SA(1, 1), a1 + hstep, voffA);
            PG8_WAIT_V(8); PG8_WAIT_L(0); PG8_BAR; PG8_MMA(0, 0, At, B0); PG8_MMA(0, 1, At, B1); PG8_BAR; PG8_SCHED;
            PG8_LDA(At, 0, 1); PG8_STAGE(PG8_SB(0, 0), b2, voffB); PG8_STAGE(PG8_SB(0, 1), b2 + hstep, voffB); PG8_STAGE(PG8_SA(0, 0), a2, voffA);
            PG8_WAIT_V(8); PG8_WAIT_L(0); PG8_BAR; PG8_MMA(1, 0, At, B0); PG8_MMA(1, 1, At, B1); PG8_BAR; PG8_SCHED;
            PG8_LDB(B0, 1, 0); PG8_LDB(B1, 1, 1); PG8_SCHED; PG8_LDA(At, 1, 0); PG8_STAGE(PG8_SA(0, 1), a2 + hstep, voffA);
            PG8_WAIT_V(8); PG8_WAIT_L(0); PG8_BAR; PG8_MMA(0, 0, At, B0); PG8_MMA(0, 1, At, B1); PG8_BAR; PG8_SCHED;
            PG8_LDA(At, 1, 1); PG8_STAGE(PG8_SB(1, 0), b3, voffB); PG8_STAGE(PG8_SB(1, 1), b3 + hstep, voffB); PG8_STAGE(PG8_SA(1, 0), a3, voffA);
            PG8_WAIT_V(8); PG8_WAIT_L(0); PG8_BAR; PG8_MMA(1, 0, At, B0); PG8_MMA(1, 1, At, B1); PG8_BAR; PG8_SCHED;
            } else {
            PG8_LDB(B0, 0, 0); PG8_SCHED; PG8_LDA(At, 0, 0); PG8_STAGE(PG8_SA(1, 1), a1 + hstep, voffA);
            PG8_WAIT_L(8); PG8_BAR; PG8_WAIT_L(0); PG8_MMA(0, 0, At, B0); PG8_BAR; PG8_SCHED;
            PG8_LDB(B1, 0, 1); PG8_STAGE(PG8_SB(0, 0), b2, voffB);
            PG8_BAR; PG8_WAIT_L(0); PG8_MMA(0, 1, At, B1); PG8_BAR;
            PG8_LDA(At, 0, 1); PG8_STAGE(PG8_SA(0, 0), a2, voffA);
            PG8_BAR; PG8_WAIT_L(0); PG8_MMA(1, 0, At, B0); PG8_BAR; PG8_SCHED;
            PG8_STAGE(PG8_SB(0, 1), b2 + hstep, voffB);
            PG8_WAIT_V(6); PG8_BAR; PG8_MMA(1, 1, At, B1); PG8_BAR;
            PG8_LDB(B0, 1, 0); PG8_SCHED; PG8_LDA(At, 1, 0); PG8_STAGE(PG8_SA(0, 1), a2 + hstep, voffA);
            PG8_WAIT_L(8); PG8_BAR; PG8_WAIT_L(0); PG8_MMA(0, 0, At, B0); PG8_BAR; PG8_SCHED;
            PG8_LDB(B1, 1, 1); PG8_STAGE(PG8_SB(1, 0), b3, voffB);
            PG8_BAR; PG8_WAIT_L(0); PG8_MMA(0, 1, At, B1); PG8_BAR;
            PG8_LDA(At, 1, 1); PG8_STAGE(PG8_SA(1, 0), a3, voffA);
            PG8_BAR; PG8_WAIT_L(0); PG8_MMA(1, 0, At, B0); PG8_BAR; PG8_SCHED;
            PG8_STAGE(PG8_SB(1, 1), b3 + hstep, voffB);
            PG8_WAIT_V(6); PG8_BAR; PG8_MMA(1, 1, At, B1); PG8_BAR;
            }
        }
        if constexpr (ALIGN_EPI) { if (wr == 0) PG8_BAR; }
        if constexpr (!Epi::AFTER_DRAIN) { E(acc, cur, wr, wc, fr, fq); S.done(cur); }
        if (!has_next) break;
#pragma unroll
        for (int a = 0; a < 2; ++a)
#pragma unroll
            for (int b = 0; b < 2; ++b)
#pragma unroll
                for (int m = 0; m < 4; ++m)
#pragma unroll
                    for (int n = 0; n < 2; ++n) acc[a][b][m][n] = (f32x4){0.f, 0.f, 0.f, 0.f};
        cur = nxt; cA = nA; cB = nB; ++ui;
        if constexpr (ALIGN_EPI) { if (wr == 1) PG8_BAR; }
    }
    PG8_WAIT_V(0);
    if constexpr (!ALIGN_EPI) { if (wr == 0) PG8_BAR; }
    PG8_BAR;
    if constexpr (Epi::AFTER_DRAIN) { E.fused(acc, cur, wr, wc, fr, fq, lds, wid, lane); S.done(cur); }
#undef PG8_SA
#undef PG8_SB
#undef PG8_STAGE
#undef PG8_LDA
#undef PG8_LDB
#undef PG8_MMA
#undef PG8_WAIT_V
#undef PG8_WAIT_L
#undef PG8_BAR
#undef PG8_SCHED
}
}

#define LAS __attribute__((address_space(3)))
typedef unsigned short bf16_t;
typedef float f32x4 __attribute__((ext_vector_type(4)));
typedef unsigned u32x4 __attribute__((ext_vector_type(4)));
typedef unsigned u32x2 __attribute__((ext_vector_type(2)));
typedef int i32x8 __attribute__((ext_vector_type(8)));
typedef short s16x2 __attribute__((ext_vector_type(2)));
#ifndef TAB_P0_PCT
#define TAB_P0_PCT 47
#endif
#define MX_ONE 0x7f7f7f7f
#define V4_SCALE 5.656854f
typedef short bf16x8 __attribute__((ext_vector_type(8)));
typedef short s16x4 __attribute__((ext_vector_type(4)));
typedef __bf16 bf16x2_t __attribute__((ext_vector_type(2)));
typedef _Float16 f16x2_t __attribute__((ext_vector_type(2)));
typedef float f32x2v __attribute__((ext_vector_type(2)));
typedef _Float16 h2v __attribute__((ext_vector_type(2)));

constexpr int DM = 1024, NB = 4, SEQ = 8192, NTOK = NB * SEQ;
constexpr int MROWS = NTOK + 256;
constexpr int INW = 3088;
constexpr int NPROJ = 3072, NP1 = 3328;
constexpr int NEXP = 16384;
constexpr float EPS = 1e-6f;
constexpr int C_GQ = 0, C_GK = 256, C_GV = 512, C_GG = 1024, C_RQ = 1536, C_RK = 1792, C_RV = 2048, C_RG = 2560;
constexpr int S_GA = 1536, S_RQ = 1552, S_RV = 2064;

constexpr int NVG = 2048;
constexpr int NCH = (NTOK + 256) / 64;
constexpr size_t QK_ARR = (size_t)NCH * 4 * 8 * 64 * 8;
constexpr size_t MiB = 1u << 20;
constexpr size_t WS_CTL = 0, WS_WIN = 1 * MiB, WS_WOUT = 8 * MiB, WS_WS = 10 * MiB, WS_ROPE = 14 * MiB, WS_SSQ = 17 * MiB, WS_SEG = 19 * MiB, WS_ASEG = 27 * MiB,
                 WS_PROJ = 28 * MiB, WS_O = 157 * MiB, WS_LA = 221 * MiB, WS_UB = 254 * MiB, WS_VB = 286 * MiB, WS_XN = 318 * MiB, WS_QK = 383 * MiB, WS_XQ = 448 * MiB, WS_END = 480 * MiB;
static_assert(WS_WIN + (size_t)NP1 * DM * 2 <= WS_WOUT && WS_ROPE + (size_t)(SEQ + 64) * 32 * 8 <= WS_SSQ && WS_XN + (size_t)MROWS * DM * 2 <= WS_QK &&
              WS_LA + QK_ARR * 4 <= WS_UB && WS_PROJ + (size_t)MROWS * NVG * 2 <= WS_O && WS_QK + 4 * QK_ARR * 2 <= WS_XQ && WS_PROJ + (size_t)256 * 2048 * 2 + (size_t)NTOK * 2048 * 2 <= WS_O &&
              WS_UB + 32 * MiB <= WS_VB && WS_VB + 32 * MiB <= WS_XN, "ws map");

constexpr size_t WS_SC = WS_PROJ + (size_t)256 * 2048 * 2;
constexpr size_t WS_HB = WS_XN + (size_t)256 * DM * 2;
constexpr size_t WS_RINV = WS_CTL + 131072, WS_GINV = WS_CTL + 262144;
constexpr int LDS_BYTES = 147456;
constexpr int NPHASE = 7;
#ifndef PROBE_R
#define PROBE_R 1
#define PROBE_U 1
#define PROBE_V 1
#endif
#ifndef PEER_FP8
#define PEER_FP8 1
#endif

struct Params {
    const float *x, *meta, *g1, *w_in, *gw2, *gb, *gla_gain, *ret_gain, *ret_bias, *w_out, *g2, *w_q, *subkeys, *pu, *pv, *gfin;
    float* out; unsigned char* ws;
    int ph_lo, ph_hi;
};

#define LDS_WAIT() asm volatile("s_waitcnt lgkmcnt(0)" ::: "memory")
__device__ __forceinline__ unsigned pk2(float lo, float hi) { const bf16x2_t v = {(__bf16)lo, (__bf16)hi}; return __builtin_bit_cast(unsigned, v); }
__device__ __forceinline__ unsigned f2bf(float f) { return (unsigned)__builtin_bit_cast(unsigned short, (__bf16)f); }

__device__ __forceinline__ float bf_lo(unsigned w) { return __builtin_bit_cast(float, w << 16); }
__device__ __forceinline__ float bf_hi(unsigned w) { return __builtin_bit_cast(float, w & 0xffff0000u); }
__device__ __forceinline__ float bf1(bf16_t h) { return __builtin_bit_cast(float, (unsigned)h << 16); }
#define WS_DPP_ADD(v, ctrl) ((v) + __builtin_bit_cast(float, __builtin_amdgcn_update_dpp(0, __builtin_bit_cast(int, (v)), (ctrl), 0xf, 0xf, true)))
__device__ __forceinline__ float wave_sum(float v) {
    v = WS_DPP_ADD(v, 0xB1); v = WS_DPP_ADD(v, 0x4E); v = WS_DPP_ADD(v, 0x124); v = WS_DPP_ADD(v, 0x128);
    const int iv = __builtin_bit_cast(int, v);
    const float r0 = __builtin_bit_cast(float, __builtin_amdgcn_readlane(iv, 0)), r1 = __builtin_bit_cast(float, __builtin_amdgcn_readlane(iv, 16));
    const float r2 = __builtin_bit_cast(float, __builtin_amdgcn_readlane(iv, 32)), r3 = __builtin_bit_cast(float, __builtin_amdgcn_readlane(iv, 48));
    return (r0 + r1) + (r2 + r3);
}

struct MapIn {
    __device__ __forceinline__ void operator()(int j, int& src, float& sc) const {
        if (j < C_RQ) { src = j; sc = (j < 256) ? 0.125f : 1.0f; }
        else if (j < C_RV) { const int jj = j - C_RQ, which = jj >> 8, within = jj & 255, head = within >> 6, p = within & 63;
            const int a = p >> 3, n = (p >> 2) & 1, i = p & 3; src = S_RQ + which * 256 + head * 64 + 32 * n + 4 * a + i; sc = which ? 0.125f : 1.0f; }
        else { src = S_RV + (j - C_RV); sc = 1.0f; }
    }
};
struct MapId { __device__ __forceinline__ void operator()(int j, int& src, float& sc) const { src = j; sc = 1.0f; } };

template <class Map>
__device__ __forceinline__ void transpose_item(const float* W, int K, int N, bf16_t* WT, LAS float* scr, int item, int nblk, int lane, const Map map) {
    const int kb = item / nblk, nb = item % nblk, k0 = 64 * kb, n0 = 32 * nb;
    int src; float sc; map(n0 + (lane & 31), src, sc);
#pragma unroll 8
    for (int i = 0; i < 32; ++i) { const int kk = 2 * i + (lane >> 5); scr[kk * 33 + (lane & 31)] = W[(size_t)(k0 + kk) * N + src] * sc; }
    LDS_WAIT();
    const int c = lane & 7;
#pragma unroll
    for (int j = 0; j < 4; ++j) { const int n = (lane >> 3) + 8 * j; const LAS float* s = scr + (8 * c) * 33 + n;
        u32x4 o; o.x = pk2(s[0 * 33], s[1 * 33]); o.y = pk2(s[2 * 33], s[3 * 33]); o.z = pk2(s[4 * 33], s[5 * 33]); o.w = pk2(s[6 * 33], s[7 * 33]);
        *(u32x4*)(WT + (size_t)(n0 + n) * K + k0 + 8 * c) = o; }
    LDS_WAIT();
}

__device__ __forceinline__ void convert_tables(const Params& p, int wt, int nwt, int e_lo, int e_hi) {
    unsigned char* ws = p.ws;
    u32x4* U4 = (u32x4*)(ws + WS_UB); u32x4* V4 = (u32x4*)(ws + WS_VB);
    for (int e = e_lo + wt; e < e_hi; e += nwt) {
        const f32x4* us = (const f32x4*)p.pu + 8 * (size_t)e; const f32x4* vs = (const f32x4*)p.pv + 8 * (size_t)e;
        const f32x4* g2s = (const f32x4*)p.g2 + 8 * (e & 31);
        unsigned tu[4], tv[4];
#pragma unroll
        for (int j = 0; j < 4; ++j) { const f32x4 a0 = us[2 * j] * g2s[2 * j] * 64.0f, a1 = us[2 * j + 1] * g2s[2 * j + 1] * 64.0f;
            const f32x4 b0 = vs[2 * j] * V4_SCALE, b1 = vs[2 * j + 1] * V4_SCALE;
            unsigned w = 0u, x = 0u;
            w = __builtin_amdgcn_cvt_scalef32_pk_fp4_f32(w, a0[0], a0[1], 1.0f, 0); w = __builtin_amdgcn_cvt_scalef32_pk_fp4_f32(w, a0[2], a0[3], 1.0f, 1);
            w = __builtin_amdgcn_cvt_scalef32_pk_fp4_f32(w, a1[0], a1[1], 1.0f, 2); w = __builtin_amdgcn_cvt_scalef32_pk_fp4_f32(w, a1[2], a1[3], 1.0f, 3); tu[j] = w;
            x = __builtin_amdgcn_cvt_scalef32_pk_fp4_f32(x, b0[0], b0[1], 1.0f, 0); x = __builtin_amdgcn_cvt_scalef32_pk_fp4_f32(x, b0[2], b0[3], 1.0f, 1);
            x = __builtin_amdgcn_cvt_scalef32_pk_fp4_f32(x, b1[0], b1[1], 1.0f, 2); x = __builtin_amdgcn_cvt_scalef32_pk_fp4_f32(x, b1[2], b1[3], 1.0f, 3); tv[j] = x; }
        const int row = e >> 5, c32 = e & 31;
        const size_t dst = ((size_t)(c32 >> 3) * NEXP + row) * 8 + (c32 & 7);
        U4[dst] = (u32x4){tu[0], tu[1], tu[2], tu[3]}; V4[dst] = (u32x4){tv[0], tv[1], tv[2], tv[3]}; }
}
__device__ __forceinline__ void convert_tables_stream(const Params& p, int ww, int nww, int rp_lo, int rp_hi) {
    unsigned char* ws = p.ws; const int lane = threadIdx.x & 63;
    unsigned* U4 = (unsigned*)(ws + WS_UB); unsigned* V4 = (unsigned*)(ws + WS_VB);
    const f32x4 g2v[4] = {((const f32x4*)p.g2)[lane], ((const f32x4*)p.g2)[64 + lane], ((const f32x4*)p.g2)[128 + lane], ((const f32x4*)p.g2)[192 + lane]};
    for (int rp0 = rp_lo + 2 * ww; rp0 < rp_hi; rp0 += 2 * nww) {
        f32x4 a[2][8], b[2][8];
#pragma unroll
        for (int h = 0; h < 2; ++h) { const int rp = min(rp0 + h, rp_hi - 1); const f32x4* us = (const f32x4*)p.pu + (size_t)rp * 512 + lane; const f32x4* vs = (const f32x4*)p.pv + (size_t)rp * 512 + lane;
#pragma unroll
            for (int i = 0; i < 8; ++i) { a[h][i] = us[64 * i]; b[h][i] = vs[64 * i]; } }
#pragma unroll
        for (int h = 0; h < 2; ++h) { const int rp = rp0 + h; if (rp >= rp_hi) continue;
#pragma unroll
            for (int i = 0; i < 8; ++i) { const f32x4 av = a[h][i] * g2v[i & 3] * 64.0f, bv = b[h][i] * V4_SCALE;
                unsigned w = 0u, x = 0u;
                w = __builtin_amdgcn_cvt_scalef32_pk_fp4_f32(w, av[0], av[1], 1.0f, 0); w = __builtin_amdgcn_cvt_scalef32_pk_fp4_f32(w, av[2], av[3], 1.0f, 1);
                x = __builtin_amdgcn_cvt_scalef32_pk_fp4_f32(x, bv[0], bv[1], 1.0f, 0); x = __builtin_amdgcn_cvt_scalef32_pk_fp4_f32(x, bv[2], bv[3], 1.0f, 1);
                const unsigned wn = (unsigned)__builtin_amdgcn_update_dpp(0, (int)w, 0xB1, 0xf, 0xf, true), xn = (unsigned)__builtin_amdgcn_update_dpp(0, (int)x, 0xB1, 0xf, 0xf, true);
                if (!(lane & 1)) { const size_t dst = ((size_t)(i & 3) * NEXP + 2 * rp + (i >> 2)) * 32 + (lane >> 1);
                    U4[dst] = (w & 0xffffu) | (wn << 16); V4[dst] = (x & 0xffffu) | (xn << 16); } } }
    }
}
constexpr int TAB_CHUNKS = NEXP * DM / 32;
__device__ __forceinline__ int gemm1_workers(int nb) { const int tiles = (MROWS / 256) * (NP1 / 256); const int side = 16;
    return (nb > side && (tiles + nb - 1) / nb == (tiles + (nb - side) - 1) / (nb - side)) ? nb - side : nb; }
__device__ __forceinline__ int tab_split(int nb) { return gemm1_workers(nb) < nb ? ((int)((long)TAB_CHUNKS * TAB_P0_PCT / 100) & ~63) : TAB_CHUNKS; }

__device__ __forceinline__ void phase0(const Params& p, LAS unsigned char* lds, int bid, int nb) {
    const int tid = threadIdx.x, lane = tid & 63, wave = __builtin_amdgcn_readfirstlane(tid >> 6);
    unsigned char* ws = p.ws;
    bf16_t* XN = (bf16_t*)(ws + WS_XN); bf16_t* WinT = (bf16_t*)(ws + WS_WIN); bf16_t* WoutT = (bf16_t*)(ws + WS_WOUT); bf16_t* WsT = (bf16_t*)(ws + WS_WS);
    const int gw = bid * 8 + wave, NGW = nb * 8;
    const int gt = bid * 512 + tid, NGT = nb * 512;

#pragma unroll 1
    for (int ti = 0; ti < 4; ++ti) { const int task = (bid & 1) ? 3 - ti : ti;
    if (task == 0) {
    {
        LAS float* SKT = (LAS float*)lds;
        LAS float* WQT = (LAS float*)(lds + 128 * 132 * 4);
        for (int item = bid; item < 256; item += nb) {
            const int hc = item >> 4, kb = item & 15;
            __syncthreads();
            for (int e0 = tid; e0 < 128 * 128; e0 += 8 * 512) { float tv[8];
#pragma unroll
                for (int i = 0; i < 8; ++i) tv[i] = p.subkeys[(size_t)hc * 16384 + e0 + 512 * i];
#pragma unroll
                for (int i = 0; i < 8; ++i) { const int e = e0 + 512 * i, n = e >> 7, d = e & 127; SKT[d * 132 + n] = tv[i]; } }
            for (int e0 = tid; e0 < 64 * 128; e0 += 8 * 512) { float tv[8];
#pragma unroll
                for (int i = 0; i < 8; ++i) { const int e = e0 + 512 * i, k = e >> 7, d = e & 127; tv[i] = p.w_q[(size_t)(kb * 64 + k) * 2048 + hc * 128 + d]; }
#pragma unroll
                for (int i = 0; i < 8; ++i) { const int e = e0 + 512 * i, k = e >> 7, d = e & 127; WQT[d * 68 + k] = tv[i]; } }
            __syncthreads();
            const int tn = tid & 31, tk = tid >> 5;
            f32x4 acc[4];
#pragma unroll
            for (int i = 0; i < 4; ++i) acc[i] = (f32x4){0.f, 0.f, 0.f, 0.f};
#pragma unroll 4
            for (int d = 0; d < 128; ++d) {
                const f32x4 sk = *(const LAS f32x4*)(SKT + d * 132 + 4 * tn); const f32x4 wq = *(const LAS f32x4*)(WQT + d * 68 + 4 * tk);
#pragma unroll
                for (int i = 0; i < 4; ++i) acc[i] += sk[i] * wq;
            }
            const f32x4 gg = *(const f32x4*)(p.g2 + kb * 64 + 4 * tk);
#pragma unroll
            for (int i = 0; i < 4; ++i) { const f32x4 v = acc[i] * gg; u32x2 o; o.x = pk2(v[0], v[1]); o.y = pk2(v[2], v[3]);
                *(u32x2*)(WsT + (size_t)(hc * 128 + 4 * tn + i) * DM + kb * 64 + 4 * tk) = o; }
        }
        __syncthreads();
    }
    {
        LAS float* scr = (LAS float*)(lds + wave * 16384);
        constexpr int I_IN = (DM / 64) * (NPROJ / 32), I_OUT = (DM / 64) * (DM / 32);
        for (int it = gw; it < I_IN + I_OUT; it += NGW) {
            if (it < I_IN) transpose_item(p.w_in, DM, INW, WinT, scr, it, NPROJ / 32, lane, MapIn());
            else transpose_item(p.w_out, DM, DM, WoutT, scr, it - I_IN, DM / 32, lane, MapId());
        }
    }
    for (int e = gt; e < 256 * DM; e += NGT) {
        const int n = e >> 10, k = e & 1023; const float* wr = p.w_in + (size_t)k * INW + S_GA; float s = 0.f;
#pragma unroll
        for (int r = 0; r < 16; ++r) s += wr[r] * p.gw2[r * 256 + n];
        WinT[(size_t)(NPROJ + n) * DM + k] = (bf16_t)f2bf(s);
    }
    } else if (task == 1) {
#if PEER_FP8
    convert_tables(p, gt, NGT, 0, tab_split(nb));
#else
    {
        u32x2* UB = (u32x2*)(ws + WS_UB); u32x2* VB = (u32x2*)(ws + WS_VB);
        const f32x4* u4 = (const f32x4*)p.pu; const f32x4* v4 = (const f32x4*)p.pv;
        for (int e = gt; e < NEXP * DM / 4; e += NGT) { const f32x4 a = u4[e]; u32x2 o; o.x = pk2(a[0], a[1]); o.y = pk2(a[2], a[3]); UB[e] = o;
            const f32x4 b = v4[e]; u32x2 q; q.x = pk2(b[0], b[1]); q.y = pk2(b[2], b[3]); VB[e] = q; }
    }
#endif
    } else if (task == 2) {
    if (gt < DM) ((float*)(ws + WS_GINV))[gt] = 1.0f / p.g1[gt];
    {
        float2* rope = (float2*)(ws + WS_ROPE);
        for (int e = gt; e < (SEQ + 64) * 32; e += NGT) { const int pi = e >> 5, d = e & 31;
            const float invf = (float)pow(10000.0, -(double)d / 32.0); const float ang = (float)(pi - 48) * invf;
            rope[e] = make_float2((float)cos((double)ang), (float)sin((double)ang)); }
    }
    } else {
    for (int m0 = gw; m0 < MROWS; m0 += 4 * NGW) {
        const float* srcp[4]; f32x4 v[4][4];
#pragma unroll
        for (int u = 0; u < 4; ++u) { const int m = m0 + u * NGW; srcp[u] = nullptr;
            if (m < MROWS) { if (m >= 256) srcp[u] = p.x + (size_t)(m - 256) * DM; else if (m >= 48 && m < 64) srcp[u] = p.meta + (size_t)(m - 48) * DM; }
            if (srcp[u] != nullptr) { const f32x4* xr = (const f32x4*)srcp[u] + lane;
#pragma unroll
                for (int j = 0; j < 4; ++j) v[u][j] = xr[64 * j]; }
            else {
#pragma unroll
                for (int j = 0; j < 4; ++j) v[u][j] = (f32x4){0.f, 0.f, 0.f, 0.f}; } }
        f32x4 gg[4];
#pragma unroll
        for (int j = 0; j < 4; ++j) gg[j] = ((const f32x4*)p.g1 + lane)[64 * j];
#pragma unroll
        for (int u = 0; u < 4; ++u) { const int m = m0 + u * NGW; if (m >= MROWS) continue;
            float s = 0.f;
#pragma unroll
            for (int j = 0; j < 4; ++j) s += (v[u][j].x * v[u][j].x + v[u][j].y * v[u][j].y) + (v[u][j].z * v[u][j].z + v[u][j].w * v[u][j].w);
            const float r = (srcp[u] != nullptr) ? __builtin_amdgcn_rsqf(wave_sum(s) * (1.0f / DM) + EPS) : 0.f;
            if (lane == 0 && m >= 256) ((float*)(ws + WS_RINV))[m - 256] = 1.0f / r;
            unsigned long long* o8 = (unsigned long long*)(XN + (size_t)m * DM) + lane;
#pragma unroll
            for (int j = 0; j < 4; ++j) { const f32x4 y = v[u][j] * r * gg[j]; o8[64 * j] = (unsigned long long)pk2(y.x, y.y) | ((unsigned long long)pk2(y.z, y.w) << 32); } }
    }
    } }
}

struct EpiProj {
    static constexpr bool PERM = true, AFTER_DRAIN = false;
    bf16_t* VG; bf16_t* QK; _Float16* LAT; const float* gb; const float2* rope;
    __device__ __forceinline__ static size_t tile_off(int r, int head, int dg) { return ((((size_t)(r >> 6) * 4 + head) * 8 + dg) * 64 + (r & 63)) * 8; }
    __device__ __forceinline__ void operator()(const pg8::f32x4 (&acc)[2][2][4][2], const pg8::Unit& u, int wr, int wc, int fr, int fq) const {
        const int row0 = u.pm * 256 + wr * 64 + fr, cb0 = wc * 32 + 8 * fq;
        if (u.pn == 12) {
            f32x4 gbv[2][2];
#pragma unroll
            for (int bj = 0; bj < 2; ++bj) { gbv[bj][0] = *(const f32x4*)(gb + cb0 + 128 * bj); gbv[bj][1] = *(const f32x4*)(gb + cb0 + 128 * bj + 4); }
#pragma unroll
            for (int bj = 0; bj < 2; ++bj) { const int c = cb0 + 128 * bj; const f32x4 b0 = gbv[bj][0], b1 = gbv[bj][1];
#pragma unroll
                for (int ai = 0; ai < 2; ++ai)
#pragma unroll
                    for (int m = 0; m < 4; ++m) { const int row = row0 + ai * 128 + m * 16; f32x4 v0 = acc[ai][bj][m][0] + b0, v1 = acc[ai][bj][m][1] + b1;
#pragma unroll
                        for (int i = 0; i < 4; ++i) {
                            v0[i] = (fminf(v0[i], 0.f) - 0.6931471806f * __builtin_amdgcn_logf(1.0f + __builtin_amdgcn_exp2f(-1.4426950409f * fabsf(v0[i])))) * 0.0625f;
                            v1[i] = (fminf(v1[i], 0.f) - 0.6931471806f * __builtin_amdgcn_logf(1.0f + __builtin_amdgcn_exp2f(-1.4426950409f * fabsf(v1[i])))) * 0.0625f; }
                        const f16x2_t h0 = {(_Float16)v0[0], (_Float16)v0[1]}, h1 = {(_Float16)v0[2], (_Float16)v0[3]}, h2 = {(_Float16)v1[0], (_Float16)v1[1]}, h3 = {(_Float16)v1[2], (_Float16)v1[3]};
                        *(u32x4*)(LAT + tile_off(row, c >> 6, (c & 63) >> 3)) = (u32x4){__builtin_bit_cast(unsigned, h0), __builtin_bit_cast(unsigned, h1), __builtin_bit_cast(unsigned, h2), __builtin_bit_cast(unsigned, h3)}; } }
        } else if (u.pn == 6 || u.pn == 7) {
            bf16_t* QA = QK + (size_t)(u.pn - 4) * QK_ARR;
            f32x4 rp[4][2][2]; u32x4 wq[4][2];
#define RP_LOAD(ai) do { _Pragma("unroll") for (int m = 0; m < 4; ++m) { const int row = row0 + (ai) * 128 + m * 16; const int pidx = (row < 256) ? row : 64 + ((row - 256) & (SEQ - 1)); \
                _Pragma("unroll") for (int bj = 0; bj < 2; ++bj) { const int c = cb0 + 128 * bj, d0 = (c & 63) >> 1; \
                    rp[m][bj][0] = *(const f32x4*)(rope + (size_t)pidx * 32 + d0); rp[m][bj][1] = *(const f32x4*)(rope + (size_t)pidx * 32 + d0 + 2); } } } while (0)
#define RP_COMP(ai) do { _Pragma("unroll") for (int m = 0; m < 4; ++m) _Pragma("unroll") for (int bj = 0; bj < 2; ++bj) { const f32x4 cs0 = rp[m][bj][0], cs1 = rp[m][bj][1]; \
                    const f32x4 t1 = acc[ai][bj][m][0], t2 = acc[ai][bj][m][1]; \
                    const float co[4] = {cs0[0], cs0[2], cs1[0], cs1[2]}, si[4] = {cs0[1], cs0[3], cs1[1], cs1[3]}; float o1[4], o2[4]; \
                    _Pragma("unroll") for (int i = 0; i < 4; ++i) { o1[i] = t1[i] * co[i] - t2[i] * si[i]; o2[i] = t1[i] * si[i] + t2[i] * co[i]; } \
                    u32x4 w; w.x = pg8::cvt_pk_bf16(o1[0], o1[1]); w.y = pg8::cvt_pk_bf16(o1[2], o1[3]); w.z = pg8::cvt_pk_bf16(o2[0], o2[1]); w.w = pg8::cvt_pk_bf16(o2[2], o2[3]); wq[m][bj] = w; } } while (0)
#define RP_STORE(ai) do { _Pragma("unroll") for (int m = 0; m < 4; ++m) { const int row = row0 + (ai) * 128 + m * 16; \
                _Pragma("unroll") for (int bj = 0; bj < 2; ++bj) { const int c = cb0 + 128 * bj; *(u32x4*)(QA + tile_off(row, c >> 6, (c & 63) >> 3)) = wq[m][bj]; } } } while (0)
            RP_LOAD(0); asm volatile("" ::: "memory");
            RP_COMP(0);
            RP_LOAD(1); asm volatile("" ::: "memory");
            RP_STORE(0); asm volatile("" ::: "memory");
            RP_COMP(1);
            RP_STORE(1);
#undef RP_LOAD
#undef RP_COMP
#undef RP_STORE
        } else if (u.pn <= 1) {
            bf16_t* QA = QK + (size_t)u.pn * QK_ARR;
#pragma unroll
            for (int ai = 0; ai < 2; ++ai)
#pragma unroll
                for (int m = 0; m < 4; ++m) { const int row = row0 + ai * 128 + m * 16;
#pragma unroll
                    for (int bj = 0; bj < 2; ++bj) { const int c = cb0 + 128 * bj; const f32x4 v0 = acc[ai][bj][m][0], v1 = acc[ai][bj][m][1];
                        u32x4 w; w.x = pg8::cvt_pk_bf16(v0[0], v0[1]); w.y = pg8::cvt_pk_bf16(v0[2], v0[3]); w.z = pg8::cvt_pk_bf16(v1[0], v1[1]); w.w = pg8::cvt_pk_bf16(v1[2], v1[3]);
                        *(u32x4*)(QA + tile_off(row, c >> 6, (c & 63) >> 3)) = w; } }
        } else {
            const int cdst = (u.pn < 6 ? (u.pn - 2) : (u.pn - 4)) * 256;
#pragma unroll
            for (int ai = 0; ai < 2; ++ai)
#pragma unroll
                for (int m = 0; m < 4; ++m) { bf16_t* rowp = VG + (size_t)(row0 + ai * 128 + m * 16) * NVG + cdst + cb0;
#pragma unroll
                    for (int bj = 0; bj < 2; ++bj) { const f32x4 v0 = acc[ai][bj][m][0], v1 = acc[ai][bj][m][1];
                        u32x4 w; w.x = pg8::cvt_pk_bf16(v0[0], v0[1]); w.y = pg8::cvt_pk_bf16(v0[2], v0[3]); w.z = pg8::cvt_pk_bf16(v1[0], v1[1]); w.w = pg8::cvt_pk_bf16(v1[2], v1[3]);
                        *(u32x4*)(rowp + bj * 128) = w; } }
        }
    }
};
struct EpiRes {
    static constexpr bool PERM = true, AFTER_DRAIN = false;
    bf16_t* HB; float* SSQ; const float* RINV; const float* GINV;
    __device__ __forceinline__ void operator()(const pg8::f32x4 (&acc)[2][2][4][2], const pg8::Unit& u, int wr, int wc, int fr, int fq) const {
        const int row0 = u.pm * 256 + wr * 64 + fr, col0 = u.pn * 256 + wc * 32 + 8 * fq;
        f32x4 gi[2][2];
#pragma unroll
        for (int bj = 0; bj < 2; ++bj) { gi[bj][0] = *(const f32x4*)(GINV + col0 + bj * 128); gi[bj][1] = *(const f32x4*)(GINV + col0 + bj * 128 + 4); }
        u32x4 xq[2][4][2]; float rq[2][4]; u32x4 wq[4][2];
#define ER_LOAD(ai) do { _Pragma("unroll") for (int m = 0; m < 4; ++m) { const int row = row0 + (ai) * 128 + m * 16; const bf16_t* hr = HB + (size_t)row * DM + col0; rq[ai][m] = RINV[row]; \
            _Pragma("unroll") for (int bj = 0; bj < 2; ++bj) xq[ai][m][bj] = *(const u32x4*)(hr + bj * 128); } } while (0)
#define ER_COMP(ai) do { _Pragma("unroll") for (int m = 0; m < 4; ++m) { float ss = 0.f; const float ri = rq[ai][m]; \
            _Pragma("unroll") for (int bj = 0; bj < 2; ++bj) { const u32x4 xn = xq[ai][m][bj]; \
                const f32x4 x0 = (f32x4){bf_lo(xn.x), bf_hi(xn.x), bf_lo(xn.y), bf_hi(xn.y)} * ri * gi[bj][0], x1 = (f32x4){bf_lo(xn.z), bf_hi(xn.z), bf_lo(xn.w), bf_hi(xn.w)} * ri * gi[bj][1]; \
                const f32x4 v0 = acc[ai][bj][m][0] + x0, v1 = acc[ai][bj][m][1] + x1; \
                ss += (v0[0] * v0[0] + v0[1] * v0[1]) + (v0[2] * v0[2] + v0[3] * v0[3]) + (v1[0] * v1[0] + v1[1] * v1[1]) + (v1[2] * v1[2] + v1[3] * v1[3]); \
                u32x4 w; w.x = pg8::cvt_pk_bf16(v0[0], v0[1]); w.y = pg8::cvt_pk_bf16(v0[2], v0[3]); w.z = pg8::cvt_pk_bf16(v1[0], v1[1]); w.w = pg8::cvt_pk_bf16(v1[2], v1[3]); wq[m][bj] = w; } \
            ss += __shfl_xor(ss, 16); ss += __shfl_xor(ss, 32); \
            { const int row = row0 + (ai) * 128 + m * 16; if (fq == 0) SSQ[((size_t)(row >> 4) * 16 + u.pn * 4 + wc) * 16 + (row & 15)] = ss; } } } while (0)
#define ER_STORE(ai) do { _Pragma("unroll") for (int m = 0; m < 4; ++m) { const int row = row0 + (ai) * 128 + m * 16; bf16_t* hr = HB + (size_t)row * DM + col0; \
            _Pragma("unroll") for (int bj = 0; bj < 2; ++bj) *(u32x4*)(hr + bj * 128) = wq[m][bj]; } } while (0)
        ER_LOAD(0); asm volatile("" ::: "memory");
        ER_COMP(0);
        ER_LOAD(1); asm volatile("" ::: "memory");
        ER_STORE(0); asm volatile("" ::: "memory");
        ER_COMP(1);
        ER_STORE(1);
#undef ER_LOAD
#undef ER_COMP
#undef ER_STORE
    }
};
struct EpiF16 {
    static constexpr bool PERM = true, AFTER_DRAIN = false;
    _Float16* SC;
    __device__ __forceinline__ void operator()(const pg8::f32x4 (&acc)[2][2][4][2], const pg8::Unit& u, int wr, int wc, int fr, int fq) const {
        const int row0 = u.pm * 256 + wr * 64 + fr, col0 = u.pn * 256 + wc * 32 + 8 * fq;
#pragma unroll
        for (int ai = 0; ai < 2; ++ai)
#pragma unroll
            for (int m = 0; m < 4; ++m) { _Float16* rowp = SC + (size_t)(row0 + ai * 128 + m * 16) * 2048 + col0;
#pragma unroll
                for (int bj = 0; bj < 2; ++bj) { const f32x4 v0 = acc[ai][bj][m][0], v1 = acc[ai][bj][m][1];
                    u32x4 w;
                    w.x = __builtin_bit_cast(unsigned, (f16x2_t){(_Float16)v0[0], (_Float16)v0[1]}); w.y = __builtin_bit_cast(unsigned, (f16x2_t){(_Float16)v0[2], (_Float16)v0[3]});
                    w.z = __builtin_bit_cast(unsigned, (f16x2_t){(_Float16)v1[0], (_Float16)v1[1]}); w.w = __builtin_bit_cast(unsigned, (f16x2_t){(_Float16)v1[2], (_Float16)v1[3]});
                    { unsigned* wp = (unsigned*)&w;
#pragma unroll
                      for (int e = 0; e < 4; ++e) { const s16x2 sg = __builtin_bit_cast(s16x2, wp[e]) >> 15; wp[e] ^= (__builtin_bit_cast(unsigned, sg) | 0x80008000u); } }
                    *(u32x4*)(rowp + bj * 128) = w; } }
    }
};

constexpr int A_QT = 0, A_KT = 9216, A_KE = 18432, A_V = 27648, A_ST = 45056, A_STSZ = 18432, A_OB = 81920, A_DEC = 115712, A_CS = 115968;
constexpr int PQ = 72, PV = 136, POB = 132;

__device__ __forceinline__ bf16x8 tr2(const LAS bf16_t* p0, const LAS bf16_t* p1) {
    const s16x4 a = __builtin_amdgcn_ds_read_tr16_b64_v4i16((LAS s16x4*)p0), b = __builtin_amdgcn_ds_read_tr16_b64_v4i16((LAS s16x4*)p1);
    return (bf16x8){a[0], a[1], a[2], a[3], b[0], b[1], b[2], b[3]};
}
__device__ __forceinline__ float ln_gamma(int hr) { return log1pf(-exp2f(-5.0f - (float)hr)); }

template <bool FULL>
__device__ __forceinline__ void attn_pass(const Params& p, LAS unsigned char* lds, int bid, int nb, int vitem = -1) {
    const int tid = threadIdx.x, lane = tid & 63, wave = __builtin_amdgcn_readfirstlane(tid >> 6);
    const int r16 = lane & 15, g4 = lane >> 4, q4 = (lane & 15) >> 2, p4 = lane & 3;
    unsigned char* ws = p.ws;
    const bf16_t* PROJ = (const bf16_t*)(ws + WS_PROJ); const _Float16* LA = (const _Float16*)(ws + WS_LA); const bf16_t* QK = (const bf16_t*)(ws + WS_QK);
    float* SEG = (float*)(ws + WS_SEG); float* ASEG = (float*)(ws + WS_ASEG); float* SEGM = (float*)(ws + WS_ASEG + 65536); bf16_t* OUT = (bf16_t*)(ws + WS_O);
    LAS bf16_t* QT = (LAS bf16_t*)(lds + A_QT); LAS bf16_t* KT = (LAS bf16_t*)(lds + A_KT); LAS bf16_t* KE = (LAS bf16_t*)(lds + A_KE); LAS bf16_t* VS = (LAS bf16_t*)(lds + A_V);
    LAS float* OB = (LAS float*)(lds + A_OB); LAS float* DEC = (LAS float*)(lds + A_DEC); LAS float* CS = (LAS float*)(lds + A_CS);

    for (int item0 = bid; item0 < 256; item0 += nb) { const int item = (vitem >= 0) ? vitem : item0;
        const int seg = item & 7, h8 = (item >> 3) & 7, b = item >> 6;
        const bool metaitem = !FULL && seg == 7 && b == 0;
        if (!FULL && seg == 7 && !metaitem) continue;
        const bool gla = h8 < 4; const int hr = h8 & 3;
        const float lng = ln_gamma(hr);
        const bf16_t* QAq = QK + (size_t)(gla ? 0 : 2) * QK_ARR; const bf16_t* QAk = QK + (size_t)(gla ? 1 : 3) * QK_ARR;
        const int vcol = (gla ? 0 : 1024) + hr * 128, gcol = (gla ? 512 : 1536) + hr * 128;
        const int nch = metaitem ? 1 : 16;

        f32x4 accS[8];
#pragma unroll
        for (int cb = 0; cb < 8; ++cb) accS[cb] = (f32x4){0.f, 0.f, 0.f, 0.f};
        float blsum[8] = {0.f, 0.f, 0.f, 0.f, 0.f, 0.f, 0.f, 0.f};
        __syncthreads();
        if (FULL) {
            if (wave >= 4) {
                const int wq = wave - 4;
                { const f32x4* Sm = (const f32x4*)(SEGM + (size_t)h8 * 8192) + (wq * 8) * 64 + lane;
#pragma unroll
                  for (int cb = 0; cb < 8; ++cb) accS[cb] = Sm[cb * 64]; }
                f32x4 nx[8], nd = (f32x4){0.f, 0.f, 0.f, 0.f};
#pragma unroll
                for (int cb = 0; cb < 8; ++cb) nx[cb] = (f32x4){0.f, 0.f, 0.f, 0.f};
#define A_LOADSUM(sp_) do { const int _it2 = (item & ~7) + (sp_); const f32x4* _sg = (const f32x4*)(SEG + (size_t)_it2 * 8192) + (wq * 8) * 64 + lane; \
                    nd = *(const f32x4*)(ASEG + _it2 * 64 + 16 * wq + 4 * g4); _Pragma("unroll") for (int cb = 0; cb < 8; ++cb) nx[cb] = _sg[cb * 64]; } while (0)
                if (seg > 0) A_LOADSUM(0);
                for (int sp = 0; sp < seg; ++sp) { f32x4 cur[8]; const f32x4 dec = nd;
#pragma unroll
                    for (int cb = 0; cb < 8; ++cb) cur[cb] = nx[cb];
                    if (sp + 1 < seg) A_LOADSUM(sp + 1);
#pragma unroll
                    for (int cb = 0; cb < 8; ++cb) accS[cb] = dec * accS[cb] + cur[cb]; }
#undef A_LOADSUM
                LAS bf16_t* ST0 = (LAS bf16_t*)(lds + A_ST);
#pragma unroll
                for (int cb = 0; cb < 8; ++cb) { u32x2 w; w.x = pk2(accS[cb][0], accS[cb][1]); w.y = pk2(accS[cb][2], accS[cb][3]); *(LAS u32x2*)(ST0 + (16 * cb + r16) * PQ + 16 * wq + 4 * g4) = w; }
            }
        }
#define A_ROWBASE(ci_) (metaitem ? 0 : 256 + b * SEQ + (16 * seg + (ci_)) * 64)
        u32x4 lav8; u32x4 qv8, kv8; u32x4 vreg[2];
        qv8 = (u32x4){0u, 0u, 0u, 0u};
#define A_LOADCHUNK(ci_) do { const int _rb = A_ROWBASE(ci_); \
            const size_t _to = ((((size_t)(_rb >> 6) * 4 + hr) * 8 + wave) * 64 + lane) * 8;       \
            lav8 = *(const u32x4*)(LA + (gla ? _to : (size_t)(8 * lane)));       \
            if (FULL) qv8 = *(const u32x4*)(QAq + _to); \
            kv8 = *(const u32x4*)(QAk + _to); \
            { const int vr = tid >> 3, cc = tid & 7; const u32x4* src = (const u32x4*)(PROJ + (size_t)(_rb + vr) * NVG + vcol + cc * 16); vreg[0] = src[0]; vreg[1] = src[1]; } } while (0)
#define A_LBAR() do { asm volatile("s_waitcnt lgkmcnt(0)" ::: "memory"); __builtin_amdgcn_s_barrier(); asm volatile("" ::: "memory"); } while (0)
        A_LOADCHUNK(0);
        f32x4 gnv[4], bsv[4];
        { const float* gptr = (gla ? p.gla_gain : p.ret_gain) + 16 * (tid & 7); const float* bptr = p.ret_bias + 16 * (tid & 7); const float bsc = gla ? 0.f : 1.f;
#pragma unroll
          for (int k4 = 0; k4 < 4; ++k4) { gnv[k4] = *(const f32x4*)(gptr + 4 * k4); bsv[k4] = *(const f32x4*)(bptr + 4 * k4) * bsc; } }
        for (int ci = 0; ci < nch; ++ci) {
            const bool metac = metaitem;
            const int rowbase = A_ROWBASE(ci);
            const LAS bf16_t* STr = (const LAS bf16_t*)(lds + A_ST + (ci & 1) * A_STSZ); LAS bf16_t* STw = (LAS bf16_t*)(lds + A_ST + ((ci + 1) & 1) * A_STSZ);
            u32x4 gpre[2] = {(u32x4){0u, 0u, 0u, 0u}, (u32x4){0u, 0u, 0u, 0u}};
            if (FULL && !metac) { const u32x4* gp = (const u32x4*)(PROJ + (size_t)(rowbase + (tid >> 3)) * NVG + gcol + 16 * (tid & 7)); gpre[0] = gp[0]; gpre[1] = gp[1]; }
            {
                float bc[8];
                const unsigned lw[4] = {lav8.x, lav8.y, lav8.z, lav8.w};
#pragma unroll
                for (int c = 0; c < 8; ++c) { float v = gla ? (float)__builtin_bit_cast(_Float16, (unsigned short)((c & 1) ? (lw[c >> 1] >> 16) : (lw[c >> 1] & 0xffffu))) : lng;
                    v += __builtin_bit_cast(float, __builtin_amdgcn_update_dpp(0, __builtin_bit_cast(int, v), 0x111, 0xf, 0xf, true));
                    v += __builtin_bit_cast(float, __builtin_amdgcn_update_dpp(0, __builtin_bit_cast(int, v), 0x112, 0xf, 0xf, true));
                    v += __builtin_bit_cast(float, __builtin_amdgcn_update_dpp(0, __builtin_bit_cast(int, v), 0x114, 0xf, 0xf, true));
                    v += __builtin_bit_cast(float, __builtin_amdgcn_update_dpp(0, __builtin_bit_cast(int, v), 0x118, 0xf, 0xf, true));
                    v += __builtin_bit_cast(float, __builtin_amdgcn_update_dpp(0, __builtin_bit_cast(int, v), 0x142, 0xa, 0xf, false));
                    v += __builtin_bit_cast(float, __builtin_amdgcn_update_dpp(0, __builtin_bit_cast(int, v), 0x143, 0xc, 0xf, false));
                    bc[c] = v; }
                float tot[8];
#pragma unroll
                for (int c = 0; c < 8; ++c) { tot[c] = __builtin_bit_cast(float, __builtin_amdgcn_readlane(__builtin_bit_cast(int, bc[c]), 63)); blsum[c] += tot[c]; }
                const unsigned qw[4] = {qv8.x, qv8.y, qv8.z, qv8.w}, kw[4] = {kv8.x, kv8.y, kv8.z, kv8.w};
                unsigned oq[4], ok[4], oe[4];
#pragma unroll
                for (int c2 = 0; c2 < 4; ++c2) { const float k0 = bf_lo(kw[c2]), k1 = bf_hi(kw[c2]);
                    if (FULL) { oq[c2] = pk2(bf_lo(qw[c2]) * __expf(bc[2 * c2]), bf_hi(qw[c2]) * __expf(bc[2 * c2 + 1])); ok[c2] = pk2(k0 * __expf(-bc[2 * c2]), k1 * __expf(-bc[2 * c2 + 1])); }
                    oe[c2] = pk2(k0 * __expf(tot[2 * c2] - bc[2 * c2]), k1 * __expf(tot[2 * c2 + 1] - bc[2 * c2 + 1])); }
                if (FULL) { *(LAS u32x4*)(QT + lane * PQ + 8 * wave) = (u32x4){oq[0], oq[1], oq[2], oq[3]}; *(LAS u32x4*)(KT + lane * PQ + 8 * wave) = (u32x4){ok[0], ok[1], ok[2], ok[3]}; }
                *(LAS u32x4*)(KE + lane * PQ + 8 * wave) = (u32x4){oe[0], oe[1], oe[2], oe[3]};
                if (lane == 63) { *(LAS f32x4*)(DEC + 8 * wave) = (f32x4){__expf(tot[0]), __expf(tot[1]), __expf(tot[2]), __expf(tot[3])};
                                  *(LAS f32x4*)(DEC + 8 * wave + 4) = (f32x4){__expf(tot[4]), __expf(tot[5]), __expf(tot[6]), __expf(tot[7])}; }
                const int vr = tid >> 3, cc = tid & 7; LAS u32x4* dst = (LAS u32x4*)(VS + vr * PV + cc * 16); dst[0] = vreg[0]; dst[1] = vreg[1];
            }
            A_LOADCHUNK(min(ci + 1, nch - 1));
            A_LBAR();
            if (wave < 4) {
                if (FULL && !metac) {
                    const int w = wave;
                    bf16x8 qf[2];
#pragma unroll
                    for (int s = 0; s < 2; ++s) qf[s] = *(const LAS bf16x8*)(QT + (16 * w + r16) * PQ + 32 * s + 8 * g4);
                    f32x4 att[4];
#pragma unroll
                    for (int jb = 0; jb < 4; ++jb) { att[jb] = (f32x4){0.f, 0.f, 0.f, 0.f};
                        if (jb <= w) {
#pragma unroll
                            for (int s = 0; s < 2; ++s) { const bf16x8 kf = *(const LAS bf16x8*)(KT + (16 * jb + r16) * PQ + 32 * s + 8 * g4);
                                att[jb] = __builtin_amdgcn_mfma_f32_16x16x32_bf16(kf, qf[s], att[jb], 0, 0, 0); }
                            if (jb == w) {
#pragma unroll
                                for (int rg = 0; rg < 4; ++rg) att[jb][rg] = (4 * g4 + rg <= r16) ? att[jb][rg] : 0.f;
                            }
                        } }
                    bf16x8 af[2];
#pragma unroll
                    for (int s = 0; s < 2; ++s) { u32x4 t; t.x = pk2(att[2 * s][0], att[2 * s][1]); t.y = pk2(att[2 * s][2], att[2 * s][3]); t.z = pk2(att[2 * s + 1][0], att[2 * s + 1][1]); t.w = pk2(att[2 * s + 1][2], att[2 * s + 1][3]);
                        af[s] = __builtin_bit_cast(bf16x8, t); }
#pragma unroll
                    for (int cb = 0; cb < 8; ++cb) { f32x4 o = (f32x4){0.f, 0.f, 0.f, 0.f};
#pragma unroll
                        for (int s = 0; s < 2; ++s) {
                            const bf16x8 vf = tr2(VS + (32 * s + 4 * g4 + q4) * PV + 16 * cb + 4 * p4, VS + (32 * s + 16 + 4 * g4 + q4) * PV + 16 * cb + 4 * p4);
                            o = __builtin_amdgcn_mfma_f32_16x16x32_bf16(vf, af[s], o, 0, 0, 0);
                            const bf16x8 sf = *(const LAS bf16x8*)(STr + (16 * cb + r16) * PQ + 32 * s + 8 * g4);
                            o = __builtin_amdgcn_mfma_f32_16x16x32_bf16(sf, qf[s], o, 0, 0, 0); }
                        *(LAS f32x4*)(OB + (16 * w + r16) * POB + 16 * cb + 4 * g4) = o; }
                }
            } else {
                const int wq = wave - 4;
                float dec[4];
#pragma unroll
                for (int rg = 0; rg < 4; ++rg) dec[rg] = DEC[16 * wq + 4 * g4 + rg];
                bf16x8 kef[2];
#pragma unroll
                for (int s = 0; s < 2; ++s) kef[s] = tr2(KE + (32 * s + 8 * g4 + q4) * PQ + 16 * wq + 4 * p4, KE + (32 * s + 8 * g4 + 4 + q4) * PQ + 16 * wq + 4 * p4);
#pragma unroll
                for (int cb = 0; cb < 8; ++cb) {
#pragma unroll
                    for (int rg = 0; rg < 4; ++rg) accS[cb][rg] *= dec[rg];
#pragma unroll
                    for (int s = 0; s < 2; ++s) { const bf16x8 vf = tr2(VS + (32 * s + 8 * g4 + q4) * PV + 16 * cb + 4 * p4, VS + (32 * s + 8 * g4 + 4 + q4) * PV + 16 * cb + 4 * p4);
                        accS[cb] = __builtin_amdgcn_mfma_f32_16x16x32_bf16(kef[s], vf, accS[cb], 0, 0, 0); }
                    if (FULL) { u32x2 w; w.x = pk2(accS[cb][0], accS[cb][1]); w.y = pk2(accS[cb][2], accS[cb][3]); *(LAS u32x2*)(STw + (16 * cb + r16) * PQ + 16 * wq + 4 * g4) = w; }
                }
            }
            A_LBAR();
            if (FULL && !metac) {
                const int i = tid >> 3, cc = tid & 7;
                float o[16];
#pragma unroll
                for (int k4 = 0; k4 < 4; ++k4) { const f32x4 t = *(const LAS f32x4*)(OB + i * POB + 16 * cc + 4 * k4); o[4 * k4] = t[0]; o[4 * k4 + 1] = t[1]; o[4 * k4 + 2] = t[2]; o[4 * k4 + 3] = t[3]; }
                const size_t row = (size_t)(rowbase + i);
                const u32x4 ga = gpre[0], gb2 = gpre[1];
                const unsigned gw[8] = {ga.x, ga.y, ga.z, ga.w, gb2.x, gb2.y, gb2.z, gb2.w};
                float s1 = 0.f, s2 = 0.f;
#pragma unroll
                for (int k = 0; k < 16; ++k) { s1 += o[k]; s2 += o[k] * o[k]; }
                s1 = WS_DPP_ADD(s1, 0xB1); s2 = WS_DPP_ADD(s2, 0xB1); s1 = WS_DPP_ADD(s1, 0x4E); s2 = WS_DPP_ADD(s2, 0x4E); s1 = WS_DPP_ADD(s1, 0x141); s2 = WS_DPP_ADD(s2, 0x141);
                const float mu = gla ? 0.f : s1 * (1.0f / 128.0f);
                const float rs = __builtin_amdgcn_rsqf(fmaxf(s2 * (1.0f / 128.0f) - mu * mu, 0.f) + EPS);
                unsigned ow[8];
#pragma unroll
                for (int k2 = 0; k2 < 8; ++k2) { float y[2];
#pragma unroll
                    for (int e = 0; e < 2; ++e) { const int k = 2 * k2 + e; const float v = (o[k] - mu) * rs * gnv[k >> 2][k & 3] + bsv[k >> 2][k & 3];
                        const float gt = e ? bf_hi(gw[k2]) : bf_lo(gw[k2]); y[e] = v * gt * __builtin_amdgcn_rcpf(1.0f + __expf(-gt)); }
                    ow[k2] = pk2(y[0], y[1]); }
                u32x4* op = (u32x4*)(OUT + (row - 256) * DM + h8 * 128 + 16 * cc);
                op[0] = (u32x4){ow[0], ow[1], ow[2], ow[3]}; op[1] = (u32x4){ow[4], ow[5], ow[6], ow[7]};
            }
        }
        if (!FULL) {
            if (wave >= 4) { const int wq = wave - 4; f32x4* Sg = (f32x4*)(metaitem ? SEGM + (size_t)h8 * 8192 : SEG + (size_t)item * 8192) + (wq * 8) * 64 + lane;
#pragma unroll
                for (int cb = 0; cb < 8; ++cb) Sg[cb * 64] = accS[cb]; }
            if (lane < 8 && !metaitem) { float bl = blsum[0];
#pragma unroll
                for (int c = 1; c < 8; ++c) bl = (lane == c) ? blsum[c] : bl;
                ASEG[item * 64 + 8 * wave + lane] = __expf(bl); }
        }
#undef A_LBAR
#undef A_ROWBASE
#undef A_LOADCHUNK
    }
}

__device__ __forceinline__ unsigned ord32(float f) { const unsigned b = __builtin_bit_cast(unsigned, f); return b ^ ((b >> 31) ? 0xffffffffu : 0x80000000u); }
__device__ __forceinline__ float unord32(unsigned o) { const unsigned b = (o >> 31) ? (o ^ 0x80000000u) : ~o; return __builtin_bit_cast(float, b); }
#define DPP_MAXU(v, ctrl, rmask) do { const unsigned _t = (unsigned)__builtin_amdgcn_update_dpp((int)(v), (int)(v), (ctrl), (rmask), 0xf, false); (v) = (v) > _t ? (v) : _t; } while (0)
#define DPP_ADDF(v, ctrl) do { const float _t = __builtin_bit_cast(float, __builtin_amdgcn_update_dpp(0, __builtin_bit_cast(int, (v)), (ctrl), 0xf, 0xf, false)); (v) += _t; } while (0)
__device__ __forceinline__ unsigned row_max_u(unsigned v) { DPP_MAXU(v, 0xB1, 0xf); DPP_MAXU(v, 0x4E, 0xf); DPP_MAXU(v, 0x124, 0xf); DPP_MAXU(v, 0x128, 0xf); return v; }
__device__ __forceinline__ float row_sum_f(float v) { DPP_ADDF(v, 0xB1); DPP_ADDF(v, 0x4E); DPP_ADDF(v, 0x124); DPP_ADDF(v, 0x128); return v; }
__device__ __forceinline__ unsigned wave_max_u(unsigned v) { v = row_max_u(v); DPP_MAXU(v, 0x142, 0xa); DPP_MAXU(v, 0x143, 0xc); return (unsigned)__builtin_amdgcn_readlane((int)v, 63); }

__device__ __forceinline__ float row_sum_x(float v) { return row_sum_f(v); }
__device__ __forceinline__ float dot2_bf16(unsigned w, unsigned x, float acc) { return __builtin_amdgcn_fdot2_f32_bf16(__builtin_bit_cast(bf16x2_t, w), __builtin_bit_cast(bf16x2_t, x), acc, false); }
__device__ __forceinline__ float gelu_exact(float v) { return 0.5f * v * (1.0f + erff(v * 0.70710678118654752f)); }

__device__ __forceinline__ void phase_peer(const Params& p, LAS unsigned char* lds, int bid, int nb) {
    const int tid = threadIdx.x, lane = tid & 63, wave = __builtin_amdgcn_readfirstlane(tid >> 6);
    const int p16 = lane & 15, rg4 = lane >> 4;
    unsigned char* ws = p.ws;
    const _Float16* SC = (const _Float16*)(ws + WS_SC); const bf16_t* HB = (const bf16_t*)(ws + WS_HB); const float* SSQ = (const float*)(ws + WS_SSQ);
    const unsigned char* UB = (const unsigned char*)(ws + WS_UB); const unsigned char* VB = (const unsigned char*)(ws + WS_VB);
    LAS float* A_s = (LAS float*)(lds + wave * 4096);
    LAS int* A_i = (LAS int*)(lds + wave * 4096 + 1024);
    LAS int* E_i = (LAS int*)(lds + wave * 4096 + 2048);
    LAS float* E_s = (LAS float*)(lds + wave * 4096 + 2560);
    int ci = 0, cj = 0; bool cvalid = lane < 50;
    { int l = lane;
      if (l < 16) { ci = 0; cj = l; } else if (l < 24) { ci = 1; cj = l - 16; } else if (l < 29) { ci = 2; cj = l - 24; } else if (l < 33) { ci = 3; cj = l - 29; }
      else if (l < 36) { ci = 4; cj = l - 33; } else if (l < 42) { ci = 5 + (l - 36) / 2; cj = (l - 36) & 1; } else { ci = 8 + (l - 42); cj = 0; } if (!cvalid) { ci = 0; cj = 0; } }
    const int gw = bid * 8 + wave, NGW = nb * 8;
    for (int t = gw; t < NTOK; t += NGW) {
        float ssq = (lane < 16) ? SSQ[((size_t)(t >> 4) * 16 + lane) * 16 + (t & 15)] : 0.f; ssq = wave_sum(ssq);
        const float rstd = 1.0f / sqrtf(ssq * (1.0f / DM) + EPS);
#pragma unroll 1
        for (int q = 0; q < 4; ++q) {
            const u32x4 raw = *(const u32x4*)(SC + (size_t)t * 2048 + 512 * q + 8 * lane);
            const unsigned rw[4] = {raw.x, raw.y, raw.z, raw.w};
            unsigned key[8];
#pragma unroll
            for (int e = 0; e < 8; ++e) { const unsigned hbits = (e & 1) ? (rw[e >> 1] >> 16) : (rw[e >> 1] & 0xffffu);
                const float f = (float)__builtin_bit_cast(_Float16, (unsigned short)hbits);
                key[e] = (ord32(f) & ~0x7fu) | (unsigned)(127 - (8 * p16 + e)); }
            unsigned mine = 0u;
#pragma unroll 1
            for (int it = 0; it < 16; ++it) {
                unsigned m = key[0];
#pragma unroll
                for (int e = 1; e < 8; ++e) m = m > key[e] ? m : key[e];
                const unsigned W = row_max_u(m);
                mine = (p16 == it) ? W : mine;
#pragma unroll
                for (int e = 0; e < 8; ++e) key[e] = (key[e] == W) ? 0u : key[e];
            }
            const int g = 4 * q + rg4;
            A_s[g * 16 + p16] = unord32(mine & ~0x7fu); A_i[g * 16 + p16] = 127 - (int)(mine & 0x7fu);
        }
        LDS_WAIT();
#pragma unroll 1
        for (int h = 0; h < 8; ++h) {
            const float sa = A_s[(2 * h) * 16 + ci], sb = A_s[(2 * h + 1) * 16 + cj];
            const int ia = A_i[(2 * h) * 16 + ci], ib = A_i[(2 * h + 1) * 16 + cj];
            const float sum = sa + sb;
            unsigned key = cvalid ? ((ord32(sum) & ~0x3fu) | (unsigned)(63 - lane)) : 0u;
            int rank = -1;
#pragma unroll 1
            for (int it = 0; it < 16; ++it) { const unsigned W = wave_max_u(key); if (key == W) { rank = it; key = 0u; } }
            if (rank >= 0) { E_i[h * 16 + rank] = ia * 128 + ib; E_s[h * 16 + rank] = sum; }
        }
        LDS_WAIT();
        float gsm[2]; int eidx[2];
#pragma unroll
        for (int sl = 0; sl < 2; ++sl) { const int e = lane + 64 * sl; const float s = E_s[e] * rstd, mx = E_s[e & ~15] * rstd; const float pe = __expf(s - mx); const float den = row_sum_x(pe);
            gsm[sl] = pe / den; eidx[sl] = E_i[e]; }
#if PEER_FP8
        f32x2v xf[4][8];
#pragma unroll
        for (int i = 0; i < 4; ++i) { const u32x4 h0 = *(const u32x4*)(HB + (size_t)t * DM + 256 * i + 16 * p16), h1 = *(const u32x4*)(HB + (size_t)t * DM + 256 * i + 16 * p16 + 8);
            const unsigned hv[8] = {h0.x, h0.y, h0.z, h0.w, h1.x, h1.y, h1.z, h1.w}; const float* gp = p.g2 + 256 * i + 16 * p16;
#pragma unroll
            for (int k2 = 0; k2 < 8; ++k2) { const f32x2v g = *(const f32x2v*)(gp + 2 * k2); xf[i][k2] = (f32x2v){bf_lo(hv[k2]) * rstd * g.x, bf_hi(hv[k2]) * rstd * g.y}; } }
        constexpr int NBB = 2;
#define P6_LOADB(buf, TAB, bt0) do { _Pragma("unroll") for (int j = 0; j < NBB; ++j) { const int bt = (bt0) + j; const int ex = E_i[64 * (bt >> 4) + 16 * rg4 + (bt & 15)]; \
            const unsigned char* rp = (TAB) + (size_t)ex * 1024 + 16 * p16; _Pragma("unroll") for (int i = 0; i < 4; ++i) buf[j][i] = *(const u32x4*)(rp + 256 * i); } } while (0)
        u32x4 bA[NBB][4], bB[NBB][4];
        float act0 = 0.f, act1 = 0.f;
#define P6_COMPU(buf, bt0) do { _Pragma("unroll") for (int j = 0; j < NBB; ++j) { const int bt = (bt0) + j; f32x2v s2 = (f32x2v){0.f, 0.f}; \
            _Pragma("unroll") for (int i = 0; i < 4; ++i) { const unsigned uu[4] = {buf[j][i].x, buf[j][i].y, buf[j][i].z, buf[j][i].w}; \
                _Pragma("unroll") for (int w = 0; w < 4; ++w) { const f32x2v lo = __builtin_amdgcn_cvt_pk_f32_fp8((int)uu[w], false), hi = __builtin_amdgcn_cvt_pk_f32_fp8((int)uu[w], true); \
                    s2 = __builtin_elementwise_fma(lo, xf[i][2 * w], s2); s2 = __builtin_elementwise_fma(hi, xf[i][2 * w + 1], s2); } } \
            const float s = row_sum_x(s2.x + s2.y); const bool mine = (p16 == (bt & 15)); act0 = (mine && bt < 16) ? s : act0; act1 = (mine && bt >= 16) ? s : act1; } } while (0)
        P6_LOADB(bA, UB, 0);
#pragma unroll 1
        for (int g = 0; g < 32; g += 2 * NBB) { P6_LOADB(bB, UB, g + NBB); P6_COMPU(bA, g); if (g + 2 * NBB < 32) P6_LOADB(bA, UB, g + 2 * NBB); P6_COMPU(bB, g + NBB); }
        P6_LOADB(bA, VB, 0);
        LAS float* E_c = E_s;
        { const float c0 = gsm[0] * gelu_exact(act0 * (1.0f / 512.0f)) * (1.0f / 32.0f), c1 = gsm[1] * gelu_exact(act1 * (1.0f / 512.0f)) * (1.0f / 32.0f);
          LDS_WAIT(); E_c[lane] = c0; E_c[lane + 64] = c1; LDS_WAIT(); }
        f32x2v acc2[4][8];
#pragma unroll
        for (int i = 0; i < 4; ++i)
#pragma unroll
            for (int k = 0; k < 8; ++k) acc2[i][k] = (f32x2v){0.f, 0.f};
#define P6_COMPV(buf, bt0) do { _Pragma("unroll") for (int j = 0; j < NBB; ++j) { const int bt = (bt0) + j; const float cf = E_c[64 * (bt >> 4) + 16 * rg4 + (bt & 15)]; const f32x2v cf2 = (f32x2v){cf, cf}; \
            _Pragma("unroll") for (int i = 0; i < 4; ++i) { const unsigned vv[4] = {buf[j][i].x, buf[j][i].y, buf[j][i].z, buf[j][i].w}; \
                _Pragma("unroll") for (int w = 0; w < 4; ++w) { const f32x2v lo = __builtin_amdgcn_cvt_pk_f32_fp8((int)vv[w], false), hi = __builtin_amdgcn_cvt_pk_f32_fp8((int)vv[w], true); \
                    acc2[i][2 * w] = __builtin_elementwise_fma(lo, cf2, acc2[i][2 * w]); acc2[i][2 * w + 1] = __builtin_elementwise_fma(hi, cf2, acc2[i][2 * w + 1]); } } } } while (0)
#pragma unroll 1
        for (int g = 0; g < 32; g += 2 * NBB) { P6_LOADB(bB, VB, g + NBB); P6_COMPV(bA, g); if (g + 2 * NBB < 32) P6_LOADB(bA, VB, g + 2 * NBB); P6_COMPV(bB, g + NBB); }
#undef P6_LOADB
#undef P6_COMPU
#undef P6_COMPV
        float ss = 0.f;
#pragma unroll
        for (int i = 0; i < 4; ++i) { const u32x4 h0 = *(const u32x4*)(HB + (size_t)t * DM + 256 * i + 16 * p16), h1 = *(const u32x4*)(HB + (size_t)t * DM + 256 * i + 16 * p16 + 8);
            const unsigned hv[8] = {h0.x, h0.y, h0.z, h0.w, h1.x, h1.y, h1.z, h1.w};
#pragma unroll
            for (int k2 = 0; k2 < 8; ++k2) { float ax = acc2[i][k2].x, ay = acc2[i][k2].y;
                ax += __shfl_xor(ax, 16); ax += __shfl_xor(ax, 32); ay += __shfl_xor(ay, 16); ay += __shfl_xor(ay, 32);
                ax += bf_lo(hv[k2]); ay += bf_hi(hv[k2]); acc2[i][k2] = (f32x2v){ax, ay}; ss += ax * ax + ay * ay; } }
        ss = row_sum_x(ss);
        const float rf = 1.0f / sqrtf(ss * (1.0f / DM) + EPS);
#pragma unroll
        for (int i = 0; i < 4; ++i) { if (i == rg4) { const float* gp = p.gfin + 256 * i + 16 * p16; float* op = p.out + (size_t)t * DM + 256 * i + 16 * p16;
#pragma unroll
                for (int k4 = 0; k4 < 4; ++k4) { const f32x4 g = *(const f32x4*)(gp + 4 * k4);
                    *(f32x4*)(op + 4 * k4) = (f32x4){acc2[i][2 * k4].x * rf * g[0], acc2[i][2 * k4].y * rf * g[1], acc2[i][2 * k4 + 1].x * rf * g[2], acc2[i][2 * k4 + 1].y * rf * g[3]}; } } }
#else
        unsigned xp[8][4];
#pragma unroll
        for (int i = 0; i < 8; ++i) { const u32x4 hw = *(const u32x4*)(HB + (size_t)t * DM + 128 * i + 8 * p16); const f32x4 ga = *(const f32x4*)(p.g2 + 128 * i + 8 * p16), gb = *(const f32x4*)(p.g2 + 128 * i + 8 * p16 + 4);
            xp[i][0] = pk2(bf_lo(hw.x) * rstd * ga[0], bf_hi(hw.x) * rstd * ga[1]); xp[i][1] = pk2(bf_lo(hw.y) * rstd * ga[2], bf_hi(hw.y) * rstd * ga[3]);
            xp[i][2] = pk2(bf_lo(hw.z) * rstd * gb[0], bf_hi(hw.z) * rstd * gb[1]); xp[i][3] = pk2(bf_lo(hw.w) * rstd * gb[2], bf_hi(hw.w) * rstd * gb[3]); }
        float act[2] = {0.f, 0.f};
#pragma unroll
        for (int sl = 0; sl < 2; ++sl) {
#pragma unroll 2
            for (int b16 = 0; b16 < 16; ++b16) {
                const int e = 64 * sl + 16 * rg4 + b16; const int ex = E_i[e];
                const unsigned char* rowp = UB + (size_t)ex * 2048 + 16 * p16;
                float s = 0.f;
#pragma unroll
                for (int i = 0; i < 8; ++i) { const u32x4 uw = *(const u32x4*)(rowp + 256 * i);
                    s = dot2_bf16(uw.x, xp[i][0], s); s = dot2_bf16(uw.y, xp[i][1], s); s = dot2_bf16(uw.z, xp[i][2], s); s = dot2_bf16(uw.w, xp[i][3], s); }
                s = row_sum_x(s);
                act[sl] = (p16 == b16) ? s : act[sl];
            }
        }
        float coef[2];
#pragma unroll
        for (int sl = 0; sl < 2; ++sl) coef[sl] = gsm[sl] * gelu_exact(act[sl]);
        float acc[8][8];
#pragma unroll
        for (int i = 0; i < 8; ++i)
#pragma unroll
            for (int k = 0; k < 8; ++k) acc[i][k] = 0.f;
#pragma unroll
        for (int sl = 0; sl < 2; ++sl) {
#pragma unroll 2
            for (int b16 = 0; b16 < 16; ++b16) {
                const int srcl = (lane & 48) + b16;
                const float cf = __shfl(coef[sl], srcl); const int ex = __shfl(eidx[sl], srcl);
                const unsigned char* rowp = VB + (size_t)ex * 2048 + 16 * p16;
#pragma unroll
                for (int i = 0; i < 8; ++i) { const u32x4 vw = *(const u32x4*)(rowp + 256 * i);
                    acc[i][0] += cf * bf_lo(vw.x); acc[i][1] += cf * bf_hi(vw.x); acc[i][2] += cf * bf_lo(vw.y); acc[i][3] += cf * bf_hi(vw.y);
                    acc[i][4] += cf * bf_lo(vw.z); acc[i][5] += cf * bf_hi(vw.z); acc[i][6] += cf * bf_lo(vw.w); acc[i][7] += cf * bf_hi(vw.w); }
            }
        }
        float ss = 0.f;
#pragma unroll
        for (int i = 0; i < 8; ++i) { const u32x4 hw = *(const u32x4*)(HB + (size_t)t * DM + 128 * i + 8 * p16); const unsigned hv[4] = {hw.x, hw.y, hw.z, hw.w};
#pragma unroll
            for (int k = 0; k < 8; ++k) { float a = acc[i][k]; a += __shfl_xor(a, 16); a += __shfl_xor(a, 32);
                a += (k & 1) ? bf_hi(hv[k >> 1]) : bf_lo(hv[k >> 1]); acc[i][k] = a; ss += a * a; } }
        ss = row_sum_x(ss);
        const float rf = 1.0f / sqrtf(ss * (1.0f / DM) + EPS);
#pragma unroll
        for (int i = 0; i < 8; ++i) { if ((i >> 1) == rg4) { const f32x4 ga = *(const f32x4*)(p.gfin + 128 * i + 8 * p16), gb = *(const f32x4*)(p.gfin + 128 * i + 8 * p16 + 4);
                float* op = p.out + (size_t)t * DM + 128 * i + 8 * p16;
                *(f32x4*)op = (f32x4){acc[i][0] * rf * ga[0], acc[i][1] * rf * ga[1], acc[i][2] * rf * ga[2], acc[i][3] * rf * ga[3]};
                *(f32x4*)(op + 4) = (f32x4){acc[i][4] * rf * gb[0], acc[i][5] * rf * gb[1], acc[i][6] * rf * gb[2], acc[i][7] * rf * gb[3]}; } }
#endif
        LDS_WAIT();
    }
}


__device__ __forceinline__ void row_max4(unsigned k0, unsigned k1, unsigned k2, unsigned k3, unsigned& w0, unsigned& w1, unsigned& w2, unsigned& w3) {
    asm volatile("s_nop 1\n\t"
                 "v_max_u32_dpp %0, %4, %4 quad_perm:[1,0,3,2] row_mask:0xf bank_mask:0xf\n\t"
                 "v_max_u32_dpp %1, %5, %5 quad_perm:[1,0,3,2] row_mask:0xf bank_mask:0xf\n\t"
                 "v_max_u32_dpp %2, %6, %6 quad_perm:[1,0,3,2] row_mask:0xf bank_mask:0xf\n\t"
                 "v_max_u32_dpp %3, %7, %7 quad_perm:[1,0,3,2] row_mask:0xf bank_mask:0xf\n\t"
                 "v_max_u32_dpp %0, %0, %0 quad_perm:[2,3,0,1] row_mask:0xf bank_mask:0xf\n\t"
                 "v_max_u32_dpp %1, %1, %1 quad_perm:[2,3,0,1] row_mask:0xf bank_mask:0xf\n\t"
                 "v_max_u32_dpp %2, %2, %2 quad_perm:[2,3,0,1] row_mask:0xf bank_mask:0xf\n\t"
                 "v_max_u32_dpp %3, %3, %3 quad_perm:[2,3,0,1] row_mask:0xf bank_mask:0xf\n\t"
                 "v_max_u32_dpp %0, %0, %0 row_ror:4 row_mask:0xf bank_mask:0xf\n\t"
                 "v_max_u32_dpp %1, %1, %1 row_ror:4 row_mask:0xf bank_mask:0xf\n\t"
                 "v_max_u32_dpp %2, %2, %2 row_ror:4 row_mask:0xf bank_mask:0xf\n\t"
                 "v_max_u32_dpp %3, %3, %3 row_ror:4 row_mask:0xf bank_mask:0xf\n\t"
                 "v_max_u32_dpp %0, %0, %0 row_ror:8 row_mask:0xf bank_mask:0xf\n\t"
                 "v_max_u32_dpp %1, %1, %1 row_ror:8 row_mask:0xf bank_mask:0xf\n\t"
                 "v_max_u32_dpp %2, %2, %2 row_ror:8 row_mask:0xf bank_mask:0xf\n\t"
                 "v_max_u32_dpp %3, %3, %3 row_ror:8 row_mask:0xf bank_mask:0xf\n\t"
                 "s_nop 1"
                 : "=&v"(w0), "=&v"(w1), "=&v"(w2), "=&v"(w3) : "v"(k0), "v"(k1), "v"(k2), "v"(k3));
}
__device__ __forceinline__ unsigned pkadd_h2(unsigned a, unsigned b) { const h2v x = __builtin_bit_cast(h2v, a), y = __builtin_bit_cast(h2v, b); const h2v s = x + y; return __builtin_bit_cast(unsigned, s); }
constexpr int NT6 = 8;
constexpr int W6_BYTES = 16640;
__device__ __forceinline__ float dpp_f(float v, int ctrl_dummy);
#define DPPF(v, ctrl) __builtin_bit_cast(float, __builtin_amdgcn_update_dpp(0, __builtin_bit_cast(int, (v)), (ctrl), 0xf, 0xf, false))

__device__ __forceinline__ void phase_peer2(const Params& p, LAS unsigned char* lds, int bid, int nb, int vid = -1) {
    const int tid = threadIdx.x, lane = tid & 63, wave = __builtin_amdgcn_readfirstlane(tid >> 6);
    const int p16 = lane & 15, rg4 = lane >> 4, q8 = lane >> 3, p8 = lane & 7;
    const bool b0 = lane & 1, b1 = lane & 2, b2 = lane & 4, c0 = lane & 8, c1 = lane & 16, c2 = lane & 32;
    unsigned char* ws = p.ws;
    const _Float16* SC = (const _Float16*)(ws + WS_SC); const bf16_t* HB = (const bf16_t*)(ws + WS_HB); const float* SSQ = (const float*)(ws + WS_SSQ);
    const unsigned char* UB = (const unsigned char*)(ws + WS_UB); const unsigned char* VB = (const unsigned char*)(ws + WS_VB); unsigned char* XQ = ws + WS_XQ; bf16_t* OS = (bf16_t*)(ws + WS_O);
    LAS unsigned char* wl = lds + wave * W6_BYTES;
    LAS unsigned* CW = (LAS unsigned*)wl;
    LAS unsigned char* XL = wl;
    LAS unsigned short* E16 = (LAS unsigned short*)(wl + 8192);
    LAS _Float16* GC = (LAS _Float16*)(wl + 10240);
    LAS unsigned* E32 = (LAS unsigned*)(wl + 4096);
    LAS float* ACT = (LAS float*)(wl + 12288);
    LAS float* RS = (LAS float*)(wl + 16384);
    const unsigned kbase[4] = {12288u + 4u * lane, 14336u + 4u * lane, 6144u + 4u * lane, ((lane >> 5) ? 5120u : 2048u) + 4u * (lane & 31)};
    constexpr unsigned kshift[4] = {8u, 8u, 8u, 7u};
    unsigned ixc[8];
#pragma unroll
    for (int e = 0; e < 8; ++e) ixc[e] = (unsigned)(127 - (8 * p16 + e));
    int ci = 0, cj = 0; bool cvalid = lane < 50;
    { int l = lane;
      if (l < 16) { ci = 0; cj = l; } else if (l < 24) { ci = 1; cj = l - 16; } else if (l < 29) { ci = 2; cj = l - 24; } else if (l < 33) { ci = 3; cj = l - 29; }
      else if (l < 36) { ci = 4; cj = l - 33; } else if (l < 42) { ci = 5 + (l - 36) / 2; cj = (l - 36) & 1; } else { ci = 8 + (l - 42); cj = 0; } if (!cvalid) { ci = 0; cj = 0; } }
    const int gw = (vid >= 0) ? 4096 * (vid & 7) + 8 * (vid >> 3) + wave : bid * 8 + wave, NGW = (vid >= 0) ? 256 : nb * 8, tend = (vid >= 0) ? 4096 * (vid & 7) + 4096 : NTOK;
#define TOK6(k) min(base + (k) * NGW, NTOK - 1)
    u32x4 raw[2][4]; float ssqv[2];
#define P6_LOADPAIR_AT(b_, k_) do { _Pragma("unroll") for (int v = 0; v < 2; ++v) { const int t = min((b_) + ((k_) + v) * NGW, NTOK - 1); \
            _Pragma("unroll") for (int q = 0; q < 4; ++q) raw[v][q] = *(const u32x4*)(SC + (size_t)t * 2048 + 512 * q + 8 * lane); \
            ssqv[v] = (lane < 16) ? SSQ[((size_t)(t >> 4) * 16 + lane) * 16 + (t & 15)] : 0.f; } } while (0)
    for (int base = gw; base < tend; base += NT6 * NGW) {
        P6_LOADPAIR_AT(base, 0);
#pragma unroll 1
        for (int k = 0; k < NT6; k += 2) {
            float rstd[2];
#pragma unroll
            for (int v = 0; v < 2; ++v) { const float ssq = wave_sum(ssqv[v]); rstd[v] = __builtin_amdgcn_rsqf(ssq * (1.0f / DM) + EPS); }
#pragma unroll
            for (int qq = 0; qq < 2; ++qq) {
                unsigned ka[4][8];
#pragma unroll
                for (int c = 0; c < 4; ++c) { const u32x4 rv = raw[c >> 1][2 * qq + (c & 1)]; const unsigned rw[4] = {rv.x, rv.y, rv.z, rv.w};
#pragma unroll
                    for (int i = 0; i < 4; ++i) {
                        const unsigned kk = rw[i];
                        ka[c][2 * i] = (kk << 16) | ixc[2 * i]; ka[c][2 * i + 1] = (kk & 0xffff0000u) | ixc[2 * i + 1]; } }
#define CE6(u, i, j) do { const unsigned _a = ka[u][i], _b = ka[u][j]; ka[u][i] = _a > _b ? _a : _b; ka[u][j] = _a > _b ? _b : _a; } while (0)
#pragma unroll
                for (int u = 0; u < 4; ++u) {
                    CE6(u, 0, 1); CE6(u, 2, 3); CE6(u, 4, 5); CE6(u, 6, 7);
                    CE6(u, 0, 2); CE6(u, 1, 3); CE6(u, 4, 6); CE6(u, 5, 7);
                    CE6(u, 1, 2); CE6(u, 5, 6);
                    CE6(u, 0, 4); CE6(u, 1, 5); CE6(u, 2, 6); CE6(u, 3, 7);
                    CE6(u, 2, 4); CE6(u, 3, 5);
                    CE6(u, 1, 2); CE6(u, 3, 4); CE6(u, 5, 6);
                }
#undef CE6
                unsigned mine[4] = {0u, 0u, 0u, 0u};
                unsigned head[4], nxt[4], kptr[4] = {0u, 0u, 0u, 0u};
#pragma unroll
                for (int c = 0; c < 4; ++c) { head[c] = ka[c][0]; nxt[c] = ka[c][1];
#pragma unroll
                    for (int j = 0; j < 8; ++j) *(LAS unsigned*)(wl + kbase[c] + (j << kshift[c])) = (j < 7) ? ka[c][j + 1] : 0u; }
#pragma unroll 1
                for (int it = 0; it < 16; ++it) {
                    unsigned Wv[4]; row_max4(head[0], head[1], head[2], head[3], Wv[0], Wv[1], Wv[2], Wv[3]);
#pragma unroll
                    for (int c = 0; c < 4; ++c) {
                        const unsigned W = Wv[c];
                        mine[c] = (p16 == it) ? W : mine[c];
                        const bool win = (head[c] == W);
                        head[c] = win ? nxt[c] : head[c];
                        kptr[c] += win ? 1u : 0u;
                        nxt[c] = *(const LAS unsigned*)(wl + kbase[c] + (kptr[c] << kshift[c]));
                    }
                }
#pragma unroll
                for (int c = 0; c < 4; ++c) { const int g = 4 * (2 * qq + (c & 1)) + rg4; LAS int* A_s = (LAS int*)(wl + 3072 * (c >> 1)); LAS int* A_i = (LAS int*)(wl + 3072 * (c >> 1) + 1024);
                    const unsigned k16 = mine[c] >> 16; const unsigned hbits = k16 ^ ((k16 & 0x8000u) ? 0x8000u : 0xffffu);
                    const float fs = (float)__builtin_bit_cast(_Float16, (unsigned short)hbits);
                    A_s[g * 16 + p16] = (int)__builtin_rintf(fs * 16384.0f); A_i[g * 16 + p16] = 127 - (int)(mine[c] & 0x7fu); }
            }
            if (k + 2 < NT6) P6_LOADPAIR_AT(base, k + 2);
            else {
#pragma unroll
                for (int kk = 0; kk < 4; ++kk) { const bf16_t* hp = HB + (size_t)TOK6(kk) * DM + 16 * lane; raw[kk >> 1][2 * (kk & 1)] = *(const u32x4*)hp; raw[kk >> 1][2 * (kk & 1) + 1] = *(const u32x4*)(hp + 8); } }
            LDS_WAIT();
            {
                int av[4], bc[4]; int iav[4], ibc[4], jp[4], hh[4], bb[4]; unsigned key[4];
#pragma unroll
                for (int c = 0; c < 4; ++c) { const LAS int* A_s = (const LAS int*)(wl + 3072 * (c >> 1)); const LAS int* A_i = (const LAS int*)(wl + 3072 * (c >> 1) + 1024);
                    hh[c] = 4 * (c & 1) + rg4; bb[c] = (2 * hh[c] + 1) * 16; av[c] = A_s[(2 * hh[c]) * 16 + p16] + (1 << 20); iav[c] = A_i[(2 * hh[c]) * 16 + p16] * 128; jp[c] = 0; bc[c] = A_s[bb[c]]; ibc[c] = A_i[bb[c]];
                    key[c] = ((unsigned)(av[c] + bc[c]) << 4) | (unsigned)(15 - p16); }
#pragma unroll 1
                for (int it = 0; it < 16; ++it) {
                    unsigned Wv[4]; row_max4(key[0], key[1], key[2], key[3], Wv[0], Wv[1], Wv[2], Wv[3]);
#pragma unroll
                    for (int c = 0; c < 4; ++c) {
                        const LAS int* A_s = (const LAS int*)(wl + 3072 * (c >> 1)); const LAS int* A_i = (const LAS int*)(wl + 3072 * (c >> 1) + 1024);
                        LAS int* E_i = (LAS int*)(wl + 3072 * (c >> 1) + 2048); LAS int* E_s = (LAS int*)(wl + 3072 * (c >> 1) + 2560);
                        const bool win = (key[c] == Wv[c]);
                        if (win) { E_i[hh[c] * 16 + it] = iav[c] + ibc[c]; E_s[hh[c] * 16 + it] = av[c] + bc[c]; }
                        jp[c] += win ? 1 : 0;
                        bc[c] = A_s[bb[c] + jp[c]]; ibc[c] = A_i[bb[c] + jp[c]];
                        key[c] = ((unsigned)(av[c] + bc[c]) << 4) | (unsigned)(15 - p16);
                    }
                }
            }
            LDS_WAIT();
#pragma unroll
            for (int v = 0; v < 2; ++v) { const LAS int* E_i = (const LAS int*)(wl + 3072 * v + 2048); const LAS int* E_s = (const LAS int*)(wl + 3072 * v + 2560);
#pragma unroll
                for (int sl = 0; sl < 2; ++sl) { const int e = lane + 64 * sl; const float pe = __expf((float)(E_s[e] - E_s[e & ~15]) * (rstd[v] * (1.0f / 16384.0f))); const float den = row_sum_x(pe);
                    const int pos = 16 * (e & 7) + (e >> 3);
                    GC[(k + v) * 128 + pos] = (_Float16)(pe * __builtin_amdgcn_rcpf(den)); E16[(k + v) * 128 + pos] = (unsigned short)E_i[e]; }
                if (lane == 0) RS[k + v] = rstd[v]; }
            LDS_WAIT();
        }
#define P6_LOADH(buf, TAB, jj, kk, hh) do { const u32x4 _iv = *(const LAS u32x4*)(E16 + (kk) * 128 + 16 * q8 + 8 * (hh)); const unsigned _iw[4] = {_iv.x, _iv.y, _iv.z, _iv.w}; \
            _Pragma("unroll") for (int c = 0; c < 8; ++c) { const unsigned _idx = (c & 1) ? (_iw[c >> 1] >> 16) : (_iw[c >> 1] & 0xffffu); \
                buf[c] = *(const u32x4*)((TAB) + (((size_t)(jj) * NEXP + _idx) << 7) + 16 * p8); } } while (0)
#define P6_LOADX(hb, jj, kk) do { const bf16_t* _hp = HB + (size_t)TOK6(kk) * DM + 128 * (jj) + 16 * p8; hb[0] = *(const u32x4*)_hp; hb[1] = *(const u32x4*)(_hp + 8); } while (0)
#pragma unroll 1
        for (int rep_u = 0; rep_u < PROBE_U; ++rep_u) {
            for (int k = 0; k < NT6; ++k) { ACT[k * 128 + lane] = 0.f; ACT[k * 128 + 64 + lane] = 0.f; }
            LDS_WAIT();
            const int n16 = lane & 15, g4 = lane >> 4, c4 = lane & 3, r16 = 4 * g4 + (n16 >> 2);
            const int eoff = 2 * (16 * (r16 & 7) + (r16 >> 3));
            const bool xkeep = ((g4 >> 1) == ((n16 >> 2) & 1)); const bool klo = xkeep && (n16 < 8), khi = xkeep && (n16 >= 8);
            u32x4 bfP[16], bfQ[16];
#define P6_ULOAD(buf, nn) do { const int _j = (nn) / NT6, _k = (nn) % NT6; const LAS unsigned char* _ip = (const LAS unsigned char*)(E16 + _k * 128) + eoff; \
                _Pragma("unroll") for (int T = 0; T < 8; ++T) { const unsigned _idx = *(const LAS unsigned short*)(_ip + 4 * T); \
                    const unsigned char* _rp = UB + (((size_t)_j * NEXP + _idx) << 7) + 16 * c4; buf[2 * T] = *(const u32x4*)_rp; buf[2 * T + 1] = *(const u32x4*)(_rp + 64); } } while (0)
#define P6_PK64(lo, hi) ((long)(((unsigned long long)(hi) << 32) | (unsigned long long)(lo)))
#define P6_UMMA(buf, nn) do { const int k = (nn) % NT6; const LAS unsigned char* _xl = XL + k * 1024 + 256 * ((nn) / NT6) + 32 * c4 + 16 * (g4 & 1); \
                const u32x4 xv0 = *(const LAS u32x4*)_xl, xv1 = *(const LAS u32x4*)(_xl + 128); \
                const i32x8 xa0 = {(int)(klo ? xv0.x : 0u), (int)(klo ? xv0.y : 0u), (int)(klo ? xv0.z : 0u), (int)(klo ? xv0.w : 0u), \
                                   (int)(khi ? xv0.x : 0u), (int)(khi ? xv0.y : 0u), (int)(khi ? xv0.z : 0u), (int)(khi ? xv0.w : 0u)}; \
                const i32x8 xa1 = {(int)(klo ? xv1.x : 0u), (int)(klo ? xv1.y : 0u), (int)(klo ? xv1.z : 0u), (int)(klo ? xv1.w : 0u), \
                                   (int)(khi ? xv1.x : 0u), (int)(khi ? xv1.y : 0u), (int)(khi ? xv1.z : 0u), (int)(khi ? xv1.w : 0u)}; \
                float dsel[2] = {0.f, 0.f}; \
                _Pragma("unroll") for (int T = 0; T < 8; ++T) { f32x4 d = (f32x4){0.f, 0.f, 0.f, 0.f}; \
                    const i32x8 bb0 = {(int)buf[2 * T].x, (int)buf[2 * T].y, (int)buf[2 * T].z, (int)buf[2 * T].w, 0, 0, 0, 0}; \
                    const i32x8 bb1 = {(int)buf[2 * T + 1].x, (int)buf[2 * T + 1].y, (int)buf[2 * T + 1].z, (int)buf[2 * T + 1].w, 0, 0, 0, 0}; \
                    d = __builtin_amdgcn_mfma_scale_f32_16x16x128_f8f6f4(xa0, bb0, d, 0, 4, 0, 0, 0, 0); \
                    d = __builtin_amdgcn_mfma_scale_f32_16x16x128_f8f6f4(xa1, bb1, d, 0, 4, 0, 0, 0, 0); \
                    float pv = (c4 == 0) ? d[0] : ((c4 == 1) ? d[1] : ((c4 == 2) ? d[2] : d[3])); \
                    pv += DPPF(pv, 0xB1); pv += DPPF(pv, 0x4E);                         \
                    dsel[T >> 2] = ((T & 3) == c4) ? pv : dsel[T >> 2]; } \
                  \
                ACT[k * 128 + 16 * c4 + r16] += dsel[0]; ACT[k * 128 + 16 * (c4 + 4) + r16] += dsel[1]; } while (0)
            P6_ULOAD(bfP, 0);
#pragma unroll
            for (int k0 = 0; k0 < NT6; k0 += 4) { u32x4 hr[4][2];
#pragma unroll
                for (int kk = 0; kk < 4; ++kk) { const bf16_t* hp = HB + (size_t)TOK6(k0 + kk) * DM + 16 * lane;
                    if (k0 == 0) { hr[kk][0] = raw[kk >> 1][2 * (kk & 1)]; hr[kk][1] = raw[kk >> 1][2 * (kk & 1) + 1]; }
                    else { hr[kk][0] = *(const u32x4*)hp; hr[kk][1] = *(const u32x4*)(hp + 8); } }
#pragma unroll
                for (int kk = 0; kk < 4; ++kk) { const float sc = RS[k0 + kk] * 16.0f;
                    const unsigned hv[8] = {hr[kk][0].x, hr[kk][0].y, hr[kk][0].z, hr[kk][0].w, hr[kk][1].x, hr[kk][1].y, hr[kk][1].z, hr[kk][1].w}; unsigned xw[4];
#pragma unroll
                    for (int w = 0; w < 4; ++w) { int pk = __builtin_amdgcn_cvt_pk_fp8_f32(bf_lo(hv[2 * w]) * sc, bf_hi(hv[2 * w]) * sc, 0, false);
                        pk = __builtin_amdgcn_cvt_pk_fp8_f32(bf_lo(hv[2 * w + 1]) * sc, bf_hi(hv[2 * w + 1]) * sc, pk, true); xw[w] = (unsigned)pk; }
                    *(LAS u32x4*)(XL + (k0 + kk) * 1024 + 16 * lane) = (u32x4){xw[0], xw[1], xw[2], xw[3]}; } }
            LDS_WAIT();
#pragma unroll 1
            for (int n = 0; n < 4 * NT6; n += 2) {
                P6_ULOAD(bfQ, n + 1); asm volatile("" ::: "memory"); __builtin_amdgcn_sched_barrier(0);
                P6_UMMA(bfP, n); __builtin_amdgcn_sched_barrier(0);
                if (n + 2 < 4 * NT6) P6_ULOAD(bfP, n + 2);
                asm volatile("" ::: "memory"); __builtin_amdgcn_sched_barrier(0);
                P6_UMMA(bfQ, n + 1); __builtin_amdgcn_sched_barrier(0);
            }
#undef P6_ULOAD
#undef P6_UMMA
#undef P6_PK64
        }
        LDS_WAIT();
        u32x4 bfP[16], bfQ[16];
        { const int n16v = lane & 15, g4v = lane >> 4; const unsigned loffv = 8u * (unsigned)n16v; const LAS unsigned short* _ip16 = E16 + 32 * g4v;
#pragma unroll
          for (int q = 0; q < 4; ++q) { const u32x2 _o0 = *(const LAS u32x2*)(_ip16 + 4 * q), _o1 = *(const LAS u32x2*)(_ip16 + 16 + 4 * q);
              const unsigned _ow0[4] = {(_o0.x & 0xffffu) << 7, (_o0.x >> 16) << 7, (_o0.y & 0xffffu) << 7, (_o0.y >> 16) << 7}, _ow1[4] = {(_o1.x & 0xffffu) << 7, (_o1.x >> 16) << 7, (_o1.y & 0xffffu) << 7, (_o1.y >> 16) << 7};
#pragma unroll
              for (int cc = 0; cc < 4; ++cc) { const u32x2 _t0 = *(const u32x2*)(VB + (size_t)(_ow0[cc] + loffv)), _t1 = *(const u32x2*)(VB + (size_t)(_ow1[cc] + loffv));
                  bfP[4 * q + cc] = (u32x4){_t0.x, _t0.y, _t1.x, _t1.y}; } } }
#pragma unroll 1
        for (int k = 0; k < NT6; ++k) {
#pragma unroll
            for (int sl = 0; sl < 2; ++sl) { const int e = lane + 64 * sl, pos = 16 * (e & 7) + (e >> 3); const float a = ACT[k * 128 + e] * (1.0f / 1024.0f);
                const float cfv = (float)GC[k * 128 + pos] * gelu_exact(a);
                CW[k * 128 + pos] = (unsigned)(__builtin_amdgcn_cvt_pk_fp8_f32(cfv * 32.0f, 0.f, 0, false) & 0xff) * 0x01010101u; E32[k * 128 + pos] = (unsigned)E16[k * 128 + pos] << 7; } }
        LDS_WAIT();
#pragma unroll 1
        for (int k = 0; k < NT6; ++k) ACT[k * 64 + lane] = 0.f;
        LDS_WAIT();
#pragma unroll 1
        for (int rep_v = 0; rep_v < PROBE_V; ++rep_v) {
            for (int k = 0; k < NT6; ++k) ACT[k * 64 + lane] = 0.f;
            LDS_WAIT();
            const int n16 = lane & 15, g4 = lane >> 4;
            const unsigned bsel = 0xffu << (8 * (n16 & 3));
            const unsigned M0 = (n16 >> 2) == 0 ? bsel : 0u, M1 = (n16 >> 2) == 1 ? bsel : 0u, M2 = (n16 >> 2) == 2 ? bsel : 0u, M3 = (n16 >> 2) == 3 ? bsel : 0u;
            const int c0 = 16 * n16 + 4 * g4;
            const unsigned loff = 8u * (unsigned)n16;
#define P6_VLOAD(buf, nn) do { const int _j = (nn) / NT6, _k = (nn) % NT6; const LAS unsigned* _ip = E32 + _k * 128 + 32 * g4; \
                const unsigned char* _tb = VB + (size_t)_j * NEXP * 128; \
                _Pragma("unroll") for (int q = 0; q < 4; ++q) { const u32x4 _o0 = *(const LAS u32x4*)(_ip + 4 * q), _o1 = *(const LAS u32x4*)(_ip + 16 + 4 * q); \
                    const unsigned _ow0[4] = {_o0.x, _o0.y, _o0.z, _o0.w}, _ow1[4] = {_o1.x, _o1.y, _o1.z, _o1.w}; \
                    _Pragma("unroll") for (int cc = 0; cc < 4; ++cc) { \
                        const u32x2 _t0 = *(const u32x2*)(_tb + (size_t)(_ow0[cc] + loff)), _t1 = *(const u32x2*)(_tb + (size_t)(_ow1[cc] + loff)); \
                        buf[4 * q + cc] = (u32x4){_t0.x, _t0.y, _t1.x, _t1.y}; } } } while (0)
#define P6_LOADR2(hb, nn) do { hb = *(const u32x2*)(HB + (size_t)TOK6((nn) % NT6) * DM + 256 * ((nn) / NT6) + c0); } while (0)
#define P6_VBODY(buf, nn, hb, FIN) do { const int j = (nn) / NT6, k = (nn) % NT6; const int t = TOK6(k); \
                  \
                u32x2 _pr[3] = {(u32x2){0u, 0u}, (u32x2){0u, 0u}, (u32x2){0u, 0u}}; f32x4 _gf[4] = {(f32x4){0.f, 0.f, 0.f, 0.f}, (f32x4){0.f, 0.f, 0.f, 0.f}, (f32x4){0.f, 0.f, 0.f, 0.f}, (f32x4){0.f, 0.f, 0.f, 0.f}}; \
                if (FIN) { _Pragma("unroll") for (int jj = 0; jj < 3; ++jj) _pr[jj] = *(const u32x2*)(OS + (size_t)t * DM + 256 * jj + c0); \
                           _Pragma("unroll") for (int jj = 0; jj < 4; ++jj) _gf[jj] = *(const f32x4*)(p.gfin + 256 * jj + c0); } \
                const LAS unsigned* _cp = CW + k * 128 + 16 * g4; \
                f32x4 dA = (f32x4){0.f, 0.f, 0.f, 0.f}, dB = (f32x4){0.f, 0.f, 0.f, 0.f}; \
                _Pragma("unroll") for (int q = 0; q < 4; ++q) { \
                    const u32x4 _c0 = *(const LAS u32x4*)(_cp + 4 * q), _d0 = *(const LAS u32x4*)(_cp + 64 + 4 * q); \
                    const unsigned _cl[4] = {_c0.x, _c0.y, _c0.z, _c0.w}, _ch[4] = {_d0.x, _d0.y, _d0.z, _d0.w}; \
                    _Pragma("unroll") for (int cc = 0; cc < 4; ++cc) { const int c = 4 * q + cc; const unsigned _l = _cl[cc], _h = _ch[cc]; \
                        const i32x8 av = {(int)(_l & M0), (int)(_l & M1), (int)(_l & M2), (int)(_l & M3), (int)(_h & M0), (int)(_h & M1), (int)(_h & M2), (int)(_h & M3)}; \
                        const i32x8 bv = {(int)buf[c].x, (int)buf[c].y, (int)buf[c].z, (int)buf[c].w, 0, 0, 0, 0}; \
                        if (c & 1) dB = __builtin_amdgcn_mfma_scale_f32_16x16x128_f8f6f4(av, bv, dB, 0, 4, 0, 0, 0, 0); \
                        else       dA = __builtin_amdgcn_mfma_scale_f32_16x16x128_f8f6f4(av, bv, dA, 0, 4, 0, 0, 0, 0); } } \
                const float hv[4] = {bf_lo(hb.x), bf_hi(hb.x), bf_lo(hb.y), bf_hi(hb.y)}; float o[4]; float ss = 0.f; \
                _Pragma("unroll") for (int r = 0; r < 4; ++r) { o[r] = (dA[r] + dB[r]) * (1.0f / (32.0f * V4_SCALE)) + hv[r]; ss += o[r] * o[r]; } \
                if (!FIN) { *(u32x2*)(OS + (size_t)t * DM + 256 * j + c0) = (u32x2){pk2(o[0], o[1]), pk2(o[2], o[3])};     \
                    ACT[k * 64 + lane] += ss; } \
                else { const float sst = wave_sum(ACT[k * 64 + lane] + ss); const float rf = __builtin_amdgcn_rsqf(sst * (1.0f / DM) + EPS);         \
                    float* op = p.out + (size_t)t * DM + c0; \
                    _Pragma("unroll") for (int jj = 0; jj < 3; ++jj) *(f32x4*)(op + 256 * jj) = (f32x4){bf_lo(_pr[jj].x), bf_hi(_pr[jj].x), bf_lo(_pr[jj].y), bf_hi(_pr[jj].y)} * rf * _gf[jj]; \
                    *(f32x4*)(op + 768) = (f32x4){o[0], o[1], o[2], o[3]} * rf * _gf[3]; } \
                } while (0)
            if (rep_v > 0) P6_VLOAD(bfP, 0);
#pragma unroll 1
            for (int n = 0; n < 3 * NT6; n += 2) {
                u32x2 hr0, hr1; P6_LOADR2(hr0, n); P6_LOADR2(hr1, n + 1);
                asm volatile("" ::: "memory");
                P6_VLOAD(bfQ, n + 1); asm volatile("" ::: "memory"); __builtin_amdgcn_sched_barrier(0);
                P6_VBODY(bfP, n, hr0, 0); __builtin_amdgcn_sched_barrier(0);
                P6_VLOAD(bfP, n + 2);
                asm volatile("" ::: "memory"); __builtin_amdgcn_sched_barrier(0);
                P6_VBODY(bfQ, n + 1, hr1, 0); __builtin_amdgcn_sched_barrier(0);
            }
            asm volatile("s_waitcnt vmcnt(0)" ::: "memory");
#pragma unroll 1
            for (int n = 3 * NT6; n < 4 * NT6; n += 2) {
                u32x2 hr0, hr1; P6_LOADR2(hr0, n); P6_LOADR2(hr1, n + 1);
                asm volatile("" ::: "memory");
                P6_VLOAD(bfQ, n + 1); asm volatile("" ::: "memory"); __builtin_amdgcn_sched_barrier(0);
                P6_VBODY(bfP, n, hr0, 1); __builtin_amdgcn_sched_barrier(0);
                if (n + 2 < 4 * NT6) P6_VLOAD(bfP, n + 2);
                asm volatile("" ::: "memory"); __builtin_amdgcn_sched_barrier(0);
                P6_VBODY(bfQ, n + 1, hr1, 1); __builtin_amdgcn_sched_barrier(0);
            }
        }
        LDS_WAIT();
    }
#undef P6_LOADH
#undef P6_LOADPAIR_AT
#undef P6_LOADX
#undef P6_VLOAD
#undef P6_VBODY
#undef P6_LOADR2
#undef P6_PK64
#undef TOK6
}

#define XB_TMO      128
#define XB_XCNT(j)  (256  + 64 * (j))
#define XB_XSUB(j)  (1280 + 64 * (j))
#define XB_XGEN(j)  (2304 + 64 * (j))
#define XB_TOP      3328
#define XB_TOPGEN   3392
#define XB_LSUB(j)  (3456 + 64 * (j))
#define XB_LGEN(j)  (4480 + 64 * (j))
#define XCD_BAR_WORDS 5504
#define XB_SPIN_CAP (1u << 18)

__device__ __forceinline__ unsigned xb_ld(unsigned* p)              { return __hip_atomic_load(p, __ATOMIC_RELAXED, __HIP_MEMORY_SCOPE_AGENT); }
__device__ __forceinline__ unsigned xb_add(unsigned* p, unsigned v) { return __hip_atomic_fetch_add(p, v, __ATOMIC_RELAXED, __HIP_MEMORY_SCOPE_AGENT); }
__device__ __forceinline__ unsigned xb_xcc_id() { return (unsigned)__builtin_amdgcn_s_getreg((3 << 11) | 20) & 0xFu; }
#define XB_SPIN(cond, bar) do { unsigned _sp = 0; while (cond) { __builtin_amdgcn_s_sleep(1); \
    if ((++_sp & 255u) == 0u) { if (xb_ld(&(bar)[XB_TMO])) break; if (_sp > XB_SPIN_CAP) { atomicAdd(&(bar)[XB_TMO], 1u); break; } } } } while (0)

struct XcdBarrier {
    unsigned* bar; unsigned x;
    volatile LAS unsigned* st;
};

__device__ __forceinline__ XcdBarrier xcd_barrier_post(unsigned* bar, volatile LAS unsigned* st) {
    XcdBarrier b; b.bar = bar; b.x = xb_xcc_id(); b.st = st;
    if (threadIdx.x == 0) st[2] = xb_add(&bar[XB_XCNT(b.x)], 1u);
    return b;
}
__device__ __forceinline__ void xcd_barrier_complete(unsigned* bar, unsigned x, unsigned& nloc, unsigned& nx, unsigned& regular) {
    const unsigned G = gridDim.x * gridDim.y * gridDim.z;
    unsigned sum, cnt, mine, sp = 0u, reg = 0u;
    for (;;) {
        sum = 0u; cnt = 0u; mine = 0u; reg = 1u;
#pragma unroll
        for (unsigned j = 0; j < 16; ++j) { const unsigned c = xb_ld(&bar[XB_XCNT(j)]); sum += c; cnt += (c > 0u) ? 1u : 0u; mine = (j == x) ? c : mine;
            reg = (c == ((j < 8u) ? G / 8u : 0u)) ? reg : 0u; }
        if (sum == G) break;
        reg = 0u;
        __builtin_amdgcn_s_sleep(1);
        if ((++sp & 255u) == 0u) { if (xb_ld(&bar[XB_TMO])) break; if (sp > XB_SPIN_CAP) { atomicAdd(&bar[XB_TMO], 1u); break; } }
    }
    nloc = mine > 0u ? mine : 1u; nx = cnt > 0u ? cnt : 1u; regular = (reg != 0u && sum == G && G == 256u) ? 1u : 0u;
}

__device__ __forceinline__ void xcd_barrier(const XcdBarrier& b) {
    asm volatile("s_waitcnt vmcnt(0)" ::: "memory");
    __syncthreads();
    if (threadIdx.x == 0) {
        unsigned* bar = b.bar;
        __builtin_amdgcn_s_waitcnt(0);
        unsigned nloc = b.st[0], nx = b.st[1];
        if (nloc == 0u) { unsigned rg; xcd_barrier_complete(bar, b.x, nloc, nx, rg); b.st[0] = nloc; b.st[1] = nx; b.st[3] = rg; }
        const unsigned old = xb_add(&bar[XB_XSUB(b.x)], 1u);
        const unsigned gen = old / nloc;
        if (old + 1u == (gen + 1u) * nloc) {
            __builtin_amdgcn_fence(__ATOMIC_RELEASE, "agent");
            asm volatile("s_waitcnt vmcnt(0)" ::: "memory");
            const unsigned og = xb_add(&bar[XB_TOP], 1u);
            const unsigned tg = og / nx;
            if (og + 1u == (tg + 1u) * nx) xb_add(&bar[XB_TOPGEN], 1u);
            else XB_SPIN(xb_ld(&bar[XB_TOPGEN]) == tg, bar);
            __builtin_amdgcn_fence(__ATOMIC_ACQUIRE, "agent");
            xb_add(&bar[XB_XGEN(b.x)], 1u);
            asm volatile("s_waitcnt vmcnt(0)" ::: "memory");
        } else {
            XB_SPIN(xb_ld(&bar[XB_XGEN(b.x)]) == gen, bar);
            __builtin_amdgcn_fence(__ATOMIC_ACQUIRE, "agent");
            asm volatile("s_waitcnt vmcnt(0)" ::: "memory");
        }
    }
    __syncthreads();
}

__device__ __forceinline__ void xcd_local_barrier(const XcdBarrier& b) {
    asm volatile("s_waitcnt vmcnt(0)" ::: "memory");
    __syncthreads();
    if (threadIdx.x == 0) {
        unsigned* bar = b.bar;
        __builtin_amdgcn_s_waitcnt(0);
        const unsigned nloc = b.st[0];
        const unsigned old = xb_add(&bar[XB_LSUB(b.x)], 1u);
        const unsigned gen = old / nloc;
        if (old + 1u == (gen + 1u) * nloc) xb_add(&bar[XB_LGEN(b.x)], 1u);
        else XB_SPIN(xb_ld(&bar[XB_LGEN(b.x)]) == gen, bar);
        __builtin_amdgcn_fence(__ATOMIC_ACQUIRE, "agent");
        asm volatile("s_waitcnt vmcnt(0)" ::: "memory");
    }
    __syncthreads();
}

__global__ void __launch_bounds__(512, 2) mk_fwd(Params p) {
    extern __shared__ __attribute__((aligned(16))) unsigned char lds_raw[];
    LAS unsigned char* lds = (LAS unsigned char*)lds_raw;
    const int bid = blockIdx.x, nb = gridDim.x;
    unsigned char* ws = p.ws;
#define IN(k) (p.ph_lo <= (k) && (k) < p.ph_hi)
#define SEAM(k) do { if (IN(k) && IN((k) + 1)) { xcd_barrier(bar); } } while (0)
#define SEAMX(k) do { if (IN(k) && IN((k) + 1)) { if (xreg) xcd_local_barrier(bar); else xcd_barrier(bar); } } while (0)
    if (threadIdx.x < 4) ((volatile LAS unsigned*)(lds + LDS_BYTES - 16))[threadIdx.x] = 0u;
    __syncthreads();
    const XcdBarrier bar = xcd_barrier_post((unsigned*)(ws + WS_CTL) + 4096, (volatile LAS unsigned*)(lds + LDS_BYTES - 16));
    if (IN(0)) phase0(p, lds, bid, nb);
    SEAM(0);
    if (IN(1)) {
        const int nw1 = gemm1_workers(nb);
        if (bid < nw1) {
            pg8::Gemm g{(const bf16_t*)(ws + WS_XN), (const bf16_t*)(ws + WS_WIN), MROWS, NP1, DM}; pg8::StaticOrder S; S.init(MROWS, NP1, nw1, bid);
            EpiProj E{(bf16_t*)(ws + WS_PROJ), (bf16_t*)(ws + WS_QK), (_Float16*)(ws + WS_LA), p.gb, (const float2*)(ws + WS_ROPE)};
            pg8::gemm_phase<EpiProj, pg8::StaticOrder, true, true>(lds, g, S, E);
        } else convert_tables_stream(p, (bid - nw1) * 8 + (int)(threadIdx.x >> 6), (nb - nw1) * 8, tab_split(nb) / 64, NEXP / 2);
    }
    SEAM(1);
    if (IN(2)) attn_pass<false>(p, lds, bid, nb);
    SEAM(2);
    const volatile LAS unsigned* bst = (const volatile LAS unsigned*)(lds + LDS_BYTES - 16);
    const bool xreg = IN(0) && IN(6) && bst[3] != 0u;
    const int vid = xreg ? (int)(8u * bst[2] + bar.x) : -1;
    if (IN(3)) { const int vx = vid & 7, vr = vid >> 3; attn_pass<true>(p, lds, bid, nb, xreg ? (4 * (vx & 1) + (vr & 3)) + 8 * ((vr >> 2) + 8 * (vx >> 1)) : -1); }
    SEAMX(3);
    if (IN(4)) {
        pg8::Gemm g{(const bf16_t*)(ws + WS_O), (const bf16_t*)(ws + WS_WOUT), NTOK, DM, DM}; pg8::StaticOrder S; S.init(NTOK, DM, nb, xreg ? vid : bid);
        EpiRes E{(bf16_t*)(ws + WS_HB), (float*)(ws + WS_SSQ), (const float*)(ws + WS_RINV), (const float*)(ws + WS_GINV)};
        pg8::gemm_phase<EpiRes, pg8::StaticOrder, true, true>(lds, g, S, E);
    }
    SEAMX(4);
    if (IN(5)) {
        pg8::Gemm g{(const bf16_t*)(ws + WS_HB), (const bf16_t*)(ws + WS_WS), NTOK, 2048, DM}; pg8::StaticOrder S; S.init(NTOK, 2048, nb, xreg ? vid : bid);
        EpiF16 E{(_Float16*)(ws + WS_SC)};
        pg8::gemm_phase<EpiF16, pg8::StaticOrder, true, true>(lds, g, S, E);
    }
    SEAMX(5);
    if (IN(6)) phase_peer2(p, lds, bid, nb, vid);
#undef IN
#undef SEAM
}

#ifndef MK_FUSED
#define MK_FUSED 1
#endif
extern "C" void kernel_launch(void* const* d_in, const int* in_sizes, int n_in, void* d_out, int out_size, void* d_ws, size_t ws_size, hipStream_t stream) {
    static int grid = 0;
    if (grid == 0) {
        if (n_in != 16 || in_sizes[0] != NTOK * DM || out_size != NTOK * DM || ws_size < WS_END) {
            fprintf(stderr, "kernel_launch: unexpected shapes (n_in %d, in0 %d, out %d, ws %zu); nothing launched\n", n_in, n_in > 0 ? in_sizes[0] : -1, out_size, ws_size); grid = -1; return; }
        int dev = 0, cus = 0, per_cu = 0;
        hipGetDevice(&dev); hipDeviceGetAttribute(&cus, hipDeviceAttributeMultiprocessorCount, dev);
        if (hipFuncSetAttribute((const void*)mk_fwd, hipFuncAttributeMaxDynamicSharedMemorySize, LDS_BYTES) != hipSuccess) { fprintf(stderr, "kernel_launch: hipFuncSetAttribute failed\n"); grid = -1; return; }
        if (hipOccupancyMaxActiveBlocksPerMultiprocessor(&per_cu, (const void*)mk_fwd, 512, LDS_BYTES) != hipSuccess || per_cu < 1) { fprintf(stderr, "kernel_launch: occupancy query failed (%d)\n", per_cu); (void)hipGetLastError(); per_cu = 1; }
        grid = cus * (per_cu < 1 ? 1 : 1);
        fprintf(stderr, "kernel_launch: %d CUs, occupancy %d/CU, grid %d\n", cus, per_cu, grid);
    }
    if (grid < 0) return;
    (void)hipMemsetAsync((char*)d_ws + WS_CTL, 0, 65536, stream);
    Params p{};
    p.x = (const float*)d_in[0]; p.meta = (const float*)d_in[1]; p.g1 = (const float*)d_in[2]; p.w_in = (const float*)d_in[3]; p.gw2 = (const float*)d_in[4]; p.gb = (const float*)d_in[5];
    p.gla_gain = (const float*)d_in[6]; p.ret_gain = (const float*)d_in[7]; p.ret_bias = (const float*)d_in[8]; p.w_out = (const float*)d_in[9]; p.g2 = (const float*)d_in[10];
    p.w_q = (const float*)d_in[11]; p.subkeys = (const float*)d_in[12]; p.pu = (const float*)d_in[13]; p.pv = (const float*)d_in[14]; p.gfin = (const float*)d_in[15];
    p.out = (float*)d_out; p.ws = (unsigned char*)d_ws;
#if MK_FUSED
    p.ph_lo = 0; p.ph_hi = NPHASE;
    void* args[] = {&p};
    hipError_t e = hipLaunchCooperativeKernel((const void*)mk_fwd, dim3(grid), dim3(512), args, LDS_BYTES, stream);
    if (e != hipSuccess) fprintf(stderr, "kernel_launch: cooperative launch failed: %s (grid %d)\n", hipGetErrorString(e), grid);
#else
    { const int order[7] = {0, 1, 2, 3, 4, 5, 6}; for (int i = 0; i < 7; ++i) { p.ph_lo = order[i]; p.ph_hi = order[i] + 1; hipLaunchKernelGGL(mk_fwd, dim3(grid), dim3(512), LDS_BYTES, stream, p); } }
#endif
}
```
